# Optimizing an MI355X kernel written in HIP

```python
import math
import jax, jax.numpy as jnp
from jax import lax
import numpy as np

D_MODEL = 1024
BATCH = 1
SEQ = 16384
DEPTH = 2

N_MEM = 256
EPS = 1e-5
NEG_INF = -1e30
H_A = 8
HD_A = 64
D_A = H_A * HD_A
WIN_DIL = ((128, 1), (512, 4), (2048, 16))
BLK = 128
D_B = D_MODEL - D_A
S5_CH = 16
S5_G = D_B // S5_CH
S5_P = 64
D_IN = 3 * D_A + D_B
NUM_BUCKETS = 32
REL_MAX_DIST = 2048
H_X = 4
HD_X = 128
D_X = H_X * HD_X
N_EXPERTS = 32
TOP_K = 4
D_FF = D_MODEL
SWIGLU_ALPHA = 1.702
SWIGLU_LIMIT = 7.0
MOE_BLOCK = 128

kernel_name = "hybrid_dilated_s5_moe_trunk"


def _rmsnorm(x, g):
    xf = x.astype(jnp.float32)
    y = xf * lax.rsqrt(jnp.mean(xf * xf, axis=-1, keepdims=True) + EPS)
    return (y * g.astype(jnp.float32)).astype(x.dtype)


def _t5_bucket(n):
    max_exact = NUM_BUCKETS // 2
    nf = jnp.maximum(n, 1).astype(jnp.float32)
    large = max_exact + (jnp.log(nf / max_exact) / math.log(REL_MAX_DIST / max_exact)
                         * (NUM_BUCKETS - max_exact)).astype(jnp.int32)
    large = jnp.minimum(large, NUM_BUCKETS - 1)
    return jnp.where(n < max_exact, n, large)


def _dilated_branch(q, k, v, rel_bias, window, dil):
    Bsz, S, H, Dh = q.shape
    steps = window // dil
    span = dil * BLK
    s_pad = -(-S // span) * span
    L = s_pad // dil
    nb = L // BLK

    def to_sub(t):
        t = jnp.pad(t, ((0, 0), (0, s_pad - S), (0, 0), (0, 0)))
        t = t.reshape(Bsz, L, dil, H, Dh).transpose(0, 2, 1, 3, 4)
        return t.reshape(Bsz, dil, nb, BLK, H, Dh)

    def with_prev(t):
        prev = jnp.pad(t[:, :, :-1], ((0, 0), (0, 0), (1, 0), (0, 0), (0, 0), (0, 0)))
        return jnp.concatenate([prev, t], axis=3)

    qs = to_sub(q)
    kb = with_prev(to_sub(k))
    vb = with_prev(to_sub(v))

    qi = jnp.arange(BLK, dtype=jnp.int32)[:, None]
    ki = jnp.arange(2 * BLK, dtype=jnp.int32)[None, :]
    dist = BLK + qi - ki
    in_win = (dist >= 0) & (dist <= steps)
    bias = rel_bias[_t5_bucket(jnp.clip(dist, 0, steps) * dil)]
    bias = bias.transpose(2, 0, 1).astype(jnp.float32)
    has_prev = jnp.arange(nb)[:, None, None] > 0
    mask = in_win[None] & (has_prev | (ki >= BLK)[None])

    s = jnp.einsum('bdnqhe,bdnkhe->bdnhqk', qs, kb,
                   preferred_element_type=jnp.float32) * (Dh ** -0.5) + bias
    s = jnp.where(mask[:, None], s, NEG_INF)
    m = jnp.max(s, axis=-1)
    e = jnp.exp(s - m[..., None])
    den = jnp.sum(e, axis=-1)
    num = jnp.einsum('bdnhqk,bdnkhe->bdnqhe', e, vb.astype(jnp.float32))

    def from_sub(t):
        t = t.reshape((Bsz, dil, L) + t.shape[4:])
        t = jnp.swapaxes(t, 1, 2)
        return t.reshape((Bsz, s_pad) + t.shape[3:])[:, :S]

    return from_sub(num), from_sub(jnp.swapaxes(den, 3, 4)), from_sub(jnp.swapaxes(m, 3, 4))


def _dilated_attention(q, k, v, rel_bias):
    nums, dens, maxs = [], [], []
    for window, dil in WIN_DIL:
        n_, d_, m_ = _dilated_branch(q, k, v, rel_bias, window, dil)
        nums.append(n_)
        dens.append(d_)
        maxs.append(m_)
    ms = jnp.stack(maxs)
    w = jnp.exp(ms - jnp.max(ms, axis=0, keepdims=True))
    num = jnp.einsum('pbsh,pbshe->bshe', w, jnp.stack(nums))
    den = jnp.einsum('pbsh,pbsh->bsh', w, jnp.stack(dens))
    return num / den[..., None]


def _linear_recurrence(left, right):
    a_l, b_l = left
    a_r, b_r = right
    return a_r * a_l, a_r * b_l + b_r


def _s5_mixer(u, a_re, a_im, b_re, b_im, c_re, c_im, log_dt, d_skip, w_glu, b_glu):
    f32 = jnp.float32
    Bsz, S, _ = u.shape
    uf = u.astype(f32).reshape(Bsz, S, S5_G, S5_CH)
    lam = lax.complex(a_re.astype(f32), a_im.astype(f32))
    dt = jnp.exp(log_dt.astype(f32))[:, None]
    a_bar = jnp.exp(lam * dt)
    b_bar = ((a_bar - 1.0) / lam)[..., None] * lax.complex(b_re.astype(f32), b_im.astype(f32))
    bu = jnp.einsum('gpc,bsgc->bsgp', b_bar, uf.astype(jnp.complex64))
    a = jnp.broadcast_to(a_bar, bu.shape)
    _, state = lax.associative_scan(_linear_recurrence, (a, bu), axis=1)
    c = lax.complex(c_re.astype(f32), c_im.astype(f32))
    y = jnp.einsum('gcp,bsgp->bsgc', c, state).real + d_skip.astype(f32).reshape(S5_G, S5_CH) * uf
    y = jax.nn.gelu(y.reshape(Bsz, S, D_B), approximate=False)
    gate = jax.nn.sigmoid(y @ w_glu.astype(f32) + b_glu.astype(f32))
    return (y * gate).astype(u.dtype)


def _memory_attention(hn, mem_n, w_q, w_kv, w_o):
    Bsz, S, _ = hn.shape
    n_mem = mem_n.shape[1]
    q = (hn @ w_q).reshape(Bsz, S, H_X, HD_X)
    kv = (mem_n @ w_kv).reshape(Bsz, n_mem, 2, H_X, HD_X)
    k, v = kv[:, :, 0], kv[:, :, 1]
    s = jnp.einsum('bshe,bmhe->bhsm', q, k, preferred_element_type=jnp.float32) * (HD_X ** -0.5)
    p = jax.nn.softmax(s, axis=-1)
    o = jnp.einsum('bhsm,bmhe->bshe', p.astype(v.dtype), v).reshape(Bsz, S, D_X)
    return o @ w_o


def _moe(hn, w_router, b_router, w1, b1, w2, b2):
    Bsz, S, D = hn.shape
    T = Bsz * S
    TK = T * TOP_K
    xt = hn.reshape(T, D)
    logits = jnp.einsum('td,de->te', xt, w_router,
                        preferred_element_type=jnp.float32) + b_router.astype(jnp.float32)
    top_val, top_idx = lax.top_k(logits, TOP_K)
    gates = jax.nn.softmax(top_val, axis=-1)
    flat_e = top_idx.reshape(TK)
    order = jnp.argsort(flat_e)
    e_sorted = flat_e[order]
    tok_sorted = order // TOP_K
    g_sorted = gates.reshape(TK)[order]
    counts = jnp.bincount(flat_e, length=N_EXPERTS)
    padded = (counts + MOE_BLOCK - 1) // MOE_BLOCK * MOE_BLOCK
    start = jnp.cumsum(counts) - counts
    pend = jnp.cumsum(padded)
    pstart = pend - padded
    dest = pstart[e_sorted] + jnp.arange(TK, dtype=jnp.int32) - start[e_sorted]
    n_rows = TK + N_EXPERTS * MOE_BLOCK
    n_blk = n_rows // MOE_BLOCK
    xpad = jnp.zeros((n_rows, D), hn.dtype).at[dest].set(xt[tok_sorted])
    blk_e = jnp.minimum(jnp.searchsorted(pend, jnp.arange(n_blk) * MOE_BLOCK, side='right'),
                        N_EXPERTS - 1)

    def expert_block(args):
        xb, e = args
        hb = xb @ w1[e] + b1[e]
        x_glu = jnp.minimum(hb[:, :D_FF], SWIGLU_LIMIT)
        x_lin = jnp.clip(hb[:, D_FF:], -SWIGLU_LIMIT, SWIGLU_LIMIT)
        act = x_glu * jax.nn.sigmoid(SWIGLU_ALPHA * x_glu) * (x_lin + 1.0)
        return act @ w2[e] + b2[e]

    out = lax.map(expert_block, (xpad.reshape(n_blk, MOE_BLOCK, D), blk_e)).reshape(n_rows, D)
    y = jax.ops.segment_sum(out[dest] * g_sorted[:, None].astype(out.dtype), tok_sorted,
                            num_segments=T)
    return y.reshape(Bsz, S, D)


def setup_inputs(seed: int = 0) -> dict:
    key = jax.random.key(seed)
    ks = iter(jax.random.split(key, 40))

    def nrm(shape, scale):
        return scale * jax.random.normal(next(ks), shape, jnp.float32)

    def gain(shape):
        return 1.0 + nrm(shape, 0.01)

    L = DEPTH
    n_idx = jnp.arange(S5_P, dtype=jnp.float32)
    return {
        "x": nrm((BATCH, SEQ, D_MODEL), 1.0),
        "mem": nrm((BATCH, N_MEM, D_MODEL), 1.0),
        "rel_bias": nrm((NUM_BUCKETS, H_A), 0.2),
        "norm_mix": gain((L, D_MODEL)),
        "w_in": nrm((L, D_MODEL, D_IN), D_MODEL ** -0.5),
        "s5_a_re": -0.5 + nrm((L, S5_G, S5_P), 0.01),
        "s5_a_im": math.pi * n_idx + nrm((L, S5_G, S5_P), 0.01),
        "s5_b_re": nrm((L, S5_G, S5_P, S5_CH), (2 * S5_CH) ** -0.5),
        "s5_b_im": nrm((L, S5_G, S5_P, S5_CH), (2 * S5_CH) ** -0.5),
        "s5_c_re": nrm((L, S5_G, S5_CH, S5_P), (2 * S5_P) ** -0.5),
        "s5_c_im": nrm((L, S5_G, S5_CH, S5_P), (2 * S5_P) ** -0.5),
        "s5_log_dt": jax.random.uniform(next(ks), (L, S5_G), jnp.float32,
                                        math.log(1e-3), math.log(1e-1)),
        "s5_d": nrm((L, D_B), 1.0),
        "w_glu": nrm((L, D_B, D_B), D_B ** -0.5),
        "b_glu": nrm((L, D_B), 0.01),
        "g_out_attn": gain((L, D_A)),
        "g_out_ssm": gain((L, D_B)),
        "w_out": nrm((L, D_MODEL, D_MODEL), D_MODEL ** -0.5),
        "norm_xattn": gain((L, D_MODEL)),
        "norm_mem": gain((L, D_MODEL)),
        "w_xq": nrm((L, D_MODEL, D_X), D_MODEL ** -0.5),
        "w_xkv": nrm((L, D_MODEL, 2 * D_X), D_MODEL ** -0.5),
        "w_xo": nrm((L, D_X, D_MODEL), D_X ** -0.5),
        "norm_moe": gain((L, D_MODEL)),
        "w_router": nrm((L, D_MODEL, N_EXPERTS), D_MODEL ** -0.5),
        "b_router": nrm((L, N_EXPERTS), 0.01),
        "w1": nrm((L, N_EXPERTS, D_MODEL, 2 * D_FF), D_MODEL ** -0.5),
        "b1": nrm((L, N_EXPERTS, 2 * D_FF), 0.01),
        "w2": nrm((L, N_EXPERTS, D_FF, D_MODEL), D_FF ** -0.5),
        "b2": nrm((L, N_EXPERTS, D_MODEL), 0.01),
        "norm_final": gain((D_MODEL,)),
    }


def reference(x, mem, rel_bias, norm_mix, w_in, s5_a_re, s5_a_im, s5_b_re, s5_b_im, s5_c_re, s5_c_im,
              s5_log_dt, s5_d, w_glu, b_glu, g_out_attn, g_out_ssm, w_out, norm_xattn, norm_mem,
              w_xq, w_xkv, w_xo, norm_moe, w_router, b_router, w1, b1, w2, b2, norm_final):
    Bsz, S, _ = x.shape
    h = x
    for l in range(DEPTH):
        xn = _rmsnorm(h, norm_mix[l])
        proj = xn @ w_in[l]
        q = proj[..., 0:D_A].reshape(Bsz, S, H_A, HD_A)
        k = proj[..., D_A:2 * D_A].reshape(Bsz, S, H_A, HD_A)
        v = proj[..., 2 * D_A:3 * D_A].reshape(Bsz, S, H_A, HD_A)
        u = proj[..., 3 * D_A:]
        y_a = _dilated_attention(q, k, v, rel_bias).reshape(Bsz, S, D_A).astype(h.dtype)
        y_b = _s5_mixer(u, s5_a_re[l], s5_a_im[l], s5_b_re[l], s5_b_im[l], s5_c_re[l], s5_c_im[l],
                        s5_log_dt[l], s5_d[l], w_glu[l], b_glu[l])
        mix = jnp.concatenate([_rmsnorm(y_a, g_out_attn[l]), _rmsnorm(y_b, g_out_ssm[l])], axis=-1)
        h = h + mix @ w_out[l]
        h = h + _memory_attention(_rmsnorm(h, norm_xattn[l]), _rmsnorm(mem, norm_mem[l]),
                                  w_xq[l], w_xkv[l], w_xo[l])
        h = h + _moe(_rmsnorm(h, norm_moe[l]), w_router[l], b_router[l], w1[l], b1[l], w2[l], b2[l])
    return _rmsnorm(h, norm_final)
```

```cpp
#include <hip/hip_runtime.h>
#include <stdint.h>

#define SEQ 16384
#define DM 1024
#define DIN 2048
#define NMEM 256
#define NEXP 32
#define TOPK 4
#define DFF 1024
#define NCHUNK 128

__global__ void k_rmsnorm(const float* in, int in_ld, const float* g, float* out, int out_ld, int rows, int D) {
    int wave = (blockIdx.x * blockDim.x + threadIdx.x) >> 6, lane = threadIdx.x & 63;
    if (wave >= rows) return;
    const float* r = in + (size_t)wave * in_ld;
    float ss = 0.f;
    for (int i = lane; i < D; i += 64) { float v = r[i]; ss += v * v; }
    for (int o = 32; o; o >>= 1) ss += __shfl_xor(ss, o);
    float sc = rsqrtf(ss / (float)D + 1e-5f);
    for (int i = lane; i < D; i += 64) out[(size_t)wave * out_ld + i] = r[i] * sc * g[i];
}

enum { EP_STORE = 0, EP_RESID = 1, EP_GLU = 2, EP_MOE1 = 3, EP_MOE2 = 4 };
struct GArgs {
    const float* A; int lda; const float* B; int ldb; float* C; int ldc; int M, N, K;
    const float* bias; const float* aux;
    const int* rowtok; const int* offs; const int* cnts;
    size_t strideB; int strideBias;
};
template <int EP> __global__ void __launch_bounds__(256) k_gemm(GArgs a) {
    __shared__ float As[16][68];
    __shared__ float Bs[16][68];
    __shared__ float Bs2[EP == EP_MOE1 ? 16 : 1][68];
    const int e = blockIdx.z;
    int M = a.M, rowbase = 0;
    if (EP == EP_MOE1 || EP == EP_MOE2) { M = a.cnts[e]; rowbase = a.offs[e]; }
    const int m0 = blockIdx.y * 64, n0 = blockIdx.x * 64;
    if (m0 >= M) return;
    const float* B = a.B + (size_t)e * a.strideB;
    const float* bias = a.bias ? a.bias + (size_t)e * a.strideBias : nullptr;
    const int tid = threadIdx.x, ty = tid >> 4, tx = tid & 15;
    const int lr = tid >> 2, lk = (tid & 3) * 4;
    int ar = m0 + lr; if (ar >= M) ar = M - 1;
    const float* Arow;
    if (EP == EP_MOE1) Arow = a.A + (size_t)a.rowtok[rowbase + ar] * a.lda;
    else Arow = a.A + (size_t)(rowbase + ar) * a.lda;
    const int bk = tid >> 4, bn = (tid & 15) * 4;
    float acc[4][4], acc2[4][4];
#pragma unroll
    for (int i = 0; i < 4; ++i)
#pragma unroll
        for (int j = 0; j < 4; ++j) { acc[i][j] = 0.f; acc2[i][j] = 0.f; }
    for (int k0 = 0; k0 < a.K; k0 += 16) {
        float4 av = *(const float4*)(Arow + k0 + lk);
        float4 bv = *(const float4*)(B + (size_t)(k0 + bk) * a.ldb + n0 + bn);
        float4 bv2 = bv;
        if (EP == EP_MOE1) bv2 = *(const float4*)(B + (size_t)(k0 + bk) * a.ldb + DFF + n0 + bn);
        __syncthreads();
        As[lk + 0][lr] = av.x; As[lk + 1][lr] = av.y; As[lk + 2][lr] = av.z; As[lk + 3][lr] = av.w;
        *(float4*)&Bs[bk][bn] = bv;
        if (EP == EP_MOE1) *(float4*)&Bs2[bk][bn] = bv2;
        __syncthreads();
#pragma unroll
        for (int kk = 0; kk < 16; ++kk) {
            float4 a4 = *(const float4*)&As[kk][ty * 4];
            float4 b4 = *(const float4*)&Bs[kk][tx * 4];
            float aa[4] = {a4.x, a4.y, a4.z, a4.w}, bb[4] = {b4.x, b4.y, b4.z, b4.w};
#pragma unroll
            for (int i = 0; i < 4; ++i)
#pragma unroll
                for (int j = 0; j < 4; ++j) acc[i][j] += aa[i] * bb[j];
            if (EP == EP_MOE1) {
                float4 c4 = *(const float4*)&Bs2[kk][tx * 4];
                float cc[4] = {c4.x, c4.y, c4.z, c4.w};
#pragma unroll
                for (int i = 0; i < 4; ++i)
#pragma unroll
                    for (int j = 0; j < 4; ++j) acc2[i][j] += aa[i] * cc[j];
            }
        }
    }
#pragma unroll
    for (int i = 0; i < 4; ++i) {
        const int r = m0 + ty * 4 + i;
        if (r >= M) continue;
        const size_t crow = (size_t)(rowbase + r) * a.ldc;
#pragma unroll
        for (int j = 0; j < 4; ++j) {
            const int c = n0 + tx * 4 + j;
            float v = acc[i][j];
            if (EP == EP_STORE) { if (bias) v += bias[c]; }
            else if (EP == EP_RESID) v += a.aux[crow + c];
            else if (EP == EP_GLU) { float y = a.aux[crow + c]; v = y / (1.f + expf(-(v + bias[c]))); }
            else if (EP == EP_MOE1) {
                float g = fminf(v + bias[c], 7.f);
                float l = fminf(fmaxf(acc2[i][j] + bias[DFF + c], -7.f), 7.f);
                v = g / (1.f + expf(-1.702f * g)) * (l + 1.f);
            } else if (EP == EP_MOE2) v += bias[c];
            a.C[crow + c] = v;
        }
    }
}

__device__ __forceinline__ int t5_bucket(int n) {
    if (n < 16) return n;
    float v = logf((float)n / 16.f) / 4.852030263919617f * 16.f;
    int large = 16 + (int)v;
    return large < 31 ? large : 31;
}
__global__ void __launch_bounds__(256) k_dilattn(const float* proj, const float* rel_bias, float* ya) {
    __shared__ float ps[4][392];
    const int w = threadIdx.x >> 6, lane = threadIdx.x & 63;
    const int gw = blockIdx.x * 4 + w;
    const int pos = gw >> 3, h = gw & 7;
    const float* q = proj + (size_t)pos * DIN + h * 64;
    float sc[7]; float mx = -1e30f;
#pragma unroll
    for (int it = 0; it < 7; ++it) {
        const int i = it * 64 + lane; float s = -1e30f;
        if (i < 387) {
            const int b = i / 129, d = i - b * 129, dil = 1 << (2 * b), kp = pos - d * dil;
            if (kp >= 0) {
                const float* kr = proj + (size_t)kp * DIN + 512 + h * 64;
                float dot = 0.f;
                for (int e = 0; e < 64; e += 4) { float4 qa = *(const float4*)(q + e), ka = *(const float4*)(kr + e); dot += qa.x * ka.x + qa.y * ka.y + qa.z * ka.z + qa.w * ka.w; }
                s = dot * 0.125f + rel_bias[t5_bucket(d * dil) * 8 + h];
            }
        }
        sc[it] = s; mx = fmaxf(mx, s);
    }
    for (int o = 32; o; o >>= 1) mx = fmaxf(mx, __shfl_xor(mx, o));
    float den = 0.f;
#pragma unroll
    for (int it = 0; it < 7; ++it) {
        const int i = it * 64 + lane;
        float p = (sc[it] > -1e29f) ? expf(sc[it] - mx) : 0.f;
        den += p;
        if (i < 387) ps[w][i] = p;
    }
    for (int o = 32; o; o >>= 1) den += __shfl_xor(den, o);
    __syncthreads();
    float acc = 0.f;
    for (int i = 0; i < 387; ++i) {
        const int b = i / 129, d = i - b * 129, dil = 1 << (2 * b), kp = pos - d * dil;
        if (kp >= 0) acc += ps[w][i] * proj[(size_t)kp * DIN + 1024 + h * 64 + lane];
    }
    ya[(size_t)pos * 512 + h * 64 + lane] = acc / den;
}

__global__ void k_s5_tables(const float* a_re, const float* a_im, const float* b_re, const float* b_im, const float* log_dt,
                            float2* abar, float2* a128, float2* bbar) {
    const int gp = blockIdx.x * blockDim.x + threadIdx.x;
    if (gp >= 2048) return;
    const int g = gp >> 6;
    const float lr = a_re[gp], li = a_im[gp], dt = expf(log_dt[g]);
    const float mag = expf(lr * dt); float sn, cs; sincosf(li * dt, &sn, &cs);
    const float ar = mag * cs, ai = mag * sn;
    abar[gp] = make_float2(ar, ai);
    float pr = ar, pi = ai;
    for (int i = 0; i < 7; ++i) { float nr = pr * pr - pi * pi, ni = 2.f * pr * pi; pr = nr; pi = ni; }
    a128[gp] = make_float2(pr, pi);
    const float nr = ar - 1.f, ni = ai, den = lr * lr + li * li;
    const float cr = (nr * lr + ni * li) / den, ci = (ni * lr - nr * li) / den;
    for (int c = 0; c < 16; ++c) {
        const float br = b_re[gp * 16 + c], bi = b_im[gp * 16 + c];
        bbar[gp * 16 + c] = make_float2(cr * br - ci * bi, cr * bi + ci * br);
    }
}
template <int MODE> __global__ void __launch_bounds__(64) k_s5_local(const float* proj, const float2* abar, const float2* bbar,
        const float* c_re, const float* c_im, const float* dskip, const float2* Sin, float2* E, float* ybuf) {
    const int chunk = blockIdx.x >> 5, g = blockIdx.x & 31, p = threadIdx.x, gp = g * 64 + p;
    float br[16], bi[16], cr[16], ci[16];
#pragma unroll
    for (int c = 0; c < 16; ++c) { float2 b = bbar[gp * 16 + c]; br[c] = b.x; bi[c] = b.y; }
    if (MODE == 1) {
#pragma unroll
        for (int c = 0; c < 16; ++c) { cr[c] = c_re[(g * 16 + c) * 64 + p]; ci[c] = c_im[(g * 16 + c) * 64 + p]; }
    }
    const float2 a = abar[gp];
    float sr = 0.f, si = 0.f;
    if (MODE == 1) { float2 s0 = Sin[chunk * 2048 + gp]; sr = s0.x; si = s0.y; }
    for (int t = 0; t < 128; ++t) {
        const int s = chunk * 128 + t;
        const float* up = proj + (size_t)s * DIN + 1536 + g * 16;
        float u[16];
#pragma unroll
        for (int c = 0; c < 16; c += 4) { float4 v = *(const float4*)(up + c); u[c] = v.x; u[c + 1] = v.y; u[c + 2] = v.z; u[c + 3] = v.w; }
        float bur = 0.f, bui = 0.f;
#pragma unroll
        for (int c = 0; c < 16; ++c) { bur += br[c] * u[c]; bui += bi[c] * u[c]; }
        const float nr = a.x * sr - a.y * si + bur, ni = a.x * si + a.y * sr + bui;
        sr = nr; si = ni;
        if (MODE == 1) {
            float myy = 0.f;
#pragma unroll
            for (int c = 0; c < 16; ++c) {
                float v = cr[c] * sr - ci[c] * si;
                for (int o = 32; o; o >>= 1) v += __shfl_xor(v, o);
                if (p == c) myy = v + dskip[g * 16 + c] * u[c];
            }
            if (p < 16) ybuf[(size_t)s * 512 + g * 16 + p] = 0.5f * myy * (1.f + erff(myy * 0.70710678118654752f));
        }
    }
    if (MODE == 0) E[chunk * 2048 + gp] = make_float2(sr, si);
}
__global__ void k_s5_carry(const float2* a128, const float2* E, float2* Sin) {
    const int gp = blockIdx.x * blockDim.x + threadIdx.x;
    if (gp >= 2048) return;
    const float2 a = a128[gp];
    float sr = 0.f, si = 0.f;
    for (int c = 0; c < NCHUNK; ++c) {
        Sin[c * 2048 + gp] = make_float2(sr, si);
        const float2 e = E[c * 2048 + gp];
        const float nr = a.x * sr - a.y * si + e.x, ni = a.x * si + a.y * sr + e.y;
        sr = nr; si = ni;
    }
}

__global__ void __launch_bounds__(256) k_xattn(const float* qx, const float* kvx, float* ox) {
    __shared__ float ps[4][256];
    const int w = threadIdx.x >> 6, lane = threadIdx.x & 63;
    const int gw = blockIdx.x * 4 + w, pos = gw >> 2, h = gw & 3;
    const float* q = qx + (size_t)pos * 512 + h * 128;
    float sc[4]; float mx = -1e30f;
#pragma unroll
    for (int j = 0; j < 4; ++j) {
        const int m = j * 64 + lane;
        const float* kr = kvx + (size_t)m * 1024 + h * 128;
        float dot = 0.f;
        for (int e = 0; e < 128; e += 4) { float4 qa = *(const float4*)(q + e), ka = *(const float4*)(kr + e); dot += qa.x * ka.x + qa.y * ka.y + qa.z * ka.z + qa.w * ka.w; }
        sc[j] = dot * 0.08838834764831845f; mx = fmaxf(mx, sc[j]);
    }
    for (int o = 32; o; o >>= 1) mx = fmaxf(mx, __shfl_xor(mx, o));
    float den = 0.f;
#pragma unroll
    for (int j = 0; j < 4; ++j) { float p = expf(sc[j] - mx); den += p; ps[w][j * 64 + lane] = p; }
    for (int o = 32; o; o >>= 1) den += __shfl_xor(den, o);
    __syncthreads();
    float a0 = 0.f, a1 = 0.f;
    for (int m = 0; m < 256; ++m) {
        const float p = ps[w][m];
        const float* vr = kvx + (size_t)m * 1024 + 512 + h * 128;
        a0 += p * vr[lane]; a1 += p * vr[64 + lane];
    }
    ox[(size_t)pos * 512 + h * 128 + lane] = a0 / den;
    ox[(size_t)pos * 512 + h * 128 + 64 + lane] = a1 / den;
}

__global__ void __launch_bounds__(256) k_router(const float* xn, const float* w_r, const float* b_r, int* topi, float* topg, int* cnt) {
    const int lane = threadIdx.x & 63, e = lane & 31;
    const int token = ((blockIdx.x * blockDim.x + threadIdx.x) >> 6) * 2 + (lane >> 5);
    const float* x = xn + (size_t)token * DM;
    float acc = 0.f;
    for (int k = 0; k < DM; ++k) acc += x[k] * w_r[k * 32 + e];
    float v = acc + b_r[e];
    float tv[4]; int ti[4];
#pragma unroll
    for (int r = 0; r < 4; ++r) {
        float bv = v; int bi = e;
#pragma unroll
        for (int o = 16; o; o >>= 1) {
            float ov = __shfl_xor(bv, o); int oi = __shfl_xor(bi, o);
            if (ov > bv || (ov == bv && oi < bi)) { bv = ov; bi = oi; }
        }
        tv[r] = bv; ti[r] = bi;
        if (e == bi) v = -3.0e38f;
    }
    float ex[4], sum = 0.f;
#pragma unroll
    for (int r = 0; r < 4; ++r) { ex[r] = expf(tv[r] - tv[0]); sum += ex[r]; }
    if (e < 4) {
        float gsel = e == 0 ? ex[0] : e == 1 ? ex[1] : e == 2 ? ex[2] : ex[3];
        int isel = e == 0 ? ti[0] : e == 1 ? ti[1] : e == 2 ? ti[2] : ti[3];
        topi[token * 4 + e] = isel; topg[token * 4 + e] = gsel / sum;
        atomicAdd(&cnt[isel], 1);
    }
}
__global__ void k_moe_scan(const int* cnt, int* offs, int* cursor) {
    if (threadIdx.x == 0) { int s = 0; for (int e = 0; e < NEXP; ++e) { offs[e] = s; s += cnt[e]; cursor[e] = 0; } }
}
__global__ void k_moe_place(const int* topi, const int* offs, int* cursor, int* rowtok, int* posof) {
    const int i = blockIdx.x * blockDim.x + threadIdx.x;
    if (i >= SEQ * TOPK) return;
    const int e = topi[i];
    const int pos = offs[e] + atomicAdd(&cursor[e], 1);
    rowtok[pos] = i >> 2; posof[i] = pos;
}
__global__ void k_combine(float* h, const float* outb, const int* posof, const float* topg) {
    const int i = blockIdx.x * blockDim.x + threadIdx.x;
    const int token = i >> 8, c4 = (i & 255) * 4;
    float4 acc = *(const float4*)(h + (size_t)token * DM + c4);
#pragma unroll
    for (int k = 0; k < 4; ++k) {
        const float g = topg[token * 4 + k];
        const float4 o = *(const float4*)(outb + (size_t)posof[token * 4 + k] * DM + c4);
        acc.x += g * o.x; acc.y += g * o.y; acc.z += g * o.z; acc.w += g * o.w;
    }
    *(float4*)(h + (size_t)token * DM + c4) = acc;
}

template <int EP> static void gemm(hipStream_t st, GArgs a, int nz, int mgrid) {
    dim3 grid(a.N / 64, (mgrid + 63) / 64, nz);
    hipLaunchKernelGGL((k_gemm<EP>), grid, dim3(256), 0, st, a);
}

extern "C" void kernel_launch(void* const* d_in, const int* in_sizes, int n_in, void* d_out, int out_size, void* d_ws, size_t ws_size, hipStream_t stream) {
    const float* x = (const float*)d_in[0];
    const float* mem = (const float*)d_in[1];
    const float* rel_bias = (const float*)d_in[2];
    const float* norm_mix = (const float*)d_in[3];
    const float* w_in = (const float*)d_in[4];
    const float* s5_a_re = (const float*)d_in[5];
    const float* s5_a_im = (const float*)d_in[6];
    const float* s5_b_re = (const float*)d_in[7];
    const float* s5_b_im = (const float*)d_in[8];
    const float* s5_c_re = (const float*)d_in[9];
    const float* s5_c_im = (const float*)d_in[10];
    const float* s5_log_dt = (const float*)d_in[11];
    const float* s5_d = (const float*)d_in[12];
    const float* w_glu = (const float*)d_in[13];
    const float* b_glu = (const float*)d_in[14];
    const float* g_out_attn = (const float*)d_in[15];
    const float* g_out_ssm = (const float*)d_in[16];
    const float* w_out = (const float*)d_in[17];
    const float* norm_xattn = (const float*)d_in[18];
    const float* norm_mem = (const float*)d_in[19];
    const float* w_xq = (const float*)d_in[20];
    const float* w_xkv = (const float*)d_in[21];
    const float* w_xo = (const float*)d_in[22];
    const float* norm_moe = (const float*)d_in[23];
    const float* w_router = (const float*)d_in[24];
    const float* b_router = (const float*)d_in[25];
    const float* w1 = (const float*)d_in[26];
    const float* b1 = (const float*)d_in[27];
    const float* w2 = (const float*)d_in[28];
    const float* b2 = (const float*)d_in[29];
    const float* norm_final = (const float*)d_in[30];

    char* ws = (char*)d_ws; size_t off = 0;
    auto alloc = [&](size_t bytes) { void* p = ws + off; off += (bytes + 255) & ~(size_t)255; return p; };
    float* h = (float*)alloc((size_t)SEQ * DM * 4);
    float* xn = (float*)alloc((size_t)SEQ * DM * 4);
    float* proj = (float*)alloc((size_t)SEQ * DIN * 4);
    float* ya = (float*)alloc((size_t)SEQ * 512 * 4);
    float* ybuf = (float*)alloc((size_t)SEQ * 512 * 4);
    float* yb = (float*)alloc((size_t)SEQ * 512 * 4);
    float* mix = (float*)alloc((size_t)SEQ * DM * 4);
    float2* abar = (float2*)alloc(2048 * 8);
    float2* a128 = (float2*)alloc(2048 * 8);
    float2* bbar = (float2*)alloc(2048 * 16 * 8);
    float2* E = (float2*)alloc((size_t)NCHUNK * 2048 * 8);
    float2* Sin = (float2*)alloc((size_t)NCHUNK * 2048 * 8);
    float* memn = (float*)alloc((size_t)NMEM * DM * 4);
    float* qx = (float*)alloc((size_t)SEQ * 512 * 4);
    float* kvx = (float*)alloc((size_t)NMEM * 1024 * 4);
    float* ox = (float*)alloc((size_t)SEQ * 512 * 4);
    int* topi = (int*)alloc((size_t)SEQ * 4 * 4);
    float* topg = (float*)alloc((size_t)SEQ * 4 * 4);
    int* cnt = (int*)alloc(256);
    int* offs = (int*)alloc(256);
    int* cursor = (int*)alloc(256);
    int* rowtok = (int*)alloc((size_t)SEQ * 4 * 4);
    int* posof = (int*)alloc((size_t)SEQ * 4 * 4);
    float* act = (float*)alloc((size_t)SEQ * 4 * DFF * 4);
    float* mout = (float*)alloc((size_t)SEQ * 4 * DM * 4);

    hipMemcpyAsync(h, x, (size_t)SEQ * DM * 4, hipMemcpyDeviceToDevice, stream);
    for (int l = 0; l < 2; ++l) {
        hipLaunchKernelGGL(k_rmsnorm, dim3(SEQ / 4), dim3(256), 0, stream, h, DM, norm_mix + l * DM, xn, DM, SEQ, DM);
        { GArgs a{}; a.A = xn; a.lda = DM; a.B = w_in + (size_t)l * DM * DIN; a.ldb = DIN; a.C = proj; a.ldc = DIN; a.M = SEQ; a.N = DIN; a.K = DM; gemm<EP_STORE>(stream, a, 1, SEQ); }
        hipLaunchKernelGGL(k_dilattn, dim3(SEQ * 8 / 4), dim3(256), 0, stream, proj, rel_bias, ya);
        hipLaunchKernelGGL(k_s5_tables, dim3(8), dim3(256), 0, stream, s5_a_re + l * 2048, s5_a_im + l * 2048, s5_b_re + l * 32768, s5_b_im + l * 32768, s5_log_dt + l * 32, abar, a128, bbar);
        hipLaunchKernelGGL((k_s5_local<0>), dim3(NCHUNK * 32), dim3(64), 0, stream, proj, abar, bbar, s5_c_re + l * 32768, s5_c_im + l * 32768, s5_d + l * 512, Sin, E, ybuf);
        hipLaunchKernelGGL(k_s5_carry, dim3(8), dim3(256), 0, stream, a128, E, Sin);
        hipLaunchKernelGGL((k_s5_local<1>), dim3(NCHUNK * 32), dim3(64), 0, stream, proj, abar, bbar, s5_c_re + l * 32768, s5_c_im + l * 32768, s5_d + l * 512, Sin, E, ybuf);
        { GArgs a{}; a.A = ybuf; a.lda = 512; a.B = w_glu + (size_t)l * 512 * 512; a.ldb = 512; a.C = yb; a.ldc = 512; a.M = SEQ; a.N = 512; a.K = 512; a.bias = b_glu + l * 512; a.aux = ybuf; gemm<EP_GLU>(stream, a, 1, SEQ); }
        hipLaunchKernelGGL(k_rmsnorm, dim3(SEQ / 4), dim3(256), 0, stream, ya, 512, g_out_attn + l * 512, mix, DM, SEQ, 512);
        hipLaunchKernelGGL(k_rmsnorm, dim3(SEQ / 4), dim3(256), 0, stream, yb, 512, g_out_ssm + l * 512, mix + 512, DM, SEQ, 512);
        { GArgs a{}; a.A = mix; a.lda = DM; a.B = w_out + (size_t)l * DM * DM; a.ldb = DM; a.C = h; a.ldc = DM; a.M = SEQ; a.N = DM; a.K = DM; a.aux = h; gemm<EP_RESID>(stream, a, 1, SEQ); }
        hipLaunchKernelGGL(k_rmsnorm, dim3(SEQ / 4), dim3(256), 0, stream, h, DM, norm_xattn + l * DM, xn, DM, SEQ, DM);
        hipLaunchKernelGGL(k_rmsnorm, dim3(NMEM / 4), dim3(256), 0, stream, mem, DM, norm_mem + l * DM, memn, DM, NMEM, DM);
        { GArgs a{}; a.A = xn; a.lda = DM; a.B = w_xq + (size_t)l * DM * 512; a.ldb = 512; a.C = qx; a.ldc = 512; a.M = SEQ; a.N = 512; a.K = DM; gemm<EP_STORE>(stream, a, 1, SEQ); }
        { GArgs a{}; a.A = memn; a.lda = DM; a.B = w_xkv + (size_t)l * DM * 1024; a.ldb = 1024; a.C = kvx; a.ldc = 1024; a.M = NMEM; a.N = 1024; a.K = DM; gemm<EP_STORE>(stream, a, 1, NMEM); }
        hipLaunchKernelGGL(k_xattn, dim3(SEQ * 4 / 4), dim3(256), 0, stream, qx, kvx, ox);
        { GArgs a{}; a.A = ox; a.lda = 512; a.B = w_xo + (size_t)l * 512 * DM; a.ldb = DM; a.C = h; a.ldc = DM; a.M = SEQ; a.N = DM; a.K = 512; a.aux = h; gemm<EP_RESID>(stream, a, 1, SEQ); }
        hipLaunchKernelGGL(k_rmsnorm, dim3(SEQ / 4), dim3(256), 0, stream, h, DM, norm_moe + l * DM, xn, DM, SEQ, DM);
        hipMemsetAsync(cnt, 0, 256, stream);
        hipLaunchKernelGGL(k_router, dim3(SEQ / 8), dim3(256), 0, stream, xn, w_router + (size_t)l * DM * 32, b_router + l * 32, topi, topg, cnt);
        hipLaunchKernelGGL(k_moe_scan, dim3(1), dim3(64), 0, stream, cnt, offs, cursor);
        hipLaunchKernelGGL(k_moe_place, dim3(SEQ * 4 / 256), dim3(256), 0, stream, topi, offs, cursor, rowtok, posof);
        { GArgs a{}; a.A = xn; a.lda = DM; a.B = w1 + (size_t)l * NEXP * DM * 2048; a.ldb = 2048; a.C = act; a.ldc = DFF; a.M = SEQ; a.N = DFF; a.K = DM; a.bias = b1 + (size_t)l * NEXP * 2048;
          a.rowtok = rowtok; a.offs = offs; a.cnts = cnt; a.strideB = (size_t)DM * 2048; a.strideBias = 2048; gemm<EP_MOE1>(stream, a, NEXP, SEQ); }
        { GArgs a{}; a.A = act; a.lda = DFF; a.B = w2 + (size_t)l * NEXP * DFF * DM; a.ldb = DM; a.C = mout; a.ldc = DM; a.M = SEQ; a.N = DM; a.K = DFF; a.bias = b2 + (size_t)l * NEXP * DM;
          a.rowtok = rowtok; a.offs = offs; a.cnts = cnt; a.strideB = (size_t)DFF * DM; a.strideBias = DM; gemm<EP_MOE2>(stream, a, NEXP, SEQ); }
        hipLaunchKernelGGL(k_combine, dim3(SEQ * 256 / 256), dim3(256), 0, stream, h, mout, posof, topg);
    }
    hipLaunchKernelGGL(k_rmsnorm, dim3(SEQ / 4), dim3(256), 0, stream, h, DM, norm_final, (float*)d_out, DM, SEQ, DM);
}
```

```cpp
#include <hip/hip_runtime.h>
#include <stdint.h>
#include <cstdio>

#ifndef MK_PER_PHASE
#define MK_PER_PHASE 0
#endif

#define SEQ 16384
#define DM 1024
#define DIN 2048
#define NMEM 256
#define NEXP 32
#define TOPK 4
#define DFF 1024
#define NCHUNK 128
#define NT 512
#define NW 8

#define LAS __attribute__((address_space(3)))
typedef float f32x4 __attribute__((ext_vector_type(4)));
constexpr int LDS_BYTES = 147456;
constexpr int MISC_OFF = 131072 + 320;

#define XB_TMO      128
#define XB_XCNT(j)  (256  + 64 * (j))
#define XB_XSUB(j)  (1280 + 64 * (j))
#define XB_XGEN(j)  (2304 + 64 * (j))
#define XB_TOP      3328
#define XB_TOPGEN   3392
#define XCD_BAR_WORDS 3456
#define XB_SPIN_CAP (1u << 18)

__device__ __forceinline__ unsigned xb_ld(unsigned* p)              { return __hip_atomic_load(p, __ATOMIC_RELAXED, __HIP_MEMORY_SCOPE_AGENT); }
__device__ __forceinline__ unsigned xb_add(unsigned* p, unsigned v) { return __hip_atomic_fetch_add(p, v, __ATOMIC_RELAXED, __HIP_MEMORY_SCOPE_AGENT); }
__device__ __forceinline__ unsigned xb_xcc_id() { return (unsigned)__builtin_amdgcn_s_getreg((3 << 11) | 20) & 0xFu; }
#define XB_SPIN(cond, bar) do { unsigned _sp = 0; while (cond) { __builtin_amdgcn_s_sleep(1); \
    if ((++_sp & 255u) == 0u) { if (xb_ld(&(bar)[XB_TMO])) break; if (_sp > XB_SPIN_CAP) { atomicAdd(&(bar)[XB_TMO], 1u); break; } } } } while (0)

struct XcdBarrier {
    unsigned* bar; unsigned x;
    volatile LAS unsigned* st;
};
__device__ __forceinline__ XcdBarrier xcd_barrier_post(unsigned* bar, volatile LAS unsigned* st) {
    XcdBarrier b; b.bar = bar; b.x = xb_xcc_id(); b.st = st;
    if (threadIdx.x == 0) (void)xb_add(&bar[XB_XCNT(b.x)], 1u);
    return b;
}
__device__ __forceinline__ void xcd_barrier_complete(unsigned* bar, unsigned x, unsigned& nloc, unsigned& nx) {
    const unsigned G = gridDim.x * gridDim.y * gridDim.z;
    unsigned sum, cnt, mine, sp = 0u;
    for (;;) {
        sum = 0u; cnt = 0u; mine = 0u;
#pragma unroll
        for (unsigned j = 0; j < 16; ++j) { const unsigned c = xb_ld(&bar[XB_XCNT(j)]); sum += c; cnt += (c > 0u) ? 1u : 0u; mine = (j == x) ? c : mine; }
        if (sum == G) break;
        __builtin_amdgcn_s_sleep(1);
        if ((++sp & 255u) == 0u) { if (xb_ld(&bar[XB_TMO])) break; if (sp > XB_SPIN_CAP) { atomicAdd(&bar[XB_TMO], 1u); break; } }
    }
    nloc = mine > 0u ? mine : 1u; nx = cnt > 0u ? cnt : 1u;
}
__device__ __noinline__ void xcd_barrier(unsigned* bar_, unsigned x_, volatile LAS unsigned* st_) {
    XcdBarrier b; b.bar = bar_; b.x = x_; b.st = st_;
    asm volatile("s_waitcnt vmcnt(0)" ::: "memory");
    __syncthreads();
    if (threadIdx.x == 0) {
        unsigned* bar = b.bar;
        __builtin_amdgcn_s_waitcnt(0);
        unsigned nloc = b.st[0], nx = b.st[1];
        if (nloc == 0u) { xcd_barrier_complete(bar, b.x, nloc, nx); b.st[0] = nloc; b.st[1] = nx; }
        const unsigned old = xb_add(&bar[XB_XSUB(b.x)], 1u);
        const unsigned gen = old / nloc;
        if (old + 1u == (gen + 1u) * nloc) {
            __builtin_amdgcn_fence(__ATOMIC_RELEASE, "agent");
            asm volatile("s_waitcnt vmcnt(0)" ::: "memory");
            const unsigned og = xb_add(&bar[XB_TOP], 1u);
            const unsigned tg = og / nx;
            if (og + 1u == (tg + 1u) * nx) xb_add(&bar[XB_TOPGEN], 1u);
            else XB_SPIN(xb_ld(&bar[XB_TOPGEN]) == tg, bar);
            __builtin_amdgcn_fence(__ATOMIC_ACQUIRE, "agent");
            xb_add(&bar[XB_XGEN(b.x)], 1u);
            asm volatile("s_waitcnt vmcnt(0)" ::: "memory");
        } else {
            XB_SPIN(xb_ld(&bar[XB_XGEN(b.x)]) == gen, bar);
            __builtin_amdgcn_fence(__ATOMIC_ACQUIRE, "agent");
            asm volatile("s_waitcnt vmcnt(0)" ::: "memory");
        }
    }
    __syncthreads();
}

constexpr size_t MiB = 1u << 20;
constexpr size_t WS_CTL = 0, CTL_ZERO_BYTES = 1 * MiB;
constexpr int CW_BAR = 4096;
constexpr int CW_CNT = 8192;
constexpr int CW_CUR = 8192 + 64;
constexpr size_t WS_H = 2 * MiB;
constexpr size_t WS_XN = WS_H + 64 * MiB;
constexpr size_t WS_PROJ = WS_XN + 64 * MiB;
constexpr size_t WS_YA = WS_PROJ + 128 * MiB;
constexpr size_t WS_YBUF = WS_YA + 32 * MiB;
constexpr size_t WS_YB = WS_YBUF + 32 * MiB;
constexpr size_t WS_MIX = WS_YB + 32 * MiB;
constexpr size_t WS_QX = WS_MIX + 64 * MiB;
constexpr size_t WS_OX = WS_QX + 32 * MiB;
constexpr size_t WS_ACT = WS_OX + 32 * MiB;
constexpr size_t WS_MOUT = WS_ACT + 256 * MiB;
constexpr size_t WS_SMALL = WS_MOUT + 256 * MiB;
constexpr size_t WS_ABAR = WS_SMALL;
constexpr size_t WS_A128 = WS_ABAR + 2 * 2048 * 8;
constexpr size_t WS_BBAR = WS_A128 + 2 * 2048 * 8;
constexpr size_t WS_E = WS_BBAR + 2 * 2048 * 16 * 8;
constexpr size_t WS_SIN = WS_E + (size_t)NCHUNK * 2048 * 8;
constexpr size_t WS_MEMN = WS_SIN + (size_t)NCHUNK * 2048 * 8;
constexpr size_t WS_KVX = WS_MEMN + 2 * (size_t)NMEM * DM * 4;
constexpr size_t WS_TOPI = WS_KVX + (size_t)NMEM * 1024 * 4;
constexpr size_t WS_TOPG = WS_TOPI + (size_t)SEQ * 4 * 4;
constexpr size_t WS_ROWTOK = WS_TOPG + (size_t)SEQ * 4 * 4;
constexpr size_t WS_POSOF = WS_ROWTOK + (size_t)SEQ * 4 * 4;
constexpr size_t WS_END = WS_POSOF + (size_t)SEQ * 4 * 4;

struct Args { const float* in[31]; float* out; unsigned char* ws; int ph_lo, ph_hi; };

__device__ __forceinline__ void p_rmsnorm(const float* in, int in_ld, const float* g, float* out, int out_ld, int rows, int D) {
    int tidx = threadIdx.x; asm volatile("" : "+v"(tidx)); int bidx = blockIdx.x; asm volatile("" : "+s"(bidx));
    const int lane = tidx & 63, wave = tidx >> 6;
    for (int r = bidx * NW + wave; r < rows; r += gridDim.x * NW) {
        const float* p = in + (size_t)r * in_ld;
        float ss = 0.f;
        for (int i = lane; i < D; i += 64) { float v = p[i]; ss += v * v; }
        for (int o = 32; o; o >>= 1) ss += __shfl_xor(ss, o);
        const float sc = rsqrtf(ss / (float)D + 1e-5f);
        for (int i = lane; i < D; i += 64) out[(size_t)r * out_ld + i] = p[i] * sc * g[i];
    }
}
__device__ __forceinline__ void p_copy4(const float* src, float* dst, size_t n4) {
    int tidx = threadIdx.x; asm volatile("" : "+v"(tidx)); int bidx = blockIdx.x; asm volatile("" : "+s"(bidx));
    for (size_t i = (size_t)bidx * NT + tidx; i < n4; i += (size_t)gridDim.x * NT) ((float4*)dst)[i] = ((const float4*)src)[i];
}

enum { EP_STORE = 0, EP_RESID = 1, EP_GLU = 2, EP_MOE1 = 3, EP_MOE2 = 4 };
struct GArgs {
    const float* A; int lda; const float* B; int ldb; float* C; int ldc; int M, N, K;
    const float* bias; const float* aux;
    const int* rowtok; const int* offs; const unsigned* cnts;
    size_t strideB; int strideBias; int nexp;
};
template <int EP> __device__ __forceinline__ void p_gemm(const GArgs& a, LAS unsigned char* lds) {
    int tidx = threadIdx.x; asm volatile("" : "+v"(tidx)); int bidx = blockIdx.x; asm volatile("" : "+s"(bidx));
    LAS float* As = (LAS float*)lds;
    LAS float* Bs = As + 16 * 132;
    LAS float* Bs2 = Bs + 16 * 68;
    const int tid = tidx, ty = tid >> 4, tx = tid & 15;
    const int lr = tid >> 2, lk = (tid & 3) * 4;
    const int bsel = tid >> 8, bt = tid & 255, bk = bt >> 4, bn = (bt & 15) * 4;
    const int nN = a.N / 64;
    const int mt_max = (a.M + 127) / 128;
    const int per_e = mt_max * nN;
    const int total = per_e * a.nexp;
    for (int t = bidx; t < total; t += gridDim.x) {
        const int e = t / per_e, r = t - e * per_e, mt = r / nN, nt = r - mt * nN;
        int M = a.M, rowbase = 0;
        if (EP == EP_MOE1 || EP == EP_MOE2) { M = (int)a.cnts[e]; rowbase = a.offs[e]; }
        const int m0 = mt * 128, n0 = nt * 64;
        if (m0 >= M) continue;
        const float* B = a.B + (size_t)e * a.strideB;
        const float* bias = a.bias ? a.bias + (size_t)e * a.strideBias : nullptr;
        int ar = m0 + lr; if (ar >= M) ar = M - 1;
        const float* Arow;
        if (EP == EP_MOE1) Arow = a.A + (size_t)a.rowtok[rowbase + ar] * a.lda;
        else Arow = a.A + (size_t)(rowbase + ar) * a.lda;
        float acc[4][4], acc2[4][4];
#pragma unroll
        for (int i = 0; i < 4; ++i)
#pragma unroll
            for (int j = 0; j < 4; ++j) { acc[i][j] = 0.f; acc2[i][j] = 0.f; }
        for (int k0 = 0; k0 < a.K; k0 += 16) {
            const float4 av = *(const float4*)(Arow + k0 + lk);
            float4 bv = make_float4(0.f, 0.f, 0.f, 0.f);
            if (bsel == 0) bv = *(const float4*)(B + (size_t)(k0 + bk) * a.ldb + n0 + bn);
            else if (EP == EP_MOE1) bv = *(const float4*)(B + (size_t)(k0 + bk) * a.ldb + DFF + n0 + bn);
            __syncthreads();
            As[(lk + 0) * 132 + lr] = av.x; As[(lk + 1) * 132 + lr] = av.y; As[(lk + 2) * 132 + lr] = av.z; As[(lk + 3) * 132 + lr] = av.w;
            if (bsel == 0) *(LAS f32x4*)&Bs[bk * 68 + bn] = (f32x4){bv.x, bv.y, bv.z, bv.w};
            else if (EP == EP_MOE1) *(LAS f32x4*)&Bs2[bk * 68 + bn] = (f32x4){bv.x, bv.y, bv.z, bv.w};
            __syncthreads();
#pragma unroll
            for (int kk = 0; kk < 16; ++kk) {
                const f32x4 a4 = *(const LAS f32x4*)&As[kk * 132 + ty * 4];
                const f32x4 b4 = *(const LAS f32x4*)&Bs[kk * 68 + tx * 4];
                const float aa[4] = {a4.x, a4.y, a4.z, a4.w}, bb[4] = {b4.x, b4.y, b4.z, b4.w};
#pragma unroll
                for (int i = 0; i < 4; ++i)
#pragma unroll
                    for (int j = 0; j < 4; ++j) acc[i][j] += aa[i] * bb[j];
                if (EP == EP_MOE1) {
                    const f32x4 c4 = *(const LAS f32x4*)&Bs2[kk * 68 + tx * 4];
                    const float cc[4] = {c4.x, c4.y, c4.z, c4.w};
#pragma unroll
                    for (int i = 0; i < 4; ++i)
#pragma unroll
                        for (int j = 0; j < 4; ++j) acc2[i][j] += aa[i] * cc[j];
                }
            }
        }
#pragma unroll
        for (int i = 0; i < 4; ++i) {
            const int rr = m0 + ty * 4 + i;
            if (rr < M) {
                const size_t crow = (size_t)(rowbase + rr) * a.ldc;
#pragma unroll
                for (int j = 0; j < 4; ++j) {
                    const int c = n0 + tx * 4 + j;
                    float v = acc[i][j];
                    if (EP == EP_STORE) { if (bias) v += bias[c]; }
                    else if (EP == EP_RESID) v += a.aux[crow + c];
                    else if (EP == EP_GLU) { const float y = a.aux[crow + c]; v = y / (1.f + expf(-(v + bias[c]))); }
                    else if (EP == EP_MOE1) {
                        const float g = fminf(v + bias[c], 7.f);
                        const float l = fminf(fmaxf(acc2[i][j] + bias[DFF + c], -7.f), 7.f);
                        v = g / (1.f + expf(-1.702f * g)) * (l + 1.f);
                    } else if (EP == EP_MOE2) v += bias[c];
                    a.C[crow + c] = v;
                }
            }
        }
    }
    __syncthreads();
}

__device__ __forceinline__ int t5_bucket(int n) {
    if (n < 16) return n;
    const float v = logf((float)n / 16.f) / 4.852030263919617f * 16.f;
    const int large = 16 + (int)v;
    return large < 31 ? large : 31;
}
__device__ __forceinline__ void p_dilattn(const float* proj, const float* rel_bias, float* ya, LAS unsigned char* lds) {
    int tidx = threadIdx.x; asm volatile("" : "+v"(tidx)); int bidx = blockIdx.x; asm volatile("" : "+s"(bidx));
    const int w = tidx >> 6, lane = tidx & 63;
    LAS float* ps = (LAS float*)lds + w * 392;
    for (int gw = bidx * NW + w; gw < SEQ * 8; gw += gridDim.x * NW) {
        const int pos = gw >> 3, h = gw & 7;
        const float* q = proj + (size_t)pos * DIN + h * 64;
        float sc[7]; float mx = -1e30f;
#pragma unroll
        for (int it = 0; it < 7; ++it) {
            const int i = it * 64 + lane; float s = -1e30f;
            if (i < 387) {
                const int b = i / 129, d = i - b * 129, dil = 1 << (2 * b), kp = pos - d * dil;
                if (kp >= 0) {
                    const float* kr = proj + (size_t)kp * DIN + 512 + h * 64;
                    float dot = 0.f;
                    for (int e = 0; e < 64; e += 4) { const float4 qa = *(const float4*)(q + e), ka = *(const float4*)(kr + e); dot += qa.x * ka.x + qa.y * ka.y + qa.z * ka.z + qa.w * ka.w; }
                    s = dot * 0.125f + rel_bias[t5_bucket(d * dil) * 8 + h];
                }
            }
            sc[it] = s; mx = fmaxf(mx, s);
        }
        for (int o = 32; o; o >>= 1) mx = fmaxf(mx, __shfl_xor(mx, o));
        float den = 0.f;
#pragma unroll
        for (int it = 0; it < 7; ++it) {
            const int i = it * 64 + lane;
            const float p = (sc[it] > -1e29f) ? expf(sc[it] - mx) : 0.f;
            den += p;
            if (i < 387) ps[i] = p;
        }
        for (int o = 32; o; o >>= 1) den += __shfl_xor(den, o);
        __syncthreads();
        float acc = 0.f;
        for (int i = 0; i < 387; ++i) {
            const int b = i / 129, d = i - b * 129, dil = 1 << (2 * b), kp = pos - d * dil;
            if (kp >= 0) acc += ps[i] * proj[(size_t)kp * DIN + 1024 + h * 64 + lane];
        }
        ya[(size_t)pos * 512 + h * 64 + lane] = acc / den;
        __syncthreads();
    }
}

__device__ __forceinline__ void p_s5_tables(const float* a_re, const float* a_im, const float* b_re, const float* b_im, const float* log_dt,
                                            float2* abar, float2* a128, float2* bbar) {
    int tidx = threadIdx.x; asm volatile("" : "+v"(tidx)); int bidx = blockIdx.x; asm volatile("" : "+s"(bidx));
    for (int gp = bidx * NT + tidx; gp < 2048; gp += gridDim.x * NT) {
        const int g = gp >> 6;
        const float lr = a_re[gp], li = a_im[gp], dt = expf(log_dt[g]);
        const float mag = expf(lr * dt); float sn, cs; sincosf(li * dt, &sn, &cs);
        const float ar = mag * cs, ai = mag * sn;
        abar[gp] = make_float2(ar, ai);
        float pr = ar, pi = ai;
        for (int i = 0; i < 7; ++i) { const float nr = pr * pr - pi * pi, ni = 2.f * pr * pi; pr = nr; pi = ni; }
        a128[gp] = make_float2(pr, pi);
        const float nr = ar - 1.f, ni = ai, den = lr * lr + li * li;
        const float cr = (nr * lr + ni * li) / den, ci = (ni * lr - nr * li) / den;
        for (int c = 0; c < 16; ++c) {
            const float br = b_re[gp * 16 + c], bi = b_im[gp * 16 + c];
            bbar[gp * 16 + c] = make_float2(cr * br - ci * bi, cr * bi + ci * br);
        }
    }
}
template <int MODE> __device__ __forceinline__ void p_s5_local(const float* proj, const float2* abar, const float2* bbar,
        const float* c_re, const float* c_im, const float* dskip, const float2* Sin, float2* E, float* ybuf) {
    int tidx = threadIdx.x; asm volatile("" : "+v"(tidx)); int bidx = blockIdx.x; asm volatile("" : "+s"(bidx));
    const int w = tidx >> 6, p = tidx & 63;
    for (int item = bidx * NW + w; item < NCHUNK * 32; item += gridDim.x * NW) {
        const int chunk = item >> 5, g = item & 31, gp = g * 64 + p;
        float br[16], bi[16], cr[16], ci[16];
#pragma unroll
        for (int c = 0; c < 16; ++c) { const float2 b = bbar[gp * 16 + c]; br[c] = b.x; bi[c] = b.y; }
        if (MODE == 1) {
#pragma unroll
            for (int c = 0; c < 16; ++c) { cr[c] = c_re[(g * 16 + c) * 64 + p]; ci[c] = c_im[(g * 16 + c) * 64 + p]; }
        }
        const float2 a = abar[gp];
        float sr = 0.f, si = 0.f;
        if (MODE == 1) { const float2 s0 = Sin[chunk * 2048 + gp]; sr = s0.x; si = s0.y; }
        for (int t = 0; t < 128; ++t) {
            const int s = chunk * 128 + t;
            const float* up = proj + (size_t)s * DIN + 1536 + g * 16;
            float u[16];
#pragma unroll
            for (int c = 0; c < 16; c += 4) { const float4 v = *(const float4*)(up + c); u[c] = v.x; u[c + 1] = v.y; u[c + 2] = v.z; u[c + 3] = v.w; }
            float bur = 0.f, bui = 0.f;
#pragma unroll
            for (int c = 0; c < 16; ++c) { bur += br[c] * u[c]; bui += bi[c] * u[c]; }
            const float nr = a.x * sr - a.y * si + bur, ni = a.x * si + a.y * sr + bui;
            sr = nr; si = ni;
            if (MODE == 1) {
                float myy = 0.f;
#pragma unroll
                for (int c = 0; c < 16; ++c) {
                    float v = cr[c] * sr - ci[c] * si;
                    for (int o = 32; o; o >>= 1) v += __shfl_xor(v, o);
                    if (p == c) myy = v + dskip[g * 16 + c] * u[c];
                }
                if (p < 16) ybuf[(size_t)s * 512 + g * 16 + p] = 0.5f * myy * (1.f + erff(myy * 0.70710678118654752f));
            }
        }
        if (MODE == 0) E[chunk * 2048 + gp] = make_float2(sr, si);
    }
}
__device__ __forceinline__ void p_s5_carry(const float2* a128, const float2* E, float2* Sin) {
    int tidx = threadIdx.x; asm volatile("" : "+v"(tidx)); int bidx = blockIdx.x; asm volatile("" : "+s"(bidx));
    for (int gp = bidx * NT + tidx; gp < 2048; gp += gridDim.x * NT) {
        const float2 a = a128[gp];
        float sr = 0.f, si = 0.f;
        for (int c = 0; c < NCHUNK; ++c) {
            Sin[c * 2048 + gp] = make_float2(sr, si);
            const float2 e = E[c * 2048 + gp];
            const float nr = a.x * sr - a.y * si + e.x, ni = a.x * si + a.y * sr + e.y;
            sr = nr; si = ni;
        }
    }
}
__device__ __forceinline__ void p_xattn(const float* qx, const float* kvx, float* ox, LAS unsigned char* lds) {
    int tidx = threadIdx.x; asm volatile("" : "+v"(tidx)); int bidx = blockIdx.x; asm volatile("" : "+s"(bidx));
    const int w = tidx >> 6, lane = tidx & 63;
    LAS float* ps = (LAS float*)lds + w * 256;
    for (int gw = bidx * NW + w; gw < SEQ * 4; gw += gridDim.x * NW) {
        const int pos = gw >> 2, h = gw & 3;
        const float* q = qx + (size_t)pos * 512 + h * 128;
        float sc[4]; float mx = -1e30f;
#pragma unroll
        for (int j = 0; j < 4; ++j) {
            const int m = j * 64 + lane;
            const float* kr = kvx + (size_t)m * 1024 + h * 128;
            float dot = 0.f;
            for (int e = 0; e < 128; e += 4) { const float4 qa = *(const float4*)(q + e), ka = *(const float4*)(kr + e); dot += qa.x * ka.x + qa.y * ka.y + qa.z * ka.z + qa.w * ka.w; }
            sc[j] = dot * 0.08838834764831845f; mx = fmaxf(mx, sc[j]);
        }
        for (int o = 32; o; o >>= 1) mx = fmaxf(mx, __shfl_xor(mx, o));
        float den = 0.f;
#pragma unroll
        for (int j = 0; j < 4; ++j) { const float p = expf(sc[j] - mx); den += p; ps[j * 64 + lane] = p; }
        for (int o = 32; o; o >>= 1) den += __shfl_xor(den, o);
        __syncthreads();
        float a0 = 0.f, a1 = 0.f;
        for (int m = 0; m < 256; ++m) {
            const float p = ps[m];
            const float* vr = kvx + (size_t)m * 1024 + 512 + h * 128;
            a0 += p * vr[lane]; a1 += p * vr[64 + lane];
        }
        ox[(size_t)pos * 512 + h * 128 + lane] = a0 / den;
        ox[(size_t)pos * 512 + h * 128 + 64 + lane] = a1 / den;
        __syncthreads();
    }
}
__device__ __forceinline__ void p_router(const float* xn, const float* w_r, const float* b_r, int* topi, float* topg, unsigned* cnt) {
    int tidx = threadIdx.x; asm volatile("" : "+v"(tidx)); int bidx = blockIdx.x; asm volatile("" : "+s"(bidx));
    const int lane = tidx & 63, e = lane & 31, w = tidx >> 6;
    for (int base = (bidx * NW + w) * 2; base < SEQ; base += gridDim.x * NW * 2) {
        const int token = base + (lane >> 5);
        const float* x = xn + (size_t)token * DM;
        float acc = 0.f;
        for (int k = 0; k < DM; ++k) acc += x[k] * w_r[k * 32 + e];
        float v = acc + b_r[e];
        float tv[4]; int ti[4];
#pragma unroll
        for (int r = 0; r < 4; ++r) {
            float bv = v; int bi = e;
#pragma unroll
            for (int o = 16; o; o >>= 1) {
                const float ov = __shfl_xor(bv, o); const int oi = __shfl_xor(bi, o);
                if (ov > bv || (ov == bv && oi < bi)) { bv = ov; bi = oi; }
            }
            tv[r] = bv; ti[r] = bi;
            if (e == bi) v = -3.0e38f;
        }
        float ex[4], sum = 0.f;
#pragma unroll
        for (int r = 0; r < 4; ++r) { ex[r] = expf(tv[r] - tv[0]); sum += ex[r]; }
        if (e < 4) {
            const float gsel = e == 0 ? ex[0] : e == 1 ? ex[1] : e == 2 ? ex[2] : ex[3];
            const int isel = e == 0 ? ti[0] : e == 1 ? ti[1] : e == 2 ? ti[2] : ti[3];
            topi[token * 4 + e] = isel; topg[token * 4 + e] = gsel / sum;
            atomicAdd(&cnt[isel], 1u);
        }
    }
}
__device__ __forceinline__ void p_moe_place(const int* topi, const unsigned* cnt, unsigned* cursor, int* rowtok, int* posof, LAS unsigned char* lds) {
    int tidx = threadIdx.x; asm volatile("" : "+v"(tidx)); int bidx = blockIdx.x; asm volatile("" : "+s"(bidx));
    LAS int* offs = (LAS int*)lds;
    if (tidx == 0) { int s = 0; for (int e = 0; e < NEXP; ++e) { offs[e] = s; s += (int)cnt[e]; } }
    __syncthreads();
    for (int i = bidx * NT + tidx; i < SEQ * TOPK; i += gridDim.x * NT) {
        const int e = topi[i];
        const int pos = offs[e] + (int)atomicAdd(&cursor[e], 1u);
        rowtok[pos] = i >> 2; posof[i] = pos;
    }
    __syncthreads();
}
__device__ __forceinline__ void p_combine(float* h, const float* outb, const int* posof, const float* topg) {
    int tidx = threadIdx.x; asm volatile("" : "+v"(tidx)); int bidx = blockIdx.x; asm volatile("" : "+s"(bidx));
    for (int i = bidx * NT + tidx; i < SEQ * 256; i += gridDim.x * NT) {
        const int token = i >> 8, c4 = (i & 255) * 4;
        float4 acc = *(const float4*)(h + (size_t)token * DM + c4);
#pragma unroll
        for (int k = 0; k < 4; ++k) {
            const float g = topg[token * 4 + k];
            const float4 o = *(const float4*)(outb + (size_t)posof[token * 4 + k] * DM + c4);
            acc.x += g * o.x; acc.y += g * o.y; acc.z += g * o.z; acc.w += g * o.w;
        }
        *(float4*)(h + (size_t)token * DM + c4) = acc;
    }
}

constexpr int NPL = 18;
constexpr int NPHASES = 1 + 2 * NPL + 1;
typedef const __attribute__((address_space(4))) Args* KA;
#define PHASE __device__ __forceinline__
#define KAP() ({ KA _t = a; asm volatile("" : "+s"(_t)); _t; })
#define WSP(T, off) ((T*)(a->ws + (off)))
extern __shared__ __attribute__((aligned(16))) unsigned char lds_raw[];
#define LDSP ((LAS unsigned char*)lds_raw)

PHASE void ph_init(KA a) {
    p_copy4(a->in[0], WSP(float, WS_H), (size_t)SEQ * DM / 4);
    for (int l = 0; l < 2; ++l) {
        p_s5_tables(a->in[5] + l * 2048, a->in[6] + l * 2048, a->in[7] + l * 32768, a->in[8] + l * 32768, a->in[11] + l * 32,
                    WSP(float2, WS_ABAR) + l * 2048, WSP(float2, WS_A128) + l * 2048, WSP(float2, WS_BBAR) + l * 32768);
        p_rmsnorm(a->in[1], DM, a->in[19] + l * DM, WSP(float, WS_MEMN) + (size_t)l * NMEM * DM, DM, NMEM, DM);
    }
}
PHASE void ph_norm(KA a, int which, int l) {
    const float* g = (which == 0 ? a->in[3] : which == 1 ? a->in[18] : a->in[23]) + l * DM;
    p_rmsnorm(WSP(float, WS_H), DM, g, WSP(float, WS_XN), DM, SEQ, DM);
}
PHASE void ph_gemm_in(KA a, int l) { GArgs g{}; g.A = WSP(float, WS_XN); g.lda = DM; g.B = a->in[4] + (size_t)l * DM * DIN; g.ldb = DIN; g.C = WSP(float, WS_PROJ); g.ldc = DIN; g.M = SEQ; g.N = DIN; g.K = DM; g.nexp = 1; p_gemm<EP_STORE>(g, LDSP); }
PHASE void ph_dilattn(KA a) { p_dilattn(WSP(float, WS_PROJ), a->in[2], WSP(float, WS_YA), LDSP); }
PHASE void ph_s5_local0(KA a, int l) {
    p_s5_local<0>(WSP(float, WS_PROJ), WSP(float2, WS_ABAR) + l * 2048, WSP(float2, WS_BBAR) + l * 32768, a->in[9] + l * 32768, a->in[10] + l * 32768, a->in[12] + l * 512,
                  WSP(float2, WS_SIN), WSP(float2, WS_E), WSP(float, WS_YBUF));
}
PHASE void ph_s5_carry(KA a, int l) { p_s5_carry(WSP(float2, WS_A128) + l * 2048, WSP(float2, WS_E), WSP(float2, WS_SIN)); }
PHASE void ph_s5_local1(KA a, int l) {
    p_s5_local<1>(WSP(float, WS_PROJ), WSP(float2, WS_ABAR) + l * 2048, WSP(float2, WS_BBAR) + l * 32768, a->in[9] + l * 32768, a->in[10] + l * 32768, a->in[12] + l * 512,
                  WSP(float2, WS_SIN), WSP(float2, WS_E), WSP(float, WS_YBUF));
}
PHASE void ph_gemm_glu(KA a, int l) { GArgs g{}; g.A = WSP(float, WS_YBUF); g.lda = 512; g.B = a->in[13] + (size_t)l * 512 * 512; g.ldb = 512; g.C = WSP(float, WS_YB); g.ldc = 512; g.M = SEQ; g.N = 512; g.K = 512; g.bias = a->in[14] + l * 512; g.aux = WSP(float, WS_YBUF); g.nexp = 1; p_gemm<EP_GLU>(g, LDSP); }
PHASE void ph_norm_mixout(KA a, int l) {
    p_rmsnorm(WSP(float, WS_YA), 512, a->in[15] + l * 512, WSP(float, WS_MIX), DM, SEQ, 512);
    p_rmsnorm(WSP(float, WS_YB), 512, a->in[16] + l * 512, WSP(float, WS_MIX) + 512, DM, SEQ, 512);
}
PHASE void ph_gemm_out(KA a, int l) { GArgs g{}; g.A = WSP(float, WS_MIX); g.lda = DM; g.B = a->in[17] + (size_t)l * DM * DM; g.ldb = DM; g.C = WSP(float, WS_H); g.ldc = DM; g.M = SEQ; g.N = DM; g.K = DM; g.aux = WSP(float, WS_H); g.nexp = 1; p_gemm<EP_RESID>(g, LDSP); }
PHASE void ph_gemm_kv(KA a, int l) { GArgs g{}; g.A = WSP(float, WS_MEMN) + (size_t)l * NMEM * DM; g.lda = DM; g.B = a->in[21] + (size_t)l * DM * 1024; g.ldb = 1024; g.C = WSP(float, WS_KVX); g.ldc = 1024; g.M = NMEM; g.N = 1024; g.K = DM; g.nexp = 1; p_gemm<EP_STORE>(g, LDSP); }
PHASE void ph_gemm_xq(KA a, int l) { GArgs g{}; g.A = WSP(float, WS_XN); g.lda = DM; g.B = a->in[20] + (size_t)l * DM * 512; g.ldb = 512; g.C = WSP(float, WS_QX); g.ldc = 512; g.M = SEQ; g.N = 512; g.K = DM; g.nexp = 1; p_gemm<EP_STORE>(g, LDSP); }
PHASE void ph_xattn(KA a) { p_xattn(WSP(float, WS_QX), WSP(float, WS_KVX), WSP(float, WS_OX), LDSP); }
PHASE void ph_gemm_xo(KA a, int l) { GArgs g{}; g.A = WSP(float, WS_OX); g.lda = 512; g.B = a->in[22] + (size_t)l * 512 * DM; g.ldb = DM; g.C = WSP(float, WS_H); g.ldc = DM; g.M = SEQ; g.N = DM; g.K = 512; g.aux = WSP(float, WS_H); g.nexp = 1; p_gemm<EP_RESID>(g, LDSP); }
PHASE void ph_router(KA a, int l) { p_router(WSP(float, WS_XN), a->in[24] + (size_t)l * DM * 32, a->in[25] + l * 32, WSP(int, WS_TOPI), WSP(float, WS_TOPG), WSP(unsigned, WS_CTL) + CW_CNT + l * 32); }
PHASE void ph_place(KA a, int l) { p_moe_place(WSP(int, WS_TOPI), WSP(unsigned, WS_CTL) + CW_CNT + l * 32, WSP(unsigned, WS_CTL) + CW_CUR + l * 32, WSP(int, WS_ROWTOK), WSP(int, WS_POSOF), LDSP); }
__device__ __forceinline__ void moe_offs(const unsigned* cnt) {
    LAS int* offs = (LAS int*)(LDSP + 65536);
    if (threadIdx.x == 0) { int s = 0; for (int e = 0; e < NEXP; ++e) { offs[e] = s; s += (int)cnt[e]; } }
    __syncthreads();
}
PHASE void ph_moe1(KA a, int l) {
    const unsigned* cnt = WSP(unsigned, WS_CTL) + CW_CNT + l * 32; moe_offs(cnt);
    GArgs g{}; g.A = WSP(float, WS_XN); g.lda = DM; g.B = a->in[26] + (size_t)l * NEXP * DM * 2048; g.ldb = 2048; g.C = WSP(float, WS_ACT); g.ldc = DFF; g.M = SEQ; g.N = DFF; g.K = DM; g.bias = a->in[27] + (size_t)l * NEXP * 2048;
    g.rowtok = WSP(int, WS_ROWTOK); g.offs = (const int*)(lds_raw + 65536); g.cnts = cnt; g.strideB = (size_t)DM * 2048; g.strideBias = 2048; g.nexp = NEXP; p_gemm<EP_MOE1>(g, LDSP);
}
PHASE void ph_moe2(KA a, int l) {
    const unsigned* cnt = WSP(unsigned, WS_CTL) + CW_CNT + l * 32; moe_offs(cnt);
    GArgs g{}; g.A = WSP(float, WS_ACT); g.lda = DFF; g.B = a->in[28] + (size_t)l * NEXP * DFF * DM; g.ldb = DM; g.C = WSP(float, WS_MOUT); g.ldc = DM; g.M = SEQ; g.N = DM; g.K = DFF; g.bias = a->in[29] + (size_t)l * NEXP * DM;
    g.rowtok = WSP(int, WS_ROWTOK); g.offs = (const int*)(lds_raw + 65536); g.cnts = cnt; g.strideB = (size_t)DFF * DM; g.strideBias = DM; g.nexp = NEXP; p_gemm<EP_MOE2>(g, LDSP);
}
PHASE void ph_combine(KA a) { p_combine(WSP(float, WS_H), WSP(float, WS_MOUT), WSP(int, WS_POSOF), WSP(float, WS_TOPG)); }
PHASE void ph_final(KA a) { p_rmsnorm(WSP(float, WS_H), DM, a->in[30], a->out, DM, SEQ, DM); }

__global__ void __launch_bounds__(NT, 2) mega(Args args) {
    KA a = (KA)__builtin_amdgcn_kernarg_segment_ptr();
    LAS unsigned char* lds = LDSP;
    volatile LAS unsigned* MISC = (volatile LAS unsigned*)(lds + MISC_OFF);
    unsigned* ctl = (unsigned*)(a->ws + WS_CTL);
    if (threadIdx.x < 32) MISC[threadIdx.x] = 0u;
    __syncthreads();
    XcdBarrier bar; bar.bar = ctl + CW_BAR; bar.x = 0; bar.st = nullptr;
    if (!MK_PER_PHASE) bar = xcd_barrier_post(ctl + CW_BAR, MISC + 8);
    const int lo = a->ph_lo, hi = a->ph_hi;
#define IN(k) (lo <= (k) && (k) < hi)
#define SEAM(k) do { if (IN(k) && IN((k) + 1)) xcd_barrier(bar.bar, bar.x, bar.st); } while (0)
    if (IN(0)) ph_init(KAP());
    SEAM(0);
#pragma unroll 1
    for (int l = 0; l < 2; ++l) {
        const int pb = 1 + l * NPL;
        if (IN(pb + 0)) ph_norm(KAP(), 0, l);
        SEAM(pb + 0);
        if (IN(pb + 1)) ph_gemm_in(KAP(), l);
        SEAM(pb + 1);
        if (IN(pb + 2)) { ph_dilattn(KAP()); ph_s5_local0(KAP(), l); }
        SEAM(pb + 2);
        if (IN(pb + 3)) ph_s5_carry(KAP(), l);
        SEAM(pb + 3);
        if (IN(pb + 4)) ph_s5_local1(KAP(), l);
        SEAM(pb + 4);
        if (IN(pb + 5)) ph_gemm_glu(KAP(), l);
        SEAM(pb + 5);
        if (IN(pb + 6)) ph_norm_mixout(KAP(), l);
        SEAM(pb + 6);
        if (IN(pb + 7)) ph_gemm_out(KAP(), l);
        SEAM(pb + 7);
        if (IN(pb + 8)) { ph_norm(KAP(), 1, l); ph_gemm_kv(KAP(), l); }
        SEAM(pb + 8);
        if (IN(pb + 9)) ph_gemm_xq(KAP(), l);
        SEAM(pb + 9);
        if (IN(pb + 10)) ph_xattn(KAP());
        SEAM(pb + 10);
        if (IN(pb + 11)) ph_gemm_xo(KAP(), l);
        SEAM(pb + 11);
        if (IN(pb + 12)) ph_norm(KAP(), 2, l);
        SEAM(pb + 12);
        if (IN(pb + 13)) ph_router(KAP(), l);
        SEAM(pb + 13);
        if (IN(pb + 14)) ph_place(KAP(), l);
        SEAM(pb + 14);
        if (IN(pb + 15)) ph_moe1(KAP(), l);
        SEAM(pb + 15);
        if (IN(pb + 16)) ph_moe2(KAP(), l);
        SEAM(pb + 16);
        if (IN(pb + 17)) ph_combine(KAP());
        SEAM(pb + 17);
    }
    if (IN(NPHASES - 1)) ph_final(KAP());
#undef IN
#undef SEAM
}

extern "C" void kernel_launch(void* const* d_in, const int* in_sizes, int n_in, void* d_out, int out_size, void* d_ws, size_t ws_size, hipStream_t stream) {
    static int grid = 0;
    if (grid == 0) {
        if (n_in != 31 || ws_size < WS_END) { fprintf(stderr, "kernel_launch: unexpected n_in %d or ws_size %zu (need %zu)\n", n_in, ws_size, (size_t)WS_END); grid = -1; return; }
        int dev = 0, cus = 0, per_cu = 0;
        if (hipGetDevice(&dev) != hipSuccess || hipDeviceGetAttribute(&cus, hipDeviceAttributeMultiprocessorCount, dev) != hipSuccess) { grid = -1; return; }
        if (hipFuncSetAttribute((const void*)mega, hipFuncAttributeMaxDynamicSharedMemorySize, LDS_BYTES) != hipSuccess) { fprintf(stderr, "kernel_launch: hipFuncSetAttribute failed\n"); grid = -1; return; }
        if (hipOccupancyMaxActiveBlocksPerMultiprocessor(&per_cu, (const void*)mega, NT, LDS_BYTES) != hipSuccess || per_cu < 1)
            fprintf(stderr, "kernel_launch: occupancy query reports %d workgroups per CU\n", per_cu);
        (void)hipGetLastError();
        grid = cus;
    }
    if (grid < 0) return;
    if (hipMemsetAsync((char*)d_ws + WS_CTL, 0, CTL_ZERO_BYTES, stream) != hipSuccess) return;
    Args a{};
    for (int i = 0; i < 31; ++i) a.in[i] = (const float*)d_in[i];
    a.out = (float*)d_out; a.ws = (unsigned char*)d_ws;
#if MK_PER_PHASE
    for (int p = 0; p < NPHASES; ++p) { a.ph_lo = p; a.ph_hi = p + 1; hipLaunchKernelGGL(mega, dim3(grid), dim3(NT), LDS_BYTES, stream, a); }
#else
    a.ph_lo = 0; a.ph_hi = NPHASES;
    hipLaunchKernelGGL(mega, dim3(grid), dim3(NT), LDS_BYTES, stream, a);
#endif
}
```

```cpp
#include <hip/hip_runtime.h>
#include <stdint.h>
#include <cstdio>

#ifndef MK_PER_PHASE
#define MK_PER_PHASE 0
#endif

#define SEQ 16384
#define DM 1024
#define DIN 2048
#define NMEM 256
#define NEXP 32
#define TOPK 4
#define DFF 1024
#define NCHUNK 128
#define NT 512
#define NW 8

#define LAS __attribute__((address_space(3)))
typedef float f32x4 __attribute__((ext_vector_type(4)));
constexpr int LDS_BYTES = 147456;
constexpr int MISC_OFF = 131072 + 320;

#define XB_TMO      128
#define XB_XCNT(j)  (256  + 64 * (j))
#define XB_XSUB(j)  (1280 + 64 * (j))
#define XB_XGEN(j)  (2304 + 64 * (j))
#define XB_TOP      3328
#define XB_TOPGEN   3392
#define XCD_BAR_WORDS 3456
#define XB_SPIN_CAP (1u << 18)

__device__ __forceinline__ unsigned xb_ld(unsigned* p)              { return __hip_atomic_load(p, __ATOMIC_RELAXED, __HIP_MEMORY_SCOPE_AGENT); }
__device__ __forceinline__ unsigned xb_add(unsigned* p, unsigned v) { return __hip_atomic_fetch_add(p, v, __ATOMIC_RELAXED, __HIP_MEMORY_SCOPE_AGENT); }
__device__ __forceinline__ unsigned xb_xcc_id() { return (unsigned)__builtin_amdgcn_s_getreg((3 << 11) | 20) & 0xFu; }
#define XB_SPIN(cond, bar) do { unsigned _sp = 0; while (cond) { __builtin_amdgcn_s_sleep(1); \
    if ((++_sp & 255u) == 0u) { if (xb_ld(&(bar)[XB_TMO])) break; if (_sp > XB_SPIN_CAP) { atomicAdd(&(bar)[XB_TMO], 1u); break; } } } } while (0)

struct XcdBarrier {
    unsigned* bar; unsigned x;
    volatile LAS unsigned* st;
};
__device__ __forceinline__ XcdBarrier xcd_barrier_post(unsigned* bar, volatile LAS unsigned* st) {
    XcdBarrier b; b.bar = bar; b.x = xb_xcc_id(); b.st = st;
    if (threadIdx.x == 0) (void)xb_add(&bar[XB_XCNT(b.x)], 1u);
    return b;
}
__device__ __forceinline__ void xcd_barrier_complete(unsigned* bar, unsigned x, unsigned& nloc, unsigned& nx) {
    const unsigned G = gridDim.x * gridDim.y * gridDim.z;
    unsigned sum, cnt, mine, sp = 0u;
    for (;;) {
        sum = 0u; cnt = 0u; mine = 0u;
#pragma unroll
        for (unsigned j = 0; j < 16; ++j) { const unsigned c = xb_ld(&bar[XB_XCNT(j)]); sum += c; cnt += (c > 0u) ? 1u : 0u; mine = (j == x) ? c : mine; }
        if (sum == G) break;
        __builtin_amdgcn_s_sleep(1);
        if ((++sp & 255u) == 0u) { if (xb_ld(&bar[XB_TMO])) break; if (sp > XB_SPIN_CAP) { atomicAdd(&bar[XB_TMO], 1u); break; } }
    }
    nloc = mine > 0u ? mine : 1u; nx = cnt > 0u ? cnt : 1u;
}
__device__ __noinline__ void xcd_barrier(unsigned* bar_, unsigned x_, volatile LAS unsigned* st_) {
    XcdBarrier b; b.bar = bar_; b.x = x_; b.st = st_;
    asm volatile("s_waitcnt vmcnt(0)" ::: "memory");
    __syncthreads();
    if (threadIdx.x == 0) {
        unsigned* bar = b.bar;
        __builtin_amdgcn_s_waitcnt(0);
        unsigned nloc = b.st[0], nx = b.st[1];
        if (nloc == 0u) { xcd_barrier_complete(bar, b.x, nloc, nx); b.st[0] = nloc; b.st[1] = nx; }
        const unsigned old = xb_add(&bar[XB_XSUB(b.x)], 1u);
        const unsigned gen = old / nloc;
        if (old + 1u == (gen + 1u) * nloc) {
            __builtin_amdgcn_fence(__ATOMIC_RELEASE, "agent");
            asm volatile("s_waitcnt vmcnt(0)" ::: "memory");
            const unsigned og = xb_add(&bar[XB_TOP], 1u);
            const unsigned tg = og / nx;
            if (og + 1u == (tg + 1u) * nx) xb_add(&bar[XB_TOPGEN], 1u);
            else XB_SPIN(xb_ld(&bar[XB_TOPGEN]) == tg, bar);
            __builtin_amdgcn_fence(__ATOMIC_ACQUIRE, "agent");
            xb_add(&bar[XB_XGEN(b.x)], 1u);
            asm volatile("s_waitcnt vmcnt(0)" ::: "memory");
        } else {
            XB_SPIN(xb_ld(&bar[XB_XGEN(b.x)]) == gen, bar);
            __builtin_amdgcn_fence(__ATOMIC_ACQUIRE, "agent");
            asm volatile("s_waitcnt vmcnt(0)" ::: "memory");
        }
    }
    __syncthreads();
}

constexpr size_t MiB = 1u << 20;
constexpr size_t WS_CTL = 0, CTL_ZERO_BYTES = 1 * MiB;
constexpr int CW_BAR = 4096;
constexpr int CW_CNT = 8192;
constexpr int CW_CUR = 8192 + 64;
constexpr size_t WS_H = 2 * MiB;
constexpr size_t WS_XN = WS_H + 64 * MiB;
constexpr size_t WS_PROJ = WS_XN + 64 * MiB;
constexpr size_t WS_YA = WS_PROJ + 128 * MiB;
constexpr size_t WS_YBUF = WS_YA + 32 * MiB;
constexpr size_t WS_YB = WS_YBUF + 32 * MiB;
constexpr size_t WS_MIX = WS_YB + 32 * MiB;
constexpr size_t WS_QX = WS_MIX + 64 * MiB;
constexpr size_t WS_OX = WS_QX + 32 * MiB;
constexpr size_t WS_ACT = WS_OX + 32 * MiB;
constexpr size_t WS_MOUT = WS_ACT + 256 * MiB;
constexpr size_t WS_SMALL = WS_MOUT + 256 * MiB;
constexpr size_t WS_ABAR = WS_SMALL;
constexpr size_t WS_A128 = WS_ABAR + 2 * 2048 * 8;
constexpr size_t WS_BBAR = WS_A128 + 2 * 2048 * 8;
constexpr size_t WS_E = WS_BBAR + 2 * 2048 * 16 * 8;
constexpr size_t WS_SIN = WS_E + (size_t)NCHUNK * 2048 * 8;
constexpr size_t WS_MEMN = WS_SIN + (size_t)NCHUNK * 2048 * 8;
constexpr size_t WS_KVX = WS_MEMN + 2 * (size_t)NMEM * DM * 4;
constexpr size_t WS_TOPI = WS_KVX + (size_t)NMEM * 1024 * 4;
constexpr size_t WS_TOPG = WS_TOPI + (size_t)SEQ * 4 * 4;
constexpr size_t WS_ROWTOK = WS_TOPG + (size_t)SEQ * 4 * 4;
constexpr size_t WS_POSOF = WS_ROWTOK + (size_t)SEQ * 4 * 4;
constexpr size_t WS_WT_IN = (WS_POSOF + (size_t)SEQ * 4 * 4 + 255) & ~(size_t)255;
constexpr size_t WS_WT_GLU = WS_WT_IN + 2 * (size_t)2048 * 1024 * 2;
constexpr size_t WS_WT_OUT = WS_WT_GLU + 2 * (size_t)512 * 512 * 2;
constexpr size_t WS_WT_XQ = WS_WT_OUT + 2 * (size_t)1024 * 1024 * 2;
constexpr size_t WS_WT_XKV = WS_WT_XQ + 2 * (size_t)512 * 1024 * 2;
constexpr size_t WS_WT_XO = WS_WT_XKV + 2 * (size_t)1024 * 1024 * 2;
constexpr size_t WS_XN16 = WS_WT_XO + 2 * (size_t)1024 * 512 * 2;
constexpr size_t WS_MIX16 = WS_XN16 + (size_t)SEQ * 1024 * 2;
constexpr size_t WS_YG16 = WS_MIX16 + (size_t)SEQ * 1024 * 2;
constexpr size_t WS_OX16 = WS_YG16 + (size_t)SEQ * 512 * 2;
constexpr size_t WS_MEMN16 = WS_OX16 + (size_t)SEQ * 512 * 2;
constexpr size_t WS_END = WS_MEMN16 + 2 * (size_t)NMEM * 1024 * 2;

struct Args { const float* in[31]; float* out; unsigned char* ws; int ph_lo, ph_hi; };


typedef unsigned short bf16_t;
typedef short bf16x8 __attribute__((ext_vector_type(8)));
typedef unsigned u32x4 __attribute__((ext_vector_type(4)));
typedef unsigned u32x2 __attribute__((ext_vector_type(2)));
constexpr int BM = 256, BK = 64, HALF = 128, HTB = HALF * BK * 2, STAGE_BYTES = 8 * HTB, NXCD = 8, WGM = 8;
__host__ __device__ __forceinline__ int lds_byte(int r, int c) { const int st = (r >> 4) * 2 + (c >> 5), rr = r & 15, cc = c & 31, ob = rr * 64 + cc * 2; return st * 1024 + (ob ^ (((ob >> 9) & 1) << 5)); }
__host__ __device__ __forceinline__ void stage_rc(int b, int& R, int& C) { const int st = b / 1024, sb = b % 1024, swz = sb ^ (((sb >> 9) & 1) << 5); R = (st >> 1) * 16 + swz / 64; C = (st & 1) * 32 + (swz % 64) / 2; }
__host__ __device__ __forceinline__ int perm32(int rho) { const int n = rho >> 4, i = rho & 15; return 8 * (i >> 2) + 4 * n + (i & 3); }
__device__ __forceinline__ unsigned cvt_pk_bf16(float lo, float hi) { unsigned r; asm volatile("v_cvt_pk_bf16_f32 %0, %1, %2" : "=v"(r) : "v"(lo), "v"(hi)); return r; }
__device__ __forceinline__ unsigned f2bf(float f) { unsigned u = __builtin_bit_cast(unsigned, f); return (u + 0x7fffu + ((u >> 16) & 1u)) >> 16; }
__device__ __forceinline__ unsigned pk2(float lo, float hi) { return f2bf(lo) | (f2bf(hi) << 16); }
__device__ __forceinline__ float bf2f(unsigned short b) { return __builtin_bit_cast(float, ((unsigned)b) << 16); }

struct GUnit { const char* A; const char* B; int pm, pn, e; };

struct DenseOrder {
    const char* A; const char* Bt; int nM, nN, nwg, G, c, K;
    __device__ __forceinline__ void init(const bf16_t* A_, const bf16_t* Bt_, int M, int N, int K_, int G_, int c_) { A = (const char*)A_; Bt = (const char*)Bt_; nM = M / BM; nN = N / BM; nwg = nM * nN; G = G_; c = c_; K = K_; }
    __device__ __forceinline__ bool next(int i, GUnit& u) const {
        const long L = (long)i * G + c; if (L >= nwg) return false;
        int wgid = (int)L; { const int q = nwg / NXCD, r = nwg % NXCD, xcd = wgid % NXCD, off = wgid / NXCD; wgid = (xcd < r ? xcd * (q + 1) : r * (q + 1) + (xcd - r) * q) + off; }
        const int nig = WGM * nN, gid = wgid / nig, fm = gid * WGM, gsz = (nM - fm) < WGM ? (nM - fm) : WGM;
        u.pm = fm + ((wgid % nig) % gsz); u.pn = (wgid % nig) / gsz; u.e = 0;
        u.A = A + (size_t)u.pm * BM * K * 2; u.B = Bt + (size_t)u.pn * BM * K * 2; return true;
    }
    __device__ __forceinline__ unsigned aoff(const GUnit&, int row) const { return (unsigned)(row * K * 2); }
};

struct EpiF32 {
    static constexpr bool PERM = false;
    float* C; int ldc; int resid;
    __device__ __forceinline__ void operator()(const f32x4 (&acc)[2][2][4][2], const GUnit& u, int wr, int wc, int fr, int fq) const {
        const int row0 = u.pm * BM + wr * 64 + fr, col0 = u.pn * BM + wc * 32 + 4 * fq;
#pragma unroll
        for (int ai = 0; ai < 2; ++ai)
#pragma unroll
            for (int m = 0; m < 4; ++m) { float* rowp = C + (size_t)(row0 + ai * HALF + m * 16) * ldc + col0;
#pragma unroll
                for (int bj = 0; bj < 2; ++bj)
#pragma unroll
                    for (int n = 0; n < 2; ++n) { f32x4 v = acc[ai][bj][m][n]; if (resid) v += *(const f32x4*)(rowp + bj * HALF + n * 16); *(f32x4*)(rowp + bj * HALF + n * 16) = v; } }
    }
};
struct EpiGlu {
    static constexpr bool PERM = false;
    float* C; const float* Y; int ldc; const float* bias;
    __device__ __forceinline__ void operator()(const f32x4 (&acc)[2][2][4][2], const GUnit& u, int wr, int wc, int fr, int fq) const {
        const int row0 = u.pm * BM + wr * 64 + fr, col0 = u.pn * BM + wc * 32 + 4 * fq;
#pragma unroll
        for (int ai = 0; ai < 2; ++ai)
#pragma unroll
            for (int m = 0; m < 4; ++m) { const size_t ro = (size_t)(row0 + ai * HALF + m * 16) * ldc + col0;
#pragma unroll
                for (int bj = 0; bj < 2; ++bj)
#pragma unroll
                    for (int n = 0; n < 2; ++n) { const f32x4 b = *(const f32x4*)(bias + col0 + bj * HALF + n * 16); const f32x4 y = *(const f32x4*)(Y + ro + bj * HALF + n * 16);
                        f32x4 v = acc[ai][bj][m][n] + b; f32x4 o;
#pragma unroll
                        for (int j = 0; j < 4; ++j) o[j] = y[j] / (1.f + __expf(-v[j]));
                        *(f32x4*)(C + ro + bj * HALF + n * 16) = o; } }
    }
};

template <class Epi, class Sched, bool GATHER, bool ALIGN_EPI>
__device__ __forceinline__ void gemm_phase(LAS unsigned char* lds, const int K, const Sched& S, const Epi& E, const int tid) {
    const int wid = __builtin_amdgcn_readfirstlane(tid >> 6), lane = tid & 63, wr = wid >> 2, wc = wid & 3, fr = lane & 15, fq = lane >> 4;
    const int nt = K / BK;
    int Rr[2], Cc[2]; unsigned voffB[2];
#pragma unroll
    for (int i = 0; i < 2; ++i) { int R, C; stage_rc(tid * 16 + i * 8192, R, C); Rr[i] = R; Cc[i] = C; const int Rb = Epi::PERM ? ((R & ~31) + perm32(R & 31)) : R; voffB[i] = (unsigned)(Rb * K + C) * 2u; }
    const size_t kstep = (size_t)(BK * 2);
    const size_t hstep = (size_t)HALF * K * 2;
    const unsigned ldsw = (unsigned)wid * 1024u;
    const int aoff = lds_byte(wr * 64 + fr, fq * 8), boff = lds_byte(wc * 32 + fr, fq * 8);
#define PG8_SA(b, h) (((b) * 2 + (h)) * HTB)
#define PG8_SB(b, h) ((4 + (b) * 2 + (h)) * HTB)
#define PG8_STAGE(bufoff, gbase, v0, v1) do { \
        __builtin_amdgcn_global_load_lds((const unsigned*)((const char*)(gbase) + (v0)), (LAS unsigned*)(lds + (bufoff) + ldsw), 16, 0, 0); \
        __builtin_amdgcn_global_load_lds((const unsigned*)((const char*)(gbase) + (v1)), (LAS unsigned*)(lds + (bufoff) + ldsw + 8192), 16, 0, 0); } while (0)
#define PG8_LDA(dst, b, h) do { _Pragma("unroll") for (int m = 0; m < 4; ++m) _Pragma("unroll") for (int k = 0; k < 2; ++k) dst[m][k] = *(const LAS bf16x8*)(lds + PG8_SA(b, h) + aoff + m * 2048 + k * 1024); } while (0)
#define PG8_LDB(dst, b, h) do { _Pragma("unroll") for (int n = 0; n < 2; ++n) _Pragma("unroll") for (int k = 0; k < 2; ++k) dst[n][k] = *(const LAS bf16x8*)(lds + PG8_SB(b, h) + boff + n * 2048 + k * 1024); } while (0)
#define PG8_MMA(ai, bj, At, Bt) do { __builtin_amdgcn_s_setprio(1); _Pragma("unroll") for (int m = 0; m < 4; ++m) _Pragma("unroll") for (int n = 0; n < 2; ++n) _Pragma("unroll") for (int k = 0; k < 2; ++k) \
        acc[ai][bj][m][n] = __builtin_amdgcn_mfma_f32_16x16x32_bf16(Bt[n][k], At[m][k], acc[ai][bj][m][n], 0, 0, 0); __builtin_amdgcn_s_setprio(0); } while (0)
#define PG8_WAIT_V(n) asm volatile("s_waitcnt vmcnt(" #n ")" ::: "memory")
#define PG8_WAIT_L(n) asm volatile("s_waitcnt lgkmcnt(" #n ")" ::: "memory")
#define PG8_BAR __builtin_amdgcn_s_barrier()
#define PG8_SCHED __builtin_amdgcn_sched_barrier(0)
    GUnit cur, nxt; int ui = 0;
    if (!S.next(0, cur)) return;
    f32x4 acc[2][2][4][2];
#pragma unroll
    for (int a = 0; a < 2; ++a)
#pragma unroll
        for (int b = 0; b < 2; ++b)
#pragma unroll
            for (int m = 0; m < 4; ++m)
#pragma unroll
                for (int n = 0; n < 2; ++n) acc[a][b][m][n] = (f32x4){0.f, 0.f, 0.f, 0.f};
    bf16x8 At[4][2], B0[2][2], B1[2][2];
    unsigned vA[2][2], vN[2][2];
#pragma unroll
    for (int h = 0; h < 2; ++h)
#pragma unroll
        for (int i = 0; i < 2; ++i) { vA[h][i] = S.aoff(cur, h * HALF + Rr[i]) + (unsigned)Cc[i] * 2u; vN[h][i] = vA[h][i]; }
    const char* cA = cur.A; const char* cB = cur.B;
    PG8_STAGE(PG8_SB(0, 0), cB, voffB[0], voffB[1]); PG8_STAGE(PG8_SB(0, 1), cB + hstep, voffB[0], voffB[1]); PG8_STAGE(PG8_SA(0, 0), cA, vA[0][0], vA[0][1]); PG8_STAGE(PG8_SA(0, 1), cA, vA[1][0], vA[1][1]);
    if (wr == 1) PG8_BAR;
    PG8_WAIT_V(2); PG8_BAR;
    PG8_STAGE(PG8_SB(1, 0), cB + kstep, voffB[0], voffB[1]); PG8_STAGE(PG8_SA(1, 0), cA + kstep, vA[0][0], vA[0][1]); PG8_STAGE(PG8_SB(1, 1), cB + hstep + kstep, voffB[0], voffB[1]);
    PG8_WAIT_V(6); PG8_BAR;
    for (;;) {
        const bool has_next = S.next(ui + 1, nxt);
        const char* nA = has_next ? nxt.A : cA; const char* nB = has_next ? nxt.B : cB;
        if (GATHER) {
            if (has_next) {
#pragma unroll
                for (int h = 0; h < 2; ++h)
#pragma unroll
                    for (int i = 0; i < 2; ++i) vN[h][i] = S.aoff(nxt, h * HALF + Rr[i]) + (unsigned)Cc[i] * 2u;
            } else {
#pragma unroll
                for (int h = 0; h < 2; ++h)
#pragma unroll
                    for (int i = 0; i < 2; ++i) vN[h][i] = vA[h][i];
            }
        }
#define PG8_KBODY(a1, a2, b2, a3, b3, W00, W01, W10, W11) do { \
              \
            PG8_LDB(B0, 0, 0); PG8_LDB(B1, 0, 1); PG8_SCHED; PG8_LDA(At, 0, 0); PG8_STAGE(PG8_SA(1, 1), a1, vA[1][0], vA[1][1]); \
            PG8_WAIT_V(8); PG8_WAIT_L(0); PG8_BAR; PG8_MMA(0, 0, At, B0); PG8_MMA(0, 1, At, B1); PG8_BAR; PG8_SCHED; \
              \
            PG8_LDA(At, 0, 1); PG8_STAGE(PG8_SB(0, 0), b2, voffB[0], voffB[1]); PG8_STAGE(PG8_SB(0, 1), (b2) + hstep, voffB[0], voffB[1]); PG8_STAGE(PG8_SA(0, 0), a2, W00, W01); \
            PG8_WAIT_V(8); PG8_WAIT_L(0); PG8_BAR; PG8_MMA(1, 0, At, B0); PG8_MMA(1, 1, At, B1); PG8_BAR; PG8_SCHED; \
              \
            PG8_LDB(B0, 1, 0); PG8_LDB(B1, 1, 1); PG8_SCHED; PG8_LDA(At, 1, 0); PG8_STAGE(PG8_SA(0, 1), a2, W10, W11); \
            PG8_WAIT_V(8); PG8_WAIT_L(0); PG8_BAR; PG8_MMA(0, 0, At, B0); PG8_MMA(0, 1, At, B1); PG8_BAR; PG8_SCHED; \
              \
            PG8_LDA(At, 1, 1); PG8_STAGE(PG8_SB(1, 0), b3, voffB[0], voffB[1]); PG8_STAGE(PG8_SB(1, 1), (b3) + hstep, voffB[0], voffB[1]); PG8_STAGE(PG8_SA(1, 0), a3, W00, W01); \
            PG8_WAIT_V(8); PG8_WAIT_L(0); PG8_BAR; PG8_MMA(1, 0, At, B0); PG8_MMA(1, 1, At, B1); PG8_BAR; PG8_SCHED; } while (0)
        for (int t = 0; t < nt - 2; t += 2) {
            const char* a1 = cA + (size_t)(t + 1) * kstep;
            const char* a2 = cA + (size_t)(t + 2) * kstep; const char* b2 = cB + (size_t)(t + 2) * kstep;
            const char* a3 = a2 + kstep; const char* b3 = b2 + kstep;
            PG8_KBODY(a1, a2, b2, a3, b3, vA[0][0], vA[0][1], vA[1][0], vA[1][1]);
        }
        {
            const char* a1 = cA + (size_t)(nt - 1) * kstep;
            const char* a3 = nA + kstep; const char* b3 = nB + kstep;
            PG8_KBODY(a1, nA, nB, a3, b3, vN[0][0], vN[0][1], vN[1][0], vN[1][1]);
        }
#undef PG8_KBODY
        if constexpr (ALIGN_EPI) { if (wr == 0) PG8_BAR; }
        E(acc, cur, wr, wc, fr, fq);
        if (!has_next) break;
#pragma unroll
        for (int a = 0; a < 2; ++a)
#pragma unroll
            for (int b = 0; b < 2; ++b)
#pragma unroll
                for (int m = 0; m < 4; ++m)
#pragma unroll
                    for (int n = 0; n < 2; ++n) acc[a][b][m][n] = (f32x4){0.f, 0.f, 0.f, 0.f};
        cur = nxt; cA = nA; cB = nB; ++ui;
        if (GATHER) {
#pragma unroll
            for (int h = 0; h < 2; ++h)
#pragma unroll
                for (int i = 0; i < 2; ++i) vA[h][i] = vN[h][i];
        }
        if constexpr (ALIGN_EPI) { if (wr == 1) PG8_BAR; }
    }
    PG8_WAIT_V(0);
    if constexpr (!ALIGN_EPI) { if (wr == 0) PG8_BAR; }
    PG8_BAR;
#undef PG8_SA
#undef PG8_SB
#undef PG8_STAGE
#undef PG8_LDA
#undef PG8_LDB
#undef PG8_MMA
#undef PG8_WAIT_V
#undef PG8_WAIT_L
#undef PG8_BAR
#undef PG8_SCHED
}

__device__ __forceinline__ void transpose_item(const float* W, int K, int N, bf16_t* WT, const float* kgain, int mode, LAS float* scr, int item, int lane) {
    const int nblk = N / 32, kb = item / nblk, nb = item % nblk, k0 = 64 * kb, n0 = 32 * nb;
#pragma unroll 8
    for (int i = 0; i < 32; ++i) { const int kk = 2 * i + (lane >> 5); float v = W[(size_t)(k0 + kk) * N + n0 + (lane & 31)]; if (kgain) v *= kgain[k0 + kk]; scr[kk * 33 + (lane & 31)] = v; }
    asm volatile("s_waitcnt lgkmcnt(0)" ::: "memory");
    int d0 = n0;
    if (mode == 1) { const int bj = n0 >> 10, rest = n0 & 1023, pn = rest >> 7, j = rest & 127; d0 = pn * 256 + bj * 128 + j; }
    const int c = lane & 7;
#pragma unroll
    for (int j = 0; j < 4; ++j) { const int n = (lane >> 3) + 8 * j; const LAS float* sp = scr + (8 * c) * 33 + n;
        u32x4 o; o.x = pk2(sp[0 * 33], sp[1 * 33]); o.y = pk2(sp[2 * 33], sp[3 * 33]); o.z = pk2(sp[4 * 33], sp[5 * 33]); o.w = pk2(sp[6 * 33], sp[7 * 33]);
        *(u32x4*)(WT + (size_t)(d0 + n) * K + k0 + 8 * c) = o; }
    asm volatile("s_waitcnt lgkmcnt(0)" ::: "memory");
}
__device__ __forceinline__ void p_transpose(const float* W, int K, int N, bf16_t* WT, const float* kgain, int mode, LAS unsigned char* lds) {
    int tidx = threadIdx.x; asm volatile("" : "+v"(tidx)); int bidx = blockIdx.x; asm volatile("" : "+s"(bidx));
    const int wave = tidx >> 6, lane = tidx & 63;
    LAS float* scr = (LAS float*)(lds + wave * 16384);
    const int nitems = (K / 64) * (N / 32);
    for (int it = bidx * NW + wave; it < nitems; it += gridDim.x * NW) transpose_item(W, K, N, WT, kgain, mode, scr, it, lane);
}

__device__ __forceinline__ void p_rmsnorm(const float* in, int in_ld, const float* g, float* out, int out_ld, int rows, int D, bf16_t* out16 = nullptr) {
    int tidx = threadIdx.x; asm volatile("" : "+v"(tidx)); int bidx = blockIdx.x; asm volatile("" : "+s"(bidx));
    const int lane = tidx & 63, wave = tidx >> 6;
    for (int r = bidx * NW + wave; r < rows; r += gridDim.x * NW) {
        const float* p = in + (size_t)r * in_ld;
        float ss = 0.f;
        for (int i = lane; i < D; i += 64) { float v = p[i]; ss += v * v; }
        for (int o = 32; o; o >>= 1) ss += __shfl_xor(ss, o);
        const float sc = rsqrtf(ss / (float)D + 1e-5f);
        if (out16) { for (int i = lane; i < D; i += 64) out16[(size_t)r * out_ld + i] = (bf16_t)f2bf(p[i] * sc * g[i]); }
        else { for (int i = lane; i < D; i += 64) out[(size_t)r * out_ld + i] = p[i] * sc * g[i]; }
    }
}
__device__ __forceinline__ void p_copy4(const float* src, float* dst, size_t n4) {
    int tidx = threadIdx.x; asm volatile("" : "+v"(tidx)); int bidx = blockIdx.x; asm volatile("" : "+s"(bidx));
    for (size_t i = (size_t)bidx * NT + tidx; i < n4; i += (size_t)gridDim.x * NT) ((float4*)dst)[i] = ((const float4*)src)[i];
}

enum { EP_STORE = 0, EP_RESID = 1, EP_GLU = 2, EP_MOE1 = 3, EP_MOE2 = 4 };
struct GArgs {
    const float* A; int lda; const float* B; int ldb; float* C; int ldc; int M, N, K;
    const float* bias; const float* aux;
    const int* rowtok; const int* offs; const unsigned* cnts;
    size_t strideB; int strideBias; int nexp;
};
template <int EP> __device__ __forceinline__ void p_gemm(const GArgs& a, LAS unsigned char* lds) {
    int tidx = threadIdx.x; asm volatile("" : "+v"(tidx)); int bidx = blockIdx.x; asm volatile("" : "+s"(bidx));
    LAS float* As = (LAS float*)lds;
    LAS float* Bs = As + 16 * 132;
    LAS float* Bs2 = Bs + 16 * 68;
    const int tid = tidx, ty = tid >> 4, tx = tid & 15;
    const int lr = tid >> 2, lk = (tid & 3) * 4;
    const int bsel = tid >> 8, bt = tid & 255, bk = bt >> 4, bn = (bt & 15) * 4;
    const int nN = a.N / 64;
    const int mt_max = (a.M + 127) / 128;
    const int per_e = mt_max * nN;
    const int total = per_e * a.nexp;
    for (int t = bidx; t < total; t += gridDim.x) {
        const int e = t / per_e, r = t - e * per_e, mt = r / nN, nt = r - mt * nN;
        int M = a.M, rowbase = 0;
        if (EP == EP_MOE1 || EP == EP_MOE2) { M = (int)a.cnts[e]; rowbase = a.offs[e]; }
        const int m0 = mt * 128, n0 = nt * 64;
        if (m0 >= M) continue;
        const float* B = a.B + (size_t)e * a.strideB;
        const float* bias = a.bias ? a.bias + (size_t)e * a.strideBias : nullptr;
        int ar = m0 + lr; if (ar >= M) ar = M - 1;
        const float* Arow;
        if (EP == EP_MOE1) Arow = a.A + (size_t)a.rowtok[rowbase + ar] * a.lda;
        else Arow = a.A + (size_t)(rowbase + ar) * a.lda;
        float acc[4][4], acc2[4][4];
#pragma unroll
        for (int i = 0; i < 4; ++i)
#pragma unroll
            for (int j = 0; j < 4; ++j) { acc[i][j] = 0.f; acc2[i][j] = 0.f; }
        for (int k0 = 0; k0 < a.K; k0 += 16) {
            const float4 av = *(const float4*)(Arow + k0 + lk);
            float4 bv = make_float4(0.f, 0.f, 0.f, 0.f);
            if (bsel == 0) bv = *(const float4*)(B + (size_t)(k0 + bk) * a.ldb + n0 + bn);
            else if (EP == EP_MOE1) bv = *(const float4*)(B + (size_t)(k0 + bk) * a.ldb + DFF + n0 + bn);
            __syncthreads();
            As[(lk + 0) * 132 + lr] = av.x; As[(lk + 1) * 132 + lr] = av.y; As[(lk + 2) * 132 + lr] = av.z; As[(lk + 3) * 132 + lr] = av.w;
            if (bsel == 0) *(LAS f32x4*)&Bs[bk * 68 + bn] = (f32x4){bv.x, bv.y, bv.z, bv.w};
            else if (EP == EP_MOE1) *(LAS f32x4*)&Bs2[bk * 68 + bn] = (f32x4){bv.x, bv.y, bv.z, bv.w};
            __syncthreads();
#pragma unroll
            for (int kk = 0; kk < 16; ++kk) {
                const f32x4 a4 = *(const LAS f32x4*)&As[kk * 132 + ty * 4];
                const f32x4 b4 = *(const LAS f32x4*)&Bs[kk * 68 + tx * 4];
                const float aa[4] = {a4.x, a4.y, a4.z, a4.w}, bb[4] = {b4.x, b4.y, b4.z, b4.w};
#pragma unroll
                for (int i = 0; i < 4; ++i)
#pragma unroll
                    for (int j = 0; j < 4; ++j) acc[i][j] += aa[i] * bb[j];
                if (EP == EP_MOE1) {
                    const f32x4 c4 = *(const LAS f32x4*)&Bs2[kk * 68 + tx * 4];
                    const float cc[4] = {c4.x, c4.y, c4.z, c4.w};
#pragma unroll
                    for (int i = 0; i < 4; ++i)
#pragma unroll
                        for (int j = 0; j < 4; ++j) acc2[i][j] += aa[i] * cc[j];
                }
            }
        }
#pragma unroll
        for (int i = 0; i < 4; ++i) {
            const int rr = m0 + ty * 4 + i;
            if (rr < M) {
                const size_t crow = (size_t)(rowbase + rr) * a.ldc;
#pragma unroll
                for (int j = 0; j < 4; ++j) {
                    const int c = n0 + tx * 4 + j;
                    float v = acc[i][j];
                    if (EP == EP_STORE) { if (bias) v += bias[c]; }
                    else if (EP == EP_RESID) v += a.aux[crow + c];
                    else if (EP == EP_GLU) { const float y = a.aux[crow + c]; v = y / (1.f + expf(-(v + bias[c]))); }
                    else if (EP == EP_MOE1) {
                        const float g = fminf(v + bias[c], 7.f);
                        const float l = fminf(fmaxf(acc2[i][j] + bias[DFF + c], -7.f), 7.f);
                        v = g / (1.f + expf(-1.702f * g)) * (l + 1.f);
                    } else if (EP == EP_MOE2) v += bias[c];
                    a.C[crow + c] = v;
                }
            }
        }
    }
    __syncthreads();
}

__device__ __forceinline__ int t5_bucket(int n) {
    if (n < 16) return n;
    const float v = logf((float)n / 16.f) / 4.852030263919617f * 16.f;
    const int large = 16 + (int)v;
    return large < 31 ? large : 31;
}
__device__ __forceinline__ void p_dilattn(const float* proj, const float* rel_bias, float* ya, LAS unsigned char* lds) {
    int tidx = threadIdx.x; asm volatile("" : "+v"(tidx)); int bidx = blockIdx.x; asm volatile("" : "+s"(bidx));
    const int w = tidx >> 6, lane = tidx & 63;
    LAS float* ps = (LAS float*)lds + w * 392;
    for (int gw = bidx * NW + w; gw < SEQ * 8; gw += gridDim.x * NW) {
        const int pos = gw >> 3, h = gw & 7;
        const float* q = proj + (size_t)pos * DIN + h * 64;
        float sc[7]; float mx = -1e30f;
#pragma unroll
        for (int it = 0; it < 7; ++it) {
            const int i = it * 64 + lane; float s = -1e30f;
            if (i < 387) {
                const int b = i / 129, d = i - b * 129, dil = 1 << (2 * b), kp = pos - d * dil;
                if (kp >= 0) {
                    const float* kr = proj + (size_t)kp * DIN + 512 + h * 64;
                    float dot = 0.f;
                    for (int e = 0; e < 64; e += 4) { const float4 qa = *(const float4*)(q + e), ka = *(const float4*)(kr + e); dot += qa.x * ka.x + qa.y * ka.y + qa.z * ka.z + qa.w * ka.w; }
                    s = dot * 0.125f + rel_bias[t5_bucket(d * dil) * 8 + h];
                }
            }
            sc[it] = s; mx = fmaxf(mx, s);
        }
        for (int o = 32; o; o >>= 1) mx = fmaxf(mx, __shfl_xor(mx, o));
        float den = 0.f;
#pragma unroll
        for (int it = 0; it < 7; ++it) {
            const int i = it * 64 + lane;
            const float p = (sc[it] > -1e29f) ? expf(sc[it] - mx) : 0.f;
            den += p;
            if (i < 387) ps[i] = p;
        }
        for (int o = 32; o; o >>= 1) den += __shfl_xor(den, o);
        __syncthreads();
        float acc = 0.f;
        for (int i = 0; i < 387; ++i) {
            const int b = i / 129, d = i - b * 129, dil = 1 << (2 * b), kp = pos - d * dil;
            if (kp >= 0) acc += ps[i] * proj[(size_t)kp * DIN + 1024 + h * 64 + lane];
        }
        ya[(size_t)pos * 512 + h * 64 + lane] = acc / den;
        __syncthreads();
    }
}

__device__ __forceinline__ void p_s5_tables(const float* a_re, const float* a_im, const float* b_re, const float* b_im, const float* log_dt,
                                            float2* abar, float2* a128, float2* bbar) {
    int tidx = threadIdx.x; asm volatile("" : "+v"(tidx)); int bidx = blockIdx.x; asm volatile("" : "+s"(bidx));
    for (int gp = bidx * NT + tidx; gp < 2048; gp += gridDim.x * NT) {
        const int g = gp >> 6;
        const float lr = a_re[gp], li = a_im[gp], dt = expf(log_dt[g]);
        const float mag = expf(lr * dt); float sn, cs; sincosf(li * dt, &sn, &cs);
        const float ar = mag * cs, ai = mag * sn;
        abar[gp] = make_float2(ar, ai);
        float pr = ar, pi = ai;
        for (int i = 0; i < 7; ++i) { const float nr = pr * pr - pi * pi, ni = 2.f * pr * pi; pr = nr; pi = ni; }
        a128[gp] = make_float2(pr, pi);
        const float nr = ar - 1.f, ni = ai, den = lr * lr + li * li;
        const float cr = (nr * lr + ni * li) / den, ci = (ni * lr - nr * li) / den;
        for (int c = 0; c < 16; ++c) {
            const float br = b_re[gp * 16 + c], bi = b_im[gp * 16 + c];
            bbar[gp * 16 + c] = make_float2(cr * br - ci * bi, cr * bi + ci * br);
        }
    }
}
template <int MODE> __device__ __forceinline__ void p_s5_local(const float* proj, const float2* abar, const float2* bbar,
        const float* c_re, const float* c_im, const float* dskip, const float2* Sin, float2* E, float* ybuf, bf16_t* yg16) {
    int tidx = threadIdx.x; asm volatile("" : "+v"(tidx)); int bidx = blockIdx.x; asm volatile("" : "+s"(bidx));
    const int w = tidx >> 6, p = tidx & 63;
    for (int item = bidx * NW + w; item < NCHUNK * 32; item += gridDim.x * NW) {
        const int chunk = item >> 5, g = item & 31, gp = g * 64 + p;
        float br[16], bi[16], cr[16], ci[16];
#pragma unroll
        for (int c = 0; c < 16; ++c) { const float2 b = bbar[gp * 16 + c]; br[c] = b.x; bi[c] = b.y; }
        if (MODE == 1) {
#pragma unroll
            for (int c = 0; c < 16; ++c) { cr[c] = c_re[(g * 16 + c) * 64 + p]; ci[c] = c_im[(g * 16 + c) * 64 + p]; }
        }
        const float2 a = abar[gp];
        float sr = 0.f, si = 0.f;
        if (MODE == 1) { const float2 s0 = Sin[chunk * 2048 + gp]; sr = s0.x; si = s0.y; }
        for (int t = 0; t < 128; ++t) {
            const int s = chunk * 128 + t;
            const float* up = proj + (size_t)s * DIN + 1536 + g * 16;
            float u[16];
#pragma unroll
            for (int c = 0; c < 16; c += 4) { const float4 v = *(const float4*)(up + c); u[c] = v.x; u[c + 1] = v.y; u[c + 2] = v.z; u[c + 3] = v.w; }
            float bur = 0.f, bui = 0.f;
#pragma unroll
            for (int c = 0; c < 16; ++c) { bur += br[c] * u[c]; bui += bi[c] * u[c]; }
            const float nr = a.x * sr - a.y * si + bur, ni = a.x * si + a.y * sr + bui;
            sr = nr; si = ni;
            if (MODE == 1) {
                float myy = 0.f;
#pragma unroll
                for (int c = 0; c < 16; ++c) {
                    float v = cr[c] * sr - ci[c] * si;
                    for (int o = 32; o; o >>= 1) v += __shfl_xor(v, o);
                    if (p == c) myy = v + dskip[g * 16 + c] * u[c];
                }
                if (p < 16) { const float yv = 0.5f * myy * (1.f + erff(myy * 0.70710678118654752f)); ybuf[(size_t)s * 512 + g * 16 + p] = yv; yg16[(size_t)s * 512 + g * 16 + p] = (bf16_t)f2bf(yv); }
            }
        }
        if (MODE == 0) E[chunk * 2048 + gp] = make_float2(sr, si);
    }
}
__device__ __forceinline__ void p_s5_carry(const float2* a128, const float2* E, float2* Sin) {
    int tidx = threadIdx.x; asm volatile("" : "+v"(tidx)); int bidx = blockIdx.x; asm volatile("" : "+s"(bidx));
    for (int gp = bidx * NT + tidx; gp < 2048; gp += gridDim.x * NT) {
        const float2 a = a128[gp];
        float sr = 0.f, si = 0.f;
        for (int c = 0; c < NCHUNK; ++c) {
            Sin[c * 2048 + gp] = make_float2(sr, si);
            const float2 e = E[c * 2048 + gp];
            const float nr = a.x * sr - a.y * si + e.x, ni = a.x * si + a.y * sr + e.y;
            sr = nr; si = ni;
        }
    }
}
__device__ __forceinline__ void p_xattn(const float* qx, const float* kvx, float* ox, bf16_t* ox16, LAS unsigned char* lds) {
    int tidx = threadIdx.x; asm volatile("" : "+v"(tidx)); int bidx = blockIdx.x; asm volatile("" : "+s"(bidx));
    const int w = tidx >> 6, lane = tidx & 63;
    LAS float* ps = (LAS float*)lds + w * 256;
    for (int gw = bidx * NW + w; gw < SEQ * 4; gw += gridDim.x * NW) {
        const int pos = gw >> 2, h = gw & 3;
        const float* q = qx + (size_t)pos * 512 + h * 128;
        float sc[4]; float mx = -1e30f;
#pragma unroll
        for (int j = 0; j < 4; ++j) {
            const int m = j * 64 + lane;
            const float* kr = kvx + (size_t)m * 1024 + h * 128;
            float dot = 0.f;
            for (int e = 0; e < 128; e += 4) { const float4 qa = *(const float4*)(q + e), ka = *(const float4*)(kr + e); dot += qa.x * ka.x + qa.y * ka.y + qa.z * ka.z + qa.w * ka.w; }
            sc[j] = dot * 0.08838834764831845f; mx = fmaxf(mx, sc[j]);
        }
        for (int o = 32; o; o >>= 1) mx = fmaxf(mx, __shfl_xor(mx, o));
        float den = 0.f;
#pragma unroll
        for (int j = 0; j < 4; ++j) { const float p = expf(sc[j] - mx); den += p; ps[j * 64 + lane] = p; }
        for (int o = 32; o; o >>= 1) den += __shfl_xor(den, o);
        __syncthreads();
        float a0 = 0.f, a1 = 0.f;
        for (int m = 0; m < 256; ++m) {
            const float p = ps[m];
            const float* vr = kvx + (size_t)m * 1024 + 512 + h * 128;
            a0 += p * vr[lane]; a1 += p * vr[64 + lane];
        }
        ox[(size_t)pos * 512 + h * 128 + lane] = a0 / den;
        ox[(size_t)pos * 512 + h * 128 + 64 + lane] = a1 / den;
        ox16[(size_t)pos * 512 + h * 128 + lane] = (bf16_t)f2bf(a0 / den);
        ox16[(size_t)pos * 512 + h * 128 + 64 + lane] = (bf16_t)f2bf(a1 / den);
        __syncthreads();
    }
}
__device__ __forceinline__ void p_router(const float* xn, const float* w_r, const float* b_r, int* topi, float* topg, unsigned* cnt) {
    int tidx = threadIdx.x; asm volatile("" : "+v"(tidx)); int bidx = blockIdx.x; asm volatile("" : "+s"(bidx));
    const int lane = tidx & 63, e = lane & 31, w = tidx >> 6;
    for (int base = (bidx * NW + w) * 2; base < SEQ; base += gridDim.x * NW * 2) {
        const int token = base + (lane >> 5);
        const float* x = xn + (size_t)token * DM;
        float acc = 0.f;
        for (int k = 0; k < DM; ++k) acc += x[k] * w_r[k * 32 + e];
        float v = acc + b_r[e];
        float tv[4]; int ti[4];
#pragma unroll
        for (int r = 0; r < 4; ++r) {
            float bv = v; int bi = e;
#pragma unroll
            for (int o = 16; o; o >>= 1) {
                const float ov = __shfl_xor(bv, o); const int oi = __shfl_xor(bi, o);
                if (ov > bv || (ov == bv && oi < bi)) { bv = ov; bi = oi; }
            }
            tv[r] = bv; ti[r] = bi;
            if (e == bi) v = -3.0e38f;
        }
        float ex[4], sum = 0.f;
#pragma unroll
        for (int r = 0; r < 4; ++r) { ex[r] = expf(tv[r] - tv[0]); sum += ex[r]; }
        if (e < 4) {
            const float gsel = e == 0 ? ex[0] : e == 1 ? ex[1] : e == 2 ? ex[2] : ex[3];
            const int isel = e == 0 ? ti[0] : e == 1 ? ti[1] : e == 2 ? ti[2] : ti[3];
            topi[token * 4 + e] = isel; topg[token * 4 + e] = gsel / sum;
            atomicAdd(&cnt[isel], 1u);
        }
    }
}
__device__ __forceinline__ void p_moe_place(const int* topi, const unsigned* cnt, unsigned* cursor, int* rowtok, int* posof, LAS unsigned char* lds) {
    int tidx = threadIdx.x; asm volatile("" : "+v"(tidx)); int bidx = blockIdx.x; asm volatile("" : "+s"(bidx));
    LAS int* offs = (LAS int*)lds;
    if (tidx == 0) { int s = 0; for (int e = 0; e < NEXP; ++e) { offs[e] = s; s += (int)cnt[e]; } }
    __syncthreads();
    for (int i = bidx * NT + tidx; i < SEQ * TOPK; i += gridDim.x * NT) {
        const int e = topi[i];
        const int pos = offs[e] + (int)atomicAdd(&cursor[e], 1u);
        rowtok[pos] = i >> 2; posof[i] = pos;
    }
    __syncthreads();
}
__device__ __forceinline__ void p_combine(float* h, const float* outb, const int* posof, const float* topg) {
    int tidx = threadIdx.x; asm volatile("" : "+v"(tidx)); int bidx = blockIdx.x; asm volatile("" : "+s"(bidx));
    for (int i = bidx * NT + tidx; i < SEQ * 256; i += gridDim.x * NT) {
        const int token = i >> 8, c4 = (i & 255) * 4;
        float4 acc = *(const float4*)(h + (size_t)token * DM + c4);
#pragma unroll
        for (int k = 0; k < 4; ++k) {
            const float g = topg[token * 4 + k];
            const float4 o = *(const float4*)(outb + (size_t)posof[token * 4 + k] * DM + c4);
            acc.x += g * o.x; acc.y += g * o.y; acc.z += g * o.z; acc.w += g * o.w;
        }
        *(float4*)(h + (size_t)token * DM + c4) = acc;
    }
}

constexpr int NPL = 18;
constexpr int NPHASES = 1 + 2 * NPL + 1;
typedef const __attribute__((address_space(4))) Args* KA;
#define PHASE __device__ __forceinline__
#define KAP() ({ KA _t = a; asm volatile("" : "+s"(_t)); _t; })
#define WSP(T, off) ((T*)(a->ws + (off)))
extern __shared__ __attribute__((aligned(16))) unsigned char lds_raw[];
#define LDSP ((LAS unsigned char*)lds_raw)

#define LTID() int tidx = threadIdx.x; asm volatile("" : "+v"(tidx)); int bidx = blockIdx.x; asm volatile("" : "+s"(bidx))
PHASE void ph_init(KA a) {
    p_copy4(a->in[0], WSP(float, WS_H), (size_t)SEQ * DM / 4);
    for (int l = 0; l < 2; ++l) {
        p_s5_tables(a->in[5] + l * 2048, a->in[6] + l * 2048, a->in[7] + l * 32768, a->in[8] + l * 32768, a->in[11] + l * 32,
                    WSP(float2, WS_ABAR) + l * 2048, WSP(float2, WS_A128) + l * 2048, WSP(float2, WS_BBAR) + l * 32768);
        p_rmsnorm(a->in[1], DM, a->in[19] + l * DM, nullptr, DM, NMEM, DM, WSP(bf16_t, WS_MEMN16) + (size_t)l * NMEM * DM);
        p_transpose(a->in[4] + (size_t)l * DM * DIN, DM, DIN, WSP(bf16_t, WS_WT_IN) + (size_t)l * DIN * DM, nullptr, 0, LDSP);
        p_transpose(a->in[13] + (size_t)l * 512 * 512, 512, 512, WSP(bf16_t, WS_WT_GLU) + (size_t)l * 512 * 512, nullptr, 0, LDSP);
        p_transpose(a->in[17] + (size_t)l * DM * DM, DM, DM, WSP(bf16_t, WS_WT_OUT) + (size_t)l * DM * DM, nullptr, 0, LDSP);
        p_transpose(a->in[20] + (size_t)l * DM * 512, DM, 512, WSP(bf16_t, WS_WT_XQ) + (size_t)l * 512 * DM, nullptr, 0, LDSP);
        p_transpose(a->in[21] + (size_t)l * DM * 1024, DM, 1024, WSP(bf16_t, WS_WT_XKV) + (size_t)l * 1024 * DM, nullptr, 0, LDSP);
        p_transpose(a->in[22] + (size_t)l * 512 * DM, 512, DM, WSP(bf16_t, WS_WT_XO) + (size_t)l * DM * 512, nullptr, 0, LDSP);
    }
    __syncthreads();
}
PHASE void ph_norm(KA a, int which, int l) {
    const float* g = (which == 0 ? a->in[3] : which == 1 ? a->in[18] : a->in[23]) + l * DM;
    if (which == 2) p_rmsnorm(WSP(float, WS_H), DM, g, WSP(float, WS_XN), DM, SEQ, DM);
    else p_rmsnorm(WSP(float, WS_H), DM, g, nullptr, DM, SEQ, DM, WSP(bf16_t, WS_XN16));
}
PHASE void ph_gemm_in(KA a, int l) { LTID();
    DenseOrder S; S.init(WSP(bf16_t, WS_XN16), WSP(bf16_t, WS_WT_IN) + (size_t)l * DIN * DM, SEQ, DIN, DM, gridDim.x, bidx);
    EpiF32 E{WSP(float, WS_PROJ), DIN, 0};
    gemm_phase<EpiF32, DenseOrder, false, false>(LDSP, DM, S, E, tidx);
}
PHASE void ph_dilattn(KA a) { p_dilattn(WSP(float, WS_PROJ), a->in[2], WSP(float, WS_YA), LDSP); }
PHASE void ph_s5_local0(KA a, int l) {
    p_s5_local<0>(WSP(float, WS_PROJ), WSP(float2, WS_ABAR) + l * 2048, WSP(float2, WS_BBAR) + l * 32768, a->in[9] + l * 32768, a->in[10] + l * 32768, a->in[12] + l * 512,
                  WSP(float2, WS_SIN), WSP(float2, WS_E), WSP(float, WS_YBUF), WSP(bf16_t, WS_YG16));
}
PHASE void ph_s5_carry(KA a, int l) { p_s5_carry(WSP(float2, WS_A128) + l * 2048, WSP(float2, WS_E), WSP(float2, WS_SIN)); }
PHASE void ph_s5_local1(KA a, int l) {
    p_s5_local<1>(WSP(float, WS_PROJ), WSP(float2, WS_ABAR) + l * 2048, WSP(float2, WS_BBAR) + l * 32768, a->in[9] + l * 32768, a->in[10] + l * 32768, a->in[12] + l * 512,
                  WSP(float2, WS_SIN), WSP(float2, WS_E), WSP(float, WS_YBUF), WSP(bf16_t, WS_YG16));
}
PHASE void ph_gemm_glu(KA a, int l) { LTID();
    DenseOrder S; S.init(WSP(bf16_t, WS_YG16), WSP(bf16_t, WS_WT_GLU) + (size_t)l * 512 * 512, SEQ, 512, 512, gridDim.x, bidx);
    EpiGlu E{WSP(float, WS_YB), WSP(float, WS_YBUF), 512, a->in[14] + l * 512};
    gemm_phase<EpiGlu, DenseOrder, false, false>(LDSP, 512, S, E, tidx);
}
PHASE void ph_norm_mixout(KA a, int l) {
    p_rmsnorm(WSP(float, WS_YA), 512, a->in[15] + l * 512, nullptr, DM, SEQ, 512, WSP(bf16_t, WS_MIX16));
    p_rmsnorm(WSP(float, WS_YB), 512, a->in[16] + l * 512, nullptr, DM, SEQ, 512, WSP(bf16_t, WS_MIX16) + 512);
}
PHASE void ph_gemm_out(KA a, int l) { LTID();
    DenseOrder S; S.init(WSP(bf16_t, WS_MIX16), WSP(bf16_t, WS_WT_OUT) + (size_t)l * DM * DM, SEQ, DM, DM, gridDim.x, bidx);
    EpiF32 E{WSP(float, WS_H), DM, 1};
    gemm_phase<EpiF32, DenseOrder, false, false>(LDSP, DM, S, E, tidx);
}
PHASE void ph_gemm_kv(KA a, int l) { LTID();
    DenseOrder S; S.init(WSP(bf16_t, WS_MEMN16) + (size_t)l * NMEM * DM, WSP(bf16_t, WS_WT_XKV) + (size_t)l * 1024 * DM, NMEM, 1024, DM, gridDim.x, bidx);
    EpiF32 E{WSP(float, WS_KVX), 1024, 0};
    gemm_phase<EpiF32, DenseOrder, false, false>(LDSP, DM, S, E, tidx);
}
PHASE void ph_gemm_xq(KA a, int l) { LTID();
    DenseOrder S; S.init(WSP(bf16_t, WS_XN16), WSP(bf16_t, WS_WT_XQ) + (size_t)l * 512 * DM, SEQ, 512, DM, gridDim.x, bidx);
    EpiF32 E{WSP(float, WS_QX), 512, 0};
    gemm_phase<EpiF32, DenseOrder, false, false>(LDSP, DM, S, E, tidx);
}
PHASE void ph_xattn(KA a) { p_xattn(WSP(float, WS_QX), WSP(float, WS_KVX), WSP(float, WS_OX), WSP(bf16_t, WS_OX16), LDSP); }
PHASE void ph_gemm_xo(KA a, int l) { LTID();
    DenseOrder S; S.init(WSP(bf16_t, WS_OX16), WSP(bf16_t, WS_WT_XO) + (size_t)l * DM * 512, SEQ, DM, 512, gridDim.x, bidx);
    EpiF32 E{WSP(float, WS_H), DM, 1};
    gemm_phase<EpiF32, DenseOrder, false, false>(LDSP, 512, S, E, tidx);
}
PHASE void ph_router(KA a, int l) { p_router(WSP(float, WS_XN), a->in[24] + (size_t)l * DM * 32, a->in[25] + l * 32, WSP(int, WS_TOPI), WSP(float, WS_TOPG), WSP(unsigned, WS_CTL) + CW_CNT + l * 32); }
PHASE void ph_place(KA a, int l) { p_moe_place(WSP(int, WS_TOPI), WSP(unsigned, WS_CTL) + CW_CNT + l * 32, WSP(unsigned, WS_CTL) + CW_CUR + l * 32, WSP(int, WS_ROWTOK), WSP(int, WS_POSOF), LDSP); }
__device__ __forceinline__ void moe_offs(const unsigned* cnt) {
    LAS int* offs = (LAS int*)(LDSP + 65536);
    if (threadIdx.x == 0) { int s = 0; for (int e = 0; e < NEXP; ++e) { offs[e] = s; s += (int)cnt[e]; } }
    __syncthreads();
}
PHASE void ph_moe1(KA a, int l) {
    const unsigned* cnt = WSP(unsigned, WS_CTL) + CW_CNT + l * 32; moe_offs(cnt);
    GArgs g{}; g.A = WSP(float, WS_XN); g.lda = DM; g.B = a->in[26] + (size_t)l * NEXP * DM * 2048; g.ldb = 2048; g.C = WSP(float, WS_ACT); g.ldc = DFF; g.M = SEQ; g.N = DFF; g.K = DM; g.bias = a->in[27] + (size_t)l * NEXP * 2048;
    g.rowtok = WSP(int, WS_ROWTOK); g.offs = (const int*)(lds_raw + 65536); g.cnts = cnt; g.strideB = (size_t)DM * 2048; g.strideBias = 2048; g.nexp = NEXP; p_gemm<EP_MOE1>(g, LDSP);
}
PHASE void ph_moe2(KA a, int l) {
    const unsigned* cnt = WSP(unsigned, WS_CTL) + CW_CNT + l * 32; moe_offs(cnt);
    GArgs g{}; g.A = WSP(float, WS_ACT); g.lda = DFF; g.B = a->in[28] + (size_t)l * NEXP * DFF * DM; g.ldb = DM; g.C = WSP(float, WS_MOUT); g.ldc = DM; g.M = SEQ; g.N = DM; g.K = DFF; g.bias = a->in[29] + (size_t)l * NEXP * DM;
    g.rowtok = WSP(int, WS_ROWTOK); g.offs = (const int*)(lds_raw + 65536); g.cnts = cnt; g.strideB = (size_t)DFF * DM; g.strideBias = DM; g.nexp = NEXP; p_gemm<EP_MOE2>(g, LDSP);
}
PHASE void ph_combine(KA a) { p_combine(WSP(float, WS_H), WSP(float, WS_MOUT), WSP(int, WS_POSOF), WSP(float, WS_TOPG)); }
PHASE void ph_final(KA a) { p_rmsnorm(WSP(float, WS_H), DM, a->in[30], a->out, DM, SEQ, DM); }

__global__ void __launch_bounds__(NT, 2) mega(Args args) {
    KA a = (KA)__builtin_amdgcn_kernarg_segment_ptr();
    LAS unsigned char* lds = LDSP;
    volatile LAS unsigned* MISC = (volatile LAS unsigned*)(lds + MISC_OFF);
    unsigned* ctl = (unsigned*)(a->ws + WS_CTL);
    if (threadIdx.x < 32) MISC[threadIdx.x] = 0u;
    __syncthreads();
    XcdBarrier bar; bar.bar = ctl + CW_BAR; bar.x = 0; bar.st = nullptr;
    if (!MK_PER_PHASE) bar = xcd_barrier_post(ctl + CW_BAR, MISC + 8);
    const int lo = a->ph_lo, hi = a->ph_hi;
#define IN(k) (lo <= (k) && (k) < hi)
#define SEAM(k) do { if (IN(k) && IN((k) + 1)) xcd_barrier(bar.bar, bar.x, bar.st); } while (0)
    if (IN(0)) ph_init(KAP());
    SEAM(0);
#pragma unroll 1
    for (int l = 0; l < 2; ++l) {
        const int pb = 1 + l * NPL;
        if (IN(pb + 0)) ph_norm(KAP(), 0, l);
        SEAM(pb + 0);
        if (IN(pb + 1)) ph_gemm_in(KAP(), l);
        SEAM(pb + 1);
        if (IN(pb + 2)) { ph_dilattn(KAP()); ph_s5_local0(KAP(), l); }
        SEAM(pb + 2);
        if (IN(pb + 3)) ph_s5_carry(KAP(), l);
        SEAM(pb + 3);
        if (IN(pb + 4)) ph_s5_local1(KAP(), l);
        SEAM(pb + 4);
        if (IN(pb + 5)) ph_gemm_glu(KAP(), l);
        SEAM(pb + 5);
        if (IN(pb + 6)) ph_norm_mixout(KAP(), l);
        SEAM(pb + 6);
        if (IN(pb + 7)) ph_gemm_out(KAP(), l);
        SEAM(pb + 7);
        if (IN(pb + 8)) { ph_norm(KAP(), 1, l); ph_gemm_kv(KAP(), l); }
        SEAM(pb + 8);
        if (IN(pb + 9)) ph_gemm_xq(KAP(), l);
        SEAM(pb + 9);
        if (IN(pb + 10)) ph_xattn(KAP());
        SEAM(pb + 10);
        if (IN(pb + 11)) ph_gemm_xo(KAP(), l);
        SEAM(pb + 11);
        if (IN(pb + 12)) ph_norm(KAP(), 2, l);
        SEAM(pb + 12);
        if (IN(pb + 13)) ph_router(KAP(), l);
        SEAM(pb + 13);
        if (IN(pb + 14)) ph_place(KAP(), l);
        SEAM(pb + 14);
        if (IN(pb + 15)) ph_moe1(KAP(), l);
        SEAM(pb + 15);
        if (IN(pb + 16)) ph_moe2(KAP(), l);
        SEAM(pb + 16);
        if (IN(pb + 17)) ph_combine(KAP());
        SEAM(pb + 17);
    }
    if (IN(NPHASES - 1)) ph_final(KAP());
#undef IN
#undef SEAM
}

extern "C" void kernel_launch(void* const* d_in, const int* in_sizes, int n_in, void* d_out, int out_size, void* d_ws, size_t ws_size, hipStream_t stream) {
    static int grid = 0;
    if (grid == 0) {
        if (n_in != 31 || ws_size < WS_END) { fprintf(stderr, "kernel_launch: unexpected n_in %d or ws_size %zu (need %zu)\n", n_in, ws_size, (size_t)WS_END); grid = -1; return; }
        int dev = 0, cus = 0, per_cu = 0;
        if (hipGetDevice(&dev) != hipSuccess || hipDeviceGetAttribute(&cus, hipDeviceAttributeMultiprocessorCount, dev) != hipSuccess) { grid = -1; return; }
        if (hipFuncSetAttribute((const void*)mega, hipFuncAttributeMaxDynamicSharedMemorySize, LDS_BYTES) != hipSuccess) { fprintf(stderr, "kernel_launch: hipFuncSetAttribute failed\n"); grid = -1; return; }
        if (hipOccupancyMaxActiveBlocksPerMultiprocessor(&per_cu, (const void*)mega, NT, LDS_BYTES) != hipSuccess || per_cu < 1)
            fprintf(stderr, "kernel_launch: occupancy query reports %d workgroups per CU\n", per_cu);
        (void)hipGetLastError();
        grid = cus;
    }
    if (grid < 0) return;
    if (hipMemsetAsync((char*)d_ws + WS_CTL, 0, CTL_ZERO_BYTES, stream) != hipSuccess) return;
    Args a{};
    for (int i = 0; i < 31; ++i) a.in[i] = (const float*)d_in[i];
    a.out = (float*)d_out; a.ws = (unsigned char*)d_ws;
#if MK_PER_PHASE
    for (int p = 0; p < NPHASES; ++p) { a.ph_lo = p; a.ph_hi = p + 1; hipLaunchKernelGGL(mega, dim3(grid), dim3(NT), LDS_BYTES, stream, a); }
#else
    a.ph_lo = 0; a.ph_hi = NPHASES;
    hipLaunchKernelGGL(mega, dim3(grid), dim3(NT), LDS_BYTES, stream, a);
#endif
}
```

```cpp
#include <hip/hip_runtime.h>
#include <stdint.h>
#include <cstdio>

#ifndef MK_PER_PHASE
#define MK_PER_PHASE 0
#endif

#define SEQ 16384
#define DM 1024
#define DIN 2048
#define NMEM 256
#define NEXP 32
#define TOPK 4
#define DFF 1024
#define NCHUNK 128
#define NT 512
#define NW 8

#define LAS __attribute__((address_space(3)))
typedef float f32x4 __attribute__((ext_vector_type(4)));
extern __shared__ __attribute__((aligned(16))) unsigned char lds_raw[];
#define LDSP ((LAS unsigned char*)lds_raw)
#define LTID() int z_ = 0; asm volatile("" : "+v"(z_)); const int lane_ = (int)__builtin_amdgcn_mbcnt_hi(~0u, __builtin_amdgcn_mbcnt_lo(~0u, (unsigned)z_)); \
    const int tidx = wv * 64 + lane_; int bidx = blockIdx.x; asm volatile("" : "+s"(bidx))
__device__ __forceinline__ float shx(float v, int mask, int lane) { return __builtin_bit_cast(float, __builtin_amdgcn_ds_bpermute((lane ^ mask) << 2, __builtin_bit_cast(int, v))); }
__device__ __forceinline__ int shxi(int v, int mask, int lane) { return __builtin_amdgcn_ds_bpermute((lane ^ mask) << 2, v); }
constexpr int LDS_BYTES = 147456;
constexpr int MISC_OFF = 131072 + 320;

#define XB_TMO      128
#define XB_XCNT(j)  (256  + 64 * (j))
#define XB_XSUB(j)  (1280 + 64 * (j))
#define XB_XGEN(j)  (2304 + 64 * (j))
#define XB_TOP      3328
#define XB_TOPGEN   3392
#define XCD_BAR_WORDS 3456
#define XB_SPIN_CAP (1u << 18)

__device__ __forceinline__ unsigned xb_ld(unsigned* p)              { return __hip_atomic_load(p, __ATOMIC_RELAXED, __HIP_MEMORY_SCOPE_AGENT); }
__device__ __forceinline__ unsigned xb_add(unsigned* p, unsigned v) { return __hip_atomic_fetch_add(p, v, __ATOMIC_RELAXED, __HIP_MEMORY_SCOPE_AGENT); }
__device__ __forceinline__ unsigned xb_xcc_id() { return (unsigned)__builtin_amdgcn_s_getreg((3 << 11) | 20) & 0xFu; }
#define XB_SPIN(cond, bar) do { unsigned _sp = 0; while (cond) { __builtin_amdgcn_s_sleep(1); \
    if ((++_sp & 255u) == 0u) { if (xb_ld(&(bar)[XB_TMO])) break; if (_sp > XB_SPIN_CAP) { atomicAdd(&(bar)[XB_TMO], 1u); break; } } } } while (0)

struct XcdBarrier {
    unsigned* bar; unsigned x;
    volatile LAS unsigned* st;
};
__device__ __forceinline__ XcdBarrier xcd_barrier_post(unsigned* bar, volatile LAS unsigned* st) {
    XcdBarrier b; b.bar = bar; b.x = xb_xcc_id(); b.st = st;
    if (threadIdx.x == 0) (void)xb_add(&bar[XB_XCNT(b.x)], 1u);
    return b;
}
__device__ __forceinline__ void xcd_barrier_complete(unsigned* bar, unsigned x, unsigned& nloc, unsigned& nx) {
    const unsigned G = gridDim.x * gridDim.y * gridDim.z;
    unsigned sum, cnt, mine, sp = 0u;
    for (;;) {
        sum = 0u; cnt = 0u; mine = 0u;
#pragma unroll
        for (unsigned j = 0; j < 16; ++j) { const unsigned c = xb_ld(&bar[XB_XCNT(j)]); sum += c; cnt += (c > 0u) ? 1u : 0u; mine = (j == x) ? c : mine; }
        if (sum == G) break;
        __builtin_amdgcn_s_sleep(1);
        if ((++sp & 255u) == 0u) { if (xb_ld(&bar[XB_TMO])) break; if (sp > XB_SPIN_CAP) { atomicAdd(&bar[XB_TMO], 1u); break; } }
    }
    nloc = mine > 0u ? mine : 1u; nx = cnt > 0u ? cnt : 1u;
}
__device__ __noinline__ void xcd_barrier(unsigned* bar_, unsigned x_, volatile LAS unsigned* st_, int is_t0) {
    XcdBarrier b; b.bar = bar_; b.x = x_; b.st = st_;
    asm volatile("s_waitcnt vmcnt(0)" ::: "memory");
    __syncthreads();
    if (is_t0) {
        unsigned* bar = b.bar;
        __builtin_amdgcn_s_waitcnt(0);
        unsigned nloc = b.st[0], nx = b.st[1];
        if (nloc == 0u) { xcd_barrier_complete(bar, b.x, nloc, nx); b.st[0] = nloc; b.st[1] = nx; }
        const unsigned old = xb_add(&bar[XB_XSUB(b.x)], 1u);
        const unsigned gen = old / nloc;
        if (old + 1u == (gen + 1u) * nloc) {
            __builtin_amdgcn_fence(__ATOMIC_RELEASE, "agent");
            asm volatile("s_waitcnt vmcnt(0)" ::: "memory");
            const unsigned og = xb_add(&bar[XB_TOP], 1u);
            const unsigned tg = og / nx;
            if (og + 1u == (tg + 1u) * nx) xb_add(&bar[XB_TOPGEN], 1u);
            else XB_SPIN(xb_ld(&bar[XB_TOPGEN]) == tg, bar);
            __builtin_amdgcn_fence(__ATOMIC_ACQUIRE, "agent");
            xb_add(&bar[XB_XGEN(b.x)], 1u);
            asm volatile("s_waitcnt vmcnt(0)" ::: "memory");
        } else {
            XB_SPIN(xb_ld(&bar[XB_XGEN(b.x)]) == gen, bar);
            __builtin_amdgcn_fence(__ATOMIC_ACQUIRE, "agent");
            asm volatile("s_waitcnt vmcnt(0)" ::: "memory");
        }
    }
    __syncthreads();
}

constexpr size_t MiB = 1u << 20;
constexpr size_t WS_CTL = 0, CTL_ZERO_BYTES = 1 * MiB;
constexpr int CW_BAR = 4096;
constexpr int CW_CNT = 8192;
constexpr int CW_CUR = 8192 + 64;
constexpr size_t WS_H = 2 * MiB;
constexpr size_t WS_XN = WS_H + 64 * MiB;
constexpr size_t WS_PROJ = WS_XN + 64 * MiB;
constexpr size_t WS_YA = WS_PROJ + 128 * MiB;
constexpr size_t WS_YBUF = WS_YA + 32 * MiB;
constexpr size_t WS_YB = WS_YBUF + 32 * MiB;
constexpr size_t WS_MIX = WS_YB + 32 * MiB;
constexpr size_t WS_QX = WS_MIX + 64 * MiB;
constexpr size_t WS_OX = WS_QX + 32 * MiB;
constexpr int MOE_ROWS = SEQ * TOPK + NEXP * 256;
constexpr size_t WS_ACT = WS_OX + 32 * MiB;
constexpr size_t WS_MOUT = WS_ACT + 144 * MiB;
constexpr size_t WS_BT1 = WS_MOUT + 144 * MiB;
constexpr size_t WS_BT2 = WS_BT1 + 256 * MiB;
constexpr size_t WS_SMALL = WS_BT2 + 128 * MiB;
constexpr size_t WS_ABAR = WS_SMALL;
constexpr size_t WS_A128 = WS_ABAR + 2 * 2048 * 8;
constexpr size_t WS_BBAR = WS_A128 + 2 * 2048 * 8;
constexpr size_t WS_E = WS_BBAR + 2 * 2048 * 16 * 8;
constexpr size_t WS_SIN = WS_E + (size_t)NCHUNK * 2048 * 8;
constexpr size_t WS_MEMN = WS_SIN + (size_t)NCHUNK * 2048 * 8;
constexpr size_t WS_KVX = WS_MEMN + 2 * (size_t)NMEM * DM * 4;
constexpr size_t WS_TOPI = WS_KVX + (size_t)NMEM * 1024 * 4;
constexpr size_t WS_TOPG = WS_TOPI + (size_t)SEQ * 4 * 4;
constexpr size_t WS_ROWTOK = WS_TOPG + (size_t)SEQ * 4 * 4;
constexpr size_t WS_POSOF = WS_ROWTOK + (size_t)MOE_ROWS * 4;
constexpr size_t WS_WT_IN = (WS_POSOF + (size_t)SEQ * 4 * 4 + 255) & ~(size_t)255;
constexpr size_t WS_WT_GLU = WS_WT_IN + 2 * (size_t)2048 * 1024 * 2;
constexpr size_t WS_WT_OUT = WS_WT_GLU + 2 * (size_t)512 * 512 * 2;
constexpr size_t WS_WT_XQ = WS_WT_OUT + 2 * (size_t)1024 * 1024 * 2;
constexpr size_t WS_WT_XKV = WS_WT_XQ + 2 * (size_t)512 * 1024 * 2;
constexpr size_t WS_WT_XO = WS_WT_XKV + 2 * (size_t)1024 * 1024 * 2;
constexpr size_t WS_XN16 = WS_WT_XO + 2 * (size_t)1024 * 512 * 2;
constexpr size_t WS_MIX16 = WS_XN16 + (size_t)SEQ * 1024 * 2;
constexpr size_t WS_YG16 = WS_MIX16 + (size_t)SEQ * 1024 * 2;
constexpr size_t WS_OX16 = WS_YG16 + (size_t)SEQ * 512 * 2;
constexpr size_t WS_MEMN16 = WS_OX16 + (size_t)SEQ * 512 * 2;
constexpr size_t WS_END = WS_MEMN16 + 2 * (size_t)NMEM * 1024 * 2;

struct Args { const float* in[31]; float* out; unsigned char* ws; int ph_lo, ph_hi; };


typedef unsigned short bf16_t;
typedef short bf16x8 __attribute__((ext_vector_type(8)));
typedef unsigned u32x4 __attribute__((ext_vector_type(4)));
typedef unsigned u32x2 __attribute__((ext_vector_type(2)));
constexpr int BM = 256, BK = 64, HALF = 128, HTB = HALF * BK * 2, STAGE_BYTES = 8 * HTB, NXCD = 8, WGM = 8;
__host__ __device__ __forceinline__ int lds_byte(int r, int c) { const int st = (r >> 4) * 2 + (c >> 5), rr = r & 15, cc = c & 31, ob = rr * 64 + cc * 2; return st * 1024 + (ob ^ (((ob >> 9) & 1) << 5)); }
__host__ __device__ __forceinline__ void stage_rc(int b, int& R, int& C) { const int st = b / 1024, sb = b % 1024, swz = sb ^ (((sb >> 9) & 1) << 5); R = (st >> 1) * 16 + swz / 64; C = (st & 1) * 32 + (swz % 64) / 2; }
__host__ __device__ __forceinline__ int perm32(int rho) { const int n = rho >> 4, i = rho & 15; return 8 * (i >> 2) + 4 * n + (i & 3); }
__device__ __forceinline__ unsigned cvt_pk_bf16(float lo, float hi) { unsigned r; asm volatile("v_cvt_pk_bf16_f32 %0, %1, %2" : "=v"(r) : "v"(lo), "v"(hi)); return r; }
__device__ __forceinline__ unsigned f2bf(float f) { unsigned u = __builtin_bit_cast(unsigned, f); return (u + 0x7fffu + ((u >> 16) & 1u)) >> 16; }
__device__ __forceinline__ unsigned pk2(float lo, float hi) { return f2bf(lo) | (f2bf(hi) << 16); }
__device__ __forceinline__ float bf2f(unsigned short b) { return __builtin_bit_cast(float, ((unsigned)b) << 16); }

struct GUnit { const char* A; const char* B; int pm, pn, e; };

struct DenseOrder {
    const char* A; const char* Bt; int nM, nN, nwg, G, c, K;
    __device__ __forceinline__ void init(const bf16_t* A_, const bf16_t* Bt_, int M, int N, int K_, int G_, int c_) { A = (const char*)A_; Bt = (const char*)Bt_; nM = M / BM; nN = N / BM; nwg = nM * nN; G = G_; c = c_; K = K_; }
    __device__ __forceinline__ bool next(int i, GUnit& u) const {
        const long L = (long)i * G + c; if (L >= nwg) return false;
        int wgid = (int)L; { const int q = nwg / NXCD, r = nwg % NXCD, xcd = wgid % NXCD, off = wgid / NXCD; wgid = (xcd < r ? xcd * (q + 1) : r * (q + 1) + (xcd - r) * q) + off; }
        const int nig = WGM * nN, gid = wgid / nig, fm = gid * WGM, gsz = (nM - fm) < WGM ? (nM - fm) : WGM;
        u.pm = fm + ((wgid % nig) % gsz); u.pn = (wgid % nig) / gsz; u.e = 0;
        u.A = A + (size_t)u.pm * BM * K * 2; u.B = Bt + (size_t)u.pn * BM * K * 2; return true;
    }
    __device__ __forceinline__ unsigned aoff(const GUnit&, int row) const { return (unsigned)(row * K * 2); }
};

struct EpiF32 {
    static constexpr bool PERM = false;
    float* C; int ldc; int resid;
    __device__ __forceinline__ void operator()(const f32x4 (&acc)[2][2][4][2], const GUnit& u, int wr, int wc, int fr, int fq) const {
        const int row0 = u.pm * BM + wr * 64 + fr, col0 = u.pn * BM + wc * 32 + 4 * fq;
#pragma unroll
        for (int ai = 0; ai < 2; ++ai)
#pragma unroll
            for (int m = 0; m < 4; ++m) { float* rowp = C + (size_t)(row0 + ai * HALF + m * 16) * ldc + col0;
#pragma unroll
                for (int bj = 0; bj < 2; ++bj)
#pragma unroll
                    for (int n = 0; n < 2; ++n) { f32x4 v = acc[ai][bj][m][n]; if (resid) v += *(const f32x4*)(rowp + bj * HALF + n * 16); *(f32x4*)(rowp + bj * HALF + n * 16) = v; } }
    }
};
struct EpiGlu {
    static constexpr bool PERM = false;
    float* C; const float* Y; int ldc; const float* bias;
    __device__ __forceinline__ void operator()(const f32x4 (&acc)[2][2][4][2], const GUnit& u, int wr, int wc, int fr, int fq) const {
        const int row0 = u.pm * BM + wr * 64 + fr, col0 = u.pn * BM + wc * 32 + 4 * fq;
#pragma unroll
        for (int ai = 0; ai < 2; ++ai)
#pragma unroll
            for (int m = 0; m < 4; ++m) { const size_t ro = (size_t)(row0 + ai * HALF + m * 16) * ldc + col0;
#pragma unroll
                for (int bj = 0; bj < 2; ++bj)
#pragma unroll
                    for (int n = 0; n < 2; ++n) { const f32x4 b = *(const f32x4*)(bias + col0 + bj * HALF + n * 16); const f32x4 y = *(const f32x4*)(Y + ro + bj * HALF + n * 16);
                        f32x4 v = acc[ai][bj][m][n] + b; f32x4 o;
#pragma unroll
                        for (int j = 0; j < 4; ++j) o[j] = y[j] / (1.f + __expf(-v[j]));
                        *(f32x4*)(C + ro + bj * HALF + n * 16) = o; } }
    }
};

template <class Epi, class Sched, bool GATHER, bool ALIGN_EPI>
__device__ __forceinline__ void gemm_phase(LAS unsigned char* lds, const int K, const Sched& S, const Epi& E, const int tid) {
    const int wid = __builtin_amdgcn_readfirstlane(tid >> 6), lane = tid & 63, wr = wid >> 2, wc = wid & 3, fr = lane & 15, fq = lane >> 4;
    const int nt = K / BK;
    unsigned voffB[2];
#pragma unroll
    for (int i = 0; i < 2; ++i) { int R, C; stage_rc(tid * 16 + i * 8192, R, C); const int Rb = Epi::PERM ? ((R & ~31) + perm32(R & 31)) : R; voffB[i] = (unsigned)(Rb * K + C) * 2u; }
#define PG8_AOFFS(dst, u) do { int t2_ = tid; asm volatile("" : "+v"(t2_)); _Pragma("unroll") for (int i = 0; i < 2; ++i) { int R, C; stage_rc(t2_ * 16 + i * 8192, R, C); \
        _Pragma("unroll") for (int h = 0; h < 2; ++h) dst[h][i] = S.aoff(u, h * HALF + R) + (unsigned)C * 2u; } } while (0)
    const size_t kstep = (size_t)(BK * 2);
    const size_t hstep = (size_t)HALF * K * 2;
    const unsigned ldsw = (unsigned)wid * 1024u;
    const int aoff = lds_byte(wr * 64 + fr, fq * 8), boff = lds_byte(wc * 32 + fr, fq * 8);
#define PG8_SA(b, h) (((b) * 2 + (h)) * HTB)
#define PG8_SB(b, h) ((4 + (b) * 2 + (h)) * HTB)
#define PG8_STAGE(bufoff, gbase, v0, v1) do { \
        __builtin_amdgcn_global_load_lds((const unsigned*)((const char*)(gbase) + (v0)), (LAS unsigned*)(lds + (bufoff) + ldsw), 16, 0, 0); \
        __builtin_amdgcn_global_load_lds((const unsigned*)((const char*)(gbase) + (v1)), (LAS unsigned*)(lds + (bufoff) + ldsw + 8192), 16, 0, 0); } while (0)
#define PG8_LDA(dst, b, h) do { _Pragma("unroll") for (int m = 0; m < 4; ++m) _Pragma("unroll") for (int k = 0; k < 2; ++k) dst[m][k] = *(const LAS bf16x8*)(lds + PG8_SA(b, h) + aoff + m * 2048 + k * 1024); } while (0)
#define PG8_LDB(dst, b, h) do { _Pragma("unroll") for (int n = 0; n < 2; ++n) _Pragma("unroll") for (int k = 0; k < 2; ++k) dst[n][k] = *(const LAS bf16x8*)(lds + PG8_SB(b, h) + boff + n * 2048 + k * 1024); } while (0)
#define PG8_MMA(ai, bj, At, Bt) do { __builtin_amdgcn_s_setprio(1); _Pragma("unroll") for (int m = 0; m < 4; ++m) _Pragma("unroll") for (int n = 0; n < 2; ++n) _Pragma("unroll") for (int k = 0; k < 2; ++k) \
        acc[ai][bj][m][n] = __builtin_amdgcn_mfma_f32_16x16x32_bf16(Bt[n][k], At[m][k], acc[ai][bj][m][n], 0, 0, 0); __builtin_amdgcn_s_setprio(0); } while (0)
#define PG8_WAIT_V(n) asm volatile("s_waitcnt vmcnt(" #n ")" ::: "memory")
#define PG8_WAIT_L(n) asm volatile("s_waitcnt lgkmcnt(" #n ")" ::: "memory")
#define PG8_BAR __builtin_amdgcn_s_barrier()
#define PG8_SCHED __builtin_amdgcn_sched_barrier(0)
    GUnit cur, nxt; int ui = 0;
    if (!S.next(0, cur)) return;
    f32x4 acc[2][2][4][2];
#pragma unroll
    for (int a = 0; a < 2; ++a)
#pragma unroll
        for (int b = 0; b < 2; ++b)
#pragma unroll
            for (int m = 0; m < 4; ++m)
#pragma unroll
                for (int n = 0; n < 2; ++n) acc[a][b][m][n] = (f32x4){0.f, 0.f, 0.f, 0.f};
    bf16x8 At[4][2], B0[2][2], B1[2][2];
    unsigned vA[2][2], vN[2][2];
    PG8_AOFFS(vA, cur);
#pragma unroll
    for (int h = 0; h < 2; ++h)
#pragma unroll
        for (int i = 0; i < 2; ++i) vN[h][i] = vA[h][i];
    const char* cA = cur.A; const char* cB = cur.B;
    PG8_STAGE(PG8_SB(0, 0), cB, voffB[0], voffB[1]); PG8_STAGE(PG8_SB(0, 1), cB + hstep, voffB[0], voffB[1]); PG8_STAGE(PG8_SA(0, 0), cA, vA[0][0], vA[0][1]); PG8_STAGE(PG8_SA(0, 1), cA, vA[1][0], vA[1][1]);
    if (wr == 1) PG8_BAR;
    PG8_WAIT_V(2); PG8_BAR;
    PG8_STAGE(PG8_SB(1, 0), cB + kstep, voffB[0], voffB[1]); PG8_STAGE(PG8_SA(1, 0), cA + kstep, vA[0][0], vA[0][1]); PG8_STAGE(PG8_SB(1, 1), cB + hstep + kstep, voffB[0], voffB[1]);
    PG8_WAIT_V(6); PG8_BAR;
    for (;;) {
        const bool has_next = S.next(ui + 1, nxt);
        const char* nA = GATHER ? cA : (has_next ? nxt.A : cA); const char* nB = has_next ? nxt.B : cB;
        if (GATHER) {
            if (has_next) { PG8_AOFFS(vN, nxt); }
            else {
#pragma unroll
                for (int h = 0; h < 2; ++h)
#pragma unroll
                    for (int i = 0; i < 2; ++i) vN[h][i] = vA[h][i];
            }
        }
#define PG8_KBODY(a1, a2, b2, a3, b3, W00, W01, W10, W11) do { \
              \
            PG8_LDB(B0, 0, 0); PG8_LDB(B1, 0, 1); PG8_SCHED; PG8_LDA(At, 0, 0); PG8_STAGE(PG8_SA(1, 1), a1, vA[1][0], vA[1][1]); \
            PG8_WAIT_V(8); PG8_WAIT_L(0); PG8_BAR; PG8_MMA(0, 0, At, B0); PG8_MMA(0, 1, At, B1); PG8_BAR; PG8_SCHED; \
              \
            PG8_LDA(At, 0, 1); PG8_STAGE(PG8_SB(0, 0), b2, voffB[0], voffB[1]); PG8_STAGE(PG8_SB(0, 1), (b2) + hstep, voffB[0], voffB[1]); PG8_STAGE(PG8_SA(0, 0), a2, W00, W01); \
            PG8_WAIT_V(8); PG8_WAIT_L(0); PG8_BAR; PG8_MMA(1, 0, At, B0); PG8_MMA(1, 1, At, B1); PG8_BAR; PG8_SCHED; \
              \
            PG8_LDB(B0, 1, 0); PG8_LDB(B1, 1, 1); PG8_SCHED; PG8_LDA(At, 1, 0); PG8_STAGE(PG8_SA(0, 1), a2, W10, W11); \
            PG8_WAIT_V(8); PG8_WAIT_L(0); PG8_BAR; PG8_MMA(0, 0, At, B0); PG8_MMA(0, 1, At, B1); PG8_BAR; PG8_SCHED; \
              \
            PG8_LDA(At, 1, 1); PG8_STAGE(PG8_SB(1, 0), b3, voffB[0], voffB[1]); PG8_STAGE(PG8_SB(1, 1), (b3) + hstep, voffB[0], voffB[1]); PG8_STAGE(PG8_SA(1, 0), a3, W00, W01); \
            PG8_WAIT_V(8); PG8_WAIT_L(0); PG8_BAR; PG8_MMA(1, 0, At, B0); PG8_MMA(1, 1, At, B1); PG8_BAR; PG8_SCHED; } while (0)
        for (int t = 0; t < nt - 2; t += 2) {
            const char* a1 = cA + (size_t)(t + 1) * kstep;
            const char* a2 = cA + (size_t)(t + 2) * kstep; const char* b2 = cB + (size_t)(t + 2) * kstep;
            const char* a3 = a2 + kstep; const char* b3 = b2 + kstep;
            PG8_KBODY(a1, a2, b2, a3, b3, vA[0][0], vA[0][1], vA[1][0], vA[1][1]);
        }
        {
            const char* a1 = cA + (size_t)(nt - 1) * kstep;
            const char* a3 = nA + kstep; const char* b3 = nB + kstep;
            PG8_KBODY(a1, nA, nB, a3, b3, vN[0][0], vN[0][1], vN[1][0], vN[1][1]);
        }
#undef PG8_KBODY
        if constexpr (ALIGN_EPI) { if (wr == 0) PG8_BAR; }
        E(acc, cur, wr, wc, fr, fq);
        if (!has_next) break;
#pragma unroll
        for (int a = 0; a < 2; ++a)
#pragma unroll
            for (int b = 0; b < 2; ++b)
#pragma unroll
                for (int m = 0; m < 4; ++m)
#pragma unroll
                    for (int n = 0; n < 2; ++n) acc[a][b][m][n] = (f32x4){0.f, 0.f, 0.f, 0.f};
        cur = nxt; cA = nA; cB = nB; ++ui;
        if (GATHER) {
#pragma unroll
            for (int h = 0; h < 2; ++h)
#pragma unroll
                for (int i = 0; i < 2; ++i) vA[h][i] = vN[h][i];
        }
        if constexpr (ALIGN_EPI) { if (wr == 1) PG8_BAR; }
    }
    PG8_WAIT_V(0);
    if constexpr (!ALIGN_EPI) { if (wr == 0) PG8_BAR; }
    PG8_BAR;
#undef PG8_AOFFS
#undef PG8_SA
#undef PG8_SB
#undef PG8_STAGE
#undef PG8_LDA
#undef PG8_LDB
#undef PG8_MMA
#undef PG8_WAIT_V
#undef PG8_WAIT_L
#undef PG8_BAR
#undef PG8_SCHED
}


constexpr int TS_OFF = 131072 + 1024;
template <bool GATHER> struct MoeOrder {
    const char* A; const char* Bt; const int* rowtok; int nN, nwg, nM, G, c, K; size_t strideE;
    __device__ __forceinline__ void init(const bf16_t* A_, const bf16_t* Bt_, const int* rowtok_, int N, int K_, size_t strideE_, int G_, int c_) {
        A = (const char*)A_; Bt = (const char*)Bt_; rowtok = rowtok_; nN = N / BM; K = K_; strideE = strideE_; G = G_; c = c_;
        nM = ((LAS const int*)(LDSP + TS_OFF))[32]; nwg = nM * nN; }
    __device__ __forceinline__ bool next(int i, GUnit& u) const {
        const long L = (long)i * G + c; if (L >= nwg) return false;
        int wgid = (int)L; { const int q = nwg / NXCD, r = nwg % NXCD, xcd = wgid % NXCD, off = wgid / NXCD; wgid = (xcd < r ? xcd * (q + 1) : r * (q + 1) + (xcd - r) * q) + off; }
        const int nig = WGM * nN, gid = wgid / nig, fm = gid * WGM, gsz = (nM - fm) < WGM ? (nM - fm) : WGM;
        u.pm = fm + ((wgid % nig) % gsz); u.pn = (wgid % nig) / gsz;
        LAS const int* ts = (LAS const int*)(LDSP + TS_OFF);
        int e = 0; while (e < NEXP - 1 && ts[e + 1] <= u.pm) ++e;
        u.e = e;
        u.A = GATHER ? A : A + (size_t)u.pm * BM * K * 2;
        u.B = Bt + (size_t)e * strideE + (size_t)u.pn * BM * K * 2; return true;
    }
    __device__ __forceinline__ unsigned aoff(const GUnit& u, int row) const {
        if (GATHER) return (unsigned)rowtok[u.pm * BM + row] * (unsigned)(K * 2);
        return (unsigned)(row * K * 2);
    }
};
__device__ __forceinline__ void moe_tiles(const unsigned* cnt, int tid) {
    LAS int* ts = (LAS int*)(LDSP + TS_OFF);
    if (tid == 0) { int s = 0; for (int e = 0; e < NEXP; ++e) { ts[e] = s; s += ((int)cnt[e] + BM - 1) / BM; } ts[NEXP] = s; }
    __syncthreads();
}
struct EpiMoe1 {
    static constexpr bool PERM = true;
    bf16_t* O; const float* b1;
    __device__ __forceinline__ void operator()(const f32x4 (&acc)[2][2][4][2], const GUnit& u, int wr, int wc, int fr, int fq) const {
        const int row0 = u.pm * BM + wr * 64 + fr, col0 = u.pn * 128 + wc * 32 + 8 * fq;
        const float* bg = b1 + (size_t)u.e * 2048 + col0;
        f32x4 bgv[2], blv[2];
#pragma unroll
        for (int n = 0; n < 2; ++n) { bgv[n] = *(const f32x4*)(bg + 4 * n); blv[n] = *(const f32x4*)(bg + DFF + 4 * n); }
#pragma unroll
        for (int ai = 0; ai < 2; ++ai)
#pragma unroll
            for (int m = 0; m < 4; ++m) {
                float o[8];
#pragma unroll
                for (int n = 0; n < 2; ++n)
#pragma unroll
                    for (int j = 0; j < 4; ++j) {
                        const float g = fminf(acc[ai][0][m][n][j] + bgv[n][j], 7.f);
                        const float l = fminf(fmaxf(acc[ai][1][m][n][j] + blv[n][j], -7.f), 7.f);
                        o[n * 4 + j] = g / (1.f + __expf(-1.702f * g)) * (l + 1.f);
                    }
                u32x4 w; w.x = cvt_pk_bf16(o[0], o[1]); w.y = cvt_pk_bf16(o[2], o[3]); w.z = cvt_pk_bf16(o[4], o[5]); w.w = cvt_pk_bf16(o[6], o[7]);
                *(u32x4*)(O + (size_t)(row0 + ai * HALF + m * 16) * DFF + col0) = w;
            }
    }
};
struct EpiMoe2 {
    static constexpr bool PERM = true;
    bf16_t* O; const float* b2;
    __device__ __forceinline__ void operator()(const f32x4 (&acc)[2][2][4][2], const GUnit& u, int wr, int wc, int fr, int fq) const {
        const int row0 = u.pm * BM + wr * 64 + fr, col0 = u.pn * BM + wc * 32 + 8 * fq;
        f32x4 bv[2][2];
#pragma unroll
        for (int bj = 0; bj < 2; ++bj)
#pragma unroll
            for (int n = 0; n < 2; ++n) bv[bj][n] = *(const f32x4*)(b2 + (size_t)u.e * DM + col0 + bj * HALF + 4 * n);
#pragma unroll
        for (int ai = 0; ai < 2; ++ai)
#pragma unroll
            for (int m = 0; m < 4; ++m) { bf16_t* rowp = O + (size_t)(row0 + ai * HALF + m * 16) * DM + col0;
#pragma unroll
                for (int bj = 0; bj < 2; ++bj) { const f32x4 v0 = acc[ai][bj][m][0] + bv[bj][0], v1 = acc[ai][bj][m][1] + bv[bj][1];
                    u32x4 w; w.x = cvt_pk_bf16(v0[0], v0[1]); w.y = cvt_pk_bf16(v0[2], v0[3]); w.z = cvt_pk_bf16(v1[0], v1[1]); w.w = cvt_pk_bf16(v1[2], v1[3]);
                    *(u32x4*)(rowp + bj * HALF) = w; } }
    }
};

__device__ __forceinline__ void transpose_item(const float* W, int K, int N, bf16_t* WT, const float* kgain, int mode, LAS float* scr, int item, int lane) {
    const int nblk = N / 32, kb = item / nblk, nb = item % nblk, k0 = 64 * kb, n0 = 32 * nb;
#pragma unroll 8
    for (int i = 0; i < 32; ++i) { const int kk = 2 * i + (lane >> 5); float v = W[(size_t)(k0 + kk) * N + n0 + (lane & 31)]; if (kgain) v *= kgain[k0 + kk]; scr[kk * 33 + (lane & 31)] = v; }
    asm volatile("s_waitcnt lgkmcnt(0)" ::: "memory");
    int d0 = n0;
    if (mode == 1) { const int bj = n0 >> 10, rest = n0 & 1023, pn = rest >> 7, j = rest & 127; d0 = pn * 256 + bj * 128 + j; }
    const int c = lane & 7;
#pragma unroll
    for (int j = 0; j < 4; ++j) { const int n = (lane >> 3) + 8 * j; const LAS float* sp = scr + (8 * c) * 33 + n;
        u32x4 o; o.x = pk2(sp[0 * 33], sp[1 * 33]); o.y = pk2(sp[2 * 33], sp[3 * 33]); o.z = pk2(sp[4 * 33], sp[5 * 33]); o.w = pk2(sp[6 * 33], sp[7 * 33]);
        *(u32x4*)(WT + (size_t)(d0 + n) * K + k0 + 8 * c) = o; }
    asm volatile("s_waitcnt lgkmcnt(0)" ::: "memory");
}
__device__ __forceinline__ void p_transpose(const int wv, const float* W, int K, int N, bf16_t* WT, const float* kgain, int mode, LAS unsigned char* lds) {
    LTID();
    const int wave = tidx >> 6, lane = tidx & 63;
    LAS float* scr = (LAS float*)(lds + wave * 16384);
    const int nitems = (K / 64) * (N / 32);
    for (int it = bidx * NW + wave; it < nitems; it += gridDim.x * NW) transpose_item(W, K, N, WT, kgain, mode, scr, it, lane);
}

__device__ __forceinline__ void p_rmsnorm(const int wv, const float* in, int in_ld, const float* g, float* out, int out_ld, int rows, int D, bf16_t* out16 = nullptr) {
    LTID();
    const int lane = tidx & 63, wave = tidx >> 6;
    for (int r = bidx * NW + wave; r < rows; r += gridDim.x * NW) {
        const float* p = in + (size_t)r * in_ld;
        float ss = 0.f;
        for (int i = lane; i < D; i += 64) { float v = p[i]; ss += v * v; }
        for (int o = 32; o; o >>= 1) ss += shx(ss, o, lane);
        const float sc = rsqrtf(ss / (float)D + 1e-5f);
        if (out16) { for (int i = lane; i < D; i += 64) out16[(size_t)r * out_ld + i] = (bf16_t)f2bf(p[i] * sc * g[i]); }
        if (out) { for (int i = lane; i < D; i += 64) out[(size_t)r * out_ld + i] = p[i] * sc * g[i]; }
    }
}
__device__ __forceinline__ void p_copy4(const int wv, const float* src, float* dst, size_t n4) {
    LTID();
    for (size_t i = (size_t)bidx * NT + tidx; i < n4; i += (size_t)gridDim.x * NT) ((float4*)dst)[i] = ((const float4*)src)[i];
}

enum { EP_STORE = 0, EP_RESID = 1, EP_GLU = 2, EP_MOE1 = 3, EP_MOE2 = 4 };
struct GArgs {
    const float* A; int lda; const float* B; int ldb; float* C; int ldc; int M, N, K;
    const float* bias; const float* aux;
    const int* rowtok; const int* offs; const unsigned* cnts;
    size_t strideB; int strideBias; int nexp;
};
template <int EP> __device__ __forceinline__ void p_gemm(const int wv, const GArgs& a, LAS unsigned char* lds) {
    LTID();
    LAS float* As = (LAS float*)lds;
    LAS float* Bs = As + 16 * 132;
    LAS float* Bs2 = Bs + 16 * 68;
    const int tid = tidx, ty = tid >> 4, tx = tid & 15;
    const int lr = tid >> 2, lk = (tid & 3) * 4;
    const int bsel = tid >> 8, bt = tid & 255, bk = bt >> 4, bn = (bt & 15) * 4;
    const int nN = a.N / 64;
    const int mt_max = (a.M + 127) / 128;
    const int per_e = mt_max * nN;
    const int total = per_e * a.nexp;
    for (int t = bidx; t < total; t += gridDim.x) {
        const int e = t / per_e, r = t - e * per_e, mt = r / nN, nt = r - mt * nN;
        int M = a.M, rowbase = 0;
        if (EP == EP_MOE1 || EP == EP_MOE2) { M = (int)a.cnts[e]; rowbase = a.offs[e]; }
        const int m0 = mt * 128, n0 = nt * 64;
        if (m0 >= M) continue;
        const float* B = a.B + (size_t)e * a.strideB;
        const float* bias = a.bias ? a.bias + (size_t)e * a.strideBias : nullptr;
        int ar = m0 + lr; if (ar >= M) ar = M - 1;
        const float* Arow;
        if (EP == EP_MOE1) Arow = a.A + (size_t)a.rowtok[rowbase + ar] * a.lda;
        else Arow = a.A + (size_t)(rowbase + ar) * a.lda;
        float acc[4][4], acc2[4][4];
#pragma unroll
        for (int i = 0; i < 4; ++i)
#pragma unroll
            for (int j = 0; j < 4; ++j) { acc[i][j] = 0.f; acc2[i][j] = 0.f; }
        for (int k0 = 0; k0 < a.K; k0 += 16) {
            const float4 av = *(const float4*)(Arow + k0 + lk);
            float4 bv = make_float4(0.f, 0.f, 0.f, 0.f);
            if (bsel == 0) bv = *(const float4*)(B + (size_t)(k0 + bk) * a.ldb + n0 + bn);
            else if (EP == EP_MOE1) bv = *(const float4*)(B + (size_t)(k0 + bk) * a.ldb + DFF + n0 + bn);
            __syncthreads();
            As[(lk + 0) * 132 + lr] = av.x; As[(lk + 1) * 132 + lr] = av.y; As[(lk + 2) * 132 + lr] = av.z; As[(lk + 3) * 132 + lr] = av.w;
            if (bsel == 0) *(LAS f32x4*)&Bs[bk * 68 + bn] = (f32x4){bv.x, bv.y, bv.z, bv.w};
            else if (EP == EP_MOE1) *(LAS f32x4*)&Bs2[bk * 68 + bn] = (f32x4){bv.x, bv.y, bv.z, bv.w};
            __syncthreads();
#pragma unroll
            for (int kk = 0; kk < 16; ++kk) {
                const f32x4 a4 = *(const LAS f32x4*)&As[kk * 132 + ty * 4];
                const f32x4 b4 = *(const LAS f32x4*)&Bs[kk * 68 + tx * 4];
                const float aa[4] = {a4.x, a4.y, a4.z, a4.w}, bb[4] = {b4.x, b4.y, b4.z, b4.w};
#pragma unroll
                for (int i = 0; i < 4; ++i)
#pragma unroll
                    for (int j = 0; j < 4; ++j) acc[i][j] += aa[i] * bb[j];
                if (EP == EP_MOE1) {
                    const f32x4 c4 = *(const LAS f32x4*)&Bs2[kk * 68 + tx * 4];
                    const float cc[4] = {c4.x, c4.y, c4.z, c4.w};
#pragma unroll
                    for (int i = 0; i < 4; ++i)
#pragma unroll
                        for (int j = 0; j < 4; ++j) acc2[i][j] += aa[i] * cc[j];
                }
            }
        }
#pragma unroll
        for (int i = 0; i < 4; ++i) {
            const int rr = m0 + ty * 4 + i;
            if (rr < M) {
                const size_t crow = (size_t)(rowbase + rr) * a.ldc;
#pragma unroll
                for (int j = 0; j < 4; ++j) {
                    const int c = n0 + tx * 4 + j;
                    float v = acc[i][j];
                    if (EP == EP_STORE) { if (bias) v += bias[c]; }
                    else if (EP == EP_RESID) v += a.aux[crow + c];
                    else if (EP == EP_GLU) { const float y = a.aux[crow + c]; v = y / (1.f + expf(-(v + bias[c]))); }
                    else if (EP == EP_MOE1) {
                        const float g = fminf(v + bias[c], 7.f);
                        const float l = fminf(fmaxf(acc2[i][j] + bias[DFF + c], -7.f), 7.f);
                        v = g / (1.f + expf(-1.702f * g)) * (l + 1.f);
                    } else if (EP == EP_MOE2) v += bias[c];
                    a.C[crow + c] = v;
                }
            }
        }
    }
    __syncthreads();
}

__device__ __forceinline__ int t5_bucket(int n) {
    if (n < 16) return n;
    const float v = logf((float)n / 16.f) / 4.852030263919617f * 16.f;
    const int large = 16 + (int)v;
    return large < 31 ? large : 31;
}
__device__ __forceinline__ void p_dilattn(const int wv, const float* proj, const float* rel_bias, float* ya, LAS unsigned char* lds) {
    LTID();
    const int w = tidx >> 6, lane = tidx & 63;
    LAS float* ps = (LAS float*)lds + w * 392;
    for (int gw = bidx * NW + w; gw < SEQ * 8; gw += gridDim.x * NW) {
        const int pos = gw >> 3, h = gw & 7;
        const float* q = proj + (size_t)pos * DIN + h * 64;
        float sc[7]; float mx = -1e30f;
#pragma unroll
        for (int it = 0; it < 7; ++it) {
            const int i = it * 64 + lane; float s = -1e30f;
            if (i < 387) {
                const int b = i / 129, d = i - b * 129, dil = 1 << (2 * b), kp = pos - d * dil;
                if (kp >= 0) {
                    const float* kr = proj + (size_t)kp * DIN + 512 + h * 64;
                    float dot = 0.f;
                    for (int e = 0; e < 64; e += 4) { const float4 qa = *(const float4*)(q + e), ka = *(const float4*)(kr + e); dot += qa.x * ka.x + qa.y * ka.y + qa.z * ka.z + qa.w * ka.w; }
                    s = dot * 0.125f + rel_bias[t5_bucket(d * dil) * 8 + h];
                }
            }
            sc[it] = s; mx = fmaxf(mx, s);
        }
        for (int o = 32; o; o >>= 1) mx = fmaxf(mx, shx(mx, o, lane));
        float den = 0.f;
#pragma unroll
        for (int it = 0; it < 7; ++it) {
            const int i = it * 64 + lane;
            const float p = (sc[it] > -1e29f) ? expf(sc[it] - mx) : 0.f;
            den += p;
            if (i < 387) ps[i] = p;
        }
        for (int o = 32; o; o >>= 1) den += shx(den, o, lane);
        __syncthreads();
        float acc = 0.f;
        for (int i = 0; i < 387; ++i) {
            const int b = i / 129, d = i - b * 129, dil = 1 << (2 * b), kp = pos - d * dil;
            if (kp >= 0) acc += ps[i] * proj[(size_t)kp * DIN + 1024 + h * 64 + lane];
        }
        ya[(size_t)pos * 512 + h * 64 + lane] = acc / den;
        __syncthreads();
    }
}

__device__ __forceinline__ void p_s5_tables(const int wv, const float* a_re, const float* a_im, const float* b_re, const float* b_im, const float* log_dt,
                                            float2* abar, float2* a128, float2* bbar) {
    LTID();
    for (int gp = bidx * NT + tidx; gp < 2048; gp += gridDim.x * NT) {
        const int g = gp >> 6;
        const float lr = a_re[gp], li = a_im[gp], dt = expf(log_dt[g]);
        const float mag = expf(lr * dt); float sn, cs; sincosf(li * dt, &sn, &cs);
        const float ar = mag * cs, ai = mag * sn;
        abar[gp] = make_float2(ar, ai);
        float pr = ar, pi = ai;
        for (int i = 0; i < 7; ++i) { const float nr = pr * pr - pi * pi, ni = 2.f * pr * pi; pr = nr; pi = ni; }
        a128[gp] = make_float2(pr, pi);
        const float nr = ar - 1.f, ni = ai, den = lr * lr + li * li;
        const float cr = (nr * lr + ni * li) / den, ci = (ni * lr - nr * li) / den;
        for (int c = 0; c < 16; ++c) {
            const float br = b_re[gp * 16 + c], bi = b_im[gp * 16 + c];
            bbar[gp * 16 + c] = make_float2(cr * br - ci * bi, cr * bi + ci * br);
        }
    }
}
template <int MODE> __device__ __forceinline__ void p_s5_local(const int wv, const float* proj, const float2* abar, const float2* bbar,
        const float* c_re, const float* c_im, const float* dskip, const float2* Sin, float2* E, float* ybuf, bf16_t* yg16) {
    LTID();
    const int w = tidx >> 6, p = tidx & 63;
    for (int item = bidx * NW + w; item < NCHUNK * 32; item += gridDim.x * NW) {
        const int chunk = item >> 5, g = item & 31, gp = g * 64 + p;
        float br[16], bi[16], cr[16], ci[16];
#pragma unroll
        for (int c = 0; c < 16; ++c) { const float2 b = bbar[gp * 16 + c]; br[c] = b.x; bi[c] = b.y; }
        if (MODE == 1) {
#pragma unroll
            for (int c = 0; c < 16; ++c) { cr[c] = c_re[(g * 16 + c) * 64 + p]; ci[c] = c_im[(g * 16 + c) * 64 + p]; }
        }
        const float2 a = abar[gp];
        float sr = 0.f, si = 0.f;
        if (MODE == 1) { const float2 s0 = Sin[chunk * 2048 + gp]; sr = s0.x; si = s0.y; }
        for (int t = 0; t < 128; ++t) {
            const int s = chunk * 128 + t;
            const float* up = proj + (size_t)s * DIN + 1536 + g * 16;
            float u[16];
#pragma unroll
            for (int c = 0; c < 16; c += 4) { const float4 v = *(const float4*)(up + c); u[c] = v.x; u[c + 1] = v.y; u[c + 2] = v.z; u[c + 3] = v.w; }
            float bur = 0.f, bui = 0.f;
#pragma unroll
            for (int c = 0; c < 16; ++c) { bur += br[c] * u[c]; bui += bi[c] * u[c]; }
            const float nr = a.x * sr - a.y * si + bur, ni = a.x * si + a.y * sr + bui;
            sr = nr; si = ni;
            if (MODE == 1) {
                float myy = 0.f;
#pragma unroll
                for (int c = 0; c < 16; ++c) {
                    float v = cr[c] * sr - ci[c] * si;
                    for (int o = 32; o; o >>= 1) v += shx(v, o, p);
                    if (p == c) myy = v + dskip[g * 16 + c] * u[c];
                }
                if (p < 16) { const float yv = 0.5f * myy * (1.f + erff(myy * 0.70710678118654752f)); ybuf[(size_t)s * 512 + g * 16 + p] = yv; yg16[(size_t)s * 512 + g * 16 + p] = (bf16_t)f2bf(yv); }
            }
        }
        if (MODE == 0) E[chunk * 2048 + gp] = make_float2(sr, si);
    }
}
__device__ __forceinline__ void p_s5_carry(const int wv, const float2* a128, const float2* E, float2* Sin) {
    LTID();
    for (int gp = bidx * NT + tidx; gp < 2048; gp += gridDim.x * NT) {
        const float2 a = a128[gp];
        float sr = 0.f, si = 0.f;
        for (int c = 0; c < NCHUNK; ++c) {
            Sin[c * 2048 + gp] = make_float2(sr, si);
            const float2 e = E[c * 2048 + gp];
            const float nr = a.x * sr - a.y * si + e.x, ni = a.x * si + a.y * sr + e.y;
            sr = nr; si = ni;
        }
    }
}
__device__ __forceinline__ void p_xattn(const int wv, const float* qx, const float* kvx, float* ox, bf16_t* ox16, LAS unsigned char* lds) {
    LTID();
    const int w = tidx >> 6, lane = tidx & 63;
    LAS float* ps = (LAS float*)lds + w * 256;
    for (int gw = bidx * NW + w; gw < SEQ * 4; gw += gridDim.x * NW) {
        const int pos = gw >> 2, h = gw & 3;
        const float* q = qx + (size_t)pos * 512 + h * 128;
        float sc[4]; float mx = -1e30f;
#pragma unroll
        for (int j = 0; j < 4; ++j) {
            const int m = j * 64 + lane;
            const float* kr = kvx + (size_t)m * 1024 + h * 128;
            float dot = 0.f;
            for (int e = 0; e < 128; e += 4) { const float4 qa = *(const float4*)(q + e), ka = *(const float4*)(kr + e); dot += qa.x * ka.x + qa.y * ka.y + qa.z * ka.z + qa.w * ka.w; }
            sc[j] = dot * 0.08838834764831845f; mx = fmaxf(mx, sc[j]);
        }
        for (int o = 32; o; o >>= 1) mx = fmaxf(mx, shx(mx, o, lane));
        float den = 0.f;
#pragma unroll
        for (int j = 0; j < 4; ++j) { const float p = expf(sc[j] - mx); den += p; ps[j * 64 + lane] = p; }
        for (int o = 32; o; o >>= 1) den += shx(den, o, lane);
        __syncthreads();
        float a0 = 0.f, a1 = 0.f;
        for (int m = 0; m < 256; ++m) {
            const float p = ps[m];
            const float* vr = kvx + (size_t)m * 1024 + 512 + h * 128;
            a0 += p * vr[lane]; a1 += p * vr[64 + lane];
        }
        ox[(size_t)pos * 512 + h * 128 + lane] = a0 / den;
        ox[(size_t)pos * 512 + h * 128 + 64 + lane] = a1 / den;
        ox16[(size_t)pos * 512 + h * 128 + lane] = (bf16_t)f2bf(a0 / den);
        ox16[(size_t)pos * 512 + h * 128 + 64 + lane] = (bf16_t)f2bf(a1 / den);
        __syncthreads();
    }
}
__device__ __forceinline__ void p_router(const int wv, const float* xn, const float* w_r, const float* b_r, int* topi, float* topg, unsigned* cnt) {
    LTID();
    const int lane = tidx & 63, e = lane & 31, w = tidx >> 6;
    for (int base = (bidx * NW + w) * 2; base < SEQ; base += gridDim.x * NW * 2) {
        const int token = base + (lane >> 5);
        const float* x = xn + (size_t)token * DM;
        float acc = 0.f;
        for (int k = 0; k < DM; ++k) acc += x[k] * w_r[k * 32 + e];
        float v = acc + b_r[e];
        float tv[4]; int ti[4];
#pragma unroll
        for (int r = 0; r < 4; ++r) {
            float bv = v; int bi = e;
#pragma unroll
            for (int o = 16; o; o >>= 1) {
                const float ov = shx(bv, o, lane); const int oi = shxi(bi, o, lane);
                if (ov > bv || (ov == bv && oi < bi)) { bv = ov; bi = oi; }
            }
            tv[r] = bv; ti[r] = bi;
            if (e == bi) v = -3.0e38f;
        }
        float ex[4], sum = 0.f;
#pragma unroll
        for (int r = 0; r < 4; ++r) { ex[r] = expf(tv[r] - tv[0]); sum += ex[r]; }
        if (e < 4) {
            const float gsel = e == 0 ? ex[0] : e == 1 ? ex[1] : e == 2 ? ex[2] : ex[3];
            const int isel = e == 0 ? ti[0] : e == 1 ? ti[1] : e == 2 ? ti[2] : ti[3];
            topi[token * 4 + e] = isel; topg[token * 4 + e] = gsel / sum;
            atomicAdd(&cnt[isel], 1u);
        }
    }
}
__device__ __forceinline__ void p_moe_place(const int wv, const int* topi, const unsigned* cnt, unsigned* cursor, int* rowtok, int* posof, LAS unsigned char* lds) {
    LTID();
    LAS int* offs = (LAS int*)lds;
    if (tidx == 0) { int s = 0; for (int e = 0; e < NEXP; ++e) { offs[e] = s; s += (((int)cnt[e] + BM - 1) / BM) * BM; } }
    __syncthreads();
    for (int i = bidx * NT + tidx; i < SEQ * TOPK; i += gridDim.x * NT) {
        const int e = topi[i];
        const int pos = offs[e] + (int)atomicAdd(&cursor[e], 1u);
        rowtok[pos] = i >> 2; posof[i] = pos;
    }
    if (bidx == 0) {
        for (int e = 0; e < NEXP; ++e) { const int c0 = (int)cnt[e], c1 = ((c0 + BM - 1) / BM) * BM; for (int r = c0 + tidx; r < c1; r += NT) rowtok[offs[e] + r] = 0; }
    }
    __syncthreads();
}
__device__ __forceinline__ void p_combine(const int wv, float* h, const bf16_t* outb, const int* posof, const float* topg) {
    LTID();
    for (int i = bidx * NT + tidx; i < SEQ * 256; i += gridDim.x * NT) {
        const int token = i >> 8, c4 = (i & 255) * 4;
        float4 acc = *(const float4*)(h + (size_t)token * DM + c4);
#pragma unroll
        for (int k = 0; k < 4; ++k) {
            const float g = topg[token * 4 + k];
            const u32x2 o = *(const u32x2*)(outb + (size_t)posof[token * 4 + k] * DM + c4);
            acc.x += g * __builtin_bit_cast(float, o.x << 16); acc.y += g * __builtin_bit_cast(float, o.x & 0xffff0000u);
            acc.z += g * __builtin_bit_cast(float, o.y << 16); acc.w += g * __builtin_bit_cast(float, o.y & 0xffff0000u);
        }
        *(float4*)(h + (size_t)token * DM + c4) = acc;
    }
}

constexpr int NPL = 18;
constexpr int NPHASES = 1 + 2 * NPL + 1;
typedef const __attribute__((address_space(4))) Args* KA;
#define PHASE __device__ __forceinline__
#define KAP() ({ KA _t = a; asm volatile("" : "+s"(_t)); _t; })
#define WSP(T, off) ((T*)(a->ws + (off)))

PHASE void ph_init(KA a, const int wv) {
    p_copy4(wv, a->in[0], WSP(float, WS_H), (size_t)SEQ * DM / 4);
    for (int l = 0; l < 2; ++l) {
        p_s5_tables(wv, a->in[5] + l * 2048, a->in[6] + l * 2048, a->in[7] + l * 32768, a->in[8] + l * 32768, a->in[11] + l * 32,
                    WSP(float2, WS_ABAR) + l * 2048, WSP(float2, WS_A128) + l * 2048, WSP(float2, WS_BBAR) + l * 32768);
        p_rmsnorm(wv, a->in[1], DM, a->in[19] + l * DM, nullptr, DM, NMEM, DM, WSP(bf16_t, WS_MEMN16) + (size_t)l * NMEM * DM);
        p_transpose(wv, a->in[4] + (size_t)l * DM * DIN, DM, DIN, WSP(bf16_t, WS_WT_IN) + (size_t)l * DIN * DM, nullptr, 0, LDSP);
        p_transpose(wv, a->in[13] + (size_t)l * 512 * 512, 512, 512, WSP(bf16_t, WS_WT_GLU) + (size_t)l * 512 * 512, nullptr, 0, LDSP);
        p_transpose(wv, a->in[17] + (size_t)l * DM * DM, DM, DM, WSP(bf16_t, WS_WT_OUT) + (size_t)l * DM * DM, nullptr, 0, LDSP);
        p_transpose(wv, a->in[20] + (size_t)l * DM * 512, DM, 512, WSP(bf16_t, WS_WT_XQ) + (size_t)l * 512 * DM, nullptr, 0, LDSP);
        p_transpose(wv, a->in[21] + (size_t)l * DM * 1024, DM, 1024, WSP(bf16_t, WS_WT_XKV) + (size_t)l * 1024 * DM, nullptr, 0, LDSP);
        p_transpose(wv, a->in[22] + (size_t)l * 512 * DM, 512, DM, WSP(bf16_t, WS_WT_XO) + (size_t)l * DM * 512, nullptr, 0, LDSP);
    }
    for (int le = 0; le < 2 * NEXP; ++le) {
        p_transpose(wv, a->in[26] + (size_t)le * DM * 2048, DM, 2048, WSP(bf16_t, WS_BT1) + (size_t)le * 2048 * DM, nullptr, 1, LDSP);
        p_transpose(wv, a->in[28] + (size_t)le * DFF * DM, DFF, DM, WSP(bf16_t, WS_BT2) + (size_t)le * DM * DFF, nullptr, 0, LDSP);
    }
    __syncthreads();
}
PHASE void ph_norm(KA a, const int wv, int which, int l) {
    const float* g = (which == 0 ? a->in[3] : which == 1 ? a->in[18] : a->in[23]) + l * DM;
    if (which == 2) p_rmsnorm(wv, WSP(float, WS_H), DM, g, WSP(float, WS_XN), DM, SEQ, DM, WSP(bf16_t, WS_XN16));
    else p_rmsnorm(wv, WSP(float, WS_H), DM, g, nullptr, DM, SEQ, DM, WSP(bf16_t, WS_XN16));
}
PHASE void ph_gemm_in(KA a, const int wv, int l) { LTID();
    DenseOrder S; S.init(WSP(bf16_t, WS_XN16), WSP(bf16_t, WS_WT_IN) + (size_t)l * DIN * DM, SEQ, DIN, DM, gridDim.x, bidx);
    EpiF32 E{WSP(float, WS_PROJ), DIN, 0};
    gemm_phase<EpiF32, DenseOrder, false, false>(LDSP, DM, S, E, tidx);
}
PHASE void ph_dilattn(KA a, const int wv) { p_dilattn(wv, WSP(float, WS_PROJ), a->in[2], WSP(float, WS_YA), LDSP); }
PHASE void ph_s5_local0(KA a, const int wv, int l) {
    p_s5_local<0>(wv, WSP(float, WS_PROJ), WSP(float2, WS_ABAR) + l * 2048, WSP(float2, WS_BBAR) + l * 32768, a->in[9] + l * 32768, a->in[10] + l * 32768, a->in[12] + l * 512,
                  WSP(float2, WS_SIN), WSP(float2, WS_E), WSP(float, WS_YBUF), WSP(bf16_t, WS_YG16));
}
PHASE void ph_s5_carry(KA a, const int wv, int l) { p_s5_carry(wv, WSP(float2, WS_A128) + l * 2048, WSP(float2, WS_E), WSP(float2, WS_SIN)); }
PHASE void ph_s5_local1(KA a, const int wv, int l) {
    p_s5_local<1>(wv, WSP(float, WS_PROJ), WSP(float2, WS_ABAR) + l * 2048, WSP(float2, WS_BBAR) + l * 32768, a->in[9] + l * 32768, a->in[10] + l * 32768, a->in[12] + l * 512,
                  WSP(float2, WS_SIN), WSP(float2, WS_E), WSP(float, WS_YBUF), WSP(bf16_t, WS_YG16));
}
PHASE void ph_gemm_glu(KA a, const int wv, int l) { LTID();
    DenseOrder S; S.init(WSP(bf16_t, WS_YG16), WSP(bf16_t, WS_WT_GLU) + (size_t)l * 512 * 512, SEQ, 512, 512, gridDim.x, bidx);
    EpiGlu E{WSP(float, WS_YB), WSP(float, WS_YBUF), 512, a->in[14] + l * 512};
    gemm_phase<EpiGlu, DenseOrder, false, false>(LDSP, 512, S, E, tidx);
}
PHASE void ph_norm_mixout(KA a, const int wv, int l) {
    p_rmsnorm(wv, WSP(float, WS_YA), 512, a->in[15] + l * 512, nullptr, DM, SEQ, 512, WSP(bf16_t, WS_MIX16));
    p_rmsnorm(wv, WSP(float, WS_YB), 512, a->in[16] + l * 512, nullptr, DM, SEQ, 512, WSP(bf16_t, WS_MIX16) + 512);
}
PHASE void ph_gemm_out(KA a, const int wv, int l) { LTID();
    DenseOrder S; S.init(WSP(bf16_t, WS_MIX16), WSP(bf16_t, WS_WT_OUT) + (size_t)l * DM * DM, SEQ, DM, DM, gridDim.x, bidx);
    EpiF32 E{WSP(float, WS_H), DM, 1};
    gemm_phase<EpiF32, DenseOrder, false, false>(LDSP, DM, S, E, tidx);
}
PHASE void ph_gemm_kv(KA a, const int wv, int l) { LTID();
    DenseOrder S; S.init(WSP(bf16_t, WS_MEMN16) + (size_t)l * NMEM * DM, WSP(bf16_t, WS_WT_XKV) + (size_t)l * 1024 * DM, NMEM, 1024, DM, gridDim.x, bidx);
    EpiF32 E{WSP(float, WS_KVX), 1024, 0};
    gemm_phase<EpiF32, DenseOrder, false, false>(LDSP, DM, S, E, tidx);
}
PHASE void ph_gemm_xq(KA a, const int wv, int l) { LTID();
    DenseOrder S; S.init(WSP(bf16_t, WS_XN16), WSP(bf16_t, WS_WT_XQ) + (size_t)l * 512 * DM, SEQ, 512, DM, gridDim.x, bidx);
    EpiF32 E{WSP(float, WS_QX), 512, 0};
    gemm_phase<EpiF32, DenseOrder, false, false>(LDSP, DM, S, E, tidx);
}
PHASE void ph_xattn(KA a, const int wv) { p_xattn(wv, WSP(float, WS_QX), WSP(float, WS_KVX), WSP(float, WS_OX), WSP(bf16_t, WS_OX16), LDSP); }
PHASE void ph_gemm_xo(KA a, const int wv, int l) { LTID();
    DenseOrder S; S.init(WSP(bf16_t, WS_OX16), WSP(bf16_t, WS_WT_XO) + (size_t)l * DM * 512, SEQ, DM, 512, gridDim.x, bidx);
    EpiF32 E{WSP(float, WS_H), DM, 1};
    gemm_phase<EpiF32, DenseOrder, false, false>(LDSP, 512, S, E, tidx);
}
PHASE void ph_router(KA a, const int wv, int l) { p_router(wv, WSP(float, WS_XN), a->in[24] + (size_t)l * DM * 32, a->in[25] + l * 32, WSP(int, WS_TOPI), WSP(float, WS_TOPG), WSP(unsigned, WS_CTL) + CW_CNT + l * 32); }
PHASE void ph_place(KA a, const int wv, int l) { p_moe_place(wv, WSP(int, WS_TOPI), WSP(unsigned, WS_CTL) + CW_CNT + l * 32, WSP(unsigned, WS_CTL) + CW_CUR + l * 32, WSP(int, WS_ROWTOK), WSP(int, WS_POSOF), LDSP); }
PHASE void ph_moe1(KA a, const int wv, int l) { LTID();
    moe_tiles(WSP(unsigned, WS_CTL) + CW_CNT + l * 32, tidx);
    MoeOrder<true> S; S.init(WSP(bf16_t, WS_XN16), WSP(bf16_t, WS_BT1) + (size_t)l * NEXP * 2048 * DM, WSP(int, WS_ROWTOK), 2048, DM, (size_t)2048 * DM * 2, gridDim.x, bidx);
    EpiMoe1 E{WSP(bf16_t, WS_ACT), a->in[27] + (size_t)l * NEXP * 2048};
    gemm_phase<EpiMoe1, MoeOrder<true>, true, false>(LDSP, DM, S, E, tidx);
}
PHASE void ph_moe2(KA a, const int wv, int l) { LTID();
    moe_tiles(WSP(unsigned, WS_CTL) + CW_CNT + l * 32, tidx);
    MoeOrder<false> S; S.init(WSP(bf16_t, WS_ACT), WSP(bf16_t, WS_BT2) + (size_t)l * NEXP * DM * DFF, nullptr, DM, DFF, (size_t)DM * DFF * 2, gridDim.x, bidx);
    EpiMoe2 E{WSP(bf16_t, WS_MOUT), a->in[29] + (size_t)l * NEXP * DM};
    gemm_phase<EpiMoe2, MoeOrder<false>, false, false>(LDSP, DFF, S, E, tidx);
}
PHASE void ph_combine(KA a, const int wv) { p_combine(wv, WSP(float, WS_H), WSP(bf16_t, WS_MOUT), WSP(int, WS_POSOF), WSP(float, WS_TOPG)); }
PHASE void ph_final(KA a, const int wv) { p_rmsnorm(wv, WSP(float, WS_H), DM, a->in[30], a->out, DM, SEQ, DM); }

__global__ void __launch_bounds__(NT, 2) mega(Args args) {
    KA a = (KA)__builtin_amdgcn_kernarg_segment_ptr();
    int wv = __builtin_amdgcn_readfirstlane((int)threadIdx.x >> 6); asm volatile("" : "+s"(wv));
    LAS unsigned char* lds = LDSP;
    volatile LAS unsigned* MISC = (volatile LAS unsigned*)(lds + MISC_OFF);
    unsigned* ctl = (unsigned*)(a->ws + WS_CTL);
    if (threadIdx.x < 32) MISC[threadIdx.x] = 0u;
    __syncthreads();
    XcdBarrier bar; bar.bar = ctl + CW_BAR; bar.x = 0; bar.st = nullptr;
    if (!MK_PER_PHASE) bar = xcd_barrier_post(ctl + CW_BAR, MISC + 8);
    const int lo = a->ph_lo, hi = a->ph_hi;
#define IN(k) (lo <= (k) && (k) < hi)
#define SEAM(k) do { if (IN(k) && IN((k) + 1)) { LTID(); xcd_barrier(bar.bar, bar.x, bar.st, tidx == 0); } } while (0)
    if (IN(0)) ph_init(KAP(), wv);
    SEAM(0);
#pragma unroll 1
    for (int l = 0; l < 2; ++l) {
        const int pb = 1 + l * NPL;
        if (IN(pb + 0)) ph_norm(KAP(), wv, 0, l);
        SEAM(pb + 0);
        if (IN(pb + 1)) ph_gemm_in(KAP(), wv, l);
        SEAM(pb + 1);
        if (IN(pb + 2)) { ph_dilattn(KAP(), wv); ph_s5_local0(KAP(), wv, l); }
        SEAM(pb + 2);
        if (IN(pb + 3)) ph_s5_carry(KAP(), wv, l);
        SEAM(pb + 3);
        if (IN(pb + 4)) ph_s5_local1(KAP(), wv, l);
        SEAM(pb + 4);
        if (IN(pb + 5)) ph_gemm_glu(KAP(), wv, l);
        SEAM(pb + 5);
        if (IN(pb + 6)) ph_norm_mixout(KAP(), wv, l);
        SEAM(pb + 6);
        if (IN(pb + 7)) ph_gemm_out(KAP(), wv, l);
        SEAM(pb + 7);
        if (IN(pb + 8)) { ph_norm(KAP(), wv, 1, l); ph_gemm_kv(KAP(), wv, l); }
        SEAM(pb + 8);
        if (IN(pb + 9)) ph_gemm_xq(KAP(), wv, l);
        SEAM(pb + 9);
        if (IN(pb + 10)) ph_xattn(KAP(), wv);
        SEAM(pb + 10);
        if (IN(pb + 11)) ph_gemm_xo(KAP(), wv, l);
        SEAM(pb + 11);
        if (IN(pb + 12)) ph_norm(KAP(), wv, 2, l);
        SEAM(pb + 12);
        if (IN(pb + 13)) ph_router(KAP(), wv, l);
        SEAM(pb + 13);
        if (IN(pb + 14)) ph_place(KAP(), wv, l);
        SEAM(pb + 14);
        if (IN(pb + 15)) ph_moe1(KAP(), wv, l);
        SEAM(pb + 15);
        if (IN(pb + 16)) ph_moe2(KAP(), wv, l);
        SEAM(pb + 16);
        if (IN(pb + 17)) ph_combine(KAP(), wv);
        SEAM(pb + 17);
    }
    if (IN(NPHASES - 1)) ph_final(KAP(), wv);
#undef IN
#undef SEAM
}

extern "C" void kernel_launch(void* const* d_in, const int* in_sizes, int n_in, void* d_out, int out_size, void* d_ws, size_t ws_size, hipStream_t stream) {
    static int grid = 0;
    if (grid == 0) {
        if (n_in != 31 || ws_size < WS_END) { fprintf(stderr, "kernel_launch: unexpected n_in %d or ws_size %zu (need %zu)\n", n_in, ws_size, (size_t)WS_END); grid = -1; return; }
        int dev = 0, cus = 0, per_cu = 0;
        if (hipGetDevice(&dev) != hipSuccess || hipDeviceGetAttribute(&cus, hipDeviceAttributeMultiprocessorCount, dev) != hipSuccess) { grid = -1; return; }
        if (hipFuncSetAttribute((const void*)mega, hipFuncAttributeMaxDynamicSharedMemorySize, LDS_BYTES) != hipSuccess) { fprintf(stderr, "kernel_launch: hipFuncSetAttribute failed\n"); grid = -1; return; }
        if (hipOccupancyMaxActiveBlocksPerMultiprocessor(&per_cu, (const void*)mega, NT, LDS_BYTES) != hipSuccess || per_cu < 1)
            fprintf(stderr, "kernel_launch: occupancy query reports %d workgroups per CU\n", per_cu);
        (void)hipGetLastError();
        grid = cus;
    }
    if (grid < 0) return;
    if (hipMemsetAsync((char*)d_ws + WS_CTL, 0, CTL_ZERO_BYTES, stream) != hipSuccess) return;
    Args a{};
    for (int i = 0; i < 31; ++i) a.in[i] = (const float*)d_in[i];
    a.out = (float*)d_out; a.ws = (unsigned char*)d_ws;
#if MK_PER_PHASE
    for (int p = 0; p < NPHASES; ++p) { a.ph_lo = p; a.ph_hi = p + 1; hipLaunchKernelGGL(mega, dim3(grid), dim3(NT), LDS_BYTES, stream, a); }
#else
    a.ph_lo = 0; a.ph_hi = NPHASES;
    hipLaunchKernelGGL(mega, dim3(grid), dim3(NT), LDS_BYTES, stream, a);
#endif
}
```

```cpp
#include <hip/hip_runtime.h>
#include <stdint.h>
#include <cstdio>

#ifndef MK_PER_PHASE
#define MK_PER_PHASE 0
#endif

#define SEQ 16384
#define DM 1024
#define DIN 2048
#define NMEM 256
#define NEXP 32
#define TOPK 4
#define DFF 1024
#define NCHUNK 128
#define NT 512
#define NW 8

#define LAS __attribute__((address_space(3)))
typedef float f32x4 __attribute__((ext_vector_type(4)));
extern __shared__ __attribute__((aligned(16))) unsigned char lds_raw[];
#define LDSP ((LAS unsigned char*)lds_raw)
#define LTID() int z_ = 0; asm volatile("" : "+v"(z_)); const int lane_ = (int)__builtin_amdgcn_mbcnt_hi(~0u, __builtin_amdgcn_mbcnt_lo(~0u, (unsigned)z_)); \
    const int tidx = wv * 64 + lane_; int bidx = blockIdx.x; asm volatile("" : "+s"(bidx))
__device__ __forceinline__ float shx(float v, int mask, int lane) { return __builtin_bit_cast(float, __builtin_amdgcn_ds_bpermute((lane ^ mask) << 2, __builtin_bit_cast(int, v))); }
__device__ __forceinline__ int shxi(int v, int mask, int lane) { return __builtin_amdgcn_ds_bpermute((lane ^ mask) << 2, v); }
constexpr int LDS_BYTES = 147456;
constexpr int MISC_OFF = 131072 + 320;

#define XB_TMO      128
#define XB_XCNT(j)  (256  + 64 * (j))
#define XB_XSUB(j)  (1280 + 64 * (j))
#define XB_XGEN(j)  (2304 + 64 * (j))
#define XB_TOP      3328
#define XB_TOPGEN   3392
#define XCD_BAR_WORDS 3456
#define XB_SPIN_CAP (1u << 18)

__device__ __forceinline__ unsigned xb_ld(unsigned* p)              { return __hip_atomic_load(p, __ATOMIC_RELAXED, __HIP_MEMORY_SCOPE_AGENT); }
__device__ __forceinline__ unsigned xb_add(unsigned* p, unsigned v) { return __hip_atomic_fetch_add(p, v, __ATOMIC_RELAXED, __HIP_MEMORY_SCOPE_AGENT); }
__device__ __forceinline__ unsigned xb_xcc_id() { return (unsigned)__builtin_amdgcn_s_getreg((3 << 11) | 20) & 0xFu; }
#define XB_SPIN(cond, bar) do { unsigned _sp = 0; while (cond) { __builtin_amdgcn_s_sleep(1); \
    if ((++_sp & 255u) == 0u) { if (xb_ld(&(bar)[XB_TMO])) break; if (_sp > XB_SPIN_CAP) { atomicAdd(&(bar)[XB_TMO], 1u); break; } } } } while (0)

struct XcdBarrier {
    unsigned* bar; unsigned x;
    volatile LAS unsigned* st;
};
__device__ __forceinline__ XcdBarrier xcd_barrier_post(unsigned* bar, volatile LAS unsigned* st) {
    XcdBarrier b; b.bar = bar; b.x = xb_xcc_id(); b.st = st;
    if (threadIdx.x == 0) (void)xb_add(&bar[XB_XCNT(b.x)], 1u);
    return b;
}
__device__ __forceinline__ void xcd_barrier_complete(unsigned* bar, unsigned x, unsigned& nloc, unsigned& nx) {
    const unsigned G = gridDim.x * gridDim.y * gridDim.z;
    unsigned sum, cnt, mine, sp = 0u;
    for (;;) {
        sum = 0u; cnt = 0u; mine = 0u;
#pragma unroll
        for (unsigned j = 0; j < 16; ++j) { const unsigned c = xb_ld(&bar[XB_XCNT(j)]); sum += c; cnt += (c > 0u) ? 1u : 0u; mine = (j == x) ? c : mine; }
        if (sum == G) break;
        __builtin_amdgcn_s_sleep(1);
        if ((++sp & 255u) == 0u) { if (xb_ld(&bar[XB_TMO])) break; if (sp > XB_SPIN_CAP) { atomicAdd(&bar[XB_TMO], 1u); break; } }
    }
    nloc = mine > 0u ? mine : 1u; nx = cnt > 0u ? cnt : 1u;
}
__device__ __noinline__ void xcd_barrier(unsigned* bar_, unsigned x_, volatile LAS unsigned* st_, int is_t0) {
    XcdBarrier b; b.bar = bar_; b.x = x_; b.st = st_;
    asm volatile("s_waitcnt vmcnt(0)" ::: "memory");
    __syncthreads();
    if (is_t0) {
        unsigned* bar = b.bar;
        __builtin_amdgcn_s_waitcnt(0);
        unsigned nloc = b.st[0], nx = b.st[1];
        if (nloc == 0u) { xcd_barrier_complete(bar, b.x, nloc, nx); b.st[0] = nloc; b.st[1] = nx; }
        const unsigned old = xb_add(&bar[XB_XSUB(b.x)], 1u);
        const unsigned gen = old / nloc;
        if (old + 1u == (gen + 1u) * nloc) {
            __builtin_amdgcn_fence(__ATOMIC_RELEASE, "agent");
            asm volatile("s_waitcnt vmcnt(0)" ::: "memory");
            const unsigned og = xb_add(&bar[XB_TOP], 1u);
            const unsigned tg = og / nx;
            if (og + 1u == (tg + 1u) * nx) xb_add(&bar[XB_TOPGEN], 1u);
            else XB_SPIN(xb_ld(&bar[XB_TOPGEN]) == tg, bar);
            __builtin_amdgcn_fence(__ATOMIC_ACQUIRE, "agent");
            xb_add(&bar[XB_XGEN(b.x)], 1u);
            asm volatile("s_waitcnt vmcnt(0)" ::: "memory");
        } else {
            XB_SPIN(xb_ld(&bar[XB_XGEN(b.x)]) == gen, bar);
            __builtin_amdgcn_fence(__ATOMIC_ACQUIRE, "agent");
            asm volatile("s_waitcnt vmcnt(0)" ::: "memory");
        }
    }
    __syncthreads();
}

constexpr size_t MiB = 1u << 20;
constexpr size_t WS_CTL = 0, CTL_ZERO_BYTES = 1 * MiB;
constexpr int CW_BAR = 4096;
constexpr int CW_CNT = 8192;
constexpr int CW_CUR = 8192 + 64;
constexpr size_t WS_H = 2 * MiB;
constexpr size_t WS_XN = WS_H + 64 * MiB;
constexpr size_t WS_PROJ = WS_XN + 64 * MiB;
constexpr size_t WS_YA = WS_PROJ + 128 * MiB;
constexpr size_t WS_YBUF = WS_YA + 32 * MiB;
constexpr size_t WS_YB = WS_YBUF + 32 * MiB;
constexpr size_t WS_MIX = WS_YB + 32 * MiB;
constexpr size_t WS_QX = WS_MIX + 64 * MiB;
constexpr size_t WS_OX = WS_QX + 32 * MiB;
constexpr int MOE_ROWS = SEQ * TOPK + NEXP * 256;
constexpr size_t WS_ACT = WS_OX + 32 * MiB;
constexpr size_t WS_MOUT = WS_ACT + 144 * MiB;
constexpr size_t WS_BT1 = WS_MOUT + 144 * MiB;
constexpr size_t WS_BT2 = WS_BT1 + 256 * MiB;
constexpr size_t WS_SMALL = WS_BT2 + 128 * MiB;
constexpr size_t WS_ABAR = WS_SMALL;
constexpr size_t WS_A128 = WS_ABAR + 2 * 2048 * 8;
constexpr size_t WS_BBAR = WS_A128 + 2 * 2048 * 8;
constexpr size_t WS_E = WS_BBAR + 2 * 2048 * 16 * 8;
constexpr size_t WS_SIN = WS_E + (size_t)NCHUNK * 2048 * 8;
constexpr size_t WS_MEMN = WS_SIN + (size_t)NCHUNK * 2048 * 8;
constexpr size_t WS_KVX = WS_MEMN + 2 * (size_t)NMEM * DM * 4;
constexpr size_t WS_TOPI = WS_KVX + (size_t)NMEM * 1024 * 4;
constexpr size_t WS_TOPG = WS_TOPI + (size_t)SEQ * 4 * 4;
constexpr size_t WS_ROWTOK = WS_TOPG + (size_t)SEQ * 4 * 4;
constexpr size_t WS_POSOF = WS_ROWTOK + (size_t)MOE_ROWS * 4;
constexpr size_t WS_WT_IN = (WS_POSOF + (size_t)SEQ * 4 * 4 + 255) & ~(size_t)255;
constexpr size_t WS_WT_GLU = WS_WT_IN + 2 * (size_t)2048 * 1024 * 2;
constexpr size_t WS_WT_OUT = WS_WT_GLU + 2 * (size_t)512 * 512 * 2;
constexpr size_t WS_WT_XQ = WS_WT_OUT + 2 * (size_t)1024 * 1024 * 2;
constexpr size_t WS_WT_XKV = WS_WT_XQ + 2 * (size_t)512 * 1024 * 2;
constexpr size_t WS_WT_XO = WS_WT_XKV + 2 * (size_t)1024 * 1024 * 2;
constexpr size_t WS_XN16 = WS_WT_XO + 2 * (size_t)1024 * 512 * 2;
constexpr size_t WS_MIX16 = WS_XN16 + (size_t)SEQ * 1024 * 2;
constexpr size_t WS_YG16 = WS_MIX16 + (size_t)SEQ * 1024 * 2;
constexpr size_t WS_OX16 = WS_YG16 + (size_t)SEQ * 512 * 2;
constexpr size_t WS_MEMN16 = WS_OX16 + (size_t)SEQ * 512 * 2;
constexpr size_t WS_PROJ16 = WS_MEMN16 + 2 * (size_t)NMEM * 1024 * 2;
constexpr size_t WS_OBR = WS_PROJ16 + (size_t)SEQ * 2048 * 2;
constexpr size_t WS_LSE = WS_OBR + 3 * (size_t)SEQ * 512 * 2;
constexpr size_t WS_BIASG = WS_LSE + 3 * (size_t)SEQ * 8 * 4;
constexpr size_t WS_END = WS_BIASG + 24 * 132 * 4 + 256;

struct Args { const float* in[31]; float* out; unsigned char* ws; int ph_lo, ph_hi; };


typedef unsigned short bf16_t;
typedef short bf16x8 __attribute__((ext_vector_type(8)));
typedef unsigned u32x4 __attribute__((ext_vector_type(4)));
typedef unsigned u32x2 __attribute__((ext_vector_type(2)));
constexpr int BM = 256, BK = 64, HALF = 128, HTB = HALF * BK * 2, STAGE_BYTES = 8 * HTB, NXCD = 8, WGM = 8;
__host__ __device__ __forceinline__ int lds_byte(int r, int c) { const int st = (r >> 4) * 2 + (c >> 5), rr = r & 15, cc = c & 31, ob = rr * 64 + cc * 2; return st * 1024 + (ob ^ (((ob >> 9) & 1) << 5)); }
__host__ __device__ __forceinline__ void stage_rc(int b, int& R, int& C) { const int st = b / 1024, sb = b % 1024, swz = sb ^ (((sb >> 9) & 1) << 5); R = (st >> 1) * 16 + swz / 64; C = (st & 1) * 32 + (swz % 64) / 2; }
__host__ __device__ __forceinline__ int perm32(int rho) { const int n = rho >> 4, i = rho & 15; return 8 * (i >> 2) + 4 * n + (i & 3); }
__device__ __forceinline__ unsigned cvt_pk_bf16(float lo, float hi) { unsigned r; asm volatile("v_cvt_pk_bf16_f32 %0, %1, %2" : "=v"(r) : "v"(lo), "v"(hi)); return r; }
__device__ __forceinline__ unsigned f2bf(float f) { unsigned u = __builtin_bit_cast(unsigned, f); return (u + 0x7fffu + ((u >> 16) & 1u)) >> 16; }
__device__ __forceinline__ unsigned pk2(float lo, float hi) { return f2bf(lo) | (f2bf(hi) << 16); }
__device__ __forceinline__ float bf2f(unsigned short b) { return __builtin_bit_cast(float, ((unsigned)b) << 16); }

__device__ __forceinline__ void glds16s(const void* sbase, unsigned voff, unsigned lds_dst) {
    unsigned keep;
    asm volatile("s_mov_b32 %0, m0\n\ts_mov_b32 m0, %3\n\ts_nop 0\n\tglobal_load_lds_dwordx4 %1, %2\n\ts_mov_b32 m0, %0" : "=&s"(keep) : "v"(voff), "s"(sbase), "s"(lds_dst) : "memory");
}
struct GUnit { const char* A; const char* B; int pm, pn, e; };

struct DenseOrder {
    const char* A; const char* Bt; int nM, nN, nwg, G, c, K;
    __device__ __forceinline__ void init(const bf16_t* A_, const bf16_t* Bt_, int M, int N, int K_, int G_, int c_) { A = (const char*)A_; Bt = (const char*)Bt_; nM = M / BM; nN = N / BM; nwg = nM * nN; G = G_; c = c_; K = K_; }
    __device__ __forceinline__ bool next(int i, GUnit& u) const {
        const long L = (long)i * G + c; if (L >= nwg) return false;
        int wgid = (int)L; { const int q = nwg / NXCD, r = nwg % NXCD, xcd = wgid % NXCD, off = wgid / NXCD; wgid = (xcd < r ? xcd * (q + 1) : r * (q + 1) + (xcd - r) * q) + off; }
        const int nig = WGM * nN, gid = wgid / nig, fm = gid * WGM, gsz = (nM - fm) < WGM ? (nM - fm) : WGM;
        u.pm = fm + ((wgid % nig) % gsz); u.pn = (wgid % nig) / gsz; u.e = 0;
        u.A = A + (size_t)u.pm * BM * K * 2; u.B = Bt + (size_t)u.pn * BM * K * 2; return true;
    }
    __device__ __forceinline__ unsigned aoff(const GUnit&, int row) const { return (unsigned)(row * K * 2); }
};

struct EpiF32 {
    static constexpr bool PERM = false;
    float* C; int ldc; int resid;
    __device__ __forceinline__ void operator()(const f32x4 (&acc)[2][2][4][2], const GUnit& u, int wr, int wc, int fr, int fq) const {
        const int row0 = u.pm * BM + wr * 64 + fr, col0 = u.pn * BM + wc * 32 + 4 * fq;
#pragma unroll
        for (int ai = 0; ai < 2; ++ai)
#pragma unroll
            for (int m = 0; m < 4; ++m) { float* rowp = C + (size_t)(row0 + ai * HALF + m * 16) * ldc + col0;
#pragma unroll
                for (int bj = 0; bj < 2; ++bj)
#pragma unroll
                    for (int n = 0; n < 2; ++n) { f32x4 v = acc[ai][bj][m][n]; if (resid) v += *(const f32x4*)(rowp + bj * HALF + n * 16); *(f32x4*)(rowp + bj * HALF + n * 16) = v; } }
    }
};
struct EpiGlu {
    static constexpr bool PERM = false;
    float* C; const float* Y; int ldc; const float* bias;
    __device__ __forceinline__ void operator()(const f32x4 (&acc)[2][2][4][2], const GUnit& u, int wr, int wc, int fr, int fq) const {
        const int row0 = u.pm * BM + wr * 64 + fr, col0 = u.pn * BM + wc * 32 + 4 * fq;
#pragma unroll
        for (int ai = 0; ai < 2; ++ai)
#pragma unroll
            for (int m = 0; m < 4; ++m) { const size_t ro = (size_t)(row0 + ai * HALF + m * 16) * ldc + col0;
#pragma unroll
                for (int bj = 0; bj < 2; ++bj)
#pragma unroll
                    for (int n = 0; n < 2; ++n) { const f32x4 b = *(const f32x4*)(bias + col0 + bj * HALF + n * 16); const f32x4 y = *(const f32x4*)(Y + ro + bj * HALF + n * 16);
                        f32x4 v = acc[ai][bj][m][n] + b; f32x4 o;
#pragma unroll
                        for (int j = 0; j < 4; ++j) o[j] = y[j] / (1.f + __expf(-v[j]));
                        *(f32x4*)(C + ro + bj * HALF + n * 16) = o; } }
    }
};

template <class Epi, class Sched, bool GATHER, bool ALIGN_EPI>
__device__ __forceinline__ void gemm_phase(LAS unsigned char* lds, const int K, const Sched& S, const Epi& E, const int tid, const int wv) {
    const int wid = wv, lane = tid & 63, wr = wid >> 2, wc = wid & 3, fr = lane & 15, fq = lane >> 4;
    const int nt = K / BK;
    unsigned voffB[2];
#pragma unroll
    for (int i = 0; i < 2; ++i) { int R, C; stage_rc(tid * 16 + i * 8192, R, C); const int Rb = Epi::PERM ? ((R & ~31) + perm32(R & 31)) : R; voffB[i] = (unsigned)(Rb * K + C) * 2u; }
#define PG8_AOFFS(dst, u) do { int t2_ = tid; asm volatile("" : "+v"(t2_)); _Pragma("unroll") for (int i = 0; i < 2; ++i) { int R, C; stage_rc(t2_ * 16 + i * 8192, R, C); \
        _Pragma("unroll") for (int h = 0; h < 2; ++h) dst[h][i] = S.aoff(u, h * HALF + R) + (unsigned)C * 2u; } } while (0)
    const size_t kstep = (size_t)(BK * 2);
    const size_t hstep = (size_t)HALF * K * 2;
    const unsigned ldsw = (unsigned)wid * 1024u;
    const int aoff = lds_byte(wr * 64 + fr, fq * 8), boff = lds_byte(wc * 32 + fr, fq * 8);
#define PG8_SA(b, h) (((b) * 2 + (h)) * HTB)
#define PG8_SB(b, h) ((4 + (b) * 2 + (h)) * HTB)
#define PG8_STAGE(bufoff, gbase, v0, v1) do { const unsigned ld_ = (unsigned)(size_t)(lds + (bufoff) + ldsw); glds16s((gbase), (v0), ld_); glds16s((gbase), (v1), ld_ + 8192u); } while (0)
#define PG8_LDA(dst, b, h) do { _Pragma("unroll") for (int m = 0; m < 4; ++m) _Pragma("unroll") for (int k = 0; k < 2; ++k) dst[m][k] = *(const LAS bf16x8*)(lds + PG8_SA(b, h) + aoff + m * 2048 + k * 1024); } while (0)
#define PG8_LDB(dst, b, h) do { _Pragma("unroll") for (int n = 0; n < 2; ++n) _Pragma("unroll") for (int k = 0; k < 2; ++k) dst[n][k] = *(const LAS bf16x8*)(lds + PG8_SB(b, h) + boff + n * 2048 + k * 1024); } while (0)
#define PG8_MMA(ai, bj, At, Bt) do { __builtin_amdgcn_s_setprio(1); _Pragma("unroll") for (int m = 0; m < 4; ++m) _Pragma("unroll") for (int n = 0; n < 2; ++n) _Pragma("unroll") for (int k = 0; k < 2; ++k) \
        acc[ai][bj][m][n] = __builtin_amdgcn_mfma_f32_16x16x32_bf16(Bt[n][k], At[m][k], acc[ai][bj][m][n], 0, 0, 0); __builtin_amdgcn_s_setprio(0); } while (0)
#define PG8_WAIT_V(n) asm volatile("s_waitcnt vmcnt(" #n ")" ::: "memory")
#define PG8_WAIT_L(n) asm volatile("s_waitcnt lgkmcnt(" #n ")" ::: "memory")
#define PG8_BAR __builtin_amdgcn_s_barrier()
#define PG8_SCHED __builtin_amdgcn_sched_barrier(0)
    GUnit cur, nxt; int ui = 0;
    if (!S.next(0, cur)) return;
    f32x4 acc[2][2][4][2];
#pragma unroll
    for (int a = 0; a < 2; ++a)
#pragma unroll
        for (int b = 0; b < 2; ++b)
#pragma unroll
            for (int m = 0; m < 4; ++m)
#pragma unroll
                for (int n = 0; n < 2; ++n) acc[a][b][m][n] = (f32x4){0.f, 0.f, 0.f, 0.f};
    bf16x8 At[4][2], B0[2][2], B1[2][2];
    unsigned vA[2][2], vN[2][2];
    PG8_AOFFS(vA, cur);
#pragma unroll
    for (int h = 0; h < 2; ++h)
#pragma unroll
        for (int i = 0; i < 2; ++i) vN[h][i] = vA[h][i];
    const char* cA = cur.A; const char* cB = cur.B;
    PG8_STAGE(PG8_SB(0, 0), cB, voffB[0], voffB[1]); PG8_STAGE(PG8_SB(0, 1), cB + hstep, voffB[0], voffB[1]); PG8_STAGE(PG8_SA(0, 0), cA, vA[0][0], vA[0][1]); PG8_STAGE(PG8_SA(0, 1), cA, vA[1][0], vA[1][1]);
    if (wr == 1) PG8_BAR;
    PG8_WAIT_V(2); PG8_BAR;
    PG8_STAGE(PG8_SB(1, 0), cB + kstep, voffB[0], voffB[1]); PG8_STAGE(PG8_SA(1, 0), cA + kstep, vA[0][0], vA[0][1]); PG8_STAGE(PG8_SB(1, 1), cB + hstep + kstep, voffB[0], voffB[1]);
    PG8_WAIT_V(6); PG8_BAR;
    for (;;) {
        const bool has_next = S.next(ui + 1, nxt);
        const char* nA = GATHER ? cA : (has_next ? nxt.A : cA); const char* nB = has_next ? nxt.B : cB;
        if (GATHER) {
            if (has_next) { PG8_AOFFS(vN, nxt); }
            else {
#pragma unroll
                for (int h = 0; h < 2; ++h)
#pragma unroll
                    for (int i = 0; i < 2; ++i) vN[h][i] = vA[h][i];
            }
        }
#define PG8_KBODY(a1, a2, b2, a3, b3, W00, W01, W10, W11) do { \
              \
            PG8_LDB(B0, 0, 0); PG8_LDB(B1, 0, 1); PG8_SCHED; PG8_LDA(At, 0, 0); PG8_STAGE(PG8_SA(1, 1), a1, vA[1][0], vA[1][1]); \
            PG8_WAIT_V(8); PG8_WAIT_L(0); PG8_BAR; PG8_MMA(0, 0, At, B0); PG8_MMA(0, 1, At, B1); PG8_BAR; PG8_SCHED; \
              \
            PG8_LDA(At, 0, 1); PG8_STAGE(PG8_SB(0, 0), b2, voffB[0], voffB[1]); PG8_STAGE(PG8_SB(0, 1), (b2) + hstep, voffB[0], voffB[1]); PG8_STAGE(PG8_SA(0, 0), a2, W00, W01); \
            PG8_WAIT_V(8); PG8_WAIT_L(0); PG8_BAR; PG8_MMA(1, 0, At, B0); PG8_MMA(1, 1, At, B1); PG8_BAR; PG8_SCHED; \
              \
            PG8_LDB(B0, 1, 0); PG8_LDB(B1, 1, 1); PG8_SCHED; PG8_LDA(At, 1, 0); PG8_STAGE(PG8_SA(0, 1), a2, W10, W11); \
            PG8_WAIT_V(8); PG8_WAIT_L(0); PG8_BAR; PG8_MMA(0, 0, At, B0); PG8_MMA(0, 1, At, B1); PG8_BAR; PG8_SCHED; \
              \
            PG8_LDA(At, 1, 1); PG8_STAGE(PG8_SB(1, 0), b3, voffB[0], voffB[1]); PG8_STAGE(PG8_SB(1, 1), (b3) + hstep, voffB[0], voffB[1]); PG8_STAGE(PG8_SA(1, 0), a3, W00, W01); \
            PG8_WAIT_V(8); PG8_WAIT_L(0); PG8_BAR; PG8_MMA(1, 0, At, B0); PG8_MMA(1, 1, At, B1); PG8_BAR; PG8_SCHED; } while (0)
        for (int t = 0; t < nt - 2; t += 2) {
            const char* a1 = cA + (size_t)(t + 1) * kstep;
            const char* a2 = cA + (size_t)(t + 2) * kstep; const char* b2 = cB + (size_t)(t + 2) * kstep;
            const char* a3 = a2 + kstep; const char* b3 = b2 + kstep;
            PG8_KBODY(a1, a2, b2, a3, b3, vA[0][0], vA[0][1], vA[1][0], vA[1][1]);
        }
        {
            const char* a1 = cA + (size_t)(nt - 1) * kstep;
            const char* a3 = nA + kstep; const char* b3 = nB + kstep;
            PG8_KBODY(a1, nA, nB, a3, b3, vN[0][0], vN[0][1], vN[1][0], vN[1][1]);
        }
#undef PG8_KBODY
        if constexpr (ALIGN_EPI) { if (wr == 0) PG8_BAR; }
        { int t3_ = tid; asm volatile("" : "+v"(t3_)); const int l3_ = t3_ & 63; E(acc, cur, wr, wc, l3_ & 15, l3_ >> 4); }
        if (!has_next) break;
#pragma unroll
        for (int a = 0; a < 2; ++a)
#pragma unroll
            for (int b = 0; b < 2; ++b)
#pragma unroll
                for (int m = 0; m < 4; ++m)
#pragma unroll
                    for (int n = 0; n < 2; ++n) acc[a][b][m][n] = (f32x4){0.f, 0.f, 0.f, 0.f};
        cur = nxt; cA = nA; cB = nB; ++ui;
        if (GATHER) {
#pragma unroll
            for (int h = 0; h < 2; ++h)
#pragma unroll
                for (int i = 0; i < 2; ++i) vA[h][i] = vN[h][i];
        }
        if constexpr (ALIGN_EPI) { if (wr == 1) PG8_BAR; }
    }
    PG8_WAIT_V(0);
    if constexpr (!ALIGN_EPI) { if (wr == 0) PG8_BAR; }
    PG8_BAR;
#undef PG8_AOFFS
#undef PG8_SA
#undef PG8_SB
#undef PG8_STAGE
#undef PG8_LDA
#undef PG8_LDB
#undef PG8_MMA
#undef PG8_WAIT_V
#undef PG8_WAIT_L
#undef PG8_BAR
#undef PG8_SCHED
}


constexpr int TS_OFF = 131072 + 1024;
template <bool GATHER> struct MoeOrder {
    const char* A; const char* Bt; const int* rowtok; int nN, nwg, nM, G, c, K; size_t strideE;
    __device__ __forceinline__ void init(const bf16_t* A_, const bf16_t* Bt_, const int* rowtok_, int N, int K_, size_t strideE_, int G_, int c_) {
        A = (const char*)A_; Bt = (const char*)Bt_; rowtok = rowtok_; nN = N / BM; K = K_; strideE = strideE_; G = G_; c = c_;
        nM = ((LAS const int*)(LDSP + TS_OFF))[32]; nwg = nM * nN; }
    __device__ __forceinline__ bool next(int i, GUnit& u) const {
        const long L = (long)i * G + c; if (L >= nwg) return false;
        int wgid = (int)L; { const int q = nwg / NXCD, r = nwg % NXCD, xcd = wgid % NXCD, off = wgid / NXCD; wgid = (xcd < r ? xcd * (q + 1) : r * (q + 1) + (xcd - r) * q) + off; }
        const int nig = WGM * nN, gid = wgid / nig, fm = gid * WGM, gsz = (nM - fm) < WGM ? (nM - fm) : WGM;
        u.pm = fm + ((wgid % nig) % gsz); u.pn = (wgid % nig) / gsz;
        LAS const int* ts = (LAS const int*)(LDSP + TS_OFF);
        int e = 0; while (e < NEXP - 1 && ts[e + 1] <= u.pm) ++e;
        u.e = e;
        u.A = GATHER ? A : A + (size_t)u.pm * BM * K * 2;
        u.B = Bt + (size_t)e * strideE + (size_t)u.pn * BM * K * 2; return true;
    }
    __device__ __forceinline__ unsigned aoff(const GUnit& u, int row) const {
        if (GATHER) return (unsigned)rowtok[u.pm * BM + row] * (unsigned)(K * 2);
        return (unsigned)(row * K * 2);
    }
};
__device__ __forceinline__ void moe_tiles(const unsigned* cnt, int tid) {
    LAS int* ts = (LAS int*)(LDSP + TS_OFF);
    if (tid == 0) { int s = 0; for (int e = 0; e < NEXP; ++e) { ts[e] = s; s += ((int)cnt[e] + BM - 1) / BM; } ts[NEXP] = s; }
    __syncthreads();
}
struct EpiMoe1 {
    static constexpr bool PERM = true;
    bf16_t* O; const float* b1;
    __device__ __forceinline__ void operator()(const f32x4 (&acc)[2][2][4][2], const GUnit& u, int wr, int wc, int fr, int fq) const {
        const int row0 = u.pm * BM + wr * 64 + fr, col0 = u.pn * 128 + wc * 32 + 8 * fq;
        const float* bg = b1 + (size_t)u.e * 2048 + col0;
        f32x4 bgv[2], blv[2];
#pragma unroll
        for (int n = 0; n < 2; ++n) { bgv[n] = *(const f32x4*)(bg + 4 * n); blv[n] = *(const f32x4*)(bg + DFF + 4 * n); }
#pragma unroll
        for (int ai = 0; ai < 2; ++ai)
#pragma unroll
            for (int m = 0; m < 4; ++m) {
                float o[8];
#pragma unroll
                for (int n = 0; n < 2; ++n)
#pragma unroll
                    for (int j = 0; j < 4; ++j) {
                        const float g = fminf(acc[ai][0][m][n][j] + bgv[n][j], 7.f);
                        const float l = fminf(fmaxf(acc[ai][1][m][n][j] + blv[n][j], -7.f), 7.f);
                        o[n * 4 + j] = g / (1.f + __expf(-1.702f * g)) * (l + 1.f);
                    }
                u32x4 w; w.x = cvt_pk_bf16(o[0], o[1]); w.y = cvt_pk_bf16(o[2], o[3]); w.z = cvt_pk_bf16(o[4], o[5]); w.w = cvt_pk_bf16(o[6], o[7]);
                *(u32x4*)(O + (size_t)(row0 + ai * HALF + m * 16) * DFF + col0) = w;
            }
    }
};
struct EpiMoe2 {
    static constexpr bool PERM = true;
    bf16_t* O; const float* b2;
    __device__ __forceinline__ void operator()(const f32x4 (&acc)[2][2][4][2], const GUnit& u, int wr, int wc, int fr, int fq) const {
        const int row0 = u.pm * BM + wr * 64 + fr, col0 = u.pn * BM + wc * 32 + 8 * fq;
        f32x4 bv[2][2];
#pragma unroll
        for (int bj = 0; bj < 2; ++bj)
#pragma unroll
            for (int n = 0; n < 2; ++n) bv[bj][n] = *(const f32x4*)(b2 + (size_t)u.e * DM + col0 + bj * HALF + 4 * n);
#pragma unroll
        for (int ai = 0; ai < 2; ++ai)
#pragma unroll
            for (int m = 0; m < 4; ++m) { bf16_t* rowp = O + (size_t)(row0 + ai * HALF + m * 16) * DM + col0;
#pragma unroll
                for (int bj = 0; bj < 2; ++bj) { const f32x4 v0 = acc[ai][bj][m][0] + bv[bj][0], v1 = acc[ai][bj][m][1] + bv[bj][1];
                    u32x4 w; w.x = cvt_pk_bf16(v0[0], v0[1]); w.y = cvt_pk_bf16(v0[2], v0[3]); w.z = cvt_pk_bf16(v1[0], v1[1]); w.w = cvt_pk_bf16(v1[2], v1[3]);
                    *(u32x4*)(rowp + bj * HALF) = w; } }
    }
};

__device__ __forceinline__ void transpose_item(const float* W, int K, int N, bf16_t* WT, const float* kgain, int mode, LAS float* scr, int item, int lane) {
    const int nblk = N / 32, kb = item / nblk, nb = item % nblk, k0 = 64 * kb, n0 = 32 * nb;
#pragma unroll 8
    for (int i = 0; i < 32; ++i) { const int kk = 2 * i + (lane >> 5); float v = W[(size_t)(k0 + kk) * N + n0 + (lane & 31)]; if (kgain) v *= kgain[k0 + kk]; scr[kk * 33 + (lane & 31)] = v; }
    asm volatile("s_waitcnt lgkmcnt(0)" ::: "memory");
    int d0 = n0;
    if (mode == 1) { const int bj = n0 >> 10, rest = n0 & 1023, pn = rest >> 7, j = rest & 127; d0 = pn * 256 + bj * 128 + j; }
    const int c = lane & 7;
#pragma unroll
    for (int j = 0; j < 4; ++j) { const int n = (lane >> 3) + 8 * j; const LAS float* sp = scr + (8 * c) * 33 + n;
        u32x4 o; o.x = pk2(sp[0 * 33], sp[1 * 33]); o.y = pk2(sp[2 * 33], sp[3 * 33]); o.z = pk2(sp[4 * 33], sp[5 * 33]); o.w = pk2(sp[6 * 33], sp[7 * 33]);
        *(u32x4*)(WT + (size_t)(d0 + n) * K + k0 + 8 * c) = o; }
    asm volatile("s_waitcnt lgkmcnt(0)" ::: "memory");
}
__device__ __forceinline__ void p_transpose(const int wv, const float* W, int K, int N, bf16_t* WT, const float* kgain, int mode, LAS unsigned char* lds) {
    LTID();
    const int wave = tidx >> 6, lane = tidx & 63;
    LAS float* scr = (LAS float*)(lds + wave * 16384);
    const int nitems = (K / 64) * (N / 32);
    for (int it = bidx * NW + wave; it < nitems; it += gridDim.x * NW) transpose_item(W, K, N, WT, kgain, mode, scr, it, lane);
}


typedef short v4i16_t __attribute__((ext_vector_type(4)));
constexpr int ATT_TAB_OFF = 131072 + 2048;
constexpr int ATT_UNITS = 3 * 8 * 128;
__device__ __forceinline__ int t5_bucket_dev(int n) {
    if (n < 16) return n;
    const float v = logf((float)n / 16.f) / 4.852030263919617f * 16.f;
    const int large = 16 + (int)v;
    return large < 31 ? large : 31;
}
__device__ __forceinline__ void p_bias_table(const int wv, const float* rel_bias, float* biasG) {
    LTID();
    for (int i = bidx * NT + tidx; i < 3 * 8 * 132; i += gridDim.x * NT) {
        const int d = i % 132, bh = i / 132, h = bh & 7, b = bh >> 3;
        biasG[i] = (d <= 128) ? rel_bias[t5_bucket_dev(d << (2 * b)) * 8 + h] : 0.f;
    }
}
__device__ __forceinline__ void p_dil_attn(const int wv, const bf16_t* proj16, const float* biasG, bf16_t* obr, float* lse, LAS unsigned char* lds) {
    LTID();
    const int lane = tidx & 63, fr = lane & 15, fq = lane >> 4, w = wv;
    const int per = (ATT_UNITS + (int)gridDim.x - 1) / (int)gridDim.x;
    const int u0 = bidx * per, u1 = (u0 + per < ATT_UNITS) ? u0 + per : ATT_UNITS;
    if (u0 >= u1) return;
    const int rowl = tidx >> 3, cs = tidx & 7;
    const unsigned cK = (unsigned)(cs ^ ((rowl >> 1) & 7)) * 16u, cV = (unsigned)(cs ^ (rowl & 7)) * 16u;
    const unsigned fK = (unsigned)((fr >> 1) & 7);
    const unsigned kro0 = (unsigned)fr * 128u + (((unsigned)fq ^ fK) * 16u), kro1 = (unsigned)fr * 128u + ((((unsigned)fq ^ fK) ^ 4u) * 16u);
    const int tq = (lane & 15) >> 2, tp = lane & 3, fv = 4 * (fq & 1) + tq;
    unsigned vro[4];
#pragma unroll
    for (int db = 0; db < 4; ++db) vro[db] = (unsigned)(4 * fq + tq) * 128u + (unsigned)(((2 * db + (tp >> 1)) ^ fv) * 16) + 8u * (unsigned)(tp & 1);
    const int ts_ = (1 + fr) & 3;
    const unsigned tab8 = (unsigned)ATT_TAB_OFF + (unsigned)ts_ * 640u + (unsigned)(((141 + fr - ts_) >> 2) - fq - 32) * 16u;
    const char* gbase = (const char*)proj16;
#define ATT_DECODE(u, b_, h_, r_, n_, dil_) const int cmb_ = (u) >> 7, b_ = cmb_ >> 3, h_ = cmb_ & 7, dil_ = 1 << (2 * b_), idx_ = (u) & 127, r_ = idx_ & (dil_ - 1), n_ = idx_ >> (2 * b_)
#define ATT_ISSUE(u, bf, q0, q1) do { ATT_DECODE(u, b__, h__, r__, n__, dil__); \
        const int nk = n__ > 0 ? n__ - 1 : 0;                                     \
        _Pragma("unroll") for (int p = 0; p < 4; ++p) { \
            int row = 64 * p + rowl; int blk = (row >> 7) ? n__ : nk; \
            const unsigned pos = (unsigned)(r__ + dil__ * (128 * blk + (row & 127))); \
            const unsigned so = pos * 4096u + (unsigned)h__ * 128u; const unsigned ld_ = (unsigned)(size_t)(lds + (bf) * 65536 + p * 8192 + w * 1024); \
            glds16s(gbase, so + 1024u + cK, ld_); glds16s(gbase, so + 2048u + cV, ld_ + 32768u); } \
        const unsigned qpos = (unsigned)(r__ + dil__ * (128 * n__ + 16 * w + fr)); \
        const char* qsrc = gbase + (size_t)qpos * 4096u + (unsigned)h__ * 128u + (unsigned)fq * 16u; \
        q0 = *(const bf16x8*)(qsrc); q1 = *(const bf16x8*)(qsrc + 64); } while (0)
    bf16x8 qf0, qf1, qn0, qn1;
    ATT_ISSUE(u0, 0, qn0, qn1);
    int prev_cmb = -1;
    for (int u = u0; u < u1; ++u) {
        const int bf = (u - u0) & 1;
        asm volatile("s_waitcnt vmcnt(0)" ::: "memory");
        __syncthreads();
        qf0 = qn0; qf1 = qn1;
        if (u + 1 < u1) ATT_ISSUE(u + 1, bf ^ 1, qn0, qn1);
        ATT_DECODE(u, b, h, r, n, dil);
        if (cmb_ != prev_cmb) {
            prev_cmb = cmb_;
            for (int e = tidx; e < 4 * 160; e += NT) { const int sft = e / 160, k = e - sft * 160, idx = k + sft, dist = idx - 16;
                const float v = (dist >= 0 && dist <= 128) ? biasG[cmb_ * 132 + dist] : -1e30f;
                ((LAS float*)(lds + ATT_TAB_OFF))[sft * 160 + k] = v; }
            __syncthreads();
        }
        const LAS unsigned char* Kb = lds + bf * 65536; const LAS unsigned char* Vb = Kb + 32768;
        const int kb0 = w;
        f32x4 sc[9];
#pragma unroll
        for (int i = 0; i < 9; ++i) {
            const unsigned ko = (unsigned)(kb0 + i) * 2048u;
            const bf16x8 k0 = *(const LAS bf16x8*)(Kb + ko + kro0), k1 = *(const LAS bf16x8*)(Kb + ko + kro1);
            f32x4 a = (f32x4){0.f, 0.f, 0.f, 0.f};
            a = __builtin_amdgcn_mfma_f32_16x16x32_bf16(k0, qf0, a, 0, 0, 0);
            a = __builtin_amdgcn_mfma_f32_16x16x32_bf16(k1, qf1, a, 0, 0, 0);
            const f32x4 t = *(const LAS f32x4*)(lds + tab8 + 64 * (8 - i));
            a = a + (f32x4){t[3], t[2], t[1], t[0]};
            if (n == 0 && kb0 + i < 8) a = (f32x4){-1e30f, -1e30f, -1e30f, -1e30f};
            sc[i] = a;
        }
        float mx = -1e30f;
#pragma unroll
        for (int i = 0; i < 9; ++i) mx = fmaxf(mx, fmaxf(fmaxf(sc[i][0], sc[i][1]), fmaxf(sc[i][2], sc[i][3])));
        mx = fmaxf(mx, shx(mx, 16, lane)); mx = fmaxf(mx, shx(mx, 32, lane));
        float sum = 0.f;
#pragma unroll
        for (int i = 0; i < 9; ++i)
#pragma unroll
            for (int j = 0; j < 4; ++j) { const float p = __expf(sc[i][j] - mx); sc[i][j] = p; sum += p; }
        sum += shx(sum, 16, lane); sum += shx(sum, 32, lane);
        f32x4 oacc[4];
#pragma unroll
        for (int db = 0; db < 4; ++db) oacc[db] = (f32x4){0.f, 0.f, 0.f, 0.f};
#pragma unroll
        for (int c = 0; c < 5; ++c) {
            const int ia = 2 * c, ib = (c < 4) ? 2 * c + 1 : 8;
            u32x4 pw; pw.x = cvt_pk_bf16(sc[ia][0], sc[ia][1]); pw.y = cvt_pk_bf16(sc[ia][2], sc[ia][3]);
            if (c < 4) { pw.z = cvt_pk_bf16(sc[ib][0], sc[ib][1]); pw.w = cvt_pk_bf16(sc[ib][2], sc[ib][3]); } else { pw.z = 0u; pw.w = 0u; }
            const bf16x8 pf = __builtin_bit_cast(bf16x8, pw);
            const unsigned va = (unsigned)(kb0 + ia) * 2048u, vb = (unsigned)(kb0 + ib) * 2048u;
#pragma unroll
            for (int db = 0; db < 4; ++db) {
                const v4i16_t x0 = __builtin_amdgcn_ds_read_tr16_b64_v4i16((LAS v4i16_t*)(Vb + va + vro[db]));
                const v4i16_t x1 = __builtin_amdgcn_ds_read_tr16_b64_v4i16((LAS v4i16_t*)(Vb + vb + vro[db]));
                const bf16x8 vf = (bf16x8){x0[0], x0[1], x0[2], x0[3], x1[0], x1[1], x1[2], x1[3]};
                oacc[db] = __builtin_amdgcn_mfma_f32_16x16x32_bf16(vf, pf, oacc[db], 0, 0, 0);
            }
        }
        const float inv = 1.f / sum;
        const unsigned qpos = (unsigned)(r + dil * (128 * n + 16 * w + fr));
        bf16_t* orow = obr + ((size_t)b * SEQ + qpos) * 512 + h * 64 + 4 * fq;
#pragma unroll
        for (int db = 0; db < 4; ++db) { u32x2 o2; o2.x = cvt_pk_bf16(oacc[db][0] * inv, oacc[db][1] * inv); o2.y = cvt_pk_bf16(oacc[db][2] * inv, oacc[db][3] * inv); *(u32x2*)(orow + 16 * db) = o2; }
        if (fq == 0) lse[((size_t)b * SEQ + qpos) * 8 + h] = mx + __logf(sum);
    }
    asm volatile("s_waitcnt vmcnt(0)" ::: "memory");
    __syncthreads();
#undef ATT_DECODE
#undef ATT_ISSUE
}
__device__ __forceinline__ void p_attn_combine(const int wv, const bf16_t* obr, const float* lse, const float* g, bf16_t* mix16) {
    LTID();
    const int lane = tidx & 63, h = lane >> 3;
    f32x4 g0 = *(const f32x4*)(g + lane * 8), g1 = *(const f32x4*)(g + lane * 8 + 4);
    for (int row = bidx * NW + wv; row < SEQ; row += gridDim.x * NW) {
        float l0 = lse[((size_t)0 * SEQ + row) * 8 + h], l1 = lse[((size_t)1 * SEQ + row) * 8 + h], l2 = lse[((size_t)2 * SEQ + row) * 8 + h];
        const float M = fmaxf(l0, fmaxf(l1, l2));
        float w0 = __expf(l0 - M), w1 = __expf(l1 - M), w2 = __expf(l2 - M);
        const float iw = 1.f / (w0 + w1 + w2); w0 *= iw; w1 *= iw; w2 *= iw;
        const u32x4 a0 = *(const u32x4*)(obr + ((size_t)0 * SEQ + row) * 512 + lane * 8);
        const u32x4 a1 = *(const u32x4*)(obr + ((size_t)1 * SEQ + row) * 512 + lane * 8);
        const u32x4 a2 = *(const u32x4*)(obr + ((size_t)2 * SEQ + row) * 512 + lane * 8);
        float y[8]; float ss = 0.f;
#pragma unroll
        for (int k = 0; k < 4; ++k) {
            const float lo = w0 * __builtin_bit_cast(float, a0[k] << 16) + w1 * __builtin_bit_cast(float, a1[k] << 16) + w2 * __builtin_bit_cast(float, a2[k] << 16);
            const float hi = w0 * __builtin_bit_cast(float, a0[k] & 0xffff0000u) + w1 * __builtin_bit_cast(float, a1[k] & 0xffff0000u) + w2 * __builtin_bit_cast(float, a2[k] & 0xffff0000u);
            y[2 * k] = lo; y[2 * k + 1] = hi; ss += lo * lo + hi * hi;
        }
#pragma unroll
        for (int o = 32; o; o >>= 1) ss += shx(ss, o, lane);
        const float sc = rsqrtf(ss * (1.f / 512.f) + 1e-5f);
        u32x4 o4; o4.x = cvt_pk_bf16(y[0] * sc * g0[0], y[1] * sc * g0[1]); o4.y = cvt_pk_bf16(y[2] * sc * g0[2], y[3] * sc * g0[3]);
        o4.z = cvt_pk_bf16(y[4] * sc * g1[0], y[5] * sc * g1[1]); o4.w = cvt_pk_bf16(y[6] * sc * g1[2], y[7] * sc * g1[3]);
        *(u32x4*)(mix16 + (size_t)row * DM + lane * 8) = o4;
    }
}
struct EpiIn {
    static constexpr bool PERM = true;
    bf16_t* O; float* Uf;
    __device__ __forceinline__ void operator()(const f32x4 (&acc)[2][2][4][2], const GUnit& u, int wr, int wc, int fr, int fq) const {
        const int row0 = u.pm * BM + wr * 64 + fr, col0 = u.pn * BM + wc * 32 + 8 * fq;
        const float sc = u.pn < 2 ? 0.125f : 1.f;
#pragma unroll
        for (int ai = 0; ai < 2; ++ai)
#pragma unroll
            for (int m = 0; m < 4; ++m) { const size_t ro = (size_t)(row0 + ai * HALF + m * 16) * DIN + col0;
#pragma unroll
                for (int bj = 0; bj < 2; ++bj) { const f32x4 v0 = acc[ai][bj][m][0] * sc, v1 = acc[ai][bj][m][1] * sc;
                    u32x4 w; w.x = cvt_pk_bf16(v0[0], v0[1]); w.y = cvt_pk_bf16(v0[2], v0[3]); w.z = cvt_pk_bf16(v1[0], v1[1]); w.w = cvt_pk_bf16(v1[2], v1[3]);
                    *(u32x4*)(O + ro + bj * HALF) = w;
                    if (u.pn >= 6) { *(f32x4*)(Uf + ro + bj * HALF) = v0; *(f32x4*)(Uf + ro + bj * HALF + 4) = v1; } } }
    }
};

__device__ __forceinline__ void p_rmsnorm(const int wv, const float* in, int in_ld, const float* g, float* out, int out_ld, int rows, int D, bf16_t* out16 = nullptr) {
    LTID();
    const int lane = tidx & 63, wave = tidx >> 6;
    for (int r = bidx * NW + wave; r < rows; r += gridDim.x * NW) {
        const float* p = in + (size_t)r * in_ld;
        float ss = 0.f;
        for (int i = lane; i < D; i += 64) { float v = p[i]; ss += v * v; }
        for (int o = 32; o; o >>= 1) ss += shx(ss, o, lane);
        const float sc = rsqrtf(ss / (float)D + 1e-5f);
        if (out16) { for (int i = lane; i < D; i += 64) out16[(size_t)r * out_ld + i] = (bf16_t)f2bf(p[i] * sc * g[i]); }
        if (out) { for (int i = lane; i < D; i += 64) out[(size_t)r * out_ld + i] = p[i] * sc * g[i]; }
    }
}
__device__ __forceinline__ void p_copy4(const int wv, const float* src, float* dst, size_t n4) {
    LTID();
    for (size_t i = (size_t)bidx * NT + tidx; i < n4; i += (size_t)gridDim.x * NT) ((float4*)dst)[i] = ((const float4*)src)[i];
}

enum { EP_STORE = 0, EP_RESID = 1, EP_GLU = 2, EP_MOE1 = 3, EP_MOE2 = 4 };
struct GArgs {
    const float* A; int lda; const float* B; int ldb; float* C; int ldc; int M, N, K;
    const float* bias; const float* aux;
    const int* rowtok; const int* offs; const unsigned* cnts;
    size_t strideB; int strideBias; int nexp;
};
template <int EP> __device__ __forceinline__ void p_gemm(const int wv, const GArgs& a, LAS unsigned char* lds) {
    LTID();
    LAS float* As = (LAS float*)lds;
    LAS float* Bs = As + 16 * 132;
    LAS float* Bs2 = Bs + 16 * 68;
    const int tid = tidx, ty = tid >> 4, tx = tid & 15;
    const int lr = tid >> 2, lk = (tid & 3) * 4;
    const int bsel = tid >> 8, bt = tid & 255, bk = bt >> 4, bn = (bt & 15) * 4;
    const int nN = a.N / 64;
    const int mt_max = (a.M + 127) / 128;
    const int per_e = mt_max * nN;
    const int total = per_e * a.nexp;
    for (int t = bidx; t < total; t += gridDim.x) {
        const int e = t / per_e, r = t - e * per_e, mt = r / nN, nt = r - mt * nN;
        int M = a.M, rowbase = 0;
        if (EP == EP_MOE1 || EP == EP_MOE2) { M = (int)a.cnts[e]; rowbase = a.offs[e]; }
        const int m0 = mt * 128, n0 = nt * 64;
        if (m0 >= M) continue;
        const float* B = a.B + (size_t)e * a.strideB;
        const float* bias = a.bias ? a.bias + (size_t)e * a.strideBias : nullptr;
        int ar = m0 + lr; if (ar >= M) ar = M - 1;
        const float* Arow;
        if (EP == EP_MOE1) Arow = a.A + (size_t)a.rowtok[rowbase + ar] * a.lda;
        else Arow = a.A + (size_t)(rowbase + ar) * a.lda;
        float acc[4][4], acc2[4][4];
#pragma unroll
        for (int i = 0; i < 4; ++i)
#pragma unroll
            for (int j = 0; j < 4; ++j) { acc[i][j] = 0.f; acc2[i][j] = 0.f; }
        for (int k0 = 0; k0 < a.K; k0 += 16) {
            const float4 av = *(const float4*)(Arow + k0 + lk);
            float4 bv = make_float4(0.f, 0.f, 0.f, 0.f);
            if (bsel == 0) bv = *(const float4*)(B + (size_t)(k0 + bk) * a.ldb + n0 + bn);
            else if (EP == EP_MOE1) bv = *(const float4*)(B + (size_t)(k0 + bk) * a.ldb + DFF + n0 + bn);
            __syncthreads();
            As[(lk + 0) * 132 + lr] = av.x; As[(lk + 1) * 132 + lr] = av.y; As[(lk + 2) * 132 + lr] = av.z; As[(lk + 3) * 132 + lr] = av.w;
            if (bsel == 0) *(LAS f32x4*)&Bs[bk * 68 + bn] = (f32x4){bv.x, bv.y, bv.z, bv.w};
            else if (EP == EP_MOE1) *(LAS f32x4*)&Bs2[bk * 68 + bn] = (f32x4){bv.x, bv.y, bv.z, bv.w};
            __syncthreads();
#pragma unroll
            for (int kk = 0; kk < 16; ++kk) {
                const f32x4 a4 = *(const LAS f32x4*)&As[kk * 132 + ty * 4];
                const f32x4 b4 = *(const LAS f32x4*)&Bs[kk * 68 + tx * 4];
                const float aa[4] = {a4.x, a4.y, a4.z, a4.w}, bb[4] = {b4.x, b4.y, b4.z, b4.w};
#pragma unroll
                for (int i = 0; i < 4; ++i)
#pragma unroll
                    for (int j = 0; j < 4; ++j) acc[i][j] += aa[i] * bb[j];
                if (EP == EP_MOE1) {
                    const f32x4 c4 = *(const LAS f32x4*)&Bs2[kk * 68 + tx * 4];
                    const float cc[4] = {c4.x, c4.y, c4.z, c4.w};
#pragma unroll
                    for (int i = 0; i < 4; ++i)
#pragma unroll
                        for (int j = 0; j < 4; ++j) acc2[i][j] += aa[i] * cc[j];
                }
            }
        }
#pragma unroll
        for (int i = 0; i < 4; ++i) {
            const int rr = m0 + ty * 4 + i;
            if (rr < M) {
                const size_t crow = (size_t)(rowbase + rr) * a.ldc;
#pragma unroll
                for (int j = 0; j < 4; ++j) {
                    const int c = n0 + tx * 4 + j;
                    float v = acc[i][j];
                    if (EP == EP_STORE) { if (bias) v += bias[c]; }
                    else if (EP == EP_RESID) v += a.aux[crow + c];
                    else if (EP == EP_GLU) { const float y = a.aux[crow + c]; v = y / (1.f + expf(-(v + bias[c]))); }
                    else if (EP == EP_MOE1) {
                        const float g = fminf(v + bias[c], 7.f);
                        const float l = fminf(fmaxf(acc2[i][j] + bias[DFF + c], -7.f), 7.f);
                        v = g / (1.f + expf(-1.702f * g)) * (l + 1.f);
                    } else if (EP == EP_MOE2) v += bias[c];
                    a.C[crow + c] = v;
                }
            }
        }
    }
    __syncthreads();
}

__device__ __forceinline__ int t5_bucket(int n) {
    if (n < 16) return n;
    const float v = logf((float)n / 16.f) / 4.852030263919617f * 16.f;
    const int large = 16 + (int)v;
    return large < 31 ? large : 31;
}
__device__ __forceinline__ void p_dilattn(const int wv, const float* proj, const float* rel_bias, float* ya, LAS unsigned char* lds) {
    LTID();
    const int w = tidx >> 6, lane = tidx & 63;
    LAS float* ps = (LAS float*)lds + w * 392;
    for (int gw = bidx * NW + w; gw < SEQ * 8; gw += gridDim.x * NW) {
        const int pos = gw >> 3, h = gw & 7;
        const float* q = proj + (size_t)pos * DIN + h * 64;
        float sc[7]; float mx = -1e30f;
#pragma unroll
        for (int it = 0; it < 7; ++it) {
            const int i = it * 64 + lane; float s = -1e30f;
            if (i < 387) {
                const int b = i / 129, d = i - b * 129, dil = 1 << (2 * b), kp = pos - d * dil;
                if (kp >= 0) {
                    const float* kr = proj + (size_t)kp * DIN + 512 + h * 64;
                    float dot = 0.f;
                    for (int e = 0; e < 64; e += 4) { const float4 qa = *(const float4*)(q + e), ka = *(const float4*)(kr + e); dot += qa.x * ka.x + qa.y * ka.y + qa.z * ka.z + qa.w * ka.w; }
                    s = dot * 0.125f + rel_bias[t5_bucket(d * dil) * 8 + h];
                }
            }
            sc[it] = s; mx = fmaxf(mx, s);
        }
        for (int o = 32; o; o >>= 1) mx = fmaxf(mx, shx(mx, o, lane));
        float den = 0.f;
#pragma unroll
        for (int it = 0; it < 7; ++it) {
            const int i = it * 64 + lane;
            const float p = (sc[it] > -1e29f) ? expf(sc[it] - mx) : 0.f;
            den += p;
            if (i < 387) ps[i] = p;
        }
        for (int o = 32; o; o >>= 1) den += shx(den, o, lane);
        __syncthreads();
        float acc = 0.f;
        for (int i = 0; i < 387; ++i) {
            const int b = i / 129, d = i - b * 129, dil = 1 << (2 * b), kp = pos - d * dil;
            if (kp >= 0) acc += ps[i] * proj[(size_t)kp * DIN + 1024 + h * 64 + lane];
        }
        ya[(size_t)pos * 512 + h * 64 + lane] = acc / den;
        __syncthreads();
    }
}

__device__ __forceinline__ void p_s5_tables(const int wv, const float* a_re, const float* a_im, const float* b_re, const float* b_im, const float* log_dt,
                                            float2* abar, float2* a128, float2* bbar) {
    LTID();
    for (int gp = bidx * NT + tidx; gp < 2048; gp += gridDim.x * NT) {
        const int g = gp >> 6;
        const float lr = a_re[gp], li = a_im[gp], dt = expf(log_dt[g]);
        const float mag = expf(lr * dt); float sn, cs; sincosf(li * dt, &sn, &cs);
        const float ar = mag * cs, ai = mag * sn;
        abar[gp] = make_float2(ar, ai);
        float pr = ar, pi = ai;
        for (int i = 0; i < 7; ++i) { const float nr = pr * pr - pi * pi, ni = 2.f * pr * pi; pr = nr; pi = ni; }
        a128[gp] = make_float2(pr, pi);
        const float nr = ar - 1.f, ni = ai, den = lr * lr + li * li;
        const float cr = (nr * lr + ni * li) / den, ci = (ni * lr - nr * li) / den;
        for (int c = 0; c < 16; ++c) {
            const float br = b_re[gp * 16 + c], bi = b_im[gp * 16 + c];
            bbar[gp * 16 + c] = make_float2(cr * br - ci * bi, cr * bi + ci * br);
        }
    }
}
template <int MODE> __device__ __forceinline__ void p_s5_local(const int wv, const float* proj, const float2* abar, const float2* bbar,
        const float* c_re, const float* c_im, const float* dskip, const float2* Sin, float2* E, float* ybuf, bf16_t* yg16) {
    LTID();
    const int w = tidx >> 6, p = tidx & 63;
    for (int item = bidx * NW + w; item < NCHUNK * 32; item += gridDim.x * NW) {
        const int chunk = item >> 5, g = item & 31, gp = g * 64 + p;
        float br[16], bi[16], cr[16], ci[16];
#pragma unroll
        for (int c = 0; c < 16; ++c) { const float2 b = bbar[gp * 16 + c]; br[c] = b.x; bi[c] = b.y; }
        if (MODE == 1) {
#pragma unroll
            for (int c = 0; c < 16; ++c) { cr[c] = c_re[(g * 16 + c) * 64 + p]; ci[c] = c_im[(g * 16 + c) * 64 + p]; }
        }
        const float2 a = abar[gp];
        float sr = 0.f, si = 0.f;
        if (MODE == 1) { const float2 s0 = Sin[chunk * 2048 + gp]; sr = s0.x; si = s0.y; }
        for (int t = 0; t < 128; ++t) {
            const int s = chunk * 128 + t;
            const float* up = proj + (size_t)s * DIN + 1536 + g * 16;
            float u[16];
#pragma unroll
            for (int c = 0; c < 16; c += 4) { const float4 v = *(const float4*)(up + c); u[c] = v.x; u[c + 1] = v.y; u[c + 2] = v.z; u[c + 3] = v.w; }
            float bur = 0.f, bui = 0.f;
#pragma unroll
            for (int c = 0; c < 16; ++c) { bur += br[c] * u[c]; bui += bi[c] * u[c]; }
            const float nr = a.x * sr - a.y * si + bur, ni = a.x * si + a.y * sr + bui;
            sr = nr; si = ni;
            if (MODE == 1) {
                float myy = 0.f;
#pragma unroll
                for (int c = 0; c < 16; ++c) {
                    float v = cr[c] * sr - ci[c] * si;
                    for (int o = 32; o; o >>= 1) v += shx(v, o, p);
                    if (p == c) myy = v + dskip[g * 16 + c] * u[c];
                }
                if (p < 16) { const float yv = 0.5f * myy * (1.f + erff(myy * 0.70710678118654752f)); ybuf[(size_t)s * 512 + g * 16 + p] = yv; yg16[(size_t)s * 512 + g * 16 + p] = (bf16_t)f2bf(yv); }
            }
        }
        if (MODE == 0) E[chunk * 2048 + gp] = make_float2(sr, si);
    }
}
__device__ __forceinline__ void p_s5_carry(const int wv, const float2* a128, const float2* E, float2* Sin) {
    LTID();
    for (int gp = bidx * NT + tidx; gp < 2048; gp += gridDim.x * NT) {
        const float2 a = a128[gp];
        float sr = 0.f, si = 0.f;
        for (int c = 0; c < NCHUNK; ++c) {
            Sin[c * 2048 + gp] = make_float2(sr, si);
            const float2 e = E[c * 2048 + gp];
            const float nr = a.x * sr - a.y * si + e.x, ni = a.x * si + a.y * sr + e.y;
            sr = nr; si = ni;
        }
    }
}
__device__ __forceinline__ void p_xattn(const int wv, const float* qx, const float* kvx, float* ox, bf16_t* ox16, LAS unsigned char* lds) {
    LTID();
    const int w = tidx >> 6, lane = tidx & 63;
    LAS float* ps = (LAS float*)lds + w * 256;
    for (int gw = bidx * NW + w; gw < SEQ * 4; gw += gridDim.x * NW) {
        const int pos = gw >> 2, h = gw & 3;
        const float* q = qx + (size_t)pos * 512 + h * 128;
        float sc[4]; float mx = -1e30f;
#pragma unroll
        for (int j = 0; j < 4; ++j) {
            const int m = j * 64 + lane;
            const float* kr = kvx + (size_t)m * 1024 + h * 128;
            float dot = 0.f;
            for (int e = 0; e < 128; e += 4) { const float4 qa = *(const float4*)(q + e), ka = *(const float4*)(kr + e); dot += qa.x * ka.x + qa.y * ka.y + qa.z * ka.z + qa.w * ka.w; }
            sc[j] = dot * 0.08838834764831845f; mx = fmaxf(mx, sc[j]);
        }
        for (int o = 32; o; o >>= 1) mx = fmaxf(mx, shx(mx, o, lane));
        float den = 0.f;
#pragma unroll
        for (int j = 0; j < 4; ++j) { const float p = expf(sc[j] - mx); den += p; ps[j * 64 + lane] = p; }
        for (int o = 32; o; o >>= 1) den += shx(den, o, lane);
        __syncthreads();
        float a0 = 0.f, a1 = 0.f;
        for (int m = 0; m < 256; ++m) {
            const float p = ps[m];
            const float* vr = kvx + (size_t)m * 1024 + 512 + h * 128;
            a0 += p * vr[lane]; a1 += p * vr[64 + lane];
        }
        ox[(size_t)pos * 512 + h * 128 + lane] = a0 / den;
        ox[(size_t)pos * 512 + h * 128 + 64 + lane] = a1 / den;
        ox16[(size_t)pos * 512 + h * 128 + lane] = (bf16_t)f2bf(a0 / den);
        ox16[(size_t)pos * 512 + h * 128 + 64 + lane] = (bf16_t)f2bf(a1 / den);
        __syncthreads();
    }
}
__device__ __forceinline__ void p_router(const int wv, const float* xn, const float* w_r, const float* b_r, int* topi, float* topg, unsigned* cnt) {
    LTID();
    const int lane = tidx & 63, e = lane & 31, w = tidx >> 6;
    for (int base = (bidx * NW + w) * 2; base < SEQ; base += gridDim.x * NW * 2) {
        const int token = base + (lane >> 5);
        const float* x = xn + (size_t)token * DM;
        float acc = 0.f;
        for (int k = 0; k < DM; ++k) acc += x[k] * w_r[k * 32 + e];
        float v = acc + b_r[e];
        float tv[4]; int ti[4];
#pragma unroll
        for (int r = 0; r < 4; ++r) {
            float bv = v; int bi = e;
#pragma unroll
            for (int o = 16; o; o >>= 1) {
                const float ov = shx(bv, o, lane); const int oi = shxi(bi, o, lane);
                if (ov > bv || (ov == bv && oi < bi)) { bv = ov; bi = oi; }
            }
            tv[r] = bv; ti[r] = bi;
            if (e == bi) v = -3.0e38f;
        }
        float ex[4], sum = 0.f;
#pragma unroll
        for (int r = 0; r < 4; ++r) { ex[r] = expf(tv[r] - tv[0]); sum += ex[r]; }
        if (e < 4) {
            const float gsel = e == 0 ? ex[0] : e == 1 ? ex[1] : e == 2 ? ex[2] : ex[3];
            const int isel = e == 0 ? ti[0] : e == 1 ? ti[1] : e == 2 ? ti[2] : ti[3];
            topi[token * 4 + e] = isel; topg[token * 4 + e] = gsel / sum;
            atomicAdd(&cnt[isel], 1u);
        }
    }
}
__device__ __forceinline__ void p_moe_place(const int wv, const int* topi, const unsigned* cnt, unsigned* cursor, int* rowtok, int* posof, LAS unsigned char* lds) {
    LTID();
    LAS int* offs = (LAS int*)lds;
    if (tidx == 0) { int s = 0; for (int e = 0; e < NEXP; ++e) { offs[e] = s; s += (((int)cnt[e] + BM - 1) / BM) * BM; } }
    __syncthreads();
    for (int i = bidx * NT + tidx; i < SEQ * TOPK; i += gridDim.x * NT) {
        const int e = topi[i];
        const int pos = offs[e] + (int)atomicAdd(&cursor[e], 1u);
        rowtok[pos] = i >> 2; posof[i] = pos;
    }
    if (bidx == 0) {
        for (int e = 0; e < NEXP; ++e) { const int c0 = (int)cnt[e], c1 = ((c0 + BM - 1) / BM) * BM; for (int r = c0 + tidx; r < c1; r += NT) rowtok[offs[e] + r] = 0; }
    }
    __syncthreads();
}
__device__ __forceinline__ void p_combine(const int wv, float* h, const bf16_t* outb, const int* posof, const float* topg) {
    LTID();
    for (int i = bidx * NT + tidx; i < SEQ * 256; i += gridDim.x * NT) {
        const int token = i >> 8, c4 = (i & 255) * 4;
        float4 acc = *(const float4*)(h + (size_t)token * DM + c4);
#pragma unroll
        for (int k = 0; k < 4; ++k) {
            const float g = topg[token * 4 + k];
            const u32x2 o = *(const u32x2*)(outb + (size_t)posof[token * 4 + k] * DM + c4);
            acc.x += g * __builtin_bit_cast(float, o.x << 16); acc.y += g * __builtin_bit_cast(float, o.x & 0xffff0000u);
            acc.z += g * __builtin_bit_cast(float, o.y << 16); acc.w += g * __builtin_bit_cast(float, o.y & 0xffff0000u);
        }
        *(float4*)(h + (size_t)token * DM + c4) = acc;
    }
}

constexpr int NPL = 18;
constexpr int NPHASES = 1 + 2 * NPL + 1;
typedef const __attribute__((address_space(4))) Args* KA;
#define PHASE __device__ __forceinline__
#define KAP() ({ KA _t = a; asm volatile("" : "+s"(_t)); _t; })
#define WSP(T, off) ((T*)(a->ws + (off)))

PHASE void ph_init(KA a, const int wv) {
    p_copy4(wv, a->in[0], WSP(float, WS_H), (size_t)SEQ * DM / 4);
    p_bias_table(wv, a->in[2], WSP(float, WS_BIASG));
    for (int l = 0; l < 2; ++l) {
        p_s5_tables(wv, a->in[5] + l * 2048, a->in[6] + l * 2048, a->in[7] + l * 32768, a->in[8] + l * 32768, a->in[11] + l * 32,
                    WSP(float2, WS_ABAR) + l * 2048, WSP(float2, WS_A128) + l * 2048, WSP(float2, WS_BBAR) + l * 32768);
        p_rmsnorm(wv, a->in[1], DM, a->in[19] + l * DM, nullptr, DM, NMEM, DM, WSP(bf16_t, WS_MEMN16) + (size_t)l * NMEM * DM);
        p_transpose(wv, a->in[4] + (size_t)l * DM * DIN, DM, DIN, WSP(bf16_t, WS_WT_IN) + (size_t)l * DIN * DM, nullptr, 0, LDSP);
        p_transpose(wv, a->in[13] + (size_t)l * 512 * 512, 512, 512, WSP(bf16_t, WS_WT_GLU) + (size_t)l * 512 * 512, nullptr, 0, LDSP);
        p_transpose(wv, a->in[17] + (size_t)l * DM * DM, DM, DM, WSP(bf16_t, WS_WT_OUT) + (size_t)l * DM * DM, nullptr, 0, LDSP);
        p_transpose(wv, a->in[20] + (size_t)l * DM * 512, DM, 512, WSP(bf16_t, WS_WT_XQ) + (size_t)l * 512 * DM, nullptr, 0, LDSP);
        p_transpose(wv, a->in[21] + (size_t)l * DM * 1024, DM, 1024, WSP(bf16_t, WS_WT_XKV) + (size_t)l * 1024 * DM, nullptr, 0, LDSP);
        p_transpose(wv, a->in[22] + (size_t)l * 512 * DM, 512, DM, WSP(bf16_t, WS_WT_XO) + (size_t)l * DM * 512, nullptr, 0, LDSP);
    }
    for (int le = 0; le < 2 * NEXP; ++le) {
        p_transpose(wv, a->in[26] + (size_t)le * DM * 2048, DM, 2048, WSP(bf16_t, WS_BT1) + (size_t)le * 2048 * DM, nullptr, 1, LDSP);
        p_transpose(wv, a->in[28] + (size_t)le * DFF * DM, DFF, DM, WSP(bf16_t, WS_BT2) + (size_t)le * DM * DFF, nullptr, 0, LDSP);
    }
    __syncthreads();
}
PHASE void ph_norm(KA a, const int wv, int which, int l) {
    const float* g = (which == 0 ? a->in[3] : which == 1 ? a->in[18] : a->in[23]) + l * DM;
    if (which == 2) p_rmsnorm(wv, WSP(float, WS_H), DM, g, WSP(float, WS_XN), DM, SEQ, DM, WSP(bf16_t, WS_XN16));
    else p_rmsnorm(wv, WSP(float, WS_H), DM, g, nullptr, DM, SEQ, DM, WSP(bf16_t, WS_XN16));
}
PHASE void ph_gemm_in(KA a, const int wv, int l) { LTID();
    DenseOrder S; S.init(WSP(bf16_t, WS_XN16), WSP(bf16_t, WS_WT_IN) + (size_t)l * DIN * DM, SEQ, DIN, DM, gridDim.x, bidx);
    EpiIn E{WSP(bf16_t, WS_PROJ16), WSP(float, WS_PROJ)};
    gemm_phase<EpiIn, DenseOrder, false, false>(LDSP, DM, S, E, tidx, wv);
}
PHASE void ph_dilattn(KA a, const int wv) { p_dil_attn(wv, WSP(bf16_t, WS_PROJ16), WSP(float, WS_BIASG), WSP(bf16_t, WS_OBR), WSP(float, WS_LSE), LDSP); }
PHASE void ph_s5_local0(KA a, const int wv, int l) {
    p_s5_local<0>(wv, WSP(float, WS_PROJ), WSP(float2, WS_ABAR) + l * 2048, WSP(float2, WS_BBAR) + l * 32768, a->in[9] + l * 32768, a->in[10] + l * 32768, a->in[12] + l * 512,
                  WSP(float2, WS_SIN), WSP(float2, WS_E), WSP(float, WS_YBUF), WSP(bf16_t, WS_YG16));
}
PHASE void ph_s5_carry(KA a, const int wv, int l) { p_s5_carry(wv, WSP(float2, WS_A128) + l * 2048, WSP(float2, WS_E), WSP(float2, WS_SIN)); }
PHASE void ph_s5_local1(KA a, const int wv, int l) {
    p_s5_local<1>(wv, WSP(float, WS_PROJ), WSP(float2, WS_ABAR) + l * 2048, WSP(float2, WS_BBAR) + l * 32768, a->in[9] + l * 32768, a->in[10] + l * 32768, a->in[12] + l * 512,
                  WSP(float2, WS_SIN), WSP(float2, WS_E), WSP(float, WS_YBUF), WSP(bf16_t, WS_YG16));
}
PHASE void ph_gemm_glu(KA a, const int wv, int l) { LTID();
    DenseOrder S; S.init(WSP(bf16_t, WS_YG16), WSP(bf16_t, WS_WT_GLU) + (size_t)l * 512 * 512, SEQ, 512, 512, gridDim.x, bidx);
    EpiGlu E{WSP(float, WS_YB), WSP(float, WS_YBUF), 512, a->in[14] + l * 512};
    gemm_phase<EpiGlu, DenseOrder, false, false>(LDSP, 512, S, E, tidx, wv);
}
PHASE void ph_norm_mixout(KA a, const int wv, int l) {
    p_attn_combine(wv, WSP(bf16_t, WS_OBR), WSP(float, WS_LSE), a->in[15] + l * 512, WSP(bf16_t, WS_MIX16));
    p_rmsnorm(wv, WSP(float, WS_YB), 512, a->in[16] + l * 512, nullptr, DM, SEQ, 512, WSP(bf16_t, WS_MIX16) + 512);
}
PHASE void ph_gemm_out(KA a, const int wv, int l) { LTID();
    DenseOrder S; S.init(WSP(bf16_t, WS_MIX16), WSP(bf16_t, WS_WT_OUT) + (size_t)l * DM * DM, SEQ, DM, DM, gridDim.x, bidx);
    EpiF32 E{WSP(float, WS_H), DM, 1};
    gemm_phase<EpiF32, DenseOrder, false, false>(LDSP, DM, S, E, tidx, wv);
}
PHASE void ph_gemm_kv(KA a, const int wv, int l) { LTID();
    DenseOrder S; S.init(WSP(bf16_t, WS_MEMN16) + (size_t)l * NMEM * DM, WSP(bf16_t, WS_WT_XKV) + (size_t)l * 1024 * DM, NMEM, 1024, DM, gridDim.x, bidx);
    EpiF32 E{WSP(float, WS_KVX), 1024, 0};
    gemm_phase<EpiF32, DenseOrder, false, false>(LDSP, DM, S, E, tidx, wv);
}
PHASE void ph_gemm_xq(KA a, const int wv, int l) { LTID();
    DenseOrder S; S.init(WSP(bf16_t, WS_XN16), WSP(bf16_t, WS_WT_XQ) + (size_t)l * 512 * DM, SEQ, 512, DM, gridDim.x, bidx);
    EpiF32 E{WSP(float, WS_QX), 512, 0};
    gemm_phase<EpiF32, DenseOrder, false, false>(LDSP, DM, S, E, tidx, wv);
}
PHASE void ph_xattn(KA a, const int wv) { p_xattn(wv, WSP(float, WS_QX), WSP(float, WS_KVX), WSP(float, WS_OX), WSP(bf16_t, WS_OX16), LDSP); }
PHASE void ph_gemm_xo(KA a, const int wv, int l) { LTID();
    DenseOrder S; S.init(WSP(bf16_t, WS_OX16), WSP(bf16_t, WS_WT_XO) + (size_t)l * DM * 512, SEQ, DM, 512, gridDim.x, bidx);
    EpiF32 E{WSP(float, WS_H), DM, 1};
    gemm_phase<EpiF32, DenseOrder, false, false>(LDSP, 512, S, E, tidx, wv);
}
PHASE void ph_router(KA a, const int wv, int l) { p_router(wv, WSP(float, WS_XN), a->in[24] + (size_t)l * DM * 32, a->in[25] + l * 32, WSP(int, WS_TOPI), WSP(float, WS_TOPG), WSP(unsigned, WS_CTL) + CW_CNT + l * 32); }
PHASE void ph_place(KA a, const int wv, int l) { p_moe_place(wv, WSP(int, WS_TOPI), WSP(unsigned, WS_CTL) + CW_CNT + l * 32, WSP(unsigned, WS_CTL) + CW_CUR + l * 32, WSP(int, WS_ROWTOK), WSP(int, WS_POSOF), LDSP); }
PHASE void ph_moe1(KA a, const int wv, int l) { LTID();
    moe_tiles(WSP(unsigned, WS_CTL) + CW_CNT + l * 32, tidx);
    MoeOrder<true> S; S.init(WSP(bf16_t, WS_XN16), WSP(bf16_t, WS_BT1) + (size_t)l * NEXP * 2048 * DM, WSP(int, WS_ROWTOK), 2048, DM, (size_t)2048 * DM * 2, gridDim.x, bidx);
    EpiMoe1 E{WSP(bf16_t, WS_ACT), a->in[27] + (size_t)l * NEXP * 2048};
    gemm_phase<EpiMoe1, MoeOrder<true>, true, false>(LDSP, DM, S, E, tidx, wv);
}
PHASE void ph_moe2(KA a, const int wv, int l) { LTID();
    moe_tiles(WSP(unsigned, WS_CTL) + CW_CNT + l * 32, tidx);
    MoeOrder<false> S; S.init(WSP(bf16_t, WS_ACT), WSP(bf16_t, WS_BT2) + (size_t)l * NEXP * DM * DFF, nullptr, DM, DFF, (size_t)DM * DFF * 2, gridDim.x, bidx);
    EpiMoe2 E{WSP(bf16_t, WS_MOUT), a->in[29] + (size_t)l * NEXP * DM};
    gemm_phase<EpiMoe2, MoeOrder<false>, false, false>(LDSP, DFF, S, E, tidx, wv);
}
PHASE void ph_combine(KA a, const int wv) { p_combine(wv, WSP(float, WS_H), WSP(bf16_t, WS_MOUT), WSP(int, WS_POSOF), WSP(float, WS_TOPG)); }
PHASE void ph_final(KA a, const int wv) { p_rmsnorm(wv, WSP(float, WS_H), DM, a->in[30], a->out, DM, SEQ, DM); }

__global__ void __launch_bounds__(NT, 2) mega(Args args) {
    KA a = (KA)__builtin_amdgcn_kernarg_segment_ptr();
    int wv = __builtin_amdgcn_readfirstlane((int)threadIdx.x >> 6); asm volatile("" : "+s"(wv));
    LAS unsigned char* lds = LDSP;
    volatile LAS unsigned* MISC = (volatile LAS unsigned*)(lds + MISC_OFF);
    unsigned* ctl = (unsigned*)(a->ws + WS_CTL);
    if (threadIdx.x < 32) MISC[threadIdx.x] = 0u;
    __syncthreads();
    XcdBarrier bar; bar.bar = ctl + CW_BAR; bar.x = 0; bar.st = nullptr;
    if (!MK_PER_PHASE) bar = xcd_barrier_post(ctl + CW_BAR, MISC + 8);
    const int lo = a->ph_lo, hi = a->ph_hi;
#define IN(k) (lo <= (k) && (k) < hi)
#define SEAM(k) do { if (IN(k) && IN((k) + 1)) { LTID(); xcd_barrier(bar.bar, bar.x, bar.st, tidx == 0); } } while (0)
    if (IN(0)) ph_init(KAP(), wv);
    SEAM(0);
#pragma unroll 1
    for (int l = 0; l < 2; ++l) {
        const int pb = 1 + l * NPL;
        if (IN(pb + 0)) ph_norm(KAP(), wv, 0, l);
        SEAM(pb + 0);
        if (IN(pb + 1)) ph_gemm_in(KAP(), wv, l);
        SEAM(pb + 1);
        if (IN(pb + 2)) { ph_dilattn(KAP(), wv); ph_s5_local0(KAP(), wv, l); }
        SEAM(pb + 2);
        if (IN(pb + 3)) ph_s5_carry(KAP(), wv, l);
        SEAM(pb + 3);
        if (IN(pb + 4)) ph_s5_local1(KAP(), wv, l);
        SEAM(pb + 4);
        if (IN(pb + 5)) ph_gemm_glu(KAP(), wv, l);
        SEAM(pb + 5);
        if (IN(pb + 6)) ph_norm_mixout(KAP(), wv, l);
        SEAM(pb + 6);
        if (IN(pb + 7)) ph_gemm_out(KAP(), wv, l);
        SEAM(pb + 7);
        if (IN(pb + 8)) { ph_norm(KAP(), wv, 1, l); ph_gemm_kv(KAP(), wv, l); }
        SEAM(pb + 8);
        if (IN(pb + 9)) ph_gemm_xq(KAP(), wv, l);
        SEAM(pb + 9);
        if (IN(pb + 10)) ph_xattn(KAP(), wv);
        SEAM(pb + 10);
        if (IN(pb + 11)) ph_gemm_xo(KAP(), wv, l);
        SEAM(pb + 11);
        if (IN(pb + 12)) ph_norm(KAP(), wv, 2, l);
        SEAM(pb + 12);
        if (IN(pb + 13)) ph_router(KAP(), wv, l);
        SEAM(pb + 13);
        if (IN(pb + 14)) ph_place(KAP(), wv, l);
        SEAM(pb + 14);
        if (IN(pb + 15)) ph_moe1(KAP(), wv, l);
        SEAM(pb + 15);
        if (IN(pb + 16)) ph_moe2(KAP(), wv, l);
        SEAM(pb + 16);
        if (IN(pb + 17)) ph_combine(KAP(), wv);
        SEAM(pb + 17);
    }
    if (IN(NPHASES - 1)) ph_final(KAP(), wv);
#undef IN
#undef SEAM
}

extern "C" void kernel_launch(void* const* d_in, const int* in_sizes, int n_in, void* d_out, int out_size, void* d_ws, size_t ws_size, hipStream_t stream) {
    static int grid = 0;
    if (grid == 0) {
        if (n_in != 31 || ws_size < WS_END) { fprintf(stderr, "kernel_launch: unexpected n_in %d or ws_size %zu (need %zu)\n", n_in, ws_size, (size_t)WS_END); grid = -1; return; }
        int dev = 0, cus = 0, per_cu = 0;
        if (hipGetDevice(&dev) != hipSuccess || hipDeviceGetAttribute(&cus, hipDeviceAttributeMultiprocessorCount, dev) != hipSuccess) { grid = -1; return; }
        if (hipFuncSetAttribute((const void*)mega, hipFuncAttributeMaxDynamicSharedMemorySize, LDS_BYTES) != hipSuccess) { fprintf(stderr, "kernel_launch: hipFuncSetAttribute failed\n"); grid = -1; return; }
        if (hipOccupancyMaxActiveBlocksPerMultiprocessor(&per_cu, (const void*)mega, NT, LDS_BYTES) != hipSuccess || per_cu < 1)
            fprintf(stderr, "kernel_launch: occupancy query reports %d workgroups per CU\n", per_cu);
        (void)hipGetLastError();
        grid = cus;
    }
    if (grid < 0) return;
    if (hipMemsetAsync((char*)d_ws + WS_CTL, 0, CTL_ZERO_BYTES, stream) != hipSuccess) return;
    Args a{};
    for (int i = 0; i < 31; ++i) a.in[i] = (const float*)d_in[i];
    a.out = (float*)d_out; a.ws = (unsigned char*)d_ws;
#if MK_PER_PHASE
    for (int p = 0; p < NPHASES; ++p) { a.ph_lo = p; a.ph_hi = p + 1; hipLaunchKernelGGL(mega, dim3(grid), dim3(NT), LDS_BYTES, stream, a); }
#else
    a.ph_lo = 0; a.ph_hi = NPHASES;
    hipLaunchKernelGGL(mega, dim3(grid), dim3(NT), LDS_BYTES, stream, a);
#endif
}
```

```cpp
#include <hip/hip_runtime.h>
#include <stdint.h>
#include <cstdio>

#ifndef MK_PER_PHASE
#define MK_PER_PHASE 0
#endif

#define SEQ 16384
#define DM 1024
#define DIN 2048
#define NMEM 256
#define NEXP 32
#define TOPK 4
#define DFF 1024
#define NCHUNK 128
#define NT 512
#define NW 8

#define LAS __attribute__((address_space(3)))
typedef float f32x4 __attribute__((ext_vector_type(4)));
extern __shared__ __attribute__((aligned(16))) unsigned char lds_raw[];
#define LDSP ((LAS unsigned char*)lds_raw)
#define LTID() int z_ = 0; asm volatile("" : "+v"(z_)); const int lane_ = (int)__builtin_amdgcn_mbcnt_hi(~0u, __builtin_amdgcn_mbcnt_lo(~0u, (unsigned)z_)); \
    const int tidx = wv * 64 + lane_; int bidx = blockIdx.x; asm volatile("" : "+s"(bidx))
__device__ __forceinline__ float shx(float v, int mask, int lane) { return __builtin_bit_cast(float, __builtin_amdgcn_ds_bpermute((lane ^ mask) << 2, __builtin_bit_cast(int, v))); }
__device__ __forceinline__ int shxi(int v, int mask, int lane) { return __builtin_amdgcn_ds_bpermute((lane ^ mask) << 2, v); }
constexpr int LDS_BYTES = 147456;
constexpr int MISC_OFF = 131072 + 320;

#define XB_TMO      128
#define XB_XCNT(j)  (256  + 64 * (j))
#define XB_XSUB(j)  (1280 + 64 * (j))
#define XB_XGEN(j)  (2304 + 64 * (j))
#define XB_TOP      3328
#define XB_TOPGEN   3392
#define XCD_BAR_WORDS 3456
#define XB_SPIN_CAP (1u << 18)

__device__ __forceinline__ unsigned xb_ld(unsigned* p)              { return __hip_atomic_load(p, __ATOMIC_RELAXED, __HIP_MEMORY_SCOPE_AGENT); }
__device__ __forceinline__ unsigned xb_add(unsigned* p, unsigned v) { return __hip_atomic_fetch_add(p, v, __ATOMIC_RELAXED, __HIP_MEMORY_SCOPE_AGENT); }
__device__ __forceinline__ unsigned xb_xcc_id() { return (unsigned)__builtin_amdgcn_s_getreg((3 << 11) | 20) & 0xFu; }
#define XB_SPIN(cond, bar) do { unsigned _sp = 0; while (cond) { __builtin_amdgcn_s_sleep(1); \
    if ((++_sp & 255u) == 0u) { if (xb_ld(&(bar)[XB_TMO])) break; if (_sp > XB_SPIN_CAP) { atomicAdd(&(bar)[XB_TMO], 1u); break; } } } } while (0)

struct XcdBarrier {
    unsigned* bar; unsigned x;
    volatile LAS unsigned* st;
};
__device__ __forceinline__ XcdBarrier xcd_barrier_post(unsigned* bar, volatile LAS unsigned* st) {
    XcdBarrier b; b.bar = bar; b.x = xb_xcc_id(); b.st = st;
    if (threadIdx.x == 0) (void)xb_add(&bar[XB_XCNT(b.x)], 1u);
    return b;
}
__device__ __forceinline__ void xcd_barrier_complete(unsigned* bar, unsigned x, unsigned& nloc, unsigned& nx) {
    const unsigned G = gridDim.x * gridDim.y * gridDim.z;
    unsigned sum, cnt, mine, sp = 0u;
    for (;;) {
        sum = 0u; cnt = 0u; mine = 0u;
#pragma unroll
        for (unsigned j = 0; j < 16; ++j) { const unsigned c = xb_ld(&bar[XB_XCNT(j)]); sum += c; cnt += (c > 0u) ? 1u : 0u; mine = (j == x) ? c : mine; }
        if (sum == G) break;
        __builtin_amdgcn_s_sleep(1);
        if ((++sp & 255u) == 0u) { if (xb_ld(&bar[XB_TMO])) break; if (sp > XB_SPIN_CAP) { atomicAdd(&bar[XB_TMO], 1u); break; } }
    }
    nloc = mine > 0u ? mine : 1u; nx = cnt > 0u ? cnt : 1u;
}
__device__ __noinline__ void xcd_barrier(unsigned* bar_, unsigned x_, volatile LAS unsigned* st_, int is_t0) {
    XcdBarrier b; b.bar = bar_; b.x = x_; b.st = st_;
    asm volatile("s_waitcnt vmcnt(0)" ::: "memory");
    __syncthreads();
    if (is_t0) {
        unsigned* bar = b.bar;
        __builtin_amdgcn_s_waitcnt(0);
        unsigned nloc = b.st[0], nx = b.st[1];
        if (nloc == 0u) { xcd_barrier_complete(bar, b.x, nloc, nx); b.st[0] = nloc; b.st[1] = nx; }
        const unsigned old = xb_add(&bar[XB_XSUB(b.x)], 1u);
        const unsigned gen = old / nloc;
        if (old + 1u == (gen + 1u) * nloc) {
            __builtin_amdgcn_fence(__ATOMIC_RELEASE, "agent");
            asm volatile("s_waitcnt vmcnt(0)" ::: "memory");
            const unsigned og = xb_add(&bar[XB_TOP], 1u);
            const unsigned tg = og / nx;
            if (og + 1u == (tg + 1u) * nx) xb_add(&bar[XB_TOPGEN], 1u);
            else XB_SPIN(xb_ld(&bar[XB_TOPGEN]) == tg, bar);
            __builtin_amdgcn_fence(__ATOMIC_ACQUIRE, "agent");
            xb_add(&bar[XB_XGEN(b.x)], 1u);
            asm volatile("s_waitcnt vmcnt(0)" ::: "memory");
        } else {
            XB_SPIN(xb_ld(&bar[XB_XGEN(b.x)]) == gen, bar);
            __builtin_amdgcn_fence(__ATOMIC_ACQUIRE, "agent");
            asm volatile("s_waitcnt vmcnt(0)" ::: "memory");
        }
    }
    __syncthreads();
}

constexpr size_t MiB = 1u << 20;
constexpr size_t WS_CTL = 0, CTL_ZERO_BYTES = 1 * MiB;
constexpr int CW_BAR = 4096;
constexpr int CW_CNT = 8192;
constexpr int CW_CUR = 8192 + 64;
constexpr size_t WS_H = 2 * MiB;
constexpr size_t WS_XN = WS_H + 64 * MiB;
constexpr size_t WS_PROJ = WS_XN + 64 * MiB;
constexpr size_t WS_YA = WS_PROJ + 128 * MiB;
constexpr size_t WS_YBUF = WS_YA + 32 * MiB;
constexpr size_t WS_YB = WS_YBUF + 32 * MiB;
constexpr size_t WS_MIX = WS_YB + 32 * MiB;
constexpr size_t WS_QX = WS_MIX + 64 * MiB;
constexpr size_t WS_OX = WS_QX + 32 * MiB;
constexpr int MOE_ROWS = SEQ * TOPK + NEXP * 256;
constexpr size_t WS_ACT = WS_OX + 32 * MiB;
constexpr size_t WS_MOUT = WS_ACT + 144 * MiB;
constexpr size_t WS_BT1 = WS_MOUT + 144 * MiB;
constexpr size_t WS_BT2 = WS_BT1 + 256 * MiB;
constexpr size_t WS_SMALL = WS_BT2 + 128 * MiB;
constexpr size_t WS_ABAR = WS_SMALL;
constexpr size_t WS_A128 = WS_ABAR + 2 * 2048 * 8;
constexpr size_t WS_BBAR = WS_A128 + 2 * 2048 * 8;
constexpr size_t WS_E = WS_BBAR + 2 * 2048 * 16 * 8;
constexpr size_t WS_SIN = WS_E + (size_t)NCHUNK * 2048 * 8;
constexpr size_t WS_MEMN = WS_SIN + (size_t)NCHUNK * 2048 * 8;
constexpr size_t WS_KVX = WS_MEMN + 2 * (size_t)NMEM * DM * 4;
constexpr size_t WS_TOPI = WS_KVX + (size_t)NMEM * 1024 * 4;
constexpr size_t WS_TOPG = WS_TOPI + (size_t)SEQ * 4 * 4;
constexpr size_t WS_ROWTOK = WS_TOPG + (size_t)SEQ * 4 * 4;
constexpr size_t WS_POSOF = WS_ROWTOK + (size_t)MOE_ROWS * 4;
constexpr size_t WS_WT_IN = (WS_POSOF + (size_t)SEQ * 4 * 4 + 255) & ~(size_t)255;
constexpr size_t WS_WT_GLU = WS_WT_IN + 2 * (size_t)2048 * 1024 * 2;
constexpr size_t WS_WT_OUT = WS_WT_GLU + 2 * (size_t)512 * 512 * 2;
constexpr size_t WS_WT_XQ = WS_WT_OUT + 2 * (size_t)1024 * 1024 * 2;
constexpr size_t WS_WT_XKV = WS_WT_XQ + 2 * (size_t)512 * 1024 * 2;
constexpr size_t WS_WT_XO = WS_WT_XKV + 2 * (size_t)1024 * 1024 * 2;
constexpr size_t WS_XN16 = WS_WT_XO + 2 * (size_t)1024 * 512 * 2;
constexpr size_t WS_MIX16 = WS_XN16 + (size_t)SEQ * 1024 * 2;
constexpr size_t WS_YG16 = WS_MIX16 + (size_t)SEQ * 1024 * 2;
constexpr size_t WS_OX16 = WS_YG16 + (size_t)SEQ * 512 * 2;
constexpr size_t WS_MEMN16 = WS_OX16 + (size_t)SEQ * 512 * 2;
constexpr size_t WS_PROJ16 = WS_MEMN16 + 2 * (size_t)NMEM * 1024 * 2;
constexpr size_t WS_OBR = WS_PROJ16 + (size_t)SEQ * 2048 * 2;
constexpr size_t WS_LSE = WS_OBR + 3 * (size_t)SEQ * 512 * 2;
constexpr size_t WS_BIASG = WS_LSE + 3 * (size_t)SEQ * 8 * 4;
constexpr size_t WS_QX16 = WS_BIASG + 24 * 132 * 4 + 256;
constexpr size_t WS_KV16 = WS_QX16 + (size_t)SEQ * 512 * 2;
constexpr size_t WS_END = WS_KV16 + (size_t)NMEM * 1024 * 2;

struct Args { const float* in[31]; float* out; unsigned char* ws; int ph_lo, ph_hi; };


typedef unsigned short bf16_t;
typedef short bf16x8 __attribute__((ext_vector_type(8)));
typedef unsigned u32x4 __attribute__((ext_vector_type(4)));
typedef unsigned u32x2 __attribute__((ext_vector_type(2)));
constexpr int BM = 256, BK = 64, HALF = 128, HTB = HALF * BK * 2, STAGE_BYTES = 8 * HTB, NXCD = 8, WGM = 8;
__host__ __device__ __forceinline__ int lds_byte(int r, int c) { const int st = (r >> 4) * 2 + (c >> 5), rr = r & 15, cc = c & 31, ob = rr * 64 + cc * 2; return st * 1024 + (ob ^ (((ob >> 9) & 1) << 5)); }
__host__ __device__ __forceinline__ void stage_rc(int b, int& R, int& C) { const int st = b / 1024, sb = b % 1024, swz = sb ^ (((sb >> 9) & 1) << 5); R = (st >> 1) * 16 + swz / 64; C = (st & 1) * 32 + (swz % 64) / 2; }
__host__ __device__ __forceinline__ int perm32(int rho) { const int n = rho >> 4, i = rho & 15; return 8 * (i >> 2) + 4 * n + (i & 3); }
__device__ __forceinline__ unsigned cvt_pk_bf16(float lo, float hi) { unsigned r; asm volatile("v_cvt_pk_bf16_f32 %0, %1, %2" : "=v"(r) : "v"(lo), "v"(hi)); return r; }
__device__ __forceinline__ unsigned f2bf(float f) { unsigned u = __builtin_bit_cast(unsigned, f); return (u + 0x7fffu + ((u >> 16) & 1u)) >> 16; }
__device__ __forceinline__ unsigned pk2(float lo, float hi) { return f2bf(lo) | (f2bf(hi) << 16); }
__device__ __forceinline__ float bf2f(unsigned short b) { return __builtin_bit_cast(float, ((unsigned)b) << 16); }

__device__ __forceinline__ void glds16s(const void* sbase, unsigned voff, unsigned lds_dst) {
    unsigned keep;
    asm volatile("s_mov_b32 %0, m0\n\ts_mov_b32 m0, %3\n\ts_nop 0\n\tglobal_load_lds_dwordx4 %1, %2\n\ts_mov_b32 m0, %0" : "=&s"(keep) : "v"(voff), "s"(sbase), "s"(lds_dst) : "memory");
}
struct GUnit { const char* A; const char* B; int pm, pn, e; };

struct DenseOrder {
    const char* A; const char* Bt; int nM, nN, nwg, G, c, K;
    __device__ __forceinline__ void init(const bf16_t* A_, const bf16_t* Bt_, int M, int N, int K_, int G_, int c_) { A = (const char*)A_; Bt = (const char*)Bt_; nM = M / BM; nN = N / BM; nwg = nM * nN; G = G_; c = c_; K = K_; }
    __device__ __forceinline__ bool next(int i, GUnit& u) const {
        const long L = (long)i * G + c; if (L >= nwg) return false;
        int wgid = (int)L; { const int q = nwg / NXCD, r = nwg % NXCD, xcd = wgid % NXCD, off = wgid / NXCD; wgid = (xcd < r ? xcd * (q + 1) : r * (q + 1) + (xcd - r) * q) + off; }
        const int nig = WGM * nN, gid = wgid / nig, fm = gid * WGM, gsz = (nM - fm) < WGM ? (nM - fm) : WGM;
        u.pm = fm + ((wgid % nig) % gsz); u.pn = (wgid % nig) / gsz; u.e = 0;
        u.A = A + (size_t)u.pm * BM * K * 2; u.B = Bt + (size_t)u.pn * BM * K * 2; return true;
    }
    __device__ __forceinline__ unsigned aoff(const GUnit&, int row) const { return (unsigned)(row * K * 2); }
};

struct EpiF32 {
    static constexpr bool PERM = false;
    float* C; int ldc; int resid;
    __device__ __forceinline__ void operator()(const f32x4 (&acc)[2][2][4][2], const GUnit& u, int wr, int wc, int fr, int fq) const {
        const int row0 = u.pm * BM + wr * 64 + fr, col0 = u.pn * BM + wc * 32 + 4 * fq;
#pragma unroll
        for (int ai = 0; ai < 2; ++ai)
#pragma unroll
            for (int m = 0; m < 4; ++m) { float* rowp = C + (size_t)(row0 + ai * HALF + m * 16) * ldc + col0;
#pragma unroll
                for (int bj = 0; bj < 2; ++bj)
#pragma unroll
                    for (int n = 0; n < 2; ++n) { f32x4 v = acc[ai][bj][m][n]; if (resid) v += *(const f32x4*)(rowp + bj * HALF + n * 16); *(f32x4*)(rowp + bj * HALF + n * 16) = v; } }
    }
};
struct EpiGlu {
    static constexpr bool PERM = false;
    float* C; const float* Y; int ldc; const float* bias;
    __device__ __forceinline__ void operator()(const f32x4 (&acc)[2][2][4][2], const GUnit& u, int wr, int wc, int fr, int fq) const {
        const int row0 = u.pm * BM + wr * 64 + fr, col0 = u.pn * BM + wc * 32 + 4 * fq;
#pragma unroll
        for (int ai = 0; ai < 2; ++ai)
#pragma unroll
            for (int m = 0; m < 4; ++m) { const size_t ro = (size_t)(row0 + ai * HALF + m * 16) * ldc + col0;
#pragma unroll
                for (int bj = 0; bj < 2; ++bj)
#pragma unroll
                    for (int n = 0; n < 2; ++n) { const f32x4 b = *(const f32x4*)(bias + col0 + bj * HALF + n * 16); const f32x4 y = *(const f32x4*)(Y + ro + bj * HALF + n * 16);
                        f32x4 v = acc[ai][bj][m][n] + b; f32x4 o;
#pragma unroll
                        for (int j = 0; j < 4; ++j) o[j] = y[j] / (1.f + __expf(-v[j]));
                        *(f32x4*)(C + ro + bj * HALF + n * 16) = o; } }
    }
};

template <class Epi, class Sched, bool GATHER, bool ALIGN_EPI>
__device__ __forceinline__ void gemm_phase(LAS unsigned char* lds, const int K, const Sched& S, const Epi& E, const int tid, const int wv) {
    const int wid = wv, lane = tid & 63, wr = wid >> 2, wc = wid & 3, fr = lane & 15, fq = lane >> 4;
    const int nt = K / BK;
    unsigned voffB[2];
#pragma unroll
    for (int i = 0; i < 2; ++i) { int R, C; stage_rc(tid * 16 + i * 8192, R, C); const int Rb = Epi::PERM ? ((R & ~31) + perm32(R & 31)) : R; voffB[i] = (unsigned)(Rb * K + C) * 2u; }
#define PG8_AOFFS(dst, u) do { int t2_ = tid; asm volatile("" : "+v"(t2_)); _Pragma("unroll") for (int i = 0; i < 2; ++i) { int R, C; stage_rc(t2_ * 16 + i * 8192, R, C); \
        _Pragma("unroll") for (int h = 0; h < 2; ++h) dst[h][i] = S.aoff(u, h * HALF + R) + (unsigned)C * 2u; } } while (0)
    const size_t kstep = (size_t)(BK * 2);
    const size_t hstep = (size_t)HALF * K * 2;
    const unsigned ldsw = (unsigned)wid * 1024u;
    const int aoff = lds_byte(wr * 64 + fr, fq * 8), boff = lds_byte(wc * 32 + fr, fq * 8);
#define PG8_SA(b, h) (((b) * 2 + (h)) * HTB)
#define PG8_SB(b, h) ((4 + (b) * 2 + (h)) * HTB)
#define PG8_STAGE(bufoff, gbase, v0, v1) do { const unsigned ld_ = (unsigned)(size_t)(lds + (bufoff) + ldsw); glds16s((gbase), (v0), ld_); glds16s((gbase), (v1), ld_ + 8192u); } while (0)
#define PG8_LDA(dst, b, h) do { _Pragma("unroll") for (int m = 0; m < 4; ++m) _Pragma("unroll") for (int k = 0; k < 2; ++k) dst[m][k] = *(const LAS bf16x8*)(lds + PG8_SA(b, h) + aoff + m * 2048 + k * 1024); } while (0)
#define PG8_LDB(dst, b, h) do { _Pragma("unroll") for (int n = 0; n < 2; ++n) _Pragma("unroll") for (int k = 0; k < 2; ++k) dst[n][k] = *(const LAS bf16x8*)(lds + PG8_SB(b, h) + boff + n * 2048 + k * 1024); } while (0)
#define PG8_MMA(ai, bj, At, Bt) do { __builtin_amdgcn_s_setprio(1); _Pragma("unroll") for (int m = 0; m < 4; ++m) _Pragma("unroll") for (int n = 0; n < 2; ++n) _Pragma("unroll") for (int k = 0; k < 2; ++k) \
        acc[ai][bj][m][n] = __builtin_amdgcn_mfma_f32_16x16x32_bf16(Bt[n][k], At[m][k], acc[ai][bj][m][n], 0, 0, 0); __builtin_amdgcn_s_setprio(0); } while (0)
#define PG8_WAIT_V(n) asm volatile("s_waitcnt vmcnt(" #n ")" ::: "memory")
#define PG8_WAIT_L(n) asm volatile("s_waitcnt lgkmcnt(" #n ")" ::: "memory")
#define PG8_BAR __builtin_amdgcn_s_barrier()
#define PG8_SCHED __builtin_amdgcn_sched_barrier(0)
    GUnit cur, nxt; int ui = 0;
    if (!S.next(0, cur)) return;
    f32x4 acc[2][2][4][2];
#pragma unroll
    for (int a = 0; a < 2; ++a)
#pragma unroll
        for (int b = 0; b < 2; ++b)
#pragma unroll
            for (int m = 0; m < 4; ++m)
#pragma unroll
                for (int n = 0; n < 2; ++n) acc[a][b][m][n] = (f32x4){0.f, 0.f, 0.f, 0.f};
    bf16x8 At[4][2], B0[2][2], B1[2][2];
    unsigned vA[2][2], vN[2][2];
    PG8_AOFFS(vA, cur);
#pragma unroll
    for (int h = 0; h < 2; ++h)
#pragma unroll
        for (int i = 0; i < 2; ++i) vN[h][i] = vA[h][i];
    const char* cA = cur.A; const char* cB = cur.B;
    PG8_STAGE(PG8_SB(0, 0), cB, voffB[0], voffB[1]); PG8_STAGE(PG8_SB(0, 1), cB + hstep, voffB[0], voffB[1]); PG8_STAGE(PG8_SA(0, 0), cA, vA[0][0], vA[0][1]); PG8_STAGE(PG8_SA(0, 1), cA, vA[1][0], vA[1][1]);
    if (wr == 1) PG8_BAR;
    PG8_WAIT_V(2); PG8_BAR;
    PG8_STAGE(PG8_SB(1, 0), cB + kstep, voffB[0], voffB[1]); PG8_STAGE(PG8_SA(1, 0), cA + kstep, vA[0][0], vA[0][1]); PG8_STAGE(PG8_SB(1, 1), cB + hstep + kstep, voffB[0], voffB[1]);
    PG8_WAIT_V(6); PG8_BAR;
    for (;;) {
        const bool has_next = S.next(ui + 1, nxt);
        const char* nA = GATHER ? cA : (has_next ? nxt.A : cA); const char* nB = has_next ? nxt.B : cB;
        if (GATHER) {
            if (has_next) { PG8_AOFFS(vN, nxt); }
            else {
#pragma unroll
                for (int h = 0; h < 2; ++h)
#pragma unroll
                    for (int i = 0; i < 2; ++i) vN[h][i] = vA[h][i];
            }
        }
#define PG8_KBODY(a1, a2, b2, a3, b3, W00, W01, W10, W11) do { \
              \
            PG8_LDB(B0, 0, 0); PG8_LDB(B1, 0, 1); PG8_SCHED; PG8_LDA(At, 0, 0); PG8_STAGE(PG8_SA(1, 1), a1, vA[1][0], vA[1][1]); \
            PG8_WAIT_V(8); PG8_WAIT_L(0); PG8_BAR; PG8_MMA(0, 0, At, B0); PG8_MMA(0, 1, At, B1); PG8_BAR; PG8_SCHED; \
              \
            PG8_LDA(At, 0, 1); PG8_STAGE(PG8_SB(0, 0), b2, voffB[0], voffB[1]); PG8_STAGE(PG8_SB(0, 1), (b2) + hstep, voffB[0], voffB[1]); PG8_STAGE(PG8_SA(0, 0), a2, W00, W01); \
            PG8_WAIT_V(8); PG8_WAIT_L(0); PG8_BAR; PG8_MMA(1, 0, At, B0); PG8_MMA(1, 1, At, B1); PG8_BAR; PG8_SCHED; \
              \
            PG8_LDB(B0, 1, 0); PG8_LDB(B1, 1, 1); PG8_SCHED; PG8_LDA(At, 1, 0); PG8_STAGE(PG8_SA(0, 1), a2, W10, W11); \
            PG8_WAIT_V(8); PG8_WAIT_L(0); PG8_BAR; PG8_MMA(0, 0, At, B0); PG8_MMA(0, 1, At, B1); PG8_BAR; PG8_SCHED; \
              \
            PG8_LDA(At, 1, 1); PG8_STAGE(PG8_SB(1, 0), b3, voffB[0], voffB[1]); PG8_STAGE(PG8_SB(1, 1), (b3) + hstep, voffB[0], voffB[1]); PG8_STAGE(PG8_SA(1, 0), a3, W00, W01); \
            PG8_WAIT_V(8); PG8_WAIT_L(0); PG8_BAR; PG8_MMA(1, 0, At, B0); PG8_MMA(1, 1, At, B1); PG8_BAR; PG8_SCHED; } while (0)
        for (int t = 0; t < nt - 2; t += 2) {
            const char* a1 = cA + (size_t)(t + 1) * kstep;
            const char* a2 = cA + (size_t)(t + 2) * kstep; const char* b2 = cB + (size_t)(t + 2) * kstep;
            const char* a3 = a2 + kstep; const char* b3 = b2 + kstep;
            PG8_KBODY(a1, a2, b2, a3, b3, vA[0][0], vA[0][1], vA[1][0], vA[1][1]);
        }
        {
            const char* a1 = cA + (size_t)(nt - 1) * kstep;
            const char* a3 = nA + kstep; const char* b3 = nB + kstep;
            PG8_KBODY(a1, nA, nB, a3, b3, vN[0][0], vN[0][1], vN[1][0], vN[1][1]);
        }
#undef PG8_KBODY
        if constexpr (ALIGN_EPI) { if (wr == 0) PG8_BAR; }
        { int t3_ = tid; asm volatile("" : "+v"(t3_)); const int l3_ = t3_ & 63; E(acc, cur, wr, wc, l3_ & 15, l3_ >> 4); }
        if (!has_next) break;
#pragma unroll
        for (int a = 0; a < 2; ++a)
#pragma unroll
            for (int b = 0; b < 2; ++b)
#pragma unroll
                for (int m = 0; m < 4; ++m)
#pragma unroll
                    for (int n = 0; n < 2; ++n) acc[a][b][m][n] = (f32x4){0.f, 0.f, 0.f, 0.f};
        cur = nxt; cA = nA; cB = nB; ++ui;
        if (GATHER) {
#pragma unroll
            for (int h = 0; h < 2; ++h)
#pragma unroll
                for (int i = 0; i < 2; ++i) vA[h][i] = vN[h][i];
        }
        if constexpr (ALIGN_EPI) { if (wr == 1) PG8_BAR; }
    }
    PG8_WAIT_V(0);
    if constexpr (!ALIGN_EPI) { if (wr == 0) PG8_BAR; }
    PG8_BAR;
#undef PG8_AOFFS
#undef PG8_SA
#undef PG8_SB
#undef PG8_STAGE
#undef PG8_LDA
#undef PG8_LDB
#undef PG8_MMA
#undef PG8_WAIT_V
#undef PG8_WAIT_L
#undef PG8_BAR
#undef PG8_SCHED
}


constexpr int TS_OFF = 131072 + 1024;
template <bool GATHER> struct MoeOrder {
    const char* A; const char* Bt; const int* rowtok; int nN, nwg, nM, G, c, K; size_t strideE;
    __device__ __forceinline__ void init(const bf16_t* A_, const bf16_t* Bt_, const int* rowtok_, int N, int K_, size_t strideE_, int G_, int c_) {
        A = (const char*)A_; Bt = (const char*)Bt_; rowtok = rowtok_; nN = N / BM; K = K_; strideE = strideE_; G = G_; c = c_;
        nM = ((LAS const int*)(LDSP + TS_OFF))[32]; nwg = nM * nN; }
    __device__ __forceinline__ bool next(int i, GUnit& u) const {
        const long L = (long)i * G + c; if (L >= nwg) return false;
        int wgid = (int)L; { const int q = nwg / NXCD, r = nwg % NXCD, xcd = wgid % NXCD, off = wgid / NXCD; wgid = (xcd < r ? xcd * (q + 1) : r * (q + 1) + (xcd - r) * q) + off; }
        const int nig = WGM * nN, gid = wgid / nig, fm = gid * WGM, gsz = (nM - fm) < WGM ? (nM - fm) : WGM;
        u.pm = fm + ((wgid % nig) % gsz); u.pn = (wgid % nig) / gsz;
        LAS const int* ts = (LAS const int*)(LDSP + TS_OFF);
        int e = 0; while (e < NEXP - 1 && ts[e + 1] <= u.pm) ++e;
        u.e = e;
        u.A = GATHER ? A : A + (size_t)u.pm * BM * K * 2;
        u.B = Bt + (size_t)e * strideE + (size_t)u.pn * BM * K * 2; return true;
    }
    __device__ __forceinline__ unsigned aoff(const GUnit& u, int row) const {
        if (GATHER) return (unsigned)rowtok[u.pm * BM + row] * (unsigned)(K * 2);
        return (unsigned)(row * K * 2);
    }
};
__device__ __forceinline__ void moe_tiles(const unsigned* cnt, int tid) {
    LAS int* ts = (LAS int*)(LDSP + TS_OFF);
    if (tid == 0) { int s = 0; for (int e = 0; e < NEXP; ++e) { ts[e] = s; s += ((int)cnt[e] + BM - 1) / BM; } ts[NEXP] = s; }
    __syncthreads();
}
struct EpiMoe1 {
    static constexpr bool PERM = true;
    bf16_t* O; const float* b1;
    __device__ __forceinline__ void operator()(const f32x4 (&acc)[2][2][4][2], const GUnit& u, int wr, int wc, int fr, int fq) const {
        const int row0 = u.pm * BM + wr * 64 + fr, col0 = u.pn * 128 + wc * 32 + 8 * fq;
        const float* bg = b1 + (size_t)u.e * 2048 + col0;
        f32x4 bgv[2], blv[2];
#pragma unroll
        for (int n = 0; n < 2; ++n) { bgv[n] = *(const f32x4*)(bg + 4 * n); blv[n] = *(const f32x4*)(bg + DFF + 4 * n); }
#pragma unroll
        for (int ai = 0; ai < 2; ++ai)
#pragma unroll
            for (int m = 0; m < 4; ++m) {
                float o[8];
#pragma unroll
                for (int n = 0; n < 2; ++n)
#pragma unroll
                    for (int j = 0; j < 4; ++j) {
                        const float g = fminf(acc[ai][0][m][n][j] + bgv[n][j], 7.f);
                        const float l = fminf(fmaxf(acc[ai][1][m][n][j] + blv[n][j], -7.f), 7.f);
                        o[n * 4 + j] = g / (1.f + __expf(-1.702f * g)) * (l + 1.f);
                    }
                u32x4 w; w.x = cvt_pk_bf16(o[0], o[1]); w.y = cvt_pk_bf16(o[2], o[3]); w.z = cvt_pk_bf16(o[4], o[5]); w.w = cvt_pk_bf16(o[6], o[7]);
                *(u32x4*)(O + (size_t)(row0 + ai * HALF + m * 16) * DFF + col0) = w;
            }
    }
};
struct EpiMoe2 {
    static constexpr bool PERM = true;
    bf16_t* O; const float* b2;
    __device__ __forceinline__ void operator()(const f32x4 (&acc)[2][2][4][2], const GUnit& u, int wr, int wc, int fr, int fq) const {
        const int row0 = u.pm * BM + wr * 64 + fr, col0 = u.pn * BM + wc * 32 + 8 * fq;
        f32x4 bv[2][2];
#pragma unroll
        for (int bj = 0; bj < 2; ++bj)
#pragma unroll
            for (int n = 0; n < 2; ++n) bv[bj][n] = *(const f32x4*)(b2 + (size_t)u.e * DM + col0 + bj * HALF + 4 * n);
#pragma unroll
        for (int ai = 0; ai < 2; ++ai)
#pragma unroll
            for (int m = 0; m < 4; ++m) { bf16_t* rowp = O + (size_t)(row0 + ai * HALF + m * 16) * DM + col0;
#pragma unroll
                for (int bj = 0; bj < 2; ++bj) { const f32x4 v0 = acc[ai][bj][m][0] + bv[bj][0], v1 = acc[ai][bj][m][1] + bv[bj][1];
                    u32x4 w; w.x = cvt_pk_bf16(v0[0], v0[1]); w.y = cvt_pk_bf16(v0[2], v0[3]); w.z = cvt_pk_bf16(v1[0], v1[1]); w.w = cvt_pk_bf16(v1[2], v1[3]);
                    *(u32x4*)(rowp + bj * HALF) = w; } }
    }
};

__device__ __forceinline__ void transpose_item(const float* W, int K, int N, bf16_t* WT, const float* kgain, int mode, LAS float* scr, int item, int lane) {
    const int nblk = N / 32, kb = item / nblk, nb = item % nblk, k0 = 64 * kb, n0 = 32 * nb;
#pragma unroll 8
    for (int i = 0; i < 32; ++i) { const int kk = 2 * i + (lane >> 5); float v = W[(size_t)(k0 + kk) * N + n0 + (lane & 31)]; if (kgain) v *= kgain[k0 + kk]; scr[kk * 33 + (lane & 31)] = v; }
    asm volatile("s_waitcnt lgkmcnt(0)" ::: "memory");
    int d0 = n0;
    if (mode == 1) { const int bj = n0 >> 10, rest = n0 & 1023, pn = rest >> 7, j = rest & 127; d0 = pn * 256 + bj * 128 + j; }
    const int c = lane & 7;
#pragma unroll
    for (int j = 0; j < 4; ++j) { const int n = (lane >> 3) + 8 * j; const LAS float* sp = scr + (8 * c) * 33 + n;
        u32x4 o; o.x = pk2(sp[0 * 33], sp[1 * 33]); o.y = pk2(sp[2 * 33], sp[3 * 33]); o.z = pk2(sp[4 * 33], sp[5 * 33]); o.w = pk2(sp[6 * 33], sp[7 * 33]);
        *(u32x4*)(WT + (size_t)(d0 + n) * K + k0 + 8 * c) = o; }
    asm volatile("s_waitcnt lgkmcnt(0)" ::: "memory");
}
__device__ __forceinline__ void p_transpose(const int wv, const float* W, int K, int N, bf16_t* WT, const float* kgain, int mode, LAS unsigned char* lds) {
    LTID();
    const int wave = tidx >> 6, lane = tidx & 63;
    LAS float* scr = (LAS float*)(lds + wave * 16384);
    const int nitems = (K / 64) * (N / 32);
    for (int it = bidx * NW + wave; it < nitems; it += gridDim.x * NW) transpose_item(W, K, N, WT, kgain, mode, scr, it, lane);
}


typedef short v4i16_t __attribute__((ext_vector_type(4)));
constexpr int ATT_TAB_OFF = 131072 + 2048;
constexpr int ATT_UNITS = 3 * 8 * 128;
__device__ __forceinline__ int t5_bucket_dev(int n) {
    if (n < 16) return n;
    const float v = logf((float)n / 16.f) / 4.852030263919617f * 16.f;
    const int large = 16 + (int)v;
    return large < 31 ? large : 31;
}
__device__ __forceinline__ void p_bias_table(const int wv, const float* rel_bias, float* biasG) {
    LTID();
    for (int i = bidx * NT + tidx; i < 3 * 8 * 132; i += gridDim.x * NT) {
        const int d = i % 132, bh = i / 132, h = bh & 7, b = bh >> 3;
        biasG[i] = (d <= 128) ? rel_bias[t5_bucket_dev(d << (2 * b)) * 8 + h] : 0.f;
    }
}
__device__ __forceinline__ void p_dil_attn(const int wv, const bf16_t* proj16, const float* biasG, bf16_t* obr, float* lse, LAS unsigned char* lds) {
    LTID();
    const int lane = tidx & 63, fr = lane & 15, fq = lane >> 4, w = wv;
    const int per = (ATT_UNITS + (int)gridDim.x - 1) / (int)gridDim.x;
    const int u0 = bidx * per, u1 = (u0 + per < ATT_UNITS) ? u0 + per : ATT_UNITS;
    if (u0 >= u1) return;
    const int rowl = tidx >> 3, cs = tidx & 7;
    const unsigned cK = (unsigned)(cs ^ ((rowl >> 1) & 7)) * 16u, cV = (unsigned)(cs ^ (rowl & 7)) * 16u;
    const unsigned fK = (unsigned)((fr >> 1) & 7);
    const unsigned kro0 = (unsigned)fr * 128u + (((unsigned)fq ^ fK) * 16u), kro1 = (unsigned)fr * 128u + ((((unsigned)fq ^ fK) ^ 4u) * 16u);
    const int tq = (lane & 15) >> 2, tp = lane & 3, fv = 4 * (fq & 1) + tq;
    unsigned vro[4];
#pragma unroll
    for (int db = 0; db < 4; ++db) vro[db] = (unsigned)(4 * fq + tq) * 128u + (unsigned)(((2 * db + (tp >> 1)) ^ fv) * 16) + 8u * (unsigned)(tp & 1);
    const int ts_ = (1 + fr) & 3;
    const unsigned tab8 = (unsigned)ATT_TAB_OFF + (unsigned)ts_ * 640u + (unsigned)(((141 + fr - ts_) >> 2) - fq - 32) * 16u;
    const char* gbase = (const char*)proj16;
#define ATT_DECODE(u, b_, h_, r_, n_, dil_) const int cmb_ = (u) >> 7, b_ = cmb_ >> 3, h_ = cmb_ & 7, dil_ = 1 << (2 * b_), idx_ = (u) & 127, r_ = idx_ & (dil_ - 1), n_ = idx_ >> (2 * b_)
#define ATT_ISSUE(u, bf, q0, q1) do { ATT_DECODE(u, b__, h__, r__, n__, dil__); \
        const int nk = n__ > 0 ? n__ - 1 : 0;                                     \
        _Pragma("unroll") for (int p = 0; p < 4; ++p) { \
            int row = 64 * p + rowl; int blk = (row >> 7) ? n__ : nk; \
            const unsigned pos = (unsigned)(r__ + dil__ * (128 * blk + (row & 127))); \
            const unsigned so = pos * 4096u + (unsigned)h__ * 128u; const unsigned ld_ = (unsigned)(size_t)(lds + (bf) * 65536 + p * 8192 + w * 1024); \
            glds16s(gbase, so + 1024u + cK, ld_); glds16s(gbase, so + 2048u + cV, ld_ + 32768u); } \
        const unsigned qpos = (unsigned)(r__ + dil__ * (128 * n__ + 16 * w + fr)); \
        const char* qsrc = gbase + (size_t)qpos * 4096u + (unsigned)h__ * 128u + (unsigned)fq * 16u; \
        q0 = *(const bf16x8*)(qsrc); q1 = *(const bf16x8*)(qsrc + 64); } while (0)
    bf16x8 qf0, qf1, qn0, qn1;
    ATT_ISSUE(u0, 0, qn0, qn1);
    int prev_cmb = -1;
    for (int u = u0; u < u1; ++u) {
        const int bf = (u - u0) & 1;
        asm volatile("s_waitcnt vmcnt(0)" ::: "memory");
        __syncthreads();
        qf0 = qn0; qf1 = qn1;
        if (u + 1 < u1) ATT_ISSUE(u + 1, bf ^ 1, qn0, qn1);
        ATT_DECODE(u, b, h, r, n, dil);
        if (cmb_ != prev_cmb) {
            prev_cmb = cmb_;
            for (int e = tidx; e < 4 * 160; e += NT) { const int sft = e / 160, k = e - sft * 160, idx = k + sft, dist = idx - 16;
                const float v = (dist >= 0 && dist <= 128) ? biasG[cmb_ * 132 + dist] : -1e30f;
                ((LAS float*)(lds + ATT_TAB_OFF))[sft * 160 + k] = v; }
            __syncthreads();
        }
        const LAS unsigned char* Kb = lds + bf * 65536; const LAS unsigned char* Vb = Kb + 32768;
        const int kb0 = w;
        f32x4 sc[9];
#pragma unroll
        for (int i = 0; i < 9; ++i) {
            const unsigned ko = (unsigned)(kb0 + i) * 2048u;
            const bf16x8 k0 = *(const LAS bf16x8*)(Kb + ko + kro0), k1 = *(const LAS bf16x8*)(Kb + ko + kro1);
            f32x4 a = (f32x4){0.f, 0.f, 0.f, 0.f};
            a = __builtin_amdgcn_mfma_f32_16x16x32_bf16(k0, qf0, a, 0, 0, 0);
            a = __builtin_amdgcn_mfma_f32_16x16x32_bf16(k1, qf1, a, 0, 0, 0);
            const f32x4 t = *(const LAS f32x4*)(lds + tab8 + 64 * (8 - i));
            a = a + (f32x4){t[3], t[2], t[1], t[0]};
            if (n == 0 && kb0 + i < 8) a = (f32x4){-1e30f, -1e30f, -1e30f, -1e30f};
            sc[i] = a;
        }
        float mx = -1e30f;
#pragma unroll
        for (int i = 0; i < 9; ++i) mx = fmaxf(mx, fmaxf(fmaxf(sc[i][0], sc[i][1]), fmaxf(sc[i][2], sc[i][3])));
        mx = fmaxf(mx, shx(mx, 16, lane)); mx = fmaxf(mx, shx(mx, 32, lane));
        float sum = 0.f;
#pragma unroll
        for (int i = 0; i < 9; ++i)
#pragma unroll
            for (int j = 0; j < 4; ++j) { const float p = __expf(sc[i][j] - mx); sc[i][j] = p; sum += p; }
        sum += shx(sum, 16, lane); sum += shx(sum, 32, lane);
        f32x4 oacc[4];
#pragma unroll
        for (int db = 0; db < 4; ++db) oacc[db] = (f32x4){0.f, 0.f, 0.f, 0.f};
#pragma unroll
        for (int c = 0; c < 5; ++c) {
            const int ia = 2 * c, ib = (c < 4) ? 2 * c + 1 : 8;
            u32x4 pw; pw.x = cvt_pk_bf16(sc[ia][0], sc[ia][1]); pw.y = cvt_pk_bf16(sc[ia][2], sc[ia][3]);
            if (c < 4) { pw.z = cvt_pk_bf16(sc[ib][0], sc[ib][1]); pw.w = cvt_pk_bf16(sc[ib][2], sc[ib][3]); } else { pw.z = 0u; pw.w = 0u; }
            const bf16x8 pf = __builtin_bit_cast(bf16x8, pw);
            const unsigned va = (unsigned)(kb0 + ia) * 2048u, vb = (unsigned)(kb0 + ib) * 2048u;
#pragma unroll
            for (int db = 0; db < 4; ++db) {
                const v4i16_t x0 = __builtin_amdgcn_ds_read_tr16_b64_v4i16((LAS v4i16_t*)(Vb + va + vro[db]));
                const v4i16_t x1 = __builtin_amdgcn_ds_read_tr16_b64_v4i16((LAS v4i16_t*)(Vb + vb + vro[db]));
                const bf16x8 vf = (bf16x8){x0[0], x0[1], x0[2], x0[3], x1[0], x1[1], x1[2], x1[3]};
                oacc[db] = __builtin_amdgcn_mfma_f32_16x16x32_bf16(vf, pf, oacc[db], 0, 0, 0);
            }
        }
        const float inv = 1.f / sum;
        const unsigned qpos = (unsigned)(r + dil * (128 * n + 16 * w + fr));
        bf16_t* orow = obr + ((size_t)b * SEQ + qpos) * 512 + h * 64 + 4 * fq;
#pragma unroll
        for (int db = 0; db < 4; ++db) { u32x2 o2; o2.x = cvt_pk_bf16(oacc[db][0] * inv, oacc[db][1] * inv); o2.y = cvt_pk_bf16(oacc[db][2] * inv, oacc[db][3] * inv); *(u32x2*)(orow + 16 * db) = o2; }
        if (fq == 0) lse[((size_t)b * SEQ + qpos) * 8 + h] = mx + __logf(sum);
    }
    asm volatile("s_waitcnt vmcnt(0)" ::: "memory");
    __syncthreads();
#undef ATT_DECODE
#undef ATT_ISSUE
}
__device__ __forceinline__ void p_attn_combine(const int wv, const bf16_t* obr, const float* lse, const float* g, bf16_t* mix16) {
    LTID();
    const int lane = tidx & 63, h = lane >> 3;
    f32x4 g0 = *(const f32x4*)(g + lane * 8), g1 = *(const f32x4*)(g + lane * 8 + 4);
    for (int row = bidx * NW + wv; row < SEQ; row += gridDim.x * NW) {
        float l0 = lse[((size_t)0 * SEQ + row) * 8 + h], l1 = lse[((size_t)1 * SEQ + row) * 8 + h], l2 = lse[((size_t)2 * SEQ + row) * 8 + h];
        const float M = fmaxf(l0, fmaxf(l1, l2));
        float w0 = __expf(l0 - M), w1 = __expf(l1 - M), w2 = __expf(l2 - M);
        const float iw = 1.f / (w0 + w1 + w2); w0 *= iw; w1 *= iw; w2 *= iw;
        const u32x4 a0 = *(const u32x4*)(obr + ((size_t)0 * SEQ + row) * 512 + lane * 8);
        const u32x4 a1 = *(const u32x4*)(obr + ((size_t)1 * SEQ + row) * 512 + lane * 8);
        const u32x4 a2 = *(const u32x4*)(obr + ((size_t)2 * SEQ + row) * 512 + lane * 8);
        float y[8]; float ss = 0.f;
#pragma unroll
        for (int k = 0; k < 4; ++k) {
            const float lo = w0 * __builtin_bit_cast(float, a0[k] << 16) + w1 * __builtin_bit_cast(float, a1[k] << 16) + w2 * __builtin_bit_cast(float, a2[k] << 16);
            const float hi = w0 * __builtin_bit_cast(float, a0[k] & 0xffff0000u) + w1 * __builtin_bit_cast(float, a1[k] & 0xffff0000u) + w2 * __builtin_bit_cast(float, a2[k] & 0xffff0000u);
            y[2 * k] = lo; y[2 * k + 1] = hi; ss += lo * lo + hi * hi;
        }
#pragma unroll
        for (int o = 32; o; o >>= 1) ss += shx(ss, o, lane);
        const float sc = rsqrtf(ss * (1.f / 512.f) + 1e-5f);
        u32x4 o4; o4.x = cvt_pk_bf16(y[0] * sc * g0[0], y[1] * sc * g0[1]); o4.y = cvt_pk_bf16(y[2] * sc * g0[2], y[3] * sc * g0[3]);
        o4.z = cvt_pk_bf16(y[4] * sc * g1[0], y[5] * sc * g1[1]); o4.w = cvt_pk_bf16(y[6] * sc * g1[2], y[7] * sc * g1[3]);
        *(u32x4*)(mix16 + (size_t)row * DM + lane * 8) = o4;
    }
}
struct EpiIn {
    static constexpr bool PERM = true;
    bf16_t* O; float* Uf;
    __device__ __forceinline__ void operator()(const f32x4 (&acc)[2][2][4][2], const GUnit& u, int wr, int wc, int fr, int fq) const {
        const int row0 = u.pm * BM + wr * 64 + fr, col0 = u.pn * BM + wc * 32 + 8 * fq;
        const float sc = u.pn < 2 ? 0.125f : 1.f;
#pragma unroll
        for (int ai = 0; ai < 2; ++ai)
#pragma unroll
            for (int m = 0; m < 4; ++m) { const size_t ro = (size_t)(row0 + ai * HALF + m * 16) * DIN + col0;
#pragma unroll
                for (int bj = 0; bj < 2; ++bj) { const f32x4 v0 = acc[ai][bj][m][0] * sc, v1 = acc[ai][bj][m][1] * sc;
                    u32x4 w; w.x = cvt_pk_bf16(v0[0], v0[1]); w.y = cvt_pk_bf16(v0[2], v0[3]); w.z = cvt_pk_bf16(v1[0], v1[1]); w.w = cvt_pk_bf16(v1[2], v1[3]);
                    *(u32x4*)(O + ro + bj * HALF) = w;
                    if (u.pn >= 6) { *(f32x4*)(Uf + ro + bj * HALF) = v0; *(f32x4*)(Uf + ro + bj * HALF + 4) = v1; } } }
    }
};


__device__ __forceinline__ unsigned xoff_b(unsigned row, unsigned ch) { return 256u * row + 16u * (ch ^ (((row & 3u) << 2) | ((row >> 2) & 3u))); }
__device__ __forceinline__ void p_xattn_mfma(const int wv, const bf16_t* qx16, const bf16_t* kv16, bf16_t* ox16, LAS unsigned char* lds) {
    LTID();
    const int lane = tidx & 63, fr = lane & 15, fq = lane >> 4, w = wv;
    const int NU = 4 * 128;
    const int per = (NU + (int)gridDim.x - 1) / (int)gridDim.x;
    const int u0 = bidx * per, u1 = (u0 + per < NU) ? u0 + per : NU;
    if (u0 >= u1) return;
    const int rowl = tidx >> 4, cs = tidx & 15;
    const unsigned csw = (unsigned)(cs ^ (((rowl & 3) << 2) | ((rowl >> 2) & 3))) * 16u;
    const unsigned kswz = (unsigned)(((fr & 3) << 2) | ((fr >> 2) & 3));
    unsigned kro[4];
#pragma unroll
    for (int s4 = 0; s4 < 4; ++s4) kro[s4] = 256u * (unsigned)fr + 16u * ((unsigned)(4 * s4 + fq) ^ kswz);
    const int tq = (lane & 15) >> 2, tp = lane & 3;
    const unsigned vswz = (unsigned)((tq << 2) | fq);
    unsigned vro[8];
#pragma unroll
    for (int c = 0; c < 8; ++c) vro[c] = 65536u + 256u * (unsigned)(4 * fq + tq) + 16u * ((unsigned)(2 * c + (tp >> 1)) ^ vswz) + 8u * (unsigned)(tp & 1);
    int prev_h = -1;
    for (int u = u0; u < u1; ++u) {
        const int h = u >> 7, qt = u & 127;
        if (h != prev_h) {
            __syncthreads();
            prev_h = h;
#pragma unroll
            for (int p = 0; p < 8; ++p) {
                const unsigned row = (unsigned)(32 * p + rowl);
                const unsigned so = row * 2048u + (unsigned)h * 256u + csw;
                const unsigned ld_ = (unsigned)(size_t)(lds + p * 8192 + w * 1024);
                glds16s(kv16, so, ld_); glds16s(kv16, so + 1024u, ld_ + 65536u);
            }
            asm volatile("s_waitcnt vmcnt(0)" ::: "memory");
            __syncthreads();
        }
        const char* qsrc = (const char*)qx16 + ((size_t)(qt * 128 + 16 * w + fr) * 512 + h * 128 + 8 * fq) * 2;
        bf16x8 qf[4];
#pragma unroll
        for (int s4 = 0; s4 < 4; ++s4) qf[s4] = *(const bf16x8*)(qsrc + 64 * s4);
        f32x4 sc[16];
#pragma unroll
        for (int i = 0; i < 16; ++i) {
            f32x4 a = (f32x4){0.f, 0.f, 0.f, 0.f};
#pragma unroll
            for (int s4 = 0; s4 < 4; ++s4) { const bf16x8 kf = *(const LAS bf16x8*)(lds + i * 4096 + kro[s4]); a = __builtin_amdgcn_mfma_f32_16x16x32_bf16(kf, qf[s4], a, 0, 0, 0); }
            sc[i] = a;
        }
        float mx = -1e30f;
#pragma unroll
        for (int i = 0; i < 16; ++i) mx = fmaxf(mx, fmaxf(fmaxf(sc[i][0], sc[i][1]), fmaxf(sc[i][2], sc[i][3])));
        mx = fmaxf(mx, shx(mx, 16, lane)); mx = fmaxf(mx, shx(mx, 32, lane));
        float sum = 0.f;
#pragma unroll
        for (int i = 0; i < 16; ++i)
#pragma unroll
            for (int j = 0; j < 4; ++j) { const float p = __expf(sc[i][j] - mx); sc[i][j] = p; sum += p; }
        sum += shx(sum, 16, lane); sum += shx(sum, 32, lane);
        f32x4 oacc[8];
#pragma unroll
        for (int c = 0; c < 8; ++c) oacc[c] = (f32x4){0.f, 0.f, 0.f, 0.f};
#pragma unroll
        for (int ch = 0; ch < 8; ++ch) {
            const int ia = 2 * ch, ib = 2 * ch + 1;
            u32x4 pw; pw.x = cvt_pk_bf16(sc[ia][0], sc[ia][1]); pw.y = cvt_pk_bf16(sc[ia][2], sc[ia][3]); pw.z = cvt_pk_bf16(sc[ib][0], sc[ib][1]); pw.w = cvt_pk_bf16(sc[ib][2], sc[ib][3]);
            const bf16x8 pf = __builtin_bit_cast(bf16x8, pw);
#pragma unroll
            for (int c = 0; c < 8; ++c) {
                const v4i16_t x0 = __builtin_amdgcn_ds_read_tr16_b64_v4i16((LAS v4i16_t*)(lds + ia * 4096 + vro[c]));
                const v4i16_t x1 = __builtin_amdgcn_ds_read_tr16_b64_v4i16((LAS v4i16_t*)(lds + ib * 4096 + vro[c]));
                const bf16x8 vf = (bf16x8){x0[0], x0[1], x0[2], x0[3], x1[0], x1[1], x1[2], x1[3]};
                oacc[c] = __builtin_amdgcn_mfma_f32_16x16x32_bf16(vf, pf, oacc[c], 0, 0, 0);
            }
        }
        const float inv = 1.f / sum;
        bf16_t* orow = ox16 + (size_t)(qt * 128 + 16 * w + fr) * 512 + h * 128 + 4 * fq;
#pragma unroll
        for (int c = 0; c < 8; ++c) { u32x2 o2; o2.x = cvt_pk_bf16(oacc[c][0] * inv, oacc[c][1] * inv); o2.y = cvt_pk_bf16(oacc[c][2] * inv, oacc[c][3] * inv); *(u32x2*)(orow + 16 * c) = o2; }
    }
    __syncthreads();
}
struct EpiBf16 {
    static constexpr bool PERM = true;
    bf16_t* O; int ldc; float scale;
    __device__ __forceinline__ void operator()(const f32x4 (&acc)[2][2][4][2], const GUnit& u, int wr, int wc, int fr, int fq) const {
        const int row0 = u.pm * BM + wr * 64 + fr, col0 = u.pn * BM + wc * 32 + 8 * fq;
#pragma unroll
        for (int ai = 0; ai < 2; ++ai)
#pragma unroll
            for (int m = 0; m < 4; ++m) { bf16_t* rowp = O + (size_t)(row0 + ai * HALF + m * 16) * ldc + col0;
#pragma unroll
                for (int bj = 0; bj < 2; ++bj) { const f32x4 v0 = acc[ai][bj][m][0] * scale, v1 = acc[ai][bj][m][1] * scale;
                    u32x4 w; w.x = cvt_pk_bf16(v0[0], v0[1]); w.y = cvt_pk_bf16(v0[2], v0[3]); w.z = cvt_pk_bf16(v1[0], v1[1]); w.w = cvt_pk_bf16(v1[2], v1[3]);
                    *(u32x4*)(rowp + bj * HALF) = w; } }
    }
};

__device__ __forceinline__ void p_rmsnorm(const int wv, const float* in, int in_ld, const float* g, float* out, int out_ld, int rows, int D, bf16_t* out16 = nullptr) {
    LTID();
    const int lane = tidx & 63, wave = tidx >> 6;
    for (int r = bidx * NW + wave; r < rows; r += gridDim.x * NW) {
        const float* p = in + (size_t)r * in_ld;
        float ss = 0.f;
        for (int i = lane; i < D; i += 64) { float v = p[i]; ss += v * v; }
        for (int o = 32; o; o >>= 1) ss += shx(ss, o, lane);
        const float sc = rsqrtf(ss / (float)D + 1e-5f);
        if (out16) { for (int i = lane; i < D; i += 64) out16[(size_t)r * out_ld + i] = (bf16_t)f2bf(p[i] * sc * g[i]); }
        if (out) { for (int i = lane; i < D; i += 64) out[(size_t)r * out_ld + i] = p[i] * sc * g[i]; }
    }
}
__device__ __forceinline__ void p_copy4(const int wv, const float* src, float* dst, size_t n4) {
    LTID();
    for (size_t i = (size_t)bidx * NT + tidx; i < n4; i += (size_t)gridDim.x * NT) ((float4*)dst)[i] = ((const float4*)src)[i];
}

enum { EP_STORE = 0, EP_RESID = 1, EP_GLU = 2, EP_MOE1 = 3, EP_MOE2 = 4 };
struct GArgs {
    const float* A; int lda; const float* B; int ldb; float* C; int ldc; int M, N, K;
    const float* bias; const float* aux;
    const int* rowtok; const int* offs; const unsigned* cnts;
    size_t strideB; int strideBias; int nexp;
};
template <int EP> __device__ __forceinline__ void p_gemm(const int wv, const GArgs& a, LAS unsigned char* lds) {
    LTID();
    LAS float* As = (LAS float*)lds;
    LAS float* Bs = As + 16 * 132;
    LAS float* Bs2 = Bs + 16 * 68;
    const int tid = tidx, ty = tid >> 4, tx = tid & 15;
    const int lr = tid >> 2, lk = (tid & 3) * 4;
    const int bsel = tid >> 8, bt = tid & 255, bk = bt >> 4, bn = (bt & 15) * 4;
    const int nN = a.N / 64;
    const int mt_max = (a.M + 127) / 128;
    const int per_e = mt_max * nN;
    const int total = per_e * a.nexp;
    for (int t = bidx; t < total; t += gridDim.x) {
        const int e = t / per_e, r = t - e * per_e, mt = r / nN, nt = r - mt * nN;
        int M = a.M, rowbase = 0;
        if (EP == EP_MOE1 || EP == EP_MOE2) { M = (int)a.cnts[e]; rowbase = a.offs[e]; }
        const int m0 = mt * 128, n0 = nt * 64;
        if (m0 >= M) continue;
        const float* B = a.B + (size_t)e * a.strideB;
        const float* bias = a.bias ? a.bias + (size_t)e * a.strideBias : nullptr;
        int ar = m0 + lr; if (ar >= M) ar = M - 1;
        const float* Arow;
        if (EP == EP_MOE1) Arow = a.A + (size_t)a.rowtok[rowbase + ar] * a.lda;
        else Arow = a.A + (size_t)(rowbase + ar) * a.lda;
        float acc[4][4], acc2[4][4];
#pragma unroll
        for (int i = 0; i < 4; ++i)
#pragma unroll
            for (int j = 0; j < 4; ++j) { acc[i][j] = 0.f; acc2[i][j] = 0.f; }
        for (int k0 = 0; k0 < a.K; k0 += 16) {
            const float4 av = *(const float4*)(Arow + k0 + lk);
            float4 bv = make_float4(0.f, 0.f, 0.f, 0.f);
            if (bsel == 0) bv = *(const float4*)(B + (size_t)(k0 + bk) * a.ldb + n0 + bn);
            else if (EP == EP_MOE1) bv = *(const float4*)(B + (size_t)(k0 + bk) * a.ldb + DFF + n0 + bn);
            __syncthreads();
            As[(lk + 0) * 132 + lr] = av.x; As[(lk + 1) * 132 + lr] = av.y; As[(lk + 2) * 132 + lr] = av.z; As[(lk + 3) * 132 + lr] = av.w;
            if (bsel == 0) *(LAS f32x4*)&Bs[bk * 68 + bn] = (f32x4){bv.x, bv.y, bv.z, bv.w};
            else if (EP == EP_MOE1) *(LAS f32x4*)&Bs2[bk * 68 + bn] = (f32x4){bv.x, bv.y, bv.z, bv.w};
            __syncthreads();
#pragma unroll
            for (int kk = 0; kk < 16; ++kk) {
                const f32x4 a4 = *(const LAS f32x4*)&As[kk * 132 + ty * 4];
                const f32x4 b4 = *(const LAS f32x4*)&Bs[kk * 68 + tx * 4];
                const float aa[4] = {a4.x, a4.y, a4.z, a4.w}, bb[4] = {b4.x, b4.y, b4.z, b4.w};
#pragma unroll
                for (int i = 0; i < 4; ++i)
#pragma unroll
                    for (int j = 0; j < 4; ++j) acc[i][j] += aa[i] * bb[j];
                if (EP == EP_MOE1) {
                    const f32x4 c4 = *(const LAS f32x4*)&Bs2[kk * 68 + tx * 4];
                    const float cc[4] = {c4.x, c4.y, c4.z, c4.w};
#pragma unroll
                    for (int i = 0; i < 4; ++i)
#pragma unroll
                        for (int j = 0; j < 4; ++j) acc2[i][j] += aa[i] * cc[j];
                }
            }
        }
#pragma unroll
        for (int i = 0; i < 4; ++i) {
            const int rr = m0 + ty * 4 + i;
            if (rr < M) {
                const size_t crow = (size_t)(rowbase + rr) * a.ldc;
#pragma unroll
                for (int j = 0; j < 4; ++j) {
                    const int c = n0 + tx * 4 + j;
                    float v = acc[i][j];
                    if (EP == EP_STORE) { if (bias) v += bias[c]; }
                    else if (EP == EP_RESID) v += a.aux[crow + c];
                    else if (EP == EP_GLU) { const float y = a.aux[crow + c]; v = y / (1.f + expf(-(v + bias[c]))); }
                    else if (EP == EP_MOE1) {
                        const float g = fminf(v + bias[c], 7.f);
                        const float l = fminf(fmaxf(acc2[i][j] + bias[DFF + c], -7.f), 7.f);
                        v = g / (1.f + expf(-1.702f * g)) * (l + 1.f);
                    } else if (EP == EP_MOE2) v += bias[c];
                    a.C[crow + c] = v;
                }
            }
        }
    }
    __syncthreads();
}

__device__ __forceinline__ int t5_bucket(int n) {
    if (n < 16) return n;
    const float v = logf((float)n / 16.f) / 4.852030263919617f * 16.f;
    const int large = 16 + (int)v;
    return large < 31 ? large : 31;
}
__device__ __forceinline__ void p_dilattn(const int wv, const float* proj, const float* rel_bias, float* ya, LAS unsigned char* lds) {
    LTID();
    const int w = tidx >> 6, lane = tidx & 63;
    LAS float* ps = (LAS float*)lds + w * 392;
    for (int gw = bidx * NW + w; gw < SEQ * 8; gw += gridDim.x * NW) {
        const int pos = gw >> 3, h = gw & 7;
        const float* q = proj + (size_t)pos * DIN + h * 64;
        float sc[7]; float mx = -1e30f;
#pragma unroll
        for (int it = 0; it < 7; ++it) {
            const int i = it * 64 + lane; float s = -1e30f;
            if (i < 387) {
                const int b = i / 129, d = i - b * 129, dil = 1 << (2 * b), kp = pos - d * dil;
                if (kp >= 0) {
                    const float* kr = proj + (size_t)kp * DIN + 512 + h * 64;
                    float dot = 0.f;
                    for (int e = 0; e < 64; e += 4) { const float4 qa = *(const float4*)(q + e), ka = *(const float4*)(kr + e); dot += qa.x * ka.x + qa.y * ka.y + qa.z * ka.z + qa.w * ka.w; }
                    s = dot * 0.125f + rel_bias[t5_bucket(d * dil) * 8 + h];
                }
            }
            sc[it] = s; mx = fmaxf(mx, s);
        }
        for (int o = 32; o; o >>= 1) mx = fmaxf(mx, shx(mx, o, lane));
        float den = 0.f;
#pragma unroll
        for (int it = 0; it < 7; ++it) {
            const int i = it * 64 + lane;
            const float p = (sc[it] > -1e29f) ? expf(sc[it] - mx) : 0.f;
            den += p;
            if (i < 387) ps[i] = p;
        }
        for (int o = 32; o; o >>= 1) den += shx(den, o, lane);
        __syncthreads();
        float acc = 0.f;
        for (int i = 0; i < 387; ++i) {
            const int b = i / 129, d = i - b * 129, dil = 1 << (2 * b), kp = pos - d * dil;
            if (kp >= 0) acc += ps[i] * proj[(size_t)kp * DIN + 1024 + h * 64 + lane];
        }
        ya[(size_t)pos * 512 + h * 64 + lane] = acc / den;
        __syncthreads();
    }
}

__device__ __forceinline__ void p_s5_tables(const int wv, const float* a_re, const float* a_im, const float* b_re, const float* b_im, const float* log_dt,
                                            float2* abar, float2* a128, float2* bbar) {
    LTID();
    for (int gp = bidx * NT + tidx; gp < 2048; gp += gridDim.x * NT) {
        const int g = gp >> 6;
        const float lr = a_re[gp], li = a_im[gp], dt = expf(log_dt[g]);
        const float mag = expf(lr * dt); float sn, cs; sincosf(li * dt, &sn, &cs);
        const float ar = mag * cs, ai = mag * sn;
        abar[gp] = make_float2(ar, ai);
        float pr = ar, pi = ai;
        for (int i = 0; i < 7; ++i) { const float nr = pr * pr - pi * pi, ni = 2.f * pr * pi; pr = nr; pi = ni; }
        a128[gp] = make_float2(pr, pi);
        const float nr = ar - 1.f, ni = ai, den = lr * lr + li * li;
        const float cr = (nr * lr + ni * li) / den, ci = (ni * lr - nr * li) / den;
        for (int c = 0; c < 16; ++c) {
            const float br = b_re[gp * 16 + c], bi = b_im[gp * 16 + c];
            bbar[gp * 16 + c] = make_float2(cr * br - ci * bi, cr * bi + ci * br);
        }
    }
}
template <int MODE> __device__ __forceinline__ void p_s5_local(const int wv, const float* proj, const float2* abar, const float2* bbar,
        const float* c_re, const float* c_im, const float* dskip, const float2* Sin, float2* E, float* ybuf, bf16_t* yg16) {
    LTID();
    const int w = tidx >> 6, p = tidx & 63;
    for (int item = bidx * NW + w; item < NCHUNK * 32; item += gridDim.x * NW) {
        const int chunk = item >> 5, g = item & 31, gp = g * 64 + p;
        float br[16], bi[16], cr[16], ci[16];
#pragma unroll
        for (int c = 0; c < 16; ++c) { const float2 b = bbar[gp * 16 + c]; br[c] = b.x; bi[c] = b.y; }
        if (MODE == 1) {
#pragma unroll
            for (int c = 0; c < 16; ++c) { cr[c] = c_re[(g * 16 + c) * 64 + p]; ci[c] = c_im[(g * 16 + c) * 64 + p]; }
        }
        const float2 a = abar[gp];
        float sr = 0.f, si = 0.f;
        if (MODE == 1) { const float2 s0 = Sin[chunk * 2048 + gp]; sr = s0.x; si = s0.y; }
        for (int t = 0; t < 128; ++t) {
            const int s = chunk * 128 + t;
            const float* up = proj + (size_t)s * DIN + 1536 + g * 16;
            float u[16];
#pragma unroll
            for (int c = 0; c < 16; c += 4) { const float4 v = *(const float4*)(up + c); u[c] = v.x; u[c + 1] = v.y; u[c + 2] = v.z; u[c + 3] = v.w; }
            float bur = 0.f, bui = 0.f;
#pragma unroll
            for (int c = 0; c < 16; ++c) { bur += br[c] * u[c]; bui += bi[c] * u[c]; }
            const float nr = a.x * sr - a.y * si + bur, ni = a.x * si + a.y * sr + bui;
            sr = nr; si = ni;
            if (MODE == 1) {
                float myy = 0.f;
#pragma unroll
                for (int c = 0; c < 16; ++c) {
                    float v = cr[c] * sr - ci[c] * si;
                    for (int o = 32; o; o >>= 1) v += shx(v, o, p);
                    if (p == c) myy = v + dskip[g * 16 + c] * u[c];
                }
                if (p < 16) { const float yv = 0.5f * myy * (1.f + erff(myy * 0.70710678118654752f)); ybuf[(size_t)s * 512 + g * 16 + p] = yv; yg16[(size_t)s * 512 + g * 16 + p] = (bf16_t)f2bf(yv); }
            }
        }
        if (MODE == 0) E[chunk * 2048 + gp] = make_float2(sr, si);
    }
}
__device__ __forceinline__ void p_s5_carry(const int wv, const float2* a128, const float2* E, float2* Sin) {
    LTID();
    for (int gp = bidx * NT + tidx; gp < 2048; gp += gridDim.x * NT) {
        const float2 a = a128[gp];
        float sr = 0.f, si = 0.f;
        for (int c = 0; c < NCHUNK; ++c) {
            Sin[c * 2048 + gp] = make_float2(sr, si);
            const float2 e = E[c * 2048 + gp];
            const float nr = a.x * sr - a.y * si + e.x, ni = a.x * si + a.y * sr + e.y;
            sr = nr; si = ni;
        }
    }
}
__device__ __forceinline__ void p_xattn(const int wv, const float* qx, const float* kvx, float* ox, bf16_t* ox16, LAS unsigned char* lds) {
    LTID();
    const int w = tidx >> 6, lane = tidx & 63;
    LAS float* ps = (LAS float*)lds + w * 256;
    for (int gw = bidx * NW + w; gw < SEQ * 4; gw += gridDim.x * NW) {
        const int pos = gw >> 2, h = gw & 3;
        const float* q = qx + (size_t)pos * 512 + h * 128;
        float sc[4]; float mx = -1e30f;
#pragma unroll
        for (int j = 0; j < 4; ++j) {
            const int m = j * 64 + lane;
            const float* kr = kvx + (size_t)m * 1024 + h * 128;
            float dot = 0.f;
            for (int e = 0; e < 128; e += 4) { const float4 qa = *(const float4*)(q + e), ka = *(const float4*)(kr + e); dot += qa.x * ka.x + qa.y * ka.y + qa.z * ka.z + qa.w * ka.w; }
            sc[j] = dot * 0.08838834764831845f; mx = fmaxf(mx, sc[j]);
        }
        for (int o = 32; o; o >>= 1) mx = fmaxf(mx, shx(mx, o, lane));
        float den = 0.f;
#pragma unroll
        for (int j = 0; j < 4; ++j) { const float p = expf(sc[j] - mx); den += p; ps[j * 64 + lane] = p; }
        for (int o = 32; o; o >>= 1) den += shx(den, o, lane);
        __syncthreads();
        float a0 = 0.f, a1 = 0.f;
        for (int m = 0; m < 256; ++m) {
            const float p = ps[m];
            const float* vr = kvx + (size_t)m * 1024 + 512 + h * 128;
            a0 += p * vr[lane]; a1 += p * vr[64 + lane];
        }
        ox[(size_t)pos * 512 + h * 128 + lane] = a0 / den;
        ox[(size_t)pos * 512 + h * 128 + 64 + lane] = a1 / den;
        ox16[(size_t)pos * 512 + h * 128 + lane] = (bf16_t)f2bf(a0 / den);
        ox16[(size_t)pos * 512 + h * 128 + 64 + lane] = (bf16_t)f2bf(a1 / den);
        __syncthreads();
    }
}
__device__ __forceinline__ void p_router(const int wv, const float* xn, const float* w_r, const float* b_r, int* topi, float* topg, unsigned* cnt) {
    LTID();
    const int lane = tidx & 63, e = lane & 31, w = tidx >> 6;
    for (int base = (bidx * NW + w) * 2; base < SEQ; base += gridDim.x * NW * 2) {
        const int token = base + (lane >> 5);
        const float* x = xn + (size_t)token * DM;
        float acc = 0.f;
        for (int k = 0; k < DM; ++k) acc += x[k] * w_r[k * 32 + e];
        float v = acc + b_r[e];
        float tv[4]; int ti[4];
#pragma unroll
        for (int r = 0; r < 4; ++r) {
            float bv = v; int bi = e;
#pragma unroll
            for (int o = 16; o; o >>= 1) {
                const float ov = shx(bv, o, lane); const int oi = shxi(bi, o, lane);
                if (ov > bv || (ov == bv && oi < bi)) { bv = ov; bi = oi; }
            }
            tv[r] = bv; ti[r] = bi;
            if (e == bi) v = -3.0e38f;
        }
        float ex[4], sum = 0.f;
#pragma unroll
        for (int r = 0; r < 4; ++r) { ex[r] = expf(tv[r] - tv[0]); sum += ex[r]; }
        if (e < 4) {
            const float gsel = e == 0 ? ex[0] : e == 1 ? ex[1] : e == 2 ? ex[2] : ex[3];
            const int isel = e == 0 ? ti[0] : e == 1 ? ti[1] : e == 2 ? ti[2] : ti[3];
            topi[token * 4 + e] = isel; topg[token * 4 + e] = gsel / sum;
            atomicAdd(&cnt[isel], 1u);
        }
    }
}
__device__ __forceinline__ void p_moe_place(const int wv, const int* topi, const unsigned* cnt, unsigned* cursor, int* rowtok, int* posof, LAS unsigned char* lds) {
    LTID();
    LAS int* offs = (LAS int*)lds;
    if (tidx == 0) { int s = 0; for (int e = 0; e < NEXP; ++e) { offs[e] = s; s += (((int)cnt[e] + BM - 1) / BM) * BM; } }
    __syncthreads();
    for (int i = bidx * NT + tidx; i < SEQ * TOPK; i += gridDim.x * NT) {
        const int e = topi[i];
        const int pos = offs[e] + (int)atomicAdd(&cursor[e], 1u);
        rowtok[pos] = i >> 2; posof[i] = pos;
    }
    if (bidx == 0) {
        for (int e = 0; e < NEXP; ++e) { const int c0 = (int)cnt[e], c1 = ((c0 + BM - 1) / BM) * BM; for (int r = c0 + tidx; r < c1; r += NT) rowtok[offs[e] + r] = 0; }
    }
    __syncthreads();
}
__device__ __forceinline__ void p_combine(const int wv, float* h, const bf16_t* outb, const int* posof, const float* topg) {
    LTID();
    for (int i = bidx * NT + tidx; i < SEQ * 256; i += gridDim.x * NT) {
        const int token = i >> 8, c4 = (i & 255) * 4;
        float4 acc = *(const float4*)(h + (size_t)token * DM + c4);
#pragma unroll
        for (int k = 0; k < 4; ++k) {
            const float g = topg[token * 4 + k];
            const u32x2 o = *(const u32x2*)(outb + (size_t)posof[token * 4 + k] * DM + c4);
            acc.x += g * __builtin_bit_cast(float, o.x << 16); acc.y += g * __builtin_bit_cast(float, o.x & 0xffff0000u);
            acc.z += g * __builtin_bit_cast(float, o.y << 16); acc.w += g * __builtin_bit_cast(float, o.y & 0xffff0000u);
        }
        *(float4*)(h + (size_t)token * DM + c4) = acc;
    }
}

constexpr int NPL = 18;
constexpr int NPHASES = 1 + 2 * NPL + 1;
typedef const __attribute__((address_space(4))) Args* KA;
#define PHASE __device__ __forceinline__
#define KAP() ({ KA _t = a; asm volatile("" : "+s"(_t)); _t; })
#define WSP(T, off) ((T*)(a->ws + (off)))

PHASE void ph_init(KA a, const int wv) {
    p_copy4(wv, a->in[0], WSP(float, WS_H), (size_t)SEQ * DM / 4);
    p_bias_table(wv, a->in[2], WSP(float, WS_BIASG));
    for (int l = 0; l < 2; ++l) {
        p_s5_tables(wv, a->in[5] + l * 2048, a->in[6] + l * 2048, a->in[7] + l * 32768, a->in[8] + l * 32768, a->in[11] + l * 32,
                    WSP(float2, WS_ABAR) + l * 2048, WSP(float2, WS_A128) + l * 2048, WSP(float2, WS_BBAR) + l * 32768);
        p_rmsnorm(wv, a->in[1], DM, a->in[19] + l * DM, nullptr, DM, NMEM, DM, WSP(bf16_t, WS_MEMN16) + (size_t)l * NMEM * DM);
        p_transpose(wv, a->in[4] + (size_t)l * DM * DIN, DM, DIN, WSP(bf16_t, WS_WT_IN) + (size_t)l * DIN * DM, nullptr, 0, LDSP);
        p_transpose(wv, a->in[13] + (size_t)l * 512 * 512, 512, 512, WSP(bf16_t, WS_WT_GLU) + (size_t)l * 512 * 512, nullptr, 0, LDSP);
        p_transpose(wv, a->in[17] + (size_t)l * DM * DM, DM, DM, WSP(bf16_t, WS_WT_OUT) + (size_t)l * DM * DM, nullptr, 0, LDSP);
        p_transpose(wv, a->in[20] + (size_t)l * DM * 512, DM, 512, WSP(bf16_t, WS_WT_XQ) + (size_t)l * 512 * DM, nullptr, 0, LDSP);
        p_transpose(wv, a->in[21] + (size_t)l * DM * 1024, DM, 1024, WSP(bf16_t, WS_WT_XKV) + (size_t)l * 1024 * DM, nullptr, 0, LDSP);
        p_transpose(wv, a->in[22] + (size_t)l * 512 * DM, 512, DM, WSP(bf16_t, WS_WT_XO) + (size_t)l * DM * 512, nullptr, 0, LDSP);
    }
    for (int le = 0; le < 2 * NEXP; ++le) {
        p_transpose(wv, a->in[26] + (size_t)le * DM * 2048, DM, 2048, WSP(bf16_t, WS_BT1) + (size_t)le * 2048 * DM, nullptr, 1, LDSP);
        p_transpose(wv, a->in[28] + (size_t)le * DFF * DM, DFF, DM, WSP(bf16_t, WS_BT2) + (size_t)le * DM * DFF, nullptr, 0, LDSP);
    }
    __syncthreads();
}
PHASE void ph_norm(KA a, const int wv, int which, int l) {
    const float* g = (which == 0 ? a->in[3] : which == 1 ? a->in[18] : a->in[23]) + l * DM;
    if (which == 2) p_rmsnorm(wv, WSP(float, WS_H), DM, g, WSP(float, WS_XN), DM, SEQ, DM, WSP(bf16_t, WS_XN16));
    else p_rmsnorm(wv, WSP(float, WS_H), DM, g, nullptr, DM, SEQ, DM, WSP(bf16_t, WS_XN16));
}
PHASE void ph_gemm_in(KA a, const int wv, int l) { LTID();
    DenseOrder S; S.init(WSP(bf16_t, WS_XN16), WSP(bf16_t, WS_WT_IN) + (size_t)l * DIN * DM, SEQ, DIN, DM, gridDim.x, bidx);
    EpiIn E{WSP(bf16_t, WS_PROJ16), WSP(float, WS_PROJ)};
    gemm_phase<EpiIn, DenseOrder, false, false>(LDSP, DM, S, E, tidx, wv);
}
PHASE void ph_dilattn(KA a, const int wv) { p_dil_attn(wv, WSP(bf16_t, WS_PROJ16), WSP(float, WS_BIASG), WSP(bf16_t, WS_OBR), WSP(float, WS_LSE), LDSP); }
PHASE void ph_s5_local0(KA a, const int wv, int l) {
    p_s5_local<0>(wv, WSP(float, WS_PROJ), WSP(float2, WS_ABAR) + l * 2048, WSP(float2, WS_BBAR) + l * 32768, a->in[9] + l * 32768, a->in[10] + l * 32768, a->in[12] + l * 512,
                  WSP(float2, WS_SIN), WSP(float2, WS_E), WSP(float, WS_YBUF), WSP(bf16_t, WS_YG16));
}
PHASE void ph_s5_carry(KA a, const int wv, int l) { p_s5_carry(wv, WSP(float2, WS_A128) + l * 2048, WSP(float2, WS_E), WSP(float2, WS_SIN)); }
PHASE void ph_s5_local1(KA a, const int wv, int l) {
    p_s5_local<1>(wv, WSP(float, WS_PROJ), WSP(float2, WS_ABAR) + l * 2048, WSP(float2, WS_BBAR) + l * 32768, a->in[9] + l * 32768, a->in[10] + l * 32768, a->in[12] + l * 512,
                  WSP(float2, WS_SIN), WSP(float2, WS_E), WSP(float, WS_YBUF), WSP(bf16_t, WS_YG16));
}
PHASE void ph_gemm_glu(KA a, const int wv, int l) { LTID();
    DenseOrder S; S.init(WSP(bf16_t, WS_YG16), WSP(bf16_t, WS_WT_GLU) + (size_t)l * 512 * 512, SEQ, 512, 512, gridDim.x, bidx);
    EpiGlu E{WSP(float, WS_YB), WSP(float, WS_YBUF), 512, a->in[14] + l * 512};
    gemm_phase<EpiGlu, DenseOrder, false, false>(LDSP, 512, S, E, tidx, wv);
}
PHASE void ph_norm_mixout(KA a, const int wv, int l) {
    p_attn_combine(wv, WSP(bf16_t, WS_OBR), WSP(float, WS_LSE), a->in[15] + l * 512, WSP(bf16_t, WS_MIX16));
    p_rmsnorm(wv, WSP(float, WS_YB), 512, a->in[16] + l * 512, nullptr, DM, SEQ, 512, WSP(bf16_t, WS_MIX16) + 512);
}
PHASE void ph_gemm_out(KA a, const int wv, int l) { LTID();
    DenseOrder S; S.init(WSP(bf16_t, WS_MIX16), WSP(bf16_t, WS_WT_OUT) + (size_t)l * DM * DM, SEQ, DM, DM, gridDim.x, bidx);
    EpiF32 E{WSP(float, WS_H), DM, 1};
    gemm_phase<EpiF32, DenseOrder, false, false>(LDSP, DM, S, E, tidx, wv);
}
PHASE void ph_gemm_kv(KA a, const int wv, int l) { LTID();
    DenseOrder S; S.init(WSP(bf16_t, WS_MEMN16) + (size_t)l * NMEM * DM, WSP(bf16_t, WS_WT_XKV) + (size_t)l * 1024 * DM, NMEM, 1024, DM, gridDim.x, bidx);
    EpiBf16 E{WSP(bf16_t, WS_KV16), 1024, 1.f};
    gemm_phase<EpiBf16, DenseOrder, false, false>(LDSP, DM, S, E, tidx, wv);
}
PHASE void ph_gemm_xq(KA a, const int wv, int l) { LTID();
    DenseOrder S; S.init(WSP(bf16_t, WS_XN16), WSP(bf16_t, WS_WT_XQ) + (size_t)l * 512 * DM, SEQ, 512, DM, gridDim.x, bidx);
    EpiBf16 E{WSP(bf16_t, WS_QX16), 512, 0.08838834764831845f};
    gemm_phase<EpiBf16, DenseOrder, false, false>(LDSP, DM, S, E, tidx, wv);
}
PHASE void ph_xattn(KA a, const int wv) { p_xattn_mfma(wv, WSP(bf16_t, WS_QX16), WSP(bf16_t, WS_KV16), WSP(bf16_t, WS_OX16), LDSP); }
PHASE void ph_gemm_xo(KA a, const int wv, int l) { LTID();
    DenseOrder S; S.init(WSP(bf16_t, WS_OX16), WSP(bf16_t, WS_WT_XO) + (size_t)l * DM * 512, SEQ, DM, 512, gridDim.x, bidx);
    EpiF32 E{WSP(float, WS_H), DM, 1};
    gemm_phase<EpiF32, DenseOrder, false, false>(LDSP, 512, S, E, tidx, wv);
}
PHASE void ph_router(KA a, const int wv, int l) { p_router(wv, WSP(float, WS_XN), a->in[24] + (size_t)l * DM * 32, a->in[25] + l * 32, WSP(int, WS_TOPI), WSP(float, WS_TOPG), WSP(unsigned, WS_CTL) + CW_CNT + l * 32); }
PHASE void ph_place(KA a, const int wv, int l) { p_moe_place(wv, WSP(int, WS_TOPI), WSP(unsigned, WS_CTL) + CW_CNT + l * 32, WSP(unsigned, WS_CTL) + CW_CUR + l * 32, WSP(int, WS_ROWTOK), WSP(int, WS_POSOF), LDSP); }
PHASE void ph_moe1(KA a, const int wv, int l) { LTID();
    moe_tiles(WSP(unsigned, WS_CTL) + CW_CNT + l * 32, tidx);
    MoeOrder<true> S; S.init(WSP(bf16_t, WS_XN16), WSP(bf16_t, WS_BT1) + (size_t)l * NEXP * 2048 * DM, WSP(int, WS_ROWTOK), 2048, DM, (size_t)2048 * DM * 2, gridDim.x, bidx);
    EpiMoe1 E{WSP(bf16_t, WS_ACT), a->in[27] + (size_t)l * NEXP * 2048};
    gemm_phase<EpiMoe1, MoeOrder<true>, true, false>(LDSP, DM, S, E, tidx, wv);
}
PHASE void ph_moe2(KA a, const int wv, int l) { LTID();
    moe_tiles(WSP(unsigned, WS_CTL) + CW_CNT + l * 32, tidx);
    MoeOrder<false> S; S.init(WSP(bf16_t, WS_ACT), WSP(bf16_t, WS_BT2) + (size_t)l * NEXP * DM * DFF, nullptr, DM, DFF, (size_t)DM * DFF * 2, gridDim.x, bidx);
    EpiMoe2 E{WSP(bf16_t, WS_MOUT), a->in[29] + (size_t)l * NEXP * DM};
    gemm_phase<EpiMoe2, MoeOrder<false>, false, false>(LDSP, DFF, S, E, tidx, wv);
}
PHASE void ph_combine(KA a, const int wv) { p_combine(wv, WSP(float, WS_H), WSP(bf16_t, WS_MOUT), WSP(int, WS_POSOF), WSP(float, WS_TOPG)); }
PHASE void ph_final(KA a, const int wv) { p_rmsnorm(wv, WSP(float, WS_H), DM, a->in[30], a->out, DM, SEQ, DM); }

__global__ void __launch_bounds__(NT, 2) mega(Args args) {
    KA a = (KA)__builtin_amdgcn_kernarg_segment_ptr();
    int wv = __builtin_amdgcn_readfirstlane((int)threadIdx.x >> 6); asm volatile("" : "+s"(wv));
    LAS unsigned char* lds = LDSP;
    volatile LAS unsigned* MISC = (volatile LAS unsigned*)(lds + MISC_OFF);
    unsigned* ctl = (unsigned*)(a->ws + WS_CTL);
    if (threadIdx.x < 32) MISC[threadIdx.x] = 0u;
    __syncthreads();
    XcdBarrier bar; bar.bar = ctl + CW_BAR; bar.x = 0; bar.st = nullptr;
    if (!MK_PER_PHASE) bar = xcd_barrier_post(ctl + CW_BAR, MISC + 8);
    const int lo = a->ph_lo, hi = a->ph_hi;
#define IN(k) (lo <= (k) && (k) < hi)
#define SEAM(k) do { if (IN(k) && IN((k) + 1)) { LTID(); xcd_barrier(bar.bar, bar.x, bar.st, tidx == 0); } } while (0)
    if (IN(0)) ph_init(KAP(), wv);
    SEAM(0);
#pragma unroll 1
    for (int l = 0; l < 2; ++l) {
        const int pb = 1 + l * NPL;
        if (IN(pb + 0)) ph_norm(KAP(), wv, 0, l);
        SEAM(pb + 0);
        if (IN(pb + 1)) ph_gemm_in(KAP(), wv, l);
        SEAM(pb + 1);
        if (IN(pb + 2)) { ph_dilattn(KAP(), wv); ph_s5_local0(KAP(), wv, l); }
        SEAM(pb + 2);
        if (IN(pb + 3)) ph_s5_carry(KAP(), wv, l);
        SEAM(pb + 3);
        if (IN(pb + 4)) ph_s5_local1(KAP(), wv, l);
        SEAM(pb + 4);
        if (IN(pb + 5)) ph_gemm_glu(KAP(), wv, l);
        SEAM(pb + 5);
        if (IN(pb + 6)) ph_norm_mixout(KAP(), wv, l);
        SEAM(pb + 6);
        if (IN(pb + 7)) ph_gemm_out(KAP(), wv, l);
        SEAM(pb + 7);
        if (IN(pb + 8)) { ph_norm(KAP(), wv, 1, l); ph_gemm_kv(KAP(), wv, l); }
        SEAM(pb + 8);
        if (IN(pb + 9)) ph_gemm_xq(KAP(), wv, l);
        SEAM(pb + 9);
        if (IN(pb + 10)) ph_xattn(KAP(), wv);
        SEAM(pb + 10);
        if (IN(pb + 11)) ph_gemm_xo(KAP(), wv, l);
        SEAM(pb + 11);
        if (IN(pb + 12)) ph_norm(KAP(), wv, 2, l);
        SEAM(pb + 12);
        if (IN(pb + 13)) ph_router(KAP(), wv, l);
        SEAM(pb + 13);
        if (IN(pb + 14)) ph_place(KAP(), wv, l);
        SEAM(pb + 14);
        if (IN(pb + 15)) ph_moe1(KAP(), wv, l);
        SEAM(pb + 15);
        if (IN(pb + 16)) ph_moe2(KAP(), wv, l);
        SEAM(pb + 16);
        if (IN(pb + 17)) ph_combine(KAP(), wv);
        SEAM(pb + 17);
    }
    if (IN(NPHASES - 1)) ph_final(KAP(), wv);
#undef IN
#undef SEAM
}

extern "C" void kernel_launch(void* const* d_in, const int* in_sizes, int n_in, void* d_out, int out_size, void* d_ws, size_t ws_size, hipStream_t stream) {
    static int grid = 0;
    if (grid == 0) {
        if (n_in != 31 || ws_size < WS_END) { fprintf(stderr, "kernel_launch: unexpected n_in %d or ws_size %zu (need %zu)\n", n_in, ws_size, (size_t)WS_END); grid = -1; return; }
        int dev = 0, cus = 0, per_cu = 0;
        if (hipGetDevice(&dev) != hipSuccess || hipDeviceGetAttribute(&cus, hipDeviceAttributeMultiprocessorCount, dev) != hipSuccess) { grid = -1; return; }
        if (hipFuncSetAttribute((const void*)mega, hipFuncAttributeMaxDynamicSharedMemorySize, LDS_BYTES) != hipSuccess) { fprintf(stderr, "kernel_launch: hipFuncSetAttribute failed\n"); grid = -1; return; }
        if (hipOccupancyMaxActiveBlocksPerMultiprocessor(&per_cu, (const void*)mega, NT, LDS_BYTES) != hipSuccess || per_cu < 1)
            fprintf(stderr, "kernel_launch: occupancy query reports %d workgroups per CU\n", per_cu);
        (void)hipGetLastError();
        grid = cus;
    }
    if (grid < 0) return;
    if (hipMemsetAsync((char*)d_ws + WS_CTL, 0, CTL_ZERO_BYTES, stream) != hipSuccess) return;
    Args a{};
    for (int i = 0; i < 31; ++i) a.in[i] = (const float*)d_in[i];
    a.out = (float*)d_out; a.ws = (unsigned char*)d_ws;
#if MK_PER_PHASE
    for (int p = 0; p < NPHASES; ++p) { a.ph_lo = p; a.ph_hi = p + 1; hipLaunchKernelGGL(mega, dim3(grid), dim3(NT), LDS_BYTES, stream, a); }
#else
    a.ph_lo = 0; a.ph_hi = NPHASES;
    hipLaunchKernelGGL(mega, dim3(grid), dim3(NT), LDS_BYTES, stream, a);
#endif
}
```

```cpp
#include <hip/hip_runtime.h>
#include <stdint.h>
#include <cstdio>

#ifndef MK_PER_PHASE
#define MK_PER_PHASE 0
#endif

#define SEQ 16384
#define DM 1024
#define DIN 2048
#define NMEM 256
#define NEXP 32
#define TOPK 4
#define DFF 1024
#define NCHUNK 128
#define NT 512
#define NW 8

#define LAS __attribute__((address_space(3)))
typedef float f32x4 __attribute__((ext_vector_type(4)));
extern __shared__ __attribute__((aligned(16))) unsigned char lds_raw[];
#define LDSP ((LAS unsigned char*)lds_raw)
#define LTID() int z_ = 0; asm volatile("" : "+v"(z_)); const int lane_ = (int)__builtin_amdgcn_mbcnt_hi(~0u, __builtin_amdgcn_mbcnt_lo(~0u, (unsigned)z_)); \
    const int tidx = wv * 64 + lane_; int bidx = blockIdx.x; asm volatile("" : "+s"(bidx))
__device__ __forceinline__ float shx(float v, int mask, int lane) { return __builtin_bit_cast(float, __builtin_amdgcn_ds_bpermute((lane ^ mask) << 2, __builtin_bit_cast(int, v))); }
__device__ __forceinline__ int shxi(int v, int mask, int lane) { return __builtin_amdgcn_ds_bpermute((lane ^ mask) << 2, v); }
constexpr int LDS_BYTES = 147456;
constexpr int MISC_OFF = 131072 + 320;

#define XB_TMO      128
#define XB_XCNT(j)  (256  + 64 * (j))
#define XB_XSUB(j)  (1280 + 64 * (j))
#define XB_XGEN(j)  (2304 + 64 * (j))
#define XB_TOP      3328
#define XB_TOPGEN   3392
#define XCD_BAR_WORDS 3456
#define XB_SPIN_CAP (1u << 18)

__device__ __forceinline__ unsigned xb_ld(unsigned* p)              { return __hip_atomic_load(p, __ATOMIC_RELAXED, __HIP_MEMORY_SCOPE_AGENT); }
__device__ __forceinline__ unsigned xb_add(unsigned* p, unsigned v) { return __hip_atomic_fetch_add(p, v, __ATOMIC_RELAXED, __HIP_MEMORY_SCOPE_AGENT); }
__device__ __forceinline__ unsigned xb_xcc_id() { return (unsigned)__builtin_amdgcn_s_getreg((3 << 11) | 20) & 0xFu; }
#define XB_SPIN(cond, bar) do { unsigned _sp = 0; while (cond) { __builtin_amdgcn_s_sleep(1); \
    if ((++_sp & 255u) == 0u) { if (xb_ld(&(bar)[XB_TMO])) break; if (_sp > XB_SPIN_CAP) { atomicAdd(&(bar)[XB_TMO], 1u); break; } } } } while (0)

struct XcdBarrier {
    unsigned* bar; unsigned x;
    volatile LAS unsigned* st;
};
__device__ __forceinline__ XcdBarrier xcd_barrier_post(unsigned* bar, volatile LAS unsigned* st) {
    XcdBarrier b; b.bar = bar; b.x = xb_xcc_id(); b.st = st;
    if (threadIdx.x == 0) (void)xb_add(&bar[XB_XCNT(b.x)], 1u);
    return b;
}
__device__ __forceinline__ void xcd_barrier_complete(unsigned* bar, unsigned x, unsigned& nloc, unsigned& nx) {
    const unsigned G = gridDim.x * gridDim.y * gridDim.z;
    unsigned sum, cnt, mine, sp = 0u;
    for (;;) {
        sum = 0u; cnt = 0u; mine = 0u;
#pragma unroll
        for (unsigned j = 0; j < 16; ++j) { const unsigned c = xb_ld(&bar[XB_XCNT(j)]); sum += c; cnt += (c > 0u) ? 1u : 0u; mine = (j == x) ? c : mine; }
        if (sum == G) break;
        __builtin_amdgcn_s_sleep(1);
        if ((++sp & 255u) == 0u) { if (xb_ld(&bar[XB_TMO])) break; if (sp > XB_SPIN_CAP) { atomicAdd(&bar[XB_TMO], 1u); break; } }
    }
    nloc = mine > 0u ? mine : 1u; nx = cnt > 0u ? cnt : 1u;
}
__device__ __noinline__ void xcd_barrier(unsigned* bar_, unsigned x_, volatile LAS unsigned* st_, int is_t0) {
    XcdBarrier b; b.bar = bar_; b.x = x_; b.st = st_;
    asm volatile("s_waitcnt vmcnt(0)" ::: "memory");
    __syncthreads();
    if (is_t0) {
        unsigned* bar = b.bar;
        __builtin_amdgcn_s_waitcnt(0);
        unsigned nloc = b.st[0], nx = b.st[1];
        if (nloc == 0u) { xcd_barrier_complete(bar, b.x, nloc, nx); b.st[0] = nloc; b.st[1] = nx; }
        const unsigned old = xb_add(&bar[XB_XSUB(b.x)], 1u);
        const unsigned gen = old / nloc;
        if (old + 1u == (gen + 1u) * nloc) {
            __builtin_amdgcn_fence(__ATOMIC_RELEASE, "agent");
            asm volatile("s_waitcnt vmcnt(0)" ::: "memory");
            const unsigned og = xb_add(&bar[XB_TOP], 1u);
            const unsigned tg = og / nx;
            if (og + 1u == (tg + 1u) * nx) xb_add(&bar[XB_TOPGEN], 1u);
            else XB_SPIN(xb_ld(&bar[XB_TOPGEN]) == tg, bar);
            __builtin_amdgcn_fence(__ATOMIC_ACQUIRE, "agent");
            xb_add(&bar[XB_XGEN(b.x)], 1u);
            asm volatile("s_waitcnt vmcnt(0)" ::: "memory");
        } else {
            XB_SPIN(xb_ld(&bar[XB_XGEN(b.x)]) == gen, bar);
            __builtin_amdgcn_fence(__ATOMIC_ACQUIRE, "agent");
            asm volatile("s_waitcnt vmcnt(0)" ::: "memory");
        }
    }
    __syncthreads();
}

constexpr size_t MiB = 1u << 20;
constexpr size_t WS_CTL = 0, CTL_ZERO_BYTES = 1 * MiB;
constexpr int CW_BAR = 4096;
constexpr int CW_CNT = 8192;
constexpr int CW_CUR = 8192 + 64;
constexpr size_t WS_H = 2 * MiB;
constexpr size_t WS_XN = WS_H + 64 * MiB;
constexpr size_t WS_PROJ = WS_XN + 64 * MiB;
constexpr size_t WS_YA = WS_PROJ + 128 * MiB;
constexpr size_t WS_YBUF = WS_YA + 32 * MiB;
constexpr size_t WS_YB = WS_YBUF + 32 * MiB;
constexpr size_t WS_MIX = WS_YB + 32 * MiB;
constexpr size_t WS_QX = WS_MIX + 64 * MiB;
constexpr size_t WS_OX = WS_QX + 32 * MiB;
constexpr int MOE_ROWS = SEQ * TOPK + NEXP * 256;
constexpr size_t WS_ACT = WS_OX + 32 * MiB;
constexpr size_t WS_MOUT = WS_ACT + 144 * MiB;
constexpr size_t WS_BT1 = WS_MOUT + 144 * MiB;
constexpr size_t WS_BT2 = WS_BT1 + 256 * MiB;
constexpr size_t WS_SMALL = WS_BT2 + 128 * MiB;
constexpr size_t WS_ABAR = WS_SMALL;
constexpr size_t WS_A128 = WS_ABAR + 2 * 2048 * 8;
constexpr size_t WS_BBAR = WS_A128 + 2 * 2048 * 8;
constexpr size_t WS_E = WS_BBAR + 2 * 2048 * 16 * 8;
constexpr size_t WS_SIN = WS_E + (size_t)NCHUNK * 2048 * 8;
constexpr size_t WS_MEMN = WS_SIN + (size_t)NCHUNK * 2048 * 8;
constexpr size_t WS_KVX = WS_MEMN + 2 * (size_t)NMEM * DM * 4;
constexpr size_t WS_TOPI = WS_KVX + (size_t)NMEM * 1024 * 4;
constexpr size_t WS_TOPG = WS_TOPI + (size_t)SEQ * 4 * 4;
constexpr size_t WS_ROWTOK = WS_TOPG + (size_t)SEQ * 4 * 4;
constexpr size_t WS_POSOF = WS_ROWTOK + (size_t)MOE_ROWS * 4;
constexpr size_t WS_WT_IN = (WS_POSOF + (size_t)SEQ * 4 * 4 + 255) & ~(size_t)255;
constexpr size_t WS_WT_GLU = WS_WT_IN + 2 * (size_t)2048 * 1024 * 2;
constexpr size_t WS_WT_OUT = WS_WT_GLU + 2 * (size_t)512 * 512 * 2;
constexpr size_t WS_WT_XQ = WS_WT_OUT + 2 * (size_t)1024 * 1024 * 2;
constexpr size_t WS_WT_XKV = WS_WT_XQ + 2 * (size_t)512 * 1024 * 2;
constexpr size_t WS_WT_XO = WS_WT_XKV + 2 * (size_t)1024 * 1024 * 2;
constexpr size_t WS_XN16 = WS_WT_XO + 2 * (size_t)1024 * 512 * 2;
constexpr size_t WS_MIX16 = WS_XN16 + (size_t)SEQ * 1024 * 2;
constexpr size_t WS_YG16 = WS_MIX16 + (size_t)SEQ * 1024 * 2;
constexpr size_t WS_OX16 = WS_YG16 + (size_t)SEQ * 512 * 2;
constexpr size_t WS_MEMN16 = WS_OX16 + (size_t)SEQ * 512 * 2;
constexpr size_t WS_PROJ16 = WS_MEMN16 + 2 * (size_t)NMEM * 1024 * 2;
constexpr size_t WS_OBR = WS_PROJ16 + (size_t)SEQ * 2048 * 2;
constexpr size_t WS_LSE = WS_OBR + 3 * (size_t)SEQ * 512 * 2;
constexpr size_t WS_BIASG = WS_LSE + 3 * (size_t)SEQ * 8 * 4;
constexpr size_t WS_QX16 = WS_BIASG + 24 * 132 * 4 + 256;
constexpr size_t WS_KV16 = WS_QX16 + (size_t)SEQ * 512 * 2;
constexpr size_t WS_A256 = WS_KV16 + (size_t)NMEM * 1024 * 2;
constexpr size_t WS_BB16 = WS_A256 + 2 * 2048 * 8;
constexpr size_t WS_CM16 = WS_BB16 + 2 * (size_t)32 * 128 * 16 * 2;
constexpr size_t WS_E2 = WS_CM16 + 2 * (size_t)32 * 16 * 128 * 2;
constexpr size_t WS_YB16 = WS_E2 + (size_t)64 * 2048 * 8;
constexpr size_t WS_END = WS_YB16 + (size_t)SEQ * 512 * 2;

struct Args { const float* in[31]; float* out; unsigned char* ws; int ph_lo, ph_hi; };


typedef unsigned short bf16_t;
typedef short bf16x8 __attribute__((ext_vector_type(8)));
typedef unsigned u32x4 __attribute__((ext_vector_type(4)));
typedef unsigned u32x2 __attribute__((ext_vector_type(2)));
constexpr int BM = 256, BK = 64, HALF = 128, HTB = HALF * BK * 2, STAGE_BYTES = 8 * HTB, NXCD = 8, WGM = 8;
__host__ __device__ __forceinline__ int lds_byte(int r, int c) { const int st = (r >> 4) * 2 + (c >> 5), rr = r & 15, cc = c & 31, ob = rr * 64 + cc * 2; return st * 1024 + (ob ^ (((ob >> 9) & 1) << 5)); }
__host__ __device__ __forceinline__ void stage_rc(int b, int& R, int& C) { const int st = b / 1024, sb = b % 1024, swz = sb ^ (((sb >> 9) & 1) << 5); R = (st >> 1) * 16 + swz / 64; C = (st & 1) * 32 + (swz % 64) / 2; }
__host__ __device__ __forceinline__ int perm32(int rho) { const int n = rho >> 4, i = rho & 15; return 8 * (i >> 2) + 4 * n + (i & 3); }
__device__ __forceinline__ unsigned cvt_pk_bf16(float lo, float hi) { unsigned r; asm volatile("v_cvt_pk_bf16_f32 %0, %1, %2" : "=v"(r) : "v"(lo), "v"(hi)); return r; }
__device__ __forceinline__ unsigned f2bf(float f) { unsigned u = __builtin_bit_cast(unsigned, f); return (u + 0x7fffu + ((u >> 16) & 1u)) >> 16; }
__device__ __forceinline__ unsigned pk2(float lo, float hi) { return f2bf(lo) | (f2bf(hi) << 16); }
__device__ __forceinline__ float bf2f(unsigned short b) { return __builtin_bit_cast(float, ((unsigned)b) << 16); }

__device__ __forceinline__ void glds16s(const void* sbase, unsigned voff, unsigned lds_dst) {
    unsigned keep;
    asm volatile("s_mov_b32 %0, m0\n\ts_mov_b32 m0, %3\n\ts_nop 0\n\tglobal_load_lds_dwordx4 %1, %2\n\ts_mov_b32 m0, %0" : "=&s"(keep) : "v"(voff), "s"(sbase), "s"(lds_dst) : "memory");
}
struct GUnit { const char* A; const char* B; int pm, pn, e; };

struct DenseOrder {
    const char* A; const char* Bt; int nM, nN, nwg, G, c, K;
    __device__ __forceinline__ void init(const bf16_t* A_, const bf16_t* Bt_, int M, int N, int K_, int G_, int c_) { A = (const char*)A_; Bt = (const char*)Bt_; nM = M / BM; nN = N / BM; nwg = nM * nN; G = G_; c = c_; K = K_; }
    __device__ __forceinline__ bool next(int i, GUnit& u) const {
        const long L = (long)i * G + c; if (L >= nwg) return false;
        int wgid = (int)L; { const int q = nwg / NXCD, r = nwg % NXCD, xcd = wgid % NXCD, off = wgid / NXCD; wgid = (xcd < r ? xcd * (q + 1) : r * (q + 1) + (xcd - r) * q) + off; }
        const int nig = WGM * nN, gid = wgid / nig, fm = gid * WGM, gsz = (nM - fm) < WGM ? (nM - fm) : WGM;
        u.pm = fm + ((wgid % nig) % gsz); u.pn = (wgid % nig) / gsz; u.e = 0;
        u.A = A + (size_t)u.pm * BM * K * 2; u.B = Bt + (size_t)u.pn * BM * K * 2; return true;
    }
    __device__ __forceinline__ unsigned aoff(const GUnit&, int row) const { return (unsigned)(row * K * 2); }
};

struct EpiF32 {
    static constexpr bool PERM = false;
    float* C; int ldc; int resid;
    __device__ __forceinline__ void operator()(const f32x4 (&acc)[2][2][4][2], const GUnit& u, int wr, int wc, int fr, int fq) const {
        const int row0 = u.pm * BM + wr * 64 + fr, col0 = u.pn * BM + wc * 32 + 4 * fq;
#pragma unroll
        for (int ai = 0; ai < 2; ++ai)
#pragma unroll
            for (int m = 0; m < 4; ++m) { float* rowp = C + (size_t)(row0 + ai * HALF + m * 16) * ldc + col0;
#pragma unroll
                for (int bj = 0; bj < 2; ++bj)
#pragma unroll
                    for (int n = 0; n < 2; ++n) { f32x4 v = acc[ai][bj][m][n]; if (resid) v += *(const f32x4*)(rowp + bj * HALF + n * 16); *(f32x4*)(rowp + bj * HALF + n * 16) = v; } }
    }
};
struct EpiGlu {
    static constexpr bool PERM = false;
    float* C; const float* Y; int ldc; const float* bias;
    __device__ __forceinline__ void operator()(const f32x4 (&acc)[2][2][4][2], const GUnit& u, int wr, int wc, int fr, int fq) const {
        const int row0 = u.pm * BM + wr * 64 + fr, col0 = u.pn * BM + wc * 32 + 4 * fq;
#pragma unroll
        for (int ai = 0; ai < 2; ++ai)
#pragma unroll
            for (int m = 0; m < 4; ++m) { const size_t ro = (size_t)(row0 + ai * HALF + m * 16) * ldc + col0;
#pragma unroll
                for (int bj = 0; bj < 2; ++bj)
#pragma unroll
                    for (int n = 0; n < 2; ++n) { const f32x4 b = *(const f32x4*)(bias + col0 + bj * HALF + n * 16); const f32x4 y = *(const f32x4*)(Y + ro + bj * HALF + n * 16);
                        f32x4 v = acc[ai][bj][m][n] + b; f32x4 o;
#pragma unroll
                        for (int j = 0; j < 4; ++j) o[j] = y[j] / (1.f + __expf(-v[j]));
                        *(f32x4*)(C + ro + bj * HALF + n * 16) = o; } }
    }
};

template <class Epi, class Sched, bool GATHER, bool ALIGN_EPI>
__device__ __forceinline__ void gemm_phase(LAS unsigned char* lds, const int K, const Sched& S, const Epi& E, const int tid, const int wv) {
    const int wid = wv, lane = tid & 63, wr = wid >> 2, wc = wid & 3, fr = lane & 15, fq = lane >> 4;
    const int nt = K / BK;
    unsigned voffB[2];
#pragma unroll
    for (int i = 0; i < 2; ++i) { int R, C; stage_rc(tid * 16 + i * 8192, R, C); const int Rb = Epi::PERM ? ((R & ~31) + perm32(R & 31)) : R; voffB[i] = (unsigned)(Rb * K + C) * 2u; }
#define PG8_AOFFS(dst, u) do { int t2_ = tid; asm volatile("" : "+v"(t2_)); _Pragma("unroll") for (int i = 0; i < 2; ++i) { int R, C; stage_rc(t2_ * 16 + i * 8192, R, C); \
        _Pragma("unroll") for (int h = 0; h < 2; ++h) dst[h][i] = S.aoff(u, h * HALF + R) + (unsigned)C * 2u; } } while (0)
    const size_t kstep = (size_t)(BK * 2);
    const size_t hstep = (size_t)HALF * K * 2;
    const unsigned ldsw = (unsigned)wid * 1024u;
    const int aoff = lds_byte(wr * 64 + fr, fq * 8), boff = lds_byte(wc * 32 + fr, fq * 8);
#define PG8_SA(b, h) (((b) * 2 + (h)) * HTB)
#define PG8_SB(b, h) ((4 + (b) * 2 + (h)) * HTB)
#define PG8_STAGE(bufoff, gbase, v0, v1) do { const unsigned ld_ = (unsigned)(size_t)(lds + (bufoff) + ldsw); glds16s((gbase), (v0), ld_); glds16s((gbase), (v1), ld_ + 8192u); } while (0)
#define PG8_LDA(dst, b, h) do { _Pragma("unroll") for (int m = 0; m < 4; ++m) _Pragma("unroll") for (int k = 0; k < 2; ++k) dst[m][k] = *(const LAS bf16x8*)(lds + PG8_SA(b, h) + aoff + m * 2048 + k * 1024); } while (0)
#define PG8_LDB(dst, b, h) do { _Pragma("unroll") for (int n = 0; n < 2; ++n) _Pragma("unroll") for (int k = 0; k < 2; ++k) dst[n][k] = *(const LAS bf16x8*)(lds + PG8_SB(b, h) + boff + n * 2048 + k * 1024); } while (0)
#define PG8_MMA(ai, bj, At, Bt) do { __builtin_amdgcn_s_setprio(1); _Pragma("unroll") for (int m = 0; m < 4; ++m) _Pragma("unroll") for (int n = 0; n < 2; ++n) _Pragma("unroll") for (int k = 0; k < 2; ++k) \
        acc[ai][bj][m][n] = __builtin_amdgcn_mfma_f32_16x16x32_bf16(Bt[n][k], At[m][k], acc[ai][bj][m][n], 0, 0, 0); __builtin_amdgcn_s_setprio(0); } while (0)
#define PG8_WAIT_V(n) asm volatile("s_waitcnt vmcnt(" #n ")" ::: "memory")
#define PG8_WAIT_L(n) asm volatile("s_waitcnt lgkmcnt(" #n ")" ::: "memory")
#define PG8_BAR __builtin_amdgcn_s_barrier()
#define PG8_SCHED __builtin_amdgcn_sched_barrier(0)
    GUnit cur, nxt; int ui = 0;
    if (!S.next(0, cur)) return;
    f32x4 acc[2][2][4][2];
#pragma unroll
    for (int a = 0; a < 2; ++a)
#pragma unroll
        for (int b = 0; b < 2; ++b)
#pragma unroll
            for (int m = 0; m < 4; ++m)
#pragma unroll
                for (int n = 0; n < 2; ++n) acc[a][b][m][n] = (f32x4){0.f, 0.f, 0.f, 0.f};
    bf16x8 At[4][2], B0[2][2], B1[2][2];
    unsigned vA[2][2], vN[2][2];
    PG8_AOFFS(vA, cur);
#pragma unroll
    for (int h = 0; h < 2; ++h)
#pragma unroll
        for (int i = 0; i < 2; ++i) vN[h][i] = vA[h][i];
    const char* cA = cur.A; const char* cB = cur.B;
    PG8_STAGE(PG8_SB(0, 0), cB, voffB[0], voffB[1]); PG8_STAGE(PG8_SB(0, 1), cB + hstep, voffB[0], voffB[1]); PG8_STAGE(PG8_SA(0, 0), cA, vA[0][0], vA[0][1]); PG8_STAGE(PG8_SA(0, 1), cA, vA[1][0], vA[1][1]);
    if (wr == 1) PG8_BAR;
    PG8_WAIT_V(2); PG8_BAR;
    PG8_STAGE(PG8_SB(1, 0), cB + kstep, voffB[0], voffB[1]); PG8_STAGE(PG8_SA(1, 0), cA + kstep, vA[0][0], vA[0][1]); PG8_STAGE(PG8_SB(1, 1), cB + hstep + kstep, voffB[0], voffB[1]);
    PG8_WAIT_V(6); PG8_BAR;
    for (;;) {
        const bool has_next = S.next(ui + 1, nxt);
        const char* nA = GATHER ? cA : (has_next ? nxt.A : cA); const char* nB = has_next ? nxt.B : cB;
        if (GATHER) {
            if (has_next) { PG8_AOFFS(vN, nxt); }
            else {
#pragma unroll
                for (int h = 0; h < 2; ++h)
#pragma unroll
                    for (int i = 0; i < 2; ++i) vN[h][i] = vA[h][i];
            }
        }
#define PG8_KBODY(a1, a2, b2, a3, b3, W00, W01, W10, W11) do { \
              \
            PG8_LDB(B0, 0, 0); PG8_LDB(B1, 0, 1); PG8_SCHED; PG8_LDA(At, 0, 0); PG8_STAGE(PG8_SA(1, 1), a1, vA[1][0], vA[1][1]); \
            PG8_WAIT_V(8); PG8_WAIT_L(0); PG8_BAR; PG8_MMA(0, 0, At, B0); PG8_MMA(0, 1, At, B1); PG8_BAR; PG8_SCHED; \
              \
            PG8_LDA(At, 0, 1); PG8_STAGE(PG8_SB(0, 0), b2, voffB[0], voffB[1]); PG8_STAGE(PG8_SB(0, 1), (b2) + hstep, voffB[0], voffB[1]); PG8_STAGE(PG8_SA(0, 0), a2, W00, W01); \
            PG8_WAIT_V(8); PG8_WAIT_L(0); PG8_BAR; PG8_MMA(1, 0, At, B0); PG8_MMA(1, 1, At, B1); PG8_BAR; PG8_SCHED; \
              \
            PG8_LDB(B0, 1, 0); PG8_LDB(B1, 1, 1); PG8_SCHED; PG8_LDA(At, 1, 0); PG8_STAGE(PG8_SA(0, 1), a2, W10, W11); \
            PG8_WAIT_V(8); PG8_WAIT_L(0); PG8_BAR; PG8_MMA(0, 0, At, B0); PG8_MMA(0, 1, At, B1); PG8_BAR; PG8_SCHED; \
              \
            PG8_LDA(At, 1, 1); PG8_STAGE(PG8_SB(1, 0), b3, voffB[0], voffB[1]); PG8_STAGE(PG8_SB(1, 1), (b3) + hstep, voffB[0], voffB[1]); PG8_STAGE(PG8_SA(1, 0), a3, W00, W01); \
            PG8_WAIT_V(8); PG8_WAIT_L(0); PG8_BAR; PG8_MMA(1, 0, At, B0); PG8_MMA(1, 1, At, B1); PG8_BAR; PG8_SCHED; } while (0)
        for (int t = 0; t < nt - 2; t += 2) {
            const char* a1 = cA + (size_t)(t + 1) * kstep;
            const char* a2 = cA + (size_t)(t + 2) * kstep; const char* b2 = cB + (size_t)(t + 2) * kstep;
            const char* a3 = a2 + kstep; const char* b3 = b2 + kstep;
            PG8_KBODY(a1, a2, b2, a3, b3, vA[0][0], vA[0][1], vA[1][0], vA[1][1]);
        }
        {
            const char* a1 = cA + (size_t)(nt - 1) * kstep;
            const char* a3 = nA + kstep; const char* b3 = nB + kstep;
            PG8_KBODY(a1, nA, nB, a3, b3, vN[0][0], vN[0][1], vN[1][0], vN[1][1]);
        }
#undef PG8_KBODY
        if constexpr (ALIGN_EPI) { if (wr == 0) PG8_BAR; }
        { int t3_ = tid; asm volatile("" : "+v"(t3_)); const int l3_ = t3_ & 63; E(acc, cur, wr, wc, l3_ & 15, l3_ >> 4); }
        if (!has_next) break;
#pragma unroll
        for (int a = 0; a < 2; ++a)
#pragma unroll
            for (int b = 0; b < 2; ++b)
#pragma unroll
                for (int m = 0; m < 4; ++m)
#pragma unroll
                    for (int n = 0; n < 2; ++n) acc[a][b][m][n] = (f32x4){0.f, 0.f, 0.f, 0.f};
        cur = nxt; cA = nA; cB = nB; ++ui;
        if (GATHER) {
#pragma unroll
            for (int h = 0; h < 2; ++h)
#pragma unroll
                for (int i = 0; i < 2; ++i) vA[h][i] = vN[h][i];
        }
        if constexpr (ALIGN_EPI) { if (wr == 1) PG8_BAR; }
    }
    PG8_WAIT_V(0);
    if constexpr (!ALIGN_EPI) { if (wr == 0) PG8_BAR; }
    PG8_BAR;
#undef PG8_AOFFS
#undef PG8_SA
#undef PG8_SB
#undef PG8_STAGE
#undef PG8_LDA
#undef PG8_LDB
#undef PG8_MMA
#undef PG8_WAIT_V
#undef PG8_WAIT_L
#undef PG8_BAR
#undef PG8_SCHED
}


constexpr int TS_OFF = 131072 + 1024;
template <bool GATHER> struct MoeOrder {
    const char* A; const char* Bt; const int* rowtok; int nN, nwg, nM, G, c, K; size_t strideE;
    __device__ __forceinline__ void init(const bf16_t* A_, const bf16_t* Bt_, const int* rowtok_, int N, int K_, size_t strideE_, int G_, int c_) {
        A = (const char*)A_; Bt = (const char*)Bt_; rowtok = rowtok_; nN = N / BM; K = K_; strideE = strideE_; G = G_; c = c_;
        nM = ((LAS const int*)(LDSP + TS_OFF))[32]; nwg = nM * nN; }
    __device__ __forceinline__ bool next(int i, GUnit& u) const {
        const long L = (long)i * G + c; if (L >= nwg) return false;
        int wgid = (int)L; { const int q = nwg / NXCD, r = nwg % NXCD, xcd = wgid % NXCD, off = wgid / NXCD; wgid = (xcd < r ? xcd * (q + 1) : r * (q + 1) + (xcd - r) * q) + off; }
        const int nig = WGM * nN, gid = wgid / nig, fm = gid * WGM, gsz = (nM - fm) < WGM ? (nM - fm) : WGM;
        u.pm = fm + ((wgid % nig) % gsz); u.pn = (wgid % nig) / gsz;
        LAS const int* ts = (LAS const int*)(LDSP + TS_OFF);
        int e = 0; while (e < NEXP - 1 && ts[e + 1] <= u.pm) ++e;
        u.e = e;
        u.A = GATHER ? A : A + (size_t)u.pm * BM * K * 2;
        u.B = Bt + (size_t)e * strideE + (size_t)u.pn * BM * K * 2; return true;
    }
    __device__ __forceinline__ unsigned aoff(const GUnit& u, int row) const {
        if (GATHER) return (unsigned)rowtok[u.pm * BM + row] * (unsigned)(K * 2);
        return (unsigned)(row * K * 2);
    }
};
__device__ __forceinline__ void moe_tiles(const unsigned* cnt, int tid) {
    LAS int* ts = (LAS int*)(LDSP + TS_OFF);
    if (tid == 0) { int s = 0; for (int e = 0; e < NEXP; ++e) { ts[e] = s; s += ((int)cnt[e] + BM - 1) / BM; } ts[NEXP] = s; }
    __syncthreads();
}
struct EpiMoe1 {
    static constexpr bool PERM = true;
    bf16_t* O; const float* b1;
    __device__ __forceinline__ void operator()(const f32x4 (&acc)[2][2][4][2], const GUnit& u, int wr, int wc, int fr, int fq) const {
        const int row0 = u.pm * BM + wr * 64 + fr, col0 = u.pn * 128 + wc * 32 + 8 * fq;
        const float* bg = b1 + (size_t)u.e * 2048 + col0;
        f32x4 bgv[2], blv[2];
#pragma unroll
        for (int n = 0; n < 2; ++n) { bgv[n] = *(const f32x4*)(bg + 4 * n); blv[n] = *(const f32x4*)(bg + DFF + 4 * n); }
#pragma unroll
        for (int ai = 0; ai < 2; ++ai)
#pragma unroll
            for (int m = 0; m < 4; ++m) {
                float o[8];
#pragma unroll
                for (int n = 0; n < 2; ++n)
#pragma unroll
                    for (int j = 0; j < 4; ++j) {
                        const float g = fminf(acc[ai][0][m][n][j] + bgv[n][j], 7.f);
                        const float l = fminf(fmaxf(acc[ai][1][m][n][j] + blv[n][j], -7.f), 7.f);
                        o[n * 4 + j] = g / (1.f + __expf(-1.702f * g)) * (l + 1.f);
                    }
                u32x4 w; w.x = cvt_pk_bf16(o[0], o[1]); w.y = cvt_pk_bf16(o[2], o[3]); w.z = cvt_pk_bf16(o[4], o[5]); w.w = cvt_pk_bf16(o[6], o[7]);
                *(u32x4*)(O + (size_t)(row0 + ai * HALF + m * 16) * DFF + col0) = w;
            }
    }
};
struct EpiMoe2 {
    static constexpr bool PERM = true;
    bf16_t* O; const float* b2;
    __device__ __forceinline__ void operator()(const f32x4 (&acc)[2][2][4][2], const GUnit& u, int wr, int wc, int fr, int fq) const {
        const int row0 = u.pm * BM + wr * 64 + fr, col0 = u.pn * BM + wc * 32 + 8 * fq;
        f32x4 bv[2][2];
#pragma unroll
        for (int bj = 0; bj < 2; ++bj)
#pragma unroll
            for (int n = 0; n < 2; ++n) bv[bj][n] = *(const f32x4*)(b2 + (size_t)u.e * DM + col0 + bj * HALF + 4 * n);
#pragma unroll
        for (int ai = 0; ai < 2; ++ai)
#pragma unroll
            for (int m = 0; m < 4; ++m) { bf16_t* rowp = O + (size_t)(row0 + ai * HALF + m * 16) * DM + col0;
#pragma unroll
                for (int bj = 0; bj < 2; ++bj) { const f32x4 v0 = acc[ai][bj][m][0] + bv[bj][0], v1 = acc[ai][bj][m][1] + bv[bj][1];
                    u32x4 w; w.x = cvt_pk_bf16(v0[0], v0[1]); w.y = cvt_pk_bf16(v0[2], v0[3]); w.z = cvt_pk_bf16(v1[0], v1[1]); w.w = cvt_pk_bf16(v1[2], v1[3]);
                    *(u32x4*)(rowp + bj * HALF) = w; } }
    }
};

__device__ __forceinline__ void transpose_item(const float* W, int K, int N, bf16_t* WT, const float* kgain, int mode, LAS float* scr, int item, int lane) {
    const int nblk = N / 32, kb = item / nblk, nb = item % nblk, k0 = 64 * kb, n0 = 32 * nb;
#pragma unroll 8
    for (int i = 0; i < 32; ++i) { const int kk = 2 * i + (lane >> 5); float v = W[(size_t)(k0 + kk) * N + n0 + (lane & 31)]; if (kgain) v *= kgain[k0 + kk]; scr[kk * 33 + (lane & 31)] = v; }
    asm volatile("s_waitcnt lgkmcnt(0)" ::: "memory");
    int d0 = n0;
    if (mode == 1) { const int bj = n0 >> 10, rest = n0 & 1023, pn = rest >> 7, j = rest & 127; d0 = pn * 256 + bj * 128 + j; }
    const int c = lane & 7;
#pragma unroll
    for (int j = 0; j < 4; ++j) { const int n = (lane >> 3) + 8 * j; const LAS float* sp = scr + (8 * c) * 33 + n;
        u32x4 o; o.x = pk2(sp[0 * 33], sp[1 * 33]); o.y = pk2(sp[2 * 33], sp[3 * 33]); o.z = pk2(sp[4 * 33], sp[5 * 33]); o.w = pk2(sp[6 * 33], sp[7 * 33]);
        *(u32x4*)(WT + (size_t)(d0 + n) * K + k0 + 8 * c) = o; }
    asm volatile("s_waitcnt lgkmcnt(0)" ::: "memory");
}
__device__ __forceinline__ void p_transpose(const int wv, const float* W, int K, int N, bf16_t* WT, const float* kgain, int mode, LAS unsigned char* lds) {
    LTID();
    const int wave = tidx >> 6, lane = tidx & 63;
    LAS float* scr = (LAS float*)(lds + wave * 16384);
    const int nitems = (K / 64) * (N / 32);
    for (int it = bidx * NW + wave; it < nitems; it += gridDim.x * NW) transpose_item(W, K, N, WT, kgain, mode, scr, it, lane);
}


typedef short v4i16_t __attribute__((ext_vector_type(4)));
constexpr int ATT_TAB_OFF = 131072 + 2048;
constexpr int ATT_UNITS = 3 * 8 * 128;
__device__ __forceinline__ int t5_bucket_dev(int n) {
    if (n < 16) return n;
    const float v = logf((float)n / 16.f) / 4.852030263919617f * 16.f;
    const int large = 16 + (int)v;
    return large < 31 ? large : 31;
}
__device__ __forceinline__ void p_bias_table(const int wv, const float* rel_bias, float* biasG) {
    LTID();
    for (int i = bidx * NT + tidx; i < 3 * 8 * 132; i += gridDim.x * NT) {
        const int d = i % 132, bh = i / 132, h = bh & 7, b = bh >> 3;
        biasG[i] = (d <= 128) ? rel_bias[t5_bucket_dev(d << (2 * b)) * 8 + h] : 0.f;
    }
}
__device__ __forceinline__ void p_dil_attn(const int wv, const bf16_t* proj16, const float* biasG, bf16_t* obr, float* lse, LAS unsigned char* lds) {
    LTID();
    const int lane = tidx & 63, fr = lane & 15, fq = lane >> 4, w = wv;
    const int per = (ATT_UNITS + (int)gridDim.x - 1) / (int)gridDim.x;
    const int u0 = bidx * per, u1 = (u0 + per < ATT_UNITS) ? u0 + per : ATT_UNITS;
    if (u0 >= u1) return;
    const int rowl = tidx >> 3, cs = tidx & 7;
    const unsigned cK = (unsigned)(cs ^ ((rowl >> 1) & 7)) * 16u, cV = (unsigned)(cs ^ (rowl & 7)) * 16u;
    const unsigned fK = (unsigned)((fr >> 1) & 7);
    const unsigned kro0 = (unsigned)fr * 128u + (((unsigned)fq ^ fK) * 16u), kro1 = (unsigned)fr * 128u + ((((unsigned)fq ^ fK) ^ 4u) * 16u);
    const int tq = (lane & 15) >> 2, tp = lane & 3, fv = 4 * (fq & 1) + tq;
    unsigned vro[4];
#pragma unroll
    for (int db = 0; db < 4; ++db) vro[db] = (unsigned)(4 * fq + tq) * 128u + (unsigned)(((2 * db + (tp >> 1)) ^ fv) * 16) + 8u * (unsigned)(tp & 1);
    const int ts_ = (1 + fr) & 3;
    const unsigned tab8 = (unsigned)ATT_TAB_OFF + (unsigned)ts_ * 640u + (unsigned)(((141 + fr - ts_) >> 2) - fq - 32) * 16u;
    const char* gbase = (const char*)proj16;
#define ATT_DECODE(u, b_, h_, r_, n_, dil_) const int cmb_ = (u) >> 7, b_ = cmb_ >> 3, h_ = cmb_ & 7, dil_ = 1 << (2 * b_), idx_ = (u) & 127, r_ = idx_ & (dil_ - 1), n_ = idx_ >> (2 * b_)
#define ATT_ISSUE(u, bf, q0, q1) do { ATT_DECODE(u, b__, h__, r__, n__, dil__); \
        const int nk = n__ > 0 ? n__ - 1 : 0;                                     \
        _Pragma("unroll") for (int p = 0; p < 4; ++p) { \
            int row = 64 * p + rowl; int blk = (row >> 7) ? n__ : nk; \
            const unsigned pos = (unsigned)(r__ + dil__ * (128 * blk + (row & 127))); \
            const unsigned so = pos * 4096u + (unsigned)h__ * 128u; const unsigned ld_ = (unsigned)(size_t)(lds + (bf) * 65536 + p * 8192 + w * 1024); \
            glds16s(gbase, so + 1024u + cK, ld_); glds16s(gbase, so + 2048u + cV, ld_ + 32768u); } \
        const unsigned qpos = (unsigned)(r__ + dil__ * (128 * n__ + 16 * w + fr)); \
        const char* qsrc = gbase + (size_t)qpos * 4096u + (unsigned)h__ * 128u + (unsigned)fq * 16u; \
        q0 = *(const bf16x8*)(qsrc); q1 = *(const bf16x8*)(qsrc + 64); } while (0)
    bf16x8 qf0, qf1, qn0, qn1;
    ATT_ISSUE(u0, 0, qn0, qn1);
    int prev_cmb = -1;
    for (int u = u0; u < u1; ++u) {
        const int bf = (u - u0) & 1;
        asm volatile("s_waitcnt vmcnt(0)" ::: "memory");
        __syncthreads();
        qf0 = qn0; qf1 = qn1;
        if (u + 1 < u1) ATT_ISSUE(u + 1, bf ^ 1, qn0, qn1);
        ATT_DECODE(u, b, h, r, n, dil);
        if (cmb_ != prev_cmb) {
            prev_cmb = cmb_;
            for (int e = tidx; e < 4 * 160; e += NT) { const int sft = e / 160, k = e - sft * 160, idx = k + sft, dist = idx - 16;
                const float v = (dist >= 0 && dist <= 128) ? biasG[cmb_ * 132 + dist] : -1e30f;
                ((LAS float*)(lds + ATT_TAB_OFF))[sft * 160 + k] = v; }
            __syncthreads();
        }
        const LAS unsigned char* Kb = lds + bf * 65536; const LAS unsigned char* Vb = Kb + 32768;
        const int kb0 = w;
        f32x4 sc[9];
#pragma unroll
        for (int i = 0; i < 9; ++i) {
            const unsigned ko = (unsigned)(kb0 + i) * 2048u;
            const bf16x8 k0 = *(const LAS bf16x8*)(Kb + ko + kro0), k1 = *(const LAS bf16x8*)(Kb + ko + kro1);
            f32x4 a = (f32x4){0.f, 0.f, 0.f, 0.f};
            a = __builtin_amdgcn_mfma_f32_16x16x32_bf16(k0, qf0, a, 0, 0, 0);
            a = __builtin_amdgcn_mfma_f32_16x16x32_bf16(k1, qf1, a, 0, 0, 0);
            const f32x4 t = *(const LAS f32x4*)(lds + tab8 + 64 * (8 - i));
            a = a + (f32x4){t[3], t[2], t[1], t[0]};
            if (n == 0 && kb0 + i < 8) a = (f32x4){-1e30f, -1e30f, -1e30f, -1e30f};
            sc[i] = a;
        }
        float mx = -1e30f;
#pragma unroll
        for (int i = 0; i < 9; ++i) mx = fmaxf(mx, fmaxf(fmaxf(sc[i][0], sc[i][1]), fmaxf(sc[i][2], sc[i][3])));
        mx = fmaxf(mx, shx(mx, 16, lane)); mx = fmaxf(mx, shx(mx, 32, lane));
        float sum = 0.f;
#pragma unroll
        for (int i = 0; i < 9; ++i)
#pragma unroll
            for (int j = 0; j < 4; ++j) { const float p = __expf(sc[i][j] - mx); sc[i][j] = p; sum += p; }
        sum += shx(sum, 16, lane); sum += shx(sum, 32, lane);
        f32x4 oacc[4];
#pragma unroll
        for (int db = 0; db < 4; ++db) oacc[db] = (f32x4){0.f, 0.f, 0.f, 0.f};
#pragma unroll
        for (int c = 0; c < 5; ++c) {
            const int ia = 2 * c, ib = (c < 4) ? 2 * c + 1 : 8;
            u32x4 pw; pw.x = cvt_pk_bf16(sc[ia][0], sc[ia][1]); pw.y = cvt_pk_bf16(sc[ia][2], sc[ia][3]);
            if (c < 4) { pw.z = cvt_pk_bf16(sc[ib][0], sc[ib][1]); pw.w = cvt_pk_bf16(sc[ib][2], sc[ib][3]); } else { pw.z = 0u; pw.w = 0u; }
            const bf16x8 pf = __builtin_bit_cast(bf16x8, pw);
            const unsigned va = (unsigned)(kb0 + ia) * 2048u, vb = (unsigned)(kb0 + ib) * 2048u;
#pragma unroll
            for (int db = 0; db < 4; ++db) {
                const v4i16_t x0 = __builtin_amdgcn_ds_read_tr16_b64_v4i16((LAS v4i16_t*)(Vb + va + vro[db]));
                const v4i16_t x1 = __builtin_amdgcn_ds_read_tr16_b64_v4i16((LAS v4i16_t*)(Vb + vb + vro[db]));
                const bf16x8 vf = (bf16x8){x0[0], x0[1], x0[2], x0[3], x1[0], x1[1], x1[2], x1[3]};
                oacc[db] = __builtin_amdgcn_mfma_f32_16x16x32_bf16(vf, pf, oacc[db], 0, 0, 0);
            }
        }
        const float inv = 1.f / sum;
        const unsigned qpos = (unsigned)(r + dil * (128 * n + 16 * w + fr));
        bf16_t* orow = obr + ((size_t)b * SEQ + qpos) * 512 + h * 64 + 4 * fq;
#pragma unroll
        for (int db = 0; db < 4; ++db) { u32x2 o2; o2.x = cvt_pk_bf16(oacc[db][0] * inv, oacc[db][1] * inv); o2.y = cvt_pk_bf16(oacc[db][2] * inv, oacc[db][3] * inv); *(u32x2*)(orow + 16 * db) = o2; }
        if (fq == 0) lse[((size_t)b * SEQ + qpos) * 8 + h] = mx + __logf(sum);
    }
    asm volatile("s_waitcnt vmcnt(0)" ::: "memory");
    __syncthreads();
#undef ATT_DECODE
#undef ATT_ISSUE
}
__device__ __forceinline__ void p_attn_combine(const int wv, const bf16_t* obr, const float* lse, const float* g, bf16_t* mix16) {
    LTID();
    const int lane = tidx & 63, h = lane >> 3;
    f32x4 g0 = *(const f32x4*)(g + lane * 8), g1 = *(const f32x4*)(g + lane * 8 + 4);
    for (int row = bidx * NW + wv; row < SEQ; row += gridDim.x * NW) {
        float l0 = lse[((size_t)0 * SEQ + row) * 8 + h], l1 = lse[((size_t)1 * SEQ + row) * 8 + h], l2 = lse[((size_t)2 * SEQ + row) * 8 + h];
        const float M = fmaxf(l0, fmaxf(l1, l2));
        float w0 = __expf(l0 - M), w1 = __expf(l1 - M), w2 = __expf(l2 - M);
        const float iw = 1.f / (w0 + w1 + w2); w0 *= iw; w1 *= iw; w2 *= iw;
        const u32x4 a0 = *(const u32x4*)(obr + ((size_t)0 * SEQ + row) * 512 + lane * 8);
        const u32x4 a1 = *(const u32x4*)(obr + ((size_t)1 * SEQ + row) * 512 + lane * 8);
        const u32x4 a2 = *(const u32x4*)(obr + ((size_t)2 * SEQ + row) * 512 + lane * 8);
        float y[8]; float ss = 0.f;
#pragma unroll
        for (int k = 0; k < 4; ++k) {
            const float lo = w0 * __builtin_bit_cast(float, a0[k] << 16) + w1 * __builtin_bit_cast(float, a1[k] << 16) + w2 * __builtin_bit_cast(float, a2[k] << 16);
            const float hi = w0 * __builtin_bit_cast(float, a0[k] & 0xffff0000u) + w1 * __builtin_bit_cast(float, a1[k] & 0xffff0000u) + w2 * __builtin_bit_cast(float, a2[k] & 0xffff0000u);
            y[2 * k] = lo; y[2 * k + 1] = hi; ss += lo * lo + hi * hi;
        }
#pragma unroll
        for (int o = 32; o; o >>= 1) ss += shx(ss, o, lane);
        const float sc = rsqrtf(ss * (1.f / 512.f) + 1e-5f);
        u32x4 o4; o4.x = cvt_pk_bf16(y[0] * sc * g0[0], y[1] * sc * g0[1]); o4.y = cvt_pk_bf16(y[2] * sc * g0[2], y[3] * sc * g0[3]);
        o4.z = cvt_pk_bf16(y[4] * sc * g1[0], y[5] * sc * g1[1]); o4.w = cvt_pk_bf16(y[6] * sc * g1[2], y[7] * sc * g1[3]);
        *(u32x4*)(mix16 + (size_t)row * DM + lane * 8) = o4;
    }
}
struct EpiIn {
    static constexpr bool PERM = true;
    bf16_t* O; float* Uf;
    __device__ __forceinline__ void operator()(const f32x4 (&acc)[2][2][4][2], const GUnit& u, int wr, int wc, int fr, int fq) const {
        const int row0 = u.pm * BM + wr * 64 + fr, col0 = u.pn * BM + wc * 32 + 8 * fq;
        const float sc = u.pn < 2 ? 0.125f : 1.f;
#pragma unroll
        for (int ai = 0; ai < 2; ++ai)
#pragma unroll
            for (int m = 0; m < 4; ++m) { const size_t ro = (size_t)(row0 + ai * HALF + m * 16) * DIN + col0;
#pragma unroll
                for (int bj = 0; bj < 2; ++bj) { const f32x4 v0 = acc[ai][bj][m][0] * sc, v1 = acc[ai][bj][m][1] * sc;
                    u32x4 w; w.x = cvt_pk_bf16(v0[0], v0[1]); w.y = cvt_pk_bf16(v0[2], v0[3]); w.z = cvt_pk_bf16(v1[0], v1[1]); w.w = cvt_pk_bf16(v1[2], v1[3]);
                    *(u32x4*)(O + ro + bj * HALF) = w;
                    } }
    }
};


__device__ __forceinline__ unsigned xoff_b(unsigned row, unsigned ch) { return 256u * row + 16u * (ch ^ (((row & 3u) << 2) | ((row >> 2) & 3u))); }
__device__ __forceinline__ void p_xattn_mfma(const int wv, const bf16_t* qx16, const bf16_t* kv16, bf16_t* ox16, LAS unsigned char* lds) {
    LTID();
    const int lane = tidx & 63, fr = lane & 15, fq = lane >> 4, w = wv;
    const int NU = 4 * 128;
    const int per = (NU + (int)gridDim.x - 1) / (int)gridDim.x;
    const int u0 = bidx * per, u1 = (u0 + per < NU) ? u0 + per : NU;
    if (u0 >= u1) return;
    const int rowl = tidx >> 4, cs = tidx & 15;
    const unsigned csw = (unsigned)(cs ^ (((rowl & 3) << 2) | ((rowl >> 2) & 3))) * 16u;
    const unsigned kswz = (unsigned)(((fr & 3) << 2) | ((fr >> 2) & 3));
    unsigned kro[4];
#pragma unroll
    for (int s4 = 0; s4 < 4; ++s4) kro[s4] = 256u * (unsigned)fr + 16u * ((unsigned)(4 * s4 + fq) ^ kswz);
    const int tq = (lane & 15) >> 2, tp = lane & 3;
    const unsigned vswz = (unsigned)((tq << 2) | fq);
    unsigned vro[8];
#pragma unroll
    for (int c = 0; c < 8; ++c) vro[c] = 65536u + 256u * (unsigned)(4 * fq + tq) + 16u * ((unsigned)(2 * c + (tp >> 1)) ^ vswz) + 8u * (unsigned)(tp & 1);
    int prev_h = -1;
    for (int u = u0; u < u1; ++u) {
        const int h = u >> 7, qt = u & 127;
        if (h != prev_h) {
            __syncthreads();
            prev_h = h;
#pragma unroll
            for (int p = 0; p < 8; ++p) {
                const unsigned row = (unsigned)(32 * p + rowl);
                const unsigned so = row * 2048u + (unsigned)h * 256u + csw;
                const unsigned ld_ = (unsigned)(size_t)(lds + p * 8192 + w * 1024);
                glds16s(kv16, so, ld_); glds16s(kv16, so + 1024u, ld_ + 65536u);
            }
            asm volatile("s_waitcnt vmcnt(0)" ::: "memory");
            __syncthreads();
        }
        const char* qsrc = (const char*)qx16 + ((size_t)(qt * 128 + 16 * w + fr) * 512 + h * 128 + 8 * fq) * 2;
        bf16x8 qf[4];
#pragma unroll
        for (int s4 = 0; s4 < 4; ++s4) qf[s4] = *(const bf16x8*)(qsrc + 64 * s4);
        f32x4 sc[16];
#pragma unroll
        for (int i = 0; i < 16; ++i) {
            f32x4 a = (f32x4){0.f, 0.f, 0.f, 0.f};
#pragma unroll
            for (int s4 = 0; s4 < 4; ++s4) { const bf16x8 kf = *(const LAS bf16x8*)(lds + i * 4096 + kro[s4]); a = __builtin_amdgcn_mfma_f32_16x16x32_bf16(kf, qf[s4], a, 0, 0, 0); }
            sc[i] = a;
        }
        float mx = -1e30f;
#pragma unroll
        for (int i = 0; i < 16; ++i) mx = fmaxf(mx, fmaxf(fmaxf(sc[i][0], sc[i][1]), fmaxf(sc[i][2], sc[i][3])));
        mx = fmaxf(mx, shx(mx, 16, lane)); mx = fmaxf(mx, shx(mx, 32, lane));
        float sum = 0.f;
#pragma unroll
        for (int i = 0; i < 16; ++i)
#pragma unroll
            for (int j = 0; j < 4; ++j) { const float p = __expf(sc[i][j] - mx); sc[i][j] = p; sum += p; }
        sum += shx(sum, 16, lane); sum += shx(sum, 32, lane);
        f32x4 oacc[8];
#pragma unroll
        for (int c = 0; c < 8; ++c) oacc[c] = (f32x4){0.f, 0.f, 0.f, 0.f};
#pragma unroll
        for (int ch = 0; ch < 8; ++ch) {
            const int ia = 2 * ch, ib = 2 * ch + 1;
            u32x4 pw; pw.x = cvt_pk_bf16(sc[ia][0], sc[ia][1]); pw.y = cvt_pk_bf16(sc[ia][2], sc[ia][3]); pw.z = cvt_pk_bf16(sc[ib][0], sc[ib][1]); pw.w = cvt_pk_bf16(sc[ib][2], sc[ib][3]);
            const bf16x8 pf = __builtin_bit_cast(bf16x8, pw);
#pragma unroll
            for (int c = 0; c < 8; ++c) {
                const v4i16_t x0 = __builtin_amdgcn_ds_read_tr16_b64_v4i16((LAS v4i16_t*)(lds + ia * 4096 + vro[c]));
                const v4i16_t x1 = __builtin_amdgcn_ds_read_tr16_b64_v4i16((LAS v4i16_t*)(lds + ib * 4096 + vro[c]));
                const bf16x8 vf = (bf16x8){x0[0], x0[1], x0[2], x0[3], x1[0], x1[1], x1[2], x1[3]};
                oacc[c] = __builtin_amdgcn_mfma_f32_16x16x32_bf16(vf, pf, oacc[c], 0, 0, 0);
            }
        }
        const float inv = 1.f / sum;
        bf16_t* orow = ox16 + (size_t)(qt * 128 + 16 * w + fr) * 512 + h * 128 + 4 * fq;
#pragma unroll
        for (int c = 0; c < 8; ++c) { u32x2 o2; o2.x = cvt_pk_bf16(oacc[c][0] * inv, oacc[c][1] * inv); o2.y = cvt_pk_bf16(oacc[c][2] * inv, oacc[c][3] * inv); *(u32x2*)(orow + 16 * c) = o2; }
    }
    __syncthreads();
}
struct EpiBf16 {
    static constexpr bool PERM = true;
    bf16_t* O; int ldc; float scale;
    __device__ __forceinline__ void operator()(const f32x4 (&acc)[2][2][4][2], const GUnit& u, int wr, int wc, int fr, int fq) const {
        const int row0 = u.pm * BM + wr * 64 + fr, col0 = u.pn * BM + wc * 32 + 8 * fq;
#pragma unroll
        for (int ai = 0; ai < 2; ++ai)
#pragma unroll
            for (int m = 0; m < 4; ++m) { bf16_t* rowp = O + (size_t)(row0 + ai * HALF + m * 16) * ldc + col0;
#pragma unroll
                for (int bj = 0; bj < 2; ++bj) { const f32x4 v0 = acc[ai][bj][m][0] * scale, v1 = acc[ai][bj][m][1] * scale;
                    u32x4 w; w.x = cvt_pk_bf16(v0[0], v0[1]); w.y = cvt_pk_bf16(v0[2], v0[3]); w.z = cvt_pk_bf16(v1[0], v1[1]); w.w = cvt_pk_bf16(v1[2], v1[3]);
                    *(u32x4*)(rowp + bj * HALF) = w; } }
    }
};


typedef short bf16x4 __attribute__((ext_vector_type(4)));
typedef float f32x2 __attribute__((ext_vector_type(2)));
constexpr int S5_CHUNK = 256, S5_NCH = SEQ / S5_CHUNK, S5_ROWB = 528;
__device__ __forceinline__ f32x2 gelu_pk(f32x2 v) {
    const f32x2 av = __builtin_elementwise_abs(v), d = av * 0.2316418882f + 1.0f;
    f32x2 t; t.x = __builtin_amdgcn_rcpf(d.x); t.y = __builtin_amdgcn_rcpf(d.y);
    f32x2 q = t * 0.5307027145f + (-0.7265760135f); q = q * t + 0.7107068705f; q = q * t + (-0.142248368f); q = q * t + 0.127414796f; q = q * t;
    const f32x2 s2 = (v * v) * (-0.72134752044f);
    f32x2 e; e.x = __builtin_amdgcn_exp2f(s2.x); e.y = __builtin_amdgcn_exp2f(s2.y);
    const f32x2 m = v * (q * e), r = v - m;
    f32x2 o; o.x = v.x < 0.f ? m.x : r.x; o.y = v.y < 0.f ? m.y : r.y; return o;
}
__device__ __forceinline__ void p_s5_tables2(const int wv, const float* a_re, const float* a_im, const float* b_re, const float* b_im, const float* c_re, const float* c_im, const float* log_dt,
                                             float2* abar, float2* a256, bf16_t* BB16, bf16_t* CM16) {
    LTID();
    for (int gp = bidx * NT + tidx; gp < 2048; gp += gridDim.x * NT) {
        const int g = gp >> 6, p = gp & 63;
        const float lr = a_re[gp], li = a_im[gp], dt = expf(log_dt[g]);
        const float mag = expf(lr * dt); float sn, cs; sincosf(li * dt, &sn, &cs);
        const float ar = mag * cs, ai = mag * sn;
        abar[gp] = make_float2(ar, ai);
        float pr = ar, pi = ai;
        for (int i = 0; i < 8; ++i) { const float nr = pr * pr - pi * pi, ni = 2.f * pr * pi; pr = nr; pi = ni; }
        a256[gp] = make_float2(pr, pi);
        const float nr = ar - 1.f, ni = ai, den = lr * lr + li * li;
        const float cr = (nr * lr + ni * li) / den, ci = (ni * lr - nr * li) / den;
        for (int c = 0; c < 16; ++c) {
            const float br = b_re[gp * 16 + c], bi = b_im[gp * 16 + c];
            BB16[((size_t)g * 128 + p) * 16 + c] = (bf16_t)f2bf(cr * br - ci * bi);
            BB16[((size_t)g * 128 + 64 + p) * 16 + c] = (bf16_t)f2bf(cr * bi + ci * br);
            CM16[((size_t)g * 16 + c) * 128 + p] = (bf16_t)f2bf(c_re[(g * 16 + c) * 64 + p]);
            CM16[((size_t)g * 16 + c) * 128 + 64 + p] = (bf16_t)f2bf(-c_im[(g * 16 + c) * 64 + p]);
        }
    }
}
template <int MODE> __device__ __forceinline__ void p_s5_pass(const int wv, const bf16_t* proj16, const float2* abar, const float2* a256, const bf16_t* BB16, const bf16_t* CM16, const float* dskip,
                                                              float2* E, bf16_t* yg16, LAS unsigned char* lds) {
    LTID();
    const int lane = tidx & 63, fr = lane & 15, fq = lane >> 4;
    LAS unsigned char* L = lds + wv * (16 * S5_ROWB);
    for (int unit = bidx * NW + wv; unit < S5_NCH * 32; unit += gridDim.x * NW) {
        const int g = unit & 31, chunk = unit >> 5;
        const float2 a = abar[g * 64 + lane];
        bf16x4 bbf[8];
#pragma unroll
        for (int cb = 0; cb < 8; ++cb) bbf[cb] = *(const bf16x4*)(BB16 + ((size_t)g * 128 + 16 * cb + fr) * 16 + 4 * fq);
        bf16x8 cmf[4]; f32x4 dsk = (f32x4){0.f, 0.f, 0.f, 0.f};
        if (MODE == 1) {
#pragma unroll
            for (int s4 = 0; s4 < 4; ++s4) cmf[s4] = *(const bf16x8*)(CM16 + ((size_t)g * 16 + fr) * 128 + 32 * s4 + 8 * fq);
            dsk = *(const f32x4*)(dskip + g * 16 + 4 * fq);
        }
        float sr = 0.f, si = 0.f;
        if (MODE == 1) {
            const float2 A = a256[g * 64 + lane];
            for (int j0 = 0; j0 < chunk; j0 += 8) {
                float2 e[8];
#pragma unroll
                for (int k = 0; k < 8; ++k) { const int j = (j0 + k < chunk) ? j0 + k : chunk - 1; e[k] = E[((size_t)j * 32 + g) * 64 + lane]; }
#pragma unroll
                for (int k = 0; k < 8; ++k) if (j0 + k < chunk) { const float nr = A.x * sr - A.y * si + e[k].x, ni = A.x * si + A.y * sr + e[k].y; sr = nr; si = ni; }
            }
        }
        const bf16_t* ubase = proj16 + (size_t)(chunk * S5_CHUNK + fr) * DIN + 1536 + g * 16 + 4 * fq;
        bf16x4 uf = *(const bf16x4*)ubase;
#pragma unroll 1
        for (int blk = 0; blk < S5_CHUNK / 16; ++blk) {
            const bf16x4 ufn = *(const bf16x4*)(ubase + (size_t)((blk < S5_CHUNK / 16 - 1) ? (blk + 1) * 16 : blk * 16) * DIN);
            asm volatile("" ::: "memory");
#pragma unroll
            for (int cb = 0; cb < 8; ++cb) {
                const f32x4 d = __builtin_amdgcn_mfma_f32_16x16x16bf16_1k(bbf[cb], uf, (f32x4){0.f, 0.f, 0.f, 0.f}, 0, 0, 0);
                *(LAS f32x4*)(L + fr * S5_ROWB + (16 * cb + 4 * fq) * 4) = d;
            }
            asm volatile("" ::: "memory");
#pragma unroll
            for (int t = 0; t < 16; ++t) {
                const float re = *(const LAS float*)(L + t * S5_ROWB + lane * 4), im = *(const LAS float*)(L + t * S5_ROWB + 256 + lane * 4);
                const float nr = a.x * sr - a.y * si + re, ni = a.x * si + a.y * sr + im; sr = nr; si = ni;
                if (MODE == 1) { *(LAS bf16_t*)(L + t * S5_ROWB + lane * 2) = (bf16_t)f2bf(sr); *(LAS bf16_t*)(L + t * S5_ROWB + 128 + lane * 2) = (bf16_t)f2bf(si); }
            }
            asm volatile("" ::: "memory");
            if (MODE == 1) {
                f32x4 y = (f32x4){0.f, 0.f, 0.f, 0.f};
#pragma unroll
                for (int s4 = 0; s4 < 4; ++s4) { const bf16x8 sf = *(const LAS bf16x8*)(L + fr * S5_ROWB + 64 * s4 + 16 * fq); y = __builtin_amdgcn_mfma_f32_16x16x32_bf16(cmf[s4], sf, y, 0, 0, 0); }
                f32x4 v;
#pragma unroll
                for (int j = 0; j < 4; ++j) v[j] = y[j] + dsk[j] * bf2f((unsigned short)uf[j]);
                const f32x2 g0 = gelu_pk((f32x2){v[0], v[1]}), g1 = gelu_pk((f32x2){v[2], v[3]});
                u32x2 o2; o2.x = cvt_pk_bf16(g0.x, g0.y); o2.y = cvt_pk_bf16(g1.x, g1.y);
                *(u32x2*)(yg16 + (size_t)(chunk * S5_CHUNK + blk * 16 + fr) * 512 + g * 16 + 4 * fq) = o2;
            }
            asm volatile("" ::: "memory");
            uf = ufn;
        }
        if (MODE == 0) E[((size_t)chunk * 32 + g) * 64 + lane] = make_float2(sr, si);
    }
}
struct EpiGlu16 {
    static constexpr bool PERM = true;
    bf16_t* O; const bf16_t* Y; const float* bias;
    __device__ __forceinline__ void operator()(const f32x4 (&acc)[2][2][4][2], const GUnit& u, int wr, int wc, int fr, int fq) const {
        const int row0 = u.pm * BM + wr * 64 + fr, col0 = u.pn * BM + wc * 32 + 8 * fq;
        f32x4 bv[2][2];
#pragma unroll
        for (int bj = 0; bj < 2; ++bj)
#pragma unroll
            for (int n = 0; n < 2; ++n) bv[bj][n] = *(const f32x4*)(bias + col0 + bj * HALF + 4 * n);
#pragma unroll
        for (int ai = 0; ai < 2; ++ai)
#pragma unroll
            for (int m = 0; m < 4; ++m) { const size_t ro = (size_t)(row0 + ai * HALF + m * 16) * 512 + col0;
#pragma unroll
                for (int bj = 0; bj < 2; ++bj) {
                    const u32x4 yv = *(const u32x4*)(Y + ro + bj * HALF);
                    float o[8];
#pragma unroll
                    for (int n = 0; n < 2; ++n)
#pragma unroll
                        for (int j = 0; j < 4; ++j) { const unsigned wd = yv[n * 2 + (j >> 1)]; const float y = __builtin_bit_cast(float, (j & 1) ? (wd & 0xffff0000u) : (wd << 16));
                            o[n * 4 + j] = y / (1.f + __expf(-(acc[ai][bj][m][n][j] + bv[bj][n][j]))); }
                    u32x4 w; w.x = cvt_pk_bf16(o[0], o[1]); w.y = cvt_pk_bf16(o[2], o[3]); w.z = cvt_pk_bf16(o[4], o[5]); w.w = cvt_pk_bf16(o[6], o[7]);
                    *(u32x4*)(O + ro + bj * HALF) = w; } }
    }
};
__device__ __forceinline__ void p_ssm_norm(const int wv, const bf16_t* yb16, const float* g, bf16_t* mix16) {
    LTID();
    const int lane = tidx & 63;
    const f32x4 g0 = *(const f32x4*)(g + lane * 8), g1 = *(const f32x4*)(g + lane * 8 + 4);
    for (int row = bidx * NW + wv; row < SEQ; row += gridDim.x * NW) {
        const u32x4 a0 = *(const u32x4*)(yb16 + (size_t)row * 512 + lane * 8);
        float y[8]; float ss = 0.f;
#pragma unroll
        for (int k = 0; k < 4; ++k) { y[2 * k] = __builtin_bit_cast(float, a0[k] << 16); y[2 * k + 1] = __builtin_bit_cast(float, a0[k] & 0xffff0000u); ss += y[2 * k] * y[2 * k] + y[2 * k + 1] * y[2 * k + 1]; }
#pragma unroll
        for (int o = 32; o; o >>= 1) ss += shx(ss, o, lane);
        const float sc = rsqrtf(ss * (1.f / 512.f) + 1e-5f);
        u32x4 o4; o4.x = cvt_pk_bf16(y[0] * sc * g0[0], y[1] * sc * g0[1]); o4.y = cvt_pk_bf16(y[2] * sc * g0[2], y[3] * sc * g0[3]);
        o4.z = cvt_pk_bf16(y[4] * sc * g1[0], y[5] * sc * g1[1]); o4.w = cvt_pk_bf16(y[6] * sc * g1[2], y[7] * sc * g1[3]);
        *(u32x4*)(mix16 + (size_t)row * DM + 512 + lane * 8) = o4;
    }
}

__device__ __forceinline__ void p_rmsnorm(const int wv, const float* in, int in_ld, const float* g, float* out, int out_ld, int rows, int D, bf16_t* out16 = nullptr) {
    LTID();
    const int lane = tidx & 63, wave = tidx >> 6;
    for (int r = bidx * NW + wave; r < rows; r += gridDim.x * NW) {
        const float* p = in + (size_t)r * in_ld;
        float ss = 0.f;
        for (int i = lane; i < D; i += 64) { float v = p[i]; ss += v * v; }
        for (int o = 32; o; o >>= 1) ss += shx(ss, o, lane);
        const float sc = rsqrtf(ss / (float)D + 1e-5f);
        if (out16) { for (int i = lane; i < D; i += 64) out16[(size_t)r * out_ld + i] = (bf16_t)f2bf(p[i] * sc * g[i]); }
        if (out) { for (int i = lane; i < D; i += 64) out[(size_t)r * out_ld + i] = p[i] * sc * g[i]; }
    }
}
__device__ __forceinline__ void p_copy4(const int wv, const float* src, float* dst, size_t n4) {
    LTID();
    for (size_t i = (size_t)bidx * NT + tidx; i < n4; i += (size_t)gridDim.x * NT) ((float4*)dst)[i] = ((const float4*)src)[i];
}

enum { EP_STORE = 0, EP_RESID = 1, EP_GLU = 2, EP_MOE1 = 3, EP_MOE2 = 4 };
struct GArgs {
    const float* A; int lda; const float* B; int ldb; float* C; int ldc; int M, N, K;
    const float* bias; const float* aux;
    const int* rowtok; const int* offs; const unsigned* cnts;
    size_t strideB; int strideBias; int nexp;
};
template <int EP> __device__ __forceinline__ void p_gemm(const int wv, const GArgs& a, LAS unsigned char* lds) {
    LTID();
    LAS float* As = (LAS float*)lds;
    LAS float* Bs = As + 16 * 132;
    LAS float* Bs2 = Bs + 16 * 68;
    const int tid = tidx, ty = tid >> 4, tx = tid & 15;
    const int lr = tid >> 2, lk = (tid & 3) * 4;
    const int bsel = tid >> 8, bt = tid & 255, bk = bt >> 4, bn = (bt & 15) * 4;
    const int nN = a.N / 64;
    const int mt_max = (a.M + 127) / 128;
    const int per_e = mt_max * nN;
    const int total = per_e * a.nexp;
    for (int t = bidx; t < total; t += gridDim.x) {
        const int e = t / per_e, r = t - e * per_e, mt = r / nN, nt = r - mt * nN;
        int M = a.M, rowbase = 0;
        if (EP == EP_MOE1 || EP == EP_MOE2) { M = (int)a.cnts[e]; rowbase = a.offs[e]; }
        const int m0 = mt * 128, n0 = nt * 64;
        if (m0 >= M) continue;
        const float* B = a.B + (size_t)e * a.strideB;
        const float* bias = a.bias ? a.bias + (size_t)e * a.strideBias : nullptr;
        int ar = m0 + lr; if (ar >= M) ar = M - 1;
        const float* Arow;
        if (EP == EP_MOE1) Arow = a.A + (size_t)a.rowtok[rowbase + ar] * a.lda;
        else Arow = a.A + (size_t)(rowbase + ar) * a.lda;
        float acc[4][4], acc2[4][4];
#pragma unroll
        for (int i = 0; i < 4; ++i)
#pragma unroll
            for (int j = 0; j < 4; ++j) { acc[i][j] = 0.f; acc2[i][j] = 0.f; }
        for (int k0 = 0; k0 < a.K; k0 += 16) {
            const float4 av = *(const float4*)(Arow + k0 + lk);
            float4 bv = make_float4(0.f, 0.f, 0.f, 0.f);
            if (bsel == 0) bv = *(const float4*)(B + (size_t)(k0 + bk) * a.ldb + n0 + bn);
            else if (EP == EP_MOE1) bv = *(const float4*)(B + (size_t)(k0 + bk) * a.ldb + DFF + n0 + bn);
            __syncthreads();
            As[(lk + 0) * 132 + lr] = av.x; As[(lk + 1) * 132 + lr] = av.y; As[(lk + 2) * 132 + lr] = av.z; As[(lk + 3) * 132 + lr] = av.w;
            if (bsel == 0) *(LAS f32x4*)&Bs[bk * 68 + bn] = (f32x4){bv.x, bv.y, bv.z, bv.w};
            else if (EP == EP_MOE1) *(LAS f32x4*)&Bs2[bk * 68 + bn] = (f32x4){bv.x, bv.y, bv.z, bv.w};
            __syncthreads();
#pragma unroll
            for (int kk = 0; kk < 16; ++kk) {
                const f32x4 a4 = *(const LAS f32x4*)&As[kk * 132 + ty * 4];
                const f32x4 b4 = *(const LAS f32x4*)&Bs[kk * 68 + tx * 4];
                const float aa[4] = {a4.x, a4.y, a4.z, a4.w}, bb[4] = {b4.x, b4.y, b4.z, b4.w};
#pragma unroll
                for (int i = 0; i < 4; ++i)
#pragma unroll
                    for (int j = 0; j < 4; ++j) acc[i][j] += aa[i] * bb[j];
                if (EP == EP_MOE1) {
                    const f32x4 c4 = *(const LAS f32x4*)&Bs2[kk * 68 + tx * 4];
                    const float cc[4] = {c4.x, c4.y, c4.z, c4.w};
#pragma unroll
                    for (int i = 0; i < 4; ++i)
#pragma unroll
                        for (int j = 0; j < 4; ++j) acc2[i][j] += aa[i] * cc[j];
                }
            }
        }
#pragma unroll
        for (int i = 0; i < 4; ++i) {
            const int rr = m0 + ty * 4 + i;
            if (rr < M) {
                const size_t crow = (size_t)(rowbase + rr) * a.ldc;
#pragma unroll
                for (int j = 0; j < 4; ++j) {
                    const int c = n0 + tx * 4 + j;
                    float v = acc[i][j];
                    if (EP == EP_STORE) { if (bias) v += bias[c]; }
                    else if (EP == EP_RESID) v += a.aux[crow + c];
                    else if (EP == EP_GLU) { const float y = a.aux[crow + c]; v = y / (1.f + expf(-(v + bias[c]))); }
                    else if (EP == EP_MOE1) {
                        const float g = fminf(v + bias[c], 7.f);
                        const float l = fminf(fmaxf(acc2[i][j] + bias[DFF + c], -7.f), 7.f);
                        v = g / (1.f + expf(-1.702f * g)) * (l + 1.f);
                    } else if (EP == EP_MOE2) v += bias[c];
                    a.C[crow + c] = v;
                }
            }
        }
    }
    __syncthreads();
}

__device__ __forceinline__ int t5_bucket(int n) {
    if (n < 16) return n;
    const float v = logf((float)n / 16.f) / 4.852030263919617f * 16.f;
    const int large = 16 + (int)v;
    return large < 31 ? large : 31;
}
__device__ __forceinline__ void p_dilattn(const int wv, const float* proj, const float* rel_bias, float* ya, LAS unsigned char* lds) {
    LTID();
    const int w = tidx >> 6, lane = tidx & 63;
    LAS float* ps = (LAS float*)lds + w * 392;
    for (int gw = bidx * NW + w; gw < SEQ * 8; gw += gridDim.x * NW) {
        const int pos = gw >> 3, h = gw & 7;
        const float* q = proj + (size_t)pos * DIN + h * 64;
        float sc[7]; float mx = -1e30f;
#pragma unroll
        for (int it = 0; it < 7; ++it) {
            const int i = it * 64 + lane; float s = -1e30f;
            if (i < 387) {
                const int b = i / 129, d = i - b * 129, dil = 1 << (2 * b), kp = pos - d * dil;
                if (kp >= 0) {
                    const float* kr = proj + (size_t)kp * DIN + 512 + h * 64;
                    float dot = 0.f;
                    for (int e = 0; e < 64; e += 4) { const float4 qa = *(const float4*)(q + e), ka = *(const float4*)(kr + e); dot += qa.x * ka.x + qa.y * ka.y + qa.z * ka.z + qa.w * ka.w; }
                    s = dot * 0.125f + rel_bias[t5_bucket(d * dil) * 8 + h];
                }
            }
            sc[it] = s; mx = fmaxf(mx, s);
        }
        for (int o = 32; o; o >>= 1) mx = fmaxf(mx, shx(mx, o, lane));
        float den = 0.f;
#pragma unroll
        for (int it = 0; it < 7; ++it) {
            const int i = it * 64 + lane;
            const float p = (sc[it] > -1e29f) ? expf(sc[it] - mx) : 0.f;
            den += p;
            if (i < 387) ps[i] = p;
        }
        for (int o = 32; o; o >>= 1) den += shx(den, o, lane);
        __syncthreads();
        float acc = 0.f;
        for (int i = 0; i < 387; ++i) {
            const int b = i / 129, d = i - b * 129, dil = 1 << (2 * b), kp = pos - d * dil;
            if (kp >= 0) acc += ps[i] * proj[(size_t)kp * DIN + 1024 + h * 64 + lane];
        }
        ya[(size_t)pos * 512 + h * 64 + lane] = acc / den;
        __syncthreads();
    }
}

__device__ __forceinline__ void p_s5_tables(const int wv, const float* a_re, const float* a_im, const float* b_re, const float* b_im, const float* log_dt,
                                            float2* abar, float2* a128, float2* bbar) {
    LTID();
    for (int gp = bidx * NT + tidx; gp < 2048; gp += gridDim.x * NT) {
        const int g = gp >> 6;
        const float lr = a_re[gp], li = a_im[gp], dt = expf(log_dt[g]);
        const float mag = expf(lr * dt); float sn, cs; sincosf(li * dt, &sn, &cs);
        const float ar = mag * cs, ai = mag * sn;
        abar[gp] = make_float2(ar, ai);
        float pr = ar, pi = ai;
        for (int i = 0; i < 7; ++i) { const float nr = pr * pr - pi * pi, ni = 2.f * pr * pi; pr = nr; pi = ni; }
        a128[gp] = make_float2(pr, pi);
        const float nr = ar - 1.f, ni = ai, den = lr * lr + li * li;
        const float cr = (nr * lr + ni * li) / den, ci = (ni * lr - nr * li) / den;
        for (int c = 0; c < 16; ++c) {
            const float br = b_re[gp * 16 + c], bi = b_im[gp * 16 + c];
            bbar[gp * 16 + c] = make_float2(cr * br - ci * bi, cr * bi + ci * br);
        }
    }
}
template <int MODE> __device__ __forceinline__ void p_s5_local(const int wv, const float* proj, const float2* abar, const float2* bbar,
        const float* c_re, const float* c_im, const float* dskip, const float2* Sin, float2* E, float* ybuf, bf16_t* yg16) {
    LTID();
    const int w = tidx >> 6, p = tidx & 63;
    for (int item = bidx * NW + w; item < NCHUNK * 32; item += gridDim.x * NW) {
        const int chunk = item >> 5, g = item & 31, gp = g * 64 + p;
        float br[16], bi[16], cr[16], ci[16];
#pragma unroll
        for (int c = 0; c < 16; ++c) { const float2 b = bbar[gp * 16 + c]; br[c] = b.x; bi[c] = b.y; }
        if (MODE == 1) {
#pragma unroll
            for (int c = 0; c < 16; ++c) { cr[c] = c_re[(g * 16 + c) * 64 + p]; ci[c] = c_im[(g * 16 + c) * 64 + p]; }
        }
        const float2 a = abar[gp];
        float sr = 0.f, si = 0.f;
        if (MODE == 1) { const float2 s0 = Sin[chunk * 2048 + gp]; sr = s0.x; si = s0.y; }
        for (int t = 0; t < 128; ++t) {
            const int s = chunk * 128 + t;
            const float* up = proj + (size_t)s * DIN + 1536 + g * 16;
            float u[16];
#pragma unroll
            for (int c = 0; c < 16; c += 4) { const float4 v = *(const float4*)(up + c); u[c] = v.x; u[c + 1] = v.y; u[c + 2] = v.z; u[c + 3] = v.w; }
            float bur = 0.f, bui = 0.f;
#pragma unroll
            for (int c = 0; c < 16; ++c) { bur += br[c] * u[c]; bui += bi[c] * u[c]; }
            const float nr = a.x * sr - a.y * si + bur, ni = a.x * si + a.y * sr + bui;
            sr = nr; si = ni;
            if (MODE == 1) {
                float myy = 0.f;
#pragma unroll
                for (int c = 0; c < 16; ++c) {
                    float v = cr[c] * sr - ci[c] * si;
                    for (int o = 32; o; o >>= 1) v += shx(v, o, p);
                    if (p == c) myy = v + dskip[g * 16 + c] * u[c];
                }
                if (p < 16) { const float yv = 0.5f * myy * (1.f + erff(myy * 0.70710678118654752f)); ybuf[(size_t)s * 512 + g * 16 + p] = yv; yg16[(size_t)s * 512 + g * 16 + p] = (bf16_t)f2bf(yv); }
            }
        }
        if (MODE == 0) E[chunk * 2048 + gp] = make_float2(sr, si);
    }
}
__device__ __forceinline__ void p_s5_carry(const int wv, const float2* a128, const float2* E, float2* Sin) {
    LTID();
    for (int gp = bidx * NT + tidx; gp < 2048; gp += gridDim.x * NT) {
        const float2 a = a128[gp];
        float sr = 0.f, si = 0.f;
        for (int c = 0; c < NCHUNK; ++c) {
            Sin[c * 2048 + gp] = make_float2(sr, si);
            const float2 e = E[c * 2048 + gp];
            const float nr = a.x * sr - a.y * si + e.x, ni = a.x * si + a.y * sr + e.y;
            sr = nr; si = ni;
        }
    }
}
__device__ __forceinline__ void p_xattn(const int wv, const float* qx, const float* kvx, float* ox, bf16_t* ox16, LAS unsigned char* lds) {
    LTID();
    const int w = tidx >> 6, lane = tidx & 63;
    LAS float* ps = (LAS float*)lds + w * 256;
    for (int gw = bidx * NW + w; gw < SEQ * 4; gw += gridDim.x * NW) {
        const int pos = gw >> 2, h = gw & 3;
        const float* q = qx + (size_t)pos * 512 + h * 128;
        float sc[4]; float mx = -1e30f;
#pragma unroll
        for (int j = 0; j < 4; ++j) {
            const int m = j * 64 + lane;
            const float* kr = kvx + (size_t)m * 1024 + h * 128;
            float dot = 0.f;
            for (int e = 0; e < 128; e += 4) { const float4 qa = *(const float4*)(q + e), ka = *(const float4*)(kr + e); dot += qa.x * ka.x + qa.y * ka.y + qa.z * ka.z + qa.w * ka.w; }
            sc[j] = dot * 0.08838834764831845f; mx = fmaxf(mx, sc[j]);
        }
        for (int o = 32; o; o >>= 1) mx = fmaxf(mx, shx(mx, o, lane));
        float den = 0.f;
#pragma unroll
        for (int j = 0; j < 4; ++j) { const float p = expf(sc[j] - mx); den += p; ps[j * 64 + lane] = p; }
        for (int o = 32; o; o >>= 1) den += shx(den, o, lane);
        __syncthreads();
        float a0 = 0.f, a1 = 0.f;
        for (int m = 0; m < 256; ++m) {
            const float p = ps[m];
            const float* vr = kvx + (size_t)m * 1024 + 512 + h * 128;
            a0 += p * vr[lane]; a1 += p * vr[64 + lane];
        }
        ox[(size_t)pos * 512 + h * 128 + lane] = a0 / den;
        ox[(size_t)pos * 512 + h * 128 + 64 + lane] = a1 / den;
        ox16[(size_t)pos * 512 + h * 128 + lane] = (bf16_t)f2bf(a0 / den);
        ox16[(size_t)pos * 512 + h * 128 + 64 + lane] = (bf16_t)f2bf(a1 / den);
        __syncthreads();
    }
}
__device__ __forceinline__ void p_router(const int wv, const float* xn, const float* w_r, const float* b_r, int* topi, float* topg, unsigned* cnt) {
    LTID();
    const int lane = tidx & 63, e = lane & 31, w = tidx >> 6;
    for (int base = (bidx * NW + w) * 2; base < SEQ; base += gridDim.x * NW * 2) {
        const int token = base + (lane >> 5);
        const float* x = xn + (size_t)token * DM;
        float acc = 0.f;
        for (int k = 0; k < DM; ++k) acc += x[k] * w_r[k * 32 + e];
        float v = acc + b_r[e];
        float tv[4]; int ti[4];
#pragma unroll
        for (int r = 0; r < 4; ++r) {
            float bv = v; int bi = e;
#pragma unroll
            for (int o = 16; o; o >>= 1) {
                const float ov = shx(bv, o, lane); const int oi = shxi(bi, o, lane);
                if (ov > bv || (ov == bv && oi < bi)) { bv = ov; bi = oi; }
            }
            tv[r] = bv; ti[r] = bi;
            if (e == bi) v = -3.0e38f;
        }
        float ex[4], sum = 0.f;
#pragma unroll
        for (int r = 0; r < 4; ++r) { ex[r] = expf(tv[r] - tv[0]); sum += ex[r]; }
        if (e < 4) {
            const float gsel = e == 0 ? ex[0] : e == 1 ? ex[1] : e == 2 ? ex[2] : ex[3];
            const int isel = e == 0 ? ti[0] : e == 1 ? ti[1] : e == 2 ? ti[2] : ti[3];
            topi[token * 4 + e] = isel; topg[token * 4 + e] = gsel / sum;
            atomicAdd(&cnt[isel], 1u);
        }
    }
}
__device__ __forceinline__ void p_moe_place(const int wv, const int* topi, const unsigned* cnt, unsigned* cursor, int* rowtok, int* posof, LAS unsigned char* lds) {
    LTID();
    LAS int* offs = (LAS int*)lds;
    if (tidx == 0) { int s = 0; for (int e = 0; e < NEXP; ++e) { offs[e] = s; s += (((int)cnt[e] + BM - 1) / BM) * BM; } }
    __syncthreads();
    for (int i = bidx * NT + tidx; i < SEQ * TOPK; i += gridDim.x * NT) {
        const int e = topi[i];
        const int pos = offs[e] + (int)atomicAdd(&cursor[e], 1u);
        rowtok[pos] = i >> 2; posof[i] = pos;
    }
    if (bidx == 0) {
        for (int e = 0; e < NEXP; ++e) { const int c0 = (int)cnt[e], c1 = ((c0 + BM - 1) / BM) * BM; for (int r = c0 + tidx; r < c1; r += NT) rowtok[offs[e] + r] = 0; }
    }
    __syncthreads();
}
__device__ __forceinline__ void p_combine(const int wv, float* h, const bf16_t* outb, const int* posof, const float* topg) {
    LTID();
    for (int i = bidx * NT + tidx; i < SEQ * 256; i += gridDim.x * NT) {
        const int token = i >> 8, c4 = (i & 255) * 4;
        float4 acc = *(const float4*)(h + (size_t)token * DM + c4);
#pragma unroll
        for (int k = 0; k < 4; ++k) {
            const float g = topg[token * 4 + k];
            const u32x2 o = *(const u32x2*)(outb + (size_t)posof[token * 4 + k] * DM + c4);
            acc.x += g * __builtin_bit_cast(float, o.x << 16); acc.y += g * __builtin_bit_cast(float, o.x & 0xffff0000u);
            acc.z += g * __builtin_bit_cast(float, o.y << 16); acc.w += g * __builtin_bit_cast(float, o.y & 0xffff0000u);
        }
        *(float4*)(h + (size_t)token * DM + c4) = acc;
    }
}

constexpr int NPL = 18;
constexpr int NPHASES = 1 + 2 * NPL + 1;
typedef const __attribute__((address_space(4))) Args* KA;
#define PHASE __device__ __forceinline__
#define KAP() ({ KA _t = a; asm volatile("" : "+s"(_t)); _t; })
#define WSP(T, off) ((T*)(a->ws + (off)))

PHASE void ph_init(KA a, const int wv) {
    p_copy4(wv, a->in[0], WSP(float, WS_H), (size_t)SEQ * DM / 4);
    p_bias_table(wv, a->in[2], WSP(float, WS_BIASG));
    for (int l = 0; l < 2; ++l) {
        p_s5_tables2(wv, a->in[5] + l * 2048, a->in[6] + l * 2048, a->in[7] + l * 32768, a->in[8] + l * 32768, a->in[9] + l * 32768, a->in[10] + l * 32768, a->in[11] + l * 32,
                     WSP(float2, WS_ABAR) + l * 2048, WSP(float2, WS_A256) + l * 2048, WSP(bf16_t, WS_BB16) + (size_t)l * 32 * 128 * 16, WSP(bf16_t, WS_CM16) + (size_t)l * 32 * 16 * 128);
        p_rmsnorm(wv, a->in[1], DM, a->in[19] + l * DM, nullptr, DM, NMEM, DM, WSP(bf16_t, WS_MEMN16) + (size_t)l * NMEM * DM);
        p_transpose(wv, a->in[4] + (size_t)l * DM * DIN, DM, DIN, WSP(bf16_t, WS_WT_IN) + (size_t)l * DIN * DM, nullptr, 0, LDSP);
        p_transpose(wv, a->in[13] + (size_t)l * 512 * 512, 512, 512, WSP(bf16_t, WS_WT_GLU) + (size_t)l * 512 * 512, nullptr, 0, LDSP);
        p_transpose(wv, a->in[17] + (size_t)l * DM * DM, DM, DM, WSP(bf16_t, WS_WT_OUT) + (size_t)l * DM * DM, nullptr, 0, LDSP);
        p_transpose(wv, a->in[20] + (size_t)l * DM * 512, DM, 512, WSP(bf16_t, WS_WT_XQ) + (size_t)l * 512 * DM, nullptr, 0, LDSP);
        p_transpose(wv, a->in[21] + (size_t)l * DM * 1024, DM, 1024, WSP(bf16_t, WS_WT_XKV) + (size_t)l * 1024 * DM, nullptr, 0, LDSP);
        p_transpose(wv, a->in[22] + (size_t)l * 512 * DM, 512, DM, WSP(bf16_t, WS_WT_XO) + (size_t)l * DM * 512, nullptr, 0, LDSP);
    }
    for (int le = 0; le < 2 * NEXP; ++le) {
        p_transpose(wv, a->in[26] + (size_t)le * DM * 2048, DM, 2048, WSP(bf16_t, WS_BT1) + (size_t)le * 2048 * DM, nullptr, 1, LDSP);
        p_transpose(wv, a->in[28] + (size_t)le * DFF * DM, DFF, DM, WSP(bf16_t, WS_BT2) + (size_t)le * DM * DFF, nullptr, 0, LDSP);
    }
    __syncthreads();
}
PHASE void ph_norm(KA a, const int wv, int which, int l) {
    const float* g = (which == 0 ? a->in[3] : which == 1 ? a->in[18] : a->in[23]) + l * DM;
    if (which == 2) p_rmsnorm(wv, WSP(float, WS_H), DM, g, WSP(float, WS_XN), DM, SEQ, DM, WSP(bf16_t, WS_XN16));
    else p_rmsnorm(wv, WSP(float, WS_H), DM, g, nullptr, DM, SEQ, DM, WSP(bf16_t, WS_XN16));
}
PHASE void ph_gemm_in(KA a, const int wv, int l) { LTID();
    DenseOrder S; S.init(WSP(bf16_t, WS_XN16), WSP(bf16_t, WS_WT_IN) + (size_t)l * DIN * DM, SEQ, DIN, DM, gridDim.x, bidx);
    EpiIn E{WSP(bf16_t, WS_PROJ16), WSP(float, WS_PROJ)};
    gemm_phase<EpiIn, DenseOrder, false, false>(LDSP, DM, S, E, tidx, wv);
}
PHASE void ph_dilattn(KA a, const int wv) { p_dil_attn(wv, WSP(bf16_t, WS_PROJ16), WSP(float, WS_BIASG), WSP(bf16_t, WS_OBR), WSP(float, WS_LSE), LDSP); }
PHASE void ph_s5_local0(KA a, const int wv, int l) {
    p_s5_pass<0>(wv, WSP(bf16_t, WS_PROJ16), WSP(float2, WS_ABAR) + l * 2048, WSP(float2, WS_A256) + l * 2048, WSP(bf16_t, WS_BB16) + (size_t)l * 32 * 128 * 16, WSP(bf16_t, WS_CM16) + (size_t)l * 32 * 16 * 128,
                 a->in[12] + l * 512, WSP(float2, WS_E2), WSP(bf16_t, WS_YG16), LDSP);
}
PHASE void ph_s5_carry(KA a, const int wv, int l) { }
PHASE void ph_s5_local1(KA a, const int wv, int l) {
    p_s5_pass<1>(wv, WSP(bf16_t, WS_PROJ16), WSP(float2, WS_ABAR) + l * 2048, WSP(float2, WS_A256) + l * 2048, WSP(bf16_t, WS_BB16) + (size_t)l * 32 * 128 * 16, WSP(bf16_t, WS_CM16) + (size_t)l * 32 * 16 * 128,
                 a->in[12] + l * 512, WSP(float2, WS_E2), WSP(bf16_t, WS_YG16), LDSP);
}
PHASE void ph_gemm_glu(KA a, const int wv, int l) { LTID();
    DenseOrder S; S.init(WSP(bf16_t, WS_YG16), WSP(bf16_t, WS_WT_GLU) + (size_t)l * 512 * 512, SEQ, 512, 512, gridDim.x, bidx);
    EpiGlu16 E{WSP(bf16_t, WS_YB16), WSP(bf16_t, WS_YG16), a->in[14] + l * 512};
    gemm_phase<EpiGlu16, DenseOrder, false, false>(LDSP, 512, S, E, tidx, wv);
}
PHASE void ph_norm_mixout(KA a, const int wv, int l) {
    p_attn_combine(wv, WSP(bf16_t, WS_OBR), WSP(float, WS_LSE), a->in[15] + l * 512, WSP(bf16_t, WS_MIX16));
    p_ssm_norm(wv, WSP(bf16_t, WS_YB16), a->in[16] + l * 512, WSP(bf16_t, WS_MIX16));
}
PHASE void ph_gemm_out(KA a, const int wv, int l) { LTID();
    DenseOrder S; S.init(WSP(bf16_t, WS_MIX16), WSP(bf16_t, WS_WT_OUT) + (size_t)l * DM * DM, SEQ, DM, DM, gridDim.x, bidx);
    EpiF32 E{WSP(float, WS_H), DM, 1};
    gemm_phase<EpiF32, DenseOrder, false, false>(LDSP, DM, S, E, tidx, wv);
}
PHASE void ph_gemm_kv(KA a, const int wv, int l) { LTID();
    DenseOrder S; S.init(WSP(bf16_t, WS_MEMN16) + (size_t)l * NMEM * DM, WSP(bf16_t, WS_WT_XKV) + (size_t)l * 1024 * DM, NMEM, 1024, DM, gridDim.x, bidx);
    EpiBf16 E{WSP(bf16_t, WS_KV16), 1024, 1.f};
    gemm_phase<EpiBf16, DenseOrder, false, false>(LDSP, DM, S, E, tidx, wv);
}
PHASE void ph_gemm_xq(KA a, const int wv, int l) { LTID();
    DenseOrder S; S.init(WSP(bf16_t, WS_XN16), WSP(bf16_t, WS_WT_XQ) + (size_t)l * 512 * DM, SEQ, 512, DM, gridDim.x, bidx);
    EpiBf16 E{WSP(bf16_t, WS_QX16), 512, 0.08838834764831845f};
    gemm_phase<EpiBf16, DenseOrder, false, false>(LDSP, DM, S, E, tidx, wv);
}
PHASE void ph_xattn(KA a, const int wv) { p_xattn_mfma(wv, WSP(bf16_t, WS_QX16), WSP(bf16_t, WS_KV16), WSP(bf16_t, WS_OX16), LDSP); }
PHASE void ph_gemm_xo(KA a, const int wv, int l) { LTID();
    DenseOrder S; S.init(WSP(bf16_t, WS_OX16), WSP(bf16_t, WS_WT_XO) + (size_t)l * DM * 512, SEQ, DM, 512, gridDim.x, bidx);
    EpiF32 E{WSP(float, WS_H), DM, 1};
    gemm_phase<EpiF32, DenseOrder, false, false>(LDSP, 512, S, E, tidx, wv);
}
PHASE void ph_router(KA a, const int wv, int l) { p_router(wv, WSP(float, WS_XN), a->in[24] + (size_t)l * DM * 32, a->in[25] + l * 32, WSP(int, WS_TOPI), WSP(float, WS_TOPG), WSP(unsigned, WS_CTL) + CW_CNT + l * 32); }
PHASE void ph_place(KA a, const int wv, int l) { p_moe_place(wv, WSP(int, WS_TOPI), WSP(unsigned, WS_CTL) + CW_CNT + l * 32, WSP(unsigned, WS_CTL) + CW_CUR + l * 32, WSP(int, WS_ROWTOK), WSP(int, WS_POSOF), LDSP); }
PHASE void ph_moe1(KA a, const int wv, int l) { LTID();
    moe_tiles(WSP(unsigned, WS_CTL) + CW_CNT + l * 32, tidx);
    MoeOrder<true> S; S.init(WSP(bf16_t, WS_XN16), WSP(bf16_t, WS_BT1) + (size_t)l * NEXP * 2048 * DM, WSP(int, WS_ROWTOK), 2048, DM, (size_t)2048 * DM * 2, gridDim.x, bidx);
    EpiMoe1 E{WSP(bf16_t, WS_ACT), a->in[27] + (size_t)l * NEXP * 2048};
    gemm_phase<EpiMoe1, MoeOrder<true>, true, false>(LDSP, DM, S, E, tidx, wv);
}
PHASE void ph_moe2(KA a, const int wv, int l) { LTID();
    moe_tiles(WSP(unsigned, WS_CTL) + CW_CNT + l * 32, tidx);
    MoeOrder<false> S; S.init(WSP(bf16_t, WS_ACT), WSP(bf16_t, WS_BT2) + (size_t)l * NEXP * DM * DFF, nullptr, DM, DFF, (size_t)DM * DFF * 2, gridDim.x, bidx);
    EpiMoe2 E{WSP(bf16_t, WS_MOUT), a->in[29] + (size_t)l * NEXP * DM};
    gemm_phase<EpiMoe2, MoeOrder<false>, false, false>(LDSP, DFF, S, E, tidx, wv);
}
PHASE void ph_combine(KA a, const int wv) { p_combine(wv, WSP(float, WS_H), WSP(bf16_t, WS_MOUT), WSP(int, WS_POSOF), WSP(float, WS_TOPG)); }
PHASE void ph_final(KA a, const int wv) { p_rmsnorm(wv, WSP(float, WS_H), DM, a->in[30], a->out, DM, SEQ, DM); }

__global__ void __launch_bounds__(NT, 2) mega(Args args) {
    KA a = (KA)__builtin_amdgcn_kernarg_segment_ptr();
    int wv = __builtin_amdgcn_readfirstlane((int)threadIdx.x >> 6); asm volatile("" : "+s"(wv));
    LAS unsigned char* lds = LDSP;
    volatile LAS unsigned* MISC = (volatile LAS unsigned*)(lds + MISC_OFF);
    unsigned* ctl = (unsigned*)(a->ws + WS_CTL);
    if (threadIdx.x < 32) MISC[threadIdx.x] = 0u;
    __syncthreads();
    XcdBarrier bar; bar.bar = ctl + CW_BAR; bar.x = 0; bar.st = nullptr;
    if (!MK_PER_PHASE) bar = xcd_barrier_post(ctl + CW_BAR, MISC + 8);
    const int lo = a->ph_lo, hi = a->ph_hi;
#define IN(k) (lo <= (k) && (k) < hi)
#define SEAM(k) do { if (IN(k) && IN((k) + 1)) { LTID(); xcd_barrier(bar.bar, bar.x, bar.st, tidx == 0); } } while (0)
    if (IN(0)) ph_init(KAP(), wv);
    SEAM(0);
#pragma unroll 1
    for (int l = 0; l < 2; ++l) {
        const int pb = 1 + l * NPL;
        if (IN(pb + 0)) ph_norm(KAP(), wv, 0, l);
        SEAM(pb + 0);
        if (IN(pb + 1)) ph_gemm_in(KAP(), wv, l);
        SEAM(pb + 1);
        if (IN(pb + 2)) { ph_dilattn(KAP(), wv); ph_s5_local0(KAP(), wv, l); }
        SEAM(pb + 2);
        if (IN(pb + 3)) ph_s5_carry(KAP(), wv, l);
        SEAM(pb + 3);
        if (IN(pb + 4)) ph_s5_local1(KAP(), wv, l);
        SEAM(pb + 4);
        if (IN(pb + 5)) ph_gemm_glu(KAP(), wv, l);
        SEAM(pb + 5);
        if (IN(pb + 6)) ph_norm_mixout(KAP(), wv, l);
        SEAM(pb + 6);
        if (IN(pb + 7)) ph_gemm_out(KAP(), wv, l);
        SEAM(pb + 7);
        if (IN(pb + 8)) { ph_norm(KAP(), wv, 1, l); ph_gemm_kv(KAP(), wv, l); }
        SEAM(pb + 8);
        if (IN(pb + 9)) ph_gemm_xq(KAP(), wv, l);
        SEAM(pb + 9);
        if (IN(pb + 10)) ph_xattn(KAP(), wv);
        SEAM(pb + 10);
        if (IN(pb + 11)) ph_gemm_xo(KAP(), wv, l);
        SEAM(pb + 11);
        if (IN(pb + 12)) ph_norm(KAP(), wv, 2, l);
        SEAM(pb + 12);
        if (IN(pb + 13)) ph_router(KAP(), wv, l);
        SEAM(pb + 13);
        if (IN(pb + 14)) ph_place(KAP(), wv, l);
        SEAM(pb + 14);
        if (IN(pb + 15)) ph_moe1(KAP(), wv, l);
        SEAM(pb + 15);
        if (IN(pb + 16)) ph_moe2(KAP(), wv, l);
        SEAM(pb + 16);
        if (IN(pb + 17)) ph_combine(KAP(), wv);
        SEAM(pb + 17);
    }
    if (IN(NPHASES - 1)) ph_final(KAP(), wv);
#undef IN
#undef SEAM
}

extern "C" void kernel_launch(void* const* d_in, const int* in_sizes, int n_in, void* d_out, int out_size, void* d_ws, size_t ws_size, hipStream_t stream) {
    static int grid = 0;
    if (grid == 0) {
        if (n_in != 31 || ws_size < WS_END) { fprintf(stderr, "kernel_launch: unexpected n_in %d or ws_size %zu (need %zu)\n", n_in, ws_size, (size_t)WS_END); grid = -1; return; }
        int dev = 0, cus = 0, per_cu = 0;
        if (hipGetDevice(&dev) != hipSuccess || hipDeviceGetAttribute(&cus, hipDeviceAttributeMultiprocessorCount, dev) != hipSuccess) { grid = -1; return; }
        if (hipFuncSetAttribute((const void*)mega, hipFuncAttributeMaxDynamicSharedMemorySize, LDS_BYTES) != hipSuccess) { fprintf(stderr, "kernel_launch: hipFuncSetAttribute failed\n"); grid = -1; return; }
        if (hipOccupancyMaxActiveBlocksPerMultiprocessor(&per_cu, (const void*)mega, NT, LDS_BYTES) != hipSuccess || per_cu < 1)
            fprintf(stderr, "kernel_launch: occupancy query reports %d workgroups per CU\n", per_cu);
        (void)hipGetLastError();
        grid = cus;
    }
    if (grid < 0) return;
    if (hipMemsetAsync((char*)d_ws + WS_CTL, 0, CTL_ZERO_BYTES, stream) != hipSuccess) return;
    Args a{};
    for (int i = 0; i < 31; ++i) a.in[i] = (const float*)d_in[i];
    a.out = (float*)d_out; a.ws = (unsigned char*)d_ws;
#if MK_PER_PHASE
    for (int p = 0; p < NPHASES; ++p) { a.ph_lo = p; a.ph_hi = p + 1; hipLaunchKernelGGL(mega, dim3(grid), dim3(NT), LDS_BYTES, stream, a); }
#else
    a.ph_lo = 0; a.ph_hi = NPHASES;
    hipLaunchKernelGGL(mega, dim3(grid), dim3(NT), LDS_BYTES, stream, a);
#endif
}
```

```cpp
#include <hip/hip_runtime.h>
#include <stdint.h>
#include <cstdio>

#ifndef MK_PER_PHASE
#define MK_PER_PHASE 0
#endif

#define SEQ 16384
#define DM 1024
#define DIN 2048
#define NMEM 256
#define NEXP 32
#define TOPK 4
#define DFF 1024
#define NT 512
#define NW 8

#define LAS __attribute__((address_space(3)))
typedef float f32x4 __attribute__((ext_vector_type(4)));
extern __shared__ __attribute__((aligned(16))) unsigned char lds_raw[];
#define LDSP ((LAS unsigned char*)lds_raw)
#define LTID() int z_ = 0; asm volatile("" : "+v"(z_)); const int lane_ = (int)__builtin_amdgcn_mbcnt_hi(~0u, __builtin_amdgcn_mbcnt_lo(~0u, (unsigned)z_)); \
    const int tidx = wv * 64 + lane_; int bidx = blockIdx.x; asm volatile("" : "+s"(bidx))
__device__ __forceinline__ float shx(float v, int mask, int lane) { return __builtin_bit_cast(float, __builtin_amdgcn_ds_bpermute((lane ^ mask) << 2, __builtin_bit_cast(int, v))); }
__device__ __forceinline__ int shxi(int v, int mask, int lane) { return __builtin_amdgcn_ds_bpermute((lane ^ mask) << 2, v); }
constexpr int LDS_BYTES = 147456;
constexpr int MISC_OFF = 131072 + 320;

#define XB_TMO      128
#define XB_XCNT(j)  (256  + 64 * (j))
#define XB_XSUB(j)  (1280 + 64 * (j))
#define XB_XGEN(j)  (2304 + 64 * (j))
#define XB_TOP      3328
#define XB_TOPGEN   3392
#define XCD_BAR_WORDS 3456
#define XB_SPIN_CAP (1u << 18)

__device__ __forceinline__ unsigned xb_ld(unsigned* p)              { return __hip_atomic_load(p, __ATOMIC_RELAXED, __HIP_MEMORY_SCOPE_AGENT); }
__device__ __forceinline__ unsigned xb_add(unsigned* p, unsigned v) { return __hip_atomic_fetch_add(p, v, __ATOMIC_RELAXED, __HIP_MEMORY_SCOPE_AGENT); }
__device__ __forceinline__ unsigned xb_xcc_id() { return (unsigned)__builtin_amdgcn_s_getreg((3 << 11) | 20) & 0xFu; }
#define XB_SPIN(cond, bar) do { unsigned _sp = 0; while (cond) { __builtin_amdgcn_s_sleep(1); \
    if ((++_sp & 255u) == 0u) { if (xb_ld(&(bar)[XB_TMO])) break; if (_sp > XB_SPIN_CAP) { atomicAdd(&(bar)[XB_TMO], 1u); break; } } } } while (0)

struct XcdBarrier {
    unsigned* bar; unsigned x;
    volatile LAS unsigned* st;
};
__device__ __forceinline__ XcdBarrier xcd_barrier_post(unsigned* bar, volatile LAS unsigned* st) {
    XcdBarrier b; b.bar = bar; b.x = xb_xcc_id(); b.st = st;
    if (threadIdx.x == 0) (void)xb_add(&bar[XB_XCNT(b.x)], 1u);
    return b;
}
__device__ __forceinline__ void xcd_barrier_complete(unsigned* bar, unsigned x, unsigned& nloc, unsigned& nx) {
    const unsigned G = gridDim.x * gridDim.y * gridDim.z;
    unsigned sum, cnt, mine, sp = 0u;
    for (;;) {
        sum = 0u; cnt = 0u; mine = 0u;
#pragma unroll
        for (unsigned j = 0; j < 16; ++j) { const unsigned c = xb_ld(&bar[XB_XCNT(j)]); sum += c; cnt += (c > 0u) ? 1u : 0u; mine = (j == x) ? c : mine; }
        if (sum == G) break;
        __builtin_amdgcn_s_sleep(1);
        if ((++sp & 255u) == 0u) { if (xb_ld(&bar[XB_TMO])) break; if (sp > XB_SPIN_CAP) { atomicAdd(&bar[XB_TMO], 1u); break; } }
    }
    nloc = mine > 0u ? mine : 1u; nx = cnt > 0u ? cnt : 1u;
}
__device__ __noinline__ void xcd_barrier(unsigned* bar_, unsigned x_, volatile LAS unsigned* st_, int is_t0) {
    XcdBarrier b; b.bar = bar_; b.x = x_; b.st = st_;
    asm volatile("s_waitcnt vmcnt(0)" ::: "memory");
    __syncthreads();
    if (is_t0) {
        unsigned* bar = b.bar;
        __builtin_amdgcn_s_waitcnt(0);
        unsigned nloc = b.st[0], nx = b.st[1];
        if (nloc == 0u) { xcd_barrier_complete(bar, b.x, nloc, nx); b.st[0] = nloc; b.st[1] = nx; }
        const unsigned old = xb_add(&bar[XB_XSUB(b.x)], 1u);
        const unsigned gen = old / nloc;
        if (old + 1u == (gen + 1u) * nloc) {
            __builtin_amdgcn_fence(__ATOMIC_RELEASE, "agent");
            asm volatile("s_waitcnt vmcnt(0)" ::: "memory");
            const unsigned og = xb_add(&bar[XB_TOP], 1u);
            const unsigned tg = og / nx;
            if (og + 1u == (tg + 1u) * nx) xb_add(&bar[XB_TOPGEN], 1u);
            else XB_SPIN(xb_ld(&bar[XB_TOPGEN]) == tg, bar);
            __builtin_amdgcn_fence(__ATOMIC_ACQUIRE, "agent");
            xb_add(&bar[XB_XGEN(b.x)], 1u);
            asm volatile("s_waitcnt vmcnt(0)" ::: "memory");
        } else {
            XB_SPIN(xb_ld(&bar[XB_XGEN(b.x)]) == gen, bar);
            __builtin_amdgcn_fence(__ATOMIC_ACQUIRE, "agent");
            asm volatile("s_waitcnt vmcnt(0)" ::: "memory");
        }
    }
    __syncthreads();
}

constexpr size_t MiB = 1u << 20;
constexpr size_t WS_CTL = 0, CTL_ZERO_BYTES = 1 * MiB;
constexpr int CW_BAR = 4096;
constexpr int CW_CNT = 8192;
constexpr int MOE_ROWS = SEQ * TOPK + NEXP * 256;
constexpr int ECAP = SEQ;
constexpr size_t al256(size_t x) { return (x + 255) & ~(size_t)255; }
constexpr size_t WS_H = 2 * MiB;
constexpr size_t WS_XN16 = WS_H + (size_t)SEQ * DM * 4;
constexpr size_t WS_HB16 = WS_XN16 + (size_t)SEQ * DM * 2;
constexpr size_t WS_PROJ16 = WS_HB16 + (size_t)SEQ * DM * 2;
constexpr size_t WS_OBR = WS_PROJ16 + (size_t)SEQ * 2048 * 2;
constexpr size_t WS_LSE = WS_OBR + 3 * (size_t)SEQ * 512 * 2;
constexpr size_t WS_YG16 = WS_LSE + 3 * (size_t)SEQ * 8 * 4;
constexpr size_t WS_YB16 = WS_YG16 + (size_t)SEQ * 512 * 2;
constexpr size_t WS_MIX16 = WS_YB16 + (size_t)SEQ * 512 * 2;
constexpr size_t WS_QX16 = WS_MIX16 + (size_t)SEQ * DM * 2;
constexpr size_t WS_OX16 = WS_QX16 + (size_t)SEQ * 512 * 2;
constexpr size_t WS_ACT = WS_OX16 + (size_t)SEQ * 512 * 2;
constexpr size_t WS_MOUT = WS_ACT + (size_t)MOE_ROWS * DFF * 2;
constexpr size_t WS_BT1 = WS_MOUT + (size_t)MOE_ROWS * DM * 2;
constexpr size_t WS_BT2 = WS_BT1 + 2 * (size_t)NEXP * 2048 * DM * 2;
constexpr size_t WS_WT_IN = WS_BT2 + 2 * (size_t)NEXP * DM * DFF * 2;
constexpr size_t WS_WT_GLU = WS_WT_IN + 2 * (size_t)2048 * 1024 * 2;
constexpr size_t WS_WT_OUT = WS_WT_GLU + 2 * (size_t)512 * 512 * 2;
constexpr size_t WS_WT_XQ = WS_WT_OUT + 2 * (size_t)1024 * 1024 * 2;
constexpr size_t WS_WT_XKV = WS_WT_XQ + 2 * (size_t)512 * 1024 * 2;
constexpr size_t WS_WT_XO = WS_WT_XKV + 2 * (size_t)1024 * 1024 * 2;
constexpr size_t WS_MEMN16 = WS_WT_XO + 2 * (size_t)1024 * 512 * 2;
constexpr size_t WS_KV16 = WS_MEMN16 + 2 * (size_t)NMEM * 1024 * 2;
constexpr size_t WS_WR16 = WS_KV16 + 2 * (size_t)NMEM * 1024 * 2;
constexpr size_t WS_BIASG = WS_WR16 + 2 * 2 * (size_t)32 * 1024 * 2;
constexpr size_t WS_ABAR = al256(WS_BIASG + 24 * 132 * 4);
constexpr size_t WS_A256 = WS_ABAR + 2 * 2048 * 8;
constexpr size_t WS_BB16 = WS_A256 + 2 * 2048 * 8;
constexpr size_t WS_CM16 = WS_BB16 + 2 * (size_t)32 * 128 * 16 * 2;
constexpr size_t WS_E2 = WS_CM16 + 2 * (size_t)32 * 16 * 128 * 2;
constexpr size_t WS_ROWTOK = WS_E2 + (size_t)64 * 2048 * 8;
constexpr size_t WS_RSC = WS_ROWTOK + (size_t)NEXP * ECAP * 4;
constexpr size_t WS_ESLOT = WS_RSC + (size_t)NEXP * ECAP * 4;
constexpr size_t WS_TOPG = WS_ESLOT + (size_t)SEQ * 4 * 4;
constexpr size_t WS_SSP = WS_TOPG + (size_t)SEQ * 4 * 4;
constexpr size_t WS_END = WS_SSP + (size_t)SEQ * 16 * 4;

struct Args { const float* in[31]; float* out; unsigned char* ws; int ph_lo, ph_hi; };


typedef unsigned short bf16_t;
typedef short bf16x8 __attribute__((ext_vector_type(8)));
typedef unsigned u32x4 __attribute__((ext_vector_type(4)));
typedef unsigned u32x2 __attribute__((ext_vector_type(2)));
constexpr int BM = 256, BK = 64, HALF = 128, HTB = HALF * BK * 2, STAGE_BYTES = 8 * HTB, NXCD = 8, WGM = 8;
__host__ __device__ __forceinline__ int lds_byte(int r, int c) { const int st = (r >> 4) * 2 + (c >> 5), rr = r & 15, cc = c & 31, ob = rr * 64 + cc * 2; return st * 1024 + (ob ^ (((ob >> 9) & 1) << 5)); }
__host__ __device__ __forceinline__ void stage_rc(int b, int& R, int& C) { const int st = b / 1024, sb = b % 1024, swz = sb ^ (((sb >> 9) & 1) << 5); R = (st >> 1) * 16 + swz / 64; C = (st & 1) * 32 + (swz % 64) / 2; }
__host__ __device__ __forceinline__ int perm32(int rho) { const int n = rho >> 4, i = rho & 15; return 8 * (i >> 2) + 4 * n + (i & 3); }
__device__ __forceinline__ unsigned cvt_pk_bf16(float lo, float hi) { unsigned r; asm volatile("v_cvt_pk_bf16_f32 %0, %1, %2" : "=v"(r) : "v"(lo), "v"(hi)); return r; }
__device__ __forceinline__ unsigned f2bf(float f) { unsigned u = __builtin_bit_cast(unsigned, f); return (u + 0x7fffu + ((u >> 16) & 1u)) >> 16; }
__device__ __forceinline__ unsigned pk2(float lo, float hi) { return f2bf(lo) | (f2bf(hi) << 16); }
__device__ __forceinline__ float bf2f(unsigned short b) { return __builtin_bit_cast(float, ((unsigned)b) << 16); }

__device__ __forceinline__ void glds16s(const void* sbase, unsigned voff, unsigned lds_dst) {
    unsigned keep;
    asm volatile("s_mov_b32 %0, m0\n\ts_mov_b32 m0, %3\n\ts_nop 0\n\tglobal_load_lds_dwordx4 %1, %2\n\ts_mov_b32 m0, %0" : "=&s"(keep) : "v"(voff), "s"(sbase), "s"(lds_dst) : "memory");
}
struct GUnit { const char* A; const char* B; int pm, pn, e, row0, cnt; };

struct DenseOrder {
    const char* A; const char* Bt; int nM, nN, nwg, G, c, K;
    __device__ __forceinline__ void init(const bf16_t* A_, const bf16_t* Bt_, int M, int N, int K_, int G_, int c_) { A = (const char*)A_; Bt = (const char*)Bt_; nM = M / BM; nN = N / BM; nwg = nM * nN; G = G_; c = c_; K = K_; }
    __device__ __forceinline__ bool next(int i, GUnit& u) const {
        const long L = (long)i * G + c; if (L >= nwg) return false;
        int wgid = (int)L; { const int q = nwg / NXCD, r = nwg % NXCD, xcd = wgid % NXCD, off = wgid / NXCD; wgid = (xcd < r ? xcd * (q + 1) : r * (q + 1) + (xcd - r) * q) + off; }
        const int nig = WGM * nN, gid = wgid / nig, fm = gid * WGM, gsz = (nM - fm) < WGM ? (nM - fm) : WGM;
        u.pm = fm + ((wgid % nig) % gsz); u.pn = (wgid % nig) / gsz; u.e = 0; u.row0 = 0; u.cnt = 0;
        u.A = A + (size_t)u.pm * BM * K * 2; u.B = Bt + (size_t)u.pn * BM * K * 2; return true;
    }
    __device__ __forceinline__ unsigned aoff(const GUnit&, int row) const { return (unsigned)(row * K * 2); }
};

struct EpiF32 {
    static constexpr bool PERM = false;
    float* C; int ldc; int resid;
    __device__ __forceinline__ void operator()(const f32x4 (&acc)[2][2][4][2], const GUnit& u, int wr, int wc, int fr, int fq) const {
        const int row0 = u.pm * BM + wr * 64 + fr, col0 = u.pn * BM + wc * 32 + 4 * fq;
#pragma unroll
        for (int ai = 0; ai < 2; ++ai)
#pragma unroll
            for (int m = 0; m < 4; ++m) { float* rowp = C + (size_t)(row0 + ai * HALF + m * 16) * ldc + col0;
#pragma unroll
                for (int bj = 0; bj < 2; ++bj)
#pragma unroll
                    for (int n = 0; n < 2; ++n) { f32x4 v = acc[ai][bj][m][n]; if (resid) v += *(const f32x4*)(rowp + bj * HALF + n * 16); *(f32x4*)(rowp + bj * HALF + n * 16) = v; } }
    }
};
struct EpiGlu {
    static constexpr bool PERM = false;
    float* C; const float* Y; int ldc; const float* bias;
    __device__ __forceinline__ void operator()(const f32x4 (&acc)[2][2][4][2], const GUnit& u, int wr, int wc, int fr, int fq) const {
        const int row0 = u.pm * BM + wr * 64 + fr, col0 = u.pn * BM + wc * 32 + 4 * fq;
#pragma unroll
        for (int ai = 0; ai < 2; ++ai)
#pragma unroll
            for (int m = 0; m < 4; ++m) { const size_t ro = (size_t)(row0 + ai * HALF + m * 16) * ldc + col0;
#pragma unroll
                for (int bj = 0; bj < 2; ++bj)
#pragma unroll
                    for (int n = 0; n < 2; ++n) { const f32x4 b = *(const f32x4*)(bias + col0 + bj * HALF + n * 16); const f32x4 y = *(const f32x4*)(Y + ro + bj * HALF + n * 16);
                        f32x4 v = acc[ai][bj][m][n] + b; f32x4 o;
#pragma unroll
                        for (int j = 0; j < 4; ++j) o[j] = y[j] / (1.f + __expf(-v[j]));
                        *(f32x4*)(C + ro + bj * HALF + n * 16) = o; } }
    }
};

template <class Epi, class Sched, bool GATHER, bool ALIGN_EPI>
__device__ __forceinline__ void gemm_phase(LAS unsigned char* lds, const int K, const Sched& S, const Epi& E, const int tid, const int wv) {
    const int wid = wv, lane = tid & 63, wr = wid >> 2, wc = wid & 3, fr = lane & 15, fq = lane >> 4;
    const int nt = K / BK;
    unsigned voffB[2];
#pragma unroll
    for (int i = 0; i < 2; ++i) { int R, C; stage_rc(tid * 16 + i * 8192, R, C); const int Rb = Epi::PERM ? ((R & ~31) + perm32(R & 31)) : R; voffB[i] = (unsigned)(Rb * K + C) * 2u; }
#define PG8_AOFFS(dst, u) do { int t2_ = tid; asm volatile("" : "+v"(t2_)); _Pragma("unroll") for (int i = 0; i < 2; ++i) { int R, C; stage_rc(t2_ * 16 + i * 8192, R, C); \
        _Pragma("unroll") for (int h = 0; h < 2; ++h) dst[h][i] = S.aoff(u, h * HALF + R) + (unsigned)C * 2u; } } while (0)
    const size_t kstep = (size_t)(BK * 2);
    const size_t hstep = (size_t)HALF * K * 2;
    const unsigned ldsw = (unsigned)wid * 1024u;
    const int aoff = lds_byte(wr * 64 + fr, fq * 8), boff = lds_byte(wc * 32 + fr, fq * 8);
#define PG8_SA(b, h) (((b) * 2 + (h)) * HTB)
#define PG8_SB(b, h) ((4 + (b) * 2 + (h)) * HTB)
#define PG8_STAGE(bufoff, gbase, v0, v1) do { const unsigned ld_ = (unsigned)(size_t)(lds + (bufoff) + ldsw); glds16s((gbase), (v0), ld_); glds16s((gbase), (v1), ld_ + 8192u); } while (0)
#define PG8_LDA(dst, b, h) do { _Pragma("unroll") for (int m = 0; m < 4; ++m) _Pragma("unroll") for (int k = 0; k < 2; ++k) dst[m][k] = *(const LAS bf16x8*)(lds + PG8_SA(b, h) + aoff + m * 2048 + k * 1024); } while (0)
#define PG8_LDB(dst, b, h) do { _Pragma("unroll") for (int n = 0; n < 2; ++n) _Pragma("unroll") for (int k = 0; k < 2; ++k) dst[n][k] = *(const LAS bf16x8*)(lds + PG8_SB(b, h) + boff + n * 2048 + k * 1024); } while (0)
#define PG8_MMA(ai, bj, At, Bt) do { __builtin_amdgcn_s_setprio(1); _Pragma("unroll") for (int m = 0; m < 4; ++m) _Pragma("unroll") for (int n = 0; n < 2; ++n) _Pragma("unroll") for (int k = 0; k < 2; ++k) \
        acc[ai][bj][m][n] = __builtin_amdgcn_mfma_f32_16x16x32_bf16(Bt[n][k], At[m][k], acc[ai][bj][m][n], 0, 0, 0); __builtin_amdgcn_s_setprio(0); } while (0)
#define PG8_WAIT_V(n) asm volatile("s_waitcnt vmcnt(" #n ")" ::: "memory")
#define PG8_WAIT_L(n) asm volatile("s_waitcnt lgkmcnt(" #n ")" ::: "memory")
#define PG8_BAR __builtin_amdgcn_s_barrier()
#define PG8_SCHED __builtin_amdgcn_sched_barrier(0)
    GUnit cur, nxt; int ui = 0;
    if (!S.next(0, cur)) return;
    f32x4 acc[2][2][4][2];
#pragma unroll
    for (int a = 0; a < 2; ++a)
#pragma unroll
        for (int b = 0; b < 2; ++b)
#pragma unroll
            for (int m = 0; m < 4; ++m)
#pragma unroll
                for (int n = 0; n < 2; ++n) acc[a][b][m][n] = (f32x4){0.f, 0.f, 0.f, 0.f};
    bf16x8 At[4][2], B0[2][2], B1[2][2];
    unsigned vA[2][2], vN[2][2];
    PG8_AOFFS(vA, cur);
#pragma unroll
    for (int h = 0; h < 2; ++h)
#pragma unroll
        for (int i = 0; i < 2; ++i) vN[h][i] = vA[h][i];
    const char* cA = cur.A; const char* cB = cur.B;
    PG8_STAGE(PG8_SB(0, 0), cB, voffB[0], voffB[1]); PG8_STAGE(PG8_SB(0, 1), cB + hstep, voffB[0], voffB[1]); PG8_STAGE(PG8_SA(0, 0), cA, vA[0][0], vA[0][1]); PG8_STAGE(PG8_SA(0, 1), cA, vA[1][0], vA[1][1]);
    if (wr == 1) PG8_BAR;
    PG8_WAIT_V(2); PG8_BAR;
    PG8_STAGE(PG8_SB(1, 0), cB + kstep, voffB[0], voffB[1]); PG8_STAGE(PG8_SA(1, 0), cA + kstep, vA[0][0], vA[0][1]); PG8_STAGE(PG8_SB(1, 1), cB + hstep + kstep, voffB[0], voffB[1]);
    PG8_WAIT_V(6); PG8_BAR;
    for (;;) {
        const bool has_next = S.next(ui + 1, nxt);
        const char* nA = GATHER ? cA : (has_next ? nxt.A : cA); const char* nB = has_next ? nxt.B : cB;
        if (GATHER) {
            if (has_next) { PG8_AOFFS(vN, nxt); }
            else {
#pragma unroll
                for (int h = 0; h < 2; ++h)
#pragma unroll
                    for (int i = 0; i < 2; ++i) vN[h][i] = vA[h][i];
            }
        }
#define PG8_KBODY(a1, a2, b2, a3, b3, W00, W01, W10, W11) do { \
              \
            PG8_LDB(B0, 0, 0); PG8_LDB(B1, 0, 1); PG8_SCHED; PG8_LDA(At, 0, 0); PG8_STAGE(PG8_SA(1, 1), a1, vA[1][0], vA[1][1]); \
            PG8_WAIT_V(8); PG8_WAIT_L(0); PG8_BAR; PG8_MMA(0, 0, At, B0); PG8_MMA(0, 1, At, B1); PG8_BAR; PG8_SCHED; \
              \
            PG8_LDA(At, 0, 1); PG8_STAGE(PG8_SB(0, 0), b2, voffB[0], voffB[1]); PG8_STAGE(PG8_SB(0, 1), (b2) + hstep, voffB[0], voffB[1]); PG8_STAGE(PG8_SA(0, 0), a2, W00, W01); \
            PG8_WAIT_V(8); PG8_WAIT_L(0); PG8_BAR; PG8_MMA(1, 0, At, B0); PG8_MMA(1, 1, At, B1); PG8_BAR; PG8_SCHED; \
              \
            PG8_LDB(B0, 1, 0); PG8_LDB(B1, 1, 1); PG8_SCHED; PG8_LDA(At, 1, 0); PG8_STAGE(PG8_SA(0, 1), a2, W10, W11); \
            PG8_WAIT_V(8); PG8_WAIT_L(0); PG8_BAR; PG8_MMA(0, 0, At, B0); PG8_MMA(0, 1, At, B1); PG8_BAR; PG8_SCHED; \
              \
            PG8_LDA(At, 1, 1); PG8_STAGE(PG8_SB(1, 0), b3, voffB[0], voffB[1]); PG8_STAGE(PG8_SB(1, 1), (b3) + hstep, voffB[0], voffB[1]); PG8_STAGE(PG8_SA(1, 0), a3, W00, W01); \
            PG8_WAIT_V(8); PG8_WAIT_L(0); PG8_BAR; PG8_MMA(1, 0, At, B0); PG8_MMA(1, 1, At, B1); PG8_BAR; PG8_SCHED; } while (0)
        for (int t = 0; t < nt - 2; t += 2) {
            const char* a1 = cA + (size_t)(t + 1) * kstep;
            const char* a2 = cA + (size_t)(t + 2) * kstep; const char* b2 = cB + (size_t)(t + 2) * kstep;
            const char* a3 = a2 + kstep; const char* b3 = b2 + kstep;
            PG8_KBODY(a1, a2, b2, a3, b3, vA[0][0], vA[0][1], vA[1][0], vA[1][1]);
        }
        {
            const char* a1 = cA + (size_t)(nt - 1) * kstep;
            const char* a3 = nA + kstep; const char* b3 = nB + kstep;
            PG8_KBODY(a1, nA, nB, a3, b3, vN[0][0], vN[0][1], vN[1][0], vN[1][1]);
        }
#undef PG8_KBODY
        if constexpr (ALIGN_EPI) { if (wr == 0) PG8_BAR; }
        { int t3_ = tid; asm volatile("" : "+v"(t3_)); const int l3_ = t3_ & 63; E(acc, cur, wr, wc, l3_ & 15, l3_ >> 4); }
        if (!has_next) break;
#pragma unroll
        for (int a = 0; a < 2; ++a)
#pragma unroll
            for (int b = 0; b < 2; ++b)
#pragma unroll
                for (int m = 0; m < 4; ++m)
#pragma unroll
                    for (int n = 0; n < 2; ++n) acc[a][b][m][n] = (f32x4){0.f, 0.f, 0.f, 0.f};
        cur = nxt; cA = nA; cB = nB; ++ui;
        if (GATHER) {
#pragma unroll
            for (int h = 0; h < 2; ++h)
#pragma unroll
                for (int i = 0; i < 2; ++i) vA[h][i] = vN[h][i];
        }
        if constexpr (ALIGN_EPI) { if (wr == 1) PG8_BAR; }
    }
    PG8_WAIT_V(0);
    if constexpr (!ALIGN_EPI) { if (wr == 0) PG8_BAR; }
    PG8_BAR;
#undef PG8_AOFFS
#undef PG8_SA
#undef PG8_SB
#undef PG8_STAGE
#undef PG8_LDA
#undef PG8_LDB
#undef PG8_MMA
#undef PG8_WAIT_V
#undef PG8_WAIT_L
#undef PG8_BAR
#undef PG8_SCHED
}


constexpr int TS_OFF = 131072 + 1024;
template <bool GATHER> struct MoeOrder {
    const char* A; const char* Bt; const int* rowtok; int nN, nwg, nM, G, c, K; size_t strideE;
    __device__ __forceinline__ void init(const bf16_t* A_, const bf16_t* Bt_, const int* rowtok_, int N, int K_, size_t strideE_, int G_, int c_) {
        A = (const char*)A_; Bt = (const char*)Bt_; rowtok = rowtok_; nN = N / BM; K = K_; strideE = strideE_; G = G_; c = c_;
        nM = ((LAS const int*)(LDSP + TS_OFF))[32]; nwg = nM * nN; }
    __device__ __forceinline__ bool next(int i, GUnit& u) const {
        const long L = (long)i * G + c; if (L >= nwg) return false;
        int wgid = (int)L; { const int q = nwg / NXCD, r = nwg % NXCD, xcd = wgid % NXCD, off = wgid / NXCD; wgid = (xcd < r ? xcd * (q + 1) : r * (q + 1) + (xcd - r) * q) + off; }
        const int nig = WGM * nN, gid = wgid / nig, fm = gid * WGM, gsz = (nM - fm) < WGM ? (nM - fm) : WGM;
        u.pm = fm + ((wgid % nig) % gsz); u.pn = (wgid % nig) / gsz;
        LAS const int* ts = (LAS const int*)(LDSP + TS_OFF);
        int e = 0; while (e < NEXP - 1 && ts[e + 1] <= u.pm) ++e;
        u.e = e; u.row0 = (u.pm - ts[e]) * BM; u.cnt = ts[33 + e];
        u.A = GATHER ? A : A + (size_t)u.pm * BM * K * 2;
        u.B = Bt + (size_t)e * strideE + (size_t)u.pn * BM * K * 2; return true;
    }
    __device__ __forceinline__ unsigned aoff(const GUnit& u, int row) const {
        if (GATHER) { int sl = u.row0 + row; sl = sl < u.cnt ? sl : u.cnt - 1; return (unsigned)rowtok[u.e * ECAP + sl] * (unsigned)(K * 2); }
        return (unsigned)(row * K * 2);
    }
};
__device__ __forceinline__ void moe_tiles(const unsigned* cnt, int tid) {
    LAS int* ts = (LAS int*)(LDSP + TS_OFF);
    if (tid == 0) { int s = 0; for (int e = 0; e < NEXP; ++e) { const int c = (int)cnt[e]; ts[e] = s; ts[33 + e] = c; s += (c + BM - 1) / BM; } ts[NEXP] = s; }
    __syncthreads();
}
struct EpiMoe1 {
    static constexpr bool PERM = true;
    bf16_t* O; const float* b1; const float* rsc;
    __device__ __forceinline__ void operator()(const f32x4 (&acc)[2][2][4][2], const GUnit& u, int wr, int wc, int fr, int fq) const {
        const int rt0 = wr * 64 + fr, col0 = u.pn * 128 + wc * 32 + 8 * fq;
        const float* bg = b1 + (size_t)u.e * 2048 + col0;
        f32x4 bgv[2], blv[2];
#pragma unroll
        for (int n = 0; n < 2; ++n) { bgv[n] = *(const f32x4*)(bg + 4 * n); blv[n] = *(const f32x4*)(bg + DFF + 4 * n); }
#pragma unroll
        for (int ai = 0; ai < 2; ++ai)
#pragma unroll
            for (int m = 0; m < 4; ++m) {
                const int rt = rt0 + ai * HALF + m * 16; int sl = u.row0 + rt; sl = sl < u.cnt ? sl : u.cnt - 1;
                const float r = rsc[u.e * ECAP + sl];
                float o[8];
#pragma unroll
                for (int n = 0; n < 2; ++n)
#pragma unroll
                    for (int j = 0; j < 4; ++j) {
                        const float g = fminf(r * acc[ai][0][m][n][j] + bgv[n][j], 7.f);
                        const float l = fminf(fmaxf(r * acc[ai][1][m][n][j] + blv[n][j], -7.f), 7.f);
                        o[n * 4 + j] = g / (1.f + __expf(-1.702f * g)) * (l + 1.f);
                    }
                u32x4 w; w.x = cvt_pk_bf16(o[0], o[1]); w.y = cvt_pk_bf16(o[2], o[3]); w.z = cvt_pk_bf16(o[4], o[5]); w.w = cvt_pk_bf16(o[6], o[7]);
                *(u32x4*)(O + (size_t)(u.pm * BM + rt) * DFF + col0) = w;
            }
    }
};
struct EpiMoe2 {
    static constexpr bool PERM = true;
    bf16_t* O; const float* b2;
    __device__ __forceinline__ void operator()(const f32x4 (&acc)[2][2][4][2], const GUnit& u, int wr, int wc, int fr, int fq) const {
        const int row0 = u.pm * BM + wr * 64 + fr, col0 = u.pn * BM + wc * 32 + 8 * fq;
        f32x4 bv[2][2];
#pragma unroll
        for (int bj = 0; bj < 2; ++bj)
#pragma unroll
            for (int n = 0; n < 2; ++n) bv[bj][n] = *(const f32x4*)(b2 + (size_t)u.e * DM + col0 + bj * HALF + 4 * n);
#pragma unroll
        for (int ai = 0; ai < 2; ++ai)
#pragma unroll
            for (int m = 0; m < 4; ++m) { bf16_t* rowp = O + (size_t)(row0 + ai * HALF + m * 16) * DM + col0;
#pragma unroll
                for (int bj = 0; bj < 2; ++bj) { const f32x4 v0 = acc[ai][bj][m][0] + bv[bj][0], v1 = acc[ai][bj][m][1] + bv[bj][1];
                    u32x4 w; w.x = cvt_pk_bf16(v0[0], v0[1]); w.y = cvt_pk_bf16(v0[2], v0[3]); w.z = cvt_pk_bf16(v1[0], v1[1]); w.w = cvt_pk_bf16(v1[2], v1[3]);
                    *(u32x4*)(rowp + bj * HALF) = w; } }
    }
};

__device__ __forceinline__ void transpose_item(const float* W, int K, int N, bf16_t* WT, const float* kgain, int mode, LAS float* scr, int item, int lane) {
    const int nblk = N / 32, kb = item / nblk, nb = item % nblk, k0 = 64 * kb, n0 = 32 * nb;
#pragma unroll 8
    for (int i = 0; i < 32; ++i) { const int kk = 2 * i + (lane >> 5); float v = W[(size_t)(k0 + kk) * N + n0 + (lane & 31)]; if (kgain) v *= kgain[k0 + kk]; scr[kk * 33 + (lane & 31)] = v; }
    asm volatile("s_waitcnt lgkmcnt(0)" ::: "memory");
    int d0 = n0;
    if (mode == 1) { const int bj = n0 >> 10, rest = n0 & 1023, pn = rest >> 7, j = rest & 127; d0 = pn * 256 + bj * 128 + j; }
    const int c = lane & 7;
#pragma unroll
    for (int j = 0; j < 4; ++j) { const int n = (lane >> 3) + 8 * j; const LAS float* sp = scr + (8 * c) * 33 + n;
        u32x4 o; o.x = pk2(sp[0 * 33], sp[1 * 33]); o.y = pk2(sp[2 * 33], sp[3 * 33]); o.z = pk2(sp[4 * 33], sp[5 * 33]); o.w = pk2(sp[6 * 33], sp[7 * 33]);
        *(u32x4*)(WT + (size_t)(d0 + n) * K + k0 + 8 * c) = o; }
    asm volatile("s_waitcnt lgkmcnt(0)" ::: "memory");
}
__device__ __forceinline__ void p_transpose(const int wv, const float* W, int K, int N, bf16_t* WT, const float* kgain, int mode, LAS unsigned char* lds) {
    LTID();
    const int wave = tidx >> 6, lane = tidx & 63;
    LAS float* scr = (LAS float*)(lds + wave * 16384);
    const int nitems = (K / 64) * (N / 32);
    for (int it = bidx * NW + wave; it < nitems; it += gridDim.x * NW) transpose_item(W, K, N, WT, kgain, mode, scr, it, lane);
}


typedef short v4i16_t __attribute__((ext_vector_type(4)));
constexpr int ATT_TAB_OFF = 131072 + 2048;
constexpr int ATT_UNITS = 3 * 8 * 128;
__device__ __forceinline__ int t5_bucket_dev(int n) {
    if (n < 16) return n;
    const float v = logf((float)n / 16.f) / 4.852030263919617f * 16.f;
    const int large = 16 + (int)v;
    return large < 31 ? large : 31;
}
__device__ __forceinline__ void p_bias_table(const int wv, const float* rel_bias, float* biasG) {
    LTID();
    for (int i = bidx * NT + tidx; i < 3 * 8 * 132; i += gridDim.x * NT) {
        const int d = i % 132, bh = i / 132, h = bh & 7, b = bh >> 3;
        biasG[i] = (d <= 128) ? rel_bias[t5_bucket_dev(d << (2 * b)) * 8 + h] : 0.f;
    }
}
__device__ __forceinline__ void p_dil_attn(const int wv, const bf16_t* proj16, const float* biasG, bf16_t* obr, float* lse, LAS unsigned char* lds) {
    LTID();
    const int lane = tidx & 63, fr = lane & 15, fq = lane >> 4, w = wv;
    const int per = (ATT_UNITS + (int)gridDim.x - 1) / (int)gridDim.x;
    const int u0 = bidx * per, u1 = (u0 + per < ATT_UNITS) ? u0 + per : ATT_UNITS;
    if (u0 >= u1) return;
    const int rowl = tidx >> 3, cs = tidx & 7;
    const unsigned cK = (unsigned)(cs ^ ((rowl >> 1) & 7)) * 16u, cV = (unsigned)(cs ^ (rowl & 7)) * 16u;
    const unsigned fK = (unsigned)((fr >> 1) & 7);
    const unsigned kro0 = (unsigned)fr * 128u + (((unsigned)fq ^ fK) * 16u), kro1 = (unsigned)fr * 128u + ((((unsigned)fq ^ fK) ^ 4u) * 16u);
    const int tq = (lane & 15) >> 2, tp = lane & 3, fv = 4 * (fq & 1) + tq;
    unsigned vro[4];
#pragma unroll
    for (int db = 0; db < 4; ++db) vro[db] = (unsigned)(4 * fq + tq) * 128u + (unsigned)(((2 * db + (tp >> 1)) ^ fv) * 16) + 8u * (unsigned)(tp & 1);
    const int ts_ = (1 + fr) & 3;
    const unsigned tab8 = (unsigned)ATT_TAB_OFF + (unsigned)ts_ * 640u + (unsigned)(((141 + fr - ts_) >> 2) - fq - 32) * 16u;
    const char* gbase = (const char*)proj16;
#define ATT_DECODE(u, b_, h_, r_, n_, dil_) const int cmb_ = (u) >> 7, b_ = cmb_ >> 3, h_ = cmb_ & 7, dil_ = 1 << (2 * b_), idx_ = (u) & 127, r_ = idx_ & (dil_ - 1), n_ = idx_ >> (2 * b_)
#define ATT_ISSUE(u, bf, q0, q1) do { ATT_DECODE(u, b__, h__, r__, n__, dil__); \
        const int nk = n__ > 0 ? n__ - 1 : 0;                                     \
        _Pragma("unroll") for (int p = 0; p < 4; ++p) { \
            int row = 64 * p + rowl; int blk = (row >> 7) ? n__ : nk; \
            const unsigned pos = (unsigned)(r__ + dil__ * (128 * blk + (row & 127))); \
            const unsigned so = pos * 4096u + (unsigned)h__ * 128u; const unsigned ld_ = (unsigned)(size_t)(lds + (bf) * 65536 + p * 8192 + w * 1024); \
            glds16s(gbase, so + 1024u + cK, ld_); glds16s(gbase, so + 2048u + cV, ld_ + 32768u); } \
        const unsigned qpos = (unsigned)(r__ + dil__ * (128 * n__ + 16 * w + fr)); \
        const char* qsrc = gbase + (size_t)qpos * 4096u + (unsigned)h__ * 128u + (unsigned)fq * 16u; \
        q0 = *(const bf16x8*)(qsrc); q1 = *(const bf16x8*)(qsrc + 64); } while (0)
    bf16x8 qf0, qf1, qn0, qn1;
    ATT_ISSUE(u0, 0, qn0, qn1);
    int prev_cmb = -1;
    for (int u = u0; u < u1; ++u) {
        const int bf = (u - u0) & 1;
        asm volatile("s_waitcnt vmcnt(0)" ::: "memory");
        __syncthreads();
        qf0 = qn0; qf1 = qn1;
        if (u + 1 < u1) ATT_ISSUE(u + 1, bf ^ 1, qn0, qn1);
        ATT_DECODE(u, b, h, r, n, dil);
        if (cmb_ != prev_cmb) {
            prev_cmb = cmb_;
            for (int e = tidx; e < 4 * 160; e += NT) { const int sft = e / 160, k = e - sft * 160, idx = k + sft, dist = idx - 16;
                const float v = (dist >= 0 && dist <= 128) ? biasG[cmb_ * 132 + dist] : -1e30f;
                ((LAS float*)(lds + ATT_TAB_OFF))[sft * 160 + k] = v; }
            __syncthreads();
        }
        const LAS unsigned char* Kb = lds + bf * 65536; const LAS unsigned char* Vb = Kb + 32768;
        const int kb0 = w;
        f32x4 sc[9];
#pragma unroll
        for (int i = 0; i < 9; ++i) {
            const unsigned ko = (unsigned)(kb0 + i) * 2048u;
            const bf16x8 k0 = *(const LAS bf16x8*)(Kb + ko + kro0), k1 = *(const LAS bf16x8*)(Kb + ko + kro1);
            f32x4 a = (f32x4){0.f, 0.f, 0.f, 0.f};
            a = __builtin_amdgcn_mfma_f32_16x16x32_bf16(k0, qf0, a, 0, 0, 0);
            a = __builtin_amdgcn_mfma_f32_16x16x32_bf16(k1, qf1, a, 0, 0, 0);
            const f32x4 t = *(const LAS f32x4*)(lds + tab8 + 64 * (8 - i));
            a = a + (f32x4){t[3], t[2], t[1], t[0]};
            if (n == 0 && kb0 + i < 8) a = (f32x4){-1e30f, -1e30f, -1e30f, -1e30f};
            sc[i] = a;
        }
        float mx = -1e30f;
#pragma unroll
        for (int i = 0; i < 9; ++i) mx = fmaxf(mx, fmaxf(fmaxf(sc[i][0], sc[i][1]), fmaxf(sc[i][2], sc[i][3])));
        mx = fmaxf(mx, shx(mx, 16, lane)); mx = fmaxf(mx, shx(mx, 32, lane));
        float sum = 0.f;
#pragma unroll
        for (int i = 0; i < 9; ++i)
#pragma unroll
            for (int j = 0; j < 4; ++j) { const float p = __expf(sc[i][j] - mx); sc[i][j] = p; sum += p; }
        sum += shx(sum, 16, lane); sum += shx(sum, 32, lane);
        f32x4 oacc[4];
#pragma unroll
        for (int db = 0; db < 4; ++db) oacc[db] = (f32x4){0.f, 0.f, 0.f, 0.f};
#pragma unroll
        for (int c = 0; c < 5; ++c) {
            const int ia = 2 * c, ib = (c < 4) ? 2 * c + 1 : 8;
            u32x4 pw; pw.x = cvt_pk_bf16(sc[ia][0], sc[ia][1]); pw.y = cvt_pk_bf16(sc[ia][2], sc[ia][3]);
            if (c < 4) { pw.z = cvt_pk_bf16(sc[ib][0], sc[ib][1]); pw.w = cvt_pk_bf16(sc[ib][2], sc[ib][3]); } else { pw.z = 0u; pw.w = 0u; }
            const bf16x8 pf = __builtin_bit_cast(bf16x8, pw);
            const unsigned va = (unsigned)(kb0 + ia) * 2048u, vb = (unsigned)(kb0 + ib) * 2048u;
#pragma unroll
            for (int db = 0; db < 4; ++db) {
                const v4i16_t x0 = __builtin_amdgcn_ds_read_tr16_b64_v4i16((LAS v4i16_t*)(Vb + va + vro[db]));
                const v4i16_t x1 = __builtin_amdgcn_ds_read_tr16_b64_v4i16((LAS v4i16_t*)(Vb + vb + vro[db]));
                const bf16x8 vf = (bf16x8){x0[0], x0[1], x0[2], x0[3], x1[0], x1[1], x1[2], x1[3]};
                oacc[db] = __builtin_amdgcn_mfma_f32_16x16x32_bf16(vf, pf, oacc[db], 0, 0, 0);
            }
        }
        const float inv = 1.f / sum;
        const unsigned qpos = (unsigned)(r + dil * (128 * n + 16 * w + fr));
        bf16_t* orow = obr + ((size_t)b * SEQ + qpos) * 512 + h * 64 + 4 * fq;
#pragma unroll
        for (int db = 0; db < 4; ++db) { u32x2 o2; o2.x = cvt_pk_bf16(oacc[db][0] * inv, oacc[db][1] * inv); o2.y = cvt_pk_bf16(oacc[db][2] * inv, oacc[db][3] * inv); *(u32x2*)(orow + 16 * db) = o2; }
        if (fq == 0) lse[((size_t)b * SEQ + qpos) * 8 + h] = mx + __logf(sum);
    }
    asm volatile("s_waitcnt vmcnt(0)" ::: "memory");
    __syncthreads();
#undef ATT_DECODE
#undef ATT_ISSUE
}
__device__ __forceinline__ void p_attn_combine(const int wv, const bf16_t* obr, const float* lse, const float* g, bf16_t* mix16) {
    LTID();
    const int lane = tidx & 63, h = lane >> 3;
    f32x4 g0 = *(const f32x4*)(g + lane * 8), g1 = *(const f32x4*)(g + lane * 8 + 4);
    for (int row = bidx * NW + wv; row < SEQ; row += gridDim.x * NW) {
        float l0 = lse[((size_t)0 * SEQ + row) * 8 + h], l1 = lse[((size_t)1 * SEQ + row) * 8 + h], l2 = lse[((size_t)2 * SEQ + row) * 8 + h];
        const float M = fmaxf(l0, fmaxf(l1, l2));
        float w0 = __expf(l0 - M), w1 = __expf(l1 - M), w2 = __expf(l2 - M);
        const float iw = 1.f / (w0 + w1 + w2); w0 *= iw; w1 *= iw; w2 *= iw;
        const u32x4 a0 = *(const u32x4*)(obr + ((size_t)0 * SEQ + row) * 512 + lane * 8);
        const u32x4 a1 = *(const u32x4*)(obr + ((size_t)1 * SEQ + row) * 512 + lane * 8);
        const u32x4 a2 = *(const u32x4*)(obr + ((size_t)2 * SEQ + row) * 512 + lane * 8);
        float y[8]; float ss = 0.f;
#pragma unroll
        for (int k = 0; k < 4; ++k) {
            const float lo = w0 * __builtin_bit_cast(float, a0[k] << 16) + w1 * __builtin_bit_cast(float, a1[k] << 16) + w2 * __builtin_bit_cast(float, a2[k] << 16);
            const float hi = w0 * __builtin_bit_cast(float, a0[k] & 0xffff0000u) + w1 * __builtin_bit_cast(float, a1[k] & 0xffff0000u) + w2 * __builtin_bit_cast(float, a2[k] & 0xffff0000u);
            y[2 * k] = lo; y[2 * k + 1] = hi; ss += lo * lo + hi * hi;
        }
#pragma unroll
        for (int o = 32; o; o >>= 1) ss += shx(ss, o, lane);
        const float sc = rsqrtf(ss * (1.f / 512.f) + 1e-5f);
        u32x4 o4; o4.x = cvt_pk_bf16(y[0] * sc * g0[0], y[1] * sc * g0[1]); o4.y = cvt_pk_bf16(y[2] * sc * g0[2], y[3] * sc * g0[3]);
        o4.z = cvt_pk_bf16(y[4] * sc * g1[0], y[5] * sc * g1[1]); o4.w = cvt_pk_bf16(y[6] * sc * g1[2], y[7] * sc * g1[3]);
        *(u32x4*)(mix16 + (size_t)row * DM + lane * 8) = o4;
    }
}
struct EpiIn {
    static constexpr bool PERM = true;
    bf16_t* O;
    __device__ __forceinline__ void operator()(const f32x4 (&acc)[2][2][4][2], const GUnit& u, int wr, int wc, int fr, int fq) const {
        const int row0 = u.pm * BM + wr * 64 + fr, col0 = u.pn * BM + wc * 32 + 8 * fq;
        const float sc = u.pn < 2 ? 0.125f : 1.f;
#pragma unroll
        for (int ai = 0; ai < 2; ++ai)
#pragma unroll
            for (int m = 0; m < 4; ++m) { const size_t ro = (size_t)(row0 + ai * HALF + m * 16) * DIN + col0;
#pragma unroll
                for (int bj = 0; bj < 2; ++bj) { const f32x4 v0 = acc[ai][bj][m][0] * sc, v1 = acc[ai][bj][m][1] * sc;
                    u32x4 w; w.x = cvt_pk_bf16(v0[0], v0[1]); w.y = cvt_pk_bf16(v0[2], v0[3]); w.z = cvt_pk_bf16(v1[0], v1[1]); w.w = cvt_pk_bf16(v1[2], v1[3]);
                    *(u32x4*)(O + ro + bj * HALF) = w;
                    } }
    }
};


__device__ __forceinline__ unsigned xoff_b(unsigned row, unsigned ch) { return 256u * row + 16u * (ch ^ (((row & 3u) << 2) | ((row >> 2) & 3u))); }
__device__ __forceinline__ void p_xattn_mfma(const int wv, const bf16_t* qx16, const bf16_t* kv16, bf16_t* ox16, LAS unsigned char* lds) {
    LTID();
    const int lane = tidx & 63, fr = lane & 15, fq = lane >> 4, w = wv;
    const int NU = 4 * 128;
    const int per = (NU + (int)gridDim.x - 1) / (int)gridDim.x;
    const int u0 = bidx * per, u1 = (u0 + per < NU) ? u0 + per : NU;
    if (u0 >= u1) return;
    const int rowl = tidx >> 4, cs = tidx & 15;
    const unsigned csw = (unsigned)(cs ^ (((rowl & 3) << 2) | ((rowl >> 2) & 3))) * 16u;
    const unsigned kswz = (unsigned)(((fr & 3) << 2) | ((fr >> 2) & 3));
    unsigned kro[4];
#pragma unroll
    for (int s4 = 0; s4 < 4; ++s4) kro[s4] = 256u * (unsigned)fr + 16u * ((unsigned)(4 * s4 + fq) ^ kswz);
    const int tq = (lane & 15) >> 2, tp = lane & 3;
    const unsigned vswz = (unsigned)((tq << 2) | fq);
    unsigned vro[8];
#pragma unroll
    for (int c = 0; c < 8; ++c) vro[c] = 65536u + 256u * (unsigned)(4 * fq + tq) + 16u * ((unsigned)(2 * c + (tp >> 1)) ^ vswz) + 8u * (unsigned)(tp & 1);
    int prev_h = -1;
    for (int u = u0; u < u1; ++u) {
        const int h = u >> 7, qt = u & 127;
        if (h != prev_h) {
            __syncthreads();
            prev_h = h;
#pragma unroll
            for (int p = 0; p < 8; ++p) {
                const unsigned row = (unsigned)(32 * p + rowl);
                const unsigned so = row * 2048u + (unsigned)h * 256u + csw;
                const unsigned ld_ = (unsigned)(size_t)(lds + p * 8192 + w * 1024);
                glds16s(kv16, so, ld_); glds16s(kv16, so + 1024u, ld_ + 65536u);
            }
            asm volatile("s_waitcnt vmcnt(0)" ::: "memory");
            __syncthreads();
        }
        const char* qsrc = (const char*)qx16 + ((size_t)(qt * 128 + 16 * w + fr) * 512 + h * 128 + 8 * fq) * 2;
        bf16x8 qf[4];
#pragma unroll
        for (int s4 = 0; s4 < 4; ++s4) qf[s4] = *(const bf16x8*)(qsrc + 64 * s4);
        f32x4 sc[16];
#pragma unroll
        for (int i = 0; i < 16; ++i) {
            f32x4 a = (f32x4){0.f, 0.f, 0.f, 0.f};
#pragma unroll
            for (int s4 = 0; s4 < 4; ++s4) { const bf16x8 kf = *(const LAS bf16x8*)(lds + i * 4096 + kro[s4]); a = __builtin_amdgcn_mfma_f32_16x16x32_bf16(kf, qf[s4], a, 0, 0, 0); }
            sc[i] = a;
        }
        float mx = -1e30f;
#pragma unroll
        for (int i = 0; i < 16; ++i) mx = fmaxf(mx, fmaxf(fmaxf(sc[i][0], sc[i][1]), fmaxf(sc[i][2], sc[i][3])));
        mx = fmaxf(mx, shx(mx, 16, lane)); mx = fmaxf(mx, shx(mx, 32, lane));
        float sum = 0.f;
#pragma unroll
        for (int i = 0; i < 16; ++i)
#pragma unroll
            for (int j = 0; j < 4; ++j) { const float p = __expf(sc[i][j] - mx); sc[i][j] = p; sum += p; }
        sum += shx(sum, 16, lane); sum += shx(sum, 32, lane);
        f32x4 oacc[8];
#pragma unroll
        for (int c = 0; c < 8; ++c) oacc[c] = (f32x4){0.f, 0.f, 0.f, 0.f};
#pragma unroll
        for (int ch = 0; ch < 8; ++ch) {
            const int ia = 2 * ch, ib = 2 * ch + 1;
            u32x4 pw; pw.x = cvt_pk_bf16(sc[ia][0], sc[ia][1]); pw.y = cvt_pk_bf16(sc[ia][2], sc[ia][3]); pw.z = cvt_pk_bf16(sc[ib][0], sc[ib][1]); pw.w = cvt_pk_bf16(sc[ib][2], sc[ib][3]);
            const bf16x8 pf = __builtin_bit_cast(bf16x8, pw);
#pragma unroll
            for (int c = 0; c < 8; ++c) {
                const v4i16_t x0 = __builtin_amdgcn_ds_read_tr16_b64_v4i16((LAS v4i16_t*)(lds + ia * 4096 + vro[c]));
                const v4i16_t x1 = __builtin_amdgcn_ds_read_tr16_b64_v4i16((LAS v4i16_t*)(lds + ib * 4096 + vro[c]));
                const bf16x8 vf = (bf16x8){x0[0], x0[1], x0[2], x0[3], x1[0], x1[1], x1[2], x1[3]};
                oacc[c] = __builtin_amdgcn_mfma_f32_16x16x32_bf16(vf, pf, oacc[c], 0, 0, 0);
            }
        }
        const float inv = 1.f / sum;
        bf16_t* orow = ox16 + (size_t)(qt * 128 + 16 * w + fr) * 512 + h * 128 + 4 * fq;
#pragma unroll
        for (int c = 0; c < 8; ++c) { u32x2 o2; o2.x = cvt_pk_bf16(oacc[c][0] * inv, oacc[c][1] * inv); o2.y = cvt_pk_bf16(oacc[c][2] * inv, oacc[c][3] * inv); *(u32x2*)(orow + 16 * c) = o2; }
    }
    __syncthreads();
}
struct EpiBf16 {
    static constexpr bool PERM = true;
    bf16_t* O; int ldc; float scale; const float* ss;
    __device__ __forceinline__ void operator()(const f32x4 (&acc)[2][2][4][2], const GUnit& u, int wr, int wc, int fr, int fq) const {
        const int row0 = u.pm * BM + wr * 64 + fr, col0 = u.pn * BM + wc * 32 + 8 * fq;
#pragma unroll
        for (int ai = 0; ai < 2; ++ai)
#pragma unroll
            for (int m = 0; m < 4; ++m) { const int row = row0 + ai * HALF + m * 16; bf16_t* rowp = O + (size_t)row * ldc + col0;
                float sc = scale;
                if (ss) { const f32x4 p0 = *(const f32x4*)(ss + (size_t)row * 16), p1 = *(const f32x4*)(ss + (size_t)row * 16 + 4), p2 = *(const f32x4*)(ss + (size_t)row * 16 + 8), p3 = *(const f32x4*)(ss + (size_t)row * 16 + 12);
                    const float t = ((p0[0] + p0[1]) + (p0[2] + p0[3])) + ((p1[0] + p1[1]) + (p1[2] + p1[3])) + ((p2[0] + p2[1]) + (p2[2] + p2[3])) + ((p3[0] + p3[1]) + (p3[2] + p3[3]));
                    sc = scale * rsqrtf(t * (1.f / 1024.f) + 1e-5f); }
#pragma unroll
                for (int bj = 0; bj < 2; ++bj) { const f32x4 v0 = acc[ai][bj][m][0] * sc, v1 = acc[ai][bj][m][1] * sc;
                    u32x4 w; w.x = cvt_pk_bf16(v0[0], v0[1]); w.y = cvt_pk_bf16(v0[2], v0[3]); w.z = cvt_pk_bf16(v1[0], v1[1]); w.w = cvt_pk_bf16(v1[2], v1[3]);
                    *(u32x4*)(rowp + bj * HALF) = w; } }
    }
};
struct EpiOut {
    static constexpr bool PERM = true;
    float* H; bf16_t* HB; float* ss;
    __device__ __forceinline__ void operator()(const f32x4 (&acc)[2][2][4][2], const GUnit& u, int wr, int wc, int fr, int fq) const {
        const int row0 = u.pm * BM + wr * 64 + fr, col0 = u.pn * BM + wc * 32 + 8 * fq, lane = fq * 16 + fr;
#pragma unroll
        for (int ai = 0; ai < 2; ++ai)
#pragma unroll
            for (int m = 0; m < 4; ++m) { const int row = row0 + ai * HALF + m * 16; const size_t ro = (size_t)row * DM + col0; float sq = 0.f;
#pragma unroll
                for (int bj = 0; bj < 2; ++bj) {
                    const f32x4 v0 = acc[ai][bj][m][0] + *(const f32x4*)(H + ro + bj * HALF), v1 = acc[ai][bj][m][1] + *(const f32x4*)(H + ro + bj * HALF + 4);
                    *(f32x4*)(H + ro + bj * HALF) = v0; *(f32x4*)(H + ro + bj * HALF + 4) = v1;
                    u32x4 w; w.x = cvt_pk_bf16(v0[0], v0[1]); w.y = cvt_pk_bf16(v0[2], v0[3]); w.z = cvt_pk_bf16(v1[0], v1[1]); w.w = cvt_pk_bf16(v1[2], v1[3]);
                    *(u32x4*)(HB + ro + bj * HALF) = w;
                    sq += (v0[0] * v0[0] + v0[1] * v0[1]) + (v0[2] * v0[2] + v0[3] * v0[3]) + (v1[0] * v1[0] + v1[1] * v1[1]) + (v1[2] * v1[2] + v1[3] * v1[3]);
                }
                sq += shx(sq, 16, lane); sq += shx(sq, 32, lane);
                if (fq == 0) ss[(size_t)row * 16 + u.pn * 4 + wc] = sq;
            }
    }
};

typedef short bf16x4 __attribute__((ext_vector_type(4)));
typedef float f32x2 __attribute__((ext_vector_type(2)));
constexpr int S5_CHUNK = 256, S5_NCH = SEQ / S5_CHUNK, S5_ROWB = 528;
__device__ __forceinline__ f32x2 gelu_pk(f32x2 v) {
    const f32x2 av = __builtin_elementwise_abs(v), d = av * 0.2316418882f + 1.0f;
    f32x2 t; t.x = __builtin_amdgcn_rcpf(d.x); t.y = __builtin_amdgcn_rcpf(d.y);
    f32x2 q = t * 0.5307027145f + (-0.7265760135f); q = q * t + 0.7107068705f; q = q * t + (-0.142248368f); q = q * t + 0.127414796f; q = q * t;
    const f32x2 s2 = (v * v) * (-0.72134752044f);
    f32x2 e; e.x = __builtin_amdgcn_exp2f(s2.x); e.y = __builtin_amdgcn_exp2f(s2.y);
    const f32x2 m = v * (q * e), r = v - m;
    f32x2 o; o.x = v.x < 0.f ? m.x : r.x; o.y = v.y < 0.f ? m.y : r.y; return o;
}
__device__ __forceinline__ void p_s5_tables2(const int wv, const float* a_re, const float* a_im, const float* b_re, const float* b_im, const float* c_re, const float* c_im, const float* log_dt,
                                             float2* abar, float2* a256, bf16_t* BB16, bf16_t* CM16) {
    LTID();
    for (int gp = bidx * NT + tidx; gp < 2048; gp += gridDim.x * NT) {
        const int g = gp >> 6, p = gp & 63;
        const float lr = a_re[gp], li = a_im[gp], dt = expf(log_dt[g]);
        const float mag = expf(lr * dt); float sn, cs; sincosf(li * dt, &sn, &cs);
        const float ar = mag * cs, ai = mag * sn;
        abar[gp] = make_float2(ar, ai);
        float pr = ar, pi = ai;
        for (int i = 0; i < 8; ++i) { const float nr = pr * pr - pi * pi, ni = 2.f * pr * pi; pr = nr; pi = ni; }
        a256[gp] = make_float2(pr, pi);
        const float nr = ar - 1.f, ni = ai, den = lr * lr + li * li;
        const float cr = (nr * lr + ni * li) / den, ci = (ni * lr - nr * li) / den;
        for (int c = 0; c < 16; ++c) {
            const float br = b_re[gp * 16 + c], bi = b_im[gp * 16 + c];
            BB16[((size_t)g * 128 + p) * 16 + c] = (bf16_t)f2bf(cr * br - ci * bi);
            BB16[((size_t)g * 128 + 64 + p) * 16 + c] = (bf16_t)f2bf(cr * bi + ci * br);
            CM16[((size_t)g * 16 + c) * 128 + p] = (bf16_t)f2bf(c_re[(g * 16 + c) * 64 + p]);
            CM16[((size_t)g * 16 + c) * 128 + 64 + p] = (bf16_t)f2bf(-c_im[(g * 16 + c) * 64 + p]);
        }
    }
}
template <int MODE> __device__ __forceinline__ void p_s5_pass(const int wv, const bf16_t* proj16, const float2* abar, const float2* a256, const bf16_t* BB16, const bf16_t* CM16, const float* dskip,
                                                              float2* E, bf16_t* yg16, LAS unsigned char* lds) {
    LTID();
    const int lane = tidx & 63, fr = lane & 15, fq = lane >> 4;
    LAS unsigned char* L = lds + wv * (16 * S5_ROWB);
    for (int unit = bidx * NW + wv; unit < S5_NCH * 32; unit += gridDim.x * NW) {
        const int g = unit & 31, chunk = unit >> 5;
        const float2 a = abar[g * 64 + lane];
        bf16x4 bbf[8];
#pragma unroll
        for (int cb = 0; cb < 8; ++cb) bbf[cb] = *(const bf16x4*)(BB16 + ((size_t)g * 128 + 16 * cb + fr) * 16 + 4 * fq);
        bf16x8 cmf[4]; f32x4 dsk = (f32x4){0.f, 0.f, 0.f, 0.f};
        if (MODE == 1) {
#pragma unroll
            for (int s4 = 0; s4 < 4; ++s4) cmf[s4] = *(const bf16x8*)(CM16 + ((size_t)g * 16 + fr) * 128 + 32 * s4 + 8 * fq);
            dsk = *(const f32x4*)(dskip + g * 16 + 4 * fq);
        }
        float sr = 0.f, si = 0.f;
        if (MODE == 1) {
            const float2 A = a256[g * 64 + lane];
            for (int j0 = 0; j0 < chunk; j0 += 8) {
                float2 e[8];
#pragma unroll
                for (int k = 0; k < 8; ++k) { const int j = (j0 + k < chunk) ? j0 + k : chunk - 1; e[k] = E[((size_t)j * 32 + g) * 64 + lane]; }
#pragma unroll
                for (int k = 0; k < 8; ++k) if (j0 + k < chunk) { const float nr = A.x * sr - A.y * si + e[k].x, ni = A.x * si + A.y * sr + e[k].y; sr = nr; si = ni; }
            }
        }
        const bf16_t* ubase = proj16 + (size_t)(chunk * S5_CHUNK + fr) * DIN + 1536 + g * 16 + 4 * fq;
        bf16x4 uf = *(const bf16x4*)ubase;
#pragma unroll 1
        for (int blk = 0; blk < S5_CHUNK / 16; ++blk) {
            const bf16x4 ufn = *(const bf16x4*)(ubase + (size_t)((blk < S5_CHUNK / 16 - 1) ? (blk + 1) * 16 : blk * 16) * DIN);
            asm volatile("" ::: "memory");
#pragma unroll
            for (int cb = 0; cb < 8; ++cb) {
                const f32x4 d = __builtin_amdgcn_mfma_f32_16x16x16bf16_1k(bbf[cb], uf, (f32x4){0.f, 0.f, 0.f, 0.f}, 0, 0, 0);
                *(LAS f32x4*)(L + fr * S5_ROWB + (16 * cb + 4 * fq) * 4) = d;
            }
            asm volatile("" ::: "memory");
#pragma unroll
            for (int t = 0; t < 16; ++t) {
                const float re = *(const LAS float*)(L + t * S5_ROWB + lane * 4), im = *(const LAS float*)(L + t * S5_ROWB + 256 + lane * 4);
                const float nr = a.x * sr - a.y * si + re, ni = a.x * si + a.y * sr + im; sr = nr; si = ni;
                if (MODE == 1) { *(LAS bf16_t*)(L + t * S5_ROWB + lane * 2) = (bf16_t)f2bf(sr); *(LAS bf16_t*)(L + t * S5_ROWB + 128 + lane * 2) = (bf16_t)f2bf(si); }
            }
            asm volatile("" ::: "memory");
            if (MODE == 1) {
                f32x4 y = (f32x4){0.f, 0.f, 0.f, 0.f};
#pragma unroll
                for (int s4 = 0; s4 < 4; ++s4) { const bf16x8 sf = *(const LAS bf16x8*)(L + fr * S5_ROWB + 64 * s4 + 16 * fq); y = __builtin_amdgcn_mfma_f32_16x16x32_bf16(cmf[s4], sf, y, 0, 0, 0); }
                f32x4 v;
#pragma unroll
                for (int j = 0; j < 4; ++j) v[j] = y[j] + dsk[j] * bf2f((unsigned short)uf[j]);
                const f32x2 g0 = gelu_pk((f32x2){v[0], v[1]}), g1 = gelu_pk((f32x2){v[2], v[3]});
                u32x2 o2; o2.x = cvt_pk_bf16(g0.x, g0.y); o2.y = cvt_pk_bf16(g1.x, g1.y);
                *(u32x2*)(yg16 + (size_t)(chunk * S5_CHUNK + blk * 16 + fr) * 512 + g * 16 + 4 * fq) = o2;
            }
            asm volatile("" ::: "memory");
            uf = ufn;
        }
        if (MODE == 0) E[((size_t)chunk * 32 + g) * 64 + lane] = make_float2(sr, si);
    }
}
struct EpiGlu16 {
    static constexpr bool PERM = true;
    bf16_t* O; const bf16_t* Y; const float* bias;
    __device__ __forceinline__ void operator()(const f32x4 (&acc)[2][2][4][2], const GUnit& u, int wr, int wc, int fr, int fq) const {
        const int row0 = u.pm * BM + wr * 64 + fr, col0 = u.pn * BM + wc * 32 + 8 * fq;
        f32x4 bv[2][2];
#pragma unroll
        for (int bj = 0; bj < 2; ++bj)
#pragma unroll
            for (int n = 0; n < 2; ++n) bv[bj][n] = *(const f32x4*)(bias + col0 + bj * HALF + 4 * n);
#pragma unroll
        for (int ai = 0; ai < 2; ++ai)
#pragma unroll
            for (int m = 0; m < 4; ++m) { const size_t ro = (size_t)(row0 + ai * HALF + m * 16) * 512 + col0;
#pragma unroll
                for (int bj = 0; bj < 2; ++bj) {
                    const u32x4 yv = *(const u32x4*)(Y + ro + bj * HALF);
                    float o[8];
#pragma unroll
                    for (int n = 0; n < 2; ++n)
#pragma unroll
                        for (int j = 0; j < 4; ++j) { const unsigned wd = yv[n * 2 + (j >> 1)]; const float y = __builtin_bit_cast(float, (j & 1) ? (wd & 0xffff0000u) : (wd << 16));
                            o[n * 4 + j] = y / (1.f + __expf(-(acc[ai][bj][m][n][j] + bv[bj][n][j]))); }
                    u32x4 w; w.x = cvt_pk_bf16(o[0], o[1]); w.y = cvt_pk_bf16(o[2], o[3]); w.z = cvt_pk_bf16(o[4], o[5]); w.w = cvt_pk_bf16(o[6], o[7]);
                    *(u32x4*)(O + ro + bj * HALF) = w; } }
    }
};
__device__ __forceinline__ void p_ssm_norm(const int wv, const bf16_t* yb16, const float* g, bf16_t* mix16) {
    LTID();
    const int lane = tidx & 63;
    const f32x4 g0 = *(const f32x4*)(g + lane * 8), g1 = *(const f32x4*)(g + lane * 8 + 4);
    for (int row = bidx * NW + wv; row < SEQ; row += gridDim.x * NW) {
        const u32x4 a0 = *(const u32x4*)(yb16 + (size_t)row * 512 + lane * 8);
        float y[8]; float ss = 0.f;
#pragma unroll
        for (int k = 0; k < 4; ++k) { y[2 * k] = __builtin_bit_cast(float, a0[k] << 16); y[2 * k + 1] = __builtin_bit_cast(float, a0[k] & 0xffff0000u); ss += y[2 * k] * y[2 * k] + y[2 * k + 1] * y[2 * k + 1]; }
#pragma unroll
        for (int o = 32; o; o >>= 1) ss += shx(ss, o, lane);
        const float sc = rsqrtf(ss * (1.f / 512.f) + 1e-5f);
        u32x4 o4; o4.x = cvt_pk_bf16(y[0] * sc * g0[0], y[1] * sc * g0[1]); o4.y = cvt_pk_bf16(y[2] * sc * g0[2], y[3] * sc * g0[3]);
        o4.z = cvt_pk_bf16(y[4] * sc * g1[0], y[5] * sc * g1[1]); o4.w = cvt_pk_bf16(y[6] * sc * g1[2], y[7] * sc * g1[3]);
        *(u32x4*)(mix16 + (size_t)row * DM + 512 + lane * 8) = o4;
    }
}

__device__ __forceinline__ void p_rmsnorm16(const int wv, const float* in, const float* g, bf16_t* out16, int rows) {
    LTID();
    const int lane = tidx & 63;
    for (int r = bidx * NW + wv; r < rows; r += gridDim.x * NW) {
        f32x4 v[4]; float ss = 0.f;
#pragma unroll
        for (int j = 0; j < 4; ++j) { v[j] = *(const f32x4*)(in + (size_t)r * DM + 4 * lane + 256 * j); ss += (v[j][0] * v[j][0] + v[j][1] * v[j][1]) + (v[j][2] * v[j][2] + v[j][3] * v[j][3]); }
#pragma unroll
        for (int o = 32; o; o >>= 1) ss += shx(ss, o, lane);
        const float sc = rsqrtf(ss * (1.f / 1024.f) + 1e-5f);
#pragma unroll
        for (int j = 0; j < 4; ++j) { const f32x4 gg = *(const f32x4*)(g + 4 * lane + 256 * j); u32x2 o2; o2.x = cvt_pk_bf16(v[j][0] * sc * gg[0], v[j][1] * sc * gg[1]); o2.y = cvt_pk_bf16(v[j][2] * sc * gg[2], v[j][3] * sc * gg[3]);
            *(u32x2*)(out16 + (size_t)r * DM + 4 * lane + 256 * j) = o2; }
    }
}
template <bool MOE, bool LAST> __device__ __forceinline__ void p_rowfinish(const int wv, const float* hin, float* h, const bf16_t* mout, const int* eslot, const float* topg, const float* g, bf16_t* xn16, float* out) {
    LTID();
    const int lane = tidx & 63;
    LAS const int* ts = (LAS const int*)(LDSP + TS_OFF);
    for (int r = bidx * NW + wv; r < SEQ; r += gridDim.x * NW) {
        f32x4 v[4];
#pragma unroll
        for (int j = 0; j < 4; ++j) v[j] = *(const f32x4*)(hin + (size_t)r * DM + 4 * lane + 256 * j);
        if (MOE) {
            const int4 es = *(const int4*)(eslot + r * 4); const f32x4 gt = *(const f32x4*)(topg + r * 4);
            const int esv[4] = {es.x, es.y, es.z, es.w};
#pragma unroll
            for (int k = 0; k < 4; ++k) {
                const int e = esv[k] >> 16, sl = esv[k] & 0xffff; const size_t row = (size_t)ts[e] * BM + sl; const float gk = gt[k];
#pragma unroll
                for (int j = 0; j < 4; ++j) { const u32x2 o = *(const u32x2*)(mout + row * DM + 4 * lane + 256 * j);
                    v[j][0] += gk * __builtin_bit_cast(float, o.x << 16); v[j][1] += gk * __builtin_bit_cast(float, o.x & 0xffff0000u);
                    v[j][2] += gk * __builtin_bit_cast(float, o.y << 16); v[j][3] += gk * __builtin_bit_cast(float, o.y & 0xffff0000u); }
            }
        }
        float ss = 0.f;
#pragma unroll
        for (int j = 0; j < 4; ++j) ss += (v[j][0] * v[j][0] + v[j][1] * v[j][1]) + (v[j][2] * v[j][2] + v[j][3] * v[j][3]);
#pragma unroll
        for (int o = 32; o; o >>= 1) ss += shx(ss, o, lane);
        const float sc = rsqrtf(ss * (1.f / 1024.f) + 1e-5f);
#pragma unroll
        for (int j = 0; j < 4; ++j) {
            const f32x4 gg = *(const f32x4*)(g + 4 * lane + 256 * j);
            if (!LAST) { *(f32x4*)(h + (size_t)r * DM + 4 * lane + 256 * j) = v[j];
                u32x2 o2; o2.x = cvt_pk_bf16(v[j][0] * sc * gg[0], v[j][1] * sc * gg[1]); o2.y = cvt_pk_bf16(v[j][2] * sc * gg[2], v[j][3] * sc * gg[3]);
                *(u32x2*)(xn16 + (size_t)r * DM + 4 * lane + 256 * j) = o2; }
            else *(f32x4*)(out + (size_t)r * DM + 4 * lane + 256 * j) = (f32x4){v[j][0] * sc * gg[0], v[j][1] * sc * gg[1], v[j][2] * sc * gg[2], v[j][3] * sc * gg[3]};
        }
    }
}
__device__ __forceinline__ void p_router_tables(const int wv, const float* w_r, const float* g, bf16_t* WR16) {
    LTID();
    for (int i = bidx * NT + tidx; i < 32 * 1024; i += gridDim.x * NT) {
        const int e = i >> 10, k = i & 1023;
        const float w = g[k] * w_r[k * 32 + e];
        const unsigned hi = f2bf(w); const float lo = w - __builtin_bit_cast(float, hi << 16);
        WR16[i] = (bf16_t)hi; WR16[32 * 1024 + i] = (bf16_t)f2bf(lo);
    }
}
constexpr int RT_CNT_OFF = 131072 + 4608;
constexpr int RT_XCH_OFF = 131072 + 5120;
__device__ __forceinline__ void p_router2(const int wv, const float* h, const bf16_t* WR16, const float* b_r, bf16_t* hb16, unsigned* gcnt, int* rowtok_e, float* rsc_e, int* eslot, float* topg, LAS unsigned char* lds) {
    LTID();
    const int lane = tidx & 63, fr = lane & 15, fq = lane >> 4, w = wv, tg = w & 3, kh = w >> 2;
#pragma unroll
    for (int part = 0; part < 2; ++part)
#pragma unroll
        for (int p = 0; p < 8; ++p) { const int row = 4 * p + (tidx >> 7), cs = tidx & 127;
            glds16s(WR16, (unsigned)(part * 65536 + row * 2048 + ((cs ^ (row & 15)) * 16)), (unsigned)(size_t)(lds + part * 65536 + p * 8192 + w * 1024)); }
    LAS int* lcnt = (LAS int*)(lds + RT_CNT_OFF);
    if (tidx < 64) lcnt[tidx] = 0;
    asm volatile("s_waitcnt vmcnt(0)" ::: "memory");
    __syncthreads();
    for (int it = bidx; it < SEQ / 64; it += gridDim.x) {
        const int token = it * 64 + 16 * tg + fr;
        const float* xr = h + (size_t)token * DM + 512 * kh + 8 * fq;
        bf16_t* hb = hb16 + (size_t)token * DM + 512 * kh + 8 * fq;
        f32x4 acc[2]; acc[0] = (f32x4){0.f, 0.f, 0.f, 0.f}; acc[1] = acc[0];
        float ss = 0.f;
#pragma unroll 4
        for (int s4 = 0; s4 < 16; ++s4) {
            const f32x4 x0 = *(const f32x4*)(xr + 32 * s4), x1 = *(const f32x4*)(xr + 32 * s4 + 4);
            ss += (x0[0] * x0[0] + x0[1] * x0[1]) + (x0[2] * x0[2] + x0[3] * x0[3]) + (x1[0] * x1[0] + x1[1] * x1[1]) + (x1[2] * x1[2] + x1[3] * x1[3]);
            u32x4 hw; hw.x = cvt_pk_bf16(x0[0], x0[1]); hw.y = cvt_pk_bf16(x0[2], x0[3]); hw.z = cvt_pk_bf16(x1[0], x1[1]); hw.w = cvt_pk_bf16(x1[2], x1[3]);
            *(u32x4*)(hb + 32 * s4) = hw;
            u32x4 lw;
            lw.x = cvt_pk_bf16(x0[0] - __builtin_bit_cast(float, hw.x << 16), x0[1] - __builtin_bit_cast(float, hw.x & 0xffff0000u));
            lw.y = cvt_pk_bf16(x0[2] - __builtin_bit_cast(float, hw.y << 16), x0[3] - __builtin_bit_cast(float, hw.y & 0xffff0000u));
            lw.z = cvt_pk_bf16(x1[0] - __builtin_bit_cast(float, hw.z << 16), x1[1] - __builtin_bit_cast(float, hw.z & 0xffff0000u));
            lw.w = cvt_pk_bf16(x1[2] - __builtin_bit_cast(float, hw.w << 16), x1[3] - __builtin_bit_cast(float, hw.w & 0xffff0000u));
            const bf16x8 xhi = __builtin_bit_cast(bf16x8, hw), xlo = __builtin_bit_cast(bf16x8, lw);
            const int c = 64 * kh + 4 * s4 + fq, slot = c ^ fr;
#pragma unroll
            for (int nb = 0; nb < 2; ++nb) {
                const bf16x8 whi = *(const LAS bf16x8*)(lds + (16 * nb + fr) * 2048 + slot * 16), wlo = *(const LAS bf16x8*)(lds + 65536 + (16 * nb + fr) * 2048 + slot * 16);
                acc[nb] = __builtin_amdgcn_mfma_f32_16x16x32_bf16(whi, xhi, acc[nb], 0, 0, 0);
                acc[nb] = __builtin_amdgcn_mfma_f32_16x16x32_bf16(whi, xlo, acc[nb], 0, 0, 0);
                acc[nb] = __builtin_amdgcn_mfma_f32_16x16x32_bf16(wlo, xhi, acc[nb], 0, 0, 0);
            }
        }
        ss += shx(ss, 16, lane); ss += shx(ss, 32, lane);
        LAS float* X = (LAS float*)(lds + RT_XCH_OFF) + (tg * 64 + lane) * 9;
        if (kh == 1) {
#pragma unroll
            for (int nb = 0; nb < 2; ++nb)
#pragma unroll
                for (int j = 0; j < 4; ++j) X[nb * 4 + j] = acc[nb][j];
            X[8] = ss;
        }
        __syncthreads();
        int ti[4] = {0, 0, 0, 0}, ls[4] = {0, 0, 0, 0}; float gv[4] = {0.f, 0.f, 0.f, 0.f}; float rs = 0.f;
        if (kh == 0) {
            float lv[8];
            ss += X[8];
            rs = rsqrtf(ss * (1.f / 1024.f) + 1e-5f);
#pragma unroll
            for (int nb = 0; nb < 2; ++nb)
#pragma unroll
                for (int j = 0; j < 4; ++j) lv[nb * 4 + j] = rs * (acc[nb][j] + X[nb * 4 + j]) + b_r[16 * nb + 4 * fq + j];
            float tv[4];
#pragma unroll
            for (int r = 0; r < 4; ++r) {
                float bv = -3.0e38f; int bi = 0;
#pragma unroll
                for (int q = 0; q < 8; ++q) { const int idx = 16 * (q >> 2) + 4 * fq + (q & 3); if (lv[q] > bv) { bv = lv[q]; bi = idx; } }
#pragma unroll
                for (int mk = 16; mk <= 32; mk <<= 1) { const float ov = shx(bv, mk, lane); const int oi = shxi(bi, mk, lane); if (ov > bv || (ov == bv && oi < bi)) { bv = ov; bi = oi; } }
                tv[r] = bv; ti[r] = bi;
#pragma unroll
                for (int q = 0; q < 8; ++q) { const int idx = 16 * (q >> 2) + 4 * fq + (q & 3); if (idx == bi) lv[q] = -3.0e38f; }
            }
            float sum = 0.f;
#pragma unroll
            for (int r = 0; r < 4; ++r) { gv[r] = __expf(tv[r] - tv[0]); sum += gv[r]; }
            const float inv = 1.f / sum;
#pragma unroll
            for (int r = 0; r < 4; ++r) gv[r] *= inv;
            if (fq == 0) {
#pragma unroll
                for (int r = 0; r < 4; ++r) ls[r] = __hip_atomic_fetch_add(&lcnt[ti[r]], 1, __ATOMIC_RELAXED, __HIP_MEMORY_SCOPE_WORKGROUP);
            }
        }
        __syncthreads();
        if (tidx < 32) { const int c = lcnt[tidx]; lcnt[32 + tidx] = c ? (int)__hip_atomic_fetch_add(gcnt + tidx, (unsigned)c, __ATOMIC_RELAXED, __HIP_MEMORY_SCOPE_AGENT) : 0; }
        __syncthreads();
        if (kh == 0 && fq == 0) {
            int es[4];
#pragma unroll
            for (int r = 0; r < 4; ++r) { const int e = ti[r], sl = lcnt[32 + e] + ls[r]; rowtok_e[e * ECAP + sl] = token; rsc_e[e * ECAP + sl] = rs; es[r] = (e << 16) | sl; }
            *(int4*)(eslot + token * 4) = make_int4(es[0], es[1], es[2], es[3]);
            *(f32x4*)(topg + token * 4) = (f32x4){gv[0], gv[1], gv[2], gv[3]};
        }
        __syncthreads();
        if (tidx < 32) lcnt[tidx] = 0;
    }
    __syncthreads();
}

constexpr int NPL = 13;
constexpr int NPHASES = 1 + 2 * NPL;
typedef const __attribute__((address_space(4))) Args* KA;
#define PHASE __device__ __forceinline__
#define KAP() ({ KA _t = a; asm volatile("" : "+s"(_t)); _t; })
#define WSP(T, off) ((T*)(a->ws + (off)))

PHASE void ph_init(KA a, const int wv) {
    p_rowfinish<false, false>(wv, a->in[0], WSP(float, WS_H), nullptr, nullptr, nullptr, a->in[3], WSP(bf16_t, WS_XN16), nullptr);
    p_bias_table(wv, a->in[2], WSP(float, WS_BIASG));
    for (int l = 0; l < 2; ++l) {
        p_s5_tables2(wv, a->in[5] + l * 2048, a->in[6] + l * 2048, a->in[7] + l * 32768, a->in[8] + l * 32768, a->in[9] + l * 32768, a->in[10] + l * 32768, a->in[11] + l * 32,
                     WSP(float2, WS_ABAR) + l * 2048, WSP(float2, WS_A256) + l * 2048, WSP(bf16_t, WS_BB16) + (size_t)l * 32 * 128 * 16, WSP(bf16_t, WS_CM16) + (size_t)l * 32 * 16 * 128);
        p_rmsnorm16(wv, a->in[1], a->in[19] + l * DM, WSP(bf16_t, WS_MEMN16) + (size_t)l * NMEM * DM, NMEM);
        p_router_tables(wv, a->in[24] + (size_t)l * DM * 32, a->in[23] + l * DM, WSP(bf16_t, WS_WR16) + (size_t)l * 2 * 32 * 1024);
        p_transpose(wv, a->in[4] + (size_t)l * DM * DIN, DM, DIN, WSP(bf16_t, WS_WT_IN) + (size_t)l * DIN * DM, nullptr, 0, LDSP);
        p_transpose(wv, a->in[13] + (size_t)l * 512 * 512, 512, 512, WSP(bf16_t, WS_WT_GLU) + (size_t)l * 512 * 512, nullptr, 0, LDSP);
        p_transpose(wv, a->in[17] + (size_t)l * DM * DM, DM, DM, WSP(bf16_t, WS_WT_OUT) + (size_t)l * DM * DM, nullptr, 0, LDSP);
        p_transpose(wv, a->in[20] + (size_t)l * DM * 512, DM, 512, WSP(bf16_t, WS_WT_XQ) + (size_t)l * 512 * DM, a->in[18] + l * DM, 0, LDSP);
        p_transpose(wv, a->in[21] + (size_t)l * DM * 1024, DM, 1024, WSP(bf16_t, WS_WT_XKV) + (size_t)l * 1024 * DM, nullptr, 0, LDSP);
        p_transpose(wv, a->in[22] + (size_t)l * 512 * DM, 512, DM, WSP(bf16_t, WS_WT_XO) + (size_t)l * DM * 512, nullptr, 0, LDSP);
    }
    for (int le = 0; le < 2 * NEXP; ++le) {
        p_transpose(wv, a->in[26] + (size_t)le * DM * 2048, DM, 2048, WSP(bf16_t, WS_BT1) + (size_t)le * 2048 * DM, a->in[23] + (le >> 5) * DM, 1, LDSP);
        p_transpose(wv, a->in[28] + (size_t)le * DFF * DM, DFF, DM, WSP(bf16_t, WS_BT2) + (size_t)le * DM * DFF, nullptr, 0, LDSP);
    }
    __syncthreads();
}
PHASE void ph_gemm_in(KA a, const int wv, int l) { LTID();
    DenseOrder S; S.init(WSP(bf16_t, WS_XN16), WSP(bf16_t, WS_WT_IN) + (size_t)l * DIN * DM, SEQ, DIN, DM, gridDim.x, bidx);
    EpiIn E{WSP(bf16_t, WS_PROJ16)};
    gemm_phase<EpiIn, DenseOrder, false, false>(LDSP, DM, S, E, tidx, wv);
}
PHASE void ph_attn_s5a(KA a, const int wv, int l) {
    p_dil_attn(wv, WSP(bf16_t, WS_PROJ16), WSP(float, WS_BIASG), WSP(bf16_t, WS_OBR), WSP(float, WS_LSE), LDSP);
    p_s5_pass<0>(wv, WSP(bf16_t, WS_PROJ16), WSP(float2, WS_ABAR) + l * 2048, WSP(float2, WS_A256) + l * 2048, WSP(bf16_t, WS_BB16) + (size_t)l * 32 * 128 * 16, WSP(bf16_t, WS_CM16) + (size_t)l * 32 * 16 * 128,
                 a->in[12] + l * 512, WSP(float2, WS_E2), WSP(bf16_t, WS_YG16), LDSP);
}
PHASE void ph_s5b(KA a, const int wv, int l) {
    p_s5_pass<1>(wv, WSP(bf16_t, WS_PROJ16), WSP(float2, WS_ABAR) + l * 2048, WSP(float2, WS_A256) + l * 2048, WSP(bf16_t, WS_BB16) + (size_t)l * 32 * 128 * 16, WSP(bf16_t, WS_CM16) + (size_t)l * 32 * 16 * 128,
                 a->in[12] + l * 512, WSP(float2, WS_E2), WSP(bf16_t, WS_YG16), LDSP);
}
PHASE void ph_gemm_glu(KA a, const int wv, int l) { LTID();
    {   DenseOrder S; S.init(WSP(bf16_t, WS_YG16), WSP(bf16_t, WS_WT_GLU) + (size_t)l * 512 * 512, SEQ, 512, 512, gridDim.x, bidx);
        EpiGlu16 E{WSP(bf16_t, WS_YB16), WSP(bf16_t, WS_YG16), a->in[14] + l * 512};
        gemm_phase<EpiGlu16, DenseOrder, false, false>(LDSP, 512, S, E, tidx, wv); }
    const int cc = (int)gridDim.x - 1 - bidx;
    if (l == 0 && cc < 8) {
        const int kl = cc >> 2;
        DenseOrder S; S.init(WSP(bf16_t, WS_MEMN16) + (size_t)kl * NMEM * DM, WSP(bf16_t, WS_WT_XKV) + (size_t)kl * 1024 * DM, NMEM, 1024, DM, 4, cc & 3);
        EpiBf16 E{WSP(bf16_t, WS_KV16) + (size_t)kl * NMEM * 1024, 1024, 1.f, nullptr};
        gemm_phase<EpiBf16, DenseOrder, false, false>(LDSP, DM, S, E, tidx, wv);
    }
}
PHASE void ph_mixnorm(KA a, const int wv, int l) {
    p_attn_combine(wv, WSP(bf16_t, WS_OBR), WSP(float, WS_LSE), a->in[15] + l * 512, WSP(bf16_t, WS_MIX16));
    p_ssm_norm(wv, WSP(bf16_t, WS_YB16), a->in[16] + l * 512, WSP(bf16_t, WS_MIX16));
}
PHASE void ph_gemm_out(KA a, const int wv, int l) { LTID();
    DenseOrder S; S.init(WSP(bf16_t, WS_MIX16), WSP(bf16_t, WS_WT_OUT) + (size_t)l * DM * DM, SEQ, DM, DM, gridDim.x, bidx);
    EpiOut E{WSP(float, WS_H), WSP(bf16_t, WS_HB16), WSP(float, WS_SSP)};
    gemm_phase<EpiOut, DenseOrder, false, false>(LDSP, DM, S, E, tidx, wv);
}
PHASE void ph_gemm_xq(KA a, const int wv, int l) { LTID();
    DenseOrder S; S.init(WSP(bf16_t, WS_HB16), WSP(bf16_t, WS_WT_XQ) + (size_t)l * 512 * DM, SEQ, 512, DM, gridDim.x, bidx);
    EpiBf16 E{WSP(bf16_t, WS_QX16), 512, 0.08838834764831845f, WSP(float, WS_SSP)};
    gemm_phase<EpiBf16, DenseOrder, false, false>(LDSP, DM, S, E, tidx, wv);
}
PHASE void ph_xattn(KA a, const int wv, int l) { p_xattn_mfma(wv, WSP(bf16_t, WS_QX16), WSP(bf16_t, WS_KV16) + (size_t)l * NMEM * 1024, WSP(bf16_t, WS_OX16), LDSP); }
PHASE void ph_gemm_xo(KA a, const int wv, int l) { LTID();
    DenseOrder S; S.init(WSP(bf16_t, WS_OX16), WSP(bf16_t, WS_WT_XO) + (size_t)l * DM * 512, SEQ, DM, 512, gridDim.x, bidx);
    EpiF32 E{WSP(float, WS_H), DM, 1};
    gemm_phase<EpiF32, DenseOrder, false, false>(LDSP, 512, S, E, tidx, wv);
}
PHASE void ph_router(KA a, const int wv, int l) {
    p_router2(wv, WSP(float, WS_H), WSP(bf16_t, WS_WR16) + (size_t)l * 2 * 32 * 1024, a->in[25] + l * 32, WSP(bf16_t, WS_HB16), WSP(unsigned, WS_CTL) + CW_CNT + l * 32,
              WSP(int, WS_ROWTOK), WSP(float, WS_RSC), WSP(int, WS_ESLOT), WSP(float, WS_TOPG), LDSP);
}
PHASE void ph_moe1(KA a, const int wv, int l) { LTID();
    moe_tiles(WSP(unsigned, WS_CTL) + CW_CNT + l * 32, tidx);
    MoeOrder<true> S; S.init(WSP(bf16_t, WS_HB16), WSP(bf16_t, WS_BT1) + (size_t)l * NEXP * 2048 * DM, WSP(int, WS_ROWTOK), 2048, DM, (size_t)2048 * DM * 2, gridDim.x, bidx);
    EpiMoe1 E{WSP(bf16_t, WS_ACT), a->in[27] + (size_t)l * NEXP * 2048, WSP(float, WS_RSC)};
    gemm_phase<EpiMoe1, MoeOrder<true>, true, false>(LDSP, DM, S, E, tidx, wv);
}
PHASE void ph_moe2(KA a, const int wv, int l) { LTID();
    moe_tiles(WSP(unsigned, WS_CTL) + CW_CNT + l * 32, tidx);
    MoeOrder<false> S; S.init(WSP(bf16_t, WS_ACT), WSP(bf16_t, WS_BT2) + (size_t)l * NEXP * DM * DFF, nullptr, DM, DFF, (size_t)DM * DFF * 2, gridDim.x, bidx);
    EpiMoe2 E{WSP(bf16_t, WS_MOUT), a->in[29] + (size_t)l * NEXP * DM};
    gemm_phase<EpiMoe2, MoeOrder<false>, false, false>(LDSP, DFF, S, E, tidx, wv);
}
PHASE void ph_combine(KA a, const int wv, int l) { LTID();
    moe_tiles(WSP(unsigned, WS_CTL) + CW_CNT + l * 32, tidx);
    if (l == 0) p_rowfinish<true, false>(wv, WSP(float, WS_H), WSP(float, WS_H), WSP(bf16_t, WS_MOUT), WSP(int, WS_ESLOT), WSP(float, WS_TOPG), a->in[3] + DM, WSP(bf16_t, WS_XN16), nullptr);
    else p_rowfinish<true, true>(wv, WSP(float, WS_H), nullptr, WSP(bf16_t, WS_MOUT), WSP(int, WS_ESLOT), WSP(float, WS_TOPG), a->in[30], nullptr, a->out);
}

__global__ void __launch_bounds__(NT, 2) mega(Args args) {
    KA a = (KA)__builtin_amdgcn_kernarg_segment_ptr();
    int wv = __builtin_amdgcn_readfirstlane((int)threadIdx.x >> 6); asm volatile("" : "+s"(wv));
    LAS unsigned char* lds = LDSP;
    volatile LAS unsigned* MISC = (volatile LAS unsigned*)(lds + MISC_OFF);
    unsigned* ctl = (unsigned*)(a->ws + WS_CTL);
    if (threadIdx.x < 32) MISC[threadIdx.x] = 0u;
    __syncthreads();
    XcdBarrier bar; bar.bar = ctl + CW_BAR; bar.x = 0; bar.st = nullptr;
    if (!MK_PER_PHASE) bar = xcd_barrier_post(ctl + CW_BAR, MISC + 8);
    const int lo = a->ph_lo, hi = a->ph_hi;
#define IN(k) (lo <= (k) && (k) < hi)
#define SEAM(k) do { if (IN(k) && IN((k) + 1)) { LTID(); xcd_barrier(bar.bar, bar.x, bar.st, tidx == 0); } } while (0)
    if (IN(0)) ph_init(KAP(), wv);
    SEAM(0);
#pragma unroll 1
    for (int l = 0; l < 2; ++l) {
        const int pb = 1 + l * NPL;
        if (IN(pb + 0)) ph_gemm_in(KAP(), wv, l);
        SEAM(pb + 0);
        if (IN(pb + 1)) ph_attn_s5a(KAP(), wv, l);
        SEAM(pb + 1);
        if (IN(pb + 2)) ph_s5b(KAP(), wv, l);
        SEAM(pb + 2);
        if (IN(pb + 3)) ph_gemm_glu(KAP(), wv, l);
        SEAM(pb + 3);
        if (IN(pb + 4)) ph_mixnorm(KAP(), wv, l);
        SEAM(pb + 4);
        if (IN(pb + 5)) ph_gemm_out(KAP(), wv, l);
        SEAM(pb + 5);
        if (IN(pb + 6)) ph_gemm_xq(KAP(), wv, l);
        SEAM(pb + 6);
        if (IN(pb + 7)) ph_xattn(KAP(), wv, l);
        SEAM(pb + 7);
        if (IN(pb + 8)) ph_gemm_xo(KAP(), wv, l);
        SEAM(pb + 8);
        if (IN(pb + 9)) ph_router(KAP(), wv, l);
        SEAM(pb + 9);
        if (IN(pb + 10)) ph_moe1(KAP(), wv, l);
        SEAM(pb + 10);
        if (IN(pb + 11)) ph_moe2(KAP(), wv, l);
        SEAM(pb + 11);
        if (IN(pb + 12)) ph_combine(KAP(), wv, l);
        SEAM(pb + 12);
    }
#undef IN
#undef SEAM
}

extern "C" void kernel_launch(void* const* d_in, const int* in_sizes, int n_in, void* d_out, int out_size, void* d_ws, size_t ws_size, hipStream_t stream) {
    static int grid = 0;
    if (grid == 0) {
        if (n_in != 31 || ws_size < WS_END) { fprintf(stderr, "kernel_launch: unexpected n_in %d or ws_size %zu (need %zu)\n", n_in, ws_size, (size_t)WS_END); grid = -1; return; }
        int dev = 0, cus = 0, per_cu = 0;
        if (hipGetDevice(&dev) != hipSuccess || hipDeviceGetAttribute(&cus, hipDeviceAttributeMultiprocessorCount, dev) != hipSuccess) { grid = -1; return; }
        if (hipFuncSetAttribute((const void*)mega, hipFuncAttributeMaxDynamicSharedMemorySize, LDS_BYTES) != hipSuccess) { fprintf(stderr, "kernel_launch: hipFuncSetAttribute failed\n"); grid = -1; return; }
        if (hipOccupancyMaxActiveBlocksPerMultiprocessor(&per_cu, (const void*)mega, NT, LDS_BYTES) != hipSuccess || per_cu < 1)
            fprintf(stderr, "kernel_launch: occupancy query reports %d workgroups per CU\n", per_cu);
        (void)hipGetLastError();
        grid = cus;
    }
    if (grid < 0) return;
    if (hipMemsetAsync((char*)d_ws + WS_CTL, 0, CTL_ZERO_BYTES, stream) != hipSuccess) return;
    Args a{};
    for (int i = 0; i < 31; ++i) a.in[i] = (const float*)d_in[i];
    a.out = (float*)d_out; a.ws = (unsigned char*)d_ws;
#if MK_PER_PHASE
    for (int p = 0; p < NPHASES; ++p) { a.ph_lo = p; a.ph_hi = p + 1; hipLaunchKernelGGL(mega, dim3(grid), dim3(NT), LDS_BYTES, stream, a); }
#else
    a.ph_lo = 0; a.ph_hi = NPHASES;
    hipLaunchKernelGGL(mega, dim3(grid), dim3(NT), LDS_BYTES, stream, a);
#endif
}
```

```cpp
#include <hip/hip_runtime.h>
#include <stdint.h>
#include <cstdio>

#ifndef PROBE_DUP
#define PROBE_DUP -1
#endif
#ifndef MK_PER_PHASE
#define MK_PER_PHASE 0
#endif

#define SEQ 16384
#define DM 1024
#define DIN 2048
#define NMEM 256
#define NEXP 32
#define TOPK 4
#define DFF 1024
#define NT 512
#define NW 8

#define LAS __attribute__((address_space(3)))
typedef float f32x4 __attribute__((ext_vector_type(4)));
extern __shared__ __attribute__((aligned(16))) unsigned char lds_raw[];
#define LDSP ((LAS unsigned char*)lds_raw)
#define LTID() int z_ = 0; asm volatile("" : "+v"(z_)); const int lane_ = (int)__builtin_amdgcn_mbcnt_hi(~0u, __builtin_amdgcn_mbcnt_lo(~0u, (unsigned)z_)); \
    const int tidx = wv * 64 + lane_; int bidx = blockIdx.x; asm volatile("" : "+s"(bidx))
__device__ __forceinline__ float shx(float v, int mask, int lane) { return __builtin_bit_cast(float, __builtin_amdgcn_ds_bpermute((lane ^ mask) << 2, __builtin_bit_cast(int, v))); }
__device__ __forceinline__ int shxi(int v, int mask, int lane) { return __builtin_amdgcn_ds_bpermute((lane ^ mask) << 2, v); }
constexpr int LDS_BYTES = 147456;
constexpr int MISC_OFF = 131072 + 320;

#define XB_TMO      128
#define XB_XCNT(j)  (256  + 64 * (j))
#define XB_XSUB(j)  (1280 + 64 * (j))
#define XB_XGEN(j)  (2304 + 64 * (j))
#define XB_TOP      3328
#define XB_TOPGEN   3392
#define XCD_BAR_WORDS 3456
#define XB_SPIN_CAP (1u << 18)

__device__ __forceinline__ unsigned xb_ld(unsigned* p)              { return __hip_atomic_load(p, __ATOMIC_RELAXED, __HIP_MEMORY_SCOPE_AGENT); }
__device__ __forceinline__ unsigned xb_add(unsigned* p, unsigned v) { return __hip_atomic_fetch_add(p, v, __ATOMIC_RELAXED, __HIP_MEMORY_SCOPE_AGENT); }
__device__ __forceinline__ unsigned xb_xcc_id() { return (unsigned)__builtin_amdgcn_s_getreg((3 << 11) | 20) & 0xFu; }
#define XB_SPIN(cond, bar) do { unsigned _sp = 0; while (cond) { __builtin_amdgcn_s_sleep(1); \
    if ((++_sp & 255u) == 0u) { if (xb_ld(&(bar)[XB_TMO])) break; if (_sp > XB_SPIN_CAP) { atomicAdd(&(bar)[XB_TMO], 1u); break; } } } } while (0)

struct XcdBarrier {
    unsigned* bar; unsigned x;
    volatile LAS unsigned* st;
};
__device__ __forceinline__ XcdBarrier xcd_barrier_post(unsigned* bar, volatile LAS unsigned* st) {
    XcdBarrier b; b.bar = bar; b.x = xb_xcc_id(); b.st = st;
    if (threadIdx.x == 0) (void)xb_add(&bar[XB_XCNT(b.x)], 1u);
    return b;
}
__device__ __forceinline__ void xcd_barrier_complete(unsigned* bar, unsigned x, unsigned& nloc, unsigned& nx) {
    const unsigned G = gridDim.x * gridDim.y * gridDim.z;
    unsigned sum, cnt, mine, sp = 0u;
    for (;;) {
        sum = 0u; cnt = 0u; mine = 0u;
#pragma unroll
        for (unsigned j = 0; j < 16; ++j) { const unsigned c = xb_ld(&bar[XB_XCNT(j)]); sum += c; cnt += (c > 0u) ? 1u : 0u; mine = (j == x) ? c : mine; }
        if (sum == G) break;
        __builtin_amdgcn_s_sleep(1);
        if ((++sp & 255u) == 0u) { if (xb_ld(&bar[XB_TMO])) break; if (sp > XB_SPIN_CAP) { atomicAdd(&bar[XB_TMO], 1u); break; } }
    }
    nloc = mine > 0u ? mine : 1u; nx = cnt > 0u ? cnt : 1u;
}
__device__ __noinline__ void xcd_barrier(unsigned* bar_, unsigned x_, volatile LAS unsigned* st_, int is_t0) {
    XcdBarrier b; b.bar = bar_; b.x = x_; b.st = st_;
    asm volatile("s_waitcnt vmcnt(0)" ::: "memory");
    __syncthreads();
    if (is_t0) {
        unsigned* bar = b.bar;
        __builtin_amdgcn_s_waitcnt(0);
        unsigned nloc = b.st[0], nx = b.st[1];
        if (nloc == 0u) { xcd_barrier_complete(bar, b.x, nloc, nx); b.st[0] = nloc; b.st[1] = nx; }
        const unsigned old = xb_add(&bar[XB_XSUB(b.x)], 1u);
        const unsigned gen = old / nloc;
        if (old + 1u == (gen + 1u) * nloc) {
            __builtin_amdgcn_fence(__ATOMIC_RELEASE, "agent");
            asm volatile("s_waitcnt vmcnt(0)" ::: "memory");
            const unsigned og = xb_add(&bar[XB_TOP], 1u);
            const unsigned tg = og / nx;
            if (og + 1u == (tg + 1u) * nx) xb_add(&bar[XB_TOPGEN], 1u);
            else XB_SPIN(xb_ld(&bar[XB_TOPGEN]) == tg, bar);
            __builtin_amdgcn_fence(__ATOMIC_ACQUIRE, "agent");
            xb_add(&bar[XB_XGEN(b.x)], 1u);
            asm volatile("s_waitcnt vmcnt(0)" ::: "memory");
        } else {
            XB_SPIN(xb_ld(&bar[XB_XGEN(b.x)]) == gen, bar);
            __builtin_amdgcn_fence(__ATOMIC_ACQUIRE, "agent");
            asm volatile("s_waitcnt vmcnt(0)" ::: "memory");
        }
    }
    __syncthreads();
}

constexpr size_t MiB = 1u << 20;
constexpr size_t WS_CTL = 0, CTL_ZERO_BYTES = 1 * MiB;
constexpr int CW_BAR = 4096;
constexpr int CW_CNT = 8192;
constexpr int MOE_ROWS = SEQ * TOPK + NEXP * 256;
constexpr int ECAP = SEQ;
constexpr size_t al256(size_t x) { return (x + 255) & ~(size_t)255; }
constexpr size_t WS_H = 2 * MiB;
constexpr size_t WS_XN16 = WS_H + (size_t)SEQ * DM * 4;
constexpr size_t WS_HB16 = WS_XN16 + (size_t)SEQ * DM * 2;
constexpr size_t WS_PROJ16 = WS_HB16 + (size_t)SEQ * DM * 2;
constexpr size_t WS_OBR = WS_PROJ16 + (size_t)SEQ * 2048 * 2;
constexpr size_t WS_LSE = WS_OBR + 3 * (size_t)SEQ * 512 * 2;
constexpr size_t WS_YG16 = WS_LSE + 3 * (size_t)SEQ * 8 * 4;
constexpr size_t WS_YB16 = WS_YG16 + (size_t)SEQ * 512 * 2;
constexpr size_t WS_MIX16 = WS_YB16 + (size_t)SEQ * 512 * 2;
constexpr size_t WS_QX16 = WS_MIX16 + (size_t)SEQ * DM * 2;
constexpr size_t WS_OX16 = WS_QX16 + (size_t)SEQ * 512 * 2;
constexpr size_t WS_ACT = WS_OX16 + (size_t)SEQ * 512 * 2;
constexpr size_t WS_MOUT = WS_ACT + (size_t)MOE_ROWS * DFF * 2;
constexpr size_t WS_BT1 = WS_MOUT + (size_t)MOE_ROWS * DM * 2;
constexpr size_t WS_BT2 = WS_BT1 + 2 * (size_t)NEXP * 2048 * DM * 2;
constexpr size_t WS_WT_IN = WS_BT2 + 2 * (size_t)NEXP * DM * DFF * 2;
constexpr size_t WS_WT_GLU = WS_WT_IN + 2 * (size_t)2048 * 1024 * 2;
constexpr size_t WS_WT_OUT = WS_WT_GLU + 2 * (size_t)512 * 512 * 2;
constexpr size_t WS_WT_XQ = WS_WT_OUT + 2 * (size_t)1024 * 1024 * 2;
constexpr size_t WS_WT_XKV = WS_WT_XQ + 2 * (size_t)512 * 1024 * 2;
constexpr size_t WS_WT_XO = WS_WT_XKV + 2 * (size_t)1024 * 1024 * 2;
constexpr size_t WS_MEMN16 = WS_WT_XO + 2 * (size_t)1024 * 512 * 2;
constexpr size_t WS_KV16 = WS_MEMN16 + 2 * (size_t)NMEM * 1024 * 2;
constexpr size_t WS_WR16 = WS_KV16 + 2 * (size_t)NMEM * 1024 * 2;
constexpr size_t WS_BIASG = WS_WR16 + 2 * 2 * (size_t)32 * 1024 * 2;
constexpr size_t WS_ABAR = al256(WS_BIASG + 24 * 132 * 4);
constexpr size_t WS_A256 = WS_ABAR + 2 * 2048 * 8;
constexpr size_t WS_BB16 = WS_A256 + 2 * 2048 * 8;
constexpr size_t WS_CM16 = WS_BB16 + 2 * (size_t)32 * 128 * 16 * 2;
constexpr size_t WS_E2 = WS_CM16 + 2 * (size_t)32 * 16 * 128 * 2;
constexpr size_t WS_ROWTOK = WS_E2 + (size_t)64 * 2048 * 8;
constexpr size_t WS_RSC = WS_ROWTOK + (size_t)NEXP * ECAP * 4;
constexpr size_t WS_ESLOT = WS_RSC + (size_t)NEXP * ECAP * 4;
constexpr size_t WS_TOPG = WS_ESLOT + (size_t)SEQ * 4 * 4;
constexpr size_t WS_SSP = WS_TOPG + (size_t)SEQ * 4 * 4;
constexpr size_t WS_END = WS_SSP + (size_t)SEQ * 16 * 4;

struct Args { const float* in[31]; float* out; unsigned char* ws; int ph_lo, ph_hi; };


typedef unsigned short bf16_t;
typedef short bf16x8 __attribute__((ext_vector_type(8)));
typedef unsigned u32x4 __attribute__((ext_vector_type(4)));
typedef unsigned u32x2 __attribute__((ext_vector_type(2)));
constexpr int BM = 256, BK = 64, HALF = 128, HTB = HALF * BK * 2, STAGE_BYTES = 8 * HTB, NXCD = 8, WGM = 8;
__host__ __device__ __forceinline__ int lds_byte(int r, int c) { const int st = (r >> 4) * 2 + (c >> 5), rr = r & 15, cc = c & 31, ob = rr * 64 + cc * 2; return st * 1024 + (ob ^ (((ob >> 9) & 1) << 5)); }
__host__ __device__ __forceinline__ void stage_rc(int b, int& R, int& C) { const int st = b / 1024, sb = b % 1024, swz = sb ^ (((sb >> 9) & 1) << 5); R = (st >> 1) * 16 + swz / 64; C = (st & 1) * 32 + (swz % 64) / 2; }
__host__ __device__ __forceinline__ int perm32(int rho) { const int n = rho >> 4, i = rho & 15; return 8 * (i >> 2) + 4 * n + (i & 3); }
__device__ __forceinline__ unsigned cvt_pk_bf16(float lo, float hi) { unsigned r; asm volatile("v_cvt_pk_bf16_f32 %0, %1, %2" : "=v"(r) : "v"(lo), "v"(hi)); return r; }
__device__ __forceinline__ unsigned f2bf(float f) { unsigned u = __builtin_bit_cast(unsigned, f); return (u + 0x7fffu + ((u >> 16) & 1u)) >> 16; }
__device__ __forceinline__ unsigned pk2(float lo, float hi) { return f2bf(lo) | (f2bf(hi) << 16); }
__device__ __forceinline__ float bf2f(unsigned short b) { return __builtin_bit_cast(float, ((unsigned)b) << 16); }

__device__ __forceinline__ void glds16s(const void* sbase, unsigned voff, unsigned lds_dst) {
    unsigned keep;
    asm volatile("s_mov_b32 %0, m0\n\ts_mov_b32 m0, %3\n\ts_nop 0\n\tglobal_load_lds_dwordx4 %1, %2\n\ts_mov_b32 m0, %0" : "=&s"(keep) : "v"(voff), "s"(sbase), "s"(lds_dst) : "memory");
}
struct GUnit { const char* A; const char* B; int pm, pn, e, row0, cnt; };

struct DenseOrder {
    const char* A; const char* Bt; int nM, nN, nwg, G, c, K;
    __device__ __forceinline__ void init(const bf16_t* A_, const bf16_t* Bt_, int M, int N, int K_, int G_, int c_) { A = (const char*)A_; Bt = (const char*)Bt_; nM = M / BM; nN = N / BM; nwg = nM * nN; G = G_; c = c_; K = K_; }
    __device__ __forceinline__ bool next(int i, GUnit& u) const {
        const long L = (long)i * G + c; if (L >= nwg) return false;
        int wgid = (int)L; { const int q = nwg / NXCD, r = nwg % NXCD, xcd = wgid % NXCD, off = wgid / NXCD; wgid = (xcd < r ? xcd * (q + 1) : r * (q + 1) + (xcd - r) * q) + off; }
        const int nig = WGM * nN, gid = wgid / nig, fm = gid * WGM, gsz = (nM - fm) < WGM ? (nM - fm) : WGM;
        u.pm = fm + ((wgid % nig) % gsz); u.pn = (wgid % nig) / gsz; u.e = 0; u.row0 = 0; u.cnt = 0;
        u.A = A + (size_t)u.pm * BM * K * 2; u.B = Bt + (size_t)u.pn * BM * K * 2; return true;
    }
    __device__ __forceinline__ unsigned aoff(const GUnit&, int row) const { return (unsigned)(row * K * 2); }
    __device__ __forceinline__ unsigned tokoff(const GUnit&, int) const { return 0u; }
    __device__ __forceinline__ const int* tokbase() const { return nullptr; }
};

struct EpiF32 {
    static constexpr bool PERM = false;
    float* C; int ldc; int resid;
    __device__ __forceinline__ void operator()(const f32x4 (&acc)[2][2][4][2], const GUnit& u, int wr, int wc, int fr, int fq) const {
        const int row0 = u.pm * BM + wr * 64 + fr, col0 = u.pn * BM + wc * 32 + 4 * fq;
#pragma unroll
        for (int ai = 0; ai < 2; ++ai)
#pragma unroll
            for (int m = 0; m < 4; ++m) { float* rowp = C + (size_t)(row0 + ai * HALF + m * 16) * ldc + col0;
#pragma unroll
                for (int bj = 0; bj < 2; ++bj)
#pragma unroll
                    for (int n = 0; n < 2; ++n) { f32x4 v = acc[ai][bj][m][n]; if (resid) v += *(const f32x4*)(rowp + bj * HALF + n * 16); *(f32x4*)(rowp + bj * HALF + n * 16) = v; } }
    }
};
struct EpiGlu {
    static constexpr bool PERM = false;
    float* C; const float* Y; int ldc; const float* bias;
    __device__ __forceinline__ void operator()(const f32x4 (&acc)[2][2][4][2], const GUnit& u, int wr, int wc, int fr, int fq) const {
        const int row0 = u.pm * BM + wr * 64 + fr, col0 = u.pn * BM + wc * 32 + 4 * fq;
#pragma unroll
        for (int ai = 0; ai < 2; ++ai)
#pragma unroll
            for (int m = 0; m < 4; ++m) { const size_t ro = (size_t)(row0 + ai * HALF + m * 16) * ldc + col0;
#pragma unroll
                for (int bj = 0; bj < 2; ++bj)
#pragma unroll
                    for (int n = 0; n < 2; ++n) { const f32x4 b = *(const f32x4*)(bias + col0 + bj * HALF + n * 16); const f32x4 y = *(const f32x4*)(Y + ro + bj * HALF + n * 16);
                        f32x4 v = acc[ai][bj][m][n] + b; f32x4 o;
#pragma unroll
                        for (int j = 0; j < 4; ++j) o[j] = y[j] / (1.f + __expf(-v[j]));
                        *(f32x4*)(C + ro + bj * HALF + n * 16) = o; } }
    }
};

template <class Epi, class Sched, bool GATHER, bool ALIGN_EPI>
__device__ __forceinline__ void gemm_phase(LAS unsigned char* lds, const int K, const Sched& S, const Epi& E, const int tid, const int wv) {
    const int wid = wv, lane = tid & 63, wr = wid >> 2, wc = wid & 3, fr = lane & 15, fq = lane >> 4;
    const int nt = K / BK;
    unsigned voffB[2];
#pragma unroll
    for (int i = 0; i < 2; ++i) { int R, C; stage_rc(tid * 16 + i * 8192, R, C); const int Rb = Epi::PERM ? ((R & ~31) + perm32(R & 31)) : R; voffB[i] = (unsigned)(Rb * K + C) * 2u; }
#define PG8_AOFFS(dst, u) do { int t2_ = tid; asm volatile("" : "+v"(t2_)); _Pragma("unroll") for (int i = 0; i < 2; ++i) { int R, C; stage_rc(t2_ * 16 + i * 8192, R, C); \
        _Pragma("unroll") for (int h = 0; h < 2; ++h) dst[h][i] = S.aoff(u, h * HALF + R) + (unsigned)C * 2u; } } while (0)
    const size_t kstep = (size_t)(BK * 2);
    const size_t hstep = (size_t)HALF * K * 2;
    const unsigned ldsw = (unsigned)wid * 1024u;
    const int aoff = lds_byte(wr * 64 + fr, fq * 8), boff = lds_byte(wc * 32 + fr, fq * 8);
#define PG8_SA(b, h) (((b) * 2 + (h)) * HTB)
#define PG8_SB(b, h) ((4 + (b) * 2 + (h)) * HTB)
#define PG8_STAGE(bufoff, gbase, v0, v1) do { const unsigned ld_ = (unsigned)(size_t)(lds + (bufoff) + ldsw); glds16s((gbase), (v0), ld_); glds16s((gbase), (v1), ld_ + 8192u); } while (0)
#define PG8_LDA(dst, b, h) do { _Pragma("unroll") for (int m = 0; m < 4; ++m) _Pragma("unroll") for (int k = 0; k < 2; ++k) dst[m][k] = *(const LAS bf16x8*)(lds + PG8_SA(b, h) + aoff + m * 2048 + k * 1024); } while (0)
#define PG8_LDB(dst, b, h) do { _Pragma("unroll") for (int n = 0; n < 2; ++n) _Pragma("unroll") for (int k = 0; k < 2; ++k) dst[n][k] = *(const LAS bf16x8*)(lds + PG8_SB(b, h) + boff + n * 2048 + k * 1024); } while (0)
#define PG8_MMA(ai, bj, At, Bt) do { __builtin_amdgcn_s_setprio(1); _Pragma("unroll") for (int m = 0; m < 4; ++m) _Pragma("unroll") for (int n = 0; n < 2; ++n) _Pragma("unroll") for (int k = 0; k < 2; ++k) \
        acc[ai][bj][m][n] = __builtin_amdgcn_mfma_f32_16x16x32_bf16(Bt[n][k], At[m][k], acc[ai][bj][m][n], 0, 0, 0); __builtin_amdgcn_s_setprio(0); } while (0)
#define PG8_WAIT_V(n) asm volatile("s_waitcnt vmcnt(" #n ")" ::: "memory")
#define PG8_WAIT_L(n) asm volatile("s_waitcnt lgkmcnt(" #n ")" ::: "memory")
#define PG8_BAR __builtin_amdgcn_s_barrier()
#define PG8_SCHED __builtin_amdgcn_sched_barrier(0)
    GUnit cur, nxt; int ui = 0;
    if (!S.next(0, cur)) return;
    f32x4 acc[2][2][4][2];
#pragma unroll
    for (int a = 0; a < 2; ++a)
#pragma unroll
        for (int b = 0; b < 2; ++b)
#pragma unroll
            for (int m = 0; m < 4; ++m)
#pragma unroll
                for (int n = 0; n < 2; ++n) acc[a][b][m][n] = (f32x4){0.f, 0.f, 0.f, 0.f};
    bf16x8 At[4][2], B0[2][2], B1[2][2];
    unsigned vA[2][2], vN[2][2];
    PG8_AOFFS(vA, cur);
#pragma unroll
    for (int h = 0; h < 2; ++h)
#pragma unroll
        for (int i = 0; i < 2; ++i) vN[h][i] = vA[h][i];
    const char* cA = cur.A; const char* cB = cur.B;
    PG8_STAGE(PG8_SB(0, 0), cB, voffB[0], voffB[1]); PG8_STAGE(PG8_SB(0, 1), cB + hstep, voffB[0], voffB[1]); PG8_STAGE(PG8_SA(0, 0), cA, vA[0][0], vA[0][1]); PG8_STAGE(PG8_SA(0, 1), cA, vA[1][0], vA[1][1]);
    if (wr == 1) PG8_BAR;
    PG8_WAIT_V(2); PG8_BAR;
    PG8_STAGE(PG8_SB(1, 0), cB + kstep, voffB[0], voffB[1]); PG8_STAGE(PG8_SA(1, 0), cA + kstep, vA[0][0], vA[0][1]); PG8_STAGE(PG8_SB(1, 1), cB + hstep + kstep, voffB[0], voffB[1]);
    PG8_WAIT_V(6); PG8_BAR;
    for (;;) {
        const bool has_next = S.next(ui + 1, nxt);
        const char* nA = GATHER ? cA : (has_next ? nxt.A : cA); const char* nB = has_next ? nxt.B : cB;
        unsigned tok_[2][2] = {{0u, 0u}, {0u, 0u}};
#define PG8_KBODY(a1, a2, b2, a3, b3, W00, W01, W10, W11) do { \
              \
            PG8_LDB(B0, 0, 0); PG8_LDB(B1, 0, 1); PG8_SCHED; PG8_LDA(At, 0, 0); PG8_STAGE(PG8_SA(1, 1), a1, vA[1][0], vA[1][1]); \
            PG8_WAIT_V(8); PG8_WAIT_L(0); PG8_BAR; PG8_MMA(0, 0, At, B0); PG8_MMA(0, 1, At, B1); PG8_BAR; PG8_SCHED; \
              \
            PG8_LDA(At, 0, 1); PG8_STAGE(PG8_SB(0, 0), b2, voffB[0], voffB[1]); PG8_STAGE(PG8_SB(0, 1), (b2) + hstep, voffB[0], voffB[1]); PG8_STAGE(PG8_SA(0, 0), a2, W00, W01); \
            PG8_WAIT_V(8); PG8_WAIT_L(0); PG8_BAR; PG8_MMA(1, 0, At, B0); PG8_MMA(1, 1, At, B1); PG8_BAR; PG8_SCHED; \
              \
            PG8_LDB(B0, 1, 0); PG8_LDB(B1, 1, 1); PG8_SCHED; PG8_LDA(At, 1, 0); PG8_STAGE(PG8_SA(0, 1), a2, W10, W11); \
            PG8_WAIT_V(8); PG8_WAIT_L(0); PG8_BAR; PG8_MMA(0, 0, At, B0); PG8_MMA(0, 1, At, B1); PG8_BAR; PG8_SCHED; \
              \
            PG8_LDA(At, 1, 1); PG8_STAGE(PG8_SB(1, 0), b3, voffB[0], voffB[1]); PG8_STAGE(PG8_SB(1, 1), (b3) + hstep, voffB[0], voffB[1]); PG8_STAGE(PG8_SA(1, 0), a3, W00, W01); \
            PG8_WAIT_V(8); PG8_WAIT_L(0); PG8_BAR; PG8_MMA(1, 0, At, B0); PG8_MMA(1, 1, At, B1); PG8_BAR; PG8_SCHED; } while (0)
        for (int t = 0; t < nt - 2; t += 2) {
            const char* a1 = cA + (size_t)(t + 1) * kstep;
            const char* a2 = cA + (size_t)(t + 2) * kstep; const char* b2 = cB + (size_t)(t + 2) * kstep;
            const char* a3 = a2 + kstep; const char* b3 = b2 + kstep;
            if (GATHER) { if (t == nt - 4 && has_next) { int t2_ = tid; asm volatile("" : "+v"(t2_));
#pragma unroll
                for (int i = 0; i < 2; ++i) { int R, C; stage_rc(t2_ * 16 + i * 8192, R, C);
#pragma unroll
                    for (int h = 0; h < 2; ++h) { const unsigned vo = S.tokoff(nxt, h * HALF + R); asm volatile("global_load_dword %0, %1, %2" : "=v"(tok_[h][i]) : "v"(vo), "s"(S.tokbase()) : "memory"); } } } }
            PG8_KBODY(a1, a2, b2, a3, b3, vA[0][0], vA[0][1], vA[1][0], vA[1][1]);
        }
        if (GATHER) {
            if (has_next) { int t2_ = tid; asm volatile("" : "+v"(t2_), "+v"(tok_[0][0]), "+v"(tok_[0][1]), "+v"(tok_[1][0]), "+v"(tok_[1][1]));
#pragma unroll
                for (int i = 0; i < 2; ++i) { int R, C; stage_rc(t2_ * 16 + i * 8192, R, C);
#pragma unroll
                    for (int h = 0; h < 2; ++h) vN[h][i] = tok_[h][i] * (unsigned)(K * 2) + (unsigned)C * 2u; } }
            else {
#pragma unroll
                for (int h = 0; h < 2; ++h)
#pragma unroll
                    for (int i = 0; i < 2; ++i) vN[h][i] = vA[h][i];
            }
        }
        {
            const char* a1 = cA + (size_t)(nt - 1) * kstep;
            const char* a3 = nA + kstep; const char* b3 = nB + kstep;
            PG8_KBODY(a1, nA, nB, a3, b3, vN[0][0], vN[0][1], vN[1][0], vN[1][1]);
        }
#undef PG8_KBODY
        if constexpr (ALIGN_EPI) { if (wr == 0) PG8_BAR; }
        { int t3_ = tid; asm volatile("" : "+v"(t3_)); const int l3_ = t3_ & 63; E(acc, cur, wr, wc, l3_ & 15, l3_ >> 4); }
        if (!has_next) break;
#pragma unroll
        for (int a = 0; a < 2; ++a)
#pragma unroll
            for (int b = 0; b < 2; ++b)
#pragma unroll
                for (int m = 0; m < 4; ++m)
#pragma unroll
                    for (int n = 0; n < 2; ++n) acc[a][b][m][n] = (f32x4){0.f, 0.f, 0.f, 0.f};
        cur = nxt; cA = nA; cB = nB; ++ui;
        if (GATHER) {
#pragma unroll
            for (int h = 0; h < 2; ++h)
#pragma unroll
                for (int i = 0; i < 2; ++i) vA[h][i] = vN[h][i];
        }
        if constexpr (ALIGN_EPI) { if (wr == 1) PG8_BAR; }
    }
    PG8_WAIT_V(0);
    if constexpr (!ALIGN_EPI) { if (wr == 0) PG8_BAR; }
    PG8_BAR;
#undef PG8_AOFFS
#undef PG8_SA
#undef PG8_SB
#undef PG8_STAGE
#undef PG8_LDA
#undef PG8_LDB
#undef PG8_MMA
#undef PG8_WAIT_V
#undef PG8_WAIT_L
#undef PG8_BAR
#undef PG8_SCHED
}


constexpr int TS_OFF = 131072 + 1024;
template <bool GATHER> struct MoeOrder {
    const char* A; const char* Bt; const int* rowtok; int nN, nwg, nM, G, c, K; size_t strideE;
    __device__ __forceinline__ void init(const bf16_t* A_, const bf16_t* Bt_, const int* rowtok_, int N, int K_, size_t strideE_, int G_, int c_) {
        A = (const char*)A_; Bt = (const char*)Bt_; rowtok = rowtok_; nN = N / BM; K = K_; strideE = strideE_; G = G_; c = c_;
        nM = ((LAS const int*)(LDSP + TS_OFF))[32]; nwg = nM * nN; }
    __device__ __forceinline__ bool next(int i, GUnit& u) const {
        const long L = (long)i * G + c; if (L >= nwg) return false;
        int wgid = (int)L; { const int q = nwg / NXCD, r = nwg % NXCD, xcd = wgid % NXCD, off = wgid / NXCD; wgid = (xcd < r ? xcd * (q + 1) : r * (q + 1) + (xcd - r) * q) + off; }
        const int nig = WGM * nN, gid = wgid / nig, fm = gid * WGM, gsz = (nM - fm) < WGM ? (nM - fm) : WGM;
        u.pm = fm + ((wgid % nig) % gsz); u.pn = (wgid % nig) / gsz;
        LAS const int* ts = (LAS const int*)(LDSP + TS_OFF);
        const int e = ts[72 + u.pm];
        u.e = e; u.row0 = (u.pm - ts[e]) * BM; u.cnt = ts[33 + e];
        u.A = GATHER ? A : A + (size_t)u.pm * BM * K * 2;
        u.B = Bt + (size_t)e * strideE + (size_t)u.pn * BM * K * 2; return true;
    }
    __device__ __forceinline__ unsigned aoff(const GUnit& u, int row) const {
        if (GATHER) { int sl = u.row0 + row; sl = sl < u.cnt ? sl : u.cnt - 1; return (unsigned)rowtok[u.e * ECAP + sl] * (unsigned)(K * 2); }
        return (unsigned)(row * K * 2);
    }
    __device__ __forceinline__ unsigned tokoff(const GUnit& u, int row) const { int sl = u.row0 + row; sl = sl < u.cnt ? sl : u.cnt - 1; return (unsigned)(u.e * ECAP + sl) * 4u; }
    __device__ __forceinline__ const int* tokbase() const { return rowtok; }
};
__device__ __forceinline__ void moe_tiles(const unsigned* cnt, int tid) {
    LAS int* ts = (LAS int*)(LDSP + TS_OFF);
    if (tid == 0) { int s = 0; for (int e = 0; e < NEXP; ++e) { const int c = (int)cnt[e]; ts[e] = s; ts[33 + e] = c; const int n = (c + BM - 1) / BM;
_Pragma("clang loop vectorize(disable) unroll(disable)") for (int t = 0; t < n; ++t) ts[72 + s + t] = e;
            s += n; } ts[NEXP] = s; }
    __syncthreads();
}
struct EpiMoe1 {
    static constexpr bool PERM = true;
    bf16_t* O; const float* b1; const float* rsc;
    __device__ __forceinline__ void operator()(const f32x4 (&acc)[2][2][4][2], const GUnit& u, int wr, int wc, int fr, int fq) const {
        const int rt0 = wr * 64 + fr, col0 = u.pn * 128 + wc * 32 + 8 * fq;
        const float* bg = b1 + (size_t)u.e * 2048 + col0;
        f32x4 bgv[2], blv[2];
#pragma unroll
        for (int n = 0; n < 2; ++n) { bgv[n] = *(const f32x4*)(bg + 4 * n); blv[n] = *(const f32x4*)(bg + DFF + 4 * n); }
#pragma unroll
        for (int ai = 0; ai < 2; ++ai)
#pragma unroll
            for (int m = 0; m < 4; ++m) {
                const int rt = rt0 + ai * HALF + m * 16; int sl = u.row0 + rt; sl = sl < u.cnt ? sl : u.cnt - 1;
                const float r = rsc[u.e * ECAP + sl];
                float o[8];
#pragma unroll
                for (int n = 0; n < 2; ++n)
#pragma unroll
                    for (int j = 0; j < 4; ++j) {
                        const float g = fminf(r * acc[ai][0][m][n][j] + bgv[n][j], 7.f);
                        const float l = fminf(fmaxf(r * acc[ai][1][m][n][j] + blv[n][j], -7.f), 7.f);
                        o[n * 4 + j] = g / (1.f + __expf(-1.702f * g)) * (l + 1.f);
                    }
                u32x4 w; w.x = cvt_pk_bf16(o[0], o[1]); w.y = cvt_pk_bf16(o[2], o[3]); w.z = cvt_pk_bf16(o[4], o[5]); w.w = cvt_pk_bf16(o[6], o[7]);
                *(u32x4*)(O + (size_t)(u.pm * BM + rt) * DFF + col0) = w;
            }
    }
};
struct EpiMoe2 {
    static constexpr bool PERM = true;
    bf16_t* O; const float* b2;
    __device__ __forceinline__ void operator()(const f32x4 (&acc)[2][2][4][2], const GUnit& u, int wr, int wc, int fr, int fq) const {
        const int row0 = u.pm * BM + wr * 64 + fr, col0 = u.pn * BM + wc * 32 + 8 * fq;
        f32x4 bv[2][2];
#pragma unroll
        for (int bj = 0; bj < 2; ++bj)
#pragma unroll
            for (int n = 0; n < 2; ++n) bv[bj][n] = *(const f32x4*)(b2 + (size_t)u.e * DM + col0 + bj * HALF + 4 * n);
#pragma unroll
        for (int ai = 0; ai < 2; ++ai)
#pragma unroll
            for (int m = 0; m < 4; ++m) { bf16_t* rowp = O + (size_t)(row0 + ai * HALF + m * 16) * DM + col0;
#pragma unroll
                for (int bj = 0; bj < 2; ++bj) { const f32x4 v0 = acc[ai][bj][m][0] + bv[bj][0], v1 = acc[ai][bj][m][1] + bv[bj][1];
                    u32x4 w; w.x = cvt_pk_bf16(v0[0], v0[1]); w.y = cvt_pk_bf16(v0[2], v0[3]); w.z = cvt_pk_bf16(v1[0], v1[1]); w.w = cvt_pk_bf16(v1[2], v1[3]);
                    *(u32x4*)(rowp + bj * HALF) = w; } }
    }
};

__device__ __forceinline__ void p_transpose(const int wv, const float* W, int nmat, int K, int N, bf16_t* WT, const float* kgain, int gdiv, int mode, LAS unsigned char* lds) {
    LTID();
    const int wave = wv, lane = tidx & 63;
    LAS float* scr = (LAS float*)(lds + wave * 16384);
    const int nblk = N / 32, per_mat = (K / 64) * nblk, total = nmat * per_mat, stride = (int)gridDim.x * NW;
    const int lrow = lane >> 5, lcol = lane & 31;
#define TR_ISSUE(item, dst) do { const int mat_ = (item) / per_mat, r_ = (item) - mat_ * per_mat, kb_ = r_ / nblk, nb_ = r_ - kb_ * nblk; \
        const float* src_ = W + (size_t)mat_ * K * N + (size_t)(64 * kb_ + lrow) * N + 32 * nb_ + lcol; \
        _Pragma("unroll") for (int i = 0; i < 32; ++i) dst[i] = src_[(size_t)(2 * i) * N]; } while (0)
    float v[32], vn[32];
    int it = bidx * NW + wave;
    if (it < total) TR_ISSUE(it, v);
    while (it < total) {
        const int itn = it + stride;
        if (itn < total) TR_ISSUE(itn, vn);
        const int mat = it / per_mat, r = it - mat * per_mat, kb = r / nblk, nb = r - kb * nblk, k0 = 64 * kb, n0 = 32 * nb;
#pragma unroll
        for (int i = 0; i < 32; ++i) scr[(2 * i + lrow) * 33 + lcol] = v[i];
        asm volatile("s_waitcnt lgkmcnt(0)" ::: "memory");
        int d0 = n0;
        if (mode == 1) { const int bj = n0 >> 10, rest = n0 & 1023, pn = rest >> 7, j = rest & 127; d0 = pn * 256 + bj * 128 + j; }
        const int c = lane & 7;
        f32x4 g0 = (f32x4){1.f, 1.f, 1.f, 1.f}, g1 = g0;
        if (kgain) { const float* gp = kgain + (size_t)(mat / gdiv) * DM + k0 + 8 * c; g0 = *(const f32x4*)gp; g1 = *(const f32x4*)(gp + 4); }
        bf16_t* dst = WT + (size_t)mat * K * N;
#pragma unroll
        for (int j = 0; j < 4; ++j) { const int n = (lane >> 3) + 8 * j; const LAS float* sp = scr + (8 * c) * 33 + n;
            u32x4 o; o.x = pk2(sp[0 * 33] * g0[0], sp[1 * 33] * g0[1]); o.y = pk2(sp[2 * 33] * g0[2], sp[3 * 33] * g0[3]); o.z = pk2(sp[4 * 33] * g1[0], sp[5 * 33] * g1[1]); o.w = pk2(sp[6 * 33] * g1[2], sp[7 * 33] * g1[3]);
            *(u32x4*)(dst + (size_t)(d0 + n) * K + k0 + 8 * c) = o; }
        asm volatile("s_waitcnt lgkmcnt(0)" ::: "memory");
#pragma unroll
        for (int i = 0; i < 32; ++i) v[i] = vn[i];
        it = itn;
    }
#undef TR_ISSUE
}
typedef short v4i16_t __attribute__((ext_vector_type(4)));
constexpr int ATT_TAB_OFF = 131072 + 2048;
constexpr int ATT_UNITS = 3 * 8 * 128;
__device__ __forceinline__ int t5_bucket_dev(int n) {
    if (n < 16) return n;
    const float v = logf((float)n / 16.f) / 4.852030263919617f * 16.f;
    const int large = 16 + (int)v;
    return large < 31 ? large : 31;
}
__device__ __forceinline__ void p_bias_table(const int wv, const float* rel_bias, float* biasG) {
    LTID();
    for (int i = bidx * NT + tidx; i < 3 * 8 * 132; i += gridDim.x * NT) {
        const int d = i % 132, bh = i / 132, h = bh & 7, b = bh >> 3;
        biasG[i] = (d <= 128) ? rel_bias[t5_bucket_dev(d << (2 * b)) * 8 + h] : 0.f;
    }
}
__device__ __forceinline__ void p_dil_attn(const int wv, const bf16_t* proj16, const float* biasG, bf16_t* obr, float* lse, LAS unsigned char* lds) {
    LTID();
    const int lane = tidx & 63, fr = lane & 15, fq = lane >> 4, w = wv;
    const int per = (ATT_UNITS + (int)gridDim.x - 1) / (int)gridDim.x;
    const int u0 = bidx * per, u1 = (u0 + per < ATT_UNITS) ? u0 + per : ATT_UNITS;
    if (u0 >= u1) return;
    const int rowl = tidx >> 3, cs = tidx & 7;
    const unsigned cK = (unsigned)(cs ^ ((rowl >> 1) & 7)) * 16u, cV = (unsigned)(cs ^ (rowl & 7)) * 16u;
    const unsigned fK = (unsigned)((fr >> 1) & 7);
    const unsigned kro0 = (unsigned)fr * 128u + (((unsigned)fq ^ fK) * 16u), kro1 = (unsigned)fr * 128u + ((((unsigned)fq ^ fK) ^ 4u) * 16u);
    const int tq = (lane & 15) >> 2, tp = lane & 3, fv = 4 * (fq & 1) + tq;
    unsigned vro[4];
#pragma unroll
    for (int db = 0; db < 4; ++db) vro[db] = (unsigned)(4 * fq + tq) * 128u + (unsigned)(((2 * db + (tp >> 1)) ^ fv) * 16) + 8u * (unsigned)(tp & 1);
    const int ts_ = (1 + fr) & 3;
    const unsigned tab8 = (unsigned)ATT_TAB_OFF + (unsigned)ts_ * 640u + (unsigned)(((141 + fr - ts_) >> 2) - fq - 32) * 16u;
    const char* gbase = (const char*)proj16;
#define ATT_DECODE(u, b_, h_, r_, n_, dil_) const int cmb_ = (u) >> 7, b_ = cmb_ >> 3, h_ = cmb_ & 7, dil_ = 1 << (2 * b_), idx_ = (u) & 127, r_ = idx_ & (dil_ - 1), n_ = idx_ >> (2 * b_)
#define ATT_ISSUE(u, bf, q0, q1) do { ATT_DECODE(u, b__, h__, r__, n__, dil__); \
        const int nk = n__ > 0 ? n__ - 1 : 0;                                     \
        _Pragma("unroll") for (int p = 0; p < 4; ++p) { \
            int row = 64 * p + rowl; int blk = (row >> 7) ? n__ : nk; \
            const unsigned pos = (unsigned)(r__ + dil__ * (128 * blk + (row & 127))); \
            const unsigned so = pos * 4096u + (unsigned)h__ * 128u; const unsigned ld_ = (unsigned)(size_t)(lds + (bf) * 65536 + p * 8192 + w * 1024); \
            glds16s(gbase, so + 1024u + cK, ld_); glds16s(gbase, so + 2048u + cV, ld_ + 32768u); } \
        const unsigned qpos = (unsigned)(r__ + dil__ * (128 * n__ + 16 * w + fr)); \
        const char* qsrc = gbase + (size_t)qpos * 4096u + (unsigned)h__ * 128u + (unsigned)fq * 16u; \
        q0 = *(const bf16x8*)(qsrc); q1 = *(const bf16x8*)(qsrc + 64); } while (0)
    bf16x8 qf0, qf1, qn0, qn1;
    ATT_ISSUE(u0, 0, qn0, qn1);
    int prev_cmb = -1;
    for (int u = u0; u < u1; ++u) {
        const int bf = (u - u0) & 1;
        asm volatile("s_waitcnt vmcnt(0)" ::: "memory");
        __syncthreads();
        qf0 = qn0; qf1 = qn1;
        if (u + 1 < u1) ATT_ISSUE(u + 1, bf ^ 1, qn0, qn1);
        ATT_DECODE(u, b, h, r, n, dil);
        if (cmb_ != prev_cmb) {
            prev_cmb = cmb_;
            for (int e = tidx; e < 4 * 160; e += NT) { const int sft = e / 160, k = e - sft * 160, idx = k + sft, dist = idx - 16;
                const float v = (dist >= 0 && dist <= 128) ? biasG[cmb_ * 132 + dist] : -1e30f;
                ((LAS float*)(lds + ATT_TAB_OFF))[sft * 160 + k] = v; }
            __syncthreads();
        }
        const LAS unsigned char* Kb = lds + bf * 65536; const LAS unsigned char* Vb = Kb + 32768;
        const int kb0 = w;
        f32x4 sc[9];
#pragma unroll
        for (int i = 0; i < 9; ++i) {
            const unsigned ko = (unsigned)(kb0 + i) * 2048u;
            const bf16x8 k0 = *(const LAS bf16x8*)(Kb + ko + kro0), k1 = *(const LAS bf16x8*)(Kb + ko + kro1);
            f32x4 a = (f32x4){0.f, 0.f, 0.f, 0.f};
            a = __builtin_amdgcn_mfma_f32_16x16x32_bf16(k0, qf0, a, 0, 0, 0);
            a = __builtin_amdgcn_mfma_f32_16x16x32_bf16(k1, qf1, a, 0, 0, 0);
            const f32x4 t = *(const LAS f32x4*)(lds + tab8 + 64 * (8 - i));
            a = a + (f32x4){t[3], t[2], t[1], t[0]};
            if (n == 0 && kb0 + i < 8) a = (f32x4){-1e30f, -1e30f, -1e30f, -1e30f};
            sc[i] = a;
        }
        float mx = -1e30f;
#pragma unroll
        for (int i = 0; i < 9; ++i) mx = fmaxf(mx, fmaxf(fmaxf(sc[i][0], sc[i][1]), fmaxf(sc[i][2], sc[i][3])));
        mx = fmaxf(mx, shx(mx, 16, lane)); mx = fmaxf(mx, shx(mx, 32, lane));
        float sum = 0.f;
#pragma unroll
        for (int i = 0; i < 9; ++i)
#pragma unroll
            for (int j = 0; j < 4; ++j) { const float p = __expf(sc[i][j] - mx); sc[i][j] = p; sum += p; }
        sum += shx(sum, 16, lane); sum += shx(sum, 32, lane);
        f32x4 oacc[4];
#pragma unroll
        for (int db = 0; db < 4; ++db) oacc[db] = (f32x4){0.f, 0.f, 0.f, 0.f};
#pragma unroll
        for (int c = 0; c < 5; ++c) {
            const int ia = 2 * c, ib = (c < 4) ? 2 * c + 1 : 8;
            u32x4 pw; pw.x = cvt_pk_bf16(sc[ia][0], sc[ia][1]); pw.y = cvt_pk_bf16(sc[ia][2], sc[ia][3]);
            if (c < 4) { pw.z = cvt_pk_bf16(sc[ib][0], sc[ib][1]); pw.w = cvt_pk_bf16(sc[ib][2], sc[ib][3]); } else { pw.z = 0u; pw.w = 0u; }
            const bf16x8 pf = __builtin_bit_cast(bf16x8, pw);
            const unsigned va = (unsigned)(kb0 + ia) * 2048u, vb = (unsigned)(kb0 + ib) * 2048u;
#pragma unroll
            for (int db = 0; db < 4; ++db) {
                const v4i16_t x0 = __builtin_amdgcn_ds_read_tr16_b64_v4i16((LAS v4i16_t*)(Vb + va + vro[db]));
                const v4i16_t x1 = __builtin_amdgcn_ds_read_tr16_b64_v4i16((LAS v4i16_t*)(Vb + vb + vro[db]));
                const bf16x8 vf = (bf16x8){x0[0], x0[1], x0[2], x0[3], x1[0], x1[1], x1[2], x1[3]};
                oacc[db] = __builtin_amdgcn_mfma_f32_16x16x32_bf16(vf, pf, oacc[db], 0, 0, 0);
            }
        }
        const float inv = 1.f / sum;
        const unsigned qpos = (unsigned)(r + dil * (128 * n + 16 * w + fr));
        bf16_t* orow = obr + ((size_t)b * SEQ + qpos) * 512 + h * 64 + 4 * fq;
#pragma unroll
        for (int db = 0; db < 4; ++db) { u32x2 o2; o2.x = cvt_pk_bf16(oacc[db][0] * inv, oacc[db][1] * inv); o2.y = cvt_pk_bf16(oacc[db][2] * inv, oacc[db][3] * inv); *(u32x2*)(orow + 16 * db) = o2; }
        if (fq == 0) lse[((size_t)b * SEQ + qpos) * 8 + h] = mx + __logf(sum);
    }
    asm volatile("s_waitcnt vmcnt(0)" ::: "memory");
    __syncthreads();
#undef ATT_DECODE
#undef ATT_ISSUE
}
__device__ __forceinline__ void p_attn_combine(const int wv, const bf16_t* obr, const float* lse, const float* g, bf16_t* mix16) {
    LTID();
    const int lane = tidx & 63, h = lane >> 3;
    f32x4 g0 = *(const f32x4*)(g + lane * 8), g1 = *(const f32x4*)(g + lane * 8 + 4);
    for (int row = bidx * NW + wv; row < SEQ; row += gridDim.x * NW) {
        float l0 = lse[((size_t)0 * SEQ + row) * 8 + h], l1 = lse[((size_t)1 * SEQ + row) * 8 + h], l2 = lse[((size_t)2 * SEQ + row) * 8 + h];
        const float M = fmaxf(l0, fmaxf(l1, l2));
        float w0 = __expf(l0 - M), w1 = __expf(l1 - M), w2 = __expf(l2 - M);
        const float iw = 1.f / (w0 + w1 + w2); w0 *= iw; w1 *= iw; w2 *= iw;
        const u32x4 a0 = *(const u32x4*)(obr + ((size_t)0 * SEQ + row) * 512 + lane * 8);
        const u32x4 a1 = *(const u32x4*)(obr + ((size_t)1 * SEQ + row) * 512 + lane * 8);
        const u32x4 a2 = *(const u32x4*)(obr + ((size_t)2 * SEQ + row) * 512 + lane * 8);
        float y[8]; float ss = 0.f;
#pragma unroll
        for (int k = 0; k < 4; ++k) {
            const float lo = w0 * __builtin_bit_cast(float, a0[k] << 16) + w1 * __builtin_bit_cast(float, a1[k] << 16) + w2 * __builtin_bit_cast(float, a2[k] << 16);
            const float hi = w0 * __builtin_bit_cast(float, a0[k] & 0xffff0000u) + w1 * __builtin_bit_cast(float, a1[k] & 0xffff0000u) + w2 * __builtin_bit_cast(float, a2[k] & 0xffff0000u);
            y[2 * k] = lo; y[2 * k + 1] = hi; ss += lo * lo + hi * hi;
        }
#pragma unroll
        for (int o = 32; o; o >>= 1) ss += shx(ss, o, lane);
        const float sc = rsqrtf(ss * (1.f / 512.f) + 1e-5f);
        u32x4 o4; o4.x = cvt_pk_bf16(y[0] * sc * g0[0], y[1] * sc * g0[1]); o4.y = cvt_pk_bf16(y[2] * sc * g0[2], y[3] * sc * g0[3]);
        o4.z = cvt_pk_bf16(y[4] * sc * g1[0], y[5] * sc * g1[1]); o4.w = cvt_pk_bf16(y[6] * sc * g1[2], y[7] * sc * g1[3]);
        *(u32x4*)(mix16 + (size_t)row * DM + lane * 8) = o4;
    }
}
struct EpiIn {
    static constexpr bool PERM = true;
    bf16_t* O;
    __device__ __forceinline__ void operator()(const f32x4 (&acc)[2][2][4][2], const GUnit& u, int wr, int wc, int fr, int fq) const {
        const int row0 = u.pm * BM + wr * 64 + fr, col0 = u.pn * BM + wc * 32 + 8 * fq;
        const float sc = u.pn < 2 ? 0.125f : 1.f;
#pragma unroll
        for (int ai = 0; ai < 2; ++ai)
#pragma unroll
            for (int m = 0; m < 4; ++m) { const size_t ro = (size_t)(row0 + ai * HALF + m * 16) * DIN + col0;
#pragma unroll
                for (int bj = 0; bj < 2; ++bj) { const f32x4 v0 = acc[ai][bj][m][0] * sc, v1 = acc[ai][bj][m][1] * sc;
                    u32x4 w; w.x = cvt_pk_bf16(v0[0], v0[1]); w.y = cvt_pk_bf16(v0[2], v0[3]); w.z = cvt_pk_bf16(v1[0], v1[1]); w.w = cvt_pk_bf16(v1[2], v1[3]);
                    *(u32x4*)(O + ro + bj * HALF) = w;
                    } }
    }
};


__device__ __forceinline__ unsigned xoff_b(unsigned row, unsigned ch) { return 256u * row + 16u * (ch ^ (((row & 3u) << 2) | ((row >> 2) & 3u))); }
__device__ __forceinline__ void p_xattn_mfma(const int wv, const bf16_t* qx16, const bf16_t* kv16, bf16_t* ox16, LAS unsigned char* lds) {
    LTID();
    const int lane = tidx & 63, fr = lane & 15, fq = lane >> 4, w = wv;
    const int NU = 4 * 128;
    const int per = (NU + (int)gridDim.x - 1) / (int)gridDim.x;
    const int u0 = bidx * per, u1 = (u0 + per < NU) ? u0 + per : NU;
    if (u0 >= u1) return;
    const int rowl = tidx >> 4, cs = tidx & 15;
    const unsigned csw = (unsigned)(cs ^ (((rowl & 3) << 2) | ((rowl >> 2) & 3))) * 16u;
    const unsigned kswz = (unsigned)(((fr & 3) << 2) | ((fr >> 2) & 3));
    unsigned kro[4];
#pragma unroll
    for (int s4 = 0; s4 < 4; ++s4) kro[s4] = 256u * (unsigned)fr + 16u * ((unsigned)(4 * s4 + fq) ^ kswz);
    const int tq = (lane & 15) >> 2, tp = lane & 3;
    const unsigned vswz = (unsigned)((tq << 2) | fq);
    unsigned vro[8];
#pragma unroll
    for (int c = 0; c < 8; ++c) vro[c] = 65536u + 256u * (unsigned)(4 * fq + tq) + 16u * ((unsigned)(2 * c + (tp >> 1)) ^ vswz) + 8u * (unsigned)(tp & 1);
    int prev_h = -1;
    for (int u = u0; u < u1; ++u) {
        const int h = u >> 7, qt = u & 127;
        if (h != prev_h) {
            __syncthreads();
            prev_h = h;
#pragma unroll
            for (int p = 0; p < 8; ++p) {
                const unsigned row = (unsigned)(32 * p + rowl);
                const unsigned so = row * 2048u + (unsigned)h * 256u + csw;
                const unsigned ld_ = (unsigned)(size_t)(lds + p * 8192 + w * 1024);
                glds16s(kv16, so, ld_); glds16s(kv16, so + 1024u, ld_ + 65536u);
            }
            asm volatile("s_waitcnt vmcnt(0)" ::: "memory");
            __syncthreads();
        }
        const char* qsrc = (const char*)qx16 + ((size_t)(qt * 128 + 16 * w + fr) * 512 + h * 128 + 8 * fq) * 2;
        bf16x8 qf[4];
#pragma unroll
        for (int s4 = 0; s4 < 4; ++s4) qf[s4] = *(const bf16x8*)(qsrc + 64 * s4);
        f32x4 sc[16];
#pragma unroll
        for (int i = 0; i < 16; ++i) {
            f32x4 a = (f32x4){0.f, 0.f, 0.f, 0.f};
#pragma unroll
            for (int s4 = 0; s4 < 4; ++s4) { const bf16x8 kf = *(const LAS bf16x8*)(lds + i * 4096 + kro[s4]); a = __builtin_amdgcn_mfma_f32_16x16x32_bf16(kf, qf[s4], a, 0, 0, 0); }
            sc[i] = a;
        }
        float mx = -1e30f;
#pragma unroll
        for (int i = 0; i < 16; ++i) mx = fmaxf(mx, fmaxf(fmaxf(sc[i][0], sc[i][1]), fmaxf(sc[i][2], sc[i][3])));
        mx = fmaxf(mx, shx(mx, 16, lane)); mx = fmaxf(mx, shx(mx, 32, lane));
        float sum = 0.f;
#pragma unroll
        for (int i = 0; i < 16; ++i)
#pragma unroll
            for (int j = 0; j < 4; ++j) { const float p = __expf(sc[i][j] - mx); sc[i][j] = p; sum += p; }
        sum += shx(sum, 16, lane); sum += shx(sum, 32, lane);
        f32x4 oacc[8];
#pragma unroll
        for (int c = 0; c < 8; ++c) oacc[c] = (f32x4){0.f, 0.f, 0.f, 0.f};
#pragma unroll
        for (int ch = 0; ch < 8; ++ch) {
            const int ia = 2 * ch, ib = 2 * ch + 1;
            u32x4 pw; pw.x = cvt_pk_bf16(sc[ia][0], sc[ia][1]); pw.y = cvt_pk_bf16(sc[ia][2], sc[ia][3]); pw.z = cvt_pk_bf16(sc[ib][0], sc[ib][1]); pw.w = cvt_pk_bf16(sc[ib][2], sc[ib][3]);
            const bf16x8 pf = __builtin_bit_cast(bf16x8, pw);
#pragma unroll
            for (int c = 0; c < 8; ++c) {
                const v4i16_t x0 = __builtin_amdgcn_ds_read_tr16_b64_v4i16((LAS v4i16_t*)(lds + ia * 4096 + vro[c]));
                const v4i16_t x1 = __builtin_amdgcn_ds_read_tr16_b64_v4i16((LAS v4i16_t*)(lds + ib * 4096 + vro[c]));
                const bf16x8 vf = (bf16x8){x0[0], x0[1], x0[2], x0[3], x1[0], x1[1], x1[2], x1[3]};
                oacc[c] = __builtin_amdgcn_mfma_f32_16x16x32_bf16(vf, pf, oacc[c], 0, 0, 0);
            }
        }
        const float inv = 1.f / sum;
        bf16_t* orow = ox16 + (size_t)(qt * 128 + 16 * w + fr) * 512 + h * 128 + 4 * fq;
#pragma unroll
        for (int c = 0; c < 8; ++c) { u32x2 o2; o2.x = cvt_pk_bf16(oacc[c][0] * inv, oacc[c][1] * inv); o2.y = cvt_pk_bf16(oacc[c][2] * inv, oacc[c][3] * inv); *(u32x2*)(orow + 16 * c) = o2; }
    }
    __syncthreads();
}
struct EpiBf16 {
    static constexpr bool PERM = true;
    bf16_t* O; int ldc; float scale; const float* ss;
    __device__ __forceinline__ void operator()(const f32x4 (&acc)[2][2][4][2], const GUnit& u, int wr, int wc, int fr, int fq) const {
        const int row0 = u.pm * BM + wr * 64 + fr, col0 = u.pn * BM + wc * 32 + 8 * fq;
#pragma unroll
        for (int ai = 0; ai < 2; ++ai)
#pragma unroll
            for (int m = 0; m < 4; ++m) { const int row = row0 + ai * HALF + m * 16; bf16_t* rowp = O + (size_t)row * ldc + col0;
                float sc = scale;
                if (ss) { const f32x4 p0 = *(const f32x4*)(ss + (size_t)row * 16), p1 = *(const f32x4*)(ss + (size_t)row * 16 + 4), p2 = *(const f32x4*)(ss + (size_t)row * 16 + 8), p3 = *(const f32x4*)(ss + (size_t)row * 16 + 12);
                    const float t = ((p0[0] + p0[1]) + (p0[2] + p0[3])) + ((p1[0] + p1[1]) + (p1[2] + p1[3])) + ((p2[0] + p2[1]) + (p2[2] + p2[3])) + ((p3[0] + p3[1]) + (p3[2] + p3[3]));
                    sc = scale * rsqrtf(t * (1.f / 1024.f) + 1e-5f); }
#pragma unroll
                for (int bj = 0; bj < 2; ++bj) { const f32x4 v0 = acc[ai][bj][m][0] * sc, v1 = acc[ai][bj][m][1] * sc;
                    u32x4 w; w.x = cvt_pk_bf16(v0[0], v0[1]); w.y = cvt_pk_bf16(v0[2], v0[3]); w.z = cvt_pk_bf16(v1[0], v1[1]); w.w = cvt_pk_bf16(v1[2], v1[3]);
                    *(u32x4*)(rowp + bj * HALF) = w; } }
    }
};
struct EpiOut {
    static constexpr bool PERM = true;
    float* H; bf16_t* HB; float* ss;
    __device__ __forceinline__ void operator()(const f32x4 (&acc)[2][2][4][2], const GUnit& u, int wr, int wc, int fr, int fq) const {
        const int row0 = u.pm * BM + wr * 64 + fr, col0 = u.pn * BM + wc * 32 + 8 * fq, lane = fq * 16 + fr;
#pragma unroll
        for (int ai = 0; ai < 2; ++ai)
#pragma unroll
            for (int m = 0; m < 4; ++m) { const int row = row0 + ai * HALF + m * 16; const size_t ro = (size_t)row * DM + col0; float sq = 0.f;
#pragma unroll
                for (int bj = 0; bj < 2; ++bj) {
                    const f32x4 v0 = acc[ai][bj][m][0] + *(const f32x4*)(H + ro + bj * HALF), v1 = acc[ai][bj][m][1] + *(const f32x4*)(H + ro + bj * HALF + 4);
                    *(f32x4*)(H + ro + bj * HALF) = v0; *(f32x4*)(H + ro + bj * HALF + 4) = v1;
                    u32x4 w; w.x = cvt_pk_bf16(v0[0], v0[1]); w.y = cvt_pk_bf16(v0[2], v0[3]); w.z = cvt_pk_bf16(v1[0], v1[1]); w.w = cvt_pk_bf16(v1[2], v1[3]);
                    *(u32x4*)(HB + ro + bj * HALF) = w;
                    sq += (v0[0] * v0[0] + v0[1] * v0[1]) + (v0[2] * v0[2] + v0[3] * v0[3]) + (v1[0] * v1[0] + v1[1] * v1[1]) + (v1[2] * v1[2] + v1[3] * v1[3]);
                }
                sq += shx(sq, 16, lane); sq += shx(sq, 32, lane);
                if (fq == 0) ss[(size_t)row * 16 + u.pn * 4 + wc] = sq;
            }
    }
};

typedef short bf16x4 __attribute__((ext_vector_type(4)));
typedef float f32x2 __attribute__((ext_vector_type(2)));
constexpr int S5_CHUNK = 256, S5_NCH = SEQ / S5_CHUNK, S5_ROWB = 528;
__device__ __forceinline__ f32x2 gelu_pk(f32x2 v) {
    const f32x2 av = __builtin_elementwise_abs(v), d = av * 0.2316418882f + 1.0f;
    f32x2 t; t.x = __builtin_amdgcn_rcpf(d.x); t.y = __builtin_amdgcn_rcpf(d.y);
    f32x2 q = t * 0.5307027145f + (-0.7265760135f); q = q * t + 0.7107068705f; q = q * t + (-0.142248368f); q = q * t + 0.127414796f; q = q * t;
    const f32x2 s2 = (v * v) * (-0.72134752044f);
    f32x2 e; e.x = __builtin_amdgcn_exp2f(s2.x); e.y = __builtin_amdgcn_exp2f(s2.y);
    const f32x2 m = v * (q * e), r = v - m;
    f32x2 o; o.x = v.x < 0.f ? m.x : r.x; o.y = v.y < 0.f ? m.y : r.y; return o;
}
__device__ __forceinline__ void p_s5_tables2(const int wv, const float* a_re, const float* a_im, const float* b_re, const float* b_im, const float* c_re, const float* c_im, const float* log_dt,
                                             float2* abar, float2* a256, bf16_t* BB16, bf16_t* CM16) {
    LTID();
    for (int gp = bidx * NT + tidx; gp < 2048; gp += gridDim.x * NT) {
        const int g = gp >> 6, p = gp & 63;
        const float lr = a_re[gp], li = a_im[gp], dt = expf(log_dt[g]);
        const float mag = expf(lr * dt); float sn, cs; sincosf(li * dt, &sn, &cs);
        const float ar = mag * cs, ai = mag * sn;
        abar[gp] = make_float2(ar, ai);
        float pr = ar, pi = ai;
        for (int i = 0; i < 8; ++i) { const float nr = pr * pr - pi * pi, ni = 2.f * pr * pi; pr = nr; pi = ni; }
        a256[gp] = make_float2(pr, pi);
        const float nr = ar - 1.f, ni = ai, den = lr * lr + li * li;
        const float cr = (nr * lr + ni * li) / den, ci = (ni * lr - nr * li) / den;
        for (int c = 0; c < 16; ++c) {
            const float br = b_re[gp * 16 + c], bi = b_im[gp * 16 + c];
            BB16[((size_t)g * 128 + p) * 16 + c] = (bf16_t)f2bf(cr * br - ci * bi);
            BB16[((size_t)g * 128 + 64 + p) * 16 + c] = (bf16_t)f2bf(cr * bi + ci * br);
            CM16[((size_t)g * 16 + c) * 128 + p] = (bf16_t)f2bf(c_re[(g * 16 + c) * 64 + p]);
            CM16[((size_t)g * 16 + c) * 128 + 64 + p] = (bf16_t)f2bf(-c_im[(g * 16 + c) * 64 + p]);
        }
    }
}
template <int MODE> __device__ __forceinline__ void p_s5_pass(const int wv, const bf16_t* proj16, const float2* abar, const float2* a256, const bf16_t* BB16, const bf16_t* CM16, const float* dskip,
                                                              float2* E, bf16_t* yg16, LAS unsigned char* lds) {
    LTID();
    const int lane = tidx & 63, fr = lane & 15, fq = lane >> 4;
    LAS unsigned char* L = lds + wv * (16 * S5_ROWB);
    for (int unit = bidx * NW + wv; unit < S5_NCH * 32; unit += gridDim.x * NW) {
        const int g = unit & 31, chunk = unit >> 5;
        const float2 a = abar[g * 64 + lane];
        bf16x4 bbf[8];
#pragma unroll
        for (int cb = 0; cb < 8; ++cb) bbf[cb] = *(const bf16x4*)(BB16 + ((size_t)g * 128 + 16 * cb + fr) * 16 + 4 * fq);
        bf16x8 cmf[4]; f32x4 dsk = (f32x4){0.f, 0.f, 0.f, 0.f};
        if (MODE == 1) {
#pragma unroll
            for (int s4 = 0; s4 < 4; ++s4) cmf[s4] = *(const bf16x8*)(CM16 + ((size_t)g * 16 + fr) * 128 + 32 * s4 + 8 * fq);
            dsk = *(const f32x4*)(dskip + g * 16 + 4 * fq);
        }
        float sr = 0.f, si = 0.f;
        if (MODE == 1) {
            const float2 A = a256[g * 64 + lane];
            for (int j0 = 0; j0 < chunk; j0 += 8) {
                float2 e[8];
#pragma unroll
                for (int k = 0; k < 8; ++k) { const int j = (j0 + k < chunk) ? j0 + k : chunk - 1; e[k] = E[((size_t)j * 32 + g) * 64 + lane]; }
#pragma unroll
                for (int k = 0; k < 8; ++k) if (j0 + k < chunk) { const float nr = A.x * sr - A.y * si + e[k].x, ni = A.x * si + A.y * sr + e[k].y; sr = nr; si = ni; }
            }
        }
        const bf16_t* ubase = proj16 + (size_t)(chunk * S5_CHUNK + fr) * DIN + 1536 + g * 16 + 4 * fq;
        bf16x4 uf = *(const bf16x4*)ubase;
#pragma unroll 1
        for (int blk = 0; blk < S5_CHUNK / 16; ++blk) {
            const bf16x4 ufn = *(const bf16x4*)(ubase + (size_t)((blk < S5_CHUNK / 16 - 1) ? (blk + 1) * 16 : blk * 16) * DIN);
            asm volatile("" ::: "memory");
#pragma unroll
            for (int cb = 0; cb < 8; ++cb) {
                const f32x4 d = __builtin_amdgcn_mfma_f32_16x16x16bf16_1k(bbf[cb], uf, (f32x4){0.f, 0.f, 0.f, 0.f}, 0, 0, 0);
                *(LAS f32x4*)(L + fr * S5_ROWB + (16 * cb + 4 * fq) * 4) = d;
            }
            asm volatile("" ::: "memory");
#pragma unroll
            for (int t = 0; t < 16; ++t) {
                const float re = *(const LAS float*)(L + t * S5_ROWB + lane * 4), im = *(const LAS float*)(L + t * S5_ROWB + 256 + lane * 4);
                const float nr = a.x * sr - a.y * si + re, ni = a.x * si + a.y * sr + im; sr = nr; si = ni;
                if (MODE == 1) { *(LAS bf16_t*)(L + t * S5_ROWB + lane * 2) = (bf16_t)f2bf(sr); *(LAS bf16_t*)(L + t * S5_ROWB + 128 + lane * 2) = (bf16_t)f2bf(si); }
            }
            asm volatile("" ::: "memory");
            if (MODE == 1) {
                f32x4 y = (f32x4){0.f, 0.f, 0.f, 0.f};
#pragma unroll
                for (int s4 = 0; s4 < 4; ++s4) { const bf16x8 sf = *(const LAS bf16x8*)(L + fr * S5_ROWB + 64 * s4 + 16 * fq); y = __builtin_amdgcn_mfma_f32_16x16x32_bf16(cmf[s4], sf, y, 0, 0, 0); }
                f32x4 v;
#pragma unroll
                for (int j = 0; j < 4; ++j) v[j] = y[j] + dsk[j] * bf2f((unsigned short)uf[j]);
                const f32x2 g0 = gelu_pk((f32x2){v[0], v[1]}), g1 = gelu_pk((f32x2){v[2], v[3]});
                u32x2 o2; o2.x = cvt_pk_bf16(g0.x, g0.y); o2.y = cvt_pk_bf16(g1.x, g1.y);
                *(u32x2*)(yg16 + (size_t)(chunk * S5_CHUNK + blk * 16 + fr) * 512 + g * 16 + 4 * fq) = o2;
            }
            asm volatile("" ::: "memory");
            uf = ufn;
        }
        if (MODE == 0) E[((size_t)chunk * 32 + g) * 64 + lane] = make_float2(sr, si);
    }
}
struct EpiGlu16 {
    static constexpr bool PERM = true;
    bf16_t* O; const bf16_t* Y; const float* bias;
    __device__ __forceinline__ void operator()(const f32x4 (&acc)[2][2][4][2], const GUnit& u, int wr, int wc, int fr, int fq) const {
        const int row0 = u.pm * BM + wr * 64 + fr, col0 = u.pn * BM + wc * 32 + 8 * fq;
        f32x4 bv[2][2];
#pragma unroll
        for (int bj = 0; bj < 2; ++bj)
#pragma unroll
            for (int n = 0; n < 2; ++n) bv[bj][n] = *(const f32x4*)(bias + col0 + bj * HALF + 4 * n);
#pragma unroll
        for (int ai = 0; ai < 2; ++ai)
#pragma unroll
            for (int m = 0; m < 4; ++m) { const size_t ro = (size_t)(row0 + ai * HALF + m * 16) * 512 + col0;
#pragma unroll
                for (int bj = 0; bj < 2; ++bj) {
                    const u32x4 yv = *(const u32x4*)(Y + ro + bj * HALF);
                    float o[8];
#pragma unroll
                    for (int n = 0; n < 2; ++n)
#pragma unroll
                        for (int j = 0; j < 4; ++j) { const unsigned wd = yv[n * 2 + (j >> 1)]; const float y = __builtin_bit_cast(float, (j & 1) ? (wd & 0xffff0000u) : (wd << 16));
                            o[n * 4 + j] = y / (1.f + __expf(-(acc[ai][bj][m][n][j] + bv[bj][n][j]))); }
                    u32x4 w; w.x = cvt_pk_bf16(o[0], o[1]); w.y = cvt_pk_bf16(o[2], o[3]); w.z = cvt_pk_bf16(o[4], o[5]); w.w = cvt_pk_bf16(o[6], o[7]);
                    *(u32x4*)(O + ro + bj * HALF) = w; } }
    }
};
__device__ __forceinline__ void p_ssm_norm(const int wv, const bf16_t* yb16, const float* g, bf16_t* mix16) {
    LTID();
    const int lane = tidx & 63;
    const f32x4 g0 = *(const f32x4*)(g + lane * 8), g1 = *(const f32x4*)(g + lane * 8 + 4);
    for (int row = bidx * NW + wv; row < SEQ; row += gridDim.x * NW) {
        const u32x4 a0 = *(const u32x4*)(yb16 + (size_t)row * 512 + lane * 8);
        float y[8]; float ss = 0.f;
#pragma unroll
        for (int k = 0; k < 4; ++k) { y[2 * k] = __builtin_bit_cast(float, a0[k] << 16); y[2 * k + 1] = __builtin_bit_cast(float, a0[k] & 0xffff0000u); ss += y[2 * k] * y[2 * k] + y[2 * k + 1] * y[2 * k + 1]; }
#pragma unroll
        for (int o = 32; o; o >>= 1) ss += shx(ss, o, lane);
        const float sc = rsqrtf(ss * (1.f / 512.f) + 1e-5f);
        u32x4 o4; o4.x = cvt_pk_bf16(y[0] * sc * g0[0], y[1] * sc * g0[1]); o4.y = cvt_pk_bf16(y[2] * sc * g0[2], y[3] * sc * g0[3]);
        o4.z = cvt_pk_bf16(y[4] * sc * g1[0], y[5] * sc * g1[1]); o4.w = cvt_pk_bf16(y[6] * sc * g1[2], y[7] * sc * g1[3]);
        *(u32x4*)(mix16 + (size_t)row * DM + 512 + lane * 8) = o4;
    }
}

__device__ __forceinline__ void p_rmsnorm16(const int wv, const float* in, const float* g, bf16_t* out16, int rows) {
    LTID();
    const int lane = tidx & 63;
    for (int r = bidx * NW + wv; r < rows; r += gridDim.x * NW) {
        f32x4 v[4]; float ss = 0.f;
#pragma unroll
        for (int j = 0; j < 4; ++j) { v[j] = *(const f32x4*)(in + (size_t)r * DM + 4 * lane + 256 * j); ss += (v[j][0] * v[j][0] + v[j][1] * v[j][1]) + (v[j][2] * v[j][2] + v[j][3] * v[j][3]); }
#pragma unroll
        for (int o = 32; o; o >>= 1) ss += shx(ss, o, lane);
        const float sc = rsqrtf(ss * (1.f / 1024.f) + 1e-5f);
#pragma unroll
        for (int j = 0; j < 4; ++j) { const f32x4 gg = *(const f32x4*)(g + 4 * lane + 256 * j); u32x2 o2; o2.x = cvt_pk_bf16(v[j][0] * sc * gg[0], v[j][1] * sc * gg[1]); o2.y = cvt_pk_bf16(v[j][2] * sc * gg[2], v[j][3] * sc * gg[3]);
            *(u32x2*)(out16 + (size_t)r * DM + 4 * lane + 256 * j) = o2; }
    }
}
template <bool MOE, bool LAST> __device__ __forceinline__ void p_rowfinish(const int wv, const float* hin, float* h, const bf16_t* mout, const int* eslot, const float* topg, const float* g, bf16_t* xn16, float* out) {
    LTID();
    const int lane = tidx & 63;
    LAS const int* ts = (LAS const int*)(LDSP + TS_OFF);
    for (int r = bidx * NW + wv; r < SEQ; r += gridDim.x * NW) {
        f32x4 v[4];
#pragma unroll
        for (int j = 0; j < 4; ++j) v[j] = *(const f32x4*)(hin + (size_t)r * DM + 4 * lane + 256 * j);
        if (MOE) {
            const int4 es = *(const int4*)(eslot + r * 4); const f32x4 gt = *(const f32x4*)(topg + r * 4);
            const int esv[4] = {es.x, es.y, es.z, es.w};
#pragma unroll
            for (int k = 0; k < 4; ++k) {
                const int e = esv[k] >> 16, sl = esv[k] & 0xffff; const size_t row = (size_t)ts[e] * BM + sl; const float gk = gt[k];
#pragma unroll
                for (int j = 0; j < 4; ++j) { const u32x2 o = *(const u32x2*)(mout + row * DM + 4 * lane + 256 * j);
                    v[j][0] += gk * __builtin_bit_cast(float, o.x << 16); v[j][1] += gk * __builtin_bit_cast(float, o.x & 0xffff0000u);
                    v[j][2] += gk * __builtin_bit_cast(float, o.y << 16); v[j][3] += gk * __builtin_bit_cast(float, o.y & 0xffff0000u); }
            }
        }
        float ss = 0.f;
#pragma unroll
        for (int j = 0; j < 4; ++j) ss += (v[j][0] * v[j][0] + v[j][1] * v[j][1]) + (v[j][2] * v[j][2] + v[j][3] * v[j][3]);
#pragma unroll
        for (int o = 32; o; o >>= 1) ss += shx(ss, o, lane);
        const float sc = rsqrtf(ss * (1.f / 1024.f) + 1e-5f);
#pragma unroll
        for (int j = 0; j < 4; ++j) {
            const f32x4 gg = *(const f32x4*)(g + 4 * lane + 256 * j);
            if (!LAST) { *(f32x4*)(h + (size_t)r * DM + 4 * lane + 256 * j) = v[j];
                u32x2 o2; o2.x = cvt_pk_bf16(v[j][0] * sc * gg[0], v[j][1] * sc * gg[1]); o2.y = cvt_pk_bf16(v[j][2] * sc * gg[2], v[j][3] * sc * gg[3]);
                *(u32x2*)(xn16 + (size_t)r * DM + 4 * lane + 256 * j) = o2; }
            else *(f32x4*)(out + (size_t)r * DM + 4 * lane + 256 * j) = (f32x4){v[j][0] * sc * gg[0], v[j][1] * sc * gg[1], v[j][2] * sc * gg[2], v[j][3] * sc * gg[3]};
        }
    }
}
__device__ __forceinline__ void p_router_tables(const int wv, const float* w_r, const float* g, bf16_t* WR16) {
    LTID();
    for (int i = bidx * NT + tidx; i < 32 * 1024; i += gridDim.x * NT) {
        const int e = i >> 10, k = i & 1023;
        const float w = g[k] * w_r[k * 32 + e];
        const unsigned hi = f2bf(w); const float lo = w - __builtin_bit_cast(float, hi << 16);
        WR16[i] = (bf16_t)hi; WR16[32 * 1024 + i] = (bf16_t)f2bf(lo);
    }
}
constexpr int RT_CNT_OFF = 131072 + 4608;
constexpr int RT_XCH_OFF = 131072 + 5120;
__device__ __forceinline__ void p_router2(const int wv, const float* h, const bf16_t* WR16, const float* b_r, bf16_t* hb16, unsigned* gcnt, int* rowtok_e, float* rsc_e, int* eslot, float* topg, LAS unsigned char* lds) {
    LTID();
    const int lane = tidx & 63, fr = lane & 15, fq = lane >> 4, w = wv, tg = w & 3, kh = w >> 2;
#pragma unroll
    for (int part = 0; part < 2; ++part)
#pragma unroll
        for (int p = 0; p < 8; ++p) { const int row = 4 * p + (tidx >> 7), cs = tidx & 127;
            glds16s(WR16, (unsigned)(part * 65536 + row * 2048 + ((cs ^ (row & 15)) * 16)), (unsigned)(size_t)(lds + part * 65536 + p * 8192 + w * 1024)); }
    LAS int* lcnt = (LAS int*)(lds + RT_CNT_OFF);
    if (tidx < 64) lcnt[tidx] = 0;
    asm volatile("s_waitcnt vmcnt(0)" ::: "memory");
    __syncthreads();
    for (int it = bidx; it < SEQ / 64; it += gridDim.x) {
        const int token = it * 64 + 16 * tg + fr;
        const float* xr = h + (size_t)token * DM + 512 * kh + 8 * fq;
        bf16_t* hb = hb16 + (size_t)token * DM + 512 * kh + 8 * fq;
        f32x4 acc[2]; acc[0] = (f32x4){0.f, 0.f, 0.f, 0.f}; acc[1] = acc[0];
        float ss = 0.f;
#pragma unroll 4
        for (int s4 = 0; s4 < 16; ++s4) {
            const f32x4 x0 = *(const f32x4*)(xr + 32 * s4), x1 = *(const f32x4*)(xr + 32 * s4 + 4);
            ss += (x0[0] * x0[0] + x0[1] * x0[1]) + (x0[2] * x0[2] + x0[3] * x0[3]) + (x1[0] * x1[0] + x1[1] * x1[1]) + (x1[2] * x1[2] + x1[3] * x1[3]);
            u32x4 hw; hw.x = cvt_pk_bf16(x0[0], x0[1]); hw.y = cvt_pk_bf16(x0[2], x0[3]); hw.z = cvt_pk_bf16(x1[0], x1[1]); hw.w = cvt_pk_bf16(x1[2], x1[3]);
            *(u32x4*)(hb + 32 * s4) = hw;
            u32x4 lw;
            lw.x = cvt_pk_bf16(x0[0] - __builtin_bit_cast(float, hw.x << 16), x0[1] - __builtin_bit_cast(float, hw.x & 0xffff0000u));
            lw.y = cvt_pk_bf16(x0[2] - __builtin_bit_cast(float, hw.y << 16), x0[3] - __builtin_bit_cast(float, hw.y & 0xffff0000u));
            lw.z = cvt_pk_bf16(x1[0] - __builtin_bit_cast(float, hw.z << 16), x1[1] - __builtin_bit_cast(float, hw.z & 0xffff0000u));
            lw.w = cvt_pk_bf16(x1[2] - __builtin_bit_cast(float, hw.w << 16), x1[3] - __builtin_bit_cast(float, hw.w & 0xffff0000u));
            const bf16x8 xhi = __builtin_bit_cast(bf16x8, hw), xlo = __builtin_bit_cast(bf16x8, lw);
            const int c = 64 * kh + 4 * s4 + fq, slot = c ^ fr;
#pragma unroll
            for (int nb = 0; nb < 2; ++nb) {
                const bf16x8 whi = *(const LAS bf16x8*)(lds + (16 * nb + fr) * 2048 + slot * 16), wlo = *(const LAS bf16x8*)(lds + 65536 + (16 * nb + fr) * 2048 + slot * 16);
                acc[nb] = __builtin_amdgcn_mfma_f32_16x16x32_bf16(whi, xhi, acc[nb], 0, 0, 0);
                acc[nb] = __builtin_amdgcn_mfma_f32_16x16x32_bf16(whi, xlo, acc[nb], 0, 0, 0);
                acc[nb] = __builtin_amdgcn_mfma_f32_16x16x32_bf16(wlo, xhi, acc[nb], 0, 0, 0);
            }
        }
        ss += shx(ss, 16, lane); ss += shx(ss, 32, lane);
        LAS float* X = (LAS float*)(lds + RT_XCH_OFF) + (tg * 64 + lane) * 9;
        if (kh == 1) {
#pragma unroll
            for (int nb = 0; nb < 2; ++nb)
#pragma unroll
                for (int j = 0; j < 4; ++j) X[nb * 4 + j] = acc[nb][j];
            X[8] = ss;
        }
        __syncthreads();
        int ti[4] = {0, 0, 0, 0}, ls[4] = {0, 0, 0, 0}; float gv[4] = {0.f, 0.f, 0.f, 0.f}; float rs = 0.f;
        if (kh == 0) {
            float lv[8];
            ss += X[8];
            rs = rsqrtf(ss * (1.f / 1024.f) + 1e-5f);
#pragma unroll
            for (int nb = 0; nb < 2; ++nb)
#pragma unroll
                for (int j = 0; j < 4; ++j) lv[nb * 4 + j] = rs * (acc[nb][j] + X[nb * 4 + j]) + b_r[16 * nb + 4 * fq + j];
            float tv[4];
#pragma unroll
            for (int r = 0; r < 4; ++r) {
                float bv = -3.0e38f; int bi = 0;
#pragma unroll
                for (int q = 0; q < 8; ++q) { const int idx = 16 * (q >> 2) + 4 * fq + (q & 3); if (lv[q] > bv) { bv = lv[q]; bi = idx; } }
#pragma unroll
                for (int mk = 16; mk <= 32; mk <<= 1) { const float ov = shx(bv, mk, lane); const int oi = shxi(bi, mk, lane); if (ov > bv || (ov == bv && oi < bi)) { bv = ov; bi = oi; } }
                tv[r] = bv; ti[r] = bi;
#pragma unroll
                for (int q = 0; q < 8; ++q) { const int idx = 16 * (q >> 2) + 4 * fq + (q & 3); if (idx == bi) lv[q] = -3.0e38f; }
            }
            float sum = 0.f;
#pragma unroll
            for (int r = 0; r < 4; ++r) { gv[r] = __expf(tv[r] - tv[0]); sum += gv[r]; }
            const float inv = 1.f / sum;
#pragma unroll
            for (int r = 0; r < 4; ++r) gv[r] *= inv;
            if (fq == 0) {
#pragma unroll
                for (int r = 0; r < 4; ++r) ls[r] = __hip_atomic_fetch_add(&lcnt[ti[r]], 1, __ATOMIC_RELAXED, __HIP_MEMORY_SCOPE_WORKGROUP);
            }
        }
        __syncthreads();
        if (tidx < 32) { const int c = lcnt[tidx]; lcnt[32 + tidx] = c ? (int)__hip_atomic_fetch_add(gcnt + tidx, (unsigned)c, __ATOMIC_RELAXED, __HIP_MEMORY_SCOPE_AGENT) : 0; }
        __syncthreads();
        if (kh == 0 && fq == 0) {
            int es[4];
#pragma unroll
            for (int r = 0; r < 4; ++r) { const int e = ti[r], sl = lcnt[32 + e] + ls[r]; rowtok_e[e * ECAP + sl] = token; rsc_e[e * ECAP + sl] = rs; es[r] = (e << 16) | sl; }
            *(int4*)(eslot + token * 4) = make_int4(es[0], es[1], es[2], es[3]);
            *(f32x4*)(topg + token * 4) = (f32x4){gv[0], gv[1], gv[2], gv[3]};
        }
        __syncthreads();
        if (tidx < 32) lcnt[tidx] = 0;
    }
    __syncthreads();
}

constexpr int NPL = 13;
constexpr int NPHASES = 1 + 2 * NPL;
typedef const __attribute__((address_space(4))) Args* KA;
#define PHASE __device__ __forceinline__
#define KAP() ({ KA _t = a; asm volatile("" : "+s"(_t)); _t; })
#define WSP(T, off) ((T*)(a->ws + (off)))

PHASE void ph_init(KA a, const int wv) {
    p_rowfinish<false, false>(wv, a->in[0], WSP(float, WS_H), nullptr, nullptr, nullptr, a->in[3], WSP(bf16_t, WS_XN16), nullptr);
    p_bias_table(wv, a->in[2], WSP(float, WS_BIASG));
    for (int l = 0; l < 2; ++l) {
        p_s5_tables2(wv, a->in[5] + l * 2048, a->in[6] + l * 2048, a->in[7] + l * 32768, a->in[8] + l * 32768, a->in[9] + l * 32768, a->in[10] + l * 32768, a->in[11] + l * 32,
                     WSP(float2, WS_ABAR) + l * 2048, WSP(float2, WS_A256) + l * 2048, WSP(bf16_t, WS_BB16) + (size_t)l * 32 * 128 * 16, WSP(bf16_t, WS_CM16) + (size_t)l * 32 * 16 * 128);
        p_rmsnorm16(wv, a->in[1], a->in[19] + l * DM, WSP(bf16_t, WS_MEMN16) + (size_t)l * NMEM * DM, NMEM);
        p_router_tables(wv, a->in[24] + (size_t)l * DM * 32, a->in[23] + l * DM, WSP(bf16_t, WS_WR16) + (size_t)l * 2 * 32 * 1024);
    }
    p_transpose(wv, a->in[4], 2, DM, DIN, WSP(bf16_t, WS_WT_IN), nullptr, 1, 0, LDSP);
    p_transpose(wv, a->in[13], 2, 512, 512, WSP(bf16_t, WS_WT_GLU), nullptr, 1, 0, LDSP);
    p_transpose(wv, a->in[17], 2, DM, DM, WSP(bf16_t, WS_WT_OUT), nullptr, 1, 0, LDSP);
    p_transpose(wv, a->in[20], 2, DM, 512, WSP(bf16_t, WS_WT_XQ), a->in[18], 1, 0, LDSP);
    p_transpose(wv, a->in[21], 2, DM, 1024, WSP(bf16_t, WS_WT_XKV), nullptr, 1, 0, LDSP);
    p_transpose(wv, a->in[22], 2, 512, DM, WSP(bf16_t, WS_WT_XO), nullptr, 1, 0, LDSP);
    p_transpose(wv, a->in[26], 2 * NEXP, DM, 2048, WSP(bf16_t, WS_BT1), a->in[23], NEXP, 1, LDSP);
    p_transpose(wv, a->in[28], 2 * NEXP, DFF, DM, WSP(bf16_t, WS_BT2), nullptr, 1, 0, LDSP);
    __syncthreads();
}
PHASE void ph_gemm_in(KA a, const int wv, int l) { LTID();
    DenseOrder S; S.init(WSP(bf16_t, WS_XN16), WSP(bf16_t, WS_WT_IN) + (size_t)l * DIN * DM, SEQ, DIN, DM, gridDim.x, bidx);
    EpiIn E{WSP(bf16_t, WS_PROJ16)};
    gemm_phase<EpiIn, DenseOrder, false, false>(LDSP, DM, S, E, tidx, wv);
}
PHASE void ph_attn_s5a(KA a, const int wv, int l) {
    p_dil_attn(wv, WSP(bf16_t, WS_PROJ16), WSP(float, WS_BIASG), WSP(bf16_t, WS_OBR), WSP(float, WS_LSE), LDSP);
    p_s5_pass<0>(wv, WSP(bf16_t, WS_PROJ16), WSP(float2, WS_ABAR) + l * 2048, WSP(float2, WS_A256) + l * 2048, WSP(bf16_t, WS_BB16) + (size_t)l * 32 * 128 * 16, WSP(bf16_t, WS_CM16) + (size_t)l * 32 * 16 * 128,
                 a->in[12] + l * 512, WSP(float2, WS_E2), WSP(bf16_t, WS_YG16), LDSP);
}
PHASE void ph_s5b(KA a, const int wv, int l) {
    p_s5_pass<1>(wv, WSP(bf16_t, WS_PROJ16), WSP(float2, WS_ABAR) + l * 2048, WSP(float2, WS_A256) + l * 2048, WSP(bf16_t, WS_BB16) + (size_t)l * 32 * 128 * 16, WSP(bf16_t, WS_CM16) + (size_t)l * 32 * 16 * 128,
                 a->in[12] + l * 512, WSP(float2, WS_E2), WSP(bf16_t, WS_YG16), LDSP);
}
PHASE void ph_gemm_glu(KA a, const int wv, int l) {
    {   LTID();
        DenseOrder S; S.init(WSP(bf16_t, WS_YG16), WSP(bf16_t, WS_WT_GLU) + (size_t)l * 512 * 512, SEQ, 512, 512, gridDim.x, bidx);
        EpiGlu16 E{WSP(bf16_t, WS_YB16), WSP(bf16_t, WS_YG16), a->in[14] + l * 512};
        gemm_phase<EpiGlu16, DenseOrder, false, false>(LDSP, 512, S, E, tidx, wv); }
    {   LTID();
    const int cc = (int)gridDim.x - 1 - bidx;
    if (l == 0 && cc < 8) {
        const int kl = cc >> 2;
        DenseOrder S; S.init(WSP(bf16_t, WS_MEMN16) + (size_t)kl * NMEM * DM, WSP(bf16_t, WS_WT_XKV) + (size_t)kl * 1024 * DM, NMEM, 1024, DM, 4, cc & 3);
        EpiBf16 E{WSP(bf16_t, WS_KV16) + (size_t)kl * NMEM * 1024, 1024, 1.f, nullptr};
        gemm_phase<EpiBf16, DenseOrder, false, false>(LDSP, DM, S, E, tidx, wv);
    } }
}
PHASE void ph_mixnorm(KA a, const int wv, int l) {
    p_attn_combine(wv, WSP(bf16_t, WS_OBR), WSP(float, WS_LSE), a->in[15] + l * 512, WSP(bf16_t, WS_MIX16));
    p_ssm_norm(wv, WSP(bf16_t, WS_YB16), a->in[16] + l * 512, WSP(bf16_t, WS_MIX16));
}
PHASE void ph_gemm_out(KA a, const int wv, int l) { LTID();
    DenseOrder S; S.init(WSP(bf16_t, WS_MIX16), WSP(bf16_t, WS_WT_OUT) + (size_t)l * DM * DM, SEQ, DM, DM, gridDim.x, bidx);
    EpiOut E{WSP(float, WS_H), WSP(bf16_t, WS_HB16), WSP(float, WS_SSP)};
    gemm_phase<EpiOut, DenseOrder, false, false>(LDSP, DM, S, E, tidx, wv);
}
PHASE void ph_gemm_xq(KA a, const int wv, int l) { LTID();
    DenseOrder S; S.init(WSP(bf16_t, WS_HB16), WSP(bf16_t, WS_WT_XQ) + (size_t)l * 512 * DM, SEQ, 512, DM, gridDim.x, bidx);
    EpiBf16 E{WSP(bf16_t, WS_QX16), 512, 0.08838834764831845f, WSP(float, WS_SSP)};
    gemm_phase<EpiBf16, DenseOrder, false, false>(LDSP, DM, S, E, tidx, wv);
}
PHASE void ph_xattn(KA a, const int wv, int l) { p_xattn_mfma(wv, WSP(bf16_t, WS_QX16), WSP(bf16_t, WS_KV16) + (size_t)l * NMEM * 1024, WSP(bf16_t, WS_OX16), LDSP); }
PHASE void ph_gemm_xo(KA a, const int wv, int l) { LTID();
    DenseOrder S; S.init(WSP(bf16_t, WS_OX16), WSP(bf16_t, WS_WT_XO) + (size_t)l * DM * 512, SEQ, DM, 512, gridDim.x, bidx);
    EpiF32 E{WSP(float, WS_H), DM, 1};
    gemm_phase<EpiF32, DenseOrder, false, false>(LDSP, 512, S, E, tidx, wv);
}
PHASE void ph_router(KA a, const int wv, int l) {
    p_router2(wv, WSP(float, WS_H), WSP(bf16_t, WS_WR16) + (size_t)l * 2 * 32 * 1024, a->in[25] + l * 32, WSP(bf16_t, WS_HB16), WSP(unsigned, WS_CTL) + CW_CNT + l * 32,
              WSP(int, WS_ROWTOK), WSP(float, WS_RSC), WSP(int, WS_ESLOT), WSP(float, WS_TOPG), LDSP);
}
PHASE void ph_moe1(KA a, const int wv, int l) { LTID();
    moe_tiles(WSP(unsigned, WS_CTL) + CW_CNT + l * 32, tidx);
    MoeOrder<true> S; S.init(WSP(bf16_t, WS_HB16), WSP(bf16_t, WS_BT1) + (size_t)l * NEXP * 2048 * DM, WSP(int, WS_ROWTOK), 2048, DM, (size_t)2048 * DM * 2, gridDim.x, bidx);
    EpiMoe1 E{WSP(bf16_t, WS_ACT), a->in[27] + (size_t)l * NEXP * 2048, WSP(float, WS_RSC)};
    gemm_phase<EpiMoe1, MoeOrder<true>, true, false>(LDSP, DM, S, E, tidx, wv);
}
PHASE void ph_moe2(KA a, const int wv, int l) { LTID();
    moe_tiles(WSP(unsigned, WS_CTL) + CW_CNT + l * 32, tidx);
    MoeOrder<false> S; S.init(WSP(bf16_t, WS_ACT), WSP(bf16_t, WS_BT2) + (size_t)l * NEXP * DM * DFF, nullptr, DM, DFF, (size_t)DM * DFF * 2, gridDim.x, bidx);
    EpiMoe2 E{WSP(bf16_t, WS_MOUT), a->in[29] + (size_t)l * NEXP * DM};
    gemm_phase<EpiMoe2, MoeOrder<false>, false, false>(LDSP, DFF, S, E, tidx, wv);
}
PHASE void ph_combine(KA a, const int wv, int l) { LTID();
    moe_tiles(WSP(unsigned, WS_CTL) + CW_CNT + l * 32, tidx);
    if (l == 0) p_rowfinish<true, false>(wv, WSP(float, WS_H), WSP(float, WS_H), WSP(bf16_t, WS_MOUT), WSP(int, WS_ESLOT), WSP(float, WS_TOPG), a->in[3] + DM, WSP(bf16_t, WS_XN16), nullptr);
    else p_rowfinish<true, true>(wv, WSP(float, WS_H), nullptr, WSP(bf16_t, WS_MOUT), WSP(int, WS_ESLOT), WSP(float, WS_TOPG), a->in[30], nullptr, a->out);
}

__global__ void __launch_bounds__(NT, 2) mega(Args args) {
    KA a = (KA)__builtin_amdgcn_kernarg_segment_ptr();
    int wv = __builtin_amdgcn_readfirstlane((int)threadIdx.x >> 6); asm volatile("" : "+s"(wv));
    LAS unsigned char* lds = LDSP;
    volatile LAS unsigned* MISC = (volatile LAS unsigned*)(lds + MISC_OFF);
    unsigned* ctl = (unsigned*)(a->ws + WS_CTL);
    if (threadIdx.x < 32) MISC[threadIdx.x] = 0u;
    __syncthreads();
    XcdBarrier bar; bar.bar = ctl + CW_BAR; bar.x = 0; bar.st = nullptr;
    if (!MK_PER_PHASE) bar = xcd_barrier_post(ctl + CW_BAR, MISC + 8);
    const int lo = a->ph_lo, hi = a->ph_hi;
#define IN(k) (lo <= (k) && (k) < hi)
#define SEAM(k) do { if (IN(k) && IN((k) + 1)) { LTID(); xcd_barrier(bar.bar, bar.x, bar.st, tidx == 0); } } while (0)
    if (IN(0)) { ph_init(KAP(), wv); if (PROBE_DUP == 100) ph_init(KAP(), wv); }
    SEAM(0);
#pragma unroll 1
    for (int l = 0; l < 2; ++l) {
        const int pb = 1 + l * NPL;
        if (IN(pb + 0)) { ph_gemm_in(KAP(), wv, l); if (PROBE_DUP == 0) { ph_gemm_in(KAP(), wv, l); } }
        SEAM(pb + 0);
        if (IN(pb + 1)) { ph_attn_s5a(KAP(), wv, l); if (PROBE_DUP == 1) { ph_attn_s5a(KAP(), wv, l); } }
        SEAM(pb + 1);
        if (IN(pb + 2)) { ph_s5b(KAP(), wv, l); if (PROBE_DUP == 2) { ph_s5b(KAP(), wv, l); } }
        SEAM(pb + 2);
        if (IN(pb + 3)) { ph_gemm_glu(KAP(), wv, l); if (PROBE_DUP == 3) { ph_gemm_glu(KAP(), wv, l); } }
        SEAM(pb + 3);
        if (IN(pb + 4)) { ph_mixnorm(KAP(), wv, l); if (PROBE_DUP == 4) { ph_mixnorm(KAP(), wv, l); } }
        SEAM(pb + 4);
        if (IN(pb + 5)) { ph_gemm_out(KAP(), wv, l); if (PROBE_DUP == 5) { ph_gemm_out(KAP(), wv, l); } }
        SEAM(pb + 5);
        if (IN(pb + 6)) { ph_gemm_xq(KAP(), wv, l); if (PROBE_DUP == 6) { ph_gemm_xq(KAP(), wv, l); } }
        SEAM(pb + 6);
        if (IN(pb + 7)) { ph_xattn(KAP(), wv, l); if (PROBE_DUP == 7) { ph_xattn(KAP(), wv, l); } }
        SEAM(pb + 7);
        if (IN(pb + 8)) { ph_gemm_xo(KAP(), wv, l); if (PROBE_DUP == 8) { ph_gemm_xo(KAP(), wv, l); } }
        SEAM(pb + 8);
        if (IN(pb + 9)) { ph_router(KAP(), wv, l); if (PROBE_DUP == 9) { ph_router(KAP(), wv, l); } }
        SEAM(pb + 9);
        if (IN(pb + 10)) { ph_moe1(KAP(), wv, l); if (PROBE_DUP == 10) { ph_moe1(KAP(), wv, l); } }
        SEAM(pb + 10);
        if (IN(pb + 11)) { ph_moe2(KAP(), wv, l); if (PROBE_DUP == 11) { ph_moe2(KAP(), wv, l); } }
        SEAM(pb + 11);
        if (IN(pb + 12)) { ph_combine(KAP(), wv, l); if (PROBE_DUP == 12) { ph_combine(KAP(), wv, l); } }
        SEAM(pb + 12);
    }
#undef IN
#undef SEAM
}

extern "C" void kernel_launch(void* const* d_in, const int* in_sizes, int n_in, void* d_out, int out_size, void* d_ws, size_t ws_size, hipStream_t stream) {
    static int grid = 0;
    if (grid == 0) {
        if (n_in != 31 || ws_size < WS_END) { fprintf(stderr, "kernel_launch: unexpected n_in %d or ws_size %zu (need %zu)\n", n_in, ws_size, (size_t)WS_END); grid = -1; return; }
        int dev = 0, cus = 0, per_cu = 0;
        if (hipGetDevice(&dev) != hipSuccess || hipDeviceGetAttribute(&cus, hipDeviceAttributeMultiprocessorCount, dev) != hipSuccess) { grid = -1; return; }
        if (hipFuncSetAttribute((const void*)mega, hipFuncAttributeMaxDynamicSharedMemorySize, LDS_BYTES) != hipSuccess) { fprintf(stderr, "kernel_launch: hipFuncSetAttribute failed\n"); grid = -1; return; }
        if (hipOccupancyMaxActiveBlocksPerMultiprocessor(&per_cu, (const void*)mega, NT, LDS_BYTES) != hipSuccess || per_cu < 1)
            fprintf(stderr, "kernel_launch: occupancy query reports %d workgroups per CU\n", per_cu);
        (void)hipGetLastError();
        grid = cus;
    }
    if (grid < 0) return;
    if (hipMemsetAsync((char*)d_ws + WS_CTL, 0, CTL_ZERO_BYTES, stream) != hipSuccess) return;
    Args a{};
    for (int i = 0; i < 31; ++i) a.in[i] = (const float*)d_in[i];
    a.out = (float*)d_out; a.ws = (unsigned char*)d_ws;
#if MK_PER_PHASE
    for (int p = 0; p < NPHASES; ++p) { a.ph_lo = p; a.ph_hi = p + 1; hipLaunchKernelGGL(mega, dim3(grid), dim3(NT), LDS_BYTES, stream, a); }
#else
    a.ph_lo = 0; a.ph_hi = NPHASES;
    hipLaunchKernelGGL(mega, dim3(grid), dim3(NT), LDS_BYTES, stream, a);
#endif
}
```

```cpp
#include <hip/hip_runtime.h>
#include <stdint.h>
#include <cstdio>

#ifndef PROBE_DUP
#define PROBE_DUP -1
#endif
#ifndef MK_PER_PHASE
#define MK_PER_PHASE 0
#endif

#define SEQ 16384
#define DM 1024
#define DIN 2048
#define NMEM 256
#define NEXP 32
#define TOPK 4
#define DFF 1024
#define NT 512
#define NW 8

#define LAS __attribute__((address_space(3)))
typedef float f32x4 __attribute__((ext_vector_type(4)));
extern __shared__ __attribute__((aligned(16))) unsigned char lds_raw[];
#define LDSP ((LAS unsigned char*)lds_raw)
#define LTID() int z_ = 0; asm volatile("" : "+v"(z_)); const int lane_ = (int)__builtin_amdgcn_mbcnt_hi(~0u, __builtin_amdgcn_mbcnt_lo(~0u, (unsigned)z_)); \
    const int tidx = wv * 64 + lane_; int bidx = blockIdx.x; asm volatile("" : "+s"(bidx))
__device__ __forceinline__ float shx(float v, int mask, int lane) { return __builtin_bit_cast(float, __builtin_amdgcn_ds_bpermute((lane ^ mask) << 2, __builtin_bit_cast(int, v))); }
__device__ __forceinline__ int shxi(int v, int mask, int lane) { return __builtin_amdgcn_ds_bpermute((lane ^ mask) << 2, v); }
constexpr int LDS_BYTES = 147456;
constexpr int MISC_OFF = 131072 + 320;

#define XB_TMO      128
#define XB_XCNT(j)  (256  + 64 * (j))
#define XB_XSUB(j)  (1280 + 64 * (j))
#define XB_XGEN(j)  (2304 + 64 * (j))
#define XB_TOP      3328
#define XB_TOPGEN   3392
#define XCD_BAR_WORDS 3456
#define XB_SPIN_CAP (1u << 18)

__device__ __forceinline__ unsigned xb_ld(unsigned* p)              { return __hip_atomic_load(p, __ATOMIC_RELAXED, __HIP_MEMORY_SCOPE_AGENT); }
__device__ __forceinline__ unsigned xb_add(unsigned* p, unsigned v) { return __hip_atomic_fetch_add(p, v, __ATOMIC_RELAXED, __HIP_MEMORY_SCOPE_AGENT); }
__device__ __forceinline__ unsigned xb_xcc_id() { return (unsigned)__builtin_amdgcn_s_getreg((3 << 11) | 20) & 0xFu; }
#define XB_SPIN(cond, bar) do { unsigned _sp = 0; while (cond) { __builtin_amdgcn_s_sleep(1); \
    if ((++_sp & 255u) == 0u) { if (xb_ld(&(bar)[XB_TMO])) break; if (_sp > XB_SPIN_CAP) { atomicAdd(&(bar)[XB_TMO], 1u); break; } } } } while (0)

struct XcdBarrier {
    unsigned* bar; unsigned x;
    volatile LAS unsigned* st;
};
__device__ __forceinline__ XcdBarrier xcd_barrier_post(unsigned* bar, volatile LAS unsigned* st) {
    XcdBarrier b; b.bar = bar; b.x = xb_xcc_id(); b.st = st;
    if (threadIdx.x == 0) (void)xb_add(&bar[XB_XCNT(b.x)], 1u);
    return b;
}
__device__ __forceinline__ void xcd_barrier_complete(unsigned* bar, unsigned x, unsigned& nloc, unsigned& nx) {
    const unsigned G = gridDim.x * gridDim.y * gridDim.z;
    unsigned sum, cnt, mine, sp = 0u;
    for (;;) {
        sum = 0u; cnt = 0u; mine = 0u;
#pragma unroll
        for (unsigned j = 0; j < 16; ++j) { const unsigned c = xb_ld(&bar[XB_XCNT(j)]); sum += c; cnt += (c > 0u) ? 1u : 0u; mine = (j == x) ? c : mine; }
        if (sum == G) break;
        __builtin_amdgcn_s_sleep(1);
        if ((++sp & 255u) == 0u) { if (xb_ld(&bar[XB_TMO])) break; if (sp > XB_SPIN_CAP) { atomicAdd(&bar[XB_TMO], 1u); break; } }
    }
    nloc = mine > 0u ? mine : 1u; nx = cnt > 0u ? cnt : 1u;
}
__device__ __noinline__ void xcd_barrier(unsigned* bar_, unsigned x_, volatile LAS unsigned* st_, int is_t0) {
    XcdBarrier b; b.bar = bar_; b.x = x_; b.st = st_;
    asm volatile("s_waitcnt vmcnt(0)" ::: "memory");
    __syncthreads();
    if (is_t0) {
        unsigned* bar = b.bar;
        __builtin_amdgcn_s_waitcnt(0);
        unsigned nloc = b.st[0], nx = b.st[1];
        if (nloc == 0u) { xcd_barrier_complete(bar, b.x, nloc, nx); b.st[0] = nloc; b.st[1] = nx; }
        const unsigned old = xb_add(&bar[XB_XSUB(b.x)], 1u);
        const unsigned gen = old / nloc;
        if (old + 1u == (gen + 1u) * nloc) {
            __builtin_amdgcn_fence(__ATOMIC_RELEASE, "agent");
            asm volatile("s_waitcnt vmcnt(0)" ::: "memory");
            const unsigned og = xb_add(&bar[XB_TOP], 1u);
            const unsigned tg = og / nx;
            if (og + 1u == (tg + 1u) * nx) xb_add(&bar[XB_TOPGEN], 1u);
            else XB_SPIN(xb_ld(&bar[XB_TOPGEN]) == tg, bar);
            __builtin_amdgcn_fence(__ATOMIC_ACQUIRE, "agent");
            xb_add(&bar[XB_XGEN(b.x)], 1u);
            asm volatile("s_waitcnt vmcnt(0)" ::: "memory");
        } else {
            XB_SPIN(xb_ld(&bar[XB_XGEN(b.x)]) == gen, bar);
            __builtin_amdgcn_fence(__ATOMIC_ACQUIRE, "agent");
            asm volatile("s_waitcnt vmcnt(0)" ::: "memory");
        }
    }
    __syncthreads();
}

constexpr size_t MiB = 1u << 20;
constexpr size_t WS_CTL = 0, CTL_ZERO_BYTES = 1 * MiB;
constexpr int CW_BAR = 4096;
constexpr int CW_CNT = 8192;
constexpr int MOE_ROWS = SEQ * TOPK + NEXP * 256;
constexpr int ECAP = SEQ;
constexpr size_t al256(size_t x) { return (x + 255) & ~(size_t)255; }
constexpr size_t WS_H = 2 * MiB;
constexpr size_t WS_XN16 = WS_H + (size_t)SEQ * DM * 4;
constexpr size_t WS_HB16 = WS_XN16 + (size_t)SEQ * DM * 2;
constexpr size_t WS_PROJ16 = WS_HB16 + (size_t)SEQ * DM * 2;
constexpr size_t WS_OBR = WS_PROJ16 + (size_t)SEQ * 2048 * 2;
constexpr size_t WS_LSE = WS_OBR + 3 * (size_t)SEQ * 512 * 2;
constexpr size_t WS_YG16 = WS_LSE + 3 * (size_t)SEQ * 8 * 4;
constexpr size_t WS_YB16 = WS_YG16 + (size_t)SEQ * 512 * 2;
constexpr size_t WS_MIX16 = WS_YB16 + (size_t)SEQ * 512 * 2;
constexpr size_t WS_QX16 = WS_MIX16 + (size_t)SEQ * DM * 2;
constexpr size_t WS_OX16 = WS_QX16 + (size_t)SEQ * 512 * 2;
constexpr size_t WS_ACT = WS_OX16 + (size_t)SEQ * 512 * 2;
constexpr size_t WS_MOUT = WS_ACT + (size_t)MOE_ROWS * DFF * 2;
constexpr size_t WS_BT1 = WS_MOUT + (size_t)MOE_ROWS * DM * 2;
constexpr size_t WS_BT2 = WS_BT1 + 2 * (size_t)NEXP * 2048 * DM * 2;
constexpr size_t WS_WT_IN = WS_BT2 + 2 * (size_t)NEXP * DM * DFF * 2;
constexpr size_t WS_WT_GLU = WS_WT_IN + 2 * (size_t)2048 * 1024 * 2;
constexpr size_t WS_WT_OUT = WS_WT_GLU + 2 * (size_t)512 * 512 * 2;
constexpr size_t WS_WT_XQ = WS_WT_OUT + 2 * (size_t)1024 * 1024 * 2;
constexpr size_t WS_WT_XKV = WS_WT_XQ + 2 * (size_t)512 * 1024 * 2;
constexpr size_t WS_WT_XO = WS_WT_XKV + 2 * (size_t)1024 * 1024 * 2;
constexpr size_t WS_MEMN16 = WS_WT_XO + 2 * (size_t)1024 * 512 * 2;
constexpr size_t WS_KV16 = WS_MEMN16 + 2 * (size_t)NMEM * 1024 * 2;
constexpr size_t WS_WR16 = WS_KV16 + 2 * (size_t)NMEM * 1024 * 2;
constexpr size_t WS_BIASG = WS_WR16 + 2 * 2 * (size_t)32 * 1024 * 2;
constexpr size_t WS_ABAR = al256(WS_BIASG + 24 * 132 * 4);
constexpr size_t WS_A256 = WS_ABAR + 2 * 2048 * 8;
constexpr size_t WS_BB16 = WS_A256 + 2 * 2048 * 8;
constexpr size_t WS_CM16 = WS_BB16 + 2 * (size_t)32 * 128 * 16 * 2;
constexpr size_t WS_E2 = WS_CM16 + 2 * (size_t)32 * 16 * 128 * 2;
constexpr size_t WS_ROWTOK = WS_E2 + (size_t)64 * 2048 * 8;
constexpr size_t WS_RSC = WS_ROWTOK + (size_t)NEXP * ECAP * 4;
constexpr size_t WS_ESLOT = WS_RSC + (size_t)NEXP * ECAP * 4;
constexpr size_t WS_TOPG = WS_ESLOT + (size_t)SEQ * 4 * 4;
constexpr size_t WS_SSP = WS_TOPG + (size_t)SEQ * 4 * 4;
constexpr size_t WS_END = WS_SSP + (size_t)SEQ * 16 * 4;

struct Args { const float* in[31]; float* out; unsigned char* ws; int ph_lo, ph_hi; };


typedef unsigned short bf16_t;
typedef short bf16x8 __attribute__((ext_vector_type(8)));
typedef unsigned u32x4 __attribute__((ext_vector_type(4)));
typedef unsigned u32x2 __attribute__((ext_vector_type(2)));
constexpr int BM = 256, BK = 64, HALF = 128, HTB = HALF * BK * 2, STAGE_BYTES = 8 * HTB, NXCD = 8, WGM = 8;
__host__ __device__ __forceinline__ int lds_byte(int r, int c) { const int st = (r >> 4) * 2 + (c >> 5), rr = r & 15, cc = c & 31, ob = rr * 64 + cc * 2; return st * 1024 + (ob ^ (((ob >> 9) & 1) << 5)); }
__host__ __device__ __forceinline__ void stage_rc(int b, int& R, int& C) { const int st = b / 1024, sb = b % 1024, swz = sb ^ (((sb >> 9) & 1) << 5); R = (st >> 1) * 16 + swz / 64; C = (st & 1) * 32 + (swz % 64) / 2; }
__host__ __device__ __forceinline__ int perm32(int rho) { const int n = rho >> 4, i = rho & 15; return 8 * (i >> 2) + 4 * n + (i & 3); }
__device__ __forceinline__ unsigned cvt_pk_bf16(float lo, float hi) { unsigned r; asm volatile("v_cvt_pk_bf16_f32 %0, %1, %2" : "=v"(r) : "v"(lo), "v"(hi)); return r; }
__device__ __forceinline__ unsigned f2bf(float f) { unsigned u = __builtin_bit_cast(unsigned, f); return (u + 0x7fffu + ((u >> 16) & 1u)) >> 16; }
__device__ __forceinline__ unsigned pk2(float lo, float hi) { return f2bf(lo) | (f2bf(hi) << 16); }
__device__ __forceinline__ float bf2f(unsigned short b) { return __builtin_bit_cast(float, ((unsigned)b) << 16); }

__device__ __forceinline__ void glds16s(const void* sbase, unsigned voff, unsigned lds_dst) {
    unsigned keep;
    asm volatile("s_mov_b32 %0, m0\n\ts_mov_b32 m0, %3\n\ts_nop 0\n\tglobal_load_lds_dwordx4 %1, %2\n\ts_mov_b32 m0, %0" : "=&s"(keep) : "v"(voff), "s"(sbase), "s"(lds_dst) : "memory");
}
struct GUnit { const char* A; const char* B; int pm, pn, e, row0, cnt; };

struct DenseOrder {
    const char* A; const char* Bt; int nM, nN, nwg, G, c, K;
    __device__ __forceinline__ void init(const bf16_t* A_, const bf16_t* Bt_, int M, int N, int K_, int G_, int c_) { A = (const char*)A_; Bt = (const char*)Bt_; nM = M / BM; nN = N / BM; nwg = nM * nN; G = G_; c = c_; K = K_; }
    __device__ __forceinline__ bool next(int i, GUnit& u) const {
        const long L = (long)i * G + c; if (L >= nwg) return false;
        int wgid = (int)L; { const int q = nwg / NXCD, r = nwg % NXCD, xcd = wgid % NXCD, off = wgid / NXCD; wgid = (xcd < r ? xcd * (q + 1) : r * (q + 1) + (xcd - r) * q) + off; }
        const int nig = WGM * nN, gid = wgid / nig, fm = gid * WGM, gsz = (nM - fm) < WGM ? (nM - fm) : WGM;
        u.pm = fm + ((wgid % nig) % gsz); u.pn = (wgid % nig) / gsz; u.e = 0; u.row0 = 0; u.cnt = 0;
        u.A = A + (size_t)u.pm * BM * K * 2; u.B = Bt + (size_t)u.pn * BM * K * 2; return true;
    }
    __device__ __forceinline__ unsigned aoff(const GUnit&, int row) const { return (unsigned)(row * K * 2); }
    __device__ __forceinline__ unsigned tokoff(const GUnit&, int) const { return 0u; }
    __device__ __forceinline__ const int* tokbase() const { return nullptr; }
};

struct EpiF32 {
    static constexpr bool PERM = false;
    float* C; int ldc; int resid;
    __device__ __forceinline__ void operator()(const f32x4 (&acc)[2][2][4][2], const GUnit& u, int wr, int wc, int fr, int fq) const {
        const int row0 = u.pm * BM + wr * 64 + fr, col0 = u.pn * BM + wc * 32 + 4 * fq;
#pragma unroll
        for (int ai = 0; ai < 2; ++ai)
#pragma unroll
            for (int m = 0; m < 4; ++m) { float* rowp = C + (size_t)(row0 + ai * HALF + m * 16) * ldc + col0;
#pragma unroll
                for (int bj = 0; bj < 2; ++bj)
#pragma unroll
                    for (int n = 0; n < 2; ++n) { f32x4 v = acc[ai][bj][m][n]; if (resid) v += *(const f32x4*)(rowp + bj * HALF + n * 16); *(f32x4*)(rowp + bj * HALF + n * 16) = v; } }
    }
};
struct EpiGlu {
    static constexpr bool PERM = false;
    float* C; const float* Y; int ldc; const float* bias;
    __device__ __forceinline__ void operator()(const f32x4 (&acc)[2][2][4][2], const GUnit& u, int wr, int wc, int fr, int fq) const {
        const int row0 = u.pm * BM + wr * 64 + fr, col0 = u.pn * BM + wc * 32 + 4 * fq;
#pragma unroll
        for (int ai = 0; ai < 2; ++ai)
#pragma unroll
            for (int m = 0; m < 4; ++m) { const size_t ro = (size_t)(row0 + ai * HALF + m * 16) * ldc + col0;
#pragma unroll
                for (int bj = 0; bj < 2; ++bj)
#pragma unroll
                    for (int n = 0; n < 2; ++n) { const f32x4 b = *(const f32x4*)(bias + col0 + bj * HALF + n * 16); const f32x4 y = *(const f32x4*)(Y + ro + bj * HALF + n * 16);
                        f32x4 v = acc[ai][bj][m][n] + b; f32x4 o;
#pragma unroll
                        for (int j = 0; j < 4; ++j) o[j] = y[j] / (1.f + __expf(-v[j]));
                        *(f32x4*)(C + ro + bj * HALF + n * 16) = o; } }
    }
};

template <class Epi, class Sched, bool GATHER, bool ALIGN_EPI>
__device__ __forceinline__ void gemm_phase(LAS unsigned char* lds, const int K, const Sched& S, const Epi& E, const int tid, const int wv) {
    const int wid = wv, lane = tid & 63, wr = wid >> 2, wc = wid & 3, fr = lane & 15, fq = lane >> 4;
    const int nt = K / BK;
    unsigned voffB[2];
#pragma unroll
    for (int i = 0; i < 2; ++i) { int R, C; stage_rc(tid * 16 + i * 8192, R, C); const int Rb = Epi::PERM ? ((R & ~31) + perm32(R & 31)) : R; voffB[i] = (unsigned)(Rb * K + C) * 2u; }
#define PG8_AOFFS(dst, u) do { int t2_ = tid; asm volatile("" : "+v"(t2_)); _Pragma("unroll") for (int i = 0; i < 2; ++i) { int R, C; stage_rc(t2_ * 16 + i * 8192, R, C); \
        _Pragma("unroll") for (int h = 0; h < 2; ++h) dst[h][i] = S.aoff(u, h * HALF + R) + (unsigned)C * 2u; } } while (0)
    const size_t kstep = (size_t)(BK * 2);
    const size_t hstep = (size_t)HALF * K * 2;
    const unsigned ldsw = (unsigned)wid * 1024u;
    const int aoff = lds_byte(wr * 64 + fr, fq * 8), boff = lds_byte(wc * 32 + fr, fq * 8);
#define PG8_SA(b, h) (((b) * 2 + (h)) * HTB)
#define PG8_SB(b, h) ((4 + (b) * 2 + (h)) * HTB)
#define PG8_STAGE(bufoff, gbase, v0, v1) do { const unsigned ld_ = (unsigned)(size_t)(lds + (bufoff) + ldsw); glds16s((gbase), (v0), ld_); glds16s((gbase), (v1), ld_ + 8192u); } while (0)
#define PG8_LDA(dst, b, h) do { _Pragma("unroll") for (int m = 0; m < 4; ++m) _Pragma("unroll") for (int k = 0; k < 2; ++k) dst[m][k] = *(const LAS bf16x8*)(lds + PG8_SA(b, h) + aoff + m * 2048 + k * 1024); } while (0)
#define PG8_LDB(dst, b, h) do { _Pragma("unroll") for (int n = 0; n < 2; ++n) _Pragma("unroll") for (int k = 0; k < 2; ++k) dst[n][k] = *(const LAS bf16x8*)(lds + PG8_SB(b, h) + boff + n * 2048 + k * 1024); } while (0)
#define PG8_MMA(ai, bj, At, Bt) do { __builtin_amdgcn_s_setprio(1); _Pragma("unroll") for (int m = 0; m < 4; ++m) _Pragma("unroll") for (int n = 0; n < 2; ++n) _Pragma("unroll") for (int k = 0; k < 2; ++k) \
        acc[ai][bj][m][n] = __builtin_amdgcn_mfma_f32_16x16x32_bf16(Bt[n][k], At[m][k], acc[ai][bj][m][n], 0, 0, 0); __builtin_amdgcn_s_setprio(0); } while (0)
#define PG8_WAIT_V(n) asm volatile("s_waitcnt vmcnt(" #n ")" ::: "memory")
#define PG8_WAIT_L(n) asm volatile("s_waitcnt lgkmcnt(" #n ")" ::: "memory")
#define PG8_BAR __builtin_amdgcn_s_barrier()
#define PG8_SCHED __builtin_amdgcn_sched_barrier(0)
    GUnit cur, nxt; int ui = 0;
    if (!S.next(0, cur)) return;
    f32x4 acc[2][2][4][2];
#pragma unroll
    for (int a = 0; a < 2; ++a)
#pragma unroll
        for (int b = 0; b < 2; ++b)
#pragma unroll
            for (int m = 0; m < 4; ++m)
#pragma unroll
                for (int n = 0; n < 2; ++n) acc[a][b][m][n] = (f32x4){0.f, 0.f, 0.f, 0.f};
    bf16x8 At[4][2], B0[2][2], B1[2][2];
    unsigned vA[2][2], vN[2][2];
    PG8_AOFFS(vA, cur);
#pragma unroll
    for (int h = 0; h < 2; ++h)
#pragma unroll
        for (int i = 0; i < 2; ++i) vN[h][i] = vA[h][i];
    const char* cA = cur.A; const char* cB = cur.B;
    PG8_STAGE(PG8_SB(0, 0), cB, voffB[0], voffB[1]); PG8_STAGE(PG8_SB(0, 1), cB + hstep, voffB[0], voffB[1]); PG8_STAGE(PG8_SA(0, 0), cA, vA[0][0], vA[0][1]); PG8_STAGE(PG8_SA(0, 1), cA, vA[1][0], vA[1][1]);
    if (wr == 1) PG8_BAR;
    PG8_WAIT_V(2); PG8_BAR;
    PG8_STAGE(PG8_SB(1, 0), cB + kstep, voffB[0], voffB[1]); PG8_STAGE(PG8_SA(1, 0), cA + kstep, vA[0][0], vA[0][1]); PG8_STAGE(PG8_SB(1, 1), cB + hstep + kstep, voffB[0], voffB[1]);
    PG8_WAIT_V(6); PG8_BAR;
    for (;;) {
        const bool has_next = S.next(ui + 1, nxt);
        const char* nA = GATHER ? cA : (has_next ? nxt.A : cA); const char* nB = has_next ? nxt.B : cB;
        unsigned tok_[2][2] = {{0u, 0u}, {0u, 0u}};
#define PG8_KBODY(a1, a2, b2, a3, b3, W00, W01, W10, W11) do { \
              \
            PG8_LDB(B0, 0, 0); PG8_LDB(B1, 0, 1); PG8_SCHED; PG8_LDA(At, 0, 0); PG8_STAGE(PG8_SA(1, 1), a1, vA[1][0], vA[1][1]); \
            PG8_WAIT_V(8); PG8_WAIT_L(0); PG8_BAR; PG8_MMA(0, 0, At, B0); PG8_MMA(0, 1, At, B1); PG8_BAR; PG8_SCHED; \
              \
            PG8_LDA(At, 0, 1); PG8_STAGE(PG8_SB(0, 0), b2, voffB[0], voffB[1]); PG8_STAGE(PG8_SB(0, 1), (b2) + hstep, voffB[0], voffB[1]); PG8_STAGE(PG8_SA(0, 0), a2, W00, W01); \
            PG8_WAIT_V(8); PG8_WAIT_L(0); PG8_BAR; PG8_MMA(1, 0, At, B0); PG8_MMA(1, 1, At, B1); PG8_BAR; PG8_SCHED; \
              \
            PG8_LDB(B0, 1, 0); PG8_LDB(B1, 1, 1); PG8_SCHED; PG8_LDA(At, 1, 0); PG8_STAGE(PG8_SA(0, 1), a2, W10, W11); \
            PG8_WAIT_V(8); PG8_WAIT_L(0); PG8_BAR; PG8_MMA(0, 0, At, B0); PG8_MMA(0, 1, At, B1); PG8_BAR; PG8_SCHED; \
              \
            PG8_LDA(At, 1, 1); PG8_STAGE(PG8_SB(1, 0), b3, voffB[0], voffB[1]); PG8_STAGE(PG8_SB(1, 1), (b3) + hstep, voffB[0], voffB[1]); PG8_STAGE(PG8_SA(1, 0), a3, W00, W01); \
            PG8_WAIT_V(8); PG8_WAIT_L(0); PG8_BAR; PG8_MMA(1, 0, At, B0); PG8_MMA(1, 1, At, B1); PG8_BAR; PG8_SCHED; } while (0)
        for (int t = 0; t < nt - 2; t += 2) {
            const char* a1 = cA + (size_t)(t + 1) * kstep;
            const char* a2 = cA + (size_t)(t + 2) * kstep; const char* b2 = cB + (size_t)(t + 2) * kstep;
            const char* a3 = a2 + kstep; const char* b3 = b2 + kstep;
            if (GATHER) { if (t == nt - 4 && has_next) { int t2_ = tid; asm volatile("" : "+v"(t2_));
#pragma unroll
                for (int i = 0; i < 2; ++i) { int R, C; stage_rc(t2_ * 16 + i * 8192, R, C);
#pragma unroll
                    for (int h = 0; h < 2; ++h) { const unsigned vo = S.tokoff(nxt, h * HALF + R); asm volatile("global_load_dword %0, %1, %2" : "=v"(tok_[h][i]) : "v"(vo), "s"(S.tokbase()) : "memory"); } } } }
            PG8_KBODY(a1, a2, b2, a3, b3, vA[0][0], vA[0][1], vA[1][0], vA[1][1]);
        }
        if (GATHER) {
            if (has_next) { int t2_ = tid; asm volatile("" : "+v"(t2_), "+v"(tok_[0][0]), "+v"(tok_[0][1]), "+v"(tok_[1][0]), "+v"(tok_[1][1]));
#pragma unroll
                for (int i = 0; i < 2; ++i) { int R, C; stage_rc(t2_ * 16 + i * 8192, R, C);
#pragma unroll
                    for (int h = 0; h < 2; ++h) vN[h][i] = tok_[h][i] * (unsigned)(K * 2) + (unsigned)C * 2u; } }
            else {
#pragma unroll
                for (int h = 0; h < 2; ++h)
#pragma unroll
                    for (int i = 0; i < 2; ++i) vN[h][i] = vA[h][i];
            }
        }
        {
            const char* a1 = cA + (size_t)(nt - 1) * kstep;
            const char* a3 = nA + kstep; const char* b3 = nB + kstep;
            PG8_KBODY(a1, nA, nB, a3, b3, vN[0][0], vN[0][1], vN[1][0], vN[1][1]);
        }
#undef PG8_KBODY
        if constexpr (ALIGN_EPI) { if (wr == 0) PG8_BAR; }
        { int t3_ = tid; asm volatile("" : "+v"(t3_)); const int l3_ = t3_ & 63; E(acc, cur, wr, wc, l3_ & 15, l3_ >> 4); }
        if (!has_next) break;
#pragma unroll
        for (int a = 0; a < 2; ++a)
#pragma unroll
            for (int b = 0; b < 2; ++b)
#pragma unroll
                for (int m = 0; m < 4; ++m)
#pragma unroll
                    for (int n = 0; n < 2; ++n) acc[a][b][m][n] = (f32x4){0.f, 0.f, 0.f, 0.f};
        cur = nxt; cA = nA; cB = nB; ++ui;
        if (GATHER) {
#pragma unroll
            for (int h = 0; h < 2; ++h)
#pragma unroll
                for (int i = 0; i < 2; ++i) vA[h][i] = vN[h][i];
        }
        if constexpr (ALIGN_EPI) { if (wr == 1) PG8_BAR; }
    }
    PG8_WAIT_V(0);
    if constexpr (!ALIGN_EPI) { if (wr == 0) PG8_BAR; }
    PG8_BAR;
#undef PG8_AOFFS
#undef PG8_SA
#undef PG8_SB
#undef PG8_STAGE
#undef PG8_LDA
#undef PG8_LDB
#undef PG8_MMA
#undef PG8_WAIT_V
#undef PG8_WAIT_L
#undef PG8_BAR
#undef PG8_SCHED
}


constexpr int TS_OFF = 131072 + 1024;
template <bool GATHER> struct MoeOrder {
    const char* A; const char* Bt; const int* rowtok; int nN, nwg, nM, G, c, K; size_t strideE;
    __device__ __forceinline__ void init(const bf16_t* A_, const bf16_t* Bt_, const int* rowtok_, int N, int K_, size_t strideE_, int G_, int c_) {
        A = (const char*)A_; Bt = (const char*)Bt_; rowtok = rowtok_; nN = N / BM; K = K_; strideE = strideE_; G = G_; c = c_;
        nM = __builtin_amdgcn_readfirstlane(((LAS const int*)(LDSP + TS_OFF))[32]); nwg = nM * nN; }
    __device__ __forceinline__ bool next(int i, GUnit& u) const {
        const long L = (long)i * G + c; if (L >= nwg) return false;
        int wgid = (int)L; { const int q = nwg / NXCD, r = nwg % NXCD, xcd = wgid % NXCD, off = wgid / NXCD; wgid = (xcd < r ? xcd * (q + 1) : r * (q + 1) + (xcd - r) * q) + off; }
        const int nig = WGM * nN, gid = wgid / nig, fm = gid * WGM, gsz = (nM - fm) < WGM ? (nM - fm) : WGM;
        u.pm = fm + ((wgid % nig) % gsz); u.pn = (wgid % nig) / gsz;
        LAS const int* ts = (LAS const int*)(LDSP + TS_OFF);
        const int e = __builtin_amdgcn_readfirstlane(ts[72 + u.pm]);
        u.e = e; u.row0 = (u.pm - __builtin_amdgcn_readfirstlane(ts[e])) * BM; u.cnt = __builtin_amdgcn_readfirstlane(ts[33 + e]);
        u.A = GATHER ? A : A + (size_t)u.pm * BM * K * 2;
        u.B = Bt + (size_t)e * strideE + (size_t)u.pn * BM * K * 2; return true;
    }
    __device__ __forceinline__ unsigned aoff(const GUnit& u, int row) const {
        if (GATHER) { int sl = u.row0 + row; sl = sl < u.cnt ? sl : u.cnt - 1; return (unsigned)rowtok[u.e * ECAP + sl] * (unsigned)(K * 2); }
        return (unsigned)(row * K * 2);
    }
    __device__ __forceinline__ unsigned tokoff(const GUnit& u, int row) const { int sl = u.row0 + row; sl = sl < u.cnt ? sl : u.cnt - 1; return (unsigned)(u.e * ECAP + sl) * 4u; }
    __device__ __forceinline__ const int* tokbase() const { return rowtok; }
};
__device__ __forceinline__ void moe_tiles(const unsigned* cnt, int tid) {
    LAS int* ts = (LAS int*)(LDSP + TS_OFF);
    if (tid == 0) { int s = 0; for (int e = 0; e < NEXP; ++e) { const int c = (int)cnt[e]; ts[e] = s; ts[33 + e] = c; const int n = (c + BM - 1) / BM;
_Pragma("clang loop vectorize(disable) unroll(disable)") for (int t = 0; t < n; ++t) ts[72 + s + t] = e;
            s += n; } ts[NEXP] = s; }
    __syncthreads();
}
struct EpiMoe1 {
    static constexpr bool PERM = true;
    bf16_t* O; const float* b1; const float* rsc;
    __device__ __forceinline__ void operator()(const f32x4 (&acc)[2][2][4][2], const GUnit& u, int wr, int wc, int fr, int fq) const {
        const int rt0 = wr * 64 + fr, col0 = u.pn * 128 + wc * 32 + 8 * fq;
        const float* bg = b1 + (size_t)u.e * 2048 + col0;
        f32x4 bgv[2], blv[2];
#pragma unroll
        for (int n = 0; n < 2; ++n) { bgv[n] = *(const f32x4*)(bg + 4 * n); blv[n] = *(const f32x4*)(bg + DFF + 4 * n); }
#pragma unroll
        for (int ai = 0; ai < 2; ++ai)
#pragma unroll
            for (int m = 0; m < 4; ++m) {
                const int rt = rt0 + ai * HALF + m * 16; int sl = u.row0 + rt; sl = sl < u.cnt ? sl : u.cnt - 1;
                const float r = rsc[u.e * ECAP + sl];
                float o[8];
#pragma unroll
                for (int n = 0; n < 2; ++n)
#pragma unroll
                    for (int j = 0; j < 4; ++j) {
                        const float g = fminf(r * acc[ai][0][m][n][j] + bgv[n][j], 7.f);
                        const float l = fminf(fmaxf(r * acc[ai][1][m][n][j] + blv[n][j], -7.f), 7.f);
                        o[n * 4 + j] = g * __builtin_amdgcn_rcpf(1.f + __builtin_amdgcn_exp2f(-2.4554669595930157f * g)) * (l + 1.f);
                    }
                u32x4 w; w.x = cvt_pk_bf16(o[0], o[1]); w.y = cvt_pk_bf16(o[2], o[3]); w.z = cvt_pk_bf16(o[4], o[5]); w.w = cvt_pk_bf16(o[6], o[7]);
                *(u32x4*)(O + (size_t)(u.pm * BM + rt) * DFF + col0) = w;
            }
    }
};
struct EpiMoe2 {
    static constexpr bool PERM = true;
    bf16_t* O; const float* b2;
    __device__ __forceinline__ void operator()(const f32x4 (&acc)[2][2][4][2], const GUnit& u, int wr, int wc, int fr, int fq) const {
        const int row0 = u.pm * BM + wr * 64 + fr, col0 = u.pn * BM + wc * 32 + 8 * fq;
        f32x4 bv[2][2];
#pragma unroll
        for (int bj = 0; bj < 2; ++bj)
#pragma unroll
            for (int n = 0; n < 2; ++n) bv[bj][n] = *(const f32x4*)(b2 + (size_t)u.e * DM + col0 + bj * HALF + 4 * n);
#pragma unroll
        for (int ai = 0; ai < 2; ++ai)
#pragma unroll
            for (int m = 0; m < 4; ++m) { bf16_t* rowp = O + (size_t)(row0 + ai * HALF + m * 16) * DM + col0;
#pragma unroll
                for (int bj = 0; bj < 2; ++bj) { const f32x4 v0 = acc[ai][bj][m][0] + bv[bj][0], v1 = acc[ai][bj][m][1] + bv[bj][1];
                    u32x4 w; w.x = cvt_pk_bf16(v0[0], v0[1]); w.y = cvt_pk_bf16(v0[2], v0[3]); w.z = cvt_pk_bf16(v1[0], v1[1]); w.w = cvt_pk_bf16(v1[2], v1[3]);
                    *(u32x4*)(rowp + bj * HALF) = w; } }
    }
};

__device__ __forceinline__ void p_transpose(const int wv, const float* W, int nmat, int K, int N, bf16_t* WT, const float* kgain, int gdiv, int mode, LAS unsigned char* lds) {
    LTID();
    const int wave = wv, lane = tidx & 63;
    LAS float* scr = (LAS float*)(lds + wave * 16384);
    const int nblk = N / 32, per_mat = (K / 64) * nblk, total = nmat * per_mat, stride = (int)gridDim.x * NW;
    const int lrow = lane >> 5, lcol = lane & 31;
#define TR_ISSUE(item, dst) do { const int mat_ = (item) / per_mat, r_ = (item) - mat_ * per_mat, kb_ = r_ / nblk, nb_ = r_ - kb_ * nblk; \
        const float* src_ = W + (size_t)mat_ * K * N + (size_t)(64 * kb_ + lrow) * N + 32 * nb_ + lcol; \
        _Pragma("unroll") for (int i = 0; i < 32; ++i) dst[i] = src_[(size_t)(2 * i) * N]; } while (0)
    float v[32], vn[32];
    int it = bidx * NW + wave;
    if (it < total) TR_ISSUE(it, v);
    while (it < total) {
        const int itn = it + stride;
        if (itn < total) TR_ISSUE(itn, vn);
        const int mat = it / per_mat, r = it - mat * per_mat, kb = r / nblk, nb = r - kb * nblk, k0 = 64 * kb, n0 = 32 * nb;
#pragma unroll
        for (int i = 0; i < 32; ++i) scr[(2 * i + lrow) * 33 + lcol] = v[i];
        asm volatile("s_waitcnt lgkmcnt(0)" ::: "memory");
        int d0 = n0;
        if (mode == 1) { const int bj = n0 >> 10, rest = n0 & 1023, pn = rest >> 7, j = rest & 127; d0 = pn * 256 + bj * 128 + j; }
        const int c = lane & 7;
        f32x4 g0 = (f32x4){1.f, 1.f, 1.f, 1.f}, g1 = g0;
        if (kgain) { const float* gp = kgain + (size_t)(mat / gdiv) * DM + k0 + 8 * c; g0 = *(const f32x4*)gp; g1 = *(const f32x4*)(gp + 4); }
        bf16_t* dst = WT + (size_t)mat * K * N;
#pragma unroll
        for (int j = 0; j < 4; ++j) { const int n = (lane >> 3) + 8 * j; const LAS float* sp = scr + (8 * c) * 33 + n;
            u32x4 o; o.x = pk2(sp[0 * 33] * g0[0], sp[1 * 33] * g0[1]); o.y = pk2(sp[2 * 33] * g0[2], sp[3 * 33] * g0[3]); o.z = pk2(sp[4 * 33] * g1[0], sp[5 * 33] * g1[1]); o.w = pk2(sp[6 * 33] * g1[2], sp[7 * 33] * g1[3]);
            *(u32x4*)(dst + (size_t)(d0 + n) * K + k0 + 8 * c) = o; }
        asm volatile("s_waitcnt lgkmcnt(0)" ::: "memory");
#pragma unroll
        for (int i = 0; i < 32; ++i) v[i] = vn[i];
        it = itn;
    }
#undef TR_ISSUE
}
typedef short v4i16_t __attribute__((ext_vector_type(4)));
constexpr int ATT_TAB_OFF = 131072 + 2048;
constexpr int ATT_UNITS = 3 * 8 * 128;
__device__ __forceinline__ int t5_bucket_dev(int n) {
    if (n < 16) return n;
    const float v = logf((float)n / 16.f) / 4.852030263919617f * 16.f;
    const int large = 16 + (int)v;
    return large < 31 ? large : 31;
}
__device__ __forceinline__ void p_bias_table(const int wv, const float* rel_bias, float* biasG) {
    LTID();
    for (int i = bidx * NT + tidx; i < 3 * 8 * 132; i += gridDim.x * NT) {
        const int d = i % 132, bh = i / 132, h = bh & 7, b = bh >> 3;
        biasG[i] = (d <= 128) ? rel_bias[t5_bucket_dev(d << (2 * b)) * 8 + h] : 0.f;
    }
}
__device__ __forceinline__ void p_dil_attn(const int wv, const bf16_t* proj16, const float* biasG, bf16_t* obr, float* lse, LAS unsigned char* lds) {
    LTID();
    const int lane = tidx & 63, fr = lane & 15, fq = lane >> 4, w = wv;
    const int per = (ATT_UNITS + (int)gridDim.x - 1) / (int)gridDim.x;
    const int u0 = bidx * per, u1 = (u0 + per < ATT_UNITS) ? u0 + per : ATT_UNITS;
    if (u0 >= u1) return;
    const int rowl = tidx >> 3, cs = tidx & 7;
    const unsigned cK = (unsigned)(cs ^ ((rowl >> 1) & 7)) * 16u, cV = (unsigned)(cs ^ (rowl & 7)) * 16u;
    const unsigned fK = (unsigned)((fr >> 1) & 7);
    const unsigned kro0 = (unsigned)fr * 128u + (((unsigned)fq ^ fK) * 16u), kro1 = (unsigned)fr * 128u + ((((unsigned)fq ^ fK) ^ 4u) * 16u);
    const int tq = (lane & 15) >> 2, tp = lane & 3, fv = 4 * (fq & 1) + tq;
    unsigned vro[4];
#pragma unroll
    for (int db = 0; db < 4; ++db) vro[db] = (unsigned)(4 * fq + tq) * 128u + (unsigned)(((2 * db + (tp >> 1)) ^ fv) * 16) + 8u * (unsigned)(tp & 1);
    const int ts_ = (1 + fr) & 3;
    const unsigned tab8 = (unsigned)ATT_TAB_OFF + (unsigned)ts_ * 640u + (unsigned)(((141 + fr - ts_) >> 2) - fq - 32) * 16u;
    const char* gbase = (const char*)proj16;
#define ATT_DECODE(u, b_, h_, r_, n_, dil_) const int cmb_ = (u) >> 7, b_ = cmb_ >> 3, h_ = cmb_ & 7, dil_ = 1 << (2 * b_), idx_ = (u) & 127, r_ = idx_ & (dil_ - 1), n_ = idx_ >> (2 * b_)
#define ATT_ISSUE(u, bf, q0, q1) do { ATT_DECODE(u, b__, h__, r__, n__, dil__); \
        const int nk = n__ > 0 ? n__ - 1 : 0;                                     \
        _Pragma("unroll") for (int p = 0; p < 4; ++p) { \
            int row = 64 * p + rowl; int blk = (row >> 7) ? n__ : nk; \
            const unsigned pos = (unsigned)(r__ + dil__ * (128 * blk + (row & 127))); \
            const unsigned so = pos * 4096u + (unsigned)h__ * 128u; const unsigned ld_ = (unsigned)(size_t)(lds + (bf) * 65536 + p * 8192 + w * 1024); \
            glds16s(gbase, so + 1024u + cK, ld_); glds16s(gbase, so + 2048u + cV, ld_ + 32768u); } \
        const unsigned qpos = (unsigned)(r__ + dil__ * (128 * n__ + 16 * w + fr)); \
        const char* qsrc = gbase + (size_t)qpos * 4096u + (unsigned)h__ * 128u + (unsigned)fq * 16u; \
        q0 = *(const bf16x8*)(qsrc); q1 = *(const bf16x8*)(qsrc + 64); } while (0)
    bf16x8 qf0, qf1, qn0, qn1;
    ATT_ISSUE(u0, 0, qn0, qn1);
    int prev_cmb = -1;
    for (int u = u0; u < u1; ++u) {
        const int bf = (u - u0) & 1;
        asm volatile("s_waitcnt vmcnt(0)" ::: "memory");
        __syncthreads();
        qf0 = qn0; qf1 = qn1;
        if (u + 1 < u1) ATT_ISSUE(u + 1, bf ^ 1, qn0, qn1);
        ATT_DECODE(u, b, h, r, n, dil);
        if (cmb_ != prev_cmb) {
            prev_cmb = cmb_;
            for (int e = tidx; e < 4 * 160; e += NT) { const int sft = e / 160, k = e - sft * 160, idx = k + sft, dist = idx - 16;
                const float v = (dist >= 0 && dist <= 128) ? biasG[cmb_ * 132 + dist] : -1e30f;
                ((LAS float*)(lds + ATT_TAB_OFF))[sft * 160 + k] = v; }
            __syncthreads();
        }
        const LAS unsigned char* Kb = lds + bf * 65536; const LAS unsigned char* Vb = Kb + 32768;
        const int kb0 = w;
        f32x4 sc[9];
#pragma unroll
        for (int i = 0; i < 9; ++i) {
            const unsigned ko = (unsigned)(kb0 + i) * 2048u;
            const bf16x8 k0 = *(const LAS bf16x8*)(Kb + ko + kro0), k1 = *(const LAS bf16x8*)(Kb + ko + kro1);
            f32x4 a = (f32x4){0.f, 0.f, 0.f, 0.f};
            a = __builtin_amdgcn_mfma_f32_16x16x32_bf16(k0, qf0, a, 0, 0, 0);
            a = __builtin_amdgcn_mfma_f32_16x16x32_bf16(k1, qf1, a, 0, 0, 0);
            const f32x4 t = *(const LAS f32x4*)(lds + tab8 + 64 * (8 - i));
            a = a + (f32x4){t[3], t[2], t[1], t[0]};
            if (n == 0 && kb0 + i < 8) a = (f32x4){-1e30f, -1e30f, -1e30f, -1e30f};
            sc[i] = a;
        }
        float mx = -1e30f;
#pragma unroll
        for (int i = 0; i < 9; ++i) mx = fmaxf(mx, fmaxf(fmaxf(sc[i][0], sc[i][1]), fmaxf(sc[i][2], sc[i][3])));
        mx = fmaxf(mx, shx(mx, 16, lane)); mx = fmaxf(mx, shx(mx, 32, lane));
        float sum = 0.f;
#pragma unroll
        for (int i = 0; i < 9; ++i)
#pragma unroll
            for (int j = 0; j < 4; ++j) { const float p = __expf(sc[i][j] - mx); sc[i][j] = p; sum += p; }
        sum += shx(sum, 16, lane); sum += shx(sum, 32, lane);
        f32x4 oacc[4];
#pragma unroll
        for (int db = 0; db < 4; ++db) oacc[db] = (f32x4){0.f, 0.f, 0.f, 0.f};
#pragma unroll
        for (int c = 0; c < 5; ++c) {
            const int ia = 2 * c, ib = (c < 4) ? 2 * c + 1 : 8;
            u32x4 pw; pw.x = cvt_pk_bf16(sc[ia][0], sc[ia][1]); pw.y = cvt_pk_bf16(sc[ia][2], sc[ia][3]);
            if (c < 4) { pw.z = cvt_pk_bf16(sc[ib][0], sc[ib][1]); pw.w = cvt_pk_bf16(sc[ib][2], sc[ib][3]); } else { pw.z = 0u; pw.w = 0u; }
            const bf16x8 pf = __builtin_bit_cast(bf16x8, pw);
            const unsigned va = (unsigned)(kb0 + ia) * 2048u, vb = (unsigned)(kb0 + ib) * 2048u;
#pragma unroll
            for (int db = 0; db < 4; ++db) {
                const v4i16_t x0 = __builtin_amdgcn_ds_read_tr16_b64_v4i16((LAS v4i16_t*)(Vb + va + vro[db]));
                const v4i16_t x1 = __builtin_amdgcn_ds_read_tr16_b64_v4i16((LAS v4i16_t*)(Vb + vb + vro[db]));
                const bf16x8 vf = (bf16x8){x0[0], x0[1], x0[2], x0[3], x1[0], x1[1], x1[2], x1[3]};
                oacc[db] = __builtin_amdgcn_mfma_f32_16x16x32_bf16(vf, pf, oacc[db], 0, 0, 0);
            }
        }
        const float inv = 1.f / sum;
        const unsigned qpos = (unsigned)(r + dil * (128 * n + 16 * w + fr));
        bf16_t* orow = obr + ((size_t)b * SEQ + qpos) * 512 + h * 64 + 4 * fq;
#pragma unroll
        for (int db = 0; db < 4; ++db) { u32x2 o2; o2.x = cvt_pk_bf16(oacc[db][0] * inv, oacc[db][1] * inv); o2.y = cvt_pk_bf16(oacc[db][2] * inv, oacc[db][3] * inv); *(u32x2*)(orow + 16 * db) = o2; }
        if (fq == 0) lse[((size_t)b * SEQ + qpos) * 8 + h] = mx + __logf(sum);
    }
    asm volatile("s_waitcnt vmcnt(0)" ::: "memory");
    __syncthreads();
#undef ATT_DECODE
#undef ATT_ISSUE
}
__device__ __forceinline__ void p_attn_combine(const int wv, const bf16_t* obr, const float* lse, const float* g, bf16_t* mix16) {
    LTID();
    const int lane = tidx & 63, h = lane >> 3;
    f32x4 g0 = *(const f32x4*)(g + lane * 8), g1 = *(const f32x4*)(g + lane * 8 + 4);
    for (int row = bidx * NW + wv; row < SEQ; row += gridDim.x * NW) {
        float l0 = lse[((size_t)0 * SEQ + row) * 8 + h], l1 = lse[((size_t)1 * SEQ + row) * 8 + h], l2 = lse[((size_t)2 * SEQ + row) * 8 + h];
        const float M = fmaxf(l0, fmaxf(l1, l2));
        float w0 = __expf(l0 - M), w1 = __expf(l1 - M), w2 = __expf(l2 - M);
        const float iw = 1.f / (w0 + w1 + w2); w0 *= iw; w1 *= iw; w2 *= iw;
        const u32x4 a0 = *(const u32x4*)(obr + ((size_t)0 * SEQ + row) * 512 + lane * 8);
        const u32x4 a1 = *(const u32x4*)(obr + ((size_t)1 * SEQ + row) * 512 + lane * 8);
        const u32x4 a2 = *(const u32x4*)(obr + ((size_t)2 * SEQ + row) * 512 + lane * 8);
        float y[8]; float ss = 0.f;
#pragma unroll
        for (int k = 0; k < 4; ++k) {
            const float lo = w0 * __builtin_bit_cast(float, a0[k] << 16) + w1 * __builtin_bit_cast(float, a1[k] << 16) + w2 * __builtin_bit_cast(float, a2[k] << 16);
            const float hi = w0 * __builtin_bit_cast(float, a0[k] & 0xffff0000u) + w1 * __builtin_bit_cast(float, a1[k] & 0xffff0000u) + w2 * __builtin_bit_cast(float, a2[k] & 0xffff0000u);
            y[2 * k] = lo; y[2 * k + 1] = hi; ss += lo * lo + hi * hi;
        }
#pragma unroll
        for (int o = 32; o; o >>= 1) ss += shx(ss, o, lane);
        const float sc = rsqrtf(ss * (1.f / 512.f) + 1e-5f);
        u32x4 o4; o4.x = cvt_pk_bf16(y[0] * sc * g0[0], y[1] * sc * g0[1]); o4.y = cvt_pk_bf16(y[2] * sc * g0[2], y[3] * sc * g0[3]);
        o4.z = cvt_pk_bf16(y[4] * sc * g1[0], y[5] * sc * g1[1]); o4.w = cvt_pk_bf16(y[6] * sc * g1[2], y[7] * sc * g1[3]);
        *(u32x4*)(mix16 + (size_t)row * DM + lane * 8) = o4;
    }
}
struct EpiIn {
    static constexpr bool PERM = true;
    bf16_t* O;
    __device__ __forceinline__ void operator()(const f32x4 (&acc)[2][2][4][2], const GUnit& u, int wr, int wc, int fr, int fq) const {
        const int row0 = u.pm * BM + wr * 64 + fr, col0 = u.pn * BM + wc * 32 + 8 * fq;
        const float sc = u.pn < 2 ? 0.125f : 1.f;
#pragma unroll
        for (int ai = 0; ai < 2; ++ai)
#pragma unroll
            for (int m = 0; m < 4; ++m) { const size_t ro = (size_t)(row0 + ai * HALF + m * 16) * DIN + col0;
#pragma unroll
                for (int bj = 0; bj < 2; ++bj) { const f32x4 v0 = acc[ai][bj][m][0] * sc, v1 = acc[ai][bj][m][1] * sc;
                    u32x4 w; w.x = cvt_pk_bf16(v0[0], v0[1]); w.y = cvt_pk_bf16(v0[2], v0[3]); w.z = cvt_pk_bf16(v1[0], v1[1]); w.w = cvt_pk_bf16(v1[2], v1[3]);
                    *(u32x4*)(O + ro + bj * HALF) = w;
                    } }
    }
};


__device__ __forceinline__ unsigned xoff_b(unsigned row, unsigned ch) { return 256u * row + 16u * (ch ^ (((row & 3u) << 2) | ((row >> 2) & 3u))); }
__device__ __forceinline__ void p_xattn_mfma(const int wv, const bf16_t* qx16, const bf16_t* kv16, bf16_t* ox16, LAS unsigned char* lds) {
    LTID();
    const int lane = tidx & 63, fr = lane & 15, fq = lane >> 4, w = wv;
    const int NU = 4 * 128;
    const int per = (NU + (int)gridDim.x - 1) / (int)gridDim.x;
    const int u0 = bidx * per, u1 = (u0 + per < NU) ? u0 + per : NU;
    if (u0 >= u1) return;
    const int rowl = tidx >> 4, cs = tidx & 15;
    const unsigned csw = (unsigned)(cs ^ (((rowl & 3) << 2) | ((rowl >> 2) & 3))) * 16u;
    const unsigned kswz = (unsigned)(((fr & 3) << 2) | ((fr >> 2) & 3));
    unsigned kro[4];
#pragma unroll
    for (int s4 = 0; s4 < 4; ++s4) kro[s4] = 256u * (unsigned)fr + 16u * ((unsigned)(4 * s4 + fq) ^ kswz);
    const int tq = (lane & 15) >> 2, tp = lane & 3;
    const unsigned vswz = (unsigned)((tq << 2) | fq);
    unsigned vro[8];
#pragma unroll
    for (int c = 0; c < 8; ++c) vro[c] = 65536u + 256u * (unsigned)(4 * fq + tq) + 16u * ((unsigned)(2 * c + (tp >> 1)) ^ vswz) + 8u * (unsigned)(tp & 1);
    int prev_h = -1;
    for (int u = u0; u < u1; ++u) {
        const int h = u >> 7, qt = u & 127;
        if (h != prev_h) {
            __syncthreads();
            prev_h = h;
#pragma unroll
            for (int p = 0; p < 8; ++p) {
                const unsigned row = (unsigned)(32 * p + rowl);
                const unsigned so = row * 2048u + (unsigned)h * 256u + csw;
                const unsigned ld_ = (unsigned)(size_t)(lds + p * 8192 + w * 1024);
                glds16s(kv16, so, ld_); glds16s(kv16, so + 1024u, ld_ + 65536u);
            }
            asm volatile("s_waitcnt vmcnt(0)" ::: "memory");
            __syncthreads();
        }
        const char* qsrc = (const char*)qx16 + ((size_t)(qt * 128 + 16 * w + fr) * 512 + h * 128 + 8 * fq) * 2;
        bf16x8 qf[4];
#pragma unroll
        for (int s4 = 0; s4 < 4; ++s4) qf[s4] = *(const bf16x8*)(qsrc + 64 * s4);
        f32x4 sc[16];
#pragma unroll
        for (int i = 0; i < 16; ++i) {
            f32x4 a = (f32x4){0.f, 0.f, 0.f, 0.f};
#pragma unroll
            for (int s4 = 0; s4 < 4; ++s4) { const bf16x8 kf = *(const LAS bf16x8*)(lds + i * 4096 + kro[s4]); a = __builtin_amdgcn_mfma_f32_16x16x32_bf16(kf, qf[s4], a, 0, 0, 0); }
            sc[i] = a;
        }
        float mx = -1e30f;
#pragma unroll
        for (int i = 0; i < 16; ++i) mx = fmaxf(mx, fmaxf(fmaxf(sc[i][0], sc[i][1]), fmaxf(sc[i][2], sc[i][3])));
        mx = fmaxf(mx, shx(mx, 16, lane)); mx = fmaxf(mx, shx(mx, 32, lane));
        float sum = 0.f;
#pragma unroll
        for (int i = 0; i < 16; ++i)
#pragma unroll
            for (int j = 0; j < 4; ++j) { const float p = __expf(sc[i][j] - mx); sc[i][j] = p; sum += p; }
        sum += shx(sum, 16, lane); sum += shx(sum, 32, lane);
        f32x4 oacc[8];
#pragma unroll
        for (int c = 0; c < 8; ++c) oacc[c] = (f32x4){0.f, 0.f, 0.f, 0.f};
#pragma unroll
        for (int ch = 0; ch < 8; ++ch) {
            const int ia = 2 * ch, ib = 2 * ch + 1;
            u32x4 pw; pw.x = cvt_pk_bf16(sc[ia][0], sc[ia][1]); pw.y = cvt_pk_bf16(sc[ia][2], sc[ia][3]); pw.z = cvt_pk_bf16(sc[ib][0], sc[ib][1]); pw.w = cvt_pk_bf16(sc[ib][2], sc[ib][3]);
            const bf16x8 pf = __builtin_bit_cast(bf16x8, pw);
#pragma unroll
            for (int c = 0; c < 8; ++c) {
                const v4i16_t x0 = __builtin_amdgcn_ds_read_tr16_b64_v4i16((LAS v4i16_t*)(lds + ia * 4096 + vro[c]));
                const v4i16_t x1 = __builtin_amdgcn_ds_read_tr16_b64_v4i16((LAS v4i16_t*)(lds + ib * 4096 + vro[c]));
                const bf16x8 vf = (bf16x8){x0[0], x0[1], x0[2], x0[3], x1[0], x1[1], x1[2], x1[3]};
                oacc[c] = __builtin_amdgcn_mfma_f32_16x16x32_bf16(vf, pf, oacc[c], 0, 0, 0);
            }
        }
        const float inv = 1.f / sum;
        bf16_t* orow = ox16 + (size_t)(qt * 128 + 16 * w + fr) * 512 + h * 128 + 4 * fq;
#pragma unroll
        for (int c = 0; c < 8; ++c) { u32x2 o2; o2.x = cvt_pk_bf16(oacc[c][0] * inv, oacc[c][1] * inv); o2.y = cvt_pk_bf16(oacc[c][2] * inv, oacc[c][3] * inv); *(u32x2*)(orow + 16 * c) = o2; }
    }
    __syncthreads();
}
struct EpiBf16 {
    static constexpr bool PERM = true;
    bf16_t* O; int ldc; float scale; const float* ss;
    __device__ __forceinline__ void operator()(const f32x4 (&acc)[2][2][4][2], const GUnit& u, int wr, int wc, int fr, int fq) const {
        const int row0 = u.pm * BM + wr * 64 + fr, col0 = u.pn * BM + wc * 32 + 8 * fq;
#pragma unroll
        for (int ai = 0; ai < 2; ++ai)
#pragma unroll
            for (int m = 0; m < 4; ++m) { const int row = row0 + ai * HALF + m * 16; bf16_t* rowp = O + (size_t)row * ldc + col0;
                float sc = scale;
                if (ss) { const f32x4 p0 = *(const f32x4*)(ss + (size_t)row * 16), p1 = *(const f32x4*)(ss + (size_t)row * 16 + 4), p2 = *(const f32x4*)(ss + (size_t)row * 16 + 8), p3 = *(const f32x4*)(ss + (size_t)row * 16 + 12);
                    const float t = ((p0[0] + p0[1]) + (p0[2] + p0[3])) + ((p1[0] + p1[1]) + (p1[2] + p1[3])) + ((p2[0] + p2[1]) + (p2[2] + p2[3])) + ((p3[0] + p3[1]) + (p3[2] + p3[3]));
                    sc = scale * rsqrtf(t * (1.f / 1024.f) + 1e-5f); }
#pragma unroll
                for (int bj = 0; bj < 2; ++bj) { const f32x4 v0 = acc[ai][bj][m][0] * sc, v1 = acc[ai][bj][m][1] * sc;
                    u32x4 w; w.x = cvt_pk_bf16(v0[0], v0[1]); w.y = cvt_pk_bf16(v0[2], v0[3]); w.z = cvt_pk_bf16(v1[0], v1[1]); w.w = cvt_pk_bf16(v1[2], v1[3]);
                    *(u32x4*)(rowp + bj * HALF) = w; } }
    }
};
struct EpiOut {
    static constexpr bool PERM = true;
    float* H; bf16_t* HB; float* ss;
    __device__ __forceinline__ void operator()(const f32x4 (&acc)[2][2][4][2], const GUnit& u, int wr, int wc, int fr, int fq) const {
        const int row0 = u.pm * BM + wr * 64 + fr, col0 = u.pn * BM + wc * 32 + 8 * fq, lane = fq * 16 + fr;
#pragma unroll
        for (int ai = 0; ai < 2; ++ai)
#pragma unroll
            for (int m = 0; m < 4; ++m) { const int row = row0 + ai * HALF + m * 16; const size_t ro = (size_t)row * DM + col0; float sq = 0.f;
#pragma unroll
                for (int bj = 0; bj < 2; ++bj) {
                    const f32x4 v0 = acc[ai][bj][m][0] + *(const f32x4*)(H + ro + bj * HALF), v1 = acc[ai][bj][m][1] + *(const f32x4*)(H + ro + bj * HALF + 4);
                    *(f32x4*)(H + ro + bj * HALF) = v0; *(f32x4*)(H + ro + bj * HALF + 4) = v1;
                    u32x4 w; w.x = cvt_pk_bf16(v0[0], v0[1]); w.y = cvt_pk_bf16(v0[2], v0[3]); w.z = cvt_pk_bf16(v1[0], v1[1]); w.w = cvt_pk_bf16(v1[2], v1[3]);
                    *(u32x4*)(HB + ro + bj * HALF) = w;
                    sq += (v0[0] * v0[0] + v0[1] * v0[1]) + (v0[2] * v0[2] + v0[3] * v0[3]) + (v1[0] * v1[0] + v1[1] * v1[1]) + (v1[2] * v1[2] + v1[3] * v1[3]);
                }
                sq += shx(sq, 16, lane); sq += shx(sq, 32, lane);
                if (fq == 0) ss[(size_t)row * 16 + u.pn * 4 + wc] = sq;
            }
    }
};

typedef short bf16x4 __attribute__((ext_vector_type(4)));
typedef float f32x2 __attribute__((ext_vector_type(2)));
constexpr int S5_CHUNK = 256, S5_NCH = SEQ / S5_CHUNK, S5_ROWB = 528;
__device__ __forceinline__ f32x2 gelu_pk(f32x2 v) {
    const f32x2 av = __builtin_elementwise_abs(v), d = av * 0.2316418882f + 1.0f;
    f32x2 t; t.x = __builtin_amdgcn_rcpf(d.x); t.y = __builtin_amdgcn_rcpf(d.y);
    f32x2 q = t * 0.5307027145f + (-0.7265760135f); q = q * t + 0.7107068705f; q = q * t + (-0.142248368f); q = q * t + 0.127414796f; q = q * t;
    const f32x2 s2 = (v * v) * (-0.72134752044f);
    f32x2 e; e.x = __builtin_amdgcn_exp2f(s2.x); e.y = __builtin_amdgcn_exp2f(s2.y);
    const f32x2 m = v * (q * e), r = v - m;
    f32x2 o; o.x = v.x < 0.f ? m.x : r.x; o.y = v.y < 0.f ? m.y : r.y; return o;
}
__device__ __forceinline__ void p_s5_tables2(const int wv, const float* a_re, const float* a_im, const float* b_re, const float* b_im, const float* c_re, const float* c_im, const float* log_dt,
                                             float2* abar, float2* a256, bf16_t* BB16, bf16_t* CM16) {
    LTID();
    for (int gp = bidx * NT + tidx; gp < 2048; gp += gridDim.x * NT) {
        const int g = gp >> 6, p = gp & 63;
        const float lr = a_re[gp], li = a_im[gp], dt = expf(log_dt[g]);
        const float mag = expf(lr * dt); float sn, cs; sincosf(li * dt, &sn, &cs);
        const float ar = mag * cs, ai = mag * sn;
        abar[gp] = make_float2(ar, ai);
        float pr = ar, pi = ai;
        for (int i = 0; i < 8; ++i) { const float nr = pr * pr - pi * pi, ni = 2.f * pr * pi; pr = nr; pi = ni; }
        a256[gp] = make_float2(pr, pi);
        const float nr = ar - 1.f, ni = ai, den = lr * lr + li * li;
        const float cr = (nr * lr + ni * li) / den, ci = (ni * lr - nr * li) / den;
        for (int c = 0; c < 16; ++c) {
            const float br = b_re[gp * 16 + c], bi = b_im[gp * 16 + c];
            BB16[((size_t)g * 128 + p) * 16 + c] = (bf16_t)f2bf(cr * br - ci * bi);
            BB16[((size_t)g * 128 + 64 + p) * 16 + c] = (bf16_t)f2bf(cr * bi + ci * br);
            CM16[((size_t)g * 16 + c) * 128 + p] = (bf16_t)f2bf(c_re[(g * 16 + c) * 64 + p]);
            CM16[((size_t)g * 16 + c) * 128 + 64 + p] = (bf16_t)f2bf(-c_im[(g * 16 + c) * 64 + p]);
        }
    }
}
template <int MODE> __device__ __forceinline__ void p_s5_pass(const int wv, const bf16_t* proj16, const float2* abar, const float2* a256, const bf16_t* BB16, const bf16_t* CM16, const float* dskip,
                                                              float2* E, bf16_t* yg16, LAS unsigned char* lds) {
    LTID();
    const int lane = tidx & 63, fr = lane & 15, fq = lane >> 4;
    LAS unsigned char* L = lds + wv * (16 * S5_ROWB);
    for (int unit = bidx * NW + wv; unit < S5_NCH * 32; unit += gridDim.x * NW) {
        const int g = unit & 31, chunk = unit >> 5;
        const float2 a = abar[g * 64 + lane];
        bf16x4 bbf[8];
#pragma unroll
        for (int cb = 0; cb < 8; ++cb) bbf[cb] = *(const bf16x4*)(BB16 + ((size_t)g * 128 + 16 * cb + fr) * 16 + 4 * fq);
        bf16x8 cmf[4]; f32x4 dsk = (f32x4){0.f, 0.f, 0.f, 0.f};
        if (MODE == 1) {
#pragma unroll
            for (int s4 = 0; s4 < 4; ++s4) cmf[s4] = *(const bf16x8*)(CM16 + ((size_t)g * 16 + fr) * 128 + 32 * s4 + 8 * fq);
            dsk = *(const f32x4*)(dskip + g * 16 + 4 * fq);
        }
        float sr = 0.f, si = 0.f;
        if (MODE == 1) {
            const float2 A = a256[g * 64 + lane];
            for (int j0 = 0; j0 < chunk; j0 += 8) {
                float2 e[8];
#pragma unroll
                for (int k = 0; k < 8; ++k) { const int j = (j0 + k < chunk) ? j0 + k : chunk - 1; e[k] = E[((size_t)j * 32 + g) * 64 + lane]; }
#pragma unroll
                for (int k = 0; k < 8; ++k) if (j0 + k < chunk) { const float nr = A.x * sr - A.y * si + e[k].x, ni = A.x * si + A.y * sr + e[k].y; sr = nr; si = ni; }
            }
        }
        const bf16_t* ubase = proj16 + (size_t)(chunk * S5_CHUNK + fr) * DIN + 1536 + g * 16 + 4 * fq;
        bf16x4 uf = *(const bf16x4*)ubase;
#pragma unroll 1
        for (int blk = 0; blk < S5_CHUNK / 16; ++blk) {
            const bf16x4 ufn = *(const bf16x4*)(ubase + (size_t)((blk < S5_CHUNK / 16 - 1) ? (blk + 1) * 16 : blk * 16) * DIN);
            asm volatile("" ::: "memory");
#pragma unroll
            for (int cb = 0; cb < 8; ++cb) {
                const f32x4 d = __builtin_amdgcn_mfma_f32_16x16x16bf16_1k(bbf[cb], uf, (f32x4){0.f, 0.f, 0.f, 0.f}, 0, 0, 0);
                *(LAS f32x4*)(L + fr * S5_ROWB + (16 * cb + 4 * fq) * 4) = d;
            }
            asm volatile("" ::: "memory");
#pragma unroll
            for (int t = 0; t < 16; ++t) {
                const float re = *(const LAS float*)(L + t * S5_ROWB + lane * 4), im = *(const LAS float*)(L + t * S5_ROWB + 256 + lane * 4);
                const float nr = a.x * sr - a.y * si + re, ni = a.x * si + a.y * sr + im; sr = nr; si = ni;
                if (MODE == 1) { *(LAS bf16_t*)(L + t * S5_ROWB + lane * 2) = (bf16_t)f2bf(sr); *(LAS bf16_t*)(L + t * S5_ROWB + 128 + lane * 2) = (bf16_t)f2bf(si); }
            }
            asm volatile("" ::: "memory");
            if (MODE == 1) {
                f32x4 y = (f32x4){0.f, 0.f, 0.f, 0.f};
#pragma unroll
                for (int s4 = 0; s4 < 4; ++s4) { const bf16x8 sf = *(const LAS bf16x8*)(L + fr * S5_ROWB + 64 * s4 + 16 * fq); y = __builtin_amdgcn_mfma_f32_16x16x32_bf16(cmf[s4], sf, y, 0, 0, 0); }
                f32x4 v;
#pragma unroll
                for (int j = 0; j < 4; ++j) v[j] = y[j] + dsk[j] * bf2f((unsigned short)uf[j]);
                const f32x2 g0 = gelu_pk((f32x2){v[0], v[1]}), g1 = gelu_pk((f32x2){v[2], v[3]});
                u32x2 o2; o2.x = cvt_pk_bf16(g0.x, g0.y); o2.y = cvt_pk_bf16(g1.x, g1.y);
                *(u32x2*)(yg16 + (size_t)(chunk * S5_CHUNK + blk * 16 + fr) * 512 + g * 16 + 4 * fq) = o2;
            }
            asm volatile("" ::: "memory");
            uf = ufn;
        }
        if (MODE == 0) E[((size_t)chunk * 32 + g) * 64 + lane] = make_float2(sr, si);
    }
}
struct EpiGlu16 {
    static constexpr bool PERM = true;
    bf16_t* O; const bf16_t* Y; const float* bias;
    __device__ __forceinline__ void operator()(const f32x4 (&acc)[2][2][4][2], const GUnit& u, int wr, int wc, int fr, int fq) const {
        const int row0 = u.pm * BM + wr * 64 + fr, col0 = u.pn * BM + wc * 32 + 8 * fq;
        f32x4 bv[2][2];
#pragma unroll
        for (int bj = 0; bj < 2; ++bj)
#pragma unroll
            for (int n = 0; n < 2; ++n) bv[bj][n] = *(const f32x4*)(bias + col0 + bj * HALF + 4 * n);
#pragma unroll
        for (int ai = 0; ai < 2; ++ai)
#pragma unroll
            for (int m = 0; m < 4; ++m) { const size_t ro = (size_t)(row0 + ai * HALF + m * 16) * 512 + col0;
#pragma unroll
                for (int bj = 0; bj < 2; ++bj) {
                    const u32x4 yv = *(const u32x4*)(Y + ro + bj * HALF);
                    float o[8];
#pragma unroll
                    for (int n = 0; n < 2; ++n)
#pragma unroll
                        for (int j = 0; j < 4; ++j) { const unsigned wd = yv[n * 2 + (j >> 1)]; const float y = __builtin_bit_cast(float, (j & 1) ? (wd & 0xffff0000u) : (wd << 16));
                            o[n * 4 + j] = y / (1.f + __expf(-(acc[ai][bj][m][n][j] + bv[bj][n][j]))); }
                    u32x4 w; w.x = cvt_pk_bf16(o[0], o[1]); w.y = cvt_pk_bf16(o[2], o[3]); w.z = cvt_pk_bf16(o[4], o[5]); w.w = cvt_pk_bf16(o[6], o[7]);
                    *(u32x4*)(O + ro + bj * HALF) = w; } }
    }
};
__device__ __forceinline__ void p_ssm_norm(const int wv, const bf16_t* yb16, const float* g, bf16_t* mix16) {
    LTID();
    const int lane = tidx & 63;
    const f32x4 g0 = *(const f32x4*)(g + lane * 8), g1 = *(const f32x4*)(g + lane * 8 + 4);
    for (int row = bidx * NW + wv; row < SEQ; row += gridDim.x * NW) {
        const u32x4 a0 = *(const u32x4*)(yb16 + (size_t)row * 512 + lane * 8);
        float y[8]; float ss = 0.f;
#pragma unroll
        for (int k = 0; k < 4; ++k) { y[2 * k] = __builtin_bit_cast(float, a0[k] << 16); y[2 * k + 1] = __builtin_bit_cast(float, a0[k] & 0xffff0000u); ss += y[2 * k] * y[2 * k] + y[2 * k + 1] * y[2 * k + 1]; }
#pragma unroll
        for (int o = 32; o; o >>= 1) ss += shx(ss, o, lane);
        const float sc = rsqrtf(ss * (1.f / 512.f) + 1e-5f);
        u32x4 o4; o4.x = cvt_pk_bf16(y[0] * sc * g0[0], y[1] * sc * g0[1]); o4.y = cvt_pk_bf16(y[2] * sc * g0[2], y[3] * sc * g0[3]);
        o4.z = cvt_pk_bf16(y[4] * sc * g1[0], y[5] * sc * g1[1]); o4.w = cvt_pk_bf16(y[6] * sc * g1[2], y[7] * sc * g1[3]);
        *(u32x4*)(mix16 + (size_t)row * DM + 512 + lane * 8) = o4;
    }
}

__device__ __forceinline__ void p_rmsnorm16(const int wv, const float* in, const float* g, bf16_t* out16, int rows) {
    LTID();
    const int lane = tidx & 63;
    for (int r = bidx * NW + wv; r < rows; r += gridDim.x * NW) {
        f32x4 v[4]; float ss = 0.f;
#pragma unroll
        for (int j = 0; j < 4; ++j) { v[j] = *(const f32x4*)(in + (size_t)r * DM + 4 * lane + 256 * j); ss += (v[j][0] * v[j][0] + v[j][1] * v[j][1]) + (v[j][2] * v[j][2] + v[j][3] * v[j][3]); }
#pragma unroll
        for (int o = 32; o; o >>= 1) ss += shx(ss, o, lane);
        const float sc = rsqrtf(ss * (1.f / 1024.f) + 1e-5f);
#pragma unroll
        for (int j = 0; j < 4; ++j) { const f32x4 gg = *(const f32x4*)(g + 4 * lane + 256 * j); u32x2 o2; o2.x = cvt_pk_bf16(v[j][0] * sc * gg[0], v[j][1] * sc * gg[1]); o2.y = cvt_pk_bf16(v[j][2] * sc * gg[2], v[j][3] * sc * gg[3]);
            *(u32x2*)(out16 + (size_t)r * DM + 4 * lane + 256 * j) = o2; }
    }
}
template <bool MOE, bool LAST> __device__ __forceinline__ void p_rowfinish(const int wv, const float* hin, float* h, const bf16_t* mout, const int* eslot, const float* topg, const float* g, bf16_t* xn16, float* out) {
    LTID();
    const int lane = tidx & 63;
    LAS const int* ts = (LAS const int*)(LDSP + TS_OFF);
    for (int r = bidx * NW + wv; r < SEQ; r += gridDim.x * NW) {
        f32x4 v[4];
#pragma unroll
        for (int j = 0; j < 4; ++j) v[j] = *(const f32x4*)(hin + (size_t)r * DM + 4 * lane + 256 * j);
        if (MOE) {
            const int4 es = *(const int4*)(eslot + r * 4); const f32x4 gt = *(const f32x4*)(topg + r * 4);
            const int esv[4] = {es.x, es.y, es.z, es.w};
#pragma unroll
            for (int k = 0; k < 4; ++k) {
                const int e = esv[k] >> 16, sl = esv[k] & 0xffff; const size_t row = (size_t)ts[e] * BM + sl; const float gk = gt[k];
#pragma unroll
                for (int j = 0; j < 4; ++j) { const u32x2 o = *(const u32x2*)(mout + row * DM + 4 * lane + 256 * j);
                    v[j][0] += gk * __builtin_bit_cast(float, o.x << 16); v[j][1] += gk * __builtin_bit_cast(float, o.x & 0xffff0000u);
                    v[j][2] += gk * __builtin_bit_cast(float, o.y << 16); v[j][3] += gk * __builtin_bit_cast(float, o.y & 0xffff0000u); }
            }
        }
        float ss = 0.f;
#pragma unroll
        for (int j = 0; j < 4; ++j) ss += (v[j][0] * v[j][0] + v[j][1] * v[j][1]) + (v[j][2] * v[j][2] + v[j][3] * v[j][3]);
#pragma unroll
        for (int o = 32; o; o >>= 1) ss += shx(ss, o, lane);
        const float sc = rsqrtf(ss * (1.f / 1024.f) + 1e-5f);
#pragma unroll
        for (int j = 0; j < 4; ++j) {
            const f32x4 gg = *(const f32x4*)(g + 4 * lane + 256 * j);
            if (!LAST) { *(f32x4*)(h + (size_t)r * DM + 4 * lane + 256 * j) = v[j];
                u32x2 o2; o2.x = cvt_pk_bf16(v[j][0] * sc * gg[0], v[j][1] * sc * gg[1]); o2.y = cvt_pk_bf16(v[j][2] * sc * gg[2], v[j][3] * sc * gg[3]);
                *(u32x2*)(xn16 + (size_t)r * DM + 4 * lane + 256 * j) = o2; }
            else *(f32x4*)(out + (size_t)r * DM + 4 * lane + 256 * j) = (f32x4){v[j][0] * sc * gg[0], v[j][1] * sc * gg[1], v[j][2] * sc * gg[2], v[j][3] * sc * gg[3]};
        }
    }
}
__device__ __forceinline__ void p_router_tables(const int wv, const float* w_r, const float* g, bf16_t* WR16) {
    LTID();
    for (int i = bidx * NT + tidx; i < 32 * 1024; i += gridDim.x * NT) {
        const int e = i >> 10, k = i & 1023;
        const float w = g[k] * w_r[k * 32 + e];
        const unsigned hi = f2bf(w); const float lo = w - __builtin_bit_cast(float, hi << 16);
        WR16[i] = (bf16_t)hi; WR16[32 * 1024 + i] = (bf16_t)f2bf(lo);
    }
}
constexpr int RT_CNT_OFF = 131072 + 4608;
constexpr int RT_XCH_OFF = 131072 + 5120;
__device__ __forceinline__ void p_router2(const int wv, const float* h, const bf16_t* WR16, const float* b_r, bf16_t* hb16, unsigned* gcnt, int* rowtok_e, float* rsc_e, int* eslot, float* topg, LAS unsigned char* lds) {
    LTID();
    const int lane = tidx & 63, fr = lane & 15, fq = lane >> 4, w = wv, tg = w & 3, kh = w >> 2;
#pragma unroll
    for (int part = 0; part < 2; ++part)
#pragma unroll
        for (int p = 0; p < 8; ++p) { const int row = 4 * p + (tidx >> 7), cs = tidx & 127;
            glds16s(WR16, (unsigned)(part * 65536 + row * 2048 + ((cs ^ (row & 15)) * 16)), (unsigned)(size_t)(lds + part * 65536 + p * 8192 + w * 1024)); }
    LAS int* lcnt = (LAS int*)(lds + RT_CNT_OFF);
    if (tidx < 64) lcnt[tidx] = 0;
    asm volatile("s_waitcnt vmcnt(0)" ::: "memory");
    __syncthreads();
    for (int it = bidx; it < SEQ / 64; it += gridDim.x) {
        const int token = it * 64 + 16 * tg + fr;
        const float* xr = h + (size_t)token * DM + 512 * kh + 8 * fq;
        bf16_t* hb = hb16 + (size_t)token * DM + 512 * kh + 8 * fq;
        f32x4 acc[2]; acc[0] = (f32x4){0.f, 0.f, 0.f, 0.f}; acc[1] = acc[0];
        float ss = 0.f;
#pragma unroll 4
        for (int s4 = 0; s4 < 16; ++s4) {
            const f32x4 x0 = *(const f32x4*)(xr + 32 * s4), x1 = *(const f32x4*)(xr + 32 * s4 + 4);
            ss += (x0[0] * x0[0] + x0[1] * x0[1]) + (x0[2] * x0[2] + x0[3] * x0[3]) + (x1[0] * x1[0] + x1[1] * x1[1]) + (x1[2] * x1[2] + x1[3] * x1[3]);
            u32x4 hw; hw.x = cvt_pk_bf16(x0[0], x0[1]); hw.y = cvt_pk_bf16(x0[2], x0[3]); hw.z = cvt_pk_bf16(x1[0], x1[1]); hw.w = cvt_pk_bf16(x1[2], x1[3]);
            *(u32x4*)(hb + 32 * s4) = hw;
            u32x4 lw;
            lw.x = cvt_pk_bf16(x0[0] - __builtin_bit_cast(float, hw.x << 16), x0[1] - __builtin_bit_cast(float, hw.x & 0xffff0000u));
            lw.y = cvt_pk_bf16(x0[2] - __builtin_bit_cast(float, hw.y << 16), x0[3] - __builtin_bit_cast(float, hw.y & 0xffff0000u));
            lw.z = cvt_pk_bf16(x1[0] - __builtin_bit_cast(float, hw.z << 16), x1[1] - __builtin_bit_cast(float, hw.z & 0xffff0000u));
            lw.w = cvt_pk_bf16(x1[2] - __builtin_bit_cast(float, hw.w << 16), x1[3] - __builtin_bit_cast(float, hw.w & 0xffff0000u));
            const bf16x8 xhi = __builtin_bit_cast(bf16x8, hw), xlo = __builtin_bit_cast(bf16x8, lw);
            const int c = 64 * kh + 4 * s4 + fq, slot = c ^ fr;
#pragma unroll
            for (int nb = 0; nb < 2; ++nb) {
                const bf16x8 whi = *(const LAS bf16x8*)(lds + (16 * nb + fr) * 2048 + slot * 16), wlo = *(const LAS bf16x8*)(lds + 65536 + (16 * nb + fr) * 2048 + slot * 16);
                acc[nb] = __builtin_amdgcn_mfma_f32_16x16x32_bf16(whi, xhi, acc[nb], 0, 0, 0);
                acc[nb] = __builtin_amdgcn_mfma_f32_16x16x32_bf16(whi, xlo, acc[nb], 0, 0, 0);
                acc[nb] = __builtin_amdgcn_mfma_f32_16x16x32_bf16(wlo, xhi, acc[nb], 0, 0, 0);
            }
        }
        ss += shx(ss, 16, lane); ss += shx(ss, 32, lane);
        LAS float* X = (LAS float*)(lds + RT_XCH_OFF) + (tg * 64 + lane) * 9;
        if (kh == 1) {
#pragma unroll
            for (int nb = 0; nb < 2; ++nb)
#pragma unroll
                for (int j = 0; j < 4; ++j) X[nb * 4 + j] = acc[nb][j];
            X[8] = ss;
        }
        __syncthreads();
        int ti[4] = {0, 0, 0, 0}, ls[4] = {0, 0, 0, 0}; float gv[4] = {0.f, 0.f, 0.f, 0.f}; float rs = 0.f;
        if (kh == 0) {
            float lv[8];
            ss += X[8];
            rs = rsqrtf(ss * (1.f / 1024.f) + 1e-5f);
#pragma unroll
            for (int nb = 0; nb < 2; ++nb)
#pragma unroll
                for (int j = 0; j < 4; ++j) lv[nb * 4 + j] = rs * (acc[nb][j] + X[nb * 4 + j]) + b_r[16 * nb + 4 * fq + j];
            float tv[4];
#pragma unroll
            for (int r = 0; r < 4; ++r) {
                float bv = -3.0e38f; int bi = 0;
#pragma unroll
                for (int q = 0; q < 8; ++q) { const int idx = 16 * (q >> 2) + 4 * fq + (q & 3); if (lv[q] > bv) { bv = lv[q]; bi = idx; } }
#pragma unroll
                for (int mk = 16; mk <= 32; mk <<= 1) { const float ov = shx(bv, mk, lane); const int oi = shxi(bi, mk, lane); if (ov > bv || (ov == bv && oi < bi)) { bv = ov; bi = oi; } }
                tv[r] = bv; ti[r] = bi;
#pragma unroll
                for (int q = 0; q < 8; ++q) { const int idx = 16 * (q >> 2) + 4 * fq + (q & 3); if (idx == bi) lv[q] = -3.0e38f; }
            }
            float sum = 0.f;
#pragma unroll
            for (int r = 0; r < 4; ++r) { gv[r] = __expf(tv[r] - tv[0]); sum += gv[r]; }
            const float inv = 1.f / sum;
#pragma unroll
            for (int r = 0; r < 4; ++r) gv[r] *= inv;
            if (fq == 0) {
#pragma unroll
                for (int r = 0; r < 4; ++r) ls[r] = __hip_atomic_fetch_add(&lcnt[ti[r]], 1, __ATOMIC_RELAXED, __HIP_MEMORY_SCOPE_WORKGROUP);
            }
        }
        __syncthreads();
        if (tidx < 32) { const int c = lcnt[tidx]; lcnt[32 + tidx] = c ? (int)__hip_atomic_fetch_add(gcnt + tidx, (unsigned)c, __ATOMIC_RELAXED, __HIP_MEMORY_SCOPE_AGENT) : 0; }
        __syncthreads();
        if (kh == 0 && fq == 0) {
            int es[4];
#pragma unroll
            for (int r = 0; r < 4; ++r) { const int e = ti[r], sl = lcnt[32 + e] + ls[r]; rowtok_e[e * ECAP + sl] = token; rsc_e[e * ECAP + sl] = rs; es[r] = (e << 16) | sl; }
            *(int4*)(eslot + token * 4) = make_int4(es[0], es[1], es[2], es[3]);
            *(f32x4*)(topg + token * 4) = (f32x4){gv[0], gv[1], gv[2], gv[3]};
        }
        __syncthreads();
        if (tidx < 32) lcnt[tidx] = 0;
    }
    __syncthreads();
}

constexpr int NPL = 13;
constexpr int NPHASES = 1 + 2 * NPL;
typedef const __attribute__((address_space(4))) Args* KA;
#define PHASE __device__ __forceinline__
#define KAP() ({ KA _t = a; asm volatile("" : "+s"(_t)); _t; })
#define WSP(T, off) ((T*)(a->ws + (off)))

PHASE void ph_init(KA a, const int wv) {
    p_rowfinish<false, false>(wv, a->in[0], WSP(float, WS_H), nullptr, nullptr, nullptr, a->in[3], WSP(bf16_t, WS_XN16), nullptr);
    p_bias_table(wv, a->in[2], WSP(float, WS_BIASG));
    for (int l = 0; l < 2; ++l) {
        p_s5_tables2(wv, a->in[5] + l * 2048, a->in[6] + l * 2048, a->in[7] + l * 32768, a->in[8] + l * 32768, a->in[9] + l * 32768, a->in[10] + l * 32768, a->in[11] + l * 32,
                     WSP(float2, WS_ABAR) + l * 2048, WSP(float2, WS_A256) + l * 2048, WSP(bf16_t, WS_BB16) + (size_t)l * 32 * 128 * 16, WSP(bf16_t, WS_CM16) + (size_t)l * 32 * 16 * 128);
        p_rmsnorm16(wv, a->in[1], a->in[19] + l * DM, WSP(bf16_t, WS_MEMN16) + (size_t)l * NMEM * DM, NMEM);
        p_router_tables(wv, a->in[24] + (size_t)l * DM * 32, a->in[23] + l * DM, WSP(bf16_t, WS_WR16) + (size_t)l * 2 * 32 * 1024);
    }
    p_transpose(wv, a->in[4], 2, DM, DIN, WSP(bf16_t, WS_WT_IN), nullptr, 1, 0, LDSP);
    p_transpose(wv, a->in[13], 2, 512, 512, WSP(bf16_t, WS_WT_GLU), nullptr, 1, 0, LDSP);
    p_transpose(wv, a->in[17], 2, DM, DM, WSP(bf16_t, WS_WT_OUT), nullptr, 1, 0, LDSP);
    p_transpose(wv, a->in[20], 2, DM, 512, WSP(bf16_t, WS_WT_XQ), a->in[18], 1, 0, LDSP);
    p_transpose(wv, a->in[21], 2, DM, 1024, WSP(bf16_t, WS_WT_XKV), nullptr, 1, 0, LDSP);
    p_transpose(wv, a->in[22], 2, 512, DM, WSP(bf16_t, WS_WT_XO), nullptr, 1, 0, LDSP);
    p_transpose(wv, a->in[26], 2 * NEXP, DM, 2048, WSP(bf16_t, WS_BT1), a->in[23], NEXP, 1, LDSP);
    p_transpose(wv, a->in[28], 2 * NEXP, DFF, DM, WSP(bf16_t, WS_BT2), nullptr, 1, 0, LDSP);
    __syncthreads();
}
PHASE void ph_gemm_in(KA a, const int wv, int l) { LTID();
    DenseOrder S; S.init(WSP(bf16_t, WS_XN16), WSP(bf16_t, WS_WT_IN) + (size_t)l * DIN * DM, SEQ, DIN, DM, gridDim.x, bidx);
    EpiIn E{WSP(bf16_t, WS_PROJ16)};
    gemm_phase<EpiIn, DenseOrder, false, true>(LDSP, DM, S, E, tidx, wv);
}
PHASE void ph_attn_s5a(KA a, const int wv, int l) {
    p_dil_attn(wv, WSP(bf16_t, WS_PROJ16), WSP(float, WS_BIASG), WSP(bf16_t, WS_OBR), WSP(float, WS_LSE), LDSP);
    p_s5_pass<0>(wv, WSP(bf16_t, WS_PROJ16), WSP(float2, WS_ABAR) + l * 2048, WSP(float2, WS_A256) + l * 2048, WSP(bf16_t, WS_BB16) + (size_t)l * 32 * 128 * 16, WSP(bf16_t, WS_CM16) + (size_t)l * 32 * 16 * 128,
                 a->in[12] + l * 512, WSP(float2, WS_E2), WSP(bf16_t, WS_YG16), LDSP);
}
PHASE void ph_s5b(KA a, const int wv, int l) {
    p_s5_pass<1>(wv, WSP(bf16_t, WS_PROJ16), WSP(float2, WS_ABAR) + l * 2048, WSP(float2, WS_A256) + l * 2048, WSP(bf16_t, WS_BB16) + (size_t)l * 32 * 128 * 16, WSP(bf16_t, WS_CM16) + (size_t)l * 32 * 16 * 128,
                 a->in[12] + l * 512, WSP(float2, WS_E2), WSP(bf16_t, WS_YG16), LDSP);
}
PHASE void ph_gemm_glu(KA a, const int wv, int l) {
    {   LTID();
        DenseOrder S; S.init(WSP(bf16_t, WS_YG16), WSP(bf16_t, WS_WT_GLU) + (size_t)l * 512 * 512, SEQ, 512, 512, gridDim.x, bidx);
        EpiGlu16 E{WSP(bf16_t, WS_YB16), WSP(bf16_t, WS_YG16), a->in[14] + l * 512};
        gemm_phase<EpiGlu16, DenseOrder, false, false>(LDSP, 512, S, E, tidx, wv); }
    {   LTID();
    const int cc = (int)gridDim.x - 1 - bidx;
    if (l == 0 && cc < 8) {
        const int kl = cc >> 2;
        DenseOrder S; S.init(WSP(bf16_t, WS_MEMN16) + (size_t)kl * NMEM * DM, WSP(bf16_t, WS_WT_XKV) + (size_t)kl * 1024 * DM, NMEM, 1024, DM, 4, cc & 3);
        EpiBf16 E{WSP(bf16_t, WS_KV16) + (size_t)kl * NMEM * 1024, 1024, 1.f, nullptr};
        gemm_phase<EpiBf16, DenseOrder, false, false>(LDSP, DM, S, E, tidx, wv);
    } }
}
PHASE void ph_mixnorm(KA a, const int wv, int l) {
    p_attn_combine(wv, WSP(bf16_t, WS_OBR), WSP(float, WS_LSE), a->in[15] + l * 512, WSP(bf16_t, WS_MIX16));
    p_ssm_norm(wv, WSP(bf16_t, WS_YB16), a->in[16] + l * 512, WSP(bf16_t, WS_MIX16));
}
PHASE void ph_gemm_out(KA a, const int wv, int l) { LTID();
    DenseOrder S; S.init(WSP(bf16_t, WS_MIX16), WSP(bf16_t, WS_WT_OUT) + (size_t)l * DM * DM, SEQ, DM, DM, gridDim.x, bidx);
    EpiOut E{WSP(float, WS_H), WSP(bf16_t, WS_HB16), WSP(float, WS_SSP)};
    gemm_phase<EpiOut, DenseOrder, false, false>(LDSP, DM, S, E, tidx, wv);
}
PHASE void ph_gemm_xq(KA a, const int wv, int l) { LTID();
    DenseOrder S; S.init(WSP(bf16_t, WS_HB16), WSP(bf16_t, WS_WT_XQ) + (size_t)l * 512 * DM, SEQ, 512, DM, gridDim.x, bidx);
    EpiBf16 E{WSP(bf16_t, WS_QX16), 512, 0.08838834764831845f, WSP(float, WS_SSP)};
    gemm_phase<EpiBf16, DenseOrder, false, false>(LDSP, DM, S, E, tidx, wv);
}
PHASE void ph_xattn(KA a, const int wv, int l) { p_xattn_mfma(wv, WSP(bf16_t, WS_QX16), WSP(bf16_t, WS_KV16) + (size_t)l * NMEM * 1024, WSP(bf16_t, WS_OX16), LDSP); }
PHASE void ph_gemm_xo(KA a, const int wv, int l) { LTID();
    DenseOrder S; S.init(WSP(bf16_t, WS_OX16), WSP(bf16_t, WS_WT_XO) + (size_t)l * DM * 512, SEQ, DM, 512, gridDim.x, bidx);
    EpiF32 E{WSP(float, WS_H), DM, 1};
    gemm_phase<EpiF32, DenseOrder, false, false>(LDSP, 512, S, E, tidx, wv);
}
PHASE void ph_router(KA a, const int wv, int l) {
    p_router2(wv, WSP(float, WS_H), WSP(bf16_t, WS_WR16) + (size_t)l * 2 * 32 * 1024, a->in[25] + l * 32, WSP(bf16_t, WS_HB16), WSP(unsigned, WS_CTL) + CW_CNT + l * 32,
              WSP(int, WS_ROWTOK), WSP(float, WS_RSC), WSP(int, WS_ESLOT), WSP(float, WS_TOPG), LDSP);
}
PHASE void ph_moe1(KA a, const int wv, int l) { LTID();
    moe_tiles(WSP(unsigned, WS_CTL) + CW_CNT + l * 32, tidx);
    MoeOrder<true> S; S.init(WSP(bf16_t, WS_HB16), WSP(bf16_t, WS_BT1) + (size_t)l * NEXP * 2048 * DM, WSP(int, WS_ROWTOK), 2048, DM, (size_t)2048 * DM * 2, gridDim.x, bidx);
    EpiMoe1 E{WSP(bf16_t, WS_ACT), a->in[27] + (size_t)l * NEXP * 2048, WSP(float, WS_RSC)};
    gemm_phase<EpiMoe1, MoeOrder<true>, true, true>(LDSP, DM, S, E, tidx, wv);
}
PHASE void ph_moe2(KA a, const int wv, int l) { LTID();
    moe_tiles(WSP(unsigned, WS_CTL) + CW_CNT + l * 32, tidx);
    MoeOrder<false> S; S.init(WSP(bf16_t, WS_ACT), WSP(bf16_t, WS_BT2) + (size_t)l * NEXP * DM * DFF, nullptr, DM, DFF, (size_t)DM * DFF * 2, gridDim.x, bidx);
    EpiMoe2 E{WSP(bf16_t, WS_MOUT), a->in[29] + (size_t)l * NEXP * DM};
    gemm_phase<EpiMoe2, MoeOrder<false>, false, true>(LDSP, DFF, S, E, tidx, wv);
}
PHASE void ph_combine(KA a, const int wv, int l) { LTID();
    moe_tiles(WSP(unsigned, WS_CTL) + CW_CNT + l * 32, tidx);
    if (l == 0) p_rowfinish<true, false>(wv, WSP(float, WS_H), WSP(float, WS_H), WSP(bf16_t, WS_MOUT), WSP(int, WS_ESLOT), WSP(float, WS_TOPG), a->in[3] + DM, WSP(bf16_t, WS_XN16), nullptr);
    else p_rowfinish<true, true>(wv, WSP(float, WS_H), nullptr, WSP(bf16_t, WS_MOUT), WSP(int, WS_ESLOT), WSP(float, WS_TOPG), a->in[30], nullptr, a->out);
}

__global__ void __launch_bounds__(NT, 2) mega(Args args) {
    KA a = (KA)__builtin_amdgcn_kernarg_segment_ptr();
    int wv = __builtin_amdgcn_readfirstlane((int)threadIdx.x >> 6); asm volatile("" : "+s"(wv));
    LAS unsigned char* lds = LDSP;
    volatile LAS unsigned* MISC = (volatile LAS unsigned*)(lds + MISC_OFF);
    unsigned* ctl = (unsigned*)(a->ws + WS_CTL);
    if (threadIdx.x < 32) MISC[threadIdx.x] = 0u;
    __syncthreads();
    XcdBarrier bar; bar.bar = ctl + CW_BAR; bar.x = 0; bar.st = nullptr;
    if (!MK_PER_PHASE) bar = xcd_barrier_post(ctl + CW_BAR, MISC + 8);
    const int lo = a->ph_lo, hi = a->ph_hi;
#define IN(k) (lo <= (k) && (k) < hi)
#define SEAM(k) do { if (IN(k) && IN((k) + 1)) { LTID(); xcd_barrier(bar.bar, bar.x, bar.st, tidx == 0); } } while (0)
    if (IN(0)) { ph_init(KAP(), wv); if (PROBE_DUP == 100) ph_init(KAP(), wv); }
    SEAM(0);
#define LAYER_PROGRAM(l) { const int pb = 1 + (l) * NPL; \
        if (IN(pb + 0)) { ph_gemm_in(KAP(), wv, (l)); if (PROBE_DUP == 0) { ph_gemm_in(KAP(), wv, (l)); } } \
        SEAM(pb + 0); \
        if (IN(pb + 1)) { ph_attn_s5a(KAP(), wv, (l)); if (PROBE_DUP == 1) { ph_attn_s5a(KAP(), wv, (l)); } } \
        SEAM(pb + 1); \
        if (IN(pb + 2)) { ph_s5b(KAP(), wv, (l)); if (PROBE_DUP == 2) { ph_s5b(KAP(), wv, (l)); } } \
        SEAM(pb + 2); \
        if (IN(pb + 3)) { ph_gemm_glu(KAP(), wv, (l)); if (PROBE_DUP == 3) { ph_gemm_glu(KAP(), wv, (l)); } } \
        SEAM(pb + 3); \
        if (IN(pb + 4)) { ph_mixnorm(KAP(), wv, (l)); if (PROBE_DUP == 4) { ph_mixnorm(KAP(), wv, (l)); } } \
        SEAM(pb + 4); \
        if (IN(pb + 5)) { ph_gemm_out(KAP(), wv, (l)); if (PROBE_DUP == 5) { ph_gemm_out(KAP(), wv, (l)); } } \
        SEAM(pb + 5); \
        if (IN(pb + 6)) { ph_gemm_xq(KAP(), wv, (l)); if (PROBE_DUP == 6) { ph_gemm_xq(KAP(), wv, (l)); } } \
        SEAM(pb + 6); \
        if (IN(pb + 7)) { ph_xattn(KAP(), wv, (l)); if (PROBE_DUP == 7) { ph_xattn(KAP(), wv, (l)); } } \
        SEAM(pb + 7); \
        if (IN(pb + 8)) { ph_gemm_xo(KAP(), wv, (l)); if (PROBE_DUP == 8) { ph_gemm_xo(KAP(), wv, (l)); } } \
        SEAM(pb + 8); \
        if (IN(pb + 9)) { ph_router(KAP(), wv, (l)); if (PROBE_DUP == 9) { ph_router(KAP(), wv, (l)); } } \
        SEAM(pb + 9); \
        if (IN(pb + 10)) { ph_moe1(KAP(), wv, (l)); if (PROBE_DUP == 10) { ph_moe1(KAP(), wv, (l)); } } \
        SEAM(pb + 10); \
        if (IN(pb + 11)) { ph_moe2(KAP(), wv, (l)); if (PROBE_DUP == 11) { ph_moe2(KAP(), wv, (l)); } } \
        SEAM(pb + 11); \
        if (IN(pb + 12)) { ph_combine(KAP(), wv, (l)); if (PROBE_DUP == 12) { ph_combine(KAP(), wv, (l)); } } \
        SEAM(pb + 12); }
    LAYER_PROGRAM(0)
    LAYER_PROGRAM(1)
#undef LAYER_PROGRAM
#undef IN
#undef SEAM
}

extern "C" void kernel_launch(void* const* d_in, const int* in_sizes, int n_in, void* d_out, int out_size, void* d_ws, size_t ws_size, hipStream_t stream) {
    static int grid = 0;
    if (grid == 0) {
        if (n_in != 31 || ws_size < WS_END) { fprintf(stderr, "kernel_launch: unexpected n_in %d or ws_size %zu (need %zu)\n", n_in, ws_size, (size_t)WS_END); grid = -1; return; }
        int dev = 0, cus = 0, per_cu = 0;
        if (hipGetDevice(&dev) != hipSuccess || hipDeviceGetAttribute(&cus, hipDeviceAttributeMultiprocessorCount, dev) != hipSuccess) { grid = -1; return; }
        if (hipFuncSetAttribute((const void*)mega, hipFuncAttributeMaxDynamicSharedMemorySize, LDS_BYTES) != hipSuccess) { fprintf(stderr, "kernel_launch: hipFuncSetAttribute failed\n"); grid = -1; return; }
        if (hipOccupancyMaxActiveBlocksPerMultiprocessor(&per_cu, (const void*)mega, NT, LDS_BYTES) != hipSuccess || per_cu < 1)
            fprintf(stderr, "kernel_launch: occupancy query reports %d workgroups per CU\n", per_cu);
        (void)hipGetLastError();
        grid = cus;
    }
    if (grid < 0) return;
    if (hipMemsetAsync((char*)d_ws + WS_CTL, 0, CTL_ZERO_BYTES, stream) != hipSuccess) return;
    Args a{};
    for (int i = 0; i < 31; ++i) a.in[i] = (const float*)d_in[i];
    a.out = (float*)d_out; a.ws = (unsigned char*)d_ws;
#if MK_PER_PHASE
    for (int p = 0; p < NPHASES; ++p) { a.ph_lo = p; a.ph_hi = p + 1; hipLaunchKernelGGL(mega, dim3(grid), dim3(NT), LDS_BYTES, stream, a); }
#else
    a.ph_lo = 0; a.ph_hi = NPHASES;
    hipLaunchKernelGGL(mega, dim3(grid), dim3(NT), LDS_BYTES, stream, a);
#endif
}
```

```cpp
#include <hip/hip_runtime.h>
#include <stdint.h>
#include <cstdio>

#ifndef PROBE_DUP
#define PROBE_DUP -1
#endif
#ifndef MK_PER_PHASE
#define MK_PER_PHASE 0
#endif

#define SEQ 16384
#define DM 1024
#define DIN 2048
#define NMEM 256
#define NEXP 32
#define TOPK 4
#define DFF 1024
#define NT 512
#define NW 8

#define LAS __attribute__((address_space(3)))
typedef float f32x4 __attribute__((ext_vector_type(4)));
extern __shared__ __attribute__((aligned(16))) unsigned char lds_raw[];
#define LDSP ((LAS unsigned char*)lds_raw)
#define LTID() int z_ = 0; asm volatile("" : "+v"(z_)); const int lane_ = (int)__builtin_amdgcn_mbcnt_hi(~0u, __builtin_amdgcn_mbcnt_lo(~0u, (unsigned)z_)); \
    const int tidx = wv * 64 + lane_; int bidx = blockIdx.x; asm volatile("" : "+s"(bidx))
__device__ __forceinline__ float shx(float v, int mask, int lane) { return __builtin_bit_cast(float, __builtin_amdgcn_ds_bpermute((lane ^ mask) << 2, __builtin_bit_cast(int, v))); }
__device__ __forceinline__ int shxi(int v, int mask, int lane) { return __builtin_amdgcn_ds_bpermute((lane ^ mask) << 2, v); }
constexpr int LDS_BYTES = 147456;
constexpr int MISC_OFF = 131072 + 320;

#define XB_TMO      128
#define XB_XCNT(j)  (256  + 64 * (j))
#define XB_XSUB(j)  (1280 + 64 * (j))
#define XB_XGEN(j)  (2304 + 64 * (j))
#define XB_TOP      3328
#define XB_TOPGEN   3392
#define XCD_BAR_WORDS 3456
#define XB_SPIN_CAP (1u << 18)

__device__ __forceinline__ unsigned xb_ld(unsigned* p)              { return __hip_atomic_load(p, __ATOMIC_RELAXED, __HIP_MEMORY_SCOPE_AGENT); }
__device__ __forceinline__ unsigned xb_add(unsigned* p, unsigned v) { return __hip_atomic_fetch_add(p, v, __ATOMIC_RELAXED, __HIP_MEMORY_SCOPE_AGENT); }
__device__ __forceinline__ unsigned xb_xcc_id() { return (unsigned)__builtin_amdgcn_s_getreg((3 << 11) | 20) & 0xFu; }
#define XB_SPIN(cond, bar) do { unsigned _sp = 0; while (cond) { __builtin_amdgcn_s_sleep(1); \
    if ((++_sp & 255u) == 0u) { if (xb_ld(&(bar)[XB_TMO])) break; if (_sp > XB_SPIN_CAP) { atomicAdd(&(bar)[XB_TMO], 1u); break; } } } } while (0)

struct XcdBarrier {
    unsigned* bar; unsigned x;
    volatile LAS unsigned* st;
};
__device__ __forceinline__ XcdBarrier xcd_barrier_post(unsigned* bar, volatile LAS unsigned* st) {
    XcdBarrier b; b.bar = bar; b.x = xb_xcc_id(); b.st = st;
    if (threadIdx.x == 0) (void)xb_add(&bar[XB_XCNT(b.x)], 1u);
    return b;
}
__device__ __forceinline__ void xcd_barrier_complete(unsigned* bar, unsigned x, unsigned& nloc, unsigned& nx) {
    const unsigned G = gridDim.x * gridDim.y * gridDim.z;
    unsigned sum, cnt, mine, sp = 0u;
    for (;;) {
        sum = 0u; cnt = 0u; mine = 0u;
#pragma unroll
        for (unsigned j = 0; j < 16; ++j) { const unsigned c = xb_ld(&bar[XB_XCNT(j)]); sum += c; cnt += (c > 0u) ? 1u : 0u; mine = (j == x) ? c : mine; }
        if (sum == G) break;
        __builtin_amdgcn_s_sleep(1);
        if ((++sp & 255u) == 0u) { if (xb_ld(&bar[XB_TMO])) break; if (sp > XB_SPIN_CAP) { atomicAdd(&bar[XB_TMO], 1u); break; } }
    }
    nloc = mine > 0u ? mine : 1u; nx = cnt > 0u ? cnt : 1u;
}
__device__ __noinline__ void xcd_barrier(unsigned* bar_, unsigned x_, volatile LAS unsigned* st_, int is_t0) {
    XcdBarrier b; b.bar = bar_; b.x = x_; b.st = st_;
    asm volatile("s_waitcnt vmcnt(0)" ::: "memory");
    __syncthreads();
    if (is_t0) {
        unsigned* bar = b.bar;
        __builtin_amdgcn_s_waitcnt(0);
        unsigned nloc = b.st[0], nx = b.st[1];
        if (nloc == 0u) { xcd_barrier_complete(bar, b.x, nloc, nx); b.st[0] = nloc; b.st[1] = nx; }
        const unsigned old = xb_add(&bar[XB_XSUB(b.x)], 1u);
        const unsigned gen = old / nloc;
        if (old + 1u == (gen + 1u) * nloc) {
            __builtin_amdgcn_fence(__ATOMIC_RELEASE, "agent");
            asm volatile("s_waitcnt vmcnt(0)" ::: "memory");
            const unsigned og = xb_add(&bar[XB_TOP], 1u);
            const unsigned tg = og / nx;
            if (og + 1u == (tg + 1u) * nx) xb_add(&bar[XB_TOPGEN], 1u);
            else XB_SPIN(xb_ld(&bar[XB_TOPGEN]) == tg, bar);
            __builtin_amdgcn_fence(__ATOMIC_ACQUIRE, "agent");
            xb_add(&bar[XB_XGEN(b.x)], 1u);
            asm volatile("s_waitcnt vmcnt(0)" ::: "memory");
        } else {
            XB_SPIN(xb_ld(&bar[XB_XGEN(b.x)]) == gen, bar);
            __builtin_amdgcn_fence(__ATOMIC_ACQUIRE, "agent");
            asm volatile("s_waitcnt vmcnt(0)" ::: "memory");
        }
    }
    __syncthreads();
}

constexpr size_t MiB = 1u << 20;
constexpr size_t WS_CTL = 0, CTL_ZERO_BYTES = 1 * MiB;
constexpr int CW_BAR = 4096;
constexpr int CW_CNT = 8192;
constexpr int MOE_ROWS = SEQ * TOPK + NEXP * 256;
constexpr int ECAP = SEQ;
constexpr size_t al256(size_t x) { return (x + 255) & ~(size_t)255; }
constexpr size_t WS_H = 2 * MiB;
constexpr size_t WS_XN16 = WS_H + (size_t)SEQ * DM * 4;
constexpr size_t WS_HB16 = WS_XN16 + (size_t)SEQ * DM * 2;
constexpr size_t WS_PROJ16 = WS_HB16 + (size_t)SEQ * DM * 2;
constexpr size_t WS_OBR = WS_PROJ16 + (size_t)SEQ * 2048 * 2;
constexpr size_t WS_LSE = WS_OBR + 3 * (size_t)SEQ * 512 * 2;
constexpr size_t WS_YG16 = WS_LSE + 3 * (size_t)SEQ * 8 * 4;
constexpr size_t WS_YB16 = WS_YG16 + (size_t)SEQ * 512 * 2;
constexpr size_t WS_MIX16 = WS_YB16 + (size_t)SEQ * 512 * 2;
constexpr size_t WS_QX16 = WS_MIX16 + (size_t)SEQ * DM * 2;
constexpr size_t WS_OX16 = WS_QX16 + (size_t)SEQ * 512 * 2;
constexpr size_t WS_ACT = WS_OX16 + (size_t)SEQ * 512 * 2;
constexpr size_t WS_MOUT = WS_ACT + (size_t)MOE_ROWS * DFF * 2;
constexpr size_t WS_BT1 = WS_MOUT + (size_t)MOE_ROWS * DM * 2;
constexpr size_t WS_BT2 = WS_BT1 + 2 * (size_t)NEXP * 2048 * DM * 2;
constexpr size_t WS_WT_IN = WS_BT2 + 2 * (size_t)NEXP * DM * DFF * 2;
constexpr size_t WS_WT_GLU = WS_WT_IN + 2 * (size_t)2048 * 1024 * 2;
constexpr size_t WS_WT_OUT = WS_WT_GLU + 2 * (size_t)512 * 512 * 2;
constexpr size_t WS_WT_XQ = WS_WT_OUT + 2 * (size_t)1024 * 1024 * 2;
constexpr size_t WS_WT_XKV = WS_WT_XQ + 2 * (size_t)512 * 1024 * 2;
constexpr size_t WS_WT_XO = WS_WT_XKV + 2 * (size_t)1024 * 1024 * 2;
constexpr size_t WS_MEMN16 = WS_WT_XO + 2 * (size_t)1024 * 512 * 2;
constexpr size_t WS_KV16 = WS_MEMN16 + 2 * (size_t)NMEM * 1024 * 2;
constexpr size_t WS_WR16 = WS_KV16 + 2 * (size_t)NMEM * 1024 * 2;
constexpr size_t WS_BIASG = WS_WR16 + 2 * 2 * (size_t)32 * 1024 * 2;
constexpr size_t WS_ABAR = al256(WS_BIASG + 24 * 132 * 4);
constexpr size_t WS_A256 = WS_ABAR + 2 * 2048 * 8;
constexpr size_t WS_BB16 = WS_A256 + 2 * 2048 * 8;
constexpr size_t WS_CM16 = WS_BB16 + 2 * (size_t)32 * 128 * 16 * 2;
constexpr size_t WS_E2 = WS_CM16 + 2 * (size_t)32 * 16 * 128 * 2;
constexpr size_t WS_ROWTOK = WS_E2 + (size_t)64 * 2048 * 8;
constexpr size_t WS_RSC = WS_ROWTOK + (size_t)NEXP * ECAP * 4;
constexpr size_t WS_ESLOT = WS_RSC + (size_t)NEXP * ECAP * 4;
constexpr size_t WS_TOPG = WS_ESLOT + (size_t)SEQ * 4 * 4;
constexpr size_t WS_SSP = WS_TOPG + (size_t)SEQ * 4 * 4;
constexpr size_t WS_END = WS_SSP + (size_t)SEQ * 16 * 4;

struct Args { const float* in[31]; float* out; unsigned char* ws; int ph_lo, ph_hi; };


typedef unsigned short bf16_t;
typedef short bf16x8 __attribute__((ext_vector_type(8)));
typedef unsigned u32x4 __attribute__((ext_vector_type(4)));
typedef unsigned u32x2 __attribute__((ext_vector_type(2)));
constexpr int BM = 256, BK = 64, HALF = 128, HTB = HALF * BK * 2, STAGE_BYTES = 8 * HTB, NXCD = 8, WGM = 8;
__host__ __device__ __forceinline__ int lds_byte(int r, int c) { const int st = (r >> 4) * 2 + (c >> 5), rr = r & 15, cc = c & 31, ob = rr * 64 + cc * 2; return st * 1024 + (ob ^ (((ob >> 9) & 1) << 5)); }
__host__ __device__ __forceinline__ void stage_rc(int b, int& R, int& C) { const int st = b / 1024, sb = b % 1024, swz = sb ^ (((sb >> 9) & 1) << 5); R = (st >> 1) * 16 + swz / 64; C = (st & 1) * 32 + (swz % 64) / 2; }
__host__ __device__ __forceinline__ int perm32(int rho) { const int n = rho >> 4, i = rho & 15; return 8 * (i >> 2) + 4 * n + (i & 3); }
__device__ __forceinline__ unsigned cvt_pk_bf16(float lo, float hi) { unsigned r; asm volatile("v_cvt_pk_bf16_f32 %0, %1, %2" : "=v"(r) : "v"(lo), "v"(hi)); return r; }
__device__ __forceinline__ unsigned f2bf(float f) { unsigned u = __builtin_bit_cast(unsigned, f); return (u + 0x7fffu + ((u >> 16) & 1u)) >> 16; }
__device__ __forceinline__ unsigned pk2(float lo, float hi) { return f2bf(lo) | (f2bf(hi) << 16); }
__device__ __forceinline__ float bf2f(unsigned short b) { return __builtin_bit_cast(float, ((unsigned)b) << 16); }

__device__ __forceinline__ void glds16s(const void* sbase, unsigned voff, unsigned lds_dst) {
    unsigned keep;
    asm volatile("s_mov_b32 %0, m0\n\ts_mov_b32 m0, %3\n\ts_nop 0\n\tglobal_load_lds_dwordx4 %1, %2\n\ts_mov_b32 m0, %0" : "=&s"(keep) : "v"(voff), "s"(sbase), "s"(lds_dst) : "memory");
}
struct GUnit { const char* A; const char* B; int pm, pn, e, row0, cnt; };

struct DenseOrder {
    const char* A; const char* Bt; int nM, nN, nwg, G, c, K;
    __device__ __forceinline__ void init(const bf16_t* A_, const bf16_t* Bt_, int M, int N, int K_, int G_, int c_) { A = (const char*)A_; Bt = (const char*)Bt_; nM = M / BM; nN = N / BM; nwg = nM * nN; G = G_; c = c_; K = K_; }
    __device__ __forceinline__ bool next(int i, GUnit& u) const {
        const long L = (long)i * G + c; if (L >= nwg) return false;
        int wgid = (int)L; { const int q = nwg / NXCD, r = nwg % NXCD, xcd = wgid % NXCD, off = wgid / NXCD; wgid = (xcd < r ? xcd * (q + 1) : r * (q + 1) + (xcd - r) * q) + off; }
        const int nig = WGM * nN, gid = wgid / nig, fm = gid * WGM, gsz = (nM - fm) < WGM ? (nM - fm) : WGM;
        u.pm = fm + ((wgid % nig) % gsz); u.pn = (wgid % nig) / gsz; u.e = 0; u.row0 = 0; u.cnt = 0;
        u.A = A + (size_t)u.pm * BM * K * 2; u.B = Bt + (size_t)u.pn * BM * K * 2; return true;
    }
    __device__ __forceinline__ unsigned aoff(const GUnit&, int row) const { return (unsigned)(row * K * 2); }
    __device__ __forceinline__ unsigned tokoff(const GUnit&, int) const { return 0u; }
    __device__ __forceinline__ const int* tokbase() const { return nullptr; }
};

struct EpiF32 {
    static constexpr bool PERM = false;
    float* C; int ldc; int resid;
    __device__ __forceinline__ void operator()(const f32x4 (&acc)[2][2][4][2], const GUnit& u, int wr, int wc, int fr, int fq) const {
        const int row0 = u.pm * BM + wr * 64 + fr, col0 = u.pn * BM + wc * 32 + 4 * fq;
#pragma unroll
        for (int ai = 0; ai < 2; ++ai)
#pragma unroll
            for (int m = 0; m < 4; ++m) { float* rowp = C + (size_t)(row0 + ai * HALF + m * 16) * ldc + col0;
#pragma unroll
                for (int bj = 0; bj < 2; ++bj)
#pragma unroll
                    for (int n = 0; n < 2; ++n) { f32x4 v = acc[ai][bj][m][n]; if (resid) v += *(const f32x4*)(rowp + bj * HALF + n * 16); *(f32x4*)(rowp + bj * HALF + n * 16) = v; } }
    }
};
struct EpiGlu {
    static constexpr bool PERM = false;
    float* C; const float* Y; int ldc; const float* bias;
    __device__ __forceinline__ void operator()(const f32x4 (&acc)[2][2][4][2], const GUnit& u, int wr, int wc, int fr, int fq) const {
        const int row0 = u.pm * BM + wr * 64 + fr, col0 = u.pn * BM + wc * 32 + 4 * fq;
#pragma unroll
        for (int ai = 0; ai < 2; ++ai)
#pragma unroll
            for (int m = 0; m < 4; ++m) { const size_t ro = (size_t)(row0 + ai * HALF + m * 16) * ldc + col0;
#pragma unroll
                for (int bj = 0; bj < 2; ++bj)
#pragma unroll
                    for (int n = 0; n < 2; ++n) { const f32x4 b = *(const f32x4*)(bias + col0 + bj * HALF + n * 16); const f32x4 y = *(const f32x4*)(Y + ro + bj * HALF + n * 16);
                        f32x4 v = acc[ai][bj][m][n] + b; f32x4 o;
#pragma unroll
                        for (int j = 0; j < 4; ++j) o[j] = y[j] / (1.f + __expf(-v[j]));
                        *(f32x4*)(C + ro + bj * HALF + n * 16) = o; } }
    }
};

template <class Epi, class Sched, bool GATHER, bool ALIGN_EPI>
__device__ __forceinline__ void gemm_phase(LAS unsigned char* lds, const int K, const Sched& S, const Epi& E, const int tid, const int wv) {
    const int wid = wv, lane = tid & 63, wr = wid >> 2, wc = wid & 3, fr = lane & 15, fq = lane >> 4;
    const int nt = K / BK;
    unsigned voffB[2];
#pragma unroll
    for (int i = 0; i < 2; ++i) { int R, C; stage_rc(tid * 16 + i * 8192, R, C); const int Rb = Epi::PERM ? ((R & ~31) + perm32(R & 31)) : R; voffB[i] = (unsigned)(Rb * K + C) * 2u; }
#define PG8_AOFFS(dst, u) do { int t2_ = tid; asm volatile("" : "+v"(t2_)); _Pragma("unroll") for (int i = 0; i < 2; ++i) { int R, C; stage_rc(t2_ * 16 + i * 8192, R, C); \
        _Pragma("unroll") for (int h = 0; h < 2; ++h) dst[h][i] = S.aoff(u, h * HALF + R) + (unsigned)C * 2u; } } while (0)
    const size_t kstep = (size_t)(BK * 2);
    const size_t hstep = (size_t)HALF * K * 2;
    const unsigned ldsw = (unsigned)wid * 1024u;
    const int aoff = lds_byte(wr * 64 + fr, fq * 8), boff = lds_byte(wc * 32 + fr, fq * 8);
#define PG8_SA(b, h) (((b) * 2 + (h)) * HTB)
#define PG8_SB(b, h) ((4 + (b) * 2 + (h)) * HTB)
#define PG8_STAGE(bufoff, gbase, v0, v1) do { const unsigned ld_ = (unsigned)(size_t)(lds + (bufoff) + ldsw); glds16s((gbase), (v0), ld_); glds16s((gbase), (v1), ld_ + 8192u); } while (0)
#define PG8_LDA(dst, b, h) do { _Pragma("unroll") for (int m = 0; m < 4; ++m) _Pragma("unroll") for (int k = 0; k < 2; ++k) dst[m][k] = *(const LAS bf16x8*)(lds + PG8_SA(b, h) + aoff + m * 2048 + k * 1024); } while (0)
#define PG8_LDB(dst, b, h) do { _Pragma("unroll") for (int n = 0; n < 2; ++n) _Pragma("unroll") for (int k = 0; k < 2; ++k) dst[n][k] = *(const LAS bf16x8*)(lds + PG8_SB(b, h) + boff + n * 2048 + k * 1024); } while (0)
#define PG8_MMA(ai, bj, At, Bt) do { __builtin_amdgcn_s_setprio(1); _Pragma("unroll") for (int m = 0; m < 4; ++m) _Pragma("unroll") for (int n = 0; n < 2; ++n) _Pragma("unroll") for (int k = 0; k < 2; ++k) \
        acc[ai][bj][m][n] = __builtin_amdgcn_mfma_f32_16x16x32_bf16(Bt[n][k], At[m][k], acc[ai][bj][m][n], 0, 0, 0); __builtin_amdgcn_s_setprio(0); } while (0)
#define PG8_WAIT_V(n) asm volatile("s_waitcnt vmcnt(" #n ")" ::: "memory")
#define PG8_WAIT_L(n) asm volatile("s_waitcnt lgkmcnt(" #n ")" ::: "memory")
#define PG8_BAR __builtin_amdgcn_s_barrier()
#define PG8_SCHED __builtin_amdgcn_sched_barrier(0)
    GUnit cur, nxt; int ui = 0;
    if (!S.next(0, cur)) return;
    f32x4 acc[2][2][4][2];
#pragma unroll
    for (int a = 0; a < 2; ++a)
#pragma unroll
        for (int b = 0; b < 2; ++b)
#pragma unroll
            for (int m = 0; m < 4; ++m)
#pragma unroll
                for (int n = 0; n < 2; ++n) acc[a][b][m][n] = (f32x4){0.f, 0.f, 0.f, 0.f};
    bf16x8 At[4][2], B0[2][2], B1[2][2];
    unsigned vA[2][2], vN[2][2];
    PG8_AOFFS(vA, cur);
#pragma unroll
    for (int h = 0; h < 2; ++h)
#pragma unroll
        for (int i = 0; i < 2; ++i) vN[h][i] = vA[h][i];
    const char* cA = cur.A; const char* cB = cur.B;
    PG8_STAGE(PG8_SB(0, 0), cB, voffB[0], voffB[1]); PG8_STAGE(PG8_SB(0, 1), cB + hstep, voffB[0], voffB[1]); PG8_STAGE(PG8_SA(0, 0), cA, vA[0][0], vA[0][1]); PG8_STAGE(PG8_SA(0, 1), cA, vA[1][0], vA[1][1]);
    if (wr == 1) PG8_BAR;
    PG8_WAIT_V(2); PG8_BAR;
    PG8_STAGE(PG8_SB(1, 0), cB + kstep, voffB[0], voffB[1]); PG8_STAGE(PG8_SA(1, 0), cA + kstep, vA[0][0], vA[0][1]); PG8_STAGE(PG8_SB(1, 1), cB + hstep + kstep, voffB[0], voffB[1]);
    PG8_WAIT_V(6); PG8_BAR;
    for (;;) {
        const bool has_next = S.next(ui + 1, nxt);
        const char* nA = GATHER ? cA : (has_next ? nxt.A : cA); const char* nB = has_next ? nxt.B : cB;
        unsigned tok_[2][2] = {{0u, 0u}, {0u, 0u}};
#define PG8_KBODY(a1, a2, b2, a3, b3, W00, W01, W10, W11) do { \
              \
            PG8_LDB(B0, 0, 0); PG8_LDB(B1, 0, 1); PG8_SCHED; PG8_LDA(At, 0, 0); PG8_STAGE(PG8_SA(1, 1), a1, vA[1][0], vA[1][1]); \
            PG8_WAIT_V(8); PG8_WAIT_L(0); PG8_BAR; PG8_MMA(0, 0, At, B0); PG8_MMA(0, 1, At, B1); PG8_BAR; PG8_SCHED; \
              \
            PG8_LDA(At, 0, 1); PG8_STAGE(PG8_SB(0, 0), b2, voffB[0], voffB[1]); PG8_STAGE(PG8_SB(0, 1), (b2) + hstep, voffB[0], voffB[1]); PG8_STAGE(PG8_SA(0, 0), a2, W00, W01); \
            PG8_WAIT_V(8); PG8_WAIT_L(0); PG8_BAR; PG8_MMA(1, 0, At, B0); PG8_MMA(1, 1, At, B1); PG8_BAR; PG8_SCHED; \
              \
            PG8_LDB(B0, 1, 0); PG8_LDB(B1, 1, 1); PG8_SCHED; PG8_LDA(At, 1, 0); PG8_STAGE(PG8_SA(0, 1), a2, W10, W11); \
            PG8_WAIT_V(8); PG8_WAIT_L(0); PG8_BAR; PG8_MMA(0, 0, At, B0); PG8_MMA(0, 1, At, B1); PG8_BAR; PG8_SCHED; \
              \
            PG8_LDA(At, 1, 1); PG8_STAGE(PG8_SB(1, 0), b3, voffB[0], voffB[1]); PG8_STAGE(PG8_SB(1, 1), (b3) + hstep, voffB[0], voffB[1]); PG8_STAGE(PG8_SA(1, 0), a3, W00, W01); \
            PG8_WAIT_V(8); PG8_WAIT_L(0); PG8_BAR; PG8_MMA(1, 0, At, B0); PG8_MMA(1, 1, At, B1); PG8_BAR; PG8_SCHED; } while (0)
        for (int t = 0; t < nt - 2; t += 2) {
            const char* a1 = cA + (size_t)(t + 1) * kstep;
            const char* a2 = cA + (size_t)(t + 2) * kstep; const char* b2 = cB + (size_t)(t + 2) * kstep;
            const char* a3 = a2 + kstep; const char* b3 = b2 + kstep;
            if (GATHER) { if (t == nt - 4 && has_next) { int t2_ = tid; asm volatile("" : "+v"(t2_));
#pragma unroll
                for (int i = 0; i < 2; ++i) { int R, C; stage_rc(t2_ * 16 + i * 8192, R, C);
#pragma unroll
                    for (int h = 0; h < 2; ++h) { const unsigned vo = S.tokoff(nxt, h * HALF + R); asm volatile("global_load_dword %0, %1, %2" : "=v"(tok_[h][i]) : "v"(vo), "s"(S.tokbase()) : "memory"); } } } }
            PG8_KBODY(a1, a2, b2, a3, b3, vA[0][0], vA[0][1], vA[1][0], vA[1][1]);
        }
        if (GATHER) {
            if (has_next) { int t2_ = tid; asm volatile("" : "+v"(t2_), "+v"(tok_[0][0]), "+v"(tok_[0][1]), "+v"(tok_[1][0]), "+v"(tok_[1][1]));
#pragma unroll
                for (int i = 0; i < 2; ++i) { int R, C; stage_rc(t2_ * 16 + i * 8192, R, C);
#pragma unroll
                    for (int h = 0; h < 2; ++h) vN[h][i] = tok_[h][i] * (unsigned)(K * 2) + (unsigned)C * 2u; } }
            else {
#pragma unroll
                for (int h = 0; h < 2; ++h)
#pragma unroll
                    for (int i = 0; i < 2; ++i) vN[h][i] = vA[h][i];
            }
        }
        {
            const char* a1 = cA + (size_t)(nt - 1) * kstep;
            const char* a3 = nA + kstep; const char* b3 = nB + kstep;
            PG8_KBODY(a1, nA, nB, a3, b3, vN[0][0], vN[0][1], vN[1][0], vN[1][1]);
        }
#undef PG8_KBODY
        if constexpr (ALIGN_EPI) { if (wr == 0) PG8_BAR; }
        { int t3_ = tid; asm volatile("" : "+v"(t3_)); const int l3_ = t3_ & 63; E(acc, cur, wr, wc, l3_ & 15, l3_ >> 4); }
        if (!has_next) break;
#pragma unroll
        for (int a = 0; a < 2; ++a)
#pragma unroll
            for (int b = 0; b < 2; ++b)
#pragma unroll
                for (int m = 0; m < 4; ++m)
#pragma unroll
                    for (int n = 0; n < 2; ++n) acc[a][b][m][n] = (f32x4){0.f, 0.f, 0.f, 0.f};
        cur = nxt; cA = nA; cB = nB; ++ui;
        if (GATHER) {
#pragma unroll
            for (int h = 0; h < 2; ++h)
#pragma unroll
                for (int i = 0; i < 2; ++i) vA[h][i] = vN[h][i];
        }
        if constexpr (ALIGN_EPI) { if (wr == 1) PG8_BAR; }
    }
    PG8_WAIT_V(0);
    if constexpr (!ALIGN_EPI) { if (wr == 0) PG8_BAR; }
    PG8_BAR;
#undef PG8_AOFFS
#undef PG8_SA
#undef PG8_SB
#undef PG8_STAGE
#undef PG8_LDA
#undef PG8_LDB
#undef PG8_MMA
#undef PG8_WAIT_V
#undef PG8_WAIT_L
#undef PG8_BAR
#undef PG8_SCHED
}


constexpr int TS_OFF = 131072 + 1024;
template <bool GATHER> struct MoeOrder {
    const char* A; const char* Bt; const int* rowtok; int nN, nwg, nM, G, c, K; size_t strideE;
    __device__ __forceinline__ void init(const bf16_t* A_, const bf16_t* Bt_, const int* rowtok_, int N, int K_, size_t strideE_, int G_, int c_) {
        A = (const char*)A_; Bt = (const char*)Bt_; rowtok = rowtok_; nN = N / BM; K = K_; strideE = strideE_; G = G_; c = c_;
        nM = __builtin_amdgcn_readfirstlane(((LAS const int*)(LDSP + TS_OFF))[32]); nwg = nM * nN; }
    __device__ __forceinline__ bool next(int i, GUnit& u) const {
        const long L = (long)i * G + c; if (L >= nwg) return false;
        int wgid = (int)L; { const int q = nwg / NXCD, r = nwg % NXCD, xcd = wgid % NXCD, off = wgid / NXCD; wgid = (xcd < r ? xcd * (q + 1) : r * (q + 1) + (xcd - r) * q) + off; }
        const int nig = WGM * nN, gid = wgid / nig, fm = gid * WGM, gsz = (nM - fm) < WGM ? (nM - fm) : WGM;
        u.pm = fm + ((wgid % nig) % gsz); u.pn = (wgid % nig) / gsz;
        LAS const int* ts = (LAS const int*)(LDSP + TS_OFF);
        const int e = __builtin_amdgcn_readfirstlane(ts[72 + u.pm]);
        u.e = e; u.row0 = (u.pm - __builtin_amdgcn_readfirstlane(ts[e])) * BM; u.cnt = __builtin_amdgcn_readfirstlane(ts[33 + e]);
        u.A = GATHER ? A : A + (size_t)u.pm * BM * K * 2;
        u.B = Bt + (size_t)e * strideE + (size_t)u.pn * BM * K * 2; return true;
    }
    __device__ __forceinline__ unsigned aoff(const GUnit& u, int row) const {
        if (GATHER) { int sl = u.row0 + row; sl = sl < u.cnt ? sl : u.cnt - 1; return (unsigned)rowtok[u.e * ECAP + sl] * (unsigned)(K * 2); }
        return (unsigned)(row * K * 2);
    }
    __device__ __forceinline__ unsigned tokoff(const GUnit& u, int row) const { int sl = u.row0 + row; sl = sl < u.cnt ? sl : u.cnt - 1; return (unsigned)(u.e * ECAP + sl) * 4u; }
    __device__ __forceinline__ const int* tokbase() const { return rowtok; }
};
__device__ __forceinline__ void moe_tiles(const unsigned* cnt, int tid) {
    LAS int* ts = (LAS int*)(LDSP + TS_OFF);
    if (tid == 0) { int s = 0; for (int e = 0; e < NEXP; ++e) { const int c = (int)cnt[e]; ts[e] = s; ts[33 + e] = c; const int n = (c + BM - 1) / BM;
_Pragma("clang loop vectorize(disable) unroll(disable)") for (int t = 0; t < n; ++t) ts[72 + s + t] = e;
            s += n; } ts[NEXP] = s; }
    __syncthreads();
}
struct EpiMoe1 {
    static constexpr bool PERM = true;
    bf16_t* O; const float* b1; const float* rsc;
    __device__ __forceinline__ void operator()(const f32x4 (&acc)[2][2][4][2], const GUnit& u, int wr, int wc, int fr, int fq) const {
        const int rt0 = wr * 64 + fr, col0 = u.pn * 128 + wc * 32 + 8 * fq;
        const float* bg = b1 + (size_t)u.e * 2048 + col0;
        f32x4 bgv[2], blv[2];
#pragma unroll
        for (int n = 0; n < 2; ++n) { bgv[n] = *(const f32x4*)(bg + 4 * n); blv[n] = *(const f32x4*)(bg + DFF + 4 * n); }
#pragma unroll
        for (int ai = 0; ai < 2; ++ai)
#pragma unroll
            for (int m = 0; m < 4; ++m) {
                const int rt = rt0 + ai * HALF + m * 16; int sl = u.row0 + rt; sl = sl < u.cnt ? sl : u.cnt - 1;
                const float r = rsc[u.e * ECAP + sl];
                float o[8];
#pragma unroll
                for (int n = 0; n < 2; ++n)
#pragma unroll
                    for (int j = 0; j < 4; ++j) {
                        const float g = fminf(r * acc[ai][0][m][n][j] + bgv[n][j], 7.f);
                        const float l = fminf(fmaxf(r * acc[ai][1][m][n][j] + blv[n][j], -7.f), 7.f);
                        o[n * 4 + j] = g * __builtin_amdgcn_rcpf(1.f + __builtin_amdgcn_exp2f(-2.4554669595930157f * g)) * (l + 1.f);
                    }
                u32x4 w; w.x = cvt_pk_bf16(o[0], o[1]); w.y = cvt_pk_bf16(o[2], o[3]); w.z = cvt_pk_bf16(o[4], o[5]); w.w = cvt_pk_bf16(o[6], o[7]);
                *(u32x4*)(O + (size_t)(u.pm * BM + rt) * DFF + col0) = w;
            }
    }
};
struct EpiMoe2 {
    static constexpr bool PERM = true;
    bf16_t* O; const float* b2;
    __device__ __forceinline__ void operator()(const f32x4 (&acc)[2][2][4][2], const GUnit& u, int wr, int wc, int fr, int fq) const {
        const int row0 = u.pm * BM + wr * 64 + fr, col0 = u.pn * BM + wc * 32 + 8 * fq;
        f32x4 bv[2][2];
#pragma unroll
        for (int bj = 0; bj < 2; ++bj)
#pragma unroll
            for (int n = 0; n < 2; ++n) bv[bj][n] = *(const f32x4*)(b2 + (size_t)u.e * DM + col0 + bj * HALF + 4 * n);
#pragma unroll
        for (int ai = 0; ai < 2; ++ai)
#pragma unroll
            for (int m = 0; m < 4; ++m) { bf16_t* rowp = O + (size_t)(row0 + ai * HALF + m * 16) * DM + col0;
#pragma unroll
                for (int bj = 0; bj < 2; ++bj) { const f32x4 v0 = acc[ai][bj][m][0] + bv[bj][0], v1 = acc[ai][bj][m][1] + bv[bj][1];
                    u32x4 w; w.x = cvt_pk_bf16(v0[0], v0[1]); w.y = cvt_pk_bf16(v0[2], v0[3]); w.z = cvt_pk_bf16(v1[0], v1[1]); w.w = cvt_pk_bf16(v1[2], v1[3]);
                    *(u32x4*)(rowp + bj * HALF) = w; } }
    }
};

__device__ __forceinline__ void p_transpose(const int wv, const float* W, int nmat, int K, int N, bf16_t* WT, const float* kgain, int gdiv, int mode, LAS unsigned char* lds) {
    LTID();
    const int wave = wv, lane = tidx & 63;
    LAS float* scr = (LAS float*)(lds + wave * 16384);
    const int nblk = N / 32, per_mat = (K / 64) * nblk, total = nmat * per_mat, stride = (int)gridDim.x * NW;
    const int lrow = lane >> 5, lcol = lane & 31;
#define TR_DECODE(item, mat_, kb_, nb_) const int mat_ = (item) / per_mat, r_ = (item) - mat_ * per_mat, g8_ = r_ >> 3, l8_ = r_ & 7, kb_ = 2 * (g8_ / (nblk >> 2)) + (l8_ & 1), nb_ = 4 * (g8_ % (nblk >> 2)) + (l8_ >> 1)
#define TR_ISSUE(item, dst) do { TR_DECODE(item, mat_, kb_, nb_); \
        const float* src_ = W + (size_t)mat_ * K * N + (size_t)(64 * kb_ + lrow) * N + 32 * nb_ + lcol; \
        _Pragma("unroll") for (int i = 0; i < 32; ++i) dst[i] = src_[(size_t)(2 * i) * N]; } while (0)
    float v[32], vn[32], vnn[32];
    int it = bidx * NW + wave;
    if (it < total) TR_ISSUE(it, v);
    if (it + stride < total) TR_ISSUE(it + stride, vn);
    while (it < total) {
        const int itn = it + stride, itnn = itn + stride;
        if (itnn < total) TR_ISSUE(itnn, vnn);
        TR_DECODE(it, mat, kb, nb); const int k0 = 64 * kb, n0 = 32 * nb;
#pragma unroll
        for (int i = 0; i < 32; ++i) scr[(2 * i + lrow) * 33 + lcol] = v[i];
        asm volatile("s_waitcnt lgkmcnt(0)" ::: "memory");
        int d0 = n0;
        if (mode == 1) { const int bj = n0 >> 10, rest = n0 & 1023, pn = rest >> 7, j = rest & 127; d0 = pn * 256 + bj * 128 + j; }
        const int c = lane & 7;
        f32x4 g0 = (f32x4){1.f, 1.f, 1.f, 1.f}, g1 = g0;
        if (kgain) { const float* gp = kgain + (size_t)(mat / gdiv) * DM + k0 + 8 * c; g0 = *(const f32x4*)gp; g1 = *(const f32x4*)(gp + 4); }
        bf16_t* dst = WT + (size_t)mat * K * N;
#pragma unroll
        for (int j = 0; j < 4; ++j) { const int n = (lane >> 3) + 8 * j; const LAS float* sp = scr + (8 * c) * 33 + n;
            u32x4 o; o.x = cvt_pk_bf16(sp[0 * 33] * g0[0], sp[1 * 33] * g0[1]); o.y = cvt_pk_bf16(sp[2 * 33] * g0[2], sp[3 * 33] * g0[3]); o.z = cvt_pk_bf16(sp[4 * 33] * g1[0], sp[5 * 33] * g1[1]); o.w = cvt_pk_bf16(sp[6 * 33] * g1[2], sp[7 * 33] * g1[3]);
            *(u32x4*)(dst + (size_t)(d0 + n) * K + k0 + 8 * c) = o; }
        asm volatile("s_waitcnt lgkmcnt(0)" ::: "memory");
#pragma unroll
        for (int i = 0; i < 32; ++i) { v[i] = vn[i]; vn[i] = vnn[i]; }
        it = itn;
    }
#undef TR_ISSUE
#undef TR_DECODE
}
typedef short v4i16_t __attribute__((ext_vector_type(4)));
constexpr int ATT_TAB_OFF = 131072 + 2048;
constexpr int ATT_UNITS = 3 * 8 * 128;
__device__ __forceinline__ int t5_bucket_dev(int n) {
    if (n < 16) return n;
    const float v = logf((float)n / 16.f) / 4.852030263919617f * 16.f;
    const int large = 16 + (int)v;
    return large < 31 ? large : 31;
}
__device__ __forceinline__ void p_bias_table(const int wv, const float* rel_bias, float* biasG) {
    LTID();
    for (int i = bidx * NT + tidx; i < 3 * 8 * 132; i += gridDim.x * NT) {
        const int d = i % 132, bh = i / 132, h = bh & 7, b = bh >> 3;
        biasG[i] = (d <= 128) ? rel_bias[t5_bucket_dev(d << (2 * b)) * 8 + h] : 0.f;
    }
}
__device__ __forceinline__ void p_dil_attn(const int wv, const bf16_t* proj16, const float* biasG, bf16_t* obr, float* lse, LAS unsigned char* lds) {
    LTID();
    const int lane = tidx & 63, fr = lane & 15, fq = lane >> 4, w = wv;
    const int per = (ATT_UNITS + (int)gridDim.x - 1) / (int)gridDim.x;
    const int u0 = bidx * per, u1 = (u0 + per < ATT_UNITS) ? u0 + per : ATT_UNITS;
    if (u0 >= u1) return;
    const int rowl = tidx >> 3, cs = tidx & 7;
    const unsigned cK = (unsigned)(cs ^ ((rowl >> 1) & 7)) * 16u, cV = (unsigned)(cs ^ (rowl & 7)) * 16u;
    const unsigned fK = (unsigned)((fr >> 1) & 7);
    const unsigned kro0 = (unsigned)fr * 128u + (((unsigned)fq ^ fK) * 16u), kro1 = (unsigned)fr * 128u + ((((unsigned)fq ^ fK) ^ 4u) * 16u);
    const int tq = (lane & 15) >> 2, tp = lane & 3, fv = 4 * (fq & 1) + tq;
    unsigned vro[4];
#pragma unroll
    for (int db = 0; db < 4; ++db) vro[db] = (unsigned)(4 * fq + tq) * 128u + (unsigned)(((2 * db + (tp >> 1)) ^ fv) * 16) + 8u * (unsigned)(tp & 1);
    const int ts_ = (1 + fr) & 3;
    const unsigned tab8 = (unsigned)ATT_TAB_OFF + (unsigned)ts_ * 640u + (unsigned)(((141 + fr - ts_) >> 2) - fq - 32) * 16u;
    const char* gbase = (const char*)proj16;
#define ATT_DECODE(u, b_, h_, r_, n_, dil_) const int cmb_ = (u) >> 7, b_ = cmb_ >> 3, h_ = cmb_ & 7, dil_ = 1 << (2 * b_), idx_ = (u) & 127, r_ = idx_ & (dil_ - 1), n_ = idx_ >> (2 * b_)
#define ATT_ISSUE(u, bf, q0, q1) do { ATT_DECODE(u, b__, h__, r__, n__, dil__); \
        const int nk = n__ > 0 ? n__ - 1 : 0;                                     \
        _Pragma("unroll") for (int p = 0; p < 4; ++p) { \
            int row = 64 * p + rowl; int blk = (row >> 7) ? n__ : nk; \
            const unsigned pos = (unsigned)(r__ + dil__ * (128 * blk + (row & 127))); \
            const unsigned so = pos * 4096u + (unsigned)h__ * 128u; const unsigned ld_ = (unsigned)(size_t)(lds + (bf) * 65536 + p * 8192 + w * 1024); \
            glds16s(gbase, so + 1024u + cK, ld_); glds16s(gbase, so + 2048u + cV, ld_ + 32768u); } \
        const unsigned qpos = (unsigned)(r__ + dil__ * (128 * n__ + 16 * w + fr)); \
        const char* qsrc = gbase + (size_t)qpos * 4096u + (unsigned)h__ * 128u + (unsigned)fq * 16u; \
        q0 = *(const bf16x8*)(qsrc); q1 = *(const bf16x8*)(qsrc + 64); } while (0)
    bf16x8 qf0, qf1, qn0, qn1;
    ATT_ISSUE(u0, 0, qn0, qn1);
    int prev_cmb = -1;
    for (int u = u0; u < u1; ++u) {
        const int bf = (u - u0) & 1;
        asm volatile("s_waitcnt vmcnt(0)" ::: "memory");
        __syncthreads();
        qf0 = qn0; qf1 = qn1;
        if (u + 1 < u1) ATT_ISSUE(u + 1, bf ^ 1, qn0, qn1);
        ATT_DECODE(u, b, h, r, n, dil);
        if (cmb_ != prev_cmb) {
            prev_cmb = cmb_;
            for (int e = tidx; e < 4 * 160; e += NT) { const int sft = e / 160, k = e - sft * 160, idx = k + sft, dist = idx - 16;
                const float v = (dist >= 0 && dist <= 128) ? biasG[cmb_ * 132 + dist] : -1e30f;
                ((LAS float*)(lds + ATT_TAB_OFF))[sft * 160 + k] = v; }
            __syncthreads();
        }
        const LAS unsigned char* Kb = lds + bf * 65536; const LAS unsigned char* Vb = Kb + 32768;
        const int kb0 = w;
        f32x4 sc[9];
#pragma unroll
        for (int i = 0; i < 9; ++i) {
            const unsigned ko = (unsigned)(kb0 + i) * 2048u;
            const bf16x8 k0 = *(const LAS bf16x8*)(Kb + ko + kro0), k1 = *(const LAS bf16x8*)(Kb + ko + kro1);
            f32x4 a = (f32x4){0.f, 0.f, 0.f, 0.f};
            a = __builtin_amdgcn_mfma_f32_16x16x32_bf16(k0, qf0, a, 0, 0, 0);
            a = __builtin_amdgcn_mfma_f32_16x16x32_bf16(k1, qf1, a, 0, 0, 0);
            const f32x4 t = *(const LAS f32x4*)(lds + tab8 + 64 * (8 - i));
            a = a + (f32x4){t[3], t[2], t[1], t[0]};
            if (n == 0 && kb0 + i < 8) a = (f32x4){-1e30f, -1e30f, -1e30f, -1e30f};
            sc[i] = a;
        }
        float mx = -1e30f;
#pragma unroll
        for (int i = 0; i < 9; ++i) mx = fmaxf(mx, fmaxf(fmaxf(sc[i][0], sc[i][1]), fmaxf(sc[i][2], sc[i][3])));
        mx = fmaxf(mx, shx(mx, 16, lane)); mx = fmaxf(mx, shx(mx, 32, lane));
        float sum = 0.f;
#pragma unroll
        for (int i = 0; i < 9; ++i)
#pragma unroll
            for (int j = 0; j < 4; ++j) { const float p = __expf(sc[i][j] - mx); sc[i][j] = p; sum += p; }
        sum += shx(sum, 16, lane); sum += shx(sum, 32, lane);
        f32x4 oacc[4];
#pragma unroll
        for (int db = 0; db < 4; ++db) oacc[db] = (f32x4){0.f, 0.f, 0.f, 0.f};
#pragma unroll
        for (int c = 0; c < 5; ++c) {
            const int ia = 2 * c, ib = (c < 4) ? 2 * c + 1 : 8;
            u32x4 pw; pw.x = cvt_pk_bf16(sc[ia][0], sc[ia][1]); pw.y = cvt_pk_bf16(sc[ia][2], sc[ia][3]);
            if (c < 4) { pw.z = cvt_pk_bf16(sc[ib][0], sc[ib][1]); pw.w = cvt_pk_bf16(sc[ib][2], sc[ib][3]); } else { pw.z = 0u; pw.w = 0u; }
            const bf16x8 pf = __builtin_bit_cast(bf16x8, pw);
            const unsigned va = (unsigned)(kb0 + ia) * 2048u, vb = (unsigned)(kb0 + ib) * 2048u;
#pragma unroll
            for (int db = 0; db < 4; ++db) {
                const v4i16_t x0 = __builtin_amdgcn_ds_read_tr16_b64_v4i16((LAS v4i16_t*)(Vb + va + vro[db]));
                const v4i16_t x1 = __builtin_amdgcn_ds_read_tr16_b64_v4i16((LAS v4i16_t*)(Vb + vb + vro[db]));
                const bf16x8 vf = (bf16x8){x0[0], x0[1], x0[2], x0[3], x1[0], x1[1], x1[2], x1[3]};
                oacc[db] = __builtin_amdgcn_mfma_f32_16x16x32_bf16(vf, pf, oacc[db], 0, 0, 0);
            }
        }
        const float inv = 1.f / sum;
        const unsigned qpos = (unsigned)(r + dil * (128 * n + 16 * w + fr));
        bf16_t* orow = obr + ((size_t)b * SEQ + qpos) * 512 + h * 64 + 4 * fq;
#pragma unroll
        for (int db = 0; db < 4; ++db) { u32x2 o2; o2.x = cvt_pk_bf16(oacc[db][0] * inv, oacc[db][1] * inv); o2.y = cvt_pk_bf16(oacc[db][2] * inv, oacc[db][3] * inv); *(u32x2*)(orow + 16 * db) = o2; }
        if (fq == 0) lse[((size_t)b * SEQ + qpos) * 8 + h] = mx + __logf(sum);
    }
    asm volatile("s_waitcnt vmcnt(0)" ::: "memory");
    __syncthreads();
#undef ATT_DECODE
#undef ATT_ISSUE
}
__device__ __forceinline__ void p_attn_combine(const int wv, const bf16_t* obr, const float* lse, const float* g, bf16_t* mix16) {
    LTID();
    const int lane = tidx & 63, h = lane >> 3;
    const f32x4 g0 = *(const f32x4*)(g + lane * 8), g1 = *(const f32x4*)(g + lane * 8 + 4);
    const int rstride = (int)gridDim.x * NW;
    for (int row0 = bidx * NW + wv; row0 < SEQ; row0 += 4 * rstride) {
        float lv[4][3]; u32x4 av[4][3];
#pragma unroll
        for (int r = 0; r < 4; ++r) { const int row = (row0 + r * rstride < SEQ) ? row0 + r * rstride : row0;
#pragma unroll
            for (int b = 0; b < 3; ++b) { lv[r][b] = lse[((size_t)b * SEQ + row) * 8 + h]; av[r][b] = *(const u32x4*)(obr + ((size_t)b * SEQ + row) * 512 + lane * 8); } }
#pragma unroll
        for (int r = 0; r < 4; ++r) {
            const int row = row0 + r * rstride;
            const float M = fmaxf(lv[r][0], fmaxf(lv[r][1], lv[r][2]));
            float w0 = __expf(lv[r][0] - M), w1 = __expf(lv[r][1] - M), w2 = __expf(lv[r][2] - M);
            const float iw = 1.f / (w0 + w1 + w2); w0 *= iw; w1 *= iw; w2 *= iw;
            float y[8]; float ss = 0.f;
#pragma unroll
            for (int k = 0; k < 4; ++k) {
                const float lo = w0 * __builtin_bit_cast(float, av[r][0][k] << 16) + w1 * __builtin_bit_cast(float, av[r][1][k] << 16) + w2 * __builtin_bit_cast(float, av[r][2][k] << 16);
                const float hi = w0 * __builtin_bit_cast(float, av[r][0][k] & 0xffff0000u) + w1 * __builtin_bit_cast(float, av[r][1][k] & 0xffff0000u) + w2 * __builtin_bit_cast(float, av[r][2][k] & 0xffff0000u);
                y[2 * k] = lo; y[2 * k + 1] = hi; ss += lo * lo + hi * hi;
            }
#pragma unroll
            for (int o = 32; o; o >>= 1) ss += shx(ss, o, lane);
            const float sc = rsqrtf(ss * (1.f / 512.f) + 1e-5f);
            u32x4 o4; o4.x = cvt_pk_bf16(y[0] * sc * g0[0], y[1] * sc * g0[1]); o4.y = cvt_pk_bf16(y[2] * sc * g0[2], y[3] * sc * g0[3]);
            o4.z = cvt_pk_bf16(y[4] * sc * g1[0], y[5] * sc * g1[1]); o4.w = cvt_pk_bf16(y[6] * sc * g1[2], y[7] * sc * g1[3]);
            if (row < SEQ) *(u32x4*)(mix16 + (size_t)row * DM + lane * 8) = o4;
        }
    }
}
struct EpiIn {
    static constexpr bool PERM = true;
    bf16_t* O;
    __device__ __forceinline__ void operator()(const f32x4 (&acc)[2][2][4][2], const GUnit& u, int wr, int wc, int fr, int fq) const {
        const int row0 = u.pm * BM + wr * 64 + fr, col0 = u.pn * BM + wc * 32 + 8 * fq;
        const float sc = u.pn < 2 ? 0.125f : 1.f;
#pragma unroll
        for (int ai = 0; ai < 2; ++ai)
#pragma unroll
            for (int m = 0; m < 4; ++m) { const size_t ro = (size_t)(row0 + ai * HALF + m * 16) * DIN + col0;
#pragma unroll
                for (int bj = 0; bj < 2; ++bj) { const f32x4 v0 = acc[ai][bj][m][0] * sc, v1 = acc[ai][bj][m][1] * sc;
                    u32x4 w; w.x = cvt_pk_bf16(v0[0], v0[1]); w.y = cvt_pk_bf16(v0[2], v0[3]); w.z = cvt_pk_bf16(v1[0], v1[1]); w.w = cvt_pk_bf16(v1[2], v1[3]);
                    *(u32x4*)(O + ro + bj * HALF) = w;
                    } }
    }
};


__device__ __forceinline__ unsigned xoff_b(unsigned row, unsigned ch) { return 256u * row + 16u * (ch ^ (((row & 3u) << 2) | ((row >> 2) & 3u))); }
__device__ __forceinline__ void p_xattn_mfma(const int wv, const bf16_t* qx16, const bf16_t* kv16, bf16_t* ox16, LAS unsigned char* lds) {
    LTID();
    const int lane = tidx & 63, fr = lane & 15, fq = lane >> 4, w = wv;
    const int NU = 4 * 128;
    const int per = (NU + (int)gridDim.x - 1) / (int)gridDim.x;
    const int u0 = bidx * per, u1 = (u0 + per < NU) ? u0 + per : NU;
    if (u0 >= u1) return;
    const int rowl = tidx >> 4, cs = tidx & 15;
    const unsigned csw = (unsigned)(cs ^ (((rowl & 3) << 2) | ((rowl >> 2) & 3))) * 16u;
    const unsigned kswz = (unsigned)(((fr & 3) << 2) | ((fr >> 2) & 3));
    unsigned kro[4];
#pragma unroll
    for (int s4 = 0; s4 < 4; ++s4) kro[s4] = 256u * (unsigned)fr + 16u * ((unsigned)(4 * s4 + fq) ^ kswz);
    const int tq = (lane & 15) >> 2, tp = lane & 3;
    const unsigned vswz = (unsigned)((tq << 2) | fq);
    unsigned vro[8];
#pragma unroll
    for (int c = 0; c < 8; ++c) vro[c] = 65536u + 256u * (unsigned)(4 * fq + tq) + 16u * ((unsigned)(2 * c + (tp >> 1)) ^ vswz) + 8u * (unsigned)(tp & 1);
    int prev_h = -1;
    for (int u = u0; u < u1; ++u) {
        const int h = u >> 7, qt = u & 127;
        if (h != prev_h) {
            __syncthreads();
            prev_h = h;
#pragma unroll
            for (int p = 0; p < 8; ++p) {
                const unsigned row = (unsigned)(32 * p + rowl);
                const unsigned so = row * 2048u + (unsigned)h * 256u + csw;
                const unsigned ld_ = (unsigned)(size_t)(lds + p * 8192 + w * 1024);
                glds16s(kv16, so, ld_); glds16s(kv16, so + 1024u, ld_ + 65536u);
            }
            asm volatile("s_waitcnt vmcnt(0)" ::: "memory");
            __syncthreads();
        }
        const char* qsrc = (const char*)qx16 + ((size_t)(qt * 128 + 16 * w + fr) * 512 + h * 128 + 8 * fq) * 2;
        bf16x8 qf[4];
#pragma unroll
        for (int s4 = 0; s4 < 4; ++s4) qf[s4] = *(const bf16x8*)(qsrc + 64 * s4);
        f32x4 sc[16];
#pragma unroll
        for (int i = 0; i < 16; ++i) {
            f32x4 a = (f32x4){0.f, 0.f, 0.f, 0.f};
#pragma unroll
            for (int s4 = 0; s4 < 4; ++s4) { const bf16x8 kf = *(const LAS bf16x8*)(lds + i * 4096 + kro[s4]); a = __builtin_amdgcn_mfma_f32_16x16x32_bf16(kf, qf[s4], a, 0, 0, 0); }
            sc[i] = a;
        }
        float mx = -1e30f;
#pragma unroll
        for (int i = 0; i < 16; ++i) mx = fmaxf(mx, fmaxf(fmaxf(sc[i][0], sc[i][1]), fmaxf(sc[i][2], sc[i][3])));
        mx = fmaxf(mx, shx(mx, 16, lane)); mx = fmaxf(mx, shx(mx, 32, lane));
        float sum = 0.f;
#pragma unroll
        for (int i = 0; i < 16; ++i)
#pragma unroll
            for (int j = 0; j < 4; ++j) { const float p = __expf(sc[i][j] - mx); sc[i][j] = p; sum += p; }
        sum += shx(sum, 16, lane); sum += shx(sum, 32, lane);
        f32x4 oacc[8];
#pragma unroll
        for (int c = 0; c < 8; ++c) oacc[c] = (f32x4){0.f, 0.f, 0.f, 0.f};
#pragma unroll
        for (int ch = 0; ch < 8; ++ch) {
            const int ia = 2 * ch, ib = 2 * ch + 1;
            u32x4 pw; pw.x = cvt_pk_bf16(sc[ia][0], sc[ia][1]); pw.y = cvt_pk_bf16(sc[ia][2], sc[ia][3]); pw.z = cvt_pk_bf16(sc[ib][0], sc[ib][1]); pw.w = cvt_pk_bf16(sc[ib][2], sc[ib][3]);
            const bf16x8 pf = __builtin_bit_cast(bf16x8, pw);
#pragma unroll
            for (int c = 0; c < 8; ++c) {
                const v4i16_t x0 = __builtin_amdgcn_ds_read_tr16_b64_v4i16((LAS v4i16_t*)(lds + ia * 4096 + vro[c]));
                const v4i16_t x1 = __builtin_amdgcn_ds_read_tr16_b64_v4i16((LAS v4i16_t*)(lds + ib * 4096 + vro[c]));
                const bf16x8 vf = (bf16x8){x0[0], x0[1], x0[2], x0[3], x1[0], x1[1], x1[2], x1[3]};
                oacc[c] = __builtin_amdgcn_mfma_f32_16x16x32_bf16(vf, pf, oacc[c], 0, 0, 0);
            }
        }
        const float inv = 1.f / sum;
        bf16_t* orow = ox16 + (size_t)(qt * 128 + 16 * w + fr) * 512 + h * 128 + 4 * fq;
#pragma unroll
        for (int c = 0; c < 8; ++c) { u32x2 o2; o2.x = cvt_pk_bf16(oacc[c][0] * inv, oacc[c][1] * inv); o2.y = cvt_pk_bf16(oacc[c][2] * inv, oacc[c][3] * inv); *(u32x2*)(orow + 16 * c) = o2; }
    }
    __syncthreads();
}
struct EpiBf16 {
    static constexpr bool PERM = true;
    bf16_t* O; int ldc; float scale; const float* ss;
    __device__ __forceinline__ void operator()(const f32x4 (&acc)[2][2][4][2], const GUnit& u, int wr, int wc, int fr, int fq) const {
        const int row0 = u.pm * BM + wr * 64 + fr, col0 = u.pn * BM + wc * 32 + 8 * fq;
#pragma unroll
        for (int ai = 0; ai < 2; ++ai)
#pragma unroll
            for (int m = 0; m < 4; ++m) { const int row = row0 + ai * HALF + m * 16; bf16_t* rowp = O + (size_t)row * ldc + col0;
                float sc = scale;
                if (ss) { const f32x4 p0 = *(const f32x4*)(ss + (size_t)row * 16), p1 = *(const f32x4*)(ss + (size_t)row * 16 + 4), p2 = *(const f32x4*)(ss + (size_t)row * 16 + 8), p3 = *(const f32x4*)(ss + (size_t)row * 16 + 12);
                    const float t = ((p0[0] + p0[1]) + (p0[2] + p0[3])) + ((p1[0] + p1[1]) + (p1[2] + p1[3])) + ((p2[0] + p2[1]) + (p2[2] + p2[3])) + ((p3[0] + p3[1]) + (p3[2] + p3[3]));
                    sc = scale * rsqrtf(t * (1.f / 1024.f) + 1e-5f); }
#pragma unroll
                for (int bj = 0; bj < 2; ++bj) { const f32x4 v0 = acc[ai][bj][m][0] * sc, v1 = acc[ai][bj][m][1] * sc;
                    u32x4 w; w.x = cvt_pk_bf16(v0[0], v0[1]); w.y = cvt_pk_bf16(v0[2], v0[3]); w.z = cvt_pk_bf16(v1[0], v1[1]); w.w = cvt_pk_bf16(v1[2], v1[3]);
                    *(u32x4*)(rowp + bj * HALF) = w; } }
    }
};
struct EpiOut {
    static constexpr bool PERM = true;
    const float* R; float* H; bf16_t* HB; float* ss;
    __device__ __forceinline__ void operator()(const f32x4 (&acc)[2][2][4][2], const GUnit& u, int wr, int wc, int fr, int fq) const {
        const int row0 = u.pm * BM + wr * 64 + fr, col0 = u.pn * BM + wc * 32 + 8 * fq, lane = fq * 16 + fr;
#pragma unroll
        for (int ai = 0; ai < 2; ++ai)
#pragma unroll
            for (int m = 0; m < 4; ++m) { const int row = row0 + ai * HALF + m * 16; const size_t ro = (size_t)row * DM + col0; float sq = 0.f;
#pragma unroll
                for (int bj = 0; bj < 2; ++bj) {
                    const f32x4 v0 = acc[ai][bj][m][0] + *(const f32x4*)(R + ro + bj * HALF), v1 = acc[ai][bj][m][1] + *(const f32x4*)(R + ro + bj * HALF + 4);
                    *(f32x4*)(H + ro + bj * HALF) = v0; *(f32x4*)(H + ro + bj * HALF + 4) = v1;
                    u32x4 w; w.x = cvt_pk_bf16(v0[0], v0[1]); w.y = cvt_pk_bf16(v0[2], v0[3]); w.z = cvt_pk_bf16(v1[0], v1[1]); w.w = cvt_pk_bf16(v1[2], v1[3]);
                    *(u32x4*)(HB + ro + bj * HALF) = w;
                    sq += (v0[0] * v0[0] + v0[1] * v0[1]) + (v0[2] * v0[2] + v0[3] * v0[3]) + (v1[0] * v1[0] + v1[1] * v1[1]) + (v1[2] * v1[2] + v1[3] * v1[3]);
                }
                sq += shx(sq, 16, lane); sq += shx(sq, 32, lane);
                if (fq == 0) ss[(size_t)row * 16 + u.pn * 4 + wc] = sq;
            }
    }
};

typedef short bf16x4 __attribute__((ext_vector_type(4)));
typedef float f32x2 __attribute__((ext_vector_type(2)));
constexpr int S5_CHUNK = 256, S5_NCH = SEQ / S5_CHUNK, S5_ROWB = 528;
__device__ __forceinline__ f32x2 gelu_pk(f32x2 v) {
    const f32x2 av = __builtin_elementwise_abs(v), d = av * 0.2316418882f + 1.0f;
    f32x2 t; t.x = __builtin_amdgcn_rcpf(d.x); t.y = __builtin_amdgcn_rcpf(d.y);
    f32x2 q = t * 0.5307027145f + (-0.7265760135f); q = q * t + 0.7107068705f; q = q * t + (-0.142248368f); q = q * t + 0.127414796f; q = q * t;
    const f32x2 s2 = (v * v) * (-0.72134752044f);
    f32x2 e; e.x = __builtin_amdgcn_exp2f(s2.x); e.y = __builtin_amdgcn_exp2f(s2.y);
    const f32x2 m = v * (q * e), r = v - m;
    f32x2 o; o.x = v.x < 0.f ? m.x : r.x; o.y = v.y < 0.f ? m.y : r.y; return o;
}
__device__ __forceinline__ void p_s5_tables2(const int wv, const float* a_re, const float* a_im, const float* b_re, const float* b_im, const float* c_re, const float* c_im, const float* log_dt,
                                             float2* abar, float2* a256, bf16_t* BB16, bf16_t* CM16) {
    LTID();
    for (int gp = bidx * NT + tidx; gp < 2048; gp += gridDim.x * NT) {
        const int g = gp >> 6, p = gp & 63;
        const float lr = a_re[gp], li = a_im[gp], dt = expf(log_dt[g]);
        const float mag = expf(lr * dt); float sn, cs; sincosf(li * dt, &sn, &cs);
        const float ar = mag * cs, ai = mag * sn;
        abar[gp] = make_float2(ar, ai);
        float pr = ar, pi = ai;
        for (int i = 0; i < 8; ++i) { const float nr = pr * pr - pi * pi, ni = 2.f * pr * pi; pr = nr; pi = ni; }
        a256[gp] = make_float2(pr, pi);
        const float nr = ar - 1.f, ni = ai, den = lr * lr + li * li;
        const float cr = (nr * lr + ni * li) / den, ci = (ni * lr - nr * li) / den;
        for (int c = 0; c < 16; ++c) {
            const float br = b_re[gp * 16 + c], bi = b_im[gp * 16 + c];
            BB16[((size_t)g * 128 + p) * 16 + c] = (bf16_t)f2bf(cr * br - ci * bi);
            BB16[((size_t)g * 128 + 64 + p) * 16 + c] = (bf16_t)f2bf(cr * bi + ci * br);
            CM16[((size_t)g * 16 + c) * 128 + p] = (bf16_t)f2bf(c_re[(g * 16 + c) * 64 + p]);
            CM16[((size_t)g * 16 + c) * 128 + 64 + p] = (bf16_t)f2bf(-c_im[(g * 16 + c) * 64 + p]);
        }
    }
}
template <int MODE> __device__ __forceinline__ void p_s5_pass(const int wv, const bf16_t* proj16, const float2* abar, const float2* a256, const bf16_t* BB16, const bf16_t* CM16, const float* dskip,
                                                              float2* E, bf16_t* yg16, LAS unsigned char* lds) {
    LTID();
    const int lane = tidx & 63, fr = lane & 15, fq = lane >> 4;
    LAS unsigned char* L = lds + wv * (16 * S5_ROWB);
    for (int unit = bidx * NW + wv; unit < S5_NCH * 32; unit += gridDim.x * NW) {
        const int g = unit & 31, chunk = unit >> 5;
        const float2 a = abar[g * 64 + lane];
        bf16x4 bbf[8];
#pragma unroll
        for (int cb = 0; cb < 8; ++cb) bbf[cb] = *(const bf16x4*)(BB16 + ((size_t)g * 128 + 16 * cb + fr) * 16 + 4 * fq);
        bf16x8 cmf[4]; f32x4 dsk = (f32x4){0.f, 0.f, 0.f, 0.f};
        if (MODE == 1) {
#pragma unroll
            for (int s4 = 0; s4 < 4; ++s4) cmf[s4] = *(const bf16x8*)(CM16 + ((size_t)g * 16 + fr) * 128 + 32 * s4 + 8 * fq);
            dsk = *(const f32x4*)(dskip + g * 16 + 4 * fq);
        }
        float sr = 0.f, si = 0.f;
        if (MODE == 1) {
            const float2 A = a256[g * 64 + lane];
            for (int j0 = 0; j0 < chunk; j0 += 8) {
                float2 e[8];
#pragma unroll
                for (int k = 0; k < 8; ++k) { const int j = (j0 + k < chunk) ? j0 + k : chunk - 1; e[k] = E[((size_t)j * 32 + g) * 64 + lane]; }
#pragma unroll
                for (int k = 0; k < 8; ++k) if (j0 + k < chunk) { const float nr = A.x * sr - A.y * si + e[k].x, ni = A.x * si + A.y * sr + e[k].y; sr = nr; si = ni; }
            }
        }
        const bf16_t* ubase = proj16 + (size_t)(chunk * S5_CHUNK + fr) * DIN + 1536 + g * 16 + 4 * fq;
        bf16x4 uf = *(const bf16x4*)ubase;
#pragma unroll 1
        for (int blk = 0; blk < S5_CHUNK / 16; ++blk) {
            const bf16x4 ufn = *(const bf16x4*)(ubase + (size_t)((blk < S5_CHUNK / 16 - 1) ? (blk + 1) * 16 : blk * 16) * DIN);
            asm volatile("" ::: "memory");
#pragma unroll
            for (int cb = 0; cb < 8; ++cb) {
                const f32x4 d = __builtin_amdgcn_mfma_f32_16x16x16bf16_1k(bbf[cb], uf, (f32x4){0.f, 0.f, 0.f, 0.f}, 0, 0, 0);
                *(LAS f32x4*)(L + fr * S5_ROWB + (16 * cb + 4 * fq) * 4) = d;
            }
            asm volatile("" ::: "memory");
#pragma unroll
            for (int t = 0; t < 16; ++t) {
                const float re = *(const LAS float*)(L + t * S5_ROWB + lane * 4), im = *(const LAS float*)(L + t * S5_ROWB + 256 + lane * 4);
                const float nr = a.x * sr - a.y * si + re, ni = a.x * si + a.y * sr + im; sr = nr; si = ni;
                if (MODE == 1) { *(LAS bf16_t*)(L + t * S5_ROWB + lane * 2) = (bf16_t)f2bf(sr); *(LAS bf16_t*)(L + t * S5_ROWB + 128 + lane * 2) = (bf16_t)f2bf(si); }
            }
            asm volatile("" ::: "memory");
            if (MODE == 1) {
                f32x4 y = (f32x4){0.f, 0.f, 0.f, 0.f};
#pragma unroll
                for (int s4 = 0; s4 < 4; ++s4) { const bf16x8 sf = *(const LAS bf16x8*)(L + fr * S5_ROWB + 64 * s4 + 16 * fq); y = __builtin_amdgcn_mfma_f32_16x16x32_bf16(cmf[s4], sf, y, 0, 0, 0); }
                f32x4 v;
#pragma unroll
                for (int j = 0; j < 4; ++j) v[j] = y[j] + dsk[j] * bf2f((unsigned short)uf[j]);
                const f32x2 g0 = gelu_pk((f32x2){v[0], v[1]}), g1 = gelu_pk((f32x2){v[2], v[3]});
                u32x2 o2; o2.x = cvt_pk_bf16(g0.x, g0.y); o2.y = cvt_pk_bf16(g1.x, g1.y);
                *(u32x2*)(yg16 + (size_t)(chunk * S5_CHUNK + blk * 16 + fr) * 512 + g * 16 + 4 * fq) = o2;
            }
            asm volatile("" ::: "memory");
            uf = ufn;
        }
        if (MODE == 0) E[((size_t)chunk * 32 + g) * 64 + lane] = make_float2(sr, si);
    }
}
struct EpiGlu16 {
    static constexpr bool PERM = true;
    bf16_t* O; const bf16_t* Y; const float* bias;
    __device__ __forceinline__ void operator()(const f32x4 (&acc)[2][2][4][2], const GUnit& u, int wr, int wc, int fr, int fq) const {
        const int row0 = u.pm * BM + wr * 64 + fr, col0 = u.pn * BM + wc * 32 + 8 * fq;
        f32x4 bv[2][2];
#pragma unroll
        for (int bj = 0; bj < 2; ++bj)
#pragma unroll
            for (int n = 0; n < 2; ++n) bv[bj][n] = *(const f32x4*)(bias + col0 + bj * HALF + 4 * n);
#pragma unroll
        for (int ai = 0; ai < 2; ++ai)
#pragma unroll
            for (int m = 0; m < 4; ++m) { const size_t ro = (size_t)(row0 + ai * HALF + m * 16) * 512 + col0;
#pragma unroll
                for (int bj = 0; bj < 2; ++bj) {
                    const u32x4 yv = *(const u32x4*)(Y + ro + bj * HALF);
                    float o[8];
#pragma unroll
                    for (int n = 0; n < 2; ++n)
#pragma unroll
                        for (int j = 0; j < 4; ++j) { const unsigned wd = yv[n * 2 + (j >> 1)]; const float y = __builtin_bit_cast(float, (j & 1) ? (wd & 0xffff0000u) : (wd << 16));
                            o[n * 4 + j] = y / (1.f + __expf(-(acc[ai][bj][m][n][j] + bv[bj][n][j]))); }
                    u32x4 w; w.x = cvt_pk_bf16(o[0], o[1]); w.y = cvt_pk_bf16(o[2], o[3]); w.z = cvt_pk_bf16(o[4], o[5]); w.w = cvt_pk_bf16(o[6], o[7]);
                    *(u32x4*)(O + ro + bj * HALF) = w; } }
    }
};
__device__ __forceinline__ void p_ssm_norm(const int wv, const bf16_t* yb16, const float* g, bf16_t* mix16) {
    LTID();
    const int lane = tidx & 63;
    const f32x4 g0 = *(const f32x4*)(g + lane * 8), g1 = *(const f32x4*)(g + lane * 8 + 4);
    const int rstride = (int)gridDim.x * NW;
    for (int row0 = bidx * NW + wv; row0 < SEQ; row0 += 4 * rstride) {
        u32x4 av[4];
#pragma unroll
        for (int r = 0; r < 4; ++r) { const int row = (row0 + r * rstride < SEQ) ? row0 + r * rstride : row0; av[r] = *(const u32x4*)(yb16 + (size_t)row * 512 + lane * 8); }
#pragma unroll
        for (int r = 0; r < 4; ++r) {
            const int row = row0 + r * rstride;
            float y[8]; float ss = 0.f;
#pragma unroll
            for (int k = 0; k < 4; ++k) { y[2 * k] = __builtin_bit_cast(float, av[r][k] << 16); y[2 * k + 1] = __builtin_bit_cast(float, av[r][k] & 0xffff0000u); ss += y[2 * k] * y[2 * k] + y[2 * k + 1] * y[2 * k + 1]; }
#pragma unroll
            for (int o = 32; o; o >>= 1) ss += shx(ss, o, lane);
            const float sc = rsqrtf(ss * (1.f / 512.f) + 1e-5f);
            u32x4 o4; o4.x = cvt_pk_bf16(y[0] * sc * g0[0], y[1] * sc * g0[1]); o4.y = cvt_pk_bf16(y[2] * sc * g0[2], y[3] * sc * g0[3]);
            o4.z = cvt_pk_bf16(y[4] * sc * g1[0], y[5] * sc * g1[1]); o4.w = cvt_pk_bf16(y[6] * sc * g1[2], y[7] * sc * g1[3]);
            if (row < SEQ) *(u32x4*)(mix16 + (size_t)row * DM + 512 + lane * 8) = o4;
        }
    }
}

__device__ __forceinline__ void p_rmsnorm16(const int wv, const float* in, const float* g, bf16_t* out16, int rows) {
    LTID();
    const int lane = tidx & 63;
    for (int r = bidx * NW + wv; r < rows; r += gridDim.x * NW) {
        f32x4 v[4]; float ss = 0.f;
#pragma unroll
        for (int j = 0; j < 4; ++j) { v[j] = *(const f32x4*)(in + (size_t)r * DM + 4 * lane + 256 * j); ss += (v[j][0] * v[j][0] + v[j][1] * v[j][1]) + (v[j][2] * v[j][2] + v[j][3] * v[j][3]); }
#pragma unroll
        for (int o = 32; o; o >>= 1) ss += shx(ss, o, lane);
        const float sc = rsqrtf(ss * (1.f / 1024.f) + 1e-5f);
#pragma unroll
        for (int j = 0; j < 4; ++j) { const f32x4 gg = *(const f32x4*)(g + 4 * lane + 256 * j); u32x2 o2; o2.x = cvt_pk_bf16(v[j][0] * sc * gg[0], v[j][1] * sc * gg[1]); o2.y = cvt_pk_bf16(v[j][2] * sc * gg[2], v[j][3] * sc * gg[3]);
            *(u32x2*)(out16 + (size_t)r * DM + 4 * lane + 256 * j) = o2; }
    }
}
template <bool MOE, bool LAST> __device__ __forceinline__ void p_rowfinish(const int wv, const float* hin, float* h, const bf16_t* mout, const int* eslot, const float* topg, const float* g, bf16_t* xn16, float* out) {
    LTID();
    const int lane = tidx & 63;
    LAS const int* ts = (LAS const int*)(LDSP + TS_OFF);
    const int rstride = (int)gridDim.x * NW;
    for (int r0 = bidx * NW + wv; r0 < SEQ; r0 += 2 * rstride) {
        int rr[2]; rr[0] = r0; rr[1] = (r0 + rstride < SEQ) ? r0 + rstride : r0;
        f32x4 v[2][4]; int4 es[2]; f32x4 gt[2]; u32x2 mo[2][4][4];
#pragma unroll
        for (int q = 0; q < 2; ++q) { if (MOE) { es[q] = *(const int4*)(eslot + rr[q] * 4); gt[q] = *(const f32x4*)(topg + rr[q] * 4); }
#pragma unroll
            for (int j = 0; j < 4; ++j) v[q][j] = *(const f32x4*)(hin + (size_t)rr[q] * DM + 4 * lane + 256 * j); }
        if (MOE) {
#pragma unroll
            for (int q = 0; q < 2; ++q) { const int esv[4] = {es[q].x, es[q].y, es[q].z, es[q].w};
#pragma unroll
                for (int k = 0; k < 4; ++k) { const int e = esv[k] >> 16, sl = esv[k] & 0xffff; const size_t row = (size_t)ts[e] * BM + sl;
#pragma unroll
                    for (int j = 0; j < 4; ++j) mo[q][k][j] = *(const u32x2*)(mout + row * DM + 4 * lane + 256 * j); } }
#pragma unroll
            for (int q = 0; q < 2; ++q)
#pragma unroll
                for (int k = 0; k < 4; ++k) { const float gk = gt[q][k];
#pragma unroll
                    for (int j = 0; j < 4; ++j) { const u32x2 o = mo[q][k][j];
                        v[q][j][0] += gk * __builtin_bit_cast(float, o.x << 16); v[q][j][1] += gk * __builtin_bit_cast(float, o.x & 0xffff0000u);
                        v[q][j][2] += gk * __builtin_bit_cast(float, o.y << 16); v[q][j][3] += gk * __builtin_bit_cast(float, o.y & 0xffff0000u); } }
        }
#pragma unroll
        for (int q = 0; q < 2; ++q) {
            if (q == 1 && r0 + rstride >= SEQ) break;
            const int r = rr[q];
            float ss = 0.f;
#pragma unroll
            for (int j = 0; j < 4; ++j) ss += (v[q][j][0] * v[q][j][0] + v[q][j][1] * v[q][j][1]) + (v[q][j][2] * v[q][j][2] + v[q][j][3] * v[q][j][3]);
#pragma unroll
            for (int o = 32; o; o >>= 1) ss += shx(ss, o, lane);
            const float sc = rsqrtf(ss * (1.f / 1024.f) + 1e-5f);
#pragma unroll
            for (int j = 0; j < 4; ++j) {
                const f32x4 gg = *(const f32x4*)(g + 4 * lane + 256 * j);
                if (!LAST) { if (h) *(f32x4*)(h + (size_t)r * DM + 4 * lane + 256 * j) = v[q][j];
                    u32x2 o2; o2.x = cvt_pk_bf16(v[q][j][0] * sc * gg[0], v[q][j][1] * sc * gg[1]); o2.y = cvt_pk_bf16(v[q][j][2] * sc * gg[2], v[q][j][3] * sc * gg[3]);
                    *(u32x2*)(xn16 + (size_t)r * DM + 4 * lane + 256 * j) = o2; }
                else *(f32x4*)(out + (size_t)r * DM + 4 * lane + 256 * j) = (f32x4){v[q][j][0] * sc * gg[0], v[q][j][1] * sc * gg[1], v[q][j][2] * sc * gg[2], v[q][j][3] * sc * gg[3]};
            }
        }
    }
}
__device__ __forceinline__ void p_router_tables(const int wv, const float* w_r, const float* g, bf16_t* WR16) {
    LTID();
    for (int i = bidx * NT + tidx; i < 32 * 1024; i += gridDim.x * NT) {
        const int e = i >> 10, k = i & 1023;
        const float w = g[k] * w_r[k * 32 + e];
        const unsigned hi = f2bf(w); const float lo = w - __builtin_bit_cast(float, hi << 16);
        WR16[i] = (bf16_t)hi; WR16[32 * 1024 + i] = (bf16_t)f2bf(lo);
    }
}
constexpr int RT_CNT_OFF = 131072 + 4608;
constexpr int RT_XCH_OFF = 131072 + 5120;
__device__ __forceinline__ void p_router2(const int wv, const float* h, const bf16_t* WR16, const float* b_r, bf16_t* hb16, unsigned* gcnt, int* rowtok_e, float* rsc_e, int* eslot, float* topg, LAS unsigned char* lds) {
    LTID();
    const int lane = tidx & 63, fr = lane & 15, fq = lane >> 4, w = wv, tg = w & 3, kh = w >> 2;
#pragma unroll
    for (int part = 0; part < 2; ++part)
#pragma unroll
        for (int p = 0; p < 8; ++p) { const int row = 4 * p + (tidx >> 7), cs = tidx & 127;
            glds16s(WR16, (unsigned)(part * 65536 + row * 2048 + ((cs ^ (row & 15)) * 16)), (unsigned)(size_t)(lds + part * 65536 + p * 8192 + w * 1024)); }
    LAS int* lcnt = (LAS int*)(lds + RT_CNT_OFF);
    if (tidx < 64) lcnt[tidx] = 0;
    asm volatile("s_waitcnt vmcnt(0)" ::: "memory");
    __syncthreads();
    for (int it = bidx; it < SEQ / 64; it += gridDim.x) {
        const int token = it * 64 + 16 * tg + fr;
        const float* xr = h + (size_t)token * DM + 512 * kh + 8 * fq;
        bf16_t* hb = hb16 + (size_t)token * DM + 512 * kh + 8 * fq;
        f32x4 acc[2]; acc[0] = (f32x4){0.f, 0.f, 0.f, 0.f}; acc[1] = acc[0];
        float ss = 0.f;
#pragma unroll 4
        for (int s4 = 0; s4 < 16; ++s4) {
            const f32x4 x0 = *(const f32x4*)(xr + 32 * s4), x1 = *(const f32x4*)(xr + 32 * s4 + 4);
            ss += (x0[0] * x0[0] + x0[1] * x0[1]) + (x0[2] * x0[2] + x0[3] * x0[3]) + (x1[0] * x1[0] + x1[1] * x1[1]) + (x1[2] * x1[2] + x1[3] * x1[3]);
            u32x4 hw; hw.x = cvt_pk_bf16(x0[0], x0[1]); hw.y = cvt_pk_bf16(x0[2], x0[3]); hw.z = cvt_pk_bf16(x1[0], x1[1]); hw.w = cvt_pk_bf16(x1[2], x1[3]);
            *(u32x4*)(hb + 32 * s4) = hw;
            u32x4 lw;
            lw.x = cvt_pk_bf16(x0[0] - __builtin_bit_cast(float, hw.x << 16), x0[1] - __builtin_bit_cast(float, hw.x & 0xffff0000u));
            lw.y = cvt_pk_bf16(x0[2] - __builtin_bit_cast(float, hw.y << 16), x0[3] - __builtin_bit_cast(float, hw.y & 0xffff0000u));
            lw.z = cvt_pk_bf16(x1[0] - __builtin_bit_cast(float, hw.z << 16), x1[1] - __builtin_bit_cast(float, hw.z & 0xffff0000u));
            lw.w = cvt_pk_bf16(x1[2] - __builtin_bit_cast(float, hw.w << 16), x1[3] - __builtin_bit_cast(float, hw.w & 0xffff0000u));
            const bf16x8 xhi = __builtin_bit_cast(bf16x8, hw), xlo = __builtin_bit_cast(bf16x8, lw);
            const int c = 64 * kh + 4 * s4 + fq, slot = c ^ fr;
#pragma unroll
            for (int nb = 0; nb < 2; ++nb) {
                const bf16x8 whi = *(const LAS bf16x8*)(lds + (16 * nb + fr) * 2048 + slot * 16), wlo = *(const LAS bf16x8*)(lds + 65536 + (16 * nb + fr) * 2048 + slot * 16);
                acc[nb] = __builtin_amdgcn_mfma_f32_16x16x32_bf16(whi, xhi, acc[nb], 0, 0, 0);
                acc[nb] = __builtin_amdgcn_mfma_f32_16x16x32_bf16(whi, xlo, acc[nb], 0, 0, 0);
                acc[nb] = __builtin_amdgcn_mfma_f32_16x16x32_bf16(wlo, xhi, acc[nb], 0, 0, 0);
            }
        }
        ss += shx(ss, 16, lane); ss += shx(ss, 32, lane);
        LAS float* X = (LAS float*)(lds + RT_XCH_OFF) + (tg * 64 + lane) * 9;
        if (kh == 1) {
#pragma unroll
            for (int nb = 0; nb < 2; ++nb)
#pragma unroll
                for (int j = 0; j < 4; ++j) X[nb * 4 + j] = acc[nb][j];
            X[8] = ss;
        }
        __syncthreads();
        int ti[4] = {0, 0, 0, 0}, ls[4] = {0, 0, 0, 0}; float gv[4] = {0.f, 0.f, 0.f, 0.f}; float rs = 0.f;
        if (kh == 0) {
            float lv[8];
            ss += X[8];
            rs = rsqrtf(ss * (1.f / 1024.f) + 1e-5f);
#pragma unroll
            for (int nb = 0; nb < 2; ++nb)
#pragma unroll
                for (int j = 0; j < 4; ++j) lv[nb * 4 + j] = rs * (acc[nb][j] + X[nb * 4 + j]) + b_r[16 * nb + 4 * fq + j];
            float tv[4];
#pragma unroll
            for (int r = 0; r < 4; ++r) {
                float bv = -3.0e38f; int bi = 0;
#pragma unroll
                for (int q = 0; q < 8; ++q) { const int idx = 16 * (q >> 2) + 4 * fq + (q & 3); if (lv[q] > bv) { bv = lv[q]; bi = idx; } }
#pragma unroll
                for (int mk = 16; mk <= 32; mk <<= 1) { const float ov = shx(bv, mk, lane); const int oi = shxi(bi, mk, lane); if (ov > bv || (ov == bv && oi < bi)) { bv = ov; bi = oi; } }
                tv[r] = bv; ti[r] = bi;
#pragma unroll
                for (int q = 0; q < 8; ++q) { const int idx = 16 * (q >> 2) + 4 * fq + (q & 3); if (idx == bi) lv[q] = -3.0e38f; }
            }
            float sum = 0.f;
#pragma unroll
            for (int r = 0; r < 4; ++r) { gv[r] = __expf(tv[r] - tv[0]); sum += gv[r]; }
            const float inv = 1.f / sum;
#pragma unroll
            for (int r = 0; r < 4; ++r) gv[r] *= inv;
            if (fq == 0) {
#pragma unroll
                for (int r = 0; r < 4; ++r) ls[r] = __hip_atomic_fetch_add(&lcnt[ti[r]], 1, __ATOMIC_RELAXED, __HIP_MEMORY_SCOPE_WORKGROUP);
            }
        }
        __syncthreads();
        if (tidx < 32) { const int c = lcnt[tidx]; lcnt[32 + tidx] = c ? (int)__hip_atomic_fetch_add(gcnt + tidx, (unsigned)c, __ATOMIC_RELAXED, __HIP_MEMORY_SCOPE_AGENT) : 0; }
        __syncthreads();
        if (kh == 0 && fq == 0) {
            int es[4];
#pragma unroll
            for (int r = 0; r < 4; ++r) { const int e = ti[r], sl = lcnt[32 + e] + ls[r]; rowtok_e[e * ECAP + sl] = token; rsc_e[e * ECAP + sl] = rs; es[r] = (e << 16) | sl; }
            *(int4*)(eslot + token * 4) = make_int4(es[0], es[1], es[2], es[3]);
            *(f32x4*)(topg + token * 4) = (f32x4){gv[0], gv[1], gv[2], gv[3]};
        }
        __syncthreads();
        if (tidx < 32) lcnt[tidx] = 0;
    }
    __syncthreads();
}

constexpr int NPL = 13;
constexpr int NPHASES = 1 + 2 * NPL;
typedef const __attribute__((address_space(4))) Args* KA;
#define PHASE __device__ __forceinline__
#define KAP() ({ KA _t = a; asm volatile("" : "+s"(_t)); _t; })
#define WSP(T, off) ((T*)(a->ws + (off)))

PHASE void ph_init(KA a, const int wv) {
    p_rowfinish<false, false>(wv, a->in[0], nullptr, nullptr, nullptr, nullptr, a->in[3], WSP(bf16_t, WS_XN16), nullptr);
    p_bias_table(wv, a->in[2], WSP(float, WS_BIASG));
    for (int l = 0; l < 2; ++l) {
        p_s5_tables2(wv, a->in[5] + l * 2048, a->in[6] + l * 2048, a->in[7] + l * 32768, a->in[8] + l * 32768, a->in[9] + l * 32768, a->in[10] + l * 32768, a->in[11] + l * 32,
                     WSP(float2, WS_ABAR) + l * 2048, WSP(float2, WS_A256) + l * 2048, WSP(bf16_t, WS_BB16) + (size_t)l * 32 * 128 * 16, WSP(bf16_t, WS_CM16) + (size_t)l * 32 * 16 * 128);
        p_rmsnorm16(wv, a->in[1], a->in[19] + l * DM, WSP(bf16_t, WS_MEMN16) + (size_t)l * NMEM * DM, NMEM);
        p_router_tables(wv, a->in[24] + (size_t)l * DM * 32, a->in[23] + l * DM, WSP(bf16_t, WS_WR16) + (size_t)l * 2 * 32 * 1024);
    }
    p_transpose(wv, a->in[4], 2, DM, DIN, WSP(bf16_t, WS_WT_IN), nullptr, 1, 0, LDSP);
    p_transpose(wv, a->in[13], 2, 512, 512, WSP(bf16_t, WS_WT_GLU), nullptr, 1, 0, LDSP);
    p_transpose(wv, a->in[17], 2, DM, DM, WSP(bf16_t, WS_WT_OUT), nullptr, 1, 0, LDSP);
    p_transpose(wv, a->in[20], 2, DM, 512, WSP(bf16_t, WS_WT_XQ), a->in[18], 1, 0, LDSP);
    p_transpose(wv, a->in[21], 2, DM, 1024, WSP(bf16_t, WS_WT_XKV), nullptr, 1, 0, LDSP);
    p_transpose(wv, a->in[22], 2, 512, DM, WSP(bf16_t, WS_WT_XO), nullptr, 1, 0, LDSP);
    p_transpose(wv, a->in[26], 2 * NEXP, DM, 2048, WSP(bf16_t, WS_BT1), a->in[23], NEXP, 1, LDSP);
    p_transpose(wv, a->in[28], 2 * NEXP, DFF, DM, WSP(bf16_t, WS_BT2), nullptr, 1, 0, LDSP);
    __syncthreads();
}
PHASE void ph_gemm_in(KA a, const int wv, int l) { LTID();
    DenseOrder S; S.init(WSP(bf16_t, WS_XN16), WSP(bf16_t, WS_WT_IN) + (size_t)l * DIN * DM, SEQ, DIN, DM, gridDim.x, bidx);
    EpiIn E{WSP(bf16_t, WS_PROJ16)};
    gemm_phase<EpiIn, DenseOrder, false, true>(LDSP, DM, S, E, tidx, wv);
}
PHASE void ph_attn_s5a(KA a, const int wv, int l) {
    p_dil_attn(wv, WSP(bf16_t, WS_PROJ16), WSP(float, WS_BIASG), WSP(bf16_t, WS_OBR), WSP(float, WS_LSE), LDSP);
    if (PROBE_DUP == 21) p_dil_attn(wv, WSP(bf16_t, WS_PROJ16), WSP(float, WS_BIASG), WSP(bf16_t, WS_OBR), WSP(float, WS_LSE), LDSP);
    if (PROBE_DUP == 22) { p_s5_pass<0>(wv, WSP(bf16_t, WS_PROJ16), WSP(float2, WS_ABAR) + l * 2048, WSP(float2, WS_A256) + l * 2048, WSP(bf16_t, WS_BB16) + (size_t)l * 32 * 128 * 16, WSP(bf16_t, WS_CM16) + (size_t)l * 32 * 16 * 128,
                 a->in[12] + l * 512, WSP(float2, WS_E2), WSP(bf16_t, WS_YG16), LDSP); __syncthreads(); }
    p_s5_pass<0>(wv, WSP(bf16_t, WS_PROJ16), WSP(float2, WS_ABAR) + l * 2048, WSP(float2, WS_A256) + l * 2048, WSP(bf16_t, WS_BB16) + (size_t)l * 32 * 128 * 16, WSP(bf16_t, WS_CM16) + (size_t)l * 32 * 16 * 128,
                 a->in[12] + l * 512, WSP(float2, WS_E2), WSP(bf16_t, WS_YG16), LDSP);
}
PHASE void ph_s5b(KA a, const int wv, int l) {
    p_s5_pass<1>(wv, WSP(bf16_t, WS_PROJ16), WSP(float2, WS_ABAR) + l * 2048, WSP(float2, WS_A256) + l * 2048, WSP(bf16_t, WS_BB16) + (size_t)l * 32 * 128 * 16, WSP(bf16_t, WS_CM16) + (size_t)l * 32 * 16 * 128,
                 a->in[12] + l * 512, WSP(float2, WS_E2), WSP(bf16_t, WS_YG16), LDSP);
}
PHASE void ph_gemm_glu(KA a, const int wv, int l) {
    {   LTID();
        DenseOrder S; S.init(WSP(bf16_t, WS_YG16), WSP(bf16_t, WS_WT_GLU) + (size_t)l * 512 * 512, SEQ, 512, 512, gridDim.x, bidx);
        EpiGlu16 E{WSP(bf16_t, WS_YB16), WSP(bf16_t, WS_YG16), a->in[14] + l * 512};
        gemm_phase<EpiGlu16, DenseOrder, false, false>(LDSP, 512, S, E, tidx, wv); }
    {   LTID();
    const int cc = (int)gridDim.x - 1 - bidx;
    if (l == 0 && cc < 8) {
        const int kl = cc >> 2;
        DenseOrder S; S.init(WSP(bf16_t, WS_MEMN16) + (size_t)kl * NMEM * DM, WSP(bf16_t, WS_WT_XKV) + (size_t)kl * 1024 * DM, NMEM, 1024, DM, 4, cc & 3);
        EpiBf16 E{WSP(bf16_t, WS_KV16) + (size_t)kl * NMEM * 1024, 1024, 1.f, nullptr};
        gemm_phase<EpiBf16, DenseOrder, false, false>(LDSP, DM, S, E, tidx, wv);
    } }
}
PHASE void ph_mixnorm(KA a, const int wv, int l) {
    p_attn_combine(wv, WSP(bf16_t, WS_OBR), WSP(float, WS_LSE), a->in[15] + l * 512, WSP(bf16_t, WS_MIX16));
    p_ssm_norm(wv, WSP(bf16_t, WS_YB16), a->in[16] + l * 512, WSP(bf16_t, WS_MIX16));
}
PHASE void ph_gemm_out(KA a, const int wv, int l) { LTID();
    DenseOrder S; S.init(WSP(bf16_t, WS_MIX16), WSP(bf16_t, WS_WT_OUT) + (size_t)l * DM * DM, SEQ, DM, DM, gridDim.x, bidx);
    EpiOut E{l == 0 ? a->in[0] : (const float*)WSP(float, WS_H), WSP(float, WS_H), WSP(bf16_t, WS_HB16), WSP(float, WS_SSP)};
    gemm_phase<EpiOut, DenseOrder, false, false>(LDSP, DM, S, E, tidx, wv);
}
PHASE void ph_gemm_xq(KA a, const int wv, int l) { LTID();
    DenseOrder S; S.init(WSP(bf16_t, WS_HB16), WSP(bf16_t, WS_WT_XQ) + (size_t)l * 512 * DM, SEQ, 512, DM, gridDim.x, bidx);
    EpiBf16 E{WSP(bf16_t, WS_QX16), 512, 0.08838834764831845f, WSP(float, WS_SSP)};
    gemm_phase<EpiBf16, DenseOrder, false, false>(LDSP, DM, S, E, tidx, wv);
}
PHASE void ph_xattn(KA a, const int wv, int l) { p_xattn_mfma(wv, WSP(bf16_t, WS_QX16), WSP(bf16_t, WS_KV16) + (size_t)l * NMEM * 1024, WSP(bf16_t, WS_OX16), LDSP); }
PHASE void ph_gemm_xo(KA a, const int wv, int l) { LTID();
    DenseOrder S; S.init(WSP(bf16_t, WS_OX16), WSP(bf16_t, WS_WT_XO) + (size_t)l * DM * 512, SEQ, DM, 512, gridDim.x, bidx);
    EpiF32 E{WSP(float, WS_H), DM, 1};
    gemm_phase<EpiF32, DenseOrder, false, false>(LDSP, 512, S, E, tidx, wv);
}
PHASE void ph_router(KA a, const int wv, int l) {
    p_router2(wv, WSP(float, WS_H), WSP(bf16_t, WS_WR16) + (size_t)l * 2 * 32 * 1024, a->in[25] + l * 32, WSP(bf16_t, WS_HB16), WSP(unsigned, WS_CTL) + CW_CNT + l * 32,
              WSP(int, WS_ROWTOK), WSP(float, WS_RSC), WSP(int, WS_ESLOT), WSP(float, WS_TOPG), LDSP);
}
PHASE void ph_moe1(KA a, const int wv, int l) { LTID();
    moe_tiles(WSP(unsigned, WS_CTL) + CW_CNT + l * 32, tidx);
    MoeOrder<true> S; S.init(WSP(bf16_t, WS_HB16), WSP(bf16_t, WS_BT1) + (size_t)l * NEXP * 2048 * DM, WSP(int, WS_ROWTOK), 2048, DM, (size_t)2048 * DM * 2, gridDim.x, bidx);
    EpiMoe1 E{WSP(bf16_t, WS_ACT), a->in[27] + (size_t)l * NEXP * 2048, WSP(float, WS_RSC)};
    gemm_phase<EpiMoe1, MoeOrder<true>, true, true>(LDSP, DM, S, E, tidx, wv);
}
PHASE void ph_moe2(KA a, const int wv, int l) { LTID();
    moe_tiles(WSP(unsigned, WS_CTL) + CW_CNT + l * 32, tidx);
    MoeOrder<false> S; S.init(WSP(bf16_t, WS_ACT), WSP(bf16_t, WS_BT2) + (size_t)l * NEXP * DM * DFF, nullptr, DM, DFF, (size_t)DM * DFF * 2, gridDim.x, bidx);
    EpiMoe2 E{WSP(bf16_t, WS_MOUT), a->in[29] + (size_t)l * NEXP * DM};
    gemm_phase<EpiMoe2, MoeOrder<false>, false, true>(LDSP, DFF, S, E, tidx, wv);
}
PHASE void ph_combine(KA a, const int wv, int l) { LTID();
    moe_tiles(WSP(unsigned, WS_CTL) + CW_CNT + l * 32, tidx);
    if (l == 0) p_rowfinish<true, false>(wv, WSP(float, WS_H), WSP(float, WS_H), WSP(bf16_t, WS_MOUT), WSP(int, WS_ESLOT), WSP(float, WS_TOPG), a->in[3] + DM, WSP(bf16_t, WS_XN16), nullptr);
    else p_rowfinish<true, true>(wv, WSP(float, WS_H), nullptr, WSP(bf16_t, WS_MOUT), WSP(int, WS_ESLOT), WSP(float, WS_TOPG), a->in[30], nullptr, a->out);
}

__global__ void __launch_bounds__(NT, 2) mega(Args args) {
    KA a = (KA)__builtin_amdgcn_kernarg_segment_ptr();
    int wv = __builtin_amdgcn_readfirstlane((int)threadIdx.x >> 6); asm volatile("" : "+s"(wv));
    LAS unsigned char* lds = LDSP;
    volatile LAS unsigned* MISC = (volatile LAS unsigned*)(lds + MISC_OFF);
    unsigned* ctl = (unsigned*)(a->ws + WS_CTL);
    if (threadIdx.x < 32) MISC[threadIdx.x] = 0u;
    __syncthreads();
    XcdBarrier bar; bar.bar = ctl + CW_BAR; bar.x = 0; bar.st = nullptr;
    if (!MK_PER_PHASE) bar = xcd_barrier_post(ctl + CW_BAR, MISC + 8);
    const int lo = a->ph_lo, hi = a->ph_hi;
#define IN(k) (lo <= (k) && (k) < hi)
#define SEAM(k) do { if (IN(k) && IN((k) + 1)) { LTID(); xcd_barrier(bar.bar, bar.x, bar.st, tidx == 0); if (PROBE_DUP == 200) xcd_barrier(bar.bar, bar.x, bar.st, tidx == 0); } } while (0)
    if (IN(0)) { ph_init(KAP(), wv); if (PROBE_DUP == 100) ph_init(KAP(), wv); }
    SEAM(0);
#define LAYER_PROGRAM(l) { const int pb = 1 + (l) * NPL; \
        if (IN(pb + 0)) { ph_gemm_in(KAP(), wv, (l)); if (PROBE_DUP == 0) { ph_gemm_in(KAP(), wv, (l)); } } \
        SEAM(pb + 0); \
        if (IN(pb + 1)) { ph_attn_s5a(KAP(), wv, (l)); if (PROBE_DUP == 1) { ph_attn_s5a(KAP(), wv, (l)); } } \
        SEAM(pb + 1); \
        if (IN(pb + 2)) { ph_s5b(KAP(), wv, (l)); if (PROBE_DUP == 2) { ph_s5b(KAP(), wv, (l)); } } \
        SEAM(pb + 2); \
        if (IN(pb + 3)) { ph_gemm_glu(KAP(), wv, (l)); if (PROBE_DUP == 3) { ph_gemm_glu(KAP(), wv, (l)); } } \
        SEAM(pb + 3); \
        if (IN(pb + 4)) { ph_mixnorm(KAP(), wv, (l)); if (PROBE_DUP == 4) { ph_mixnorm(KAP(), wv, (l)); } } \
        SEAM(pb + 4); \
        if (IN(pb + 5)) { ph_gemm_out(KAP(), wv, (l)); if (PROBE_DUP == 5) { ph_gemm_out(KAP(), wv, (l)); } } \
        SEAM(pb + 5); \
        if (IN(pb + 6)) { ph_gemm_xq(KAP(), wv, (l)); if (PROBE_DUP == 6) { ph_gemm_xq(KAP(), wv, (l)); } } \
        SEAM(pb + 6); \
        if (IN(pb + 7)) { ph_xattn(KAP(), wv, (l)); if (PROBE_DUP == 7) { ph_xattn(KAP(), wv, (l)); } } \
        SEAM(pb + 7); \
        if (IN(pb + 8)) { ph_gemm_xo(KAP(), wv, (l)); if (PROBE_DUP == 8) { ph_gemm_xo(KAP(), wv, (l)); } } \
        SEAM(pb + 8); \
        if (IN(pb + 9)) { ph_router(KAP(), wv, (l)); if (PROBE_DUP == 9) { ph_router(KAP(), wv, (l)); } } \
        SEAM(pb + 9); \
        if (IN(pb + 10)) { ph_moe1(KAP(), wv, (l)); if (PROBE_DUP == 10) { ph_moe1(KAP(), wv, (l)); } } \
        SEAM(pb + 10); \
        if (IN(pb + 11)) { ph_moe2(KAP(), wv, (l)); if (PROBE_DUP == 11) { ph_moe2(KAP(), wv, (l)); } } \
        SEAM(pb + 11); \
        if (IN(pb + 12)) { ph_combine(KAP(), wv, (l)); if (PROBE_DUP == 12) { ph_combine(KAP(), wv, (l)); } } \
        SEAM(pb + 12); }
    LAYER_PROGRAM(0)
    LAYER_PROGRAM(1)
#undef LAYER_PROGRAM
#undef IN
#undef SEAM
}

extern "C" void kernel_launch(void* const* d_in, const int* in_sizes, int n_in, void* d_out, int out_size, void* d_ws, size_t ws_size, hipStream_t stream) {
    static int grid = 0;
    if (grid == 0) {
        if (n_in != 31 || ws_size < WS_END) { fprintf(stderr, "kernel_launch: unexpected n_in %d or ws_size %zu (need %zu)\n", n_in, ws_size, (size_t)WS_END); grid = -1; return; }
        int dev = 0, cus = 0, per_cu = 0;
        if (hipGetDevice(&dev) != hipSuccess || hipDeviceGetAttribute(&cus, hipDeviceAttributeMultiprocessorCount, dev) != hipSuccess) { grid = -1; return; }
        if (hipFuncSetAttribute((const void*)mega, hipFuncAttributeMaxDynamicSharedMemorySize, LDS_BYTES) != hipSuccess) { fprintf(stderr, "kernel_launch: hipFuncSetAttribute failed\n"); grid = -1; return; }
        if (hipOccupancyMaxActiveBlocksPerMultiprocessor(&per_cu, (const void*)mega, NT, LDS_BYTES) != hipSuccess || per_cu < 1)
            fprintf(stderr, "kernel_launch: occupancy query reports %d workgroups per CU\n", per_cu);
        (void)hipGetLastError();
        grid = cus;
    }
    if (grid < 0) return;
    if (hipMemsetAsync((char*)d_ws + WS_CTL, 0, CTL_ZERO_BYTES, stream) != hipSuccess) return;
    Args a{};
    for (int i = 0; i < 31; ++i) a.in[i] = (const float*)d_in[i];
    a.out = (float*)d_out; a.ws = (unsigned char*)d_ws;
#if MK_PER_PHASE
    for (int p = 0; p < NPHASES; ++p) { a.ph_lo = p; a.ph_hi = p + 1; hipLaunchKernelGGL(mega, dim3(grid), dim3(NT), LDS_BYTES, stream, a); }
#else
    a.ph_lo = 0; a.ph_hi = NPHASES;
    hipLaunchKernelGGL(mega, dim3(grid), dim3(NT), LDS_BYTES, stream, a);
#endif
}
```

```cpp
#include <hip/hip_runtime.h>
#include <stdint.h>
#include <cstdio>

#ifndef PROBE_DUP
#define PROBE_DUP -1
#endif
#ifndef MK_PER_PHASE
#define MK_PER_PHASE 0
#endif

#define SEQ 16384
#define DM 1024
#define DIN 2048
#define NMEM 256
#define NEXP 32
#define TOPK 4
#define DFF 1024
#define NT 512
#define NW 8

#define LAS __attribute__((address_space(3)))
typedef float f32x4 __attribute__((ext_vector_type(4)));
extern __shared__ __attribute__((aligned(16))) unsigned char lds_raw[];
#define LDSP ((LAS unsigned char*)lds_raw)
#define LTID() int z_ = 0; asm volatile("" : "+v"(z_)); const int lane_ = (int)__builtin_amdgcn_mbcnt_hi(~0u, __builtin_amdgcn_mbcnt_lo(~0u, (unsigned)z_)); \
    const int tidx = wv * 64 + lane_; int bidx = blockIdx.x; asm volatile("" : "+s"(bidx))
__device__ __forceinline__ float shx(float v, int mask, int lane) { return __builtin_bit_cast(float, __builtin_amdgcn_ds_bpermute((lane ^ mask) << 2, __builtin_bit_cast(int, v))); }
__device__ __forceinline__ int shxi(int v, int mask, int lane) { return __builtin_amdgcn_ds_bpermute((lane ^ mask) << 2, v); }
constexpr int LDS_BYTES = 147456;
constexpr int MISC_OFF = 131072 + 320;

#define XB_TMO      128
#define XB_XCNT(j)  (256  + 64 * (j))
#define XB_XSUB(j)  (1280 + 64 * (j))
#define XB_XGEN(j)  (2304 + 64 * (j))
#define XB_TOP      3328
#define XB_TOPGEN   3392
#define XCD_BAR_WORDS 3456
#define XB_SPIN_CAP (1u << 18)

__device__ __forceinline__ unsigned xb_ld(unsigned* p)              { return __hip_atomic_load(p, __ATOMIC_RELAXED, __HIP_MEMORY_SCOPE_AGENT); }
__device__ __forceinline__ unsigned xb_add(unsigned* p, unsigned v) { return __hip_atomic_fetch_add(p, v, __ATOMIC_RELAXED, __HIP_MEMORY_SCOPE_AGENT); }
__device__ __forceinline__ unsigned xb_xcc_id() { return (unsigned)__builtin_amdgcn_s_getreg((3 << 11) | 20) & 0xFu; }
#define XB_SPIN(cond, bar) do { unsigned _sp = 0; while (cond) { __builtin_amdgcn_s_sleep(1); \
    if ((++_sp & 255u) == 0u) { if (xb_ld(&(bar)[XB_TMO])) break; if (_sp > XB_SPIN_CAP) { atomicAdd(&(bar)[XB_TMO], 1u); break; } } } } while (0)

struct XcdBarrier {
    unsigned* bar; unsigned x;
    volatile LAS unsigned* st;
};
__device__ __forceinline__ XcdBarrier xcd_barrier_post(unsigned* bar, volatile LAS unsigned* st) {
    XcdBarrier b; b.bar = bar; b.x = xb_xcc_id(); b.st = st;
    if (threadIdx.x == 0) (void)xb_add(&bar[XB_XCNT(b.x)], 1u);
    return b;
}
__device__ __forceinline__ void xcd_barrier_complete(unsigned* bar, unsigned x, unsigned& nloc, unsigned& nx) {
    const unsigned G = gridDim.x * gridDim.y * gridDim.z;
    unsigned sum, cnt, mine, sp = 0u;
    for (;;) {
        sum = 0u; cnt = 0u; mine = 0u;
#pragma unroll
        for (unsigned j = 0; j < 16; ++j) { const unsigned c = xb_ld(&bar[XB_XCNT(j)]); sum += c; cnt += (c > 0u) ? 1u : 0u; mine = (j == x) ? c : mine; }
        if (sum == G) break;
        __builtin_amdgcn_s_sleep(1);
        if ((++sp & 255u) == 0u) { if (xb_ld(&bar[XB_TMO])) break; if (sp > XB_SPIN_CAP) { atomicAdd(&bar[XB_TMO], 1u); break; } }
    }
    nloc = mine > 0u ? mine : 1u; nx = cnt > 0u ? cnt : 1u;
}
__device__ __noinline__ void xcd_barrier(unsigned* bar_, unsigned x_, volatile LAS unsigned* st_, int is_t0) {
    XcdBarrier b; b.bar = bar_; b.x = x_; b.st = st_;
    asm volatile("s_waitcnt vmcnt(0)" ::: "memory");
    __syncthreads();
    if (is_t0) {
        unsigned* bar = b.bar;
        __builtin_amdgcn_s_waitcnt(0);
        unsigned nloc = b.st[0], nx = b.st[1];
        if (nloc == 0u) { xcd_barrier_complete(bar, b.x, nloc, nx); b.st[0] = nloc; b.st[1] = nx; }
        const unsigned old = xb_add(&bar[XB_XSUB(b.x)], 1u);
        const unsigned gen = old / nloc;
        if (old + 1u == (gen + 1u) * nloc) {
            __builtin_amdgcn_fence(__ATOMIC_RELEASE, "agent");
            asm volatile("s_waitcnt vmcnt(0)" ::: "memory");
            const unsigned og = xb_add(&bar[XB_TOP], 1u);
            const unsigned tg = og / nx;
            if (og + 1u == (tg + 1u) * nx) xb_add(&bar[XB_TOPGEN], 1u);
            else XB_SPIN(xb_ld(&bar[XB_TOPGEN]) == tg, bar);
            __builtin_amdgcn_fence(__ATOMIC_ACQUIRE, "agent");
            xb_add(&bar[XB_XGEN(b.x)], 1u);
            asm volatile("s_waitcnt vmcnt(0)" ::: "memory");
        } else {
            XB_SPIN(xb_ld(&bar[XB_XGEN(b.x)]) == gen, bar);
            __builtin_amdgcn_fence(__ATOMIC_ACQUIRE, "agent");
            asm volatile("s_waitcnt vmcnt(0)" ::: "memory");
        }
    }
    __syncthreads();
}

constexpr size_t MiB = 1u << 20;
constexpr size_t WS_CTL = 0, CTL_ZERO_BYTES = 1 * MiB;
constexpr int CW_BAR = 4096;
constexpr int CW_CNT = 8192;
constexpr int MOE_ROWS = SEQ * TOPK + NEXP * 256;
constexpr int ECAP = SEQ;
constexpr size_t al256(size_t x) { return (x + 255) & ~(size_t)255; }
constexpr size_t WS_H = 2 * MiB;
constexpr size_t WS_XN16 = WS_H + (size_t)SEQ * DM * 4;
constexpr size_t WS_HB16 = WS_XN16 + (size_t)SEQ * DM * 2;
constexpr size_t WS_PROJ16 = WS_HB16 + (size_t)SEQ * DM * 2;
constexpr size_t WS_OBR = WS_PROJ16 + (size_t)SEQ * 2048 * 2;
constexpr size_t WS_LSE = WS_OBR + 3 * (size_t)SEQ * 512 * 2;
constexpr size_t WS_YG16 = WS_LSE + 3 * (size_t)SEQ * 8 * 4;
constexpr size_t WS_YB16 = WS_YG16 + (size_t)SEQ * 512 * 2;
constexpr size_t WS_MIX16 = WS_YB16 + (size_t)SEQ * 512 * 2;
constexpr size_t WS_QX16 = WS_MIX16 + (size_t)SEQ * DM * 2;
constexpr size_t WS_OX16 = WS_QX16 + (size_t)SEQ * 512 * 2;
constexpr size_t WS_ACT = WS_OX16 + (size_t)SEQ * 512 * 2;
constexpr size_t WS_MOUT = WS_ACT + (size_t)MOE_ROWS * DFF * 2;
constexpr size_t WS_BT1 = WS_MOUT + (size_t)MOE_ROWS * DM * 2;
constexpr size_t WS_BT2 = WS_BT1 + 2 * (size_t)NEXP * 2048 * DM * 2;
constexpr size_t WS_WT_IN = WS_BT2 + 2 * (size_t)NEXP * DM * DFF * 2;
constexpr size_t WS_WT_GLU = WS_WT_IN + 2 * (size_t)2048 * 1024 * 2;
constexpr size_t WS_WT_OUT = WS_WT_GLU + 2 * (size_t)512 * 512 * 2;
constexpr size_t WS_WT_XQ = WS_WT_OUT + 2 * (size_t)1024 * 1024 * 2;
constexpr size_t WS_WT_XKV = WS_WT_XQ + 2 * (size_t)512 * 1024 * 2;
constexpr size_t WS_WT_XO = WS_WT_XKV + 2 * (size_t)1024 * 1024 * 2;
constexpr size_t WS_MEMN16 = WS_WT_XO + 2 * (size_t)1024 * 512 * 2;
constexpr size_t WS_KV16 = WS_MEMN16 + 2 * (size_t)NMEM * 1024 * 2;
constexpr size_t WS_WR16 = WS_KV16 + 2 * (size_t)NMEM * 1024 * 2;
constexpr size_t WS_BIASG = WS_WR16 + 2 * 2 * (size_t)32 * 1024 * 2;
constexpr size_t WS_ABAR = al256(WS_BIASG + 24 * 132 * 4);
constexpr size_t WS_A256 = WS_ABAR + 2 * 2048 * 8;
constexpr size_t WS_BB16 = WS_A256 + 2 * 2048 * 8;
constexpr size_t WS_CM16 = WS_BB16 + 2 * (size_t)32 * 128 * 16 * 2;
constexpr size_t WS_E2 = WS_CM16 + 2 * (size_t)32 * 16 * 128 * 2;
constexpr size_t WS_ROWTOK = WS_E2 + (size_t)64 * 2048 * 8;
constexpr size_t WS_RSC = WS_ROWTOK + (size_t)NEXP * ECAP * 4;
constexpr size_t WS_ESLOT = WS_RSC + (size_t)NEXP * ECAP * 4;
constexpr size_t WS_TOPG = WS_ESLOT + (size_t)SEQ * 4 * 4;
constexpr size_t WS_SSP = WS_TOPG + (size_t)SEQ * 4 * 4;
constexpr size_t WS_END = WS_SSP + (size_t)SEQ * 16 * 4;

struct Args { const float* in[31]; float* out; unsigned char* ws; int ph_lo, ph_hi; };


typedef unsigned short bf16_t;
typedef short bf16x8 __attribute__((ext_vector_type(8)));
typedef unsigned u32x4 __attribute__((ext_vector_type(4)));
typedef unsigned u32x2 __attribute__((ext_vector_type(2)));
constexpr int BM = 256, BK = 64, HALF = 128, HTB = HALF * BK * 2, STAGE_BYTES = 8 * HTB, NXCD = 8, WGM = 8;
__host__ __device__ __forceinline__ int lds_byte(int r, int c) { const int st = (r >> 4) * 2 + (c >> 5), rr = r & 15, cc = c & 31, ob = rr * 64 + cc * 2; return st * 1024 + (ob ^ (((ob >> 9) & 1) << 5)); }
__host__ __device__ __forceinline__ void stage_rc(int b, int& R, int& C) { const int st = b / 1024, sb = b % 1024, swz = sb ^ (((sb >> 9) & 1) << 5); R = (st >> 1) * 16 + swz / 64; C = (st & 1) * 32 + (swz % 64) / 2; }
__host__ __device__ __forceinline__ int perm32(int rho) { const int n = rho >> 4, i = rho & 15; return 8 * (i >> 2) + 4 * n + (i & 3); }
__device__ __forceinline__ unsigned cvt_pk_bf16(float lo, float hi) { unsigned r; asm volatile("v_cvt_pk_bf16_f32 %0, %1, %2" : "=v"(r) : "v"(lo), "v"(hi)); return r; }
__device__ __forceinline__ unsigned f2bf(float f) { unsigned u = __builtin_bit_cast(unsigned, f); return (u + 0x7fffu + ((u >> 16) & 1u)) >> 16; }
__device__ __forceinline__ unsigned pk2(float lo, float hi) { return f2bf(lo) | (f2bf(hi) << 16); }
__device__ __forceinline__ float bf2f(unsigned short b) { return __builtin_bit_cast(float, ((unsigned)b) << 16); }

__device__ __forceinline__ void glds16s(const void* sbase, unsigned voff, unsigned lds_dst) {
    unsigned keep;
    asm volatile("s_mov_b32 %0, m0\n\ts_mov_b32 m0, %3\n\ts_nop 0\n\tglobal_load_lds_dwordx4 %1, %2\n\ts_mov_b32 m0, %0" : "=&s"(keep) : "v"(voff), "s"(sbase), "s"(lds_dst) : "memory");
}
struct GUnit { const char* A; const char* B; int pm, pn, e, row0, cnt; };

struct DenseOrder {
    const char* A; const char* Bt; int nM, nN, nwg, G, c, K;
    __device__ __forceinline__ void init(const bf16_t* A_, const bf16_t* Bt_, int M, int N, int K_, int G_, int c_) { A = (const char*)A_; Bt = (const char*)Bt_; nM = M / BM; nN = N / BM; nwg = nM * nN; G = G_; c = c_; K = K_; }
    __device__ __forceinline__ bool next(int i, GUnit& u) const {
        const long L = (long)i * G + c; if (L >= nwg) return false;
        int wgid = (int)L; { const int q = nwg / NXCD, r = nwg % NXCD, xcd = wgid % NXCD, off = wgid / NXCD; wgid = (xcd < r ? xcd * (q + 1) : r * (q + 1) + (xcd - r) * q) + off; }
        const int nig = WGM * nN, gid = wgid / nig, fm = gid * WGM, gsz = (nM - fm) < WGM ? (nM - fm) : WGM;
        u.pm = fm + ((wgid % nig) % gsz); u.pn = (wgid % nig) / gsz; u.e = 0; u.row0 = 0; u.cnt = 0;
        u.A = A + (size_t)u.pm * BM * K * 2; u.B = Bt + (size_t)u.pn * BM * K * 2; return true;
    }
    __device__ __forceinline__ unsigned aoff(const GUnit&, int row) const { return (unsigned)(row * K * 2); }
    __device__ __forceinline__ unsigned tokoff(const GUnit&, int) const { return 0u; }
    __device__ __forceinline__ const int* tokbase() const { return nullptr; }
};

struct EpiF32 {
    static constexpr bool PERM = false;
    float* C; int ldc; int resid;
    __device__ __forceinline__ void operator()(const f32x4 (&acc)[2][2][4][2], const GUnit& u, int wr, int wc, int fr, int fq) const {
        const int row0 = u.pm * BM + wr * 64 + fr, col0 = u.pn * BM + wc * 32 + 4 * fq;
#pragma unroll
        for (int ai = 0; ai < 2; ++ai)
#pragma unroll
            for (int m = 0; m < 4; ++m) { float* rowp = C + (size_t)(row0 + ai * HALF + m * 16) * ldc + col0;
#pragma unroll
                for (int bj = 0; bj < 2; ++bj)
#pragma unroll
                    for (int n = 0; n < 2; ++n) { f32x4 v = acc[ai][bj][m][n]; if (resid) v += *(const f32x4*)(rowp + bj * HALF + n * 16); *(f32x4*)(rowp + bj * HALF + n * 16) = v; } }
    }
};
struct EpiGlu {
    static constexpr bool PERM = false;
    float* C; const float* Y; int ldc; const float* bias;
    __device__ __forceinline__ void operator()(const f32x4 (&acc)[2][2][4][2], const GUnit& u, int wr, int wc, int fr, int fq) const {
        const int row0 = u.pm * BM + wr * 64 + fr, col0 = u.pn * BM + wc * 32 + 4 * fq;
#pragma unroll
        for (int ai = 0; ai < 2; ++ai)
#pragma unroll
            for (int m = 0; m < 4; ++m) { const size_t ro = (size_t)(row0 + ai * HALF + m * 16) * ldc + col0;
#pragma unroll
                for (int bj = 0; bj < 2; ++bj)
#pragma unroll
                    for (int n = 0; n < 2; ++n) { const f32x4 b = *(const f32x4*)(bias + col0 + bj * HALF + n * 16); const f32x4 y = *(const f32x4*)(Y + ro + bj * HALF + n * 16);
                        f32x4 v = acc[ai][bj][m][n] + b; f32x4 o;
#pragma unroll
                        for (int j = 0; j < 4; ++j) o[j] = y[j] / (1.f + __expf(-v[j]));
                        *(f32x4*)(C + ro + bj * HALF + n * 16) = o; } }
    }
};

template <class Epi, class Sched, bool GATHER, bool ALIGN_EPI>
__device__ __forceinline__ void gemm_phase(LAS unsigned char* lds, const int K, const Sched& S, const Epi& E, const int tid, const int wv) {
    const int wid = wv, lane = tid & 63, wr = wid >> 2, wc = wid & 3, fr = lane & 15, fq = lane >> 4;
    const int nt = K / BK;
    unsigned voffB[2];
#pragma unroll
    for (int i = 0; i < 2; ++i) { int R, C; stage_rc(tid * 16 + i * 8192, R, C); const int Rb = Epi::PERM ? ((R & ~31) + perm32(R & 31)) : R; voffB[i] = (unsigned)(Rb * K + C) * 2u; }
#define PG8_AOFFS(dst, u) do { int t2_ = tid; asm volatile("" : "+v"(t2_)); _Pragma("unroll") for (int i = 0; i < 2; ++i) { int R, C; stage_rc(t2_ * 16 + i * 8192, R, C); \
        _Pragma("unroll") for (int h = 0; h < 2; ++h) dst[h][i] = S.aoff(u, h * HALF + R) + (unsigned)C * 2u; } } while (0)
    const size_t kstep = (size_t)(BK * 2);
    const size_t hstep = (size_t)HALF * K * 2;
    const unsigned ldsw = (unsigned)wid * 1024u;
    const int aoff = lds_byte(wr * 64 + fr, fq * 8), boff = lds_byte(wc * 32 + fr, fq * 8);
#define PG8_SA(b, h) (((b) * 2 + (h)) * HTB)
#define PG8_SB(b, h) ((4 + (b) * 2 + (h)) * HTB)
#define PG8_STAGE(bufoff, gbase, v0, v1) do { const unsigned ld_ = (unsigned)(size_t)(lds + (bufoff) + ldsw); glds16s((gbase), (v0), ld_); glds16s((gbase), (v1), ld_ + 8192u); } while (0)
#define PG8_LDA(dst, b, h) do { _Pragma("unroll") for (int m = 0; m < 4; ++m) _Pragma("unroll") for (int k = 0; k < 2; ++k) dst[m][k] = *(const LAS bf16x8*)(lds + PG8_SA(b, h) + aoff + m * 2048 + k * 1024); } while (0)
#define PG8_LDB(dst, b, h) do { _Pragma("unroll") for (int n = 0; n < 2; ++n) _Pragma("unroll") for (int k = 0; k < 2; ++k) dst[n][k] = *(const LAS bf16x8*)(lds + PG8_SB(b, h) + boff + n * 2048 + k * 1024); } while (0)
#define PG8_MMA(ai, bj, At, Bt) do { __builtin_amdgcn_s_setprio(1); _Pragma("unroll") for (int m = 0; m < 4; ++m) _Pragma("unroll") for (int n = 0; n < 2; ++n) _Pragma("unroll") for (int k = 0; k < 2; ++k) \
        acc[ai][bj][m][n] = __builtin_amdgcn_mfma_f32_16x16x32_bf16(Bt[n][k], At[m][k], acc[ai][bj][m][n], 0, 0, 0); __builtin_amdgcn_s_setprio(0); } while (0)
#define PG8_WAIT_V(n) asm volatile("s_waitcnt vmcnt(" #n ")" ::: "memory")
#define PG8_WAIT_L(n) asm volatile("s_waitcnt lgkmcnt(" #n ")" ::: "memory")
#define PG8_BAR __builtin_amdgcn_s_barrier()
#define PG8_SCHED __builtin_amdgcn_sched_barrier(0)
    GUnit cur, nxt; int ui = 0;
    if (!S.next(0, cur)) return;
    f32x4 acc[2][2][4][2];
#pragma unroll
    for (int a = 0; a < 2; ++a)
#pragma unroll
        for (int b = 0; b < 2; ++b)
#pragma unroll
            for (int m = 0; m < 4; ++m)
#pragma unroll
                for (int n = 0; n < 2; ++n) acc[a][b][m][n] = (f32x4){0.f, 0.f, 0.f, 0.f};
    bf16x8 At[4][2], B0[2][2], B1[2][2];
    unsigned vA[2][2], vN[2][2];
    PG8_AOFFS(vA, cur);
#pragma unroll
    for (int h = 0; h < 2; ++h)
#pragma unroll
        for (int i = 0; i < 2; ++i) vN[h][i] = vA[h][i];
    const char* cA = cur.A; const char* cB = cur.B;
    PG8_STAGE(PG8_SB(0, 0), cB, voffB[0], voffB[1]); PG8_STAGE(PG8_SB(0, 1), cB + hstep, voffB[0], voffB[1]); PG8_STAGE(PG8_SA(0, 0), cA, vA[0][0], vA[0][1]); PG8_STAGE(PG8_SA(0, 1), cA, vA[1][0], vA[1][1]);
    if (wr == 1) PG8_BAR;
    PG8_WAIT_V(2); PG8_BAR;
    PG8_STAGE(PG8_SB(1, 0), cB + kstep, voffB[0], voffB[1]); PG8_STAGE(PG8_SA(1, 0), cA + kstep, vA[0][0], vA[0][1]); PG8_STAGE(PG8_SB(1, 1), cB + hstep + kstep, voffB[0], voffB[1]);
    PG8_WAIT_V(6); PG8_BAR;
    for (;;) {
        const bool has_next = S.next(ui + 1, nxt);
        const char* nA = GATHER ? cA : (has_next ? nxt.A : cA); const char* nB = has_next ? nxt.B : cB;
        unsigned tok_[2][2] = {{0u, 0u}, {0u, 0u}};
#define PG8_KBODY(a1, a2, b2, a3, b3, W00, W01, W10, W11) do { \
              \
            PG8_LDB(B0, 0, 0); PG8_LDB(B1, 0, 1); PG8_SCHED; PG8_LDA(At, 0, 0); PG8_STAGE(PG8_SA(1, 1), a1, vA[1][0], vA[1][1]); \
            PG8_WAIT_V(8); PG8_WAIT_L(0); PG8_BAR; PG8_MMA(0, 0, At, B0); PG8_MMA(0, 1, At, B1); PG8_BAR; PG8_SCHED; \
              \
            PG8_LDA(At, 0, 1); PG8_STAGE(PG8_SB(0, 0), b2, voffB[0], voffB[1]); PG8_STAGE(PG8_SB(0, 1), (b2) + hstep, voffB[0], voffB[1]); PG8_STAGE(PG8_SA(0, 0), a2, W00, W01); \
            PG8_WAIT_V(8); PG8_WAIT_L(0); PG8_BAR; PG8_MMA(1, 0, At, B0); PG8_MMA(1, 1, At, B1); PG8_BAR; PG8_SCHED; \
              \
            PG8_LDB(B0, 1, 0); PG8_LDB(B1, 1, 1); PG8_SCHED; PG8_LDA(At, 1, 0); PG8_STAGE(PG8_SA(0, 1), a2, W10, W11); \
            PG8_WAIT_V(8); PG8_WAIT_L(0); PG8_BAR; PG8_MMA(0, 0, At, B0); PG8_MMA(0, 1, At, B1); PG8_BAR; PG8_SCHED; \
              \
            PG8_LDA(At, 1, 1); PG8_STAGE(PG8_SB(1, 0), b3, voffB[0], voffB[1]); PG8_STAGE(PG8_SB(1, 1), (b3) + hstep, voffB[0], voffB[1]); PG8_STAGE(PG8_SA(1, 0), a3, W00, W01); \
            PG8_WAIT_V(8); PG8_WAIT_L(0); PG8_BAR; PG8_MMA(1, 0, At, B0); PG8_MMA(1, 1, At, B1); PG8_BAR; PG8_SCHED; } while (0)
        for (int t = 0; t < nt - 2; t += 2) {
            const char* a1 = cA + (size_t)(t + 1) * kstep;
            const char* a2 = cA + (size_t)(t + 2) * kstep; const char* b2 = cB + (size_t)(t + 2) * kstep;
            const char* a3 = a2 + kstep; const char* b3 = b2 + kstep;
            if (GATHER) { if (t == nt - 4 && has_next) { int t2_ = tid; asm volatile("" : "+v"(t2_));
#pragma unroll
                for (int i = 0; i < 2; ++i) { int R, C; stage_rc(t2_ * 16 + i * 8192, R, C);
#pragma unroll
                    for (int h = 0; h < 2; ++h) { const unsigned vo = S.tokoff(nxt, h * HALF + R); asm volatile("global_load_dword %0, %1, %2" : "=v"(tok_[h][i]) : "v"(vo), "s"(S.tokbase()) : "memory"); } } } }
            PG8_KBODY(a1, a2, b2, a3, b3, vA[0][0], vA[0][1], vA[1][0], vA[1][1]);
        }
        if (GATHER) {
            if (has_next) { int t2_ = tid; asm volatile("" : "+v"(t2_), "+v"(tok_[0][0]), "+v"(tok_[0][1]), "+v"(tok_[1][0]), "+v"(tok_[1][1]));
#pragma unroll
                for (int i = 0; i < 2; ++i) { int R, C; stage_rc(t2_ * 16 + i * 8192, R, C);
#pragma unroll
                    for (int h = 0; h < 2; ++h) vN[h][i] = tok_[h][i] * (unsigned)(K * 2) + (unsigned)C * 2u; } }
            else {
#pragma unroll
                for (int h = 0; h < 2; ++h)
#pragma unroll
                    for (int i = 0; i < 2; ++i) vN[h][i] = vA[h][i];
            }
        }
        {
            const char* a1 = cA + (size_t)(nt - 1) * kstep;
            const char* a3 = nA + kstep; const char* b3 = nB + kstep;
            PG8_KBODY(a1, nA, nB, a3, b3, vN[0][0], vN[0][1], vN[1][0], vN[1][1]);
        }
#undef PG8_KBODY
        if constexpr (ALIGN_EPI) { if (wr == 0) PG8_BAR; }
        { int t3_ = tid; asm volatile("" : "+v"(t3_)); const int l3_ = t3_ & 63; E(acc, cur, wr, wc, l3_ & 15, l3_ >> 4); }
        if (!has_next) break;
#pragma unroll
        for (int a = 0; a < 2; ++a)
#pragma unroll
            for (int b = 0; b < 2; ++b)
#pragma unroll
                for (int m = 0; m < 4; ++m)
#pragma unroll
                    for (int n = 0; n < 2; ++n) acc[a][b][m][n] = (f32x4){0.f, 0.f, 0.f, 0.f};
        cur = nxt; cA = nA; cB = nB; ++ui;
        if (GATHER) {
#pragma unroll
            for (int h = 0; h < 2; ++h)
#pragma unroll
                for (int i = 0; i < 2; ++i) vA[h][i] = vN[h][i];
        }
        if constexpr (ALIGN_EPI) { if (wr == 1) PG8_BAR; }
    }
    PG8_WAIT_V(0);
    if constexpr (!ALIGN_EPI) { if (wr == 0) PG8_BAR; }
    PG8_BAR;
#undef PG8_AOFFS
#undef PG8_SA
#undef PG8_SB
#undef PG8_STAGE
#undef PG8_LDA
#undef PG8_LDB
#undef PG8_MMA
#undef PG8_WAIT_V
#undef PG8_WAIT_L
#undef PG8_BAR
#undef PG8_SCHED
}


constexpr int TS_OFF = 131072 + 1024;
template <bool GATHER> struct MoeOrder {
    const char* A; const char* Bt; const int* rowtok; int nN, nwg, nM, G, c, K; size_t strideE;
    __device__ __forceinline__ void init(const bf16_t* A_, const bf16_t* Bt_, const int* rowtok_, int N, int K_, size_t strideE_, int G_, int c_) {
        A = (const char*)A_; Bt = (const char*)Bt_; rowtok = rowtok_; nN = N / BM; K = K_; strideE = strideE_; G = G_; c = c_;
        nM = __builtin_amdgcn_readfirstlane(((LAS const int*)(LDSP + TS_OFF))[32]); nwg = nM * nN; }
    __device__ __forceinline__ bool next(int i, GUnit& u) const {
        const long L = (long)i * G + c; if (L >= nwg) return false;
        int wgid = (int)L; { const int q = nwg / NXCD, r = nwg % NXCD, xcd = wgid % NXCD, off = wgid / NXCD; wgid = (xcd < r ? xcd * (q + 1) : r * (q + 1) + (xcd - r) * q) + off; }
        const int nig = WGM * nN, gid = wgid / nig, fm = gid * WGM, gsz = (nM - fm) < WGM ? (nM - fm) : WGM;
        u.pm = fm + ((wgid % nig) % gsz); u.pn = (wgid % nig) / gsz;
        LAS const int* ts = (LAS const int*)(LDSP + TS_OFF);
        const int e = __builtin_amdgcn_readfirstlane(ts[72 + u.pm]);
        u.e = e; u.row0 = (u.pm - __builtin_amdgcn_readfirstlane(ts[e])) * BM; u.cnt = __builtin_amdgcn_readfirstlane(ts[33 + e]);
        u.A = GATHER ? A : A + (size_t)u.pm * BM * K * 2;
        u.B = Bt + (size_t)e * strideE + (size_t)u.pn * BM * K * 2; return true;
    }
    __device__ __forceinline__ unsigned aoff(const GUnit& u, int row) const {
        if (GATHER) { int sl = u.row0 + row; sl = sl < u.cnt ? sl : u.cnt - 1; return (unsigned)rowtok[u.e * ECAP + sl] * (unsigned)(K * 2); }
        return (unsigned)(row * K * 2);
    }
    __device__ __forceinline__ unsigned tokoff(const GUnit& u, int row) const { int sl = u.row0 + row; sl = sl < u.cnt ? sl : u.cnt - 1; return (unsigned)(u.e * ECAP + sl) * 4u; }
    __device__ __forceinline__ const int* tokbase() const { return rowtok; }
};
__device__ __forceinline__ void moe_tiles(const unsigned* cnt, int tid) {
    LAS int* ts = (LAS int*)(LDSP + TS_OFF);
    if (tid == 0) { int s = 0; for (int e = 0; e < NEXP; ++e) { const int c = (int)cnt[e]; ts[e] = s; ts[33 + e] = c; const int n = (c + BM - 1) / BM;
_Pragma("clang loop vectorize(disable) unroll(disable)") for (int t = 0; t < n; ++t) ts[72 + s + t] = e;
            s += n; } ts[NEXP] = s; }
    __syncthreads();
}
struct EpiMoe1 {
    static constexpr bool PERM = true;
    bf16_t* O; const float* b1; const float* rsc;
    __device__ __forceinline__ void operator()(const f32x4 (&acc)[2][2][4][2], const GUnit& u, int wr, int wc, int fr, int fq) const {
        const int rt0 = wr * 64 + fr, col0 = u.pn * 128 + wc * 32 + 8 * fq;
        const float* bg = b1 + (size_t)u.e * 2048 + col0;
        f32x4 bgv[2], blv[2];
#pragma unroll
        for (int n = 0; n < 2; ++n) { bgv[n] = *(const f32x4*)(bg + 4 * n); blv[n] = *(const f32x4*)(bg + DFF + 4 * n); }
#pragma unroll
        for (int ai = 0; ai < 2; ++ai)
#pragma unroll
            for (int m = 0; m < 4; ++m) {
                const int rt = rt0 + ai * HALF + m * 16; int sl = u.row0 + rt; sl = sl < u.cnt ? sl : u.cnt - 1;
                const float r = rsc[u.e * ECAP + sl];
                float o[8];
#pragma unroll
                for (int n = 0; n < 2; ++n)
#pragma unroll
                    for (int j = 0; j < 4; ++j) {
                        const float g = fminf(r * acc[ai][0][m][n][j] + bgv[n][j], 7.f);
                        const float l = fminf(fmaxf(r * acc[ai][1][m][n][j] + blv[n][j], -7.f), 7.f);
                        o[n * 4 + j] = g * __builtin_amdgcn_rcpf(1.f + __builtin_amdgcn_exp2f(-2.4554669595930157f * g)) * (l + 1.f);
                    }
                u32x4 w; w.x = cvt_pk_bf16(o[0], o[1]); w.y = cvt_pk_bf16(o[2], o[3]); w.z = cvt_pk_bf16(o[4], o[5]); w.w = cvt_pk_bf16(o[6], o[7]);
                *(u32x4*)(O + (size_t)(u.pm * BM + rt) * DFF + col0) = w;
            }
    }
};
struct EpiMoe2 {
    static constexpr bool PERM = true;
    bf16_t* O; const float* b2;
    __device__ __forceinline__ void operator()(const f32x4 (&acc)[2][2][4][2], const GUnit& u, int wr, int wc, int fr, int fq) const {
        const int row0 = u.pm * BM + wr * 64 + fr, col0 = u.pn * BM + wc * 32 + 8 * fq;
        f32x4 bv[2][2];
#pragma unroll
        for (int bj = 0; bj < 2; ++bj)
#pragma unroll
            for (int n = 0; n < 2; ++n) bv[bj][n] = *(const f32x4*)(b2 + (size_t)u.e * DM + col0 + bj * HALF + 4 * n);
#pragma unroll
        for (int ai = 0; ai < 2; ++ai)
#pragma unroll
            for (int m = 0; m < 4; ++m) { bf16_t* rowp = O + (size_t)(row0 + ai * HALF + m * 16) * DM + col0;
#pragma unroll
                for (int bj = 0; bj < 2; ++bj) { const f32x4 v0 = acc[ai][bj][m][0] + bv[bj][0], v1 = acc[ai][bj][m][1] + bv[bj][1];
                    u32x4 w; w.x = cvt_pk_bf16(v0[0], v0[1]); w.y = cvt_pk_bf16(v0[2], v0[3]); w.z = cvt_pk_bf16(v1[0], v1[1]); w.w = cvt_pk_bf16(v1[2], v1[3]);
                    *(u32x4*)(rowp + bj * HALF) = w; } }
    }
};

__device__ __forceinline__ void p_transpose_r(const int wv, const float* W, int nmat, int K, int N, bf16_t* WT, const float* kgain, int gdiv, int mode, LAS unsigned char* lds, int it_begin, int it_end, int wrank, int wstride) {
    LTID();
    const int wave = wv, lane = tidx & 63;
    LAS float* scr = (LAS float*)(lds + wave * 16384);
    const int nblk = N / 32, per_mat = (K / 64) * nblk, total = it_end, stride = wstride;
    const int lrow = lane >> 5, lcol = lane & 31;
#define TR_DECODE(item, mat_, kb_, nb_) const int mat_ = (item) / per_mat, r_ = (item) - mat_ * per_mat, g8_ = r_ >> 3, l8_ = r_ & 7, kb_ = 2 * (g8_ / (nblk >> 2)) + (l8_ & 1), nb_ = 4 * (g8_ % (nblk >> 2)) + (l8_ >> 1)
#define TR_ISSUE(item, dst) do { TR_DECODE(item, mat_, kb_, nb_); \
        const float* src_ = W + (size_t)mat_ * K * N + (size_t)(64 * kb_ + lrow) * N + 32 * nb_ + lcol; \
        _Pragma("unroll") for (int i = 0; i < 32; ++i) dst[i] = __builtin_nontemporal_load(src_ + (size_t)(2 * i) * N); } while (0)
    float v[32], vn[32], vnn[32];
    int it = it_begin + wrank;
    if (it < total) TR_ISSUE(it, v);
    if (it + stride < total) TR_ISSUE(it + stride, vn);
    while (it < total) {
        const int itn = it + stride, itnn = itn + stride;
        if (itnn < total) TR_ISSUE(itnn, vnn);
        TR_DECODE(it, mat, kb, nb); const int k0 = 64 * kb, n0 = 32 * nb;
#pragma unroll
        for (int i = 0; i < 32; ++i) scr[(2 * i + lrow) * 33 + lcol] = v[i];
        asm volatile("s_waitcnt lgkmcnt(0)" ::: "memory");
        int d0 = n0;
        if (mode == 1) { const int bj = n0 >> 10, rest = n0 & 1023, pn = rest >> 7, j = rest & 127; d0 = pn * 256 + bj * 128 + j; }
        const int c = lane & 7;
        f32x4 g0 = (f32x4){1.f, 1.f, 1.f, 1.f}, g1 = g0;
        if (kgain) { const float* gp = kgain + (size_t)(mat / gdiv) * DM + k0 + 8 * c; g0 = *(const f32x4*)gp; g1 = *(const f32x4*)(gp + 4); }
        bf16_t* dst = WT + (size_t)mat * K * N;
#pragma unroll
        for (int j = 0; j < 4; ++j) { const int n = (lane >> 3) + 8 * j; const LAS float* sp = scr + (8 * c) * 33 + n;
            u32x4 o; o.x = cvt_pk_bf16(sp[0 * 33] * g0[0], sp[1 * 33] * g0[1]); o.y = cvt_pk_bf16(sp[2 * 33] * g0[2], sp[3 * 33] * g0[3]); o.z = cvt_pk_bf16(sp[4 * 33] * g1[0], sp[5 * 33] * g1[1]); o.w = cvt_pk_bf16(sp[6 * 33] * g1[2], sp[7 * 33] * g1[3]);
            __builtin_nontemporal_store(o, (u32x4*)(dst + (size_t)(d0 + n) * K + k0 + 8 * c)); }
        asm volatile("s_waitcnt lgkmcnt(0)" ::: "memory");
#pragma unroll
        for (int i = 0; i < 32; ++i) { v[i] = vn[i]; vn[i] = vnn[i]; }
        it = itn;
    }
#undef TR_ISSUE
#undef TR_DECODE
}
__device__ __forceinline__ void p_transpose(const int wv, const float* W, int nmat, int K, int N, bf16_t* WT, const float* kgain, int gdiv, int mode, LAS unsigned char* lds) {
    p_transpose_r(wv, W, nmat, K, N, WT, kgain, gdiv, mode, lds, 0, nmat * (K / 64) * (N / 32), (int)blockIdx.x * NW + wv, (int)gridDim.x * NW);
}
typedef short v4i16_t __attribute__((ext_vector_type(4)));
constexpr int ATT_TAB_OFF = 131072 + 2048;
constexpr int ATT_UNITS = 3 * 8 * 128;
__device__ __forceinline__ int t5_bucket_dev(int n) {
    if (n < 16) return n;
    const float v = logf((float)n / 16.f) / 4.852030263919617f * 16.f;
    const int large = 16 + (int)v;
    return large < 31 ? large : 31;
}
__device__ __forceinline__ void p_bias_table(const int wv, const float* rel_bias, float* biasG) {
    LTID();
    for (int i = bidx * NT + tidx; i < 3 * 8 * 132; i += gridDim.x * NT) {
        const int d = i % 132, bh = i / 132, h = bh & 7, b = bh >> 3;
        biasG[i] = (d <= 128) ? rel_bias[t5_bucket_dev(d << (2 * b)) * 8 + h] : 0.f;
    }
}
__device__ __forceinline__ void p_dil_attn(const int wv, const bf16_t* proj16, const float* biasG, bf16_t* obr, float* lse, LAS unsigned char* lds) {
    LTID();
    const int lane = tidx & 63, fr = lane & 15, fq = lane >> 4, w = wv;
    const int per = (ATT_UNITS + (int)gridDim.x - 1) / (int)gridDim.x;
    const int u0 = bidx * per, u1 = (u0 + per < ATT_UNITS) ? u0 + per : ATT_UNITS;
    if (u0 >= u1) return;
    const int rowl = tidx >> 3, cs = tidx & 7;
    const unsigned cK = (unsigned)(cs ^ ((rowl >> 1) & 7)) * 16u, cV = (unsigned)(cs ^ (rowl & 7)) * 16u;
    const unsigned fK = (unsigned)((fr >> 1) & 7);
    const unsigned kro0 = (unsigned)fr * 128u + (((unsigned)fq ^ fK) * 16u), kro1 = (unsigned)fr * 128u + ((((unsigned)fq ^ fK) ^ 4u) * 16u);
    const int tq = (lane & 15) >> 2, tp = lane & 3, fv = 4 * (fq & 1) + tq;
    unsigned vro[4];
#pragma unroll
    for (int db = 0; db < 4; ++db) vro[db] = (unsigned)(4 * fq + tq) * 128u + (unsigned)(((2 * db + (tp >> 1)) ^ fv) * 16) + 8u * (unsigned)(tp & 1);
    const int ts_ = (1 + fr) & 3;
    const unsigned tab8 = (unsigned)ATT_TAB_OFF + (unsigned)ts_ * 640u + (unsigned)(((141 + fr - ts_) >> 2) - fq - 32) * 16u;
    const char* gbase = (const char*)proj16;
#define ATT_DECODE(u, b_, h_, r_, n_, dil_) const int cmb_ = (u) >> 7, b_ = cmb_ >> 3, h_ = cmb_ & 7, dil_ = 1 << (2 * b_), idx_ = (u) & 127, r_ = idx_ & (dil_ - 1), n_ = idx_ >> (2 * b_)
#define ATT_ISSUE(u, bf, q0, q1) do { ATT_DECODE(u, b__, h__, r__, n__, dil__); \
        const int nk = n__ > 0 ? n__ - 1 : 0;                                     \
        _Pragma("unroll") for (int p = 0; p < 4; ++p) { \
            int row = 64 * p + rowl; int blk = (row >> 7) ? n__ : nk; \
            const unsigned pos = (unsigned)(r__ + dil__ * (128 * blk + (row & 127))); \
            const unsigned so = pos * 4096u + (unsigned)h__ * 128u; const unsigned ld_ = (unsigned)(size_t)(lds + (bf) * 65536 + p * 8192 + w * 1024); \
            glds16s(gbase, so + 1024u + cK, ld_); glds16s(gbase, so + 2048u + cV, ld_ + 32768u); } \
        const unsigned qpos = (unsigned)(r__ + dil__ * (128 * n__ + 16 * w + fr)); \
        const char* qsrc = gbase + (size_t)qpos * 4096u + (unsigned)h__ * 128u + (unsigned)fq * 16u; \
        q0 = *(const bf16x8*)(qsrc); q1 = *(const bf16x8*)(qsrc + 64); } while (0)
    bf16x8 qf0, qf1, qn0, qn1;
    ATT_ISSUE(u0, 0, qn0, qn1);
    int prev_cmb = -1;
    for (int u = u0; u < u1; ++u) {
        const int bf = (u - u0) & 1;
        asm volatile("s_waitcnt vmcnt(0)" ::: "memory");
        __syncthreads();
        qf0 = qn0; qf1 = qn1;
        if (u + 1 < u1) ATT_ISSUE(u + 1, bf ^ 1, qn0, qn1);
        ATT_DECODE(u, b, h, r, n, dil);
        if (cmb_ != prev_cmb) {
            prev_cmb = cmb_;
            for (int e = tidx; e < 4 * 160; e += NT) { const int sft = e / 160, k = e - sft * 160, idx = k + sft, dist = idx - 16;
                const float v = (dist >= 0 && dist <= 128) ? biasG[cmb_ * 132 + dist] : -1e30f;
                ((LAS float*)(lds + ATT_TAB_OFF))[sft * 160 + k] = v; }
            __syncthreads();
        }
        const LAS unsigned char* Kb = lds + bf * 65536; const LAS unsigned char* Vb = Kb + 32768;
        const int kb0 = w;
        f32x4 sc[9];
#pragma unroll
        for (int i = 0; i < 9; ++i) {
            const unsigned ko = (unsigned)(kb0 + i) * 2048u;
            const bf16x8 k0 = *(const LAS bf16x8*)(Kb + ko + kro0), k1 = *(const LAS bf16x8*)(Kb + ko + kro1);
            f32x4 a = (f32x4){0.f, 0.f, 0.f, 0.f};
            a = __builtin_amdgcn_mfma_f32_16x16x32_bf16(k0, qf0, a, 0, 0, 0);
            a = __builtin_amdgcn_mfma_f32_16x16x32_bf16(k1, qf1, a, 0, 0, 0);
            const f32x4 t = *(const LAS f32x4*)(lds + tab8 + 64 * (8 - i));
            a = a + (f32x4){t[3], t[2], t[1], t[0]};
            if (n == 0 && kb0 + i < 8) a = (f32x4){-1e30f, -1e30f, -1e30f, -1e30f};
            sc[i] = a;
        }
        float mx = -1e30f;
#pragma unroll
        for (int i = 0; i < 9; ++i) mx = fmaxf(mx, fmaxf(fmaxf(sc[i][0], sc[i][1]), fmaxf(sc[i][2], sc[i][3])));
        mx = fmaxf(mx, shx(mx, 16, lane)); mx = fmaxf(mx, shx(mx, 32, lane));
        float sum = 0.f;
#pragma unroll
        for (int i = 0; i < 9; ++i)
#pragma unroll
            for (int j = 0; j < 4; ++j) { const float p = __expf(sc[i][j] - mx); sc[i][j] = p; sum += p; }
        sum += shx(sum, 16, lane); sum += shx(sum, 32, lane);
        f32x4 oacc[4];
#pragma unroll
        for (int db = 0; db < 4; ++db) oacc[db] = (f32x4){0.f, 0.f, 0.f, 0.f};
#pragma unroll
        for (int c = 0; c < 5; ++c) {
            const int ia = 2 * c, ib = (c < 4) ? 2 * c + 1 : 8;
            u32x4 pw; pw.x = cvt_pk_bf16(sc[ia][0], sc[ia][1]); pw.y = cvt_pk_bf16(sc[ia][2], sc[ia][3]);
            if (c < 4) { pw.z = cvt_pk_bf16(sc[ib][0], sc[ib][1]); pw.w = cvt_pk_bf16(sc[ib][2], sc[ib][3]); } else { pw.z = 0u; pw.w = 0u; }
            const bf16x8 pf = __builtin_bit_cast(bf16x8, pw);
            const unsigned va = (unsigned)(kb0 + ia) * 2048u, vb = (unsigned)(kb0 + ib) * 2048u;
#pragma unroll
            for (int db = 0; db < 4; ++db) {
                const v4i16_t x0 = __builtin_amdgcn_ds_read_tr16_b64_v4i16((LAS v4i16_t*)(Vb + va + vro[db]));
                const v4i16_t x1 = __builtin_amdgcn_ds_read_tr16_b64_v4i16((LAS v4i16_t*)(Vb + vb + vro[db]));
                const bf16x8 vf = (bf16x8){x0[0], x0[1], x0[2], x0[3], x1[0], x1[1], x1[2], x1[3]};
                oacc[db] = __builtin_amdgcn_mfma_f32_16x16x32_bf16(vf, pf, oacc[db], 0, 0, 0);
            }
        }
        const float inv = 1.f / sum;
        const unsigned qpos = (unsigned)(r + dil * (128 * n + 16 * w + fr));
        bf16_t* orow = obr + ((size_t)b * SEQ + qpos) * 512 + h * 64 + 4 * fq;
#pragma unroll
        for (int db = 0; db < 4; ++db) { u32x2 o2; o2.x = cvt_pk_bf16(oacc[db][0] * inv, oacc[db][1] * inv); o2.y = cvt_pk_bf16(oacc[db][2] * inv, oacc[db][3] * inv); *(u32x2*)(orow + 16 * db) = o2; }
        if (fq == 0) lse[((size_t)b * SEQ + qpos) * 8 + h] = mx + __logf(sum);
    }
    asm volatile("s_waitcnt vmcnt(0)" ::: "memory");
    __syncthreads();
#undef ATT_DECODE
#undef ATT_ISSUE
}
__device__ __forceinline__ void p_attn_combine(const int wv, const bf16_t* obr, const float* lse, const float* g, bf16_t* mix16) {
    LTID();
    const int lane = tidx & 63, h = lane >> 3;
    const f32x4 g0 = *(const f32x4*)(g + lane * 8), g1 = *(const f32x4*)(g + lane * 8 + 4);
    const int rstride = (int)gridDim.x * NW;
    for (int row0 = bidx * NW + wv; row0 < SEQ; row0 += 4 * rstride) {
        float lv[4][3]; u32x4 av[4][3];
#pragma unroll
        for (int r = 0; r < 4; ++r) { const int row = (row0 + r * rstride < SEQ) ? row0 + r * rstride : row0;
#pragma unroll
            for (int b = 0; b < 3; ++b) { lv[r][b] = lse[((size_t)b * SEQ + row) * 8 + h]; av[r][b] = *(const u32x4*)(obr + ((size_t)b * SEQ + row) * 512 + lane * 8); } }
#pragma unroll
        for (int r = 0; r < 4; ++r) {
            const int row = row0 + r * rstride;
            const float M = fmaxf(lv[r][0], fmaxf(lv[r][1], lv[r][2]));
            float w0 = __expf(lv[r][0] - M), w1 = __expf(lv[r][1] - M), w2 = __expf(lv[r][2] - M);
            const float iw = 1.f / (w0 + w1 + w2); w0 *= iw; w1 *= iw; w2 *= iw;
            float y[8]; float ss = 0.f;
#pragma unroll
            for (int k = 0; k < 4; ++k) {
                const float lo = w0 * __builtin_bit_cast(float, av[r][0][k] << 16) + w1 * __builtin_bit_cast(float, av[r][1][k] << 16) + w2 * __builtin_bit_cast(float, av[r][2][k] << 16);
                const float hi = w0 * __builtin_bit_cast(float, av[r][0][k] & 0xffff0000u) + w1 * __builtin_bit_cast(float, av[r][1][k] & 0xffff0000u) + w2 * __builtin_bit_cast(float, av[r][2][k] & 0xffff0000u);
                y[2 * k] = lo; y[2 * k + 1] = hi; ss += lo * lo + hi * hi;
            }
#pragma unroll
            for (int o = 32; o; o >>= 1) ss += shx(ss, o, lane);
            const float sc = rsqrtf(ss * (1.f / 512.f) + 1e-5f);
            u32x4 o4; o4.x = cvt_pk_bf16(y[0] * sc * g0[0], y[1] * sc * g0[1]); o4.y = cvt_pk_bf16(y[2] * sc * g0[2], y[3] * sc * g0[3]);
            o4.z = cvt_pk_bf16(y[4] * sc * g1[0], y[5] * sc * g1[1]); o4.w = cvt_pk_bf16(y[6] * sc * g1[2], y[7] * sc * g1[3]);
            if (row < SEQ) *(u32x4*)(mix16 + (size_t)row * DM + lane * 8) = o4;
        }
    }
}
struct EpiIn {
    static constexpr bool PERM = true;
    bf16_t* O;
    __device__ __forceinline__ void operator()(const f32x4 (&acc)[2][2][4][2], const GUnit& u, int wr, int wc, int fr, int fq) const {
        const int row0 = u.pm * BM + wr * 64 + fr, col0 = u.pn * BM + wc * 32 + 8 * fq;
        const float sc = u.pn < 2 ? 0.125f : 1.f;
#pragma unroll
        for (int ai = 0; ai < 2; ++ai)
#pragma unroll
            for (int m = 0; m < 4; ++m) { const size_t ro = (size_t)(row0 + ai * HALF + m * 16) * DIN + col0;
#pragma unroll
                for (int bj = 0; bj < 2; ++bj) { const f32x4 v0 = acc[ai][bj][m][0] * sc, v1 = acc[ai][bj][m][1] * sc;
                    u32x4 w; w.x = cvt_pk_bf16(v0[0], v0[1]); w.y = cvt_pk_bf16(v0[2], v0[3]); w.z = cvt_pk_bf16(v1[0], v1[1]); w.w = cvt_pk_bf16(v1[2], v1[3]);
                    *(u32x4*)(O + ro + bj * HALF) = w;
                    } }
    }
};


__device__ __forceinline__ unsigned xoff_b(unsigned row, unsigned ch) { return 256u * row + 16u * (ch ^ (((row & 3u) << 2) | ((row >> 2) & 3u))); }
__device__ __forceinline__ void p_xattn_mfma(const int wv, const bf16_t* qx16, const bf16_t* kv16, bf16_t* ox16, LAS unsigned char* lds) {
    LTID();
    const int lane = tidx & 63, fr = lane & 15, fq = lane >> 4, w = wv;
    const int NU = 4 * 128;
    const int per = (NU + (int)gridDim.x - 1) / (int)gridDim.x;
    const int u0 = bidx * per, u1 = (u0 + per < NU) ? u0 + per : NU;
    if (u0 >= u1) return;
    const int rowl = tidx >> 4, cs = tidx & 15;
    const unsigned csw = (unsigned)(cs ^ (((rowl & 3) << 2) | ((rowl >> 2) & 3))) * 16u;
    const unsigned kswz = (unsigned)(((fr & 3) << 2) | ((fr >> 2) & 3));
    unsigned kro[4];
#pragma unroll
    for (int s4 = 0; s4 < 4; ++s4) kro[s4] = 256u * (unsigned)fr + 16u * ((unsigned)(4 * s4 + fq) ^ kswz);
    const int tq = (lane & 15) >> 2, tp = lane & 3;
    const unsigned vswz = (unsigned)((tq << 2) | fq);
    unsigned vro[8];
#pragma unroll
    for (int c = 0; c < 8; ++c) vro[c] = 65536u + 256u * (unsigned)(4 * fq + tq) + 16u * ((unsigned)(2 * c + (tp >> 1)) ^ vswz) + 8u * (unsigned)(tp & 1);
    int prev_h = -1;
    for (int u = u0; u < u1; ++u) {
        const int h = u >> 7, qt = u & 127;
        if (h != prev_h) {
            __syncthreads();
            prev_h = h;
#pragma unroll
            for (int p = 0; p < 8; ++p) {
                const unsigned row = (unsigned)(32 * p + rowl);
                const unsigned so = row * 2048u + (unsigned)h * 256u + csw;
                const unsigned ld_ = (unsigned)(size_t)(lds + p * 8192 + w * 1024);
                glds16s(kv16, so, ld_); glds16s(kv16, so + 1024u, ld_ + 65536u);
            }
            asm volatile("s_waitcnt vmcnt(0)" ::: "memory");
            __syncthreads();
        }
        const char* qsrc = (const char*)qx16 + ((size_t)(qt * 128 + 16 * w + fr) * 512 + h * 128 + 8 * fq) * 2;
        bf16x8 qf[4];
#pragma unroll
        for (int s4 = 0; s4 < 4; ++s4) qf[s4] = *(const bf16x8*)(qsrc + 64 * s4);
        f32x4 sc[16];
#pragma unroll
        for (int i = 0; i < 16; ++i) {
            f32x4 a = (f32x4){0.f, 0.f, 0.f, 0.f};
#pragma unroll
            for (int s4 = 0; s4 < 4; ++s4) { const bf16x8 kf = *(const LAS bf16x8*)(lds + i * 4096 + kro[s4]); a = __builtin_amdgcn_mfma_f32_16x16x32_bf16(kf, qf[s4], a, 0, 0, 0); }
            sc[i] = a;
        }
        float mx = -1e30f;
#pragma unroll
        for (int i = 0; i < 16; ++i) mx = fmaxf(mx, fmaxf(fmaxf(sc[i][0], sc[i][1]), fmaxf(sc[i][2], sc[i][3])));
        mx = fmaxf(mx, shx(mx, 16, lane)); mx = fmaxf(mx, shx(mx, 32, lane));
        float sum = 0.f;
#pragma unroll
        for (int i = 0; i < 16; ++i)
#pragma unroll
            for (int j = 0; j < 4; ++j) { const float p = __expf(sc[i][j] - mx); sc[i][j] = p; sum += p; }
        sum += shx(sum, 16, lane); sum += shx(sum, 32, lane);
        f32x4 oacc[8];
#pragma unroll
        for (int c = 0; c < 8; ++c) oacc[c] = (f32x4){0.f, 0.f, 0.f, 0.f};
#pragma unroll
        for (int ch = 0; ch < 8; ++ch) {
            const int ia = 2 * ch, ib = 2 * ch + 1;
            u32x4 pw; pw.x = cvt_pk_bf16(sc[ia][0], sc[ia][1]); pw.y = cvt_pk_bf16(sc[ia][2], sc[ia][3]); pw.z = cvt_pk_bf16(sc[ib][0], sc[ib][1]); pw.w = cvt_pk_bf16(sc[ib][2], sc[ib][3]);
            const bf16x8 pf = __builtin_bit_cast(bf16x8, pw);
#pragma unroll
            for (int c = 0; c < 8; ++c) {
                const v4i16_t x0 = __builtin_amdgcn_ds_read_tr16_b64_v4i16((LAS v4i16_t*)(lds + ia * 4096 + vro[c]));
                const v4i16_t x1 = __builtin_amdgcn_ds_read_tr16_b64_v4i16((LAS v4i16_t*)(lds + ib * 4096 + vro[c]));
                const bf16x8 vf = (bf16x8){x0[0], x0[1], x0[2], x0[3], x1[0], x1[1], x1[2], x1[3]};
                oacc[c] = __builtin_amdgcn_mfma_f32_16x16x32_bf16(vf, pf, oacc[c], 0, 0, 0);
            }
        }
        const float inv = 1.f / sum;
        bf16_t* orow = ox16 + (size_t)(qt * 128 + 16 * w + fr) * 512 + h * 128 + 4 * fq;
#pragma unroll
        for (int c = 0; c < 8; ++c) { u32x2 o2; o2.x = cvt_pk_bf16(oacc[c][0] * inv, oacc[c][1] * inv); o2.y = cvt_pk_bf16(oacc[c][2] * inv, oacc[c][3] * inv); *(u32x2*)(orow + 16 * c) = o2; }
    }
    __syncthreads();
}
struct EpiBf16 {
    static constexpr bool PERM = true;
    bf16_t* O; int ldc; float scale; const float* ss;
    __device__ __forceinline__ void operator()(const f32x4 (&acc)[2][2][4][2], const GUnit& u, int wr, int wc, int fr, int fq) const {
        const int row0 = u.pm * BM + wr * 64 + fr, col0 = u.pn * BM + wc * 32 + 8 * fq;
#pragma unroll
        for (int ai = 0; ai < 2; ++ai)
#pragma unroll
            for (int m = 0; m < 4; ++m) { const int row = row0 + ai * HALF + m * 16; bf16_t* rowp = O + (size_t)row * ldc + col0;
                float sc = scale;
                if (ss) { const f32x4 p0 = *(const f32x4*)(ss + (size_t)row * 16), p1 = *(const f32x4*)(ss + (size_t)row * 16 + 4), p2 = *(const f32x4*)(ss + (size_t)row * 16 + 8), p3 = *(const f32x4*)(ss + (size_t)row * 16 + 12);
                    const float t = ((p0[0] + p0[1]) + (p0[2] + p0[3])) + ((p1[0] + p1[1]) + (p1[2] + p1[3])) + ((p2[0] + p2[1]) + (p2[2] + p2[3])) + ((p3[0] + p3[1]) + (p3[2] + p3[3]));
                    sc = scale * rsqrtf(t * (1.f / 1024.f) + 1e-5f); }
#pragma unroll
                for (int bj = 0; bj < 2; ++bj) { const f32x4 v0 = acc[ai][bj][m][0] * sc, v1 = acc[ai][bj][m][1] * sc;
                    u32x4 w; w.x = cvt_pk_bf16(v0[0], v0[1]); w.y = cvt_pk_bf16(v0[2], v0[3]); w.z = cvt_pk_bf16(v1[0], v1[1]); w.w = cvt_pk_bf16(v1[2], v1[3]);
                    *(u32x4*)(rowp + bj * HALF) = w; } }
    }
};
struct EpiOut {
    static constexpr bool PERM = true;
    const float* R; float* H; bf16_t* HB; float* ss;
    __device__ __forceinline__ void operator()(const f32x4 (&acc)[2][2][4][2], const GUnit& u, int wr, int wc, int fr, int fq) const {
        const int row0 = u.pm * BM + wr * 64 + fr, col0 = u.pn * BM + wc * 32 + 8 * fq, lane = fq * 16 + fr;
#pragma unroll
        for (int ai = 0; ai < 2; ++ai)
#pragma unroll
            for (int m = 0; m < 4; ++m) { const int row = row0 + ai * HALF + m * 16; const size_t ro = (size_t)row * DM + col0; float sq = 0.f;
#pragma unroll
                for (int bj = 0; bj < 2; ++bj) {
                    const f32x4 v0 = acc[ai][bj][m][0] + *(const f32x4*)(R + ro + bj * HALF), v1 = acc[ai][bj][m][1] + *(const f32x4*)(R + ro + bj * HALF + 4);
                    *(f32x4*)(H + ro + bj * HALF) = v0; *(f32x4*)(H + ro + bj * HALF + 4) = v1;
                    u32x4 w; w.x = cvt_pk_bf16(v0[0], v0[1]); w.y = cvt_pk_bf16(v0[2], v0[3]); w.z = cvt_pk_bf16(v1[0], v1[1]); w.w = cvt_pk_bf16(v1[2], v1[3]);
                    *(u32x4*)(HB + ro + bj * HALF) = w;
                    sq += (v0[0] * v0[0] + v0[1] * v0[1]) + (v0[2] * v0[2] + v0[3] * v0[3]) + (v1[0] * v1[0] + v1[1] * v1[1]) + (v1[2] * v1[2] + v1[3] * v1[3]);
                }
                sq += shx(sq, 16, lane); sq += shx(sq, 32, lane);
                if (fq == 0) ss[(size_t)row * 16 + u.pn * 4 + wc] = sq;
            }
    }
};

typedef short bf16x4 __attribute__((ext_vector_type(4)));
typedef float f32x2 __attribute__((ext_vector_type(2)));
constexpr int S5_CHUNK = 256, S5_NCH = SEQ / S5_CHUNK, S5_ROWB = 528;
__device__ __forceinline__ f32x2 gelu_pk(f32x2 v) {
    const f32x2 av = __builtin_elementwise_abs(v), d = av * 0.2316418882f + 1.0f;
    f32x2 t; t.x = __builtin_amdgcn_rcpf(d.x); t.y = __builtin_amdgcn_rcpf(d.y);
    f32x2 q = t * 0.5307027145f + (-0.7265760135f); q = q * t + 0.7107068705f; q = q * t + (-0.142248368f); q = q * t + 0.127414796f; q = q * t;
    const f32x2 s2 = (v * v) * (-0.72134752044f);
    f32x2 e; e.x = __builtin_amdgcn_exp2f(s2.x); e.y = __builtin_amdgcn_exp2f(s2.y);
    const f32x2 m = v * (q * e), r = v - m;
    f32x2 o; o.x = v.x < 0.f ? m.x : r.x; o.y = v.y < 0.f ? m.y : r.y; return o;
}
__device__ __forceinline__ void p_s5_tables2(const int wv, const float* a_re, const float* a_im, const float* b_re, const float* b_im, const float* c_re, const float* c_im, const float* log_dt,
                                             float2* abar, float2* a256, bf16_t* BB16, bf16_t* CM16) {
    LTID();
    for (int gp = bidx * NT + tidx; gp < 2048; gp += gridDim.x * NT) {
        const int g = gp >> 6, p = gp & 63;
        const float lr = a_re[gp], li = a_im[gp], dt = expf(log_dt[g]);
        const float mag = expf(lr * dt); float sn, cs; sincosf(li * dt, &sn, &cs);
        const float ar = mag * cs, ai = mag * sn;
        abar[gp] = make_float2(ar, ai);
        float pr = ar, pi = ai;
        for (int i = 0; i < 8; ++i) { const float nr = pr * pr - pi * pi, ni = 2.f * pr * pi; pr = nr; pi = ni; }
        a256[gp] = make_float2(pr, pi);
        const float nr = ar - 1.f, ni = ai, den = lr * lr + li * li;
        const float cr = (nr * lr + ni * li) / den, ci = (ni * lr - nr * li) / den;
        for (int c = 0; c < 16; ++c) {
            const float br = b_re[gp * 16 + c], bi = b_im[gp * 16 + c];
            BB16[((size_t)g * 128 + p) * 16 + c] = (bf16_t)f2bf(cr * br - ci * bi);
            BB16[((size_t)g * 128 + 64 + p) * 16 + c] = (bf16_t)f2bf(cr * bi + ci * br);
            CM16[((size_t)g * 16 + c) * 128 + p] = (bf16_t)f2bf(c_re[(g * 16 + c) * 64 + p]);
            CM16[((size_t)g * 16 + c) * 128 + 64 + p] = (bf16_t)f2bf(-c_im[(g * 16 + c) * 64 + p]);
        }
    }
}
template <int MODE> __device__ __forceinline__ void p_s5_pass(const int wv, const bf16_t* proj16, const float2* abar, const float2* a256, const bf16_t* BB16, const bf16_t* CM16, const float* dskip,
                                                              float2* E, bf16_t* yg16, LAS unsigned char* lds) {
    LTID();
    const int lane = tidx & 63, fr = lane & 15, fq = lane >> 4;
    LAS unsigned char* L = lds + wv * (16 * S5_ROWB);
    for (int unit = bidx * NW + wv; unit < S5_NCH * 32; unit += gridDim.x * NW) {
        const int g = unit & 31, chunk = unit >> 5;
        const float2 a = abar[g * 64 + lane];
        bf16x4 bbf[8];
#pragma unroll
        for (int cb = 0; cb < 8; ++cb) bbf[cb] = *(const bf16x4*)(BB16 + ((size_t)g * 128 + 16 * cb + fr) * 16 + 4 * fq);
        bf16x8 cmf[4]; f32x4 dsk = (f32x4){0.f, 0.f, 0.f, 0.f};
        if (MODE == 1) {
#pragma unroll
            for (int s4 = 0; s4 < 4; ++s4) cmf[s4] = *(const bf16x8*)(CM16 + ((size_t)g * 16 + fr) * 128 + 32 * s4 + 8 * fq);
            dsk = *(const f32x4*)(dskip + g * 16 + 4 * fq);
        }
        float sr = 0.f, si = 0.f;
        if (MODE == 1) {
            const float2 A = a256[g * 64 + lane];
            for (int j0 = 0; j0 < chunk; j0 += 8) {
                float2 e[8];
#pragma unroll
                for (int k = 0; k < 8; ++k) { const int j = (j0 + k < chunk) ? j0 + k : chunk - 1; e[k] = E[((size_t)j * 32 + g) * 64 + lane]; }
#pragma unroll
                for (int k = 0; k < 8; ++k) if (j0 + k < chunk) { const float nr = A.x * sr - A.y * si + e[k].x, ni = A.x * si + A.y * sr + e[k].y; sr = nr; si = ni; }
            }
        }
        const bf16_t* ubase = proj16 + (size_t)(chunk * S5_CHUNK + fr) * DIN + 1536 + g * 16 + 4 * fq;
        bf16x4 uf = *(const bf16x4*)ubase;
#pragma unroll 1
        for (int blk = 0; blk < S5_CHUNK / 16; ++blk) {
            const bf16x4 ufn = *(const bf16x4*)(ubase + (size_t)((blk < S5_CHUNK / 16 - 1) ? (blk + 1) * 16 : blk * 16) * DIN);
            asm volatile("" ::: "memory");
#pragma unroll
            for (int cb = 0; cb < 8; ++cb) {
                const f32x4 d = __builtin_amdgcn_mfma_f32_16x16x16bf16_1k(bbf[cb], uf, (f32x4){0.f, 0.f, 0.f, 0.f}, 0, 0, 0);
                *(LAS f32x4*)(L + fr * S5_ROWB + (16 * cb + 4 * fq) * 4) = d;
            }
            asm volatile("" ::: "memory");
#pragma unroll
            for (int t = 0; t < 16; ++t) {
                const float re = *(const LAS float*)(L + t * S5_ROWB + lane * 4), im = *(const LAS float*)(L + t * S5_ROWB + 256 + lane * 4);
                const float nr = a.x * sr - a.y * si + re, ni = a.x * si + a.y * sr + im; sr = nr; si = ni;
                if (MODE == 1) { *(LAS bf16_t*)(L + t * S5_ROWB + lane * 2) = (bf16_t)f2bf(sr); *(LAS bf16_t*)(L + t * S5_ROWB + 128 + lane * 2) = (bf16_t)f2bf(si); }
            }
            asm volatile("" ::: "memory");
            if (MODE == 1) {
                f32x4 y = (f32x4){0.f, 0.f, 0.f, 0.f};
#pragma unroll
                for (int s4 = 0; s4 < 4; ++s4) { const bf16x8 sf = *(const LAS bf16x8*)(L + fr * S5_ROWB + 64 * s4 + 16 * fq); y = __builtin_amdgcn_mfma_f32_16x16x32_bf16(cmf[s4], sf, y, 0, 0, 0); }
                f32x4 v;
#pragma unroll
                for (int j = 0; j < 4; ++j) v[j] = y[j] + dsk[j] * bf2f((unsigned short)uf[j]);
                const f32x2 g0 = gelu_pk((f32x2){v[0], v[1]}), g1 = gelu_pk((f32x2){v[2], v[3]});
                u32x2 o2; o2.x = cvt_pk_bf16(g0.x, g0.y); o2.y = cvt_pk_bf16(g1.x, g1.y);
                *(u32x2*)(yg16 + (size_t)(chunk * S5_CHUNK + blk * 16 + fr) * 512 + g * 16 + 4 * fq) = o2;
            }
            asm volatile("" ::: "memory");
            uf = ufn;
        }
        if (MODE == 0) E[((size_t)chunk * 32 + g) * 64 + lane] = make_float2(sr, si);
    }
}
struct EpiGlu16 {
    static constexpr bool PERM = true;
    bf16_t* O; const bf16_t* Y; const float* bias;
    __device__ __forceinline__ void operator()(const f32x4 (&acc)[2][2][4][2], const GUnit& u, int wr, int wc, int fr, int fq) const {
        const int row0 = u.pm * BM + wr * 64 + fr, col0 = u.pn * BM + wc * 32 + 8 * fq;
        f32x4 bv[2][2];
#pragma unroll
        for (int bj = 0; bj < 2; ++bj)
#pragma unroll
            for (int n = 0; n < 2; ++n) bv[bj][n] = *(const f32x4*)(bias + col0 + bj * HALF + 4 * n);
#pragma unroll
        for (int ai = 0; ai < 2; ++ai)
#pragma unroll
            for (int m = 0; m < 4; ++m) { const size_t ro = (size_t)(row0 + ai * HALF + m * 16) * 512 + col0;
#pragma unroll
                for (int bj = 0; bj < 2; ++bj) {
                    const u32x4 yv = *(const u32x4*)(Y + ro + bj * HALF);
                    float o[8];
#pragma unroll
                    for (int n = 0; n < 2; ++n)
#pragma unroll
                        for (int j = 0; j < 4; ++j) { const unsigned wd = yv[n * 2 + (j >> 1)]; const float y = __builtin_bit_cast(float, (j & 1) ? (wd & 0xffff0000u) : (wd << 16));
                            o[n * 4 + j] = y / (1.f + __expf(-(acc[ai][bj][m][n][j] + bv[bj][n][j]))); }
                    u32x4 w; w.x = cvt_pk_bf16(o[0], o[1]); w.y = cvt_pk_bf16(o[2], o[3]); w.z = cvt_pk_bf16(o[4], o[5]); w.w = cvt_pk_bf16(o[6], o[7]);
                    *(u32x4*)(O + ro + bj * HALF) = w; } }
    }
};
__device__ __forceinline__ void p_ssm_norm(const int wv, const bf16_t* yb16, const float* g, bf16_t* mix16) {
    LTID();
    const int lane = tidx & 63;
    const f32x4 g0 = *(const f32x4*)(g + lane * 8), g1 = *(const f32x4*)(g + lane * 8 + 4);
    const int rstride = (int)gridDim.x * NW;
    for (int row0 = bidx * NW + wv; row0 < SEQ; row0 += 4 * rstride) {
        u32x4 av[4];
#pragma unroll
        for (int r = 0; r < 4; ++r) { const int row = (row0 + r * rstride < SEQ) ? row0 + r * rstride : row0; av[r] = *(const u32x4*)(yb16 + (size_t)row * 512 + lane * 8); }
#pragma unroll
        for (int r = 0; r < 4; ++r) {
            const int row = row0 + r * rstride;
            float y[8]; float ss = 0.f;
#pragma unroll
            for (int k = 0; k < 4; ++k) { y[2 * k] = __builtin_bit_cast(float, av[r][k] << 16); y[2 * k + 1] = __builtin_bit_cast(float, av[r][k] & 0xffff0000u); ss += y[2 * k] * y[2 * k] + y[2 * k + 1] * y[2 * k + 1]; }
#pragma unroll
            for (int o = 32; o; o >>= 1) ss += shx(ss, o, lane);
            const float sc = rsqrtf(ss * (1.f / 512.f) + 1e-5f);
            u32x4 o4; o4.x = cvt_pk_bf16(y[0] * sc * g0[0], y[1] * sc * g0[1]); o4.y = cvt_pk_bf16(y[2] * sc * g0[2], y[3] * sc * g0[3]);
            o4.z = cvt_pk_bf16(y[4] * sc * g1[0], y[5] * sc * g1[1]); o4.w = cvt_pk_bf16(y[6] * sc * g1[2], y[7] * sc * g1[3]);
            if (row < SEQ) *(u32x4*)(mix16 + (size_t)row * DM + 512 + lane * 8) = o4;
        }
    }
}

__device__ __forceinline__ void p_rmsnorm16(const int wv, const float* in, const float* g, bf16_t* out16, int rows) {
    LTID();
    const int lane = tidx & 63;
    for (int r = bidx * NW + wv; r < rows; r += gridDim.x * NW) {
        f32x4 v[4]; float ss = 0.f;
#pragma unroll
        for (int j = 0; j < 4; ++j) { v[j] = *(const f32x4*)(in + (size_t)r * DM + 4 * lane + 256 * j); ss += (v[j][0] * v[j][0] + v[j][1] * v[j][1]) + (v[j][2] * v[j][2] + v[j][3] * v[j][3]); }
#pragma unroll
        for (int o = 32; o; o >>= 1) ss += shx(ss, o, lane);
        const float sc = rsqrtf(ss * (1.f / 1024.f) + 1e-5f);
#pragma unroll
        for (int j = 0; j < 4; ++j) { const f32x4 gg = *(const f32x4*)(g + 4 * lane + 256 * j); u32x2 o2; o2.x = cvt_pk_bf16(v[j][0] * sc * gg[0], v[j][1] * sc * gg[1]); o2.y = cvt_pk_bf16(v[j][2] * sc * gg[2], v[j][3] * sc * gg[3]);
            *(u32x2*)(out16 + (size_t)r * DM + 4 * lane + 256 * j) = o2; }
    }
}
template <bool MOE, bool LAST> __device__ __forceinline__ void p_rowfinish(const int wv, const float* hin, float* h, const bf16_t* mout, const int* eslot, const float* topg, const float* g, bf16_t* xn16, float* out) {
    LTID();
    const int lane = tidx & 63;
    LAS const int* ts = (LAS const int*)(LDSP + TS_OFF);
    const int rstride = (int)gridDim.x * NW;
    for (int r0 = bidx * NW + wv; r0 < SEQ; r0 += 2 * rstride) {
        int rr[2]; rr[0] = r0; rr[1] = (r0 + rstride < SEQ) ? r0 + rstride : r0;
        f32x4 v[2][4]; int4 es[2]; f32x4 gt[2]; u32x2 mo[2][4][4];
#pragma unroll
        for (int q = 0; q < 2; ++q) { if (MOE) { es[q] = *(const int4*)(eslot + rr[q] * 4); gt[q] = *(const f32x4*)(topg + rr[q] * 4); }
#pragma unroll
            for (int j = 0; j < 4; ++j) v[q][j] = *(const f32x4*)(hin + (size_t)rr[q] * DM + 4 * lane + 256 * j); }
        if (MOE) {
#pragma unroll
            for (int q = 0; q < 2; ++q) { const int esv[4] = {es[q].x, es[q].y, es[q].z, es[q].w};
#pragma unroll
                for (int k = 0; k < 4; ++k) { const int e = esv[k] >> 16, sl = esv[k] & 0xffff; const size_t row = (size_t)ts[e] * BM + sl;
#pragma unroll
                    for (int j = 0; j < 4; ++j) mo[q][k][j] = *(const u32x2*)(mout + row * DM + 4 * lane + 256 * j); } }
#pragma unroll
            for (int q = 0; q < 2; ++q)
#pragma unroll
                for (int k = 0; k < 4; ++k) { const float gk = gt[q][k];
#pragma unroll
                    for (int j = 0; j < 4; ++j) { const u32x2 o = mo[q][k][j];
                        v[q][j][0] += gk * __builtin_bit_cast(float, o.x << 16); v[q][j][1] += gk * __builtin_bit_cast(float, o.x & 0xffff0000u);
                        v[q][j][2] += gk * __builtin_bit_cast(float, o.y << 16); v[q][j][3] += gk * __builtin_bit_cast(float, o.y & 0xffff0000u); } }
        }
#pragma unroll
        for (int q = 0; q < 2; ++q) {
            if (q == 1 && r0 + rstride >= SEQ) break;
            const int r = rr[q];
            float ss = 0.f;
#pragma unroll
            for (int j = 0; j < 4; ++j) ss += (v[q][j][0] * v[q][j][0] + v[q][j][1] * v[q][j][1]) + (v[q][j][2] * v[q][j][2] + v[q][j][3] * v[q][j][3]);
#pragma unroll
            for (int o = 32; o; o >>= 1) ss += shx(ss, o, lane);
            const float sc = rsqrtf(ss * (1.f / 1024.f) + 1e-5f);
#pragma unroll
            for (int j = 0; j < 4; ++j) {
                const f32x4 gg = *(const f32x4*)(g + 4 * lane + 256 * j);
                if (!LAST) { if (h) *(f32x4*)(h + (size_t)r * DM + 4 * lane + 256 * j) = v[q][j];
                    u32x2 o2; o2.x = cvt_pk_bf16(v[q][j][0] * sc * gg[0], v[q][j][1] * sc * gg[1]); o2.y = cvt_pk_bf16(v[q][j][2] * sc * gg[2], v[q][j][3] * sc * gg[3]);
                    *(u32x2*)(xn16 + (size_t)r * DM + 4 * lane + 256 * j) = o2; }
                else *(f32x4*)(out + (size_t)r * DM + 4 * lane + 256 * j) = (f32x4){v[q][j][0] * sc * gg[0], v[q][j][1] * sc * gg[1], v[q][j][2] * sc * gg[2], v[q][j][3] * sc * gg[3]};
            }
        }
    }
}
__device__ __forceinline__ void p_router_tables(const int wv, const float* w_r, const float* g, bf16_t* WR16) {
    LTID();
    for (int i = bidx * NT + tidx; i < 32 * 1024; i += gridDim.x * NT) {
        const int e = i >> 10, k = i & 1023;
        const float w = g[k] * w_r[k * 32 + e];
        const unsigned hi = f2bf(w); const float lo = w - __builtin_bit_cast(float, hi << 16);
        WR16[i] = (bf16_t)hi; WR16[32 * 1024 + i] = (bf16_t)f2bf(lo);
    }
}
constexpr int RT_CNT_OFF = 131072 + 4608;
constexpr int RT_XCH_OFF = 131072 + 5120;
__device__ __forceinline__ void p_router2(const int wv, const float* h, const bf16_t* WR16, const float* b_r, bf16_t* hb16, unsigned* gcnt, int* rowtok_e, float* rsc_e, int* eslot, float* topg, LAS unsigned char* lds) {
    LTID();
    const int lane = tidx & 63, fr = lane & 15, fq = lane >> 4, w = wv, tg = w & 3, kh = w >> 2;
#pragma unroll
    for (int part = 0; part < 2; ++part)
#pragma unroll
        for (int p = 0; p < 8; ++p) { const int row = 4 * p + (tidx >> 7), cs = tidx & 127;
            glds16s(WR16, (unsigned)(part * 65536 + row * 2048 + ((cs ^ (row & 15)) * 16)), (unsigned)(size_t)(lds + part * 65536 + p * 8192 + w * 1024)); }
    LAS int* lcnt = (LAS int*)(lds + RT_CNT_OFF);
    if (tidx < 64) lcnt[tidx] = 0;
    asm volatile("s_waitcnt vmcnt(0)" ::: "memory");
    __syncthreads();
    for (int it = bidx; it < SEQ / 64; it += gridDim.x) {
        const int token = it * 64 + 16 * tg + fr;
        const float* xr = h + (size_t)token * DM + 512 * kh + 8 * fq;
        bf16_t* hb = hb16 + (size_t)token * DM + 512 * kh + 8 * fq;
        f32x4 acc[2]; acc[0] = (f32x4){0.f, 0.f, 0.f, 0.f}; acc[1] = acc[0];
        float ss = 0.f;
#pragma unroll 4
        for (int s4 = 0; s4 < 16; ++s4) {
            const f32x4 x0 = *(const f32x4*)(xr + 32 * s4), x1 = *(const f32x4*)(xr + 32 * s4 + 4);
            ss += (x0[0] * x0[0] + x0[1] * x0[1]) + (x0[2] * x0[2] + x0[3] * x0[3]) + (x1[0] * x1[0] + x1[1] * x1[1]) + (x1[2] * x1[2] + x1[3] * x1[3]);
            u32x4 hw; hw.x = cvt_pk_bf16(x0[0], x0[1]); hw.y = cvt_pk_bf16(x0[2], x0[3]); hw.z = cvt_pk_bf16(x1[0], x1[1]); hw.w = cvt_pk_bf16(x1[2], x1[3]);
            *(u32x4*)(hb + 32 * s4) = hw;
            u32x4 lw;
            lw.x = cvt_pk_bf16(x0[0] - __builtin_bit_cast(float, hw.x << 16), x0[1] - __builtin_bit_cast(float, hw.x & 0xffff0000u));
            lw.y = cvt_pk_bf16(x0[2] - __builtin_bit_cast(float, hw.y << 16), x0[3] - __builtin_bit_cast(float, hw.y & 0xffff0000u));
            lw.z = cvt_pk_bf16(x1[0] - __builtin_bit_cast(float, hw.z << 16), x1[1] - __builtin_bit_cast(float, hw.z & 0xffff0000u));
            lw.w = cvt_pk_bf16(x1[2] - __builtin_bit_cast(float, hw.w << 16), x1[3] - __builtin_bit_cast(float, hw.w & 0xffff0000u));
            const bf16x8 xhi = __builtin_bit_cast(bf16x8, hw), xlo = __builtin_bit_cast(bf16x8, lw);
            const int c = 64 * kh + 4 * s4 + fq, slot = c ^ fr;
#pragma unroll
            for (int nb = 0; nb < 2; ++nb) {
                const bf16x8 whi = *(const LAS bf16x8*)(lds + (16 * nb + fr) * 2048 + slot * 16), wlo = *(const LAS bf16x8*)(lds + 65536 + (16 * nb + fr) * 2048 + slot * 16);
                acc[nb] = __builtin_amdgcn_mfma_f32_16x16x32_bf16(whi, xhi, acc[nb], 0, 0, 0);
                acc[nb] = __builtin_amdgcn_mfma_f32_16x16x32_bf16(whi, xlo, acc[nb], 0, 0, 0);
                acc[nb] = __builtin_amdgcn_mfma_f32_16x16x32_bf16(wlo, xhi, acc[nb], 0, 0, 0);
            }
        }
        ss += shx(ss, 16, lane); ss += shx(ss, 32, lane);
        LAS float* X = (LAS float*)(lds + RT_XCH_OFF) + (tg * 64 + lane) * 9;
        if (kh == 1) {
#pragma unroll
            for (int nb = 0; nb < 2; ++nb)
#pragma unroll
                for (int j = 0; j < 4; ++j) X[nb * 4 + j] = acc[nb][j];
            X[8] = ss;
        }
        __syncthreads();
        int ti[4] = {0, 0, 0, 0}, ls[4] = {0, 0, 0, 0}; float gv[4] = {0.f, 0.f, 0.f, 0.f}; float rs = 0.f;
        if (kh == 0) {
            float lv[8];
            ss += X[8];
            rs = rsqrtf(ss * (1.f / 1024.f) + 1e-5f);
#pragma unroll
            for (int nb = 0; nb < 2; ++nb)
#pragma unroll
                for (int j = 0; j < 4; ++j) lv[nb * 4 + j] = rs * (acc[nb][j] + X[nb * 4 + j]) + b_r[16 * nb + 4 * fq + j];
            float tv[4];
#pragma unroll
            for (int r = 0; r < 4; ++r) {
                float bv = -3.0e38f; int bi = 0;
#pragma unroll
                for (int q = 0; q < 8; ++q) { const int idx = 16 * (q >> 2) + 4 * fq + (q & 3); if (lv[q] > bv) { bv = lv[q]; bi = idx; } }
#pragma unroll
                for (int mk = 16; mk <= 32; mk <<= 1) { const float ov = shx(bv, mk, lane); const int oi = shxi(bi, mk, lane); if (ov > bv || (ov == bv && oi < bi)) { bv = ov; bi = oi; } }
                tv[r] = bv; ti[r] = bi;
#pragma unroll
                for (int q = 0; q < 8; ++q) { const int idx = 16 * (q >> 2) + 4 * fq + (q & 3); if (idx == bi) lv[q] = -3.0e38f; }
            }
            float sum = 0.f;
#pragma unroll
            for (int r = 0; r < 4; ++r) { gv[r] = __expf(tv[r] - tv[0]); sum += gv[r]; }
            const float inv = 1.f / sum;
#pragma unroll
            for (int r = 0; r < 4; ++r) gv[r] *= inv;
            if (fq == 0) {
#pragma unroll
                for (int r = 0; r < 4; ++r) ls[r] = __hip_atomic_fetch_add(&lcnt[ti[r]], 1, __ATOMIC_RELAXED, __HIP_MEMORY_SCOPE_WORKGROUP);
            }
        }
        __syncthreads();
        if (tidx < 32) { const int c = lcnt[tidx]; lcnt[32 + tidx] = c ? (int)__hip_atomic_fetch_add(gcnt + tidx, (unsigned)c, __ATOMIC_RELAXED, __HIP_MEMORY_SCOPE_AGENT) : 0; }
        __syncthreads();
        if (kh == 0 && fq == 0) {
            int es[4];
#pragma unroll
            for (int r = 0; r < 4; ++r) { const int e = ti[r], sl = lcnt[32 + e] + ls[r]; rowtok_e[e * ECAP + sl] = token; rsc_e[e * ECAP + sl] = rs; es[r] = (e << 16) | sl; }
            *(int4*)(eslot + token * 4) = make_int4(es[0], es[1], es[2], es[3]);
            *(f32x4*)(topg + token * 4) = (f32x4){gv[0], gv[1], gv[2], gv[3]};
        }
        __syncthreads();
        if (tidx < 32) lcnt[tidx] = 0;
    }
    __syncthreads();
}

constexpr int NPL = 13;
constexpr int NPHASES = 1 + 2 * NPL;
typedef const __attribute__((address_space(4))) Args* KA;
#define PHASE __device__ __forceinline__
#define KAP() ({ KA _t = a; asm volatile("" : "+s"(_t)); _t; })
#define WSP(T, off) ((T*)(a->ws + (off)))

constexpr int NIT = 49152, NIT1 = 32768;
constexpr int QG = 6, QX = 9, QA = 11, QB = 8;
struct ConvBounds { int A1, A2, B1, B2, B3, B4; };
__device__ __forceinline__ int cmin(int a, int b) { return a < b ? a : b; }
__device__ __forceinline__ ConvBounds conv_bounds(int G, int T0) {
    ConvBounds b;
    const int Pg0 = G > 136 ? G - 136 : G, Px = G > 128 ? G - 128 : G;
    b.A1 = cmin(NIT, Pg0 * 8 * QG); b.A2 = cmin(NIT, b.A1 + Px * 8 * QX);
    const int r1 = (8 * T0) % G, r2 = (4 * T0) % G;
    b.B1 = cmin(NIT, r1 ? (G - r1) * 8 * QA : G * 8 * 2);
    b.B2 = cmin(NIT, b.B1 + (r2 ? (G - r2) * 8 * QB : G * 8 * 2));
    b.B3 = cmin(NIT, b.B2 + Px * 8 * QG); b.B4 = cmin(NIT, b.B3 + Px * 8 * QX);
    return b;
}
__device__ __forceinline__ void conv_moe(KA a, const int wv, int l, int begin, int end, int rank, int nranks) {
    if (begin >= end) return;
    const int wr = rank * NW + wv, ws_ = nranks * NW;
    if (begin < NIT1) p_transpose_r(wv, a->in[26] + (size_t)l * NEXP * DM * 2048, NEXP, DM, 2048, WSP(bf16_t, WS_BT1) + (size_t)l * NEXP * 2048 * DM, a->in[23] + l * DM, NEXP, 1, LDSP, begin, cmin(end, NIT1), wr, ws_);
    if (end > NIT1) { const int b2 = begin > NIT1 ? begin - NIT1 : 0;
        p_transpose_r(wv, a->in[28] + (size_t)l * NEXP * DFF * DM, NEXP, DFF, DM, WSP(bf16_t, WS_BT2) + (size_t)l * NEXP * DM * DFF, nullptr, 1, 0, LDSP, b2, end - NIT1, wr, ws_); }
}
__device__ __forceinline__ int moe_T_lds() { return __builtin_amdgcn_readfirstlane(((LAS const int*)(LDSP + TS_OFF))[32]); }
PHASE void ph_init(KA a, const int wv) {
    p_rowfinish<false, false>(wv, a->in[0], nullptr, nullptr, nullptr, nullptr, a->in[3], WSP(bf16_t, WS_XN16), nullptr);
    p_bias_table(wv, a->in[2], WSP(float, WS_BIASG));
    for (int l = 0; l < 2; ++l) {
        p_s5_tables2(wv, a->in[5] + l * 2048, a->in[6] + l * 2048, a->in[7] + l * 32768, a->in[8] + l * 32768, a->in[9] + l * 32768, a->in[10] + l * 32768, a->in[11] + l * 32,
                     WSP(float2, WS_ABAR) + l * 2048, WSP(float2, WS_A256) + l * 2048, WSP(bf16_t, WS_BB16) + (size_t)l * 32 * 128 * 16, WSP(bf16_t, WS_CM16) + (size_t)l * 32 * 16 * 128);
        p_rmsnorm16(wv, a->in[1], a->in[19] + l * DM, WSP(bf16_t, WS_MEMN16) + (size_t)l * NMEM * DM, NMEM);
        p_router_tables(wv, a->in[24] + (size_t)l * DM * 32, a->in[23] + l * DM, WSP(bf16_t, WS_WR16) + (size_t)l * 2 * 32 * 1024);
    }
    p_transpose(wv, a->in[4], 2, DM, DIN, WSP(bf16_t, WS_WT_IN), nullptr, 1, 0, LDSP);
    p_transpose(wv, a->in[13], 2, 512, 512, WSP(bf16_t, WS_WT_GLU), nullptr, 1, 0, LDSP);
    p_transpose(wv, a->in[17], 2, DM, DM, WSP(bf16_t, WS_WT_OUT), nullptr, 1, 0, LDSP);
    p_transpose(wv, a->in[20], 2, DM, 512, WSP(bf16_t, WS_WT_XQ), a->in[18], 1, 0, LDSP);
    p_transpose(wv, a->in[21], 2, DM, 1024, WSP(bf16_t, WS_WT_XKV), nullptr, 1, 0, LDSP);
    p_transpose(wv, a->in[22], 2, 512, DM, WSP(bf16_t, WS_WT_XO), nullptr, 1, 0, LDSP);
    __syncthreads();
}
PHASE void ph_gemm_in(KA a, const int wv, int l) { LTID();
    DenseOrder S; S.init(WSP(bf16_t, WS_XN16), WSP(bf16_t, WS_WT_IN) + (size_t)l * DIN * DM, SEQ, DIN, DM, gridDim.x, bidx);
    EpiIn E{WSP(bf16_t, WS_PROJ16)};
    gemm_phase<EpiIn, DenseOrder, false, true>(LDSP, DM, S, E, tidx, wv);
}
PHASE void ph_attn_s5a(KA a, const int wv, int l) {
    p_dil_attn(wv, WSP(bf16_t, WS_PROJ16), WSP(float, WS_BIASG), WSP(bf16_t, WS_OBR), WSP(float, WS_LSE), LDSP);
    if (PROBE_DUP == 21) p_dil_attn(wv, WSP(bf16_t, WS_PROJ16), WSP(float, WS_BIASG), WSP(bf16_t, WS_OBR), WSP(float, WS_LSE), LDSP);
    if (PROBE_DUP == 22) { p_s5_pass<0>(wv, WSP(bf16_t, WS_PROJ16), WSP(float2, WS_ABAR) + l * 2048, WSP(float2, WS_A256) + l * 2048, WSP(bf16_t, WS_BB16) + (size_t)l * 32 * 128 * 16, WSP(bf16_t, WS_CM16) + (size_t)l * 32 * 16 * 128,
                 a->in[12] + l * 512, WSP(float2, WS_E2), WSP(bf16_t, WS_YG16), LDSP); __syncthreads(); }
    p_s5_pass<0>(wv, WSP(bf16_t, WS_PROJ16), WSP(float2, WS_ABAR) + l * 2048, WSP(float2, WS_A256) + l * 2048, WSP(bf16_t, WS_BB16) + (size_t)l * 32 * 128 * 16, WSP(bf16_t, WS_CM16) + (size_t)l * 32 * 16 * 128,
                 a->in[12] + l * 512, WSP(float2, WS_E2), WSP(bf16_t, WS_YG16), LDSP);
}
PHASE void ph_s5b(KA a, const int wv, int l) {
    p_s5_pass<1>(wv, WSP(bf16_t, WS_PROJ16), WSP(float2, WS_ABAR) + l * 2048, WSP(float2, WS_A256) + l * 2048, WSP(bf16_t, WS_BB16) + (size_t)l * 32 * 128 * 16, WSP(bf16_t, WS_CM16) + (size_t)l * 32 * 16 * 128,
                 a->in[12] + l * 512, WSP(float2, WS_E2), WSP(bf16_t, WS_YG16), LDSP);
}
PHASE void ph_gemm_glu(KA a, const int wv, int l) {
    {   LTID();
        DenseOrder S; S.init(WSP(bf16_t, WS_YG16), WSP(bf16_t, WS_WT_GLU) + (size_t)l * 512 * 512, SEQ, 512, 512, gridDim.x, bidx);
        EpiGlu16 E{WSP(bf16_t, WS_YB16), WSP(bf16_t, WS_YG16), a->in[14] + l * 512};
        gemm_phase<EpiGlu16, DenseOrder, false, false>(LDSP, 512, S, E, tidx, wv); }
    {   LTID();
    const int cc = (int)gridDim.x - 1 - bidx;
    if (l == 0 && cc < 8) {
        const int kl = cc >> 2;
        DenseOrder S; S.init(WSP(bf16_t, WS_MEMN16) + (size_t)kl * NMEM * DM, WSP(bf16_t, WS_WT_XKV) + (size_t)kl * 1024 * DM, NMEM, 1024, DM, 4, cc & 3);
        EpiBf16 E{WSP(bf16_t, WS_KV16) + (size_t)kl * NMEM * 1024, 1024, 1.f, nullptr};
        gemm_phase<EpiBf16, DenseOrder, false, false>(LDSP, DM, S, E, tidx, wv);
    } }
    {   LTID();
        const int G = (int)gridDim.x;
        int T0 = 0; if (l == 1) { moe_tiles(WSP(unsigned, WS_CTL) + CW_CNT, tidx); T0 = moe_T_lds(); }
        const ConvBounds cb = conv_bounds(G, T0);
        const int skip = (l == 0) ? 8 : 0;
        if (G > 128 + skip) { if (bidx >= 128 && bidx < G - skip) conv_moe(a, wv, l, l == 0 ? 0 : cb.B2, l == 0 ? cb.A1 : cb.B3, bidx - 128, G - 128 - skip); }
        else conv_moe(a, wv, l, l == 0 ? 0 : cb.B2, l == 0 ? cb.A1 : cb.B3, bidx, G);
    }
}
PHASE void ph_mixnorm(KA a, const int wv, int l) {
    p_attn_combine(wv, WSP(bf16_t, WS_OBR), WSP(float, WS_LSE), a->in[15] + l * 512, WSP(bf16_t, WS_MIX16));
    p_ssm_norm(wv, WSP(bf16_t, WS_YB16), a->in[16] + l * 512, WSP(bf16_t, WS_MIX16));
}
PHASE void ph_gemm_out(KA a, const int wv, int l) { LTID();
    DenseOrder S; S.init(WSP(bf16_t, WS_MIX16), WSP(bf16_t, WS_WT_OUT) + (size_t)l * DM * DM, SEQ, DM, DM, gridDim.x, bidx);
    EpiOut E{l == 0 ? a->in[0] : (const float*)WSP(float, WS_H), WSP(float, WS_H), WSP(bf16_t, WS_HB16), WSP(float, WS_SSP)};
    gemm_phase<EpiOut, DenseOrder, false, false>(LDSP, DM, S, E, tidx, wv);
}
PHASE void ph_gemm_xq(KA a, const int wv, int l) {
    {   LTID();
        DenseOrder S; S.init(WSP(bf16_t, WS_HB16), WSP(bf16_t, WS_WT_XQ) + (size_t)l * 512 * DM, SEQ, 512, DM, gridDim.x, bidx);
        EpiBf16 E{WSP(bf16_t, WS_QX16), 512, 0.08838834764831845f, WSP(float, WS_SSP)};
        gemm_phase<EpiBf16, DenseOrder, false, false>(LDSP, DM, S, E, tidx, wv); }
    {   LTID();
        const int G = (int)gridDim.x;
        int T0 = 0; if (l == 1) { moe_tiles(WSP(unsigned, WS_CTL) + CW_CNT, tidx); T0 = moe_T_lds(); }
        const ConvBounds cb = conv_bounds(G, T0);
        if (G > 128) { if (bidx >= 128) conv_moe(a, wv, l, l == 0 ? cb.A1 : cb.B3, l == 0 ? cb.A2 : cb.B4, bidx - 128, G - 128); }
        else conv_moe(a, wv, l, l == 0 ? cb.A1 : cb.B3, l == 0 ? cb.A2 : cb.B4, bidx, G);
    }
}
PHASE void ph_xattn(KA a, const int wv, int l) { p_xattn_mfma(wv, WSP(bf16_t, WS_QX16), WSP(bf16_t, WS_KV16) + (size_t)l * NMEM * 1024, WSP(bf16_t, WS_OX16), LDSP); }
PHASE void ph_gemm_xo(KA a, const int wv, int l) { LTID();
    DenseOrder S; S.init(WSP(bf16_t, WS_OX16), WSP(bf16_t, WS_WT_XO) + (size_t)l * DM * 512, SEQ, DM, 512, gridDim.x, bidx);
    EpiF32 E{WSP(float, WS_H), DM, 1};
    gemm_phase<EpiF32, DenseOrder, false, false>(LDSP, 512, S, E, tidx, wv);
}
PHASE void ph_router(KA a, const int wv, int l) {
    {   LTID();
        const int G = (int)gridDim.x;
        int T0 = 0; if (l == 1) { moe_tiles(WSP(unsigned, WS_CTL) + CW_CNT, tidx); T0 = moe_T_lds(); }
        const ConvBounds cb = conv_bounds(G, T0);
        conv_moe(a, wv, l, l == 0 ? cb.A2 : cb.B4, NIT, bidx, G);
        __syncthreads();
    }
    p_router2(wv, WSP(float, WS_H), WSP(bf16_t, WS_WR16) + (size_t)l * 2 * 32 * 1024, a->in[25] + l * 32, WSP(bf16_t, WS_HB16), WSP(unsigned, WS_CTL) + CW_CNT + l * 32,
              WSP(int, WS_ROWTOK), WSP(float, WS_RSC), WSP(int, WS_ESLOT), WSP(float, WS_TOPG), LDSP);
}
PHASE void ph_moe1(KA a, const int wv, int l) {
    {   LTID();
        moe_tiles(WSP(unsigned, WS_CTL) + CW_CNT + l * 32, tidx);
        MoeOrder<true> S; S.init(WSP(bf16_t, WS_HB16), WSP(bf16_t, WS_BT1) + (size_t)l * NEXP * 2048 * DM, WSP(int, WS_ROWTOK), 2048, DM, (size_t)2048 * DM * 2, gridDim.x, bidx);
        EpiMoe1 E{WSP(bf16_t, WS_ACT), a->in[27] + (size_t)l * NEXP * 2048, WSP(float, WS_RSC)};
        gemm_phase<EpiMoe1, MoeOrder<true>, true, true>(LDSP, DM, S, E, tidx, wv); }
    if (l == 0) { LTID();
        const int G = (int)gridDim.x, T0 = moe_T_lds(), r1 = (8 * T0) % G; const ConvBounds cb = conv_bounds(G, T0);
        if (r1) { if (bidx >= r1) conv_moe(a, wv, 1, 0, cb.B1, bidx - r1, G - r1); } else conv_moe(a, wv, 1, 0, cb.B1, bidx, G);
    }
}
PHASE void ph_moe2(KA a, const int wv, int l) {
    {   LTID();
        moe_tiles(WSP(unsigned, WS_CTL) + CW_CNT + l * 32, tidx);
        MoeOrder<false> S; S.init(WSP(bf16_t, WS_ACT), WSP(bf16_t, WS_BT2) + (size_t)l * NEXP * DM * DFF, nullptr, DM, DFF, (size_t)DM * DFF * 2, gridDim.x, bidx);
        EpiMoe2 E{WSP(bf16_t, WS_MOUT), a->in[29] + (size_t)l * NEXP * DM};
        gemm_phase<EpiMoe2, MoeOrder<false>, false, true>(LDSP, DFF, S, E, tidx, wv); }
    if (l == 0) { LTID();
        const int G = (int)gridDim.x, T0 = moe_T_lds(), r2 = (4 * T0) % G; const ConvBounds cb = conv_bounds(G, T0);
        if (r2) { if (bidx >= r2) conv_moe(a, wv, 1, cb.B1, cb.B2, bidx - r2, G - r2); } else conv_moe(a, wv, 1, cb.B1, cb.B2, bidx, G);
    }
}
PHASE void ph_combine(KA a, const int wv, int l) { LTID();
    moe_tiles(WSP(unsigned, WS_CTL) + CW_CNT + l * 32, tidx);
    if (l == 0) p_rowfinish<true, false>(wv, WSP(float, WS_H), WSP(float, WS_H), WSP(bf16_t, WS_MOUT), WSP(int, WS_ESLOT), WSP(float, WS_TOPG), a->in[3] + DM, WSP(bf16_t, WS_XN16), nullptr);
    else p_rowfinish<true, true>(wv, WSP(float, WS_H), nullptr, WSP(bf16_t, WS_MOUT), WSP(int, WS_ESLOT), WSP(float, WS_TOPG), a->in[30], nullptr, a->out);
}

__global__ void __launch_bounds__(NT, 2) mega(Args args) {
    KA a = (KA)__builtin_amdgcn_kernarg_segment_ptr();
    int wv = __builtin_amdgcn_readfirstlane((int)threadIdx.x >> 6); asm volatile("" : "+s"(wv));
    LAS unsigned char* lds = LDSP;
    volatile LAS unsigned* MISC = (volatile LAS unsigned*)(lds + MISC_OFF);
    unsigned* ctl = (unsigned*)(a->ws + WS_CTL);
    if (threadIdx.x < 32) MISC[threadIdx.x] = 0u;
    __syncthreads();
    XcdBarrier bar; bar.bar = ctl + CW_BAR; bar.x = 0; bar.st = nullptr;
    if (!MK_PER_PHASE) bar = xcd_barrier_post(ctl + CW_BAR, MISC + 8);
    const int lo = a->ph_lo, hi = a->ph_hi;
#define IN(k) (lo <= (k) && (k) < hi)
#define SEAM(k) do { if (IN(k) && IN((k) + 1)) { LTID(); xcd_barrier(bar.bar, bar.x, bar.st, tidx == 0); if (PROBE_DUP == 200) xcd_barrier(bar.bar, bar.x, bar.st, tidx == 0); } } while (0)
    if (IN(0)) { ph_init(KAP(), wv); if (PROBE_DUP == 100) ph_init(KAP(), wv); }
    SEAM(0);
#define LAYER_PROGRAM(l) { const int pb = 1 + (l) * NPL; \
        if (IN(pb + 0)) { ph_gemm_in(KAP(), wv, (l)); if (PROBE_DUP == 0) { ph_gemm_in(KAP(), wv, (l)); } } \
        SEAM(pb + 0); \
        if (IN(pb + 1)) { ph_attn_s5a(KAP(), wv, (l)); if (PROBE_DUP == 1) { ph_attn_s5a(KAP(), wv, (l)); } } \
        SEAM(pb + 1); \
        if (IN(pb + 2)) { ph_s5b(KAP(), wv, (l)); if (PROBE_DUP == 2) { ph_s5b(KAP(), wv, (l)); } } \
        SEAM(pb + 2); \
        if (IN(pb + 3)) { ph_gemm_glu(KAP(), wv, (l)); if (PROBE_DUP == 3) { ph_gemm_glu(KAP(), wv, (l)); } } \
        SEAM(pb + 3); \
        if (IN(pb + 4)) { ph_mixnorm(KAP(), wv, (l)); if (PROBE_DUP == 4) { ph_mixnorm(KAP(), wv, (l)); } } \
        SEAM(pb + 4); \
        if (IN(pb + 5)) { ph_gemm_out(KAP(), wv, (l)); if (PROBE_DUP == 5) { ph_gemm_out(KAP(), wv, (l)); } } \
        SEAM(pb + 5); \
        if (IN(pb + 6)) { ph_gemm_xq(KAP(), wv, (l)); if (PROBE_DUP == 6) { ph_gemm_xq(KAP(), wv, (l)); } } \
        SEAM(pb + 6); \
        if (IN(pb + 7)) { ph_xattn(KAP(), wv, (l)); if (PROBE_DUP == 7) { ph_xattn(KAP(), wv, (l)); } } \
        SEAM(pb + 7); \
        if (IN(pb + 8)) { ph_gemm_xo(KAP(), wv, (l)); if (PROBE_DUP == 8) { ph_gemm_xo(KAP(), wv, (l)); } } \
        SEAM(pb + 8); \
        if (IN(pb + 9)) { ph_router(KAP(), wv, (l)); if (PROBE_DUP == 9) { ph_router(KAP(), wv, (l)); } } \
        SEAM(pb + 9); \
        if (IN(pb + 10)) { ph_moe1(KAP(), wv, (l)); if (PROBE_DUP == 10) { ph_moe1(KAP(), wv, (l)); } } \
        SEAM(pb + 10); \
        if (IN(pb + 11)) { ph_moe2(KAP(), wv, (l)); if (PROBE_DUP == 11) { ph_moe2(KAP(), wv, (l)); } } \
        SEAM(pb + 11); \
        if (IN(pb + 12)) { ph_combine(KAP(), wv, (l)); if (PROBE_DUP == 12) { ph_combine(KAP(), wv, (l)); } } \
        SEAM(pb + 12); }
    LAYER_PROGRAM(0)
    LAYER_PROGRAM(1)
#undef LAYER_PROGRAM
#undef IN
#undef SEAM
}

extern "C" void kernel_launch(void* const* d_in, const int* in_sizes, int n_in, void* d_out, int out_size, void* d_ws, size_t ws_size, hipStream_t stream) {
    static int grid = 0;
    if (grid == 0) {
        if (n_in != 31 || ws_size < WS_END) { fprintf(stderr, "kernel_launch: unexpected n_in %d or ws_size %zu (need %zu)\n", n_in, ws_size, (size_t)WS_END); grid = -1; return; }
        int dev = 0, cus = 0, per_cu = 0;
        if (hipGetDevice(&dev) != hipSuccess || hipDeviceGetAttribute(&cus, hipDeviceAttributeMultiprocessorCount, dev) != hipSuccess) { grid = -1; return; }
        if (hipFuncSetAttribute((const void*)mega, hipFuncAttributeMaxDynamicSharedMemorySize, LDS_BYTES) != hipSuccess) { fprintf(stderr, "kernel_launch: hipFuncSetAttribute failed\n"); grid = -1; return; }
        if (hipOccupancyMaxActiveBlocksPerMultiprocessor(&per_cu, (const void*)mega, NT, LDS_BYTES) != hipSuccess || per_cu < 1)
            fprintf(stderr, "kernel_launch: occupancy query reports %d workgroups per CU\n", per_cu);
        (void)hipGetLastError();
        grid = cus;
    }
    if (grid < 0) return;
    if (hipMemsetAsync((char*)d_ws + WS_CTL, 0, CTL_ZERO_BYTES, stream) != hipSuccess) return;
    Args a{};
    for (int i = 0; i < 31; ++i) a.in[i] = (const float*)d_in[i];
    a.out = (float*)d_out; a.ws = (unsigned char*)d_ws;
#if MK_PER_PHASE
    for (int p = 0; p < NPHASES; ++p) { a.ph_lo = p; a.ph_hi = p + 1; hipLaunchKernelGGL(mega, dim3(grid), dim3(NT), LDS_BYTES, stream, a); }
#else
    a.ph_lo = 0; a.ph_hi = NPHASES;
    hipLaunchKernelGGL(mega, dim3(grid), dim3(NT), LDS_BYTES, stream, a);
#endif
}
```

```cpp
#include <hip/hip_runtime.h>
#include <stdint.h>
#include <cstdio>

#ifndef PROBE_DUP
#define PROBE_DUP -1
#endif
#ifndef MK_PER_PHASE
#define MK_PER_PHASE 0
#endif

#define SEQ 16384
#define DM 1024
#define DIN 2048
#define NMEM 256
#define NEXP 32
#define TOPK 4
#define DFF 1024
#define NT 512
#define NW 8

#define LAS __attribute__((address_space(3)))
typedef float f32x4 __attribute__((ext_vector_type(4)));
typedef float f32x2 __attribute__((ext_vector_type(2)));
extern __shared__ __attribute__((aligned(16))) unsigned char lds_raw[];
#define LDSP ((LAS unsigned char*)lds_raw)
#define LTID() int z_ = 0; asm volatile("" : "+v"(z_)); const int lane_ = (int)__builtin_amdgcn_mbcnt_hi(~0u, __builtin_amdgcn_mbcnt_lo(~0u, (unsigned)z_)); \
    const int tidx = wv * 64 + lane_; int bidx = blockIdx.x; asm volatile("" : "+s"(bidx))
__device__ __forceinline__ float shx(float v, int mask, int lane) { return __builtin_bit_cast(float, __builtin_amdgcn_ds_bpermute((lane ^ mask) << 2, __builtin_bit_cast(int, v))); }
__device__ __forceinline__ int shxi(int v, int mask, int lane) { return __builtin_amdgcn_ds_bpermute((lane ^ mask) << 2, v); }
constexpr int LDS_BYTES = 147456;
constexpr int MISC_OFF = 131072 + 320;

#define XB_TMO      128
#define XB_XCNT(j)  (256  + 64 * (j))
#define XB_XSUB(j)  (1280 + 64 * (j))
#define XB_XGEN(j)  (2304 + 64 * (j))
#define XB_TOP      3328
#define XB_TOPGEN   3392
#define XCD_BAR_WORDS 3456
#define XB_SPIN_CAP (1u << 18)

__device__ __forceinline__ unsigned xb_ld(unsigned* p)              { return __hip_atomic_load(p, __ATOMIC_RELAXED, __HIP_MEMORY_SCOPE_AGENT); }
__device__ __forceinline__ unsigned xb_add(unsigned* p, unsigned v) { return __hip_atomic_fetch_add(p, v, __ATOMIC_RELAXED, __HIP_MEMORY_SCOPE_AGENT); }
__device__ __forceinline__ unsigned xb_xcc_id() { return (unsigned)__builtin_amdgcn_s_getreg((3 << 11) | 20) & 0xFu; }
#define XB_SPIN(cond, bar) do { unsigned _sp = 0; while (cond) { __builtin_amdgcn_s_sleep(1); \
    if ((++_sp & 255u) == 0u) { if (xb_ld(&(bar)[XB_TMO])) break; if (_sp > XB_SPIN_CAP) { atomicAdd(&(bar)[XB_TMO], 1u); break; } } } } while (0)

struct XcdBarrier {
    unsigned* bar; unsigned x;
    volatile LAS unsigned* st;
};
__device__ __forceinline__ XcdBarrier xcd_barrier_post(unsigned* bar, volatile LAS unsigned* st) {
    XcdBarrier b; b.bar = bar; b.x = xb_xcc_id(); b.st = st;
    if (threadIdx.x == 0) (void)xb_add(&bar[XB_XCNT(b.x)], 1u);
    return b;
}
__device__ __forceinline__ void xcd_barrier_complete(unsigned* bar, unsigned x, unsigned& nloc, unsigned& nx) {
    const unsigned G = gridDim.x * gridDim.y * gridDim.z;
    unsigned sum, cnt, mine, sp = 0u;
    for (;;) {
        sum = 0u; cnt = 0u; mine = 0u;
#pragma unroll
        for (unsigned j = 0; j < 16; ++j) { const unsigned c = xb_ld(&bar[XB_XCNT(j)]); sum += c; cnt += (c > 0u) ? 1u : 0u; mine = (j == x) ? c : mine; }
        if (sum == G) break;
        __builtin_amdgcn_s_sleep(1);
        if ((++sp & 255u) == 0u) { if (xb_ld(&bar[XB_TMO])) break; if (sp > XB_SPIN_CAP) { atomicAdd(&bar[XB_TMO], 1u); break; } }
    }
    nloc = mine > 0u ? mine : 1u; nx = cnt > 0u ? cnt : 1u;
}
__device__ __noinline__ void xcd_barrier(unsigned* bar_, unsigned x_, volatile LAS unsigned* st_, int is_t0) {
    XcdBarrier b; b.bar = bar_; b.x = x_; b.st = st_;
    asm volatile("s_waitcnt vmcnt(0)" ::: "memory");
    __syncthreads();
    if (is_t0) {
        unsigned* bar = b.bar;
        __builtin_amdgcn_s_waitcnt(0);
        unsigned nloc = b.st[0], nx = b.st[1];
        if (nloc == 0u) { xcd_barrier_complete(bar, b.x, nloc, nx); b.st[0] = nloc; b.st[1] = nx; }
        const unsigned old = xb_add(&bar[XB_XSUB(b.x)], 1u);
        const unsigned gen = old / nloc;
        if (old + 1u == (gen + 1u) * nloc) {
            __builtin_amdgcn_fence(__ATOMIC_RELEASE, "agent");
            asm volatile("s_waitcnt vmcnt(0)" ::: "memory");
            const unsigned og = xb_add(&bar[XB_TOP], 1u);
            const unsigned tg = og / nx;
            if (og + 1u == (tg + 1u) * nx) xb_add(&bar[XB_TOPGEN], 1u);
            else XB_SPIN(xb_ld(&bar[XB_TOPGEN]) == tg, bar);
            __builtin_amdgcn_fence(__ATOMIC_ACQUIRE, "agent");
            xb_add(&bar[XB_XGEN(b.x)], 1u);
            asm volatile("s_waitcnt vmcnt(0)" ::: "memory");
        } else {
            XB_SPIN(xb_ld(&bar[XB_XGEN(b.x)]) == gen, bar);
            __builtin_amdgcn_fence(__ATOMIC_ACQUIRE, "agent");
            asm volatile("s_waitcnt vmcnt(0)" ::: "memory");
        }
    }
    __syncthreads();
}

constexpr size_t MiB = 1u << 20;
constexpr size_t WS_CTL = 0, CTL_ZERO_BYTES = 1 * MiB;
constexpr int CW_BAR = 4096;
constexpr int CW_CNT = 8192;
constexpr int MOE_ROWS = SEQ * TOPK + NEXP * 256;
constexpr int ECAP = SEQ;
constexpr size_t al256(size_t x) { return (x + 255) & ~(size_t)255; }
constexpr size_t WS_H = 2 * MiB;
constexpr size_t WS_XN16 = WS_H + (size_t)SEQ * DM * 4;
constexpr size_t WS_HB16 = WS_XN16 + (size_t)SEQ * DM * 2;
constexpr size_t WS_PROJ16 = WS_HB16 + (size_t)SEQ * DM * 2;
constexpr size_t WS_OBR = WS_PROJ16 + (size_t)SEQ * 2048 * 2;
constexpr size_t WS_LSE = WS_OBR + 3 * (size_t)SEQ * 512 * 2;
constexpr size_t WS_YG16 = WS_LSE + 3 * (size_t)SEQ * 8 * 4;
constexpr size_t WS_YB16 = WS_YG16 + (size_t)SEQ * 512 * 2;
constexpr size_t WS_MIX16 = WS_YB16 + (size_t)SEQ * 512 * 2;
constexpr size_t WS_QX16 = WS_MIX16 + (size_t)SEQ * DM * 2;
constexpr size_t WS_OX16 = WS_QX16 + (size_t)SEQ * 512 * 2;
constexpr size_t WS_ACT = WS_OX16 + (size_t)SEQ * 512 * 2;
constexpr size_t WS_MOUT = WS_ACT + (size_t)MOE_ROWS * DFF * 2;
constexpr size_t WS_BT1 = WS_MOUT + (size_t)MOE_ROWS * DM * 2;
constexpr size_t WS_BT2 = WS_BT1 + 2 * (size_t)NEXP * 2048 * DM * 2;
constexpr size_t WS_WT_IN = WS_BT2 + 2 * (size_t)NEXP * DM * DFF * 2;
constexpr size_t WS_WT_GLU = WS_WT_IN + 2 * (size_t)2048 * 1024 * 2;
constexpr size_t WS_WT_OUT = WS_WT_GLU + 2 * (size_t)512 * 512 * 2;
constexpr size_t WS_WT_XQ = WS_WT_OUT + 2 * (size_t)1024 * 1024 * 2;
constexpr size_t WS_WT_XKV = WS_WT_XQ + 2 * (size_t)512 * 1024 * 2;
constexpr size_t WS_WT_XO = WS_WT_XKV + 2 * (size_t)1024 * 1024 * 2;
constexpr size_t WS_MEMN16 = WS_WT_XO + 2 * (size_t)1024 * 512 * 2;
constexpr size_t WS_KV16 = WS_MEMN16 + 2 * (size_t)NMEM * 1024 * 2;
constexpr size_t WS_WR16 = WS_KV16 + 2 * (size_t)NMEM * 1024 * 2;
constexpr size_t WS_BIASG = WS_WR16 + 2 * 2 * (size_t)32 * 1024 * 2;
constexpr size_t WS_ABAR = al256(WS_BIASG + 24 * 132 * 4);
constexpr size_t WS_A256 = WS_ABAR + 2 * 2048 * 8;
constexpr size_t WS_BB16 = WS_A256 + 2 * 2048 * 8;
constexpr size_t WS_CM16 = WS_BB16 + 2 * (size_t)32 * 128 * 16 * 2;
constexpr size_t WS_E2 = WS_CM16 + 2 * (size_t)32 * 16 * 128 * 2;
constexpr size_t WS_ROWTOK = WS_E2 + (size_t)64 * 2048 * 8;
constexpr size_t WS_RSC = WS_ROWTOK + (size_t)NEXP * ECAP * 4;
constexpr size_t WS_ESLOT = WS_RSC + (size_t)NEXP * ECAP * 4;
constexpr size_t WS_TOPG = WS_ESLOT + (size_t)SEQ * 4 * 4;
constexpr size_t WS_SSP = WS_TOPG + (size_t)SEQ * 4 * 4;
constexpr size_t WS_END = WS_SSP + (size_t)SEQ * 16 * 4;

struct Args { const float* in[31]; float* out; unsigned char* ws; int ph_lo, ph_hi; };


typedef unsigned short bf16_t;
typedef short bf16x8 __attribute__((ext_vector_type(8)));
typedef unsigned u32x4 __attribute__((ext_vector_type(4)));
typedef unsigned u32x2 __attribute__((ext_vector_type(2)));
constexpr int BM = 256, BK = 64, HALF = 128, HTB = HALF * BK * 2, STAGE_BYTES = 8 * HTB, NXCD = 8, WGM = 8;
__host__ __device__ __forceinline__ int lds_byte(int r, int c) { const int st = (r >> 4) * 2 + (c >> 5), rr = r & 15, cc = c & 31, ob = rr * 64 + cc * 2; return st * 1024 + (ob ^ (((ob >> 9) & 1) << 5)); }
__host__ __device__ __forceinline__ void stage_rc(int b, int& R, int& C) { const int st = b / 1024, sb = b % 1024, swz = sb ^ (((sb >> 9) & 1) << 5); R = (st >> 1) * 16 + swz / 64; C = (st & 1) * 32 + (swz % 64) / 2; }
__host__ __device__ __forceinline__ int perm32(int rho) { const int n = rho >> 4, i = rho & 15; return 8 * (i >> 2) + 4 * n + (i & 3); }
__device__ __forceinline__ unsigned cvt_pk_bf16(float lo, float hi) { unsigned r; asm volatile("v_cvt_pk_bf16_f32 %0, %1, %2" : "=v"(r) : "v"(lo), "v"(hi)); return r; }
__device__ __forceinline__ unsigned f2bf(float f) { unsigned u = __builtin_bit_cast(unsigned, f); return (u + 0x7fffu + ((u >> 16) & 1u)) >> 16; }
__device__ __forceinline__ unsigned pk2(float lo, float hi) { return f2bf(lo) | (f2bf(hi) << 16); }
__device__ __forceinline__ float bf2f(unsigned short b) { return __builtin_bit_cast(float, ((unsigned)b) << 16); }

__device__ __forceinline__ void glds16s(const void* sbase, unsigned voff, unsigned lds_dst) {
    unsigned keep;
    asm volatile("s_mov_b32 %0, m0\n\ts_mov_b32 m0, %3\n\ts_nop 0\n\tglobal_load_lds_dwordx4 %1, %2\n\ts_mov_b32 m0, %0" : "=&s"(keep) : "v"(voff), "s"(sbase), "s"(lds_dst) : "memory");
}
struct GUnit { const char* A; const char* B; int pm, pn, e, row0, cnt; };

struct DenseOrder {
    const char* A; const char* Bt; int nM, nN, nwg, G, c, K;
    __device__ __forceinline__ void init(const bf16_t* A_, const bf16_t* Bt_, int M, int N, int K_, int G_, int c_) { A = (const char*)A_; Bt = (const char*)Bt_; nM = M / BM; nN = N / BM; nwg = nM * nN; G = G_; c = c_; K = K_; }
    __device__ __forceinline__ bool next(int i, GUnit& u) const {
        const long L = (long)i * G + c; if (L >= nwg) return false;
        int wgid = (int)L; { const int q = nwg / NXCD, r = nwg % NXCD, xcd = wgid % NXCD, off = wgid / NXCD; wgid = (xcd < r ? xcd * (q + 1) : r * (q + 1) + (xcd - r) * q) + off; }
        const int nig = WGM * nN, gid = wgid / nig, fm = gid * WGM, gsz = (nM - fm) < WGM ? (nM - fm) : WGM;
        u.pm = fm + ((wgid % nig) % gsz); u.pn = (wgid % nig) / gsz; u.e = 0; u.row0 = 0; u.cnt = 0;
        u.A = A + (size_t)u.pm * BM * K * 2; u.B = Bt + (size_t)u.pn * BM * K * 2; return true;
    }
    __device__ __forceinline__ unsigned aoff(const GUnit&, int row) const { return (unsigned)(row * K * 2); }
    __device__ __forceinline__ unsigned tokoff(const GUnit&, int) const { return 0u; }
    __device__ __forceinline__ const int* tokbase() const { return nullptr; }
};

struct EpiF32 {
    static constexpr bool PERM = false;
    float* C; int ldc; int resid;
    __device__ __forceinline__ void operator()(const f32x4 (&acc)[2][2][4][2], const GUnit& u, int wr, int wc, int fr, int fq) const {
        const int row0 = u.pm * BM + wr * 64 + fr, col0 = u.pn * BM + wc * 32 + 4 * fq;
#pragma unroll
        for (int ai = 0; ai < 2; ++ai)
#pragma unroll
            for (int m = 0; m < 4; ++m) { float* rowp = C + (size_t)(row0 + ai * HALF + m * 16) * ldc + col0;
#pragma unroll
                for (int bj = 0; bj < 2; ++bj)
#pragma unroll
                    for (int n = 0; n < 2; ++n) { f32x4 v = acc[ai][bj][m][n]; if (resid) v += *(const f32x4*)(rowp + bj * HALF + n * 16); *(f32x4*)(rowp + bj * HALF + n * 16) = v; } }
    }
};
struct EpiGlu {
    static constexpr bool PERM = false;
    float* C; const float* Y; int ldc; const float* bias;
    __device__ __forceinline__ void operator()(const f32x4 (&acc)[2][2][4][2], const GUnit& u, int wr, int wc, int fr, int fq) const {
        const int row0 = u.pm * BM + wr * 64 + fr, col0 = u.pn * BM + wc * 32 + 4 * fq;
#pragma unroll
        for (int ai = 0; ai < 2; ++ai)
#pragma unroll
            for (int m = 0; m < 4; ++m) { const size_t ro = (size_t)(row0 + ai * HALF + m * 16) * ldc + col0;
#pragma unroll
                for (int bj = 0; bj < 2; ++bj)
#pragma unroll
                    for (int n = 0; n < 2; ++n) { const f32x4 b = *(const f32x4*)(bias + col0 + bj * HALF + n * 16); const f32x4 y = *(const f32x4*)(Y + ro + bj * HALF + n * 16);
                        f32x4 v = acc[ai][bj][m][n] + b; f32x4 o;
#pragma unroll
                        for (int j = 0; j < 4; ++j) o[j] = y[j] / (1.f + __expf(-v[j]));
                        *(f32x4*)(C + ro + bj * HALF + n * 16) = o; } }
    }
};

template <class Epi, class Sched, bool GATHER, bool ALIGN_EPI>
__device__ __forceinline__ void gemm_phase(LAS unsigned char* lds, const int K, const Sched& S, const Epi& E, const int tid, const int wv) {
    const int wid = wv, lane = tid & 63, wr = wid >> 2, wc = wid & 3, fr = lane & 15, fq = lane >> 4;
    const int nt = K / BK;
    unsigned voffB[2];
#pragma unroll
    for (int i = 0; i < 2; ++i) { int R, C; stage_rc(tid * 16 + i * 8192, R, C); const int Rb = Epi::PERM ? ((R & ~31) + perm32(R & 31)) : R; voffB[i] = (unsigned)(Rb * K + C) * 2u; }
#define PG8_AOFFS(dst, u) do { int t2_ = tid; asm volatile("" : "+v"(t2_)); _Pragma("unroll") for (int i = 0; i < 2; ++i) { int R, C; stage_rc(t2_ * 16 + i * 8192, R, C); \
        _Pragma("unroll") for (int h = 0; h < 2; ++h) dst[h][i] = S.aoff(u, h * HALF + R) + (unsigned)C * 2u; } } while (0)
    const size_t kstep = (size_t)(BK * 2);
    const size_t hstep = (size_t)HALF * K * 2;
    const unsigned ldsw = (unsigned)wid * 1024u;
    const int aoff = lds_byte(wr * 64 + fr, fq * 8), boff = lds_byte(wc * 32 + fr, fq * 8);
#define PG8_SA(b, h) (((b) * 2 + (h)) * HTB)
#define PG8_SB(b, h) ((4 + (b) * 2 + (h)) * HTB)
#define PG8_STAGE(bufoff, gbase, v0, v1) do { const unsigned ld_ = (unsigned)(size_t)(lds + (bufoff) + ldsw); glds16s((gbase), (v0), ld_); glds16s((gbase), (v1), ld_ + 8192u); } while (0)
#define PG8_LDA(dst, b, h) do { _Pragma("unroll") for (int m = 0; m < 4; ++m) _Pragma("unroll") for (int k = 0; k < 2; ++k) dst[m][k] = *(const LAS bf16x8*)(lds + PG8_SA(b, h) + aoff + m * 2048 + k * 1024); } while (0)
#define PG8_LDB(dst, b, h) do { _Pragma("unroll") for (int n = 0; n < 2; ++n) _Pragma("unroll") for (int k = 0; k < 2; ++k) dst[n][k] = *(const LAS bf16x8*)(lds + PG8_SB(b, h) + boff + n * 2048 + k * 1024); } while (0)
#define PG8_MMA(ai, bj, At, Bt) do { __builtin_amdgcn_s_setprio(1); _Pragma("unroll") for (int m = 0; m < 4; ++m) _Pragma("unroll") for (int n = 0; n < 2; ++n) _Pragma("unroll") for (int k = 0; k < 2; ++k) \
        acc[ai][bj][m][n] = __builtin_amdgcn_mfma_f32_16x16x32_bf16(Bt[n][k], At[m][k], acc[ai][bj][m][n], 0, 0, 0); __builtin_amdgcn_s_setprio(0); } while (0)
#define PG8_WAIT_V(n) asm volatile("s_waitcnt vmcnt(" #n ")" ::: "memory")
#define PG8_WAIT_L(n) asm volatile("s_waitcnt lgkmcnt(" #n ")" ::: "memory")
#define PG8_BAR __builtin_amdgcn_s_barrier()
#define PG8_SCHED __builtin_amdgcn_sched_barrier(0)
    GUnit cur, nxt; int ui = 0;
    if (!S.next(0, cur)) return;
    f32x4 acc[2][2][4][2];
#pragma unroll
    for (int a = 0; a < 2; ++a)
#pragma unroll
        for (int b = 0; b < 2; ++b)
#pragma unroll
            for (int m = 0; m < 4; ++m)
#pragma unroll
                for (int n = 0; n < 2; ++n) acc[a][b][m][n] = (f32x4){0.f, 0.f, 0.f, 0.f};
    bf16x8 At[4][2], B0[2][2], B1[2][2];
    unsigned vA[2][2], vN[2][2];
    PG8_AOFFS(vA, cur);
#pragma unroll
    for (int h = 0; h < 2; ++h)
#pragma unroll
        for (int i = 0; i < 2; ++i) vN[h][i] = vA[h][i];
    const char* cA = cur.A; const char* cB = cur.B;
    PG8_STAGE(PG8_SB(0, 0), cB, voffB[0], voffB[1]); PG8_STAGE(PG8_SB(0, 1), cB + hstep, voffB[0], voffB[1]); PG8_STAGE(PG8_SA(0, 0), cA, vA[0][0], vA[0][1]); PG8_STAGE(PG8_SA(0, 1), cA, vA[1][0], vA[1][1]);
    if (wr == 1) PG8_BAR;
    PG8_WAIT_V(2); PG8_BAR;
    PG8_STAGE(PG8_SB(1, 0), cB + kstep, voffB[0], voffB[1]); PG8_STAGE(PG8_SA(1, 0), cA + kstep, vA[0][0], vA[0][1]); PG8_STAGE(PG8_SB(1, 1), cB + hstep + kstep, voffB[0], voffB[1]);
    PG8_WAIT_V(6); PG8_BAR;
    for (;;) {
        const bool has_next = S.next(ui + 1, nxt);
        const char* nA = GATHER ? cA : (has_next ? nxt.A : cA); const char* nB = has_next ? nxt.B : cB;
        unsigned tok_[2][2] = {{0u, 0u}, {0u, 0u}};
#define PG8_KBODY(a1, a2, b2, a3, b3, W00, W01, W10, W11) do { \
              \
            PG8_LDB(B0, 0, 0); PG8_LDB(B1, 0, 1); PG8_SCHED; PG8_LDA(At, 0, 0); PG8_STAGE(PG8_SA(1, 1), a1, vA[1][0], vA[1][1]); \
            PG8_WAIT_V(8); PG8_WAIT_L(0); PG8_BAR; PG8_MMA(0, 0, At, B0); PG8_MMA(0, 1, At, B1); PG8_BAR; PG8_SCHED; \
              \
            PG8_LDA(At, 0, 1); PG8_STAGE(PG8_SB(0, 0), b2, voffB[0], voffB[1]); PG8_STAGE(PG8_SB(0, 1), (b2) + hstep, voffB[0], voffB[1]); PG8_STAGE(PG8_SA(0, 0), a2, W00, W01); \
            PG8_WAIT_V(8); PG8_WAIT_L(0); PG8_BAR; PG8_MMA(1, 0, At, B0); PG8_MMA(1, 1, At, B1); PG8_BAR; PG8_SCHED; \
              \
            PG8_LDB(B0, 1, 0); PG8_LDB(B1, 1, 1); PG8_SCHED; PG8_LDA(At, 1, 0); PG8_STAGE(PG8_SA(0, 1), a2, W10, W11); \
            PG8_WAIT_V(8); PG8_WAIT_L(0); PG8_BAR; PG8_MMA(0, 0, At, B0); PG8_MMA(0, 1, At, B1); PG8_BAR; PG8_SCHED; \
              \
            PG8_LDA(At, 1, 1); PG8_STAGE(PG8_SB(1, 0), b3, voffB[0], voffB[1]); PG8_STAGE(PG8_SB(1, 1), (b3) + hstep, voffB[0], voffB[1]); PG8_STAGE(PG8_SA(1, 0), a3, W00, W01); \
            PG8_WAIT_V(8); PG8_WAIT_L(0); PG8_BAR; PG8_MMA(1, 0, At, B0); PG8_MMA(1, 1, At, B1); PG8_BAR; PG8_SCHED; } while (0)
        for (int t = 0; t < nt - 2; t += 2) {
            const char* a1 = cA + (size_t)(t + 1) * kstep;
            const char* a2 = cA + (size_t)(t + 2) * kstep; const char* b2 = cB + (size_t)(t + 2) * kstep;
            const char* a3 = a2 + kstep; const char* b3 = b2 + kstep;
            if (GATHER) { if (t == nt - 4 && has_next) { int t2_ = tid; asm volatile("" : "+v"(t2_));
#pragma unroll
                for (int i = 0; i < 2; ++i) { int R, C; stage_rc(t2_ * 16 + i * 8192, R, C);
#pragma unroll
                    for (int h = 0; h < 2; ++h) { const unsigned vo = S.tokoff(nxt, h * HALF + R); asm volatile("global_load_dword %0, %1, %2" : "=v"(tok_[h][i]) : "v"(vo), "s"(S.tokbase()) : "memory"); } } } }
            PG8_KBODY(a1, a2, b2, a3, b3, vA[0][0], vA[0][1], vA[1][0], vA[1][1]);
        }
        if (GATHER) {
            if (has_next) { int t2_ = tid; asm volatile("" : "+v"(t2_), "+v"(tok_[0][0]), "+v"(tok_[0][1]), "+v"(tok_[1][0]), "+v"(tok_[1][1]));
#pragma unroll
                for (int i = 0; i < 2; ++i) { int R, C; stage_rc(t2_ * 16 + i * 8192, R, C);
#pragma unroll
                    for (int h = 0; h < 2; ++h) vN[h][i] = tok_[h][i] * (unsigned)(K * 2) + (unsigned)C * 2u; } }
            else {
#pragma unroll
                for (int h = 0; h < 2; ++h)
#pragma unroll
                    for (int i = 0; i < 2; ++i) vN[h][i] = vA[h][i];
            }
        }
        {
            const char* a1 = cA + (size_t)(nt - 1) * kstep;
            const char* a3 = nA + kstep; const char* b3 = nB + kstep;
            PG8_KBODY(a1, nA, nB, a3, b3, vN[0][0], vN[0][1], vN[1][0], vN[1][1]);
        }
#undef PG8_KBODY
        if constexpr (ALIGN_EPI) { if (wr == 0) PG8_BAR; }
        { int t3_ = tid; asm volatile("" : "+v"(t3_)); const int l3_ = t3_ & 63; E(acc, cur, wr, wc, l3_ & 15, l3_ >> 4); }
        if (!has_next) break;
#pragma unroll
        for (int a = 0; a < 2; ++a)
#pragma unroll
            for (int b = 0; b < 2; ++b)
#pragma unroll
                for (int m = 0; m < 4; ++m)
#pragma unroll
                    for (int n = 0; n < 2; ++n) acc[a][b][m][n] = (f32x4){0.f, 0.f, 0.f, 0.f};
        cur = nxt; cA = nA; cB = nB; ++ui;
        if (GATHER) {
#pragma unroll
            for (int h = 0; h < 2; ++h)
#pragma unroll
                for (int i = 0; i < 2; ++i) vA[h][i] = vN[h][i];
        }
        if constexpr (ALIGN_EPI) { if (wr == 1) PG8_BAR; }
    }
    PG8_WAIT_V(0);
    if constexpr (!ALIGN_EPI) { if (wr == 0) PG8_BAR; }
    PG8_BAR;
#undef PG8_AOFFS
#undef PG8_SA
#undef PG8_SB
#undef PG8_STAGE
#undef PG8_LDA
#undef PG8_LDB
#undef PG8_MMA
#undef PG8_WAIT_V
#undef PG8_WAIT_L
#undef PG8_BAR
#undef PG8_SCHED
}


constexpr int TS_OFF = 131072 + 1024;
template <bool GATHER> struct MoeOrder {
    const char* A; const char* Bt; const int* rowtok; int nN, nwg, nM, G, c, K; size_t strideE;
    __device__ __forceinline__ void init(const bf16_t* A_, const bf16_t* Bt_, const int* rowtok_, int N, int K_, size_t strideE_, int G_, int c_) {
        A = (const char*)A_; Bt = (const char*)Bt_; rowtok = rowtok_; nN = N / BM; K = K_; strideE = strideE_; G = G_; c = c_;
        nM = __builtin_amdgcn_readfirstlane(((LAS const int*)(LDSP + TS_OFF))[32]); nwg = nM * nN; }
    __device__ __forceinline__ bool next(int i, GUnit& u) const {
        const long L = (long)i * G + c; if (L >= nwg) return false;
        int wgid = (int)L; { const int q = nwg / NXCD, r = nwg % NXCD, xcd = wgid % NXCD, off = wgid / NXCD; wgid = (xcd < r ? xcd * (q + 1) : r * (q + 1) + (xcd - r) * q) + off; }
        const int nig = WGM * nN, gid = wgid / nig, fm = gid * WGM, gsz = (nM - fm) < WGM ? (nM - fm) : WGM;
        u.pm = fm + ((wgid % nig) % gsz); u.pn = (wgid % nig) / gsz;
        LAS const int* ts = (LAS const int*)(LDSP + TS_OFF);
        const int e = __builtin_amdgcn_readfirstlane(ts[72 + u.pm]);
        u.e = e; u.row0 = (u.pm - __builtin_amdgcn_readfirstlane(ts[e])) * BM; u.cnt = __builtin_amdgcn_readfirstlane(ts[33 + e]);
        u.A = GATHER ? A : A + (size_t)u.pm * BM * K * 2;
        u.B = Bt + (size_t)e * strideE + (size_t)u.pn * BM * K * 2; return true;
    }
    __device__ __forceinline__ unsigned aoff(const GUnit& u, int row) const {
        if (GATHER) { int sl = u.row0 + row; sl = sl < u.cnt ? sl : u.cnt - 1; return (unsigned)rowtok[u.e * ECAP + sl] * (unsigned)(K * 2); }
        return (unsigned)(row * K * 2);
    }
    __device__ __forceinline__ unsigned tokoff(const GUnit& u, int row) const { int sl = u.row0 + row; sl = sl < u.cnt ? sl : u.cnt - 1; return (unsigned)(u.e * ECAP + sl) * 4u; }
    __device__ __forceinline__ const int* tokbase() const { return rowtok; }
};
__device__ __forceinline__ void moe_tiles(const unsigned* cnt, int tid) {
    LAS int* ts = (LAS int*)(LDSP + TS_OFF);
    if (tid == 0) { int s = 0; for (int e = 0; e < NEXP; ++e) { const int c = (int)cnt[e]; ts[e] = s; ts[33 + e] = c; const int n = (c + BM - 1) / BM;
_Pragma("clang loop vectorize(disable) unroll(disable)") for (int t = 0; t < n; ++t) ts[72 + s + t] = e;
            s += n; } ts[NEXP] = s; }
    __syncthreads();
}
struct EpiMoe1 {
    static constexpr bool PERM = true;
    bf16_t* O; const float* b1; const float* rsc;
    __device__ __forceinline__ void operator()(const f32x4 (&acc)[2][2][4][2], const GUnit& u, int wr, int wc, int fr, int fq) const {
        const int rt0 = wr * 64 + fr, col0 = u.pn * 128 + wc * 32 + 8 * fq;
        const float* bg = b1 + (size_t)u.e * 2048 + col0;
        f32x4 bgv[2], blv[2];
#pragma unroll
        for (int n = 0; n < 2; ++n) { bgv[n] = *(const f32x4*)(bg + 4 * n); blv[n] = *(const f32x4*)(bg + DFF + 4 * n); }
#pragma unroll
        for (int ai = 0; ai < 2; ++ai)
#pragma unroll
            for (int m = 0; m < 4; ++m) {
                const int rt = rt0 + ai * HALF + m * 16; int sl = u.row0 + rt; sl = sl < u.cnt ? sl : u.cnt - 1;
                const float r = rsc[u.e * ECAP + sl];
                float o[8];
                const f32x2 r2 = (f32x2){r, r};
#pragma unroll
                for (int n = 0; n < 2; ++n)
#pragma unroll
                    for (int jp = 0; jp < 2; ++jp) {
                        const f32x2 ag = (f32x2){acc[ai][0][m][n][2 * jp], acc[ai][0][m][n][2 * jp + 1]}, al = (f32x2){acc[ai][1][m][n][2 * jp], acc[ai][1][m][n][2 * jp + 1]};
                        f32x2 g = ag * r2 + (f32x2){bgv[n][2 * jp], bgv[n][2 * jp + 1]}, l = al * r2 + (f32x2){blv[n][2 * jp], blv[n][2 * jp + 1]};
                        g.x = fminf(g.x, 7.f); g.y = fminf(g.y, 7.f);
                        l.x = __builtin_amdgcn_fmed3f(l.x, -7.f, 7.f); l.y = __builtin_amdgcn_fmed3f(l.y, -7.f, 7.f);
                        const f32x2 z = g * (-2.4554669595930157f);
                        f32x2 e; e.x = __builtin_amdgcn_exp2f(z.x); e.y = __builtin_amdgcn_exp2f(z.y);
                        e = e + 1.0f;
                        f32x2 q; q.x = __builtin_amdgcn_rcpf(e.x); q.y = __builtin_amdgcn_rcpf(e.y);
                        const f32x2 v = (g * q) * (l + 1.0f);
                        o[n * 4 + 2 * jp] = v.x; o[n * 4 + 2 * jp + 1] = v.y;
                    }
                u32x4 w; w.x = cvt_pk_bf16(o[0], o[1]); w.y = cvt_pk_bf16(o[2], o[3]); w.z = cvt_pk_bf16(o[4], o[5]); w.w = cvt_pk_bf16(o[6], o[7]);
                *(u32x4*)(O + (size_t)(u.pm * BM + rt) * DFF + col0) = w;
            }
    }
};
struct EpiMoe2 {
    static constexpr bool PERM = true;
    bf16_t* O; const float* b2;
    __device__ __forceinline__ void operator()(const f32x4 (&acc)[2][2][4][2], const GUnit& u, int wr, int wc, int fr, int fq) const {
        const int row0 = u.pm * BM + wr * 64 + fr, col0 = u.pn * BM + wc * 32 + 8 * fq;
        f32x4 bv[2][2];
#pragma unroll
        for (int bj = 0; bj < 2; ++bj)
#pragma unroll
            for (int n = 0; n < 2; ++n) bv[bj][n] = *(const f32x4*)(b2 + (size_t)u.e * DM + col0 + bj * HALF + 4 * n);
#pragma unroll
        for (int ai = 0; ai < 2; ++ai)
#pragma unroll
            for (int m = 0; m < 4; ++m) { bf16_t* rowp = O + (size_t)(row0 + ai * HALF + m * 16) * DM + col0;
#pragma unroll
                for (int bj = 0; bj < 2; ++bj) { const f32x4 v0 = acc[ai][bj][m][0] + bv[bj][0], v1 = acc[ai][bj][m][1] + bv[bj][1];
                    u32x4 w; w.x = cvt_pk_bf16(v0[0], v0[1]); w.y = cvt_pk_bf16(v0[2], v0[3]); w.z = cvt_pk_bf16(v1[0], v1[1]); w.w = cvt_pk_bf16(v1[2], v1[3]);
                    *(u32x4*)(rowp + bj * HALF) = w; } }
    }
};

__device__ __forceinline__ void p_transpose_r(const int wv, const float* W, int nmat, int K, int N, bf16_t* WT, const float* kgain, int gdiv, int mode, LAS unsigned char* lds, int it_begin, int it_end, int wrank, int wstride) {
    LTID();
    const int wave = wv, lane = tidx & 63;
    LAS float* scr = (LAS float*)(lds + wave * 16384);
    const int nblk = N / 32, per_mat = (K / 64) * nblk, total = it_end, stride = wstride;
    const int lrow = lane >> 5, lcol = lane & 31;
#define TR_DECODE(item, mat_, kb_, nb_) const int mat_ = (item) / per_mat, r_ = (item) - mat_ * per_mat, g8_ = r_ >> 3, l8_ = r_ & 7, kb_ = 2 * (g8_ / (nblk >> 2)) + (l8_ & 1), nb_ = 4 * (g8_ % (nblk >> 2)) + (l8_ >> 1)
#define TR_ISSUE(item, dst) do { TR_DECODE(item, mat_, kb_, nb_); \
        const float* src_ = W + (size_t)mat_ * K * N + (size_t)(64 * kb_ + lrow) * N + 32 * nb_ + lcol; \
        _Pragma("unroll") for (int i = 0; i < 32; ++i) dst[i] = __builtin_nontemporal_load(src_ + (size_t)(2 * i) * N); } while (0)
    float v[32], vn[32], vnn[32];
    int it = it_begin + wrank;
    if (it < total) TR_ISSUE(it, v);
    if (it + stride < total) TR_ISSUE(it + stride, vn);
    while (it < total) {
        const int itn = it + stride, itnn = itn + stride;
        if (itnn < total) TR_ISSUE(itnn, vnn);
        TR_DECODE(it, mat, kb, nb); const int k0 = 64 * kb, n0 = 32 * nb;
#pragma unroll
        for (int i = 0; i < 32; ++i) scr[(2 * i + lrow) * 33 + lcol] = v[i];
        asm volatile("s_waitcnt lgkmcnt(0)" ::: "memory");
        int d0 = n0;
        if (mode == 1) { const int bj = n0 >> 10, rest = n0 & 1023, pn = rest >> 7, j = rest & 127; d0 = pn * 256 + bj * 128 + j; }
        const int c = lane & 7;
        f32x4 g0 = (f32x4){1.f, 1.f, 1.f, 1.f}, g1 = g0;
        if (kgain) { const float* gp = kgain + (size_t)(mat / gdiv) * DM + k0 + 8 * c; g0 = *(const f32x4*)gp; g1 = *(const f32x4*)(gp + 4); }
        bf16_t* dst = WT + (size_t)mat * K * N;
#pragma unroll
        for (int j = 0; j < 4; ++j) { const int n = (lane >> 3) + 8 * j; const LAS float* sp = scr + (8 * c) * 33 + n;
            u32x4 o; o.x = cvt_pk_bf16(sp[0 * 33] * g0[0], sp[1 * 33] * g0[1]); o.y = cvt_pk_bf16(sp[2 * 33] * g0[2], sp[3 * 33] * g0[3]); o.z = cvt_pk_bf16(sp[4 * 33] * g1[0], sp[5 * 33] * g1[1]); o.w = cvt_pk_bf16(sp[6 * 33] * g1[2], sp[7 * 33] * g1[3]);
            __builtin_nontemporal_store(o, (u32x4*)(dst + (size_t)(d0 + n) * K + k0 + 8 * c)); }
        asm volatile("s_waitcnt lgkmcnt(0)" ::: "memory");
#pragma unroll
        for (int i = 0; i < 32; ++i) { v[i] = vn[i]; vn[i] = vnn[i]; }
        it = itn;
    }
#undef TR_ISSUE
#undef TR_DECODE
}
__device__ __forceinline__ void p_transpose(const int wv, const float* W, int nmat, int K, int N, bf16_t* WT, const float* kgain, int gdiv, int mode, LAS unsigned char* lds) {
    p_transpose_r(wv, W, nmat, K, N, WT, kgain, gdiv, mode, lds, 0, nmat * (K / 64) * (N / 32), (int)blockIdx.x * NW + wv, (int)gridDim.x * NW);
}
typedef short v4i16_t __attribute__((ext_vector_type(4)));
constexpr int ATT_TAB_OFF = 131072 + 2048;
constexpr int ATT_UNITS = 3 * 8 * 128;
__device__ __forceinline__ int t5_bucket_dev(int n) {
    if (n < 16) return n;
    const float v = logf((float)n / 16.f) / 4.852030263919617f * 16.f;
    const int large = 16 + (int)v;
    return large < 31 ? large : 31;
}
__device__ __forceinline__ void p_bias_table(const int wv, const float* rel_bias, float* biasG) {
    LTID();
    for (int i = bidx * NT + tidx; i < 3 * 8 * 132; i += gridDim.x * NT) {
        const int d = i % 132, bh = i / 132, h = bh & 7, b = bh >> 3;
        biasG[i] = (d <= 128) ? rel_bias[t5_bucket_dev(d << (2 * b)) * 8 + h] * 1.4426950408889634f : 0.f;
    }
}
__device__ __forceinline__ void p_dil_attn(const int wv, const bf16_t* proj16, const float* biasG, bf16_t* obr, float* lse, LAS unsigned char* lds) {
    LTID();
    const int lane = tidx & 63, fr = lane & 15, fq = lane >> 4, w = wv;
    const int per = (ATT_UNITS + (int)gridDim.x - 1) / (int)gridDim.x;
    const int u0 = bidx * per, u1 = (u0 + per < ATT_UNITS) ? u0 + per : ATT_UNITS;
    if (u0 >= u1) return;
    const int rowl = tidx >> 3, cs = tidx & 7;
    const unsigned cK = (unsigned)(cs ^ ((rowl >> 1) & 7)) * 16u, cV = (unsigned)(cs ^ (rowl & 7)) * 16u;
    const unsigned fK = (unsigned)((fr >> 1) & 7);
    const unsigned kro0 = (unsigned)fr * 128u + (((unsigned)fq ^ fK) * 16u), kro1 = (unsigned)fr * 128u + ((((unsigned)fq ^ fK) ^ 4u) * 16u);
    const int tq = (lane & 15) >> 2, tp = lane & 3, fv = 4 * (fq & 1) + tq;
    unsigned vro[4];
#pragma unroll
    for (int db = 0; db < 4; ++db) vro[db] = (unsigned)(4 * fq + tq) * 128u + (unsigned)(((2 * db + (tp >> 1)) ^ fv) * 16) + 8u * (unsigned)(tp & 1);
    const int ts_ = (1 + fr) & 3;
    const unsigned tab8 = (unsigned)ATT_TAB_OFF + (unsigned)ts_ * 640u + (unsigned)(((141 + fr - ts_) >> 2) - fq - 32) * 16u;
    const char* gbase = (const char*)proj16;
#define ATT_DECODE(u, b_, h_, r_, n_, dil_) const int cmb_ = (u) >> 7, b_ = cmb_ >> 3, h_ = cmb_ & 7, dil_ = 1 << (2 * b_), idx_ = (u) & 127, r_ = idx_ & (dil_ - 1), n_ = idx_ >> (2 * b_)
#define ATT_ISSUE(u, bf, q0, q1) do { ATT_DECODE(u, b__, h__, r__, n__, dil__); \
        const int nk = n__ > 0 ? n__ - 1 : 0;                                     \
        _Pragma("unroll") for (int p = 0; p < 4; ++p) { \
            int row = 64 * p + rowl; int blk = (row >> 7) ? n__ : nk; \
            const unsigned pos = (unsigned)(r__ + dil__ * (128 * blk + (row & 127))); \
            const unsigned so = pos * 4096u + (unsigned)h__ * 128u; const unsigned ld_ = (unsigned)(size_t)(lds + (bf) * 65536 + p * 8192 + w * 1024); \
            glds16s(gbase, so + 1024u + cK, ld_); glds16s(gbase, so + 2048u + cV, ld_ + 32768u); } \
        const unsigned qpos = (unsigned)(r__ + dil__ * (128 * n__ + 16 * w + fr)); \
        const char* qsrc = gbase + (size_t)qpos * 4096u + (unsigned)h__ * 128u + (unsigned)fq * 16u; \
        q0 = *(const bf16x8*)(qsrc); q1 = *(const bf16x8*)(qsrc + 64); } while (0)
    bf16x8 qf0, qf1, qn0, qn1;
    ATT_ISSUE(u0, 0, qn0, qn1);
    int prev_cmb = -1;
    for (int u = u0; u < u1; ++u) {
        const int bf = (u - u0) & 1;
        asm volatile("s_waitcnt vmcnt(0)" ::: "memory");
        __syncthreads();
        qf0 = qn0; qf1 = qn1;
        if (u + 1 < u1) ATT_ISSUE(u + 1, bf ^ 1, qn0, qn1);
        ATT_DECODE(u, b, h, r, n, dil);
        if (cmb_ != prev_cmb) {
            prev_cmb = cmb_;
            for (int e = tidx; e < 4 * 160; e += NT) { const int sft = e / 160, k = e - sft * 160, idx = k + sft, dist = idx - 16;
                const float v = (dist >= 0 && dist <= 128) ? biasG[cmb_ * 132 + dist] : -1e30f;
                ((LAS float*)(lds + ATT_TAB_OFF))[sft * 160 + k] = v; }
            __syncthreads();
        }
        const LAS unsigned char* Kb = lds + bf * 65536; const LAS unsigned char* Vb = Kb + 32768;
        const int kb0 = w;
        f32x4 sc[9];
#pragma unroll
        for (int i = 0; i < 9; ++i) {
            const unsigned ko = (unsigned)(kb0 + i) * 2048u;
            const bf16x8 k0 = *(const LAS bf16x8*)(Kb + ko + kro0), k1 = *(const LAS bf16x8*)(Kb + ko + kro1);
            f32x4 a = (f32x4){0.f, 0.f, 0.f, 0.f};
            a = __builtin_amdgcn_mfma_f32_16x16x32_bf16(k0, qf0, a, 0, 0, 0);
            a = __builtin_amdgcn_mfma_f32_16x16x32_bf16(k1, qf1, a, 0, 0, 0);
            const f32x4 t = *(const LAS f32x4*)(lds + tab8 + 64 * (8 - i));
            a = a + (f32x4){t[3], t[2], t[1], t[0]};
            if (n == 0 && kb0 + i < 8) a = (f32x4){-1e30f, -1e30f, -1e30f, -1e30f};
            sc[i] = a;
        }
#pragma unroll
        for (int i = 0; i < 9; ++i)
#pragma unroll
            for (int j = 0; j < 4; ++j) sc[i][j] = __builtin_amdgcn_exp2f(fminf(sc[i][j], 100.f));
        f32x4 oacc[4]; f32x4 sacc = (f32x4){0.f, 0.f, 0.f, 0.f};
        const bf16x8 ones = (bf16x8){0x3F80, 0x3F80, 0x3F80, 0x3F80, 0x3F80, 0x3F80, 0x3F80, 0x3F80};
#pragma unroll
        for (int db = 0; db < 4; ++db) oacc[db] = (f32x4){0.f, 0.f, 0.f, 0.f};
#pragma unroll
        for (int c = 0; c < 5; ++c) {
            const int ia = 2 * c, ib = (c < 4) ? 2 * c + 1 : 8;
            u32x4 pw; pw.x = cvt_pk_bf16(sc[ia][0], sc[ia][1]); pw.y = cvt_pk_bf16(sc[ia][2], sc[ia][3]);
            if (c < 4) { pw.z = cvt_pk_bf16(sc[ib][0], sc[ib][1]); pw.w = cvt_pk_bf16(sc[ib][2], sc[ib][3]); } else { pw.z = 0u; pw.w = 0u; }
            const bf16x8 pf = __builtin_bit_cast(bf16x8, pw);
            const unsigned va = (unsigned)(kb0 + ia) * 2048u, vb = (unsigned)(kb0 + ib) * 2048u;
            sacc = __builtin_amdgcn_mfma_f32_16x16x32_bf16(ones, pf, sacc, 0, 0, 0);
#pragma unroll
            for (int db = 0; db < 4; ++db) {
                const v4i16_t x0 = __builtin_amdgcn_ds_read_tr16_b64_v4i16((LAS v4i16_t*)(Vb + va + vro[db]));
                const v4i16_t x1 = __builtin_amdgcn_ds_read_tr16_b64_v4i16((LAS v4i16_t*)(Vb + vb + vro[db]));
                const bf16x8 vf = (bf16x8){x0[0], x0[1], x0[2], x0[3], x1[0], x1[1], x1[2], x1[3]};
                oacc[db] = __builtin_amdgcn_mfma_f32_16x16x32_bf16(vf, pf, oacc[db], 0, 0, 0);
            }
        }
        const float sum = sacc[0];
        const float inv = 1.f / sum;
        const unsigned qpos = (unsigned)(r + dil * (128 * n + 16 * w + fr));
        bf16_t* orow = obr + ((size_t)b * SEQ + qpos) * 512 + h * 64 + 4 * fq;
#pragma unroll
        for (int db = 0; db < 4; ++db) { u32x2 o2; o2.x = cvt_pk_bf16(oacc[db][0] * inv, oacc[db][1] * inv); o2.y = cvt_pk_bf16(oacc[db][2] * inv, oacc[db][3] * inv); *(u32x2*)(orow + 16 * db) = o2; }
        if (fq == 0) lse[((size_t)b * SEQ + qpos) * 8 + h] = sum;
    }
    asm volatile("s_waitcnt vmcnt(0)" ::: "memory");
    __syncthreads();
#undef ATT_DECODE
#undef ATT_ISSUE
}
__device__ __forceinline__ void p_attn_combine(const int wv, const bf16_t* obr, const float* lse, const float* g, bf16_t* mix16) {
    LTID();
    const int lane = tidx & 63, h = lane >> 3;
    const f32x4 g0 = *(const f32x4*)(g + lane * 8), g1 = *(const f32x4*)(g + lane * 8 + 4);
    const int rstride = (int)gridDim.x * NW;
    for (int row0 = bidx * NW + wv; row0 < SEQ; row0 += 4 * rstride) {
        float lv[4][3]; u32x4 av[4][3];
#pragma unroll
        for (int r = 0; r < 4; ++r) { const int row = (row0 + r * rstride < SEQ) ? row0 + r * rstride : row0;
#pragma unroll
            for (int b = 0; b < 3; ++b) { lv[r][b] = lse[((size_t)b * SEQ + row) * 8 + h]; av[r][b] = *(const u32x4*)(obr + ((size_t)b * SEQ + row) * 512 + lane * 8); } }
#pragma unroll
        for (int r = 0; r < 4; ++r) {
            const int row = row0 + r * rstride;
            float w0 = lv[r][0], w1 = lv[r][1], w2 = lv[r][2];
            const float iw = 1.f / (w0 + w1 + w2); w0 *= iw; w1 *= iw; w2 *= iw;
            float y[8]; float ss = 0.f;
#pragma unroll
            for (int k = 0; k < 4; ++k) {
                const float lo = w0 * __builtin_bit_cast(float, av[r][0][k] << 16) + w1 * __builtin_bit_cast(float, av[r][1][k] << 16) + w2 * __builtin_bit_cast(float, av[r][2][k] << 16);
                const float hi = w0 * __builtin_bit_cast(float, av[r][0][k] & 0xffff0000u) + w1 * __builtin_bit_cast(float, av[r][1][k] & 0xffff0000u) + w2 * __builtin_bit_cast(float, av[r][2][k] & 0xffff0000u);
                y[2 * k] = lo; y[2 * k + 1] = hi; ss += lo * lo + hi * hi;
            }
#pragma unroll
            for (int o = 32; o; o >>= 1) ss += shx(ss, o, lane);
            const float sc = rsqrtf(ss * (1.f / 512.f) + 1e-5f);
            u32x4 o4; o4.x = cvt_pk_bf16(y[0] * sc * g0[0], y[1] * sc * g0[1]); o4.y = cvt_pk_bf16(y[2] * sc * g0[2], y[3] * sc * g0[3]);
            o4.z = cvt_pk_bf16(y[4] * sc * g1[0], y[5] * sc * g1[1]); o4.w = cvt_pk_bf16(y[6] * sc * g1[2], y[7] * sc * g1[3]);
            if (row < SEQ) *(u32x4*)(mix16 + (size_t)row * DM + lane * 8) = o4;
        }
    }
}
struct EpiIn {
    static constexpr bool PERM = true;
    bf16_t* O;
    __device__ __forceinline__ void operator()(const f32x4 (&acc)[2][2][4][2], const GUnit& u, int wr, int wc, int fr, int fq) const {
        const int row0 = u.pm * BM + wr * 64 + fr, col0 = u.pn * BM + wc * 32 + 8 * fq;
        const float sc = u.pn < 2 ? 0.18033688011112042f : 1.f;
#pragma unroll
        for (int ai = 0; ai < 2; ++ai)
#pragma unroll
            for (int m = 0; m < 4; ++m) { const size_t ro = (size_t)(row0 + ai * HALF + m * 16) * DIN + col0;
#pragma unroll
                for (int bj = 0; bj < 2; ++bj) { const f32x4 v0 = acc[ai][bj][m][0] * sc, v1 = acc[ai][bj][m][1] * sc;
                    u32x4 w; w.x = cvt_pk_bf16(v0[0], v0[1]); w.y = cvt_pk_bf16(v0[2], v0[3]); w.z = cvt_pk_bf16(v1[0], v1[1]); w.w = cvt_pk_bf16(v1[2], v1[3]);
                    *(u32x4*)(O + ro + bj * HALF) = w;
                    } }
    }
};


__device__ __forceinline__ unsigned xoff_b(unsigned row, unsigned ch) { return 256u * row + 16u * (ch ^ (((row & 3u) << 2) | ((row >> 2) & 3u))); }
__device__ __forceinline__ void p_xattn_mfma(const int wv, const bf16_t* qx16, const bf16_t* kv16, bf16_t* ox16, LAS unsigned char* lds) {
    LTID();
    const int lane = tidx & 63, fr = lane & 15, fq = lane >> 4, w = wv;
    const int NU = 4 * 128;
    const int per = (NU + (int)gridDim.x - 1) / (int)gridDim.x;
    const int u0 = bidx * per, u1 = (u0 + per < NU) ? u0 + per : NU;
    if (u0 >= u1) return;
    const int rowl = tidx >> 4, cs = tidx & 15;
    const unsigned csw = (unsigned)(cs ^ (((rowl & 3) << 2) | ((rowl >> 2) & 3))) * 16u;
    const unsigned kswz = (unsigned)(((fr & 3) << 2) | ((fr >> 2) & 3));
    unsigned kro[4];
#pragma unroll
    for (int s4 = 0; s4 < 4; ++s4) kro[s4] = 256u * (unsigned)fr + 16u * ((unsigned)(4 * s4 + fq) ^ kswz);
    const int tq = (lane & 15) >> 2, tp = lane & 3;
    const unsigned vswz = (unsigned)((tq << 2) | fq);
    unsigned vro[8];
#pragma unroll
    for (int c = 0; c < 8; ++c) vro[c] = 65536u + 256u * (unsigned)(4 * fq + tq) + 16u * ((unsigned)(2 * c + (tp >> 1)) ^ vswz) + 8u * (unsigned)(tp & 1);
    int prev_h = -1;
    for (int u = u0; u < u1; ++u) {
        const int h = u >> 7, qt = u & 127;
        if (h != prev_h) {
            __syncthreads();
            prev_h = h;
#pragma unroll
            for (int p = 0; p < 8; ++p) {
                const unsigned row = (unsigned)(32 * p + rowl);
                const unsigned so = row * 2048u + (unsigned)h * 256u + csw;
                const unsigned ld_ = (unsigned)(size_t)(lds + p * 8192 + w * 1024);
                glds16s(kv16, so, ld_); glds16s(kv16, so + 1024u, ld_ + 65536u);
            }
            asm volatile("s_waitcnt vmcnt(0)" ::: "memory");
            __syncthreads();
        }
        const char* qsrc = (const char*)qx16 + ((size_t)(qt * 128 + 16 * w + fr) * 512 + h * 128 + 8 * fq) * 2;
        bf16x8 qf[4];
#pragma unroll
        for (int s4 = 0; s4 < 4; ++s4) qf[s4] = *(const bf16x8*)(qsrc + 64 * s4);
        f32x4 sc[16];
#pragma unroll
        for (int i = 0; i < 16; ++i) {
            f32x4 a = (f32x4){0.f, 0.f, 0.f, 0.f};
#pragma unroll
            for (int s4 = 0; s4 < 4; ++s4) { const bf16x8 kf = *(const LAS bf16x8*)(lds + i * 4096 + kro[s4]); a = __builtin_amdgcn_mfma_f32_16x16x32_bf16(kf, qf[s4], a, 0, 0, 0); }
            sc[i] = a;
        }
        float mx = -1e30f;
#pragma unroll
        for (int i = 0; i < 16; ++i) mx = fmaxf(mx, fmaxf(fmaxf(sc[i][0], sc[i][1]), fmaxf(sc[i][2], sc[i][3])));
        mx = fmaxf(mx, shx(mx, 16, lane)); mx = fmaxf(mx, shx(mx, 32, lane));
        float sum = 0.f;
#pragma unroll
        for (int i = 0; i < 16; ++i)
#pragma unroll
            for (int j = 0; j < 4; ++j) { const float p = __expf(sc[i][j] - mx); sc[i][j] = p; sum += p; }
        sum += shx(sum, 16, lane); sum += shx(sum, 32, lane);
        f32x4 oacc[8];
#pragma unroll
        for (int c = 0; c < 8; ++c) oacc[c] = (f32x4){0.f, 0.f, 0.f, 0.f};
#pragma unroll
        for (int ch = 0; ch < 8; ++ch) {
            const int ia = 2 * ch, ib = 2 * ch + 1;
            u32x4 pw; pw.x = cvt_pk_bf16(sc[ia][0], sc[ia][1]); pw.y = cvt_pk_bf16(sc[ia][2], sc[ia][3]); pw.z = cvt_pk_bf16(sc[ib][0], sc[ib][1]); pw.w = cvt_pk_bf16(sc[ib][2], sc[ib][3]);
            const bf16x8 pf = __builtin_bit_cast(bf16x8, pw);
#pragma unroll
            for (int c = 0; c < 8; ++c) {
                const v4i16_t x0 = __builtin_amdgcn_ds_read_tr16_b64_v4i16((LAS v4i16_t*)(lds + ia * 4096 + vro[c]));
                const v4i16_t x1 = __builtin_amdgcn_ds_read_tr16_b64_v4i16((LAS v4i16_t*)(lds + ib * 4096 + vro[c]));
                const bf16x8 vf = (bf16x8){x0[0], x0[1], x0[2], x0[3], x1[0], x1[1], x1[2], x1[3]};
                oacc[c] = __builtin_amdgcn_mfma_f32_16x16x32_bf16(vf, pf, oacc[c], 0, 0, 0);
            }
        }
        const float inv = 1.f / sum;
        bf16_t* orow = ox16 + (size_t)(qt * 128 + 16 * w + fr) * 512 + h * 128 + 4 * fq;
#pragma unroll
        for (int c = 0; c < 8; ++c) { u32x2 o2; o2.x = cvt_pk_bf16(oacc[c][0] * inv, oacc[c][1] * inv); o2.y = cvt_pk_bf16(oacc[c][2] * inv, oacc[c][3] * inv); *(u32x2*)(orow + 16 * c) = o2; }
    }
    __syncthreads();
}
struct EpiBf16 {
    static constexpr bool PERM = true;
    bf16_t* O; int ldc; float scale; const float* ss;
    __device__ __forceinline__ void operator()(const f32x4 (&acc)[2][2][4][2], const GUnit& u, int wr, int wc, int fr, int fq) const {
        const int row0 = u.pm * BM + wr * 64 + fr, col0 = u.pn * BM + wc * 32 + 8 * fq;
#pragma unroll
        for (int ai = 0; ai < 2; ++ai)
#pragma unroll
            for (int m = 0; m < 4; ++m) { const int row = row0 + ai * HALF + m * 16; bf16_t* rowp = O + (size_t)row * ldc + col0;
                float sc = scale;
                if (ss) { const f32x4 p0 = *(const f32x4*)(ss + (size_t)row * 16), p1 = *(const f32x4*)(ss + (size_t)row * 16 + 4), p2 = *(const f32x4*)(ss + (size_t)row * 16 + 8), p3 = *(const f32x4*)(ss + (size_t)row * 16 + 12);
                    const float t = ((p0[0] + p0[1]) + (p0[2] + p0[3])) + ((p1[0] + p1[1]) + (p1[2] + p1[3])) + ((p2[0] + p2[1]) + (p2[2] + p2[3])) + ((p3[0] + p3[1]) + (p3[2] + p3[3]));
                    sc = scale * rsqrtf(t * (1.f / 1024.f) + 1e-5f); }
#pragma unroll
                for (int bj = 0; bj < 2; ++bj) { const f32x4 v0 = acc[ai][bj][m][0] * sc, v1 = acc[ai][bj][m][1] * sc;
                    u32x4 w; w.x = cvt_pk_bf16(v0[0], v0[1]); w.y = cvt_pk_bf16(v0[2], v0[3]); w.z = cvt_pk_bf16(v1[0], v1[1]); w.w = cvt_pk_bf16(v1[2], v1[3]);
                    *(u32x4*)(rowp + bj * HALF) = w; } }
    }
};
struct EpiOut {
    static constexpr bool PERM = true;
    const float* R; float* H; bf16_t* HB; float* ss;
    __device__ __forceinline__ void operator()(const f32x4 (&acc)[2][2][4][2], const GUnit& u, int wr, int wc, int fr, int fq) const {
        const int row0 = u.pm * BM + wr * 64 + fr, col0 = u.pn * BM + wc * 32 + 8 * fq, lane = fq * 16 + fr;
#pragma unroll
        for (int ai = 0; ai < 2; ++ai)
#pragma unroll
            for (int m = 0; m < 4; ++m) { const int row = row0 + ai * HALF + m * 16; const size_t ro = (size_t)row * DM + col0; float sq = 0.f;
#pragma unroll
                for (int bj = 0; bj < 2; ++bj) {
                    const f32x4 v0 = acc[ai][bj][m][0] + *(const f32x4*)(R + ro + bj * HALF), v1 = acc[ai][bj][m][1] + *(const f32x4*)(R + ro + bj * HALF + 4);
                    *(f32x4*)(H + ro + bj * HALF) = v0; *(f32x4*)(H + ro + bj * HALF + 4) = v1;
                    u32x4 w; w.x = cvt_pk_bf16(v0[0], v0[1]); w.y = cvt_pk_bf16(v0[2], v0[3]); w.z = cvt_pk_bf16(v1[0], v1[1]); w.w = cvt_pk_bf16(v1[2], v1[3]);
                    *(u32x4*)(HB + ro + bj * HALF) = w;
                    sq += (v0[0] * v0[0] + v0[1] * v0[1]) + (v0[2] * v0[2] + v0[3] * v0[3]) + (v1[0] * v1[0] + v1[1] * v1[1]) + (v1[2] * v1[2] + v1[3] * v1[3]);
                }
                sq += shx(sq, 16, lane); sq += shx(sq, 32, lane);
                if (fq == 0) ss[(size_t)row * 16 + u.pn * 4 + wc] = sq;
            }
    }
};

typedef short bf16x4 __attribute__((ext_vector_type(4)));
constexpr int S5_CHUNK = 256, S5_NCH = SEQ / S5_CHUNK, S5_ROWB = 528;
__device__ __forceinline__ f32x2 gelu_pk(f32x2 v) {
    const f32x2 av = __builtin_elementwise_abs(v), d = av * 0.2316418882f + 1.0f;
    f32x2 t; t.x = __builtin_amdgcn_rcpf(d.x); t.y = __builtin_amdgcn_rcpf(d.y);
    f32x2 q = t * 0.5307027145f + (-0.7265760135f); q = q * t + 0.7107068705f; q = q * t + (-0.142248368f); q = q * t + 0.127414796f; q = q * t;
    const f32x2 s2 = (v * v) * (-0.72134752044f);
    f32x2 e; e.x = __builtin_amdgcn_exp2f(s2.x); e.y = __builtin_amdgcn_exp2f(s2.y);
    const f32x2 m = v * (q * e), r = v - m;
    f32x2 o; o.x = v.x < 0.f ? m.x : r.x; o.y = v.y < 0.f ? m.y : r.y; return o;
}
__device__ __forceinline__ void p_s5_tables2(const int wv, const float* a_re, const float* a_im, const float* b_re, const float* b_im, const float* c_re, const float* c_im, const float* log_dt,
                                             float2* abar, float2* a256, bf16_t* BB16, bf16_t* CM16) {
    LTID();
    for (int gp = bidx * NT + tidx; gp < 2048; gp += gridDim.x * NT) {
        const int g = gp >> 6, p = gp & 63;
        const float lr = a_re[gp], li = a_im[gp], dt = expf(log_dt[g]);
        const float mag = expf(lr * dt); float sn, cs; sincosf(li * dt, &sn, &cs);
        const float ar = mag * cs, ai = mag * sn;
        abar[gp] = make_float2(ar, ai);
        float pr = ar, pi = ai;
        for (int i = 0; i < 8; ++i) { const float nr = pr * pr - pi * pi, ni = 2.f * pr * pi; pr = nr; pi = ni; }
        a256[gp] = make_float2(pr, pi);
        const float nr = ar - 1.f, ni = ai, den = lr * lr + li * li;
        const float cr = (nr * lr + ni * li) / den, ci = (ni * lr - nr * li) / den;
        for (int c = 0; c < 16; ++c) {
            const float br = b_re[gp * 16 + c], bi = b_im[gp * 16 + c];
            BB16[((size_t)g * 128 + p) * 16 + c] = (bf16_t)f2bf(cr * br - ci * bi);
            BB16[((size_t)g * 128 + 64 + p) * 16 + c] = (bf16_t)f2bf(cr * bi + ci * br);
            CM16[((size_t)g * 16 + c) * 128 + p] = (bf16_t)f2bf(c_re[(g * 16 + c) * 64 + p]);
            CM16[((size_t)g * 16 + c) * 128 + 64 + p] = (bf16_t)f2bf(-c_im[(g * 16 + c) * 64 + p]);
        }
    }
}
template <int MODE> __device__ __forceinline__ void p_s5_pass(const int wv, const bf16_t* proj16, const float2* abar, const float2* a256, const bf16_t* BB16, const bf16_t* CM16, const float* dskip,
                                                              float2* E, bf16_t* yg16, LAS unsigned char* lds) {
    LTID();
    const int lane = tidx & 63, fr = lane & 15, fq = lane >> 4;
    LAS unsigned char* L = lds + wv * (16 * S5_ROWB);
    for (int unit = bidx * NW + wv; unit < S5_NCH * 32; unit += gridDim.x * NW) {
        const int g = unit & 31, chunk = unit >> 5;
        const float2 a = abar[g * 64 + lane];
        bf16x4 bbf[8];
#pragma unroll
        for (int cb = 0; cb < 8; ++cb) bbf[cb] = *(const bf16x4*)(BB16 + ((size_t)g * 128 + 16 * cb + fr) * 16 + 4 * fq);
        bf16x8 cmf[4]; f32x4 dsk = (f32x4){0.f, 0.f, 0.f, 0.f};
        if (MODE == 1) {
#pragma unroll
            for (int s4 = 0; s4 < 4; ++s4) cmf[s4] = *(const bf16x8*)(CM16 + ((size_t)g * 16 + fr) * 128 + 32 * s4 + 8 * fq);
            dsk = *(const f32x4*)(dskip + g * 16 + 4 * fq);
        }
        float sr = 0.f, si = 0.f;
        if (MODE == 1) {
            const float2 A = a256[g * 64 + lane];
            for (int j0 = 0; j0 < chunk; j0 += 16) {
                float2 e[16];
#pragma unroll
                for (int k = 0; k < 16; ++k) { const int j = (j0 + k < chunk) ? j0 + k : chunk - 1; e[k] = E[((size_t)j * 32 + g) * 64 + lane]; }
#pragma unroll
                for (int k = 0; k < 16; ++k) if (j0 + k < chunk) { const float nr = A.x * sr - A.y * si + e[k].x, ni = A.x * si + A.y * sr + e[k].y; sr = nr; si = ni; }
            }
        }
        const bf16_t* ubase = proj16 + (size_t)(chunk * S5_CHUNK + fr) * DIN + 1536 + g * 16 + 4 * fq;
        bf16x4 uf = *(const bf16x4*)ubase;
#pragma unroll 1
        for (int blk = 0; blk < S5_CHUNK / 16; ++blk) {
            const bf16x4 ufn = *(const bf16x4*)(ubase + (size_t)((blk < S5_CHUNK / 16 - 1) ? (blk + 1) * 16 : blk * 16) * DIN);
            asm volatile("" ::: "memory");
#pragma unroll
            for (int cb = 0; cb < 8; ++cb) {
                const f32x4 d = __builtin_amdgcn_mfma_f32_16x16x16bf16_1k(bbf[cb], uf, (f32x4){0.f, 0.f, 0.f, 0.f}, 0, 0, 0);
                *(LAS f32x4*)(L + fr * S5_ROWB + (16 * cb + 4 * fq) * 4) = d;
            }
            asm volatile("" ::: "memory");
#pragma unroll
            for (int t = 0; t < 16; ++t) {
                const float re = *(const LAS float*)(L + t * S5_ROWB + lane * 4), im = *(const LAS float*)(L + t * S5_ROWB + 256 + lane * 4);
                const float nr = a.x * sr - a.y * si + re, ni = a.x * si + a.y * sr + im; sr = nr; si = ni;
                if (MODE == 1) { *(LAS bf16_t*)(L + t * S5_ROWB + lane * 2) = (bf16_t)f2bf(sr); *(LAS bf16_t*)(L + t * S5_ROWB + 128 + lane * 2) = (bf16_t)f2bf(si); }
            }
            asm volatile("" ::: "memory");
            if (MODE == 1) {
                f32x4 y = (f32x4){0.f, 0.f, 0.f, 0.f};
#pragma unroll
                for (int s4 = 0; s4 < 4; ++s4) { const bf16x8 sf = *(const LAS bf16x8*)(L + fr * S5_ROWB + 64 * s4 + 16 * fq); y = __builtin_amdgcn_mfma_f32_16x16x32_bf16(cmf[s4], sf, y, 0, 0, 0); }
                f32x4 v;
#pragma unroll
                for (int j = 0; j < 4; ++j) v[j] = y[j] + dsk[j] * bf2f((unsigned short)uf[j]);
                const f32x2 g0 = gelu_pk((f32x2){v[0], v[1]}), g1 = gelu_pk((f32x2){v[2], v[3]});
                u32x2 o2; o2.x = cvt_pk_bf16(g0.x, g0.y); o2.y = cvt_pk_bf16(g1.x, g1.y);
                *(u32x2*)(yg16 + (size_t)(chunk * S5_CHUNK + blk * 16 + fr) * 512 + g * 16 + 4 * fq) = o2;
            }
            asm volatile("" ::: "memory");
            uf = ufn;
        }
        if (MODE == 0) E[((size_t)chunk * 32 + g) * 64 + lane] = make_float2(sr, si);
    }
}
struct EpiGlu16 {
    static constexpr bool PERM = true;
    bf16_t* O; const bf16_t* Y; const float* bias;
    __device__ __forceinline__ void operator()(const f32x4 (&acc)[2][2][4][2], const GUnit& u, int wr, int wc, int fr, int fq) const {
        const int row0 = u.pm * BM + wr * 64 + fr, col0 = u.pn * BM + wc * 32 + 8 * fq;
        f32x4 bv[2][2];
#pragma unroll
        for (int bj = 0; bj < 2; ++bj)
#pragma unroll
            for (int n = 0; n < 2; ++n) bv[bj][n] = *(const f32x4*)(bias + col0 + bj * HALF + 4 * n);
#pragma unroll
        for (int ai = 0; ai < 2; ++ai)
#pragma unroll
            for (int m = 0; m < 4; ++m) { const size_t ro = (size_t)(row0 + ai * HALF + m * 16) * 512 + col0;
#pragma unroll
                for (int bj = 0; bj < 2; ++bj) {
                    const u32x4 yv = *(const u32x4*)(Y + ro + bj * HALF);
                    float o[8];
#pragma unroll
                    for (int n = 0; n < 2; ++n)
#pragma unroll
                        for (int j = 0; j < 4; ++j) { const unsigned wd = yv[n * 2 + (j >> 1)]; const float y = __builtin_bit_cast(float, (j & 1) ? (wd & 0xffff0000u) : (wd << 16));
                            o[n * 4 + j] = y / (1.f + __expf(-(acc[ai][bj][m][n][j] + bv[bj][n][j]))); }
                    u32x4 w; w.x = cvt_pk_bf16(o[0], o[1]); w.y = cvt_pk_bf16(o[2], o[3]); w.z = cvt_pk_bf16(o[4], o[5]); w.w = cvt_pk_bf16(o[6], o[7]);
                    *(u32x4*)(O + ro + bj * HALF) = w; } }
    }
};
__device__ __forceinline__ void p_ssm_norm(const int wv, const bf16_t* yb16, const float* g, bf16_t* mix16) {
    LTID();
    const int lane = tidx & 63;
    const f32x4 g0 = *(const f32x4*)(g + lane * 8), g1 = *(const f32x4*)(g + lane * 8 + 4);
    const int rstride = (int)gridDim.x * NW;
    for (int row0 = bidx * NW + wv; row0 < SEQ; row0 += 4 * rstride) {
        u32x4 av[4];
#pragma unroll
        for (int r = 0; r < 4; ++r) { const int row = (row0 + r * rstride < SEQ) ? row0 + r * rstride : row0; av[r] = *(const u32x4*)(yb16 + (size_t)row * 512 + lane * 8); }
#pragma unroll
        for (int r = 0; r < 4; ++r) {
            const int row = row0 + r * rstride;
            float y[8]; float ss = 0.f;
#pragma unroll
            for (int k = 0; k < 4; ++k) { y[2 * k] = __builtin_bit_cast(float, av[r][k] << 16); y[2 * k + 1] = __builtin_bit_cast(float, av[r][k] & 0xffff0000u); ss += y[2 * k] * y[2 * k] + y[2 * k + 1] * y[2 * k + 1]; }
#pragma unroll
            for (int o = 32; o; o >>= 1) ss += shx(ss, o, lane);
            const float sc = rsqrtf(ss * (1.f / 512.f) + 1e-5f);
            u32x4 o4; o4.x = cvt_pk_bf16(y[0] * sc * g0[0], y[1] * sc * g0[1]); o4.y = cvt_pk_bf16(y[2] * sc * g0[2], y[3] * sc * g0[3]);
            o4.z = cvt_pk_bf16(y[4] * sc * g1[0], y[5] * sc * g1[1]); o4.w = cvt_pk_bf16(y[6] * sc * g1[2], y[7] * sc * g1[3]);
            if (row < SEQ) *(u32x4*)(mix16 + (size_t)row * DM + 512 + lane * 8) = o4;
        }
    }
}

__device__ __forceinline__ void p_rmsnorm16(const int wv, const float* in, const float* g, bf16_t* out16, int rows) {
    LTID();
    const int lane = tidx & 63;
    for (int r = bidx * NW + wv; r < rows; r += gridDim.x * NW) {
        f32x4 v[4]; float ss = 0.f;
#pragma unroll
        for (int j = 0; j < 4; ++j) { v[j] = *(const f32x4*)(in + (size_t)r * DM + 4 * lane + 256 * j); ss += (v[j][0] * v[j][0] + v[j][1] * v[j][1]) + (v[j][2] * v[j][2] + v[j][3] * v[j][3]); }
#pragma unroll
        for (int o = 32; o; o >>= 1) ss += shx(ss, o, lane);
        const float sc = rsqrtf(ss * (1.f / 1024.f) + 1e-5f);
#pragma unroll
        for (int j = 0; j < 4; ++j) { const f32x4 gg = *(const f32x4*)(g + 4 * lane + 256 * j); u32x2 o2; o2.x = cvt_pk_bf16(v[j][0] * sc * gg[0], v[j][1] * sc * gg[1]); o2.y = cvt_pk_bf16(v[j][2] * sc * gg[2], v[j][3] * sc * gg[3]);
            *(u32x2*)(out16 + (size_t)r * DM + 4 * lane + 256 * j) = o2; }
    }
}
template <bool MOE, bool LAST> __device__ __forceinline__ void p_rowfinish(const int wv, const float* hin, float* h, const bf16_t* mout, const int* eslot, const float* topg, const float* g, bf16_t* xn16, float* out) {
    LTID();
    const int lane = tidx & 63;
    LAS const int* ts = (LAS const int*)(LDSP + TS_OFF);
    const int rstride = (int)gridDim.x * NW;
    for (int r0 = bidx * NW + wv; r0 < SEQ; r0 += 2 * rstride) {
        int rr[2]; rr[0] = r0; rr[1] = (r0 + rstride < SEQ) ? r0 + rstride : r0;
        f32x4 v[2][4]; int4 es[2]; f32x4 gt[2]; u32x2 mo[2][4][4];
#pragma unroll
        for (int q = 0; q < 2; ++q) { if (MOE) { es[q] = *(const int4*)(eslot + rr[q] * 4); gt[q] = *(const f32x4*)(topg + rr[q] * 4); }
#pragma unroll
            for (int j = 0; j < 4; ++j) v[q][j] = *(const f32x4*)(hin + (size_t)rr[q] * DM + 4 * lane + 256 * j); }
        if (MOE) {
#pragma unroll
            for (int q = 0; q < 2; ++q) { const int esv[4] = {es[q].x, es[q].y, es[q].z, es[q].w};
#pragma unroll
                for (int k = 0; k < 4; ++k) { const int e = esv[k] >> 16, sl = esv[k] & 0xffff; const size_t row = (size_t)ts[e] * BM + sl;
#pragma unroll
                    for (int j = 0; j < 4; ++j) mo[q][k][j] = *(const u32x2*)(mout + row * DM + 4 * lane + 256 * j); } }
#pragma unroll
            for (int q = 0; q < 2; ++q)
#pragma unroll
                for (int k = 0; k < 4; ++k) { const float gk = gt[q][k];
#pragma unroll
                    for (int j = 0; j < 4; ++j) { const u32x2 o = mo[q][k][j];
                        v[q][j][0] += gk * __builtin_bit_cast(float, o.x << 16); v[q][j][1] += gk * __builtin_bit_cast(float, o.x & 0xffff0000u);
                        v[q][j][2] += gk * __builtin_bit_cast(float, o.y << 16); v[q][j][3] += gk * __builtin_bit_cast(float, o.y & 0xffff0000u); } }
        }
#pragma unroll
        for (int q = 0; q < 2; ++q) {
            if (q == 1 && r0 + rstride >= SEQ) break;
            const int r = rr[q];
            float ss = 0.f;
#pragma unroll
            for (int j = 0; j < 4; ++j) ss += (v[q][j][0] * v[q][j][0] + v[q][j][1] * v[q][j][1]) + (v[q][j][2] * v[q][j][2] + v[q][j][3] * v[q][j][3]);
#pragma unroll
            for (int o = 32; o; o >>= 1) ss += shx(ss, o, lane);
            const float sc = rsqrtf(ss * (1.f / 1024.f) + 1e-5f);
#pragma unroll
            for (int j = 0; j < 4; ++j) {
                const f32x4 gg = *(const f32x4*)(g + 4 * lane + 256 * j);
                if (!LAST) { if (h) *(f32x4*)(h + (size_t)r * DM + 4 * lane + 256 * j) = v[q][j];
                    u32x2 o2; o2.x = cvt_pk_bf16(v[q][j][0] * sc * gg[0], v[q][j][1] * sc * gg[1]); o2.y = cvt_pk_bf16(v[q][j][2] * sc * gg[2], v[q][j][3] * sc * gg[3]);
                    *(u32x2*)(xn16 + (size_t)r * DM + 4 * lane + 256 * j) = o2; }
                else *(f32x4*)(out + (size_t)r * DM + 4 * lane + 256 * j) = (f32x4){v[q][j][0] * sc * gg[0], v[q][j][1] * sc * gg[1], v[q][j][2] * sc * gg[2], v[q][j][3] * sc * gg[3]};
            }
        }
    }
}
__device__ __forceinline__ void p_router_tables(const int wv, const float* w_r, const float* g, bf16_t* WR16) {
    LTID();
    for (int i = bidx * NT + tidx; i < 32 * 1024; i += gridDim.x * NT) {
        const int e = i >> 10, k = i & 1023;
        const float w = g[k] * w_r[k * 32 + e];
        const unsigned hi = f2bf(w); const float lo = w - __builtin_bit_cast(float, hi << 16);
        WR16[i] = (bf16_t)hi; WR16[32 * 1024 + i] = (bf16_t)f2bf(lo);
    }
}
constexpr int RT_CNT_OFF = 131072 + 4608;
constexpr int RT_XCH_OFF = 131072 + 5120;
__device__ __forceinline__ void p_router2(const int wv, const float* h, const bf16_t* WR16, const float* b_r, bf16_t* hb16, unsigned* gcnt, int* rowtok_e, float* rsc_e, int* eslot, float* topg, LAS unsigned char* lds) {
    LTID();
    const int lane = tidx & 63, fr = lane & 15, fq = lane >> 4, w = wv, tg = w & 3, kh = w >> 2;
#pragma unroll
    for (int part = 0; part < 2; ++part)
#pragma unroll
        for (int p = 0; p < 8; ++p) { const int row = 4 * p + (tidx >> 7), cs = tidx & 127;
            glds16s(WR16, (unsigned)(part * 65536 + row * 2048 + ((cs ^ (row & 15)) * 16)), (unsigned)(size_t)(lds + part * 65536 + p * 8192 + w * 1024)); }
    LAS int* lcnt = (LAS int*)(lds + RT_CNT_OFF);
    if (tidx < 64) lcnt[tidx] = 0;
    asm volatile("s_waitcnt vmcnt(0)" ::: "memory");
    __syncthreads();
    for (int it = bidx; it < SEQ / 64; it += gridDim.x) {
        const int token = it * 64 + 16 * tg + fr;
        const float* xr = h + (size_t)token * DM + 512 * kh + 8 * fq;
        bf16_t* hb = hb16 + (size_t)token * DM + 512 * kh + 8 * fq;
        f32x4 acc[2]; acc[0] = (f32x4){0.f, 0.f, 0.f, 0.f}; acc[1] = acc[0];
        float ss = 0.f;
#pragma unroll 4
        for (int s4 = 0; s4 < 16; ++s4) {
            const f32x4 x0 = *(const f32x4*)(xr + 32 * s4), x1 = *(const f32x4*)(xr + 32 * s4 + 4);
            ss += (x0[0] * x0[0] + x0[1] * x0[1]) + (x0[2] * x0[2] + x0[3] * x0[3]) + (x1[0] * x1[0] + x1[1] * x1[1]) + (x1[2] * x1[2] + x1[3] * x1[3]);
            u32x4 hw; hw.x = cvt_pk_bf16(x0[0], x0[1]); hw.y = cvt_pk_bf16(x0[2], x0[3]); hw.z = cvt_pk_bf16(x1[0], x1[1]); hw.w = cvt_pk_bf16(x1[2], x1[3]);
            *(u32x4*)(hb + 32 * s4) = hw;
            u32x4 lw;
            lw.x = cvt_pk_bf16(x0[0] - __builtin_bit_cast(float, hw.x << 16), x0[1] - __builtin_bit_cast(float, hw.x & 0xffff0000u));
            lw.y = cvt_pk_bf16(x0[2] - __builtin_bit_cast(float, hw.y << 16), x0[3] - __builtin_bit_cast(float, hw.y & 0xffff0000u));
            lw.z = cvt_pk_bf16(x1[0] - __builtin_bit_cast(float, hw.z << 16), x1[1] - __builtin_bit_cast(float, hw.z & 0xffff0000u));
            lw.w = cvt_pk_bf16(x1[2] - __builtin_bit_cast(float, hw.w << 16), x1[3] - __builtin_bit_cast(float, hw.w & 0xffff0000u));
            const bf16x8 xhi = __builtin_bit_cast(bf16x8, hw), xlo = __builtin_bit_cast(bf16x8, lw);
            const int c = 64 * kh + 4 * s4 + fq, slot = c ^ fr;
#pragma unroll
            for (int nb = 0; nb < 2; ++nb) {
                const bf16x8 whi = *(const LAS bf16x8*)(lds + (16 * nb + fr) * 2048 + slot * 16), wlo = *(const LAS bf16x8*)(lds + 65536 + (16 * nb + fr) * 2048 + slot * 16);
                acc[nb] = __builtin_amdgcn_mfma_f32_16x16x32_bf16(whi, xhi, acc[nb], 0, 0, 0);
                acc[nb] = __builtin_amdgcn_mfma_f32_16x16x32_bf16(whi, xlo, acc[nb], 0, 0, 0);
                acc[nb] = __builtin_amdgcn_mfma_f32_16x16x32_bf16(wlo, xhi, acc[nb], 0, 0, 0);
            }
        }
        ss += shx(ss, 16, lane); ss += shx(ss, 32, lane);
        LAS float* X = (LAS float*)(lds + RT_XCH_OFF) + (tg * 64 + lane) * 9;
        if (kh == 1) {
#pragma unroll
            for (int nb = 0; nb < 2; ++nb)
#pragma unroll
                for (int j = 0; j < 4; ++j) X[nb * 4 + j] = acc[nb][j];
            X[8] = ss;
        }
        __syncthreads();
        int ti[4] = {0, 0, 0, 0}, ls[4] = {0, 0, 0, 0}; float gv[4] = {0.f, 0.f, 0.f, 0.f}; float rs = 0.f;
        if (kh == 0) {
            float lv[8];
            ss += X[8];
            rs = rsqrtf(ss * (1.f / 1024.f) + 1e-5f);
#pragma unroll
            for (int nb = 0; nb < 2; ++nb)
#pragma unroll
                for (int j = 0; j < 4; ++j) lv[nb * 4 + j] = rs * (acc[nb][j] + X[nb * 4 + j]) + b_r[16 * nb + 4 * fq + j];
            float tv[4];
#pragma unroll
            for (int r = 0; r < 4; ++r) {
                float bv = -3.0e38f; int bi = 0;
#pragma unroll
                for (int q = 0; q < 8; ++q) { const int idx = 16 * (q >> 2) + 4 * fq + (q & 3); if (lv[q] > bv) { bv = lv[q]; bi = idx; } }
#pragma unroll
                for (int mk = 16; mk <= 32; mk <<= 1) { const float ov = shx(bv, mk, lane); const int oi = shxi(bi, mk, lane); if (ov > bv || (ov == bv && oi < bi)) { bv = ov; bi = oi; } }
                tv[r] = bv; ti[r] = bi;
#pragma unroll
                for (int q = 0; q < 8; ++q) { const int idx = 16 * (q >> 2) + 4 * fq + (q & 3); if (idx == bi) lv[q] = -3.0e38f; }
            }
            float sum = 0.f;
#pragma unroll
            for (int r = 0; r < 4; ++r) { gv[r] = __expf(tv[r] - tv[0]); sum += gv[r]; }
            const float inv = 1.f / sum;
#pragma unroll
            for (int r = 0; r < 4; ++r) gv[r] *= inv;
            if (fq == 0) {
#pragma unroll
                for (int r = 0; r < 4; ++r) ls[r] = __hip_atomic_fetch_add(&lcnt[ti[r]], 1, __ATOMIC_RELAXED, __HIP_MEMORY_SCOPE_WORKGROUP);
            }
        }
        __syncthreads();
        if (tidx < 32) { const int c = lcnt[tidx]; lcnt[32 + tidx] = c ? (int)__hip_atomic_fetch_add(gcnt + tidx, (unsigned)c, __ATOMIC_RELAXED, __HIP_MEMORY_SCOPE_AGENT) : 0; }
        __syncthreads();
        if (kh == 0 && fq == 0) {
            int es[4];
#pragma unroll
            for (int r = 0; r < 4; ++r) { const int e = ti[r], sl = lcnt[32 + e] + ls[r]; rowtok_e[e * ECAP + sl] = token; rsc_e[e * ECAP + sl] = rs; es[r] = (e << 16) | sl; }
            *(int4*)(eslot + token * 4) = make_int4(es[0], es[1], es[2], es[3]);
            *(f32x4*)(topg + token * 4) = (f32x4){gv[0], gv[1], gv[2], gv[3]};
        }
        __syncthreads();
        if (tidx < 32) lcnt[tidx] = 0;
    }
    __syncthreads();
}

constexpr int NPL = 13;
constexpr int NPHASES = 1 + 2 * NPL;
typedef const __attribute__((address_space(4))) Args* KA;
#define PHASE __device__ __forceinline__
#define KAP() ({ KA _t = a; asm volatile("" : "+s"(_t)); _t; })
#define WSP(T, off) ((T*)(a->ws + (off)))

constexpr int NIT = 49152, NIT1 = 32768;
constexpr int QG = 6, QX = 9, QA = 11, QB = 8;
struct ConvBounds { int A1, A2, B1, B2, B3, B4; };
__device__ __forceinline__ int cmin(int a, int b) { return a < b ? a : b; }
__device__ __forceinline__ ConvBounds conv_bounds(int G, int T0) {
    ConvBounds b;
    const int Pg0 = G > 136 ? G - 136 : G, Px = G > 128 ? G - 128 : G;
    b.A1 = cmin(NIT, Pg0 * 8 * QG); b.A2 = cmin(NIT, b.A1 + Px * 8 * QX);
    const int r1 = (8 * T0) % G, r2 = (4 * T0) % G;
    b.B1 = cmin(NIT, r1 ? (G - r1) * 8 * QA : G * 8 * 2);
    b.B2 = cmin(NIT, b.B1 + (r2 ? (G - r2) * 8 * QB : G * 8 * 2));
    b.B3 = cmin(NIT, b.B2 + Px * 8 * QG); b.B4 = cmin(NIT, b.B3 + Px * 8 * QX);
    return b;
}
__device__ __forceinline__ void conv_moe(KA a, const int wv, int l, int begin, int end, int rank, int nranks) {
    if (begin >= end) return;
    const int wr = rank * NW + wv, ws_ = nranks * NW;
    if (begin < NIT1) p_transpose_r(wv, a->in[26] + (size_t)l * NEXP * DM * 2048, NEXP, DM, 2048, WSP(bf16_t, WS_BT1) + (size_t)l * NEXP * 2048 * DM, a->in[23] + l * DM, NEXP, 1, LDSP, begin, cmin(end, NIT1), wr, ws_);
    if (end > NIT1) { const int b2 = begin > NIT1 ? begin - NIT1 : 0;
        p_transpose_r(wv, a->in[28] + (size_t)l * NEXP * DFF * DM, NEXP, DFF, DM, WSP(bf16_t, WS_BT2) + (size_t)l * NEXP * DM * DFF, nullptr, 1, 0, LDSP, b2, end - NIT1, wr, ws_); }
}
__device__ __forceinline__ int moe_T_lds() { return __builtin_amdgcn_readfirstlane(((LAS const int*)(LDSP + TS_OFF))[32]); }
PHASE void ph_init(KA a, const int wv) {
    p_rowfinish<false, false>(wv, a->in[0], nullptr, nullptr, nullptr, nullptr, a->in[3], WSP(bf16_t, WS_XN16), nullptr);
    p_bias_table(wv, a->in[2], WSP(float, WS_BIASG));
    for (int l = 0; l < 2; ++l) {
        p_s5_tables2(wv, a->in[5] + l * 2048, a->in[6] + l * 2048, a->in[7] + l * 32768, a->in[8] + l * 32768, a->in[9] + l * 32768, a->in[10] + l * 32768, a->in[11] + l * 32,
                     WSP(float2, WS_ABAR) + l * 2048, WSP(float2, WS_A256) + l * 2048, WSP(bf16_t, WS_BB16) + (size_t)l * 32 * 128 * 16, WSP(bf16_t, WS_CM16) + (size_t)l * 32 * 16 * 128);
        p_rmsnorm16(wv, a->in[1], a->in[19] + l * DM, WSP(bf16_t, WS_MEMN16) + (size_t)l * NMEM * DM, NMEM);
        p_router_tables(wv, a->in[24] + (size_t)l * DM * 32, a->in[23] + l * DM, WSP(bf16_t, WS_WR16) + (size_t)l * 2 * 32 * 1024);
    }
    p_transpose(wv, a->in[4], 2, DM, DIN, WSP(bf16_t, WS_WT_IN), nullptr, 1, 0, LDSP);
    p_transpose(wv, a->in[13], 2, 512, 512, WSP(bf16_t, WS_WT_GLU), nullptr, 1, 0, LDSP);
    p_transpose(wv, a->in[17], 2, DM, DM, WSP(bf16_t, WS_WT_OUT), nullptr, 1, 0, LDSP);
    p_transpose(wv, a->in[20], 2, DM, 512, WSP(bf16_t, WS_WT_XQ), a->in[18], 1, 0, LDSP);
    p_transpose(wv, a->in[21], 2, DM, 1024, WSP(bf16_t, WS_WT_XKV), nullptr, 1, 0, LDSP);
    p_transpose(wv, a->in[22], 2, 512, DM, WSP(bf16_t, WS_WT_XO), nullptr, 1, 0, LDSP);
    __syncthreads();
}
PHASE void ph_gemm_in(KA a, const int wv, int l) { LTID();
    DenseOrder S; S.init(WSP(bf16_t, WS_XN16), WSP(bf16_t, WS_WT_IN) + (size_t)l * DIN * DM, SEQ, DIN, DM, gridDim.x, bidx);
    EpiIn E{WSP(bf16_t, WS_PROJ16)};
    gemm_phase<EpiIn, DenseOrder, false, true>(LDSP, DM, S, E, tidx, wv);
}
PHASE void ph_attn_s5a(KA a, const int wv, int l) {
    p_dil_attn(wv, WSP(bf16_t, WS_PROJ16), WSP(float, WS_BIASG), WSP(bf16_t, WS_OBR), WSP(float, WS_LSE), LDSP);
    if (PROBE_DUP == 21) p_dil_attn(wv, WSP(bf16_t, WS_PROJ16), WSP(float, WS_BIASG), WSP(bf16_t, WS_OBR), WSP(float, WS_LSE), LDSP);
    if (PROBE_DUP == 22) { p_s5_pass<0>(wv, WSP(bf16_t, WS_PROJ16), WSP(float2, WS_ABAR) + l * 2048, WSP(float2, WS_A256) + l * 2048, WSP(bf16_t, WS_BB16) + (size_t)l * 32 * 128 * 16, WSP(bf16_t, WS_CM16) + (size_t)l * 32 * 16 * 128,
                 a->in[12] + l * 512, WSP(float2, WS_E2), WSP(bf16_t, WS_YG16), LDSP); __syncthreads(); }
    p_s5_pass<0>(wv, WSP(bf16_t, WS_PROJ16), WSP(float2, WS_ABAR) + l * 2048, WSP(float2, WS_A256) + l * 2048, WSP(bf16_t, WS_BB16) + (size_t)l * 32 * 128 * 16, WSP(bf16_t, WS_CM16) + (size_t)l * 32 * 16 * 128,
                 a->in[12] + l * 512, WSP(float2, WS_E2), WSP(bf16_t, WS_YG16), LDSP);
}
PHASE void ph_s5b(KA a, const int wv, int l) {
    p_s5_pass<1>(wv, WSP(bf16_t, WS_PROJ16), WSP(float2, WS_ABAR) + l * 2048, WSP(float2, WS_A256) + l * 2048, WSP(bf16_t, WS_BB16) + (size_t)l * 32 * 128 * 16, WSP(bf16_t, WS_CM16) + (size_t)l * 32 * 16 * 128,
                 a->in[12] + l * 512, WSP(float2, WS_E2), WSP(bf16_t, WS_YG16), LDSP);
}
PHASE void ph_gemm_glu(KA a, const int wv, int l) {
    {   LTID();
        DenseOrder S; S.init(WSP(bf16_t, WS_YG16), WSP(bf16_t, WS_WT_GLU) + (size_t)l * 512 * 512, SEQ, 512, 512, gridDim.x, bidx);
        EpiGlu16 E{WSP(bf16_t, WS_YB16), WSP(bf16_t, WS_YG16), a->in[14] + l * 512};
        gemm_phase<EpiGlu16, DenseOrder, false, false>(LDSP, 512, S, E, tidx, wv); }
    {   LTID();
    const int cc = (int)gridDim.x - 1 - bidx;
    if (l == 0 && cc < 8) {
        const int kl = cc >> 2;
        DenseOrder S; S.init(WSP(bf16_t, WS_MEMN16) + (size_t)kl * NMEM * DM, WSP(bf16_t, WS_WT_XKV) + (size_t)kl * 1024 * DM, NMEM, 1024, DM, 4, cc & 3);
        EpiBf16 E{WSP(bf16_t, WS_KV16) + (size_t)kl * NMEM * 1024, 1024, 1.f, nullptr};
        gemm_phase<EpiBf16, DenseOrder, false, false>(LDSP, DM, S, E, tidx, wv);
    } }
    {   LTID();
        const int G = (int)gridDim.x;
        int T0 = 0; if (l == 1) { moe_tiles(WSP(unsigned, WS_CTL) + CW_CNT, tidx); T0 = moe_T_lds(); }
        const ConvBounds cb = conv_bounds(G, T0);
        const int skip = (l == 0) ? 8 : 0;
        if (G > 128 + skip) { if (bidx >= 128 && bidx < G - skip) conv_moe(a, wv, l, l == 0 ? 0 : cb.B2, l == 0 ? cb.A1 : cb.B3, bidx - 128, G - 128 - skip); }
        else conv_moe(a, wv, l, l == 0 ? 0 : cb.B2, l == 0 ? cb.A1 : cb.B3, bidx, G);
    }
}
PHASE void ph_mixnorm(KA a, const int wv, int l) {
    p_attn_combine(wv, WSP(bf16_t, WS_OBR), WSP(float, WS_LSE), a->in[15] + l * 512, WSP(bf16_t, WS_MIX16));
    p_ssm_norm(wv, WSP(bf16_t, WS_YB16), a->in[16] + l * 512, WSP(bf16_t, WS_MIX16));
}
PHASE void ph_gemm_out(KA a, const int wv, int l) { LTID();
    DenseOrder S; S.init(WSP(bf16_t, WS_MIX16), WSP(bf16_t, WS_WT_OUT) + (size_t)l * DM * DM, SEQ, DM, DM, gridDim.x, bidx);
    EpiOut E{l == 0 ? a->in[0] : (const float*)WSP(float, WS_H), WSP(float, WS_H), WSP(bf16_t, WS_HB16), WSP(float, WS_SSP)};
    gemm_phase<EpiOut, DenseOrder, false, false>(LDSP, DM, S, E, tidx, wv);
}
PHASE void ph_gemm_xq(KA a, const int wv, int l) {
    {   LTID();
        DenseOrder S; S.init(WSP(bf16_t, WS_HB16), WSP(bf16_t, WS_WT_XQ) + (size_t)l * 512 * DM, SEQ, 512, DM, gridDim.x, bidx);
        EpiBf16 E{WSP(bf16_t, WS_QX16), 512, 0.08838834764831845f, WSP(float, WS_SSP)};
        gemm_phase<EpiBf16, DenseOrder, false, false>(LDSP, DM, S, E, tidx, wv); }
    {   LTID();
        const int G = (int)gridDim.x;
        int T0 = 0; if (l == 1) { moe_tiles(WSP(unsigned, WS_CTL) + CW_CNT, tidx); T0 = moe_T_lds(); }
        const ConvBounds cb = conv_bounds(G, T0);
        if (G > 128) { if (bidx >= 128) conv_moe(a, wv, l, l == 0 ? cb.A1 : cb.B3, l == 0 ? cb.A2 : cb.B4, bidx - 128, G - 128); }
        else conv_moe(a, wv, l, l == 0 ? cb.A1 : cb.B3, l == 0 ? cb.A2 : cb.B4, bidx, G);
    }
}
PHASE void ph_xattn(KA a, const int wv, int l) { p_xattn_mfma(wv, WSP(bf16_t, WS_QX16), WSP(bf16_t, WS_KV16) + (size_t)l * NMEM * 1024, WSP(bf16_t, WS_OX16), LDSP); }
PHASE void ph_gemm_xo(KA a, const int wv, int l) { LTID();
    DenseOrder S; S.init(WSP(bf16_t, WS_OX16), WSP(bf16_t, WS_WT_XO) + (size_t)l * DM * 512, SEQ, DM, 512, gridDim.x, bidx);
    EpiF32 E{WSP(float, WS_H), DM, 1};
    gemm_phase<EpiF32, DenseOrder, false, false>(LDSP, 512, S, E, tidx, wv);
}
PHASE void ph_router(KA a, const int wv, int l) {
    {   LTID();
        const int G = (int)gridDim.x;
        int T0 = 0; if (l == 1) { moe_tiles(WSP(unsigned, WS_CTL) + CW_CNT, tidx); T0 = moe_T_lds(); }
        const ConvBounds cb = conv_bounds(G, T0);
        conv_moe(a, wv, l, l == 0 ? cb.A2 : cb.B4, NIT, bidx, G);
        __syncthreads();
    }
    p_router2(wv, WSP(float, WS_H), WSP(bf16_t, WS_WR16) + (size_t)l * 2 * 32 * 1024, a->in[25] + l * 32, WSP(bf16_t, WS_HB16), WSP(unsigned, WS_CTL) + CW_CNT + l * 32,
              WSP(int, WS_ROWTOK), WSP(float, WS_RSC), WSP(int, WS_ESLOT), WSP(float, WS_TOPG), LDSP);
}
PHASE void ph_moe1(KA a, const int wv, int l) {
    {   LTID();
        moe_tiles(WSP(unsigned, WS_CTL) + CW_CNT + l * 32, tidx);
        MoeOrder<true> S; S.init(WSP(bf16_t, WS_HB16), WSP(bf16_t, WS_BT1) + (size_t)l * NEXP * 2048 * DM, WSP(int, WS_ROWTOK), 2048, DM, (size_t)2048 * DM * 2, gridDim.x, bidx);
        EpiMoe1 E{WSP(bf16_t, WS_ACT), a->in[27] + (size_t)l * NEXP * 2048, WSP(float, WS_RSC)};
        gemm_phase<EpiMoe1, MoeOrder<true>, true, true>(LDSP, DM, S, E, tidx, wv); }
    if (l == 0) { LTID();
        const int G = (int)gridDim.x, T0 = moe_T_lds(), r1 = (8 * T0) % G; const ConvBounds cb = conv_bounds(G, T0);
        if (r1) { if (bidx >= r1) conv_moe(a, wv, 1, 0, cb.B1, bidx - r1, G - r1); } else conv_moe(a, wv, 1, 0, cb.B1, bidx, G);
    }
}
PHASE void ph_moe2(KA a, const int wv, int l) {
    {   LTID();
        moe_tiles(WSP(unsigned, WS_CTL) + CW_CNT + l * 32, tidx);
        MoeOrder<false> S; S.init(WSP(bf16_t, WS_ACT), WSP(bf16_t, WS_BT2) + (size_t)l * NEXP * DM * DFF, nullptr, DM, DFF, (size_t)DM * DFF * 2, gridDim.x, bidx);
        EpiMoe2 E{WSP(bf16_t, WS_MOUT), a->in[29] + (size_t)l * NEXP * DM};
        gemm_phase<EpiMoe2, MoeOrder<false>, false, true>(LDSP, DFF, S, E, tidx, wv); }
    if (l == 0) { LTID();
        const int G = (int)gridDim.x, T0 = moe_T_lds(), r2 = (4 * T0) % G; const ConvBounds cb = conv_bounds(G, T0);
        if (r2) { if (bidx >= r2) conv_moe(a, wv, 1, cb.B1, cb.B2, bidx - r2, G - r2); } else conv_moe(a, wv, 1, cb.B1, cb.B2, bidx, G);
    }
}
PHASE void ph_combine(KA a, const int wv, int l) { LTID();
    moe_tiles(WSP(unsigned, WS_CTL) + CW_CNT + l * 32, tidx);
    if (l == 0) p_rowfinish<true, false>(wv, WSP(float, WS_H), WSP(float, WS_H), WSP(bf16_t, WS_MOUT), WSP(int, WS_ESLOT), WSP(float, WS_TOPG), a->in[3] + DM, WSP(bf16_t, WS_XN16), nullptr);
    else p_rowfinish<true, true>(wv, WSP(float, WS_H), nullptr, WSP(bf16_t, WS_MOUT), WSP(int, WS_ESLOT), WSP(float, WS_TOPG), a->in[30], nullptr, a->out);
}

__global__ void __launch_bounds__(NT, 2) mega(Args args) {
    KA a = (KA)__builtin_amdgcn_kernarg_segment_ptr();
    int wv = __builtin_amdgcn_readfirstlane((int)threadIdx.x >> 6); asm volatile("" : "+s"(wv));
    LAS unsigned char* lds = LDSP;
    volatile LAS unsigned* MISC = (volatile LAS unsigned*)(lds + MISC_OFF);
    unsigned* ctl = (unsigned*)(a->ws + WS_CTL);
    if (threadIdx.x < 32) MISC[threadIdx.x] = 0u;
    __syncthreads();
    XcdBarrier bar; bar.bar = ctl + CW_BAR; bar.x = 0; bar.st = nullptr;
    if (!MK_PER_PHASE) bar = xcd_barrier_post(ctl + CW_BAR, MISC + 8);
    const int lo = a->ph_lo, hi = a->ph_hi;
#define IN(k) (lo <= (k) && (k) < hi)
#define SEAM(k) do { if (IN(k) && IN((k) + 1)) { LTID(); xcd_barrier(bar.bar, bar.x, bar.st, tidx == 0); if (PROBE_DUP == 200) xcd_barrier(bar.bar, bar.x, bar.st, tidx == 0); } } while (0)
    if (IN(0)) { ph_init(KAP(), wv); if (PROBE_DUP == 100) ph_init(KAP(), wv); }
    SEAM(0);
#define LAYER_PROGRAM(l) { const int pb = 1 + (l) * NPL; \
        if (IN(pb + 0)) { ph_gemm_in(KAP(), wv, (l)); if (PROBE_DUP == 0) { ph_gemm_in(KAP(), wv, (l)); } } \
        SEAM(pb + 0); \
        if (IN(pb + 1)) { ph_attn_s5a(KAP(), wv, (l)); if (PROBE_DUP == 1) { ph_attn_s5a(KAP(), wv, (l)); } } \
        SEAM(pb + 1); \
        if (IN(pb + 2)) { ph_s5b(KAP(), wv, (l)); if (PROBE_DUP == 2) { ph_s5b(KAP(), wv, (l)); } } \
        SEAM(pb + 2); \
        if (IN(pb + 3)) { ph_gemm_glu(KAP(), wv, (l)); if (PROBE_DUP == 3) { ph_gemm_glu(KAP(), wv, (l)); } } \
        SEAM(pb + 3); \
        if (IN(pb + 4)) { ph_mixnorm(KAP(), wv, (l)); if (PROBE_DUP == 4) { ph_mixnorm(KAP(), wv, (l)); } } \
        SEAM(pb + 4); \
        if (IN(pb + 5)) { ph_gemm_out(KAP(), wv, (l)); if (PROBE_DUP == 5) { ph_gemm_out(KAP(), wv, (l)); } } \
        SEAM(pb + 5); \
        if (IN(pb + 6)) { ph_gemm_xq(KAP(), wv, (l)); if (PROBE_DUP == 6) { ph_gemm_xq(KAP(), wv, (l)); } } \
        SEAM(pb + 6); \
        if (IN(pb + 7)) { ph_xattn(KAP(), wv, (l)); if (PROBE_DUP == 7) { ph_xattn(KAP(), wv, (l)); } } \
        SEAM(pb + 7); \
        if (IN(pb + 8)) { ph_gemm_xo(KAP(), wv, (l)); if (PROBE_DUP == 8) { ph_gemm_xo(KAP(), wv, (l)); } } \
        SEAM(pb + 8); \
        if (IN(pb + 9)) { ph_router(KAP(), wv, (l)); if (PROBE_DUP == 9) { ph_router(KAP(), wv, (l)); } } \
        SEAM(pb + 9); \
        if (IN(pb + 10)) { ph_moe1(KAP(), wv, (l)); if (PROBE_DUP == 10) { ph_moe1(KAP(), wv, (l)); } } \
        SEAM(pb + 10); \
        if (IN(pb + 11)) { ph_moe2(KAP(), wv, (l)); if (PROBE_DUP == 11) { ph_moe2(KAP(), wv, (l)); } } \
        SEAM(pb + 11); \
        if (IN(pb + 12)) { ph_combine(KAP(), wv, (l)); if (PROBE_DUP == 12) { ph_combine(KAP(), wv, (l)); } } \
        SEAM(pb + 12); }
    LAYER_PROGRAM(0)
    LAYER_PROGRAM(1)
#undef LAYER_PROGRAM
#undef IN
#undef SEAM
}

extern "C" void kernel_launch(void* const* d_in, const int* in_sizes, int n_in, void* d_out, int out_size, void* d_ws, size_t ws_size, hipStream_t stream) {
    static int grid = 0;
    if (grid == 0) {
        if (n_in != 31 || ws_size < WS_END) { fprintf(stderr, "kernel_launch: unexpected n_in %d or ws_size %zu (need %zu)\n", n_in, ws_size, (size_t)WS_END); grid = -1; return; }
        int dev = 0, cus = 0, per_cu = 0;
        if (hipGetDevice(&dev) != hipSuccess || hipDeviceGetAttribute(&cus, hipDeviceAttributeMultiprocessorCount, dev) != hipSuccess) { grid = -1; return; }
        if (hipFuncSetAttribute((const void*)mega, hipFuncAttributeMaxDynamicSharedMemorySize, LDS_BYTES) != hipSuccess) { fprintf(stderr, "kernel_launch: hipFuncSetAttribute failed\n"); grid = -1; return; }
        if (hipOccupancyMaxActiveBlocksPerMultiprocessor(&per_cu, (const void*)mega, NT, LDS_BYTES) != hipSuccess || per_cu < 1)
            fprintf(stderr, "kernel_launch: occupancy query reports %d workgroups per CU\n", per_cu);
        (void)hipGetLastError();
        grid = cus;
    }
    if (grid < 0) return;
    if (hipMemsetAsync((char*)d_ws + WS_CTL, 0, CTL_ZERO_BYTES, stream) != hipSuccess) return;
    Args a{};
    for (int i = 0; i < 31; ++i) a.in[i] = (const float*)d_in[i];
    a.out = (float*)d_out; a.ws = (unsigned char*)d_ws;
#if MK_PER_PHASE
    for (int p = 0; p < NPHASES; ++p) { a.ph_lo = p; a.ph_hi = p + 1; hipLaunchKernelGGL(mega, dim3(grid), dim3(NT), LDS_BYTES, stream, a); }
#else
    a.ph_lo = 0; a.ph_hi = NPHASES;
    hipLaunchKernelGGL(mega, dim3(grid), dim3(NT), LDS_BYTES, stream, a);
#endif
}
```

```cpp
#include <hip/hip_runtime.h>
#include <stdint.h>
#include <cstdio>

#ifndef PROBE_DUP
#define PROBE_DUP -1
#endif
#ifndef MK_PER_PHASE
#define MK_PER_PHASE 0
#endif

#define SEQ 16384
#define DM 1024
#define DIN 2048
#define NMEM 256
#define NEXP 32
#define TOPK 4
#define DFF 1024
#define NT 512
#define NW 8

#define LAS __attribute__((address_space(3)))
typedef float f32x4 __attribute__((ext_vector_type(4)));
typedef float f32x2 __attribute__((ext_vector_type(2)));
extern __shared__ __attribute__((aligned(16))) unsigned char lds_raw[];
#define LDSP ((LAS unsigned char*)lds_raw)
#define LTID() int z_ = 0; asm volatile("" : "+v"(z_)); const int lane_ = (int)__builtin_amdgcn_mbcnt_hi(~0u, __builtin_amdgcn_mbcnt_lo(~0u, (unsigned)z_)); \
    const int tidx = wv * 64 + lane_; int bidx = blockIdx.x; asm volatile("" : "+s"(bidx))
__device__ __forceinline__ float shx(float v, int mask, int lane) { return __builtin_bit_cast(float, __builtin_amdgcn_ds_bpermute((lane ^ mask) << 2, __builtin_bit_cast(int, v))); }
__device__ __forceinline__ int shxi(int v, int mask, int lane) { return __builtin_amdgcn_ds_bpermute((lane ^ mask) << 2, v); }
constexpr int LDS_BYTES = 147456;
constexpr int MISC_OFF = 131072 + 320;

#define XB_TMO      128
#define XB_XCNT(j)  (256  + 64 * (j))
#define XB_XSUB(j)  (1280 + 64 * (j))
#define XB_XGEN(j)  (2304 + 64 * (j))
#define XB_TOP      3328
#define XB_TOPGEN   3392
#define XCD_BAR_WORDS 3456
#define XB_SPIN_CAP (1u << 18)

__device__ __forceinline__ unsigned xb_ld(unsigned* p)              { return __hip_atomic_load(p, __ATOMIC_RELAXED, __HIP_MEMORY_SCOPE_AGENT); }
__device__ __forceinline__ unsigned xb_add(unsigned* p, unsigned v) { return __hip_atomic_fetch_add(p, v, __ATOMIC_RELAXED, __HIP_MEMORY_SCOPE_AGENT); }
__device__ __forceinline__ unsigned xb_xcc_id() { return (unsigned)__builtin_amdgcn_s_getreg((3 << 11) | 20) & 0xFu; }
#define XB_SPIN(cond, bar) do { unsigned _sp = 0; while (cond) { __builtin_amdgcn_s_sleep(1); \
    if ((++_sp & 255u) == 0u) { if (xb_ld(&(bar)[XB_TMO])) break; if (_sp > XB_SPIN_CAP) { atomicAdd(&(bar)[XB_TMO], 1u); break; } } } } while (0)

struct XcdBarrier {
    unsigned* bar; unsigned x;
    volatile LAS unsigned* st;
};
__device__ __forceinline__ XcdBarrier xcd_barrier_post(unsigned* bar, volatile LAS unsigned* st) {
    XcdBarrier b; b.bar = bar; b.x = xb_xcc_id(); b.st = st;
    if (threadIdx.x == 0) (void)xb_add(&bar[XB_XCNT(b.x)], 1u);
    return b;
}
__device__ __forceinline__ void xcd_barrier_complete(unsigned* bar, unsigned x, unsigned& nloc, unsigned& nx) {
    const unsigned G = gridDim.x * gridDim.y * gridDim.z;
    unsigned sum, cnt, mine, sp = 0u;
    for (;;) {
        sum = 0u; cnt = 0u; mine = 0u;
#pragma unroll
        for (unsigned j = 0; j < 16; ++j) { const unsigned c = xb_ld(&bar[XB_XCNT(j)]); sum += c; cnt += (c > 0u) ? 1u : 0u; mine = (j == x) ? c : mine; }
        if (sum == G) break;
        __builtin_amdgcn_s_sleep(1);
        if ((++sp & 255u) == 0u) { if (xb_ld(&bar[XB_TMO])) break; if (sp > XB_SPIN_CAP) { atomicAdd(&bar[XB_TMO], 1u); break; } }
    }
    nloc = mine > 0u ? mine : 1u; nx = cnt > 0u ? cnt : 1u;
}
__device__ __noinline__ void xcd_barrier(unsigned* bar_, unsigned x_, volatile LAS unsigned* st_, int is_t0) {
    XcdBarrier b; b.bar = bar_; b.x = x_; b.st = st_;
    asm volatile("s_waitcnt vmcnt(0)" ::: "memory");
    __syncthreads();
    if (is_t0) {
        unsigned* bar = b.bar;
        __builtin_amdgcn_s_waitcnt(0);
        unsigned nloc = b.st[0], nx = b.st[1];
        if (nloc == 0u) { xcd_barrier_complete(bar, b.x, nloc, nx); b.st[0] = nloc; b.st[1] = nx; }
        const unsigned old = xb_add(&bar[XB_XSUB(b.x)], 1u);
        const unsigned gen = old / nloc;
        if (old + 1u == (gen + 1u) * nloc) {
            __builtin_amdgcn_fence(__ATOMIC_RELEASE, "agent");
            asm volatile("s_waitcnt vmcnt(0)" ::: "memory");
            const unsigned og = xb_add(&bar[XB_TOP], 1u);
            const unsigned tg = og / nx;
            if (og + 1u == (tg + 1u) * nx) xb_add(&bar[XB_TOPGEN], 1u);
            else XB_SPIN(xb_ld(&bar[XB_TOPGEN]) == tg, bar);
            __builtin_amdgcn_fence(__ATOMIC_ACQUIRE, "agent");
            xb_add(&bar[XB_XGEN(b.x)], 1u);
            asm volatile("s_waitcnt vmcnt(0)" ::: "memory");
        } else {
            XB_SPIN(xb_ld(&bar[XB_XGEN(b.x)]) == gen, bar);
            __builtin_amdgcn_fence(__ATOMIC_ACQUIRE, "agent");
            asm volatile("s_waitcnt vmcnt(0)" ::: "memory");
        }
    }
    __syncthreads();
}

constexpr size_t MiB = 1u << 20;
constexpr size_t WS_CTL = 0, CTL_ZERO_BYTES = 1 * MiB;
constexpr int CW_BAR = 4096;
constexpr int CW_CNT = 8192;
constexpr int MOE_ROWS = SEQ * TOPK + NEXP * 256;
constexpr int ECAP = SEQ;
constexpr size_t al256(size_t x) { return (x + 255) & ~(size_t)255; }
constexpr size_t WS_H = 2 * MiB;
constexpr size_t WS_XN16 = WS_H + (size_t)SEQ * DM * 4;
constexpr size_t WS_HB16 = WS_XN16 + (size_t)SEQ * DM * 2;
constexpr size_t WS_PROJ16 = WS_HB16 + (size_t)SEQ * DM * 2;
constexpr size_t WS_OBR = WS_PROJ16 + (size_t)SEQ * 2048 * 2;
constexpr size_t WS_LSE = WS_OBR + 3 * (size_t)SEQ * 512 * 2;
constexpr size_t WS_YG16 = WS_LSE + 3 * (size_t)SEQ * 8 * 4;
constexpr size_t WS_YB16 = WS_YG16 + (size_t)SEQ * 512 * 2;
constexpr size_t WS_MIX16 = WS_YB16 + (size_t)SEQ * 512 * 2;
constexpr size_t WS_QX16 = WS_MIX16 + (size_t)SEQ * DM * 2;
constexpr size_t WS_OX16 = WS_QX16 + (size_t)SEQ * 512 * 2;
constexpr size_t WS_ACT = WS_OX16 + (size_t)SEQ * 512 * 2;
constexpr size_t WS_MOUT = WS_ACT + (size_t)MOE_ROWS * DFF * 2;
constexpr size_t WS_BT1 = WS_MOUT + (size_t)MOE_ROWS * DM * 2;
constexpr size_t WS_BT2 = WS_BT1 + 2 * (size_t)NEXP * 2048 * DM * 2;
constexpr size_t WS_WT_IN = WS_BT2 + 2 * (size_t)NEXP * DM * DFF * 2;
constexpr size_t WS_WT_GLU = WS_WT_IN + 2 * (size_t)2048 * 1024 * 2;
constexpr size_t WS_WT_OUT = WS_WT_GLU + 2 * (size_t)512 * 512 * 2;
constexpr size_t WS_WT_XQ = WS_WT_OUT + 2 * (size_t)1024 * 1024 * 2;
constexpr size_t WS_WT_XKV = WS_WT_XQ + 2 * (size_t)512 * 1024 * 2;
constexpr size_t WS_WT_XO = WS_WT_XKV + 2 * (size_t)1024 * 1024 * 2;
constexpr size_t WS_MEMN16 = WS_WT_XO + 2 * (size_t)1024 * 512 * 2;
constexpr size_t WS_KV16 = WS_MEMN16 + 2 * (size_t)NMEM * 1024 * 2;
constexpr size_t WS_WR16 = WS_KV16 + 2 * (size_t)NMEM * 1024 * 2;
constexpr size_t WS_BIASG = WS_WR16 + 2 * 2 * (size_t)32 * 1024 * 2;
constexpr size_t WS_ABAR = al256(WS_BIASG + 24 * 132 * 4);
constexpr size_t WS_A256 = WS_ABAR + 2 * 2048 * 8;
constexpr size_t WS_BB16 = WS_A256 + 2 * 2048 * 8;
constexpr size_t WS_CM16 = WS_BB16 + 2 * (size_t)32 * 128 * 16 * 2;
constexpr size_t WS_E2 = WS_CM16 + 2 * (size_t)32 * 16 * 128 * 2;
constexpr size_t WS_ROWTOK = WS_E2 + (size_t)64 * 2048 * 8;
constexpr size_t WS_RSC = WS_ROWTOK + (size_t)NEXP * ECAP * 4;
constexpr size_t WS_ESLOT = WS_RSC + (size_t)NEXP * ECAP * 4;
constexpr size_t WS_TOPG = WS_ESLOT + (size_t)SEQ * 4 * 4;
constexpr size_t WS_SSP = WS_TOPG + (size_t)SEQ * 4 * 4;
constexpr size_t WS_END = WS_SSP + (size_t)SEQ * 16 * 4;

struct Args { const float* in[31]; float* out; unsigned char* ws; int ph_lo, ph_hi; };


typedef unsigned short bf16_t;
typedef short bf16x8 __attribute__((ext_vector_type(8)));
typedef unsigned u32x4 __attribute__((ext_vector_type(4)));
typedef unsigned u32x2 __attribute__((ext_vector_type(2)));
constexpr int BM = 256, BK = 64, HALF = 128, HTB = HALF * BK * 2, STAGE_BYTES = 8 * HTB, NXCD = 8, WGM = 8;
__host__ __device__ __forceinline__ int lds_byte(int r, int c) { const int st = (r >> 4) * 2 + (c >> 5), rr = r & 15, cc = c & 31, ob = rr * 64 + cc * 2; return st * 1024 + (ob ^ (((ob >> 9) & 1) << 5)); }
__host__ __device__ __forceinline__ void stage_rc(int b, int& R, int& C) { const int st = b / 1024, sb = b % 1024, swz = sb ^ (((sb >> 9) & 1) << 5); R = (st >> 1) * 16 + swz / 64; C = (st & 1) * 32 + (swz % 64) / 2; }
__host__ __device__ __forceinline__ int perm32(int rho) { const int n = rho >> 4, i = rho & 15; return 8 * (i >> 2) + 4 * n + (i & 3); }
__device__ __forceinline__ unsigned cvt_pk_bf16(float lo, float hi) { unsigned r; asm volatile("v_cvt_pk_bf16_f32 %0, %1, %2" : "=v"(r) : "v"(lo), "v"(hi)); return r; }
__device__ __forceinline__ unsigned f2bf(float f) { unsigned u = __builtin_bit_cast(unsigned, f); return (u + 0x7fffu + ((u >> 16) & 1u)) >> 16; }
__device__ __forceinline__ unsigned pk2(float lo, float hi) { return f2bf(lo) | (f2bf(hi) << 16); }
__device__ __forceinline__ float bf2f(unsigned short b) { return __builtin_bit_cast(float, ((unsigned)b) << 16); }

__device__ __forceinline__ void glds16s(const void* sbase, unsigned voff, unsigned lds_dst) {
    unsigned keep;
    asm volatile("s_mov_b32 %0, m0\n\ts_mov_b32 m0, %3\n\ts_nop 0\n\tglobal_load_lds_dwordx4 %1, %2\n\ts_mov_b32 m0, %0" : "=&s"(keep) : "v"(voff), "s"(sbase), "s"(lds_dst) : "memory");
}
struct GUnit { const char* A; const char* B; int pm, pn, e, row0, cnt; };

struct DenseOrder {
    const char* A; const char* Bt; int nM, nN, nwg, G, c, K;
    __device__ __forceinline__ void init(const bf16_t* A_, const bf16_t* Bt_, int M, int N, int K_, int G_, int c_) { A = (const char*)A_; Bt = (const char*)Bt_; nM = M / BM; nN = N / BM; nwg = nM * nN; G = G_; c = c_; K = K_; }
    __device__ __forceinline__ bool next(int i, GUnit& u) const {
        const long L = (long)i * G + c; if (L >= nwg) return false;
        int wgid = (int)L; { const int q = nwg / NXCD, r = nwg % NXCD, xcd = wgid % NXCD, off = wgid / NXCD; wgid = (xcd < r ? xcd * (q + 1) : r * (q + 1) + (xcd - r) * q) + off; }
        const int nig = WGM * nN, gid = wgid / nig, fm = gid * WGM, gsz = (nM - fm) < WGM ? (nM - fm) : WGM;
        u.pm = fm + ((wgid % nig) % gsz); u.pn = (wgid % nig) / gsz; u.e = 0; u.row0 = 0; u.cnt = 0;
        u.A = A + (size_t)u.pm * BM * K * 2; u.B = Bt + (size_t)u.pn * BM * K * 2; return true;
    }
    __device__ __forceinline__ unsigned aoff(const GUnit&, int row) const { return (unsigned)(row * K * 2); }
    __device__ __forceinline__ unsigned tokoff(const GUnit&, int) const { return 0u; }
    __device__ __forceinline__ const int* tokbase() const { return nullptr; }
};

struct EpiF32 {
    static constexpr bool PERM = false;
    float* C; int ldc; int resid;
    __device__ __forceinline__ void operator()(const f32x4 (&acc)[2][2][4][2], const GUnit& u, int wr, int wc, int fr, int fq) const {
        const int row0 = u.pm * BM + wr * 64 + fr, col0 = u.pn * BM + wc * 32 + 4 * fq;
#pragma unroll
        for (int ai = 0; ai < 2; ++ai)
#pragma unroll
            for (int m = 0; m < 4; ++m) { float* rowp = C + (size_t)(row0 + ai * HALF + m * 16) * ldc + col0;
#pragma unroll
                for (int bj = 0; bj < 2; ++bj)
#pragma unroll
                    for (int n = 0; n < 2; ++n) { f32x4 v = acc[ai][bj][m][n]; if (resid) v += *(const f32x4*)(rowp + bj * HALF + n * 16); *(f32x4*)(rowp + bj * HALF + n * 16) = v; } }
    }
};
struct EpiGlu {
    static constexpr bool PERM = false;
    float* C; const float* Y; int ldc; const float* bias;
    __device__ __forceinline__ void operator()(const f32x4 (&acc)[2][2][4][2], const GUnit& u, int wr, int wc, int fr, int fq) const {
        const int row0 = u.pm * BM + wr * 64 + fr, col0 = u.pn * BM + wc * 32 + 4 * fq;
#pragma unroll
        for (int ai = 0; ai < 2; ++ai)
#pragma unroll
            for (int m = 0; m < 4; ++m) { const size_t ro = (size_t)(row0 + ai * HALF + m * 16) * ldc + col0;
#pragma unroll
                for (int bj = 0; bj < 2; ++bj)
#pragma unroll
                    for (int n = 0; n < 2; ++n) { const f32x4 b = *(const f32x4*)(bias + col0 + bj * HALF + n * 16); const f32x4 y = *(const f32x4*)(Y + ro + bj * HALF + n * 16);
                        f32x4 v = acc[ai][bj][m][n] + b; f32x4 o;
#pragma unroll
                        for (int j = 0; j < 4; ++j) o[j] = y[j] / (1.f + __expf(-v[j]));
                        *(f32x4*)(C + ro + bj * HALF + n * 16) = o; } }
    }
};

template <class Epi, class Sched, bool GATHER, bool ALIGN_EPI>
__device__ __forceinline__ void gemm_phase(LAS unsigned char* lds, const int K, const Sched& S, const Epi& E, const int tid, const int wv) {
    const int wid = wv, lane = tid & 63, wr = wid >> 2, wc = wid & 3, fr = lane & 15, fq = lane >> 4;
    const int nt = K / BK;
    unsigned voffB[2];
#pragma unroll
    for (int i = 0; i < 2; ++i) { int R, C; stage_rc(tid * 16 + i * 8192, R, C); const int Rb = Epi::PERM ? ((R & ~31) + perm32(R & 31)) : R; voffB[i] = (unsigned)(Rb * K + C) * 2u; }
#define PG8_AOFFS(dst, u) do { int t2_ = tid; asm volatile("" : "+v"(t2_)); _Pragma("unroll") for (int i = 0; i < 2; ++i) { int R, C; stage_rc(t2_ * 16 + i * 8192, R, C); \
        _Pragma("unroll") for (int h = 0; h < 2; ++h) dst[h][i] = S.aoff(u, h * HALF + R) + (unsigned)C * 2u; } } while (0)
    const size_t kstep = (size_t)(BK * 2);
    const size_t hstep = (size_t)HALF * K * 2;
    const unsigned ldsw = (unsigned)wid * 1024u;
    const int aoff = lds_byte(wr * 64 + fr, fq * 8), boff = lds_byte(wc * 32 + fr, fq * 8);
#define PG8_SA(b, h) (((b) * 2 + (h)) * HTB)
#define PG8_SB(b, h) ((4 + (b) * 2 + (h)) * HTB)
#define PG8_STAGE(bufoff, gbase, v0, v1) do { const unsigned ld_ = (unsigned)(size_t)(lds + (bufoff) + ldsw); glds16s((gbase), (v0), ld_); glds16s((gbase), (v1), ld_ + 8192u); } while (0)
#define PG8_LDA(dst, b, h) do { _Pragma("unroll") for (int m = 0; m < 4; ++m) _Pragma("unroll") for (int k = 0; k < 2; ++k) dst[m][k] = *(const LAS bf16x8*)(lds + PG8_SA(b, h) + aoff + m * 2048 + k * 1024); } while (0)
#define PG8_LDB(dst, b, h) do { _Pragma("unroll") for (int n = 0; n < 2; ++n) _Pragma("unroll") for (int k = 0; k < 2; ++k) dst[n][k] = *(const LAS bf16x8*)(lds + PG8_SB(b, h) + boff + n * 2048 + k * 1024); } while (0)
#define PG8_MMA(ai, bj, At, Bt) do { __builtin_amdgcn_s_setprio(1); _Pragma("unroll") for (int m = 0; m < 4; ++m) _Pragma("unroll") for (int n = 0; n < 2; ++n) _Pragma("unroll") for (int k = 0; k < 2; ++k) \
        acc[ai][bj][m][n] = __builtin_amdgcn_mfma_f32_16x16x32_bf16(Bt[n][k], At[m][k], acc[ai][bj][m][n], 0, 0, 0); __builtin_amdgcn_s_setprio(0); } while (0)
#define PG8_WAIT_V(n) asm volatile("s_waitcnt vmcnt(" #n ")" ::: "memory")
#define PG8_WAIT_L(n) asm volatile("s_waitcnt lgkmcnt(" #n ")" ::: "memory")
#define PG8_BAR __builtin_amdgcn_s_barrier()
#define PG8_SCHED __builtin_amdgcn_sched_barrier(0)
    GUnit cur, nxt; int ui = 0;
    if (!S.next(0, cur)) return;
    f32x4 acc[2][2][4][2];
#pragma unroll
    for (int a = 0; a < 2; ++a)
#pragma unroll
        for (int b = 0; b < 2; ++b)
#pragma unroll
            for (int m = 0; m < 4; ++m)
#pragma unroll
                for (int n = 0; n < 2; ++n) acc[a][b][m][n] = (f32x4){0.f, 0.f, 0.f, 0.f};
    bf16x8 At[4][2], B0[2][2], B1[2][2];
    unsigned vA[2][2], vN[2][2];
    PG8_AOFFS(vA, cur);
#pragma unroll
    for (int h = 0; h < 2; ++h)
#pragma unroll
        for (int i = 0; i < 2; ++i) vN[h][i] = vA[h][i];
    const char* cA = cur.A; const char* cB = cur.B;
    PG8_STAGE(PG8_SB(0, 0), cB, voffB[0], voffB[1]); PG8_STAGE(PG8_SB(0, 1), cB + hstep, voffB[0], voffB[1]); PG8_STAGE(PG8_SA(0, 0), cA, vA[0][0], vA[0][1]); PG8_STAGE(PG8_SA(0, 1), cA, vA[1][0], vA[1][1]);
    if (wr == 1) PG8_BAR;
    PG8_WAIT_V(2); PG8_BAR;
    PG8_STAGE(PG8_SB(1, 0), cB + kstep, voffB[0], voffB[1]); PG8_STAGE(PG8_SA(1, 0), cA + kstep, vA[0][0], vA[0][1]); PG8_STAGE(PG8_SB(1, 1), cB + hstep + kstep, voffB[0], voffB[1]);
    PG8_WAIT_V(6); PG8_BAR;
    for (;;) {
        const bool has_next = S.next(ui + 1, nxt);
        const char* nA = GATHER ? cA : (has_next ? nxt.A : cA); const char* nB = has_next ? nxt.B : cB;
        unsigned tok_[2][2] = {{0u, 0u}, {0u, 0u}};
#define PG8_KBODY(a1, a2, b2, a3, b3, W00, W01, W10, W11) do { \
              \
            PG8_LDB(B0, 0, 0); PG8_LDB(B1, 0, 1); PG8_SCHED; PG8_LDA(At, 0, 0); PG8_STAGE(PG8_SA(1, 1), a1, vA[1][0], vA[1][1]); \
            PG8_WAIT_V(8); PG8_WAIT_L(0); PG8_BAR; PG8_MMA(0, 0, At, B0); PG8_MMA(0, 1, At, B1); PG8_BAR; PG8_SCHED; \
              \
            PG8_LDA(At, 0, 1); PG8_STAGE(PG8_SB(0, 0), b2, voffB[0], voffB[1]); PG8_STAGE(PG8_SB(0, 1), (b2) + hstep, voffB[0], voffB[1]); PG8_STAGE(PG8_SA(0, 0), a2, W00, W01); \
            PG8_WAIT_V(8); PG8_WAIT_L(0); PG8_BAR; PG8_MMA(1, 0, At, B0); PG8_MMA(1, 1, At, B1); PG8_BAR; PG8_SCHED; \
              \
            PG8_LDB(B0, 1, 0); PG8_LDB(B1, 1, 1); PG8_SCHED; PG8_LDA(At, 1, 0); PG8_STAGE(PG8_SA(0, 1), a2, W10, W11); \
            PG8_WAIT_V(8); PG8_WAIT_L(0); PG8_BAR; PG8_MMA(0, 0, At, B0); PG8_MMA(0, 1, At, B1); PG8_BAR; PG8_SCHED; \
              \
            PG8_LDA(At, 1, 1); PG8_STAGE(PG8_SB(1, 0), b3, voffB[0], voffB[1]); PG8_STAGE(PG8_SB(1, 1), (b3) + hstep, voffB[0], voffB[1]); PG8_STAGE(PG8_SA(1, 0), a3, W00, W01); \
            PG8_WAIT_V(8); PG8_WAIT_L(0); PG8_BAR; PG8_MMA(1, 0, At, B0); PG8_MMA(1, 1, At, B1); PG8_BAR; PG8_SCHED; } while (0)
        for (int t = 0; t < nt - 2; t += 2) {
            const char* a1 = cA + (size_t)(t + 1) * kstep;
            const char* a2 = cA + (size_t)(t + 2) * kstep; const char* b2 = cB + (size_t)(t + 2) * kstep;
            const char* a3 = a2 + kstep; const char* b3 = b2 + kstep;
            if (GATHER) { if (t == nt - 4 && has_next) { int t2_ = tid; asm volatile("" : "+v"(t2_));
#pragma unroll
                for (int i = 0; i < 2; ++i) { int R, C; stage_rc(t2_ * 16 + i * 8192, R, C);
#pragma unroll
                    for (int h = 0; h < 2; ++h) { const unsigned vo = S.tokoff(nxt, h * HALF + R); asm volatile("global_load_dword %0, %1, %2" : "=v"(tok_[h][i]) : "v"(vo), "s"(S.tokbase()) : "memory"); } } } }
            PG8_KBODY(a1, a2, b2, a3, b3, vA[0][0], vA[0][1], vA[1][0], vA[1][1]);
        }
        if (GATHER) {
            if (has_next) { int t2_ = tid; asm volatile("" : "+v"(t2_), "+v"(tok_[0][0]), "+v"(tok_[0][1]), "+v"(tok_[1][0]), "+v"(tok_[1][1]));
#pragma unroll
                for (int i = 0; i < 2; ++i) { int R, C; stage_rc(t2_ * 16 + i * 8192, R, C);
#pragma unroll
                    for (int h = 0; h < 2; ++h) vN[h][i] = tok_[h][i] * (unsigned)(K * 2) + (unsigned)C * 2u; } }
            else {
#pragma unroll
                for (int h = 0; h < 2; ++h)
#pragma unroll
                    for (int i = 0; i < 2; ++i) vN[h][i] = vA[h][i];
            }
        }
        {
            const char* a1 = cA + (size_t)(nt - 1) * kstep;
            const char* a3 = nA + kstep; const char* b3 = nB + kstep;
            PG8_KBODY(a1, nA, nB, a3, b3, vN[0][0], vN[0][1], vN[1][0], vN[1][1]);
        }
#undef PG8_KBODY
        if constexpr (ALIGN_EPI) { if (wr == 0) PG8_BAR; }
        { int t3_ = tid; asm volatile("" : "+v"(t3_)); const int l3_ = t3_ & 63; E(acc, cur, wr, wc, l3_ & 15, l3_ >> 4); }
        if (!has_next) break;
#pragma unroll
        for (int a = 0; a < 2; ++a)
#pragma unroll
            for (int b = 0; b < 2; ++b)
#pragma unroll
                for (int m = 0; m < 4; ++m)
#pragma unroll
                    for (int n = 0; n < 2; ++n) acc[a][b][m][n] = (f32x4){0.f, 0.f, 0.f, 0.f};
        cur = nxt; cA = nA; cB = nB; ++ui;
        if (GATHER) {
#pragma unroll
            for (int h = 0; h < 2; ++h)
#pragma unroll
                for (int i = 0; i < 2; ++i) vA[h][i] = vN[h][i];
        }
        if constexpr (ALIGN_EPI) { if (wr == 1) PG8_BAR; }
    }
    PG8_WAIT_V(0);
    if constexpr (!ALIGN_EPI) { if (wr == 0) PG8_BAR; }
    PG8_BAR;
#undef PG8_AOFFS
#undef PG8_SA
#undef PG8_SB
#undef PG8_STAGE
#undef PG8_LDA
#undef PG8_LDB
#undef PG8_MMA
#undef PG8_WAIT_V
#undef PG8_WAIT_L
#undef PG8_BAR
#undef PG8_SCHED
}


constexpr int TS_OFF = 131072 + 1024;
template <bool GATHER> struct MoeOrder {
    const char* A; const char* Bt; const int* rowtok; int nN, nwg, nM, G, c, K; size_t strideE;
    __device__ __forceinline__ void init(const bf16_t* A_, const bf16_t* Bt_, const int* rowtok_, int N, int K_, size_t strideE_, int G_, int c_) {
        A = (const char*)A_; Bt = (const char*)Bt_; rowtok = rowtok_; nN = N / BM; K = K_; strideE = strideE_; G = G_; c = c_;
        nM = __builtin_amdgcn_readfirstlane(((LAS const int*)(LDSP + TS_OFF))[32]); nwg = nM * nN; }
    __device__ __forceinline__ bool next(int i, GUnit& u) const {
        const long L = (long)i * G + c; if (L >= nwg) return false;
        int wgid = (int)L; { const int q = nwg / NXCD, r = nwg % NXCD, xcd = wgid % NXCD, off = wgid / NXCD; wgid = (xcd < r ? xcd * (q + 1) : r * (q + 1) + (xcd - r) * q) + off; }
        const int nig = WGM * nN, gid = wgid / nig, fm = gid * WGM, gsz = (nM - fm) < WGM ? (nM - fm) : WGM;
        u.pm = fm + ((wgid % nig) % gsz); u.pn = (wgid % nig) / gsz;
        LAS const int* ts = (LAS const int*)(LDSP + TS_OFF);
        const int e = __builtin_amdgcn_readfirstlane(ts[72 + u.pm]);
        u.e = e; u.row0 = (u.pm - __builtin_amdgcn_readfirstlane(ts[e])) * BM; u.cnt = __builtin_amdgcn_readfirstlane(ts[33 + e]);
        u.A = GATHER ? A : A + (size_t)u.pm * BM * K * 2;
        u.B = Bt + (size_t)e * strideE + (size_t)u.pn * BM * K * 2; return true;
    }
    __device__ __forceinline__ unsigned aoff(const GUnit& u, int row) const {
        if (GATHER) { int sl = u.row0 + row; sl = sl < u.cnt ? sl : u.cnt - 1; return (unsigned)rowtok[u.e * ECAP + sl] * (unsigned)(K * 2); }
        return (unsigned)(row * K * 2);
    }
    __device__ __forceinline__ unsigned tokoff(const GUnit& u, int row) const { int sl = u.row0 + row; sl = sl < u.cnt ? sl : u.cnt - 1; return (unsigned)(u.e * ECAP + sl) * 4u; }
    __device__ __forceinline__ const int* tokbase() const { return rowtok; }
};
__device__ __forceinline__ void moe_tiles(const unsigned* cnt, int tid) {
    LAS int* ts = (LAS int*)(LDSP + TS_OFF);
    if (tid == 0) { int s = 0; for (int e = 0; e < NEXP; ++e) { const int c = (int)cnt[e]; ts[e] = s; ts[33 + e] = c; const int n = (c + BM - 1) / BM;
_Pragma("clang loop vectorize(disable) unroll(disable)") for (int t = 0; t < n; ++t) ts[72 + s + t] = e;
            s += n; } ts[NEXP] = s; }
    __syncthreads();
}
struct EpiMoe1 {
    static constexpr bool PERM = true;
    bf16_t* O; const float* b1; const float* rsc;
    __device__ __forceinline__ void operator()(const f32x4 (&acc)[2][2][4][2], const GUnit& u, int wr, int wc, int fr, int fq) const {
        const int rt0 = wr * 64 + fr, col0 = u.pn * 128 + wc * 32 + 8 * fq;
        const float* bg = b1 + (size_t)u.e * 2048 + col0;
        f32x4 bgv[2], blv[2];
#pragma unroll
        for (int n = 0; n < 2; ++n) { bgv[n] = *(const f32x4*)(bg + 4 * n); blv[n] = *(const f32x4*)(bg + DFF + 4 * n); }
#pragma unroll
        for (int ai = 0; ai < 2; ++ai)
#pragma unroll
            for (int m = 0; m < 4; ++m) {
                const int rt = rt0 + ai * HALF + m * 16; int sl = u.row0 + rt; sl = sl < u.cnt ? sl : u.cnt - 1;
                const float r = rsc[u.e * ECAP + sl];
                float o[8];
                const f32x2 r2 = (f32x2){r, r};
#pragma unroll
                for (int n = 0; n < 2; ++n)
#pragma unroll
                    for (int jp = 0; jp < 2; ++jp) {
                        const f32x2 ag = (f32x2){acc[ai][0][m][n][2 * jp], acc[ai][0][m][n][2 * jp + 1]}, al = (f32x2){acc[ai][1][m][n][2 * jp], acc[ai][1][m][n][2 * jp + 1]};
                        f32x2 g = ag * r2 + (f32x2){bgv[n][2 * jp], bgv[n][2 * jp + 1]}, l = al * r2 + (f32x2){blv[n][2 * jp], blv[n][2 * jp + 1]};
                        g.x = fminf(g.x, 7.f); g.y = fminf(g.y, 7.f);
                        l.x = __builtin_amdgcn_fmed3f(l.x, -7.f, 7.f); l.y = __builtin_amdgcn_fmed3f(l.y, -7.f, 7.f);
                        const f32x2 z = g * (-2.4554669595930157f);
                        f32x2 e; e.x = __builtin_amdgcn_exp2f(z.x); e.y = __builtin_amdgcn_exp2f(z.y);
                        e = e + 1.0f;
                        f32x2 q; q.x = __builtin_amdgcn_rcpf(e.x); q.y = __builtin_amdgcn_rcpf(e.y);
                        const f32x2 v = (g * q) * (l + 1.0f);
                        o[n * 4 + 2 * jp] = v.x; o[n * 4 + 2 * jp + 1] = v.y;
                    }
                u32x4 w; w.x = cvt_pk_bf16(o[0], o[1]); w.y = cvt_pk_bf16(o[2], o[3]); w.z = cvt_pk_bf16(o[4], o[5]); w.w = cvt_pk_bf16(o[6], o[7]);
                *(u32x4*)(O + (size_t)(u.pm * BM + rt) * DFF + col0) = w;
            }
    }
};
struct EpiMoe2 {
    static constexpr bool PERM = true;
    bf16_t* O; const float* b2;
    __device__ __forceinline__ void operator()(const f32x4 (&acc)[2][2][4][2], const GUnit& u, int wr, int wc, int fr, int fq) const {
        const int row0 = u.pm * BM + wr * 64 + fr, col0 = u.pn * BM + wc * 32 + 8 * fq;
        f32x4 bv[2][2];
#pragma unroll
        for (int bj = 0; bj < 2; ++bj)
#pragma unroll
            for (int n = 0; n < 2; ++n) bv[bj][n] = *(const f32x4*)(b2 + (size_t)u.e * DM + col0 + bj * HALF + 4 * n);
#pragma unroll
        for (int ai = 0; ai < 2; ++ai)
#pragma unroll
            for (int m = 0; m < 4; ++m) { bf16_t* rowp = O + (size_t)(row0 + ai * HALF + m * 16) * DM + col0;
#pragma unroll
                for (int bj = 0; bj < 2; ++bj) { const f32x4 v0 = acc[ai][bj][m][0] + bv[bj][0], v1 = acc[ai][bj][m][1] + bv[bj][1];
                    u32x4 w; w.x = cvt_pk_bf16(v0[0], v0[1]); w.y = cvt_pk_bf16(v0[2], v0[3]); w.z = cvt_pk_bf16(v1[0], v1[1]); w.w = cvt_pk_bf16(v1[2], v1[3]);
                    *(u32x4*)(rowp + bj * HALF) = w; } }
    }
};

__device__ __forceinline__ void p_transpose_r(const int wv, const float* W, int nmat, int K, int N, bf16_t* WT, const float* kgain, int gdiv, int mode, LAS unsigned char* lds, int it_begin, int it_end, int wrank, int wstride) {
    LTID();
    const int wave = wv, lane = tidx & 63;
    LAS float* scr = (LAS float*)(lds + wave * 16384);
    const int nblk = N / 32, per_mat = (K / 64) * nblk, total = it_end, stride = wstride;
    const int lrow = lane >> 5, lcol = lane & 31;
#define TR_DECODE(item, mat_, kb_, nb_) const int mat_ = (item) / per_mat, r_ = (item) - mat_ * per_mat, g8_ = r_ >> 3, l8_ = r_ & 7, kb_ = 2 * (g8_ / (nblk >> 2)) + (l8_ & 1), nb_ = 4 * (g8_ % (nblk >> 2)) + (l8_ >> 1)
#define TR_ISSUE(item, dst) do { TR_DECODE(item, mat_, kb_, nb_); \
        const float* src_ = W + (size_t)mat_ * K * N + (size_t)(64 * kb_ + lrow) * N + 32 * nb_ + lcol; \
        _Pragma("unroll") for (int i = 0; i < 32; ++i) dst[i] = __builtin_nontemporal_load(src_ + (size_t)(2 * i) * N); } while (0)
    float v[32], vn[32], vnn[32];
    int it = it_begin + wrank;
    if (it < total) TR_ISSUE(it, v);
    if (it + stride < total) TR_ISSUE(it + stride, vn);
    while (it < total) {
        const int itn = it + stride, itnn = itn + stride;
        if (itnn < total) TR_ISSUE(itnn, vnn);
        TR_DECODE(it, mat, kb, nb); const int k0 = 64 * kb, n0 = 32 * nb;
#pragma unroll
        for (int i = 0; i < 32; ++i) scr[(2 * i + lrow) * 33 + lcol] = v[i];
        asm volatile("s_waitcnt lgkmcnt(0)" ::: "memory");
        int d0 = n0;
        if (mode == 1) { const int bj = n0 >> 10, rest = n0 & 1023, pn = rest >> 7, j = rest & 127; d0 = pn * 256 + bj * 128 + j; }
        const int c = lane & 7;
        f32x4 g0 = (f32x4){1.f, 1.f, 1.f, 1.f}, g1 = g0;
        if (kgain) { const float* gp = kgain + (size_t)(mat / gdiv) * DM + k0 + 8 * c; g0 = *(const f32x4*)gp; g1 = *(const f32x4*)(gp + 4); }
        bf16_t* dst = WT + (size_t)mat * K * N;
#pragma unroll
        for (int j = 0; j < 4; ++j) { const int n = (lane >> 3) + 8 * j; const LAS float* sp = scr + (8 * c) * 33 + n;
            u32x4 o; o.x = cvt_pk_bf16(sp[0 * 33] * g0[0], sp[1 * 33] * g0[1]); o.y = cvt_pk_bf16(sp[2 * 33] * g0[2], sp[3 * 33] * g0[3]); o.z = cvt_pk_bf16(sp[4 * 33] * g1[0], sp[5 * 33] * g1[1]); o.w = cvt_pk_bf16(sp[6 * 33] * g1[2], sp[7 * 33] * g1[3]);
            __builtin_nontemporal_store(o, (u32x4*)(dst + (size_t)(d0 + n) * K + k0 + 8 * c)); }
        asm volatile("s_waitcnt lgkmcnt(0)" ::: "memory");
#pragma unroll
        for (int i = 0; i < 32; ++i) { v[i] = vn[i]; vn[i] = vnn[i]; }
        it = itn;
    }
#undef TR_ISSUE
#undef TR_DECODE
}
__device__ __forceinline__ void p_transpose(const int wv, const float* W, int nmat, int K, int N, bf16_t* WT, const float* kgain, int gdiv, int mode, LAS unsigned char* lds) {
    p_transpose_r(wv, W, nmat, K, N, WT, kgain, gdiv, mode, lds, 0, nmat * (K / 64) * (N / 32), (int)blockIdx.x * NW + wv, (int)gridDim.x * NW);
}
typedef short v4i16_t __attribute__((ext_vector_type(4)));
constexpr int ATT_TAB_OFF = 131072 + 2048;
constexpr int ATT_UNITS = 3 * 8 * 128;
__device__ __forceinline__ int t5_bucket_dev(int n) {
    if (n < 16) return n;
    const float v = logf((float)n / 16.f) / 4.852030263919617f * 16.f;
    const int large = 16 + (int)v;
    return large < 31 ? large : 31;
}
__device__ __forceinline__ void p_bias_table(const int wv, const float* rel_bias, float* biasG) {
    LTID();
    for (int i = bidx * NT + tidx; i < 3 * 8 * 132; i += gridDim.x * NT) {
        const int d = i % 132, bh = i / 132, h = bh & 7, b = bh >> 3;
        biasG[i] = (d <= 128) ? rel_bias[t5_bucket_dev(d << (2 * b)) * 8 + h] * 1.4426950408889634f : 0.f;
    }
}
__device__ __forceinline__ void p_dil_attn(const int wv, const bf16_t* proj16, const float* biasG, bf16_t* obr, float* lse, LAS unsigned char* lds) {
    LTID();
    const int lane = tidx & 63, fr = lane & 15, fq = lane >> 4, w = wv;
    const int per = (ATT_UNITS + (int)gridDim.x - 1) / (int)gridDim.x;
    const int u0 = bidx * per, u1 = (u0 + per < ATT_UNITS) ? u0 + per : ATT_UNITS;
    if (u0 >= u1) return;
    const int rowl = tidx >> 3, cs = tidx & 7;
    const unsigned cK = (unsigned)(cs ^ ((rowl >> 1) & 7)) * 16u, cV = (unsigned)(cs ^ (rowl & 7)) * 16u;
    const unsigned fK = (unsigned)((fr >> 1) & 7);
    const unsigned kro0 = (unsigned)fr * 128u + (((unsigned)fq ^ fK) * 16u), kro1 = (unsigned)fr * 128u + ((((unsigned)fq ^ fK) ^ 4u) * 16u);
    const int tq = (lane & 15) >> 2, tp = lane & 3, fv = 4 * (fq & 1) + tq;
    unsigned vro[4];
#pragma unroll
    for (int db = 0; db < 4; ++db) vro[db] = (unsigned)(4 * fq + tq) * 128u + (unsigned)(((2 * db + (tp >> 1)) ^ fv) * 16) + 8u * (unsigned)(tp & 1);
    const int ts_ = (1 + fr) & 3;
    const unsigned tab8 = (unsigned)ATT_TAB_OFF + (unsigned)ts_ * 640u + (unsigned)(((141 + fr - ts_) >> 2) - fq - 32) * 16u;
    const char* gbase = (const char*)proj16;
#define ATT_DECODE(u, b_, h_, r_, n_, dil_) const int cmb_ = (u) >> 7, b_ = cmb_ >> 3, h_ = cmb_ & 7, dil_ = 1 << (2 * b_), idx_ = (u) & 127, r_ = idx_ & (dil_ - 1), n_ = idx_ >> (2 * b_)
#define ATT_ISSUE(u, bf, q0, q1) do { ATT_DECODE(u, b__, h__, r__, n__, dil__); \
        const int nk = n__ > 0 ? n__ - 1 : 0;                                     \
        _Pragma("unroll") for (int p = 0; p < 4; ++p) { \
            int row = 64 * p + rowl; int blk = (row >> 7) ? n__ : nk; \
            const unsigned pos = (unsigned)(r__ + dil__ * (128 * blk + (row & 127))); \
            const unsigned so = pos * 4096u + (unsigned)h__ * 128u; const unsigned ld_ = (unsigned)(size_t)(lds + (bf) * 65536 + p * 8192 + w * 1024); \
            glds16s(gbase, so + 1024u + cK, ld_); glds16s(gbase, so + 2048u + cV, ld_ + 32768u); } \
        const unsigned qpos = (unsigned)(r__ + dil__ * (128 * n__ + 16 * w + fr)); \
        const char* qsrc = gbase + (size_t)qpos * 4096u + (unsigned)h__ * 128u + (unsigned)fq * 16u; \
        q0 = *(const bf16x8*)(qsrc); q1 = *(const bf16x8*)(qsrc + 64); } while (0)
    bf16x8 qf0, qf1, qn0, qn1;
    ATT_ISSUE(u0, 0, qn0, qn1);
    int prev_cmb = -1;
    for (int u = u0; u < u1; ++u) {
        const int bf = (u - u0) & 1;
        asm volatile("s_waitcnt vmcnt(0)" ::: "memory");
        __syncthreads();
        qf0 = qn0; qf1 = qn1;
        if (u + 1 < u1) ATT_ISSUE(u + 1, bf ^ 1, qn0, qn1);
        ATT_DECODE(u, b, h, r, n, dil);
        if (cmb_ != prev_cmb) {
            prev_cmb = cmb_;
            for (int e = tidx; e < 4 * 160; e += NT) { const int sft = e / 160, k = e - sft * 160, idx = k + sft, dist = idx - 16;
                const float v = (dist >= 0 && dist <= 128) ? biasG[cmb_ * 132 + dist] : -1e30f;
                ((LAS float*)(lds + ATT_TAB_OFF))[sft * 160 + k] = v; }
            __syncthreads();
        }
        const LAS unsigned char* Kb = lds + bf * 65536; const LAS unsigned char* Vb = Kb + 32768;
        const int kb0 = w;
        f32x4 sc[9];
#pragma unroll
        for (int i = 0; i < 9; ++i) {
            const unsigned ko = (unsigned)(kb0 + i) * 2048u;
            const bf16x8 k0 = *(const LAS bf16x8*)(Kb + ko + kro0), k1 = *(const LAS bf16x8*)(Kb + ko + kro1);
            f32x4 a = (f32x4){0.f, 0.f, 0.f, 0.f};
            a = __builtin_amdgcn_mfma_f32_16x16x32_bf16(k0, qf0, a, 0, 0, 0);
            a = __builtin_amdgcn_mfma_f32_16x16x32_bf16(k1, qf1, a, 0, 0, 0);
            const f32x4 t = *(const LAS f32x4*)(lds + tab8 + 64 * (8 - i));
            a = a + (f32x4){t[3], t[2], t[1], t[0]};
            if (n == 0 && kb0 + i < 8) a = (f32x4){-1e30f, -1e30f, -1e30f, -1e30f};
            sc[i] = a;
        }
#pragma unroll
        for (int i = 0; i < 9; ++i)
#pragma unroll
            for (int j = 0; j < 4; ++j) sc[i][j] = __builtin_amdgcn_exp2f(fminf(sc[i][j], 100.f));
        f32x4 oacc[4]; f32x4 sacc = (f32x4){0.f, 0.f, 0.f, 0.f};
        const bf16x8 ones = (bf16x8){0x3F80, 0x3F80, 0x3F80, 0x3F80, 0x3F80, 0x3F80, 0x3F80, 0x3F80};
#pragma unroll
        for (int db = 0; db < 4; ++db) oacc[db] = (f32x4){0.f, 0.f, 0.f, 0.f};
#pragma unroll
        for (int c = 0; c < 5; ++c) {
            const int ia = 2 * c, ib = (c < 4) ? 2 * c + 1 : 8;
            u32x4 pw; pw.x = cvt_pk_bf16(sc[ia][0], sc[ia][1]); pw.y = cvt_pk_bf16(sc[ia][2], sc[ia][3]);
            if (c < 4) { pw.z = cvt_pk_bf16(sc[ib][0], sc[ib][1]); pw.w = cvt_pk_bf16(sc[ib][2], sc[ib][3]); } else { pw.z = 0u; pw.w = 0u; }
            const bf16x8 pf = __builtin_bit_cast(bf16x8, pw);
            const unsigned va = (unsigned)(kb0 + ia) * 2048u, vb = (unsigned)(kb0 + ib) * 2048u;
            sacc = __builtin_amdgcn_mfma_f32_16x16x32_bf16(ones, pf, sacc, 0, 0, 0);
#pragma unroll
            for (int db = 0; db < 4; ++db) {
                const v4i16_t x0 = __builtin_amdgcn_ds_read_tr16_b64_v4i16((LAS v4i16_t*)(Vb + va + vro[db]));
                const v4i16_t x1 = __builtin_amdgcn_ds_read_tr16_b64_v4i16((LAS v4i16_t*)(Vb + vb + vro[db]));
                const bf16x8 vf = (bf16x8){x0[0], x0[1], x0[2], x0[3], x1[0], x1[1], x1[2], x1[3]};
                oacc[db] = __builtin_amdgcn_mfma_f32_16x16x32_bf16(vf, pf, oacc[db], 0, 0, 0);
            }
        }
        const float sum = sacc[0];
        const float inv = 1.f / sum;
        const unsigned qpos = (unsigned)(r + dil * (128 * n + 16 * w + fr));
        bf16_t* orow = obr + ((size_t)b * SEQ + qpos) * 512 + h * 64 + 4 * fq;
#pragma unroll
        for (int db = 0; db < 4; ++db) { u32x2 o2; o2.x = cvt_pk_bf16(oacc[db][0] * inv, oacc[db][1] * inv); o2.y = cvt_pk_bf16(oacc[db][2] * inv, oacc[db][3] * inv); *(u32x2*)(orow + 16 * db) = o2; }
        if (fq == 0) lse[((size_t)b * SEQ + qpos) * 8 + h] = sum;
    }
    asm volatile("s_waitcnt vmcnt(0)" ::: "memory");
    __syncthreads();
#undef ATT_DECODE
#undef ATT_ISSUE
}
__device__ __forceinline__ void p_attn_combine(const int wv, const bf16_t* obr, const float* lse, const float* g, bf16_t* mix16) {
    LTID();
    const int lane = tidx & 63, h = lane >> 3;
    const f32x4 g0 = *(const f32x4*)(g + lane * 8), g1 = *(const f32x4*)(g + lane * 8 + 4);
    const int rstride = (int)gridDim.x * NW;
    for (int row0 = bidx * NW + wv; row0 < SEQ; row0 += 4 * rstride) {
        float lv[4][3]; u32x4 av[4][3];
#pragma unroll
        for (int r = 0; r < 4; ++r) { const int row = (row0 + r * rstride < SEQ) ? row0 + r * rstride : row0;
#pragma unroll
            for (int b = 0; b < 3; ++b) { lv[r][b] = lse[((size_t)b * SEQ + row) * 8 + h]; av[r][b] = *(const u32x4*)(obr + ((size_t)b * SEQ + row) * 512 + lane * 8); } }
#pragma unroll
        for (int r = 0; r < 4; ++r) {
            const int row = row0 + r * rstride;
            float w0 = lv[r][0], w1 = lv[r][1], w2 = lv[r][2];
            const float iw = 1.f / (w0 + w1 + w2); w0 *= iw; w1 *= iw; w2 *= iw;
            float y[8]; float ss = 0.f;
#pragma unroll
            for (int k = 0; k < 4; ++k) {
                const float lo = w0 * __builtin_bit_cast(float, av[r][0][k] << 16) + w1 * __builtin_bit_cast(float, av[r][1][k] << 16) + w2 * __builtin_bit_cast(float, av[r][2][k] << 16);
                const float hi = w0 * __builtin_bit_cast(float, av[r][0][k] & 0xffff0000u) + w1 * __builtin_bit_cast(float, av[r][1][k] & 0xffff0000u) + w2 * __builtin_bit_cast(float, av[r][2][k] & 0xffff0000u);
                y[2 * k] = lo; y[2 * k + 1] = hi; ss += lo * lo + hi * hi;
            }
#pragma unroll
            for (int o = 32; o; o >>= 1) ss += shx(ss, o, lane);
            const float sc = rsqrtf(ss * (1.f / 512.f) + 1e-5f);
            u32x4 o4; o4.x = cvt_pk_bf16(y[0] * sc * g0[0], y[1] * sc * g0[1]); o4.y = cvt_pk_bf16(y[2] * sc * g0[2], y[3] * sc * g0[3]);
            o4.z = cvt_pk_bf16(y[4] * sc * g1[0], y[5] * sc * g1[1]); o4.w = cvt_pk_bf16(y[6] * sc * g1[2], y[7] * sc * g1[3]);
            if (row < SEQ) *(u32x4*)(mix16 + (size_t)row * DM + lane * 8) = o4;
        }
    }
}
struct EpiIn {
    static constexpr bool PERM = true;
    bf16_t* O;
    __device__ __forceinline__ void operator()(const f32x4 (&acc)[2][2][4][2], const GUnit& u, int wr, int wc, int fr, int fq) const {
        const int row0 = u.pm * BM + wr * 64 + fr, col0 = u.pn * BM + wc * 32 + 8 * fq;
        const float sc = u.pn < 2 ? 0.18033688011112042f : 1.f;
#pragma unroll
        for (int ai = 0; ai < 2; ++ai)
#pragma unroll
            for (int m = 0; m < 4; ++m) { const size_t ro = (size_t)(row0 + ai * HALF + m * 16) * DIN + col0;
#pragma unroll
                for (int bj = 0; bj < 2; ++bj) { const f32x4 v0 = acc[ai][bj][m][0] * sc, v1 = acc[ai][bj][m][1] * sc;
                    u32x4 w; w.x = cvt_pk_bf16(v0[0], v0[1]); w.y = cvt_pk_bf16(v0[2], v0[3]); w.z = cvt_pk_bf16(v1[0], v1[1]); w.w = cvt_pk_bf16(v1[2], v1[3]);
                    *(u32x4*)(O + ro + bj * HALF) = w;
                    } }
    }
};


__device__ __forceinline__ unsigned xoff_b(unsigned row, unsigned ch) { return 256u * row + 16u * (ch ^ (((row & 3u) << 2) | ((row >> 2) & 3u))); }
__device__ __forceinline__ void p_xattn_mfma(const int wv, const bf16_t* qx16, const bf16_t* kv16, bf16_t* ox16, LAS unsigned char* lds) {
    LTID();
    const int lane = tidx & 63, fr = lane & 15, fq = lane >> 4, w = wv;
    const int NU = 4 * 128;
    const int per = (NU + (int)gridDim.x - 1) / (int)gridDim.x;
    const int u0 = bidx * per, u1 = (u0 + per < NU) ? u0 + per : NU;
    if (u0 >= u1) return;
    const int rowl = tidx >> 4, cs = tidx & 15;
    const unsigned csw = (unsigned)(cs ^ (((rowl & 3) << 2) | ((rowl >> 2) & 3))) * 16u;
    const unsigned kswz = (unsigned)(((fr & 3) << 2) | ((fr >> 2) & 3));
    unsigned kro[4];
#pragma unroll
    for (int s4 = 0; s4 < 4; ++s4) kro[s4] = 256u * (unsigned)fr + 16u * ((unsigned)(4 * s4 + fq) ^ kswz);
    const int tq = (lane & 15) >> 2, tp = lane & 3;
    const unsigned vswz = (unsigned)((tq << 2) | fq);
    unsigned vro[8];
#pragma unroll
    for (int c = 0; c < 8; ++c) vro[c] = 65536u + 256u * (unsigned)(4 * fq + tq) + 16u * ((unsigned)(2 * c + (tp >> 1)) ^ vswz) + 8u * (unsigned)(tp & 1);
    int prev_h = -1;
    for (int u = u0; u < u1; ++u) {
        const int h = u >> 7, qt = u & 127;
        if (h != prev_h) {
            __syncthreads();
            prev_h = h;
#pragma unroll
            for (int p = 0; p < 8; ++p) {
                const unsigned row = (unsigned)(32 * p + rowl);
                const unsigned so = row * 2048u + (unsigned)h * 256u + csw;
                const unsigned ld_ = (unsigned)(size_t)(lds + p * 8192 + w * 1024);
                glds16s(kv16, so, ld_); glds16s(kv16, so + 1024u, ld_ + 65536u);
            }
            asm volatile("s_waitcnt vmcnt(0)" ::: "memory");
            __syncthreads();
        }
        const char* qsrc = (const char*)qx16 + ((size_t)(qt * 128 + 16 * w + fr) * 512 + h * 128 + 8 * fq) * 2;
        bf16x8 qf[4];
#pragma unroll
        for (int s4 = 0; s4 < 4; ++s4) qf[s4] = *(const bf16x8*)(qsrc + 64 * s4);
        f32x4 sc[16];
#pragma unroll
        for (int i = 0; i < 16; ++i) {
            f32x4 a = (f32x4){0.f, 0.f, 0.f, 0.f};
#pragma unroll
            for (int s4 = 0; s4 < 4; ++s4) { const bf16x8 kf = *(const LAS bf16x8*)(lds + i * 4096 + kro[s4]); a = __builtin_amdgcn_mfma_f32_16x16x32_bf16(kf, qf[s4], a, 0, 0, 0); }
            sc[i] = a;
        }
        float mx = -1e30f;
#pragma unroll
        for (int i = 0; i < 16; ++i) mx = fmaxf(mx, fmaxf(fmaxf(sc[i][0], sc[i][1]), fmaxf(sc[i][2], sc[i][3])));
        mx = fmaxf(mx, shx(mx, 16, lane)); mx = fmaxf(mx, shx(mx, 32, lane));
        float sum = 0.f;
#pragma unroll
        for (int i = 0; i < 16; ++i)
#pragma unroll
            for (int j = 0; j < 4; ++j) { const float p = __expf(sc[i][j] - mx); sc[i][j] = p; sum += p; }
        sum += shx(sum, 16, lane); sum += shx(sum, 32, lane);
        f32x4 oacc[8];
#pragma unroll
        for (int c = 0; c < 8; ++c) oacc[c] = (f32x4){0.f, 0.f, 0.f, 0.f};
#pragma unroll
        for (int ch = 0; ch < 8; ++ch) {
            const int ia = 2 * ch, ib = 2 * ch + 1;
            u32x4 pw; pw.x = cvt_pk_bf16(sc[ia][0], sc[ia][1]); pw.y = cvt_pk_bf16(sc[ia][2], sc[ia][3]); pw.z = cvt_pk_bf16(sc[ib][0], sc[ib][1]); pw.w = cvt_pk_bf16(sc[ib][2], sc[ib][3]);
            const bf16x8 pf = __builtin_bit_cast(bf16x8, pw);
#pragma unroll
            for (int c = 0; c < 8; ++c) {
                const v4i16_t x0 = __builtin_amdgcn_ds_read_tr16_b64_v4i16((LAS v4i16_t*)(lds + ia * 4096 + vro[c]));
                const v4i16_t x1 = __builtin_amdgcn_ds_read_tr16_b64_v4i16((LAS v4i16_t*)(lds + ib * 4096 + vro[c]));
                const bf16x8 vf = (bf16x8){x0[0], x0[1], x0[2], x0[3], x1[0], x1[1], x1[2], x1[3]};
                oacc[c] = __builtin_amdgcn_mfma_f32_16x16x32_bf16(vf, pf, oacc[c], 0, 0, 0);
            }
        }
        const float inv = 1.f / sum;
        bf16_t* orow = ox16 + (size_t)(qt * 128 + 16 * w + fr) * 512 + h * 128 + 4 * fq;
#pragma unroll
        for (int c = 0; c < 8; ++c) { u32x2 o2; o2.x = cvt_pk_bf16(oacc[c][0] * inv, oacc[c][1] * inv); o2.y = cvt_pk_bf16(oacc[c][2] * inv, oacc[c][3] * inv); *(u32x2*)(orow + 16 * c) = o2; }
    }
    __syncthreads();
}
struct EpiBf16 {
    static constexpr bool PERM = true;
    bf16_t* O; int ldc; float scale; const float* ss;
    __device__ __forceinline__ void operator()(const f32x4 (&acc)[2][2][4][2], const GUnit& u, int wr, int wc, int fr, int fq) const {
        const int row0 = u.pm * BM + wr * 64 + fr, col0 = u.pn * BM + wc * 32 + 8 * fq;
#pragma unroll
        for (int ai = 0; ai < 2; ++ai)
#pragma unroll
            for (int m = 0; m < 4; ++m) { const int row = row0 + ai * HALF + m * 16; bf16_t* rowp = O + (size_t)row * ldc + col0;
                float sc = scale;
                if (ss) { const f32x4 p0 = *(const f32x4*)(ss + (size_t)row * 16), p1 = *(const f32x4*)(ss + (size_t)row * 16 + 4), p2 = *(const f32x4*)(ss + (size_t)row * 16 + 8), p3 = *(const f32x4*)(ss + (size_t)row * 16 + 12);
                    const float t = ((p0[0] + p0[1]) + (p0[2] + p0[3])) + ((p1[0] + p1[1]) + (p1[2] + p1[3])) + ((p2[0] + p2[1]) + (p2[2] + p2[3])) + ((p3[0] + p3[1]) + (p3[2] + p3[3]));
                    sc = scale * rsqrtf(t * (1.f / 1024.f) + 1e-5f); }
#pragma unroll
                for (int bj = 0; bj < 2; ++bj) { const f32x4 v0 = acc[ai][bj][m][0] * sc, v1 = acc[ai][bj][m][1] * sc;
                    u32x4 w; w.x = cvt_pk_bf16(v0[0], v0[1]); w.y = cvt_pk_bf16(v0[2], v0[3]); w.z = cvt_pk_bf16(v1[0], v1[1]); w.w = cvt_pk_bf16(v1[2], v1[3]);
                    *(u32x4*)(rowp + bj * HALF) = w; } }
    }
};
struct EpiOut {
    static constexpr bool PERM = true;
    const float* R; float* H; bf16_t* HB; float* ss;
    __device__ __forceinline__ void operator()(const f32x4 (&acc)[2][2][4][2], const GUnit& u, int wr, int wc, int fr, int fq) const {
        const int row0 = u.pm * BM + wr * 64 + fr, col0 = u.pn * BM + wc * 32 + 8 * fq, lane = fq * 16 + fr;
#pragma unroll
        for (int ai = 0; ai < 2; ++ai)
#pragma unroll
            for (int m = 0; m < 4; ++m) { const int row = row0 + ai * HALF + m * 16; const size_t ro = (size_t)row * DM + col0; float sq = 0.f;
#pragma unroll
                for (int bj = 0; bj < 2; ++bj) {
                    const f32x4 v0 = acc[ai][bj][m][0] + *(const f32x4*)(R + ro + bj * HALF), v1 = acc[ai][bj][m][1] + *(const f32x4*)(R + ro + bj * HALF + 4);
                    *(f32x4*)(H + ro + bj * HALF) = v0; *(f32x4*)(H + ro + bj * HALF + 4) = v1;
                    u32x4 w; w.x = cvt_pk_bf16(v0[0], v0[1]); w.y = cvt_pk_bf16(v0[2], v0[3]); w.z = cvt_pk_bf16(v1[0], v1[1]); w.w = cvt_pk_bf16(v1[2], v1[3]);
                    *(u32x4*)(HB + ro + bj * HALF) = w;
                    sq += (v0[0] * v0[0] + v0[1] * v0[1]) + (v0[2] * v0[2] + v0[3] * v0[3]) + (v1[0] * v1[0] + v1[1] * v1[1]) + (v1[2] * v1[2] + v1[3] * v1[3]);
                }
                sq += shx(sq, 16, lane); sq += shx(sq, 32, lane);
                if (fq == 0) ss[(size_t)row * 16 + u.pn * 4 + wc] = sq;
            }
    }
};

typedef short bf16x4 __attribute__((ext_vector_type(4)));
constexpr int S5_CHUNK = 256, S5_NCH = SEQ / S5_CHUNK, S5_ROWB = 528;
__device__ __forceinline__ f32x2 gelu_pk(f32x2 v) {
    const f32x2 av = __builtin_elementwise_abs(v), d = av * 0.2316418882f + 1.0f;
    f32x2 t; t.x = __builtin_amdgcn_rcpf(d.x); t.y = __builtin_amdgcn_rcpf(d.y);
    f32x2 q = t * 0.5307027145f + (-0.7265760135f); q = q * t + 0.7107068705f; q = q * t + (-0.142248368f); q = q * t + 0.127414796f; q = q * t;
    const f32x2 s2 = (v * v) * (-0.72134752044f);
    f32x2 e; e.x = __builtin_amdgcn_exp2f(s2.x); e.y = __builtin_amdgcn_exp2f(s2.y);
    const f32x2 m = v * (q * e), r = v - m;
    f32x2 o; o.x = v.x < 0.f ? m.x : r.x; o.y = v.y < 0.f ? m.y : r.y; return o;
}
__device__ __forceinline__ void p_s5_tables2(const int wv, const float* a_re, const float* a_im, const float* b_re, const float* b_im, const float* c_re, const float* c_im, const float* log_dt,
                                             float2* abar, float2* a256, bf16_t* BB16, bf16_t* CM16) {
    LTID();
    for (int gp = bidx * NT + tidx; gp < 2048; gp += gridDim.x * NT) {
        const int g = gp >> 6, p = gp & 63;
        const float lr = a_re[gp], li = a_im[gp], dt = expf(log_dt[g]);
        const float mag = expf(lr * dt); float sn, cs; sincosf(li * dt, &sn, &cs);
        const float ar = mag * cs, ai = mag * sn;
        abar[gp] = make_float2(ar, ai);
        float pr = ar, pi = ai;
        for (int i = 0; i < 8; ++i) { const float nr = pr * pr - pi * pi, ni = 2.f * pr * pi; pr = nr; pi = ni; }
        a256[gp] = make_float2(pr, pi);
        const float nr = ar - 1.f, ni = ai, den = lr * lr + li * li;
        const float cr = (nr * lr + ni * li) / den, ci = (ni * lr - nr * li) / den;
        for (int c = 0; c < 16; ++c) {
            const float br = b_re[gp * 16 + c], bi = b_im[gp * 16 + c];
            BB16[((size_t)g * 128 + p) * 16 + c] = (bf16_t)f2bf(cr * br - ci * bi);
            BB16[((size_t)g * 128 + 64 + p) * 16 + c] = (bf16_t)f2bf(cr * bi + ci * br);
            CM16[((size_t)g * 16 + c) * 128 + p] = (bf16_t)f2bf(c_re[(g * 16 + c) * 64 + p]);
            CM16[((size_t)g * 16 + c) * 128 + 64 + p] = (bf16_t)f2bf(-c_im[(g * 16 + c) * 64 + p]);
        }
    }
}
template <int MODE> __device__ __forceinline__ void p_s5_pass(const int wv, const bf16_t* proj16, const float2* abar, const float2* a256, const bf16_t* BB16, const bf16_t* CM16, const float* dskip,
                                                              float2* E, bf16_t* yg16, LAS unsigned char* lds) {
    LTID();
    const int lane = tidx & 63, fr = lane & 15, fq = lane >> 4;
    LAS unsigned char* L = lds + wv * (16 * S5_ROWB);
    for (int unit = bidx * NW + wv; unit < S5_NCH * 32; unit += gridDim.x * NW) {
        const int g = unit & 31, chunk = unit >> 5;
        const float2 a = abar[g * 64 + lane];
        bf16x4 bbf[8];
#pragma unroll
        for (int cb = 0; cb < 8; ++cb) bbf[cb] = *(const bf16x4*)(BB16 + ((size_t)g * 128 + 16 * cb + fr) * 16 + 4 * fq);
        bf16x8 cmf[4]; f32x4 dsk = (f32x4){0.f, 0.f, 0.f, 0.f};
        if (MODE == 1) {
#pragma unroll
            for (int s4 = 0; s4 < 4; ++s4) cmf[s4] = *(const bf16x8*)(CM16 + ((size_t)g * 16 + fr) * 128 + 32 * s4 + 8 * fq);
            dsk = *(const f32x4*)(dskip + g * 16 + 4 * fq);
        }
        float sr = 0.f, si = 0.f;
        if (MODE == 1) {
            const float2 A = a256[g * 64 + lane];
            for (int j0 = 0; j0 < chunk; j0 += 16) {
                float2 e[16];
#pragma unroll
                for (int k = 0; k < 16; ++k) { const int j = (j0 + k < chunk) ? j0 + k : chunk - 1; e[k] = E[((size_t)j * 32 + g) * 64 + lane]; }
#pragma unroll
                for (int k = 0; k < 16; ++k) if (j0 + k < chunk) { const float nr = A.x * sr - A.y * si + e[k].x, ni = A.x * si + A.y * sr + e[k].y; sr = nr; si = ni; }
            }
        }
        const bf16_t* ubase = proj16 + (size_t)(chunk * S5_CHUNK + fr) * DIN + 1536 + g * 16 + 4 * fq;
        bf16x4 uf = *(const bf16x4*)ubase;
#pragma unroll 1
        for (int blk = 0; blk < S5_CHUNK / 16; ++blk) {
            const bf16x4 ufn = *(const bf16x4*)(ubase + (size_t)((blk < S5_CHUNK / 16 - 1) ? (blk + 1) * 16 : blk * 16) * DIN);
            asm volatile("" ::: "memory");
#pragma unroll
            for (int cb = 0; cb < 8; ++cb) {
                const f32x4 d = __builtin_amdgcn_mfma_f32_16x16x16bf16_1k(bbf[cb], uf, (f32x4){0.f, 0.f, 0.f, 0.f}, 0, 0, 0);
                *(LAS f32x4*)(L + fr * S5_ROWB + (16 * cb + 4 * fq) * 4) = d;
            }
            asm volatile("" ::: "memory");
#pragma unroll
            for (int t = 0; t < 16; ++t) {
                const float re = *(const LAS float*)(L + t * S5_ROWB + lane * 4), im = *(const LAS float*)(L + t * S5_ROWB + 256 + lane * 4);
                const float nr = a.x * sr - a.y * si + re, ni = a.x * si + a.y * sr + im; sr = nr; si = ni;
                if (MODE == 1) { *(LAS bf16_t*)(L + t * S5_ROWB + lane * 2) = (bf16_t)f2bf(sr); *(LAS bf16_t*)(L + t * S5_ROWB + 128 + lane * 2) = (bf16_t)f2bf(si); }
            }
            asm volatile("" ::: "memory");
            if (MODE == 1) {
                f32x4 y = (f32x4){0.f, 0.f, 0.f, 0.f};
#pragma unroll
                for (int s4 = 0; s4 < 4; ++s4) { const bf16x8 sf = *(const LAS bf16x8*)(L + fr * S5_ROWB + 64 * s4 + 16 * fq); y = __builtin_amdgcn_mfma_f32_16x16x32_bf16(cmf[s4], sf, y, 0, 0, 0); }
                f32x4 v;
#pragma unroll
                for (int j = 0; j < 4; ++j) v[j] = y[j] + dsk[j] * bf2f((unsigned short)uf[j]);
                const f32x2 g0 = gelu_pk((f32x2){v[0], v[1]}), g1 = gelu_pk((f32x2){v[2], v[3]});
                u32x2 o2; o2.x = cvt_pk_bf16(g0.x, g0.y); o2.y = cvt_pk_bf16(g1.x, g1.y);
                *(u32x2*)(yg16 + (size_t)(chunk * S5_CHUNK + blk * 16 + fr) * 512 + g * 16 + 4 * fq) = o2;
            }
            asm volatile("" ::: "memory");
            uf = ufn;
        }
        if (MODE == 0) E[((size_t)chunk * 32 + g) * 64 + lane] = make_float2(sr, si);
    }
}
struct EpiGlu16 {
    static constexpr bool PERM = true;
    bf16_t* O; const bf16_t* Y; const float* bias;
    __device__ __forceinline__ void operator()(const f32x4 (&acc)[2][2][4][2], const GUnit& u, int wr, int wc, int fr, int fq) const {
        const int row0 = u.pm * BM + wr * 64 + fr, col0 = u.pn * BM + wc * 32 + 8 * fq;
        f32x4 bv[2][2];
#pragma unroll
        for (int bj = 0; bj < 2; ++bj)
#pragma unroll
            for (int n = 0; n < 2; ++n) bv[bj][n] = *(const f32x4*)(bias + col0 + bj * HALF + 4 * n);
#pragma unroll
        for (int ai = 0; ai < 2; ++ai)
#pragma unroll
            for (int m = 0; m < 4; ++m) { const size_t ro = (size_t)(row0 + ai * HALF + m * 16) * 512 + col0;
#pragma unroll
                for (int bj = 0; bj < 2; ++bj) {
                    const u32x4 yv = *(const u32x4*)(Y + ro + bj * HALF);
                    float o[8];
#pragma unroll
                    for (int n = 0; n < 2; ++n)
#pragma unroll
                        for (int j = 0; j < 4; ++j) { const unsigned wd = yv[n * 2 + (j >> 1)]; const float y = __builtin_bit_cast(float, (j & 1) ? (wd & 0xffff0000u) : (wd << 16));
                            o[n * 4 + j] = y / (1.f + __expf(-(acc[ai][bj][m][n][j] + bv[bj][n][j]))); }
                    u32x4 w; w.x = cvt_pk_bf16(o[0], o[1]); w.y = cvt_pk_bf16(o[2], o[3]); w.z = cvt_pk_bf16(o[4], o[5]); w.w = cvt_pk_bf16(o[6], o[7]);
                    *(u32x4*)(O + ro + bj * HALF) = w; } }
    }
};
__device__ __forceinline__ void p_ssm_norm(const int wv, const bf16_t* yb16, const float* g, bf16_t* mix16) {
    LTID();
    const int lane = tidx & 63;
    const f32x4 g0 = *(const f32x4*)(g + lane * 8), g1 = *(const f32x4*)(g + lane * 8 + 4);
    const int rstride = (int)gridDim.x * NW;
    for (int row0 = bidx * NW + wv; row0 < SEQ; row0 += 4 * rstride) {
        u32x4 av[4];
#pragma unroll
        for (int r = 0; r < 4; ++r) { const int row = (row0 + r * rstride < SEQ) ? row0 + r * rstride : row0; av[r] = *(const u32x4*)(yb16 + (size_t)row * 512 + lane * 8); }
#pragma unroll
        for (int r = 0; r < 4; ++r) {
            const int row = row0 + r * rstride;
            float y[8]; float ss = 0.f;
#pragma unroll
            for (int k = 0; k < 4; ++k) { y[2 * k] = __builtin_bit_cast(float, av[r][k] << 16); y[2 * k + 1] = __builtin_bit_cast(float, av[r][k] & 0xffff0000u); ss += y[2 * k] * y[2 * k] + y[2 * k + 1] * y[2 * k + 1]; }
#pragma unroll
            for (int o = 32; o; o >>= 1) ss += shx(ss, o, lane);
            const float sc = rsqrtf(ss * (1.f / 512.f) + 1e-5f);
            u32x4 o4; o4.x = cvt_pk_bf16(y[0] * sc * g0[0], y[1] * sc * g0[1]); o4.y = cvt_pk_bf16(y[2] * sc * g0[2], y[3] * sc * g0[3]);
            o4.z = cvt_pk_bf16(y[4] * sc * g1[0], y[5] * sc * g1[1]); o4.w = cvt_pk_bf16(y[6] * sc * g1[2], y[7] * sc * g1[3]);
            if (row < SEQ) *(u32x4*)(mix16 + (size_t)row * DM + 512 + lane * 8) = o4;
        }
    }
}

__device__ __forceinline__ void p_rmsnorm16(const int wv, const float* in, const float* g, bf16_t* out16, int rows) {
    LTID();
    const int lane = tidx & 63;
    for (int r = bidx * NW + wv; r < rows; r += gridDim.x * NW) {
        f32x4 v[4]; float ss = 0.f;
#pragma unroll
        for (int j = 0; j < 4; ++j) { v[j] = *(const f32x4*)(in + (size_t)r * DM + 4 * lane + 256 * j); ss += (v[j][0] * v[j][0] + v[j][1] * v[j][1]) + (v[j][2] * v[j][2] + v[j][3] * v[j][3]); }
#pragma unroll
        for (int o = 32; o; o >>= 1) ss += shx(ss, o, lane);
        const float sc = rsqrtf(ss * (1.f / 1024.f) + 1e-5f);
#pragma unroll
        for (int j = 0; j < 4; ++j) { const f32x4 gg = *(const f32x4*)(g + 4 * lane + 256 * j); u32x2 o2; o2.x = cvt_pk_bf16(v[j][0] * sc * gg[0], v[j][1] * sc * gg[1]); o2.y = cvt_pk_bf16(v[j][2] * sc * gg[2], v[j][3] * sc * gg[3]);
            *(u32x2*)(out16 + (size_t)r * DM + 4 * lane + 256 * j) = o2; }
    }
}
template <bool MOE, bool LAST> __device__ __forceinline__ void p_rowfinish(const int wv, const float* hin, float* h, const bf16_t* mout, const int* eslot, const float* topg, const float* g, bf16_t* xn16, float* out) {
    LTID();
    const int lane = tidx & 63;
    LAS const int* ts = (LAS const int*)(LDSP + TS_OFF);
    const int rstride = (int)gridDim.x * NW;
    for (int r0 = bidx * NW + wv; r0 < SEQ; r0 += 2 * rstride) {
        int rr[2]; rr[0] = r0; rr[1] = (r0 + rstride < SEQ) ? r0 + rstride : r0;
        f32x4 v[2][4]; int4 es[2]; f32x4 gt[2]; u32x2 mo[2][4][4];
#pragma unroll
        for (int q = 0; q < 2; ++q) { if (MOE) { es[q] = *(const int4*)(eslot + rr[q] * 4); gt[q] = *(const f32x4*)(topg + rr[q] * 4); }
#pragma unroll
            for (int j = 0; j < 4; ++j) v[q][j] = *(const f32x4*)(hin + (size_t)rr[q] * DM + 4 * lane + 256 * j); }
        if (MOE) {
#pragma unroll
            for (int q = 0; q < 2; ++q) { const int esv[4] = {es[q].x, es[q].y, es[q].z, es[q].w};
#pragma unroll
                for (int k = 0; k < 4; ++k) { const int e = esv[k] >> 16, sl = esv[k] & 0xffff; const size_t row = (size_t)ts[e] * BM + sl;
#pragma unroll
                    for (int j = 0; j < 4; ++j) mo[q][k][j] = *(const u32x2*)(mout + row * DM + 4 * lane + 256 * j); } }
#pragma unroll
            for (int q = 0; q < 2; ++q)
#pragma unroll
                for (int k = 0; k < 4; ++k) { const float gk = gt[q][k];
#pragma unroll
                    for (int j = 0; j < 4; ++j) { const u32x2 o = mo[q][k][j];
                        v[q][j][0] += gk * __builtin_bit_cast(float, o.x << 16); v[q][j][1] += gk * __builtin_bit_cast(float, o.x & 0xffff0000u);
                        v[q][j][2] += gk * __builtin_bit_cast(float, o.y << 16); v[q][j][3] += gk * __builtin_bit_cast(float, o.y & 0xffff0000u); } }
        }
#pragma unroll
        for (int q = 0; q < 2; ++q) {
            if (q == 1 && r0 + rstride >= SEQ) break;
            const int r = rr[q];
            float ss = 0.f;
#pragma unroll
            for (int j = 0; j < 4; ++j) ss += (v[q][j][0] * v[q][j][0] + v[q][j][1] * v[q][j][1]) + (v[q][j][2] * v[q][j][2] + v[q][j][3] * v[q][j][3]);
#pragma unroll
            for (int o = 32; o; o >>= 1) ss += shx(ss, o, lane);
            const float sc = rsqrtf(ss * (1.f / 1024.f) + 1e-5f);
#pragma unroll
            for (int j = 0; j < 4; ++j) {
                const f32x4 gg = *(const f32x4*)(g + 4 * lane + 256 * j);
                if (!LAST) { if (h) *(f32x4*)(h + (size_t)r * DM + 4 * lane + 256 * j) = v[q][j];
                    u32x2 o2; o2.x = cvt_pk_bf16(v[q][j][0] * sc * gg[0], v[q][j][1] * sc * gg[1]); o2.y = cvt_pk_bf16(v[q][j][2] * sc * gg[2], v[q][j][3] * sc * gg[3]);
                    *(u32x2*)(xn16 + (size_t)r * DM + 4 * lane + 256 * j) = o2; }
                else *(f32x4*)(out + (size_t)r * DM + 4 * lane + 256 * j) = (f32x4){v[q][j][0] * sc * gg[0], v[q][j][1] * sc * gg[1], v[q][j][2] * sc * gg[2], v[q][j][3] * sc * gg[3]};
            }
        }
    }
}
__device__ __forceinline__ void p_router_tables(const int wv, const float* w_r, const float* g, bf16_t* WR16) {
    LTID();
    for (int i = bidx * NT + tidx; i < 32 * 1024; i += gridDim.x * NT) {
        const int e = i >> 10, k = i & 1023;
        const float w = g[k] * w_r[k * 32 + e];
        const unsigned hi = f2bf(w); const float lo = w - __builtin_bit_cast(float, hi << 16);
        WR16[i] = (bf16_t)hi; WR16[32 * 1024 + i] = (bf16_t)f2bf(lo);
    }
}
constexpr int RT_CNT_OFF = 131072 + 4608;
constexpr int RT_XCH_OFF = 131072 + 5120;
__device__ __forceinline__ void p_router2(const int wv, const float* h, const bf16_t* WR16, const float* b_r, bf16_t* hb16, unsigned* gcnt, int* rowtok_e, float* rsc_e, int* eslot, float* topg, LAS unsigned char* lds) {
    LTID();
    const int lane = tidx & 63, fr = lane & 15, fq = lane >> 4, w = wv, tg = w & 3, kh = w >> 2;
#pragma unroll
    for (int part = 0; part < 2; ++part)
#pragma unroll
        for (int p = 0; p < 8; ++p) { const int row = 4 * p + (tidx >> 7), cs = tidx & 127;
            glds16s(WR16, (unsigned)(part * 65536 + row * 2048 + ((cs ^ (row & 15)) * 16)), (unsigned)(size_t)(lds + part * 65536 + p * 8192 + w * 1024)); }
    LAS int* lcnt = (LAS int*)(lds + RT_CNT_OFF);
    if (tidx < 64) lcnt[tidx] = 0;
    asm volatile("s_waitcnt vmcnt(0)" ::: "memory");
    __syncthreads();
    for (int it = bidx; it < SEQ / 64; it += gridDim.x) {
        const int token = it * 64 + 16 * tg + fr;
        const float* xr = h + (size_t)token * DM + 512 * kh + 8 * fq;
        bf16_t* hb = hb16 + (size_t)token * DM + 512 * kh + 8 * fq;
        f32x4 acc[2]; acc[0] = (f32x4){0.f, 0.f, 0.f, 0.f}; acc[1] = acc[0];
        float ss = 0.f;
#pragma unroll 4
        for (int s4 = 0; s4 < 16; ++s4) {
            const f32x4 x0 = *(const f32x4*)(xr + 32 * s4), x1 = *(const f32x4*)(xr + 32 * s4 + 4);
            ss += (x0[0] * x0[0] + x0[1] * x0[1]) + (x0[2] * x0[2] + x0[3] * x0[3]) + (x1[0] * x1[0] + x1[1] * x1[1]) + (x1[2] * x1[2] + x1[3] * x1[3]);
            u32x4 hw; hw.x = cvt_pk_bf16(x0[0], x0[1]); hw.y = cvt_pk_bf16(x0[2], x0[3]); hw.z = cvt_pk_bf16(x1[0], x1[1]); hw.w = cvt_pk_bf16(x1[2], x1[3]);
            *(u32x4*)(hb + 32 * s4) = hw;
            u32x4 lw;
            lw.x = cvt_pk_bf16(x0[0] - __builtin_bit_cast(float, hw.x << 16), x0[1] - __builtin_bit_cast(float, hw.x & 0xffff0000u));
            lw.y = cvt_pk_bf16(x0[2] - __builtin_bit_cast(float, hw.y << 16), x0[3] - __builtin_bit_cast(float, hw.y & 0xffff0000u));
            lw.z = cvt_pk_bf16(x1[0] - __builtin_bit_cast(float, hw.z << 16), x1[1] - __builtin_bit_cast(float, hw.z & 0xffff0000u));
            lw.w = cvt_pk_bf16(x1[2] - __builtin_bit_cast(float, hw.w << 16), x1[3] - __builtin_bit_cast(float, hw.w & 0xffff0000u));
            const bf16x8 xhi = __builtin_bit_cast(bf16x8, hw), xlo = __builtin_bit_cast(bf16x8, lw);
            const int c = 64 * kh + 4 * s4 + fq, slot = c ^ fr;
#pragma unroll
            for (int nb = 0; nb < 2; ++nb) {
                const bf16x8 whi = *(const LAS bf16x8*)(lds + (16 * nb + fr) * 2048 + slot * 16), wlo = *(const LAS bf16x8*)(lds + 65536 + (16 * nb + fr) * 2048 + slot * 16);
                acc[nb] = __builtin_amdgcn_mfma_f32_16x16x32_bf16(whi, xhi, acc[nb], 0, 0, 0);
                acc[nb] = __builtin_amdgcn_mfma_f32_16x16x32_bf16(whi, xlo, acc[nb], 0, 0, 0);
                acc[nb] = __builtin_amdgcn_mfma_f32_16x16x32_bf16(wlo, xhi, acc[nb], 0, 0, 0);
            }
        }
        ss += shx(ss, 16, lane); ss += shx(ss, 32, lane);
        LAS float* X = (LAS float*)(lds + RT_XCH_OFF) + (tg * 64 + lane) * 9;
        if (kh == 1) {
#pragma unroll
            for (int nb = 0; nb < 2; ++nb)
#pragma unroll
                for (int j = 0; j < 4; ++j) X[nb * 4 + j] = acc[nb][j];
            X[8] = ss;
        }
        __syncthreads();
        int ti[4] = {0, 0, 0, 0}, ls[4] = {0, 0, 0, 0}; float gv[4] = {0.f, 0.f, 0.f, 0.f}; float rs = 0.f;
        if (kh == 0) {
            float lv[8];
            ss += X[8];
            rs = rsqrtf(ss * (1.f / 1024.f) + 1e-5f);
#pragma unroll
            for (int nb = 0; nb < 2; ++nb)
#pragma unroll
                for (int j = 0; j < 4; ++j) lv[nb * 4 + j] = rs * (acc[nb][j] + X[nb * 4 + j]) + b_r[16 * nb + 4 * fq + j];
            float tv[4];
#pragma unroll
            for (int r = 0; r < 4; ++r) {
                float bv = -3.0e38f; int bi = 0;
#pragma unroll
                for (int q = 0; q < 8; ++q) { const int idx = 16 * (q >> 2) + 4 * fq + (q & 3); if (lv[q] > bv) { bv = lv[q]; bi = idx; } }
#pragma unroll
                for (int mk = 16; mk <= 32; mk <<= 1) { const float ov = shx(bv, mk, lane); const int oi = shxi(bi, mk, lane); if (ov > bv || (ov == bv && oi < bi)) { bv = ov; bi = oi; } }
                tv[r] = bv; ti[r] = bi;
#pragma unroll
                for (int q = 0; q < 8; ++q) { const int idx = 16 * (q >> 2) + 4 * fq + (q & 3); if (idx == bi) lv[q] = -3.0e38f; }
            }
            float sum = 0.f;
#pragma unroll
            for (int r = 0; r < 4; ++r) { gv[r] = __expf(tv[r] - tv[0]); sum += gv[r]; }
            const float inv = 1.f / sum;
#pragma unroll
            for (int r = 0; r < 4; ++r) gv[r] *= inv;
            if (fq == 0) {
#pragma unroll
                for (int r = 0; r < 4; ++r) ls[r] = __hip_atomic_fetch_add(&lcnt[ti[r]], 1, __ATOMIC_RELAXED, __HIP_MEMORY_SCOPE_WORKGROUP);
            }
        }
        __syncthreads();
        if (tidx < 32) { const int c = lcnt[tidx]; lcnt[32 + tidx] = c ? (int)__hip_atomic_fetch_add(gcnt + tidx, (unsigned)c, __ATOMIC_RELAXED, __HIP_MEMORY_SCOPE_AGENT) : 0; }
        __syncthreads();
        if (kh == 0 && fq == 0) {
            int es[4];
#pragma unroll
            for (int r = 0; r < 4; ++r) { const int e = ti[r], sl = lcnt[32 + e] + ls[r]; rowtok_e[e * ECAP + sl] = token; rsc_e[e * ECAP + sl] = rs; es[r] = (e << 16) | sl; }
            *(int4*)(eslot + token * 4) = make_int4(es[0], es[1], es[2], es[3]);
            *(f32x4*)(topg + token * 4) = (f32x4){gv[0], gv[1], gv[2], gv[3]};
        }
        __syncthreads();
        if (tidx < 32) lcnt[tidx] = 0;
    }
    __syncthreads();
}

constexpr int NPL = 13;
constexpr int NPHASES = 1 + 2 * NPL;
typedef const __attribute__((address_space(4))) Args* KA;
#define PHASE __device__ __forceinline__
#define KAP() ({ KA _t = a; asm volatile("" : "+s"(_t)); _t; })
#define WSP(T, off) ((T*)(a->ws + (off)))

constexpr int NIT = 49152, NIT1 = 32768;
constexpr int QG = 9, QX = 13, QA = 11, QB = 8;
struct ConvBounds { int A1, A2, B1, B2, B3, B4; };
__device__ __forceinline__ int cmin(int a, int b) { return a < b ? a : b; }
__device__ __forceinline__ ConvBounds conv_bounds(int G, int T0) {
    ConvBounds b;
    const int Pg0 = G > 136 ? G - 136 : G, Px = G > 128 ? G - 128 : G;
    b.A1 = cmin(NIT, Pg0 * 8 * QG); b.A2 = cmin(NIT, b.A1 + Px * 8 * QX);
    const int r1 = (8 * T0) % G, r2 = (4 * T0) % G;
    b.B1 = cmin(NIT, r1 ? (G - r1) * 8 * QA : G * 8 * 2);
    b.B2 = cmin(NIT, b.B1 + (r2 ? (G - r2) * 8 * QB : G * 8 * 2));
    b.B3 = cmin(NIT, b.B2 + Px * 8 * QG); b.B4 = cmin(NIT, b.B3 + Px * 8 * QX);
    return b;
}
__device__ __forceinline__ void conv_moe(KA a, const int wv, int l, int begin, int end, int rank, int nranks) {
    if (begin >= end) return;
    const int wr = rank * NW + wv, ws_ = nranks * NW;
    if (begin < NIT1) p_transpose_r(wv, a->in[26] + (size_t)l * NEXP * DM * 2048, NEXP, DM, 2048, WSP(bf16_t, WS_BT1) + (size_t)l * NEXP * 2048 * DM, a->in[23] + l * DM, NEXP, 1, LDSP, begin, cmin(end, NIT1), wr, ws_);
    if (end > NIT1) { const int b2 = begin > NIT1 ? begin - NIT1 : 0;
        p_transpose_r(wv, a->in[28] + (size_t)l * NEXP * DFF * DM, NEXP, DFF, DM, WSP(bf16_t, WS_BT2) + (size_t)l * NEXP * DM * DFF, nullptr, 1, 0, LDSP, b2, end - NIT1, wr, ws_); }
}
__device__ __forceinline__ int moe_T_lds() { return __builtin_amdgcn_readfirstlane(((LAS const int*)(LDSP + TS_OFF))[32]); }
PHASE void ph_init(KA a, const int wv) {
    p_rowfinish<false, false>(wv, a->in[0], nullptr, nullptr, nullptr, nullptr, a->in[3], WSP(bf16_t, WS_XN16), nullptr);
    p_bias_table(wv, a->in[2], WSP(float, WS_BIASG));
    for (int l = 0; l < 2; ++l) {
        p_s5_tables2(wv, a->in[5] + l * 2048, a->in[6] + l * 2048, a->in[7] + l * 32768, a->in[8] + l * 32768, a->in[9] + l * 32768, a->in[10] + l * 32768, a->in[11] + l * 32,
                     WSP(float2, WS_ABAR) + l * 2048, WSP(float2, WS_A256) + l * 2048, WSP(bf16_t, WS_BB16) + (size_t)l * 32 * 128 * 16, WSP(bf16_t, WS_CM16) + (size_t)l * 32 * 16 * 128);
        p_rmsnorm16(wv, a->in[1], a->in[19] + l * DM, WSP(bf16_t, WS_MEMN16) + (size_t)l * NMEM * DM, NMEM);
        p_router_tables(wv, a->in[24] + (size_t)l * DM * 32, a->in[23] + l * DM, WSP(bf16_t, WS_WR16) + (size_t)l * 2 * 32 * 1024);
    }
    p_transpose(wv, a->in[4], 2, DM, DIN, WSP(bf16_t, WS_WT_IN), nullptr, 1, 0, LDSP);
    p_transpose(wv, a->in[13], 2, 512, 512, WSP(bf16_t, WS_WT_GLU), nullptr, 1, 0, LDSP);
    p_transpose(wv, a->in[17], 2, DM, DM, WSP(bf16_t, WS_WT_OUT), nullptr, 1, 0, LDSP);
    p_transpose(wv, a->in[20], 2, DM, 512, WSP(bf16_t, WS_WT_XQ), a->in[18], 1, 0, LDSP);
    p_transpose(wv, a->in[21], 2, DM, 1024, WSP(bf16_t, WS_WT_XKV), nullptr, 1, 0, LDSP);
    p_transpose(wv, a->in[22], 2, 512, DM, WSP(bf16_t, WS_WT_XO), nullptr, 1, 0, LDSP);
    __syncthreads();
}
PHASE void ph_gemm_in(KA a, const int wv, int l) { LTID();
    DenseOrder S; S.init(WSP(bf16_t, WS_XN16), WSP(bf16_t, WS_WT_IN) + (size_t)l * DIN * DM, SEQ, DIN, DM, gridDim.x, bidx);
    EpiIn E{WSP(bf16_t, WS_PROJ16)};
    gemm_phase<EpiIn, DenseOrder, false, true>(LDSP, DM, S, E, tidx, wv);
}
PHASE void ph_attn_s5a(KA a, const int wv, int l) {
    p_dil_attn(wv, WSP(bf16_t, WS_PROJ16), WSP(float, WS_BIASG), WSP(bf16_t, WS_OBR), WSP(float, WS_LSE), LDSP);
    if (PROBE_DUP == 21) p_dil_attn(wv, WSP(bf16_t, WS_PROJ16), WSP(float, WS_BIASG), WSP(bf16_t, WS_OBR), WSP(float, WS_LSE), LDSP);
    if (PROBE_DUP == 22) { p_s5_pass<0>(wv, WSP(bf16_t, WS_PROJ16), WSP(float2, WS_ABAR) + l * 2048, WSP(float2, WS_A256) + l * 2048, WSP(bf16_t, WS_BB16) + (size_t)l * 32 * 128 * 16, WSP(bf16_t, WS_CM16) + (size_t)l * 32 * 16 * 128,
                 a->in[12] + l * 512, WSP(float2, WS_E2), WSP(bf16_t, WS_YG16), LDSP); __syncthreads(); }
    p_s5_pass<0>(wv, WSP(bf16_t, WS_PROJ16), WSP(float2, WS_ABAR) + l * 2048, WSP(float2, WS_A256) + l * 2048, WSP(bf16_t, WS_BB16) + (size_t)l * 32 * 128 * 16, WSP(bf16_t, WS_CM16) + (size_t)l * 32 * 16 * 128,
                 a->in[12] + l * 512, WSP(float2, WS_E2), WSP(bf16_t, WS_YG16), LDSP);
}
PHASE void ph_s5b(KA a, const int wv, int l) {
    p_s5_pass<1>(wv, WSP(bf16_t, WS_PROJ16), WSP(float2, WS_ABAR) + l * 2048, WSP(float2, WS_A256) + l * 2048, WSP(bf16_t, WS_BB16) + (size_t)l * 32 * 128 * 16, WSP(bf16_t, WS_CM16) + (size_t)l * 32 * 16 * 128,
                 a->in[12] + l * 512, WSP(float2, WS_E2), WSP(bf16_t, WS_YG16), LDSP);
}
PHASE void ph_gemm_glu(KA a, const int wv, int l) {
    {   LTID();
        DenseOrder S; S.init(WSP(bf16_t, WS_YG16), WSP(bf16_t, WS_WT_GLU) + (size_t)l * 512 * 512, SEQ, 512, 512, gridDim.x, bidx);
        EpiGlu16 E{WSP(bf16_t, WS_YB16), WSP(bf16_t, WS_YG16), a->in[14] + l * 512};
        gemm_phase<EpiGlu16, DenseOrder, false, false>(LDSP, 512, S, E, tidx, wv); }
    {   LTID();
    const int cc = (int)gridDim.x - 1 - bidx;
    if (l == 0 && cc < 8) {
        const int kl = cc >> 2;
        DenseOrder S; S.init(WSP(bf16_t, WS_MEMN16) + (size_t)kl * NMEM * DM, WSP(bf16_t, WS_WT_XKV) + (size_t)kl * 1024 * DM, NMEM, 1024, DM, 4, cc & 3);
        EpiBf16 E{WSP(bf16_t, WS_KV16) + (size_t)kl * NMEM * 1024, 1024, 1.f, nullptr};
        gemm_phase<EpiBf16, DenseOrder, false, false>(LDSP, DM, S, E, tidx, wv);
    } }
    {   LTID();
        const int G = (int)gridDim.x;
        int T0 = 0; if (l == 1) { moe_tiles(WSP(unsigned, WS_CTL) + CW_CNT, tidx); T0 = moe_T_lds(); }
        const ConvBounds cb = conv_bounds(G, T0);
        const int skip = (l == 0) ? 8 : 0;
        if (G > 128 + skip) { if (bidx >= 128 && bidx < G - skip) conv_moe(a, wv, l, l == 0 ? 0 : cb.B2, l == 0 ? cb.A1 : cb.B3, bidx - 128, G - 128 - skip); }
        else conv_moe(a, wv, l, l == 0 ? 0 : cb.B2, l == 0 ? cb.A1 : cb.B3, bidx, G);
    }
}
PHASE void ph_mixnorm(KA a, const int wv, int l) {
    p_attn_combine(wv, WSP(bf16_t, WS_OBR), WSP(float, WS_LSE), a->in[15] + l * 512, WSP(bf16_t, WS_MIX16));
    p_ssm_norm(wv, WSP(bf16_t, WS_YB16), a->in[16] + l * 512, WSP(bf16_t, WS_MIX16));
}
PHASE void ph_gemm_out(KA a, const int wv, int l) { LTID();
    DenseOrder S; S.init(WSP(bf16_t, WS_MIX16), WSP(bf16_t, WS_WT_OUT) + (size_t)l * DM * DM, SEQ, DM, DM, gridDim.x, bidx);
    EpiOut E{l == 0 ? a->in[0] : (const float*)WSP(float, WS_H), WSP(float, WS_H), WSP(bf16_t, WS_HB16), WSP(float, WS_SSP)};
    gemm_phase<EpiOut, DenseOrder, false, false>(LDSP, DM, S, E, tidx, wv);
}
PHASE void ph_gemm_xq(KA a, const int wv, int l) {
    {   LTID();
        DenseOrder S; S.init(WSP(bf16_t, WS_HB16), WSP(bf16_t, WS_WT_XQ) + (size_t)l * 512 * DM, SEQ, 512, DM, gridDim.x, bidx);
        EpiBf16 E{WSP(bf16_t, WS_QX16), 512, 0.08838834764831845f, WSP(float, WS_SSP)};
        gemm_phase<EpiBf16, DenseOrder, false, false>(LDSP, DM, S, E, tidx, wv); }
    {   LTID();
        const int G = (int)gridDim.x;
        int T0 = 0; if (l == 1) { moe_tiles(WSP(unsigned, WS_CTL) + CW_CNT, tidx); T0 = moe_T_lds(); }
        const ConvBounds cb = conv_bounds(G, T0);
        if (G > 128) { if (bidx >= 128) conv_moe(a, wv, l, l == 0 ? cb.A1 : cb.B3, l == 0 ? cb.A2 : cb.B4, bidx - 128, G - 128); }
        else conv_moe(a, wv, l, l == 0 ? cb.A1 : cb.B3, l == 0 ? cb.A2 : cb.B4, bidx, G);
    }
}
PHASE void ph_xattn(KA a, const int wv, int l) { p_xattn_mfma(wv, WSP(bf16_t, WS_QX16), WSP(bf16_t, WS_KV16) + (size_t)l * NMEM * 1024, WSP(bf16_t, WS_OX16), LDSP); }
PHASE void ph_gemm_xo(KA a, const int wv, int l) { LTID();
    DenseOrder S; S.init(WSP(bf16_t, WS_OX16), WSP(bf16_t, WS_WT_XO) + (size_t)l * DM * 512, SEQ, DM, 512, gridDim.x, bidx);
    EpiF32 E{WSP(float, WS_H), DM, 1};
    gemm_phase<EpiF32, DenseOrder, false, false>(LDSP, 512, S, E, tidx, wv);
}
PHASE void ph_router(KA a, const int wv, int l) {
    {   LTID();
        const int G = (int)gridDim.x;
        int T0 = 0; if (l == 1) { moe_tiles(WSP(unsigned, WS_CTL) + CW_CNT, tidx); T0 = moe_T_lds(); }
        const ConvBounds cb = conv_bounds(G, T0);
        conv_moe(a, wv, l, l == 0 ? cb.A2 : cb.B4, NIT, bidx, G);
        __syncthreads();
    }
    p_router2(wv, WSP(float, WS_H), WSP(bf16_t, WS_WR16) + (size_t)l * 2 * 32 * 1024, a->in[25] + l * 32, WSP(bf16_t, WS_HB16), WSP(unsigned, WS_CTL) + CW_CNT + l * 32,
              WSP(int, WS_ROWTOK), WSP(float, WS_RSC), WSP(int, WS_ESLOT), WSP(float, WS_TOPG), LDSP);
}
PHASE void ph_moe1(KA a, const int wv, int l) {
    {   LTID();
        moe_tiles(WSP(unsigned, WS_CTL) + CW_CNT + l * 32, tidx);
        MoeOrder<true> S; S.init(WSP(bf16_t, WS_HB16), WSP(bf16_t, WS_BT1) + (size_t)l * NEXP * 2048 * DM, WSP(int, WS_ROWTOK), 2048, DM, (size_t)2048 * DM * 2, gridDim.x, bidx);
        EpiMoe1 E{WSP(bf16_t, WS_ACT), a->in[27] + (size_t)l * NEXP * 2048, WSP(float, WS_RSC)};
        gemm_phase<EpiMoe1, MoeOrder<true>, true, true>(LDSP, DM, S, E, tidx, wv); }
    if (l == 0) { LTID();
        const int G = (int)gridDim.x, T0 = moe_T_lds(), r1 = (8 * T0) % G; const ConvBounds cb = conv_bounds(G, T0);
        if (r1) { if (bidx >= r1) conv_moe(a, wv, 1, 0, cb.B1, bidx - r1, G - r1); } else conv_moe(a, wv, 1, 0, cb.B1, bidx, G);
    }
}
PHASE void ph_moe2(KA a, const int wv, int l) {
    {   LTID();
        moe_tiles(WSP(unsigned, WS_CTL) + CW_CNT + l * 32, tidx);
        MoeOrder<false> S; S.init(WSP(bf16_t, WS_ACT), WSP(bf16_t, WS_BT2) + (size_t)l * NEXP * DM * DFF, nullptr, DM, DFF, (size_t)DM * DFF * 2, gridDim.x, bidx);
        EpiMoe2 E{WSP(bf16_t, WS_MOUT), a->in[29] + (size_t)l * NEXP * DM};
        gemm_phase<EpiMoe2, MoeOrder<false>, false, true>(LDSP, DFF, S, E, tidx, wv); }
    if (l == 0) { LTID();
        const int G = (int)gridDim.x, T0 = moe_T_lds(), r2 = (4 * T0) % G; const ConvBounds cb = conv_bounds(G, T0);
        if (r2) { if (bidx >= r2) conv_moe(a, wv, 1, cb.B1, cb.B2, bidx - r2, G - r2); } else conv_moe(a, wv, 1, cb.B1, cb.B2, bidx, G);
    }
}
PHASE void ph_combine(KA a, const int wv, int l) { LTID();
    moe_tiles(WSP(unsigned, WS_CTL) + CW_CNT + l * 32, tidx);
    if (l == 0) p_rowfinish<true, false>(wv, WSP(float, WS_H), WSP(float, WS_H), WSP(bf16_t, WS_MOUT), WSP(int, WS_ESLOT), WSP(float, WS_TOPG), a->in[3] + DM, WSP(bf16_t, WS_XN16), nullptr);
    else p_rowfinish<true, true>(wv, WSP(float, WS_H), nullptr, WSP(bf16_t, WS_MOUT), WSP(int, WS_ESLOT), WSP(float, WS_TOPG), a->in[30], nullptr, a->out);
}

__global__ void __launch_bounds__(NT, 2) mega(Args args) {
    KA a = (KA)__builtin_amdgcn_kernarg_segment_ptr();
    int wv = __builtin_amdgcn_readfirstlane((int)threadIdx.x >> 6); asm volatile("" : "+s"(wv));
    LAS unsigned char* lds = LDSP;
    volatile LAS unsigned* MISC = (volatile LAS unsigned*)(lds + MISC_OFF);
    unsigned* ctl = (unsigned*)(a->ws + WS_CTL);
    if (threadIdx.x < 32) MISC[threadIdx.x] = 0u;
    __syncthreads();
    XcdBarrier bar; bar.bar = ctl + CW_BAR; bar.x = 0; bar.st = nullptr;
    if (!MK_PER_PHASE) bar = xcd_barrier_post(ctl + CW_BAR, MISC + 8);
    const int lo = a->ph_lo, hi = a->ph_hi;
#define IN(k) (lo <= (k) && (k) < hi)
#define SEAM(k) do { if (IN(k) && IN((k) + 1)) { LTID(); xcd_barrier(bar.bar, bar.x, bar.st, tidx == 0); if (PROBE_DUP == 200) xcd_barrier(bar.bar, bar.x, bar.st, tidx == 0); } } while (0)
    if (IN(0)) { ph_init(KAP(), wv); if (PROBE_DUP == 100) ph_init(KAP(), wv); }
    SEAM(0);
#define LAYER_PROGRAM(l) { const int pb = 1 + (l) * NPL; \
        if (IN(pb + 0)) { ph_gemm_in(KAP(), wv, (l)); if (PROBE_DUP == 0) { ph_gemm_in(KAP(), wv, (l)); } } \
        SEAM(pb + 0); \
        if (IN(pb + 1)) { ph_attn_s5a(KAP(), wv, (l)); if (PROBE_DUP == 1) { ph_attn_s5a(KAP(), wv, (l)); } } \
        SEAM(pb + 1); \
        if (IN(pb + 2)) { ph_s5b(KAP(), wv, (l)); if (PROBE_DUP == 2) { ph_s5b(KAP(), wv, (l)); } } \
        SEAM(pb + 2); \
        if (IN(pb + 3)) { ph_gemm_glu(KAP(), wv, (l)); if (PROBE_DUP == 3) { ph_gemm_glu(KAP(), wv, (l)); } } \
        SEAM(pb + 3); \
        if (IN(pb + 4)) { ph_mixnorm(KAP(), wv, (l)); if (PROBE_DUP == 4) { ph_mixnorm(KAP(), wv, (l)); } } \
        SEAM(pb + 4); \
        if (IN(pb + 5)) { ph_gemm_out(KAP(), wv, (l)); if (PROBE_DUP == 5) { ph_gemm_out(KAP(), wv, (l)); } } \
        SEAM(pb + 5); \
        if (IN(pb + 6)) { ph_gemm_xq(KAP(), wv, (l)); if (PROBE_DUP == 6) { ph_gemm_xq(KAP(), wv, (l)); } } \
        SEAM(pb + 6); \
        if (IN(pb + 7)) { ph_xattn(KAP(), wv, (l)); if (PROBE_DUP == 7) { ph_xattn(KAP(), wv, (l)); } } \
        SEAM(pb + 7); \
        if (IN(pb + 8)) { ph_gemm_xo(KAP(), wv, (l)); if (PROBE_DUP == 8) { ph_gemm_xo(KAP(), wv, (l)); } } \
        SEAM(pb + 8); \
        if (IN(pb + 9)) { ph_router(KAP(), wv, (l)); if (PROBE_DUP == 9) { ph_router(KAP(), wv, (l)); } } \
        SEAM(pb + 9); \
        if (IN(pb + 10)) { ph_moe1(KAP(), wv, (l)); if (PROBE_DUP == 10) { ph_moe1(KAP(), wv, (l)); } } \
        SEAM(pb + 10); \
        if (IN(pb + 11)) { ph_moe2(KAP(), wv, (l)); if (PROBE_DUP == 11) { ph_moe2(KAP(), wv, (l)); } } \
        SEAM(pb + 11); \
        if (IN(pb + 12)) { ph_combine(KAP(), wv, (l)); if (PROBE_DUP == 12) { ph_combine(KAP(), wv, (l)); } } \
        SEAM(pb + 12); }
    LAYER_PROGRAM(0)
    LAYER_PROGRAM(1)
#undef LAYER_PROGRAM
#undef IN
#undef SEAM
}

extern "C" void kernel_launch(void* const* d_in, const int* in_sizes, int n_in, void* d_out, int out_size, void* d_ws, size_t ws_size, hipStream_t stream) {
    static int grid = 0;
    if (grid == 0) {
        if (n_in != 31 || ws_size < WS_END) { fprintf(stderr, "kernel_launch: unexpected n_in %d or ws_size %zu (need %zu)\n", n_in, ws_size, (size_t)WS_END); grid = -1; return; }
        int dev = 0, cus = 0, per_cu = 0;
        if (hipGetDevice(&dev) != hipSuccess || hipDeviceGetAttribute(&cus, hipDeviceAttributeMultiprocessorCount, dev) != hipSuccess) { grid = -1; return; }
        if (hipFuncSetAttribute((const void*)mega, hipFuncAttributeMaxDynamicSharedMemorySize, LDS_BYTES) != hipSuccess) { fprintf(stderr, "kernel_launch: hipFuncSetAttribute failed\n"); grid = -1; return; }
        if (hipOccupancyMaxActiveBlocksPerMultiprocessor(&per_cu, (const void*)mega, NT, LDS_BYTES) != hipSuccess || per_cu < 1)
            fprintf(stderr, "kernel_launch: occupancy query reports %d workgroups per CU\n", per_cu);
        (void)hipGetLastError();
        grid = cus;
    }
    if (grid < 0) return;
    if (hipMemsetAsync((char*)d_ws + WS_CTL, 0, CTL_ZERO_BYTES, stream) != hipSuccess) return;
    Args a{};
    for (int i = 0; i < 31; ++i) a.in[i] = (const float*)d_in[i];
    a.out = (float*)d_out; a.ws = (unsigned char*)d_ws;
#if MK_PER_PHASE
    for (int p = 0; p < NPHASES; ++p) { a.ph_lo = p; a.ph_hi = p + 1; hipLaunchKernelGGL(mega, dim3(grid), dim3(NT), LDS_BYTES, stream, a); }
#else
    a.ph_lo = 0; a.ph_hi = NPHASES;
    hipLaunchKernelGGL(mega, dim3(grid), dim3(NT), LDS_BYTES, stream, a);
#endif
}
```

```cpp
#include <hip/hip_runtime.h>
#include <stdint.h>
#include <cstdio>

#ifndef PROBE_DUP
#define PROBE_DUP -1
#endif
#ifndef MK_PER_PHASE
#define MK_PER_PHASE 0
#endif

#define SEQ 16384
#define DM 1024
#define DIN 2048
#define NMEM 256
#define NEXP 32
#define TOPK 4
#define DFF 1024
#define NT 512
#define NW 8

#define LAS __attribute__((address_space(3)))
typedef float f32x4 __attribute__((ext_vector_type(4)));
typedef float f32x2 __attribute__((ext_vector_type(2)));
extern __shared__ __attribute__((aligned(16))) unsigned char lds_raw[];
#define LDSP ((LAS unsigned char*)lds_raw)
#define LTID() int z_ = 0; asm volatile("" : "+v"(z_)); const int lane_ = (int)__builtin_amdgcn_mbcnt_hi(~0u, __builtin_amdgcn_mbcnt_lo(~0u, (unsigned)z_)); \
    const int tidx = wv * 64 + lane_; int bidx = blockIdx.x; asm volatile("" : "+s"(bidx))
#define ROTB(rot) ((bidx + (int)gridDim.x - (rot) % (int)gridDim.x) % (int)gridDim.x)
__device__ __forceinline__ float shx(float v, int mask, int lane) { return __builtin_bit_cast(float, __builtin_amdgcn_ds_bpermute((lane ^ mask) << 2, __builtin_bit_cast(int, v))); }
__device__ __forceinline__ int shxi(int v, int mask, int lane) { return __builtin_amdgcn_ds_bpermute((lane ^ mask) << 2, v); }
constexpr int LDS_BYTES = 147456;
constexpr int MISC_OFF = 131072 + 320;

#define XB_TMO      128
#define XB_XCNT(j)  (256  + 64 * (j))
#define XB_XSUB(j)  (1280 + 64 * (j))
#define XB_XGEN(j)  (2304 + 64 * (j))
#define XB_TOP      3328
#define XB_TOPGEN   3392
#define XCD_BAR_WORDS 3456
#define XB_SPIN_CAP (1u << 18)

__device__ __forceinline__ unsigned xb_ld(unsigned* p)              { return __hip_atomic_load(p, __ATOMIC_RELAXED, __HIP_MEMORY_SCOPE_AGENT); }
__device__ __forceinline__ unsigned xb_add(unsigned* p, unsigned v) { return __hip_atomic_fetch_add(p, v, __ATOMIC_RELAXED, __HIP_MEMORY_SCOPE_AGENT); }
__device__ __forceinline__ unsigned xb_xcc_id() { return (unsigned)__builtin_amdgcn_s_getreg((3 << 11) | 20) & 0xFu; }
#define XB_SPIN(cond, bar) do { unsigned _sp = 0; while (cond) { __builtin_amdgcn_s_sleep(1); \
    if ((++_sp & 255u) == 0u) { if (xb_ld(&(bar)[XB_TMO])) break; if (_sp > XB_SPIN_CAP) { atomicAdd(&(bar)[XB_TMO], 1u); break; } } } } while (0)

struct XcdBarrier {
    unsigned* bar; unsigned x;
    volatile LAS unsigned* st;
};
__device__ __forceinline__ XcdBarrier xcd_barrier_post(unsigned* bar, volatile LAS unsigned* st) {
    XcdBarrier b; b.bar = bar; b.x = xb_xcc_id(); b.st = st;
    if (threadIdx.x == 0) (void)xb_add(&bar[XB_XCNT(b.x)], 1u);
    return b;
}
__device__ __forceinline__ void xcd_barrier_complete(unsigned* bar, unsigned x, unsigned& nloc, unsigned& nx) {
    const unsigned G = gridDim.x * gridDim.y * gridDim.z;
    unsigned sum, cnt, mine, sp = 0u;
    for (;;) {
        sum = 0u; cnt = 0u; mine = 0u;
#pragma unroll
        for (unsigned j = 0; j < 16; ++j) { const unsigned c = xb_ld(&bar[XB_XCNT(j)]); sum += c; cnt += (c > 0u) ? 1u : 0u; mine = (j == x) ? c : mine; }
        if (sum == G) break;
        __builtin_amdgcn_s_sleep(1);
        if ((++sp & 255u) == 0u) { if (xb_ld(&bar[XB_TMO])) break; if (sp > XB_SPIN_CAP) { atomicAdd(&bar[XB_TMO], 1u); break; } }
    }
    nloc = mine > 0u ? mine : 1u; nx = cnt > 0u ? cnt : 1u;
}
__device__ __noinline__ void xcd_barrier(unsigned* bar_, unsigned x_, volatile LAS unsigned* st_, int is_t0) {
    XcdBarrier b; b.bar = bar_; b.x = x_; b.st = st_;
    asm volatile("s_waitcnt vmcnt(0)" ::: "memory");
    __syncthreads();
    if (is_t0) {
        unsigned* bar = b.bar;
        __builtin_amdgcn_s_waitcnt(0);
        unsigned nloc = b.st[0], nx = b.st[1];
        if (nloc == 0u) { xcd_barrier_complete(bar, b.x, nloc, nx); b.st[0] = nloc; b.st[1] = nx; }
        const unsigned old = xb_add(&bar[XB_XSUB(b.x)], 1u);
        const unsigned gen = old / nloc;
        if (old + 1u == (gen + 1u) * nloc) {
            __builtin_amdgcn_fence(__ATOMIC_RELEASE, "agent");
            asm volatile("s_waitcnt vmcnt(0)" ::: "memory");
            const unsigned og = xb_add(&bar[XB_TOP], 1u);
            const unsigned tg = og / nx;
            if (og + 1u == (tg + 1u) * nx) xb_add(&bar[XB_TOPGEN], 1u);
            else XB_SPIN(xb_ld(&bar[XB_TOPGEN]) == tg, bar);
            __builtin_amdgcn_fence(__ATOMIC_ACQUIRE, "agent");
            xb_add(&bar[XB_XGEN(b.x)], 1u);
            asm volatile("s_waitcnt vmcnt(0)" ::: "memory");
        } else {
            XB_SPIN(xb_ld(&bar[XB_XGEN(b.x)]) == gen, bar);
            __builtin_amdgcn_fence(__ATOMIC_ACQUIRE, "agent");
            asm volatile("s_waitcnt vmcnt(0)" ::: "memory");
        }
    }
    __syncthreads();
}

constexpr size_t MiB = 1u << 20;
constexpr size_t WS_CTL = 0, CTL_ZERO_BYTES = 1 * MiB;
constexpr int CW_BAR = 4096;
constexpr int CW_CNT = 8192;
constexpr int MOE_ROWS = SEQ * TOPK + NEXP * 256;
constexpr int ECAP = SEQ;
constexpr size_t al256(size_t x) { return (x + 255) & ~(size_t)255; }
constexpr size_t WS_H = 2 * MiB;
constexpr size_t WS_XN16 = WS_H + (size_t)SEQ * DM * 4;
constexpr size_t WS_HB16 = WS_XN16 + (size_t)SEQ * DM * 2;
constexpr size_t WS_PROJ16 = WS_HB16 + (size_t)SEQ * DM * 2;
constexpr size_t WS_OBR = WS_PROJ16 + (size_t)SEQ * 2048 * 2;
constexpr size_t WS_LSE = WS_OBR + 3 * (size_t)SEQ * 512 * 2;
constexpr size_t WS_YG16 = WS_LSE + 3 * (size_t)SEQ * 8 * 4;
constexpr size_t WS_YB16 = WS_YG16 + (size_t)SEQ * 512 * 2;
constexpr size_t WS_MIX16 = WS_YB16 + (size_t)SEQ * 512 * 2;
constexpr size_t WS_QX16 = WS_MIX16 + (size_t)SEQ * DM * 2;
constexpr size_t WS_OX16 = WS_QX16 + (size_t)SEQ * 512 * 2;
constexpr size_t WS_ACT = WS_OX16 + (size_t)SEQ * 512 * 2;
constexpr size_t WS_MOUT = WS_ACT + (size_t)MOE_ROWS * DFF * 2;
constexpr size_t WS_BT1 = WS_MOUT + (size_t)MOE_ROWS * DM * 2;
constexpr size_t WS_BT2 = WS_BT1 + 2 * (size_t)NEXP * 2048 * DM * 2;
constexpr size_t WS_WT_IN = WS_BT2 + 2 * (size_t)NEXP * DM * DFF * 2;
constexpr size_t WS_WT_GLU = WS_WT_IN + 2 * (size_t)2048 * 1024 * 2;
constexpr size_t WS_WT_OUT = WS_WT_GLU + 2 * (size_t)512 * 512 * 2;
constexpr size_t WS_WT_XQ = WS_WT_OUT + 2 * (size_t)1024 * 1024 * 2;
constexpr size_t WS_WT_XKV = WS_WT_XQ + 2 * (size_t)512 * 1024 * 2;
constexpr size_t WS_WT_XO = WS_WT_XKV + 2 * (size_t)1024 * 1024 * 2;
constexpr size_t WS_MEMN16 = WS_WT_XO + 2 * (size_t)1024 * 512 * 2;
constexpr size_t WS_KV16 = WS_MEMN16 + 2 * (size_t)NMEM * 1024 * 2;
constexpr size_t WS_WR16 = WS_KV16 + 2 * (size_t)NMEM * 1024 * 2;
constexpr size_t WS_BIASG = WS_WR16 + 2 * 2 * (size_t)32 * 1024 * 2;
constexpr size_t WS_ABAR = al256(WS_BIASG + 24 * 132 * 4);
constexpr size_t WS_A256 = WS_ABAR + 2 * 2048 * 8;
constexpr size_t WS_BB16 = WS_A256 + 2 * 2048 * 8;
constexpr size_t WS_CM16 = WS_BB16 + 2 * (size_t)32 * 128 * 16 * 2;
constexpr size_t WS_E2 = WS_CM16 + 2 * (size_t)32 * 16 * 128 * 2;
constexpr size_t WS_ROWTOK = WS_E2 + (size_t)64 * 2048 * 8;
constexpr size_t WS_RSC = WS_ROWTOK + (size_t)NEXP * ECAP * 4;
constexpr size_t WS_ESLOT = WS_RSC + (size_t)NEXP * ECAP * 4;
constexpr size_t WS_TOPG = WS_ESLOT + (size_t)SEQ * 4 * 4;
constexpr size_t WS_SSP = WS_TOPG + (size_t)SEQ * 4 * 4;
constexpr size_t WS_END = WS_SSP + (size_t)SEQ * 16 * 4;

struct Args { const float* in[31]; float* out; unsigned char* ws; int ph_lo, ph_hi; };


typedef unsigned short bf16_t;
typedef short bf16x8 __attribute__((ext_vector_type(8)));
typedef unsigned u32x4 __attribute__((ext_vector_type(4)));
typedef unsigned u32x2 __attribute__((ext_vector_type(2)));
constexpr int BM = 256, BK = 64, HALF = 128, HTB = HALF * BK * 2, STAGE_BYTES = 8 * HTB, NXCD = 8, WGM = 8;
__host__ __device__ __forceinline__ int lds_byte(int r, int c) { const int st = (r >> 4) * 2 + (c >> 5), rr = r & 15, cc = c & 31, ob = rr * 64 + cc * 2; return st * 1024 + (ob ^ (((ob >> 9) & 1) << 5)); }
__host__ __device__ __forceinline__ void stage_rc(int b, int& R, int& C) { const int st = b / 1024, sb = b % 1024, swz = sb ^ (((sb >> 9) & 1) << 5); R = (st >> 1) * 16 + swz / 64; C = (st & 1) * 32 + (swz % 64) / 2; }
__host__ __device__ __forceinline__ int perm32(int rho) { const int n = rho >> 4, i = rho & 15; return 8 * (i >> 2) + 4 * n + (i & 3); }
__device__ __forceinline__ unsigned cvt_pk_bf16(float lo, float hi) { unsigned r; asm volatile("v_cvt_pk_bf16_f32 %0, %1, %2" : "=v"(r) : "v"(lo), "v"(hi)); return r; }
__device__ __forceinline__ unsigned f2bf(float f) { unsigned u = __builtin_bit_cast(unsigned, f); return (u + 0x7fffu + ((u >> 16) & 1u)) >> 16; }
__device__ __forceinline__ unsigned pk2(float lo, float hi) { return f2bf(lo) | (f2bf(hi) << 16); }
__device__ __forceinline__ float bf2f(unsigned short b) { return __builtin_bit_cast(float, ((unsigned)b) << 16); }

__device__ __forceinline__ void glds16s(const void* sbase, unsigned voff, unsigned lds_dst) {
    unsigned keep;
    asm volatile("s_mov_b32 %0, m0\n\ts_mov_b32 m0, %3\n\ts_nop 0\n\tglobal_load_lds_dwordx4 %1, %2\n\ts_mov_b32 m0, %0" : "=&s"(keep) : "v"(voff), "s"(sbase), "s"(lds_dst) : "memory");
}
struct GUnit { const char* A; const char* B; int pm, pn, e, row0, cnt; };

struct DenseOrder {
    const char* A; const char* Bt; int nM, nN, nwg, G, c, K;
    __device__ __forceinline__ void init(const bf16_t* A_, const bf16_t* Bt_, int M, int N, int K_, int G_, int c_) { A = (const char*)A_; Bt = (const char*)Bt_; nM = M / BM; nN = N / BM; nwg = nM * nN; G = G_; c = c_; K = K_; }
    __device__ __forceinline__ bool next(int i, GUnit& u) const {
        const long L = (long)i * G + c; if (L >= nwg) return false;
        int wgid = (int)L; { const int q = nwg / NXCD, r = nwg % NXCD, xcd = wgid % NXCD, off = wgid / NXCD; wgid = (xcd < r ? xcd * (q + 1) : r * (q + 1) + (xcd - r) * q) + off; }
        const int nig = WGM * nN, gid = wgid / nig, fm = gid * WGM, gsz = (nM - fm) < WGM ? (nM - fm) : WGM;
        u.pm = fm + ((wgid % nig) % gsz); u.pn = (wgid % nig) / gsz; u.e = 0; u.row0 = 0; u.cnt = 0;
        u.A = A + (size_t)u.pm * BM * K * 2; u.B = Bt + (size_t)u.pn * BM * K * 2; return true;
    }
    __device__ __forceinline__ unsigned aoff(const GUnit&, int row) const { return (unsigned)(row * K * 2); }
    __device__ __forceinline__ unsigned tokoff(const GUnit&, int) const { return 0u; }
    __device__ __forceinline__ const int* tokbase() const { return nullptr; }
};

struct EpiF32 {
    static constexpr bool PERM = false;
    float* C; int ldc; int resid;
    __device__ __forceinline__ void operator()(const f32x4 (&acc)[2][2][4][2], const GUnit& u, int wr, int wc, int fr, int fq) const {
        const int row0 = u.pm * BM + wr * 64 + fr, col0 = u.pn * BM + wc * 32 + 4 * fq;
#pragma unroll
        for (int ai = 0; ai < 2; ++ai)
#pragma unroll
            for (int m = 0; m < 4; ++m) { float* rowp = C + (size_t)(row0 + ai * HALF + m * 16) * ldc + col0;
#pragma unroll
                for (int bj = 0; bj < 2; ++bj)
#pragma unroll
                    for (int n = 0; n < 2; ++n) { f32x4 v = acc[ai][bj][m][n]; if (resid) v += *(const f32x4*)(rowp + bj * HALF + n * 16); *(f32x4*)(rowp + bj * HALF + n * 16) = v; } }
    }
};
struct EpiGlu {
    static constexpr bool PERM = false;
    float* C; const float* Y; int ldc; const float* bias;
    __device__ __forceinline__ void operator()(const f32x4 (&acc)[2][2][4][2], const GUnit& u, int wr, int wc, int fr, int fq) const {
        const int row0 = u.pm * BM + wr * 64 + fr, col0 = u.pn * BM + wc * 32 + 4 * fq;
#pragma unroll
        for (int ai = 0; ai < 2; ++ai)
#pragma unroll
            for (int m = 0; m < 4; ++m) { const size_t ro = (size_t)(row0 + ai * HALF + m * 16) * ldc + col0;
#pragma unroll
                for (int bj = 0; bj < 2; ++bj)
#pragma unroll
                    for (int n = 0; n < 2; ++n) { const f32x4 b = *(const f32x4*)(bias + col0 + bj * HALF + n * 16); const f32x4 y = *(const f32x4*)(Y + ro + bj * HALF + n * 16);
                        f32x4 v = acc[ai][bj][m][n] + b; f32x4 o;
#pragma unroll
                        for (int j = 0; j < 4; ++j) o[j] = y[j] / (1.f + __expf(-v[j]));
                        *(f32x4*)(C + ro + bj * HALF + n * 16) = o; } }
    }
};

template <class Epi, class Sched, bool GATHER, bool ALIGN_EPI>
__device__ __forceinline__ void gemm_phase(LAS unsigned char* lds, const int K, const Sched& S, const Epi& E, const int tid, const int wv) {
    const int wid = wv, lane = tid & 63, wr = wid >> 2, wc = wid & 3, fr = lane & 15, fq = lane >> 4;
    const int nt = K / BK;
    unsigned voffB[2];
#pragma unroll
    for (int i = 0; i < 2; ++i) { int R, C; stage_rc(tid * 16 + i * 8192, R, C); const int Rb = Epi::PERM ? ((R & ~31) + perm32(R & 31)) : R; voffB[i] = (unsigned)(Rb * K + C) * 2u; }
#define PG8_AOFFS(dst, u) do { int t2_ = tid; asm volatile("" : "+v"(t2_)); _Pragma("unroll") for (int i = 0; i < 2; ++i) { int R, C; stage_rc(t2_ * 16 + i * 8192, R, C); \
        _Pragma("unroll") for (int h = 0; h < 2; ++h) dst[h][i] = S.aoff(u, h * HALF + R) + (unsigned)C * 2u; } } while (0)
    const size_t kstep = (size_t)(BK * 2);
    const size_t hstep = (size_t)HALF * K * 2;
    const unsigned ldsw = (unsigned)wid * 1024u;
    const int aoff = lds_byte(wr * 64 + fr, fq * 8), boff = lds_byte(wc * 32 + fr, fq * 8);
#define PG8_SA(b, h) (((b) * 2 + (h)) * HTB)
#define PG8_SB(b, h) ((4 + (b) * 2 + (h)) * HTB)
#define PG8_STAGE(bufoff, gbase, v0, v1) do { const unsigned ld_ = (unsigned)(size_t)(lds + (bufoff) + ldsw); glds16s((gbase), (v0), ld_); glds16s((gbase), (v1), ld_ + 8192u); } while (0)
#define PG8_LDA(dst, b, h) do { _Pragma("unroll") for (int m = 0; m < 4; ++m) _Pragma("unroll") for (int k = 0; k < 2; ++k) dst[m][k] = *(const LAS bf16x8*)(lds + PG8_SA(b, h) + aoff + m * 2048 + k * 1024); } while (0)
#define PG8_LDB(dst, b, h) do { _Pragma("unroll") for (int n = 0; n < 2; ++n) _Pragma("unroll") for (int k = 0; k < 2; ++k) dst[n][k] = *(const LAS bf16x8*)(lds + PG8_SB(b, h) + boff + n * 2048 + k * 1024); } while (0)
#define PG8_MMA(ai, bj, At, Bt) do { __builtin_amdgcn_s_setprio(1); _Pragma("unroll") for (int m = 0; m < 4; ++m) _Pragma("unroll") for (int n = 0; n < 2; ++n) _Pragma("unroll") for (int k = 0; k < 2; ++k) \
        acc[ai][bj][m][n] = __builtin_amdgcn_mfma_f32_16x16x32_bf16(Bt[n][k], At[m][k], acc[ai][bj][m][n], 0, 0, 0); __builtin_amdgcn_s_setprio(0); } while (0)
#define PG8_WAIT_V(n) asm volatile("s_waitcnt vmcnt(" #n ")" ::: "memory")
#define PG8_WAIT_L(n) asm volatile("s_waitcnt lgkmcnt(" #n ")" ::: "memory")
#define PG8_BAR __builtin_amdgcn_s_barrier()
#define PG8_SCHED __builtin_amdgcn_sched_barrier(0)
    GUnit cur, nxt; int ui = 0;
    if (!S.next(0, cur)) return;
    f32x4 acc[2][2][4][2];
#pragma unroll
    for (int a = 0; a < 2; ++a)
#pragma unroll
        for (int b = 0; b < 2; ++b)
#pragma unroll
            for (int m = 0; m < 4; ++m)
#pragma unroll
                for (int n = 0; n < 2; ++n) acc[a][b][m][n] = (f32x4){0.f, 0.f, 0.f, 0.f};
    bf16x8 At[4][2], B0[2][2], B1[2][2];
    unsigned vA[2][2], vN[2][2];
    PG8_AOFFS(vA, cur);
#pragma unroll
    for (int h = 0; h < 2; ++h)
#pragma unroll
        for (int i = 0; i < 2; ++i) vN[h][i] = vA[h][i];
    const char* cA = cur.A; const char* cB = cur.B;
    PG8_STAGE(PG8_SB(0, 0), cB, voffB[0], voffB[1]); PG8_STAGE(PG8_SB(0, 1), cB + hstep, voffB[0], voffB[1]); PG8_STAGE(PG8_SA(0, 0), cA, vA[0][0], vA[0][1]); PG8_STAGE(PG8_SA(0, 1), cA, vA[1][0], vA[1][1]);
    if (wr == 1) PG8_BAR;
    PG8_WAIT_V(2); PG8_BAR;
    PG8_STAGE(PG8_SB(1, 0), cB + kstep, voffB[0], voffB[1]); PG8_STAGE(PG8_SA(1, 0), cA + kstep, vA[0][0], vA[0][1]); PG8_STAGE(PG8_SB(1, 1), cB + hstep + kstep, voffB[0], voffB[1]);
    PG8_WAIT_V(6); PG8_BAR;
    for (;;) {
        const bool has_next = S.next(ui + 1, nxt);
        const char* nA = GATHER ? cA : (has_next ? nxt.A : cA); const char* nB = has_next ? nxt.B : cB;
        unsigned tok_[2][2] = {{0u, 0u}, {0u, 0u}};
#define PG8_KBODY(a1, a2, b2, a3, b3, W00, W01, W10, W11) do { \
              \
            PG8_LDB(B0, 0, 0); PG8_LDB(B1, 0, 1); PG8_SCHED; PG8_LDA(At, 0, 0); PG8_STAGE(PG8_SA(1, 1), a1, vA[1][0], vA[1][1]); \
            PG8_WAIT_V(8); PG8_WAIT_L(0); PG8_BAR; PG8_MMA(0, 0, At, B0); PG8_MMA(0, 1, At, B1); PG8_BAR; PG8_SCHED; \
              \
            PG8_LDA(At, 0, 1); PG8_STAGE(PG8_SB(0, 0), b2, voffB[0], voffB[1]); PG8_STAGE(PG8_SB(0, 1), (b2) + hstep, voffB[0], voffB[1]); PG8_STAGE(PG8_SA(0, 0), a2, W00, W01); \
            PG8_WAIT_V(8); PG8_WAIT_L(0); PG8_BAR; PG8_MMA(1, 0, At, B0); PG8_MMA(1, 1, At, B1); PG8_BAR; PG8_SCHED; \
              \
            PG8_LDB(B0, 1, 0); PG8_LDB(B1, 1, 1); PG8_SCHED; PG8_LDA(At, 1, 0); PG8_STAGE(PG8_SA(0, 1), a2, W10, W11); \
            PG8_WAIT_V(8); PG8_WAIT_L(0); PG8_BAR; PG8_MMA(0, 0, At, B0); PG8_MMA(0, 1, At, B1); PG8_BAR; PG8_SCHED; \
              \
            PG8_LDA(At, 1, 1); PG8_STAGE(PG8_SB(1, 0), b3, voffB[0], voffB[1]); PG8_STAGE(PG8_SB(1, 1), (b3) + hstep, voffB[0], voffB[1]); PG8_STAGE(PG8_SA(1, 0), a3, W00, W01); \
            PG8_WAIT_V(8); PG8_WAIT_L(0); PG8_BAR; PG8_MMA(1, 0, At, B0); PG8_MMA(1, 1, At, B1); PG8_BAR; PG8_SCHED; } while (0)
        for (int t = 0; t < nt - 2; t += 2) {
            const char* a1 = cA + (size_t)(t + 1) * kstep;
            const char* a2 = cA + (size_t)(t + 2) * kstep; const char* b2 = cB + (size_t)(t + 2) * kstep;
            const char* a3 = a2 + kstep; const char* b3 = b2 + kstep;
            if (GATHER) { if (t == nt - 4 && has_next) { int t2_ = tid; asm volatile("" : "+v"(t2_));
#pragma unroll
                for (int i = 0; i < 2; ++i) { int R, C; stage_rc(t2_ * 16 + i * 8192, R, C);
#pragma unroll
                    for (int h = 0; h < 2; ++h) { const unsigned vo = S.tokoff(nxt, h * HALF + R); asm volatile("global_load_dword %0, %1, %2" : "=v"(tok_[h][i]) : "v"(vo), "s"(S.tokbase()) : "memory"); } } } }
            PG8_KBODY(a1, a2, b2, a3, b3, vA[0][0], vA[0][1], vA[1][0], vA[1][1]);
        }
        if (GATHER) {
            if (has_next) { int t2_ = tid; asm volatile("" : "+v"(t2_), "+v"(tok_[0][0]), "+v"(tok_[0][1]), "+v"(tok_[1][0]), "+v"(tok_[1][1]));
#pragma unroll
                for (int i = 0; i < 2; ++i) { int R, C; stage_rc(t2_ * 16 + i * 8192, R, C);
#pragma unroll
                    for (int h = 0; h < 2; ++h) vN[h][i] = tok_[h][i] * (unsigned)(K * 2) + (unsigned)C * 2u; } }
            else {
#pragma unroll
                for (int h = 0; h < 2; ++h)
#pragma unroll
                    for (int i = 0; i < 2; ++i) vN[h][i] = vA[h][i];
            }
        }
        {
            const char* a1 = cA + (size_t)(nt - 1) * kstep;
            const char* a3 = nA + kstep; const char* b3 = nB + kstep;
            PG8_KBODY(a1, nA, nB, a3, b3, vN[0][0], vN[0][1], vN[1][0], vN[1][1]);
        }
#undef PG8_KBODY
        if constexpr (ALIGN_EPI) { if (wr == 0) PG8_BAR; }
        { int t3_ = tid; asm volatile("" : "+v"(t3_)); const int l3_ = t3_ & 63; E(acc, cur, wr, wc, l3_ & 15, l3_ >> 4); }
        if (!has_next) break;
#pragma unroll
        for (int a = 0; a < 2; ++a)
#pragma unroll
            for (int b = 0; b < 2; ++b)
#pragma unroll
                for (int m = 0; m < 4; ++m)
#pragma unroll
                    for (int n = 0; n < 2; ++n) acc[a][b][m][n] = (f32x4){0.f, 0.f, 0.f, 0.f};
        cur = nxt; cA = nA; cB = nB; ++ui;
        if (GATHER) {
#pragma unroll
            for (int h = 0; h < 2; ++h)
#pragma unroll
                for (int i = 0; i < 2; ++i) vA[h][i] = vN[h][i];
        }
        if constexpr (ALIGN_EPI) { if (wr == 1) PG8_BAR; }
    }
    PG8_WAIT_V(0);
    if constexpr (!ALIGN_EPI) { if (wr == 0) PG8_BAR; }
    PG8_BAR;
#undef PG8_AOFFS
#undef PG8_SA
#undef PG8_SB
#undef PG8_STAGE
#undef PG8_LDA
#undef PG8_LDB
#undef PG8_MMA
#undef PG8_WAIT_V
#undef PG8_WAIT_L
#undef PG8_BAR
#undef PG8_SCHED
}


constexpr int TS_OFF = 131072 + 1024;
template <bool GATHER> struct MoeOrder {
    const char* A; const char* Bt; const int* rowtok; int nN, nwg, nM, G, c, K; size_t strideE;
    __device__ __forceinline__ void init(const bf16_t* A_, const bf16_t* Bt_, const int* rowtok_, int N, int K_, size_t strideE_, int G_, int c_) {
        A = (const char*)A_; Bt = (const char*)Bt_; rowtok = rowtok_; nN = N / BM; K = K_; strideE = strideE_; G = G_; c = c_;
        nM = __builtin_amdgcn_readfirstlane(((LAS const int*)(LDSP + TS_OFF))[32]); nwg = nM * nN; }
    __device__ __forceinline__ bool next(int i, GUnit& u) const {
        const long L = (long)i * G + c; if (L >= nwg) return false;
        int wgid = (int)L; { const int q = nwg / NXCD, r = nwg % NXCD, xcd = wgid % NXCD, off = wgid / NXCD; wgid = (xcd < r ? xcd * (q + 1) : r * (q + 1) + (xcd - r) * q) + off; }
        const int nig = WGM * nN, gid = wgid / nig, fm = gid * WGM, gsz = (nM - fm) < WGM ? (nM - fm) : WGM;
        u.pm = fm + ((wgid % nig) % gsz); u.pn = (wgid % nig) / gsz;
        LAS const int* ts = (LAS const int*)(LDSP + TS_OFF);
        const int e = __builtin_amdgcn_readfirstlane(ts[72 + u.pm]);
        u.e = e; u.row0 = (u.pm - __builtin_amdgcn_readfirstlane(ts[e])) * BM; u.cnt = __builtin_amdgcn_readfirstlane(ts[33 + e]);
        u.A = GATHER ? A : A + (size_t)u.pm * BM * K * 2;
        u.B = Bt + (size_t)e * strideE + (size_t)u.pn * BM * K * 2; return true;
    }
    __device__ __forceinline__ unsigned aoff(const GUnit& u, int row) const {
        if (GATHER) { int sl = u.row0 + row; sl = sl < u.cnt ? sl : u.cnt - 1; return (unsigned)rowtok[u.e * ECAP + sl] * (unsigned)(K * 2); }
        return (unsigned)(row * K * 2);
    }
    __device__ __forceinline__ unsigned tokoff(const GUnit& u, int row) const { int sl = u.row0 + row; sl = sl < u.cnt ? sl : u.cnt - 1; return (unsigned)(u.e * ECAP + sl) * 4u; }
    __device__ __forceinline__ const int* tokbase() const { return rowtok; }
};
__device__ __forceinline__ void moe_tiles(const unsigned* cnt, int tid) {
    LAS int* ts = (LAS int*)(LDSP + TS_OFF);
    if (tid == 0) { int s = 0; for (int e = 0; e < NEXP; ++e) { const int c = (int)cnt[e]; ts[e] = s; ts[33 + e] = c; const int n = (c + BM - 1) / BM;
_Pragma("clang loop vectorize(disable) unroll(disable)") for (int t = 0; t < n; ++t) ts[72 + s + t] = e;
            s += n; } ts[NEXP] = s; }
    __syncthreads();
}
struct EpiMoe1 {
    static constexpr bool PERM = true;
    bf16_t* O; const float* b1; const float* rsc;
    __device__ __forceinline__ void operator()(const f32x4 (&acc)[2][2][4][2], const GUnit& u, int wr, int wc, int fr, int fq) const {
        const int rt0 = wr * 64 + fr, col0 = u.pn * 128 + wc * 32 + 8 * fq;
        const float* bg = b1 + (size_t)u.e * 2048 + col0;
        f32x4 bgv[2], blv[2];
#pragma unroll
        for (int n = 0; n < 2; ++n) { bgv[n] = *(const f32x4*)(bg + 4 * n); blv[n] = *(const f32x4*)(bg + DFF + 4 * n); }
#pragma unroll
        for (int ai = 0; ai < 2; ++ai)
#pragma unroll
            for (int m = 0; m < 4; ++m) {
                const int rt = rt0 + ai * HALF + m * 16; int sl = u.row0 + rt; sl = sl < u.cnt ? sl : u.cnt - 1;
                const float r = rsc[u.e * ECAP + sl];
                float o[8];
                const f32x2 r2 = (f32x2){r, r};
#pragma unroll
                for (int n = 0; n < 2; ++n)
#pragma unroll
                    for (int jp = 0; jp < 2; ++jp) {
                        const f32x2 ag = (f32x2){acc[ai][0][m][n][2 * jp], acc[ai][0][m][n][2 * jp + 1]}, al = (f32x2){acc[ai][1][m][n][2 * jp], acc[ai][1][m][n][2 * jp + 1]};
                        f32x2 g = ag * r2 + (f32x2){bgv[n][2 * jp], bgv[n][2 * jp + 1]}, l = al * r2 + (f32x2){blv[n][2 * jp], blv[n][2 * jp + 1]};
                        g.x = fminf(g.x, 7.f); g.y = fminf(g.y, 7.f);
                        l.x = __builtin_amdgcn_fmed3f(l.x, -7.f, 7.f); l.y = __builtin_amdgcn_fmed3f(l.y, -7.f, 7.f);
                        const f32x2 z = g * (-2.4554669595930157f);
                        f32x2 e; e.x = __builtin_amdgcn_exp2f(z.x); e.y = __builtin_amdgcn_exp2f(z.y);
                        e = e + 1.0f;
                        f32x2 q; q.x = __builtin_amdgcn_rcpf(e.x); q.y = __builtin_amdgcn_rcpf(e.y);
                        const f32x2 v = (g * q) * (l + 1.0f);
                        o[n * 4 + 2 * jp] = v.x; o[n * 4 + 2 * jp + 1] = v.y;
                    }
                u32x4 w; w.x = cvt_pk_bf16(o[0], o[1]); w.y = cvt_pk_bf16(o[2], o[3]); w.z = cvt_pk_bf16(o[4], o[5]); w.w = cvt_pk_bf16(o[6], o[7]);
                *(u32x4*)(O + (size_t)(u.pm * BM + rt) * DFF + col0) = w;
            }
    }
};
struct EpiMoe2 {
    static constexpr bool PERM = true;
    bf16_t* O; const float* b2;
    __device__ __forceinline__ void operator()(const f32x4 (&acc)[2][2][4][2], const GUnit& u, int wr, int wc, int fr, int fq) const {
        const int row0 = u.pm * BM + wr * 64 + fr, col0 = u.pn * BM + wc * 32 + 8 * fq;
        f32x4 bv[2][2];
#pragma unroll
        for (int bj = 0; bj < 2; ++bj)
#pragma unroll
            for (int n = 0; n < 2; ++n) bv[bj][n] = *(const f32x4*)(b2 + (size_t)u.e * DM + col0 + bj * HALF + 4 * n);
#pragma unroll
        for (int ai = 0; ai < 2; ++ai)
#pragma unroll
            for (int m = 0; m < 4; ++m) { bf16_t* rowp = O + (size_t)(row0 + ai * HALF + m * 16) * DM + col0;
#pragma unroll
                for (int bj = 0; bj < 2; ++bj) { const f32x4 v0 = acc[ai][bj][m][0] + bv[bj][0], v1 = acc[ai][bj][m][1] + bv[bj][1];
                    u32x4 w; w.x = cvt_pk_bf16(v0[0], v0[1]); w.y = cvt_pk_bf16(v0[2], v0[3]); w.z = cvt_pk_bf16(v1[0], v1[1]); w.w = cvt_pk_bf16(v1[2], v1[3]);
                    *(u32x4*)(rowp + bj * HALF) = w; } }
    }
};

__device__ __forceinline__ void p_transpose_r(const int wv, const float* W, int nmat, int K, int N, bf16_t* WT, const float* kgain, int gdiv, int mode, LAS unsigned char* lds, int it_begin, int it_end, int wrank, int wstride) {
    LTID();
    const int wave = wv, lane = tidx & 63;
    LAS float* scr = (LAS float*)(lds + wave * 16384);
    const int nblk = N / 32, per_mat = (K / 64) * nblk, total = it_end, stride = wstride;
    const int lrow = lane >> 5, lcol = lane & 31;
#define TR_DECODE(item, mat_, kb_, nb_) const int mat_ = (item) / per_mat, r_ = (item) - mat_ * per_mat, g8_ = r_ >> 3, l8_ = r_ & 7, kb_ = 2 * (g8_ / (nblk >> 2)) + (l8_ & 1), nb_ = 4 * (g8_ % (nblk >> 2)) + (l8_ >> 1)
#define TR_ISSUE(item, dst) do { TR_DECODE(item, mat_, kb_, nb_); \
        const float* src_ = W + (size_t)mat_ * K * N + (size_t)(64 * kb_ + lrow) * N + 32 * nb_ + lcol; \
        _Pragma("unroll") for (int i = 0; i < 32; ++i) dst[i] = __builtin_nontemporal_load(src_ + (size_t)(2 * i) * N); } while (0)
    float v[32], vn[32], vnn[32];
    int it = it_begin + wrank;
    if (it < total) TR_ISSUE(it, v);
    if (it + stride < total) TR_ISSUE(it + stride, vn);
    while (it < total) {
        const int itn = it + stride, itnn = itn + stride;
        if (itnn < total) TR_ISSUE(itnn, vnn);
        TR_DECODE(it, mat, kb, nb); const int k0 = 64 * kb, n0 = 32 * nb;
#pragma unroll
        for (int i = 0; i < 32; ++i) scr[(2 * i + lrow) * 33 + lcol] = v[i];
        asm volatile("s_waitcnt lgkmcnt(0)" ::: "memory");
        int d0 = n0;
        if (mode == 1) { const int bj = n0 >> 10, rest = n0 & 1023, pn = rest >> 7, j = rest & 127; d0 = pn * 256 + bj * 128 + j; }
        const int c = lane & 7;
        f32x4 g0 = (f32x4){1.f, 1.f, 1.f, 1.f}, g1 = g0;
        if (kgain) { const float* gp = kgain + (size_t)(mat / gdiv) * DM + k0 + 8 * c; g0 = *(const f32x4*)gp; g1 = *(const f32x4*)(gp + 4); }
        bf16_t* dst = WT + (size_t)mat * K * N;
#pragma unroll
        for (int j = 0; j < 4; ++j) { const int n = (lane >> 3) + 8 * j; const LAS float* sp = scr + (8 * c) * 33 + n;
            u32x4 o; o.x = cvt_pk_bf16(sp[0 * 33] * g0[0], sp[1 * 33] * g0[1]); o.y = cvt_pk_bf16(sp[2 * 33] * g0[2], sp[3 * 33] * g0[3]); o.z = cvt_pk_bf16(sp[4 * 33] * g1[0], sp[5 * 33] * g1[1]); o.w = cvt_pk_bf16(sp[6 * 33] * g1[2], sp[7 * 33] * g1[3]);
            __builtin_nontemporal_store(o, (u32x4*)(dst + (size_t)(d0 + n) * K + k0 + 8 * c)); }
        asm volatile("s_waitcnt lgkmcnt(0)" ::: "memory");
#pragma unroll
        for (int i = 0; i < 32; ++i) { v[i] = vn[i]; vn[i] = vnn[i]; }
        it = itn;
    }
#undef TR_ISSUE
#undef TR_DECODE
}
__device__ __forceinline__ void p_transpose(const int wv, const float* W, int nmat, int K, int N, bf16_t* WT, const float* kgain, int gdiv, int mode, LAS unsigned char* lds, int rot) {
    const int G_ = (int)gridDim.x, b_ = ((int)blockIdx.x + G_ - rot % G_) % G_;
    p_transpose_r(wv, W, nmat, K, N, WT, kgain, gdiv, mode, lds, 0, nmat * (K / 64) * (N / 32), b_ * NW + wv, G_ * NW);
}
typedef short v4i16_t __attribute__((ext_vector_type(4)));
constexpr int ATT_TAB_OFF = 131072 + 2048;
constexpr int ATT_UNITS = 3 * 8 * 128;
__device__ __forceinline__ int t5_bucket_dev(int n) {
    if (n < 16) return n;
    const float v = logf((float)n / 16.f) / 4.852030263919617f * 16.f;
    const int large = 16 + (int)v;
    return large < 31 ? large : 31;
}
__device__ __forceinline__ void p_bias_table(const int wv, const float* rel_bias, float* biasG, int rot) {
    LTID();
    for (int i = ROTB(rot) * NT + tidx; i < 3 * 8 * 132; i += gridDim.x * NT) {
        const int d = i % 132, bh = i / 132, h = bh & 7, b = bh >> 3;
        biasG[i] = (d <= 128) ? rel_bias[t5_bucket_dev(d << (2 * b)) * 8 + h] * 1.4426950408889634f : 0.f;
    }
}
__device__ __forceinline__ void p_dil_attn(const int wv, const bf16_t* proj16, const float* biasG, bf16_t* obr, float* lse, LAS unsigned char* lds) {
    LTID();
    const int lane = tidx & 63, fr = lane & 15, fq = lane >> 4, w = wv;
    const int per = (ATT_UNITS + (int)gridDim.x - 1) / (int)gridDim.x;
    const int u0 = bidx * per, u1 = (u0 + per < ATT_UNITS) ? u0 + per : ATT_UNITS;
    if (u0 >= u1) return;
    const int rowl = tidx >> 3, cs = tidx & 7;
    const unsigned cK = (unsigned)(cs ^ ((rowl >> 1) & 7)) * 16u, cV = (unsigned)(cs ^ (rowl & 7)) * 16u;
    const unsigned fK = (unsigned)((fr >> 1) & 7);
    const unsigned kro0 = (unsigned)fr * 128u + (((unsigned)fq ^ fK) * 16u), kro1 = (unsigned)fr * 128u + ((((unsigned)fq ^ fK) ^ 4u) * 16u);
    const int tq = (lane & 15) >> 2, tp = lane & 3, fv = 4 * (fq & 1) + tq;
    unsigned vro[4];
#pragma unroll
    for (int db = 0; db < 4; ++db) vro[db] = (unsigned)(4 * fq + tq) * 128u + (unsigned)(((2 * db + (tp >> 1)) ^ fv) * 16) + 8u * (unsigned)(tp & 1);
    const int ts_ = (1 + fr) & 3;
    const unsigned tab8 = (unsigned)ATT_TAB_OFF + (unsigned)ts_ * 640u + (unsigned)(((141 + fr - ts_) >> 2) - fq - 32) * 16u;
    const char* gbase = (const char*)proj16;
#define ATT_DECODE(u, b_, h_, r_, n_, dil_) const int cmb_ = (u) >> 7, b_ = cmb_ >> 3, h_ = cmb_ & 7, dil_ = 1 << (2 * b_), idx_ = (u) & 127, r_ = idx_ & (dil_ - 1), n_ = idx_ >> (2 * b_)
#define ATT_ISSUE(u, bf, q0, q1) do { ATT_DECODE(u, b__, h__, r__, n__, dil__); \
        const int nk = n__ > 0 ? n__ - 1 : 0;                                     \
        _Pragma("unroll") for (int p = 0; p < 4; ++p) { \
            int row = 64 * p + rowl; int blk = (row >> 7) ? n__ : nk; \
            const unsigned pos = (unsigned)(r__ + dil__ * (128 * blk + (row & 127))); \
            const unsigned so = pos * 4096u + (unsigned)h__ * 128u; const unsigned ld_ = (unsigned)(size_t)(lds + (bf) * 65536 + p * 8192 + w * 1024); \
            glds16s(gbase, so + 1024u + cK, ld_); glds16s(gbase, so + 2048u + cV, ld_ + 32768u); } \
        const unsigned qpos = (unsigned)(r__ + dil__ * (128 * n__ + 16 * w + fr)); \
        const char* qsrc = gbase + (size_t)qpos * 4096u + (unsigned)h__ * 128u + (unsigned)fq * 16u; \
        q0 = *(const bf16x8*)(qsrc); q1 = *(const bf16x8*)(qsrc + 64); } while (0)
    bf16x8 qf0, qf1, qn0, qn1;
    ATT_ISSUE(u0, 0, qn0, qn1);
    int prev_cmb = -1;
    for (int u = u0; u < u1; ++u) {
        const int bf = (u - u0) & 1;
        asm volatile("s_waitcnt vmcnt(0)" ::: "memory");
        __syncthreads();
        qf0 = qn0; qf1 = qn1;
        if (u + 1 < u1) ATT_ISSUE(u + 1, bf ^ 1, qn0, qn1);
        ATT_DECODE(u, b, h, r, n, dil);
        if (cmb_ != prev_cmb) {
            prev_cmb = cmb_;
            for (int e = tidx; e < 4 * 160; e += NT) { const int sft = e / 160, k = e - sft * 160, idx = k + sft, dist = idx - 16;
                const float v = (dist >= 0 && dist <= 128) ? biasG[cmb_ * 132 + dist] : -1e30f;
                ((LAS float*)(lds + ATT_TAB_OFF))[sft * 160 + k] = v; }
            __syncthreads();
        }
        const LAS unsigned char* Kb = lds + bf * 65536; const LAS unsigned char* Vb = Kb + 32768;
        const int kb0 = w;
        f32x4 sc[9];
#pragma unroll
        for (int i = 0; i < 9; ++i) {
            const unsigned ko = (unsigned)(kb0 + i) * 2048u;
            const bf16x8 k0 = *(const LAS bf16x8*)(Kb + ko + kro0), k1 = *(const LAS bf16x8*)(Kb + ko + kro1);
            f32x4 a = (f32x4){0.f, 0.f, 0.f, 0.f};
            a = __builtin_amdgcn_mfma_f32_16x16x32_bf16(k0, qf0, a, 0, 0, 0);
            a = __builtin_amdgcn_mfma_f32_16x16x32_bf16(k1, qf1, a, 0, 0, 0);
            const f32x4 t = *(const LAS f32x4*)(lds + tab8 + 64 * (8 - i));
            a = a + (f32x4){t[3], t[2], t[1], t[0]};
            if (n == 0 && kb0 + i < 8) a = (f32x4){-1e30f, -1e30f, -1e30f, -1e30f};
            sc[i] = a;
        }
#pragma unroll
        for (int i = 0; i < 9; ++i)
#pragma unroll
            for (int j = 0; j < 4; ++j) sc[i][j] = __builtin_amdgcn_exp2f(fminf(sc[i][j], 100.f));
        f32x4 oacc[4]; f32x4 sacc = (f32x4){0.f, 0.f, 0.f, 0.f};
        const bf16x8 ones = (bf16x8){0x3F80, 0x3F80, 0x3F80, 0x3F80, 0x3F80, 0x3F80, 0x3F80, 0x3F80};
#pragma unroll
        for (int db = 0; db < 4; ++db) oacc[db] = (f32x4){0.f, 0.f, 0.f, 0.f};
#pragma unroll
        for (int c = 0; c < 5; ++c) {
            const int ia = 2 * c, ib = (c < 4) ? 2 * c + 1 : 8;
            u32x4 pw; pw.x = cvt_pk_bf16(sc[ia][0], sc[ia][1]); pw.y = cvt_pk_bf16(sc[ia][2], sc[ia][3]);
            if (c < 4) { pw.z = cvt_pk_bf16(sc[ib][0], sc[ib][1]); pw.w = cvt_pk_bf16(sc[ib][2], sc[ib][3]); } else { pw.z = 0u; pw.w = 0u; }
            const bf16x8 pf = __builtin_bit_cast(bf16x8, pw);
            const unsigned va = (unsigned)(kb0 + ia) * 2048u, vb = (unsigned)(kb0 + ib) * 2048u;
            sacc = __builtin_amdgcn_mfma_f32_16x16x32_bf16(ones, pf, sacc, 0, 0, 0);
#pragma unroll
            for (int db = 0; db < 4; ++db) {
                const v4i16_t x0 = __builtin_amdgcn_ds_read_tr16_b64_v4i16((LAS v4i16_t*)(Vb + va + vro[db]));
                const v4i16_t x1 = __builtin_amdgcn_ds_read_tr16_b64_v4i16((LAS v4i16_t*)(Vb + vb + vro[db]));
                const bf16x8 vf = (bf16x8){x0[0], x0[1], x0[2], x0[3], x1[0], x1[1], x1[2], x1[3]};
                oacc[db] = __builtin_amdgcn_mfma_f32_16x16x32_bf16(vf, pf, oacc[db], 0, 0, 0);
            }
        }
        const float sum = sacc[0];
        const float inv = 1.f / sum;
        const unsigned qpos = (unsigned)(r + dil * (128 * n + 16 * w + fr));
        bf16_t* orow = obr + ((size_t)b * SEQ + qpos) * 512 + h * 64 + 4 * fq;
#pragma unroll
        for (int db = 0; db < 4; ++db) { u32x2 o2; o2.x = cvt_pk_bf16(oacc[db][0] * inv, oacc[db][1] * inv); o2.y = cvt_pk_bf16(oacc[db][2] * inv, oacc[db][3] * inv); *(u32x2*)(orow + 16 * db) = o2; }
        if (fq == 0) lse[((size_t)b * SEQ + qpos) * 8 + h] = sum;
    }
    asm volatile("s_waitcnt vmcnt(0)" ::: "memory");
    __syncthreads();
#undef ATT_DECODE
#undef ATT_ISSUE
}
__device__ __forceinline__ void p_attn_combine(const int wv, const bf16_t* obr, const float* lse, const float* g, bf16_t* mix16) {
    LTID();
    const int lane = tidx & 63, h = lane >> 3;
    const f32x4 g0 = *(const f32x4*)(g + lane * 8), g1 = *(const f32x4*)(g + lane * 8 + 4);
    const int rstride = (int)gridDim.x * NW;
    for (int row0 = bidx * NW + wv; row0 < SEQ; row0 += 4 * rstride) {
        float lv[4][3]; u32x4 av[4][3];
#pragma unroll
        for (int r = 0; r < 4; ++r) { const int row = (row0 + r * rstride < SEQ) ? row0 + r * rstride : row0;
#pragma unroll
            for (int b = 0; b < 3; ++b) { lv[r][b] = lse[((size_t)b * SEQ + row) * 8 + h]; av[r][b] = *(const u32x4*)(obr + ((size_t)b * SEQ + row) * 512 + lane * 8); } }
#pragma unroll
        for (int r = 0; r < 4; ++r) {
            const int row = row0 + r * rstride;
            float w0 = lv[r][0], w1 = lv[r][1], w2 = lv[r][2];
            const float iw = 1.f / (w0 + w1 + w2); w0 *= iw; w1 *= iw; w2 *= iw;
            float y[8]; float ss = 0.f;
#pragma unroll
            for (int k = 0; k < 4; ++k) {
                const float lo = w0 * __builtin_bit_cast(float, av[r][0][k] << 16) + w1 * __builtin_bit_cast(float, av[r][1][k] << 16) + w2 * __builtin_bit_cast(float, av[r][2][k] << 16);
                const float hi = w0 * __builtin_bit_cast(float, av[r][0][k] & 0xffff0000u) + w1 * __builtin_bit_cast(float, av[r][1][k] & 0xffff0000u) + w2 * __builtin_bit_cast(float, av[r][2][k] & 0xffff0000u);
                y[2 * k] = lo; y[2 * k + 1] = hi; ss += lo * lo + hi * hi;
            }
#pragma unroll
            for (int o = 32; o; o >>= 1) ss += shx(ss, o, lane);
            const float sc = rsqrtf(ss * (1.f / 512.f) + 1e-5f);
            u32x4 o4; o4.x = cvt_pk_bf16(y[0] * sc * g0[0], y[1] * sc * g0[1]); o4.y = cvt_pk_bf16(y[2] * sc * g0[2], y[3] * sc * g0[3]);
            o4.z = cvt_pk_bf16(y[4] * sc * g1[0], y[5] * sc * g1[1]); o4.w = cvt_pk_bf16(y[6] * sc * g1[2], y[7] * sc * g1[3]);
            if (row < SEQ) *(u32x4*)(mix16 + (size_t)row * DM + lane * 8) = o4;
        }
    }
}
struct EpiIn {
    static constexpr bool PERM = true;
    bf16_t* O;
    __device__ __forceinline__ void operator()(const f32x4 (&acc)[2][2][4][2], const GUnit& u, int wr, int wc, int fr, int fq) const {
        const int row0 = u.pm * BM + wr * 64 + fr, col0 = u.pn * BM + wc * 32 + 8 * fq;
        const float sc = u.pn < 2 ? 0.18033688011112042f : 1.f;
#pragma unroll
        for (int ai = 0; ai < 2; ++ai)
#pragma unroll
            for (int m = 0; m < 4; ++m) { const size_t ro = (size_t)(row0 + ai * HALF + m * 16) * DIN + col0;
#pragma unroll
                for (int bj = 0; bj < 2; ++bj) { const f32x4 v0 = acc[ai][bj][m][0] * sc, v1 = acc[ai][bj][m][1] * sc;
                    u32x4 w; w.x = cvt_pk_bf16(v0[0], v0[1]); w.y = cvt_pk_bf16(v0[2], v0[3]); w.z = cvt_pk_bf16(v1[0], v1[1]); w.w = cvt_pk_bf16(v1[2], v1[3]);
                    *(u32x4*)(O + ro + bj * HALF) = w;
                    } }
    }
};


__device__ __forceinline__ unsigned xoff_b(unsigned row, unsigned ch) { return 256u * row + 16u * (ch ^ (((row & 3u) << 2) | ((row >> 2) & 3u))); }
__device__ __forceinline__ void p_xattn_mfma(const int wv, const bf16_t* qx16, const bf16_t* kv16, bf16_t* ox16, LAS unsigned char* lds) {
    LTID();
    const int lane = tidx & 63, fr = lane & 15, fq = lane >> 4, w = wv;
    const int NU = 4 * 128;
    const int per = (NU + (int)gridDim.x - 1) / (int)gridDim.x;
    const int u0 = bidx * per, u1 = (u0 + per < NU) ? u0 + per : NU;
    if (u0 >= u1) return;
    const int rowl = tidx >> 4, cs = tidx & 15;
    const unsigned csw = (unsigned)(cs ^ (((rowl & 3) << 2) | ((rowl >> 2) & 3))) * 16u;
    const unsigned kswz = (unsigned)(((fr & 3) << 2) | ((fr >> 2) & 3));
    unsigned kro[4];
#pragma unroll
    for (int s4 = 0; s4 < 4; ++s4) kro[s4] = 256u * (unsigned)fr + 16u * ((unsigned)(4 * s4 + fq) ^ kswz);
    const int tq = (lane & 15) >> 2, tp = lane & 3;
    const unsigned vswz = (unsigned)((tq << 2) | fq);
    unsigned vro[8];
#pragma unroll
    for (int c = 0; c < 8; ++c) vro[c] = 65536u + 256u * (unsigned)(4 * fq + tq) + 16u * ((unsigned)(2 * c + (tp >> 1)) ^ vswz) + 8u * (unsigned)(tp & 1);
    int prev_h = -1;
    for (int u = u0; u < u1; ++u) {
        const int h = u >> 7, qt = u & 127;
        if (h != prev_h) {
            __syncthreads();
            prev_h = h;
#pragma unroll
            for (int p = 0; p < 8; ++p) {
                const unsigned row = (unsigned)(32 * p + rowl);
                const unsigned so = row * 2048u + (unsigned)h * 256u + csw;
                const unsigned ld_ = (unsigned)(size_t)(lds + p * 8192 + w * 1024);
                glds16s(kv16, so, ld_); glds16s(kv16, so + 1024u, ld_ + 65536u);
            }
            asm volatile("s_waitcnt vmcnt(0)" ::: "memory");
            __syncthreads();
        }
        const char* qsrc = (const char*)qx16 + ((size_t)(qt * 128 + 16 * w + fr) * 512 + h * 128 + 8 * fq) * 2;
        bf16x8 qf[4];
#pragma unroll
        for (int s4 = 0; s4 < 4; ++s4) qf[s4] = *(const bf16x8*)(qsrc + 64 * s4);
        f32x4 sc[16];
#pragma unroll
        for (int i = 0; i < 16; ++i) {
            f32x4 a = (f32x4){0.f, 0.f, 0.f, 0.f};
#pragma unroll
            for (int s4 = 0; s4 < 4; ++s4) { const bf16x8 kf = *(const LAS bf16x8*)(lds + i * 4096 + kro[s4]); a = __builtin_amdgcn_mfma_f32_16x16x32_bf16(kf, qf[s4], a, 0, 0, 0); }
            sc[i] = a;
        }
        float mx = -1e30f;
#pragma unroll
        for (int i = 0; i < 16; ++i) mx = fmaxf(mx, fmaxf(fmaxf(sc[i][0], sc[i][1]), fmaxf(sc[i][2], sc[i][3])));
        mx = fmaxf(mx, shx(mx, 16, lane)); mx = fmaxf(mx, shx(mx, 32, lane));
        float sum = 0.f;
#pragma unroll
        for (int i = 0; i < 16; ++i)
#pragma unroll
            for (int j = 0; j < 4; ++j) { const float p = __expf(sc[i][j] - mx); sc[i][j] = p; sum += p; }
        sum += shx(sum, 16, lane); sum += shx(sum, 32, lane);
        f32x4 oacc[8];
#pragma unroll
        for (int c = 0; c < 8; ++c) oacc[c] = (f32x4){0.f, 0.f, 0.f, 0.f};
#pragma unroll
        for (int ch = 0; ch < 8; ++ch) {
            const int ia = 2 * ch, ib = 2 * ch + 1;
            u32x4 pw; pw.x = cvt_pk_bf16(sc[ia][0], sc[ia][1]); pw.y = cvt_pk_bf16(sc[ia][2], sc[ia][3]); pw.z = cvt_pk_bf16(sc[ib][0], sc[ib][1]); pw.w = cvt_pk_bf16(sc[ib][2], sc[ib][3]);
            const bf16x8 pf = __builtin_bit_cast(bf16x8, pw);
#pragma unroll
            for (int c = 0; c < 8; ++c) {
                const v4i16_t x0 = __builtin_amdgcn_ds_read_tr16_b64_v4i16((LAS v4i16_t*)(lds + ia * 4096 + vro[c]));
                const v4i16_t x1 = __builtin_amdgcn_ds_read_tr16_b64_v4i16((LAS v4i16_t*)(lds + ib * 4096 + vro[c]));
                const bf16x8 vf = (bf16x8){x0[0], x0[1], x0[2], x0[3], x1[0], x1[1], x1[2], x1[3]};
                oacc[c] = __builtin_amdgcn_mfma_f32_16x16x32_bf16(vf, pf, oacc[c], 0, 0, 0);
            }
        }
        const float inv = 1.f / sum;
        bf16_t* orow = ox16 + (size_t)(qt * 128 + 16 * w + fr) * 512 + h * 128 + 4 * fq;
#pragma unroll
        for (int c = 0; c < 8; ++c) { u32x2 o2; o2.x = cvt_pk_bf16(oacc[c][0] * inv, oacc[c][1] * inv); o2.y = cvt_pk_bf16(oacc[c][2] * inv, oacc[c][3] * inv); *(u32x2*)(orow + 16 * c) = o2; }
    }
    __syncthreads();
}
struct EpiBf16 {
    static constexpr bool PERM = true;
    bf16_t* O; int ldc; float scale; const float* ss;
    __device__ __forceinline__ void operator()(const f32x4 (&acc)[2][2][4][2], const GUnit& u, int wr, int wc, int fr, int fq) const {
        const int row0 = u.pm * BM + wr * 64 + fr, col0 = u.pn * BM + wc * 32 + 8 * fq;
#pragma unroll
        for (int ai = 0; ai < 2; ++ai)
#pragma unroll
            for (int m = 0; m < 4; ++m) { const int row = row0 + ai * HALF + m * 16; bf16_t* rowp = O + (size_t)row * ldc + col0;
                float sc = scale;
                if (ss) { const f32x4 p0 = *(const f32x4*)(ss + (size_t)row * 16), p1 = *(const f32x4*)(ss + (size_t)row * 16 + 4), p2 = *(const f32x4*)(ss + (size_t)row * 16 + 8), p3 = *(const f32x4*)(ss + (size_t)row * 16 + 12);
                    const float t = ((p0[0] + p0[1]) + (p0[2] + p0[3])) + ((p1[0] + p1[1]) + (p1[2] + p1[3])) + ((p2[0] + p2[1]) + (p2[2] + p2[3])) + ((p3[0] + p3[1]) + (p3[2] + p3[3]));
                    sc = scale * rsqrtf(t * (1.f / 1024.f) + 1e-5f); }
#pragma unroll
                for (int bj = 0; bj < 2; ++bj) { const f32x4 v0 = acc[ai][bj][m][0] * sc, v1 = acc[ai][bj][m][1] * sc;
                    u32x4 w; w.x = cvt_pk_bf16(v0[0], v0[1]); w.y = cvt_pk_bf16(v0[2], v0[3]); w.z = cvt_pk_bf16(v1[0], v1[1]); w.w = cvt_pk_bf16(v1[2], v1[3]);
                    *(u32x4*)(rowp + bj * HALF) = w; } }
    }
};
struct EpiOut {
    static constexpr bool PERM = true;
    const float* R; float* H; bf16_t* HB; float* ss;
    __device__ __forceinline__ void operator()(const f32x4 (&acc)[2][2][4][2], const GUnit& u, int wr, int wc, int fr, int fq) const {
        const int row0 = u.pm * BM + wr * 64 + fr, col0 = u.pn * BM + wc * 32 + 8 * fq, lane = fq * 16 + fr;
#pragma unroll
        for (int ai = 0; ai < 2; ++ai)
#pragma unroll
            for (int m = 0; m < 4; ++m) { const int row = row0 + ai * HALF + m * 16; const size_t ro = (size_t)row * DM + col0; float sq = 0.f;
#pragma unroll
                for (int bj = 0; bj < 2; ++bj) {
                    const f32x4 v0 = acc[ai][bj][m][0] + *(const f32x4*)(R + ro + bj * HALF), v1 = acc[ai][bj][m][1] + *(const f32x4*)(R + ro + bj * HALF + 4);
                    *(f32x4*)(H + ro + bj * HALF) = v0; *(f32x4*)(H + ro + bj * HALF + 4) = v1;
                    u32x4 w; w.x = cvt_pk_bf16(v0[0], v0[1]); w.y = cvt_pk_bf16(v0[2], v0[3]); w.z = cvt_pk_bf16(v1[0], v1[1]); w.w = cvt_pk_bf16(v1[2], v1[3]);
                    *(u32x4*)(HB + ro + bj * HALF) = w;
                    sq += (v0[0] * v0[0] + v0[1] * v0[1]) + (v0[2] * v0[2] + v0[3] * v0[3]) + (v1[0] * v1[0] + v1[1] * v1[1]) + (v1[2] * v1[2] + v1[3] * v1[3]);
                }
                sq += shx(sq, 16, lane); sq += shx(sq, 32, lane);
                if (fq == 0) ss[(size_t)row * 16 + u.pn * 4 + wc] = sq;
            }
    }
};

typedef short bf16x4 __attribute__((ext_vector_type(4)));
constexpr int S5_CHUNK = 256, S5_NCH = SEQ / S5_CHUNK, S5_ROWB = 528;
__device__ __forceinline__ f32x2 gelu_pk(f32x2 v) {
    const f32x2 av = __builtin_elementwise_abs(v), d = av * 0.2316418882f + 1.0f;
    f32x2 t; t.x = __builtin_amdgcn_rcpf(d.x); t.y = __builtin_amdgcn_rcpf(d.y);
    f32x2 q = t * 0.5307027145f + (-0.7265760135f); q = q * t + 0.7107068705f; q = q * t + (-0.142248368f); q = q * t + 0.127414796f; q = q * t;
    const f32x2 s2 = (v * v) * (-0.72134752044f);
    f32x2 e; e.x = __builtin_amdgcn_exp2f(s2.x); e.y = __builtin_amdgcn_exp2f(s2.y);
    const f32x2 m = v * (q * e), r = v - m;
    f32x2 o; o.x = v.x < 0.f ? m.x : r.x; o.y = v.y < 0.f ? m.y : r.y; return o;
}
__device__ __forceinline__ void p_s5_tables2(const int wv, const float* a_re, const float* a_im, const float* b_re, const float* b_im, const float* c_re, const float* c_im, const float* log_dt,
                                             float2* abar, float2* a256, bf16_t* BB16, bf16_t* CM16, int rot) {
    LTID();
    for (int i = ROTB(rot) * NT + tidx; i < 2048 * 16; i += gridDim.x * NT) {
        const int gp = i >> 4, c = i & 15, g = gp >> 6, p = gp & 63;
        const float lr = a_re[gp], li = a_im[gp], dt = expf(log_dt[g]);
        const float mag = expf(lr * dt); float sn, cs; sincosf(li * dt, &sn, &cs);
        const float ar = mag * cs, ai = mag * sn;
        if (c == 0) {
            abar[gp] = make_float2(ar, ai);
            float pr = ar, pi = ai;
            for (int k = 0; k < 8; ++k) { const float nr = pr * pr - pi * pi, ni = 2.f * pr * pi; pr = nr; pi = ni; }
            a256[gp] = make_float2(pr, pi);
        }
        const float nr = ar - 1.f, ni = ai, den = lr * lr + li * li;
        const float cr = (nr * lr + ni * li) / den, ci = (ni * lr - nr * li) / den;
        const float br = b_re[gp * 16 + c], bi = b_im[gp * 16 + c];
        BB16[((size_t)g * 128 + p) * 16 + c] = (bf16_t)f2bf(cr * br - ci * bi);
        BB16[((size_t)g * 128 + 64 + p) * 16 + c] = (bf16_t)f2bf(cr * bi + ci * br);
        CM16[((size_t)g * 16 + c) * 128 + p] = (bf16_t)f2bf(c_re[(g * 16 + c) * 64 + p]);
        CM16[((size_t)g * 16 + c) * 128 + 64 + p] = (bf16_t)f2bf(-c_im[(g * 16 + c) * 64 + p]);
    }
}
template <int MODE> __device__ __forceinline__ void p_s5_pass(const int wv, const bf16_t* proj16, const float2* abar, const float2* a256, const bf16_t* BB16, const bf16_t* CM16, const float* dskip,
                                                              float2* E, bf16_t* yg16, LAS unsigned char* lds) {
    LTID();
    const int lane = tidx & 63, fr = lane & 15, fq = lane >> 4;
    LAS unsigned char* L = lds + wv * (16 * S5_ROWB);
    for (int unit = bidx * NW + wv; unit < S5_NCH * 32; unit += gridDim.x * NW) {
        const int g = unit & 31, chunk = unit >> 5;
        const float2 a = abar[g * 64 + lane];
        bf16x4 bbf[8];
#pragma unroll
        for (int cb = 0; cb < 8; ++cb) bbf[cb] = *(const bf16x4*)(BB16 + ((size_t)g * 128 + 16 * cb + fr) * 16 + 4 * fq);
        bf16x8 cmf[4]; f32x4 dsk = (f32x4){0.f, 0.f, 0.f, 0.f};
        if (MODE == 1) {
#pragma unroll
            for (int s4 = 0; s4 < 4; ++s4) cmf[s4] = *(const bf16x8*)(CM16 + ((size_t)g * 16 + fr) * 128 + 32 * s4 + 8 * fq);
            dsk = *(const f32x4*)(dskip + g * 16 + 4 * fq);
        }
        float sr = 0.f, si = 0.f;
        if (MODE == 1) {
            const float2 A = a256[g * 64 + lane];
            for (int j0 = 0; j0 < chunk; j0 += 16) {
                float2 e[16];
#pragma unroll
                for (int k = 0; k < 16; ++k) { const int j = (j0 + k < chunk) ? j0 + k : chunk - 1; e[k] = E[((size_t)j * 32 + g) * 64 + lane]; }
#pragma unroll
                for (int k = 0; k < 16; ++k) if (j0 + k < chunk) { const float nr = A.x * sr - A.y * si + e[k].x, ni = A.x * si + A.y * sr + e[k].y; sr = nr; si = ni; }
            }
        }
        const bf16_t* ubase = proj16 + (size_t)(chunk * S5_CHUNK + fr) * DIN + 1536 + g * 16 + 4 * fq;
        bf16x4 uf = *(const bf16x4*)ubase;
#pragma unroll 1
        for (int blk = 0; blk < S5_CHUNK / 16; ++blk) {
            const bf16x4 ufn = *(const bf16x4*)(ubase + (size_t)((blk < S5_CHUNK / 16 - 1) ? (blk + 1) * 16 : blk * 16) * DIN);
            asm volatile("" ::: "memory");
#pragma unroll
            for (int cb = 0; cb < 8; ++cb) {
                const f32x4 d = __builtin_amdgcn_mfma_f32_16x16x16bf16_1k(bbf[cb], uf, (f32x4){0.f, 0.f, 0.f, 0.f}, 0, 0, 0);
                *(LAS f32x4*)(L + fr * S5_ROWB + (16 * cb + 4 * fq) * 4) = d;
            }
            asm volatile("" ::: "memory");
#pragma unroll
            for (int t = 0; t < 16; ++t) {
                const float re = *(const LAS float*)(L + t * S5_ROWB + lane * 4), im = *(const LAS float*)(L + t * S5_ROWB + 256 + lane * 4);
                const float nr = a.x * sr - a.y * si + re, ni = a.x * si + a.y * sr + im; sr = nr; si = ni;
                if (MODE == 1) { *(LAS bf16_t*)(L + t * S5_ROWB + lane * 2) = (bf16_t)f2bf(sr); *(LAS bf16_t*)(L + t * S5_ROWB + 128 + lane * 2) = (bf16_t)f2bf(si); }
            }
            asm volatile("" ::: "memory");
            if (MODE == 1) {
                f32x4 y = (f32x4){0.f, 0.f, 0.f, 0.f};
#pragma unroll
                for (int s4 = 0; s4 < 4; ++s4) { const bf16x8 sf = *(const LAS bf16x8*)(L + fr * S5_ROWB + 64 * s4 + 16 * fq); y = __builtin_amdgcn_mfma_f32_16x16x32_bf16(cmf[s4], sf, y, 0, 0, 0); }
                f32x4 v;
#pragma unroll
                for (int j = 0; j < 4; ++j) v[j] = y[j] + dsk[j] * bf2f((unsigned short)uf[j]);
                const f32x2 g0 = gelu_pk((f32x2){v[0], v[1]}), g1 = gelu_pk((f32x2){v[2], v[3]});
                u32x2 o2; o2.x = cvt_pk_bf16(g0.x, g0.y); o2.y = cvt_pk_bf16(g1.x, g1.y);
                *(u32x2*)(yg16 + (size_t)(chunk * S5_CHUNK + blk * 16 + fr) * 512 + g * 16 + 4 * fq) = o2;
            }
            asm volatile("" ::: "memory");
            uf = ufn;
        }
        if (MODE == 0) E[((size_t)chunk * 32 + g) * 64 + lane] = make_float2(sr, si);
    }
}
struct EpiGlu16 {
    static constexpr bool PERM = true;
    bf16_t* O; const bf16_t* Y; const float* bias;
    __device__ __forceinline__ void operator()(const f32x4 (&acc)[2][2][4][2], const GUnit& u, int wr, int wc, int fr, int fq) const {
        const int row0 = u.pm * BM + wr * 64 + fr, col0 = u.pn * BM + wc * 32 + 8 * fq;
        f32x4 bv[2][2];
#pragma unroll
        for (int bj = 0; bj < 2; ++bj)
#pragma unroll
            for (int n = 0; n < 2; ++n) bv[bj][n] = *(const f32x4*)(bias + col0 + bj * HALF + 4 * n);
#pragma unroll
        for (int ai = 0; ai < 2; ++ai)
#pragma unroll
            for (int m = 0; m < 4; ++m) { const size_t ro = (size_t)(row0 + ai * HALF + m * 16) * 512 + col0;
#pragma unroll
                for (int bj = 0; bj < 2; ++bj) {
                    const u32x4 yv = *(const u32x4*)(Y + ro + bj * HALF);
                    float o[8];
#pragma unroll
                    for (int n = 0; n < 2; ++n)
#pragma unroll
                        for (int j = 0; j < 4; ++j) { const unsigned wd = yv[n * 2 + (j >> 1)]; const float y = __builtin_bit_cast(float, (j & 1) ? (wd & 0xffff0000u) : (wd << 16));
                            o[n * 4 + j] = y / (1.f + __expf(-(acc[ai][bj][m][n][j] + bv[bj][n][j]))); }
                    u32x4 w; w.x = cvt_pk_bf16(o[0], o[1]); w.y = cvt_pk_bf16(o[2], o[3]); w.z = cvt_pk_bf16(o[4], o[5]); w.w = cvt_pk_bf16(o[6], o[7]);
                    *(u32x4*)(O + ro + bj * HALF) = w; } }
    }
};
__device__ __forceinline__ void p_ssm_norm(const int wv, const bf16_t* yb16, const float* g, bf16_t* mix16) {
    LTID();
    const int lane = tidx & 63;
    const f32x4 g0 = *(const f32x4*)(g + lane * 8), g1 = *(const f32x4*)(g + lane * 8 + 4);
    const int rstride = (int)gridDim.x * NW;
    for (int row0 = bidx * NW + wv; row0 < SEQ; row0 += 4 * rstride) {
        u32x4 av[4];
#pragma unroll
        for (int r = 0; r < 4; ++r) { const int row = (row0 + r * rstride < SEQ) ? row0 + r * rstride : row0; av[r] = *(const u32x4*)(yb16 + (size_t)row * 512 + lane * 8); }
#pragma unroll
        for (int r = 0; r < 4; ++r) {
            const int row = row0 + r * rstride;
            float y[8]; float ss = 0.f;
#pragma unroll
            for (int k = 0; k < 4; ++k) { y[2 * k] = __builtin_bit_cast(float, av[r][k] << 16); y[2 * k + 1] = __builtin_bit_cast(float, av[r][k] & 0xffff0000u); ss += y[2 * k] * y[2 * k] + y[2 * k + 1] * y[2 * k + 1]; }
#pragma unroll
            for (int o = 32; o; o >>= 1) ss += shx(ss, o, lane);
            const float sc = rsqrtf(ss * (1.f / 512.f) + 1e-5f);
            u32x4 o4; o4.x = cvt_pk_bf16(y[0] * sc * g0[0], y[1] * sc * g0[1]); o4.y = cvt_pk_bf16(y[2] * sc * g0[2], y[3] * sc * g0[3]);
            o4.z = cvt_pk_bf16(y[4] * sc * g1[0], y[5] * sc * g1[1]); o4.w = cvt_pk_bf16(y[6] * sc * g1[2], y[7] * sc * g1[3]);
            if (row < SEQ) *(u32x4*)(mix16 + (size_t)row * DM + 512 + lane * 8) = o4;
        }
    }
}

__device__ __forceinline__ void p_rmsnorm16(const int wv, const float* in, const float* g, bf16_t* out16, int rows, int rot) {
    LTID();
    const int lane = tidx & 63;
    for (int r = ROTB(rot) * NW + wv; r < rows; r += gridDim.x * NW) {
        f32x4 v[4]; float ss = 0.f;
#pragma unroll
        for (int j = 0; j < 4; ++j) { v[j] = *(const f32x4*)(in + (size_t)r * DM + 4 * lane + 256 * j); ss += (v[j][0] * v[j][0] + v[j][1] * v[j][1]) + (v[j][2] * v[j][2] + v[j][3] * v[j][3]); }
#pragma unroll
        for (int o = 32; o; o >>= 1) ss += shx(ss, o, lane);
        const float sc = rsqrtf(ss * (1.f / 1024.f) + 1e-5f);
#pragma unroll
        for (int j = 0; j < 4; ++j) { const f32x4 gg = *(const f32x4*)(g + 4 * lane + 256 * j); u32x2 o2; o2.x = cvt_pk_bf16(v[j][0] * sc * gg[0], v[j][1] * sc * gg[1]); o2.y = cvt_pk_bf16(v[j][2] * sc * gg[2], v[j][3] * sc * gg[3]);
            *(u32x2*)(out16 + (size_t)r * DM + 4 * lane + 256 * j) = o2; }
    }
}
template <bool MOE, bool LAST> __device__ __forceinline__ void p_rowfinish(const int wv, const float* hin, float* h, const bf16_t* mout, const int* eslot, const float* topg, const float* g, bf16_t* xn16, float* out) {
    LTID();
    const int lane = tidx & 63;
    LAS const int* ts = (LAS const int*)(LDSP + TS_OFF);
    const int rstride = (int)gridDim.x * NW;
    for (int r0 = bidx * NW + wv; r0 < SEQ; r0 += 2 * rstride) {
        int rr[2]; rr[0] = r0; rr[1] = (r0 + rstride < SEQ) ? r0 + rstride : r0;
        f32x4 v[2][4]; int4 es[2]; f32x4 gt[2]; u32x2 mo[2][4][4];
#pragma unroll
        for (int q = 0; q < 2; ++q) { if (MOE) { es[q] = *(const int4*)(eslot + rr[q] * 4); gt[q] = *(const f32x4*)(topg + rr[q] * 4); }
#pragma unroll
            for (int j = 0; j < 4; ++j) v[q][j] = *(const f32x4*)(hin + (size_t)rr[q] * DM + 4 * lane + 256 * j); }
        if (MOE) {
#pragma unroll
            for (int q = 0; q < 2; ++q) { const int esv[4] = {es[q].x, es[q].y, es[q].z, es[q].w};
#pragma unroll
                for (int k = 0; k < 4; ++k) { const int e = esv[k] >> 16, sl = esv[k] & 0xffff; const size_t row = (size_t)ts[e] * BM + sl;
#pragma unroll
                    for (int j = 0; j < 4; ++j) mo[q][k][j] = *(const u32x2*)(mout + row * DM + 4 * lane + 256 * j); } }
#pragma unroll
            for (int q = 0; q < 2; ++q)
#pragma unroll
                for (int k = 0; k < 4; ++k) { const float gk = gt[q][k];
#pragma unroll
                    for (int j = 0; j < 4; ++j) { const u32x2 o = mo[q][k][j];
                        v[q][j][0] += gk * __builtin_bit_cast(float, o.x << 16); v[q][j][1] += gk * __builtin_bit_cast(float, o.x & 0xffff0000u);
                        v[q][j][2] += gk * __builtin_bit_cast(float, o.y << 16); v[q][j][3] += gk * __builtin_bit_cast(float, o.y & 0xffff0000u); } }
        }
#pragma unroll
        for (int q = 0; q < 2; ++q) {
            if (q == 1 && r0 + rstride >= SEQ) break;
            const int r = rr[q];
            float ss = 0.f;
#pragma unroll
            for (int j = 0; j < 4; ++j) ss += (v[q][j][0] * v[q][j][0] + v[q][j][1] * v[q][j][1]) + (v[q][j][2] * v[q][j][2] + v[q][j][3] * v[q][j][3]);
#pragma unroll
            for (int o = 32; o; o >>= 1) ss += shx(ss, o, lane);
            const float sc = rsqrtf(ss * (1.f / 1024.f) + 1e-5f);
#pragma unroll
            for (int j = 0; j < 4; ++j) {
                const f32x4 gg = *(const f32x4*)(g + 4 * lane + 256 * j);
                if (!LAST) { if (h) *(f32x4*)(h + (size_t)r * DM + 4 * lane + 256 * j) = v[q][j];
                    u32x2 o2; o2.x = cvt_pk_bf16(v[q][j][0] * sc * gg[0], v[q][j][1] * sc * gg[1]); o2.y = cvt_pk_bf16(v[q][j][2] * sc * gg[2], v[q][j][3] * sc * gg[3]);
                    *(u32x2*)(xn16 + (size_t)r * DM + 4 * lane + 256 * j) = o2; }
                else *(f32x4*)(out + (size_t)r * DM + 4 * lane + 256 * j) = (f32x4){v[q][j][0] * sc * gg[0], v[q][j][1] * sc * gg[1], v[q][j][2] * sc * gg[2], v[q][j][3] * sc * gg[3]};
            }
        }
    }
}
__device__ __forceinline__ void p_router_tables(const int wv, const float* w_r, const float* g, bf16_t* WR16, int rot) {
    LTID();
    for (int i = ROTB(rot) * NT + tidx; i < 32 * 1024; i += gridDim.x * NT) {
        const int e = i >> 10, k = i & 1023;
        const float w = g[k] * w_r[k * 32 + e];
        const unsigned hi = f2bf(w); const float lo = w - __builtin_bit_cast(float, hi << 16);
        WR16[i] = (bf16_t)hi; WR16[32 * 1024 + i] = (bf16_t)f2bf(lo);
    }
}
constexpr int RT_CNT_OFF = 131072 + 4608;
constexpr int RT_XCH_OFF = 131072 + 5120;
__device__ __forceinline__ void p_router2(const int wv, const float* h, const bf16_t* WR16, const float* b_r, bf16_t* hb16, unsigned* gcnt, int* rowtok_e, float* rsc_e, int* eslot, float* topg, LAS unsigned char* lds) {
    LTID();
    const int lane = tidx & 63, fr = lane & 15, fq = lane >> 4, w = wv, tg = w & 3, kh = w >> 2;
#pragma unroll
    for (int part = 0; part < 2; ++part)
#pragma unroll
        for (int p = 0; p < 8; ++p) { const int row = 4 * p + (tidx >> 7), cs = tidx & 127;
            glds16s(WR16, (unsigned)(part * 65536 + row * 2048 + ((cs ^ (row & 15)) * 16)), (unsigned)(size_t)(lds + part * 65536 + p * 8192 + w * 1024)); }
    LAS int* lcnt = (LAS int*)(lds + RT_CNT_OFF);
    if (tidx < 64) lcnt[tidx] = 0;
    asm volatile("s_waitcnt vmcnt(0)" ::: "memory");
    __syncthreads();
    for (int it = bidx; it < SEQ / 64; it += gridDim.x) {
        const int token = it * 64 + 16 * tg + fr;
        const float* xr = h + (size_t)token * DM + 512 * kh + 8 * fq;
        bf16_t* hb = hb16 + (size_t)token * DM + 512 * kh + 8 * fq;
        f32x4 acc[2]; acc[0] = (f32x4){0.f, 0.f, 0.f, 0.f}; acc[1] = acc[0];
        float ss = 0.f;
#pragma unroll 4
        for (int s4 = 0; s4 < 16; ++s4) {
            const f32x4 x0 = *(const f32x4*)(xr + 32 * s4), x1 = *(const f32x4*)(xr + 32 * s4 + 4);
            ss += (x0[0] * x0[0] + x0[1] * x0[1]) + (x0[2] * x0[2] + x0[3] * x0[3]) + (x1[0] * x1[0] + x1[1] * x1[1]) + (x1[2] * x1[2] + x1[3] * x1[3]);
            u32x4 hw; hw.x = cvt_pk_bf16(x0[0], x0[1]); hw.y = cvt_pk_bf16(x0[2], x0[3]); hw.z = cvt_pk_bf16(x1[0], x1[1]); hw.w = cvt_pk_bf16(x1[2], x1[3]);
            *(u32x4*)(hb + 32 * s4) = hw;
            u32x4 lw;
            lw.x = cvt_pk_bf16(x0[0] - __builtin_bit_cast(float, hw.x << 16), x0[1] - __builtin_bit_cast(float, hw.x & 0xffff0000u));
            lw.y = cvt_pk_bf16(x0[2] - __builtin_bit_cast(float, hw.y << 16), x0[3] - __builtin_bit_cast(float, hw.y & 0xffff0000u));
            lw.z = cvt_pk_bf16(x1[0] - __builtin_bit_cast(float, hw.z << 16), x1[1] - __builtin_bit_cast(float, hw.z & 0xffff0000u));
            lw.w = cvt_pk_bf16(x1[2] - __builtin_bit_cast(float, hw.w << 16), x1[3] - __builtin_bit_cast(float, hw.w & 0xffff0000u));
            const bf16x8 xhi = __builtin_bit_cast(bf16x8, hw), xlo = __builtin_bit_cast(bf16x8, lw);
            const int c = 64 * kh + 4 * s4 + fq, slot = c ^ fr;
#pragma unroll
            for (int nb = 0; nb < 2; ++nb) {
                const bf16x8 whi = *(const LAS bf16x8*)(lds + (16 * nb + fr) * 2048 + slot * 16), wlo = *(const LAS bf16x8*)(lds + 65536 + (16 * nb + fr) * 2048 + slot * 16);
                acc[nb] = __builtin_amdgcn_mfma_f32_16x16x32_bf16(whi, xhi, acc[nb], 0, 0, 0);
                acc[nb] = __builtin_amdgcn_mfma_f32_16x16x32_bf16(whi, xlo, acc[nb], 0, 0, 0);
                acc[nb] = __builtin_amdgcn_mfma_f32_16x16x32_bf16(wlo, xhi, acc[nb], 0, 0, 0);
            }
        }
        ss += shx(ss, 16, lane); ss += shx(ss, 32, lane);
        LAS float* X = (LAS float*)(lds + RT_XCH_OFF) + (tg * 64 + lane) * 9;
        if (kh == 1) {
#pragma unroll
            for (int nb = 0; nb < 2; ++nb)
#pragma unroll
                for (int j = 0; j < 4; ++j) X[nb * 4 + j] = acc[nb][j];
            X[8] = ss;
        }
        __syncthreads();
        int ti[4] = {0, 0, 0, 0}, ls[4] = {0, 0, 0, 0}; float gv[4] = {0.f, 0.f, 0.f, 0.f}; float rs = 0.f;
        if (kh == 0) {
            float lv[8];
            ss += X[8];
            rs = rsqrtf(ss * (1.f / 1024.f) + 1e-5f);
#pragma unroll
            for (int nb = 0; nb < 2; ++nb)
#pragma unroll
                for (int j = 0; j < 4; ++j) lv[nb * 4 + j] = rs * (acc[nb][j] + X[nb * 4 + j]) + b_r[16 * nb + 4 * fq + j];
            float tv[4];
#pragma unroll
            for (int r = 0; r < 4; ++r) {
                float bv = -3.0e38f; int bi = 0;
#pragma unroll
                for (int q = 0; q < 8; ++q) { const int idx = 16 * (q >> 2) + 4 * fq + (q & 3); if (lv[q] > bv) { bv = lv[q]; bi = idx; } }
#pragma unroll
                for (int mk = 16; mk <= 32; mk <<= 1) { const float ov = shx(bv, mk, lane); const int oi = shxi(bi, mk, lane); if (ov > bv || (ov == bv && oi < bi)) { bv = ov; bi = oi; } }
                tv[r] = bv; ti[r] = bi;
#pragma unroll
                for (int q = 0; q < 8; ++q) { const int idx = 16 * (q >> 2) + 4 * fq + (q & 3); if (idx == bi) lv[q] = -3.0e38f; }
            }
            float sum = 0.f;
#pragma unroll
            for (int r = 0; r < 4; ++r) { gv[r] = __expf(tv[r] - tv[0]); sum += gv[r]; }
            const float inv = 1.f / sum;
#pragma unroll
            for (int r = 0; r < 4; ++r) gv[r] *= inv;
            if (fq == 0) {
#pragma unroll
                for (int r = 0; r < 4; ++r) ls[r] = __hip_atomic_fetch_add(&lcnt[ti[r]], 1, __ATOMIC_RELAXED, __HIP_MEMORY_SCOPE_WORKGROUP);
            }
        }
        __syncthreads();
        if (tidx < 32) { const int c = lcnt[tidx]; lcnt[32 + tidx] = c ? (int)__hip_atomic_fetch_add(gcnt + tidx, (unsigned)c, __ATOMIC_RELAXED, __HIP_MEMORY_SCOPE_AGENT) : 0; }
        __syncthreads();
        if (kh == 0 && fq == 0) {
            int es[4];
#pragma unroll
            for (int r = 0; r < 4; ++r) { const int e = ti[r], sl = lcnt[32 + e] + ls[r]; rowtok_e[e * ECAP + sl] = token; rsc_e[e * ECAP + sl] = rs; es[r] = (e << 16) | sl; }
            *(int4*)(eslot + token * 4) = make_int4(es[0], es[1], es[2], es[3]);
            *(f32x4*)(topg + token * 4) = (f32x4){gv[0], gv[1], gv[2], gv[3]};
        }
        __syncthreads();
        if (tidx < 32) lcnt[tidx] = 0;
    }
    __syncthreads();
}

constexpr int NPL = 13;
constexpr int NPHASES = 1 + 2 * NPL;
typedef const __attribute__((address_space(4))) Args* KA;
#define PHASE __device__ __forceinline__
#define KAP() ({ KA _t = a; asm volatile("" : "+s"(_t)); _t; })
#define WSP(T, off) ((T*)(a->ws + (off)))

constexpr int NIT = 49152, NIT1 = 32768;
constexpr int QG = 9, QX = 13, QA = 11, QB = 8;
struct ConvBounds { int A1, A2, B1, B2, B3, B4; };
__device__ __forceinline__ int cmin(int a, int b) { return a < b ? a : b; }
__device__ __forceinline__ ConvBounds conv_bounds(int G, int T0) {
    ConvBounds b;
    const int Pg0 = G > 136 ? G - 136 : G, Px = G > 128 ? G - 128 : G;
    b.A1 = cmin(NIT, Pg0 * 8 * QG); b.A2 = cmin(NIT, b.A1 + Px * 8 * QX);
    const int r1 = (8 * T0) % G, r2 = (4 * T0) % G;
    b.B1 = cmin(NIT, r1 ? (G - r1) * 8 * QA : G * 8 * 2);
    b.B2 = cmin(NIT, b.B1 + (r2 ? (G - r2) * 8 * QB : G * 8 * 2));
    b.B3 = cmin(NIT, b.B2 + Px * 8 * QG); b.B4 = cmin(NIT, b.B3 + Px * 8 * QX);
    return b;
}
__device__ __forceinline__ void conv_moe(KA a, const int wv, int l, int begin, int end, int rank, int nranks) {
    if (begin >= end) return;
    const int wr = rank * NW + wv, ws_ = nranks * NW;
    if (begin < NIT1) p_transpose_r(wv, a->in[26] + (size_t)l * NEXP * DM * 2048, NEXP, DM, 2048, WSP(bf16_t, WS_BT1) + (size_t)l * NEXP * 2048 * DM, a->in[23] + l * DM, NEXP, 1, LDSP, begin, cmin(end, NIT1), wr, ws_);
    if (end > NIT1) { const int b2 = begin > NIT1 ? begin - NIT1 : 0;
        p_transpose_r(wv, a->in[28] + (size_t)l * NEXP * DFF * DM, NEXP, DFF, DM, WSP(bf16_t, WS_BT2) + (size_t)l * NEXP * DM * DFF, nullptr, 1, 0, LDSP, b2, end - NIT1, wr, ws_); }
}
__device__ __forceinline__ int moe_T_lds() { return __builtin_amdgcn_readfirstlane(((LAS const int*)(LDSP + TS_OFF))[32]); }
PHASE void ph_init(KA a, const int wv) {
    p_rowfinish<false, false>(wv, a->in[0], nullptr, nullptr, nullptr, nullptr, a->in[3], WSP(bf16_t, WS_XN16), nullptr);
    p_bias_table(wv, a->in[2], WSP(float, WS_BIASG), 152);
    for (int l = 0; l < 2; ++l) {
        p_s5_tables2(wv, a->in[5] + l * 2048, a->in[6] + l * 2048, a->in[7] + l * 32768, a->in[8] + l * 32768, a->in[9] + l * 32768, a->in[10] + l * 32768, a->in[11] + l * 32,
                     WSP(float2, WS_ABAR) + l * 2048, WSP(float2, WS_A256) + l * 2048, WSP(bf16_t, WS_BB16) + (size_t)l * 32 * 128 * 16, WSP(bf16_t, WS_CM16) + (size_t)l * 32 * 16 * 128, 160 + 32 * l);
        p_rmsnorm16(wv, a->in[1], a->in[19] + l * DM, WSP(bf16_t, WS_MEMN16) + (size_t)l * NMEM * DM, NMEM, 224 + 16 * l);
        p_router_tables(wv, a->in[24] + (size_t)l * DM * 32, a->in[23] + l * DM, WSP(bf16_t, WS_WR16) + (size_t)l * 2 * 32 * 1024, 160 + 64 * l);
    }
    p_transpose(wv, a->in[4], 2, DM, DIN, WSP(bf16_t, WS_WT_IN), nullptr, 1, 0, LDSP, 0);
    p_transpose(wv, a->in[13], 2, 512, 512, WSP(bf16_t, WS_WT_GLU), nullptr, 1, 0, LDSP, 0);
    p_transpose(wv, a->in[17], 2, DM, DM, WSP(bf16_t, WS_WT_OUT), nullptr, 1, 0, LDSP, 32);
    p_transpose(wv, a->in[20], 2, DM, 512, WSP(bf16_t, WS_WT_XQ), a->in[18], 1, 0, LDSP, 160);
    p_transpose(wv, a->in[21], 2, DM, 1024, WSP(bf16_t, WS_WT_XKV), nullptr, 1, 0, LDSP, 224);
    p_transpose(wv, a->in[22], 2, 512, DM, WSP(bf16_t, WS_WT_XO), nullptr, 1, 0, LDSP, 96);
    __syncthreads();
}
PHASE void ph_gemm_in(KA a, const int wv, int l) { LTID();
    DenseOrder S; S.init(WSP(bf16_t, WS_XN16), WSP(bf16_t, WS_WT_IN) + (size_t)l * DIN * DM, SEQ, DIN, DM, gridDim.x, bidx);
    EpiIn E{WSP(bf16_t, WS_PROJ16)};
    gemm_phase<EpiIn, DenseOrder, false, true>(LDSP, DM, S, E, tidx, wv);
}
PHASE void ph_attn_s5a(KA a, const int wv, int l) {
    p_dil_attn(wv, WSP(bf16_t, WS_PROJ16), WSP(float, WS_BIASG), WSP(bf16_t, WS_OBR), WSP(float, WS_LSE), LDSP);
    if (PROBE_DUP == 21) p_dil_attn(wv, WSP(bf16_t, WS_PROJ16), WSP(float, WS_BIASG), WSP(bf16_t, WS_OBR), WSP(float, WS_LSE), LDSP);
    if (PROBE_DUP == 22) { p_s5_pass<0>(wv, WSP(bf16_t, WS_PROJ16), WSP(float2, WS_ABAR) + l * 2048, WSP(float2, WS_A256) + l * 2048, WSP(bf16_t, WS_BB16) + (size_t)l * 32 * 128 * 16, WSP(bf16_t, WS_CM16) + (size_t)l * 32 * 16 * 128,
                 a->in[12] + l * 512, WSP(float2, WS_E2), WSP(bf16_t, WS_YG16), LDSP); __syncthreads(); }
    p_s5_pass<0>(wv, WSP(bf16_t, WS_PROJ16), WSP(float2, WS_ABAR) + l * 2048, WSP(float2, WS_A256) + l * 2048, WSP(bf16_t, WS_BB16) + (size_t)l * 32 * 128 * 16, WSP(bf16_t, WS_CM16) + (size_t)l * 32 * 16 * 128,
                 a->in[12] + l * 512, WSP(float2, WS_E2), WSP(bf16_t, WS_YG16), LDSP);
}
PHASE void ph_s5b(KA a, const int wv, int l) {
    p_s5_pass<1>(wv, WSP(bf16_t, WS_PROJ16), WSP(float2, WS_ABAR) + l * 2048, WSP(float2, WS_A256) + l * 2048, WSP(bf16_t, WS_BB16) + (size_t)l * 32 * 128 * 16, WSP(bf16_t, WS_CM16) + (size_t)l * 32 * 16 * 128,
                 a->in[12] + l * 512, WSP(float2, WS_E2), WSP(bf16_t, WS_YG16), LDSP);
}
PHASE void ph_gemm_glu(KA a, const int wv, int l) {
    {   LTID();
        DenseOrder S; S.init(WSP(bf16_t, WS_YG16), WSP(bf16_t, WS_WT_GLU) + (size_t)l * 512 * 512, SEQ, 512, 512, gridDim.x, bidx);
        EpiGlu16 E{WSP(bf16_t, WS_YB16), WSP(bf16_t, WS_YG16), a->in[14] + l * 512};
        gemm_phase<EpiGlu16, DenseOrder, false, false>(LDSP, 512, S, E, tidx, wv); }
    {   LTID();
    const int cc = (int)gridDim.x - 1 - bidx;
    if (l == 0 && cc < 8) {
        const int kl = cc >> 2;
        DenseOrder S; S.init(WSP(bf16_t, WS_MEMN16) + (size_t)kl * NMEM * DM, WSP(bf16_t, WS_WT_XKV) + (size_t)kl * 1024 * DM, NMEM, 1024, DM, 4, cc & 3);
        EpiBf16 E{WSP(bf16_t, WS_KV16) + (size_t)kl * NMEM * 1024, 1024, 1.f, nullptr};
        gemm_phase<EpiBf16, DenseOrder, false, false>(LDSP, DM, S, E, tidx, wv);
    } }
    {   LTID();
        const int G = (int)gridDim.x;
        int T0 = 0; if (l == 1) { moe_tiles(WSP(unsigned, WS_CTL) + CW_CNT, tidx); T0 = moe_T_lds(); }
        const ConvBounds cb = conv_bounds(G, T0);
        const int skip = (l == 0) ? 8 : 0;
        if (G > 128 + skip) { if (bidx >= 128 && bidx < G - skip) conv_moe(a, wv, l, l == 0 ? 0 : cb.B2, l == 0 ? cb.A1 : cb.B3, bidx - 128, G - 128 - skip); }
        else conv_moe(a, wv, l, l == 0 ? 0 : cb.B2, l == 0 ? cb.A1 : cb.B3, bidx, G);
    }
}
PHASE void ph_mixnorm(KA a, const int wv, int l) {
    p_attn_combine(wv, WSP(bf16_t, WS_OBR), WSP(float, WS_LSE), a->in[15] + l * 512, WSP(bf16_t, WS_MIX16));
    p_ssm_norm(wv, WSP(bf16_t, WS_YB16), a->in[16] + l * 512, WSP(bf16_t, WS_MIX16));
}
PHASE void ph_gemm_out(KA a, const int wv, int l) { LTID();
    DenseOrder S; S.init(WSP(bf16_t, WS_MIX16), WSP(bf16_t, WS_WT_OUT) + (size_t)l * DM * DM, SEQ, DM, DM, gridDim.x, bidx);
    EpiOut E{l == 0 ? a->in[0] : (const float*)WSP(float, WS_H), WSP(float, WS_H), WSP(bf16_t, WS_HB16), WSP(float, WS_SSP)};
    gemm_phase<EpiOut, DenseOrder, false, false>(LDSP, DM, S, E, tidx, wv);
}
PHASE void ph_gemm_xq(KA a, const int wv, int l) {
    {   LTID();
        DenseOrder S; S.init(WSP(bf16_t, WS_HB16), WSP(bf16_t, WS_WT_XQ) + (size_t)l * 512 * DM, SEQ, 512, DM, gridDim.x, bidx);
        EpiBf16 E{WSP(bf16_t, WS_QX16), 512, 0.08838834764831845f, WSP(float, WS_SSP)};
        gemm_phase<EpiBf16, DenseOrder, false, false>(LDSP, DM, S, E, tidx, wv); }
    {   LTID();
        const int G = (int)gridDim.x;
        int T0 = 0; if (l == 1) { moe_tiles(WSP(unsigned, WS_CTL) + CW_CNT, tidx); T0 = moe_T_lds(); }
        const ConvBounds cb = conv_bounds(G, T0);
        if (G > 128) { if (bidx >= 128) conv_moe(a, wv, l, l == 0 ? cb.A1 : cb.B3, l == 0 ? cb.A2 : cb.B4, bidx - 128, G - 128); }
        else conv_moe(a, wv, l, l == 0 ? cb.A1 : cb.B3, l == 0 ? cb.A2 : cb.B4, bidx, G);
    }
}
PHASE void ph_xattn(KA a, const int wv, int l) { p_xattn_mfma(wv, WSP(bf16_t, WS_QX16), WSP(bf16_t, WS_KV16) + (size_t)l * NMEM * 1024, WSP(bf16_t, WS_OX16), LDSP); }
PHASE void ph_gemm_xo(KA a, const int wv, int l) { LTID();
    DenseOrder S; S.init(WSP(bf16_t, WS_OX16), WSP(bf16_t, WS_WT_XO) + (size_t)l * DM * 512, SEQ, DM, 512, gridDim.x, bidx);
    EpiF32 E{WSP(float, WS_H), DM, 1};
    gemm_phase<EpiF32, DenseOrder, false, false>(LDSP, 512, S, E, tidx, wv);
}
PHASE void ph_router(KA a, const int wv, int l) {
    {   LTID();
        const int G = (int)gridDim.x;
        int T0 = 0; if (l == 1) { moe_tiles(WSP(unsigned, WS_CTL) + CW_CNT, tidx); T0 = moe_T_lds(); }
        const ConvBounds cb = conv_bounds(G, T0);
        conv_moe(a, wv, l, l == 0 ? cb.A2 : cb.B4, NIT, bidx, G);
        __syncthreads();
    }
    p_router2(wv, WSP(float, WS_H), WSP(bf16_t, WS_WR16) + (size_t)l * 2 * 32 * 1024, a->in[25] + l * 32, WSP(bf16_t, WS_HB16), WSP(unsigned, WS_CTL) + CW_CNT + l * 32,
              WSP(int, WS_ROWTOK), WSP(float, WS_RSC), WSP(int, WS_ESLOT), WSP(float, WS_TOPG), LDSP);
}
PHASE void ph_moe1(KA a, const int wv, int l) {
    {   LTID();
        moe_tiles(WSP(unsigned, WS_CTL) + CW_CNT + l * 32, tidx);
        MoeOrder<true> S; S.init(WSP(bf16_t, WS_HB16), WSP(bf16_t, WS_BT1) + (size_t)l * NEXP * 2048 * DM, WSP(int, WS_ROWTOK), 2048, DM, (size_t)2048 * DM * 2, gridDim.x, bidx);
        EpiMoe1 E{WSP(bf16_t, WS_ACT), a->in[27] + (size_t)l * NEXP * 2048, WSP(float, WS_RSC)};
        gemm_phase<EpiMoe1, MoeOrder<true>, true, true>(LDSP, DM, S, E, tidx, wv); }
    if (l == 0) { LTID();
        const int G = (int)gridDim.x, T0 = moe_T_lds(), r1 = (8 * T0) % G; const ConvBounds cb = conv_bounds(G, T0);
        if (r1) { if (bidx >= r1) conv_moe(a, wv, 1, 0, cb.B1, bidx - r1, G - r1); } else conv_moe(a, wv, 1, 0, cb.B1, bidx, G);
    }
}
PHASE void ph_moe2(KA a, const int wv, int l) {
    {   LTID();
        moe_tiles(WSP(unsigned, WS_CTL) + CW_CNT + l * 32, tidx);
        MoeOrder<false> S; S.init(WSP(bf16_t, WS_ACT), WSP(bf16_t, WS_BT2) + (size_t)l * NEXP * DM * DFF, nullptr, DM, DFF, (size_t)DM * DFF * 2, gridDim.x, bidx);
        EpiMoe2 E{WSP(bf16_t, WS_MOUT), a->in[29] + (size_t)l * NEXP * DM};
        gemm_phase<EpiMoe2, MoeOrder<false>, false, true>(LDSP, DFF, S, E, tidx, wv); }
    if (l == 0) { LTID();
        const int G = (int)gridDim.x, T0 = moe_T_lds(), r2 = (4 * T0) % G; const ConvBounds cb = conv_bounds(G, T0);
        if (r2) { if (bidx >= r2) conv_moe(a, wv, 1, cb.B1, cb.B2, bidx - r2, G - r2); } else conv_moe(a, wv, 1, cb.B1, cb.B2, bidx, G);
    }
}
PHASE void ph_combine(KA a, const int wv, int l) { LTID();
    moe_tiles(WSP(unsigned, WS_CTL) + CW_CNT + l * 32, tidx);
    if (l == 0) p_rowfinish<true, false>(wv, WSP(float, WS_H), WSP(float, WS_H), WSP(bf16_t, WS_MOUT), WSP(int, WS_ESLOT), WSP(float, WS_TOPG), a->in[3] + DM, WSP(bf16_t, WS_XN16), nullptr);
    else p_rowfinish<true, true>(wv, WSP(float, WS_H), nullptr, WSP(bf16_t, WS_MOUT), WSP(int, WS_ESLOT), WSP(float, WS_TOPG), a->in[30], nullptr, a->out);
}

__global__ void __launch_bounds__(NT, 2) mega(Args args) {
    KA a = (KA)__builtin_amdgcn_kernarg_segment_ptr();
    int wv = __builtin_amdgcn_readfirstlane((int)threadIdx.x >> 6); asm volatile("" : "+s"(wv));
    LAS unsigned char* lds = LDSP;
    volatile LAS unsigned* MISC = (volatile LAS unsigned*)(lds + MISC_OFF);
    unsigned* ctl = (unsigned*)(a->ws + WS_CTL);
    if (threadIdx.x < 32) MISC[threadIdx.x] = 0u;
    __syncthreads();
    XcdBarrier bar; bar.bar = ctl + CW_BAR; bar.x = 0; bar.st = nullptr;
    if (!MK_PER_PHASE) bar = xcd_barrier_post(ctl + CW_BAR, MISC + 8);
    const int lo = a->ph_lo, hi = a->ph_hi;
#define IN(k) (lo <= (k) && (k) < hi)
#define SEAM(k) do { if (IN(k) && IN((k) + 1)) { LTID(); xcd_barrier(bar.bar, bar.x, bar.st, tidx == 0); if (PROBE_DUP == 200) xcd_barrier(bar.bar, bar.x, bar.st, tidx == 0); } } while (0)
    if (IN(0)) { ph_init(KAP(), wv); if (PROBE_DUP == 100) ph_init(KAP(), wv); }
    SEAM(0);
#define LAYER_PROGRAM(l) { const int pb = 1 + (l) * NPL; \
        if (IN(pb + 0)) { ph_gemm_in(KAP(), wv, (l)); if (PROBE_DUP == 0) { ph_gemm_in(KAP(), wv, (l)); } } \
        SEAM(pb + 0); \
        if (IN(pb + 1)) { ph_attn_s5a(KAP(), wv, (l)); if (PROBE_DUP == 1) { ph_attn_s5a(KAP(), wv, (l)); } } \
        SEAM(pb + 1); \
        if (IN(pb + 2)) { ph_s5b(KAP(), wv, (l)); if (PROBE_DUP == 2) { ph_s5b(KAP(), wv, (l)); } } \
        SEAM(pb + 2); \
        if (IN(pb + 3)) { ph_gemm_glu(KAP(), wv, (l)); if (PROBE_DUP == 3) { ph_gemm_glu(KAP(), wv, (l)); } } \
        SEAM(pb + 3); \
        if (IN(pb + 4)) { ph_mixnorm(KAP(), wv, (l)); if (PROBE_DUP == 4) { ph_mixnorm(KAP(), wv, (l)); } } \
        SEAM(pb + 4); \
        if (IN(pb + 5)) { ph_gemm_out(KAP(), wv, (l)); if (PROBE_DUP == 5) { ph_gemm_out(KAP(), wv, (l)); } } \
        SEAM(pb + 5); \
        if (IN(pb + 6)) { ph_gemm_xq(KAP(), wv, (l)); if (PROBE_DUP == 6) { ph_gemm_xq(KAP(), wv, (l)); } } \
        SEAM(pb + 6); \
        if (IN(pb + 7)) { ph_xattn(KAP(), wv, (l)); if (PROBE_DUP == 7) { ph_xattn(KAP(), wv, (l)); } } \
        SEAM(pb + 7); \
        if (IN(pb + 8)) { ph_gemm_xo(KAP(), wv, (l)); if (PROBE_DUP == 8) { ph_gemm_xo(KAP(), wv, (l)); } } \
        SEAM(pb + 8); \
        if (IN(pb + 9)) { ph_router(KAP(), wv, (l)); if (PROBE_DUP == 9) { ph_router(KAP(), wv, (l)); } } \
        SEAM(pb + 9); \
        if (IN(pb + 10)) { ph_moe1(KAP(), wv, (l)); if (PROBE_DUP == 10) { ph_moe1(KAP(), wv, (l)); } } \
        SEAM(pb + 10); \
        if (IN(pb + 11)) { ph_moe2(KAP(), wv, (l)); if (PROBE_DUP == 11) { ph_moe2(KAP(), wv, (l)); } } \
        SEAM(pb + 11); \
        if (IN(pb + 12)) { ph_combine(KAP(), wv, (l)); if (PROBE_DUP == 12) { ph_combine(KAP(), wv, (l)); } } \
        SEAM(pb + 12); }
    LAYER_PROGRAM(0)
    LAYER_PROGRAM(1)
#undef LAYER_PROGRAM
#undef IN
#undef SEAM
}

extern "C" void kernel_launch(void* const* d_in, const int* in_sizes, int n_in, void* d_out, int out_size, void* d_ws, size_t ws_size, hipStream_t stream) {
    static int grid = 0;
    if (grid == 0) {
        if (n_in != 31 || ws_size < WS_END) { fprintf(stderr, "kernel_launch: unexpected n_in %d or ws_size %zu (need %zu)\n", n_in, ws_size, (size_t)WS_END); grid = -1; return; }
        int dev = 0, cus = 0, per_cu = 0;
        if (hipGetDevice(&dev) != hipSuccess || hipDeviceGetAttribute(&cus, hipDeviceAttributeMultiprocessorCount, dev) != hipSuccess) { grid = -1; return; }
        if (hipFuncSetAttribute((const void*)mega, hipFuncAttributeMaxDynamicSharedMemorySize, LDS_BYTES) != hipSuccess) { fprintf(stderr, "kernel_launch: hipFuncSetAttribute failed\n"); grid = -1; return; }
        if (hipOccupancyMaxActiveBlocksPerMultiprocessor(&per_cu, (const void*)mega, NT, LDS_BYTES) != hipSuccess || per_cu < 1)
            fprintf(stderr, "kernel_launch: occupancy query reports %d workgroups per CU\n", per_cu);
        (void)hipGetLastError();
        grid = cus;
    }
    if (grid < 0) return;
    if (hipMemsetAsync((char*)d_ws + WS_CTL, 0, CTL_ZERO_BYTES, stream) != hipSuccess) return;
    Args a{};
    for (int i = 0; i < 31; ++i) a.in[i] = (const float*)d_in[i];
    a.out = (float*)d_out; a.ws = (unsigned char*)d_ws;
#if MK_PER_PHASE
    for (int p = 0; p < NPHASES; ++p) { a.ph_lo = p; a.ph_hi = p + 1; hipLaunchKernelGGL(mega, dim3(grid), dim3(NT), LDS_BYTES, stream, a); }
#else
    a.ph_lo = 0; a.ph_hi = NPHASES;
    hipLaunchKernelGGL(mega, dim3(grid), dim3(NT), LDS_BYTES, stream, a);
#endif
}
```

```cpp
#include <hip/hip_runtime.h>
#include <stdint.h>
#include <cstdio>

#ifndef PROBE_DUP
#define PROBE_DUP -1
#endif
#ifndef MK_PER_PHASE
#define MK_PER_PHASE 0
#endif

#define SEQ 16384
#define DM 1024
#define DIN 2048
#define NMEM 256
#define NEXP 32
#define TOPK 4
#define DFF 1024
#define NT 512
#define NW 8

#define LAS __attribute__((address_space(3)))
typedef float f32x4 __attribute__((ext_vector_type(4)));
typedef float f32x2 __attribute__((ext_vector_type(2)));
extern __shared__ __attribute__((aligned(16))) unsigned char lds_raw[];
#define LDSP ((LAS unsigned char*)lds_raw)
#define LTID() int z_ = 0; asm volatile("" : "+v"(z_)); const int lane_ = (int)__builtin_amdgcn_mbcnt_hi(~0u, __builtin_amdgcn_mbcnt_lo(~0u, (unsigned)z_)); \
    const int tidx = wv * 64 + lane_; int bidx = blockIdx.x; asm volatile("" : "+s"(bidx))
#define ROTB(rot) ((bidx + (int)gridDim.x - (rot) % (int)gridDim.x) % (int)gridDim.x)
__device__ __forceinline__ float shx(float v, int mask, int lane) { return __builtin_bit_cast(float, __builtin_amdgcn_ds_bpermute((lane ^ mask) << 2, __builtin_bit_cast(int, v))); }
__device__ __forceinline__ int shxi(int v, int mask, int lane) { return __builtin_amdgcn_ds_bpermute((lane ^ mask) << 2, v); }
constexpr int LDS_BYTES = 147456;
constexpr int MISC_OFF = 131072 + 320;

#define XB_TMO      128
#define XB_XCNT(j)  (256  + 64 * (j))
#define XB_XSUB(j)  (1280 + 64 * (j))
#define XB_XGEN(j)  (2304 + 64 * (j))
#define XB_TOP      3328
#define XB_TOPGEN   3392
#define XCD_BAR_WORDS 3456
#define XB_SPIN_CAP (1u << 18)

__device__ __forceinline__ unsigned xb_ld(unsigned* p)              { return __hip_atomic_load(p, __ATOMIC_RELAXED, __HIP_MEMORY_SCOPE_AGENT); }
__device__ __forceinline__ unsigned xb_add(unsigned* p, unsigned v) { return __hip_atomic_fetch_add(p, v, __ATOMIC_RELAXED, __HIP_MEMORY_SCOPE_AGENT); }
__device__ __forceinline__ unsigned xb_xcc_id() { return (unsigned)__builtin_amdgcn_s_getreg((3 << 11) | 20) & 0xFu; }
#define XB_SPIN(cond, bar) do { unsigned _sp = 0; while (cond) { __builtin_amdgcn_s_sleep(1); \
    if ((++_sp & 255u) == 0u) { if (xb_ld(&(bar)[XB_TMO])) break; if (_sp > XB_SPIN_CAP) { atomicAdd(&(bar)[XB_TMO], 1u); break; } } } } while (0)

struct XcdBarrier {
    unsigned* bar; unsigned x;
    volatile LAS unsigned* st;
};
__device__ __forceinline__ XcdBarrier xcd_barrier_post(unsigned* bar, volatile LAS unsigned* st) {
    XcdBarrier b; b.bar = bar; b.x = xb_xcc_id(); b.st = st;
    if (threadIdx.x == 0) (void)xb_add(&bar[XB_XCNT(b.x)], 1u);
    return b;
}
__device__ __forceinline__ void xcd_barrier_complete(unsigned* bar, unsigned x, unsigned& nloc, unsigned& nx) {
    const unsigned G = gridDim.x * gridDim.y * gridDim.z;
    unsigned sum, cnt, mine, sp = 0u;
    for (;;) {
        sum = 0u; cnt = 0u; mine = 0u;
#pragma unroll
        for (unsigned j = 0; j < 16; ++j) { const unsigned c = xb_ld(&bar[XB_XCNT(j)]); sum += c; cnt += (c > 0u) ? 1u : 0u; mine = (j == x) ? c : mine; }
        if (sum == G) break;
        __builtin_amdgcn_s_sleep(1);
        if ((++sp & 255u) == 0u) { if (xb_ld(&bar[XB_TMO])) break; if (sp > XB_SPIN_CAP) { atomicAdd(&bar[XB_TMO], 1u); break; } }
    }
    nloc = mine > 0u ? mine : 1u; nx = cnt > 0u ? cnt : 1u;
}
__device__ __noinline__ void xcd_barrier(unsigned* bar_, unsigned x_, volatile LAS unsigned* st_, int is_t0) {
    XcdBarrier b; b.bar = bar_; b.x = x_; b.st = st_;
    asm volatile("s_waitcnt vmcnt(0)" ::: "memory");
    __syncthreads();
    if (is_t0) {
        unsigned* bar = b.bar;
        __builtin_amdgcn_s_waitcnt(0);
        unsigned nloc = b.st[0], nx = b.st[1];
        if (nloc == 0u) { xcd_barrier_complete(bar, b.x, nloc, nx); b.st[0] = nloc; b.st[1] = nx; }
        const unsigned old = xb_add(&bar[XB_XSUB(b.x)], 1u);
        const unsigned gen = old / nloc;
        if (old + 1u == (gen + 1u) * nloc) {
            __builtin_amdgcn_fence(__ATOMIC_RELEASE, "agent");
            asm volatile("s_waitcnt vmcnt(0)" ::: "memory");
            const unsigned og = xb_add(&bar[XB_TOP], 1u);
            const unsigned tg = og / nx;
            if (og + 1u == (tg + 1u) * nx) xb_add(&bar[XB_TOPGEN], 1u);
            else XB_SPIN(xb_ld(&bar[XB_TOPGEN]) == tg, bar);
            __builtin_amdgcn_fence(__ATOMIC_ACQUIRE, "agent");
            xb_add(&bar[XB_XGEN(b.x)], 1u);
            asm volatile("s_waitcnt vmcnt(0)" ::: "memory");
        } else {
            XB_SPIN(xb_ld(&bar[XB_XGEN(b.x)]) == gen, bar);
            __builtin_amdgcn_fence(__ATOMIC_ACQUIRE, "agent");
            asm volatile("s_waitcnt vmcnt(0)" ::: "memory");
        }
    }
    __syncthreads();
}

constexpr size_t MiB = 1u << 20;
constexpr size_t WS_CTL = 0, CTL_ZERO_BYTES = 1 * MiB;
constexpr int CW_BAR = 4096;
constexpr int CW_CNT = 8192;
constexpr int MOE_ROWS = SEQ * TOPK + NEXP * 256;
constexpr int ECAP = SEQ;
constexpr size_t al256(size_t x) { return (x + 255) & ~(size_t)255; }
constexpr size_t WS_H = 2 * MiB;
constexpr size_t WS_XN16 = WS_H + (size_t)SEQ * DM * 4;
constexpr size_t WS_HB16 = WS_XN16 + (size_t)SEQ * DM * 2;
constexpr size_t WS_PROJ16 = WS_HB16 + (size_t)SEQ * DM * 2;
constexpr size_t WS_OBR = WS_PROJ16 + (size_t)SEQ * 2048 * 2;
constexpr size_t WS_LSE = WS_OBR + 3 * (size_t)SEQ * 512 * 2;
constexpr size_t WS_YG16 = WS_LSE + 3 * (size_t)SEQ * 8 * 4;
constexpr size_t WS_YB16 = WS_YG16 + (size_t)SEQ * 512 * 2;
constexpr size_t WS_MIX16 = WS_YB16 + (size_t)SEQ * 512 * 2;
constexpr size_t WS_QX16 = WS_MIX16 + (size_t)SEQ * DM * 2;
constexpr size_t WS_OX16 = WS_QX16 + (size_t)SEQ * 512 * 2;
constexpr size_t WS_ACT = WS_OX16 + (size_t)SEQ * 512 * 2;
constexpr size_t WS_MOUT = WS_ACT + (size_t)MOE_ROWS * DFF * 2;
constexpr size_t WS_BT1 = WS_MOUT + (size_t)MOE_ROWS * DM * 2;
constexpr size_t WS_BT2 = WS_BT1 + 2 * (size_t)NEXP * 2048 * DM * 2;
constexpr size_t WS_WT_IN = WS_BT2 + 2 * (size_t)NEXP * DM * DFF * 2;
constexpr size_t WS_WT_GLU = WS_WT_IN + 2 * (size_t)2048 * 1024 * 2;
constexpr size_t WS_WT_OUT = WS_WT_GLU + 2 * (size_t)512 * 512 * 2;
constexpr size_t WS_WT_XQ = WS_WT_OUT + 2 * (size_t)1024 * 1024 * 2;
constexpr size_t WS_WT_XKV = WS_WT_XQ + 2 * (size_t)512 * 1024 * 2;
constexpr size_t WS_WT_XO = WS_WT_XKV + 2 * (size_t)1024 * 1024 * 2;
constexpr size_t WS_MEMN16 = WS_WT_XO + 2 * (size_t)1024 * 512 * 2;
constexpr size_t WS_KV16 = WS_MEMN16 + 2 * (size_t)NMEM * 1024 * 2;
constexpr size_t WS_WR16 = WS_KV16 + 2 * (size_t)NMEM * 1024 * 2;
constexpr size_t WS_BIASG = WS_WR16 + 2 * 2 * (size_t)32 * 1024 * 2;
constexpr size_t WS_ABAR = al256(WS_BIASG + 24 * 132 * 4);
constexpr size_t WS_A256 = WS_ABAR + 2 * 2048 * 8;
constexpr size_t WS_BB16 = WS_A256 + 2 * 2048 * 8;
constexpr size_t WS_CM16 = WS_BB16 + 2 * (size_t)32 * 128 * 16 * 2;
constexpr size_t WS_E2 = WS_CM16 + 2 * (size_t)32 * 16 * 128 * 2;
constexpr size_t WS_ROWTOK = WS_E2 + (size_t)64 * 2048 * 8;
constexpr size_t WS_RSC = WS_ROWTOK + (size_t)NEXP * ECAP * 4;
constexpr size_t WS_ESLOT = WS_RSC + (size_t)NEXP * ECAP * 4;
constexpr size_t WS_TOPG = WS_ESLOT + (size_t)SEQ * 4 * 4;
constexpr size_t WS_SSP = WS_TOPG + (size_t)SEQ * 4 * 4;
constexpr size_t WS_END = WS_SSP + (size_t)SEQ * 16 * 4;

struct Args { const float* in[31]; float* out; unsigned char* ws; int ph_lo, ph_hi; };


typedef unsigned short bf16_t;
typedef short bf16x8 __attribute__((ext_vector_type(8)));
typedef unsigned u32x4 __attribute__((ext_vector_type(4)));
typedef unsigned u32x2 __attribute__((ext_vector_type(2)));
constexpr int BM = 256, BK = 64, HALF = 128, HTB = HALF * BK * 2, STAGE_BYTES = 8 * HTB, NXCD = 8, WGM = 4, WGM_MOE = 1;
__host__ __device__ __forceinline__ int lds_byte(int r, int c) { const int st = (r >> 4) * 2 + (c >> 5), rr = r & 15, cc = c & 31, ob = rr * 64 + cc * 2; return st * 1024 + (ob ^ (((ob >> 9) & 1) << 5)); }
__host__ __device__ __forceinline__ void stage_rc(int b, int& R, int& C) { const int st = b / 1024, sb = b % 1024, swz = sb ^ (((sb >> 9) & 1) << 5); R = (st >> 1) * 16 + swz / 64; C = (st & 1) * 32 + (swz % 64) / 2; }
__host__ __device__ __forceinline__ int perm32(int rho) { const int n = rho >> 4, i = rho & 15; return 8 * (i >> 2) + 4 * n + (i & 3); }
__device__ __forceinline__ unsigned cvt_pk_bf16(float lo, float hi) { unsigned r; asm volatile("v_cvt_pk_bf16_f32 %0, %1, %2" : "=v"(r) : "v"(lo), "v"(hi)); return r; }
__device__ __forceinline__ unsigned f2bf(float f) { unsigned u = __builtin_bit_cast(unsigned, f); return (u + 0x7fffu + ((u >> 16) & 1u)) >> 16; }
__device__ __forceinline__ unsigned pk2(float lo, float hi) { return f2bf(lo) | (f2bf(hi) << 16); }
__device__ __forceinline__ float bf2f(unsigned short b) { return __builtin_bit_cast(float, ((unsigned)b) << 16); }

__device__ __forceinline__ void glds16s(const void* sbase, unsigned voff, unsigned lds_dst) {
    unsigned keep;
    asm volatile("s_mov_b32 %0, m0\n\ts_mov_b32 m0, %3\n\ts_nop 0\n\tglobal_load_lds_dwordx4 %1, %2\n\ts_mov_b32 m0, %0" : "=&s"(keep) : "v"(voff), "s"(sbase), "s"(lds_dst) : "memory");
}
struct GUnit { const char* A; const char* B; int pm, pn, e, row0, cnt; };

struct DenseOrder {
    const char* A; const char* Bt; int nM, nN, nwg, G, c, K;
    __device__ __forceinline__ void init(const bf16_t* A_, const bf16_t* Bt_, int M, int N, int K_, int G_, int c_) { A = (const char*)A_; Bt = (const char*)Bt_; nM = M / BM; nN = N / BM; nwg = nM * nN; G = G_; c = c_; K = K_; }
    __device__ __forceinline__ bool next(int i, GUnit& u) const {
        const long L = (long)i * G + c; if (L >= nwg) return false;
        int wgid = (int)L; { const int q = nwg / NXCD, r = nwg % NXCD, xcd = wgid % NXCD, off = wgid / NXCD; wgid = (xcd < r ? xcd * (q + 1) : r * (q + 1) + (xcd - r) * q) + off; }
        const int nig = WGM * nN, gid = wgid / nig, fm = gid * WGM, gsz = (nM - fm) < WGM ? (nM - fm) : WGM;
        u.pm = fm + ((wgid % nig) % gsz); u.pn = (wgid % nig) / gsz; u.e = 0; u.row0 = 0; u.cnt = 0;
        u.A = A + (size_t)u.pm * BM * K * 2; u.B = Bt + (size_t)u.pn * BM * K * 2; return true;
    }
    __device__ __forceinline__ unsigned aoff(const GUnit&, int row) const { return (unsigned)(row * K * 2); }
    __device__ __forceinline__ unsigned tokoff(const GUnit&, int) const { return 0u; }
    __device__ __forceinline__ const int* tokbase() const { return nullptr; }
};

struct EpiF32 {
    static constexpr bool PERM = false;
    float* C; int ldc; int resid;
    __device__ __forceinline__ void operator()(const f32x4 (&acc)[2][2][4][2], const GUnit& u, int wr, int wc, int fr, int fq) const {
        const int row0 = u.pm * BM + wr * 64 + fr, col0 = u.pn * BM + wc * 32 + 4 * fq;
#pragma unroll
        for (int ai = 0; ai < 2; ++ai)
#pragma unroll
            for (int m = 0; m < 4; ++m) { float* rowp = C + (size_t)(row0 + ai * HALF + m * 16) * ldc + col0;
#pragma unroll
                for (int bj = 0; bj < 2; ++bj)
#pragma unroll
                    for (int n = 0; n < 2; ++n) { f32x4 v = acc[ai][bj][m][n]; if (resid) v += *(const f32x4*)(rowp + bj * HALF + n * 16); *(f32x4*)(rowp + bj * HALF + n * 16) = v; } }
    }
};
struct EpiGlu {
    static constexpr bool PERM = false;
    float* C; const float* Y; int ldc; const float* bias;
    __device__ __forceinline__ void operator()(const f32x4 (&acc)[2][2][4][2], const GUnit& u, int wr, int wc, int fr, int fq) const {
        const int row0 = u.pm * BM + wr * 64 + fr, col0 = u.pn * BM + wc * 32 + 4 * fq;
#pragma unroll
        for (int ai = 0; ai < 2; ++ai)
#pragma unroll
            for (int m = 0; m < 4; ++m) { const size_t ro = (size_t)(row0 + ai * HALF + m * 16) * ldc + col0;
#pragma unroll
                for (int bj = 0; bj < 2; ++bj)
#pragma unroll
                    for (int n = 0; n < 2; ++n) { const f32x4 b = *(const f32x4*)(bias + col0 + bj * HALF + n * 16); const f32x4 y = *(const f32x4*)(Y + ro + bj * HALF + n * 16);
                        f32x4 v = acc[ai][bj][m][n] + b; f32x4 o;
#pragma unroll
                        for (int j = 0; j < 4; ++j) o[j] = y[j] / (1.f + __expf(-v[j]));
                        *(f32x4*)(C + ro + bj * HALF + n * 16) = o; } }
    }
};

template <class Epi, class Sched, bool GATHER, bool ALIGN_EPI>
__device__ __forceinline__ void gemm_phase(LAS unsigned char* lds, const int K, const Sched& S, const Epi& E, const int tid, const int wv) {
    const int wid = wv, lane = tid & 63, wr = wid >> 2, wc = wid & 3, fr = lane & 15, fq = lane >> 4;
    const int nt = K / BK;
    unsigned voffB[2];
#pragma unroll
    for (int i = 0; i < 2; ++i) { int R, C; stage_rc(tid * 16 + i * 8192, R, C); const int Rb = Epi::PERM ? ((R & ~31) + perm32(R & 31)) : R; voffB[i] = (unsigned)(Rb * K + C) * 2u; }
#define PG8_AOFFS(dst, u) do { int t2_ = tid; asm volatile("" : "+v"(t2_)); _Pragma("unroll") for (int i = 0; i < 2; ++i) { int R, C; stage_rc(t2_ * 16 + i * 8192, R, C); \
        _Pragma("unroll") for (int h = 0; h < 2; ++h) dst[h][i] = S.aoff(u, h * HALF + R) + (unsigned)C * 2u; } } while (0)
    const size_t kstep = (size_t)(BK * 2);
    const size_t hstep = (size_t)HALF * K * 2;
    const unsigned ldsw = (unsigned)wid * 1024u;
    const int aoff = lds_byte(wr * 64 + fr, fq * 8), boff = lds_byte(wc * 32 + fr, fq * 8);
#define PG8_SA(b, h) (((b) * 2 + (h)) * HTB)
#define PG8_SB(b, h) ((4 + (b) * 2 + (h)) * HTB)
#define PG8_STAGE(bufoff, gbase, v0, v1) do { const unsigned ld_ = (unsigned)(size_t)(lds + (bufoff) + ldsw); glds16s((gbase), (v0), ld_); glds16s((gbase), (v1), ld_ + 8192u); } while (0)
#define PG8_LDA(dst, b, h) do { _Pragma("unroll") for (int m = 0; m < 4; ++m) _Pragma("unroll") for (int k = 0; k < 2; ++k) dst[m][k] = *(const LAS bf16x8*)(lds + PG8_SA(b, h) + aoff + m * 2048 + k * 1024); } while (0)
#define PG8_LDB(dst, b, h) do { _Pragma("unroll") for (int n = 0; n < 2; ++n) _Pragma("unroll") for (int k = 0; k < 2; ++k) dst[n][k] = *(const LAS bf16x8*)(lds + PG8_SB(b, h) + boff + n * 2048 + k * 1024); } while (0)
#define PG8_MMA(ai, bj, At, Bt) do { __builtin_amdgcn_s_setprio(1); _Pragma("unroll") for (int m = 0; m < 4; ++m) _Pragma("unroll") for (int n = 0; n < 2; ++n) _Pragma("unroll") for (int k = 0; k < 2; ++k) \
        acc[ai][bj][m][n] = __builtin_amdgcn_mfma_f32_16x16x32_bf16(Bt[n][k], At[m][k], acc[ai][bj][m][n], 0, 0, 0); __builtin_amdgcn_s_setprio(0); } while (0)
#define PG8_WAIT_V(n) asm volatile("s_waitcnt vmcnt(" #n ")" ::: "memory")
#define PG8_WAIT_L(n) asm volatile("s_waitcnt lgkmcnt(" #n ")" ::: "memory")
#define PG8_BAR __builtin_amdgcn_s_barrier()
#define PG8_SCHED __builtin_amdgcn_sched_barrier(0)
    GUnit cur, nxt; int ui = 0;
    if (!S.next(0, cur)) return;
    f32x4 acc[2][2][4][2];
#pragma unroll
    for (int a = 0; a < 2; ++a)
#pragma unroll
        for (int b = 0; b < 2; ++b)
#pragma unroll
            for (int m = 0; m < 4; ++m)
#pragma unroll
                for (int n = 0; n < 2; ++n) acc[a][b][m][n] = (f32x4){0.f, 0.f, 0.f, 0.f};
    bf16x8 At[4][2], B0[2][2], B1[2][2];
    unsigned vA[2][2], vN[2][2];
    PG8_AOFFS(vA, cur);
#pragma unroll
    for (int h = 0; h < 2; ++h)
#pragma unroll
        for (int i = 0; i < 2; ++i) vN[h][i] = vA[h][i];
    const char* cA = cur.A; const char* cB = cur.B;
    PG8_STAGE(PG8_SB(0, 0), cB, voffB[0], voffB[1]); PG8_STAGE(PG8_SB(0, 1), cB + hstep, voffB[0], voffB[1]); PG8_STAGE(PG8_SA(0, 0), cA, vA[0][0], vA[0][1]); PG8_STAGE(PG8_SA(0, 1), cA, vA[1][0], vA[1][1]);
    if (wr == 1) PG8_BAR;
    PG8_WAIT_V(2); PG8_BAR;
    PG8_STAGE(PG8_SB(1, 0), cB + kstep, voffB[0], voffB[1]); PG8_STAGE(PG8_SA(1, 0), cA + kstep, vA[0][0], vA[0][1]); PG8_STAGE(PG8_SB(1, 1), cB + hstep + kstep, voffB[0], voffB[1]);
    PG8_WAIT_V(6); PG8_BAR;
    for (;;) {
        const bool has_next = S.next(ui + 1, nxt);
        const char* nA = GATHER ? cA : (has_next ? nxt.A : cA); const char* nB = has_next ? nxt.B : cB;
        unsigned tok_[2][2] = {{0u, 0u}, {0u, 0u}};
#define PG8_KBODY(a1, a2, b2, a3, b3, W00, W01, W10, W11) do { \
              \
            PG8_LDB(B0, 0, 0); PG8_LDB(B1, 0, 1); PG8_SCHED; PG8_LDA(At, 0, 0); PG8_STAGE(PG8_SA(1, 1), a1, vA[1][0], vA[1][1]); \
            PG8_WAIT_V(8); PG8_WAIT_L(0); PG8_BAR; PG8_MMA(0, 0, At, B0); PG8_MMA(0, 1, At, B1); PG8_BAR; PG8_SCHED; \
              \
            PG8_LDA(At, 0, 1); PG8_STAGE(PG8_SB(0, 0), b2, voffB[0], voffB[1]); PG8_STAGE(PG8_SB(0, 1), (b2) + hstep, voffB[0], voffB[1]); PG8_STAGE(PG8_SA(0, 0), a2, W00, W01); \
            PG8_WAIT_V(8); PG8_WAIT_L(0); PG8_BAR; PG8_MMA(1, 0, At, B0); PG8_MMA(1, 1, At, B1); PG8_BAR; PG8_SCHED; \
              \
            PG8_LDB(B0, 1, 0); PG8_LDB(B1, 1, 1); PG8_SCHED; PG8_LDA(At, 1, 0); PG8_STAGE(PG8_SA(0, 1), a2, W10, W11); \
            PG8_WAIT_V(8); PG8_WAIT_L(0); PG8_BAR; PG8_MMA(0, 0, At, B0); PG8_MMA(0, 1, At, B1); PG8_BAR; PG8_SCHED; \
              \
            PG8_LDA(At, 1, 1); PG8_STAGE(PG8_SB(1, 0), b3, voffB[0], voffB[1]); PG8_STAGE(PG8_SB(1, 1), (b3) + hstep, voffB[0], voffB[1]); PG8_STAGE(PG8_SA(1, 0), a3, W00, W01); \
            PG8_WAIT_V(8); PG8_WAIT_L(0); PG8_BAR; PG8_MMA(1, 0, At, B0); PG8_MMA(1, 1, At, B1); PG8_BAR; PG8_SCHED; } while (0)
        for (int t = 0; t < nt - 2; t += 2) {
            const char* a1 = cA + (size_t)(t + 1) * kstep;
            const char* a2 = cA + (size_t)(t + 2) * kstep; const char* b2 = cB + (size_t)(t + 2) * kstep;
            const char* a3 = a2 + kstep; const char* b3 = b2 + kstep;
            if (GATHER) { if (t == nt - 4 && has_next) { int t2_ = tid; asm volatile("" : "+v"(t2_));
#pragma unroll
                for (int i = 0; i < 2; ++i) { int R, C; stage_rc(t2_ * 16 + i * 8192, R, C);
#pragma unroll
                    for (int h = 0; h < 2; ++h) { const unsigned vo = S.tokoff(nxt, h * HALF + R); asm volatile("global_load_dword %0, %1, %2" : "=v"(tok_[h][i]) : "v"(vo), "s"(S.tokbase()) : "memory"); } } } }
            PG8_KBODY(a1, a2, b2, a3, b3, vA[0][0], vA[0][1], vA[1][0], vA[1][1]);
        }
        if (GATHER) {
            if (has_next) { int t2_ = tid; asm volatile("" : "+v"(t2_), "+v"(tok_[0][0]), "+v"(tok_[0][1]), "+v"(tok_[1][0]), "+v"(tok_[1][1]));
#pragma unroll
                for (int i = 0; i < 2; ++i) { int R, C; stage_rc(t2_ * 16 + i * 8192, R, C);
#pragma unroll
                    for (int h = 0; h < 2; ++h) vN[h][i] = tok_[h][i] * (unsigned)(K * 2) + (unsigned)C * 2u; } }
            else {
#pragma unroll
                for (int h = 0; h < 2; ++h)
#pragma unroll
                    for (int i = 0; i < 2; ++i) vN[h][i] = vA[h][i];
            }
        }
        {
            const char* a1 = cA + (size_t)(nt - 1) * kstep;
            const char* a3 = nA + kstep; const char* b3 = nB + kstep;
            PG8_KBODY(a1, nA, nB, a3, b3, vN[0][0], vN[0][1], vN[1][0], vN[1][1]);
        }
#undef PG8_KBODY
        if constexpr (ALIGN_EPI) { if (wr == 0) PG8_BAR; }
        { int t3_ = tid; asm volatile("" : "+v"(t3_)); const int l3_ = t3_ & 63; E(acc, cur, wr, wc, l3_ & 15, l3_ >> 4); }
        if (!has_next) break;
#pragma unroll
        for (int a = 0; a < 2; ++a)
#pragma unroll
            for (int b = 0; b < 2; ++b)
#pragma unroll
                for (int m = 0; m < 4; ++m)
#pragma unroll
                    for (int n = 0; n < 2; ++n) acc[a][b][m][n] = (f32x4){0.f, 0.f, 0.f, 0.f};
        cur = nxt; cA = nA; cB = nB; ++ui;
        if (GATHER) {
#pragma unroll
            for (int h = 0; h < 2; ++h)
#pragma unroll
                for (int i = 0; i < 2; ++i) vA[h][i] = vN[h][i];
        }
        if constexpr (ALIGN_EPI) { if (wr == 1) PG8_BAR; }
    }
    PG8_WAIT_V(0);
    if constexpr (!ALIGN_EPI) { if (wr == 0) PG8_BAR; }
    PG8_BAR;
#undef PG8_AOFFS
#undef PG8_SA
#undef PG8_SB
#undef PG8_STAGE
#undef PG8_LDA
#undef PG8_LDB
#undef PG8_MMA
#undef PG8_WAIT_V
#undef PG8_WAIT_L
#undef PG8_BAR
#undef PG8_SCHED
}


constexpr int TS_OFF = 131072 + 1024;
template <bool GATHER> struct MoeOrder {
    const char* A; const char* Bt; const int* rowtok; int nN, nwg, nM, G, c, K; size_t strideE;
    __device__ __forceinline__ void init(const bf16_t* A_, const bf16_t* Bt_, const int* rowtok_, int N, int K_, size_t strideE_, int G_, int c_) {
        A = (const char*)A_; Bt = (const char*)Bt_; rowtok = rowtok_; nN = N / BM; K = K_; strideE = strideE_; G = G_; c = c_;
        nM = __builtin_amdgcn_readfirstlane(((LAS const int*)(LDSP + TS_OFF))[32]); nwg = nM * nN; }
    __device__ __forceinline__ bool next(int i, GUnit& u) const {
        const long L = (long)i * G + c; if (L >= nwg) return false;
        int wgid = (int)L; { const int q = nwg / NXCD, r = nwg % NXCD, xcd = wgid % NXCD, off = wgid / NXCD; wgid = (xcd < r ? xcd * (q + 1) : r * (q + 1) + (xcd - r) * q) + off; }
        const int nig = WGM_MOE * nN, gid = wgid / nig, fm = gid * WGM_MOE, gsz = (nM - fm) < WGM_MOE ? (nM - fm) : WGM_MOE;
        u.pm = fm + ((wgid % nig) % gsz); u.pn = (wgid % nig) / gsz;
        LAS const int* ts = (LAS const int*)(LDSP + TS_OFF);
        const int e = __builtin_amdgcn_readfirstlane(ts[72 + u.pm]);
        u.e = e; u.row0 = (u.pm - __builtin_amdgcn_readfirstlane(ts[e])) * BM; u.cnt = __builtin_amdgcn_readfirstlane(ts[33 + e]);
        u.A = GATHER ? A : A + (size_t)u.pm * BM * K * 2;
        u.B = Bt + (size_t)e * strideE + (size_t)u.pn * BM * K * 2; return true;
    }
    __device__ __forceinline__ unsigned aoff(const GUnit& u, int row) const {
        if (GATHER) { int sl = u.row0 + row; sl = sl < u.cnt ? sl : u.cnt - 1; return (unsigned)rowtok[u.e * ECAP + sl] * (unsigned)(K * 2); }
        return (unsigned)(row * K * 2);
    }
    __device__ __forceinline__ unsigned tokoff(const GUnit& u, int row) const { int sl = u.row0 + row; sl = sl < u.cnt ? sl : u.cnt - 1; return (unsigned)(u.e * ECAP + sl) * 4u; }
    __device__ __forceinline__ const int* tokbase() const { return rowtok; }
};
__device__ __forceinline__ void moe_tiles(const unsigned* cnt, int tid) {
    LAS int* ts = (LAS int*)(LDSP + TS_OFF);
    if (tid == 0) { int s = 0; for (int e = 0; e < NEXP; ++e) { const int c = (int)cnt[e]; ts[e] = s; ts[33 + e] = c; const int n = (c + BM - 1) / BM;
_Pragma("clang loop vectorize(disable) unroll(disable)") for (int t = 0; t < n; ++t) ts[72 + s + t] = e;
            s += n; } ts[NEXP] = s; }
    __syncthreads();
}
struct EpiMoe1 {
    static constexpr bool PERM = true;
    bf16_t* O; const float* b1; const float* rsc;
    __device__ __forceinline__ void operator()(const f32x4 (&acc)[2][2][4][2], const GUnit& u, int wr, int wc, int fr, int fq) const {
        const int rt0 = wr * 64 + fr, col0 = u.pn * 128 + wc * 32 + 8 * fq;
        const float* bg = b1 + (size_t)u.e * 2048 + col0;
        f32x4 bgv[2], blv[2];
#pragma unroll
        for (int n = 0; n < 2; ++n) { bgv[n] = *(const f32x4*)(bg + 4 * n); blv[n] = *(const f32x4*)(bg + DFF + 4 * n); }
#pragma unroll
        for (int ai = 0; ai < 2; ++ai)
#pragma unroll
            for (int m = 0; m < 4; ++m) {
                const int rt = rt0 + ai * HALF + m * 16; int sl = u.row0 + rt; sl = sl < u.cnt ? sl : u.cnt - 1;
                const float r = rsc[u.e * ECAP + sl];
                float o[8];
                const f32x2 r2 = (f32x2){r, r};
#pragma unroll
                for (int n = 0; n < 2; ++n)
#pragma unroll
                    for (int jp = 0; jp < 2; ++jp) {
                        const f32x2 ag = (f32x2){acc[ai][0][m][n][2 * jp], acc[ai][0][m][n][2 * jp + 1]}, al = (f32x2){acc[ai][1][m][n][2 * jp], acc[ai][1][m][n][2 * jp + 1]};
                        f32x2 g = ag * r2 + (f32x2){bgv[n][2 * jp], bgv[n][2 * jp + 1]}, l = al * r2 + (f32x2){blv[n][2 * jp], blv[n][2 * jp + 1]};
                        g.x = fminf(g.x, 7.f); g.y = fminf(g.y, 7.f);
                        l.x = __builtin_amdgcn_fmed3f(l.x, -7.f, 7.f); l.y = __builtin_amdgcn_fmed3f(l.y, -7.f, 7.f);
                        const f32x2 z = g * (-2.4554669595930157f);
                        f32x2 e; e.x = __builtin_amdgcn_exp2f(z.x); e.y = __builtin_amdgcn_exp2f(z.y);
                        e = e + 1.0f;
                        f32x2 q; q.x = __builtin_amdgcn_rcpf(e.x); q.y = __builtin_amdgcn_rcpf(e.y);
                        const f32x2 v = (g * q) * (l + 1.0f);
                        o[n * 4 + 2 * jp] = v.x; o[n * 4 + 2 * jp + 1] = v.y;
                    }
                u32x4 w; w.x = cvt_pk_bf16(o[0], o[1]); w.y = cvt_pk_bf16(o[2], o[3]); w.z = cvt_pk_bf16(o[4], o[5]); w.w = cvt_pk_bf16(o[6], o[7]);
                *(u32x4*)(O + (size_t)(u.pm * BM + rt) * DFF + col0) = w;
            }
    }
};
struct EpiMoe2 {
    static constexpr bool PERM = true;
    bf16_t* O; const float* b2;
    __device__ __forceinline__ void operator()(const f32x4 (&acc)[2][2][4][2], const GUnit& u, int wr, int wc, int fr, int fq) const {
        const int row0 = u.pm * BM + wr * 64 + fr, col0 = u.pn * BM + wc * 32 + 8 * fq;
        f32x4 bv[2][2];
#pragma unroll
        for (int bj = 0; bj < 2; ++bj)
#pragma unroll
            for (int n = 0; n < 2; ++n) bv[bj][n] = *(const f32x4*)(b2 + (size_t)u.e * DM + col0 + bj * HALF + 4 * n);
#pragma unroll
        for (int ai = 0; ai < 2; ++ai)
#pragma unroll
            for (int m = 0; m < 4; ++m) { bf16_t* rowp = O + (size_t)(row0 + ai * HALF + m * 16) * DM + col0;
#pragma unroll
                for (int bj = 0; bj < 2; ++bj) { const f32x4 v0 = acc[ai][bj][m][0] + bv[bj][0], v1 = acc[ai][bj][m][1] + bv[bj][1];
                    u32x4 w; w.x = cvt_pk_bf16(v0[0], v0[1]); w.y = cvt_pk_bf16(v0[2], v0[3]); w.z = cvt_pk_bf16(v1[0], v1[1]); w.w = cvt_pk_bf16(v1[2], v1[3]);
                    *(u32x4*)(rowp + bj * HALF) = w; } }
    }
};

__device__ __forceinline__ void p_transpose_r(const int wv, const float* W, int nmat, int K, int N, bf16_t* WT, const float* kgain, int gdiv, int mode, LAS unsigned char* lds, int it_begin, int it_end, int wrank, int wstride) {
    LTID();
    const int wave = wv, lane = tidx & 63;
    LAS float* scr = (LAS float*)(lds + wave * 16384);
    const int nblk = N / 32, per_mat = (K / 64) * nblk, total = it_end, stride = wstride;
    const int lrow = lane >> 5, lcol = lane & 31;
#define TR_DECODE(item, mat_, kb_, nb_) const int mat_ = (item) / per_mat, r_ = (item) - mat_ * per_mat, g8_ = r_ >> 3, l8_ = r_ & 7, kb_ = 2 * (g8_ / (nblk >> 2)) + (l8_ & 1), nb_ = 4 * (g8_ % (nblk >> 2)) + (l8_ >> 1)
#define TR_ISSUE(item, dst) do { TR_DECODE(item, mat_, kb_, nb_); \
        const float* src_ = W + (size_t)mat_ * K * N + (size_t)(64 * kb_ + lrow) * N + 32 * nb_ + lcol; \
        _Pragma("unroll") for (int i = 0; i < 32; ++i) dst[i] = __builtin_nontemporal_load(src_ + (size_t)(2 * i) * N); } while (0)
    float v[32], vn[32], vnn[32];
    int it = it_begin + wrank;
    if (it < total) TR_ISSUE(it, v);
    if (it + stride < total) TR_ISSUE(it + stride, vn);
    while (it < total) {
        const int itn = it + stride, itnn = itn + stride;
        if (itnn < total) TR_ISSUE(itnn, vnn);
        TR_DECODE(it, mat, kb, nb); const int k0 = 64 * kb, n0 = 32 * nb;
#pragma unroll
        for (int i = 0; i < 32; ++i) scr[(2 * i + lrow) * 33 + lcol] = v[i];
        asm volatile("s_waitcnt lgkmcnt(0)" ::: "memory");
        int d0 = n0;
        if (mode == 1) { const int bj = n0 >> 10, rest = n0 & 1023, pn = rest >> 7, j = rest & 127; d0 = pn * 256 + bj * 128 + j; }
        const int c = lane & 7;
        f32x4 g0 = (f32x4){1.f, 1.f, 1.f, 1.f}, g1 = g0;
        if (kgain) { const float* gp = kgain + (size_t)(mat / gdiv) * DM + k0 + 8 * c; g0 = *(const f32x4*)gp; g1 = *(const f32x4*)(gp + 4); }
        bf16_t* dst = WT + (size_t)mat * K * N;
#pragma unroll
        for (int j = 0; j < 4; ++j) { const int n = (lane >> 3) + 8 * j; const LAS float* sp = scr + (8 * c) * 33 + n;
            u32x4 o; o.x = cvt_pk_bf16(sp[0 * 33] * g0[0], sp[1 * 33] * g0[1]); o.y = cvt_pk_bf16(sp[2 * 33] * g0[2], sp[3 * 33] * g0[3]); o.z = cvt_pk_bf16(sp[4 * 33] * g1[0], sp[5 * 33] * g1[1]); o.w = cvt_pk_bf16(sp[6 * 33] * g1[2], sp[7 * 33] * g1[3]);
            __builtin_nontemporal_store(o, (u32x4*)(dst + (size_t)(d0 + n) * K + k0 + 8 * c)); }
        asm volatile("s_waitcnt lgkmcnt(0)" ::: "memory");
#pragma unroll
        for (int i = 0; i < 32; ++i) { v[i] = vn[i]; vn[i] = vnn[i]; }
        it = itn;
    }
#undef TR_ISSUE
#undef TR_DECODE
}
__device__ __forceinline__ void p_transpose(const int wv, const float* W, int nmat, int K, int N, bf16_t* WT, const float* kgain, int gdiv, int mode, LAS unsigned char* lds, int rot) {
    const int G_ = (int)gridDim.x, b_ = ((int)blockIdx.x + G_ - rot % G_) % G_;
    p_transpose_r(wv, W, nmat, K, N, WT, kgain, gdiv, mode, lds, 0, nmat * (K / 64) * (N / 32), b_ * NW + wv, G_ * NW);
}
typedef short v4i16_t __attribute__((ext_vector_type(4)));
constexpr int ATT_TAB_OFF = 131072 + 2048;
constexpr int ATT_UNITS = 3 * 8 * 128;
__device__ __forceinline__ int t5_bucket_dev(int n) {
    if (n < 16) return n;
    const float v = logf((float)n / 16.f) / 4.852030263919617f * 16.f;
    const int large = 16 + (int)v;
    return large < 31 ? large : 31;
}
__device__ __forceinline__ void p_bias_table(const int wv, const float* rel_bias, float* biasG, int rot) {
    LTID();
    for (int i = ROTB(rot) * NT + tidx; i < 3 * 8 * 132; i += gridDim.x * NT) {
        const int d = i % 132, bh = i / 132, h = bh & 7, b = bh >> 3;
        biasG[i] = (d <= 128) ? rel_bias[t5_bucket_dev(d << (2 * b)) * 8 + h] * 1.4426950408889634f : 0.f;
    }
}
__device__ __forceinline__ void p_dil_attn(const int wv, const bf16_t* proj16, const float* biasG, bf16_t* obr, float* lse, LAS unsigned char* lds) {
    LTID();
    const int lane = tidx & 63, fr = lane & 15, fq = lane >> 4, w = wv;
    const int per = (ATT_UNITS + (int)gridDim.x - 1) / (int)gridDim.x;
    const int u0 = bidx * per, u1 = (u0 + per < ATT_UNITS) ? u0 + per : ATT_UNITS;
    if (u0 >= u1) return;
    const int rowl = tidx >> 3, cs = tidx & 7;
    const unsigned cK = (unsigned)(cs ^ ((rowl >> 1) & 7)) * 16u, cV = (unsigned)(cs ^ (rowl & 7)) * 16u;
    const unsigned fK = (unsigned)((fr >> 1) & 7);
    const unsigned kro0 = (unsigned)fr * 128u + (((unsigned)fq ^ fK) * 16u), kro1 = (unsigned)fr * 128u + ((((unsigned)fq ^ fK) ^ 4u) * 16u);
    const int tq = (lane & 15) >> 2, tp = lane & 3, fv = 4 * (fq & 1) + tq;
    unsigned vro[4];
#pragma unroll
    for (int db = 0; db < 4; ++db) vro[db] = (unsigned)(4 * fq + tq) * 128u + (unsigned)(((2 * db + (tp >> 1)) ^ fv) * 16) + 8u * (unsigned)(tp & 1);
    const int ts_ = (1 + fr) & 3;
    const unsigned tab8 = (unsigned)ATT_TAB_OFF + (unsigned)ts_ * 640u + (unsigned)(((141 + fr - ts_) >> 2) - fq - 32) * 16u;
    const char* gbase = (const char*)proj16;
#define ATT_DECODE(u, b_, h_, r_, n_, dil_) const int cmb_ = (u) >> 7, b_ = cmb_ >> 3, h_ = cmb_ & 7, dil_ = 1 << (2 * b_), idx_ = (u) & 127, r_ = idx_ & (dil_ - 1), n_ = idx_ >> (2 * b_)
#define ATT_ISSUE(u, bf, q0, q1) do { ATT_DECODE(u, b__, h__, r__, n__, dil__); \
        const int nk = n__ > 0 ? n__ - 1 : 0;                                     \
        _Pragma("unroll") for (int p = 0; p < 4; ++p) { \
            int row = 64 * p + rowl; int blk = (row >> 7) ? n__ : nk; \
            const unsigned pos = (unsigned)(r__ + dil__ * (128 * blk + (row & 127))); \
            const unsigned so = pos * 4096u + (unsigned)h__ * 128u; const unsigned ld_ = (unsigned)(size_t)(lds + (bf) * 65536 + p * 8192 + w * 1024); \
            glds16s(gbase, so + 1024u + cK, ld_); glds16s(gbase, so + 2048u + cV, ld_ + 32768u); } \
        const unsigned qpos = (unsigned)(r__ + dil__ * (128 * n__ + 16 * w + fr)); \
        const char* qsrc = gbase + (size_t)qpos * 4096u + (unsigned)h__ * 128u + (unsigned)fq * 16u; \
        q0 = *(const bf16x8*)(qsrc); q1 = *(const bf16x8*)(qsrc + 64); } while (0)
    bf16x8 qf0, qf1, qn0, qn1;
    ATT_ISSUE(u0, 0, qn0, qn1);
    int prev_cmb = -1;
    for (int u = u0; u < u1; ++u) {
        const int bf = (u - u0) & 1;
        asm volatile("s_waitcnt vmcnt(0)" ::: "memory");
        __syncthreads();
        qf0 = qn0; qf1 = qn1;
        if (u + 1 < u1) ATT_ISSUE(u + 1, bf ^ 1, qn0, qn1);
        ATT_DECODE(u, b, h, r, n, dil);
        if (cmb_ != prev_cmb) {
            prev_cmb = cmb_;
            for (int e = tidx; e < 4 * 160; e += NT) { const int sft = e / 160, k = e - sft * 160, idx = k + sft, dist = idx - 16;
                const float v = (dist >= 0 && dist <= 128) ? biasG[cmb_ * 132 + dist] : -1e30f;
                ((LAS float*)(lds + ATT_TAB_OFF))[sft * 160 + k] = v; }
            __syncthreads();
        }
        const LAS unsigned char* Kb = lds + bf * 65536; const LAS unsigned char* Vb = Kb + 32768;
        const int kb0 = w;
        f32x4 sc[9];
#pragma unroll
        for (int i = 0; i < 9; ++i) {
            const unsigned ko = (unsigned)(kb0 + i) * 2048u;
            const bf16x8 k0 = *(const LAS bf16x8*)(Kb + ko + kro0), k1 = *(const LAS bf16x8*)(Kb + ko + kro1);
            f32x4 a = (f32x4){0.f, 0.f, 0.f, 0.f};
            a = __builtin_amdgcn_mfma_f32_16x16x32_bf16(k0, qf0, a, 0, 0, 0);
            a = __builtin_amdgcn_mfma_f32_16x16x32_bf16(k1, qf1, a, 0, 0, 0);
            const f32x4 t = *(const LAS f32x4*)(lds + tab8 + 64 * (8 - i));
            a = a + (f32x4){t[3], t[2], t[1], t[0]};
            if (n == 0 && kb0 + i < 8) a = (f32x4){-1e30f, -1e30f, -1e30f, -1e30f};
            sc[i] = a;
        }
#pragma unroll
        for (int i = 0; i < 9; ++i)
#pragma unroll
            for (int j = 0; j < 4; ++j) sc[i][j] = __builtin_amdgcn_exp2f(fminf(sc[i][j], 100.f));
        f32x4 oacc[4]; f32x4 sacc = (f32x4){0.f, 0.f, 0.f, 0.f};
        const bf16x8 ones = (bf16x8){0x3F80, 0x3F80, 0x3F80, 0x3F80, 0x3F80, 0x3F80, 0x3F80, 0x3F80};
#pragma unroll
        for (int db = 0; db < 4; ++db) oacc[db] = (f32x4){0.f, 0.f, 0.f, 0.f};
#pragma unroll
        for (int c = 0; c < 5; ++c) {
            const int ia = 2 * c, ib = (c < 4) ? 2 * c + 1 : 8;
            u32x4 pw; pw.x = cvt_pk_bf16(sc[ia][0], sc[ia][1]); pw.y = cvt_pk_bf16(sc[ia][2], sc[ia][3]);
            if (c < 4) { pw.z = cvt_pk_bf16(sc[ib][0], sc[ib][1]); pw.w = cvt_pk_bf16(sc[ib][2], sc[ib][3]); } else { pw.z = 0u; pw.w = 0u; }
            const bf16x8 pf = __builtin_bit_cast(bf16x8, pw);
            const unsigned va = (unsigned)(kb0 + ia) * 2048u, vb = (unsigned)(kb0 + ib) * 2048u;
            sacc = __builtin_amdgcn_mfma_f32_16x16x32_bf16(ones, pf, sacc, 0, 0, 0);
#pragma unroll
            for (int db = 0; db < 4; ++db) {
                const v4i16_t x0 = __builtin_amdgcn_ds_read_tr16_b64_v4i16((LAS v4i16_t*)(Vb + va + vro[db]));
                const v4i16_t x1 = __builtin_amdgcn_ds_read_tr16_b64_v4i16((LAS v4i16_t*)(Vb + vb + vro[db]));
                const bf16x8 vf = (bf16x8){x0[0], x0[1], x0[2], x0[3], x1[0], x1[1], x1[2], x1[3]};
                oacc[db] = __builtin_amdgcn_mfma_f32_16x16x32_bf16(vf, pf, oacc[db], 0, 0, 0);
            }
        }
        const float sum = sacc[0];
        const float inv = 1.f / sum;
        const unsigned qpos = (unsigned)(r + dil * (128 * n + 16 * w + fr));
        bf16_t* orow = obr + ((size_t)b * SEQ + qpos) * 512 + h * 64 + 4 * fq;
#pragma unroll
        for (int db = 0; db < 4; ++db) { u32x2 o2; o2.x = cvt_pk_bf16(oacc[db][0] * inv, oacc[db][1] * inv); o2.y = cvt_pk_bf16(oacc[db][2] * inv, oacc[db][3] * inv); *(u32x2*)(orow + 16 * db) = o2; }
        if (fq == 0) lse[((size_t)b * SEQ + qpos) * 8 + h] = sum;
    }
    asm volatile("s_waitcnt vmcnt(0)" ::: "memory");
    __syncthreads();
#undef ATT_DECODE
#undef ATT_ISSUE
}
__device__ __forceinline__ void p_attn_combine(const int wv, const bf16_t* obr, const float* lse, const float* g, bf16_t* mix16) {
    LTID();
    const int lane = tidx & 63, h = lane >> 3;
    const f32x4 g0 = *(const f32x4*)(g + lane * 8), g1 = *(const f32x4*)(g + lane * 8 + 4);
    const int rstride = (int)gridDim.x * NW;
    for (int row0 = bidx * NW + wv; row0 < SEQ; row0 += 4 * rstride) {
        float lv[4][3]; u32x4 av[4][3];
#pragma unroll
        for (int r = 0; r < 4; ++r) { const int row = (row0 + r * rstride < SEQ) ? row0 + r * rstride : row0;
#pragma unroll
            for (int b = 0; b < 3; ++b) { lv[r][b] = lse[((size_t)b * SEQ + row) * 8 + h]; av[r][b] = *(const u32x4*)(obr + ((size_t)b * SEQ + row) * 512 + lane * 8); } }
#pragma unroll
        for (int r = 0; r < 4; ++r) {
            const int row = row0 + r * rstride;
            float w0 = lv[r][0], w1 = lv[r][1], w2 = lv[r][2];
            const float iw = 1.f / (w0 + w1 + w2); w0 *= iw; w1 *= iw; w2 *= iw;
            float y[8]; float ss = 0.f;
#pragma unroll
            for (int k = 0; k < 4; ++k) {
                const float lo = w0 * __builtin_bit_cast(float, av[r][0][k] << 16) + w1 * __builtin_bit_cast(float, av[r][1][k] << 16) + w2 * __builtin_bit_cast(float, av[r][2][k] << 16);
                const float hi = w0 * __builtin_bit_cast(float, av[r][0][k] & 0xffff0000u) + w1 * __builtin_bit_cast(float, av[r][1][k] & 0xffff0000u) + w2 * __builtin_bit_cast(float, av[r][2][k] & 0xffff0000u);
                y[2 * k] = lo; y[2 * k + 1] = hi; ss += lo * lo + hi * hi;
            }
#pragma unroll
            for (int o = 32; o; o >>= 1) ss += shx(ss, o, lane);
            const float sc = rsqrtf(ss * (1.f / 512.f) + 1e-5f);
            u32x4 o4; o4.x = cvt_pk_bf16(y[0] * sc * g0[0], y[1] * sc * g0[1]); o4.y = cvt_pk_bf16(y[2] * sc * g0[2], y[3] * sc * g0[3]);
            o4.z = cvt_pk_bf16(y[4] * sc * g1[0], y[5] * sc * g1[1]); o4.w = cvt_pk_bf16(y[6] * sc * g1[2], y[7] * sc * g1[3]);
            if (row < SEQ) *(u32x4*)(mix16 + (size_t)row * DM + lane * 8) = o4;
        }
    }
}
struct EpiIn {
    static constexpr bool PERM = true;
    bf16_t* O;
    __device__ __forceinline__ void operator()(const f32x4 (&acc)[2][2][4][2], const GUnit& u, int wr, int wc, int fr, int fq) const {
        const int row0 = u.pm * BM + wr * 64 + fr, col0 = u.pn * BM + wc * 32 + 8 * fq;
        const float sc = u.pn < 2 ? 0.18033688011112042f : 1.f;
#pragma unroll
        for (int ai = 0; ai < 2; ++ai)
#pragma unroll
            for (int m = 0; m < 4; ++m) { const size_t ro = (size_t)(row0 + ai * HALF + m * 16) * DIN + col0;
#pragma unroll
                for (int bj = 0; bj < 2; ++bj) { const f32x4 v0 = acc[ai][bj][m][0] * sc, v1 = acc[ai][bj][m][1] * sc;
                    u32x4 w; w.x = cvt_pk_bf16(v0[0], v0[1]); w.y = cvt_pk_bf16(v0[2], v0[3]); w.z = cvt_pk_bf16(v1[0], v1[1]); w.w = cvt_pk_bf16(v1[2], v1[3]);
                    *(u32x4*)(O + ro + bj * HALF) = w;
                    } }
    }
};


__device__ __forceinline__ unsigned xoff_b(unsigned row, unsigned ch) { return 256u * row + 16u * (ch ^ (((row & 3u) << 2) | ((row >> 2) & 3u))); }
__device__ __forceinline__ void p_xattn_mfma(const int wv, const bf16_t* qx16, const bf16_t* kv16, bf16_t* ox16, LAS unsigned char* lds) {
    LTID();
    const int lane = tidx & 63, fr = lane & 15, fq = lane >> 4, w = wv;
    const int NU = 4 * 128;
    const int per = (NU + (int)gridDim.x - 1) / (int)gridDim.x;
    const int u0 = bidx * per, u1 = (u0 + per < NU) ? u0 + per : NU;
    if (u0 >= u1) return;
    const int rowl = tidx >> 4, cs = tidx & 15;
    const unsigned csw = (unsigned)(cs ^ (((rowl & 3) << 2) | ((rowl >> 2) & 3))) * 16u;
    const unsigned kswz = (unsigned)(((fr & 3) << 2) | ((fr >> 2) & 3));
    unsigned kro[4];
#pragma unroll
    for (int s4 = 0; s4 < 4; ++s4) kro[s4] = 256u * (unsigned)fr + 16u * ((unsigned)(4 * s4 + fq) ^ kswz);
    const int tq = (lane & 15) >> 2, tp = lane & 3;
    const unsigned vswz = (unsigned)((tq << 2) | fq);
    unsigned vro[8];
#pragma unroll
    for (int c = 0; c < 8; ++c) vro[c] = 65536u + 256u * (unsigned)(4 * fq + tq) + 16u * ((unsigned)(2 * c + (tp >> 1)) ^ vswz) + 8u * (unsigned)(tp & 1);
    int prev_h = -1;
    for (int u = u0; u < u1; ++u) {
        const int h = u >> 7, qt = u & 127;
        if (h != prev_h) {
            __syncthreads();
            prev_h = h;
#pragma unroll
            for (int p = 0; p < 8; ++p) {
                const unsigned row = (unsigned)(32 * p + rowl);
                const unsigned so = row * 2048u + (unsigned)h * 256u + csw;
                const unsigned ld_ = (unsigned)(size_t)(lds + p * 8192 + w * 1024);
                glds16s(kv16, so, ld_); glds16s(kv16, so + 1024u, ld_ + 65536u);
            }
            asm volatile("s_waitcnt vmcnt(0)" ::: "memory");
            __syncthreads();
        }
        const char* qsrc = (const char*)qx16 + ((size_t)(qt * 128 + 16 * w + fr) * 512 + h * 128 + 8 * fq) * 2;
        bf16x8 qf[4];
#pragma unroll
        for (int s4 = 0; s4 < 4; ++s4) qf[s4] = *(const bf16x8*)(qsrc + 64 * s4);
        f32x4 sc[16];
#pragma unroll
        for (int i = 0; i < 16; ++i) {
            f32x4 a = (f32x4){0.f, 0.f, 0.f, 0.f};
#pragma unroll
            for (int s4 = 0; s4 < 4; ++s4) { const bf16x8 kf = *(const LAS bf16x8*)(lds + i * 4096 + kro[s4]); a = __builtin_amdgcn_mfma_f32_16x16x32_bf16(kf, qf[s4], a, 0, 0, 0); }
            sc[i] = a;
        }
        float mx = -1e30f;
#pragma unroll
        for (int i = 0; i < 16; ++i) mx = fmaxf(mx, fmaxf(fmaxf(sc[i][0], sc[i][1]), fmaxf(sc[i][2], sc[i][3])));
        mx = fmaxf(mx, shx(mx, 16, lane)); mx = fmaxf(mx, shx(mx, 32, lane));
        float sum = 0.f;
#pragma unroll
        for (int i = 0; i < 16; ++i)
#pragma unroll
            for (int j = 0; j < 4; ++j) { const float p = __expf(sc[i][j] - mx); sc[i][j] = p; sum += p; }
        sum += shx(sum, 16, lane); sum += shx(sum, 32, lane);
        f32x4 oacc[8];
#pragma unroll
        for (int c = 0; c < 8; ++c) oacc[c] = (f32x4){0.f, 0.f, 0.f, 0.f};
#pragma unroll
        for (int ch = 0; ch < 8; ++ch) {
            const int ia = 2 * ch, ib = 2 * ch + 1;
            u32x4 pw; pw.x = cvt_pk_bf16(sc[ia][0], sc[ia][1]); pw.y = cvt_pk_bf16(sc[ia][2], sc[ia][3]); pw.z = cvt_pk_bf16(sc[ib][0], sc[ib][1]); pw.w = cvt_pk_bf16(sc[ib][2], sc[ib][3]);
            const bf16x8 pf = __builtin_bit_cast(bf16x8, pw);
#pragma unroll
            for (int c = 0; c < 8; ++c) {
                const v4i16_t x0 = __builtin_amdgcn_ds_read_tr16_b64_v4i16((LAS v4i16_t*)(lds + ia * 4096 + vro[c]));
                const v4i16_t x1 = __builtin_amdgcn_ds_read_tr16_b64_v4i16((LAS v4i16_t*)(lds + ib * 4096 + vro[c]));
                const bf16x8 vf = (bf16x8){x0[0], x0[1], x0[2], x0[3], x1[0], x1[1], x1[2], x1[3]};
                oacc[c] = __builtin_amdgcn_mfma_f32_16x16x32_bf16(vf, pf, oacc[c], 0, 0, 0);
            }
        }
        const float inv = 1.f / sum;
        bf16_t* orow = ox16 + (size_t)(qt * 128 + 16 * w + fr) * 512 + h * 128 + 4 * fq;
#pragma unroll
        for (int c = 0; c < 8; ++c) { u32x2 o2; o2.x = cvt_pk_bf16(oacc[c][0] * inv, oacc[c][1] * inv); o2.y = cvt_pk_bf16(oacc[c][2] * inv, oacc[c][3] * inv); *(u32x2*)(orow + 16 * c) = o2; }
    }
    __syncthreads();
}
struct EpiBf16 {
    static constexpr bool PERM = true;
    bf16_t* O; int ldc; float scale; const float* ss;
    __device__ __forceinline__ void operator()(const f32x4 (&acc)[2][2][4][2], const GUnit& u, int wr, int wc, int fr, int fq) const {
        const int row0 = u.pm * BM + wr * 64 + fr, col0 = u.pn * BM + wc * 32 + 8 * fq;
#pragma unroll
        for (int ai = 0; ai < 2; ++ai)
#pragma unroll
            for (int m = 0; m < 4; ++m) { const int row = row0 + ai * HALF + m * 16; bf16_t* rowp = O + (size_t)row * ldc + col0;
                float sc = scale;
                if (ss) { const f32x4 p0 = *(const f32x4*)(ss + (size_t)row * 16), p1 = *(const f32x4*)(ss + (size_t)row * 16 + 4), p2 = *(const f32x4*)(ss + (size_t)row * 16 + 8), p3 = *(const f32x4*)(ss + (size_t)row * 16 + 12);
                    const float t = ((p0[0] + p0[1]) + (p0[2] + p0[3])) + ((p1[0] + p1[1]) + (p1[2] + p1[3])) + ((p2[0] + p2[1]) + (p2[2] + p2[3])) + ((p3[0] + p3[1]) + (p3[2] + p3[3]));
                    sc = scale * rsqrtf(t * (1.f / 1024.f) + 1e-5f); }
#pragma unroll
                for (int bj = 0; bj < 2; ++bj) { const f32x4 v0 = acc[ai][bj][m][0] * sc, v1 = acc[ai][bj][m][1] * sc;
                    u32x4 w; w.x = cvt_pk_bf16(v0[0], v0[1]); w.y = cvt_pk_bf16(v0[2], v0[3]); w.z = cvt_pk_bf16(v1[0], v1[1]); w.w = cvt_pk_bf16(v1[2], v1[3]);
                    *(u32x4*)(rowp + bj * HALF) = w; } }
    }
};
struct EpiOut {
    static constexpr bool PERM = true;
    const float* R; float* H; bf16_t* HB; float* ss;
    __device__ __forceinline__ void operator()(const f32x4 (&acc)[2][2][4][2], const GUnit& u, int wr, int wc, int fr, int fq) const {
        const int row0 = u.pm * BM + wr * 64 + fr, col0 = u.pn * BM + wc * 32 + 8 * fq, lane = fq * 16 + fr;
#pragma unroll
        for (int ai = 0; ai < 2; ++ai)
#pragma unroll
            for (int m = 0; m < 4; ++m) { const int row = row0 + ai * HALF + m * 16; const size_t ro = (size_t)row * DM + col0; float sq = 0.f;
#pragma unroll
                for (int bj = 0; bj < 2; ++bj) {
                    const f32x4 v0 = acc[ai][bj][m][0] + *(const f32x4*)(R + ro + bj * HALF), v1 = acc[ai][bj][m][1] + *(const f32x4*)(R + ro + bj * HALF + 4);
                    *(f32x4*)(H + ro + bj * HALF) = v0; *(f32x4*)(H + ro + bj * HALF + 4) = v1;
                    u32x4 w; w.x = cvt_pk_bf16(v0[0], v0[1]); w.y = cvt_pk_bf16(v0[2], v0[3]); w.z = cvt_pk_bf16(v1[0], v1[1]); w.w = cvt_pk_bf16(v1[2], v1[3]);
                    *(u32x4*)(HB + ro + bj * HALF) = w;
                    sq += (v0[0] * v0[0] + v0[1] * v0[1]) + (v0[2] * v0[2] + v0[3] * v0[3]) + (v1[0] * v1[0] + v1[1] * v1[1]) + (v1[2] * v1[2] + v1[3] * v1[3]);
                }
                sq += shx(sq, 16, lane); sq += shx(sq, 32, lane);
                if (fq == 0) ss[(size_t)row * 16 + u.pn * 4 + wc] = sq;
            }
    }
};

typedef short bf16x4 __attribute__((ext_vector_type(4)));
constexpr int S5_CHUNK = 256, S5_NCH = SEQ / S5_CHUNK, S5_ROWB = 528;
__device__ __forceinline__ f32x2 gelu_pk(f32x2 v) {
    const f32x2 av = __builtin_elementwise_abs(v), d = av * 0.2316418882f + 1.0f;
    f32x2 t; t.x = __builtin_amdgcn_rcpf(d.x); t.y = __builtin_amdgcn_rcpf(d.y);
    f32x2 q = t * 0.5307027145f + (-0.7265760135f); q = q * t + 0.7107068705f; q = q * t + (-0.142248368f); q = q * t + 0.127414796f; q = q * t;
    const f32x2 s2 = (v * v) * (-0.72134752044f);
    f32x2 e; e.x = __builtin_amdgcn_exp2f(s2.x); e.y = __builtin_amdgcn_exp2f(s2.y);
    const f32x2 m = v * (q * e), r = v - m;
    f32x2 o; o.x = v.x < 0.f ? m.x : r.x; o.y = v.y < 0.f ? m.y : r.y; return o;
}
__device__ __forceinline__ void p_s5_tables2(const int wv, const float* a_re, const float* a_im, const float* b_re, const float* b_im, const float* c_re, const float* c_im, const float* log_dt,
                                             float2* abar, float2* a256, bf16_t* BB16, bf16_t* CM16, int rot) {
    LTID();
    for (int i = ROTB(rot) * NT + tidx; i < 2048 * 16; i += gridDim.x * NT) {
        const int gp = i >> 4, c = i & 15, g = gp >> 6, p = gp & 63;
        const float lr = a_re[gp], li = a_im[gp], dt = expf(log_dt[g]);
        const float mag = expf(lr * dt); float sn, cs; sincosf(li * dt, &sn, &cs);
        const float ar = mag * cs, ai = mag * sn;
        if (c == 0) {
            abar[gp] = make_float2(ar, ai);
            float pr = ar, pi = ai;
            for (int k = 0; k < 8; ++k) { const float nr = pr * pr - pi * pi, ni = 2.f * pr * pi; pr = nr; pi = ni; }
            a256[gp] = make_float2(pr, pi);
        }
        const float nr = ar - 1.f, ni = ai, den = lr * lr + li * li;
        const float cr = (nr * lr + ni * li) / den, ci = (ni * lr - nr * li) / den;
        const float br = b_re[gp * 16 + c], bi = b_im[gp * 16 + c];
        BB16[((size_t)g * 128 + p) * 16 + c] = (bf16_t)f2bf(cr * br - ci * bi);
        BB16[((size_t)g * 128 + 64 + p) * 16 + c] = (bf16_t)f2bf(cr * bi + ci * br);
        CM16[((size_t)g * 16 + c) * 128 + p] = (bf16_t)f2bf(c_re[(g * 16 + c) * 64 + p]);
        CM16[((size_t)g * 16 + c) * 128 + 64 + p] = (bf16_t)f2bf(-c_im[(g * 16 + c) * 64 + p]);
    }
}
template <int MODE> __device__ __forceinline__ void p_s5_pass(const int wv, const bf16_t* proj16, const float2* abar, const float2* a256, const bf16_t* BB16, const bf16_t* CM16, const float* dskip,
                                                              float2* E, bf16_t* yg16, LAS unsigned char* lds) {
    LTID();
    const int lane = tidx & 63, fr = lane & 15, fq = lane >> 4;
    LAS unsigned char* L = lds + wv * (16 * S5_ROWB);
    for (int unit = bidx * NW + wv; unit < S5_NCH * 32; unit += gridDim.x * NW) {
        const int g = unit & 31, chunk = unit >> 5;
        const float2 a = abar[g * 64 + lane];
        bf16x4 bbf[8];
#pragma unroll
        for (int cb = 0; cb < 8; ++cb) bbf[cb] = *(const bf16x4*)(BB16 + ((size_t)g * 128 + 16 * cb + fr) * 16 + 4 * fq);
        bf16x8 cmf[4]; f32x4 dsk = (f32x4){0.f, 0.f, 0.f, 0.f};
        if (MODE == 1) {
#pragma unroll
            for (int s4 = 0; s4 < 4; ++s4) cmf[s4] = *(const bf16x8*)(CM16 + ((size_t)g * 16 + fr) * 128 + 32 * s4 + 8 * fq);
            dsk = *(const f32x4*)(dskip + g * 16 + 4 * fq);
        }
        float sr = 0.f, si = 0.f;
        if (MODE == 1) {
            const float2 A = a256[g * 64 + lane];
            for (int j0 = 0; j0 < chunk; j0 += 16) {
                float2 e[16];
#pragma unroll
                for (int k = 0; k < 16; ++k) { const int j = (j0 + k < chunk) ? j0 + k : chunk - 1; e[k] = E[((size_t)j * 32 + g) * 64 + lane]; }
#pragma unroll
                for (int k = 0; k < 16; ++k) if (j0 + k < chunk) { const float nr = A.x * sr - A.y * si + e[k].x, ni = A.x * si + A.y * sr + e[k].y; sr = nr; si = ni; }
            }
        }
        const bf16_t* ubase = proj16 + (size_t)(chunk * S5_CHUNK + fr) * DIN + 1536 + g * 16 + 4 * fq;
        bf16x4 uf = *(const bf16x4*)ubase;
#pragma unroll 1
        for (int blk = 0; blk < S5_CHUNK / 16; ++blk) {
            const bf16x4 ufn = *(const bf16x4*)(ubase + (size_t)((blk < S5_CHUNK / 16 - 1) ? (blk + 1) * 16 : blk * 16) * DIN);
            asm volatile("" ::: "memory");
#pragma unroll
            for (int cb = 0; cb < 8; ++cb) {
                const f32x4 d = __builtin_amdgcn_mfma_f32_16x16x16bf16_1k(bbf[cb], uf, (f32x4){0.f, 0.f, 0.f, 0.f}, 0, 0, 0);
                *(LAS f32x4*)(L + fr * S5_ROWB + (16 * cb + 4 * fq) * 4) = d;
            }
            asm volatile("" ::: "memory");
#pragma unroll
            for (int t = 0; t < 16; ++t) {
                const float re = *(const LAS float*)(L + t * S5_ROWB + lane * 4), im = *(const LAS float*)(L + t * S5_ROWB + 256 + lane * 4);
                const float nr = a.x * sr - a.y * si + re, ni = a.x * si + a.y * sr + im; sr = nr; si = ni;
                if (MODE == 1) { *(LAS bf16_t*)(L + t * S5_ROWB + lane * 2) = (bf16_t)f2bf(sr); *(LAS bf16_t*)(L + t * S5_ROWB + 128 + lane * 2) = (bf16_t)f2bf(si); }
            }
            asm volatile("" ::: "memory");
            if (MODE == 1) {
                f32x4 y = (f32x4){0.f, 0.f, 0.f, 0.f};
#pragma unroll
                for (int s4 = 0; s4 < 4; ++s4) { const bf16x8 sf = *(const LAS bf16x8*)(L + fr * S5_ROWB + 64 * s4 + 16 * fq); y = __builtin_amdgcn_mfma_f32_16x16x32_bf16(cmf[s4], sf, y, 0, 0, 0); }
                f32x4 v;
#pragma unroll
                for (int j = 0; j < 4; ++j) v[j] = y[j] + dsk[j] * bf2f((unsigned short)uf[j]);
                const f32x2 g0 = gelu_pk((f32x2){v[0], v[1]}), g1 = gelu_pk((f32x2){v[2], v[3]});
                u32x2 o2; o2.x = cvt_pk_bf16(g0.x, g0.y); o2.y = cvt_pk_bf16(g1.x, g1.y);
                *(u32x2*)(yg16 + (size_t)(chunk * S5_CHUNK + blk * 16 + fr) * 512 + g * 16 + 4 * fq) = o2;
            }
            asm volatile("" ::: "memory");
            uf = ufn;
        }
        if (MODE == 0) E[((size_t)chunk * 32 + g) * 64 + lane] = make_float2(sr, si);
    }
}
struct EpiGlu16 {
    static constexpr bool PERM = true;
    bf16_t* O; const bf16_t* Y; const float* bias;
    __device__ __forceinline__ void operator()(const f32x4 (&acc)[2][2][4][2], const GUnit& u, int wr, int wc, int fr, int fq) const {
        const int row0 = u.pm * BM + wr * 64 + fr, col0 = u.pn * BM + wc * 32 + 8 * fq;
        f32x4 bv[2][2];
#pragma unroll
        for (int bj = 0; bj < 2; ++bj)
#pragma unroll
            for (int n = 0; n < 2; ++n) bv[bj][n] = *(const f32x4*)(bias + col0 + bj * HALF + 4 * n);
#pragma unroll
        for (int ai = 0; ai < 2; ++ai)
#pragma unroll
            for (int m = 0; m < 4; ++m) { const size_t ro = (size_t)(row0 + ai * HALF + m * 16) * 512 + col0;
#pragma unroll
                for (int bj = 0; bj < 2; ++bj) {
                    const u32x4 yv = *(const u32x4*)(Y + ro + bj * HALF);
                    float o[8];
#pragma unroll
                    for (int n = 0; n < 2; ++n)
#pragma unroll
                        for (int j = 0; j < 4; ++j) { const unsigned wd = yv[n * 2 + (j >> 1)]; const float y = __builtin_bit_cast(float, (j & 1) ? (wd & 0xffff0000u) : (wd << 16));
                            o[n * 4 + j] = y / (1.f + __expf(-(acc[ai][bj][m][n][j] + bv[bj][n][j]))); }
                    u32x4 w; w.x = cvt_pk_bf16(o[0], o[1]); w.y = cvt_pk_bf16(o[2], o[3]); w.z = cvt_pk_bf16(o[4], o[5]); w.w = cvt_pk_bf16(o[6], o[7]);
                    *(u32x4*)(O + ro + bj * HALF) = w; } }
    }
};
__device__ __forceinline__ void p_ssm_norm(const int wv, const bf16_t* yb16, const float* g, bf16_t* mix16) {
    LTID();
    const int lane = tidx & 63;
    const f32x4 g0 = *(const f32x4*)(g + lane * 8), g1 = *(const f32x4*)(g + lane * 8 + 4);
    const int rstride = (int)gridDim.x * NW;
    for (int row0 = bidx * NW + wv; row0 < SEQ; row0 += 4 * rstride) {
        u32x4 av[4];
#pragma unroll
        for (int r = 0; r < 4; ++r) { const int row = (row0 + r * rstride < SEQ) ? row0 + r * rstride : row0; av[r] = *(const u32x4*)(yb16 + (size_t)row * 512 + lane * 8); }
#pragma unroll
        for (int r = 0; r < 4; ++r) {
            const int row = row0 + r * rstride;
            float y[8]; float ss = 0.f;
#pragma unroll
            for (int k = 0; k < 4; ++k) { y[2 * k] = __builtin_bit_cast(float, av[r][k] << 16); y[2 * k + 1] = __builtin_bit_cast(float, av[r][k] & 0xffff0000u); ss += y[2 * k] * y[2 * k] + y[2 * k + 1] * y[2 * k + 1]; }
#pragma unroll
            for (int o = 32; o; o >>= 1) ss += shx(ss, o, lane);
            const float sc = rsqrtf(ss * (1.f / 512.f) + 1e-5f);
            u32x4 o4; o4.x = cvt_pk_bf16(y[0] * sc * g0[0], y[1] * sc * g0[1]); o4.y = cvt_pk_bf16(y[2] * sc * g0[2], y[3] * sc * g0[3]);
            o4.z = cvt_pk_bf16(y[4] * sc * g1[0], y[5] * sc * g1[1]); o4.w = cvt_pk_bf16(y[6] * sc * g1[2], y[7] * sc * g1[3]);
            if (row < SEQ) *(u32x4*)(mix16 + (size_t)row * DM + 512 + lane * 8) = o4;
        }
    }
}

__device__ __forceinline__ void p_rmsnorm16(const int wv, const float* in, const float* g, bf16_t* out16, int rows, int rot) {
    LTID();
    const int lane = tidx & 63;
    for (int r = ROTB(rot) * NW + wv; r < rows; r += gridDim.x * NW) {
        f32x4 v[4]; float ss = 0.f;
#pragma unroll
        for (int j = 0; j < 4; ++j) { v[j] = *(const f32x4*)(in + (size_t)r * DM + 4 * lane + 256 * j); ss += (v[j][0] * v[j][0] + v[j][1] * v[j][1]) + (v[j][2] * v[j][2] + v[j][3] * v[j][3]); }
#pragma unroll
        for (int o = 32; o; o >>= 1) ss += shx(ss, o, lane);
        const float sc = rsqrtf(ss * (1.f / 1024.f) + 1e-5f);
#pragma unroll
        for (int j = 0; j < 4; ++j) { const f32x4 gg = *(const f32x4*)(g + 4 * lane + 256 * j); u32x2 o2; o2.x = cvt_pk_bf16(v[j][0] * sc * gg[0], v[j][1] * sc * gg[1]); o2.y = cvt_pk_bf16(v[j][2] * sc * gg[2], v[j][3] * sc * gg[3]);
            *(u32x2*)(out16 + (size_t)r * DM + 4 * lane + 256 * j) = o2; }
    }
}
template <bool MOE, bool LAST> __device__ __forceinline__ void p_rowfinish(const int wv, const float* hin, float* h, const bf16_t* mout, const int* eslot, const float* topg, const float* g, bf16_t* xn16, float* out) {
    LTID();
    const int lane = tidx & 63;
    LAS const int* ts = (LAS const int*)(LDSP + TS_OFF);
    const int rstride = (int)gridDim.x * NW;
    for (int r0 = bidx * NW + wv; r0 < SEQ; r0 += 2 * rstride) {
        int rr[2]; rr[0] = r0; rr[1] = (r0 + rstride < SEQ) ? r0 + rstride : r0;
        f32x4 v[2][4]; int4 es[2]; f32x4 gt[2]; u32x2 mo[2][4][4];
#pragma unroll
        for (int q = 0; q < 2; ++q) { if (MOE) { es[q] = *(const int4*)(eslot + rr[q] * 4); gt[q] = *(const f32x4*)(topg + rr[q] * 4); }
#pragma unroll
            for (int j = 0; j < 4; ++j) v[q][j] = *(const f32x4*)(hin + (size_t)rr[q] * DM + 4 * lane + 256 * j); }
        if (MOE) {
#pragma unroll
            for (int q = 0; q < 2; ++q) { const int esv[4] = {es[q].x, es[q].y, es[q].z, es[q].w};
#pragma unroll
                for (int k = 0; k < 4; ++k) { const int e = esv[k] >> 16, sl = esv[k] & 0xffff; const size_t row = (size_t)ts[e] * BM + sl;
#pragma unroll
                    for (int j = 0; j < 4; ++j) mo[q][k][j] = *(const u32x2*)(mout + row * DM + 4 * lane + 256 * j); } }
#pragma unroll
            for (int q = 0; q < 2; ++q)
#pragma unroll
                for (int k = 0; k < 4; ++k) { const float gk = gt[q][k];
#pragma unroll
                    for (int j = 0; j < 4; ++j) { const u32x2 o = mo[q][k][j];
                        v[q][j][0] += gk * __builtin_bit_cast(float, o.x << 16); v[q][j][1] += gk * __builtin_bit_cast(float, o.x & 0xffff0000u);
                        v[q][j][2] += gk * __builtin_bit_cast(float, o.y << 16); v[q][j][3] += gk * __builtin_bit_cast(float, o.y & 0xffff0000u); } }
        }
#pragma unroll
        for (int q = 0; q < 2; ++q) {
            if (q == 1 && r0 + rstride >= SEQ) break;
            const int r = rr[q];
            float ss = 0.f;
#pragma unroll
            for (int j = 0; j < 4; ++j) ss += (v[q][j][0] * v[q][j][0] + v[q][j][1] * v[q][j][1]) + (v[q][j][2] * v[q][j][2] + v[q][j][3] * v[q][j][3]);
#pragma unroll
            for (int o = 32; o; o >>= 1) ss += shx(ss, o, lane);
            const float sc = rsqrtf(ss * (1.f / 1024.f) + 1e-5f);
#pragma unroll
            for (int j = 0; j < 4; ++j) {
                const f32x4 gg = *(const f32x4*)(g + 4 * lane + 256 * j);
                if (!LAST) { if (h) *(f32x4*)(h + (size_t)r * DM + 4 * lane + 256 * j) = v[q][j];
                    u32x2 o2; o2.x = cvt_pk_bf16(v[q][j][0] * sc * gg[0], v[q][j][1] * sc * gg[1]); o2.y = cvt_pk_bf16(v[q][j][2] * sc * gg[2], v[q][j][3] * sc * gg[3]);
                    *(u32x2*)(xn16 + (size_t)r * DM + 4 * lane + 256 * j) = o2; }
                else *(f32x4*)(out + (size_t)r * DM + 4 * lane + 256 * j) = (f32x4){v[q][j][0] * sc * gg[0], v[q][j][1] * sc * gg[1], v[q][j][2] * sc * gg[2], v[q][j][3] * sc * gg[3]};
            }
        }
    }
}
__device__ __forceinline__ void p_router_tables(const int wv, const float* w_r, const float* g, bf16_t* WR16, int rot) {
    LTID();
    for (int i = ROTB(rot) * NT + tidx; i < 32 * 1024; i += gridDim.x * NT) {
        const int e = i >> 10, k = i & 1023;
        const float w = g[k] * w_r[k * 32 + e];
        const unsigned hi = f2bf(w); const float lo = w - __builtin_bit_cast(float, hi << 16);
        WR16[i] = (bf16_t)hi; WR16[32 * 1024 + i] = (bf16_t)f2bf(lo);
    }
}
constexpr int RT_CNT_OFF = 131072 + 4608;
constexpr int RT_XCH_OFF = 131072 + 5120;
__device__ __forceinline__ void p_router2(const int wv, const float* h, const bf16_t* WR16, const float* b_r, bf16_t* hb16, unsigned* gcnt, int* rowtok_e, float* rsc_e, int* eslot, float* topg, LAS unsigned char* lds) {
    LTID();
    const int lane = tidx & 63, fr = lane & 15, fq = lane >> 4, w = wv, tg = w & 3, kh = w >> 2;
#pragma unroll
    for (int part = 0; part < 2; ++part)
#pragma unroll
        for (int p = 0; p < 8; ++p) { const int row = 4 * p + (tidx >> 7), cs = tidx & 127;
            glds16s(WR16, (unsigned)(part * 65536 + row * 2048 + ((cs ^ (row & 15)) * 16)), (unsigned)(size_t)(lds + part * 65536 + p * 8192 + w * 1024)); }
    LAS int* lcnt = (LAS int*)(lds + RT_CNT_OFF);
    if (tidx < 64) lcnt[tidx] = 0;
    asm volatile("s_waitcnt vmcnt(0)" ::: "memory");
    __syncthreads();
    for (int it = bidx; it < SEQ / 64; it += gridDim.x) {
        const int token = it * 64 + 16 * tg + fr;
        const float* xr = h + (size_t)token * DM + 512 * kh + 8 * fq;
        bf16_t* hb = hb16 + (size_t)token * DM + 512 * kh + 8 * fq;
        f32x4 acc[2]; acc[0] = (f32x4){0.f, 0.f, 0.f, 0.f}; acc[1] = acc[0];
        float ss = 0.f;
#pragma unroll 4
        for (int s4 = 0; s4 < 16; ++s4) {
            const f32x4 x0 = *(const f32x4*)(xr + 32 * s4), x1 = *(const f32x4*)(xr + 32 * s4 + 4);
            ss += (x0[0] * x0[0] + x0[1] * x0[1]) + (x0[2] * x0[2] + x0[3] * x0[3]) + (x1[0] * x1[0] + x1[1] * x1[1]) + (x1[2] * x1[2] + x1[3] * x1[3]);
            u32x4 hw; hw.x = cvt_pk_bf16(x0[0], x0[1]); hw.y = cvt_pk_bf16(x0[2], x0[3]); hw.z = cvt_pk_bf16(x1[0], x1[1]); hw.w = cvt_pk_bf16(x1[2], x1[3]);
            *(u32x4*)(hb + 32 * s4) = hw;
            u32x4 lw;
            lw.x = cvt_pk_bf16(x0[0] - __builtin_bit_cast(float, hw.x << 16), x0[1] - __builtin_bit_cast(float, hw.x & 0xffff0000u));
            lw.y = cvt_pk_bf16(x0[2] - __builtin_bit_cast(float, hw.y << 16), x0[3] - __builtin_bit_cast(float, hw.y & 0xffff0000u));
            lw.z = cvt_pk_bf16(x1[0] - __builtin_bit_cast(float, hw.z << 16), x1[1] - __builtin_bit_cast(float, hw.z & 0xffff0000u));
            lw.w = cvt_pk_bf16(x1[2] - __builtin_bit_cast(float, hw.w << 16), x1[3] - __builtin_bit_cast(float, hw.w & 0xffff0000u));
            const bf16x8 xhi = __builtin_bit_cast(bf16x8, hw), xlo = __builtin_bit_cast(bf16x8, lw);
            const int c = 64 * kh + 4 * s4 + fq, slot = c ^ fr;
#pragma unroll
            for (int nb = 0; nb < 2; ++nb) {
                const bf16x8 whi = *(const LAS bf16x8*)(lds + (16 * nb + fr) * 2048 + slot * 16), wlo = *(const LAS bf16x8*)(lds + 65536 + (16 * nb + fr) * 2048 + slot * 16);
                acc[nb] = __builtin_amdgcn_mfma_f32_16x16x32_bf16(whi, xhi, acc[nb], 0, 0, 0);
                acc[nb] = __builtin_amdgcn_mfma_f32_16x16x32_bf16(whi, xlo, acc[nb], 0, 0, 0);
                acc[nb] = __builtin_amdgcn_mfma_f32_16x16x32_bf16(wlo, xhi, acc[nb], 0, 0, 0);
            }
        }
        ss += shx(ss, 16, lane); ss += shx(ss, 32, lane);
        LAS float* X = (LAS float*)(lds + RT_XCH_OFF) + (tg * 64 + lane) * 9;
        if (kh == 1) {
#pragma unroll
            for (int nb = 0; nb < 2; ++nb)
#pragma unroll
                for (int j = 0; j < 4; ++j) X[nb * 4 + j] = acc[nb][j];
            X[8] = ss;
        }
        __syncthreads();
        int ti[4] = {0, 0, 0, 0}, ls[4] = {0, 0, 0, 0}; float gv[4] = {0.f, 0.f, 0.f, 0.f}; float rs = 0.f;
        if (kh == 0) {
            float lv[8];
            ss += X[8];
            rs = rsqrtf(ss * (1.f / 1024.f) + 1e-5f);
#pragma unroll
            for (int nb = 0; nb < 2; ++nb)
#pragma unroll
                for (int j = 0; j < 4; ++j) lv[nb * 4 + j] = rs * (acc[nb][j] + X[nb * 4 + j]) + b_r[16 * nb + 4 * fq + j];
            float tv[4];
#pragma unroll
            for (int r = 0; r < 4; ++r) {
                float bv = -3.0e38f; int bi = 0;
#pragma unroll
                for (int q = 0; q < 8; ++q) { const int idx = 16 * (q >> 2) + 4 * fq + (q & 3); if (lv[q] > bv) { bv = lv[q]; bi = idx; } }
#pragma unroll
                for (int mk = 16; mk <= 32; mk <<= 1) { const float ov = shx(bv, mk, lane); const int oi = shxi(bi, mk, lane); if (ov > bv || (ov == bv && oi < bi)) { bv = ov; bi = oi; } }
                tv[r] = bv; ti[r] = bi;
#pragma unroll
                for (int q = 0; q < 8; ++q) { const int idx = 16 * (q >> 2) + 4 * fq + (q & 3); if (idx == bi) lv[q] = -3.0e38f; }
            }
            float sum = 0.f;
#pragma unroll
            for (int r = 0; r < 4; ++r) { gv[r] = __expf(tv[r] - tv[0]); sum += gv[r]; }
            const float inv = 1.f / sum;
#pragma unroll
            for (int r = 0; r < 4; ++r) gv[r] *= inv;
            if (fq == 0) {
#pragma unroll
                for (int r = 0; r < 4; ++r) ls[r] = __hip_atomic_fetch_add(&lcnt[ti[r]], 1, __ATOMIC_RELAXED, __HIP_MEMORY_SCOPE_WORKGROUP);
            }
        }
        __syncthreads();
        if (tidx < 32) { const int c = lcnt[tidx]; lcnt[32 + tidx] = c ? (int)__hip_atomic_fetch_add(gcnt + tidx, (unsigned)c, __ATOMIC_RELAXED, __HIP_MEMORY_SCOPE_AGENT) : 0; }
        __syncthreads();
        if (kh == 0 && fq == 0) {
            int es[4];
#pragma unroll
            for (int r = 0; r < 4; ++r) { const int e = ti[r], sl = lcnt[32 + e] + ls[r]; rowtok_e[e * ECAP + sl] = token; rsc_e[e * ECAP + sl] = rs; es[r] = (e << 16) | sl; }
            *(int4*)(eslot + token * 4) = make_int4(es[0], es[1], es[2], es[3]);
            *(f32x4*)(topg + token * 4) = (f32x4){gv[0], gv[1], gv[2], gv[3]};
        }
        __syncthreads();
        if (tidx < 32) lcnt[tidx] = 0;
    }
    __syncthreads();
}

constexpr int NPL = 13;
constexpr int NPHASES = 1 + 2 * NPL;
typedef const __attribute__((address_space(4))) Args* KA;
#define PHASE __device__ __forceinline__
#define KAP() ({ KA _t = a; asm volatile("" : "+s"(_t)); _t; })
#define WSP(T, off) ((T*)(a->ws + (off)))

constexpr int NIT = 49152, NIT1 = 32768;
constexpr int QG = 9, QX = 13, QA = 11, QB = 8, QG0 = 12, QX0 = 17;
struct ConvBounds { int A1, A2, B1, B2, B3, B4; };
__device__ __forceinline__ int cmin(int a, int b) { return a < b ? a : b; }
__device__ __forceinline__ ConvBounds conv_bounds(int G, int T0) {
    ConvBounds b;
    const int Px = G > 128 ? G - 128 : G, Px0 = G > 136 ? G - 136 : G;
    b.A1 = cmin(NIT, Px * 8 * QG0); b.A2 = cmin(NIT, b.A1 + Px0 * 8 * QX0);
    const int r1 = (8 * T0) % G, r2 = (4 * T0) % G;
    b.B1 = cmin(NIT, r1 ? (G - r1) * 8 * QA : G * 8 * 2);
    b.B2 = cmin(NIT, b.B1 + (r2 ? (G - r2) * 8 * QB : G * 8 * 2));
    b.B3 = cmin(NIT, b.B2 + Px * 8 * QG); b.B4 = cmin(NIT, b.B3 + Px * 8 * QX);
    return b;
}
__device__ __forceinline__ void conv_moe(KA a, const int wv, int l, int begin, int end, int rank, int nranks) {
    if (begin >= end) return;
    const int wr = rank * NW + wv, ws_ = nranks * NW;
    if (begin < NIT1) p_transpose_r(wv, a->in[26] + (size_t)l * NEXP * DM * 2048, NEXP, DM, 2048, WSP(bf16_t, WS_BT1) + (size_t)l * NEXP * 2048 * DM, a->in[23] + l * DM, NEXP, 1, LDSP, begin, cmin(end, NIT1), wr, ws_);
    if (end > NIT1) { const int b2 = begin > NIT1 ? begin - NIT1 : 0;
        p_transpose_r(wv, a->in[28] + (size_t)l * NEXP * DFF * DM, NEXP, DFF, DM, WSP(bf16_t, WS_BT2) + (size_t)l * NEXP * DM * DFF, nullptr, 1, 0, LDSP, b2, end - NIT1, wr, ws_); }
}
__device__ __forceinline__ int moe_T_lds() { return __builtin_amdgcn_readfirstlane(((LAS const int*)(LDSP + TS_OFF))[32]); }
PHASE void ph_init(KA a, const int wv) {
    p_rowfinish<false, false>(wv, a->in[0], nullptr, nullptr, nullptr, nullptr, a->in[3], WSP(bf16_t, WS_XN16), nullptr);
    p_bias_table(wv, a->in[2], WSP(float, WS_BIASG), 152);
    for (int l = 0; l < 2; ++l) {
        p_s5_tables2(wv, a->in[5] + l * 2048, a->in[6] + l * 2048, a->in[7] + l * 32768, a->in[8] + l * 32768, a->in[9] + l * 32768, a->in[10] + l * 32768, a->in[11] + l * 32,
                     WSP(float2, WS_ABAR) + l * 2048, WSP(float2, WS_A256) + l * 2048, WSP(bf16_t, WS_BB16) + (size_t)l * 32 * 128 * 16, WSP(bf16_t, WS_CM16) + (size_t)l * 32 * 16 * 128, 160 + 32 * l);
        p_rmsnorm16(wv, a->in[1], a->in[19] + l * DM, WSP(bf16_t, WS_MEMN16) + (size_t)l * NMEM * DM, NMEM, 224 + 16 * l);
        p_router_tables(wv, a->in[24] + (size_t)l * DM * 32, a->in[23] + l * DM, WSP(bf16_t, WS_WR16) + (size_t)l * 2 * 32 * 1024, 160 + 64 * l);
    }
    p_transpose(wv, a->in[4], 2, DM, DIN, WSP(bf16_t, WS_WT_IN), nullptr, 1, 0, LDSP, 0);
    p_transpose(wv, a->in[13], 2, 512, 512, WSP(bf16_t, WS_WT_GLU), nullptr, 1, 0, LDSP, 0);
    p_transpose(wv, a->in[17], 2, DM, DM, WSP(bf16_t, WS_WT_OUT), nullptr, 1, 0, LDSP, 32);
    p_transpose(wv, a->in[20], 2, DM, 512, WSP(bf16_t, WS_WT_XQ), a->in[18], 1, 0, LDSP, 160);
    p_transpose(wv, a->in[21], 2, DM, 1024, WSP(bf16_t, WS_WT_XKV), nullptr, 1, 0, LDSP, 224);
    p_transpose(wv, a->in[22], 2, 512, DM, WSP(bf16_t, WS_WT_XO), nullptr, 1, 0, LDSP, 96);
    __syncthreads();
}
PHASE void ph_gemm_in(KA a, const int wv, int l) { LTID();
    DenseOrder S; S.init(WSP(bf16_t, WS_XN16), WSP(bf16_t, WS_WT_IN) + (size_t)l * DIN * DM, SEQ, DIN, DM, gridDim.x, bidx);
    EpiIn E{WSP(bf16_t, WS_PROJ16)};
    gemm_phase<EpiIn, DenseOrder, false, true>(LDSP, DM, S, E, tidx, wv);
}
PHASE void ph_attn_s5a(KA a, const int wv, int l) {
    p_dil_attn(wv, WSP(bf16_t, WS_PROJ16), WSP(float, WS_BIASG), WSP(bf16_t, WS_OBR), WSP(float, WS_LSE), LDSP);
    if (PROBE_DUP == 21) p_dil_attn(wv, WSP(bf16_t, WS_PROJ16), WSP(float, WS_BIASG), WSP(bf16_t, WS_OBR), WSP(float, WS_LSE), LDSP);
    if (PROBE_DUP == 22) { p_s5_pass<0>(wv, WSP(bf16_t, WS_PROJ16), WSP(float2, WS_ABAR) + l * 2048, WSP(float2, WS_A256) + l * 2048, WSP(bf16_t, WS_BB16) + (size_t)l * 32 * 128 * 16, WSP(bf16_t, WS_CM16) + (size_t)l * 32 * 16 * 128,
                 a->in[12] + l * 512, WSP(float2, WS_E2), WSP(bf16_t, WS_YG16), LDSP); __syncthreads(); }
    p_s5_pass<0>(wv, WSP(bf16_t, WS_PROJ16), WSP(float2, WS_ABAR) + l * 2048, WSP(float2, WS_A256) + l * 2048, WSP(bf16_t, WS_BB16) + (size_t)l * 32 * 128 * 16, WSP(bf16_t, WS_CM16) + (size_t)l * 32 * 16 * 128,
                 a->in[12] + l * 512, WSP(float2, WS_E2), WSP(bf16_t, WS_YG16), LDSP);
}
PHASE void ph_s5b(KA a, const int wv, int l) {
    p_s5_pass<1>(wv, WSP(bf16_t, WS_PROJ16), WSP(float2, WS_ABAR) + l * 2048, WSP(float2, WS_A256) + l * 2048, WSP(bf16_t, WS_BB16) + (size_t)l * 32 * 128 * 16, WSP(bf16_t, WS_CM16) + (size_t)l * 32 * 16 * 128,
                 a->in[12] + l * 512, WSP(float2, WS_E2), WSP(bf16_t, WS_YG16), LDSP);
}
PHASE void ph_gemm_glu(KA a, const int wv, int l) {
    {   LTID();
        DenseOrder S; S.init(WSP(bf16_t, WS_YG16), WSP(bf16_t, WS_WT_GLU) + (size_t)l * 512 * 512, SEQ, 512, 512, gridDim.x, bidx);
        EpiGlu16 E{WSP(bf16_t, WS_YB16), WSP(bf16_t, WS_YG16), a->in[14] + l * 512};
        gemm_phase<EpiGlu16, DenseOrder, false, false>(LDSP, 512, S, E, tidx, wv); }
    {   LTID();
        const int G = (int)gridDim.x;
        int T0 = 0; if (l == 1) { moe_tiles(WSP(unsigned, WS_CTL) + CW_CNT, tidx); T0 = moe_T_lds(); }
        const ConvBounds cb = conv_bounds(G, T0);
        if (G > 128) { if (bidx >= 128) conv_moe(a, wv, l, l == 0 ? 0 : cb.B2, l == 0 ? cb.A1 : cb.B3, bidx - 128, G - 128); }
        else conv_moe(a, wv, l, l == 0 ? 0 : cb.B2, l == 0 ? cb.A1 : cb.B3, bidx, G);
    }
}
PHASE void ph_mixnorm(KA a, const int wv, int l) {
    p_attn_combine(wv, WSP(bf16_t, WS_OBR), WSP(float, WS_LSE), a->in[15] + l * 512, WSP(bf16_t, WS_MIX16));
    p_ssm_norm(wv, WSP(bf16_t, WS_YB16), a->in[16] + l * 512, WSP(bf16_t, WS_MIX16));
}
PHASE void ph_gemm_out(KA a, const int wv, int l) { LTID();
    DenseOrder S; S.init(WSP(bf16_t, WS_MIX16), WSP(bf16_t, WS_WT_OUT) + (size_t)l * DM * DM, SEQ, DM, DM, gridDim.x, bidx);
    EpiOut E{l == 0 ? a->in[0] : (const float*)WSP(float, WS_H), WSP(float, WS_H), WSP(bf16_t, WS_HB16), WSP(float, WS_SSP)};
    gemm_phase<EpiOut, DenseOrder, false, false>(LDSP, DM, S, E, tidx, wv);
}
PHASE void ph_gemm_xq(KA a, const int wv, int l) {
    {   LTID();
        DenseOrder S; S.init(WSP(bf16_t, WS_HB16), WSP(bf16_t, WS_WT_XQ) + (size_t)l * 512 * DM, SEQ, 512, DM, gridDim.x, bidx);
        EpiBf16 E{WSP(bf16_t, WS_QX16), 512, 0.08838834764831845f, WSP(float, WS_SSP)};
        gemm_phase<EpiBf16, DenseOrder, false, false>(LDSP, DM, S, E, tidx, wv); }
    {   LTID();
    const int cc = (int)gridDim.x - 1 - bidx;
    if (l == 0 && cc < 8) {
        const int kl = cc >> 2;
        DenseOrder S; S.init(WSP(bf16_t, WS_MEMN16) + (size_t)kl * NMEM * DM, WSP(bf16_t, WS_WT_XKV) + (size_t)kl * 1024 * DM, NMEM, 1024, DM, 4, cc & 3);
        EpiBf16 E{WSP(bf16_t, WS_KV16) + (size_t)kl * NMEM * 1024, 1024, 1.f, nullptr};
        gemm_phase<EpiBf16, DenseOrder, false, false>(LDSP, DM, S, E, tidx, wv);
    } }
    {   LTID();
        const int G = (int)gridDim.x;
        int T0 = 0; if (l == 1) { moe_tiles(WSP(unsigned, WS_CTL) + CW_CNT, tidx); T0 = moe_T_lds(); }
        const ConvBounds cb = conv_bounds(G, T0);
        const int skip = (l == 0) ? 8 : 0;
        if (G > 128 + skip) { if (bidx >= 128 && bidx < G - skip) conv_moe(a, wv, l, l == 0 ? cb.A1 : cb.B3, l == 0 ? cb.A2 : cb.B4, bidx - 128, G - 128 - skip); }
        else conv_moe(a, wv, l, l == 0 ? cb.A1 : cb.B3, l == 0 ? cb.A2 : cb.B4, bidx, G);
    }
}
PHASE void ph_xattn(KA a, const int wv, int l) { p_xattn_mfma(wv, WSP(bf16_t, WS_QX16), WSP(bf16_t, WS_KV16) + (size_t)l * NMEM * 1024, WSP(bf16_t, WS_OX16), LDSP); }
PHASE void ph_gemm_xo(KA a, const int wv, int l) { LTID();
    DenseOrder S; S.init(WSP(bf16_t, WS_OX16), WSP(bf16_t, WS_WT_XO) + (size_t)l * DM * 512, SEQ, DM, 512, gridDim.x, bidx);
    EpiF32 E{WSP(float, WS_H), DM, 1};
    gemm_phase<EpiF32, DenseOrder, false, false>(LDSP, 512, S, E, tidx, wv);
}
PHASE void ph_router(KA a, const int wv, int l) {
    {   LTID();
        const int G = (int)gridDim.x;
        int T0 = 0; if (l == 1) { moe_tiles(WSP(unsigned, WS_CTL) + CW_CNT, tidx); T0 = moe_T_lds(); }
        const ConvBounds cb = conv_bounds(G, T0);
        conv_moe(a, wv, l, l == 0 ? cb.A2 : cb.B4, NIT, bidx, G);
        __syncthreads();
    }
    p_router2(wv, WSP(float, WS_H), WSP(bf16_t, WS_WR16) + (size_t)l * 2 * 32 * 1024, a->in[25] + l * 32, WSP(bf16_t, WS_HB16), WSP(unsigned, WS_CTL) + CW_CNT + l * 32,
              WSP(int, WS_ROWTOK), WSP(float, WS_RSC), WSP(int, WS_ESLOT), WSP(float, WS_TOPG), LDSP);
}
PHASE void ph_moe1(KA a, const int wv, int l) {
    {   LTID();
        moe_tiles(WSP(unsigned, WS_CTL) + CW_CNT + l * 32, tidx);
        MoeOrder<true> S; S.init(WSP(bf16_t, WS_HB16), WSP(bf16_t, WS_BT1) + (size_t)l * NEXP * 2048 * DM, WSP(int, WS_ROWTOK), 2048, DM, (size_t)2048 * DM * 2, gridDim.x, bidx);
        EpiMoe1 E{WSP(bf16_t, WS_ACT), a->in[27] + (size_t)l * NEXP * 2048, WSP(float, WS_RSC)};
        gemm_phase<EpiMoe1, MoeOrder<true>, true, true>(LDSP, DM, S, E, tidx, wv); }
    if (l == 0) { LTID();
        const int G = (int)gridDim.x, T0 = moe_T_lds(), r1 = (8 * T0) % G; const ConvBounds cb = conv_bounds(G, T0);
        if (r1) { if (bidx >= r1) conv_moe(a, wv, 1, 0, cb.B1, bidx - r1, G - r1); } else conv_moe(a, wv, 1, 0, cb.B1, bidx, G);
    }
}
PHASE void ph_moe2(KA a, const int wv, int l) {
    {   LTID();
        moe_tiles(WSP(unsigned, WS_CTL) + CW_CNT + l * 32, tidx);
        MoeOrder<false> S; S.init(WSP(bf16_t, WS_ACT), WSP(bf16_t, WS_BT2) + (size_t)l * NEXP * DM * DFF, nullptr, DM, DFF, (size_t)DM * DFF * 2, gridDim.x, bidx);
        EpiMoe2 E{WSP(bf16_t, WS_MOUT), a->in[29] + (size_t)l * NEXP * DM};
        gemm_phase<EpiMoe2, MoeOrder<false>, false, true>(LDSP, DFF, S, E, tidx, wv); }
    if (l == 0) { LTID();
        const int G = (int)gridDim.x, T0 = moe_T_lds(), r2 = (4 * T0) % G; const ConvBounds cb = conv_bounds(G, T0);
        if (r2) { if (bidx >= r2) conv_moe(a, wv, 1, cb.B1, cb.B2, bidx - r2, G - r2); } else conv_moe(a, wv, 1, cb.B1, cb.B2, bidx, G);
    }
}
PHASE void ph_combine(KA a, const int wv, int l) { LTID();
    moe_tiles(WSP(unsigned, WS_CTL) + CW_CNT + l * 32, tidx);
    if (l == 0) p_rowfinish<true, false>(wv, WSP(float, WS_H), WSP(float, WS_H), WSP(bf16_t, WS_MOUT), WSP(int, WS_ESLOT), WSP(float, WS_TOPG), a->in[3] + DM, WSP(bf16_t, WS_XN16), nullptr);
    else p_rowfinish<true, true>(wv, WSP(float, WS_H), nullptr, WSP(bf16_t, WS_MOUT), WSP(int, WS_ESLOT), WSP(float, WS_TOPG), a->in[30], nullptr, a->out);
}

__global__ void __launch_bounds__(NT, 2) mega(Args args) {
    KA a = (KA)__builtin_amdgcn_kernarg_segment_ptr();
    int wv = __builtin_amdgcn_readfirstlane((int)threadIdx.x >> 6); asm volatile("" : "+s"(wv));
    LAS unsigned char* lds = LDSP;
    volatile LAS unsigned* MISC = (volatile LAS unsigned*)(lds + MISC_OFF);
    unsigned* ctl = (unsigned*)(a->ws + WS_CTL);
    if (threadIdx.x < 32) MISC[threadIdx.x] = 0u;
    __syncthreads();
    XcdBarrier bar; bar.bar = ctl + CW_BAR; bar.x = 0; bar.st = nullptr;
    if (!MK_PER_PHASE) bar = xcd_barrier_post(ctl + CW_BAR, MISC + 8);
    const int lo = a->ph_lo, hi = a->ph_hi;
#define IN(k) (lo <= (k) && (k) < hi)
#define SEAM(k) do { if (IN(k) && IN((k) + 1)) { LTID(); xcd_barrier(bar.bar, bar.x, bar.st, tidx == 0); if (PROBE_DUP == 200) xcd_barrier(bar.bar, bar.x, bar.st, tidx == 0); } } while (0)
    if (IN(0)) { ph_init(KAP(), wv); if (PROBE_DUP == 100) ph_init(KAP(), wv); }
    SEAM(0);
#define LAYER_PROGRAM(l) { const int pb = 1 + (l) * NPL; \
        if (IN(pb + 0)) { ph_gemm_in(KAP(), wv, (l)); if (PROBE_DUP == 0) { ph_gemm_in(KAP(), wv, (l)); } } \
        SEAM(pb + 0); \
        if (IN(pb + 1)) { ph_attn_s5a(KAP(), wv, (l)); if (PROBE_DUP == 1) { ph_attn_s5a(KAP(), wv, (l)); } } \
        SEAM(pb + 1); \
        if (IN(pb + 2)) { ph_s5b(KAP(), wv, (l)); if (PROBE_DUP == 2) { ph_s5b(KAP(), wv, (l)); } } \
        SEAM(pb + 2); \
        if (IN(pb + 3)) { ph_gemm_glu(KAP(), wv, (l)); if (PROBE_DUP == 3) { ph_gemm_glu(KAP(), wv, (l)); } } \
        SEAM(pb + 3); \
        if (IN(pb + 4)) { ph_mixnorm(KAP(), wv, (l)); if (PROBE_DUP == 4) { ph_mixnorm(KAP(), wv, (l)); } } \
        SEAM(pb + 4); \
        if (IN(pb + 5)) { ph_gemm_out(KAP(), wv, (l)); if (PROBE_DUP == 5) { ph_gemm_out(KAP(), wv, (l)); } } \
        SEAM(pb + 5); \
        if (IN(pb + 6)) { ph_gemm_xq(KAP(), wv, (l)); if (PROBE_DUP == 6) { ph_gemm_xq(KAP(), wv, (l)); } } \
        SEAM(pb + 6); \
        if (IN(pb + 7)) { ph_xattn(KAP(), wv, (l)); if (PROBE_DUP == 7) { ph_xattn(KAP(), wv, (l)); } } \
        SEAM(pb + 7); \
        if (IN(pb + 8)) { ph_gemm_xo(KAP(), wv, (l)); if (PROBE_DUP == 8) { ph_gemm_xo(KAP(), wv, (l)); } } \
        SEAM(pb + 8); \
        if (IN(pb + 9)) { ph_router(KAP(), wv, (l)); if (PROBE_DUP == 9) { ph_router(KAP(), wv, (l)); } } \
        SEAM(pb + 9); \
        if (IN(pb + 10)) { ph_moe1(KAP(), wv, (l)); if (PROBE_DUP == 10) { ph_moe1(KAP(), wv, (l)); } } \
        SEAM(pb + 10); \
        if (IN(pb + 11)) { ph_moe2(KAP(), wv, (l)); if (PROBE_DUP == 11) { ph_moe2(KAP(), wv, (l)); } } \
        SEAM(pb + 11); \
        if (IN(pb + 12)) { ph_combine(KAP(), wv, (l)); if (PROBE_DUP == 12) { ph_combine(KAP(), wv, (l)); } } \
        SEAM(pb + 12); }
    LAYER_PROGRAM(0)
    LAYER_PROGRAM(1)
#undef LAYER_PROGRAM
#undef IN
#undef SEAM
}

extern "C" void kernel_launch(void* const* d_in, const int* in_sizes, int n_in, void* d_out, int out_size, void* d_ws, size_t ws_size, hipStream_t stream) {
    static int grid = 0;
    if (grid == 0) {
        if (n_in != 31 || ws_size < WS_END) { fprintf(stderr, "kernel_launch: unexpected n_in %d or ws_size %zu (need %zu)\n", n_in, ws_size, (size_t)WS_END); grid = -1; return; }
        int dev = 0, cus = 0, per_cu = 0;
        if (hipGetDevice(&dev) != hipSuccess || hipDeviceGetAttribute(&cus, hipDeviceAttributeMultiprocessorCount, dev) != hipSuccess) { grid = -1; return; }
        if (hipFuncSetAttribute((const void*)mega, hipFuncAttributeMaxDynamicSharedMemorySize, LDS_BYTES) != hipSuccess) { fprintf(stderr, "kernel_launch: hipFuncSetAttribute failed\n"); grid = -1; return; }
        if (hipOccupancyMaxActiveBlocksPerMultiprocessor(&per_cu, (const void*)mega, NT, LDS_BYTES) != hipSuccess || per_cu < 1)
            fprintf(stderr, "kernel_launch: occupancy query reports %d workgroups per CU\n", per_cu);
        (void)hipGetLastError();
        grid = cus;
    }
    if (grid < 0) return;
    if (hipMemsetAsync((char*)d_ws + WS_CTL, 0, CTL_ZERO_BYTES, stream) != hipSuccess) return;
    Args a{};
    for (int i = 0; i < 31; ++i) a.in[i] = (const float*)d_in[i];
    a.out = (float*)d_out; a.ws = (unsigned char*)d_ws;
#if MK_PER_PHASE
    for (int p = 0; p < NPHASES; ++p) { a.ph_lo = p; a.ph_hi = p + 1; hipLaunchKernelGGL(mega, dim3(grid), dim3(NT), LDS_BYTES, stream, a); }
#else
    a.ph_lo = 0; a.ph_hi = NPHASES;
    hipLaunchKernelGGL(mega, dim3(grid), dim3(NT), LDS_BYTES, stream, a);
#endif
}
```

```cpp
#include <hip/hip_runtime.h>
#include <stdint.h>
#include <cstdio>

#ifndef PROBE_DUP
#define PROBE_DUP -1
#endif
#ifndef MK_PER_PHASE
#define MK_PER_PHASE 0
#endif

#define SEQ 16384
#define DM 1024
#define DIN 2048
#define NMEM 256
#define NEXP 32
#define TOPK 4
#define DFF 1024
#define NT 512
#define NW 8

#define LAS __attribute__((address_space(3)))
typedef float f32x4 __attribute__((ext_vector_type(4)));
typedef float f32x2 __attribute__((ext_vector_type(2)));
extern __shared__ __attribute__((aligned(16))) unsigned char lds_raw[];
#define LDSP ((LAS unsigned char*)lds_raw)
#define LTID() int z_ = 0; asm volatile("" : "+v"(z_)); const int lane_ = (int)__builtin_amdgcn_mbcnt_hi(~0u, __builtin_amdgcn_mbcnt_lo(~0u, (unsigned)z_)); \
    const int tidx = wv * 64 + lane_; int bidx = blockIdx.x; asm volatile("" : "+s"(bidx))
#define ROTB(rot) ((bidx + (int)gridDim.x - (rot) % (int)gridDim.x) % (int)gridDim.x)
__device__ __forceinline__ float shx(float v, int mask, int lane) { return __builtin_bit_cast(float, __builtin_amdgcn_ds_bpermute((lane ^ mask) << 2, __builtin_bit_cast(int, v))); }
__device__ __forceinline__ int shxi(int v, int mask, int lane) { return __builtin_amdgcn_ds_bpermute((lane ^ mask) << 2, v); }
constexpr int LDS_BYTES = 147456;
constexpr int MISC_OFF = 131072 + 320;

#define XB_TMO      128
#define XB_XCNT(j)  (256  + 64 * (j))
#define XB_XSUB(j)  (1280 + 64 * (j))
#define XB_XGEN(j)  (2304 + 64 * (j))
#define XB_TOP      3328
#define XB_TOPGEN   3392
#define XCD_BAR_WORDS 3456
#define XB_SPIN_CAP (1u << 18)

__device__ __forceinline__ unsigned xb_ld(unsigned* p)              { return __hip_atomic_load(p, __ATOMIC_RELAXED, __HIP_MEMORY_SCOPE_AGENT); }
__device__ __forceinline__ unsigned xb_add(unsigned* p, unsigned v) { return __hip_atomic_fetch_add(p, v, __ATOMIC_RELAXED, __HIP_MEMORY_SCOPE_AGENT); }
__device__ __forceinline__ unsigned xb_xcc_id() { return (unsigned)__builtin_amdgcn_s_getreg((3 << 11) | 20) & 0xFu; }
#define XB_SPIN(cond, bar) do { unsigned _sp = 0; while (cond) { __builtin_amdgcn_s_sleep(1); \
    if ((++_sp & 255u) == 0u) { if (xb_ld(&(bar)[XB_TMO])) break; if (_sp > XB_SPIN_CAP) { atomicAdd(&(bar)[XB_TMO], 1u); break; } } } } while (0)

struct XcdBarrier {
    unsigned* bar; unsigned x;
    volatile LAS unsigned* st;
};
__device__ __forceinline__ XcdBarrier xcd_barrier_post(unsigned* bar, volatile LAS unsigned* st) {
    XcdBarrier b; b.bar = bar; b.x = xb_xcc_id(); b.st = st;
    if (threadIdx.x == 0) (void)xb_add(&bar[XB_XCNT(b.x)], 1u);
    return b;
}
__device__ __forceinline__ void xcd_barrier_complete(unsigned* bar, unsigned x, unsigned& nloc, unsigned& nx) {
    const unsigned G = gridDim.x * gridDim.y * gridDim.z;
    unsigned sum, cnt, mine, sp = 0u;
    for (;;) {
        sum = 0u; cnt = 0u; mine = 0u;
#pragma unroll
        for (unsigned j = 0; j < 16; ++j) { const unsigned c = xb_ld(&bar[XB_XCNT(j)]); sum += c; cnt += (c > 0u) ? 1u : 0u; mine = (j == x) ? c : mine; }
        if (sum == G) break;
        __builtin_amdgcn_s_sleep(1);
        if ((++sp & 255u) == 0u) { if (xb_ld(&bar[XB_TMO])) break; if (sp > XB_SPIN_CAP) { atomicAdd(&bar[XB_TMO], 1u); break; } }
    }
    nloc = mine > 0u ? mine : 1u; nx = cnt > 0u ? cnt : 1u;
}
__device__ __noinline__ void xcd_barrier(unsigned* bar_, unsigned x_, volatile LAS unsigned* st_, int is_t0) {
    XcdBarrier b; b.bar = bar_; b.x = x_; b.st = st_;
    asm volatile("s_waitcnt vmcnt(0)" ::: "memory");
    __syncthreads();
    if (is_t0) {
        unsigned* bar = b.bar;
        __builtin_amdgcn_s_waitcnt(0);
        unsigned nloc = b.st[0], nx = b.st[1];
        if (nloc == 0u) { xcd_barrier_complete(bar, b.x, nloc, nx); b.st[0] = nloc; b.st[1] = nx; }
        const unsigned old = xb_add(&bar[XB_XSUB(b.x)], 1u);
        const unsigned gen = old / nloc;
        if (old + 1u == (gen + 1u) * nloc) {
            __builtin_amdgcn_fence(__ATOMIC_RELEASE, "agent");
            asm volatile("s_waitcnt vmcnt(0)" ::: "memory");
            const unsigned og = xb_add(&bar[XB_TOP], 1u);
            const unsigned tg = og / nx;
            if (og + 1u == (tg + 1u) * nx) xb_add(&bar[XB_TOPGEN], 1u);
            else XB_SPIN(xb_ld(&bar[XB_TOPGEN]) == tg, bar);
            __builtin_amdgcn_fence(__ATOMIC_ACQUIRE, "agent");
            xb_add(&bar[XB_XGEN(b.x)], 1u);
            asm volatile("s_waitcnt vmcnt(0)" ::: "memory");
        } else {
            XB_SPIN(xb_ld(&bar[XB_XGEN(b.x)]) == gen, bar);
            __builtin_amdgcn_fence(__ATOMIC_ACQUIRE, "agent");
            asm volatile("s_waitcnt vmcnt(0)" ::: "memory");
        }
    }
    __syncthreads();
}

constexpr size_t MiB = 1u << 20;
constexpr size_t WS_CTL = 0, CTL_ZERO_BYTES = 1 * MiB;
constexpr int CW_BAR = 4096;
constexpr int CW_CNT = 8192;
constexpr int MOE_ROWS = SEQ * TOPK + NEXP * 256;
constexpr int ECAP = SEQ;
constexpr size_t al256(size_t x) { return (x + 255) & ~(size_t)255; }
constexpr size_t WS_H = 2 * MiB;
constexpr size_t WS_XN16 = WS_H + (size_t)SEQ * DM * 4;
constexpr size_t WS_HB16 = WS_XN16 + (size_t)SEQ * DM * 2;
constexpr size_t WS_PROJ16 = WS_HB16 + (size_t)SEQ * DM * 2;
constexpr size_t WS_OBR = WS_PROJ16 + (size_t)SEQ * 2048 * 2;
constexpr size_t WS_LSE = WS_OBR + 3 * (size_t)SEQ * 512 * 2;
constexpr size_t WS_YG16 = WS_LSE + 3 * (size_t)SEQ * 8 * 4;
constexpr size_t WS_YB16 = WS_YG16 + (size_t)SEQ * 512 * 2;
constexpr size_t WS_MIX16 = WS_YB16 + (size_t)SEQ * 512 * 2;
constexpr size_t WS_QX16 = WS_MIX16 + (size_t)SEQ * DM * 2;
constexpr size_t WS_OX16 = WS_QX16 + (size_t)SEQ * 512 * 2;
constexpr size_t WS_ACT = WS_OX16 + (size_t)SEQ * 512 * 2;
constexpr size_t WS_MOUT = WS_ACT + (size_t)MOE_ROWS * DFF * 2;
constexpr size_t WS_BT1 = WS_MOUT + (size_t)MOE_ROWS * DM * 2;
constexpr size_t WS_BT2 = WS_BT1 + 2 * (size_t)NEXP * 2048 * DM * 2;
constexpr size_t WS_WT_IN = WS_BT2 + 2 * (size_t)NEXP * DM * DFF * 2;
constexpr size_t WS_WT_GLU = WS_WT_IN + 2 * (size_t)2048 * 1024 * 2;
constexpr size_t WS_WT_OUT = WS_WT_GLU + 2 * (size_t)512 * 512 * 2;
constexpr size_t WS_WT_XQ = WS_WT_OUT + 2 * (size_t)1024 * 1024 * 2;
constexpr size_t WS_WT_XKV = WS_WT_XQ + 2 * (size_t)512 * 1024 * 2;
constexpr size_t WS_WT_XO = WS_WT_XKV + 2 * (size_t)1024 * 1024 * 2;
constexpr size_t WS_MEMN16 = WS_WT_XO + 2 * (size_t)1024 * 512 * 2;
constexpr size_t WS_KV16 = WS_MEMN16 + 2 * (size_t)NMEM * 1024 * 2;
constexpr size_t WS_WR16 = WS_KV16 + 2 * (size_t)NMEM * 1024 * 2;
constexpr size_t WS_BIASG = WS_WR16 + 2 * 2 * (size_t)32 * 1024 * 2;
constexpr size_t WS_ABAR = al256(WS_BIASG + 24 * 132 * 4);
constexpr size_t WS_A256 = WS_ABAR + 2 * 2048 * 8;
constexpr size_t WS_BB16 = WS_A256 + 2 * 2048 * 8;
constexpr size_t WS_CM16 = WS_BB16 + 2 * (size_t)32 * 128 * 16 * 2;
constexpr size_t WS_E2 = WS_CM16 + 2 * (size_t)32 * 16 * 128 * 2;
constexpr size_t WS_ROWTOK = WS_E2 + (size_t)64 * 2048 * 8;
constexpr size_t WS_RSC = WS_ROWTOK + (size_t)NEXP * ECAP * 4;
constexpr size_t WS_ESLOT = WS_RSC + (size_t)NEXP * ECAP * 4;
constexpr size_t WS_TOPG = WS_ESLOT + (size_t)SEQ * 4 * 4;
constexpr size_t WS_SSP = WS_TOPG + (size_t)SEQ * 4 * 4;
constexpr size_t WS_END = WS_SSP + (size_t)SEQ * 16 * 4;

struct Args { const float* in[31]; float* out; unsigned char* ws; int ph_lo, ph_hi; };


typedef unsigned short bf16_t;
typedef short bf16x8 __attribute__((ext_vector_type(8)));
typedef unsigned u32x4 __attribute__((ext_vector_type(4)));
typedef unsigned u32x2 __attribute__((ext_vector_type(2)));
constexpr int BM = 256, BK = 64, HALF = 128, HTB = HALF * BK * 2, STAGE_BYTES = 8 * HTB, NXCD = 8, WGM = 4, WGM_MOE = 1;
__host__ __device__ __forceinline__ int lds_byte(int r, int c) { const int st = (r >> 4) * 2 + (c >> 5), rr = r & 15, cc = c & 31, ob = rr * 64 + cc * 2; return st * 1024 + (ob ^ (((ob >> 9) & 1) << 5)); }
__host__ __device__ __forceinline__ void stage_rc(int b, int& R, int& C) { const int st = b / 1024, sb = b % 1024, swz = sb ^ (((sb >> 9) & 1) << 5); R = (st >> 1) * 16 + swz / 64; C = (st & 1) * 32 + (swz % 64) / 2; }
__host__ __device__ __forceinline__ int perm32(int rho) { const int n = rho >> 4, i = rho & 15; return 8 * (i >> 2) + 4 * n + (i & 3); }
__device__ __forceinline__ unsigned cvt_pk_bf16(float lo, float hi) { unsigned r; asm volatile("v_cvt_pk_bf16_f32 %0, %1, %2" : "=v"(r) : "v"(lo), "v"(hi)); return r; }
__device__ __forceinline__ unsigned f2bf(float f) { unsigned u = __builtin_bit_cast(unsigned, f); return (u + 0x7fffu + ((u >> 16) & 1u)) >> 16; }
__device__ __forceinline__ unsigned pk2(float lo, float hi) { return f2bf(lo) | (f2bf(hi) << 16); }
__device__ __forceinline__ float bf2f(unsigned short b) { return __builtin_bit_cast(float, ((unsigned)b) << 16); }

__device__ __forceinline__ void glds16s(const void* sbase, unsigned voff, unsigned lds_dst) {
    unsigned keep;
    asm volatile("s_mov_b32 %0, m0\n\ts_mov_b32 m0, %3\n\ts_nop 0\n\tglobal_load_lds_dwordx4 %1, %2\n\ts_mov_b32 m0, %0" : "=&s"(keep) : "v"(voff), "s"(sbase), "s"(lds_dst) : "memory");
}
struct GUnit { const char* A; const char* B; int pm, pn, e, row0, cnt; };

struct DenseOrder {
    const char* A; const char* Bt; int nM, nN, nwg, G, c, K;
    __device__ __forceinline__ void init(const bf16_t* A_, const bf16_t* Bt_, int M, int N, int K_, int G_, int c_) { A = (const char*)A_; Bt = (const char*)Bt_; nM = M / BM; nN = N / BM; nwg = nM * nN; G = G_; c = c_; K = K_; }
    __device__ __forceinline__ bool next(int i, GUnit& u) const {
        const long L = (long)i * G + c; if (L >= nwg) return false;
        int wgid = (int)L; { const int q = nwg / NXCD, r = nwg % NXCD, xcd = wgid % NXCD, off = wgid / NXCD; wgid = (xcd < r ? xcd * (q + 1) : r * (q + 1) + (xcd - r) * q) + off; }
        const int nig = WGM * nN, gid = wgid / nig, fm = gid * WGM, gsz = (nM - fm) < WGM ? (nM - fm) : WGM;
        u.pm = fm + ((wgid % nig) % gsz); u.pn = (wgid % nig) / gsz; u.e = 0; u.row0 = 0; u.cnt = 0;
        u.A = A + (size_t)u.pm * BM * K * 2; u.B = Bt + (size_t)u.pn * BM * K * 2; return true;
    }
    __device__ __forceinline__ unsigned aoff(const GUnit&, int row) const { return (unsigned)(row * K * 2); }
    __device__ __forceinline__ unsigned tokoff(const GUnit&, int) const { return 0u; }
    __device__ __forceinline__ const int* tokbase() const { return nullptr; }
};

struct EpiF32 {
    static constexpr bool PERM = false;
    float* C; int ldc; int resid;
    __device__ __forceinline__ void operator()(const f32x4 (&acc)[2][2][4][2], const GUnit& u, int wr, int wc, int fr, int fq) const {
        const int row0 = u.pm * BM + wr * 64 + fr, col0 = u.pn * BM + wc * 32 + 4 * fq;
#pragma unroll
        for (int ai = 0; ai < 2; ++ai)
#pragma unroll
            for (int m = 0; m < 4; ++m) { float* rowp = C + (size_t)(row0 + ai * HALF + m * 16) * ldc + col0;
#pragma unroll
                for (int bj = 0; bj < 2; ++bj)
#pragma unroll
                    for (int n = 0; n < 2; ++n) { f32x4 v = acc[ai][bj][m][n]; if (resid) v += *(const f32x4*)(rowp + bj * HALF + n * 16); *(f32x4*)(rowp + bj * HALF + n * 16) = v; } }
    }
};
struct EpiGlu {
    static constexpr bool PERM = false;
    float* C; const float* Y; int ldc; const float* bias;
    __device__ __forceinline__ void operator()(const f32x4 (&acc)[2][2][4][2], const GUnit& u, int wr, int wc, int fr, int fq) const {
        const int row0 = u.pm * BM + wr * 64 + fr, col0 = u.pn * BM + wc * 32 + 4 * fq;
#pragma unroll
        for (int ai = 0; ai < 2; ++ai)
#pragma unroll
            for (int m = 0; m < 4; ++m) { const size_t ro = (size_t)(row0 + ai * HALF + m * 16) * ldc + col0;
#pragma unroll
                for (int bj = 0; bj < 2; ++bj)
#pragma unroll
                    for (int n = 0; n < 2; ++n) { const f32x4 b = *(const f32x4*)(bias + col0 + bj * HALF + n * 16); const f32x4 y = *(const f32x4*)(Y + ro + bj * HALF + n * 16);
                        f32x4 v = acc[ai][bj][m][n] + b; f32x4 o;
#pragma unroll
                        for (int j = 0; j < 4; ++j) o[j] = y[j] / (1.f + __expf(-v[j]));
                        *(f32x4*)(C + ro + bj * HALF + n * 16) = o; } }
    }
};

template <class Epi, class Sched, bool GATHER, bool ALIGN_EPI>
__device__ __forceinline__ void gemm_phase(LAS unsigned char* lds, const int K, const Sched& S, const Epi& E, const int tid, const int wv) {
    const int wid = wv, lane = tid & 63, wr = wid >> 2, wc = wid & 3, fr = lane & 15, fq = lane >> 4;
    const int nt = K / BK;
    unsigned voffB[2];
#pragma unroll
    for (int i = 0; i < 2; ++i) { int R, C; stage_rc(tid * 16 + i * 8192, R, C); const int Rb = Epi::PERM ? ((R & ~31) + perm32(R & 31)) : R; voffB[i] = (unsigned)(Rb * K + C) * 2u; }
#define PG8_AOFFS(dst, u) do { int t2_ = tid; asm volatile("" : "+v"(t2_)); _Pragma("unroll") for (int i = 0; i < 2; ++i) { int R, C; stage_rc(t2_ * 16 + i * 8192, R, C); \
        _Pragma("unroll") for (int h = 0; h < 2; ++h) dst[h][i] = S.aoff(u, h * HALF + R) + (unsigned)C * 2u; } } while (0)
    const size_t kstep = (size_t)(BK * 2);
    const size_t hstep = (size_t)HALF * K * 2;
    const unsigned ldsw = (unsigned)wid * 1024u;
    const int aoff = lds_byte(wr * 64 + fr, fq * 8), boff = lds_byte(wc * 32 + fr, fq * 8);
#define PG8_SA(b, h) (((b) * 2 + (h)) * HTB)
#define PG8_SB(b, h) ((4 + (b) * 2 + (h)) * HTB)
#define PG8_STAGE(bufoff, gbase, v0, v1) do { const unsigned ld_ = (unsigned)(size_t)(lds + (bufoff) + ldsw); glds16s((gbase), (v0), ld_); glds16s((gbase), (v1), ld_ + 8192u); } while (0)
#define PG8_LDA(dst, b, h) do { _Pragma("unroll") for (int m = 0; m < 4; ++m) _Pragma("unroll") for (int k = 0; k < 2; ++k) dst[m][k] = *(const LAS bf16x8*)(lds + PG8_SA(b, h) + aoff + m * 2048 + k * 1024); } while (0)
#define PG8_LDB(dst, b, h) do { _Pragma("unroll") for (int n = 0; n < 2; ++n) _Pragma("unroll") for (int k = 0; k < 2; ++k) dst[n][k] = *(const LAS bf16x8*)(lds + PG8_SB(b, h) + boff + n * 2048 + k * 1024); } while (0)
#define PG8_MMA(ai, bj, At, Bt) do { __builtin_amdgcn_s_setprio(1); _Pragma("unroll") for (int m = 0; m < 4; ++m) _Pragma("unroll") for (int n = 0; n < 2; ++n) _Pragma("unroll") for (int k = 0; k < 2; ++k) \
        acc[ai][bj][m][n] = __builtin_amdgcn_mfma_f32_16x16x32_bf16(Bt[n][k], At[m][k], acc[ai][bj][m][n], 0, 0, 0); __builtin_amdgcn_s_setprio(0); } while (0)
#define PG8_WAIT_V(n) asm volatile("s_waitcnt vmcnt(" #n ")" ::: "memory")
#define PG8_WAIT_L(n) asm volatile("s_waitcnt lgkmcnt(" #n ")" ::: "memory")
#define PG8_BAR __builtin_amdgcn_s_barrier()
#define PG8_SCHED __builtin_amdgcn_sched_barrier(0)
    GUnit cur, nxt; int ui = 0;
    if (!S.next(0, cur)) return;
    f32x4 acc[2][2][4][2];
#pragma unroll
    for (int a = 0; a < 2; ++a)
#pragma unroll
        for (int b = 0; b < 2; ++b)
#pragma unroll
            for (int m = 0; m < 4; ++m)
#pragma unroll
                for (int n = 0; n < 2; ++n) acc[a][b][m][n] = (f32x4){0.f, 0.f, 0.f, 0.f};
    bf16x8 At[4][2], B0[2][2], B1[2][2];
    unsigned vA[2][2], vN[2][2];
    PG8_AOFFS(vA, cur);
#pragma unroll
    for (int h = 0; h < 2; ++h)
#pragma unroll
        for (int i = 0; i < 2; ++i) vN[h][i] = vA[h][i];
    const char* cA = cur.A; const char* cB = cur.B;
    PG8_STAGE(PG8_SB(0, 0), cB, voffB[0], voffB[1]); PG8_STAGE(PG8_SB(0, 1), cB + hstep, voffB[0], voffB[1]); PG8_STAGE(PG8_SA(0, 0), cA, vA[0][0], vA[0][1]); PG8_STAGE(PG8_SA(0, 1), cA, vA[1][0], vA[1][1]);
    if (wr == 1) PG8_BAR;
    PG8_WAIT_V(2); PG8_BAR;
    PG8_STAGE(PG8_SB(1, 0), cB + kstep, voffB[0], voffB[1]); PG8_STAGE(PG8_SA(1, 0), cA + kstep, vA[0][0], vA[0][1]); PG8_STAGE(PG8_SB(1, 1), cB + hstep + kstep, voffB[0], voffB[1]);
    PG8_WAIT_V(6); PG8_BAR;
    for (;;) {
        const bool has_next = S.next(ui + 1, nxt);
        const char* nA = GATHER ? cA : (has_next ? nxt.A : cA); const char* nB = has_next ? nxt.B : cB;
        unsigned tok_[2][2] = {{0u, 0u}, {0u, 0u}};
#define PG8_KBODY(a1, a2, b2, a3, b3, W00, W01, W10, W11) do { \
              \
            PG8_LDB(B0, 0, 0); PG8_LDB(B1, 0, 1); PG8_SCHED; PG8_LDA(At, 0, 0); PG8_STAGE(PG8_SA(1, 1), a1, vA[1][0], vA[1][1]); \
            PG8_WAIT_V(8); PG8_WAIT_L(0); PG8_BAR; PG8_MMA(0, 0, At, B0); PG8_MMA(0, 1, At, B1); PG8_BAR; PG8_SCHED; \
              \
            PG8_LDA(At, 0, 1); PG8_STAGE(PG8_SB(0, 0), b2, voffB[0], voffB[1]); PG8_STAGE(PG8_SB(0, 1), (b2) + hstep, voffB[0], voffB[1]); PG8_STAGE(PG8_SA(0, 0), a2, W00, W01); \
            PG8_WAIT_V(8); PG8_WAIT_L(0); PG8_BAR; PG8_MMA(1, 0, At, B0); PG8_MMA(1, 1, At, B1); PG8_BAR; PG8_SCHED; \
              \
            PG8_LDB(B0, 1, 0); PG8_LDB(B1, 1, 1); PG8_SCHED; PG8_LDA(At, 1, 0); PG8_STAGE(PG8_SA(0, 1), a2, W10, W11); \
            PG8_WAIT_V(8); PG8_WAIT_L(0); PG8_BAR; PG8_MMA(0, 0, At, B0); PG8_MMA(0, 1, At, B1); PG8_BAR; PG8_SCHED; \
              \
            PG8_LDA(At, 1, 1); PG8_STAGE(PG8_SB(1, 0), b3, voffB[0], voffB[1]); PG8_STAGE(PG8_SB(1, 1), (b3) + hstep, voffB[0], voffB[1]); PG8_STAGE(PG8_SA(1, 0), a3, W00, W01); \
            PG8_WAIT_V(8); PG8_WAIT_L(0); PG8_BAR; PG8_MMA(1, 0, At, B0); PG8_MMA(1, 1, At, B1); PG8_BAR; PG8_SCHED; } while (0)
        for (int t = 0; t < nt - 2; t += 2) {
            const char* a1 = cA + (size_t)(t + 1) * kstep;
            const char* a2 = cA + (size_t)(t + 2) * kstep; const char* b2 = cB + (size_t)(t + 2) * kstep;
            const char* a3 = a2 + kstep; const char* b3 = b2 + kstep;
            if (GATHER) { if (t == nt - 4 && has_next) { int t2_ = tid; asm volatile("" : "+v"(t2_));
#pragma unroll
                for (int i = 0; i < 2; ++i) { int R, C; stage_rc(t2_ * 16 + i * 8192, R, C);
#pragma unroll
                    for (int h = 0; h < 2; ++h) { const unsigned vo = S.tokoff(nxt, h * HALF + R); asm volatile("global_load_dword %0, %1, %2" : "=v"(tok_[h][i]) : "v"(vo), "s"(S.tokbase()) : "memory"); } } } }
            PG8_KBODY(a1, a2, b2, a3, b3, vA[0][0], vA[0][1], vA[1][0], vA[1][1]);
        }
        if (GATHER) {
            if (has_next) { int t2_ = tid; asm volatile("" : "+v"(t2_), "+v"(tok_[0][0]), "+v"(tok_[0][1]), "+v"(tok_[1][0]), "+v"(tok_[1][1]));
#pragma unroll
                for (int i = 0; i < 2; ++i) { int R, C; stage_rc(t2_ * 16 + i * 8192, R, C);
#pragma unroll
                    for (int h = 0; h < 2; ++h) vN[h][i] = tok_[h][i] * (unsigned)(K * 2) + (unsigned)C * 2u; } }
            else {
#pragma unroll
                for (int h = 0; h < 2; ++h)
#pragma unroll
                    for (int i = 0; i < 2; ++i) vN[h][i] = vA[h][i];
            }
        }
        {
            const char* a1 = cA + (size_t)(nt - 1) * kstep;
            const char* a3 = nA + kstep; const char* b3 = nB + kstep;
            PG8_KBODY(a1, nA, nB, a3, b3, vN[0][0], vN[0][1], vN[1][0], vN[1][1]);
        }
#undef PG8_KBODY
        if constexpr (ALIGN_EPI) { if (wr == 0) PG8_BAR; }
        { int t3_ = tid; asm volatile("" : "+v"(t3_)); const int l3_ = t3_ & 63; E(acc, cur, wr, wc, l3_ & 15, l3_ >> 4); }
        if (!has_next) break;
#pragma unroll
        for (int a = 0; a < 2; ++a)
#pragma unroll
            for (int b = 0; b < 2; ++b)
#pragma unroll
                for (int m = 0; m < 4; ++m)
#pragma unroll
                    for (int n = 0; n < 2; ++n) acc[a][b][m][n] = (f32x4){0.f, 0.f, 0.f, 0.f};
        cur = nxt; cA = nA; cB = nB; ++ui;
        if (GATHER) {
#pragma unroll
            for (int h = 0; h < 2; ++h)
#pragma unroll
                for (int i = 0; i < 2; ++i) vA[h][i] = vN[h][i];
        }
        if constexpr (ALIGN_EPI) { if (wr == 1) PG8_BAR; }
    }
    PG8_WAIT_V(0);
    if constexpr (!ALIGN_EPI) { if (wr == 0) PG8_BAR; }
    PG8_BAR;
#undef PG8_AOFFS
#undef PG8_SA
#undef PG8_SB
#undef PG8_STAGE
#undef PG8_LDA
#undef PG8_LDB
#undef PG8_MMA
#undef PG8_WAIT_V
#undef PG8_WAIT_L
#undef PG8_BAR
#undef PG8_SCHED
}


constexpr int TS_OFF = 131072 + 1024;
template <bool GATHER> struct MoeOrder {
    const char* A; const char* Bt; const int* rowtok; int nN, nwg, nM, G, c, K; size_t strideE;
    __device__ __forceinline__ void init(const bf16_t* A_, const bf16_t* Bt_, const int* rowtok_, int N, int K_, size_t strideE_, int G_, int c_) {
        A = (const char*)A_; Bt = (const char*)Bt_; rowtok = rowtok_; nN = N / BM; K = K_; strideE = strideE_; G = G_; c = c_;
        nM = __builtin_amdgcn_readfirstlane(((LAS const int*)(LDSP + TS_OFF))[32]); nwg = nM * nN; }
    __device__ __forceinline__ bool next(int i, GUnit& u) const {
        const long L = (long)i * G + c; if (L >= nwg) return false;
        int wgid = (int)L; { const int q = nwg / NXCD, r = nwg % NXCD, xcd = wgid % NXCD, off = wgid / NXCD; wgid = (xcd < r ? xcd * (q + 1) : r * (q + 1) + (xcd - r) * q) + off; }
        const int nig = WGM_MOE * nN, gid = wgid / nig, fm = gid * WGM_MOE, gsz = (nM - fm) < WGM_MOE ? (nM - fm) : WGM_MOE;
        u.pm = fm + ((wgid % nig) % gsz); u.pn = (wgid % nig) / gsz;
        LAS const int* ts = (LAS const int*)(LDSP + TS_OFF);
        const int e = __builtin_amdgcn_readfirstlane(ts[72 + u.pm]);
        u.e = e; u.row0 = (u.pm - __builtin_amdgcn_readfirstlane(ts[e])) * BM; u.cnt = __builtin_amdgcn_readfirstlane(ts[33 + e]);
        u.A = GATHER ? A : A + (size_t)u.pm * BM * K * 2;
        u.B = Bt + (size_t)e * strideE + (size_t)u.pn * BM * K * 2; return true;
    }
    __device__ __forceinline__ unsigned aoff(const GUnit& u, int row) const {
        if (GATHER) { int sl = u.row0 + row; sl = sl < u.cnt ? sl : u.cnt - 1; return (unsigned)rowtok[u.e * ECAP + sl] * (unsigned)(K * 2); }
        return (unsigned)(row * K * 2);
    }
    __device__ __forceinline__ unsigned tokoff(const GUnit& u, int row) const { int sl = u.row0 + row; sl = sl < u.cnt ? sl : u.cnt - 1; return (unsigned)(u.e * ECAP + sl) * 4u; }
    __device__ __forceinline__ const int* tokbase() const { return rowtok; }
};
__device__ __forceinline__ void moe_tiles(const unsigned* cnt, int tid) {
    LAS int* ts = (LAS int*)(LDSP + TS_OFF);
    if (tid == 0) { int s = 0; for (int e = 0; e < NEXP; ++e) { const int c = (int)cnt[e]; ts[e] = s; ts[33 + e] = c; const int n = (c + BM - 1) / BM;
_Pragma("clang loop vectorize(disable) unroll(disable)") for (int t = 0; t < n; ++t) ts[72 + s + t] = e;
            s += n; } ts[NEXP] = s; }
    __syncthreads();
}
struct EpiMoe1 {
    static constexpr bool PERM = true;
    bf16_t* O; const float* b1; const float* rsc;
    __device__ __forceinline__ void operator()(const f32x4 (&acc)[2][2][4][2], const GUnit& u, int wr, int wc, int fr, int fq) const {
        const int rt0 = wr * 64 + fr, col0 = u.pn * 128 + wc * 32 + 8 * fq;
        const float* bg = b1 + (size_t)u.e * 2048 + col0;
        f32x4 bgv[2], blv[2];
#pragma unroll
        for (int n = 0; n < 2; ++n) { bgv[n] = *(const f32x4*)(bg + 4 * n); blv[n] = *(const f32x4*)(bg + DFF + 4 * n); }
#pragma unroll
        for (int ai = 0; ai < 2; ++ai)
#pragma unroll
            for (int m = 0; m < 4; ++m) {
                const int rt = rt0 + ai * HALF + m * 16; int sl = u.row0 + rt; sl = sl < u.cnt ? sl : u.cnt - 1;
                const float r = rsc[u.e * ECAP + sl];
                float o[8];
                const f32x2 r2 = (f32x2){r, r};
#pragma unroll
                for (int n = 0; n < 2; ++n)
#pragma unroll
                    for (int jp = 0; jp < 2; ++jp) {
                        const f32x2 ag = (f32x2){acc[ai][0][m][n][2 * jp], acc[ai][0][m][n][2 * jp + 1]}, al = (f32x2){acc[ai][1][m][n][2 * jp], acc[ai][1][m][n][2 * jp + 1]};
                        f32x2 g = ag * r2 + (f32x2){bgv[n][2 * jp], bgv[n][2 * jp + 1]}, l = al * r2 + (f32x2){blv[n][2 * jp], blv[n][2 * jp + 1]};
                        g.x = fminf(g.x, 7.f); g.y = fminf(g.y, 7.f);
                        l.x = __builtin_amdgcn_fmed3f(l.x, -7.f, 7.f); l.y = __builtin_amdgcn_fmed3f(l.y, -7.f, 7.f);
                        const f32x2 z = g * (-2.4554669595930157f);
                        f32x2 e; e.x = __builtin_amdgcn_exp2f(z.x); e.y = __builtin_amdgcn_exp2f(z.y);
                        e = e + 1.0f;
                        f32x2 q; q.x = __builtin_amdgcn_rcpf(e.x); q.y = __builtin_amdgcn_rcpf(e.y);
                        const f32x2 v = (g * q) * (l + 1.0f);
                        o[n * 4 + 2 * jp] = v.x; o[n * 4 + 2 * jp + 1] = v.y;
                    }
                u32x4 w; w.x = cvt_pk_bf16(o[0], o[1]); w.y = cvt_pk_bf16(o[2], o[3]); w.z = cvt_pk_bf16(o[4], o[5]); w.w = cvt_pk_bf16(o[6], o[7]);
                *(u32x4*)(O + (size_t)(u.pm * BM + rt) * DFF + col0) = w;
            }
    }
};
struct EpiMoe2 {
    static constexpr bool PERM = true;
    bf16_t* O; const float* b2;
    __device__ __forceinline__ void operator()(const f32x4 (&acc)[2][2][4][2], const GUnit& u, int wr, int wc, int fr, int fq) const {
        const int row0 = u.pm * BM + wr * 64 + fr, col0 = u.pn * BM + wc * 32 + 8 * fq;
        f32x4 bv[2][2];
#pragma unroll
        for (int bj = 0; bj < 2; ++bj)
#pragma unroll
            for (int n = 0; n < 2; ++n) bv[bj][n] = *(const f32x4*)(b2 + (size_t)u.e * DM + col0 + bj * HALF + 4 * n);
#pragma unroll
        for (int ai = 0; ai < 2; ++ai)
#pragma unroll
            for (int m = 0; m < 4; ++m) { bf16_t* rowp = O + (size_t)(row0 + ai * HALF + m * 16) * DM + col0;
#pragma unroll
                for (int bj = 0; bj < 2; ++bj) { const f32x4 v0 = acc[ai][bj][m][0] + bv[bj][0], v1 = acc[ai][bj][m][1] + bv[bj][1];
                    u32x4 w; w.x = cvt_pk_bf16(v0[0], v0[1]); w.y = cvt_pk_bf16(v0[2], v0[3]); w.z = cvt_pk_bf16(v1[0], v1[1]); w.w = cvt_pk_bf16(v1[2], v1[3]);
                    *(u32x4*)(rowp + bj * HALF) = w; } }
    }
};

__device__ __forceinline__ void p_transpose_r(const int wv, const float* W, int nmat, int K, int N, bf16_t* WT, const float* kgain, int gdiv, int mode, LAS unsigned char* lds, int it_begin, int it_end, int wrank, int wstride) {
    LTID();
    const int wave = wv, lane = tidx & 63;
    LAS float* scr = (LAS float*)(lds + wave * 16384);
    const int nblk = N / 32, per_mat = (K / 64) * nblk, total = it_end, stride = wstride;
    const int lrow = lane >> 5, lcol = lane & 31;
#define TR_DECODE(item, mat_, kb_, nb_) const int mat_ = (item) / per_mat, r_ = (item) - mat_ * per_mat, g8_ = r_ >> 3, l8_ = r_ & 7, kb_ = 2 * (g8_ / (nblk >> 2)) + (l8_ & 1), nb_ = 4 * (g8_ % (nblk >> 2)) + (l8_ >> 1)
#define TR_ISSUE(item, dst) do { TR_DECODE(item, mat_, kb_, nb_); \
        const float* src_ = W + (size_t)mat_ * K * N + (size_t)(64 * kb_ + lrow) * N + 32 * nb_ + lcol; \
        _Pragma("unroll") for (int i = 0; i < 32; ++i) dst[i] = __builtin_nontemporal_load(src_ + (size_t)(2 * i) * N); } while (0)
    float v[32], vn[32], vnn[32];
    int it = it_begin + wrank;
    if (it < total) TR_ISSUE(it, v);
    if (it + stride < total) TR_ISSUE(it + stride, vn);
    while (it < total) {
        const int itn = it + stride, itnn = itn + stride;
        if (itnn < total) TR_ISSUE(itnn, vnn);
        TR_DECODE(it, mat, kb, nb); const int k0 = 64 * kb, n0 = 32 * nb;
#pragma unroll
        for (int i = 0; i < 32; ++i) scr[(2 * i + lrow) * 33 + lcol] = v[i];
        asm volatile("s_waitcnt lgkmcnt(0)" ::: "memory");
        int d0 = n0;
        if (mode == 1) { const int bj = n0 >> 10, rest = n0 & 1023, pn = rest >> 7, j = rest & 127; d0 = pn * 256 + bj * 128 + j; }
        const int c = lane & 7;
        f32x4 g0 = (f32x4){1.f, 1.f, 1.f, 1.f}, g1 = g0;
        if (kgain) { const float* gp = kgain + (size_t)(mat / gdiv) * DM + k0 + 8 * c; g0 = *(const f32x4*)gp; g1 = *(const f32x4*)(gp + 4); }
        bf16_t* dst = WT + (size_t)mat * K * N;
#pragma unroll
        for (int j = 0; j < 4; ++j) { const int n = (lane >> 3) + 8 * j; const LAS float* sp = scr + (8 * c) * 33 + n;
            u32x4 o; o.x = cvt_pk_bf16(sp[0 * 33] * g0[0], sp[1 * 33] * g0[1]); o.y = cvt_pk_bf16(sp[2 * 33] * g0[2], sp[3 * 33] * g0[3]); o.z = cvt_pk_bf16(sp[4 * 33] * g1[0], sp[5 * 33] * g1[1]); o.w = cvt_pk_bf16(sp[6 * 33] * g1[2], sp[7 * 33] * g1[3]);
            __builtin_nontemporal_store(o, (u32x4*)(dst + (size_t)(d0 + n) * K + k0 + 8 * c)); }
        asm volatile("s_waitcnt lgkmcnt(0)" ::: "memory");
#pragma unroll
        for (int i = 0; i < 32; ++i) { v[i] = vn[i]; vn[i] = vnn[i]; }
        it = itn;
    }
#undef TR_ISSUE
#undef TR_DECODE
}
__device__ __forceinline__ void p_transpose(const int wv, const float* W, int nmat, int K, int N, bf16_t* WT, const float* kgain, int gdiv, int mode, LAS unsigned char* lds, int rot) {
    const int G_ = (int)gridDim.x, b_ = ((int)blockIdx.x + G_ - rot % G_) % G_;
    p_transpose_r(wv, W, nmat, K, N, WT, kgain, gdiv, mode, lds, 0, nmat * (K / 64) * (N / 32), b_ * NW + wv, G_ * NW);
}
typedef short v4i16_t __attribute__((ext_vector_type(4)));
constexpr int ATT_TAB_OFF = 131072 + 2048;
constexpr int ATT_UNITS = 3 * 8 * 128;
__device__ __forceinline__ int t5_bucket_dev(int n) {
    if (n < 16) return n;
    const float v = logf((float)n / 16.f) / 4.852030263919617f * 16.f;
    const int large = 16 + (int)v;
    return large < 31 ? large : 31;
}
__device__ __forceinline__ void p_bias_table(const int wv, const float* rel_bias, float* biasG, int rot) {
    LTID();
    for (int i = ROTB(rot) * NT + tidx; i < 3 * 8 * 132; i += gridDim.x * NT) {
        const int d = i % 132, bh = i / 132, h = bh & 7, b = bh >> 3;
        biasG[i] = (d <= 128) ? rel_bias[t5_bucket_dev(d << (2 * b)) * 8 + h] * 1.4426950408889634f : 0.f;
    }
}
__device__ __forceinline__ void p_dil_attn(const int wv, const bf16_t* proj16, const float* biasG, bf16_t* obr, float* lse, LAS unsigned char* lds) {
    LTID();
    const int lane = tidx & 63, fr = lane & 15, fq = lane >> 4, w = wv;
    const int per = (ATT_UNITS + (int)gridDim.x - 1) / (int)gridDim.x;
    const int u0 = bidx * per, u1 = (u0 + per < ATT_UNITS) ? u0 + per : ATT_UNITS;
    if (u0 >= u1) return;
    const int rowl = tidx >> 3, cs = tidx & 7;
    const unsigned cK = (unsigned)(cs ^ ((rowl >> 1) & 7)) * 16u, cV = (unsigned)(cs ^ (rowl & 7)) * 16u;
    const unsigned fK = (unsigned)((fr >> 1) & 7);
    const unsigned kro0 = (unsigned)fr * 128u + (((unsigned)fq ^ fK) * 16u), kro1 = (unsigned)fr * 128u + ((((unsigned)fq ^ fK) ^ 4u) * 16u);
    const int tq = (lane & 15) >> 2, tp = lane & 3, fv = 4 * (fq & 1) + tq;
    unsigned vro[4];
#pragma unroll
    for (int db = 0; db < 4; ++db) vro[db] = (unsigned)(4 * fq + tq) * 128u + (unsigned)(((2 * db + (tp >> 1)) ^ fv) * 16) + 8u * (unsigned)(tp & 1);
    const int ts_ = (1 + fr) & 3;
    const unsigned tab8 = (unsigned)ATT_TAB_OFF + (unsigned)ts_ * 640u + (unsigned)(((141 + fr - ts_) >> 2) - fq - 32) * 16u;
    const char* gbase = (const char*)proj16;
#define ATT_DECODE(u, b_, h_, r_, n_, dil_) const int cmb_ = (u) >> 7, b_ = cmb_ >> 3, h_ = cmb_ & 7, dil_ = 1 << (2 * b_), idx_ = (u) & 127, r_ = idx_ & (dil_ - 1), n_ = idx_ >> (2 * b_)
#define ATT_ISSUE(u, bf, q0, q1) do { ATT_DECODE(u, b__, h__, r__, n__, dil__); \
        const int nk = n__ > 0 ? n__ - 1 : 0;                                     \
        _Pragma("unroll") for (int p = 0; p < 4; ++p) { \
            int row = 64 * p + rowl; int blk = (row >> 7) ? n__ : nk; \
            const unsigned pos = (unsigned)(r__ + dil__ * (128 * blk + (row & 127))); \
            const unsigned so = pos * 4096u + (unsigned)h__ * 128u; const unsigned ld_ = (unsigned)(size_t)(lds + (bf) * 65536 + p * 8192 + w * 1024); \
            glds16s(gbase, so + 1024u + cK, ld_); glds16s(gbase, so + 2048u + cV, ld_ + 32768u); } \
        const unsigned qpos = (unsigned)(r__ + dil__ * (128 * n__ + 16 * w + fr)); \
        const char* qsrc = gbase + (size_t)qpos * 4096u + (unsigned)h__ * 128u + (unsigned)fq * 16u; \
        q0 = *(const bf16x8*)(qsrc); q1 = *(const bf16x8*)(qsrc + 64); } while (0)
    bf16x8 qf0, qf1, qn0, qn1;
    ATT_ISSUE(u0, 0, qn0, qn1);
    int prev_cmb = -1;
    for (int u = u0; u < u1; ++u) {
        const int bf = (u - u0) & 1;
        if (u == u0) asm volatile("s_waitcnt vmcnt(0)" ::: "memory"); else asm volatile("s_waitcnt vmcnt(5)" ::: "memory");
        __builtin_amdgcn_s_barrier();
        qf0 = qn0; qf1 = qn1;
        if (u + 1 < u1) ATT_ISSUE(u + 1, bf ^ 1, qn0, qn1);
        ATT_DECODE(u, b, h, r, n, dil);
        if (cmb_ != prev_cmb) {
            prev_cmb = cmb_;
            for (int e = tidx; e < 4 * 160; e += NT) { const int sft = e / 160, k = e - sft * 160, idx = k + sft, dist = idx - 16;
                const float v = (dist >= 0 && dist <= 128) ? biasG[cmb_ * 132 + dist] : -1e30f;
                ((LAS float*)(lds + ATT_TAB_OFF))[sft * 160 + k] = v; }
            __syncthreads();
        }
        const LAS unsigned char* Kb = lds + bf * 65536; const LAS unsigned char* Vb = Kb + 32768;
        const int kb0 = w;
        f32x4 sc[9];
#pragma unroll
        for (int i = 0; i < 9; ++i) {
            const unsigned ko = (unsigned)(kb0 + i) * 2048u;
            const bf16x8 k0 = *(const LAS bf16x8*)(Kb + ko + kro0), k1 = *(const LAS bf16x8*)(Kb + ko + kro1);
            f32x4 a = (f32x4){0.f, 0.f, 0.f, 0.f};
            a = __builtin_amdgcn_mfma_f32_16x16x32_bf16(k0, qf0, a, 0, 0, 0);
            a = __builtin_amdgcn_mfma_f32_16x16x32_bf16(k1, qf1, a, 0, 0, 0);
            const f32x4 t = *(const LAS f32x4*)(lds + tab8 + 64 * (8 - i));
            a = a + (f32x4){t[3], t[2], t[1], t[0]};
            if (n == 0 && kb0 + i < 8) a = (f32x4){-1e30f, -1e30f, -1e30f, -1e30f};
            sc[i] = a;
        }
#pragma unroll
        for (int i = 0; i < 9; ++i)
#pragma unroll
            for (int j = 0; j < 4; ++j) sc[i][j] = __builtin_amdgcn_exp2f(fminf(sc[i][j], 100.f));
        f32x4 oacc[4]; f32x4 sacc = (f32x4){0.f, 0.f, 0.f, 0.f};
        const bf16x8 ones = (bf16x8){0x3F80, 0x3F80, 0x3F80, 0x3F80, 0x3F80, 0x3F80, 0x3F80, 0x3F80};
#pragma unroll
        for (int db = 0; db < 4; ++db) oacc[db] = (f32x4){0.f, 0.f, 0.f, 0.f};
#pragma unroll
        for (int c = 0; c < 5; ++c) {
            const int ia = 2 * c, ib = (c < 4) ? 2 * c + 1 : 8;
            u32x4 pw; pw.x = cvt_pk_bf16(sc[ia][0], sc[ia][1]); pw.y = cvt_pk_bf16(sc[ia][2], sc[ia][3]);
            if (c < 4) { pw.z = cvt_pk_bf16(sc[ib][0], sc[ib][1]); pw.w = cvt_pk_bf16(sc[ib][2], sc[ib][3]); } else { pw.z = 0u; pw.w = 0u; }
            const bf16x8 pf = __builtin_bit_cast(bf16x8, pw);
            const unsigned va = (unsigned)(kb0 + ia) * 2048u, vb = (unsigned)(kb0 + ib) * 2048u;
            sacc = __builtin_amdgcn_mfma_f32_16x16x32_bf16(ones, pf, sacc, 0, 0, 0);
#pragma unroll
            for (int db = 0; db < 4; ++db) {
                const v4i16_t x0 = __builtin_amdgcn_ds_read_tr16_b64_v4i16((LAS v4i16_t*)(Vb + va + vro[db]));
                const v4i16_t x1 = __builtin_amdgcn_ds_read_tr16_b64_v4i16((LAS v4i16_t*)(Vb + vb + vro[db]));
                const bf16x8 vf = (bf16x8){x0[0], x0[1], x0[2], x0[3], x1[0], x1[1], x1[2], x1[3]};
                oacc[db] = __builtin_amdgcn_mfma_f32_16x16x32_bf16(vf, pf, oacc[db], 0, 0, 0);
            }
        }
        const float sum = sacc[0];
        const float inv = 1.f / sum;
        const unsigned qpos = (unsigned)(r + dil * (128 * n + 16 * w + fr));
        bf16_t* orow = obr + ((size_t)b * SEQ + qpos) * 512 + h * 64 + 4 * fq;
#pragma unroll
        for (int db = 0; db < 4; ++db) { u32x2 o2; o2.x = cvt_pk_bf16(oacc[db][0] * inv, oacc[db][1] * inv); o2.y = cvt_pk_bf16(oacc[db][2] * inv, oacc[db][3] * inv); *(u32x2*)(orow + 16 * db) = o2; }
        if (fq == 0) lse[((size_t)b * SEQ + qpos) * 8 + h] = sum;
    }
    asm volatile("s_waitcnt vmcnt(0)" ::: "memory");
    __syncthreads();
#undef ATT_DECODE
#undef ATT_ISSUE
}
__device__ __forceinline__ void p_attn_combine(const int wv, const bf16_t* obr, const float* lse, const float* g, bf16_t* mix16) {
    LTID();
    const int lane = tidx & 63, h = lane >> 3;
    const f32x4 g0 = *(const f32x4*)(g + lane * 8), g1 = *(const f32x4*)(g + lane * 8 + 4);
    const int rstride = (int)gridDim.x * NW;
    for (int row0 = bidx * NW + wv; row0 < SEQ; row0 += 4 * rstride) {
        float lv[4][3]; u32x4 av[4][3];
#pragma unroll
        for (int r = 0; r < 4; ++r) { const int row = (row0 + r * rstride < SEQ) ? row0 + r * rstride : row0;
#pragma unroll
            for (int b = 0; b < 3; ++b) { lv[r][b] = lse[((size_t)b * SEQ + row) * 8 + h]; av[r][b] = *(const u32x4*)(obr + ((size_t)b * SEQ + row) * 512 + lane * 8); } }
#pragma unroll
        for (int r = 0; r < 4; ++r) {
            const int row = row0 + r * rstride;
            float w0 = lv[r][0], w1 = lv[r][1], w2 = lv[r][2];
            const float iw = 1.f / (w0 + w1 + w2); w0 *= iw; w1 *= iw; w2 *= iw;
            float y[8]; float ss = 0.f;
#pragma unroll
            for (int k = 0; k < 4; ++k) {
                const float lo = w0 * __builtin_bit_cast(float, av[r][0][k] << 16) + w1 * __builtin_bit_cast(float, av[r][1][k] << 16) + w2 * __builtin_bit_cast(float, av[r][2][k] << 16);
                const float hi = w0 * __builtin_bit_cast(float, av[r][0][k] & 0xffff0000u) + w1 * __builtin_bit_cast(float, av[r][1][k] & 0xffff0000u) + w2 * __builtin_bit_cast(float, av[r][2][k] & 0xffff0000u);
                y[2 * k] = lo; y[2 * k + 1] = hi; ss += lo * lo + hi * hi;
            }
#pragma unroll
            for (int o = 32; o; o >>= 1) ss += shx(ss, o, lane);
            const float sc = rsqrtf(ss * (1.f / 512.f) + 1e-5f);
            u32x4 o4; o4.x = cvt_pk_bf16(y[0] * sc * g0[0], y[1] * sc * g0[1]); o4.y = cvt_pk_bf16(y[2] * sc * g0[2], y[3] * sc * g0[3]);
            o4.z = cvt_pk_bf16(y[4] * sc * g1[0], y[5] * sc * g1[1]); o4.w = cvt_pk_bf16(y[6] * sc * g1[2], y[7] * sc * g1[3]);
            if (row < SEQ) *(u32x4*)(mix16 + (size_t)row * DM + lane * 8) = o4;
        }
    }
}
struct EpiIn {
    static constexpr bool PERM = true;
    bf16_t* O;
    __device__ __forceinline__ void operator()(const f32x4 (&acc)[2][2][4][2], const GUnit& u, int wr, int wc, int fr, int fq) const {
        const int row0 = u.pm * BM + wr * 64 + fr, col0 = u.pn * BM + wc * 32 + 8 * fq;
        const float sc = u.pn < 2 ? 0.18033688011112042f : 1.f;
#pragma unroll
        for (int ai = 0; ai < 2; ++ai)
#pragma unroll
            for (int m = 0; m < 4; ++m) { const size_t ro = (size_t)(row0 + ai * HALF + m * 16) * DIN + col0;
#pragma unroll
                for (int bj = 0; bj < 2; ++bj) { const f32x4 v0 = acc[ai][bj][m][0] * sc, v1 = acc[ai][bj][m][1] * sc;
                    u32x4 w; w.x = cvt_pk_bf16(v0[0], v0[1]); w.y = cvt_pk_bf16(v0[2], v0[3]); w.z = cvt_pk_bf16(v1[0], v1[1]); w.w = cvt_pk_bf16(v1[2], v1[3]);
                    *(u32x4*)(O + ro + bj * HALF) = w;
                    } }
    }
};


__device__ __forceinline__ unsigned xoff_b(unsigned row, unsigned ch) { return 256u * row + 16u * (ch ^ (((row & 3u) << 2) | ((row >> 2) & 3u))); }
__device__ __forceinline__ void p_xattn_mfma(const int wv, const bf16_t* qx16, const bf16_t* kv16, bf16_t* ox16, LAS unsigned char* lds) {
    LTID();
    const int lane = tidx & 63, fr = lane & 15, fq = lane >> 4, w = wv;
    const int NU = 4 * 128;
    const int per = (NU + (int)gridDim.x - 1) / (int)gridDim.x;
    const int u0 = bidx * per, u1 = (u0 + per < NU) ? u0 + per : NU;
    if (u0 >= u1) return;
    const int rowl = tidx >> 4, cs = tidx & 15;
    const unsigned csw = (unsigned)(cs ^ (((rowl & 3) << 2) | ((rowl >> 2) & 3))) * 16u;
    const unsigned kswz = (unsigned)(((fr & 3) << 2) | ((fr >> 2) & 3));
    unsigned kro[4];
#pragma unroll
    for (int s4 = 0; s4 < 4; ++s4) kro[s4] = 256u * (unsigned)fr + 16u * ((unsigned)(4 * s4 + fq) ^ kswz);
    const int tq = (lane & 15) >> 2, tp = lane & 3;
    const unsigned vswz = (unsigned)((tq << 2) | fq);
    unsigned vro[8];
#pragma unroll
    for (int c = 0; c < 8; ++c) vro[c] = 65536u + 256u * (unsigned)(4 * fq + tq) + 16u * ((unsigned)(2 * c + (tp >> 1)) ^ vswz) + 8u * (unsigned)(tp & 1);
    int prev_h = -1;
    for (int u = u0; u < u1; ++u) {
        const int h = u >> 7, qt = u & 127;
        if (h != prev_h) {
            __syncthreads();
            prev_h = h;
#pragma unroll
            for (int p = 0; p < 8; ++p) {
                const unsigned row = (unsigned)(32 * p + rowl);
                const unsigned so = row * 2048u + (unsigned)h * 256u + csw;
                const unsigned ld_ = (unsigned)(size_t)(lds + p * 8192 + w * 1024);
                glds16s(kv16, so, ld_); glds16s(kv16, so + 1024u, ld_ + 65536u);
            }
            asm volatile("s_waitcnt vmcnt(0)" ::: "memory");
            __syncthreads();
        }
        const char* qsrc = (const char*)qx16 + ((size_t)(qt * 128 + 16 * w + fr) * 512 + h * 128 + 8 * fq) * 2;
        bf16x8 qf[4];
#pragma unroll
        for (int s4 = 0; s4 < 4; ++s4) qf[s4] = *(const bf16x8*)(qsrc + 64 * s4);
        f32x4 sc[16];
#pragma unroll
        for (int i = 0; i < 16; ++i) {
            f32x4 a = (f32x4){0.f, 0.f, 0.f, 0.f};
#pragma unroll
            for (int s4 = 0; s4 < 4; ++s4) { const bf16x8 kf = *(const LAS bf16x8*)(lds + i * 4096 + kro[s4]); a = __builtin_amdgcn_mfma_f32_16x16x32_bf16(kf, qf[s4], a, 0, 0, 0); }
            sc[i] = a;
        }
        float mx = -1e30f;
#pragma unroll
        for (int i = 0; i < 16; ++i) mx = fmaxf(mx, fmaxf(fmaxf(sc[i][0], sc[i][1]), fmaxf(sc[i][2], sc[i][3])));
        mx = fmaxf(mx, shx(mx, 16, lane)); mx = fmaxf(mx, shx(mx, 32, lane));
        float sum = 0.f;
#pragma unroll
        for (int i = 0; i < 16; ++i)
#pragma unroll
            for (int j = 0; j < 4; ++j) { const float p = __expf(sc[i][j] - mx); sc[i][j] = p; sum += p; }
        sum += shx(sum, 16, lane); sum += shx(sum, 32, lane);
        f32x4 oacc[8];
#pragma unroll
        for (int c = 0; c < 8; ++c) oacc[c] = (f32x4){0.f, 0.f, 0.f, 0.f};
#pragma unroll
        for (int ch = 0; ch < 8; ++ch) {
            const int ia = 2 * ch, ib = 2 * ch + 1;
            u32x4 pw; pw.x = cvt_pk_bf16(sc[ia][0], sc[ia][1]); pw.y = cvt_pk_bf16(sc[ia][2], sc[ia][3]); pw.z = cvt_pk_bf16(sc[ib][0], sc[ib][1]); pw.w = cvt_pk_bf16(sc[ib][2], sc[ib][3]);
            const bf16x8 pf = __builtin_bit_cast(bf16x8, pw);
#pragma unroll
            for (int c = 0; c < 8; ++c) {
                const v4i16_t x0 = __builtin_amdgcn_ds_read_tr16_b64_v4i16((LAS v4i16_t*)(lds + ia * 4096 + vro[c]));
                const v4i16_t x1 = __builtin_amdgcn_ds_read_tr16_b64_v4i16((LAS v4i16_t*)(lds + ib * 4096 + vro[c]));
                const bf16x8 vf = (bf16x8){x0[0], x0[1], x0[2], x0[3], x1[0], x1[1], x1[2], x1[3]};
                oacc[c] = __builtin_amdgcn_mfma_f32_16x16x32_bf16(vf, pf, oacc[c], 0, 0, 0);
            }
        }
        const float inv = 1.f / sum;
        bf16_t* orow = ox16 + (size_t)(qt * 128 + 16 * w + fr) * 512 + h * 128 + 4 * fq;
#pragma unroll
        for (int c = 0; c < 8; ++c) { u32x2 o2; o2.x = cvt_pk_bf16(oacc[c][0] * inv, oacc[c][1] * inv); o2.y = cvt_pk_bf16(oacc[c][2] * inv, oacc[c][3] * inv); *(u32x2*)(orow + 16 * c) = o2; }
    }
    __syncthreads();
}
struct EpiBf16 {
    static constexpr bool PERM = true;
    bf16_t* O; int ldc; float scale; const float* ss;
    __device__ __forceinline__ void operator()(const f32x4 (&acc)[2][2][4][2], const GUnit& u, int wr, int wc, int fr, int fq) const {
        const int row0 = u.pm * BM + wr * 64 + fr, col0 = u.pn * BM + wc * 32 + 8 * fq;
#pragma unroll
        for (int ai = 0; ai < 2; ++ai)
#pragma unroll
            for (int m = 0; m < 4; ++m) { const int row = row0 + ai * HALF + m * 16; bf16_t* rowp = O + (size_t)row * ldc + col0;
                float sc = scale;
                if (ss) { const f32x4 p0 = *(const f32x4*)(ss + (size_t)row * 16), p1 = *(const f32x4*)(ss + (size_t)row * 16 + 4), p2 = *(const f32x4*)(ss + (size_t)row * 16 + 8), p3 = *(const f32x4*)(ss + (size_t)row * 16 + 12);
                    const float t = ((p0[0] + p0[1]) + (p0[2] + p0[3])) + ((p1[0] + p1[1]) + (p1[2] + p1[3])) + ((p2[0] + p2[1]) + (p2[2] + p2[3])) + ((p3[0] + p3[1]) + (p3[2] + p3[3]));
                    sc = scale * rsqrtf(t * (1.f / 1024.f) + 1e-5f); }
#pragma unroll
                for (int bj = 0; bj < 2; ++bj) { const f32x4 v0 = acc[ai][bj][m][0] * sc, v1 = acc[ai][bj][m][1] * sc;
                    u32x4 w; w.x = cvt_pk_bf16(v0[0], v0[1]); w.y = cvt_pk_bf16(v0[2], v0[3]); w.z = cvt_pk_bf16(v1[0], v1[1]); w.w = cvt_pk_bf16(v1[2], v1[3]);
                    *(u32x4*)(rowp + bj * HALF) = w; } }
    }
};
struct EpiOut {
    static constexpr bool PERM = true;
    const float* R; float* H; bf16_t* HB; float* ss;
    __device__ __forceinline__ void operator()(const f32x4 (&acc)[2][2][4][2], const GUnit& u, int wr, int wc, int fr, int fq) const {
        const int row0 = u.pm * BM + wr * 64 + fr, col0 = u.pn * BM + wc * 32 + 8 * fq, lane = fq * 16 + fr;
#pragma unroll
        for (int ai = 0; ai < 2; ++ai)
#pragma unroll
            for (int m = 0; m < 4; ++m) { const int row = row0 + ai * HALF + m * 16; const size_t ro = (size_t)row * DM + col0; float sq = 0.f;
#pragma unroll
                for (int bj = 0; bj < 2; ++bj) {
                    const f32x4 v0 = acc[ai][bj][m][0] + *(const f32x4*)(R + ro + bj * HALF), v1 = acc[ai][bj][m][1] + *(const f32x4*)(R + ro + bj * HALF + 4);
                    *(f32x4*)(H + ro + bj * HALF) = v0; *(f32x4*)(H + ro + bj * HALF + 4) = v1;
                    u32x4 w; w.x = cvt_pk_bf16(v0[0], v0[1]); w.y = cvt_pk_bf16(v0[2], v0[3]); w.z = cvt_pk_bf16(v1[0], v1[1]); w.w = cvt_pk_bf16(v1[2], v1[3]);
                    *(u32x4*)(HB + ro + bj * HALF) = w;
                    sq += (v0[0] * v0[0] + v0[1] * v0[1]) + (v0[2] * v0[2] + v0[3] * v0[3]) + (v1[0] * v1[0] + v1[1] * v1[1]) + (v1[2] * v1[2] + v1[3] * v1[3]);
                }
                sq += shx(sq, 16, lane); sq += shx(sq, 32, lane);
                if (fq == 0) ss[(size_t)row * 16 + u.pn * 4 + wc] = sq;
            }
    }
};

typedef short bf16x4 __attribute__((ext_vector_type(4)));
constexpr int S5_CHUNK = 256, S5_NCH = SEQ / S5_CHUNK, S5_ROWB = 528;
__device__ __forceinline__ f32x2 gelu_pk(f32x2 v) {
    const f32x2 av = __builtin_elementwise_abs(v), d = av * 0.2316418882f + 1.0f;
    f32x2 t; t.x = __builtin_amdgcn_rcpf(d.x); t.y = __builtin_amdgcn_rcpf(d.y);
    f32x2 q = t * 0.5307027145f + (-0.7265760135f); q = q * t + 0.7107068705f; q = q * t + (-0.142248368f); q = q * t + 0.127414796f; q = q * t;
    const f32x2 s2 = (v * v) * (-0.72134752044f);
    f32x2 e; e.x = __builtin_amdgcn_exp2f(s2.x); e.y = __builtin_amdgcn_exp2f(s2.y);
    const f32x2 m = v * (q * e), r = v - m;
    f32x2 o; o.x = v.x < 0.f ? m.x : r.x; o.y = v.y < 0.f ? m.y : r.y; return o;
}
__device__ __forceinline__ void p_s5_tables2(const int wv, const float* a_re, const float* a_im, const float* b_re, const float* b_im, const float* c_re, const float* c_im, const float* log_dt,
                                             float2* abar, float2* a256, bf16_t* BB16, bf16_t* CM16, int rot) {
    LTID();
    for (int i = ROTB(rot) * NT + tidx; i < 2048 * 16; i += gridDim.x * NT) {
        const int gp = i >> 4, c = i & 15, g = gp >> 6, p = gp & 63;
        const float lr = a_re[gp], li = a_im[gp], dt = expf(log_dt[g]);
        const float mag = expf(lr * dt); float sn, cs; sincosf(li * dt, &sn, &cs);
        const float ar = mag * cs, ai = mag * sn;
        if (c == 0) {
            abar[gp] = make_float2(ar, ai);
            float pr = ar, pi = ai;
            for (int k = 0; k < 8; ++k) { const float nr = pr * pr - pi * pi, ni = 2.f * pr * pi; pr = nr; pi = ni; }
            a256[gp] = make_float2(pr, pi);
        }
        const float nr = ar - 1.f, ni = ai, den = lr * lr + li * li;
        const float cr = (nr * lr + ni * li) / den, ci = (ni * lr - nr * li) / den;
        const float br = b_re[gp * 16 + c], bi = b_im[gp * 16 + c];
        BB16[((size_t)g * 128 + p) * 16 + c] = (bf16_t)f2bf(cr * br - ci * bi);
        BB16[((size_t)g * 128 + 64 + p) * 16 + c] = (bf16_t)f2bf(cr * bi + ci * br);
        CM16[((size_t)g * 16 + c) * 128 + p] = (bf16_t)f2bf(c_re[(g * 16 + c) * 64 + p]);
        CM16[((size_t)g * 16 + c) * 128 + 64 + p] = (bf16_t)f2bf(-c_im[(g * 16 + c) * 64 + p]);
    }
}
template <int MODE> __device__ __forceinline__ void p_s5_pass(const int wv, const bf16_t* proj16, const float2* abar, const float2* a256, const bf16_t* BB16, const bf16_t* CM16, const float* dskip,
                                                              float2* E, bf16_t* yg16, LAS unsigned char* lds) {
    LTID();
    const int lane = tidx & 63, fr = lane & 15, fq = lane >> 4;
    LAS unsigned char* L = lds + wv * (16 * S5_ROWB);
    for (int unit = bidx * NW + wv; unit < S5_NCH * 32; unit += gridDim.x * NW) {
        const int g = unit & 31, chunk = unit >> 5;
        const float2 a = abar[g * 64 + lane];
        bf16x4 bbf[8];
#pragma unroll
        for (int cb = 0; cb < 8; ++cb) bbf[cb] = *(const bf16x4*)(BB16 + ((size_t)g * 128 + 16 * cb + fr) * 16 + 4 * fq);
        bf16x8 cmf[4]; f32x4 dsk = (f32x4){0.f, 0.f, 0.f, 0.f};
        if (MODE == 1) {
#pragma unroll
            for (int s4 = 0; s4 < 4; ++s4) cmf[s4] = *(const bf16x8*)(CM16 + ((size_t)g * 16 + fr) * 128 + 32 * s4 + 8 * fq);
            dsk = *(const f32x4*)(dskip + g * 16 + 4 * fq);
        }
        float sr = 0.f, si = 0.f;
        if (MODE == 1) {
            const float2 A = a256[g * 64 + lane];
            for (int j0 = 0; j0 < chunk; j0 += 16) {
                float2 e[16];
#pragma unroll
                for (int k = 0; k < 16; ++k) { const int j = (j0 + k < chunk) ? j0 + k : chunk - 1; e[k] = E[((size_t)j * 32 + g) * 64 + lane]; }
#pragma unroll
                for (int k = 0; k < 16; ++k) if (j0 + k < chunk) { const float nr = A.x * sr - A.y * si + e[k].x, ni = A.x * si + A.y * sr + e[k].y; sr = nr; si = ni; }
            }
        }
        const bf16_t* ubase = proj16 + (size_t)(chunk * S5_CHUNK + fr) * DIN + 1536 + g * 16 + 4 * fq;
        bf16x4 uf = *(const bf16x4*)ubase;
#pragma unroll 1
        for (int blk = 0; blk < S5_CHUNK / 16; ++blk) {
            const bf16x4 ufn = *(const bf16x4*)(ubase + (size_t)((blk < S5_CHUNK / 16 - 1) ? (blk + 1) * 16 : blk * 16) * DIN);
            asm volatile("" ::: "memory");
#pragma unroll
            for (int cb = 0; cb < 8; ++cb) {
                const f32x4 d = __builtin_amdgcn_mfma_f32_16x16x16bf16_1k(bbf[cb], uf, (f32x4){0.f, 0.f, 0.f, 0.f}, 0, 0, 0);
                *(LAS f32x4*)(L + fr * S5_ROWB + (16 * cb + 4 * fq) * 4) = d;
            }
            asm volatile("" ::: "memory");
#pragma unroll
            for (int t = 0; t < 16; ++t) {
                const float re = *(const LAS float*)(L + t * S5_ROWB + lane * 4), im = *(const LAS float*)(L + t * S5_ROWB + 256 + lane * 4);
                const float nr = a.x * sr - a.y * si + re, ni = a.x * si + a.y * sr + im; sr = nr; si = ni;
                if (MODE == 1) { *(LAS bf16_t*)(L + t * S5_ROWB + lane * 2) = (bf16_t)f2bf(sr); *(LAS bf16_t*)(L + t * S5_ROWB + 128 + lane * 2) = (bf16_t)f2bf(si); }
            }
            asm volatile("" ::: "memory");
            if (MODE == 1) {
                f32x4 y = (f32x4){0.f, 0.f, 0.f, 0.f};
#pragma unroll
                for (int s4 = 0; s4 < 4; ++s4) { const bf16x8 sf = *(const LAS bf16x8*)(L + fr * S5_ROWB + 64 * s4 + 16 * fq); y = __builtin_amdgcn_mfma_f32_16x16x32_bf16(cmf[s4], sf, y, 0, 0, 0); }
                f32x4 v;
#pragma unroll
                for (int j = 0; j < 4; ++j) v[j] = y[j] + dsk[j] * bf2f((unsigned short)uf[j]);
                const f32x2 g0 = gelu_pk((f32x2){v[0], v[1]}), g1 = gelu_pk((f32x2){v[2], v[3]});
                u32x2 o2; o2.x = cvt_pk_bf16(g0.x, g0.y); o2.y = cvt_pk_bf16(g1.x, g1.y);
                *(u32x2*)(yg16 + (size_t)(chunk * S5_CHUNK + blk * 16 + fr) * 512 + g * 16 + 4 * fq) = o2;
            }
            asm volatile("" ::: "memory");
            uf = ufn;
        }
        if (MODE == 0) E[((size_t)chunk * 32 + g) * 64 + lane] = make_float2(sr, si);
    }
}
struct EpiGlu16 {
    static constexpr bool PERM = true;
    bf16_t* O; const bf16_t* Y; const float* bias;
    __device__ __forceinline__ void operator()(const f32x4 (&acc)[2][2][4][2], const GUnit& u, int wr, int wc, int fr, int fq) const {
        const int row0 = u.pm * BM + wr * 64 + fr, col0 = u.pn * BM + wc * 32 + 8 * fq;
        f32x4 bv[2][2];
#pragma unroll
        for (int bj = 0; bj < 2; ++bj)
#pragma unroll
            for (int n = 0; n < 2; ++n) bv[bj][n] = *(const f32x4*)(bias + col0 + bj * HALF + 4 * n);
#pragma unroll
        for (int ai = 0; ai < 2; ++ai)
#pragma unroll
            for (int m = 0; m < 4; ++m) { const size_t ro = (size_t)(row0 + ai * HALF + m * 16) * 512 + col0;
#pragma unroll
                for (int bj = 0; bj < 2; ++bj) {
                    const u32x4 yv = *(const u32x4*)(Y + ro + bj * HALF);
                    float o[8];
#pragma unroll
                    for (int n = 0; n < 2; ++n)
#pragma unroll
                        for (int j = 0; j < 4; ++j) { const unsigned wd = yv[n * 2 + (j >> 1)]; const float y = __builtin_bit_cast(float, (j & 1) ? (wd & 0xffff0000u) : (wd << 16));
                            o[n * 4 + j] = y / (1.f + __expf(-(acc[ai][bj][m][n][j] + bv[bj][n][j]))); }
                    u32x4 w; w.x = cvt_pk_bf16(o[0], o[1]); w.y = cvt_pk_bf16(o[2], o[3]); w.z = cvt_pk_bf16(o[4], o[5]); w.w = cvt_pk_bf16(o[6], o[7]);
                    *(u32x4*)(O + ro + bj * HALF) = w; } }
    }
};
__device__ __forceinline__ void p_ssm_norm(const int wv, const bf16_t* yb16, const float* g, bf16_t* mix16) {
    LTID();
    const int lane = tidx & 63;
    const f32x4 g0 = *(const f32x4*)(g + lane * 8), g1 = *(const f32x4*)(g + lane * 8 + 4);
    const int rstride = (int)gridDim.x * NW;
    for (int row0 = bidx * NW + wv; row0 < SEQ; row0 += 4 * rstride) {
        u32x4 av[4];
#pragma unroll
        for (int r = 0; r < 4; ++r) { const int row = (row0 + r * rstride < SEQ) ? row0 + r * rstride : row0; av[r] = *(const u32x4*)(yb16 + (size_t)row * 512 + lane * 8); }
#pragma unroll
        for (int r = 0; r < 4; ++r) {
            const int row = row0 + r * rstride;
            float y[8]; float ss = 0.f;
#pragma unroll
            for (int k = 0; k < 4; ++k) { y[2 * k] = __builtin_bit_cast(float, av[r][k] << 16); y[2 * k + 1] = __builtin_bit_cast(float, av[r][k] & 0xffff0000u); ss += y[2 * k] * y[2 * k] + y[2 * k + 1] * y[2 * k + 1]; }
#pragma unroll
            for (int o = 32; o; o >>= 1) ss += shx(ss, o, lane);
            const float sc = rsqrtf(ss * (1.f / 512.f) + 1e-5f);
            u32x4 o4; o4.x = cvt_pk_bf16(y[0] * sc * g0[0], y[1] * sc * g0[1]); o4.y = cvt_pk_bf16(y[2] * sc * g0[2], y[3] * sc * g0[3]);
            o4.z = cvt_pk_bf16(y[4] * sc * g1[0], y[5] * sc * g1[1]); o4.w = cvt_pk_bf16(y[6] * sc * g1[2], y[7] * sc * g1[3]);
            if (row < SEQ) *(u32x4*)(mix16 + (size_t)row * DM + 512 + lane * 8) = o4;
        }
    }
}

__device__ __forceinline__ void p_rmsnorm16(const int wv, const float* in, const float* g, bf16_t* out16, int rows, int rot) {
    LTID();
    const int lane = tidx & 63;
    for (int r = ROTB(rot) * NW + wv; r < rows; r += gridDim.x * NW) {
        f32x4 v[4]; float ss = 0.f;
#pragma unroll
        for (int j = 0; j < 4; ++j) { v[j] = *(const f32x4*)(in + (size_t)r * DM + 4 * lane + 256 * j); ss += (v[j][0] * v[j][0] + v[j][1] * v[j][1]) + (v[j][2] * v[j][2] + v[j][3] * v[j][3]); }
#pragma unroll
        for (int o = 32; o; o >>= 1) ss += shx(ss, o, lane);
        const float sc = rsqrtf(ss * (1.f / 1024.f) + 1e-5f);
#pragma unroll
        for (int j = 0; j < 4; ++j) { const f32x4 gg = *(const f32x4*)(g + 4 * lane + 256 * j); u32x2 o2; o2.x = cvt_pk_bf16(v[j][0] * sc * gg[0], v[j][1] * sc * gg[1]); o2.y = cvt_pk_bf16(v[j][2] * sc * gg[2], v[j][3] * sc * gg[3]);
            *(u32x2*)(out16 + (size_t)r * DM + 4 * lane + 256 * j) = o2; }
    }
}
template <bool MOE, bool LAST> __device__ __forceinline__ void p_rowfinish(const int wv, const float* hin, float* h, const bf16_t* mout, const int* eslot, const float* topg, const float* g, bf16_t* xn16, float* out) {
    LTID();
    const int lane = tidx & 63;
    LAS const int* ts = (LAS const int*)(LDSP + TS_OFF);
    const int rstride = (int)gridDim.x * NW;
    for (int r0 = bidx * NW + wv; r0 < SEQ; r0 += 2 * rstride) {
        int rr[2]; rr[0] = r0; rr[1] = (r0 + rstride < SEQ) ? r0 + rstride : r0;
        f32x4 v[2][4]; int4 es[2]; f32x4 gt[2]; u32x2 mo[2][4][4];
#pragma unroll
        for (int q = 0; q < 2; ++q) { if (MOE) { es[q] = *(const int4*)(eslot + rr[q] * 4); gt[q] = *(const f32x4*)(topg + rr[q] * 4); }
#pragma unroll
            for (int j = 0; j < 4; ++j) v[q][j] = *(const f32x4*)(hin + (size_t)rr[q] * DM + 4 * lane + 256 * j); }
        if (MOE) {
#pragma unroll
            for (int q = 0; q < 2; ++q) { const int esv[4] = {es[q].x, es[q].y, es[q].z, es[q].w};
#pragma unroll
                for (int k = 0; k < 4; ++k) { const int e = esv[k] >> 16, sl = esv[k] & 0xffff; const size_t row = (size_t)ts[e] * BM + sl;
#pragma unroll
                    for (int j = 0; j < 4; ++j) mo[q][k][j] = *(const u32x2*)(mout + row * DM + 4 * lane + 256 * j); } }
#pragma unroll
            for (int q = 0; q < 2; ++q)
#pragma unroll
                for (int k = 0; k < 4; ++k) { const float gk = gt[q][k];
#pragma unroll
                    for (int j = 0; j < 4; ++j) { const u32x2 o = mo[q][k][j];
                        v[q][j][0] += gk * __builtin_bit_cast(float, o.x << 16); v[q][j][1] += gk * __builtin_bit_cast(float, o.x & 0xffff0000u);
                        v[q][j][2] += gk * __builtin_bit_cast(float, o.y << 16); v[q][j][3] += gk * __builtin_bit_cast(float, o.y & 0xffff0000u); } }
        }
#pragma unroll
        for (int q = 0; q < 2; ++q) {
            if (q == 1 && r0 + rstride >= SEQ) break;
            const int r = rr[q];
            float ss = 0.f;
#pragma unroll
            for (int j = 0; j < 4; ++j) ss += (v[q][j][0] * v[q][j][0] + v[q][j][1] * v[q][j][1]) + (v[q][j][2] * v[q][j][2] + v[q][j][3] * v[q][j][3]);
#pragma unroll
            for (int o = 32; o; o >>= 1) ss += shx(ss, o, lane);
            const float sc = rsqrtf(ss * (1.f / 1024.f) + 1e-5f);
#pragma unroll
            for (int j = 0; j < 4; ++j) {
                const f32x4 gg = *(const f32x4*)(g + 4 * lane + 256 * j);
                if (!LAST) { if (h) *(f32x4*)(h + (size_t)r * DM + 4 * lane + 256 * j) = v[q][j];
                    u32x2 o2; o2.x = cvt_pk_bf16(v[q][j][0] * sc * gg[0], v[q][j][1] * sc * gg[1]); o2.y = cvt_pk_bf16(v[q][j][2] * sc * gg[2], v[q][j][3] * sc * gg[3]);
                    *(u32x2*)(xn16 + (size_t)r * DM + 4 * lane + 256 * j) = o2; }
                else *(f32x4*)(out + (size_t)r * DM + 4 * lane + 256 * j) = (f32x4){v[q][j][0] * sc * gg[0], v[q][j][1] * sc * gg[1], v[q][j][2] * sc * gg[2], v[q][j][3] * sc * gg[3]};
            }
        }
    }
}
__device__ __forceinline__ void p_router_tables(const int wv, const float* w_r, const float* g, bf16_t* WR16, int rot) {
    LTID();
    for (int i = ROTB(rot) * NT + tidx; i < 32 * 1024; i += gridDim.x * NT) {
        const int e = i >> 10, k = i & 1023;
        const float w = g[k] * w_r[k * 32 + e];
        const unsigned hi = f2bf(w); const float lo = w - __builtin_bit_cast(float, hi << 16);
        WR16[i] = (bf16_t)hi; WR16[32 * 1024 + i] = (bf16_t)f2bf(lo);
    }
}
constexpr int RT_CNT_OFF = 131072 + 4608;
constexpr int RT_XCH_OFF = 131072 + 5120;
__device__ __forceinline__ void p_router2(const int wv, const float* h, const bf16_t* WR16, const float* b_r, bf16_t* hb16, unsigned* gcnt, int* rowtok_e, float* rsc_e, int* eslot, float* topg, LAS unsigned char* lds) {
    LTID();
    const int lane = tidx & 63, fr = lane & 15, fq = lane >> 4, w = wv, tg = w & 3, kh = w >> 2;
#pragma unroll
    for (int part = 0; part < 2; ++part)
#pragma unroll
        for (int p = 0; p < 8; ++p) { const int row = 4 * p + (tidx >> 7), cs = tidx & 127;
            glds16s(WR16, (unsigned)(part * 65536 + row * 2048 + ((cs ^ (row & 15)) * 16)), (unsigned)(size_t)(lds + part * 65536 + p * 8192 + w * 1024)); }
    LAS int* lcnt = (LAS int*)(lds + RT_CNT_OFF);
    if (tidx < 64) lcnt[tidx] = 0;
    asm volatile("s_waitcnt vmcnt(0)" ::: "memory");
    __syncthreads();
    for (int it = bidx; it < SEQ / 64; it += gridDim.x) {
        const int token = it * 64 + 16 * tg + fr;
        const float* xr = h + (size_t)token * DM + 512 * kh + 8 * fq;
        bf16_t* hb = hb16 + (size_t)token * DM + 512 * kh + 8 * fq;
        f32x4 acc[2]; acc[0] = (f32x4){0.f, 0.f, 0.f, 0.f}; acc[1] = acc[0];
        float ss = 0.f;
#pragma unroll 4
        for (int s4 = 0; s4 < 16; ++s4) {
            const f32x4 x0 = *(const f32x4*)(xr + 32 * s4), x1 = *(const f32x4*)(xr + 32 * s4 + 4);
            ss += (x0[0] * x0[0] + x0[1] * x0[1]) + (x0[2] * x0[2] + x0[3] * x0[3]) + (x1[0] * x1[0] + x1[1] * x1[1]) + (x1[2] * x1[2] + x1[3] * x1[3]);
            u32x4 hw; hw.x = cvt_pk_bf16(x0[0], x0[1]); hw.y = cvt_pk_bf16(x0[2], x0[3]); hw.z = cvt_pk_bf16(x1[0], x1[1]); hw.w = cvt_pk_bf16(x1[2], x1[3]);
            *(u32x4*)(hb + 32 * s4) = hw;
            u32x4 lw;
            lw.x = cvt_pk_bf16(x0[0] - __builtin_bit_cast(float, hw.x << 16), x0[1] - __builtin_bit_cast(float, hw.x & 0xffff0000u));
            lw.y = cvt_pk_bf16(x0[2] - __builtin_bit_cast(float, hw.y << 16), x0[3] - __builtin_bit_cast(float, hw.y & 0xffff0000u));
            lw.z = cvt_pk_bf16(x1[0] - __builtin_bit_cast(float, hw.z << 16), x1[1] - __builtin_bit_cast(float, hw.z & 0xffff0000u));
            lw.w = cvt_pk_bf16(x1[2] - __builtin_bit_cast(float, hw.w << 16), x1[3] - __builtin_bit_cast(float, hw.w & 0xffff0000u));
            const bf16x8 xhi = __builtin_bit_cast(bf16x8, hw), xlo = __builtin_bit_cast(bf16x8, lw);
            const int c = 64 * kh + 4 * s4 + fq, slot = c ^ fr;
#pragma unroll
            for (int nb = 0; nb < 2; ++nb) {
                const bf16x8 whi = *(const LAS bf16x8*)(lds + (16 * nb + fr) * 2048 + slot * 16), wlo = *(const LAS bf16x8*)(lds + 65536 + (16 * nb + fr) * 2048 + slot * 16);
                acc[nb] = __builtin_amdgcn_mfma_f32_16x16x32_bf16(whi, xhi, acc[nb], 0, 0, 0);
                acc[nb] = __builtin_amdgcn_mfma_f32_16x16x32_bf16(whi, xlo, acc[nb], 0, 0, 0);
                acc[nb] = __builtin_amdgcn_mfma_f32_16x16x32_bf16(wlo, xhi, acc[nb], 0, 0, 0);
            }
        }
        ss += shx(ss, 16, lane); ss += shx(ss, 32, lane);
        LAS float* X = (LAS float*)(lds + RT_XCH_OFF) + (tg * 64 + lane) * 9;
        if (kh == 1) {
#pragma unroll
            for (int nb = 0; nb < 2; ++nb)
#pragma unroll
                for (int j = 0; j < 4; ++j) X[nb * 4 + j] = acc[nb][j];
            X[8] = ss;
        }
        __syncthreads();
        int ti[4] = {0, 0, 0, 0}, ls[4] = {0, 0, 0, 0}; float gv[4] = {0.f, 0.f, 0.f, 0.f}; float rs = 0.f;
        if (kh == 0) {
            float lv[8];
            ss += X[8];
            rs = rsqrtf(ss * (1.f / 1024.f) + 1e-5f);
#pragma unroll
            for (int nb = 0; nb < 2; ++nb)
#pragma unroll
                for (int j = 0; j < 4; ++j) lv[nb * 4 + j] = rs * (acc[nb][j] + X[nb * 4 + j]) + b_r[16 * nb + 4 * fq + j];
            float tv[4];
#pragma unroll
            for (int r = 0; r < 4; ++r) {
                float bv = -3.0e38f; int bi = 0;
#pragma unroll
                for (int q = 0; q < 8; ++q) { const int idx = 16 * (q >> 2) + 4 * fq + (q & 3); if (lv[q] > bv) { bv = lv[q]; bi = idx; } }
#pragma unroll
                for (int mk = 16; mk <= 32; mk <<= 1) { const float ov = shx(bv, mk, lane); const int oi = shxi(bi, mk, lane); if (ov > bv || (ov == bv && oi < bi)) { bv = ov; bi = oi; } }
                tv[r] = bv; ti[r] = bi;
#pragma unroll
                for (int q = 0; q < 8; ++q) { const int idx = 16 * (q >> 2) + 4 * fq + (q & 3); if (idx == bi) lv[q] = -3.0e38f; }
            }
            float sum = 0.f;
#pragma unroll
            for (int r = 0; r < 4; ++r) { gv[r] = __expf(tv[r] - tv[0]); sum += gv[r]; }
            const float inv = 1.f / sum;
#pragma unroll
            for (int r = 0; r < 4; ++r) gv[r] *= inv;
            if (fq == 0) {
#pragma unroll
                for (int r = 0; r < 4; ++r) ls[r] = __hip_atomic_fetch_add(&lcnt[ti[r]], 1, __ATOMIC_RELAXED, __HIP_MEMORY_SCOPE_WORKGROUP);
            }
        }
        __syncthreads();
        if (tidx < 32) { const int c = lcnt[tidx]; lcnt[32 + tidx] = c ? (int)__hip_atomic_fetch_add(gcnt + tidx, (unsigned)c, __ATOMIC_RELAXED, __HIP_MEMORY_SCOPE_AGENT) : 0; }
        __syncthreads();
        if (kh == 0 && fq == 0) {
            int es[4];
#pragma unroll
            for (int r = 0; r < 4; ++r) { const int e = ti[r], sl = lcnt[32 + e] + ls[r]; rowtok_e[e * ECAP + sl] = token; rsc_e[e * ECAP + sl] = rs; es[r] = (e << 16) | sl; }
            *(int4*)(eslot + token * 4) = make_int4(es[0], es[1], es[2], es[3]);
            *(f32x4*)(topg + token * 4) = (f32x4){gv[0], gv[1], gv[2], gv[3]};
        }
        __syncthreads();
        if (tidx < 32) lcnt[tidx] = 0;
    }
    __syncthreads();
}

constexpr int NPL = 13;
constexpr int NPHASES = 1 + 2 * NPL;
typedef const __attribute__((address_space(4))) Args* KA;
#define PHASE __device__ __forceinline__
#define KAP() ({ KA _t = a; asm volatile("" : "+s"(_t)); _t; })
#define WSP(T, off) ((T*)(a->ws + (off)))

constexpr int NIT = 49152, NIT1 = 32768;
constexpr int QG = 9, QX = 13, QA = 11, QB = 8, QG0 = 12, QX0 = 17;
struct ConvBounds { int A1, A2, B1, B2, B3, B4; };
__device__ __forceinline__ int cmin(int a, int b) { return a < b ? a : b; }
__device__ __forceinline__ ConvBounds conv_bounds(int G, int T0) {
    ConvBounds b;
    const int Px = G > 128 ? G - 128 : G, Px0 = G > 136 ? G - 136 : G;
    b.A1 = cmin(NIT, Px * 8 * QG0); b.A2 = cmin(NIT, b.A1 + Px0 * 8 * QX0);
    const int r1 = (8 * T0) % G, r2 = (4 * T0) % G;
    b.B1 = cmin(NIT, r1 ? (G - r1) * 8 * QA : G * 8 * 2);
    b.B2 = cmin(NIT, b.B1 + (r2 ? (G - r2) * 8 * QB : G * 8 * 2));
    b.B3 = cmin(NIT, b.B2 + Px * 8 * QG); b.B4 = cmin(NIT, b.B3 + Px * 8 * QX);
    return b;
}
__device__ __forceinline__ void conv_moe(KA a, const int wv, int l, int begin, int end, int rank, int nranks) {
    if (begin >= end) return;
    const int wr = rank * NW + wv, ws_ = nranks * NW;
    if (begin < NIT1) p_transpose_r(wv, a->in[26] + (size_t)l * NEXP * DM * 2048, NEXP, DM, 2048, WSP(bf16_t, WS_BT1) + (size_t)l * NEXP * 2048 * DM, a->in[23] + l * DM, NEXP, 1, LDSP, begin, cmin(end, NIT1), wr, ws_);
    if (end > NIT1) { const int b2 = begin > NIT1 ? begin - NIT1 : 0;
        p_transpose_r(wv, a->in[28] + (size_t)l * NEXP * DFF * DM, NEXP, DFF, DM, WSP(bf16_t, WS_BT2) + (size_t)l * NEXP * DM * DFF, nullptr, 1, 0, LDSP, b2, end - NIT1, wr, ws_); }
}
__device__ __forceinline__ int moe_T_lds() { return __builtin_amdgcn_readfirstlane(((LAS const int*)(LDSP + TS_OFF))[32]); }
PHASE void ph_init(KA a, const int wv) {
    p_rowfinish<false, false>(wv, a->in[0], nullptr, nullptr, nullptr, nullptr, a->in[3], WSP(bf16_t, WS_XN16), nullptr);
    p_bias_table(wv, a->in[2], WSP(float, WS_BIASG), 152);
    for (int l = 0; l < 2; ++l) {
        p_s5_tables2(wv, a->in[5] + l * 2048, a->in[6] + l * 2048, a->in[7] + l * 32768, a->in[8] + l * 32768, a->in[9] + l * 32768, a->in[10] + l * 32768, a->in[11] + l * 32,
                     WSP(float2, WS_ABAR) + l * 2048, WSP(float2, WS_A256) + l * 2048, WSP(bf16_t, WS_BB16) + (size_t)l * 32 * 128 * 16, WSP(bf16_t, WS_CM16) + (size_t)l * 32 * 16 * 128, 160 + 32 * l);
        p_rmsnorm16(wv, a->in[1], a->in[19] + l * DM, WSP(bf16_t, WS_MEMN16) + (size_t)l * NMEM * DM, NMEM, 224 + 16 * l);
        p_router_tables(wv, a->in[24] + (size_t)l * DM * 32, a->in[23] + l * DM, WSP(bf16_t, WS_WR16) + (size_t)l * 2 * 32 * 1024, 160 + 64 * l);
    }
    p_transpose(wv, a->in[4], 2, DM, DIN, WSP(bf16_t, WS_WT_IN), nullptr, 1, 0, LDSP, 0);
    p_transpose(wv, a->in[13], 2, 512, 512, WSP(bf16_t, WS_WT_GLU), nullptr, 1, 0, LDSP, 0);
    p_transpose(wv, a->in[17], 2, DM, DM, WSP(bf16_t, WS_WT_OUT), nullptr, 1, 0, LDSP, 32);
    p_transpose(wv, a->in[20], 2, DM, 512, WSP(bf16_t, WS_WT_XQ), a->in[18], 1, 0, LDSP, 160);
    p_transpose(wv, a->in[21], 2, DM, 1024, WSP(bf16_t, WS_WT_XKV), nullptr, 1, 0, LDSP, 224);
    p_transpose(wv, a->in[22], 2, 512, DM, WSP(bf16_t, WS_WT_XO), nullptr, 1, 0, LDSP, 96);
    __syncthreads();
}
PHASE void ph_gemm_in(KA a, const int wv, int l) { LTID();
    DenseOrder S; S.init(WSP(bf16_t, WS_XN16), WSP(bf16_t, WS_WT_IN) + (size_t)l * DIN * DM, SEQ, DIN, DM, gridDim.x, bidx);
    EpiIn E{WSP(bf16_t, WS_PROJ16)};
    gemm_phase<EpiIn, DenseOrder, false, true>(LDSP, DM, S, E, tidx, wv);
}
PHASE void ph_attn_s5a(KA a, const int wv, int l) {
    p_dil_attn(wv, WSP(bf16_t, WS_PROJ16), WSP(float, WS_BIASG), WSP(bf16_t, WS_OBR), WSP(float, WS_LSE), LDSP);
    if (PROBE_DUP == 21) p_dil_attn(wv, WSP(bf16_t, WS_PROJ16), WSP(float, WS_BIASG), WSP(bf16_t, WS_OBR), WSP(float, WS_LSE), LDSP);
    if (PROBE_DUP == 22) { p_s5_pass<0>(wv, WSP(bf16_t, WS_PROJ16), WSP(float2, WS_ABAR) + l * 2048, WSP(float2, WS_A256) + l * 2048, WSP(bf16_t, WS_BB16) + (size_t)l * 32 * 128 * 16, WSP(bf16_t, WS_CM16) + (size_t)l * 32 * 16 * 128,
                 a->in[12] + l * 512, WSP(float2, WS_E2), WSP(bf16_t, WS_YG16), LDSP); __syncthreads(); }
    p_s5_pass<0>(wv, WSP(bf16_t, WS_PROJ16), WSP(float2, WS_ABAR) + l * 2048, WSP(float2, WS_A256) + l * 2048, WSP(bf16_t, WS_BB16) + (size_t)l * 32 * 128 * 16, WSP(bf16_t, WS_CM16) + (size_t)l * 32 * 16 * 128,
                 a->in[12] + l * 512, WSP(float2, WS_E2), WSP(bf16_t, WS_YG16), LDSP);
}
PHASE void ph_s5b(KA a, const int wv, int l) {
    p_s5_pass<1>(wv, WSP(bf16_t, WS_PROJ16), WSP(float2, WS_ABAR) + l * 2048, WSP(float2, WS_A256) + l * 2048, WSP(bf16_t, WS_BB16) + (size_t)l * 32 * 128 * 16, WSP(bf16_t, WS_CM16) + (size_t)l * 32 * 16 * 128,
                 a->in[12] + l * 512, WSP(float2, WS_E2), WSP(bf16_t, WS_YG16), LDSP);
}
PHASE void ph_gemm_glu(KA a, const int wv, int l) {
    {   LTID();
        DenseOrder S; S.init(WSP(bf16_t, WS_YG16), WSP(bf16_t, WS_WT_GLU) + (size_t)l * 512 * 512, SEQ, 512, 512, gridDim.x, bidx);
        EpiGlu16 E{WSP(bf16_t, WS_YB16), WSP(bf16_t, WS_YG16), a->in[14] + l * 512};
        gemm_phase<EpiGlu16, DenseOrder, false, false>(LDSP, 512, S, E, tidx, wv); }
    {   LTID();
        const int G = (int)gridDim.x;
        int T0 = 0; if (l == 1) { moe_tiles(WSP(unsigned, WS_CTL) + CW_CNT, tidx); T0 = moe_T_lds(); }
        const ConvBounds cb = conv_bounds(G, T0);
        if (G > 128) { if (bidx >= 128) conv_moe(a, wv, l, l == 0 ? 0 : cb.B2, l == 0 ? cb.A1 : cb.B3, bidx - 128, G - 128); }
        else conv_moe(a, wv, l, l == 0 ? 0 : cb.B2, l == 0 ? cb.A1 : cb.B3, bidx, G);
    }
}
PHASE void ph_mixnorm(KA a, const int wv, int l) {
    p_attn_combine(wv, WSP(bf16_t, WS_OBR), WSP(float, WS_LSE), a->in[15] + l * 512, WSP(bf16_t, WS_MIX16));
    p_ssm_norm(wv, WSP(bf16_t, WS_YB16), a->in[16] + l * 512, WSP(bf16_t, WS_MIX16));
}
PHASE void ph_gemm_out(KA a, const int wv, int l) { LTID();
    DenseOrder S; S.init(WSP(bf16_t, WS_MIX16), WSP(bf16_t, WS_WT_OUT) + (size_t)l * DM * DM, SEQ, DM, DM, gridDim.x, bidx);
    EpiOut E{l == 0 ? a->in[0] : (const float*)WSP(float, WS_H), WSP(float, WS_H), WSP(bf16_t, WS_HB16), WSP(float, WS_SSP)};
    gemm_phase<EpiOut, DenseOrder, false, false>(LDSP, DM, S, E, tidx, wv);
}
PHASE void ph_gemm_xq(KA a, const int wv, int l) {
    {   LTID();
        DenseOrder S; S.init(WSP(bf16_t, WS_HB16), WSP(bf16_t, WS_WT_XQ) + (size_t)l * 512 * DM, SEQ, 512, DM, gridDim.x, bidx);
        EpiBf16 E{WSP(bf16_t, WS_QX16), 512, 0.08838834764831845f, WSP(float, WS_SSP)};
        gemm_phase<EpiBf16, DenseOrder, false, false>(LDSP, DM, S, E, tidx, wv); }
    {   LTID();
    const int cc = (int)gridDim.x - 1 - bidx;
    if (l == 0 && cc < 8) {
        const int kl = cc >> 2;
        DenseOrder S; S.init(WSP(bf16_t, WS_MEMN16) + (size_t)kl * NMEM * DM, WSP(bf16_t, WS_WT_XKV) + (size_t)kl * 1024 * DM, NMEM, 1024, DM, 4, cc & 3);
        EpiBf16 E{WSP(bf16_t, WS_KV16) + (size_t)kl * NMEM * 1024, 1024, 1.f, nullptr};
        gemm_phase<EpiBf16, DenseOrder, false, false>(LDSP, DM, S, E, tidx, wv);
    } }
    {   LTID();
        const int G = (int)gridDim.x;
        int T0 = 0; if (l == 1) { moe_tiles(WSP(unsigned, WS_CTL) + CW_CNT, tidx); T0 = moe_T_lds(); }
        const ConvBounds cb = conv_bounds(G, T0);
        const int skip = (l == 0) ? 8 : 0;
        if (G > 128 + skip) { if (bidx >= 128 && bidx < G - skip) conv_moe(a, wv, l, l == 0 ? cb.A1 : cb.B3, l == 0 ? cb.A2 : cb.B4, bidx - 128, G - 128 - skip); }
        else conv_moe(a, wv, l, l == 0 ? cb.A1 : cb.B3, l == 0 ? cb.A2 : cb.B4, bidx, G);
    }
}
PHASE void ph_xattn(KA a, const int wv, int l) { p_xattn_mfma(wv, WSP(bf16_t, WS_QX16), WSP(bf16_t, WS_KV16) + (size_t)l * NMEM * 1024, WSP(bf16_t, WS_OX16), LDSP); }
PHASE void ph_gemm_xo(KA a, const int wv, int l) { LTID();
    DenseOrder S; S.init(WSP(bf16_t, WS_OX16), WSP(bf16_t, WS_WT_XO) + (size_t)l * DM * 512, SEQ, DM, 512, gridDim.x, bidx);
    EpiF32 E{WSP(float, WS_H), DM, 1};
    gemm_phase<EpiF32, DenseOrder, false, false>(LDSP, 512, S, E, tidx, wv);
}
PHASE void ph_router(KA a, const int wv, int l) {
    {   LTID();
        const int G = (int)gridDim.x;
        int T0 = 0; if (l == 1) { moe_tiles(WSP(unsigned, WS_CTL) + CW_CNT, tidx); T0 = moe_T_lds(); }
        const ConvBounds cb = conv_bounds(G, T0);
        conv_moe(a, wv, l, l == 0 ? cb.A2 : cb.B4, NIT, bidx, G);
        __syncthreads();
    }
    p_router2(wv, WSP(float, WS_H), WSP(bf16_t, WS_WR16) + (size_t)l * 2 * 32 * 1024, a->in[25] + l * 32, WSP(bf16_t, WS_HB16), WSP(unsigned, WS_CTL) + CW_CNT + l * 32,
              WSP(int, WS_ROWTOK), WSP(float, WS_RSC), WSP(int, WS_ESLOT), WSP(float, WS_TOPG), LDSP);
}
PHASE void ph_moe1(KA a, const int wv, int l) {
    {   LTID();
        moe_tiles(WSP(unsigned, WS_CTL) + CW_CNT + l * 32, tidx);
        MoeOrder<true> S; S.init(WSP(bf16_t, WS_HB16), WSP(bf16_t, WS_BT1) + (size_t)l * NEXP * 2048 * DM, WSP(int, WS_ROWTOK), 2048, DM, (size_t)2048 * DM * 2, gridDim.x, bidx);
        EpiMoe1 E{WSP(bf16_t, WS_ACT), a->in[27] + (size_t)l * NEXP * 2048, WSP(float, WS_RSC)};
        gemm_phase<EpiMoe1, MoeOrder<true>, true, true>(LDSP, DM, S, E, tidx, wv); }
    if (l == 0) { LTID();
        const int G = (int)gridDim.x, T0 = moe_T_lds(), r1 = (8 * T0) % G; const ConvBounds cb = conv_bounds(G, T0);
        if (r1) { if (bidx >= r1) conv_moe(a, wv, 1, 0, cb.B1, bidx - r1, G - r1); } else conv_moe(a, wv, 1, 0, cb.B1, bidx, G);
    }
}
PHASE void ph_moe2(KA a, const int wv, int l) {
    {   LTID();
        moe_tiles(WSP(unsigned, WS_CTL) + CW_CNT + l * 32, tidx);
        MoeOrder<false> S; S.init(WSP(bf16_t, WS_ACT), WSP(bf16_t, WS_BT2) + (size_t)l * NEXP * DM * DFF, nullptr, DM, DFF, (size_t)DM * DFF * 2, gridDim.x, bidx);
        EpiMoe2 E{WSP(bf16_t, WS_MOUT), a->in[29] + (size_t)l * NEXP * DM};
        gemm_phase<EpiMoe2, MoeOrder<false>, false, true>(LDSP, DFF, S, E, tidx, wv); }
    if (l == 0) { LTID();
        const int G = (int)gridDim.x, T0 = moe_T_lds(), r2 = (4 * T0) % G; const ConvBounds cb = conv_bounds(G, T0);
        if (r2) { if (bidx >= r2) conv_moe(a, wv, 1, cb.B1, cb.B2, bidx - r2, G - r2); } else conv_moe(a, wv, 1, cb.B1, cb.B2, bidx, G);
    }
}
PHASE void ph_combine(KA a, const int wv, int l) { LTID();
    moe_tiles(WSP(unsigned, WS_CTL) + CW_CNT + l * 32, tidx);
    if (l == 0) p_rowfinish<true, false>(wv, WSP(float, WS_H), WSP(float, WS_H), WSP(bf16_t, WS_MOUT), WSP(int, WS_ESLOT), WSP(float, WS_TOPG), a->in[3] + DM, WSP(bf16_t, WS_XN16), nullptr);
    else p_rowfinish<true, true>(wv, WSP(float, WS_H), nullptr, WSP(bf16_t, WS_MOUT), WSP(int, WS_ESLOT), WSP(float, WS_TOPG), a->in[30], nullptr, a->out);
}

__global__ void __launch_bounds__(NT, 2) mega(Args args) {
    KA a = (KA)__builtin_amdgcn_kernarg_segment_ptr();
    int wv = __builtin_amdgcn_readfirstlane((int)threadIdx.x >> 6); asm volatile("" : "+s"(wv));
    LAS unsigned char* lds = LDSP;
    volatile LAS unsigned* MISC = (volatile LAS unsigned*)(lds + MISC_OFF);
    unsigned* ctl = (unsigned*)(a->ws + WS_CTL);
    if (threadIdx.x < 32) MISC[threadIdx.x] = 0u;
    __syncthreads();
    XcdBarrier bar; bar.bar = ctl + CW_BAR; bar.x = 0; bar.st = nullptr;
    if (!MK_PER_PHASE) bar = xcd_barrier_post(ctl + CW_BAR, MISC + 8);
    const int lo = a->ph_lo, hi = a->ph_hi;
#define IN(k) (lo <= (k) && (k) < hi)
#define SEAM(k) do { if (IN(k) && IN((k) + 1)) { LTID(); xcd_barrier(bar.bar, bar.x, bar.st, tidx == 0); if (PROBE_DUP == 200) xcd_barrier(bar.bar, bar.x, bar.st, tidx == 0); } } while (0)
    if (IN(0)) { ph_init(KAP(), wv); if (PROBE_DUP == 100) ph_init(KAP(), wv); }
    SEAM(0);
#define LAYER_PROGRAM(l) { const int pb = 1 + (l) * NPL; \
        if (IN(pb + 0)) { ph_gemm_in(KAP(), wv, (l)); if (PROBE_DUP == 0) { ph_gemm_in(KAP(), wv, (l)); } } \
        SEAM(pb + 0); \
        if (IN(pb + 1)) { ph_attn_s5a(KAP(), wv, (l)); if (PROBE_DUP == 1) { ph_attn_s5a(KAP(), wv, (l)); } } \
        SEAM(pb + 1); \
        if (IN(pb + 2)) { ph_s5b(KAP(), wv, (l)); if (PROBE_DUP == 2) { ph_s5b(KAP(), wv, (l)); } } \
        SEAM(pb + 2); \
        if (IN(pb + 3)) { ph_gemm_glu(KAP(), wv, (l)); if (PROBE_DUP == 3) { ph_gemm_glu(KAP(), wv, (l)); } } \
        SEAM(pb + 3); \
        if (IN(pb + 4)) { ph_mixnorm(KAP(), wv, (l)); if (PROBE_DUP == 4) { ph_mixnorm(KAP(), wv, (l)); } } \
        SEAM(pb + 4); \
        if (IN(pb + 5)) { ph_gemm_out(KAP(), wv, (l)); if (PROBE_DUP == 5) { ph_gemm_out(KAP(), wv, (l)); } } \
        SEAM(pb + 5); \
        if (IN(pb + 6)) { ph_gemm_xq(KAP(), wv, (l)); if (PROBE_DUP == 6) { ph_gemm_xq(KAP(), wv, (l)); } } \
        SEAM(pb + 6); \
        if (IN(pb + 7)) { ph_xattn(KAP(), wv, (l)); if (PROBE_DUP == 7) { ph_xattn(KAP(), wv, (l)); } } \
        SEAM(pb + 7); \
        if (IN(pb + 8)) { ph_gemm_xo(KAP(), wv, (l)); if (PROBE_DUP == 8) { ph_gemm_xo(KAP(), wv, (l)); } } \
        SEAM(pb + 8); \
        if (IN(pb + 9)) { ph_router(KAP(), wv, (l)); if (PROBE_DUP == 9) { ph_router(KAP(), wv, (l)); } } \
        SEAM(pb + 9); \
        if (IN(pb + 10)) { ph_moe1(KAP(), wv, (l)); if (PROBE_DUP == 10) { ph_moe1(KAP(), wv, (l)); } } \
        SEAM(pb + 10); \
        if (IN(pb + 11)) { ph_moe2(KAP(), wv, (l)); if (PROBE_DUP == 11) { ph_moe2(KAP(), wv, (l)); } } \
        SEAM(pb + 11); \
        if (IN(pb + 12)) { ph_combine(KAP(), wv, (l)); if (PROBE_DUP == 12) { ph_combine(KAP(), wv, (l)); } } \
        SEAM(pb + 12); }
    LAYER_PROGRAM(0)
    LAYER_PROGRAM(1)
#undef LAYER_PROGRAM
#undef IN
#undef SEAM
}

extern "C" void kernel_launch(void* const* d_in, const int* in_sizes, int n_in, void* d_out, int out_size, void* d_ws, size_t ws_size, hipStream_t stream) {
    static int grid = 0;
    if (grid == 0) {
        if (n_in != 31 || ws_size < WS_END) { fprintf(stderr, "kernel_launch: unexpected n_in %d or ws_size %zu (need %zu)\n", n_in, ws_size, (size_t)WS_END); grid = -1; return; }
        int dev = 0, cus = 0, per_cu = 0;
        if (hipGetDevice(&dev) != hipSuccess || hipDeviceGetAttribute(&cus, hipDeviceAttributeMultiprocessorCount, dev) != hipSuccess) { grid = -1; return; }
        if (hipFuncSetAttribute((const void*)mega, hipFuncAttributeMaxDynamicSharedMemorySize, LDS_BYTES) != hipSuccess) { fprintf(stderr, "kernel_launch: hipFuncSetAttribute failed\n"); grid = -1; return; }
        if (hipOccupancyMaxActiveBlocksPerMultiprocessor(&per_cu, (const void*)mega, NT, LDS_BYTES) != hipSuccess || per_cu < 1)
            fprintf(stderr, "kernel_launch: occupancy query reports %d workgroups per CU\n", per_cu);
        (void)hipGetLastError();
        grid = cus;
    }
    if (grid < 0) return;
    if (hipMemsetAsync((char*)d_ws + WS_CTL, 0, CTL_ZERO_BYTES, stream) != hipSuccess) return;
    Args a{};
    for (int i = 0; i < 31; ++i) a.in[i] = (const float*)d_in[i];
    a.out = (float*)d_out; a.ws = (unsigned char*)d_ws;
#if MK_PER_PHASE
    for (int p = 0; p < NPHASES; ++p) { a.ph_lo = p; a.ph_hi = p + 1; hipLaunchKernelGGL(mega, dim3(grid), dim3(NT), LDS_BYTES, stream, a); }
#else
    a.ph_lo = 0; a.ph_hi = NPHASES;
    hipLaunchKernelGGL(mega, dim3(grid), dim3(NT), LDS_BYTES, stream, a);
#endif
}
```

```cpp
#include <hip/hip_runtime.h>
#include <stdint.h>
#include <cstdio>

#ifndef PROBE_DUP
#define PROBE_DUP -1
#endif
#ifndef MK_PER_PHASE
#define MK_PER_PHASE 0
#endif

#define SEQ 16384
#define DM 1024
#define DIN 2048
#define NMEM 256
#define NEXP 32
#define TOPK 4
#define DFF 1024
#define NT 512
#define NW 8

#define LAS __attribute__((address_space(3)))
typedef float f32x4 __attribute__((ext_vector_type(4)));
typedef float f32x2 __attribute__((ext_vector_type(2)));
extern __shared__ __attribute__((aligned(16))) unsigned char lds_raw[];
#define LDSP ((LAS unsigned char*)lds_raw)
#define LTID() int z_ = 0; asm volatile("" : "+v"(z_)); const int lane_ = (int)__builtin_amdgcn_mbcnt_hi(~0u, __builtin_amdgcn_mbcnt_lo(~0u, (unsigned)z_)); \
    const int tidx = wv * 64 + lane_; int bidx = blockIdx.x; asm volatile("" : "+s"(bidx))
#define ROTB(rot) ((bidx + (int)gridDim.x - (rot) % (int)gridDim.x) % (int)gridDim.x)
__device__ __forceinline__ float shx(float v, int mask, int lane) { return __builtin_bit_cast(float, __builtin_amdgcn_ds_bpermute((lane ^ mask) << 2, __builtin_bit_cast(int, v))); }
__device__ __forceinline__ int shxi(int v, int mask, int lane) { return __builtin_amdgcn_ds_bpermute((lane ^ mask) << 2, v); }
constexpr int LDS_BYTES = 147456;
constexpr int MISC_OFF = 131072 + 320;

#define XB_TMO      128
#define XB_XCNT(j)  (256  + 64 * (j))
#define XB_XSUB(j)  (1280 + 64 * (j))
#define XB_XGEN(j)  (2304 + 64 * (j))
#define XB_TOP      3328
#define XB_TOPGEN   3392
#define XCD_BAR_WORDS 3456
#define XB_SPIN_CAP (1u << 18)

__device__ __forceinline__ unsigned xb_ld(unsigned* p)              { return __hip_atomic_load(p, __ATOMIC_RELAXED, __HIP_MEMORY_SCOPE_AGENT); }
__device__ __forceinline__ unsigned xb_add(unsigned* p, unsigned v) { return __hip_atomic_fetch_add(p, v, __ATOMIC_RELAXED, __HIP_MEMORY_SCOPE_AGENT); }
__device__ __forceinline__ unsigned xb_xcc_id() { return (unsigned)__builtin_amdgcn_s_getreg((3 << 11) | 20) & 0xFu; }
#define XB_SPIN(cond, bar) do { unsigned _sp = 0; while (cond) { __builtin_amdgcn_s_sleep(1); \
    if ((++_sp & 255u) == 0u) { if (xb_ld(&(bar)[XB_TMO])) break; if (_sp > XB_SPIN_CAP) { atomicAdd(&(bar)[XB_TMO], 1u); break; } } } } while (0)

struct XcdBarrier {
    unsigned* bar; unsigned x;
    volatile LAS unsigned* st;
};
__device__ __forceinline__ XcdBarrier xcd_barrier_post(unsigned* bar, volatile LAS unsigned* st) {
    XcdBarrier b; b.bar = bar; b.x = xb_xcc_id(); b.st = st;
    if (threadIdx.x == 0) (void)xb_add(&bar[XB_XCNT(b.x)], 1u);
    return b;
}
__device__ __forceinline__ void xcd_barrier_complete(unsigned* bar, unsigned x, unsigned& nloc, unsigned& nx) {
    const unsigned G = gridDim.x * gridDim.y * gridDim.z;
    unsigned sum, cnt, mine, sp = 0u;
    for (;;) {
        sum = 0u; cnt = 0u; mine = 0u;
#pragma unroll
        for (unsigned j = 0; j < 16; ++j) { const unsigned c = xb_ld(&bar[XB_XCNT(j)]); sum += c; cnt += (c > 0u) ? 1u : 0u; mine = (j == x) ? c : mine; }
        if (sum == G) break;
        __builtin_amdgcn_s_sleep(1);
        if ((++sp & 255u) == 0u) { if (xb_ld(&bar[XB_TMO])) break; if (sp > XB_SPIN_CAP) { atomicAdd(&bar[XB_TMO], 1u); break; } }
    }
    nloc = mine > 0u ? mine : 1u; nx = cnt > 0u ? cnt : 1u;
}
__device__ __noinline__ void xcd_barrier(unsigned* bar_, unsigned x_, volatile LAS unsigned* st_, int is_t0) {
    XcdBarrier b; b.bar = bar_; b.x = x_; b.st = st_;
    asm volatile("s_waitcnt vmcnt(0)" ::: "memory");
    __syncthreads();
    if (is_t0) {
        unsigned* bar = b.bar;
        __builtin_amdgcn_s_waitcnt(0);
        unsigned nloc = b.st[0], nx = b.st[1];
        if (nloc == 0u) { xcd_barrier_complete(bar, b.x, nloc, nx); b.st[0] = nloc; b.st[1] = nx; }
        const unsigned old = xb_add(&bar[XB_XSUB(b.x)], 1u);
        const unsigned gen = old / nloc;
        if (old + 1u == (gen + 1u) * nloc) {
            __builtin_amdgcn_fence(__ATOMIC_RELEASE, "agent");
            asm volatile("s_waitcnt vmcnt(0)" ::: "memory");
            const unsigned og = xb_add(&bar[XB_TOP], 1u);
            const unsigned tg = og / nx;
            if (og + 1u == (tg + 1u) * nx) xb_add(&bar[XB_TOPGEN], 1u);
            else XB_SPIN(xb_ld(&bar[XB_TOPGEN]) == tg, bar);
            __builtin_amdgcn_fence(__ATOMIC_ACQUIRE, "agent");
            xb_add(&bar[XB_XGEN(b.x)], 1u);
            asm volatile("s_waitcnt vmcnt(0)" ::: "memory");
        } else {
            XB_SPIN(xb_ld(&bar[XB_XGEN(b.x)]) == gen, bar);
            __builtin_amdgcn_fence(__ATOMIC_ACQUIRE, "agent");
            asm volatile("s_waitcnt vmcnt(0)" ::: "memory");
        }
    }
    __syncthreads();
}

constexpr size_t MiB = 1u << 20;
constexpr size_t WS_CTL = 0, CTL_ZERO_BYTES = 1 * MiB;
constexpr int CW_BAR = 4096;
constexpr int CW_CNT = 8192;
constexpr int MOE_ROWS = SEQ * TOPK + NEXP * 256;
constexpr int ECAP = SEQ;
constexpr size_t al256(size_t x) { return (x + 255) & ~(size_t)255; }
constexpr size_t WS_H = 2 * MiB;
constexpr size_t WS_XN16 = WS_H + (size_t)SEQ * DM * 4;
constexpr size_t WS_HB16 = WS_XN16 + (size_t)SEQ * DM * 2;
constexpr size_t WS_PROJ16 = WS_HB16 + (size_t)SEQ * DM * 2;
constexpr size_t WS_OBR = WS_PROJ16 + (size_t)SEQ * 2048 * 2;
constexpr size_t WS_LSE = WS_OBR + 3 * (size_t)SEQ * 512 * 2;
constexpr size_t WS_YG16 = WS_LSE + 3 * (size_t)SEQ * 8 * 4;
constexpr size_t WS_YB16 = WS_YG16 + (size_t)SEQ * 512 * 2;
constexpr size_t WS_MIX16 = WS_YB16 + (size_t)SEQ * 512 * 2;
constexpr size_t WS_QX16 = WS_MIX16 + (size_t)SEQ * DM * 2;
constexpr size_t WS_OX16 = WS_QX16 + (size_t)SEQ * 512 * 2;
constexpr size_t WS_ACT = WS_OX16 + (size_t)SEQ * 512 * 2;
constexpr size_t WS_MOUT = WS_ACT + (size_t)MOE_ROWS * DFF * 2;
constexpr size_t WS_BT1 = WS_MOUT + (size_t)MOE_ROWS * DM * 2;
constexpr size_t WS_BT2 = WS_BT1 + 2 * (size_t)NEXP * 2048 * DM * 2;
constexpr size_t WS_WT_IN = WS_BT2 + 2 * (size_t)NEXP * DM * DFF * 2;
constexpr size_t WS_WT_GLU = WS_WT_IN + 2 * (size_t)2048 * 1024 * 2;
constexpr size_t WS_WT_OUT = WS_WT_GLU + 2 * (size_t)512 * 512 * 2;
constexpr size_t WS_WT_XQ = WS_WT_OUT + 2 * (size_t)1024 * 1024 * 2;
constexpr size_t WS_WT_XKV = WS_WT_XQ + 2 * (size_t)512 * 1024 * 2;
constexpr size_t WS_WT_XO = WS_WT_XKV + 2 * (size_t)1024 * 1024 * 2;
constexpr size_t WS_MEMN16 = WS_WT_XO + 2 * (size_t)1024 * 512 * 2;
constexpr size_t WS_KV16 = WS_MEMN16 + 2 * (size_t)NMEM * 1024 * 2;
constexpr size_t WS_WR16 = WS_KV16 + 2 * (size_t)NMEM * 1024 * 2;
constexpr size_t WS_BIASG = WS_WR16 + 2 * 2 * (size_t)32 * 1024 * 2;
constexpr size_t WS_ABAR = al256(WS_BIASG + 24 * 132 * 4);
constexpr size_t WS_A256 = WS_ABAR + 2 * 2048 * 8;
constexpr size_t WS_BB16 = WS_A256 + 2 * 2048 * 8;
constexpr size_t WS_CM16 = WS_BB16 + 2 * (size_t)32 * 128 * 16 * 2;
constexpr size_t WS_E2 = WS_CM16 + 2 * (size_t)32 * 16 * 128 * 2;
constexpr size_t WS_ROWTOK = WS_E2 + (size_t)64 * 2048 * 8;
constexpr size_t WS_RSC = WS_ROWTOK + (size_t)NEXP * ECAP * 4;
constexpr size_t WS_ESLOT = WS_RSC + (size_t)NEXP * ECAP * 4;
constexpr size_t WS_TOPG = WS_ESLOT + (size_t)SEQ * 4 * 4;
constexpr size_t WS_SSP = WS_TOPG + (size_t)SEQ * 4 * 4;
constexpr size_t WS_END = WS_SSP + (size_t)SEQ * 16 * 4;

struct Args { const float* in[31]; float* out; unsigned char* ws; int ph_lo, ph_hi; };


typedef unsigned short bf16_t;
typedef short bf16x8 __attribute__((ext_vector_type(8)));
typedef unsigned u32x4 __attribute__((ext_vector_type(4)));
typedef unsigned u32x2 __attribute__((ext_vector_type(2)));
constexpr int BM = 256, BK = 64, HALF = 128, HTB = HALF * BK * 2, STAGE_BYTES = 8 * HTB, NXCD = 8, WGM = 4, WGM_MOE = 1;
__host__ __device__ __forceinline__ int lds_byte(int r, int c) { const int st = (r >> 4) * 2 + (c >> 5), rr = r & 15, cc = c & 31, ob = rr * 64 + cc * 2; return st * 1024 + (ob ^ (((ob >> 9) & 1) << 5)); }
__host__ __device__ __forceinline__ void stage_rc(int b, int& R, int& C) { const int st = b / 1024, sb = b % 1024, swz = sb ^ (((sb >> 9) & 1) << 5); R = (st >> 1) * 16 + swz / 64; C = (st & 1) * 32 + (swz % 64) / 2; }
__host__ __device__ __forceinline__ int perm32(int rho) { const int n = rho >> 4, i = rho & 15; return 8 * (i >> 2) + 4 * n + (i & 3); }
__device__ __forceinline__ unsigned cvt_pk_bf16(float lo, float hi) { unsigned r; asm volatile("v_cvt_pk_bf16_f32 %0, %1, %2" : "=v"(r) : "v"(lo), "v"(hi)); return r; }
__device__ __forceinline__ unsigned f2bf(float f) { unsigned u = __builtin_bit_cast(unsigned, f); return (u + 0x7fffu + ((u >> 16) & 1u)) >> 16; }
__device__ __forceinline__ unsigned pk2(float lo, float hi) { return f2bf(lo) | (f2bf(hi) << 16); }
__device__ __forceinline__ float bf2f(unsigned short b) { return __builtin_bit_cast(float, ((unsigned)b) << 16); }

__device__ __forceinline__ void glds16s(const void* sbase, unsigned voff, unsigned lds_dst) {
    unsigned keep;
    asm volatile("s_mov_b32 %0, m0\n\ts_mov_b32 m0, %3\n\ts_nop 0\n\tglobal_load_lds_dwordx4 %1, %2\n\ts_mov_b32 m0, %0" : "=&s"(keep) : "v"(voff), "s"(sbase), "s"(lds_dst) : "memory");
}
struct GUnit { const char* A; const char* B; int pm, pn, e, row0, cnt; };

struct DenseOrder {
    const char* A; const char* Bt; int nM, nN, nwg, G, c, K;
    __device__ __forceinline__ void init(const bf16_t* A_, const bf16_t* Bt_, int M, int N, int K_, int G_, int c_) { A = (const char*)A_; Bt = (const char*)Bt_; nM = M / BM; nN = N / BM; nwg = nM * nN; G = G_; c = c_; K = K_; }
    __device__ __forceinline__ bool next(int i, GUnit& u) const {
        const long L = (long)i * G + c; if (L >= nwg) return false;
        int wgid = (int)L; { const int q = nwg / NXCD, r = nwg % NXCD, xcd = wgid % NXCD, off = wgid / NXCD; wgid = (xcd < r ? xcd * (q + 1) : r * (q + 1) + (xcd - r) * q) + off; }
        const int nig = WGM * nN, gid = wgid / nig, fm = gid * WGM, gsz = (nM - fm) < WGM ? (nM - fm) : WGM;
        u.pm = fm + ((wgid % nig) % gsz); u.pn = (wgid % nig) / gsz; u.e = 0; u.row0 = 0; u.cnt = 0;
        u.A = A + (size_t)u.pm * BM * K * 2; u.B = Bt + (size_t)u.pn * BM * K * 2; return true;
    }
    __device__ __forceinline__ unsigned aoff(const GUnit&, int row) const { return (unsigned)(row * K * 2); }
    __device__ __forceinline__ unsigned tokoff(const GUnit&, int) const { return 0u; }
    __device__ __forceinline__ const int* tokbase() const { return nullptr; }
};

struct EpiF32 {
    static constexpr bool PERM = false;
    float* C; int ldc; int resid;
    __device__ __forceinline__ void operator()(const f32x4 (&acc)[2][2][4][2], const GUnit& u, int wr, int wc, int fr, int fq) const {
        const int row0 = u.pm * BM + wr * 64 + fr, col0 = u.pn * BM + wc * 32 + 4 * fq;
#pragma unroll
        for (int ai = 0; ai < 2; ++ai)
#pragma unroll
            for (int m = 0; m < 4; ++m) { float* rowp = C + (size_t)(row0 + ai * HALF + m * 16) * ldc + col0;
#pragma unroll
                for (int bj = 0; bj < 2; ++bj)
#pragma unroll
                    for (int n = 0; n < 2; ++n) { f32x4 v = acc[ai][bj][m][n]; if (resid) v += *(const f32x4*)(rowp + bj * HALF + n * 16); *(f32x4*)(rowp + bj * HALF + n * 16) = v; } }
    }
};
struct EpiGlu {
    static constexpr bool PERM = false;
    float* C; const float* Y; int ldc; const float* bias;
    __device__ __forceinline__ void operator()(const f32x4 (&acc)[2][2][4][2], const GUnit& u, int wr, int wc, int fr, int fq) const {
        const int row0 = u.pm * BM + wr * 64 + fr, col0 = u.pn * BM + wc * 32 + 4 * fq;
#pragma unroll
        for (int ai = 0; ai < 2; ++ai)
#pragma unroll
            for (int m = 0; m < 4; ++m) { const size_t ro = (size_t)(row0 + ai * HALF + m * 16) * ldc + col0;
#pragma unroll
                for (int bj = 0; bj < 2; ++bj)
#pragma unroll
                    for (int n = 0; n < 2; ++n) { const f32x4 b = *(const f32x4*)(bias + col0 + bj * HALF + n * 16); const f32x4 y = *(const f32x4*)(Y + ro + bj * HALF + n * 16);
                        f32x4 v = acc[ai][bj][m][n] + b; f32x4 o;
#pragma unroll
                        for (int j = 0; j < 4; ++j) o[j] = y[j] / (1.f + __expf(-v[j]));
                        *(f32x4*)(C + ro + bj * HALF + n * 16) = o; } }
    }
};

template <class Epi, class Sched, bool GATHER, bool ALIGN_EPI>
__device__ __forceinline__ void gemm_phase(LAS unsigned char* lds, const int K, const Sched& S, const Epi& E, const int tid, const int wv) {
    const int wid = wv, lane = tid & 63, wr = wid >> 2, wc = wid & 3, fr = lane & 15, fq = lane >> 4;
    const int nt = K / BK;
    unsigned voffB[2];
#pragma unroll
    for (int i = 0; i < 2; ++i) { int R, C; stage_rc(tid * 16 + i * 8192, R, C); const int Rb = Epi::PERM ? ((R & ~31) + perm32(R & 31)) : R; voffB[i] = (unsigned)(Rb * K + C) * 2u; }
#define PG8_AOFFS(dst, u) do { int t2_ = tid; asm volatile("" : "+v"(t2_)); _Pragma("unroll") for (int i = 0; i < 2; ++i) { int R, C; stage_rc(t2_ * 16 + i * 8192, R, C); \
        _Pragma("unroll") for (int h = 0; h < 2; ++h) dst[h][i] = S.aoff(u, h * HALF + R) + (unsigned)C * 2u; } } while (0)
    const size_t kstep = (size_t)(BK * 2);
    const size_t hstep = (size_t)HALF * K * 2;
    const unsigned ldsw = (unsigned)wid * 1024u;
    const int aoff = lds_byte(wr * 64 + fr, fq * 8), boff = lds_byte(wc * 32 + fr, fq * 8);
#define PG8_SA(b, h) (((b) * 2 + (h)) * HTB)
#define PG8_SB(b, h) ((4 + (b) * 2 + (h)) * HTB)
#define PG8_STAGE(bufoff, gbase, v0, v1) do { const unsigned ld_ = (unsigned)(size_t)(lds + (bufoff) + ldsw); glds16s((gbase), (v0), ld_); glds16s((gbase), (v1), ld_ + 8192u); } while (0)
#define PG8_LDA(dst, b, h) do { _Pragma("unroll") for (int m = 0; m < 4; ++m) _Pragma("unroll") for (int k = 0; k < 2; ++k) dst[m][k] = *(const LAS bf16x8*)(lds + PG8_SA(b, h) + aoff + m * 2048 + k * 1024); } while (0)
#define PG8_LDB(dst, b, h) do { _Pragma("unroll") for (int n = 0; n < 2; ++n) _Pragma("unroll") for (int k = 0; k < 2; ++k) dst[n][k] = *(const LAS bf16x8*)(lds + PG8_SB(b, h) + boff + n * 2048 + k * 1024); } while (0)
#define PG8_MMA(ai, bj, At, Bt) do { __builtin_amdgcn_s_setprio(1); _Pragma("unroll") for (int m = 0; m < 4; ++m) _Pragma("unroll") for (int n = 0; n < 2; ++n) _Pragma("unroll") for (int k = 0; k < 2; ++k) \
        acc[ai][bj][m][n] = __builtin_amdgcn_mfma_f32_16x16x32_bf16(Bt[n][k], At[m][k], acc[ai][bj][m][n], 0, 0, 0); __builtin_amdgcn_s_setprio(0); } while (0)
#define PG8_WAIT_V(n) asm volatile("s_waitcnt vmcnt(" #n ")" ::: "memory")
#define PG8_WAIT_L(n) asm volatile("s_waitcnt lgkmcnt(" #n ")" ::: "memory")
#define PG8_BAR __builtin_amdgcn_s_barrier()
#define PG8_SCHED __builtin_amdgcn_sched_barrier(0)
    GUnit cur, nxt; int ui = 0;
    if (!S.next(0, cur)) return;
    f32x4 acc[2][2][4][2];
#pragma unroll
    for (int a = 0; a < 2; ++a)
#pragma unroll
        for (int b = 0; b < 2; ++b)
#pragma unroll
            for (int m = 0; m < 4; ++m)
#pragma unroll
                for (int n = 0; n < 2; ++n) acc[a][b][m][n] = (f32x4){0.f, 0.f, 0.f, 0.f};
    bf16x8 At[4][2], B0[2][2], B1[2][2];
    unsigned vA[2][2], vN[2][2];
    PG8_AOFFS(vA, cur);
#pragma unroll
    for (int h = 0; h < 2; ++h)
#pragma unroll
        for (int i = 0; i < 2; ++i) vN[h][i] = vA[h][i];
    const char* cA = cur.A; const char* cB = cur.B;
    PG8_STAGE(PG8_SB(0, 0), cB, voffB[0], voffB[1]); PG8_STAGE(PG8_SB(0, 1), cB + hstep, voffB[0], voffB[1]); PG8_STAGE(PG8_SA(0, 0), cA, vA[0][0], vA[0][1]); PG8_STAGE(PG8_SA(0, 1), cA, vA[1][0], vA[1][1]);
    if (wr == 1) PG8_BAR;
    PG8_WAIT_V(2); PG8_BAR;
    PG8_STAGE(PG8_SB(1, 0), cB + kstep, voffB[0], voffB[1]); PG8_STAGE(PG8_SA(1, 0), cA + kstep, vA[0][0], vA[0][1]); PG8_STAGE(PG8_SB(1, 1), cB + hstep + kstep, voffB[0], voffB[1]);
    PG8_WAIT_V(6); PG8_BAR;
    for (;;) {
        const bool has_next = S.next(ui + 1, nxt);
        const char* nA = GATHER ? cA : (has_next ? nxt.A : cA); const char* nB = has_next ? nxt.B : cB;
        unsigned tok_[2][2] = {{0u, 0u}, {0u, 0u}};
#define PG8_KBODY(a1, a2, b2, a3, b3, W00, W01, W10, W11) do { \
              \
            PG8_LDB(B0, 0, 0); PG8_LDB(B1, 0, 1); PG8_SCHED; PG8_LDA(At, 0, 0); PG8_STAGE(PG8_SA(1, 1), a1, vA[1][0], vA[1][1]); \
            PG8_WAIT_V(8); PG8_WAIT_L(0); PG8_BAR; PG8_MMA(0, 0, At, B0); PG8_MMA(0, 1, At, B1); PG8_BAR; PG8_SCHED; \
              \
            PG8_LDA(At, 0, 1); PG8_STAGE(PG8_SB(0, 0), b2, voffB[0], voffB[1]); PG8_STAGE(PG8_SB(0, 1), (b2) + hstep, voffB[0], voffB[1]); PG8_STAGE(PG8_SA(0, 0), a2, W00, W01); \
            PG8_WAIT_V(8); PG8_WAIT_L(0); PG8_BAR; PG8_MMA(1, 0, At, B0); PG8_MMA(1, 1, At, B1); PG8_BAR; PG8_SCHED; \
              \
            PG8_LDB(B0, 1, 0); PG8_LDB(B1, 1, 1); PG8_SCHED; PG8_LDA(At, 1, 0); PG8_STAGE(PG8_SA(0, 1), a2, W10, W11); \
            PG8_WAIT_V(8); PG8_WAIT_L(0); PG8_BAR; PG8_MMA(0, 0, At, B0); PG8_MMA(0, 1, At, B1); PG8_BAR; PG8_SCHED; \
              \
            PG8_LDA(At, 1, 1); PG8_STAGE(PG8_SB(1, 0), b3, voffB[0], voffB[1]); PG8_STAGE(PG8_SB(1, 1), (b3) + hstep, voffB[0], voffB[1]); PG8_STAGE(PG8_SA(1, 0), a3, W00, W01); \
            PG8_WAIT_V(8); PG8_WAIT_L(0); PG8_BAR; PG8_MMA(1, 0, At, B0); PG8_MMA(1, 1, At, B1); PG8_BAR; PG8_SCHED; } while (0)
        for (int t = 0; t < nt - 2; t += 2) {
            const char* a1 = cA + (size_t)(t + 1) * kstep;
            const char* a2 = cA + (size_t)(t + 2) * kstep; const char* b2 = cB + (size_t)(t + 2) * kstep;
            const char* a3 = a2 + kstep; const char* b3 = b2 + kstep;
            if (GATHER) { if (t == nt - 4 && has_next) { int t2_ = tid; asm volatile("" : "+v"(t2_));
#pragma unroll
                for (int i = 0; i < 2; ++i) { int R, C; stage_rc(t2_ * 16 + i * 8192, R, C);
#pragma unroll
                    for (int h = 0; h < 2; ++h) { const unsigned vo = S.tokoff(nxt, h * HALF + R); asm volatile("global_load_dword %0, %1, %2" : "=v"(tok_[h][i]) : "v"(vo), "s"(S.tokbase()) : "memory"); } } } }
            PG8_KBODY(a1, a2, b2, a3, b3, vA[0][0], vA[0][1], vA[1][0], vA[1][1]);
        }
        if (GATHER) {
            if (has_next) { int t2_ = tid; asm volatile("" : "+v"(t2_), "+v"(tok_[0][0]), "+v"(tok_[0][1]), "+v"(tok_[1][0]), "+v"(tok_[1][1]));
#pragma unroll
                for (int i = 0; i < 2; ++i) { int R, C; stage_rc(t2_ * 16 + i * 8192, R, C);
#pragma unroll
                    for (int h = 0; h < 2; ++h) vN[h][i] = tok_[h][i] * (unsigned)(K * 2) + (unsigned)C * 2u; } }
            else {
#pragma unroll
                for (int h = 0; h < 2; ++h)
#pragma unroll
                    for (int i = 0; i < 2; ++i) vN[h][i] = vA[h][i];
            }
        }
        {
            const char* a1 = cA + (size_t)(nt - 1) * kstep;
            const char* a3 = nA + kstep; const char* b3 = nB + kstep;
            PG8_KBODY(a1, nA, nB, a3, b3, vN[0][0], vN[0][1], vN[1][0], vN[1][1]);
        }
#undef PG8_KBODY
        if constexpr (ALIGN_EPI) { if (wr == 0) PG8_BAR; }
        { int t3_ = tid; asm volatile("" : "+v"(t3_)); const int l3_ = t3_ & 63; E(acc, cur, wr, wc, l3_ & 15, l3_ >> 4); }
        if (!has_next) break;
#pragma unroll
        for (int a = 0; a < 2; ++a)
#pragma unroll
            for (int b = 0; b < 2; ++b)
#pragma unroll
                for (int m = 0; m < 4; ++m)
#pragma unroll
                    for (int n = 0; n < 2; ++n) acc[a][b][m][n] = (f32x4){0.f, 0.f, 0.f, 0.f};
        cur = nxt; cA = nA; cB = nB; ++ui;
        if (GATHER) {
#pragma unroll
            for (int h = 0; h < 2; ++h)
#pragma unroll
                for (int i = 0; i < 2; ++i) vA[h][i] = vN[h][i];
        }
        if constexpr (ALIGN_EPI) { if (wr == 1) PG8_BAR; }
    }
    PG8_WAIT_V(0);
    if constexpr (!ALIGN_EPI) { if (wr == 0) PG8_BAR; }
    PG8_BAR;
#undef PG8_AOFFS
#undef PG8_SA
#undef PG8_SB
#undef PG8_STAGE
#undef PG8_LDA
#undef PG8_LDB
#undef PG8_MMA
#undef PG8_WAIT_V
#undef PG8_WAIT_L
#undef PG8_BAR
#undef PG8_SCHED
}


constexpr int TS_OFF = 131072 + 1024;
template <bool GATHER> struct MoeOrder {
    const char* A; const char* Bt; const int* rowtok; int nN, nwg, nM, G, c, K; size_t strideE;
    __device__ __forceinline__ void init(const bf16_t* A_, const bf16_t* Bt_, const int* rowtok_, int N, int K_, size_t strideE_, int G_, int c_) {
        A = (const char*)A_; Bt = (const char*)Bt_; rowtok = rowtok_; nN = N / BM; K = K_; strideE = strideE_; G = G_; c = c_;
        nM = __builtin_amdgcn_readfirstlane(((LAS const int*)(LDSP + TS_OFF))[32]); nwg = nM * nN; }
    __device__ __forceinline__ bool next(int i, GUnit& u) const {
        const long L = (long)i * G + c; if (L >= nwg) return false;
        int wgid = (int)L; { const int q = nwg / NXCD, r = nwg % NXCD, xcd = wgid % NXCD, off = wgid / NXCD; wgid = (xcd < r ? xcd * (q + 1) : r * (q + 1) + (xcd - r) * q) + off; }
        const int nig = WGM_MOE * nN, gid = wgid / nig, fm = gid * WGM_MOE, gsz = (nM - fm) < WGM_MOE ? (nM - fm) : WGM_MOE;
        u.pm = fm + ((wgid % nig) % gsz); u.pn = (wgid % nig) / gsz;
        LAS const int* ts = (LAS const int*)(LDSP + TS_OFF);
        const int e = __builtin_amdgcn_readfirstlane(ts[72 + u.pm]);
        u.e = e; u.row0 = (u.pm - __builtin_amdgcn_readfirstlane(ts[e])) * BM; u.cnt = __builtin_amdgcn_readfirstlane(ts[33 + e]);
        u.A = GATHER ? A : A + (size_t)u.pm * BM * K * 2;
        u.B = Bt + (size_t)e * strideE + (size_t)u.pn * BM * K * 2; return true;
    }
    __device__ __forceinline__ unsigned aoff(const GUnit& u, int row) const {
        if (GATHER) { int sl = u.row0 + row; sl = sl < u.cnt ? sl : u.cnt - 1; return (unsigned)rowtok[u.e * ECAP + sl] * (unsigned)(K * 2); }
        return (unsigned)(row * K * 2);
    }
    __device__ __forceinline__ unsigned tokoff(const GUnit& u, int row) const { int sl = u.row0 + row; sl = sl < u.cnt ? sl : u.cnt - 1; return (unsigned)(u.e * ECAP + sl) * 4u; }
    __device__ __forceinline__ const int* tokbase() const { return rowtok; }
};
__device__ __forceinline__ void moe_tiles(const unsigned* cnt, int tid) {
    LAS int* ts = (LAS int*)(LDSP + TS_OFF);
    if (tid == 0) { int s = 0; for (int e = 0; e < NEXP; ++e) { const int c = (int)cnt[e]; ts[e] = s; ts[33 + e] = c; const int n = (c + BM - 1) / BM;
_Pragma("clang loop vectorize(disable) unroll(disable)") for (int t = 0; t < n; ++t) ts[72 + s + t] = e;
            s += n; } ts[NEXP] = s; }
    __syncthreads();
}
struct EpiMoe1 {
    static constexpr bool PERM = true;
    bf16_t* O; const float* b1; const float* rsc;
    __device__ __forceinline__ void operator()(const f32x4 (&acc)[2][2][4][2], const GUnit& u, int wr, int wc, int fr, int fq) const {
        const int rt0 = wr * 64 + fr, col0 = u.pn * 128 + wc * 32 + 8 * fq;
        const float* bg = b1 + (size_t)u.e * 2048 + col0;
        f32x4 bgv[2], blv[2];
#pragma unroll
        for (int n = 0; n < 2; ++n) { bgv[n] = *(const f32x4*)(bg + 4 * n); blv[n] = *(const f32x4*)(bg + DFF + 4 * n); }
#pragma unroll
        for (int ai = 0; ai < 2; ++ai)
#pragma unroll
            for (int m = 0; m < 4; ++m) {
                const int rt = rt0 + ai * HALF + m * 16; int sl = u.row0 + rt; sl = sl < u.cnt ? sl : u.cnt - 1;
                const float r = rsc[u.e * ECAP + sl];
                float o[8];
                const f32x2 r2 = (f32x2){r, r};
#pragma unroll
                for (int n = 0; n < 2; ++n)
#pragma unroll
                    for (int jp = 0; jp < 2; ++jp) {
                        const f32x2 ag = (f32x2){acc[ai][0][m][n][2 * jp], acc[ai][0][m][n][2 * jp + 1]}, al = (f32x2){acc[ai][1][m][n][2 * jp], acc[ai][1][m][n][2 * jp + 1]};
                        f32x2 g = ag * r2 + (f32x2){bgv[n][2 * jp], bgv[n][2 * jp + 1]}, l = al * r2 + (f32x2){blv[n][2 * jp], blv[n][2 * jp + 1]};
                        g.x = fminf(g.x, 7.f); g.y = fminf(g.y, 7.f);
                        l.x = __builtin_amdgcn_fmed3f(l.x, -7.f, 7.f); l.y = __builtin_amdgcn_fmed3f(l.y, -7.f, 7.f);
                        const f32x2 z = g * (-2.4554669595930157f);
                        f32x2 e; e.x = __builtin_amdgcn_exp2f(z.x); e.y = __builtin_amdgcn_exp2f(z.y);
                        e = e + 1.0f;
                        f32x2 q; q.x = __builtin_amdgcn_rcpf(e.x); q.y = __builtin_amdgcn_rcpf(e.y);
                        const f32x2 v = (g * q) * (l + 1.0f);
                        o[n * 4 + 2 * jp] = v.x; o[n * 4 + 2 * jp + 1] = v.y;
                    }
                u32x4 w; w.x = cvt_pk_bf16(o[0], o[1]); w.y = cvt_pk_bf16(o[2], o[3]); w.z = cvt_pk_bf16(o[4], o[5]); w.w = cvt_pk_bf16(o[6], o[7]);
                *(u32x4*)(O + (size_t)(u.pm * BM + rt) * DFF + col0) = w;
            }
    }
};
struct EpiMoe2 {
    static constexpr bool PERM = true;
    bf16_t* O; const float* b2;
    __device__ __forceinline__ void operator()(const f32x4 (&acc)[2][2][4][2], const GUnit& u, int wr, int wc, int fr, int fq) const {
        const int row0 = u.pm * BM + wr * 64 + fr, col0 = u.pn * BM + wc * 32 + 8 * fq;
        f32x4 bv[2][2];
#pragma unroll
        for (int bj = 0; bj < 2; ++bj)
#pragma unroll
            for (int n = 0; n < 2; ++n) bv[bj][n] = *(const f32x4*)(b2 + (size_t)u.e * DM + col0 + bj * HALF + 4 * n);
#pragma unroll
        for (int ai = 0; ai < 2; ++ai)
#pragma unroll
            for (int m = 0; m < 4; ++m) { bf16_t* rowp = O + (size_t)(row0 + ai * HALF + m * 16) * DM + col0;
#pragma unroll
                for (int bj = 0; bj < 2; ++bj) { const f32x4 v0 = acc[ai][bj][m][0] + bv[bj][0], v1 = acc[ai][bj][m][1] + bv[bj][1];
                    u32x4 w; w.x = cvt_pk_bf16(v0[0], v0[1]); w.y = cvt_pk_bf16(v0[2], v0[3]); w.z = cvt_pk_bf16(v1[0], v1[1]); w.w = cvt_pk_bf16(v1[2], v1[3]);
                    *(u32x4*)(rowp + bj * HALF) = w; } }
    }
};

__device__ __forceinline__ void p_transpose_r(const int wv, const float* W, int nmat, int K, int N, bf16_t* WT, const float* kgain, int gdiv, int mode, LAS unsigned char* lds, int it_begin, int it_end, int wrank, int wstride, int scr_pitch = 16384) {
    LTID();
    const int wave = wv, lane = tidx & 63;
    LAS float* scr = (LAS float*)(lds + wave * scr_pitch);
    const int nblk = N / 32, per_mat = (K / 64) * nblk, total = it_end, stride = wstride;
    const int lrow = lane >> 5, lcol = lane & 31;
#define TR_DECODE(item, mat_, kb_, nb_) const int mat_ = (item) / per_mat, r_ = (item) - mat_ * per_mat, g8_ = r_ >> 3, l8_ = r_ & 7, kb_ = 2 * (g8_ / (nblk >> 2)) + (l8_ & 1), nb_ = 4 * (g8_ % (nblk >> 2)) + (l8_ >> 1)
#define TR_ISSUE(item, dst) do { TR_DECODE(item, mat_, kb_, nb_); \
        const float* src_ = W + (size_t)mat_ * K * N + (size_t)(64 * kb_ + lrow) * N + 32 * nb_ + lcol; \
        _Pragma("unroll") for (int i = 0; i < 32; ++i) dst[i] = __builtin_nontemporal_load(src_ + (size_t)(2 * i) * N); } while (0)
    float v[32], vn[32], vnn[32];
    int it = it_begin + wrank;
    if (it < total) TR_ISSUE(it, v);
    if (it + stride < total) TR_ISSUE(it + stride, vn);
    while (it < total) {
        const int itn = it + stride, itnn = itn + stride;
        if (itnn < total) TR_ISSUE(itnn, vnn);
        TR_DECODE(it, mat, kb, nb); const int k0 = 64 * kb, n0 = 32 * nb;
#pragma unroll
        for (int i = 0; i < 32; ++i) scr[(2 * i + lrow) * 33 + lcol] = v[i];
        asm volatile("s_waitcnt lgkmcnt(0)" ::: "memory");
        int d0 = n0;
        if (mode == 1) { const int bj = n0 >> 10, rest = n0 & 1023, pn = rest >> 7, j = rest & 127; d0 = pn * 256 + bj * 128 + j; }
        const int c = lane & 7;
        f32x4 g0 = (f32x4){1.f, 1.f, 1.f, 1.f}, g1 = g0;
        if (kgain) { const float* gp = kgain + (size_t)(mat / gdiv) * DM + k0 + 8 * c; g0 = *(const f32x4*)gp; g1 = *(const f32x4*)(gp + 4); }
        bf16_t* dst = WT + (size_t)mat * K * N;
#pragma unroll
        for (int j = 0; j < 4; ++j) { const int n = (lane >> 3) + 8 * j; const LAS float* sp = scr + (8 * c) * 33 + n;
            u32x4 o; o.x = cvt_pk_bf16(sp[0 * 33] * g0[0], sp[1 * 33] * g0[1]); o.y = cvt_pk_bf16(sp[2 * 33] * g0[2], sp[3 * 33] * g0[3]); o.z = cvt_pk_bf16(sp[4 * 33] * g1[0], sp[5 * 33] * g1[1]); o.w = cvt_pk_bf16(sp[6 * 33] * g1[2], sp[7 * 33] * g1[3]);
            __builtin_nontemporal_store(o, (u32x4*)(dst + (size_t)(d0 + n) * K + k0 + 8 * c)); }
        asm volatile("s_waitcnt lgkmcnt(0)" ::: "memory");
#pragma unroll
        for (int i = 0; i < 32; ++i) { v[i] = vn[i]; vn[i] = vnn[i]; }
        it = itn;
    }
#undef TR_ISSUE
#undef TR_DECODE
}
__device__ __forceinline__ void p_transpose(const int wv, const float* W, int nmat, int K, int N, bf16_t* WT, const float* kgain, int gdiv, int mode, LAS unsigned char* lds, int rot) {
    const int G_ = (int)gridDim.x, b_ = ((int)blockIdx.x + G_ - rot % G_) % G_;
    p_transpose_r(wv, W, nmat, K, N, WT, kgain, gdiv, mode, lds, 0, nmat * (K / 64) * (N / 32), b_ * NW + wv, G_ * NW);
}
typedef short v4i16_t __attribute__((ext_vector_type(4)));
constexpr int ATT_TAB_OFF = 131072 + 2048;
constexpr int ATT_UNITS = 3 * 8 * 128;
__device__ __forceinline__ int t5_bucket_dev(int n) {
    if (n < 16) return n;
    const float v = logf((float)n / 16.f) / 4.852030263919617f * 16.f;
    const int large = 16 + (int)v;
    return large < 31 ? large : 31;
}
__device__ __forceinline__ void p_bias_table(const int wv, const float* rel_bias, float* biasG, int rot) {
    LTID();
    for (int i = ROTB(rot) * NT + tidx; i < 3 * 8 * 132; i += gridDim.x * NT) {
        const int d = i % 132, bh = i / 132, h = bh & 7, b = bh >> 3;
        biasG[i] = (d <= 128) ? rel_bias[t5_bucket_dev(d << (2 * b)) * 8 + h] * 1.4426950408889634f : 0.f;
    }
}
__device__ __forceinline__ void p_dil_attn(const int wv, const bf16_t* proj16, const float* biasG, bf16_t* obr, float* lse, LAS unsigned char* lds) {
    LTID();
    const int lane = tidx & 63, fr = lane & 15, fq = lane >> 4, w = wv;
    const int per = (ATT_UNITS + (int)gridDim.x - 1) / (int)gridDim.x;
    const int u0 = bidx * per, u1 = (u0 + per < ATT_UNITS) ? u0 + per : ATT_UNITS;
    if (u0 >= u1) return;
    const int rowl = tidx >> 3, cs = tidx & 7;
    const unsigned cK = (unsigned)(cs ^ ((rowl >> 1) & 7)) * 16u, cV = (unsigned)(cs ^ (rowl & 7)) * 16u;
    const unsigned fK = (unsigned)((fr >> 1) & 7);
    const unsigned kro0 = (unsigned)fr * 128u + (((unsigned)fq ^ fK) * 16u), kro1 = (unsigned)fr * 128u + ((((unsigned)fq ^ fK) ^ 4u) * 16u);
    const int tq = (lane & 15) >> 2, tp = lane & 3, fv = 4 * (fq & 1) + tq;
    unsigned vro[4];
#pragma unroll
    for (int db = 0; db < 4; ++db) vro[db] = (unsigned)(4 * fq + tq) * 128u + (unsigned)(((2 * db + (tp >> 1)) ^ fv) * 16) + 8u * (unsigned)(tp & 1);
    const int ts_ = (1 + fr) & 3;
    const unsigned tab8 = (unsigned)ATT_TAB_OFF + (unsigned)ts_ * 640u + (unsigned)(((141 + fr - ts_) >> 2) - fq - 32) * 16u;
    const char* gbase = (const char*)proj16;
#define ATT_DECODE(u, b_, h_, r_, n_, dil_) const int cmb_ = (u) >> 7, b_ = cmb_ >> 3, h_ = cmb_ & 7, dil_ = 1 << (2 * b_), idx_ = (u) & 127, r_ = idx_ & (dil_ - 1), n_ = idx_ >> (2 * b_)
#define ATT_ISSUE(u, bf, q0, q1) do { ATT_DECODE(u, b__, h__, r__, n__, dil__); \
        const int nk = n__ > 0 ? n__ - 1 : 0;                                     \
        _Pragma("unroll") for (int p = 0; p < 4; ++p) { \
            int row = 64 * p + rowl; int blk = (row >> 7) ? n__ : nk; \
            const unsigned pos = (unsigned)(r__ + dil__ * (128 * blk + (row & 127))); \
            const unsigned so = pos * 4096u + (unsigned)h__ * 128u; const unsigned ld_ = (unsigned)(size_t)(lds + (bf) * 65536 + p * 8192 + w * 1024); \
            glds16s(gbase, so + 1024u + cK, ld_); glds16s(gbase, so + 2048u + cV, ld_ + 32768u); } \
        const unsigned qpos = (unsigned)(r__ + dil__ * (128 * n__ + 16 * w + fr)); \
        const char* qsrc = gbase + (size_t)qpos * 4096u + (unsigned)h__ * 128u + (unsigned)fq * 16u; \
        q0 = *(const bf16x8*)(qsrc); q1 = *(const bf16x8*)(qsrc + 64); } while (0)
    bf16x8 qf0, qf1, qn0, qn1;
    ATT_ISSUE(u0, 0, qn0, qn1);
    int prev_cmb = -1;
    for (int u = u0; u < u1; ++u) {
        const int bf = (u - u0) & 1;
        if (u == u0) asm volatile("s_waitcnt vmcnt(0)" ::: "memory"); else asm volatile("s_waitcnt vmcnt(5)" ::: "memory");
        __builtin_amdgcn_s_barrier();
        qf0 = qn0; qf1 = qn1;
        if (u + 1 < u1) ATT_ISSUE(u + 1, bf ^ 1, qn0, qn1);
        ATT_DECODE(u, b, h, r, n, dil);
        if (cmb_ != prev_cmb) {
            prev_cmb = cmb_;
            for (int e = tidx; e < 4 * 160; e += NT) { const int sft = e / 160, k = e - sft * 160, idx = k + sft, dist = idx - 16;
                const float v = (dist >= 0 && dist <= 128) ? biasG[cmb_ * 132 + dist] : -1e30f;
                ((LAS float*)(lds + ATT_TAB_OFF))[sft * 160 + k] = v; }
            __syncthreads();
        }
        const LAS unsigned char* Kb = lds + bf * 65536; const LAS unsigned char* Vb = Kb + 32768;
        const int kb0 = w;
        f32x4 sc[9];
#pragma unroll
        for (int i = 0; i < 9; ++i) {
            const unsigned ko = (unsigned)(kb0 + i) * 2048u;
            const bf16x8 k0 = *(const LAS bf16x8*)(Kb + ko + kro0), k1 = *(const LAS bf16x8*)(Kb + ko + kro1);
            f32x4 a = (f32x4){0.f, 0.f, 0.f, 0.f};
            a = __builtin_amdgcn_mfma_f32_16x16x32_bf16(k0, qf0, a, 0, 0, 0);
            a = __builtin_amdgcn_mfma_f32_16x16x32_bf16(k1, qf1, a, 0, 0, 0);
            const f32x4 t = *(const LAS f32x4*)(lds + tab8 + 64 * (8 - i));
            a = a + (f32x4){t[3], t[2], t[1], t[0]};
            if (n == 0 && kb0 + i < 8) a = (f32x4){-1e30f, -1e30f, -1e30f, -1e30f};
            sc[i] = a;
        }
#pragma unroll
        for (int i = 0; i < 9; ++i)
#pragma unroll
            for (int j = 0; j < 4; ++j) sc[i][j] = __builtin_amdgcn_exp2f(fminf(sc[i][j], 100.f));
        f32x4 oacc[4]; f32x4 sacc = (f32x4){0.f, 0.f, 0.f, 0.f};
        const bf16x8 ones = (bf16x8){0x3F80, 0x3F80, 0x3F80, 0x3F80, 0x3F80, 0x3F80, 0x3F80, 0x3F80};
#pragma unroll
        for (int db = 0; db < 4; ++db) oacc[db] = (f32x4){0.f, 0.f, 0.f, 0.f};
#pragma unroll
        for (int c = 0; c < 5; ++c) {
            const int ia = 2 * c, ib = (c < 4) ? 2 * c + 1 : 8;
            u32x4 pw; pw.x = cvt_pk_bf16(sc[ia][0], sc[ia][1]); pw.y = cvt_pk_bf16(sc[ia][2], sc[ia][3]);
            if (c < 4) { pw.z = cvt_pk_bf16(sc[ib][0], sc[ib][1]); pw.w = cvt_pk_bf16(sc[ib][2], sc[ib][3]); } else { pw.z = 0u; pw.w = 0u; }
            const bf16x8 pf = __builtin_bit_cast(bf16x8, pw);
            const unsigned va = (unsigned)(kb0 + ia) * 2048u, vb = (unsigned)(kb0 + ib) * 2048u;
            sacc = __builtin_amdgcn_mfma_f32_16x16x32_bf16(ones, pf, sacc, 0, 0, 0);
#pragma unroll
            for (int db = 0; db < 4; ++db) {
                const v4i16_t x0 = __builtin_amdgcn_ds_read_tr16_b64_v4i16((LAS v4i16_t*)(Vb + va + vro[db]));
                const v4i16_t x1 = __builtin_amdgcn_ds_read_tr16_b64_v4i16((LAS v4i16_t*)(Vb + vb + vro[db]));
                const bf16x8 vf = (bf16x8){x0[0], x0[1], x0[2], x0[3], x1[0], x1[1], x1[2], x1[3]};
                oacc[db] = __builtin_amdgcn_mfma_f32_16x16x32_bf16(vf, pf, oacc[db], 0, 0, 0);
            }
        }
        const float sum = sacc[0];
        const float inv = 1.f / sum;
        const unsigned qpos = (unsigned)(r + dil * (128 * n + 16 * w + fr));
        bf16_t* orow = obr + ((size_t)b * SEQ + qpos) * 512 + h * 64 + 4 * fq;
#pragma unroll
        for (int db = 0; db < 4; ++db) { u32x2 o2; o2.x = cvt_pk_bf16(oacc[db][0] * inv, oacc[db][1] * inv); o2.y = cvt_pk_bf16(oacc[db][2] * inv, oacc[db][3] * inv); *(u32x2*)(orow + 16 * db) = o2; }
        if (fq == 0) lse[((size_t)b * SEQ + qpos) * 8 + h] = sum;
    }
    asm volatile("s_waitcnt vmcnt(0)" ::: "memory");
    __syncthreads();
#undef ATT_DECODE
#undef ATT_ISSUE
}
__device__ __forceinline__ void p_attn_combine(const int wv, const bf16_t* obr, const float* lse, const float* g, bf16_t* mix16) {
    LTID();
    const int lane = tidx & 63, h = lane >> 3;
    const f32x4 g0 = *(const f32x4*)(g + lane * 8), g1 = *(const f32x4*)(g + lane * 8 + 4);
    const int rstride = (int)gridDim.x * NW;
    for (int row0 = bidx * NW + wv; row0 < SEQ; row0 += 4 * rstride) {
        float lv[4][3]; u32x4 av[4][3];
#pragma unroll
        for (int r = 0; r < 4; ++r) { const int row = (row0 + r * rstride < SEQ) ? row0 + r * rstride : row0;
#pragma unroll
            for (int b = 0; b < 3; ++b) { lv[r][b] = lse[((size_t)b * SEQ + row) * 8 + h]; av[r][b] = *(const u32x4*)(obr + ((size_t)b * SEQ + row) * 512 + lane * 8); } }
#pragma unroll
        for (int r = 0; r < 4; ++r) {
            const int row = row0 + r * rstride;
            float w0 = lv[r][0], w1 = lv[r][1], w2 = lv[r][2];
            const float iw = 1.f / (w0 + w1 + w2); w0 *= iw; w1 *= iw; w2 *= iw;
            float y[8]; float ss = 0.f;
#pragma unroll
            for (int k = 0; k < 4; ++k) {
                const float lo = w0 * __builtin_bit_cast(float, av[r][0][k] << 16) + w1 * __builtin_bit_cast(float, av[r][1][k] << 16) + w2 * __builtin_bit_cast(float, av[r][2][k] << 16);
                const float hi = w0 * __builtin_bit_cast(float, av[r][0][k] & 0xffff0000u) + w1 * __builtin_bit_cast(float, av[r][1][k] & 0xffff0000u) + w2 * __builtin_bit_cast(float, av[r][2][k] & 0xffff0000u);
                y[2 * k] = lo; y[2 * k + 1] = hi; ss += lo * lo + hi * hi;
            }
#pragma unroll
            for (int o = 32; o; o >>= 1) ss += shx(ss, o, lane);
            const float sc = rsqrtf(ss * (1.f / 512.f) + 1e-5f);
            u32x4 o4; o4.x = cvt_pk_bf16(y[0] * sc * g0[0], y[1] * sc * g0[1]); o4.y = cvt_pk_bf16(y[2] * sc * g0[2], y[3] * sc * g0[3]);
            o4.z = cvt_pk_bf16(y[4] * sc * g1[0], y[5] * sc * g1[1]); o4.w = cvt_pk_bf16(y[6] * sc * g1[2], y[7] * sc * g1[3]);
            if (row < SEQ) *(u32x4*)(mix16 + (size_t)row * DM + lane * 8) = o4;
        }
    }
}
struct EpiIn {
    static constexpr bool PERM = true;
    bf16_t* O;
    __device__ __forceinline__ void operator()(const f32x4 (&acc)[2][2][4][2], const GUnit& u, int wr, int wc, int fr, int fq) const {
        const int row0 = u.pm * BM + wr * 64 + fr, col0 = u.pn * BM + wc * 32 + 8 * fq;
        const float sc = u.pn < 2 ? 0.18033688011112042f : 1.f;
#pragma unroll
        for (int ai = 0; ai < 2; ++ai)
#pragma unroll
            for (int m = 0; m < 4; ++m) { const size_t ro = (size_t)(row0 + ai * HALF + m * 16) * DIN + col0;
#pragma unroll
                for (int bj = 0; bj < 2; ++bj) { const f32x4 v0 = acc[ai][bj][m][0] * sc, v1 = acc[ai][bj][m][1] * sc;
                    u32x4 w; w.x = cvt_pk_bf16(v0[0], v0[1]); w.y = cvt_pk_bf16(v0[2], v0[3]); w.z = cvt_pk_bf16(v1[0], v1[1]); w.w = cvt_pk_bf16(v1[2], v1[3]);
                    *(u32x4*)(O + ro + bj * HALF) = w;
                    } }
    }
};


__device__ __forceinline__ unsigned xoff_b(unsigned row, unsigned ch) { return 256u * row + 16u * (ch ^ (((row & 3u) << 2) | ((row >> 2) & 3u))); }
__device__ __forceinline__ void p_xattn_mfma(const int wv, const bf16_t* qx16, const bf16_t* kv16, bf16_t* ox16, LAS unsigned char* lds) {
    LTID();
    const int lane = tidx & 63, fr = lane & 15, fq = lane >> 4, w = wv;
    const int NU = 4 * 128;
    const int per = (NU + (int)gridDim.x - 1) / (int)gridDim.x;
    const int u0 = bidx * per, u1 = (u0 + per < NU) ? u0 + per : NU;
    if (u0 >= u1) return;
    const int rowl = tidx >> 4, cs = tidx & 15;
    const unsigned csw = (unsigned)(cs ^ (((rowl & 3) << 2) | ((rowl >> 2) & 3))) * 16u;
    const unsigned kswz = (unsigned)(((fr & 3) << 2) | ((fr >> 2) & 3));
    unsigned kro[4];
#pragma unroll
    for (int s4 = 0; s4 < 4; ++s4) kro[s4] = 256u * (unsigned)fr + 16u * ((unsigned)(4 * s4 + fq) ^ kswz);
    const int tq = (lane & 15) >> 2, tp = lane & 3;
    const unsigned vswz = (unsigned)((tq << 2) | fq);
    unsigned vro[8];
#pragma unroll
    for (int c = 0; c < 8; ++c) vro[c] = 65536u + 256u * (unsigned)(4 * fq + tq) + 16u * ((unsigned)(2 * c + (tp >> 1)) ^ vswz) + 8u * (unsigned)(tp & 1);
    int prev_h = -1;
    for (int u = u0; u < u1; ++u) {
        const int h = u >> 7, qt = u & 127;
        if (h != prev_h) {
            __syncthreads();
            prev_h = h;
#pragma unroll
            for (int p = 0; p < 8; ++p) {
                const unsigned row = (unsigned)(32 * p + rowl);
                const unsigned so = row * 2048u + (unsigned)h * 256u + csw;
                const unsigned ld_ = (unsigned)(size_t)(lds + p * 8192 + w * 1024);
                glds16s(kv16, so, ld_); glds16s(kv16, so + 1024u, ld_ + 65536u);
            }
            asm volatile("s_waitcnt vmcnt(0)" ::: "memory");
            __syncthreads();
        }
        const char* qsrc = (const char*)qx16 + ((size_t)(qt * 128 + 16 * w + fr) * 512 + h * 128 + 8 * fq) * 2;
        bf16x8 qf[4];
#pragma unroll
        for (int s4 = 0; s4 < 4; ++s4) qf[s4] = *(const bf16x8*)(qsrc + 64 * s4);
        f32x4 sc[16];
#pragma unroll
        for (int i = 0; i < 16; ++i) {
            f32x4 a = (f32x4){0.f, 0.f, 0.f, 0.f};
#pragma unroll
            for (int s4 = 0; s4 < 4; ++s4) { const bf16x8 kf = *(const LAS bf16x8*)(lds + i * 4096 + kro[s4]); a = __builtin_amdgcn_mfma_f32_16x16x32_bf16(kf, qf[s4], a, 0, 0, 0); }
            sc[i] = a;
        }
        float mx = -1e30f;
#pragma unroll
        for (int i = 0; i < 16; ++i) mx = fmaxf(mx, fmaxf(fmaxf(sc[i][0], sc[i][1]), fmaxf(sc[i][2], sc[i][3])));
        mx = fmaxf(mx, shx(mx, 16, lane)); mx = fmaxf(mx, shx(mx, 32, lane));
        float sum = 0.f;
#pragma unroll
        for (int i = 0; i < 16; ++i)
#pragma unroll
            for (int j = 0; j < 4; ++j) { const float p = __expf(sc[i][j] - mx); sc[i][j] = p; sum += p; }
        sum += shx(sum, 16, lane); sum += shx(sum, 32, lane);
        f32x4 oacc[8];
#pragma unroll
        for (int c = 0; c < 8; ++c) oacc[c] = (f32x4){0.f, 0.f, 0.f, 0.f};
#pragma unroll
        for (int ch = 0; ch < 8; ++ch) {
            const int ia = 2 * ch, ib = 2 * ch + 1;
            u32x4 pw; pw.x = cvt_pk_bf16(sc[ia][0], sc[ia][1]); pw.y = cvt_pk_bf16(sc[ia][2], sc[ia][3]); pw.z = cvt_pk_bf16(sc[ib][0], sc[ib][1]); pw.w = cvt_pk_bf16(sc[ib][2], sc[ib][3]);
            const bf16x8 pf = __builtin_bit_cast(bf16x8, pw);
#pragma unroll
            for (int c = 0; c < 8; ++c) {
                const v4i16_t x0 = __builtin_amdgcn_ds_read_tr16_b64_v4i16((LAS v4i16_t*)(lds + ia * 4096 + vro[c]));
                const v4i16_t x1 = __builtin_amdgcn_ds_read_tr16_b64_v4i16((LAS v4i16_t*)(lds + ib * 4096 + vro[c]));
                const bf16x8 vf = (bf16x8){x0[0], x0[1], x0[2], x0[3], x1[0], x1[1], x1[2], x1[3]};
                oacc[c] = __builtin_amdgcn_mfma_f32_16x16x32_bf16(vf, pf, oacc[c], 0, 0, 0);
            }
        }
        const float inv = 1.f / sum;
        bf16_t* orow = ox16 + (size_t)(qt * 128 + 16 * w + fr) * 512 + h * 128 + 4 * fq;
#pragma unroll
        for (int c = 0; c < 8; ++c) { u32x2 o2; o2.x = cvt_pk_bf16(oacc[c][0] * inv, oacc[c][1] * inv); o2.y = cvt_pk_bf16(oacc[c][2] * inv, oacc[c][3] * inv); *(u32x2*)(orow + 16 * c) = o2; }
    }
    __syncthreads();
}
struct EpiBf16 {
    static constexpr bool PERM = true;
    bf16_t* O; int ldc; float scale; const float* ss;
    __device__ __forceinline__ void operator()(const f32x4 (&acc)[2][2][4][2], const GUnit& u, int wr, int wc, int fr, int fq) const {
        const int row0 = u.pm * BM + wr * 64 + fr, col0 = u.pn * BM + wc * 32 + 8 * fq;
#pragma unroll
        for (int ai = 0; ai < 2; ++ai)
#pragma unroll
            for (int m = 0; m < 4; ++m) { const int row = row0 + ai * HALF + m * 16; bf16_t* rowp = O + (size_t)row * ldc + col0;
                float sc = scale;
                if (ss) { const f32x4 p0 = *(const f32x4*)(ss + (size_t)row * 16), p1 = *(const f32x4*)(ss + (size_t)row * 16 + 4), p2 = *(const f32x4*)(ss + (size_t)row * 16 + 8), p3 = *(const f32x4*)(ss + (size_t)row * 16 + 12);
                    const float t = ((p0[0] + p0[1]) + (p0[2] + p0[3])) + ((p1[0] + p1[1]) + (p1[2] + p1[3])) + ((p2[0] + p2[1]) + (p2[2] + p2[3])) + ((p3[0] + p3[1]) + (p3[2] + p3[3]));
                    sc = scale * rsqrtf(t * (1.f / 1024.f) + 1e-5f); }
#pragma unroll
                for (int bj = 0; bj < 2; ++bj) { const f32x4 v0 = acc[ai][bj][m][0] * sc, v1 = acc[ai][bj][m][1] * sc;
                    u32x4 w; w.x = cvt_pk_bf16(v0[0], v0[1]); w.y = cvt_pk_bf16(v0[2], v0[3]); w.z = cvt_pk_bf16(v1[0], v1[1]); w.w = cvt_pk_bf16(v1[2], v1[3]);
                    *(u32x4*)(rowp + bj * HALF) = w; } }
    }
};
struct EpiOut {
    static constexpr bool PERM = true;
    const float* R; float* H; bf16_t* HB; float* ss;
    __device__ __forceinline__ void operator()(const f32x4 (&acc)[2][2][4][2], const GUnit& u, int wr, int wc, int fr, int fq) const {
        const int row0 = u.pm * BM + wr * 64 + fr, col0 = u.pn * BM + wc * 32 + 8 * fq, lane = fq * 16 + fr;
#pragma unroll
        for (int ai = 0; ai < 2; ++ai)
#pragma unroll
            for (int m = 0; m < 4; ++m) { const int row = row0 + ai * HALF + m * 16; const size_t ro = (size_t)row * DM + col0; float sq = 0.f;
#pragma unroll
                for (int bj = 0; bj < 2; ++bj) {
                    const f32x4 v0 = acc[ai][bj][m][0] + *(const f32x4*)(R + ro + bj * HALF), v1 = acc[ai][bj][m][1] + *(const f32x4*)(R + ro + bj * HALF + 4);
                    *(f32x4*)(H + ro + bj * HALF) = v0; *(f32x4*)(H + ro + bj * HALF + 4) = v1;
                    u32x4 w; w.x = cvt_pk_bf16(v0[0], v0[1]); w.y = cvt_pk_bf16(v0[2], v0[3]); w.z = cvt_pk_bf16(v1[0], v1[1]); w.w = cvt_pk_bf16(v1[2], v1[3]);
                    *(u32x4*)(HB + ro + bj * HALF) = w;
                    sq += (v0[0] * v0[0] + v0[1] * v0[1]) + (v0[2] * v0[2] + v0[3] * v0[3]) + (v1[0] * v1[0] + v1[1] * v1[1]) + (v1[2] * v1[2] + v1[3] * v1[3]);
                }
                sq += shx(sq, 16, lane); sq += shx(sq, 32, lane);
                if (fq == 0) ss[(size_t)row * 16 + u.pn * 4 + wc] = sq;
            }
    }
};

typedef short bf16x4 __attribute__((ext_vector_type(4)));
constexpr int S5_CHUNK = 256, S5_NCH = SEQ / S5_CHUNK, S5_ROWB = 528;
__device__ __forceinline__ f32x2 gelu_pk(f32x2 v) {
    const f32x2 av = __builtin_elementwise_abs(v), d = av * 0.2316418882f + 1.0f;
    f32x2 t; t.x = __builtin_amdgcn_rcpf(d.x); t.y = __builtin_amdgcn_rcpf(d.y);
    f32x2 q = t * 0.5307027145f + (-0.7265760135f); q = q * t + 0.7107068705f; q = q * t + (-0.142248368f); q = q * t + 0.127414796f; q = q * t;
    const f32x2 s2 = (v * v) * (-0.72134752044f);
    f32x2 e; e.x = __builtin_amdgcn_exp2f(s2.x); e.y = __builtin_amdgcn_exp2f(s2.y);
    const f32x2 m = v * (q * e), r = v - m;
    f32x2 o; o.x = v.x < 0.f ? m.x : r.x; o.y = v.y < 0.f ? m.y : r.y; return o;
}
__device__ __forceinline__ void p_s5_tables2(const int wv, const float* a_re, const float* a_im, const float* b_re, const float* b_im, const float* c_re, const float* c_im, const float* log_dt,
                                             float2* abar, float2* a256, bf16_t* BB16, bf16_t* CM16, int rot) {
    LTID();
    for (int i = ROTB(rot) * NT + tidx; i < 2048 * 16; i += gridDim.x * NT) {
        const int gp = i >> 4, c = i & 15, g = gp >> 6, p = gp & 63;
        const float lr = a_re[gp], li = a_im[gp], dt = expf(log_dt[g]);
        const float mag = expf(lr * dt); float sn, cs; sincosf(li * dt, &sn, &cs);
        const float ar = mag * cs, ai = mag * sn;
        if (c == 0) {
            abar[gp] = make_float2(ar, ai);
            float pr = ar, pi = ai;
            for (int k = 0; k < 8; ++k) { const float nr = pr * pr - pi * pi, ni = 2.f * pr * pi; pr = nr; pi = ni; }
            a256[gp] = make_float2(pr, pi);
        }
        const float nr = ar - 1.f, ni = ai, den = lr * lr + li * li;
        const float cr = (nr * lr + ni * li) / den, ci = (ni * lr - nr * li) / den;
        const float br = b_re[gp * 16 + c], bi = b_im[gp * 16 + c];
        BB16[((size_t)g * 128 + p) * 16 + c] = (bf16_t)f2bf(cr * br - ci * bi);
        BB16[((size_t)g * 128 + 64 + p) * 16 + c] = (bf16_t)f2bf(cr * bi + ci * br);
        CM16[((size_t)g * 16 + c) * 128 + p] = (bf16_t)f2bf(c_re[(g * 16 + c) * 64 + p]);
        CM16[((size_t)g * 16 + c) * 128 + 64 + p] = (bf16_t)f2bf(-c_im[(g * 16 + c) * 64 + p]);
    }
}
template <int MODE> __device__ __forceinline__ void p_s5_pass(const int wv, const bf16_t* proj16, const float2* abar, const float2* a256, const bf16_t* BB16, const bf16_t* CM16, const float* dskip,
                                                              float2* E, bf16_t* yg16, LAS unsigned char* lds) {
    LTID();
    const int lane = tidx & 63, fr = lane & 15, fq = lane >> 4;
    LAS unsigned char* L = lds + wv * (16 * S5_ROWB);
    for (int unit = bidx * NW + wv; unit < S5_NCH * 32; unit += gridDim.x * NW) {
        const int g = unit & 31, chunk = unit >> 5;
        const float2 a = abar[g * 64 + lane];
        bf16x4 bbf[8];
#pragma unroll
        for (int cb = 0; cb < 8; ++cb) bbf[cb] = *(const bf16x4*)(BB16 + ((size_t)g * 128 + 16 * cb + fr) * 16 + 4 * fq);
        bf16x8 cmf[4]; f32x4 dsk = (f32x4){0.f, 0.f, 0.f, 0.f};
        if (MODE == 1) {
#pragma unroll
            for (int s4 = 0; s4 < 4; ++s4) cmf[s4] = *(const bf16x8*)(CM16 + ((size_t)g * 16 + fr) * 128 + 32 * s4 + 8 * fq);
            dsk = *(const f32x4*)(dskip + g * 16 + 4 * fq);
        }
        float sr = 0.f, si = 0.f;
        if (MODE == 1) {
            const float2 A = a256[g * 64 + lane];
            for (int j0 = 0; j0 < chunk; j0 += 16) {
                float2 e[16];
#pragma unroll
                for (int k = 0; k < 16; ++k) { const int j = (j0 + k < chunk) ? j0 + k : chunk - 1; e[k] = E[((size_t)j * 32 + g) * 64 + lane]; }
#pragma unroll
                for (int k = 0; k < 16; ++k) if (j0 + k < chunk) { const float nr = A.x * sr - A.y * si + e[k].x, ni = A.x * si + A.y * sr + e[k].y; sr = nr; si = ni; }
            }
        }
        const bf16_t* ubase = proj16 + (size_t)(chunk * S5_CHUNK + fr) * DIN + 1536 + g * 16 + 4 * fq;
        bf16x4 uf = *(const bf16x4*)ubase;
#pragma unroll 1
        for (int blk = 0; blk < S5_CHUNK / 16; ++blk) {
            const bf16x4 ufn = *(const bf16x4*)(ubase + (size_t)((blk < S5_CHUNK / 16 - 1) ? (blk + 1) * 16 : blk * 16) * DIN);
            asm volatile("" ::: "memory");
#pragma unroll
            for (int cb = 0; cb < 8; ++cb) {
                const f32x4 d = __builtin_amdgcn_mfma_f32_16x16x16bf16_1k(bbf[cb], uf, (f32x4){0.f, 0.f, 0.f, 0.f}, 0, 0, 0);
                *(LAS f32x4*)(L + fr * S5_ROWB + (16 * cb + 4 * fq) * 4) = d;
            }
            asm volatile("" ::: "memory");
#pragma unroll
            for (int t = 0; t < 16; ++t) {
                const float re = *(const LAS float*)(L + t * S5_ROWB + lane * 4), im = *(const LAS float*)(L + t * S5_ROWB + 256 + lane * 4);
                const float nr = a.x * sr - a.y * si + re, ni = a.x * si + a.y * sr + im; sr = nr; si = ni;
                if (MODE == 1) { *(LAS bf16_t*)(L + t * S5_ROWB + lane * 2) = (bf16_t)f2bf(sr); *(LAS bf16_t*)(L + t * S5_ROWB + 128 + lane * 2) = (bf16_t)f2bf(si); }
            }
            asm volatile("" ::: "memory");
            if (MODE == 1) {
                f32x4 y = (f32x4){0.f, 0.f, 0.f, 0.f};
#pragma unroll
                for (int s4 = 0; s4 < 4; ++s4) { const bf16x8 sf = *(const LAS bf16x8*)(L + fr * S5_ROWB + 64 * s4 + 16 * fq); y = __builtin_amdgcn_mfma_f32_16x16x32_bf16(cmf[s4], sf, y, 0, 0, 0); }
                f32x4 v;
#pragma unroll
                for (int j = 0; j < 4; ++j) v[j] = y[j] + dsk[j] * bf2f((unsigned short)uf[j]);
                const f32x2 g0 = gelu_pk((f32x2){v[0], v[1]}), g1 = gelu_pk((f32x2){v[2], v[3]});
                u32x2 o2; o2.x = cvt_pk_bf16(g0.x, g0.y); o2.y = cvt_pk_bf16(g1.x, g1.y);
                *(u32x2*)(yg16 + (size_t)(chunk * S5_CHUNK + blk * 16 + fr) * 512 + g * 16 + 4 * fq) = o2;
            }
            asm volatile("" ::: "memory");
            uf = ufn;
        }
        if (MODE == 0) E[((size_t)chunk * 32 + g) * 64 + lane] = make_float2(sr, si);
    }
}
struct EpiGlu16 {
    static constexpr bool PERM = true;
    bf16_t* O; const bf16_t* Y; const float* bias;
    __device__ __forceinline__ void operator()(const f32x4 (&acc)[2][2][4][2], const GUnit& u, int wr, int wc, int fr, int fq) const {
        const int row0 = u.pm * BM + wr * 64 + fr, col0 = u.pn * BM + wc * 32 + 8 * fq;
        f32x4 bv[2][2];
#pragma unroll
        for (int bj = 0; bj < 2; ++bj)
#pragma unroll
            for (int n = 0; n < 2; ++n) bv[bj][n] = *(const f32x4*)(bias + col0 + bj * HALF + 4 * n);
#pragma unroll
        for (int ai = 0; ai < 2; ++ai)
#pragma unroll
            for (int m = 0; m < 4; ++m) { const size_t ro = (size_t)(row0 + ai * HALF + m * 16) * 512 + col0;
#pragma unroll
                for (int bj = 0; bj < 2; ++bj) {
                    const u32x4 yv = *(const u32x4*)(Y + ro + bj * HALF);
                    float o[8];
#pragma unroll
                    for (int n = 0; n < 2; ++n)
#pragma unroll
                        for (int j = 0; j < 4; ++j) { const unsigned wd = yv[n * 2 + (j >> 1)]; const float y = __builtin_bit_cast(float, (j & 1) ? (wd & 0xffff0000u) : (wd << 16));
                            o[n * 4 + j] = y / (1.f + __expf(-(acc[ai][bj][m][n][j] + bv[bj][n][j]))); }
                    u32x4 w; w.x = cvt_pk_bf16(o[0], o[1]); w.y = cvt_pk_bf16(o[2], o[3]); w.z = cvt_pk_bf16(o[4], o[5]); w.w = cvt_pk_bf16(o[6], o[7]);
                    *(u32x4*)(O + ro + bj * HALF) = w; } }
    }
};
__device__ __forceinline__ void p_ssm_norm(const int wv, const bf16_t* yb16, const float* g, bf16_t* mix16) {
    LTID();
    const int lane = tidx & 63;
    const f32x4 g0 = *(const f32x4*)(g + lane * 8), g1 = *(const f32x4*)(g + lane * 8 + 4);
    const int rstride = (int)gridDim.x * NW;
    for (int row0 = bidx * NW + wv; row0 < SEQ; row0 += 4 * rstride) {
        u32x4 av[4];
#pragma unroll
        for (int r = 0; r < 4; ++r) { const int row = (row0 + r * rstride < SEQ) ? row0 + r * rstride : row0; av[r] = *(const u32x4*)(yb16 + (size_t)row * 512 + lane * 8); }
#pragma unroll
        for (int r = 0; r < 4; ++r) {
            const int row = row0 + r * rstride;
            float y[8]; float ss = 0.f;
#pragma unroll
            for (int k = 0; k < 4; ++k) { y[2 * k] = __builtin_bit_cast(float, av[r][k] << 16); y[2 * k + 1] = __builtin_bit_cast(float, av[r][k] & 0xffff0000u); ss += y[2 * k] * y[2 * k] + y[2 * k + 1] * y[2 * k + 1]; }
#pragma unroll
            for (int o = 32; o; o >>= 1) ss += shx(ss, o, lane);
            const float sc = rsqrtf(ss * (1.f / 512.f) + 1e-5f);
            u32x4 o4; o4.x = cvt_pk_bf16(y[0] * sc * g0[0], y[1] * sc * g0[1]); o4.y = cvt_pk_bf16(y[2] * sc * g0[2], y[3] * sc * g0[3]);
            o4.z = cvt_pk_bf16(y[4] * sc * g1[0], y[5] * sc * g1[1]); o4.w = cvt_pk_bf16(y[6] * sc * g1[2], y[7] * sc * g1[3]);
            if (row < SEQ) *(u32x4*)(mix16 + (size_t)row * DM + 512 + lane * 8) = o4;
        }
    }
}

__device__ __forceinline__ void p_rmsnorm16(const int wv, const float* in, const float* g, bf16_t* out16, int rows, int rot) {
    LTID();
    const int lane = tidx & 63;
    for (int r = ROTB(rot) * NW + wv; r < rows; r += gridDim.x * NW) {
        f32x4 v[4]; float ss = 0.f;
#pragma unroll
        for (int j = 0; j < 4; ++j) { v[j] = *(const f32x4*)(in + (size_t)r * DM + 4 * lane + 256 * j); ss += (v[j][0] * v[j][0] + v[j][1] * v[j][1]) + (v[j][2] * v[j][2] + v[j][3] * v[j][3]); }
#pragma unroll
        for (int o = 32; o; o >>= 1) ss += shx(ss, o, lane);
        const float sc = rsqrtf(ss * (1.f / 1024.f) + 1e-5f);
#pragma unroll
        for (int j = 0; j < 4; ++j) { const f32x4 gg = *(const f32x4*)(g + 4 * lane + 256 * j); u32x2 o2; o2.x = cvt_pk_bf16(v[j][0] * sc * gg[0], v[j][1] * sc * gg[1]); o2.y = cvt_pk_bf16(v[j][2] * sc * gg[2], v[j][3] * sc * gg[3]);
            *(u32x2*)(out16 + (size_t)r * DM + 4 * lane + 256 * j) = o2; }
    }
}
template <bool MOE, bool LAST> __device__ __forceinline__ void p_rowfinish(const int wv, const float* hin, float* h, const bf16_t* mout, const int* eslot, const float* topg, const float* g, bf16_t* xn16, float* out) {
    LTID();
    const int lane = tidx & 63;
    LAS const int* ts = (LAS const int*)(LDSP + TS_OFF);
    const int rstride = (int)gridDim.x * NW;
    for (int r0 = bidx * NW + wv; r0 < SEQ; r0 += 2 * rstride) {
        int rr[2]; rr[0] = r0; rr[1] = (r0 + rstride < SEQ) ? r0 + rstride : r0;
        f32x4 v[2][4]; int4 es[2]; f32x4 gt[2]; u32x2 mo[2][4][4];
#pragma unroll
        for (int q = 0; q < 2; ++q) { if (MOE) { es[q] = *(const int4*)(eslot + rr[q] * 4); gt[q] = *(const f32x4*)(topg + rr[q] * 4); }
#pragma unroll
            for (int j = 0; j < 4; ++j) v[q][j] = *(const f32x4*)(hin + (size_t)rr[q] * DM + 4 * lane + 256 * j); }
        if (MOE) {
#pragma unroll
            for (int q = 0; q < 2; ++q) { const int esv[4] = {es[q].x, es[q].y, es[q].z, es[q].w};
#pragma unroll
                for (int k = 0; k < 4; ++k) { const int e = esv[k] >> 16, sl = esv[k] & 0xffff; const size_t row = (size_t)ts[e] * BM + sl;
#pragma unroll
                    for (int j = 0; j < 4; ++j) mo[q][k][j] = *(const u32x2*)(mout + row * DM + 4 * lane + 256 * j); } }
#pragma unroll
            for (int q = 0; q < 2; ++q)
#pragma unroll
                for (int k = 0; k < 4; ++k) { const float gk = gt[q][k];
#pragma unroll
                    for (int j = 0; j < 4; ++j) { const u32x2 o = mo[q][k][j];
                        v[q][j][0] += gk * __builtin_bit_cast(float, o.x << 16); v[q][j][1] += gk * __builtin_bit_cast(float, o.x & 0xffff0000u);
                        v[q][j][2] += gk * __builtin_bit_cast(float, o.y << 16); v[q][j][3] += gk * __builtin_bit_cast(float, o.y & 0xffff0000u); } }
        }
#pragma unroll
        for (int q = 0; q < 2; ++q) {
            if (q == 1 && r0 + rstride >= SEQ) break;
            const int r = rr[q];
            float ss = 0.f;
#pragma unroll
            for (int j = 0; j < 4; ++j) ss += (v[q][j][0] * v[q][j][0] + v[q][j][1] * v[q][j][1]) + (v[q][j][2] * v[q][j][2] + v[q][j][3] * v[q][j][3]);
#pragma unroll
            for (int o = 32; o; o >>= 1) ss += shx(ss, o, lane);
            const float sc = rsqrtf(ss * (1.f / 1024.f) + 1e-5f);
#pragma unroll
            for (int j = 0; j < 4; ++j) {
                const f32x4 gg = *(const f32x4*)(g + 4 * lane + 256 * j);
                if (!LAST) { if (h) *(f32x4*)(h + (size_t)r * DM + 4 * lane + 256 * j) = v[q][j];
                    u32x2 o2; o2.x = cvt_pk_bf16(v[q][j][0] * sc * gg[0], v[q][j][1] * sc * gg[1]); o2.y = cvt_pk_bf16(v[q][j][2] * sc * gg[2], v[q][j][3] * sc * gg[3]);
                    *(u32x2*)(xn16 + (size_t)r * DM + 4 * lane + 256 * j) = o2; }
                else *(f32x4*)(out + (size_t)r * DM + 4 * lane + 256 * j) = (f32x4){v[q][j][0] * sc * gg[0], v[q][j][1] * sc * gg[1], v[q][j][2] * sc * gg[2], v[q][j][3] * sc * gg[3]};
            }
        }
    }
}
__device__ __forceinline__ void p_router_tables(const int wv, const float* w_r, const float* g, bf16_t* WR16, int rot) {
    LTID();
    for (int i = ROTB(rot) * NT + tidx; i < 32 * 1024; i += gridDim.x * NT) {
        const int e = i >> 10, k = i & 1023;
        const float w = g[k] * w_r[k * 32 + e];
        const unsigned hi = f2bf(w); const float lo = w - __builtin_bit_cast(float, hi << 16);
        WR16[i] = (bf16_t)hi; WR16[32 * 1024 + i] = (bf16_t)f2bf(lo);
    }
}
constexpr int RT_CNT_OFF = 131072 + 4608;
constexpr int RT_XCH_OFF = 131072 + 5120;
__device__ __forceinline__ void p_router2(const int wv, const float* h, const bf16_t* WR16, const float* b_r, bf16_t* hb16, unsigned* gcnt, int* rowtok_e, float* rsc_e, int* eslot, float* topg, LAS unsigned char* lds) {
    LTID();
    const int lane = tidx & 63, fr = lane & 15, fq = lane >> 4, w = wv, tg = w & 3, kh = w >> 2;
#pragma unroll
    for (int part = 0; part < 2; ++part)
#pragma unroll
        for (int p = 0; p < 8; ++p) { const int row = 4 * p + (tidx >> 7), cs = tidx & 127;
            glds16s(WR16, (unsigned)(part * 65536 + row * 2048 + ((cs ^ (row & 15)) * 16)), (unsigned)(size_t)(lds + part * 65536 + p * 8192 + w * 1024)); }
    LAS int* lcnt = (LAS int*)(lds + RT_CNT_OFF);
    if (tidx < 64) lcnt[tidx] = 0;
    asm volatile("s_waitcnt vmcnt(0)" ::: "memory");
    __syncthreads();
    for (int it = bidx; it < SEQ / 64; it += gridDim.x) {
        const int token = it * 64 + 16 * tg + fr;
        const float* xr = h + (size_t)token * DM + 512 * kh + 8 * fq;
        bf16_t* hb = hb16 + (size_t)token * DM + 512 * kh + 8 * fq;
        f32x4 acc[2]; acc[0] = (f32x4){0.f, 0.f, 0.f, 0.f}; acc[1] = acc[0];
        float ss = 0.f;
#pragma unroll 4
        for (int s4 = 0; s4 < 16; ++s4) {
            const f32x4 x0 = *(const f32x4*)(xr + 32 * s4), x1 = *(const f32x4*)(xr + 32 * s4 + 4);
            ss += (x0[0] * x0[0] + x0[1] * x0[1]) + (x0[2] * x0[2] + x0[3] * x0[3]) + (x1[0] * x1[0] + x1[1] * x1[1]) + (x1[2] * x1[2] + x1[3] * x1[3]);
            u32x4 hw; hw.x = cvt_pk_bf16(x0[0], x0[1]); hw.y = cvt_pk_bf16(x0[2], x0[3]); hw.z = cvt_pk_bf16(x1[0], x1[1]); hw.w = cvt_pk_bf16(x1[2], x1[3]);
            *(u32x4*)(hb + 32 * s4) = hw;
            u32x4 lw;
            lw.x = cvt_pk_bf16(x0[0] - __builtin_bit_cast(float, hw.x << 16), x0[1] - __builtin_bit_cast(float, hw.x & 0xffff0000u));
            lw.y = cvt_pk_bf16(x0[2] - __builtin_bit_cast(float, hw.y << 16), x0[3] - __builtin_bit_cast(float, hw.y & 0xffff0000u));
            lw.z = cvt_pk_bf16(x1[0] - __builtin_bit_cast(float, hw.z << 16), x1[1] - __builtin_bit_cast(float, hw.z & 0xffff0000u));
            lw.w = cvt_pk_bf16(x1[2] - __builtin_bit_cast(float, hw.w << 16), x1[3] - __builtin_bit_cast(float, hw.w & 0xffff0000u));
            const bf16x8 xhi = __builtin_bit_cast(bf16x8, hw), xlo = __builtin_bit_cast(bf16x8, lw);
            const int c = 64 * kh + 4 * s4 + fq, slot = c ^ fr;
#pragma unroll
            for (int nb = 0; nb < 2; ++nb) {
                const bf16x8 whi = *(const LAS bf16x8*)(lds + (16 * nb + fr) * 2048 + slot * 16), wlo = *(const LAS bf16x8*)(lds + 65536 + (16 * nb + fr) * 2048 + slot * 16);
                acc[nb] = __builtin_amdgcn_mfma_f32_16x16x32_bf16(whi, xhi, acc[nb], 0, 0, 0);
                acc[nb] = __builtin_amdgcn_mfma_f32_16x16x32_bf16(whi, xlo, acc[nb], 0, 0, 0);
                acc[nb] = __builtin_amdgcn_mfma_f32_16x16x32_bf16(wlo, xhi, acc[nb], 0, 0, 0);
            }
        }
        ss += shx(ss, 16, lane); ss += shx(ss, 32, lane);
        LAS float* X = (LAS float*)(lds + RT_XCH_OFF) + (tg * 64 + lane) * 9;
        if (kh == 1) {
#pragma unroll
            for (int nb = 0; nb < 2; ++nb)
#pragma unroll
                for (int j = 0; j < 4; ++j) X[nb * 4 + j] = acc[nb][j];
            X[8] = ss;
        }
        __syncthreads();
        int ti[4] = {0, 0, 0, 0}, ls[4] = {0, 0, 0, 0}; float gv[4] = {0.f, 0.f, 0.f, 0.f}; float rs = 0.f;
        if (kh == 0) {
            float lv[8];
            ss += X[8];
            rs = rsqrtf(ss * (1.f / 1024.f) + 1e-5f);
#pragma unroll
            for (int nb = 0; nb < 2; ++nb)
#pragma unroll
                for (int j = 0; j < 4; ++j) lv[nb * 4 + j] = rs * (acc[nb][j] + X[nb * 4 + j]) + b_r[16 * nb + 4 * fq + j];
            float tv[4];
#pragma unroll
            for (int r = 0; r < 4; ++r) {
                float bv = -3.0e38f; int bi = 0;
#pragma unroll
                for (int q = 0; q < 8; ++q) { const int idx = 16 * (q >> 2) + 4 * fq + (q & 3); if (lv[q] > bv) { bv = lv[q]; bi = idx; } }
#pragma unroll
                for (int mk = 16; mk <= 32; mk <<= 1) { const float ov = shx(bv, mk, lane); const int oi = shxi(bi, mk, lane); if (ov > bv || (ov == bv && oi < bi)) { bv = ov; bi = oi; } }
                tv[r] = bv; ti[r] = bi;
#pragma unroll
                for (int q = 0; q < 8; ++q) { const int idx = 16 * (q >> 2) + 4 * fq + (q & 3); if (idx == bi) lv[q] = -3.0e38f; }
            }
            float sum = 0.f;
#pragma unroll
            for (int r = 0; r < 4; ++r) { gv[r] = __expf(tv[r] - tv[0]); sum += gv[r]; }
            const float inv = 1.f / sum;
#pragma unroll
            for (int r = 0; r < 4; ++r) gv[r] *= inv;
            if (fq == 0) {
#pragma unroll
                for (int r = 0; r < 4; ++r) ls[r] = __hip_atomic_fetch_add(&lcnt[ti[r]], 1, __ATOMIC_RELAXED, __HIP_MEMORY_SCOPE_WORKGROUP);
            }
        }
        __syncthreads();
        if (tidx < 32) { const int c = lcnt[tidx]; lcnt[32 + tidx] = c ? (int)__hip_atomic_fetch_add(gcnt + tidx, (unsigned)c, __ATOMIC_RELAXED, __HIP_MEMORY_SCOPE_AGENT) : 0; }
        __syncthreads();
        if (kh == 0 && fq == 0) {
            int es[4];
#pragma unroll
            for (int r = 0; r < 4; ++r) { const int e = ti[r], sl = lcnt[32 + e] + ls[r]; rowtok_e[e * ECAP + sl] = token; rsc_e[e * ECAP + sl] = rs; es[r] = (e << 16) | sl; }
            *(int4*)(eslot + token * 4) = make_int4(es[0], es[1], es[2], es[3]);
            *(f32x4*)(topg + token * 4) = (f32x4){gv[0], gv[1], gv[2], gv[3]};
        }
        __syncthreads();
        if (tidx < 32) lcnt[tidx] = 0;
    }
    __syncthreads();
}

constexpr int NPL = 13;
constexpr int NPHASES = 1 + 2 * NPL;
typedef const __attribute__((address_space(4))) Args* KA;
#define PHASE __device__ __forceinline__
#define KAP() ({ KA _t = a; asm volatile("" : "+s"(_t)); _t; })
#define WSP(T, off) ((T*)(a->ws + (off)))

constexpr int NIT = 49152, NIT1 = 32768;
constexpr int QS0 = 5, QS1 = 8, QG = 9, QX = 13;
struct ConvBounds { int S1, S2, S3, S4; };
__device__ __forceinline__ int cmin(int a, int b) { return a < b ? a : b; }
__device__ __forceinline__ ConvBounds conv_bounds(int G, int l) {
    ConvBounds b;
    const int Px = G > 128 ? G - 128 : G, Px0 = G > 136 ? G - 136 : G;
    b.S1 = cmin(NIT, G * 8 * QS0); b.S2 = cmin(NIT, b.S1 + G * 8 * QS1);
    b.S3 = cmin(NIT, b.S2 + Px * 8 * QG); b.S4 = cmin(NIT, b.S3 + (l == 0 ? Px0 : Px) * 8 * QX);
    return b;
}
__device__ __forceinline__ void conv_moe(KA a, const int wv, int l, int begin, int end, int rank, int nranks, int scr_pitch = 16384) {
    if (begin >= end) return;
    const int wr = rank * NW + wv, ws_ = nranks * NW;
    if (begin < NIT1) p_transpose_r(wv, a->in[26] + (size_t)l * NEXP * DM * 2048, NEXP, DM, 2048, WSP(bf16_t, WS_BT1) + (size_t)l * NEXP * 2048 * DM, a->in[23] + l * DM, NEXP, 1, LDSP, begin, cmin(end, NIT1), wr, ws_, scr_pitch);
    if (end > NIT1) { const int b2 = begin > NIT1 ? begin - NIT1 : 0;
        p_transpose_r(wv, a->in[28] + (size_t)l * NEXP * DFF * DM, NEXP, DFF, DM, WSP(bf16_t, WS_BT2) + (size_t)l * NEXP * DM * DFF, nullptr, 1, 0, LDSP, b2, end - NIT1, wr, ws_, scr_pitch); }
}
__device__ __forceinline__ int moe_T_lds() { return __builtin_amdgcn_readfirstlane(((LAS const int*)(LDSP + TS_OFF))[32]); }
PHASE void ph_init(KA a, const int wv) {
    p_rowfinish<false, false>(wv, a->in[0], nullptr, nullptr, nullptr, nullptr, a->in[3], WSP(bf16_t, WS_XN16), nullptr);
    p_bias_table(wv, a->in[2], WSP(float, WS_BIASG), 152);
    for (int l = 0; l < 2; ++l) {
        p_s5_tables2(wv, a->in[5] + l * 2048, a->in[6] + l * 2048, a->in[7] + l * 32768, a->in[8] + l * 32768, a->in[9] + l * 32768, a->in[10] + l * 32768, a->in[11] + l * 32,
                     WSP(float2, WS_ABAR) + l * 2048, WSP(float2, WS_A256) + l * 2048, WSP(bf16_t, WS_BB16) + (size_t)l * 32 * 128 * 16, WSP(bf16_t, WS_CM16) + (size_t)l * 32 * 16 * 128, 160 + 32 * l);
        p_rmsnorm16(wv, a->in[1], a->in[19] + l * DM, WSP(bf16_t, WS_MEMN16) + (size_t)l * NMEM * DM, NMEM, 224 + 16 * l);
        p_router_tables(wv, a->in[24] + (size_t)l * DM * 32, a->in[23] + l * DM, WSP(bf16_t, WS_WR16) + (size_t)l * 2 * 32 * 1024, 160 + 64 * l);
    }
    p_transpose(wv, a->in[4], 2, DM, DIN, WSP(bf16_t, WS_WT_IN), nullptr, 1, 0, LDSP, 0);
    p_transpose(wv, a->in[13], 2, 512, 512, WSP(bf16_t, WS_WT_GLU), nullptr, 1, 0, LDSP, 0);
    p_transpose(wv, a->in[17], 2, DM, DM, WSP(bf16_t, WS_WT_OUT), nullptr, 1, 0, LDSP, 32);
    p_transpose(wv, a->in[20], 2, DM, 512, WSP(bf16_t, WS_WT_XQ), a->in[18], 1, 0, LDSP, 160);
    p_transpose(wv, a->in[21], 2, DM, 1024, WSP(bf16_t, WS_WT_XKV), nullptr, 1, 0, LDSP, 224);
    p_transpose(wv, a->in[22], 2, 512, DM, WSP(bf16_t, WS_WT_XO), nullptr, 1, 0, LDSP, 96);
    __syncthreads();
}
PHASE void ph_gemm_in(KA a, const int wv, int l) { LTID();
    DenseOrder S; S.init(WSP(bf16_t, WS_XN16), WSP(bf16_t, WS_WT_IN) + (size_t)l * DIN * DM, SEQ, DIN, DM, gridDim.x, bidx);
    EpiIn E{WSP(bf16_t, WS_PROJ16)};
    gemm_phase<EpiIn, DenseOrder, false, true>(LDSP, DM, S, E, tidx, wv);
}
PHASE void ph_attn_s5a(KA a, const int wv, int l) {
    p_dil_attn(wv, WSP(bf16_t, WS_PROJ16), WSP(float, WS_BIASG), WSP(bf16_t, WS_OBR), WSP(float, WS_LSE), LDSP);
    const ConvBounds cb = conv_bounds((int)gridDim.x, l);
    if (wv & 1) conv_moe(a, wv, l, 0, cb.S1, (int)blockIdx.x, (int)gridDim.x, 16 * S5_ROWB);
    p_s5_pass<0>(wv, WSP(bf16_t, WS_PROJ16), WSP(float2, WS_ABAR) + l * 2048, WSP(float2, WS_A256) + l * 2048, WSP(bf16_t, WS_BB16) + (size_t)l * 32 * 128 * 16, WSP(bf16_t, WS_CM16) + (size_t)l * 32 * 16 * 128,
                 a->in[12] + l * 512, WSP(float2, WS_E2), WSP(bf16_t, WS_YG16), LDSP);
    if (!(wv & 1)) conv_moe(a, wv, l, 0, cb.S1, (int)blockIdx.x, (int)gridDim.x, 16 * S5_ROWB);
}
PHASE void ph_s5b(KA a, const int wv, int l) {
    const ConvBounds cb = conv_bounds((int)gridDim.x, l);
    if (wv & 1) conv_moe(a, wv, l, cb.S1, cb.S2, (int)blockIdx.x, (int)gridDim.x, 16 * S5_ROWB);
    p_s5_pass<1>(wv, WSP(bf16_t, WS_PROJ16), WSP(float2, WS_ABAR) + l * 2048, WSP(float2, WS_A256) + l * 2048, WSP(bf16_t, WS_BB16) + (size_t)l * 32 * 128 * 16, WSP(bf16_t, WS_CM16) + (size_t)l * 32 * 16 * 128,
                 a->in[12] + l * 512, WSP(float2, WS_E2), WSP(bf16_t, WS_YG16), LDSP);
    if (!(wv & 1)) conv_moe(a, wv, l, cb.S1, cb.S2, (int)blockIdx.x, (int)gridDim.x, 16 * S5_ROWB);
}
PHASE void ph_gemm_glu(KA a, const int wv, int l) {
    {   LTID();
        DenseOrder S; S.init(WSP(bf16_t, WS_YG16), WSP(bf16_t, WS_WT_GLU) + (size_t)l * 512 * 512, SEQ, 512, 512, gridDim.x, bidx);
        EpiGlu16 E{WSP(bf16_t, WS_YB16), WSP(bf16_t, WS_YG16), a->in[14] + l * 512};
        gemm_phase<EpiGlu16, DenseOrder, false, false>(LDSP, 512, S, E, tidx, wv); }
    {   LTID();
        const int G = (int)gridDim.x; const ConvBounds cb = conv_bounds(G, l);
        if (G > 128) { if (bidx >= 128) conv_moe(a, wv, l, cb.S2, cb.S3, bidx - 128, G - 128); }
        else conv_moe(a, wv, l, cb.S2, cb.S3, bidx, G);
    }
}
PHASE void ph_mixnorm(KA a, const int wv, int l) {
    p_attn_combine(wv, WSP(bf16_t, WS_OBR), WSP(float, WS_LSE), a->in[15] + l * 512, WSP(bf16_t, WS_MIX16));
    p_ssm_norm(wv, WSP(bf16_t, WS_YB16), a->in[16] + l * 512, WSP(bf16_t, WS_MIX16));
}
PHASE void ph_gemm_out(KA a, const int wv, int l) { LTID();
    DenseOrder S; S.init(WSP(bf16_t, WS_MIX16), WSP(bf16_t, WS_WT_OUT) + (size_t)l * DM * DM, SEQ, DM, DM, gridDim.x, bidx);
    EpiOut E{l == 0 ? a->in[0] : (const float*)WSP(float, WS_H), WSP(float, WS_H), WSP(bf16_t, WS_HB16), WSP(float, WS_SSP)};
    gemm_phase<EpiOut, DenseOrder, false, false>(LDSP, DM, S, E, tidx, wv);
}
PHASE void ph_gemm_xq(KA a, const int wv, int l) {
    {   LTID();
        DenseOrder S; S.init(WSP(bf16_t, WS_HB16), WSP(bf16_t, WS_WT_XQ) + (size_t)l * 512 * DM, SEQ, 512, DM, gridDim.x, bidx);
        EpiBf16 E{WSP(bf16_t, WS_QX16), 512, 0.08838834764831845f, WSP(float, WS_SSP)};
        gemm_phase<EpiBf16, DenseOrder, false, false>(LDSP, DM, S, E, tidx, wv); }
    {   LTID();
    const int cc = (int)gridDim.x - 1 - bidx;
    if (l == 0 && cc < 8) {
        const int kl = cc >> 2;
        DenseOrder S; S.init(WSP(bf16_t, WS_MEMN16) + (size_t)kl * NMEM * DM, WSP(bf16_t, WS_WT_XKV) + (size_t)kl * 1024 * DM, NMEM, 1024, DM, 4, cc & 3);
        EpiBf16 E{WSP(bf16_t, WS_KV16) + (size_t)kl * NMEM * 1024, 1024, 1.f, nullptr};
        gemm_phase<EpiBf16, DenseOrder, false, false>(LDSP, DM, S, E, tidx, wv);
    } }
    {   LTID();
        const int G = (int)gridDim.x; const ConvBounds cb = conv_bounds(G, l);
        const int skip = (l == 0) ? 8 : 0;
        if (G > 128 + skip) { if (bidx >= 128 && bidx < G - skip) conv_moe(a, wv, l, cb.S3, cb.S4, bidx - 128, G - 128 - skip); }
        else conv_moe(a, wv, l, cb.S3, cb.S4, bidx, G);
    }
}
PHASE void ph_xattn(KA a, const int wv, int l) { p_xattn_mfma(wv, WSP(bf16_t, WS_QX16), WSP(bf16_t, WS_KV16) + (size_t)l * NMEM * 1024, WSP(bf16_t, WS_OX16), LDSP); }
PHASE void ph_gemm_xo(KA a, const int wv, int l) { LTID();
    DenseOrder S; S.init(WSP(bf16_t, WS_OX16), WSP(bf16_t, WS_WT_XO) + (size_t)l * DM * 512, SEQ, DM, 512, gridDim.x, bidx);
    EpiF32 E{WSP(float, WS_H), DM, 1};
    gemm_phase<EpiF32, DenseOrder, false, false>(LDSP, 512, S, E, tidx, wv);
}
PHASE void ph_router(KA a, const int wv, int l) {
    {   LTID();
        const int G = (int)gridDim.x; const ConvBounds cb = conv_bounds(G, l);
        conv_moe(a, wv, l, cb.S4, NIT, bidx, G);
        __syncthreads();
    }
    p_router2(wv, WSP(float, WS_H), WSP(bf16_t, WS_WR16) + (size_t)l * 2 * 32 * 1024, a->in[25] + l * 32, WSP(bf16_t, WS_HB16), WSP(unsigned, WS_CTL) + CW_CNT + l * 32,
              WSP(int, WS_ROWTOK), WSP(float, WS_RSC), WSP(int, WS_ESLOT), WSP(float, WS_TOPG), LDSP);
}
PHASE void ph_moe1(KA a, const int wv, int l) {
    {   LTID();
        moe_tiles(WSP(unsigned, WS_CTL) + CW_CNT + l * 32, tidx);
        MoeOrder<true> S; S.init(WSP(bf16_t, WS_HB16), WSP(bf16_t, WS_BT1) + (size_t)l * NEXP * 2048 * DM, WSP(int, WS_ROWTOK), 2048, DM, (size_t)2048 * DM * 2, gridDim.x, bidx);
        EpiMoe1 E{WSP(bf16_t, WS_ACT), a->in[27] + (size_t)l * NEXP * 2048, WSP(float, WS_RSC)};
        gemm_phase<EpiMoe1, MoeOrder<true>, true, true>(LDSP, DM, S, E, tidx, wv); }
}
PHASE void ph_moe2(KA a, const int wv, int l) {
    {   LTID();
        moe_tiles(WSP(unsigned, WS_CTL) + CW_CNT + l * 32, tidx);
        MoeOrder<false> S; S.init(WSP(bf16_t, WS_ACT), WSP(bf16_t, WS_BT2) + (size_t)l * NEXP * DM * DFF, nullptr, DM, DFF, (size_t)DM * DFF * 2, gridDim.x, bidx);
        EpiMoe2 E{WSP(bf16_t, WS_MOUT), a->in[29] + (size_t)l * NEXP * DM};
        gemm_phase<EpiMoe2, MoeOrder<false>, false, true>(LDSP, DFF, S, E, tidx, wv); }
}
PHASE void ph_combine(KA a, const int wv, int l) { LTID();
    moe_tiles(WSP(unsigned, WS_CTL) + CW_CNT + l * 32, tidx);
    if (l == 0) p_rowfinish<true, false>(wv, WSP(float, WS_H), WSP(float, WS_H), WSP(bf16_t, WS_MOUT), WSP(int, WS_ESLOT), WSP(float, WS_TOPG), a->in[3] + DM, WSP(bf16_t, WS_XN16), nullptr);
    else p_rowfinish<true, true>(wv, WSP(float, WS_H), nullptr, WSP(bf16_t, WS_MOUT), WSP(int, WS_ESLOT), WSP(float, WS_TOPG), a->in[30], nullptr, a->out);
}

__global__ void __launch_bounds__(NT, 2) mega(Args args) {
    KA a = (KA)__builtin_amdgcn_kernarg_segment_ptr();
    int wv = __builtin_amdgcn_readfirstlane((int)threadIdx.x >> 6); asm volatile("" : "+s"(wv));
    LAS unsigned char* lds = LDSP;
    volatile LAS unsigned* MISC = (volatile LAS unsigned*)(lds + MISC_OFF);
    unsigned* ctl = (unsigned*)(a->ws + WS_CTL);
    if (threadIdx.x < 32) MISC[threadIdx.x] = 0u;
    __syncthreads();
    XcdBarrier bar; bar.bar = ctl + CW_BAR; bar.x = 0; bar.st = nullptr;
    if (!MK_PER_PHASE) bar = xcd_barrier_post(ctl + CW_BAR, MISC + 8);
    const int lo = a->ph_lo, hi = a->ph_hi;
#define IN(k) (lo <= (k) && (k) < hi)
#define SEAM(k) do { if (IN(k) && IN((k) + 1)) { LTID(); xcd_barrier(bar.bar, bar.x, bar.st, tidx == 0); if (PROBE_DUP == 200) xcd_barrier(bar.bar, bar.x, bar.st, tidx == 0); } } while (0)
    if (IN(0)) { ph_init(KAP(), wv); if (PROBE_DUP == 100) ph_init(KAP(), wv); }
    SEAM(0);
#define LAYER_PROGRAM(l) { const int pb = 1 + (l) * NPL; \
        if (IN(pb + 0)) { ph_gemm_in(KAP(), wv, (l)); if (PROBE_DUP == 0) { ph_gemm_in(KAP(), wv, (l)); } } \
        SEAM(pb + 0); \
        if (IN(pb + 1)) { ph_attn_s5a(KAP(), wv, (l)); if (PROBE_DUP == 1) { ph_attn_s5a(KAP(), wv, (l)); } } \
        SEAM(pb + 1); \
        if (IN(pb + 2)) { ph_s5b(KAP(), wv, (l)); if (PROBE_DUP == 2) { ph_s5b(KAP(), wv, (l)); } } \
        SEAM(pb + 2); \
        if (IN(pb + 3)) { ph_gemm_glu(KAP(), wv, (l)); if (PROBE_DUP == 3) { ph_gemm_glu(KAP(), wv, (l)); } } \
        SEAM(pb + 3); \
        if (IN(pb + 4)) { ph_mixnorm(KAP(), wv, (l)); if (PROBE_DUP == 4) { ph_mixnorm(KAP(), wv, (l)); } } \
        SEAM(pb + 4); \
        if (IN(pb + 5)) { ph_gemm_out(KAP(), wv, (l)); if (PROBE_DUP == 5) { ph_gemm_out(KAP(), wv, (l)); } } \
        SEAM(pb + 5); \
        if (IN(pb + 6)) { ph_gemm_xq(KAP(), wv, (l)); if (PROBE_DUP == 6) { ph_gemm_xq(KAP(), wv, (l)); } } \
        SEAM(pb + 6); \
        if (IN(pb + 7)) { ph_xattn(KAP(), wv, (l)); if (PROBE_DUP == 7) { ph_xattn(KAP(), wv, (l)); } } \
        SEAM(pb + 7); \
        if (IN(pb + 8)) { ph_gemm_xo(KAP(), wv, (l)); if (PROBE_DUP == 8) { ph_gemm_xo(KAP(), wv, (l)); } } \
        SEAM(pb + 8); \
        if (IN(pb + 9)) { ph_router(KAP(), wv, (l)); if (PROBE_DUP == 9) { ph_router(KAP(), wv, (l)); } } \
        SEAM(pb + 9); \
        if (IN(pb + 10)) { ph_moe1(KAP(), wv, (l)); if (PROBE_DUP == 10) { ph_moe1(KAP(), wv, (l)); } } \
        SEAM(pb + 10); \
        if (IN(pb + 11)) { ph_moe2(KAP(), wv, (l)); if (PROBE_DUP == 11) { ph_moe2(KAP(), wv, (l)); } } \
        SEAM(pb + 11); \
        if (IN(pb + 12)) { ph_combine(KAP(), wv, (l)); if (PROBE_DUP == 12) { ph_combine(KAP(), wv, (l)); } } \
        SEAM(pb + 12); }
    LAYER_PROGRAM(0)
    LAYER_PROGRAM(1)
#undef LAYER_PROGRAM
#undef IN
#undef SEAM
}

extern "C" void kernel_launch(void* const* d_in, const int* in_sizes, int n_in, void* d_out, int out_size, void* d_ws, size_t ws_size, hipStream_t stream) {
    static int grid = 0;
    if (grid == 0) {
        if (n_in != 31 || ws_size < WS_END) { fprintf(stderr, "kernel_launch: unexpected n_in %d or ws_size %zu (need %zu)\n", n_in, ws_size, (size_t)WS_END); grid = -1; return; }
        int dev = 0, cus = 0, per_cu = 0;
        if (hipGetDevice(&dev) != hipSuccess || hipDeviceGetAttribute(&cus, hipDeviceAttributeMultiprocessorCount, dev) != hipSuccess) { grid = -1; return; }
        if (hipFuncSetAttribute((const void*)mega, hipFuncAttributeMaxDynamicSharedMemorySize, LDS_BYTES) != hipSuccess) { fprintf(stderr, "kernel_launch: hipFuncSetAttribute failed\n"); grid = -1; return; }
        if (hipOccupancyMaxActiveBlocksPerMultiprocessor(&per_cu, (const void*)mega, NT, LDS_BYTES) != hipSuccess || per_cu < 1)
            fprintf(stderr, "kernel_launch: occupancy query reports %d workgroups per CU\n", per_cu);
        (void)hipGetLastError();
        grid = cus;
    }
    if (grid < 0) return;
    if (hipMemsetAsync((char*)d_ws + WS_CTL, 0, CTL_ZERO_BYTES, stream) != hipSuccess) return;
    Args a{};
    for (int i = 0; i < 31; ++i) a.in[i] = (const float*)d_in[i];
    a.out = (float*)d_out; a.ws = (unsigned char*)d_ws;
#if MK_PER_PHASE
    for (int p = 0; p < NPHASES; ++p) { a.ph_lo = p; a.ph_hi = p + 1; hipLaunchKernelGGL(mega, dim3(grid), dim3(NT), LDS_BYTES, stream, a); }
#else
    a.ph_lo = 0; a.ph_hi = NPHASES;
    hipLaunchKernelGGL(mega, dim3(grid), dim3(NT), LDS_BYTES, stream, a);
#endif
}
```

```cpp
#include <hip/hip_runtime.h>
#include <stdint.h>
#include <cstdio>

#ifndef PROBE_DUP
#define PROBE_DUP -1
#endif
#ifndef MK_PER_PHASE
#define MK_PER_PHASE 0
#endif

#define SEQ 16384
#define DM 1024
#define DIN 2048
#define NMEM 256
#define NEXP 32
#define TOPK 4
#define DFF 1024
#define NT 512
#define NW 8

#define LAS __attribute__((address_space(3)))
typedef float f32x4 __attribute__((ext_vector_type(4)));
typedef float f32x2 __attribute__((ext_vector_type(2)));
extern __shared__ __attribute__((aligned(16))) unsigned char lds_raw[];
#define LDSP ((LAS unsigned char*)lds_raw)
#define LTID() int z_ = 0; asm volatile("" : "+v"(z_)); const int lane_ = (int)__builtin_amdgcn_mbcnt_hi(~0u, __builtin_amdgcn_mbcnt_lo(~0u, (unsigned)z_)); \
    const int tidx = wv * 64 + lane_; int bidx = blockIdx.x; asm volatile("" : "+s"(bidx))
#define ROTB(rot) ((bidx + (int)gridDim.x - (rot) % (int)gridDim.x) % (int)gridDim.x)
__device__ __forceinline__ float shx(float v, int mask, int lane) { return __builtin_bit_cast(float, __builtin_amdgcn_ds_bpermute((lane ^ mask) << 2, __builtin_bit_cast(int, v))); }
__device__ __forceinline__ int shxi(int v, int mask, int lane) { return __builtin_amdgcn_ds_bpermute((lane ^ mask) << 2, v); }
constexpr int LDS_BYTES = 147456;
constexpr int MISC_OFF = 131072 + 320;

#define XB_TMO      128
#define XB_XCNT(j)  (256  + 64 * (j))
#define XB_XSUB(j)  (1280 + 64 * (j))
#define XB_XGEN(j)  (2304 + 64 * (j))
#define XB_TOP      3328
#define XB_TOPGEN   3392
#define XCD_BAR_WORDS 3456
#define XB_SPIN_CAP (1u << 18)

__device__ __forceinline__ unsigned xb_ld(unsigned* p)              { return __hip_atomic_load(p, __ATOMIC_RELAXED, __HIP_MEMORY_SCOPE_AGENT); }
__device__ __forceinline__ unsigned xb_add(unsigned* p, unsigned v) { return __hip_atomic_fetch_add(p, v, __ATOMIC_RELAXED, __HIP_MEMORY_SCOPE_AGENT); }
__device__ __forceinline__ unsigned xb_xcc_id() { return (unsigned)__builtin_amdgcn_s_getreg((3 << 11) | 20) & 0xFu; }
#define XB_SPIN(cond, bar) do { unsigned _sp = 0; while (cond) { __builtin_amdgcn_s_sleep(1); \
    if ((++_sp & 255u) == 0u) { if (xb_ld(&(bar)[XB_TMO])) break; if (_sp > XB_SPIN_CAP) { atomicAdd(&(bar)[XB_TMO], 1u); break; } } } } while (0)

struct XcdBarrier {
    unsigned* bar; unsigned x;
    volatile LAS unsigned* st;
};
__device__ __forceinline__ XcdBarrier xcd_barrier_post(unsigned* bar, volatile LAS unsigned* st) {
    XcdBarrier b; b.bar = bar; b.x = xb_xcc_id(); b.st = st;
    if (threadIdx.x == 0) (void)xb_add(&bar[XB_XCNT(b.x)], 1u);
    return b;
}
__device__ __forceinline__ void xcd_barrier_complete(unsigned* bar, unsigned x, unsigned& nloc, unsigned& nx) {
    const unsigned G = gridDim.x * gridDim.y * gridDim.z;
    unsigned sum, cnt, mine, sp = 0u;
    for (;;) {
        sum = 0u; cnt = 0u; mine = 0u;
#pragma unroll
        for (unsigned j = 0; j < 16; ++j) { const unsigned c = xb_ld(&bar[XB_XCNT(j)]); sum += c; cnt += (c > 0u) ? 1u : 0u; mine = (j == x) ? c : mine; }
        if (sum == G) break;
        __builtin_amdgcn_s_sleep(1);
        if ((++sp & 255u) == 0u) { if (xb_ld(&bar[XB_TMO])) break; if (sp > XB_SPIN_CAP) { atomicAdd(&bar[XB_TMO], 1u); break; } }
    }
    nloc = mine > 0u ? mine : 1u; nx = cnt > 0u ? cnt : 1u;
}
__device__ __noinline__ void xcd_barrier(unsigned* bar_, unsigned x_, volatile LAS unsigned* st_, int is_t0) {
    XcdBarrier b; b.bar = bar_; b.x = x_; b.st = st_;
    asm volatile("s_waitcnt vmcnt(0)" ::: "memory");
    __syncthreads();
    if (is_t0) {
        unsigned* bar = b.bar;
        __builtin_amdgcn_s_waitcnt(0);
        unsigned nloc = b.st[0], nx = b.st[1];
        if (nloc == 0u) { xcd_barrier_complete(bar, b.x, nloc, nx); b.st[0] = nloc; b.st[1] = nx; }
        const unsigned old = xb_add(&bar[XB_XSUB(b.x)], 1u);
        const unsigned gen = old / nloc;
        if (old + 1u == (gen + 1u) * nloc) {
            __builtin_amdgcn_fence(__ATOMIC_RELEASE, "agent");
            asm volatile("s_waitcnt vmcnt(0)" ::: "memory");
            const unsigned og = xb_add(&bar[XB_TOP], 1u);
            const unsigned tg = og / nx;
            if (og + 1u == (tg + 1u) * nx) xb_add(&bar[XB_TOPGEN], 1u);
            else XB_SPIN(xb_ld(&bar[XB_TOPGEN]) == tg, bar);
            __builtin_amdgcn_fence(__ATOMIC_ACQUIRE, "agent");
            xb_add(&bar[XB_XGEN(b.x)], 1u);
            asm volatile("s_waitcnt vmcnt(0)" ::: "memory");
        } else {
            XB_SPIN(xb_ld(&bar[XB_XGEN(b.x)]) == gen, bar);
            __builtin_amdgcn_fence(__ATOMIC_ACQUIRE, "agent");
            asm volatile("s_waitcnt vmcnt(0)" ::: "memory");
        }
    }
    __syncthreads();
}

constexpr size_t MiB = 1u << 20;
constexpr size_t WS_CTL = 0, CTL_ZERO_BYTES = 1 * MiB;
constexpr int CW_BAR = 4096;
constexpr int CW_CNT = 8192;
constexpr int MOE_ROWS = SEQ * TOPK + NEXP * 256;
constexpr int ECAP = SEQ;
constexpr size_t al256(size_t x) { return (x + 255) & ~(size_t)255; }
constexpr size_t WS_H = 2 * MiB;
constexpr size_t WS_XN16 = WS_H + (size_t)SEQ * DM * 4;
constexpr size_t WS_RS = WS_H;
constexpr size_t WS_HB16 = WS_XN16 + (size_t)SEQ * DM * 2;
constexpr size_t WS_PROJ16 = WS_HB16 + (size_t)SEQ * DM * 2;
constexpr size_t WS_OBR = WS_PROJ16 + (size_t)SEQ * 2048 * 2;
constexpr size_t WS_LSE = WS_OBR + 3 * (size_t)SEQ * 512 * 2;
constexpr size_t WS_YG16 = WS_LSE + 3 * (size_t)SEQ * 8 * 4;
constexpr size_t WS_YB16 = WS_YG16 + (size_t)SEQ * 512 * 2;
constexpr size_t WS_MIX16 = WS_YB16 + (size_t)SEQ * 512 * 2;
constexpr size_t WS_QX16 = WS_MIX16 + (size_t)SEQ * DM * 2;
constexpr size_t WS_OX16 = WS_QX16 + (size_t)SEQ * 512 * 2;
constexpr size_t WS_ACT = WS_OX16 + (size_t)SEQ * 512 * 2;
constexpr size_t WS_MOUT = WS_ACT + (size_t)MOE_ROWS * DFF * 2;
constexpr size_t WS_BT1 = WS_MOUT + (size_t)MOE_ROWS * DM * 2;
constexpr size_t WS_BT2 = WS_BT1 + 2 * (size_t)NEXP * 2048 * DM * 2;
constexpr size_t WS_WT_IN = WS_BT2 + 2 * (size_t)NEXP * DM * DFF * 2;
constexpr size_t WS_WT_GLU = WS_WT_IN + 2 * (size_t)2048 * 1024 * 2;
constexpr size_t WS_WT_OUT = WS_WT_GLU + 2 * (size_t)512 * 512 * 2;
constexpr size_t WS_WT_XQ = WS_WT_OUT + 2 * (size_t)1024 * 1024 * 2;
constexpr size_t WS_WT_XKV = WS_WT_XQ + 2 * (size_t)512 * 1024 * 2;
constexpr size_t WS_WT_XO = WS_WT_XKV + 2 * (size_t)1024 * 1024 * 2;
constexpr size_t WS_MEMN16 = WS_WT_XO + 2 * (size_t)1024 * 512 * 2;
constexpr size_t WS_KV16 = WS_MEMN16 + 2 * (size_t)NMEM * 1024 * 2;
constexpr size_t WS_WR16 = WS_KV16 + 2 * (size_t)NMEM * 1024 * 2;
constexpr size_t WS_BIASG = WS_WR16 + 2 * 2 * (size_t)32 * 1024 * 2;
constexpr size_t WS_ABAR = al256(WS_BIASG + 24 * 132 * 4);
constexpr size_t WS_A256 = WS_ABAR + 2 * 2048 * 8;
constexpr size_t WS_BB16 = WS_A256 + 2 * 2048 * 8;
constexpr size_t WS_CM16 = WS_BB16 + 2 * (size_t)32 * 128 * 16 * 2;
constexpr size_t WS_E2 = WS_CM16 + 2 * (size_t)32 * 16 * 128 * 2;
constexpr size_t WS_ROWTOK = WS_E2 + (size_t)64 * 2048 * 8;
constexpr size_t WS_RSC = WS_ROWTOK + (size_t)NEXP * ECAP * 4;
constexpr size_t WS_ESLOT = WS_RSC + (size_t)NEXP * ECAP * 4;
constexpr size_t WS_TOPG = WS_ESLOT + (size_t)SEQ * 4 * 4;
constexpr size_t WS_SSP = WS_TOPG + (size_t)SEQ * 4 * 4;
constexpr size_t WS_END = WS_SSP + (size_t)SEQ * 16 * 4;

struct Args { const float* in[31]; float* out; unsigned char* ws; int ph_lo, ph_hi; };


typedef unsigned short bf16_t;
typedef short bf16x8 __attribute__((ext_vector_type(8)));
typedef unsigned u32x4 __attribute__((ext_vector_type(4)));
typedef unsigned u32x2 __attribute__((ext_vector_type(2)));
constexpr int BM = 256, BK = 64, HALF = 128, HTB = HALF * BK * 2, STAGE_BYTES = 8 * HTB, NXCD = 8, WGM = 4, WGM_MOE = 1;
__host__ __device__ __forceinline__ int lds_byte(int r, int c) { const int st = (r >> 4) * 2 + (c >> 5), rr = r & 15, cc = c & 31, ob = rr * 64 + cc * 2; return st * 1024 + (ob ^ (((ob >> 9) & 1) << 5)); }
__host__ __device__ __forceinline__ void stage_rc(int b, int& R, int& C) { const int st = b / 1024, sb = b % 1024, swz = sb ^ (((sb >> 9) & 1) << 5); R = (st >> 1) * 16 + swz / 64; C = (st & 1) * 32 + (swz % 64) / 2; }
__host__ __device__ __forceinline__ int perm32(int rho) { const int n = rho >> 4, i = rho & 15; return 8 * (i >> 2) + 4 * n + (i & 3); }
__device__ __forceinline__ unsigned cvt_pk_bf16(float lo, float hi) { unsigned r; asm volatile("v_cvt_pk_bf16_f32 %0, %1, %2" : "=v"(r) : "v"(lo), "v"(hi)); return r; }
__device__ __forceinline__ unsigned f2bf(float f) { unsigned u = __builtin_bit_cast(unsigned, f); return (u + 0x7fffu + ((u >> 16) & 1u)) >> 16; }
__device__ __forceinline__ unsigned pk2(float lo, float hi) { return f2bf(lo) | (f2bf(hi) << 16); }
__device__ __forceinline__ float bf2f(unsigned short b) { return __builtin_bit_cast(float, ((unsigned)b) << 16); }

__device__ __forceinline__ void glds16s(const void* sbase, unsigned voff, unsigned lds_dst) {
    unsigned keep;
    asm volatile("s_mov_b32 %0, m0\n\ts_mov_b32 m0, %3\n\ts_nop 0\n\tglobal_load_lds_dwordx4 %1, %2\n\ts_mov_b32 m0, %0" : "=&s"(keep) : "v"(voff), "s"(sbase), "s"(lds_dst) : "memory");
}
struct GUnit { const char* A; const char* B; int pm, pn, e, row0, cnt; };

struct DenseOrder {
    const char* A; const char* Bt; int nM, nN, nwg, G, c, K;
    __device__ __forceinline__ void init(const bf16_t* A_, const bf16_t* Bt_, int M, int N, int K_, int G_, int c_) { A = (const char*)A_; Bt = (const char*)Bt_; nM = M / BM; nN = N / BM; nwg = nM * nN; G = G_; c = c_; K = K_; }
    __device__ __forceinline__ bool next(int i, GUnit& u) const {
        const long L = (long)i * G + c; if (L >= nwg) return false;
        int wgid = (int)L; { const int q = nwg / NXCD, r = nwg % NXCD, xcd = wgid % NXCD, off = wgid / NXCD; wgid = (xcd < r ? xcd * (q + 1) : r * (q + 1) + (xcd - r) * q) + off; }
        const int nig = WGM * nN, gid = wgid / nig, fm = gid * WGM, gsz = (nM - fm) < WGM ? (nM - fm) : WGM;
        u.pm = fm + ((wgid % nig) % gsz); u.pn = (wgid % nig) / gsz; u.e = 0; u.row0 = 0; u.cnt = 0;
        u.A = A + (size_t)u.pm * BM * K * 2; u.B = Bt + (size_t)u.pn * BM * K * 2; return true;
    }
    __device__ __forceinline__ unsigned aoff(const GUnit&, int row) const { return (unsigned)(row * K * 2); }
    __device__ __forceinline__ unsigned tokoff(const GUnit&, int) const { return 0u; }
    __device__ __forceinline__ const int* tokbase() const { return nullptr; }
};

struct EpiF32 {
    static constexpr bool PERM = false;
    float* C; int ldc; int resid;
    __device__ __forceinline__ void operator()(const f32x4 (&acc)[2][2][4][2], const GUnit& u, int wr, int wc, int fr, int fq) const {
        const int row0 = u.pm * BM + wr * 64 + fr, col0 = u.pn * BM + wc * 32 + 4 * fq;
#pragma unroll
        for (int ai = 0; ai < 2; ++ai)
#pragma unroll
            for (int m = 0; m < 4; ++m) { float* rowp = C + (size_t)(row0 + ai * HALF + m * 16) * ldc + col0;
#pragma unroll
                for (int bj = 0; bj < 2; ++bj)
#pragma unroll
                    for (int n = 0; n < 2; ++n) { f32x4 v = acc[ai][bj][m][n]; if (resid) v += *(const f32x4*)(rowp + bj * HALF + n * 16); *(f32x4*)(rowp + bj * HALF + n * 16) = v; } }
    }
};
struct EpiGlu {
    static constexpr bool PERM = false;
    float* C; const float* Y; int ldc; const float* bias;
    __device__ __forceinline__ void operator()(const f32x4 (&acc)[2][2][4][2], const GUnit& u, int wr, int wc, int fr, int fq) const {
        const int row0 = u.pm * BM + wr * 64 + fr, col0 = u.pn * BM + wc * 32 + 4 * fq;
#pragma unroll
        for (int ai = 0; ai < 2; ++ai)
#pragma unroll
            for (int m = 0; m < 4; ++m) { const size_t ro = (size_t)(row0 + ai * HALF + m * 16) * ldc + col0;
#pragma unroll
                for (int bj = 0; bj < 2; ++bj)
#pragma unroll
                    for (int n = 0; n < 2; ++n) { const f32x4 b = *(const f32x4*)(bias + col0 + bj * HALF + n * 16); const f32x4 y = *(const f32x4*)(Y + ro + bj * HALF + n * 16);
                        f32x4 v = acc[ai][bj][m][n] + b; f32x4 o;
#pragma unroll
                        for (int j = 0; j < 4; ++j) o[j] = y[j] / (1.f + __expf(-v[j]));
                        *(f32x4*)(C + ro + bj * HALF + n * 16) = o; } }
    }
};

template <class Epi, class Sched, bool GATHER, bool ALIGN_EPI>
__device__ __forceinline__ void gemm_phase(LAS unsigned char* lds, const int K, const Sched& S, const Epi& E, const int tid, const int wv) {
    const int wid = wv, lane = tid & 63, wr = wid >> 2, wc = wid & 3, fr = lane & 15, fq = lane >> 4;
    const int nt = K / BK;
    unsigned voffB[2];
#pragma unroll
    for (int i = 0; i < 2; ++i) { int R, C; stage_rc(tid * 16 + i * 8192, R, C); const int Rb = Epi::PERM ? ((R & ~31) + perm32(R & 31)) : R; voffB[i] = (unsigned)(Rb * K + C) * 2u; }
#define PG8_AOFFS(dst, u) do { int t2_ = tid; asm volatile("" : "+v"(t2_)); _Pragma("unroll") for (int i = 0; i < 2; ++i) { int R, C; stage_rc(t2_ * 16 + i * 8192, R, C); \
        _Pragma("unroll") for (int h = 0; h < 2; ++h) dst[h][i] = S.aoff(u, h * HALF + R) + (unsigned)C * 2u; } } while (0)
    const size_t kstep = (size_t)(BK * 2);
    const size_t hstep = (size_t)HALF * K * 2;
    const unsigned ldsw = (unsigned)wid * 1024u;
    const int aoff = lds_byte(wr * 64 + fr, fq * 8), boff = lds_byte(wc * 32 + fr, fq * 8);
#define PG8_SA(b, h) (((b) * 2 + (h)) * HTB)
#define PG8_SB(b, h) ((4 + (b) * 2 + (h)) * HTB)
#define PG8_STAGE(bufoff, gbase, v0, v1) do { const unsigned ld_ = (unsigned)(size_t)(lds + (bufoff) + ldsw); glds16s((gbase), (v0), ld_); glds16s((gbase), (v1), ld_ + 8192u); } while (0)
#define PG8_LDA(dst, b, h) do { _Pragma("unroll") for (int m = 0; m < 4; ++m) _Pragma("unroll") for (int k = 0; k < 2; ++k) dst[m][k] = *(const LAS bf16x8*)(lds + PG8_SA(b, h) + aoff + m * 2048 + k * 1024); } while (0)
#define PG8_LDB(dst, b, h) do { _Pragma("unroll") for (int n = 0; n < 2; ++n) _Pragma("unroll") for (int k = 0; k < 2; ++k) dst[n][k] = *(const LAS bf16x8*)(lds + PG8_SB(b, h) + boff + n * 2048 + k * 1024); } while (0)
#define PG8_MMA(ai, bj, At, Bt) do { __builtin_amdgcn_s_setprio(1); _Pragma("unroll") for (int m = 0; m < 4; ++m) _Pragma("unroll") for (int n = 0; n < 2; ++n) _Pragma("unroll") for (int k = 0; k < 2; ++k) \
        acc[ai][bj][m][n] = __builtin_amdgcn_mfma_f32_16x16x32_bf16(Bt[n][k], At[m][k], acc[ai][bj][m][n], 0, 0, 0); __builtin_amdgcn_s_setprio(0); } while (0)
#define PG8_WAIT_V(n) asm volatile("s_waitcnt vmcnt(" #n ")" ::: "memory")
#define PG8_WAIT_L(n) asm volatile("s_waitcnt lgkmcnt(" #n ")" ::: "memory")
#define PG8_BAR __builtin_amdgcn_s_barrier()
#define PG8_SCHED __builtin_amdgcn_sched_barrier(0)
    GUnit cur, nxt; int ui = 0;
    if (!S.next(0, cur)) return;
    f32x4 acc[2][2][4][2];
#pragma unroll
    for (int a = 0; a < 2; ++a)
#pragma unroll
        for (int b = 0; b < 2; ++b)
#pragma unroll
            for (int m = 0; m < 4; ++m)
#pragma unroll
                for (int n = 0; n < 2; ++n) acc[a][b][m][n] = (f32x4){0.f, 0.f, 0.f, 0.f};
    bf16x8 At[4][2], B0[2][2], B1[2][2];
    unsigned vA[2][2], vN[2][2];
    PG8_AOFFS(vA, cur);
#pragma unroll
    for (int h = 0; h < 2; ++h)
#pragma unroll
        for (int i = 0; i < 2; ++i) vN[h][i] = vA[h][i];
    const char* cA = cur.A; const char* cB = cur.B;
    PG8_STAGE(PG8_SB(0, 0), cB, voffB[0], voffB[1]); PG8_STAGE(PG8_SB(0, 1), cB + hstep, voffB[0], voffB[1]); PG8_STAGE(PG8_SA(0, 0), cA, vA[0][0], vA[0][1]); PG8_STAGE(PG8_SA(0, 1), cA, vA[1][0], vA[1][1]);
    if (wr == 1) PG8_BAR;
    PG8_WAIT_V(2); PG8_BAR;
    PG8_STAGE(PG8_SB(1, 0), cB + kstep, voffB[0], voffB[1]); PG8_STAGE(PG8_SA(1, 0), cA + kstep, vA[0][0], vA[0][1]); PG8_STAGE(PG8_SB(1, 1), cB + hstep + kstep, voffB[0], voffB[1]);
    PG8_WAIT_V(6); PG8_BAR;
    for (;;) {
        const bool has_next = S.next(ui + 1, nxt);
        const char* nA = GATHER ? cA : (has_next ? nxt.A : cA); const char* nB = has_next ? nxt.B : cB;
        unsigned tok_[2][2] = {{0u, 0u}, {0u, 0u}};
#define PG8_KBODY(a1, a2, b2, a3, b3, W00, W01, W10, W11) do { \
              \
            PG8_LDB(B0, 0, 0); PG8_LDB(B1, 0, 1); PG8_SCHED; PG8_LDA(At, 0, 0); PG8_STAGE(PG8_SA(1, 1), a1, vA[1][0], vA[1][1]); \
            PG8_WAIT_V(8); PG8_WAIT_L(0); PG8_BAR; PG8_MMA(0, 0, At, B0); PG8_MMA(0, 1, At, B1); PG8_BAR; PG8_SCHED; \
              \
            PG8_LDA(At, 0, 1); PG8_STAGE(PG8_SB(0, 0), b2, voffB[0], voffB[1]); PG8_STAGE(PG8_SB(0, 1), (b2) + hstep, voffB[0], voffB[1]); PG8_STAGE(PG8_SA(0, 0), a2, W00, W01); \
            PG8_WAIT_V(8); PG8_WAIT_L(0); PG8_BAR; PG8_MMA(1, 0, At, B0); PG8_MMA(1, 1, At, B1); PG8_BAR; PG8_SCHED; \
              \
            PG8_LDB(B0, 1, 0); PG8_LDB(B1, 1, 1); PG8_SCHED; PG8_LDA(At, 1, 0); PG8_STAGE(PG8_SA(0, 1), a2, W10, W11); \
            PG8_WAIT_V(8); PG8_WAIT_L(0); PG8_BAR; PG8_MMA(0, 0, At, B0); PG8_MMA(0, 1, At, B1); PG8_BAR; PG8_SCHED; \
              \
            PG8_LDA(At, 1, 1); PG8_STAGE(PG8_SB(1, 0), b3, voffB[0], voffB[1]); PG8_STAGE(PG8_SB(1, 1), (b3) + hstep, voffB[0], voffB[1]); PG8_STAGE(PG8_SA(1, 0), a3, W00, W01); \
            PG8_WAIT_V(8); PG8_WAIT_L(0); PG8_BAR; PG8_MMA(1, 0, At, B0); PG8_MMA(1, 1, At, B1); PG8_BAR; PG8_SCHED; } while (0)
        for (int t = 0; t < nt - 2; t += 2) {
            const char* a1 = cA + (size_t)(t + 1) * kstep;
            const char* a2 = cA + (size_t)(t + 2) * kstep; const char* b2 = cB + (size_t)(t + 2) * kstep;
            const char* a3 = a2 + kstep; const char* b3 = b2 + kstep;
            if (GATHER) { if (t == nt - 4 && has_next) { int t2_ = tid; asm volatile("" : "+v"(t2_));
#pragma unroll
                for (int i = 0; i < 2; ++i) { int R, C; stage_rc(t2_ * 16 + i * 8192, R, C);
#pragma unroll
                    for (int h = 0; h < 2; ++h) { const unsigned vo = S.tokoff(nxt, h * HALF + R); asm volatile("global_load_dword %0, %1, %2" : "=v"(tok_[h][i]) : "v"(vo), "s"(S.tokbase()) : "memory"); } } } }
            PG8_KBODY(a1, a2, b2, a3, b3, vA[0][0], vA[0][1], vA[1][0], vA[1][1]);
        }
        if (GATHER) {
            if (has_next) { int t2_ = tid; asm volatile("" : "+v"(t2_), "+v"(tok_[0][0]), "+v"(tok_[0][1]), "+v"(tok_[1][0]), "+v"(tok_[1][1]));
#pragma unroll
                for (int i = 0; i < 2; ++i) { int R, C; stage_rc(t2_ * 16 + i * 8192, R, C);
#pragma unroll
                    for (int h = 0; h < 2; ++h) vN[h][i] = tok_[h][i] * (unsigned)(K * 2) + (unsigned)C * 2u; } }
            else {
#pragma unroll
                for (int h = 0; h < 2; ++h)
#pragma unroll
                    for (int i = 0; i < 2; ++i) vN[h][i] = vA[h][i];
            }
        }
        {
            const char* a1 = cA + (size_t)(nt - 1) * kstep;
            const char* a3 = nA + kstep; const char* b3 = nB + kstep;
            PG8_KBODY(a1, nA, nB, a3, b3, vN[0][0], vN[0][1], vN[1][0], vN[1][1]);
        }
#undef PG8_KBODY
        if constexpr (ALIGN_EPI) { if (wr == 0) PG8_BAR; }
        { int t3_ = tid; asm volatile("" : "+v"(t3_)); const int l3_ = t3_ & 63; E(acc, cur, wr, wc, l3_ & 15, l3_ >> 4); }
        if (!has_next) break;
#pragma unroll
        for (int a = 0; a < 2; ++a)
#pragma unroll
            for (int b = 0; b < 2; ++b)
#pragma unroll
                for (int m = 0; m < 4; ++m)
#pragma unroll
                    for (int n = 0; n < 2; ++n) acc[a][b][m][n] = (f32x4){0.f, 0.f, 0.f, 0.f};
        cur = nxt; cA = nA; cB = nB; ++ui;
        if (GATHER) {
#pragma unroll
            for (int h = 0; h < 2; ++h)
#pragma unroll
                for (int i = 0; i < 2; ++i) vA[h][i] = vN[h][i];
        }
        if constexpr (ALIGN_EPI) { if (wr == 1) PG8_BAR; }
    }
    PG8_WAIT_V(0);
    if constexpr (!ALIGN_EPI) { if (wr == 0) PG8_BAR; }
    PG8_BAR;
#undef PG8_AOFFS
#undef PG8_SA
#undef PG8_SB
#undef PG8_STAGE
#undef PG8_LDA
#undef PG8_LDB
#undef PG8_MMA
#undef PG8_WAIT_V
#undef PG8_WAIT_L
#undef PG8_BAR
#undef PG8_SCHED
}


constexpr int TS_OFF = 131072 + 1024;
template <bool GATHER> struct MoeOrder {
    const char* A; const char* Bt; const int* rowtok; int nN, nwg, nM, G, c, K; size_t strideE;
    __device__ __forceinline__ void init(const bf16_t* A_, const bf16_t* Bt_, const int* rowtok_, int N, int K_, size_t strideE_, int G_, int c_) {
        A = (const char*)A_; Bt = (const char*)Bt_; rowtok = rowtok_; nN = N / BM; K = K_; strideE = strideE_; G = G_; c = c_;
        nM = __builtin_amdgcn_readfirstlane(((LAS const int*)(LDSP + TS_OFF))[32]); nwg = nM * nN; }
    __device__ __forceinline__ bool next(int i, GUnit& u) const {
        const long L = (long)i * G + c; if (L >= nwg) return false;
        int wgid = (int)L; { const int q = nwg / NXCD, r = nwg % NXCD, xcd = wgid % NXCD, off = wgid / NXCD; wgid = (xcd < r ? xcd * (q + 1) : r * (q + 1) + (xcd - r) * q) + off; }
        const int nig = WGM_MOE * nN, gid = wgid / nig, fm = gid * WGM_MOE, gsz = (nM - fm) < WGM_MOE ? (nM - fm) : WGM_MOE;
        u.pm = fm + ((wgid % nig) % gsz); u.pn = (wgid % nig) / gsz;
        LAS const int* ts = (LAS const int*)(LDSP + TS_OFF);
        const int e = __builtin_amdgcn_readfirstlane(ts[72 + u.pm]);
        u.e = e; u.row0 = (u.pm - __builtin_amdgcn_readfirstlane(ts[e])) * BM; u.cnt = __builtin_amdgcn_readfirstlane(ts[33 + e]);
        u.A = GATHER ? A : A + (size_t)u.pm * BM * K * 2;
        u.B = Bt + (size_t)e * strideE + (size_t)u.pn * BM * K * 2; return true;
    }
    __device__ __forceinline__ unsigned aoff(const GUnit& u, int row) const {
        if (GATHER) { int sl = u.row0 + row; sl = sl < u.cnt ? sl : u.cnt - 1; return (unsigned)rowtok[u.e * ECAP + sl] * (unsigned)(K * 2); }
        return (unsigned)(row * K * 2);
    }
    __device__ __forceinline__ unsigned tokoff(const GUnit& u, int row) const { int sl = u.row0 + row; sl = sl < u.cnt ? sl : u.cnt - 1; return (unsigned)(u.e * ECAP + sl) * 4u; }
    __device__ __forceinline__ const int* tokbase() const { return rowtok; }
};
__device__ __forceinline__ void moe_tiles(const unsigned* cnt, int tid) {
    LAS int* ts = (LAS int*)(LDSP + TS_OFF);
    if (tid == 0) { int s = 0; for (int e = 0; e < NEXP; ++e) { const int c = (int)cnt[e]; ts[e] = s; ts[33 + e] = c; const int n = (c + BM - 1) / BM;
_Pragma("clang loop vectorize(disable) unroll(disable)") for (int t = 0; t < n; ++t) ts[72 + s + t] = e;
            s += n; } ts[NEXP] = s; }
    __syncthreads();
}
struct EpiMoe1 {
    static constexpr bool PERM = true;
    bf16_t* O; const float* b1; const float* rsc;
    __device__ __forceinline__ void operator()(const f32x4 (&acc)[2][2][4][2], const GUnit& u, int wr, int wc, int fr, int fq) const {
        const int rt0 = wr * 64 + fr, col0 = u.pn * 128 + wc * 32 + 8 * fq;
        const float* bg = b1 + (size_t)u.e * 2048 + col0;
        f32x4 bgv[2], blv[2];
#pragma unroll
        for (int n = 0; n < 2; ++n) { bgv[n] = *(const f32x4*)(bg + 4 * n); blv[n] = *(const f32x4*)(bg + DFF + 4 * n); }
#pragma unroll
        for (int ai = 0; ai < 2; ++ai)
#pragma unroll
            for (int m = 0; m < 4; ++m) {
                const int rt = rt0 + ai * HALF + m * 16; int sl = u.row0 + rt; sl = sl < u.cnt ? sl : u.cnt - 1;
                const float r = rsc[u.e * ECAP + sl];
                float o[8];
                const f32x2 r2 = (f32x2){r, r};
#pragma unroll
                for (int n = 0; n < 2; ++n)
#pragma unroll
                    for (int jp = 0; jp < 2; ++jp) {
                        const f32x2 ag = (f32x2){acc[ai][0][m][n][2 * jp], acc[ai][0][m][n][2 * jp + 1]}, al = (f32x2){acc[ai][1][m][n][2 * jp], acc[ai][1][m][n][2 * jp + 1]};
                        f32x2 g = ag * r2 + (f32x2){bgv[n][2 * jp], bgv[n][2 * jp + 1]}, l = al * r2 + (f32x2){blv[n][2 * jp], blv[n][2 * jp + 1]};
                        g.x = fminf(g.x, 7.f); g.y = fminf(g.y, 7.f);
                        l.x = __builtin_amdgcn_fmed3f(l.x, -7.f, 7.f); l.y = __builtin_amdgcn_fmed3f(l.y, -7.f, 7.f);
                        const f32x2 z = g * (-2.4554669595930157f);
                        f32x2 e; e.x = __builtin_amdgcn_exp2f(z.x); e.y = __builtin_amdgcn_exp2f(z.y);
                        e = e + 1.0f;
                        f32x2 q; q.x = __builtin_amdgcn_rcpf(e.x); q.y = __builtin_amdgcn_rcpf(e.y);
                        const f32x2 v = (g * q) * (l + 1.0f);
                        o[n * 4 + 2 * jp] = v.x; o[n * 4 + 2 * jp + 1] = v.y;
                    }
                u32x4 w; w.x = cvt_pk_bf16(o[0], o[1]); w.y = cvt_pk_bf16(o[2], o[3]); w.z = cvt_pk_bf16(o[4], o[5]); w.w = cvt_pk_bf16(o[6], o[7]);
                *(u32x4*)(O + (size_t)(u.pm * BM + rt) * DFF + col0) = w;
            }
    }
};
struct EpiMoe2 {
    static constexpr bool PERM = true;
    bf16_t* O; const float* b2;
    __device__ __forceinline__ void operator()(const f32x4 (&acc)[2][2][4][2], const GUnit& u, int wr, int wc, int fr, int fq) const {
        const int row0 = u.pm * BM + wr * 64 + fr, col0 = u.pn * BM + wc * 32 + 8 * fq;
        f32x4 bv[2][2];
#pragma unroll
        for (int bj = 0; bj < 2; ++bj)
#pragma unroll
            for (int n = 0; n < 2; ++n) bv[bj][n] = *(const f32x4*)(b2 + (size_t)u.e * DM + col0 + bj * HALF + 4 * n);
#pragma unroll
        for (int ai = 0; ai < 2; ++ai)
#pragma unroll
            for (int m = 0; m < 4; ++m) { bf16_t* rowp = O + (size_t)(row0 + ai * HALF + m * 16) * DM + col0;
#pragma unroll
                for (int bj = 0; bj < 2; ++bj) { const f32x4 v0 = acc[ai][bj][m][0] + bv[bj][0], v1 = acc[ai][bj][m][1] + bv[bj][1];
                    u32x4 w; w.x = cvt_pk_bf16(v0[0], v0[1]); w.y = cvt_pk_bf16(v0[2], v0[3]); w.z = cvt_pk_bf16(v1[0], v1[1]); w.w = cvt_pk_bf16(v1[2], v1[3]);
                    *(u32x4*)(rowp + bj * HALF) = w; } }
    }
};

__device__ __forceinline__ void p_transpose_r(const int wv, const float* W, int nmat, int K, int N, bf16_t* WT, const float* kgain, int gdiv, int mode, LAS unsigned char* lds, int it_begin, int it_end, int wrank, int wstride, int scr_pitch = 16384) {
    LTID();
    const int wave = wv, lane = tidx & 63;
    LAS float* scr = (LAS float*)(lds + wave * scr_pitch);
    const int nblk = N / 32, per_mat = (K / 64) * nblk, total = it_end, stride = wstride;
    const int lrow = lane >> 5, lcol = lane & 31;
#define TR_DECODE(item, mat_, kb_, nb_) const int mat_ = (item) / per_mat, r_ = (item) - mat_ * per_mat, g8_ = r_ >> 3, l8_ = r_ & 7, kb_ = 2 * (g8_ / (nblk >> 2)) + (l8_ & 1), nb_ = 4 * (g8_ % (nblk >> 2)) + (l8_ >> 1)
#define TR_ISSUE(item, dst) do { TR_DECODE(item, mat_, kb_, nb_); \
        const float* src_ = W + (size_t)mat_ * K * N + (size_t)(64 * kb_ + lrow) * N + 32 * nb_ + lcol; \
        _Pragma("unroll") for (int i = 0; i < 32; ++i) dst[i] = __builtin_nontemporal_load(src_ + (size_t)(2 * i) * N); } while (0)
    float v[32], vn[32], vnn[32];
    int it = it_begin + wrank;
    if (it < total) TR_ISSUE(it, v);
    if (it + stride < total) TR_ISSUE(it + stride, vn);
    while (it < total) {
        const int itn = it + stride, itnn = itn + stride;
        if (itnn < total) TR_ISSUE(itnn, vnn);
        TR_DECODE(it, mat, kb, nb); const int k0 = 64 * kb, n0 = 32 * nb;
#pragma unroll
        for (int i = 0; i < 32; ++i) scr[(2 * i + lrow) * 33 + lcol] = v[i];
        asm volatile("s_waitcnt lgkmcnt(0)" ::: "memory");
        int d0 = n0;
        if (mode == 1) { const int bj = n0 >> 10, rest = n0 & 1023, pn = rest >> 7, j = rest & 127; d0 = pn * 256 + bj * 128 + j; }
        const int c = lane & 7;
        f32x4 g0 = (f32x4){1.f, 1.f, 1.f, 1.f}, g1 = g0;
        if (kgain) { const float* gp = kgain + (size_t)(mat / gdiv) * DM + k0 + 8 * c; g0 = *(const f32x4*)gp; g1 = *(const f32x4*)(gp + 4); }
        bf16_t* dst = WT + (size_t)mat * K * N;
#pragma unroll
        for (int j = 0; j < 4; ++j) { const int n = (lane >> 3) + 8 * j; const LAS float* sp = scr + (8 * c) * 33 + n;
            u32x4 o; o.x = cvt_pk_bf16(sp[0 * 33] * g0[0], sp[1 * 33] * g0[1]); o.y = cvt_pk_bf16(sp[2 * 33] * g0[2], sp[3 * 33] * g0[3]); o.z = cvt_pk_bf16(sp[4 * 33] * g1[0], sp[5 * 33] * g1[1]); o.w = cvt_pk_bf16(sp[6 * 33] * g1[2], sp[7 * 33] * g1[3]);
            __builtin_nontemporal_store(o, (u32x4*)(dst + (size_t)(d0 + n) * K + k0 + 8 * c)); }
        asm volatile("s_waitcnt lgkmcnt(0)" ::: "memory");
#pragma unroll
        for (int i = 0; i < 32; ++i) { v[i] = vn[i]; vn[i] = vnn[i]; }
        it = itn;
    }
#undef TR_ISSUE
#undef TR_DECODE
}
__device__ __forceinline__ void p_transpose(const int wv, const float* W, int nmat, int K, int N, bf16_t* WT, const float* kgain, int gdiv, int mode, LAS unsigned char* lds, int rot) {
    const int G_ = (int)gridDim.x, b_ = ((int)blockIdx.x + G_ - rot % G_) % G_;
    p_transpose_r(wv, W, nmat, K, N, WT, kgain, gdiv, mode, lds, 0, nmat * (K / 64) * (N / 32), b_ * NW + wv, G_ * NW);
}
typedef short v4i16_t __attribute__((ext_vector_type(4)));
constexpr int ATT_TAB_OFF = 131072 + 2048;
constexpr int ATT_UNITS = 3 * 8 * 128;
__device__ __forceinline__ int t5_bucket_dev(int n) {
    if (n < 16) return n;
    const float v = logf((float)n / 16.f) / 4.852030263919617f * 16.f;
    const int large = 16 + (int)v;
    return large < 31 ? large : 31;
}
__device__ __forceinline__ void p_bias_table(const int wv, const float* rel_bias, float* biasG, int rot) {
    LTID();
    for (int i = ROTB(rot) * NT + tidx; i < 3 * 8 * 132; i += gridDim.x * NT) {
        const int d = i % 132, bh = i / 132, h = bh & 7, b = bh >> 3;
        biasG[i] = (d <= 128) ? rel_bias[t5_bucket_dev(d << (2 * b)) * 8 + h] * 1.4426950408889634f : 0.f;
    }
}
__device__ __forceinline__ void p_dil_attn(const int wv, const bf16_t* proj16, const float* biasG, bf16_t* obr, float* lse, LAS unsigned char* lds) {
    LTID();
    const int lane = tidx & 63, fr = lane & 15, fq = lane >> 4, w = wv;
    const int per = (ATT_UNITS + (int)gridDim.x - 1) / (int)gridDim.x;
    const int u0 = bidx * per, u1 = (u0 + per < ATT_UNITS) ? u0 + per : ATT_UNITS;
    if (u0 >= u1) return;
    const int rowl = tidx >> 3, cs = tidx & 7;
    const unsigned cK = (unsigned)(cs ^ ((rowl >> 1) & 7)) * 16u, cV = (unsigned)(cs ^ (rowl & 7)) * 16u;
    const unsigned fK = (unsigned)((fr >> 1) & 7);
    const unsigned kro0 = (unsigned)fr * 128u + (((unsigned)fq ^ fK) * 16u), kro1 = (unsigned)fr * 128u + ((((unsigned)fq ^ fK) ^ 4u) * 16u);
    const int tq = (lane & 15) >> 2, tp = lane & 3, fv = 4 * (fq & 1) + tq;
    unsigned vro[4];
#pragma unroll
    for (int db = 0; db < 4; ++db) vro[db] = (unsigned)(4 * fq + tq) * 128u + (unsigned)(((2 * db + (tp >> 1)) ^ fv) * 16) + 8u * (unsigned)(tp & 1);
    const int ts_ = (1 + fr) & 3;
    const unsigned tab8 = (unsigned)ATT_TAB_OFF + (unsigned)ts_ * 640u + (unsigned)(((141 + fr - ts_) >> 2) - fq - 32) * 16u;
    const char* gbase = (const char*)proj16;
#define ATT_DECODE(u, b_, h_, r_, n_, dil_) const int cmb_ = (u) >> 7, b_ = cmb_ >> 3, h_ = cmb_ & 7, dil_ = 1 << (2 * b_), idx_ = (u) & 127, r_ = idx_ & (dil_ - 1), n_ = idx_ >> (2 * b_)
#define ATT_ISSUE(u, bf, q0, q1) do { ATT_DECODE(u, b__, h__, r__, n__, dil__); \
        const int nk = n__ > 0 ? n__ - 1 : 0;                                     \
        _Pragma("unroll") for (int p = 0; p < 4; ++p) { \
            int row = 64 * p + rowl; int blk = (row >> 7) ? n__ : nk; \
            const unsigned pos = (unsigned)(r__ + dil__ * (128 * blk + (row & 127))); \
            const unsigned so = pos * 4096u + (unsigned)h__ * 128u; const unsigned ld_ = (unsigned)(size_t)(lds + (bf) * 65536 + p * 8192 + w * 1024); \
            glds16s(gbase, so + 1024u + cK, ld_); glds16s(gbase, so + 2048u + cV, ld_ + 32768u); } \
        const unsigned qpos = (unsigned)(r__ + dil__ * (128 * n__ + 16 * w + fr)); \
        const char* qsrc = gbase + (size_t)qpos * 4096u + (unsigned)h__ * 128u + (unsigned)fq * 16u; \
        q0 = *(const bf16x8*)(qsrc); q1 = *(const bf16x8*)(qsrc + 64); } while (0)
    bf16x8 qf0, qf1, qn0, qn1;
    ATT_ISSUE(u0, 0, qn0, qn1);
    int prev_cmb = -1;
    for (int u = u0; u < u1; ++u) {
        const int bf = (u - u0) & 1;
        if (u == u0) asm volatile("s_waitcnt vmcnt(0)" ::: "memory"); else asm volatile("s_waitcnt vmcnt(5)" ::: "memory");
        __builtin_amdgcn_s_barrier();
        qf0 = qn0; qf1 = qn1;
        if (u + 1 < u1) ATT_ISSUE(u + 1, bf ^ 1, qn0, qn1);
        ATT_DECODE(u, b, h, r, n, dil);
        if (cmb_ != prev_cmb) {
            prev_cmb = cmb_;
            for (int e = tidx; e < 4 * 160; e += NT) { const int sft = e / 160, k = e - sft * 160, idx = k + sft, dist = idx - 16;
                const float v = (dist >= 0 && dist <= 128) ? biasG[cmb_ * 132 + dist] : -1e30f;
                ((LAS float*)(lds + ATT_TAB_OFF))[sft * 160 + k] = v; }
            __syncthreads();
        }
        const LAS unsigned char* Kb = lds + bf * 65536; const LAS unsigned char* Vb = Kb + 32768;
        const int kb0 = w;
        f32x4 sc[9];
#pragma unroll
        for (int i = 0; i < 9; ++i) {
            const unsigned ko = (unsigned)(kb0 + i) * 2048u;
            const bf16x8 k0 = *(const LAS bf16x8*)(Kb + ko + kro0), k1 = *(const LAS bf16x8*)(Kb + ko + kro1);
            f32x4 a = (f32x4){0.f, 0.f, 0.f, 0.f};
            a = __builtin_amdgcn_mfma_f32_16x16x32_bf16(k0, qf0, a, 0, 0, 0);
            a = __builtin_amdgcn_mfma_f32_16x16x32_bf16(k1, qf1, a, 0, 0, 0);
            const f32x4 t = *(const LAS f32x4*)(lds + tab8 + 64 * (8 - i));
            a = a + (f32x4){t[3], t[2], t[1], t[0]};
            if (n == 0 && kb0 + i < 8) a = (f32x4){-1e30f, -1e30f, -1e30f, -1e30f};
            sc[i] = a;
        }
#pragma unroll
        for (int i = 0; i < 9; ++i)
#pragma unroll
            for (int j = 0; j < 4; ++j) sc[i][j] = __builtin_amdgcn_exp2f(fminf(sc[i][j], 100.f));
        f32x4 oacc[4]; f32x4 sacc = (f32x4){0.f, 0.f, 0.f, 0.f};
        const bf16x8 ones = (bf16x8){0x3F80, 0x3F80, 0x3F80, 0x3F80, 0x3F80, 0x3F80, 0x3F80, 0x3F80};
#pragma unroll
        for (int db = 0; db < 4; ++db) oacc[db] = (f32x4){0.f, 0.f, 0.f, 0.f};
#pragma unroll
        for (int c = 0; c < 5; ++c) {
            const int ia = 2 * c, ib = (c < 4) ? 2 * c + 1 : 8;
            u32x4 pw; pw.x = cvt_pk_bf16(sc[ia][0], sc[ia][1]); pw.y = cvt_pk_bf16(sc[ia][2], sc[ia][3]);
            if (c < 4) { pw.z = cvt_pk_bf16(sc[ib][0], sc[ib][1]); pw.w = cvt_pk_bf16(sc[ib][2], sc[ib][3]); } else { pw.z = 0u; pw.w = 0u; }
            const bf16x8 pf = __builtin_bit_cast(bf16x8, pw);
            const unsigned va = (unsigned)(kb0 + ia) * 2048u, vb = (unsigned)(kb0 + ib) * 2048u;
            sacc = __builtin_amdgcn_mfma_f32_16x16x32_bf16(ones, pf, sacc, 0, 0, 0);
#pragma unroll
            for (int db = 0; db < 4; ++db) {
                const v4i16_t x0 = __builtin_amdgcn_ds_read_tr16_b64_v4i16((LAS v4i16_t*)(Vb + va + vro[db]));
                const v4i16_t x1 = __builtin_amdgcn_ds_read_tr16_b64_v4i16((LAS v4i16_t*)(Vb + vb + vro[db]));
                const bf16x8 vf = (bf16x8){x0[0], x0[1], x0[2], x0[3], x1[0], x1[1], x1[2], x1[3]};
                oacc[db] = __builtin_amdgcn_mfma_f32_16x16x32_bf16(vf, pf, oacc[db], 0, 0, 0);
            }
        }
        const float sum = sacc[0];
        const float inv = 1.f / sum;
        const unsigned qpos = (unsigned)(r + dil * (128 * n + 16 * w + fr));
        bf16_t* orow = obr + ((size_t)b * SEQ + qpos) * 512 + h * 64 + 4 * fq;
#pragma unroll
        for (int db = 0; db < 4; ++db) { u32x2 o2; o2.x = cvt_pk_bf16(oacc[db][0] * inv, oacc[db][1] * inv); o2.y = cvt_pk_bf16(oacc[db][2] * inv, oacc[db][3] * inv); *(u32x2*)(orow + 16 * db) = o2; }
        if (fq == 0) lse[((size_t)b * SEQ + qpos) * 8 + h] = sum;
    }
    asm volatile("s_waitcnt vmcnt(0)" ::: "memory");
    __syncthreads();
#undef ATT_DECODE
#undef ATT_ISSUE
}
__device__ __forceinline__ void p_attn_combine(const int wv, const bf16_t* obr, const float* lse, const float* g, bf16_t* mix16) {
    LTID();
    const int lane = tidx & 63, h = lane >> 3;
    const f32x4 g0 = *(const f32x4*)(g + lane * 8), g1 = *(const f32x4*)(g + lane * 8 + 4);
    const int rstride = (int)gridDim.x * NW;
    for (int row0 = bidx * NW + wv; row0 < SEQ; row0 += 4 * rstride) {
        float lv[4][3]; u32x4 av[4][3];
#pragma unroll
        for (int r = 0; r < 4; ++r) { const int row = (row0 + r * rstride < SEQ) ? row0 + r * rstride : row0;
#pragma unroll
            for (int b = 0; b < 3; ++b) { lv[r][b] = lse[((size_t)b * SEQ + row) * 8 + h]; av[r][b] = *(const u32x4*)(obr + ((size_t)b * SEQ + row) * 512 + lane * 8); } }
#pragma unroll
        for (int r = 0; r < 4; ++r) {
            const int row = row0 + r * rstride;
            float w0 = lv[r][0], w1 = lv[r][1], w2 = lv[r][2];
            const float iw = 1.f / (w0 + w1 + w2); w0 *= iw; w1 *= iw; w2 *= iw;
            float y[8]; float ss = 0.f;
#pragma unroll
            for (int k = 0; k < 4; ++k) {
                const float lo = w0 * __builtin_bit_cast(float, av[r][0][k] << 16) + w1 * __builtin_bit_cast(float, av[r][1][k] << 16) + w2 * __builtin_bit_cast(float, av[r][2][k] << 16);
                const float hi = w0 * __builtin_bit_cast(float, av[r][0][k] & 0xffff0000u) + w1 * __builtin_bit_cast(float, av[r][1][k] & 0xffff0000u) + w2 * __builtin_bit_cast(float, av[r][2][k] & 0xffff0000u);
                y[2 * k] = lo; y[2 * k + 1] = hi; ss += lo * lo + hi * hi;
            }
#pragma unroll
            for (int o = 32; o; o >>= 1) ss += shx(ss, o, lane);
            const float sc = rsqrtf(ss * (1.f / 512.f) + 1e-5f);
            u32x4 o4; o4.x = cvt_pk_bf16(y[0] * sc * g0[0], y[1] * sc * g0[1]); o4.y = cvt_pk_bf16(y[2] * sc * g0[2], y[3] * sc * g0[3]);
            o4.z = cvt_pk_bf16(y[4] * sc * g1[0], y[5] * sc * g1[1]); o4.w = cvt_pk_bf16(y[6] * sc * g1[2], y[7] * sc * g1[3]);
            if (row < SEQ) *(u32x4*)(mix16 + (size_t)row * DM + lane * 8) = o4;
        }
    }
}
struct EpiIn {
    static constexpr bool PERM = true;
    bf16_t* O; const float* rs;
    __device__ __forceinline__ void operator()(const f32x4 (&acc)[2][2][4][2], const GUnit& u, int wr, int wc, int fr, int fq) const {
        const int row0 = u.pm * BM + wr * 64 + fr, col0 = u.pn * BM + wc * 32 + 8 * fq;
        const float sc0 = u.pn < 2 ? 0.18033688011112042f : 1.f;
#pragma unroll
        for (int ai = 0; ai < 2; ++ai)
#pragma unroll
            for (int m = 0; m < 4; ++m) { const int row = row0 + ai * HALF + m * 16; const size_t ro = (size_t)row * DIN + col0; const float sc = sc0 * rs[row];
#pragma unroll
                for (int bj = 0; bj < 2; ++bj) { const f32x4 v0 = acc[ai][bj][m][0] * sc, v1 = acc[ai][bj][m][1] * sc;
                    u32x4 w; w.x = cvt_pk_bf16(v0[0], v0[1]); w.y = cvt_pk_bf16(v0[2], v0[3]); w.z = cvt_pk_bf16(v1[0], v1[1]); w.w = cvt_pk_bf16(v1[2], v1[3]);
                    *(u32x4*)(O + ro + bj * HALF) = w;
                    } }
    }
};


__device__ __forceinline__ unsigned xoff_b(unsigned row, unsigned ch) { return 256u * row + 16u * (ch ^ (((row & 3u) << 2) | ((row >> 2) & 3u))); }
__device__ __forceinline__ void p_xattn_mfma(const int wv, const bf16_t* qx16, const bf16_t* kv16, bf16_t* ox16, LAS unsigned char* lds) {
    LTID();
    const int lane = tidx & 63, fr = lane & 15, fq = lane >> 4, w = wv;
    const int NU = 4 * 128;
    const int per = (NU + (int)gridDim.x - 1) / (int)gridDim.x;
    const int u0 = bidx * per, u1 = (u0 + per < NU) ? u0 + per : NU;
    if (u0 >= u1) return;
    const int rowl = tidx >> 4, cs = tidx & 15;
    const unsigned csw = (unsigned)(cs ^ (((rowl & 3) << 2) | ((rowl >> 2) & 3))) * 16u;
    const unsigned kswz = (unsigned)(((fr & 3) << 2) | ((fr >> 2) & 3));
    unsigned kro[4];
#pragma unroll
    for (int s4 = 0; s4 < 4; ++s4) kro[s4] = 256u * (unsigned)fr + 16u * ((unsigned)(4 * s4 + fq) ^ kswz);
    const int tq = (lane & 15) >> 2, tp = lane & 3;
    const unsigned vswz = (unsigned)((tq << 2) | fq);
    unsigned vro[8];
#pragma unroll
    for (int c = 0; c < 8; ++c) vro[c] = 65536u + 256u * (unsigned)(4 * fq + tq) + 16u * ((unsigned)(2 * c + (tp >> 1)) ^ vswz) + 8u * (unsigned)(tp & 1);
    int prev_h = -1;
    for (int u = u0; u < u1; ++u) {
        const int h = u >> 7, qt = u & 127;
        if (h != prev_h) {
            __syncthreads();
            prev_h = h;
#pragma unroll
            for (int p = 0; p < 8; ++p) {
                const unsigned row = (unsigned)(32 * p + rowl);
                const unsigned so = row * 2048u + (unsigned)h * 256u + csw;
                const unsigned ld_ = (unsigned)(size_t)(lds + p * 8192 + w * 1024);
                glds16s(kv16, so, ld_); glds16s(kv16, so + 1024u, ld_ + 65536u);
            }
            asm volatile("s_waitcnt vmcnt(0)" ::: "memory");
            __syncthreads();
        }
        const char* qsrc = (const char*)qx16 + ((size_t)(qt * 128 + 16 * w + fr) * 512 + h * 128 + 8 * fq) * 2;
        bf16x8 qf[4];
#pragma unroll
        for (int s4 = 0; s4 < 4; ++s4) qf[s4] = *(const bf16x8*)(qsrc + 64 * s4);
        f32x4 sc[16];
#pragma unroll
        for (int i = 0; i < 16; ++i) {
            f32x4 a = (f32x4){0.f, 0.f, 0.f, 0.f};
#pragma unroll
            for (int s4 = 0; s4 < 4; ++s4) { const bf16x8 kf = *(const LAS bf16x8*)(lds + i * 4096 + kro[s4]); a = __builtin_amdgcn_mfma_f32_16x16x32_bf16(kf, qf[s4], a, 0, 0, 0); }
            sc[i] = a;
        }
        float mx = -1e30f;
#pragma unroll
        for (int i = 0; i < 16; ++i) mx = fmaxf(mx, fmaxf(fmaxf(sc[i][0], sc[i][1]), fmaxf(sc[i][2], sc[i][3])));
        mx = fmaxf(mx, shx(mx, 16, lane)); mx = fmaxf(mx, shx(mx, 32, lane));
        float sum = 0.f;
#pragma unroll
        for (int i = 0; i < 16; ++i)
#pragma unroll
            for (int j = 0; j < 4; ++j) { const float p = __expf(sc[i][j] - mx); sc[i][j] = p; sum += p; }
        sum += shx(sum, 16, lane); sum += shx(sum, 32, lane);
        f32x4 oacc[8];
#pragma unroll
        for (int c = 0; c < 8; ++c) oacc[c] = (f32x4){0.f, 0.f, 0.f, 0.f};
#pragma unroll
        for (int ch = 0; ch < 8; ++ch) {
            const int ia = 2 * ch, ib = 2 * ch + 1;
            u32x4 pw; pw.x = cvt_pk_bf16(sc[ia][0], sc[ia][1]); pw.y = cvt_pk_bf16(sc[ia][2], sc[ia][3]); pw.z = cvt_pk_bf16(sc[ib][0], sc[ib][1]); pw.w = cvt_pk_bf16(sc[ib][2], sc[ib][3]);
            const bf16x8 pf = __builtin_bit_cast(bf16x8, pw);
#pragma unroll
            for (int c = 0; c < 8; ++c) {
                const v4i16_t x0 = __builtin_amdgcn_ds_read_tr16_b64_v4i16((LAS v4i16_t*)(lds + ia * 4096 + vro[c]));
                const v4i16_t x1 = __builtin_amdgcn_ds_read_tr16_b64_v4i16((LAS v4i16_t*)(lds + ib * 4096 + vro[c]));
                const bf16x8 vf = (bf16x8){x0[0], x0[1], x0[2], x0[3], x1[0], x1[1], x1[2], x1[3]};
                oacc[c] = __builtin_amdgcn_mfma_f32_16x16x32_bf16(vf, pf, oacc[c], 0, 0, 0);
            }
        }
        const float inv = 1.f / sum;
        bf16_t* orow = ox16 + (size_t)(qt * 128 + 16 * w + fr) * 512 + h * 128 + 4 * fq;
#pragma unroll
        for (int c = 0; c < 8; ++c) { u32x2 o2; o2.x = cvt_pk_bf16(oacc[c][0] * inv, oacc[c][1] * inv); o2.y = cvt_pk_bf16(oacc[c][2] * inv, oacc[c][3] * inv); *(u32x2*)(orow + 16 * c) = o2; }
    }
    __syncthreads();
}
struct EpiBf16 {
    static constexpr bool PERM = true;
    bf16_t* O; int ldc; float scale; const float* ss;
    __device__ __forceinline__ void operator()(const f32x4 (&acc)[2][2][4][2], const GUnit& u, int wr, int wc, int fr, int fq) const {
        const int row0 = u.pm * BM + wr * 64 + fr, col0 = u.pn * BM + wc * 32 + 8 * fq;
#pragma unroll
        for (int ai = 0; ai < 2; ++ai)
#pragma unroll
            for (int m = 0; m < 4; ++m) { const int row = row0 + ai * HALF + m * 16; bf16_t* rowp = O + (size_t)row * ldc + col0;
                float sc = scale;
                if (ss) { const f32x4 p0 = *(const f32x4*)(ss + (size_t)row * 16), p1 = *(const f32x4*)(ss + (size_t)row * 16 + 4), p2 = *(const f32x4*)(ss + (size_t)row * 16 + 8), p3 = *(const f32x4*)(ss + (size_t)row * 16 + 12);
                    const float t = ((p0[0] + p0[1]) + (p0[2] + p0[3])) + ((p1[0] + p1[1]) + (p1[2] + p1[3])) + ((p2[0] + p2[1]) + (p2[2] + p2[3])) + ((p3[0] + p3[1]) + (p3[2] + p3[3]));
                    sc = scale * rsqrtf(t * (1.f / 1024.f) + 1e-5f); }
#pragma unroll
                for (int bj = 0; bj < 2; ++bj) { const f32x4 v0 = acc[ai][bj][m][0] * sc, v1 = acc[ai][bj][m][1] * sc;
                    u32x4 w; w.x = cvt_pk_bf16(v0[0], v0[1]); w.y = cvt_pk_bf16(v0[2], v0[3]); w.z = cvt_pk_bf16(v1[0], v1[1]); w.w = cvt_pk_bf16(v1[2], v1[3]);
                    *(u32x4*)(rowp + bj * HALF) = w; } }
    }
};
__device__ __forceinline__ float bflo(unsigned u) { return __builtin_bit_cast(float, u << 16); }
__device__ __forceinline__ float bfhi(unsigned u) { return __builtin_bit_cast(float, u & 0xffff0000u); }
template <bool R32, bool SS> struct EpiRes16 {
    static constexpr bool PERM = true;
    const void* R; bf16_t* H; float* ss;
    __device__ __forceinline__ void operator()(const f32x4 (&acc)[2][2][4][2], const GUnit& u, int wr, int wc, int fr, int fq) const {
        const int row0 = u.pm * BM + wr * 64 + fr, col0 = u.pn * BM + wc * 32 + 8 * fq, lane = fq * 16 + fr;
#pragma unroll
        for (int ai = 0; ai < 2; ++ai)
#pragma unroll
            for (int m = 0; m < 4; ++m) { const int row = row0 + ai * HALF + m * 16; const size_t ro = (size_t)row * DM + col0; float sq = 0.f;
#pragma unroll
                for (int bj = 0; bj < 2; ++bj) {
                    f32x4 r0, r1;
                    if (R32) { r0 = *(const f32x4*)((const float*)R + ro + bj * HALF); r1 = *(const f32x4*)((const float*)R + ro + bj * HALF + 4); }
                    else { const u32x4 rw = *(const u32x4*)((const bf16_t*)R + ro + bj * HALF); r0 = (f32x4){bflo(rw.x), bfhi(rw.x), bflo(rw.y), bfhi(rw.y)}; r1 = (f32x4){bflo(rw.z), bfhi(rw.z), bflo(rw.w), bfhi(rw.w)}; }
                    const f32x4 v0 = acc[ai][bj][m][0] + r0, v1 = acc[ai][bj][m][1] + r1;
                    u32x4 w; w.x = cvt_pk_bf16(v0[0], v0[1]); w.y = cvt_pk_bf16(v0[2], v0[3]); w.z = cvt_pk_bf16(v1[0], v1[1]); w.w = cvt_pk_bf16(v1[2], v1[3]);
                    *(u32x4*)(H + ro + bj * HALF) = w;
                    if (SS) sq += (v0[0] * v0[0] + v0[1] * v0[1]) + (v0[2] * v0[2] + v0[3] * v0[3]) + (v1[0] * v1[0] + v1[1] * v1[1]) + (v1[2] * v1[2] + v1[3] * v1[3]);
                }
                if (SS) { sq += shx(sq, 16, lane); sq += shx(sq, 32, lane);
                    if (fq == 0) ss[(size_t)row * 16 + u.pn * 4 + wc] = sq; }
            }
    }
};

typedef short bf16x4 __attribute__((ext_vector_type(4)));
constexpr int S5_CHUNK = 256, S5_NCH = SEQ / S5_CHUNK, S5_ROWB = 528;
__device__ __forceinline__ f32x2 gelu_pk(f32x2 v) {
    const f32x2 av = __builtin_elementwise_abs(v), d = av * 0.2316418882f + 1.0f;
    f32x2 t; t.x = __builtin_amdgcn_rcpf(d.x); t.y = __builtin_amdgcn_rcpf(d.y);
    f32x2 q = t * 0.5307027145f + (-0.7265760135f); q = q * t + 0.7107068705f; q = q * t + (-0.142248368f); q = q * t + 0.127414796f; q = q * t;
    const f32x2 s2 = (v * v) * (-0.72134752044f);
    f32x2 e; e.x = __builtin_amdgcn_exp2f(s2.x); e.y = __builtin_amdgcn_exp2f(s2.y);
    const f32x2 m = v * (q * e), r = v - m;
    f32x2 o; o.x = v.x < 0.f ? m.x : r.x; o.y = v.y < 0.f ? m.y : r.y; return o;
}
__device__ __forceinline__ void p_s5_tables2(const int wv, const float* a_re, const float* a_im, const float* b_re, const float* b_im, const float* c_re, const float* c_im, const float* log_dt,
                                             float2* abar, float2* a256, bf16_t* BB16, bf16_t* CM16, int rot) {
    LTID();
    for (int i = ROTB(rot) * NT + tidx; i < 2048 * 16; i += gridDim.x * NT) {
        const int gp = i >> 4, c = i & 15, g = gp >> 6, p = gp & 63;
        const float lr = a_re[gp], li = a_im[gp], dt = expf(log_dt[g]);
        const float mag = expf(lr * dt); float sn, cs; sincosf(li * dt, &sn, &cs);
        const float ar = mag * cs, ai = mag * sn;
        if (c == 0) {
            abar[gp] = make_float2(ar, ai);
            float pr = ar, pi = ai;
            for (int k = 0; k < 8; ++k) { const float nr = pr * pr - pi * pi, ni = 2.f * pr * pi; pr = nr; pi = ni; }
            a256[gp] = make_float2(pr, pi);
        }
        const float nr = ar - 1.f, ni = ai, den = lr * lr + li * li;
        const float cr = (nr * lr + ni * li) / den, ci = (ni * lr - nr * li) / den;
        const float br = b_re[gp * 16 + c], bi = b_im[gp * 16 + c];
        BB16[((size_t)g * 128 + p) * 16 + c] = (bf16_t)f2bf(cr * br - ci * bi);
        BB16[((size_t)g * 128 + 64 + p) * 16 + c] = (bf16_t)f2bf(cr * bi + ci * br);
        CM16[((size_t)g * 16 + c) * 128 + p] = (bf16_t)f2bf(c_re[(g * 16 + c) * 64 + p]);
        CM16[((size_t)g * 16 + c) * 128 + 64 + p] = (bf16_t)f2bf(-c_im[(g * 16 + c) * 64 + p]);
    }
}
template <int MODE> __device__ __forceinline__ void p_s5_pass(const int wv, const bf16_t* proj16, const float2* abar, const float2* a256, const bf16_t* BB16, const bf16_t* CM16, const float* dskip,
                                                              float2* E, bf16_t* yg16, LAS unsigned char* lds) {
    LTID();
    const int lane = tidx & 63, fr = lane & 15, fq = lane >> 4;
    LAS unsigned char* L = lds + wv * (16 * S5_ROWB);
    for (int unit = bidx * NW + wv; unit < S5_NCH * 32; unit += gridDim.x * NW) {
        const int g = unit & 31, chunk = unit >> 5;
        const float2 a = abar[g * 64 + lane];
        bf16x4 bbf[8];
#pragma unroll
        for (int cb = 0; cb < 8; ++cb) bbf[cb] = *(const bf16x4*)(BB16 + ((size_t)g * 128 + 16 * cb + fr) * 16 + 4 * fq);
        bf16x8 cmf[4]; f32x4 dsk = (f32x4){0.f, 0.f, 0.f, 0.f};
        if (MODE == 1) {
#pragma unroll
            for (int s4 = 0; s4 < 4; ++s4) cmf[s4] = *(const bf16x8*)(CM16 + ((size_t)g * 16 + fr) * 128 + 32 * s4 + 8 * fq);
            dsk = *(const f32x4*)(dskip + g * 16 + 4 * fq);
        }
        float sr = 0.f, si = 0.f;
        if (MODE == 1) {
            const float2 A = a256[g * 64 + lane];
            for (int j0 = 0; j0 < chunk; j0 += 16) {
                float2 e[16];
#pragma unroll
                for (int k = 0; k < 16; ++k) { const int j = (j0 + k < chunk) ? j0 + k : chunk - 1; e[k] = E[((size_t)j * 32 + g) * 64 + lane]; }
#pragma unroll
                for (int k = 0; k < 16; ++k) if (j0 + k < chunk) { const float nr = A.x * sr - A.y * si + e[k].x, ni = A.x * si + A.y * sr + e[k].y; sr = nr; si = ni; }
            }
        }
        const bf16_t* ubase = proj16 + (size_t)(chunk * S5_CHUNK + fr) * DIN + 1536 + g * 16 + 4 * fq;
        bf16x4 uf = *(const bf16x4*)ubase;
#pragma unroll 1
        for (int blk = 0; blk < S5_CHUNK / 16; ++blk) {
            const bf16x4 ufn = *(const bf16x4*)(ubase + (size_t)((blk < S5_CHUNK / 16 - 1) ? (blk + 1) * 16 : blk * 16) * DIN);
            asm volatile("" ::: "memory");
#pragma unroll
            for (int cb = 0; cb < 8; ++cb) {
                const f32x4 d = __builtin_amdgcn_mfma_f32_16x16x16bf16_1k(bbf[cb], uf, (f32x4){0.f, 0.f, 0.f, 0.f}, 0, 0, 0);
                *(LAS f32x4*)(L + fr * S5_ROWB + (16 * cb + 4 * fq) * 4) = d;
            }
            asm volatile("" ::: "memory");
#pragma unroll
            for (int t = 0; t < 16; ++t) {
                const float re = *(const LAS float*)(L + t * S5_ROWB + lane * 4), im = *(const LAS float*)(L + t * S5_ROWB + 256 + lane * 4);
                const float nr = a.x * sr - a.y * si + re, ni = a.x * si + a.y * sr + im; sr = nr; si = ni;
                if (MODE == 1) { *(LAS bf16_t*)(L + t * S5_ROWB + lane * 2) = (bf16_t)f2bf(sr); *(LAS bf16_t*)(L + t * S5_ROWB + 128 + lane * 2) = (bf16_t)f2bf(si); }
            }
            asm volatile("" ::: "memory");
            if (MODE == 1) {
                f32x4 y = (f32x4){0.f, 0.f, 0.f, 0.f};
#pragma unroll
                for (int s4 = 0; s4 < 4; ++s4) { const bf16x8 sf = *(const LAS bf16x8*)(L + fr * S5_ROWB + 64 * s4 + 16 * fq); y = __builtin_amdgcn_mfma_f32_16x16x32_bf16(cmf[s4], sf, y, 0, 0, 0); }
                f32x4 v;
#pragma unroll
                for (int j = 0; j < 4; ++j) v[j] = y[j] + dsk[j] * bf2f((unsigned short)uf[j]);
                const f32x2 g0 = gelu_pk((f32x2){v[0], v[1]}), g1 = gelu_pk((f32x2){v[2], v[3]});
                u32x2 o2; o2.x = cvt_pk_bf16(g0.x, g0.y); o2.y = cvt_pk_bf16(g1.x, g1.y);
                *(u32x2*)(yg16 + (size_t)(chunk * S5_CHUNK + blk * 16 + fr) * 512 + g * 16 + 4 * fq) = o2;
            }
            asm volatile("" ::: "memory");
            uf = ufn;
        }
        if (MODE == 0) E[((size_t)chunk * 32 + g) * 64 + lane] = make_float2(sr, si);
    }
}
struct EpiGlu16 {
    static constexpr bool PERM = true;
    bf16_t* O; const bf16_t* Y; const float* bias;
    __device__ __forceinline__ void operator()(const f32x4 (&acc)[2][2][4][2], const GUnit& u, int wr, int wc, int fr, int fq) const {
        const int row0 = u.pm * BM + wr * 64 + fr, col0 = u.pn * BM + wc * 32 + 8 * fq;
        f32x4 bv[2][2];
#pragma unroll
        for (int bj = 0; bj < 2; ++bj)
#pragma unroll
            for (int n = 0; n < 2; ++n) bv[bj][n] = *(const f32x4*)(bias + col0 + bj * HALF + 4 * n);
#pragma unroll
        for (int ai = 0; ai < 2; ++ai)
#pragma unroll
            for (int m = 0; m < 4; ++m) { const size_t ro = (size_t)(row0 + ai * HALF + m * 16) * 512 + col0;
#pragma unroll
                for (int bj = 0; bj < 2; ++bj) {
                    const u32x4 yv = *(const u32x4*)(Y + ro + bj * HALF);
                    float o[8];
#pragma unroll
                    for (int n = 0; n < 2; ++n)
#pragma unroll
                        for (int j = 0; j < 4; ++j) { const unsigned wd = yv[n * 2 + (j >> 1)]; const float y = __builtin_bit_cast(float, (j & 1) ? (wd & 0xffff0000u) : (wd << 16));
                            o[n * 4 + j] = y / (1.f + __expf(-(acc[ai][bj][m][n][j] + bv[bj][n][j]))); }
                    u32x4 w; w.x = cvt_pk_bf16(o[0], o[1]); w.y = cvt_pk_bf16(o[2], o[3]); w.z = cvt_pk_bf16(o[4], o[5]); w.w = cvt_pk_bf16(o[6], o[7]);
                    *(u32x4*)(O + ro + bj * HALF) = w; } }
    }
};
__device__ __forceinline__ void p_ssm_norm(const int wv, const bf16_t* yb16, const float* g, bf16_t* mix16) {
    LTID();
    const int lane = tidx & 63;
    const f32x4 g0 = *(const f32x4*)(g + lane * 8), g1 = *(const f32x4*)(g + lane * 8 + 4);
    const int rstride = (int)gridDim.x * NW;
    for (int row0 = bidx * NW + wv; row0 < SEQ; row0 += 4 * rstride) {
        u32x4 av[4];
#pragma unroll
        for (int r = 0; r < 4; ++r) { const int row = (row0 + r * rstride < SEQ) ? row0 + r * rstride : row0; av[r] = *(const u32x4*)(yb16 + (size_t)row * 512 + lane * 8); }
#pragma unroll
        for (int r = 0; r < 4; ++r) {
            const int row = row0 + r * rstride;
            float y[8]; float ss = 0.f;
#pragma unroll
            for (int k = 0; k < 4; ++k) { y[2 * k] = __builtin_bit_cast(float, av[r][k] << 16); y[2 * k + 1] = __builtin_bit_cast(float, av[r][k] & 0xffff0000u); ss += y[2 * k] * y[2 * k] + y[2 * k + 1] * y[2 * k + 1]; }
#pragma unroll
            for (int o = 32; o; o >>= 1) ss += shx(ss, o, lane);
            const float sc = rsqrtf(ss * (1.f / 512.f) + 1e-5f);
            u32x4 o4; o4.x = cvt_pk_bf16(y[0] * sc * g0[0], y[1] * sc * g0[1]); o4.y = cvt_pk_bf16(y[2] * sc * g0[2], y[3] * sc * g0[3]);
            o4.z = cvt_pk_bf16(y[4] * sc * g1[0], y[5] * sc * g1[1]); o4.w = cvt_pk_bf16(y[6] * sc * g1[2], y[7] * sc * g1[3]);
            if (row < SEQ) *(u32x4*)(mix16 + (size_t)row * DM + 512 + lane * 8) = o4;
        }
    }
}

__device__ __forceinline__ void p_rmsnorm16(const int wv, const float* in, const float* g, bf16_t* out16, int rows, int rot) {
    LTID();
    const int lane = tidx & 63;
    for (int r = ROTB(rot) * NW + wv; r < rows; r += gridDim.x * NW) {
        f32x4 v[4]; float ss = 0.f;
#pragma unroll
        for (int j = 0; j < 4; ++j) { v[j] = *(const f32x4*)(in + (size_t)r * DM + 4 * lane + 256 * j); ss += (v[j][0] * v[j][0] + v[j][1] * v[j][1]) + (v[j][2] * v[j][2] + v[j][3] * v[j][3]); }
#pragma unroll
        for (int o = 32; o; o >>= 1) ss += shx(ss, o, lane);
        const float sc = rsqrtf(ss * (1.f / 1024.f) + 1e-5f);
#pragma unroll
        for (int j = 0; j < 4; ++j) { const f32x4 gg = *(const f32x4*)(g + 4 * lane + 256 * j); u32x2 o2; o2.x = cvt_pk_bf16(v[j][0] * sc * gg[0], v[j][1] * sc * gg[1]); o2.y = cvt_pk_bf16(v[j][2] * sc * gg[2], v[j][3] * sc * gg[3]);
            *(u32x2*)(out16 + (size_t)r * DM + 4 * lane + 256 * j) = o2; }
    }
}
__device__ __forceinline__ void p_x16(const int wv, const float* x, bf16_t* h16, float* rs) {
    LTID();
    const int lane = tidx & 63;
    const int rstride = (int)gridDim.x * NW;
    for (int r0 = bidx * NW + wv; r0 < SEQ; r0 += 2 * rstride) {
        int rr[2]; rr[0] = r0; rr[1] = (r0 + rstride < SEQ) ? r0 + rstride : r0;
        f32x4 v[2][2][2];
#pragma unroll
        for (int q = 0; q < 2; ++q)
#pragma unroll
            for (int j = 0; j < 2; ++j) { v[q][j][0] = *(const f32x4*)(x + (size_t)rr[q] * DM + 8 * lane + 512 * j); v[q][j][1] = *(const f32x4*)(x + (size_t)rr[q] * DM + 8 * lane + 512 * j + 4); }
#pragma unroll
        for (int q = 0; q < 2; ++q) {
            if (q == 1 && r0 + rstride >= SEQ) break;
            const int r = rr[q];
            float ss = 0.f;
#pragma unroll
            for (int j = 0; j < 2; ++j)
#pragma unroll
                for (int t = 0; t < 2; ++t) ss += (v[q][j][t][0] * v[q][j][t][0] + v[q][j][t][1] * v[q][j][t][1]) + (v[q][j][t][2] * v[q][j][t][2] + v[q][j][t][3] * v[q][j][t][3]);
#pragma unroll
            for (int o = 32; o; o >>= 1) ss += shx(ss, o, lane);
            if (lane == 0) rs[r] = rsqrtf(ss * (1.f / 1024.f) + 1e-5f);
#pragma unroll
            for (int j = 0; j < 2; ++j) { u32x4 w; w.x = cvt_pk_bf16(v[q][j][0][0], v[q][j][0][1]); w.y = cvt_pk_bf16(v[q][j][0][2], v[q][j][0][3]); w.z = cvt_pk_bf16(v[q][j][1][0], v[q][j][1][1]); w.w = cvt_pk_bf16(v[q][j][1][2], v[q][j][1][3]);
                *(u32x4*)(h16 + (size_t)r * DM + 8 * lane + 512 * j) = w; }
        }
    }
}
template <bool LAST> __device__ __forceinline__ void p_combine16(const int wv, bf16_t* h16, const bf16_t* mout, const int* eslot, const float* topg, const float* g, float* rs, float* out) {
    LTID();
    const int lane = tidx & 63;
    LAS const int* ts = (LAS const int*)(LDSP + TS_OFF);
    const int rstride = (int)gridDim.x * NW;
    for (int r0 = bidx * NW + wv; r0 < SEQ; r0 += 2 * rstride) {
        int rr[2]; rr[0] = r0; rr[1] = (r0 + rstride < SEQ) ? r0 + rstride : r0;
        u32x4 hw[2][2]; int4 es[2]; f32x4 gt[2]; u32x4 mo[2][4][2];
#pragma unroll
        for (int q = 0; q < 2; ++q) { es[q] = *(const int4*)(eslot + rr[q] * 4); gt[q] = *(const f32x4*)(topg + rr[q] * 4);
#pragma unroll
            for (int j = 0; j < 2; ++j) hw[q][j] = *(const u32x4*)(h16 + (size_t)rr[q] * DM + 8 * lane + 512 * j); }
#pragma unroll
        for (int q = 0; q < 2; ++q) { const int esv[4] = {es[q].x, es[q].y, es[q].z, es[q].w};
#pragma unroll
            for (int k = 0; k < 4; ++k) { const int e = esv[k] >> 16, sl = esv[k] & 0xffff; const size_t row = (size_t)ts[e] * BM + sl;
#pragma unroll
                for (int j = 0; j < 2; ++j) mo[q][k][j] = *(const u32x4*)(mout + row * DM + 8 * lane + 512 * j); } }
        float v[2][2][8];
#pragma unroll
        for (int q = 0; q < 2; ++q)
#pragma unroll
            for (int j = 0; j < 2; ++j) { const u32x4 o = hw[q][j];
                v[q][j][0] = bflo(o.x); v[q][j][1] = bfhi(o.x); v[q][j][2] = bflo(o.y); v[q][j][3] = bfhi(o.y); v[q][j][4] = bflo(o.z); v[q][j][5] = bfhi(o.z); v[q][j][6] = bflo(o.w); v[q][j][7] = bfhi(o.w); }
#pragma unroll
        for (int q = 0; q < 2; ++q)
#pragma unroll
            for (int k = 0; k < 4; ++k) { const float gk = gt[q][k];
#pragma unroll
                for (int j = 0; j < 2; ++j) { const u32x4 o = mo[q][k][j];
                    v[q][j][0] += gk * bflo(o.x); v[q][j][1] += gk * bfhi(o.x); v[q][j][2] += gk * bflo(o.y); v[q][j][3] += gk * bfhi(o.y);
                    v[q][j][4] += gk * bflo(o.z); v[q][j][5] += gk * bfhi(o.z); v[q][j][6] += gk * bflo(o.w); v[q][j][7] += gk * bfhi(o.w); } }
#pragma unroll
        for (int q = 0; q < 2; ++q) {
            if (q == 1 && r0 + rstride >= SEQ) break;
            const int r = rr[q];
            float ss = 0.f;
#pragma unroll
            for (int j = 0; j < 2; ++j) ss += ((v[q][j][0] * v[q][j][0] + v[q][j][1] * v[q][j][1]) + (v[q][j][2] * v[q][j][2] + v[q][j][3] * v[q][j][3])) + ((v[q][j][4] * v[q][j][4] + v[q][j][5] * v[q][j][5]) + (v[q][j][6] * v[q][j][6] + v[q][j][7] * v[q][j][7]));
#pragma unroll
            for (int o = 32; o; o >>= 1) ss += shx(ss, o, lane);
            const float sc = rsqrtf(ss * (1.f / 1024.f) + 1e-5f);
#pragma unroll
            for (int j = 0; j < 2; ++j) {
                if (!LAST) { u32x4 w; w.x = cvt_pk_bf16(v[q][j][0], v[q][j][1]); w.y = cvt_pk_bf16(v[q][j][2], v[q][j][3]); w.z = cvt_pk_bf16(v[q][j][4], v[q][j][5]); w.w = cvt_pk_bf16(v[q][j][6], v[q][j][7]);
                    *(u32x4*)(h16 + (size_t)r * DM + 8 * lane + 512 * j) = w; }
                else { const f32x4 g0 = *(const f32x4*)(g + 8 * lane + 512 * j), g1 = *(const f32x4*)(g + 8 * lane + 512 * j + 4);
                    *(f32x4*)(out + (size_t)r * DM + 8 * lane + 512 * j) = (f32x4){v[q][j][0] * sc * g0[0], v[q][j][1] * sc * g0[1], v[q][j][2] * sc * g0[2], v[q][j][3] * sc * g0[3]};
                    *(f32x4*)(out + (size_t)r * DM + 8 * lane + 512 * j + 4) = (f32x4){v[q][j][4] * sc * g1[0], v[q][j][5] * sc * g1[1], v[q][j][6] * sc * g1[2], v[q][j][7] * sc * g1[3]}; }
            }
            if (!LAST) { if (lane == 0) rs[r] = sc; }
        }
    }
}
__device__ __forceinline__ void p_router_tables(const int wv, const float* w_r, const float* g, bf16_t* WR16, int rot) {
    LTID();
    for (int i = ROTB(rot) * NT + tidx; i < 32 * 1024; i += gridDim.x * NT) {
        const int e = i >> 10, k = i & 1023;
        const float w = g[k] * w_r[k * 32 + e];
        const unsigned hi = f2bf(w); const float lo = w - __builtin_bit_cast(float, hi << 16);
        WR16[i] = (bf16_t)hi; WR16[32 * 1024 + i] = (bf16_t)f2bf(lo);
    }
}
constexpr int RT_CNT_OFF = 131072 + 4608;
constexpr int RT_XCH_OFF = 131072 + 5120;
__device__ __forceinline__ void p_router2(const int wv, const bf16_t* h16, const bf16_t* WR16, const float* b_r, unsigned* gcnt, int* rowtok_e, float* rsc_e, int* eslot, float* topg, LAS unsigned char* lds) {
    LTID();
    const int lane = tidx & 63, fr = lane & 15, fq = lane >> 4, w = wv, tg = w & 3, kh = w >> 2;
#pragma unroll
    for (int part = 0; part < 2; ++part)
#pragma unroll
        for (int p = 0; p < 8; ++p) { const int row = 4 * p + (tidx >> 7), cs = tidx & 127;
            glds16s(WR16, (unsigned)(part * 65536 + row * 2048 + ((cs ^ (row & 15)) * 16)), (unsigned)(size_t)(lds + part * 65536 + p * 8192 + w * 1024)); }
    LAS int* lcnt = (LAS int*)(lds + RT_CNT_OFF);
    if (tidx < 64) lcnt[tidx] = 0;
    asm volatile("s_waitcnt vmcnt(0)" ::: "memory");
    __syncthreads();
    for (int it = bidx; it < SEQ / 64; it += gridDim.x) {
        const int token = it * 64 + 16 * tg + fr;
        const bf16_t* xr = h16 + (size_t)token * DM + 512 * kh + 8 * fq;
        f32x4 acc[2]; acc[0] = (f32x4){0.f, 0.f, 0.f, 0.f}; acc[1] = acc[0];
        float ss = 0.f;
#pragma unroll 4
        for (int s4 = 0; s4 < 16; ++s4) {
            const u32x4 hw = *(const u32x4*)(xr + 32 * s4);
            { const float x0 = bflo(hw.x), x1 = bfhi(hw.x), x2 = bflo(hw.y), x3 = bfhi(hw.y), x4 = bflo(hw.z), x5 = bfhi(hw.z), x6 = bflo(hw.w), x7 = bfhi(hw.w);
              ss += ((x0 * x0 + x1 * x1) + (x2 * x2 + x3 * x3)) + ((x4 * x4 + x5 * x5) + (x6 * x6 + x7 * x7)); }
            const bf16x8 xhi = __builtin_bit_cast(bf16x8, hw);
            const int c = 64 * kh + 4 * s4 + fq, slot = c ^ fr;
#pragma unroll
            for (int nb = 0; nb < 2; ++nb) {
                const bf16x8 whi = *(const LAS bf16x8*)(lds + (16 * nb + fr) * 2048 + slot * 16), wlo = *(const LAS bf16x8*)(lds + 65536 + (16 * nb + fr) * 2048 + slot * 16);
                acc[nb] = __builtin_amdgcn_mfma_f32_16x16x32_bf16(whi, xhi, acc[nb], 0, 0, 0);
                acc[nb] = __builtin_amdgcn_mfma_f32_16x16x32_bf16(wlo, xhi, acc[nb], 0, 0, 0);
            }
        }
        ss += shx(ss, 16, lane); ss += shx(ss, 32, lane);
        LAS float* X = (LAS float*)(lds + RT_XCH_OFF) + (tg * 64 + lane) * 9;
        if (kh == 1) {
#pragma unroll
            for (int nb = 0; nb < 2; ++nb)
#pragma unroll
                for (int j = 0; j < 4; ++j) X[nb * 4 + j] = acc[nb][j];
            X[8] = ss;
        }
        __syncthreads();
        int ti[4] = {0, 0, 0, 0}, ls[4] = {0, 0, 0, 0}; float gv[4] = {0.f, 0.f, 0.f, 0.f}; float rs = 0.f;
        if (kh == 0) {
            float lv[8];
            ss += X[8];
            rs = rsqrtf(ss * (1.f / 1024.f) + 1e-5f);
#pragma unroll
            for (int nb = 0; nb < 2; ++nb)
#pragma unroll
                for (int j = 0; j < 4; ++j) lv[nb * 4 + j] = rs * (acc[nb][j] + X[nb * 4 + j]) + b_r[16 * nb + 4 * fq + j];
            float tv[4];
#pragma unroll
            for (int r = 0; r < 4; ++r) {
                float bv = -3.0e38f; int bi = 0;
#pragma unroll
                for (int q = 0; q < 8; ++q) { const int idx = 16 * (q >> 2) + 4 * fq + (q & 3); if (lv[q] > bv) { bv = lv[q]; bi = idx; } }
#pragma unroll
                for (int mk = 16; mk <= 32; mk <<= 1) { const float ov = shx(bv, mk, lane); const int oi = shxi(bi, mk, lane); if (ov > bv || (ov == bv && oi < bi)) { bv = ov; bi = oi; } }
                tv[r] = bv; ti[r] = bi;
#pragma unroll
                for (int q = 0; q < 8; ++q) { const int idx = 16 * (q >> 2) + 4 * fq + (q & 3); if (idx == bi) lv[q] = -3.0e38f; }
            }
            float sum = 0.f;
#pragma unroll
            for (int r = 0; r < 4; ++r) { gv[r] = __expf(tv[r] - tv[0]); sum += gv[r]; }
            const float inv = 1.f / sum;
#pragma unroll
            for (int r = 0; r < 4; ++r) gv[r] *= inv;
            if (fq == 0) {
#pragma unroll
                for (int r = 0; r < 4; ++r) ls[r] = __hip_atomic_fetch_add(&lcnt[ti[r]], 1, __ATOMIC_RELAXED, __HIP_MEMORY_SCOPE_WORKGROUP);
            }
        }
        __syncthreads();
        if (tidx < 32) { const int c = lcnt[tidx]; lcnt[32 + tidx] = c ? (int)__hip_atomic_fetch_add(gcnt + tidx, (unsigned)c, __ATOMIC_RELAXED, __HIP_MEMORY_SCOPE_AGENT) : 0; }
        __syncthreads();
        if (kh == 0 && fq == 0) {
            int es[4];
#pragma unroll
            for (int r = 0; r < 4; ++r) { const int e = ti[r], sl = lcnt[32 + e] + ls[r]; rowtok_e[e * ECAP + sl] = token; rsc_e[e * ECAP + sl] = rs; es[r] = (e << 16) | sl; }
            *(int4*)(eslot + token * 4) = make_int4(es[0], es[1], es[2], es[3]);
            *(f32x4*)(topg + token * 4) = (f32x4){gv[0], gv[1], gv[2], gv[3]};
        }
        __syncthreads();
        if (tidx < 32) lcnt[tidx] = 0;
    }
    __syncthreads();
}

constexpr int NPL = 13;
constexpr int NPHASES = 1 + 2 * NPL;
typedef const __attribute__((address_space(4))) Args* KA;
#define PHASE __device__ __forceinline__
#define KAP() ({ KA _t = a; asm volatile("" : "+s"(_t)); _t; })
#define WSP(T, off) ((T*)(a->ws + (off)))

constexpr int NIT = 49152, NIT1 = 32768;
constexpr int QS0 = 5, QS1 = 8, QG = 9, QX = 13;
struct ConvBounds { int S1, S2, S3, S4; };
__device__ __forceinline__ int cmin(int a, int b) { return a < b ? a : b; }
__device__ __forceinline__ ConvBounds conv_bounds(int G, int l) {
    ConvBounds b;
    const int Px = G > 128 ? G - 128 : G, Px0 = G > 136 ? G - 136 : G;
    b.S1 = cmin(NIT, G * 8 * QS0); b.S2 = cmin(NIT, b.S1 + G * 8 * QS1);
    b.S3 = cmin(NIT, b.S2 + Px * 8 * QG); b.S4 = cmin(NIT, b.S3 + (l == 0 ? Px0 : Px) * 8 * QX);
    return b;
}
__device__ __forceinline__ void conv_moe(KA a, const int wv, int l, int begin, int end, int rank, int nranks, int scr_pitch = 16384) {
    if (begin >= end) return;
    const int wr = rank * NW + wv, ws_ = nranks * NW;
    if (begin < NIT1) p_transpose_r(wv, a->in[26] + (size_t)l * NEXP * DM * 2048, NEXP, DM, 2048, WSP(bf16_t, WS_BT1) + (size_t)l * NEXP * 2048 * DM, a->in[23] + l * DM, NEXP, 1, LDSP, begin, cmin(end, NIT1), wr, ws_, scr_pitch);
    if (end > NIT1) { const int b2 = begin > NIT1 ? begin - NIT1 : 0;
        p_transpose_r(wv, a->in[28] + (size_t)l * NEXP * DFF * DM, NEXP, DFF, DM, WSP(bf16_t, WS_BT2) + (size_t)l * NEXP * DM * DFF, nullptr, 1, 0, LDSP, b2, end - NIT1, wr, ws_, scr_pitch); }
}
__device__ __forceinline__ int moe_T_lds() { return __builtin_amdgcn_readfirstlane(((LAS const int*)(LDSP + TS_OFF))[32]); }
PHASE void ph_init(KA a, const int wv) {
    p_x16(wv, a->in[0], WSP(bf16_t, WS_HB16), WSP(float, WS_RS));
    p_bias_table(wv, a->in[2], WSP(float, WS_BIASG), 152);
    for (int l = 0; l < 2; ++l) {
        p_s5_tables2(wv, a->in[5] + l * 2048, a->in[6] + l * 2048, a->in[7] + l * 32768, a->in[8] + l * 32768, a->in[9] + l * 32768, a->in[10] + l * 32768, a->in[11] + l * 32,
                     WSP(float2, WS_ABAR) + l * 2048, WSP(float2, WS_A256) + l * 2048, WSP(bf16_t, WS_BB16) + (size_t)l * 32 * 128 * 16, WSP(bf16_t, WS_CM16) + (size_t)l * 32 * 16 * 128, 160 + 32 * l);
        p_rmsnorm16(wv, a->in[1], a->in[19] + l * DM, WSP(bf16_t, WS_MEMN16) + (size_t)l * NMEM * DM, NMEM, 224 + 16 * l);
        p_router_tables(wv, a->in[24] + (size_t)l * DM * 32, a->in[23] + l * DM, WSP(bf16_t, WS_WR16) + (size_t)l * 2 * 32 * 1024, 160 + 64 * l);
    }
    p_transpose(wv, a->in[4], 2, DM, DIN, WSP(bf16_t, WS_WT_IN), a->in[3], 1, 0, LDSP, 0);
    p_transpose(wv, a->in[13], 2, 512, 512, WSP(bf16_t, WS_WT_GLU), nullptr, 1, 0, LDSP, 0);
    p_transpose(wv, a->in[17], 2, DM, DM, WSP(bf16_t, WS_WT_OUT), nullptr, 1, 0, LDSP, 32);
    p_transpose(wv, a->in[20], 2, DM, 512, WSP(bf16_t, WS_WT_XQ), a->in[18], 1, 0, LDSP, 160);
    p_transpose(wv, a->in[21], 2, DM, 1024, WSP(bf16_t, WS_WT_XKV), nullptr, 1, 0, LDSP, 224);
    p_transpose(wv, a->in[22], 2, 512, DM, WSP(bf16_t, WS_WT_XO), nullptr, 1, 0, LDSP, 96);
    __syncthreads();
}
PHASE void ph_gemm_in(KA a, const int wv, int l) { LTID();
    DenseOrder S; S.init(WSP(bf16_t, WS_HB16), WSP(bf16_t, WS_WT_IN) + (size_t)l * DIN * DM, SEQ, DIN, DM, gridDim.x, bidx);
    EpiIn E{WSP(bf16_t, WS_PROJ16), WSP(float, WS_RS)};
    gemm_phase<EpiIn, DenseOrder, false, true>(LDSP, DM, S, E, tidx, wv);
}
PHASE void ph_attn_s5a(KA a, const int wv, int l) {
    p_dil_attn(wv, WSP(bf16_t, WS_PROJ16), WSP(float, WS_BIASG), WSP(bf16_t, WS_OBR), WSP(float, WS_LSE), LDSP);
    const ConvBounds cb = conv_bounds((int)gridDim.x, l);
    if (wv & 1) conv_moe(a, wv, l, 0, cb.S1, (int)blockIdx.x, (int)gridDim.x, 16 * S5_ROWB);
    p_s5_pass<0>(wv, WSP(bf16_t, WS_PROJ16), WSP(float2, WS_ABAR) + l * 2048, WSP(float2, WS_A256) + l * 2048, WSP(bf16_t, WS_BB16) + (size_t)l * 32 * 128 * 16, WSP(bf16_t, WS_CM16) + (size_t)l * 32 * 16 * 128,
                 a->in[12] + l * 512, WSP(float2, WS_E2), WSP(bf16_t, WS_YG16), LDSP);
    if (!(wv & 1)) conv_moe(a, wv, l, 0, cb.S1, (int)blockIdx.x, (int)gridDim.x, 16 * S5_ROWB);
}
PHASE void ph_s5b(KA a, const int wv, int l) {
    const ConvBounds cb = conv_bounds((int)gridDim.x, l);
    if (wv & 1) conv_moe(a, wv, l, cb.S1, cb.S2, (int)blockIdx.x, (int)gridDim.x, 16 * S5_ROWB);
    p_s5_pass<1>(wv, WSP(bf16_t, WS_PROJ16), WSP(float2, WS_ABAR) + l * 2048, WSP(float2, WS_A256) + l * 2048, WSP(bf16_t, WS_BB16) + (size_t)l * 32 * 128 * 16, WSP(bf16_t, WS_CM16) + (size_t)l * 32 * 16 * 128,
                 a->in[12] + l * 512, WSP(float2, WS_E2), WSP(bf16_t, WS_YG16), LDSP);
    if (!(wv & 1)) conv_moe(a, wv, l, cb.S1, cb.S2, (int)blockIdx.x, (int)gridDim.x, 16 * S5_ROWB);
}
PHASE void ph_gemm_glu(KA a, const int wv, int l) {
    {   LTID();
        DenseOrder S; S.init(WSP(bf16_t, WS_YG16), WSP(bf16_t, WS_WT_GLU) + (size_t)l * 512 * 512, SEQ, 512, 512, gridDim.x, bidx);
        EpiGlu16 E{WSP(bf16_t, WS_YB16), WSP(bf16_t, WS_YG16), a->in[14] + l * 512};
        gemm_phase<EpiGlu16, DenseOrder, false, false>(LDSP, 512, S, E, tidx, wv); }
    {   LTID();
        const int G = (int)gridDim.x; const ConvBounds cb = conv_bounds(G, l);
        if (G > 128) { if (bidx >= 128) conv_moe(a, wv, l, cb.S2, cb.S3, bidx - 128, G - 128); }
        else conv_moe(a, wv, l, cb.S2, cb.S3, bidx, G);
    }
}
PHASE void ph_mixnorm(KA a, const int wv, int l) {
    p_attn_combine(wv, WSP(bf16_t, WS_OBR), WSP(float, WS_LSE), a->in[15] + l * 512, WSP(bf16_t, WS_MIX16));
    p_ssm_norm(wv, WSP(bf16_t, WS_YB16), a->in[16] + l * 512, WSP(bf16_t, WS_MIX16));
}
PHASE void ph_gemm_out(KA a, const int wv, int l) { LTID();
    DenseOrder S; S.init(WSP(bf16_t, WS_MIX16), WSP(bf16_t, WS_WT_OUT) + (size_t)l * DM * DM, SEQ, DM, DM, gridDim.x, bidx);
    if (l == 0) { EpiRes16<true, true> E{a->in[0], WSP(bf16_t, WS_HB16), WSP(float, WS_SSP)};
        gemm_phase<EpiRes16<true, true>, DenseOrder, false, false>(LDSP, DM, S, E, tidx, wv); }
    else { EpiRes16<false, true> E{WSP(bf16_t, WS_HB16), WSP(bf16_t, WS_HB16), WSP(float, WS_SSP)};
        gemm_phase<EpiRes16<false, true>, DenseOrder, false, false>(LDSP, DM, S, E, tidx, wv); }
}
PHASE void ph_gemm_xq(KA a, const int wv, int l) {
    {   LTID();
        DenseOrder S; S.init(WSP(bf16_t, WS_HB16), WSP(bf16_t, WS_WT_XQ) + (size_t)l * 512 * DM, SEQ, 512, DM, gridDim.x, bidx);
        EpiBf16 E{WSP(bf16_t, WS_QX16), 512, 0.08838834764831845f, WSP(float, WS_SSP)};
        gemm_phase<EpiBf16, DenseOrder, false, false>(LDSP, DM, S, E, tidx, wv); }
    {   LTID();
    const int cc = (int)gridDim.x - 1 - bidx;
    if (l == 0 && cc < 8) {
        const int kl = cc >> 2;
        DenseOrder S; S.init(WSP(bf16_t, WS_MEMN16) + (size_t)kl * NMEM * DM, WSP(bf16_t, WS_WT_XKV) + (size_t)kl * 1024 * DM, NMEM, 1024, DM, 4, cc & 3);
        EpiBf16 E{WSP(bf16_t, WS_KV16) + (size_t)kl * NMEM * 1024, 1024, 1.f, nullptr};
        gemm_phase<EpiBf16, DenseOrder, false, false>(LDSP, DM, S, E, tidx, wv);
    } }
    {   LTID();
        const int G = (int)gridDim.x; const ConvBounds cb = conv_bounds(G, l);
        const int skip = (l == 0) ? 8 : 0;
        if (G > 128 + skip) { if (bidx >= 128 && bidx < G - skip) conv_moe(a, wv, l, cb.S3, cb.S4, bidx - 128, G - 128 - skip); }
        else conv_moe(a, wv, l, cb.S3, cb.S4, bidx, G);
    }
}
PHASE void ph_xattn(KA a, const int wv, int l) { p_xattn_mfma(wv, WSP(bf16_t, WS_QX16), WSP(bf16_t, WS_KV16) + (size_t)l * NMEM * 1024, WSP(bf16_t, WS_OX16), LDSP); }
PHASE void ph_gemm_xo(KA a, const int wv, int l) { LTID();
    DenseOrder S; S.init(WSP(bf16_t, WS_OX16), WSP(bf16_t, WS_WT_XO) + (size_t)l * DM * 512, SEQ, DM, 512, gridDim.x, bidx);
    EpiRes16<false, false> E{WSP(bf16_t, WS_HB16), WSP(bf16_t, WS_HB16), nullptr};
    gemm_phase<EpiRes16<false, false>, DenseOrder, false, false>(LDSP, 512, S, E, tidx, wv);
}
PHASE void ph_router(KA a, const int wv, int l) {
    {   LTID();
        const int G = (int)gridDim.x; const ConvBounds cb = conv_bounds(G, l);
        conv_moe(a, wv, l, cb.S4, NIT, bidx, G);
        __syncthreads();
    }
    p_router2(wv, WSP(bf16_t, WS_HB16), WSP(bf16_t, WS_WR16) + (size_t)l * 2 * 32 * 1024, a->in[25] + l * 32, WSP(unsigned, WS_CTL) + CW_CNT + l * 32,
              WSP(int, WS_ROWTOK), WSP(float, WS_RSC), WSP(int, WS_ESLOT), WSP(float, WS_TOPG), LDSP);
}
PHASE void ph_moe1(KA a, const int wv, int l) {
    {   LTID();
        moe_tiles(WSP(unsigned, WS_CTL) + CW_CNT + l * 32, tidx);
        MoeOrder<true> S; S.init(WSP(bf16_t, WS_HB16), WSP(bf16_t, WS_BT1) + (size_t)l * NEXP * 2048 * DM, WSP(int, WS_ROWTOK), 2048, DM, (size_t)2048 * DM * 2, gridDim.x, bidx);
        EpiMoe1 E{WSP(bf16_t, WS_ACT), a->in[27] + (size_t)l * NEXP * 2048, WSP(float, WS_RSC)};
        gemm_phase<EpiMoe1, MoeOrder<true>, true, true>(LDSP, DM, S, E, tidx, wv); }
}
PHASE void ph_moe2(KA a, const int wv, int l) {
    {   LTID();
        moe_tiles(WSP(unsigned, WS_CTL) + CW_CNT + l * 32, tidx);
        MoeOrder<false> S; S.init(WSP(bf16_t, WS_ACT), WSP(bf16_t, WS_BT2) + (size_t)l * NEXP * DM * DFF, nullptr, DM, DFF, (size_t)DM * DFF * 2, gridDim.x, bidx);
        EpiMoe2 E{WSP(bf16_t, WS_MOUT), a->in[29] + (size_t)l * NEXP * DM};
        gemm_phase<EpiMoe2, MoeOrder<false>, false, true>(LDSP, DFF, S, E, tidx, wv); }
}
PHASE void ph_combine(KA a, const int wv, int l) { LTID();
    moe_tiles(WSP(unsigned, WS_CTL) + CW_CNT + l * 32, tidx);
    if (l == 0) p_combine16<false>(wv, WSP(bf16_t, WS_HB16), WSP(bf16_t, WS_MOUT), WSP(int, WS_ESLOT), WSP(float, WS_TOPG), nullptr, WSP(float, WS_RS), nullptr);
    else p_combine16<true>(wv, WSP(bf16_t, WS_HB16), WSP(bf16_t, WS_MOUT), WSP(int, WS_ESLOT), WSP(float, WS_TOPG), a->in[30], nullptr, a->out);
}

__global__ void __launch_bounds__(NT, 2) mega(Args args) {
    KA a = (KA)__builtin_amdgcn_kernarg_segment_ptr();
    int wv = __builtin_amdgcn_readfirstlane((int)threadIdx.x >> 6); asm volatile("" : "+s"(wv));
    LAS unsigned char* lds = LDSP;
    volatile LAS unsigned* MISC = (volatile LAS unsigned*)(lds + MISC_OFF);
    unsigned* ctl = (unsigned*)(a->ws + WS_CTL);
    if (threadIdx.x < 32) MISC[threadIdx.x] = 0u;
    __syncthreads();
    XcdBarrier bar; bar.bar = ctl + CW_BAR; bar.x = 0; bar.st = nullptr;
    if (!MK_PER_PHASE) bar = xcd_barrier_post(ctl + CW_BAR, MISC + 8);
    const int lo = a->ph_lo, hi = a->ph_hi;
#define IN(k) (lo <= (k) && (k) < hi)
#define SEAM(k) do { if (IN(k) && IN((k) + 1)) { LTID(); xcd_barrier(bar.bar, bar.x, bar.st, tidx == 0); if (PROBE_DUP == 200) xcd_barrier(bar.bar, bar.x, bar.st, tidx == 0); } } while (0)
    if (IN(0)) { ph_init(KAP(), wv); if (PROBE_DUP == 100) ph_init(KAP(), wv); }
    SEAM(0);
#define LAYER_PROGRAM(l) { const int pb = 1 + (l) * NPL; \
        if (IN(pb + 0)) { ph_gemm_in(KAP(), wv, (l)); if (PROBE_DUP == 0) { ph_gemm_in(KAP(), wv, (l)); } } \
        SEAM(pb + 0); \
        if (IN(pb + 1)) { ph_attn_s5a(KAP(), wv, (l)); if (PROBE_DUP == 1) { ph_attn_s5a(KAP(), wv, (l)); } } \
        SEAM(pb + 1); \
        if (IN(pb + 2)) { ph_s5b(KAP(), wv, (l)); if (PROBE_DUP == 2) { ph_s5b(KAP(), wv, (l)); } } \
        SEAM(pb + 2); \
        if (IN(pb + 3)) { ph_gemm_glu(KAP(), wv, (l)); if (PROBE_DUP == 3) { ph_gemm_glu(KAP(), wv, (l)); } } \
        SEAM(pb + 3); \
        if (IN(pb + 4)) { ph_mixnorm(KAP(), wv, (l)); if (PROBE_DUP == 4) { ph_mixnorm(KAP(), wv, (l)); } } \
        SEAM(pb + 4); \
        if (IN(pb + 5)) { ph_gemm_out(KAP(), wv, (l)); if (PROBE_DUP == 5) { ph_gemm_out(KAP(), wv, (l)); } } \
        SEAM(pb + 5); \
        if (IN(pb + 6)) { ph_gemm_xq(KAP(), wv, (l)); if (PROBE_DUP == 6) { ph_gemm_xq(KAP(), wv, (l)); } } \
        SEAM(pb + 6); \
        if (IN(pb + 7)) { ph_xattn(KAP(), wv, (l)); if (PROBE_DUP == 7) { ph_xattn(KAP(), wv, (l)); } } \
        SEAM(pb + 7); \
        if (IN(pb + 8)) { ph_gemm_xo(KAP(), wv, (l)); if (PROBE_DUP == 8) { ph_gemm_xo(KAP(), wv, (l)); } } \
        SEAM(pb + 8); \
        if (IN(pb + 9)) { ph_router(KAP(), wv, (l)); if (PROBE_DUP == 9) { ph_router(KAP(), wv, (l)); } } \
        SEAM(pb + 9); \
        if (IN(pb + 10)) { ph_moe1(KAP(), wv, (l)); if (PROBE_DUP == 10) { ph_moe1(KAP(), wv, (l)); } } \
        SEAM(pb + 10); \
        if (IN(pb + 11)) { ph_moe2(KAP(), wv, (l)); if (PROBE_DUP == 11) { ph_moe2(KAP(), wv, (l)); } } \
        SEAM(pb + 11); \
        if (IN(pb + 12)) { ph_combine(KAP(), wv, (l)); if (PROBE_DUP == 12) { ph_combine(KAP(), wv, (l)); } } \
        SEAM(pb + 12); }
    LAYER_PROGRAM(0)
    LAYER_PROGRAM(1)
#undef LAYER_PROGRAM
#undef IN
#undef SEAM
}

extern "C" void kernel_launch(void* const* d_in, const int* in_sizes, int n_in, void* d_out, int out_size, void* d_ws, size_t ws_size, hipStream_t stream) {
    static int grid = 0;
    if (grid == 0) {
        if (n_in != 31 || ws_size < WS_END) { fprintf(stderr, "kernel_launch: unexpected n_in %d or ws_size %zu (need %zu)\n", n_in, ws_size, (size_t)WS_END); grid = -1; return; }
        int dev = 0, cus = 0, per_cu = 0;
        if (hipGetDevice(&dev) != hipSuccess || hipDeviceGetAttribute(&cus, hipDeviceAttributeMultiprocessorCount, dev) != hipSuccess) { grid = -1; return; }
        if (hipFuncSetAttribute((const void*)mega, hipFuncAttributeMaxDynamicSharedMemorySize, LDS_BYTES) != hipSuccess) { fprintf(stderr, "kernel_launch: hipFuncSetAttribute failed\n"); grid = -1; return; }
        if (hipOccupancyMaxActiveBlocksPerMultiprocessor(&per_cu, (const void*)mega, NT, LDS_BYTES) != hipSuccess || per_cu < 1)
            fprintf(stderr, "kernel_launch: occupancy query reports %d workgroups per CU\n", per_cu);
        (void)hipGetLastError();
        grid = cus;
    }
    if (grid < 0) return;
    if (hipMemsetAsync((char*)d_ws + WS_CTL, 0, CTL_ZERO_BYTES, stream) != hipSuccess) return;
    Args a{};
    for (int i = 0; i < 31; ++i) a.in[i] = (const float*)d_in[i];
    a.out = (float*)d_out; a.ws = (unsigned char*)d_ws;
#if MK_PER_PHASE
    for (int p = 0; p < NPHASES; ++p) { a.ph_lo = p; a.ph_hi = p + 1; hipLaunchKernelGGL(mega, dim3(grid), dim3(NT), LDS_BYTES, stream, a); }
#else
    a.ph_lo = 0; a.ph_hi = NPHASES;
    hipLaunchKernelGGL(mega, dim3(grid), dim3(NT), LDS_BYTES, stream, a);
#endif
}
```

```cpp
#include <hip/hip_runtime.h>
#include <stdint.h>
#include <cstdio>

#ifndef PROBE_AMP_LO
#define PROBE_AMP_LO -1
#define PROBE_AMP_HI -1
#define PROBE_AMP_K 4
#endif
#ifndef PROBE_DUP
#define PROBE_DUP -1
#endif
#ifndef MK_PER_PHASE
#define MK_PER_PHASE 0
#endif

#define SEQ 16384
#define DM 1024
#define DIN 2048
#define NMEM 256
#define NEXP 32
#define TOPK 4
#define DFF 1024
#define NT 512
#define NW 8

#define LAS __attribute__((address_space(3)))
typedef float f32x4 __attribute__((ext_vector_type(4)));
typedef float f32x2 __attribute__((ext_vector_type(2)));
extern __shared__ __attribute__((aligned(16))) unsigned char lds_raw[];
#define LDSP ((LAS unsigned char*)lds_raw)
#define LTID() int z_ = 0; asm volatile("" : "+v"(z_)); const int lane_ = (int)__builtin_amdgcn_mbcnt_hi(~0u, __builtin_amdgcn_mbcnt_lo(~0u, (unsigned)z_)); \
    const int tidx = wv * 64 + lane_; int bidx = blockIdx.x; asm volatile("" : "+s"(bidx))
#define ROTB(rot) ((bidx + (int)gridDim.x - (rot) % (int)gridDim.x) % (int)gridDim.x)
__device__ __forceinline__ float shx(float v, int mask, int lane) { return __builtin_bit_cast(float, __builtin_amdgcn_ds_bpermute((lane ^ mask) << 2, __builtin_bit_cast(int, v))); }
__device__ __forceinline__ int shxi(int v, int mask, int lane) { return __builtin_amdgcn_ds_bpermute((lane ^ mask) << 2, v); }
constexpr int LDS_BYTES = 147456;
constexpr int MISC_OFF = 131072 + 320;

#define XB_TMO      128
#define XB_XCNT(j)  (256  + 64 * (j))
#define XB_XSUB(j)  (1280 + 64 * (j))
#define XB_XGEN(j)  (2304 + 64 * (j))
#define XB_TOP      3328
#define XB_TOPGEN   3392
#define XCD_BAR_WORDS 3456
#define XB_SPIN_CAP (1u << 18)

__device__ __forceinline__ unsigned xb_ld(unsigned* p)              { return __hip_atomic_load(p, __ATOMIC_RELAXED, __HIP_MEMORY_SCOPE_AGENT); }
__device__ __forceinline__ unsigned xb_add(unsigned* p, unsigned v) { return __hip_atomic_fetch_add(p, v, __ATOMIC_RELAXED, __HIP_MEMORY_SCOPE_AGENT); }
__device__ __forceinline__ unsigned xb_xcc_id() { return (unsigned)__builtin_amdgcn_s_getreg((3 << 11) | 20) & 0xFu; }
#define XB_SPIN(cond, bar) do { unsigned _sp = 0; while (cond) { __builtin_amdgcn_s_sleep(1); \
    if ((++_sp & 255u) == 0u) { if (xb_ld(&(bar)[XB_TMO])) break; if (_sp > XB_SPIN_CAP) { atomicAdd(&(bar)[XB_TMO], 1u); break; } } } } while (0)

struct XcdBarrier {
    unsigned* bar; unsigned x;
    volatile LAS unsigned* st;
};
__device__ __forceinline__ XcdBarrier xcd_barrier_post(unsigned* bar, volatile LAS unsigned* st) {
    XcdBarrier b; b.bar = bar; b.x = xb_xcc_id(); b.st = st;
    if (threadIdx.x == 0) (void)xb_add(&bar[XB_XCNT(b.x)], 1u);
    return b;
}
__device__ __forceinline__ void xcd_barrier_complete(unsigned* bar, unsigned x, unsigned& nloc, unsigned& nx) {
    const unsigned G = gridDim.x * gridDim.y * gridDim.z;
    unsigned sum, cnt, mine, sp = 0u;
    for (;;) {
        sum = 0u; cnt = 0u; mine = 0u;
#pragma unroll
        for (unsigned j = 0; j < 16; ++j) { const unsigned c = xb_ld(&bar[XB_XCNT(j)]); sum += c; cnt += (c > 0u) ? 1u : 0u; mine = (j == x) ? c : mine; }
        if (sum == G) break;
        __builtin_amdgcn_s_sleep(1);
        if ((++sp & 255u) == 0u) { if (xb_ld(&bar[XB_TMO])) break; if (sp > XB_SPIN_CAP) { atomicAdd(&bar[XB_TMO], 1u); break; } }
    }
    nloc = mine > 0u ? mine : 1u; nx = cnt > 0u ? cnt : 1u;
}
__device__ __noinline__ void xcd_barrier(unsigned* bar_, unsigned x_, volatile LAS unsigned* st_, int is_t0) {
    XcdBarrier b; b.bar = bar_; b.x = x_; b.st = st_;
    asm volatile("s_waitcnt vmcnt(0)" ::: "memory");
    __syncthreads();
    if (is_t0) {
        unsigned* bar = b.bar;
        __builtin_amdgcn_s_waitcnt(0);
        unsigned nloc = b.st[0], nx = b.st[1];
        if (nloc == 0u) { xcd_barrier_complete(bar, b.x, nloc, nx); b.st[0] = nloc; b.st[1] = nx; }
        const unsigned old = xb_add(&bar[XB_XSUB(b.x)], 1u);
        const unsigned gen = old / nloc;
        if (old + 1u == (gen + 1u) * nloc) {
            __builtin_amdgcn_fence(__ATOMIC_RELEASE, "agent");
            asm volatile("s_waitcnt vmcnt(0)" ::: "memory");
            const unsigned og = xb_add(&bar[XB_TOP], 1u);
            const unsigned tg = og / nx;
            if (og + 1u == (tg + 1u) * nx) xb_add(&bar[XB_TOPGEN], 1u);
            else XB_SPIN(xb_ld(&bar[XB_TOPGEN]) == tg, bar);
            __builtin_amdgcn_fence(__ATOMIC_ACQUIRE, "agent");
            xb_add(&bar[XB_XGEN(b.x)], 1u);
            asm volatile("s_waitcnt vmcnt(0)" ::: "memory");
        } else {
            XB_SPIN(xb_ld(&bar[XB_XGEN(b.x)]) == gen, bar);
            __builtin_amdgcn_fence(__ATOMIC_ACQUIRE, "agent");
            asm volatile("s_waitcnt vmcnt(0)" ::: "memory");
        }
    }
    __syncthreads();
}

constexpr size_t MiB = 1u << 20;
constexpr size_t WS_CTL = 0, CTL_ZERO_BYTES = 64 * 1024;
constexpr int CW_BAR = 4096;
constexpr int CW_CNT = 8192;
constexpr int CW_MX = 8192 + 192;
constexpr int MOE_ROWS = SEQ * TOPK + NEXP * 256;
constexpr int ECAP = SEQ;
constexpr size_t al256(size_t x) { return (x + 255) & ~(size_t)255; }
constexpr size_t WS_H = 2 * MiB;
constexpr size_t WS_XN16 = WS_H + (size_t)SEQ * DM * 4;
constexpr size_t WS_RS = WS_H;
constexpr size_t WS_HB16 = WS_XN16 + (size_t)SEQ * DM * 2;
constexpr size_t WS_PROJ16 = WS_HB16 + (size_t)SEQ * DM * 2;
constexpr size_t WS_OBR = WS_PROJ16 + (size_t)SEQ * 2048 * 2;
constexpr size_t WS_LSE = WS_OBR + 3 * (size_t)SEQ * 512 * 2;
constexpr size_t WS_YG16 = WS_LSE + 3 * (size_t)SEQ * 8 * 4;
constexpr size_t WS_YB16 = WS_YG16 + (size_t)SEQ * 512 * 2;
constexpr size_t WS_MIX16 = WS_YB16 + (size_t)SEQ * 512 * 2;
constexpr size_t WS_QX16 = WS_MIX16 + (size_t)SEQ * DM * 2;
constexpr size_t WS_OX16 = WS_QX16 + (size_t)SEQ * 512 * 2;
constexpr size_t WS_ACT = WS_OX16 + (size_t)SEQ * 512 * 2;
constexpr size_t WS_MOUT = WS_ACT + (size_t)MOE_ROWS * DFF * 2;
constexpr size_t WS_BT1 = WS_MOUT + (size_t)MOE_ROWS * DM * 2;
constexpr size_t WS_BT2 = WS_BT1 + 2 * (size_t)NEXP * 2048 * DM * 2;
constexpr size_t WS_WT_IN = WS_BT2 + 2 * (size_t)NEXP * DM * DFF * 2;
constexpr size_t WS_WT_GLU = WS_WT_IN + 2 * (size_t)2048 * 1024 * 2;
constexpr size_t WS_WT_OUT = WS_WT_GLU + 2 * (size_t)512 * 512 * 2;
constexpr size_t WS_WT_XQ = WS_WT_OUT + 2 * (size_t)1024 * 1024 * 2;
constexpr size_t WS_WT_XKV = WS_WT_XQ + 2 * (size_t)512 * 1024 * 2;
constexpr size_t WS_WT_XO = WS_WT_XKV + 2 * (size_t)1024 * 1024 * 2;
constexpr size_t WS_MEMN16 = WS_WT_XO + 2 * (size_t)1024 * 512 * 2;
constexpr size_t WS_KV16 = WS_MEMN16 + 2 * (size_t)NMEM * 1024 * 2;
constexpr size_t WS_WR16 = WS_KV16 + 2 * (size_t)NMEM * 1024 * 2;
constexpr size_t WS_BIASG = WS_WR16 + 2 * 2 * (size_t)32 * 1024 * 2;
constexpr size_t WS_ABAR = al256(WS_BIASG + 24 * 132 * 4);
constexpr size_t WS_A256 = WS_ABAR + 2 * 2048 * 8;
constexpr size_t WS_BB16 = WS_A256 + 2 * 2048 * 8;
constexpr size_t WS_CM16 = WS_BB16 + 2 * (size_t)32 * 128 * 16 * 2;
constexpr size_t WS_E2 = WS_CM16 + 2 * (size_t)32 * 16 * 128 * 2;
constexpr size_t WS_ROWTOK = WS_E2 + (size_t)64 * 2048 * 8;
constexpr size_t WS_RSC = WS_ROWTOK + (size_t)NEXP * ECAP * 4;
constexpr size_t WS_ESLOT = WS_RSC + (size_t)NEXP * ECAP * 4;
constexpr size_t WS_TOPG = WS_ESLOT + (size_t)SEQ * 4 * 4;
constexpr size_t WS_SSP = WS_TOPG + (size_t)SEQ * 4 * 4;
constexpr size_t WS_END = WS_SSP + (size_t)SEQ * 16 * 4;

struct Args { const float* in[31]; float* out; unsigned char* ws; int ph_lo, ph_hi; };


typedef unsigned short bf16_t;
typedef short bf16x8 __attribute__((ext_vector_type(8)));
typedef unsigned u32x4 __attribute__((ext_vector_type(4)));
typedef unsigned u32x2 __attribute__((ext_vector_type(2)));
constexpr int BM = 256, BK = 64, HALF = 128, HTB = HALF * BK * 2, STAGE_BYTES = 8 * HTB, NXCD = 8, WGM = 4, WGM_MOE = 1;
__host__ __device__ __forceinline__ int lds_byte(int r, int c) { const int st = (r >> 4) * 2 + (c >> 5), rr = r & 15, cc = c & 31, ob = rr * 64 + cc * 2; return st * 1024 + (ob ^ (((ob >> 9) & 1) << 5)); }
__host__ __device__ __forceinline__ void stage_rc(int b, int& R, int& C) { const int st = b / 1024, sb = b % 1024, swz = sb ^ (((sb >> 9) & 1) << 5); R = (st >> 1) * 16 + swz / 64; C = (st & 1) * 32 + (swz % 64) / 2; }
__host__ __device__ __forceinline__ int perm32(int rho) { const int n = rho >> 4, i = rho & 15; return 8 * (i >> 2) + 4 * n + (i & 3); }
__device__ __forceinline__ unsigned cvt_pk_bf16(float lo, float hi) { unsigned r; asm volatile("v_cvt_pk_bf16_f32 %0, %1, %2" : "=v"(r) : "v"(lo), "v"(hi)); return r; }
__device__ __forceinline__ unsigned f2bf(float f) { unsigned u = __builtin_bit_cast(unsigned, f); return (u + 0x7fffu + ((u >> 16) & 1u)) >> 16; }
__device__ __forceinline__ unsigned pk2(float lo, float hi) { return f2bf(lo) | (f2bf(hi) << 16); }
__device__ __forceinline__ float bf2f(unsigned short b) { return __builtin_bit_cast(float, ((unsigned)b) << 16); }

__device__ __forceinline__ void glds16s(const void* sbase, unsigned voff, unsigned lds_dst) {
    unsigned keep;
    asm volatile("s_mov_b32 %0, m0\n\ts_mov_b32 m0, %3\n\ts_nop 0\n\tglobal_load_lds_dwordx4 %1, %2\n\ts_mov_b32 m0, %0" : "=&s"(keep) : "v"(voff), "s"(sbase), "s"(lds_dst) : "memory");
}
struct GUnit { const char* A; const char* B; int pm, pn, e, row0, cnt; };

struct DenseOrder {
    const char* A; const char* Bt; int nM, nN, nwg, G, c, K;
    __device__ __forceinline__ void init(const bf16_t* A_, const bf16_t* Bt_, int M, int N, int K_, int G_, int c_) { A = (const char*)A_; Bt = (const char*)Bt_; nM = M / BM; nN = N / BM; nwg = nM * nN; G = G_; c = c_; K = K_; }
    __device__ __forceinline__ bool next(int i, GUnit& u) const {
        const long L = (long)i * G + c; if (L >= nwg) return false;
        int wgid = (int)L; { const int q = nwg / NXCD, r = nwg % NXCD, xcd = wgid % NXCD, off = wgid / NXCD; wgid = (xcd < r ? xcd * (q + 1) : r * (q + 1) + (xcd - r) * q) + off; }
        const int nig = WGM * nN, gid = wgid / nig, fm = gid * WGM, gsz = (nM - fm) < WGM ? (nM - fm) : WGM;
        u.pm = fm + ((wgid % nig) % gsz); u.pn = (wgid % nig) / gsz; u.e = 0; u.row0 = 0; u.cnt = 0;
        u.A = A + (size_t)u.pm * BM * K * 2; u.B = Bt + (size_t)u.pn * BM * K * 2; return true;
    }
    __device__ __forceinline__ unsigned aoff(const GUnit&, int row) const { return (unsigned)(row * K * 2); }
    __device__ __forceinline__ unsigned tokoff(const GUnit&, int) const { return 0u; }
    __device__ __forceinline__ const int* tokbase() const { return nullptr; }
};

struct EpiF32 {
    static constexpr bool PERM = false;
    float* C; int ldc; int resid;
    __device__ __forceinline__ void operator()(const f32x4 (&acc)[2][2][4][2], const GUnit& u, int wr, int wc, int fr, int fq) const {
        const int row0 = u.pm * BM + wr * 64 + fr, col0 = u.pn * BM + wc * 32 + 4 * fq;
#pragma unroll
        for (int ai = 0; ai < 2; ++ai)
#pragma unroll
            for (int m = 0; m < 4; ++m) { float* rowp = C + (size_t)(row0 + ai * HALF + m * 16) * ldc + col0;
#pragma unroll
                for (int bj = 0; bj < 2; ++bj)
#pragma unroll
                    for (int n = 0; n < 2; ++n) { f32x4 v = acc[ai][bj][m][n]; if (resid) v += *(const f32x4*)(rowp + bj * HALF + n * 16); *(f32x4*)(rowp + bj * HALF + n * 16) = v; } }
    }
};
struct EpiGlu {
    static constexpr bool PERM = false;
    float* C; const float* Y; int ldc; const float* bias;
    __device__ __forceinline__ void operator()(const f32x4 (&acc)[2][2][4][2], const GUnit& u, int wr, int wc, int fr, int fq) const {
        const int row0 = u.pm * BM + wr * 64 + fr, col0 = u.pn * BM + wc * 32 + 4 * fq;
#pragma unroll
        for (int ai = 0; ai < 2; ++ai)
#pragma unroll
            for (int m = 0; m < 4; ++m) { const size_t ro = (size_t)(row0 + ai * HALF + m * 16) * ldc + col0;
#pragma unroll
                for (int bj = 0; bj < 2; ++bj)
#pragma unroll
                    for (int n = 0; n < 2; ++n) { const f32x4 b = *(const f32x4*)(bias + col0 + bj * HALF + n * 16); const f32x4 y = *(const f32x4*)(Y + ro + bj * HALF + n * 16);
                        f32x4 v = acc[ai][bj][m][n] + b; f32x4 o;
#pragma unroll
                        for (int j = 0; j < 4; ++j) o[j] = y[j] / (1.f + __expf(-v[j]));
                        *(f32x4*)(C + ro + bj * HALF + n * 16) = o; } }
    }
};

template <class Epi, class Sched, bool GATHER, bool ALIGN_EPI>
__device__ __forceinline__ void gemm_phase(LAS unsigned char* lds, const int K, const Sched& S, const Epi& E, const int tid, const int wv) {
    const int wid = wv, lane = tid & 63, wr = wid >> 2, wc = wid & 3, fr = lane & 15, fq = lane >> 4;
    const int nt = K / BK;
    unsigned voffB[2];
#pragma unroll
    for (int i = 0; i < 2; ++i) { int R, C; stage_rc(tid * 16 + i * 8192, R, C); const int Rb = Epi::PERM ? ((R & ~31) + perm32(R & 31)) : R; voffB[i] = (unsigned)(Rb * K + C) * 2u; }
#define PG8_AOFFS(dst, u) do { int t2_ = tid; asm volatile("" : "+v"(t2_)); _Pragma("unroll") for (int i = 0; i < 2; ++i) { int R, C; stage_rc(t2_ * 16 + i * 8192, R, C); \
        _Pragma("unroll") for (int h = 0; h < 2; ++h) dst[h][i] = S.aoff(u, h * HALF + R) + (unsigned)C * 2u; } } while (0)
    const size_t kstep = (size_t)(BK * 2);
    const size_t hstep = (size_t)HALF * K * 2;
    const unsigned ldsw = (unsigned)wid * 1024u;
    const int aoff = lds_byte(wr * 64 + fr, fq * 8), boff = lds_byte(wc * 32 + fr, fq * 8);
#define PG8_SA(b, h) (((b) * 2 + (h)) * HTB)
#define PG8_SB(b, h) ((4 + (b) * 2 + (h)) * HTB)
#define PG8_STAGE(bufoff, gbase, v0, v1) do { const unsigned ld_ = (unsigned)(size_t)(lds + (bufoff) + ldsw); glds16s((gbase), (v0), ld_); glds16s((gbase), (v1), ld_ + 8192u); } while (0)
#define PG8_LDA(dst, b, h) do { _Pragma("unroll") for (int m = 0; m < 4; ++m) _Pragma("unroll") for (int k = 0; k < 2; ++k) dst[m][k] = *(const LAS bf16x8*)(lds + PG8_SA(b, h) + aoff + m * 2048 + k * 1024); } while (0)
#define PG8_LDB(dst, b, h) do { _Pragma("unroll") for (int n = 0; n < 2; ++n) _Pragma("unroll") for (int k = 0; k < 2; ++k) dst[n][k] = *(const LAS bf16x8*)(lds + PG8_SB(b, h) + boff + n * 2048 + k * 1024); } while (0)
#define PG8_MMA(ai, bj, At, Bt) do { __builtin_amdgcn_s_setprio(1); _Pragma("unroll") for (int m = 0; m < 4; ++m) _Pragma("unroll") for (int n = 0; n < 2; ++n) _Pragma("unroll") for (int k = 0; k < 2; ++k) \
        acc[ai][bj][m][n] = __builtin_amdgcn_mfma_f32_16x16x32_bf16(Bt[n][k], At[m][k], acc[ai][bj][m][n], 0, 0, 0); __builtin_amdgcn_s_setprio(0); } while (0)
#define PG8_WAIT_V(n) asm volatile("s_waitcnt vmcnt(" #n ")" ::: "memory")
#define PG8_WAIT_L(n) asm volatile("s_waitcnt lgkmcnt(" #n ")" ::: "memory")
#define PG8_BAR __builtin_amdgcn_s_barrier()
#define PG8_SCHED __builtin_amdgcn_sched_barrier(0)
    GUnit cur, nxt; int ui = 0;
    if (!S.next(0, cur)) return;
    f32x4 acc[2][2][4][2];
#pragma unroll
    for (int a = 0; a < 2; ++a)
#pragma unroll
        for (int b = 0; b < 2; ++b)
#pragma unroll
            for (int m = 0; m < 4; ++m)
#pragma unroll
                for (int n = 0; n < 2; ++n) acc[a][b][m][n] = (f32x4){0.f, 0.f, 0.f, 0.f};
    bf16x8 At[4][2], B0[2][2], B1[2][2];
    unsigned vA[2][2], vN[2][2];
    PG8_AOFFS(vA, cur);
#pragma unroll
    for (int h = 0; h < 2; ++h)
#pragma unroll
        for (int i = 0; i < 2; ++i) vN[h][i] = vA[h][i];
    const char* cA = cur.A; const char* cB = cur.B;
    PG8_STAGE(PG8_SB(0, 0), cB, voffB[0], voffB[1]); PG8_STAGE(PG8_SB(0, 1), cB + hstep, voffB[0], voffB[1]); PG8_STAGE(PG8_SA(0, 0), cA, vA[0][0], vA[0][1]); PG8_STAGE(PG8_SA(0, 1), cA, vA[1][0], vA[1][1]);
    if (wr == 1) PG8_BAR;
    PG8_WAIT_V(2); PG8_BAR;
    PG8_STAGE(PG8_SB(1, 0), cB + kstep, voffB[0], voffB[1]); PG8_STAGE(PG8_SA(1, 0), cA + kstep, vA[0][0], vA[0][1]); PG8_STAGE(PG8_SB(1, 1), cB + hstep + kstep, voffB[0], voffB[1]);
    PG8_WAIT_V(6); PG8_BAR;
    for (;;) {
        const bool has_next = S.next(ui + 1, nxt);
        const char* nA = GATHER ? cA : (has_next ? nxt.A : cA); const char* nB = has_next ? nxt.B : cB;
        unsigned tok_[2][2] = {{0u, 0u}, {0u, 0u}};
#define PG8_KBODY(a1, a2, b2, a3, b3, W00, W01, W10, W11) do { \
              \
            PG8_LDB(B0, 0, 0); PG8_LDB(B1, 0, 1); PG8_SCHED; PG8_LDA(At, 0, 0); PG8_STAGE(PG8_SA(1, 1), a1, vA[1][0], vA[1][1]); \
            PG8_WAIT_V(8); PG8_WAIT_L(0); PG8_BAR; PG8_MMA(0, 0, At, B0); PG8_MMA(0, 1, At, B1); PG8_BAR; PG8_SCHED; \
              \
            PG8_LDA(At, 0, 1); PG8_STAGE(PG8_SB(0, 0), b2, voffB[0], voffB[1]); PG8_STAGE(PG8_SB(0, 1), (b2) + hstep, voffB[0], voffB[1]); PG8_STAGE(PG8_SA(0, 0), a2, W00, W01); \
            PG8_WAIT_V(8); PG8_WAIT_L(0); PG8_BAR; PG8_MMA(1, 0, At, B0); PG8_MMA(1, 1, At, B1); PG8_BAR; PG8_SCHED; \
              \
            PG8_LDB(B0, 1, 0); PG8_LDB(B1, 1, 1); PG8_SCHED; PG8_LDA(At, 1, 0); PG8_STAGE(PG8_SA(0, 1), a2, W10, W11); \
            PG8_WAIT_V(8); PG8_WAIT_L(0); PG8_BAR; PG8_MMA(0, 0, At, B0); PG8_MMA(0, 1, At, B1); PG8_BAR; PG8_SCHED; \
              \
            PG8_LDA(At, 1, 1); PG8_STAGE(PG8_SB(1, 0), b3, voffB[0], voffB[1]); PG8_STAGE(PG8_SB(1, 1), (b3) + hstep, voffB[0], voffB[1]); PG8_STAGE(PG8_SA(1, 0), a3, W00, W01); \
            PG8_WAIT_V(8); PG8_WAIT_L(0); PG8_BAR; PG8_MMA(1, 0, At, B0); PG8_MMA(1, 1, At, B1); PG8_BAR; PG8_SCHED; } while (0)
        for (int t = 0; t < nt - 2; t += 2) {
            const char* a1 = cA + (size_t)(t + 1) * kstep;
            const char* a2 = cA + (size_t)(t + 2) * kstep; const char* b2 = cB + (size_t)(t + 2) * kstep;
            const char* a3 = a2 + kstep; const char* b3 = b2 + kstep;
            if (GATHER) { if (t == nt - 4 && has_next) { int t2_ = tid; asm volatile("" : "+v"(t2_));
#pragma unroll
                for (int i = 0; i < 2; ++i) { int R, C; stage_rc(t2_ * 16 + i * 8192, R, C);
#pragma unroll
                    for (int h = 0; h < 2; ++h) { const unsigned vo = S.tokoff(nxt, h * HALF + R); asm volatile("global_load_dword %0, %1, %2" : "=v"(tok_[h][i]) : "v"(vo), "s"(S.tokbase()) : "memory"); } } } }
            PG8_KBODY(a1, a2, b2, a3, b3, vA[0][0], vA[0][1], vA[1][0], vA[1][1]);
        }
        if (GATHER) {
            if (has_next) { int t2_ = tid; asm volatile("" : "+v"(t2_), "+v"(tok_[0][0]), "+v"(tok_[0][1]), "+v"(tok_[1][0]), "+v"(tok_[1][1]));
#pragma unroll
                for (int i = 0; i < 2; ++i) { int R, C; stage_rc(t2_ * 16 + i * 8192, R, C);
#pragma unroll
                    for (int h = 0; h < 2; ++h) vN[h][i] = tok_[h][i] * (unsigned)(K * 2) + (unsigned)C * 2u; } }
            else {
#pragma unroll
                for (int h = 0; h < 2; ++h)
#pragma unroll
                    for (int i = 0; i < 2; ++i) vN[h][i] = vA[h][i];
            }
        }
        {
            const char* a1 = cA + (size_t)(nt - 1) * kstep;
            const char* a3 = nA + kstep; const char* b3 = nB + kstep;
            PG8_KBODY(a1, nA, nB, a3, b3, vN[0][0], vN[0][1], vN[1][0], vN[1][1]);
        }
#undef PG8_KBODY
        if constexpr (ALIGN_EPI) { if (wr == 0) PG8_BAR; }
        { int t3_ = tid; asm volatile("" : "+v"(t3_)); const int l3_ = t3_ & 63; E(acc, cur, wr, wc, l3_ & 15, l3_ >> 4); }
        if (!has_next) break;
#pragma unroll
        for (int a = 0; a < 2; ++a)
#pragma unroll
            for (int b = 0; b < 2; ++b)
#pragma unroll
                for (int m = 0; m < 4; ++m)
#pragma unroll
                    for (int n = 0; n < 2; ++n) acc[a][b][m][n] = (f32x4){0.f, 0.f, 0.f, 0.f};
        cur = nxt; cA = nA; cB = nB; ++ui;
        if (GATHER) {
#pragma unroll
            for (int h = 0; h < 2; ++h)
#pragma unroll
                for (int i = 0; i < 2; ++i) vA[h][i] = vN[h][i];
        }
        if constexpr (ALIGN_EPI) { if (wr == 1) PG8_BAR; }
    }
    PG8_WAIT_V(0);
    if constexpr (!ALIGN_EPI) { if (wr == 0) PG8_BAR; }
    PG8_BAR;
#undef PG8_AOFFS
#undef PG8_SA
#undef PG8_SB
#undef PG8_STAGE
#undef PG8_LDA
#undef PG8_LDB
#undef PG8_MMA
#undef PG8_WAIT_V
#undef PG8_WAIT_L
#undef PG8_BAR
#undef PG8_SCHED
}


constexpr int TS_OFF = 131072 + 1024;
template <bool GATHER> struct MoeOrder {
    const char* A; const char* Bt; const int* rowtok; int nN, nwg, nM, G, c, K, pm0, i0, Loff; size_t strideE;
    __device__ __forceinline__ void init(const bf16_t* A_, const bf16_t* Bt_, const int* rowtok_, int N, int K_, size_t strideE_, int G_, int c_, int pm0_, int nM_, int Loff_) {
        A = (const char*)A_; Bt = (const char*)Bt_; rowtok = rowtok_; nN = N / BM; K = K_; strideE = strideE_; G = G_; c = c_;
        pm0 = pm0_; nM = nM_; nwg = nM * nN; Loff = Loff_; i0 = Loff_ > c_ ? (Loff_ - c_ + G_ - 1) / G_ : 0; }
    __device__ __forceinline__ bool next(int i, GUnit& u) const {
        const long L = (long)(i + i0) * G + c - Loff; if (L >= nwg) return false;
        int wgid = (int)L; { const int q = nwg / NXCD, r = nwg % NXCD, xcd = wgid % NXCD, off = wgid / NXCD; wgid = (xcd < r ? xcd * (q + 1) : r * (q + 1) + (xcd - r) * q) + off; }
        const int nig = WGM_MOE * nN, gid = wgid / nig, fm = gid * WGM_MOE, gsz = (nM - fm) < WGM_MOE ? (nM - fm) : WGM_MOE;
        u.pm = pm0 + fm + ((wgid % nig) % gsz); u.pn = (wgid % nig) / gsz;
        LAS const int* ts = (LAS const int*)(LDSP + TS_OFF);
        const int e = __builtin_amdgcn_readfirstlane(ts[72 + u.pm]);
        u.e = e; u.row0 = (u.pm - __builtin_amdgcn_readfirstlane(ts[e])) * BM; u.cnt = __builtin_amdgcn_readfirstlane(ts[33 + e]);
        u.A = GATHER ? A : A + (size_t)u.pm * BM * K * 2;
        u.B = Bt + (size_t)e * strideE + (size_t)u.pn * BM * K * 2; return true;
    }
    __device__ __forceinline__ unsigned aoff(const GUnit& u, int row) const {
        if (GATHER) { int sl = u.row0 + row; sl = sl < u.cnt ? sl : u.cnt - 1; return (unsigned)rowtok[u.e * ECAP + sl] * (unsigned)(K * 2); }
        return (unsigned)(row * K * 2);
    }
    __device__ __forceinline__ unsigned tokoff(const GUnit& u, int row) const { int sl = u.row0 + row; sl = sl < u.cnt ? sl : u.cnt - 1; return (unsigned)(u.e * ECAP + sl) * 4u; }
    __device__ __forceinline__ const int* tokbase() const { return rowtok; }
};
__device__ __forceinline__ void moe_tiles(const unsigned* cnt, int tid) {
    LAS int* ts = (LAS int*)(LDSP + TS_OFF);
    if (tid < 64) {
        const int e = tid & 31, c = (int)cnt[e], n = (c + BM - 1) / BM;
        int incl = n;
#pragma unroll
        for (int d = 1; d < 32; d <<= 1) { const int o = __builtin_amdgcn_ds_bpermute(((tid - d) & 63) << 2, incl); if (e >= d) incl += o; }
        const int s = incl - n;
        if (tid < 32) { ts[e] = s; ts[33 + e] = c; if (e == 31) ts[NEXP] = incl;
_Pragma("clang loop vectorize(disable) unroll(disable)") for (int t = 0; t < n; ++t) ts[72 + s + t] = e; }
    }
    __syncthreads();
}
struct EpiMoe1 {
    static constexpr bool PERM = true;
    bf16_t* O; const float* b1; const float* rsc;
    __device__ __forceinline__ void operator()(const f32x4 (&acc)[2][2][4][2], const GUnit& u, int wr, int wc, int fr, int fq) const {
        const int rt0 = wr * 64 + fr, col0 = u.pn * 128 + wc * 32 + 8 * fq;
        const float* bg = b1 + (size_t)u.e * 2048 + col0;
        f32x4 bgv[2], blv[2];
#pragma unroll
        for (int n = 0; n < 2; ++n) { bgv[n] = *(const f32x4*)(bg + 4 * n); blv[n] = *(const f32x4*)(bg + DFF + 4 * n); }
#pragma unroll
        for (int ai = 0; ai < 2; ++ai)
#pragma unroll
            for (int m = 0; m < 4; ++m) {
                const int rt = rt0 + ai * HALF + m * 16; int sl = u.row0 + rt; sl = sl < u.cnt ? sl : u.cnt - 1;
                const float r = rsc[u.e * ECAP + sl];
                float o[8];
                const f32x2 r2 = (f32x2){r, r};
#pragma unroll
                for (int n = 0; n < 2; ++n)
#pragma unroll
                    for (int jp = 0; jp < 2; ++jp) {
                        const f32x2 ag = (f32x2){acc[ai][0][m][n][2 * jp], acc[ai][0][m][n][2 * jp + 1]}, al = (f32x2){acc[ai][1][m][n][2 * jp], acc[ai][1][m][n][2 * jp + 1]};
                        f32x2 g = ag * r2 + (f32x2){bgv[n][2 * jp], bgv[n][2 * jp + 1]}, l = al * r2 + (f32x2){blv[n][2 * jp], blv[n][2 * jp + 1]};
                        g.x = fminf(g.x, 7.f); g.y = fminf(g.y, 7.f);
                        l.x = __builtin_amdgcn_fmed3f(l.x, -7.f, 7.f); l.y = __builtin_amdgcn_fmed3f(l.y, -7.f, 7.f);
                        const f32x2 z = g * (-2.4554669595930157f);
                        f32x2 e; e.x = __builtin_amdgcn_exp2f(z.x); e.y = __builtin_amdgcn_exp2f(z.y);
                        e = e + 1.0f;
                        f32x2 q; q.x = __builtin_amdgcn_rcpf(e.x); q.y = __builtin_amdgcn_rcpf(e.y);
                        const f32x2 v = (g * q) * (l + 1.0f);
                        o[n * 4 + 2 * jp] = v.x; o[n * 4 + 2 * jp + 1] = v.y;
                    }
                u32x4 w; w.x = cvt_pk_bf16(o[0], o[1]); w.y = cvt_pk_bf16(o[2], o[3]); w.z = cvt_pk_bf16(o[4], o[5]); w.w = cvt_pk_bf16(o[6], o[7]);
                *(u32x4*)(O + (size_t)(u.pm * BM + rt) * DFF + col0) = w;
            }
    }
};
struct EpiMoe2 {
    static constexpr bool PERM = true;
    bf16_t* O; const float* b2;
    __device__ __forceinline__ void operator()(const f32x4 (&acc)[2][2][4][2], const GUnit& u, int wr, int wc, int fr, int fq) const {
        const int row0 = u.pm * BM + wr * 64 + fr, col0 = u.pn * BM + wc * 32 + 8 * fq;
        f32x4 bv[2][2];
#pragma unroll
        for (int bj = 0; bj < 2; ++bj)
#pragma unroll
            for (int n = 0; n < 2; ++n) bv[bj][n] = *(const f32x4*)(b2 + (size_t)u.e * DM + col0 + bj * HALF + 4 * n);
#pragma unroll
        for (int ai = 0; ai < 2; ++ai)
#pragma unroll
            for (int m = 0; m < 4; ++m) { bf16_t* rowp = O + (size_t)(row0 + ai * HALF + m * 16) * DM + col0;
#pragma unroll
                for (int bj = 0; bj < 2; ++bj) { const f32x4 v0 = acc[ai][bj][m][0] + bv[bj][0], v1 = acc[ai][bj][m][1] + bv[bj][1];
                    u32x4 w; w.x = cvt_pk_bf16(v0[0], v0[1]); w.y = cvt_pk_bf16(v0[2], v0[3]); w.z = cvt_pk_bf16(v1[0], v1[1]); w.w = cvt_pk_bf16(v1[2], v1[3]);
                    *(u32x4*)(rowp + bj * HALF) = w; } }
    }
};

__device__ __forceinline__ void p_transpose_r(const int wv, const float* W, int nmat, int K, int N, bf16_t* WT, const float* kgain, int gdiv, int mode, LAS unsigned char* lds, int it_begin, int it_end, int wrank, int wstride, int scr_pitch = 16384) {
    LTID();
    const int wave = wv, lane = tidx & 63;
    LAS float* scr = (LAS float*)(lds + wave * scr_pitch);
    const int nblk = N / 32, per_mat = (K / 64) * nblk, total = it_end, stride = wstride;
    const int lk = lane >> 3, lc4 = lane & 7;
#define TR_DECODE(item, mat_, kb_, nb_) const int mat_ = (item) / per_mat, r_ = (item) - mat_ * per_mat, g8_ = r_ >> 3, l8_ = r_ & 7, kb_ = 2 * (g8_ / (nblk >> 2)) + (l8_ & 1), nb_ = 4 * (g8_ % (nblk >> 2)) + (l8_ >> 1)
#define TR_ISSUE(item, dst, G0, G1) do { TR_DECODE(item, mat_, kb_, nb_); \
        const float* src_ = W + (size_t)mat_ * K * N + (size_t)(64 * kb_ + lk) * N + 32 * nb_ + 4 * lc4; \
        _Pragma("unroll") for (int i = 0; i < 8; ++i) dst[i] = __builtin_nontemporal_load((const f32x4*)(src_ + (size_t)(8 * i) * N));      \
        if (kgain) { const float* gp_ = kgain + (size_t)(mat_ / gdiv) * DM + 64 * kb_ + 8 * lc4; G0 = *(const f32x4*)gp_; G1 = *(const f32x4*)(gp_ + 4); } } while (0)
#define TR_PROCESS(v, G0, G1, item) do { TR_DECODE(item, mat, kb, nb); const int k0 = 64 * kb, n0 = 32 * nb; \
        _Pragma("unroll") for (int i = 0; i < 8; ++i) \
            _Pragma("unroll") for (int e = 0; e < 4; ++e) scr[(lk + 8 * i) * 33 + 4 * lc4 + e] = v[i][e]; \
        asm volatile("s_waitcnt lgkmcnt(0)" ::: "memory"); \
        int d0 = n0; \
        if (mode == 1) { const int bj = n0 >> 10, rest = n0 & 1023, pn = rest >> 7, j = rest & 127; d0 = pn * 256 + bj * 128 + j; } \
        bf16_t* dst = WT + (size_t)mat * K * N; \
        _Pragma("unroll") for (int j = 0; j < 4; ++j) { const int n = lk + 8 * j; const LAS float* sp = scr + (8 * lc4) * 33 + n; \
            u32x4 o; o.x = cvt_pk_bf16(sp[0 * 33] * G0[0], sp[1 * 33] * G0[1]); o.y = cvt_pk_bf16(sp[2 * 33] * G0[2], sp[3 * 33] * G0[3]); o.z = cvt_pk_bf16(sp[4 * 33] * G1[0], sp[5 * 33] * G1[1]); o.w = cvt_pk_bf16(sp[6 * 33] * G1[2], sp[7 * 33] * G1[3]); \
            __builtin_nontemporal_store(o, (u32x4*)(dst + (size_t)(d0 + n) * K + k0 + 8 * lc4)); } \
        asm volatile("s_waitcnt lgkmcnt(0)" ::: "memory"); } while (0)
    f32x4 va[8], vb[8], vc[8];
    f32x4 ga0 = (f32x4){1.f, 1.f, 1.f, 1.f}, ga1 = ga0, gb0 = ga0, gb1 = ga0, gc0 = ga0, gc1 = ga0;
    int it = it_begin + wrank;
    if (it + 4 * stride < total) {
        TR_ISSUE(it, va, ga0, ga1);
        TR_ISSUE(it + stride, vb, gb0, gb1);
        do {
            TR_ISSUE(it + 2 * stride, vc, gc0, gc1);
            TR_PROCESS(va, ga0, ga1, it);
            TR_ISSUE(it + 3 * stride, va, ga0, ga1);
            TR_PROCESS(vb, gb0, gb1, it + stride);
            TR_ISSUE(it + 4 * stride, vb, gb0, gb1);
            TR_PROCESS(vc, gc0, gc1, it + 2 * stride);
            it += 3 * stride;
        } while (it + 4 * stride < total);
    } else {
        if (it < total) TR_ISSUE(it, va, ga0, ga1);
        if (it + stride < total) TR_ISSUE(it + stride, vb, gb0, gb1);
    }
    if (it + 2 * stride < total) TR_ISSUE(it + 2 * stride, vc, gc0, gc1);
    if (it < total) TR_PROCESS(va, ga0, ga1, it);
    if (it + 3 * stride < total) TR_ISSUE(it + 3 * stride, va, ga0, ga1);
    if (it + stride < total) TR_PROCESS(vb, gb0, gb1, it + stride);
    if (it + 2 * stride < total) TR_PROCESS(vc, gc0, gc1, it + 2 * stride);
    if (it + 3 * stride < total) TR_PROCESS(va, ga0, ga1, it + 3 * stride);
#undef TR_PROCESS
#undef TR_ISSUE
#undef TR_DECODE
}
__device__ __forceinline__ void p_transpose(const int wv, const float* W, int nmat, int K, int N, bf16_t* WT, const float* kgain, int gdiv, int mode, LAS unsigned char* lds, int rot) {
    const int G_ = (int)gridDim.x, b_ = ((int)blockIdx.x + G_ - rot % G_) % G_;
    p_transpose_r(wv, W, nmat, K, N, WT, kgain, gdiv, mode, lds, 0, nmat * (K / 64) * (N / 32), b_ * NW + wv, G_ * NW);
}
typedef short v4i16_t __attribute__((ext_vector_type(4)));
constexpr int ATT_TAB_OFF = 131072 + 2048;
constexpr int ATT_UNITS = 3 * 8 * 128;
__device__ __forceinline__ int t5_bucket_dev(int n) {
    if (n < 16) return n;
    const float v = logf((float)n / 16.f) / 4.852030263919617f * 16.f;
    const int large = 16 + (int)v;
    return large < 31 ? large : 31;
}
__device__ __forceinline__ void p_bias_table(const int wv, const float* rel_bias, float* biasG, int rot) {
    LTID();
    for (int i = ROTB(rot) * NT + tidx; i < 3 * 8 * 132; i += gridDim.x * NT) {
        const int d = i % 132, bh = i / 132, h = bh & 7, b = bh >> 3;
        biasG[i] = (d <= 128) ? rel_bias[t5_bucket_dev(d << (2 * b)) * 8 + h] * 1.4426950408889634f : 0.f;
    }
}
__device__ __forceinline__ void p_dil_attn(const int wv, const bf16_t* proj16, const float* biasG, bf16_t* obr, float* lse, LAS unsigned char* lds) {
    LTID();
    const int lane = tidx & 63, fr = lane & 15, fq = lane >> 4, w = wv;
    const int per = (ATT_UNITS + (int)gridDim.x - 1) / (int)gridDim.x;
    const int u0 = bidx * per, u1 = (u0 + per < ATT_UNITS) ? u0 + per : ATT_UNITS;
    if (u0 >= u1) return;
    const int rowl = tidx >> 3, cs = tidx & 7;
    const unsigned cK = (unsigned)(cs ^ ((rowl >> 1) & 7)) * 16u, cV = (unsigned)(cs ^ (rowl & 7)) * 16u;
    const unsigned fK = (unsigned)((fr >> 1) & 7);
    const unsigned kro0 = (unsigned)fr * 128u + (((unsigned)fq ^ fK) * 16u), kro1 = (unsigned)fr * 128u + ((((unsigned)fq ^ fK) ^ 4u) * 16u);
    const int tq = (lane & 15) >> 2, tp = lane & 3, fv = 4 * (fq & 1) + tq;
    unsigned vro[4];
#pragma unroll
    for (int db = 0; db < 4; ++db) vro[db] = (unsigned)(4 * fq + tq) * 128u + (unsigned)(((2 * db + (tp >> 1)) ^ fv) * 16) + 8u * (unsigned)(tp & 1);
    const int ts_ = (1 + fr) & 3;
    const unsigned tab8 = (unsigned)ATT_TAB_OFF + (unsigned)ts_ * 640u + (unsigned)(((141 + fr - ts_) >> 2) - fq - 32) * 16u;
    const char* gbase = (const char*)proj16;
#define ATT_DECODE(u, b_, h_, r_, n_, dil_) const int cmb_ = (u) >> 7, b_ = cmb_ >> 3, h_ = cmb_ & 7, dil_ = 1 << (2 * b_), idx_ = (u) & 127, r_ = idx_ & (dil_ - 1), n_ = idx_ >> (2 * b_)
#define ATT_ISSUE(u, bf, q0, q1) do { ATT_DECODE(u, b__, h__, r__, n__, dil__); \
        const int nk = n__ > 0 ? n__ - 1 : 0;                                     \
        _Pragma("unroll") for (int p = 0; p < 4; ++p) { \
            int row = 64 * p + rowl; int blk = (row >> 7) ? n__ : nk; \
            const unsigned pos = (unsigned)(r__ + dil__ * (128 * blk + (row & 127))); \
            const unsigned so = pos * 4096u + (unsigned)h__ * 128u; const unsigned ld_ = (unsigned)(size_t)(lds + (bf) * 65536 + p * 8192 + w * 1024); \
            glds16s(gbase, so + 1024u + cK, ld_); glds16s(gbase, so + 2048u + cV, ld_ + 32768u); } \
        const unsigned qpos = (unsigned)(r__ + dil__ * (128 * n__ + 16 * w + fr)); \
        const char* qsrc = gbase + (size_t)qpos * 4096u + (unsigned)h__ * 128u + (unsigned)fq * 16u; \
        q0 = *(const bf16x8*)(qsrc); q1 = *(const bf16x8*)(qsrc + 64); } while (0)
    bf16x8 qf0, qf1, qn0, qn1;
    ATT_ISSUE(u0, 0, qn0, qn1);
    int prev_cmb = -1;
    for (int u = u0; u < u1; ++u) {
        const int bf = (u - u0) & 1;
        if (u == u0) asm volatile("s_waitcnt vmcnt(0)" ::: "memory"); else asm volatile("s_waitcnt vmcnt(5)" ::: "memory");
        __builtin_amdgcn_s_barrier();
        qf0 = qn0; qf1 = qn1;
        if (u + 1 < u1) ATT_ISSUE(u + 1, bf ^ 1, qn0, qn1);
        ATT_DECODE(u, b, h, r, n, dil);
        if (cmb_ != prev_cmb) {
            prev_cmb = cmb_;
            for (int e = tidx; e < 4 * 160; e += NT) { const int sft = e / 160, k = e - sft * 160, idx = k + sft, dist = idx - 16;
                const float v = (dist >= 0 && dist <= 128) ? biasG[cmb_ * 132 + dist] : -1e30f;
                ((LAS float*)(lds + ATT_TAB_OFF))[sft * 160 + k] = v; }
            __syncthreads();
        }
        const LAS unsigned char* Kb = lds + bf * 65536; const LAS unsigned char* Vb = Kb + 32768;
        const int kb0 = w;
        f32x4 sc[9];
#pragma unroll
        for (int i = 0; i < 9; ++i) {
            const unsigned ko = (unsigned)(kb0 + i) * 2048u;
            const bf16x8 k0 = *(const LAS bf16x8*)(Kb + ko + kro0), k1 = *(const LAS bf16x8*)(Kb + ko + kro1);
            f32x4 a = (f32x4){0.f, 0.f, 0.f, 0.f};
            a = __builtin_amdgcn_mfma_f32_16x16x32_bf16(k0, qf0, a, 0, 0, 0);
            a = __builtin_amdgcn_mfma_f32_16x16x32_bf16(k1, qf1, a, 0, 0, 0);
            const f32x4 t = *(const LAS f32x4*)(lds + tab8 + 64 * (8 - i));
            a = a + (f32x4){t[3], t[2], t[1], t[0]};
            if (n == 0 && kb0 + i < 8) a = (f32x4){-1e30f, -1e30f, -1e30f, -1e30f};
            sc[i] = a;
        }
#pragma unroll
        for (int i = 0; i < 9; ++i)
#pragma unroll
            for (int j = 0; j < 4; ++j) sc[i][j] = __builtin_amdgcn_exp2f(fminf(sc[i][j], 100.f));
        f32x4 oacc[4]; f32x4 sacc = (f32x4){0.f, 0.f, 0.f, 0.f};
        const bf16x8 ones = (bf16x8){0x3F80, 0x3F80, 0x3F80, 0x3F80, 0x3F80, 0x3F80, 0x3F80, 0x3F80};
#pragma unroll
        for (int db = 0; db < 4; ++db) oacc[db] = (f32x4){0.f, 0.f, 0.f, 0.f};
#pragma unroll
        for (int c = 0; c < 5; ++c) {
            const int ia = 2 * c, ib = (c < 4) ? 2 * c + 1 : 8;
            u32x4 pw; pw.x = cvt_pk_bf16(sc[ia][0], sc[ia][1]); pw.y = cvt_pk_bf16(sc[ia][2], sc[ia][3]);
            if (c < 4) { pw.z = cvt_pk_bf16(sc[ib][0], sc[ib][1]); pw.w = cvt_pk_bf16(sc[ib][2], sc[ib][3]); } else { pw.z = 0u; pw.w = 0u; }
            const bf16x8 pf = __builtin_bit_cast(bf16x8, pw);
            const unsigned va = (unsigned)(kb0 + ia) * 2048u, vb = (unsigned)(kb0 + ib) * 2048u;
            sacc = __builtin_amdgcn_mfma_f32_16x16x32_bf16(ones, pf, sacc, 0, 0, 0);
#pragma unroll
            for (int db = 0; db < 4; ++db) {
                const v4i16_t x0 = __builtin_amdgcn_ds_read_tr16_b64_v4i16((LAS v4i16_t*)(Vb + va + vro[db]));
                const v4i16_t x1 = __builtin_amdgcn_ds_read_tr16_b64_v4i16((LAS v4i16_t*)(Vb + vb + vro[db]));
                const bf16x8 vf = (bf16x8){x0[0], x0[1], x0[2], x0[3], x1[0], x1[1], x1[2], x1[3]};
                oacc[db] = __builtin_amdgcn_mfma_f32_16x16x32_bf16(vf, pf, oacc[db], 0, 0, 0);
            }
        }
        const float sum = sacc[0];
        const float inv = 1.f / sum;
        const unsigned qpos = (unsigned)(r + dil * (128 * n + 16 * w + fr));
        bf16_t* orow = obr + ((size_t)b * SEQ + qpos) * 512 + h * 64 + 4 * fq;
#pragma unroll
        for (int db = 0; db < 4; ++db) { u32x2 o2; o2.x = cvt_pk_bf16(oacc[db][0] * inv, oacc[db][1] * inv); o2.y = cvt_pk_bf16(oacc[db][2] * inv, oacc[db][3] * inv); *(u32x2*)(orow + 16 * db) = o2; }
        if (fq == 0) lse[((size_t)b * SEQ + qpos) * 8 + h] = sum;
    }
    asm volatile("s_waitcnt vmcnt(0)" ::: "memory");
    __syncthreads();
#undef ATT_DECODE
#undef ATT_ISSUE
}
__device__ __forceinline__ void p_attn_combine(const int wv, const bf16_t* obr, const float* lse, const float* g, bf16_t* mix16) {
    LTID();
    const int lane = tidx & 63, h = lane >> 3;
    const f32x4 g0 = *(const f32x4*)(g + lane * 8), g1 = *(const f32x4*)(g + lane * 8 + 4);
    const int rstride = (int)gridDim.x * NW;
    for (int row0 = bidx * NW + wv; row0 < SEQ; row0 += 4 * rstride) {
        float lv[4][3]; u32x4 av[4][3];
#pragma unroll
        for (int r = 0; r < 4; ++r) { const int row = (row0 + r * rstride < SEQ) ? row0 + r * rstride : row0;
#pragma unroll
            for (int b = 0; b < 3; ++b) { lv[r][b] = lse[((size_t)b * SEQ + row) * 8 + h]; av[r][b] = *(const u32x4*)(obr + ((size_t)b * SEQ + row) * 512 + lane * 8); } }
#pragma unroll
        for (int r = 0; r < 4; ++r) {
            const int row = row0 + r * rstride;
            float w0 = lv[r][0], w1 = lv[r][1], w2 = lv[r][2];
            const float iw = 1.f / (w0 + w1 + w2); w0 *= iw; w1 *= iw; w2 *= iw;
            float y[8]; float ss = 0.f;
#pragma unroll
            for (int k = 0; k < 4; ++k) {
                const float lo = w0 * __builtin_bit_cast(float, av[r][0][k] << 16) + w1 * __builtin_bit_cast(float, av[r][1][k] << 16) + w2 * __builtin_bit_cast(float, av[r][2][k] << 16);
                const float hi = w0 * __builtin_bit_cast(float, av[r][0][k] & 0xffff0000u) + w1 * __builtin_bit_cast(float, av[r][1][k] & 0xffff0000u) + w2 * __builtin_bit_cast(float, av[r][2][k] & 0xffff0000u);
                y[2 * k] = lo; y[2 * k + 1] = hi; ss += lo * lo + hi * hi;
            }
#pragma unroll
            for (int o = 32; o; o >>= 1) ss += shx(ss, o, lane);
            const float sc = rsqrtf(ss * (1.f / 512.f) + 1e-5f);
            u32x4 o4; o4.x = cvt_pk_bf16(y[0] * sc * g0[0], y[1] * sc * g0[1]); o4.y = cvt_pk_bf16(y[2] * sc * g0[2], y[3] * sc * g0[3]);
            o4.z = cvt_pk_bf16(y[4] * sc * g1[0], y[5] * sc * g1[1]); o4.w = cvt_pk_bf16(y[6] * sc * g1[2], y[7] * sc * g1[3]);
            if (row < SEQ) *(u32x4*)(mix16 + (size_t)row * DM + lane * 8) = o4;
        }
    }
}
struct EpiIn {
    static constexpr bool PERM = true;
    bf16_t* O; const float* rs;
    __device__ __forceinline__ void operator()(const f32x4 (&acc)[2][2][4][2], const GUnit& u, int wr, int wc, int fr, int fq) const {
        const int row0 = u.pm * BM + wr * 64 + fr, col0 = u.pn * BM + wc * 32 + 8 * fq;
        const float sc0 = u.pn < 2 ? 0.18033688011112042f : 1.f;
#pragma unroll
        for (int ai = 0; ai < 2; ++ai)
#pragma unroll
            for (int m = 0; m < 4; ++m) { const int row = row0 + ai * HALF + m * 16; const size_t ro = (size_t)row * DIN + col0; const float sc = sc0 * rs[row];
#pragma unroll
                for (int bj = 0; bj < 2; ++bj) { const f32x4 v0 = acc[ai][bj][m][0] * sc, v1 = acc[ai][bj][m][1] * sc;
                    u32x4 w; w.x = cvt_pk_bf16(v0[0], v0[1]); w.y = cvt_pk_bf16(v0[2], v0[3]); w.z = cvt_pk_bf16(v1[0], v1[1]); w.w = cvt_pk_bf16(v1[2], v1[3]);
                    *(u32x4*)(O + ro + bj * HALF) = w;
                    } }
    }
};


__device__ __forceinline__ unsigned xoff_b(unsigned row, unsigned ch) { return 256u * row + 16u * (ch ^ (((row & 3u) << 2) | ((row >> 2) & 3u))); }
__device__ __forceinline__ void p_xattn_mfma(const int wv, const bf16_t* qx16, const bf16_t* kv16, bf16_t* ox16, LAS unsigned char* lds) {
    LTID();
    const int lane = tidx & 63, fr = lane & 15, fq = lane >> 4, w = wv;
    const int NU = 4 * 128;
    const int per = (NU + (int)gridDim.x - 1) / (int)gridDim.x;
    const int u0 = bidx * per, u1 = (u0 + per < NU) ? u0 + per : NU;
    if (u0 >= u1) return;
    const int rowl = tidx >> 4, cs = tidx & 15;
    const unsigned csw = (unsigned)(cs ^ (((rowl & 3) << 2) | ((rowl >> 2) & 3))) * 16u;
    const unsigned kswz = (unsigned)(((fr & 3) << 2) | ((fr >> 2) & 3));
    unsigned kro[4];
#pragma unroll
    for (int s4 = 0; s4 < 4; ++s4) kro[s4] = 256u * (unsigned)fr + 16u * ((unsigned)(4 * s4 + fq) ^ kswz);
    const int tq = (lane & 15) >> 2, tp = lane & 3;
    const unsigned vswz = (unsigned)((tq << 2) | fq);
    unsigned vro[8];
#pragma unroll
    for (int c = 0; c < 8; ++c) vro[c] = 65536u + 256u * (unsigned)(4 * fq + tq) + 16u * ((unsigned)(2 * c + (tp >> 1)) ^ vswz) + 8u * (unsigned)(tp & 1);
    int prev_h = -1;
    for (int u = u0; u < u1; ++u) {
        const int h = u >> 7, qt = u & 127;
        if (h != prev_h) {
            __syncthreads();
            prev_h = h;
#pragma unroll
            for (int p = 0; p < 8; ++p) {
                const unsigned row = (unsigned)(32 * p + rowl);
                const unsigned so = row * 2048u + (unsigned)h * 256u + csw;
                const unsigned ld_ = (unsigned)(size_t)(lds + p * 8192 + w * 1024);
                glds16s(kv16, so, ld_); glds16s(kv16, so + 1024u, ld_ + 65536u);
            }
            asm volatile("s_waitcnt vmcnt(0)" ::: "memory");
            __syncthreads();
        }
        const char* qsrc = (const char*)qx16 + ((size_t)(qt * 128 + 16 * w + fr) * 512 + h * 128 + 8 * fq) * 2;
        bf16x8 qf[4];
#pragma unroll
        for (int s4 = 0; s4 < 4; ++s4) qf[s4] = *(const bf16x8*)(qsrc + 64 * s4);
        f32x4 sc[16];
#pragma unroll
        for (int i = 0; i < 16; ++i) {
            f32x4 a = (f32x4){0.f, 0.f, 0.f, 0.f};
#pragma unroll
            for (int s4 = 0; s4 < 4; ++s4) { const bf16x8 kf = *(const LAS bf16x8*)(lds + i * 4096 + kro[s4]); a = __builtin_amdgcn_mfma_f32_16x16x32_bf16(kf, qf[s4], a, 0, 0, 0); }
            sc[i] = a;
        }
        float mx = -1e30f;
#pragma unroll
        for (int i = 0; i < 16; ++i) mx = fmaxf(mx, fmaxf(fmaxf(sc[i][0], sc[i][1]), fmaxf(sc[i][2], sc[i][3])));
        mx = fmaxf(mx, shx(mx, 16, lane)); mx = fmaxf(mx, shx(mx, 32, lane));
        float sum = 0.f;
#pragma unroll
        for (int i = 0; i < 16; ++i)
#pragma unroll
            for (int j = 0; j < 4; ++j) { const float p = __expf(sc[i][j] - mx); sc[i][j] = p; sum += p; }
        sum += shx(sum, 16, lane); sum += shx(sum, 32, lane);
        f32x4 oacc[8];
#pragma unroll
        for (int c = 0; c < 8; ++c) oacc[c] = (f32x4){0.f, 0.f, 0.f, 0.f};
#pragma unroll
        for (int ch = 0; ch < 8; ++ch) {
            const int ia = 2 * ch, ib = 2 * ch + 1;
            u32x4 pw; pw.x = cvt_pk_bf16(sc[ia][0], sc[ia][1]); pw.y = cvt_pk_bf16(sc[ia][2], sc[ia][3]); pw.z = cvt_pk_bf16(sc[ib][0], sc[ib][1]); pw.w = cvt_pk_bf16(sc[ib][2], sc[ib][3]);
            const bf16x8 pf = __builtin_bit_cast(bf16x8, pw);
#pragma unroll
            for (int c = 0; c < 8; ++c) {
                const v4i16_t x0 = __builtin_amdgcn_ds_read_tr16_b64_v4i16((LAS v4i16_t*)(lds + ia * 4096 + vro[c]));
                const v4i16_t x1 = __builtin_amdgcn_ds_read_tr16_b64_v4i16((LAS v4i16_t*)(lds + ib * 4096 + vro[c]));
                const bf16x8 vf = (bf16x8){x0[0], x0[1], x0[2], x0[3], x1[0], x1[1], x1[2], x1[3]};
                oacc[c] = __builtin_amdgcn_mfma_f32_16x16x32_bf16(vf, pf, oacc[c], 0, 0, 0);
            }
        }
        const float inv = 1.f / sum;
        bf16_t* orow = ox16 + (size_t)(qt * 128 + 16 * w + fr) * 512 + h * 128 + 4 * fq;
#pragma unroll
        for (int c = 0; c < 8; ++c) { u32x2 o2; o2.x = cvt_pk_bf16(oacc[c][0] * inv, oacc[c][1] * inv); o2.y = cvt_pk_bf16(oacc[c][2] * inv, oacc[c][3] * inv); *(u32x2*)(orow + 16 * c) = o2; }
    }
    __syncthreads();
}
struct EpiBf16 {
    static constexpr bool PERM = true;
    bf16_t* O; int ldc; float scale; const float* ss;
    __device__ __forceinline__ void operator()(const f32x4 (&acc)[2][2][4][2], const GUnit& u, int wr, int wc, int fr, int fq) const {
        const int row0 = u.pm * BM + wr * 64 + fr, col0 = u.pn * BM + wc * 32 + 8 * fq;
#pragma unroll
        for (int ai = 0; ai < 2; ++ai)
#pragma unroll
            for (int m = 0; m < 4; ++m) { const int row = row0 + ai * HALF + m * 16; bf16_t* rowp = O + (size_t)row * ldc + col0;
                float sc = scale;
                if (ss) { const f32x4 p0 = *(const f32x4*)(ss + (size_t)row * 16), p1 = *(const f32x4*)(ss + (size_t)row * 16 + 4), p2 = *(const f32x4*)(ss + (size_t)row * 16 + 8), p3 = *(const f32x4*)(ss + (size_t)row * 16 + 12);
                    const float t = ((p0[0] + p0[1]) + (p0[2] + p0[3])) + ((p1[0] + p1[1]) + (p1[2] + p1[3])) + ((p2[0] + p2[1]) + (p2[2] + p2[3])) + ((p3[0] + p3[1]) + (p3[2] + p3[3]));
                    sc = scale * rsqrtf(t * (1.f / 1024.f) + 1e-5f); }
#pragma unroll
                for (int bj = 0; bj < 2; ++bj) { const f32x4 v0 = acc[ai][bj][m][0] * sc, v1 = acc[ai][bj][m][1] * sc;
                    u32x4 w; w.x = cvt_pk_bf16(v0[0], v0[1]); w.y = cvt_pk_bf16(v0[2], v0[3]); w.z = cvt_pk_bf16(v1[0], v1[1]); w.w = cvt_pk_bf16(v1[2], v1[3]);
                    *(u32x4*)(rowp + bj * HALF) = w; } }
    }
};
__device__ __forceinline__ float bflo(unsigned u) { return __builtin_bit_cast(float, u << 16); }
__device__ __forceinline__ float bfhi(unsigned u) { return __builtin_bit_cast(float, u & 0xffff0000u); }
template <bool R32, bool SS> struct EpiRes16 {
    static constexpr bool PERM = true;
    const void* R; bf16_t* H; float* ss;
    __device__ __forceinline__ void operator()(const f32x4 (&acc)[2][2][4][2], const GUnit& u, int wr, int wc, int fr, int fq) const {
        const int row0 = u.pm * BM + wr * 64 + fr, col0 = u.pn * BM + wc * 32 + 8 * fq, lane = fq * 16 + fr;
#pragma unroll
        for (int ai = 0; ai < 2; ++ai)
#pragma unroll
            for (int m = 0; m < 4; ++m) { const int row = row0 + ai * HALF + m * 16; const size_t ro = (size_t)row * DM + col0; float sq = 0.f;
#pragma unroll
                for (int bj = 0; bj < 2; ++bj) {
                    f32x4 r0, r1;
                    if (R32) { r0 = *(const f32x4*)((const float*)R + ro + bj * HALF); r1 = *(const f32x4*)((const float*)R + ro + bj * HALF + 4); }
                    else { const u32x4 rw = *(const u32x4*)((const bf16_t*)R + ro + bj * HALF); r0 = (f32x4){bflo(rw.x), bfhi(rw.x), bflo(rw.y), bfhi(rw.y)}; r1 = (f32x4){bflo(rw.z), bfhi(rw.z), bflo(rw.w), bfhi(rw.w)}; }
                    const f32x4 v0 = acc[ai][bj][m][0] + r0, v1 = acc[ai][bj][m][1] + r1;
                    u32x4 w; w.x = cvt_pk_bf16(v0[0], v0[1]); w.y = cvt_pk_bf16(v0[2], v0[3]); w.z = cvt_pk_bf16(v1[0], v1[1]); w.w = cvt_pk_bf16(v1[2], v1[3]);
                    *(u32x4*)(H + ro + bj * HALF) = w;
                    if (SS) sq += (v0[0] * v0[0] + v0[1] * v0[1]) + (v0[2] * v0[2] + v0[3] * v0[3]) + (v1[0] * v1[0] + v1[1] * v1[1]) + (v1[2] * v1[2] + v1[3] * v1[3]);
                }
                if (SS) { sq += shx(sq, 16, lane); sq += shx(sq, 32, lane);
                    if (fq == 0) ss[(size_t)row * 16 + u.pn * 4 + wc] = sq; }
            }
    }
};

typedef short bf16x4 __attribute__((ext_vector_type(4)));
constexpr int S5_CHUNK = 256, S5_NCH = SEQ / S5_CHUNK, S5_ROWB = 528;
__device__ __forceinline__ f32x2 gelu_pk(f32x2 v) {
    const f32x2 av = __builtin_elementwise_abs(v), d = av * 0.2316418882f + 1.0f;
    f32x2 t; t.x = __builtin_amdgcn_rcpf(d.x); t.y = __builtin_amdgcn_rcpf(d.y);
    f32x2 q = t * 0.5307027145f + (-0.7265760135f); q = q * t + 0.7107068705f; q = q * t + (-0.142248368f); q = q * t + 0.127414796f; q = q * t;
    const f32x2 s2 = (v * v) * (-0.72134752044f);
    f32x2 e; e.x = __builtin_amdgcn_exp2f(s2.x); e.y = __builtin_amdgcn_exp2f(s2.y);
    const f32x2 m = v * (q * e), r = v - m;
    f32x2 o; o.x = v.x < 0.f ? m.x : r.x; o.y = v.y < 0.f ? m.y : r.y; return o;
}
__device__ __forceinline__ void p_s5_tables2(const int wv, const float* a_re, const float* a_im, const float* b_re, const float* b_im, const float* c_re, const float* c_im, const float* log_dt,
                                             float2* abar, float2* a256, bf16_t* BB16, bf16_t* CM16, int rot) {
    LTID();
    for (int i = ROTB(rot) * NT + tidx; i < 2048 * 16; i += gridDim.x * NT) {
        const int gp = i >> 4, c = i & 15, g = gp >> 6, p = gp & 63;
        const float lr = a_re[gp], li = a_im[gp], dt = expf(log_dt[g]);
        const float mag = expf(lr * dt); float sn, cs; sincosf(li * dt, &sn, &cs);
        const float ar = mag * cs, ai = mag * sn;
        if (c == 0) {
            abar[gp] = make_float2(ar, ai);
            float pr = ar, pi = ai;
            for (int k = 0; k < 8; ++k) { const float nr = pr * pr - pi * pi, ni = 2.f * pr * pi; pr = nr; pi = ni; }
            a256[gp] = make_float2(pr, pi);
        }
        const float nr = ar - 1.f, ni = ai, den = lr * lr + li * li;
        const float cr = (nr * lr + ni * li) / den, ci = (ni * lr - nr * li) / den;
        const float br = b_re[gp * 16 + c], bi = b_im[gp * 16 + c];
        BB16[((size_t)g * 128 + p) * 16 + c] = (bf16_t)f2bf(cr * br - ci * bi);
        BB16[((size_t)g * 128 + 64 + p) * 16 + c] = (bf16_t)f2bf(cr * bi + ci * br);
        CM16[((size_t)g * 16 + c) * 128 + p] = (bf16_t)f2bf(c_re[(g * 16 + c) * 64 + p]);
        CM16[((size_t)g * 16 + c) * 128 + 64 + p] = (bf16_t)f2bf(-c_im[(g * 16 + c) * 64 + p]);
    }
}
struct ConvCtx { const float* W1; const float* W2; bf16_t* T1; bf16_t* T2; const float* kg; bf16_t* dump; int begin, end, wr, stride; };
constexpr int CV_NIT1 = 32768;
#define CV_DECODE(item) const bool w1_ = (item) < CV_NIT1; const int it_ = w1_ ? (item) : (item) - CV_NIT1; const int N_ = w1_ ? 2048 : 1024, nq_ = N_ >> 7, per_mat_ = N_ >> 1; \
        const int mat_ = it_ / per_mat_, r_ = it_ - mat_ * per_mat_, g8_ = r_ >> 3, l8_ = r_ & 7, kb_ = 2 * (g8_ / nq_) + (l8_ & 1), nb_ = 4 * (g8_ % nq_) + (l8_ >> 1)
#define CV_ISSUE(cx, item, ok, dst) do { CV_DECODE((ok) ? (item) : 0); int ln_ = lane; asm volatile("" : "+v"(ln_)); const int lk = ln_ >> 3, lc4 = ln_ & 7;     \
        const float* src_ = (ok) ? (w1_ ? cx.W1 : cx.W2) + (size_t)mat_ * 1024 * N_ + (size_t)(64 * kb_ + lk) * N_ + 32 * nb_ + 4 * lc4 : cx.W1; \
        const size_t rs_ = (ok) ? (size_t)(8 * N_) : 0; \
        _Pragma("unroll") for (int i = 0; i < 8; ++i) dst[i] = __builtin_nontemporal_load((const f32x4*)(src_ + (size_t)i * rs_)); \
        } while (0)
#define CV_PROCESS(cx, item, ok, v, scr) do { CV_DECODE((ok) ? (item) : 0); const int k0 = 64 * kb_, n0 = 32 * nb_; int ln_ = lane; asm volatile("" : "+v"(ln_)); const int lk = ln_ >> 3, lc4 = ln_ & 7; \
        const float* gp_ = cx.kg + 64 * kb_ + 8 * lc4; const f32x4 gl0_ = *(const f32x4*)gp_, gl1_ = *(const f32x4*)(gp_ + 4); \
        const f32x4 G0 = w1_ ? gl0_ : (f32x4){1.f, 1.f, 1.f, 1.f}, G1 = w1_ ? gl1_ : (f32x4){1.f, 1.f, 1.f, 1.f}; \
        _Pragma("unroll") for (int i = 0; i < 8; ++i) \
            _Pragma("unroll") for (int e = 0; e < 4; ++e) scr[(lk + 8 * i) * 33 + 4 * lc4 + e] = v[i][e]; \
        asm volatile("s_waitcnt lgkmcnt(0)" ::: "memory"); \
        const int bj_ = n0 >> 10, rest_ = n0 & 1023; const int d0 = w1_ ? (rest_ >> 7) * 256 + bj_ * 128 + (rest_ & 127) : n0; \
        bf16_t* dst = (ok) ? (w1_ ? cx.T1 : cx.T2) + (size_t)mat_ * 1024 * N_ : cx.dump; \
        _Pragma("unroll") for (int j = 0; j < 4; ++j) { const int n = lk + 8 * j; const LAS float* sp = scr + (8 * lc4) * 33 + n; \
            u32x4 o; o.x = cvt_pk_bf16(sp[0 * 33] * G0[0], sp[1 * 33] * G0[1]); o.y = cvt_pk_bf16(sp[2 * 33] * G0[2], sp[3 * 33] * G0[3]); o.z = cvt_pk_bf16(sp[4 * 33] * G1[0], sp[5 * 33] * G1[1]); o.w = cvt_pk_bf16(sp[6 * 33] * G1[2], sp[7 * 33] * G1[3]); \
            __builtin_nontemporal_store(o, (u32x4*)(dst + (size_t)(d0 + n) * 1024 + k0 + 8 * lc4)); } \
        asm volatile("s_waitcnt lgkmcnt(0)" ::: "memory"); } while (0)
template <int MODE> __device__ __forceinline__ int p_s5_pass(const int wv, const bf16_t* proj16, const float2* abar, const float2* a256, const bf16_t* BB16, const bf16_t* CM16, const float* dskip,
                                                              float2* E, bf16_t* yg16, LAS unsigned char* lds, const ConvCtx cx) {
    LTID();
    const int lane = tidx & 63, fr = lane & 15, fq = lane >> 4;
    LAS unsigned char* L = lds + wv * (16 * S5_ROWB);
    LAS float* scr = (LAS float*)L;
    f32x4 cva[8], cvb[8];
    int mdone = 0;
    for (int unit = bidx * NW + wv; unit < S5_NCH * 32; unit += gridDim.x * NW) {
        const int g = unit & 31, chunk = unit >> 5;
        const float2 a = abar[g * 64 + lane];
        bf16x4 bbf[8];
#pragma unroll
        for (int cb = 0; cb < 8; ++cb) bbf[cb] = *(const bf16x4*)(BB16 + ((size_t)g * 128 + 16 * cb + fr) * 16 + 4 * fq);
        bf16x8 cmf[4]; f32x4 dsk = (f32x4){0.f, 0.f, 0.f, 0.f};
        if (MODE == 1) {
#pragma unroll
            for (int s4 = 0; s4 < 4; ++s4) cmf[s4] = *(const bf16x8*)(CM16 + ((size_t)g * 16 + fr) * 128 + 32 * s4 + 8 * fq);
            dsk = *(const f32x4*)(dskip + g * 16 + 4 * fq);
        }
        float sr = 0.f, si = 0.f;
        if (MODE == 1) {
            const float2 A = a256[g * 64 + lane];
            for (int j0 = 0; j0 < chunk; j0 += 16) {
                float2 e[16];
#pragma unroll
                for (int k = 0; k < 16; ++k) { const int j = (j0 + k < chunk) ? j0 + k : chunk - 1; e[k] = E[((size_t)j * 32 + g) * 64 + lane]; }
#pragma unroll
                for (int k = 0; k < 16; ++k) if (j0 + k < chunk) { const float nr = A.x * sr - A.y * si + e[k].x, ni = A.x * si + A.y * sr + e[k].y; sr = nr; si = ni; }
            }
        }
        const bf16_t* ubase = proj16 + (size_t)(chunk * S5_CHUNK + fr) * DIN + 1536 + g * 16 + 4 * fq;
        bf16x4 uf = *(const bf16x4*)ubase;
#define S5_BLOCK(blk, HOOK) do { \
            const bf16x4 ufn = *(const bf16x4*)(ubase + (size_t)(((blk) < S5_CHUNK / 16 - 1) ? ((blk) + 1) * 16 : (blk) * 16) * DIN); \
            HOOK; \
            asm volatile("" ::: "memory"); \
_Pragma("unroll") \
            for (int cb = 0; cb < 8; ++cb) { \
                const f32x4 d = __builtin_amdgcn_mfma_f32_16x16x16bf16_1k(bbf[cb], uf, (f32x4){0.f, 0.f, 0.f, 0.f}, 0, 0, 0); \
                *(LAS f32x4*)(L + fr * S5_ROWB + (16 * cb + 4 * fq) * 4) = d; \
            } \
            asm volatile("" ::: "memory"); \
_Pragma("unroll") \
            for (int t = 0; t < 16; ++t) { \
                const float re = *(const LAS float*)(L + t * S5_ROWB + lane * 4), im = *(const LAS float*)(L + t * S5_ROWB + 256 + lane * 4); \
                const float nr = a.x * sr - a.y * si + re, ni = a.x * si + a.y * sr + im; sr = nr; si = ni; \
                if (MODE == 1) { *(LAS bf16_t*)(L + t * S5_ROWB + lane * 2) = (bf16_t)f2bf(sr); *(LAS bf16_t*)(L + t * S5_ROWB + 128 + lane * 2) = (bf16_t)f2bf(si); } \
            } \
            asm volatile("" ::: "memory"); \
            if (MODE == 1) { \
                f32x4 y = (f32x4){0.f, 0.f, 0.f, 0.f}; \
_Pragma("unroll") \
                for (int s4 = 0; s4 < 4; ++s4) { const bf16x8 sf = *(const LAS bf16x8*)(L + fr * S5_ROWB + 64 * s4 + 16 * fq); y = __builtin_amdgcn_mfma_f32_16x16x32_bf16(cmf[s4], sf, y, 0, 0, 0); } \
                f32x4 v; \
_Pragma("unroll") \
                for (int j = 0; j < 4; ++j) v[j] = y[j] + dsk[j] * bf2f((unsigned short)uf[j]); \
                const f32x2 g0 = gelu_pk((f32x2){v[0], v[1]}), g1 = gelu_pk((f32x2){v[2], v[3]}); \
                u32x2 o2; o2.x = cvt_pk_bf16(g0.x, g0.y); o2.y = cvt_pk_bf16(g1.x, g1.y); \
                *(u32x2*)(yg16 + (size_t)(chunk * S5_CHUNK + (blk) * 16 + fr) * 512 + g * 16 + 4 * fq) = o2; \
            } \
            asm volatile("" ::: "memory"); \
            uf = ufn; } while (0)
        if constexpr (MODE == 1) {
            const int cvi0 = cx.begin + cx.wr + mdone * cx.stride;
#pragma unroll 1
            for (int q4 = 0; q4 < S5_CHUNK / 64; ++q4) {
                const int ia = cvi0 + (2 * q4) * cx.stride, ibp = cvi0 + (2 * q4 - 1) * cx.stride, ib = cvi0 + (2 * q4 + 1) * cx.stride;
                S5_BLOCK(4 * q4, CV_ISSUE(cx, ia, ia < cx.end, cva));
                S5_BLOCK(4 * q4 + 1, (void)0);
                CV_PROCESS(cx, ibp, q4 > 0 && ibp < cx.end, cvb, scr);
                S5_BLOCK(4 * q4 + 2, CV_ISSUE(cx, ib, ib < cx.end, cvb));
                S5_BLOCK(4 * q4 + 3, (void)0);
                CV_PROCESS(cx, ia, ia < cx.end, cva, scr);
            }
            { const int ib = cvi0 + 7 * cx.stride; CV_PROCESS(cx, ib, ib < cx.end, cvb, scr); }
            mdone += 8;
        } else {
#pragma unroll 1
            for (int blk = 0; blk < S5_CHUNK / 16; ++blk) S5_BLOCK(blk, (void)0);
        }
#undef S5_BLOCK
        if (MODE == 0) E[((size_t)chunk * 32 + g) * 64 + lane] = make_float2(sr, si);
    }
    return mdone;
}
struct EpiGlu16 {
    static constexpr bool PERM = true;
    bf16_t* O; const bf16_t* Y; const float* bias;
    __device__ __forceinline__ void operator()(const f32x4 (&acc)[2][2][4][2], const GUnit& u, int wr, int wc, int fr, int fq) const {
        const int row0 = u.pm * BM + wr * 64 + fr, col0 = u.pn * BM + wc * 32 + 8 * fq;
        f32x4 bv[2][2];
#pragma unroll
        for (int bj = 0; bj < 2; ++bj)
#pragma unroll
            for (int n = 0; n < 2; ++n) bv[bj][n] = *(const f32x4*)(bias + col0 + bj * HALF + 4 * n);
#pragma unroll
        for (int ai = 0; ai < 2; ++ai)
#pragma unroll
            for (int m = 0; m < 4; ++m) { const size_t ro = (size_t)(row0 + ai * HALF + m * 16) * 512 + col0;
#pragma unroll
                for (int bj = 0; bj < 2; ++bj) {
                    const u32x4 yv = *(const u32x4*)(Y + ro + bj * HALF);
                    float o[8];
#pragma unroll
                    for (int n = 0; n < 2; ++n)
#pragma unroll
                        for (int j = 0; j < 4; ++j) { const unsigned wd = yv[n * 2 + (j >> 1)]; const float y = __builtin_bit_cast(float, (j & 1) ? (wd & 0xffff0000u) : (wd << 16));
                            o[n * 4 + j] = y / (1.f + __expf(-(acc[ai][bj][m][n][j] + bv[bj][n][j]))); }
                    u32x4 w; w.x = cvt_pk_bf16(o[0], o[1]); w.y = cvt_pk_bf16(o[2], o[3]); w.z = cvt_pk_bf16(o[4], o[5]); w.w = cvt_pk_bf16(o[6], o[7]);
                    *(u32x4*)(O + ro + bj * HALF) = w; } }
    }
};
__device__ __forceinline__ void p_ssm_norm(const int wv, const bf16_t* yb16, const float* g, bf16_t* mix16) {
    LTID();
    const int lane = tidx & 63;
    const f32x4 g0 = *(const f32x4*)(g + lane * 8), g1 = *(const f32x4*)(g + lane * 8 + 4);
    const int rstride = (int)gridDim.x * NW;
    for (int row0 = bidx * NW + wv; row0 < SEQ; row0 += 4 * rstride) {
        u32x4 av[4];
#pragma unroll
        for (int r = 0; r < 4; ++r) { const int row = (row0 + r * rstride < SEQ) ? row0 + r * rstride : row0; av[r] = *(const u32x4*)(yb16 + (size_t)row * 512 + lane * 8); }
#pragma unroll
        for (int r = 0; r < 4; ++r) {
            const int row = row0 + r * rstride;
            float y[8]; float ss = 0.f;
#pragma unroll
            for (int k = 0; k < 4; ++k) { y[2 * k] = __builtin_bit_cast(float, av[r][k] << 16); y[2 * k + 1] = __builtin_bit_cast(float, av[r][k] & 0xffff0000u); ss += y[2 * k] * y[2 * k] + y[2 * k + 1] * y[2 * k + 1]; }
#pragma unroll
            for (int o = 32; o; o >>= 1) ss += shx(ss, o, lane);
            const float sc = rsqrtf(ss * (1.f / 512.f) + 1e-5f);
            u32x4 o4; o4.x = cvt_pk_bf16(y[0] * sc * g0[0], y[1] * sc * g0[1]); o4.y = cvt_pk_bf16(y[2] * sc * g0[2], y[3] * sc * g0[3]);
            o4.z = cvt_pk_bf16(y[4] * sc * g1[0], y[5] * sc * g1[1]); o4.w = cvt_pk_bf16(y[6] * sc * g1[2], y[7] * sc * g1[3]);
            if (row < SEQ) *(u32x4*)(mix16 + (size_t)row * DM + 512 + lane * 8) = o4;
        }
    }
}

__device__ __forceinline__ void p_rmsnorm16(const int wv, const float* in, const float* g, bf16_t* out16, int rows, int rot) {
    LTID();
    const int lane = tidx & 63;
    for (int r = ROTB(rot) * NW + wv; r < rows; r += gridDim.x * NW) {
        f32x4 v[4]; float ss = 0.f;
#pragma unroll
        for (int j = 0; j < 4; ++j) { v[j] = *(const f32x4*)(in + (size_t)r * DM + 4 * lane + 256 * j); ss += (v[j][0] * v[j][0] + v[j][1] * v[j][1]) + (v[j][2] * v[j][2] + v[j][3] * v[j][3]); }
#pragma unroll
        for (int o = 32; o; o >>= 1) ss += shx(ss, o, lane);
        const float sc = rsqrtf(ss * (1.f / 1024.f) + 1e-5f);
#pragma unroll
        for (int j = 0; j < 4; ++j) { const f32x4 gg = *(const f32x4*)(g + 4 * lane + 256 * j); u32x2 o2; o2.x = cvt_pk_bf16(v[j][0] * sc * gg[0], v[j][1] * sc * gg[1]); o2.y = cvt_pk_bf16(v[j][2] * sc * gg[2], v[j][3] * sc * gg[3]);
            *(u32x2*)(out16 + (size_t)r * DM + 4 * lane + 256 * j) = o2; }
    }
}
__device__ __forceinline__ void p_x16(const int wv, const float* x, bf16_t* h16, float* rs) {
    LTID();
    const int lane = tidx & 63;
    const int rstride = (int)gridDim.x * NW;
    for (int r0 = bidx * NW + wv; r0 < SEQ; r0 += 2 * rstride) {
        int rr[2]; rr[0] = r0; rr[1] = (r0 + rstride < SEQ) ? r0 + rstride : r0;
        f32x4 v[2][2][2];
#pragma unroll
        for (int q = 0; q < 2; ++q)
#pragma unroll
            for (int j = 0; j < 2; ++j) { v[q][j][0] = *(const f32x4*)(x + (size_t)rr[q] * DM + 8 * lane + 512 * j); v[q][j][1] = *(const f32x4*)(x + (size_t)rr[q] * DM + 8 * lane + 512 * j + 4); }
#pragma unroll
        for (int q = 0; q < 2; ++q) {
            if (q == 1 && r0 + rstride >= SEQ) break;
            const int r = rr[q];
            float ss = 0.f;
#pragma unroll
            for (int j = 0; j < 2; ++j)
#pragma unroll
                for (int t = 0; t < 2; ++t) ss += (v[q][j][t][0] * v[q][j][t][0] + v[q][j][t][1] * v[q][j][t][1]) + (v[q][j][t][2] * v[q][j][t][2] + v[q][j][t][3] * v[q][j][t][3]);
#pragma unroll
            for (int o = 32; o; o >>= 1) ss += shx(ss, o, lane);
            if (lane == 0) rs[r] = rsqrtf(ss * (1.f / 1024.f) + 1e-5f);
#pragma unroll
            for (int j = 0; j < 2; ++j) { u32x4 w; w.x = cvt_pk_bf16(v[q][j][0][0], v[q][j][0][1]); w.y = cvt_pk_bf16(v[q][j][0][2], v[q][j][0][3]); w.z = cvt_pk_bf16(v[q][j][1][0], v[q][j][1][1]); w.w = cvt_pk_bf16(v[q][j][1][2], v[q][j][1][3]);
                *(u32x4*)(h16 + (size_t)r * DM + 8 * lane + 512 * j) = w; }
        }
    }
}
template <bool LAST> __device__ __forceinline__ void p_combine16(const int wv, bf16_t* h16, const bf16_t* mout, const int* eslot, const float* topg, const float* g, float* rs, float* out) {
    LTID();
    const int lane = tidx & 63;
    LAS const int* ts = (LAS const int*)(LDSP + TS_OFF);
    const int rstride = (int)gridDim.x * NW;
    for (int r0 = bidx * NW + wv; r0 < SEQ; r0 += 2 * rstride) {
        int rr[2]; rr[0] = r0; rr[1] = (r0 + rstride < SEQ) ? r0 + rstride : r0;
        u32x4 hw[2][2]; int4 es[2]; f32x4 gt[2]; u32x4 mo[2][4][2];
#pragma unroll
        for (int q = 0; q < 2; ++q) { es[q] = *(const int4*)(eslot + rr[q] * 4); gt[q] = *(const f32x4*)(topg + rr[q] * 4);
#pragma unroll
            for (int j = 0; j < 2; ++j) hw[q][j] = *(const u32x4*)(h16 + (size_t)rr[q] * DM + 8 * lane + 512 * j); }
#pragma unroll
        for (int q = 0; q < 2; ++q) { const int esv[4] = {es[q].x, es[q].y, es[q].z, es[q].w};
#pragma unroll
            for (int k = 0; k < 4; ++k) { const int e = esv[k] >> 16, sl = esv[k] & 0xffff; const size_t row = (size_t)ts[e] * BM + sl;
#pragma unroll
                for (int j = 0; j < 2; ++j) mo[q][k][j] = *(const u32x4*)(mout + row * DM + 8 * lane + 512 * j); } }
        float v[2][2][8];
#pragma unroll
        for (int q = 0; q < 2; ++q)
#pragma unroll
            for (int j = 0; j < 2; ++j) { const u32x4 o = hw[q][j];
                v[q][j][0] = bflo(o.x); v[q][j][1] = bfhi(o.x); v[q][j][2] = bflo(o.y); v[q][j][3] = bfhi(o.y); v[q][j][4] = bflo(o.z); v[q][j][5] = bfhi(o.z); v[q][j][6] = bflo(o.w); v[q][j][7] = bfhi(o.w); }
#pragma unroll
        for (int q = 0; q < 2; ++q)
#pragma unroll
            for (int k = 0; k < 4; ++k) { const float gk = gt[q][k];
#pragma unroll
                for (int j = 0; j < 2; ++j) { const u32x4 o = mo[q][k][j];
                    v[q][j][0] += gk * bflo(o.x); v[q][j][1] += gk * bfhi(o.x); v[q][j][2] += gk * bflo(o.y); v[q][j][3] += gk * bfhi(o.y);
                    v[q][j][4] += gk * bflo(o.z); v[q][j][5] += gk * bfhi(o.z); v[q][j][6] += gk * bflo(o.w); v[q][j][7] += gk * bfhi(o.w); } }
#pragma unroll
        for (int q = 0; q < 2; ++q) {
            if (q == 1 && r0 + rstride >= SEQ) break;
            const int r = rr[q];
            float ss = 0.f;
#pragma unroll
            for (int j = 0; j < 2; ++j) ss += ((v[q][j][0] * v[q][j][0] + v[q][j][1] * v[q][j][1]) + (v[q][j][2] * v[q][j][2] + v[q][j][3] * v[q][j][3])) + ((v[q][j][4] * v[q][j][4] + v[q][j][5] * v[q][j][5]) + (v[q][j][6] * v[q][j][6] + v[q][j][7] * v[q][j][7]));
#pragma unroll
            for (int o = 32; o; o >>= 1) ss += shx(ss, o, lane);
            const float sc = rsqrtf(ss * (1.f / 1024.f) + 1e-5f);
#pragma unroll
            for (int j = 0; j < 2; ++j) {
                if (!LAST) { u32x4 w; w.x = cvt_pk_bf16(v[q][j][0], v[q][j][1]); w.y = cvt_pk_bf16(v[q][j][2], v[q][j][3]); w.z = cvt_pk_bf16(v[q][j][4], v[q][j][5]); w.w = cvt_pk_bf16(v[q][j][6], v[q][j][7]);
                    *(u32x4*)(h16 + (size_t)r * DM + 8 * lane + 512 * j) = w; }
                else { const f32x4 g0 = *(const f32x4*)(g + 8 * lane + 512 * j), g1 = *(const f32x4*)(g + 8 * lane + 512 * j + 4);
                    *(f32x4*)(out + (size_t)r * DM + 8 * lane + 512 * j) = (f32x4){v[q][j][0] * sc * g0[0], v[q][j][1] * sc * g0[1], v[q][j][2] * sc * g0[2], v[q][j][3] * sc * g0[3]};
                    *(f32x4*)(out + (size_t)r * DM + 8 * lane + 512 * j + 4) = (f32x4){v[q][j][4] * sc * g1[0], v[q][j][5] * sc * g1[1], v[q][j][6] * sc * g1[2], v[q][j][7] * sc * g1[3]}; }
            }
            if (!LAST) { if (lane == 0) rs[r] = sc; }
        }
    }
}
__device__ __forceinline__ void p_router_tables(const int wv, const float* w_r, const float* g, bf16_t* WR16, int rot) {
    LTID();
    for (int i = ROTB(rot) * NT + tidx; i < 32 * 1024; i += gridDim.x * NT) {
        const int e = i >> 10, k = i & 1023;
        const float w = g[k] * w_r[k * 32 + e];
        const unsigned hi = f2bf(w); const float lo = w - __builtin_bit_cast(float, hi << 16);
        WR16[i] = (bf16_t)hi; WR16[32 * 1024 + i] = (bf16_t)f2bf(lo);
    }
}
constexpr int RT_CNT_OFF = 131072 + 4608;
constexpr int RT_XCH_OFF = 131072 + 5120;
__device__ __forceinline__ void p_router2(const int wv, const bf16_t* h16, const bf16_t* WR16, const float* b_r, unsigned* gcnt, int* rowtok_e, float* rsc_e, int* eslot, float* topg, LAS unsigned char* lds) {
    LTID();
    const int lane = tidx & 63, fr = lane & 15, fq = lane >> 4, w = wv, tg = w & 3, kh = w >> 2;
#pragma unroll
    for (int part = 0; part < 2; ++part)
#pragma unroll
        for (int p = 0; p < 8; ++p) { const int row = 4 * p + (tidx >> 7), cs = tidx & 127;
            glds16s(WR16, (unsigned)(part * 65536 + row * 2048 + ((cs ^ (row & 15)) * 16)), (unsigned)(size_t)(lds + part * 65536 + p * 8192 + w * 1024)); }
    LAS int* lcnt = (LAS int*)(lds + RT_CNT_OFF);
    if (tidx < 64) lcnt[tidx] = 0;
    asm volatile("s_waitcnt vmcnt(0)" ::: "memory");
    __syncthreads();
    for (int it = bidx; it < SEQ / 64; it += gridDim.x) {
        const int token = it * 64 + 16 * tg + fr;
        const bf16_t* xr = h16 + (size_t)token * DM + 512 * kh + 8 * fq;
        f32x4 acc[2]; acc[0] = (f32x4){0.f, 0.f, 0.f, 0.f}; acc[1] = acc[0];
        float ss = 0.f;
#pragma unroll 4
        for (int s4 = 0; s4 < 16; ++s4) {
            const u32x4 hw = *(const u32x4*)(xr + 32 * s4);
            { const float x0 = bflo(hw.x), x1 = bfhi(hw.x), x2 = bflo(hw.y), x3 = bfhi(hw.y), x4 = bflo(hw.z), x5 = bfhi(hw.z), x6 = bflo(hw.w), x7 = bfhi(hw.w);
              ss += ((x0 * x0 + x1 * x1) + (x2 * x2 + x3 * x3)) + ((x4 * x4 + x5 * x5) + (x6 * x6 + x7 * x7)); }
            const bf16x8 xhi = __builtin_bit_cast(bf16x8, hw);
            const int c = 64 * kh + 4 * s4 + fq, slot = c ^ fr;
#pragma unroll
            for (int nb = 0; nb < 2; ++nb) {
                const bf16x8 whi = *(const LAS bf16x8*)(lds + (16 * nb + fr) * 2048 + slot * 16), wlo = *(const LAS bf16x8*)(lds + 65536 + (16 * nb + fr) * 2048 + slot * 16);
                acc[nb] = __builtin_amdgcn_mfma_f32_16x16x32_bf16(whi, xhi, acc[nb], 0, 0, 0);
                acc[nb] = __builtin_amdgcn_mfma_f32_16x16x32_bf16(wlo, xhi, acc[nb], 0, 0, 0);
            }
        }
        ss += shx(ss, 16, lane); ss += shx(ss, 32, lane);
        LAS float* X = (LAS float*)(lds + RT_XCH_OFF) + (tg * 64 + lane) * 9;
        if (kh == 1) {
#pragma unroll
            for (int nb = 0; nb < 2; ++nb)
#pragma unroll
                for (int j = 0; j < 4; ++j) X[nb * 4 + j] = acc[nb][j];
            X[8] = ss;
        }
        __syncthreads();
        int ti[4] = {0, 0, 0, 0}, ls[4] = {0, 0, 0, 0}; float gv[4] = {0.f, 0.f, 0.f, 0.f}; float rs = 0.f;
        if (kh == 0) {
            float lv[8];
            ss += X[8];
            rs = rsqrtf(ss * (1.f / 1024.f) + 1e-5f);
#pragma unroll
            for (int nb = 0; nb < 2; ++nb)
#pragma unroll
                for (int j = 0; j < 4; ++j) lv[nb * 4 + j] = rs * (acc[nb][j] + X[nb * 4 + j]) + b_r[16 * nb + 4 * fq + j];
            float tv[4];
#pragma unroll
            for (int r = 0; r < 4; ++r) {
                float bv = -3.0e38f; int bi = 0;
#pragma unroll
                for (int q = 0; q < 8; ++q) { const int idx = 16 * (q >> 2) + 4 * fq + (q & 3); if (lv[q] > bv) { bv = lv[q]; bi = idx; } }
#pragma unroll
                for (int mk = 16; mk <= 32; mk <<= 1) { const float ov = shx(bv, mk, lane); const int oi = shxi(bi, mk, lane); if (ov > bv || (ov == bv && oi < bi)) { bv = ov; bi = oi; } }
                tv[r] = bv; ti[r] = bi;
#pragma unroll
                for (int q = 0; q < 8; ++q) { const int idx = 16 * (q >> 2) + 4 * fq + (q & 3); if (idx == bi) lv[q] = -3.0e38f; }
            }
            float sum = 0.f;
#pragma unroll
            for (int r = 0; r < 4; ++r) { gv[r] = __expf(tv[r] - tv[0]); sum += gv[r]; }
            const float inv = 1.f / sum;
#pragma unroll
            for (int r = 0; r < 4; ++r) gv[r] *= inv;
            if (fq == 0) {
#pragma unroll
                for (int r = 0; r < 4; ++r) ls[r] = __hip_atomic_fetch_add(&lcnt[ti[r]], 1, __ATOMIC_RELAXED, __HIP_MEMORY_SCOPE_WORKGROUP);
            }
        }
        __syncthreads();
        if (tidx < 32) { const int c = lcnt[tidx]; lcnt[32 + tidx] = c ? (int)__hip_atomic_fetch_add(gcnt + tidx, (unsigned)c, __ATOMIC_RELAXED, __HIP_MEMORY_SCOPE_AGENT) : 0; }
        __syncthreads();
        if (kh == 0 && fq == 0) {
            int es[4];
#pragma unroll
            for (int r = 0; r < 4; ++r) { const int e = ti[r], sl = lcnt[32 + e] + ls[r]; rowtok_e[e * ECAP + sl] = token; rsc_e[e * ECAP + sl] = rs; es[r] = (e << 16) | sl; }
            *(int4*)(eslot + token * 4) = make_int4(es[0], es[1], es[2], es[3]);
            *(f32x4*)(topg + token * 4) = (f32x4){gv[0], gv[1], gv[2], gv[3]};
        }
        __syncthreads();
        if (tidx < 32) lcnt[tidx] = 0;
    }
    __syncthreads();
}

constexpr int NPL = 13;
constexpr int NPHASES = 1 + 2 * NPL;
typedef const __attribute__((address_space(4))) Args* KA;
#define PHASE __device__ __forceinline__
#define KAP() ({ KA _t = a; asm volatile("" : "+s"(_t)); _t; })
#define WSP(T, off) ((T*)(a->ws + (off)))

constexpr int NIT = 49152, NIT1 = 32768;
constexpr int QS0 = 5, QS1 = 8, QG = 9, QX = 13;
struct ConvBounds { int S1, S2, S3, S4; };
__device__ __forceinline__ int cmin(int a, int b) { return a < b ? a : b; }
__device__ __forceinline__ ConvBounds conv_bounds(int G, int l) {
    ConvBounds b;
    const int Px = G > 128 ? G - 128 : G, Px0 = G > 136 ? G - 136 : G;
    b.S1 = cmin(NIT, G * 8 * QS0); b.S2 = cmin(NIT, b.S1 + G * 8 * QS1);
    b.S3 = cmin(NIT, b.S2 + Px * 8 * QG); b.S4 = cmin(NIT, b.S3 + (l == 0 ? Px0 : Px) * 8 * QX);
    return b;
}
__device__ __forceinline__ ConvCtx conv_ctx(KA a, int l, int begin, int end, int wr, int stride) {
    ConvCtx c; c.W1 = a->in[26] + (size_t)l * NEXP * DM * 2048; c.W2 = a->in[28] + (size_t)l * NEXP * DFF * DM; c.T1 = WSP(bf16_t, WS_BT1) + (size_t)l * NEXP * 2048 * DM; c.T2 = WSP(bf16_t, WS_BT2) + (size_t)l * NEXP * DM * DFF;
    c.kg = a->in[23] + l * DM; c.dump = WSP(bf16_t, WS_H + 4 * MiB);       c.begin = begin; c.end = end; c.wr = wr; c.stride = stride; return c;
}
__device__ __forceinline__ void conv_moe(KA a, const int wv, int l, int begin, int end, int rank, int nranks, int scr_pitch = 16384) {
    if (begin >= end) return;
    const int wr = rank * NW + wv, ws_ = nranks * NW;
    if (begin < NIT1) p_transpose_r(wv, a->in[26] + (size_t)l * NEXP * DM * 2048, NEXP, DM, 2048, WSP(bf16_t, WS_BT1) + (size_t)l * NEXP * 2048 * DM, a->in[23] + l * DM, NEXP, 1, LDSP, begin, cmin(end, NIT1), wr, ws_, scr_pitch);
    if (end > NIT1) { const int b2 = begin > NIT1 ? begin - NIT1 : 0;
        p_transpose_r(wv, a->in[28] + (size_t)l * NEXP * DFF * DM, NEXP, DFF, DM, WSP(bf16_t, WS_BT2) + (size_t)l * NEXP * DM * DFF, nullptr, 1, 0, LDSP, b2, end - NIT1, wr, ws_, scr_pitch); }
}
__device__ __forceinline__ int moe_T_lds() { return __builtin_amdgcn_readfirstlane(((LAS const int*)(LDSP + TS_OFF))[32]); }
PHASE void ph_init(KA a, const int wv) {
    p_x16(wv, a->in[0], WSP(bf16_t, WS_HB16), WSP(float, WS_RS));
    p_bias_table(wv, a->in[2], WSP(float, WS_BIASG), 152);
    for (int l = 0; l < 2; ++l) {
        p_s5_tables2(wv, a->in[5] + l * 2048, a->in[6] + l * 2048, a->in[7] + l * 32768, a->in[8] + l * 32768, a->in[9] + l * 32768, a->in[10] + l * 32768, a->in[11] + l * 32,
                     WSP(float2, WS_ABAR) + l * 2048, WSP(float2, WS_A256) + l * 2048, WSP(bf16_t, WS_BB16) + (size_t)l * 32 * 128 * 16, WSP(bf16_t, WS_CM16) + (size_t)l * 32 * 16 * 128, 160 + 32 * l);
        p_rmsnorm16(wv, a->in[1], a->in[19] + l * DM, WSP(bf16_t, WS_MEMN16) + (size_t)l * NMEM * DM, NMEM, 224 + 16 * l);
        p_router_tables(wv, a->in[24] + (size_t)l * DM * 32, a->in[23] + l * DM, WSP(bf16_t, WS_WR16) + (size_t)l * 2 * 32 * 1024, 160 + 64 * l);
    }
    p_transpose(wv, a->in[4], 2, DM, DIN, WSP(bf16_t, WS_WT_IN), a->in[3], 1, 0, LDSP, 0);
    p_transpose(wv, a->in[13], 2, 512, 512, WSP(bf16_t, WS_WT_GLU), nullptr, 1, 0, LDSP, 0);
    p_transpose(wv, a->in[17], 2, DM, DM, WSP(bf16_t, WS_WT_OUT), nullptr, 1, 0, LDSP, 32);
    p_transpose(wv, a->in[20], 2, DM, 512, WSP(bf16_t, WS_WT_XQ), a->in[18], 1, 0, LDSP, 160);
    p_transpose(wv, a->in[21], 2, DM, 1024, WSP(bf16_t, WS_WT_XKV), nullptr, 1, 0, LDSP, 224);
    p_transpose(wv, a->in[22], 2, 512, DM, WSP(bf16_t, WS_WT_XO), nullptr, 1, 0, LDSP, 96);
    __syncthreads();
}
PHASE void ph_gemm_in(KA a, const int wv, int l) { LTID();
    DenseOrder S; S.init(WSP(bf16_t, WS_HB16), WSP(bf16_t, WS_WT_IN) + (size_t)l * DIN * DM, SEQ, DIN, DM, gridDim.x, bidx);
    EpiIn E{WSP(bf16_t, WS_PROJ16), WSP(float, WS_RS)};
    gemm_phase<EpiIn, DenseOrder, false, true>(LDSP, DM, S, E, tidx, wv);
}
PHASE void ph_attn_s5a(KA a, const int wv, int l) {
    p_dil_attn(wv, WSP(bf16_t, WS_PROJ16), WSP(float, WS_BIASG), WSP(bf16_t, WS_OBR), WSP(float, WS_LSE), LDSP);
    const ConvBounds cb = conv_bounds((int)gridDim.x, l);
    if (wv & 1) conv_moe(a, wv, l, 0, cb.S1, (int)blockIdx.x, (int)gridDim.x, 16 * S5_ROWB);
    p_s5_pass<0>(wv, WSP(bf16_t, WS_PROJ16), WSP(float2, WS_ABAR) + l * 2048, WSP(float2, WS_A256) + l * 2048, WSP(bf16_t, WS_BB16) + (size_t)l * 32 * 128 * 16, WSP(bf16_t, WS_CM16) + (size_t)l * 32 * 16 * 128,
                 a->in[12] + l * 512, WSP(float2, WS_E2), WSP(bf16_t, WS_YG16), LDSP, conv_ctx(a, l, 0, 0, 0, 8));
    if (!(wv & 1)) conv_moe(a, wv, l, 0, cb.S1, (int)blockIdx.x, (int)gridDim.x, 16 * S5_ROWB);
}
PHASE void ph_s5b(KA a, const int wv, int l) {
    const ConvBounds cb = conv_bounds((int)gridDim.x, l);
    const int cstride = (int)gridDim.x * NW;
    const int md = p_s5_pass<1>(wv, WSP(bf16_t, WS_PROJ16), WSP(float2, WS_ABAR) + l * 2048, WSP(float2, WS_A256) + l * 2048, WSP(bf16_t, WS_BB16) + (size_t)l * 32 * 128 * 16, WSP(bf16_t, WS_CM16) + (size_t)l * 32 * 16 * 128,
                 a->in[12] + l * 512, WSP(float2, WS_E2), WSP(bf16_t, WS_YG16), LDSP, conv_ctx(a, l, cb.S1, cb.S2, (int)blockIdx.x * NW + wv, cstride));
    conv_moe(a, wv, l, cmin(cb.S1 + md * cstride, cb.S2), cb.S2, (int)blockIdx.x, (int)gridDim.x, 16 * S5_ROWB);
}
PHASE void ph_gemm_glu(KA a, const int wv, int l) {
    {   LTID();
        DenseOrder S; S.init(WSP(bf16_t, WS_YG16), WSP(bf16_t, WS_WT_GLU) + (size_t)l * 512 * 512, SEQ, 512, 512, gridDim.x, bidx);
        EpiGlu16 E{WSP(bf16_t, WS_YB16), WSP(bf16_t, WS_YG16), a->in[14] + l * 512};
        gemm_phase<EpiGlu16, DenseOrder, false, false>(LDSP, 512, S, E, tidx, wv); }
    {   LTID();
        const int G = (int)gridDim.x; const ConvBounds cb = conv_bounds(G, l);
        if (G > 128) { if (bidx >= 128) conv_moe(a, wv, l, cb.S2, cb.S3, bidx - 128, G - 128); }
        else conv_moe(a, wv, l, cb.S2, cb.S3, bidx, G);
    }
}
PHASE void ph_mixnorm(KA a, const int wv, int l) {
    p_attn_combine(wv, WSP(bf16_t, WS_OBR), WSP(float, WS_LSE), a->in[15] + l * 512, WSP(bf16_t, WS_MIX16));
    p_ssm_norm(wv, WSP(bf16_t, WS_YB16), a->in[16] + l * 512, WSP(bf16_t, WS_MIX16));
}
PHASE void ph_gemm_out(KA a, const int wv, int l) { LTID();
    DenseOrder S; S.init(WSP(bf16_t, WS_MIX16), WSP(bf16_t, WS_WT_OUT) + (size_t)l * DM * DM, SEQ, DM, DM, gridDim.x, bidx);
    {   EpiRes16<false, true> E{WSP(bf16_t, WS_HB16), WSP(bf16_t, WS_HB16), WSP(float, WS_SSP)};
        gemm_phase<EpiRes16<false, true>, DenseOrder, false, false>(LDSP, DM, S, E, tidx, wv); }
}
PHASE void ph_gemm_xq(KA a, const int wv, int l) {
    {   LTID();
        DenseOrder S; S.init(WSP(bf16_t, WS_HB16), WSP(bf16_t, WS_WT_XQ) + (size_t)l * 512 * DM, SEQ, 512, DM, gridDim.x, bidx);
        EpiBf16 E{WSP(bf16_t, WS_QX16), 512, 0.08838834764831845f, WSP(float, WS_SSP)};
        gemm_phase<EpiBf16, DenseOrder, false, false>(LDSP, DM, S, E, tidx, wv); }
    {   LTID();
    const int cc = (int)gridDim.x - 1 - bidx;
    if (l == 0 && cc < 8) {
        const int kl = cc >> 2;
        DenseOrder S; S.init(WSP(bf16_t, WS_MEMN16) + (size_t)kl * NMEM * DM, WSP(bf16_t, WS_WT_XKV) + (size_t)kl * 1024 * DM, NMEM, 1024, DM, 4, cc & 3);
        EpiBf16 E{WSP(bf16_t, WS_KV16) + (size_t)kl * NMEM * 1024, 1024, 1.f, nullptr};
        gemm_phase<EpiBf16, DenseOrder, false, false>(LDSP, DM, S, E, tidx, wv);
    } }
    {   LTID();
        const int G = (int)gridDim.x; const ConvBounds cb = conv_bounds(G, l);
        const int skip = (l == 0) ? 8 : 0;
        if (G > 128 + skip) { if (bidx >= 128 && bidx < G - skip) conv_moe(a, wv, l, cb.S3, cb.S4, bidx - 128, G - 128 - skip); }
        else conv_moe(a, wv, l, cb.S3, cb.S4, bidx, G);
    }
}
PHASE void ph_xattn(KA a, const int wv, int l) { p_xattn_mfma(wv, WSP(bf16_t, WS_QX16), WSP(bf16_t, WS_KV16) + (size_t)l * NMEM * 1024, WSP(bf16_t, WS_OX16), LDSP); }
PHASE void ph_gemm_xo(KA a, const int wv, int l) { LTID();
    DenseOrder S; S.init(WSP(bf16_t, WS_OX16), WSP(bf16_t, WS_WT_XO) + (size_t)l * DM * 512, SEQ, DM, 512, gridDim.x, bidx);
    EpiRes16<false, false> E{WSP(bf16_t, WS_HB16), WSP(bf16_t, WS_HB16), nullptr};
    gemm_phase<EpiRes16<false, false>, DenseOrder, false, false>(LDSP, 512, S, E, tidx, wv);
}
PHASE void ph_router(KA a, const int wv, int l) {
    {   LTID();
        const int G = (int)gridDim.x; const ConvBounds cb = conv_bounds(G, l);
        conv_moe(a, wv, l, cb.S4, NIT, bidx, G);
        __syncthreads();
    }
    p_router2(wv, WSP(bf16_t, WS_HB16), WSP(bf16_t, WS_WR16) + (size_t)l * 2 * 32 * 1024, a->in[25] + l * 32, WSP(unsigned, WS_CTL) + CW_CNT + l * 32,
              WSP(int, WS_ROWTOK), WSP(float, WS_RSC), WSP(int, WS_ESLOT), WSP(float, WS_TOPG), LDSP);
}
__device__ __forceinline__ int moe_split(int T, int G) {
    const int tpr = G / 8, Ta = (T / tpr) * tpr;
    const int base = (8 * T + G - 1) / G + (4 * T + G - 1) / G, alt = (8 * Ta) / G + (8 * (T - Ta) + 4 * T + G - 1) / G;
    return (Ta > 0 && Ta < T && alt < base) ? Ta : T;
}
PHASE void ph_moe1(KA a, const int wv, int l) {
    {   LTID();
        moe_tiles(WSP(unsigned, WS_CTL) + CW_CNT + l * 32, tidx);
        const int G = (int)gridDim.x, T = moe_T_lds(), Ta = moe_split(T, G);
        MoeOrder<true> S; S.init(WSP(bf16_t, WS_HB16), WSP(bf16_t, WS_BT1) + (size_t)l * NEXP * 2048 * DM, WSP(int, WS_ROWTOK), 2048, DM, (size_t)2048 * DM * 2, G, bidx, 0, Ta, 0);
        EpiMoe1 E{WSP(bf16_t, WS_ACT), a->in[27] + (size_t)l * NEXP * 2048, WSP(float, WS_RSC)};
        gemm_phase<EpiMoe1, MoeOrder<true>, true, true>(LDSP, DM, S, E, tidx, wv); }
}
PHASE void ph_moe2(KA a, const int wv, int l) {
    {   LTID();
        moe_tiles(WSP(unsigned, WS_CTL) + CW_CNT + l * 32, tidx);
        const int G = (int)gridDim.x, T = moe_T_lds(), Ta = moe_split(T, G), n1 = 8 * (T - Ta);
        if (n1 > 0) {
            MoeOrder<true> S; S.init(WSP(bf16_t, WS_HB16), WSP(bf16_t, WS_BT1) + (size_t)l * NEXP * 2048 * DM, WSP(int, WS_ROWTOK), 2048, DM, (size_t)2048 * DM * 2, G, bidx, Ta, T - Ta, 0);
            EpiMoe1 E{WSP(bf16_t, WS_ACT), a->in[27] + (size_t)l * NEXP * 2048, WSP(float, WS_RSC)};
            gemm_phase<EpiMoe1, MoeOrder<true>, true, true>(LDSP, DM, S, E, tidx, wv);
            const int mine = n1 > bidx ? (n1 - 1 - bidx) / G + 1 : 0;
            if (mine > 0) {
                asm volatile("s_waitcnt vmcnt(0)" ::: "memory");
                __syncthreads();
                if (tidx == 0) { __builtin_amdgcn_fence(__ATOMIC_RELEASE, "agent"); asm volatile("s_waitcnt vmcnt(0)" ::: "memory");
                    __hip_atomic_fetch_add(WSP(unsigned, WS_CTL) + CW_MX + l, (unsigned)mine, __ATOMIC_RELAXED, __HIP_MEMORY_SCOPE_AGENT); }
            }
        } }
    {   LTID();
        const int G = (int)gridDim.x, T = moe_T_lds(), Ta = moe_split(T, G), n1 = 8 * (T - Ta);
        MoeOrder<false> S; S.init(WSP(bf16_t, WS_ACT), WSP(bf16_t, WS_BT2) + (size_t)l * NEXP * DM * DFF, nullptr, DM, DFF, (size_t)DM * DFF * 2, G, bidx, 0, Ta, n1);
        EpiMoe2 E{WSP(bf16_t, WS_MOUT), a->in[29] + (size_t)l * NEXP * DM};
        gemm_phase<EpiMoe2, MoeOrder<false>, false, true>(LDSP, DFF, S, E, tidx, wv); }
    {   LTID();
        const int G = (int)gridDim.x, T = moe_T_lds(), Ta = moe_split(T, G), n1 = 8 * (T - Ta);
        if (n1 > 0) {
            MoeOrder<false> S; S.init(WSP(bf16_t, WS_ACT), WSP(bf16_t, WS_BT2) + (size_t)l * NEXP * DM * DFF, nullptr, DM, DFF, (size_t)DM * DFF * 2, G, bidx, Ta, T - Ta, n1 + 4 * Ta);
            GUnit u0;
            if (S.next(0, u0)) {
                if (tidx == 0) { unsigned sp = 0;
                    while (__hip_atomic_load(WSP(unsigned, WS_CTL) + CW_MX + l, __ATOMIC_RELAXED, __HIP_MEMORY_SCOPE_AGENT) < (unsigned)n1) { __builtin_amdgcn_s_sleep(2); if (++sp > (1u << 24)) break; }
                    __builtin_amdgcn_fence(__ATOMIC_ACQUIRE, "agent"); }
                __syncthreads();
                EpiMoe2 E{WSP(bf16_t, WS_MOUT), a->in[29] + (size_t)l * NEXP * DM};
                gemm_phase<EpiMoe2, MoeOrder<false>, false, true>(LDSP, DFF, S, E, tidx, wv);
            }
        } }
}
PHASE void ph_combine(KA a, const int wv, int l) { LTID();
    moe_tiles(WSP(unsigned, WS_CTL) + CW_CNT + l * 32, tidx);
    if (l == 0) p_combine16<false>(wv, WSP(bf16_t, WS_HB16), WSP(bf16_t, WS_MOUT), WSP(int, WS_ESLOT), WSP(float, WS_TOPG), nullptr, WSP(float, WS_RS), nullptr);
    else p_combine16<true>(wv, WSP(bf16_t, WS_HB16), WSP(bf16_t, WS_MOUT), WSP(int, WS_ESLOT), WSP(float, WS_TOPG), a->in[30], nullptr, a->out);
}

__global__ void __launch_bounds__(NT, 2) mega(Args args) {
    KA a = (KA)__builtin_amdgcn_kernarg_segment_ptr();
    int wv = __builtin_amdgcn_readfirstlane((int)threadIdx.x >> 6); asm volatile("" : "+s"(wv));
    LAS unsigned char* lds = LDSP;
    volatile LAS unsigned* MISC = (volatile LAS unsigned*)(lds + MISC_OFF);
    unsigned* ctl = (unsigned*)(a->ws + WS_CTL);
    if (threadIdx.x < 32) MISC[threadIdx.x] = 0u;
    __syncthreads();
    XcdBarrier bar; bar.bar = ctl + CW_BAR; bar.x = 0; bar.st = nullptr;
    if (!MK_PER_PHASE) bar = xcd_barrier_post(ctl + CW_BAR, MISC + 8);
    const int lo = a->ph_lo, hi = a->ph_hi;
#define IN(k) (lo <= (k) && (k) < hi)
#define SEAM(k) do { if (IN(k) && IN((k) + 1)) { LTID(); xcd_barrier(bar.bar, bar.x, bar.st, tidx == 0); if (PROBE_DUP == 200) xcd_barrier(bar.bar, bar.x, bar.st, tidx == 0); \
        if (PROBE_AMP_LO >= 0 && ((k) == PROBE_AMP_LO - 1 || (k) == PROBE_AMP_HI)) { if (bidx == 0) { volatile LAS unsigned* M_ = MISC + 20; \
            if (tidx == 0) { const unsigned t_ = (unsigned)__builtin_amdgcn_s_memrealtime(); if ((k) != PROBE_AMP_HI) M_[0] = t_; \
                else { const unsigned d_ = (t_ - M_[0]) * PROBE_AMP_K; while ((unsigned)__builtin_amdgcn_s_memrealtime() - t_ < d_) __builtin_amdgcn_s_sleep(8); } } \
            __syncthreads(); } } } } while (0)
    if (IN(0)) { ph_init(KAP(), wv); if (PROBE_DUP == 100) ph_init(KAP(), wv); }
    SEAM(0);
#define LAYER_PROGRAM(l) { const int pb = 1 + (l) * NPL; \
        if (IN(pb + 0)) { ph_gemm_in(KAP(), wv, (l)); if (PROBE_DUP == 0) { ph_gemm_in(KAP(), wv, (l)); } } \
        SEAM(pb + 0); \
        if (IN(pb + 1)) { ph_attn_s5a(KAP(), wv, (l)); if (PROBE_DUP == 1) { ph_attn_s5a(KAP(), wv, (l)); } } \
        SEAM(pb + 1); \
        if (IN(pb + 2)) { ph_s5b(KAP(), wv, (l)); if (PROBE_DUP == 2) { ph_s5b(KAP(), wv, (l)); } } \
        SEAM(pb + 2); \
        if (IN(pb + 3)) { ph_gemm_glu(KAP(), wv, (l)); if (PROBE_DUP == 3) { ph_gemm_glu(KAP(), wv, (l)); } } \
        SEAM(pb + 3); \
        if (IN(pb + 4)) { ph_mixnorm(KAP(), wv, (l)); if (PROBE_DUP == 4) { ph_mixnorm(KAP(), wv, (l)); } } \
        SEAM(pb + 4); \
        if (IN(pb + 5)) { ph_gemm_out(KAP(), wv, (l)); if (PROBE_DUP == 5) { ph_gemm_out(KAP(), wv, (l)); } } \
        SEAM(pb + 5); \
        if (IN(pb + 6)) { ph_gemm_xq(KAP(), wv, (l)); if (PROBE_DUP == 6) { ph_gemm_xq(KAP(), wv, (l)); } } \
        SEAM(pb + 6); \
        if (IN(pb + 7)) { ph_xattn(KAP(), wv, (l)); if (PROBE_DUP == 7) { ph_xattn(KAP(), wv, (l)); } } \
        SEAM(pb + 7); \
        if (IN(pb + 8)) { ph_gemm_xo(KAP(), wv, (l)); if (PROBE_DUP == 8) { ph_gemm_xo(KAP(), wv, (l)); } } \
        SEAM(pb + 8); \
        if (IN(pb + 9)) { ph_router(KAP(), wv, (l)); if (PROBE_DUP == 9) { ph_router(KAP(), wv, (l)); } } \
        SEAM(pb + 9); \
        if (IN(pb + 10)) { ph_moe1(KAP(), wv, (l)); if (PROBE_DUP == 10) { ph_moe1(KAP(), wv, (l)); } } \
        SEAM(pb + 10); \
        if (IN(pb + 11)) { ph_moe2(KAP(), wv, (l)); if (PROBE_DUP == 11) { ph_moe2(KAP(), wv, (l)); } } \
        SEAM(pb + 11); \
        if (IN(pb + 12)) { ph_combine(KAP(), wv, (l)); if (PROBE_DUP == 12) { ph_combine(KAP(), wv, (l)); } } \
        SEAM(pb + 12); }
    LAYER_PROGRAM(0)
    LAYER_PROGRAM(1)
#undef LAYER_PROGRAM
#undef IN
#undef SEAM
}

extern "C" void kernel_launch(void* const* d_in, const int* in_sizes, int n_in, void* d_out, int out_size, void* d_ws, size_t ws_size, hipStream_t stream) {
    static int grid = 0;
    if (grid == 0) {
        if (n_in != 31 || ws_size < WS_END) { fprintf(stderr, "kernel_launch: unexpected n_in %d or ws_size %zu (need %zu)\n", n_in, ws_size, (size_t)WS_END); grid = -1; return; }
        int dev = 0, cus = 0, per_cu = 0;
        if (hipGetDevice(&dev) != hipSuccess || hipDeviceGetAttribute(&cus, hipDeviceAttributeMultiprocessorCount, dev) != hipSuccess) { grid = -1; return; }
        if (hipFuncSetAttribute((const void*)mega, hipFuncAttributeMaxDynamicSharedMemorySize, LDS_BYTES) != hipSuccess) { fprintf(stderr, "kernel_launch: hipFuncSetAttribute failed\n"); grid = -1; return; }
        if (hipOccupancyMaxActiveBlocksPerMultiprocessor(&per_cu, (const void*)mega, NT, LDS_BYTES) != hipSuccess || per_cu < 1)
            fprintf(stderr, "kernel_launch: occupancy query reports %d workgroups per CU\n", per_cu);
        (void)hipGetLastError();
        grid = cus;
    }
    if (grid < 0) return;
    if (hipMemsetAsync((char*)d_ws + WS_CTL, 0, CTL_ZERO_BYTES, stream) != hipSuccess) return;
    Args a{};
    for (int i = 0; i < 31; ++i) a.in[i] = (const float*)d_in[i];
    a.out = (float*)d_out; a.ws = (unsigned char*)d_ws;
#if MK_PER_PHASE
    for (int p = 0; p < NPHASES; ++p) { a.ph_lo = p; a.ph_hi = p + 1; hipLaunchKernelGGL(mega, dim3(grid), dim3(NT), LDS_BYTES, stream, a); }
#else
    a.ph_lo = 0; a.ph_hi = NPHASES;
    hipLaunchKernelGGL(mega, dim3(grid), dim3(NT), LDS_BYTES, stream, a);
#endif
}
```

```cpp
#include <hip/hip_runtime.h>
#include <stdint.h>
#include <cstdio>

#ifndef PROBE_AMP_LO
#define PROBE_AMP_LO -1
#define PROBE_AMP_HI -1
#define PROBE_AMP_K 4
#endif
#ifndef PROBE_DUP
#define PROBE_DUP -1
#endif
#ifndef MK_PER_PHASE
#define MK_PER_PHASE 0
#endif

#define SEQ 16384
#define DM 1024
#define DIN 2048
#define NMEM 256
#define NEXP 32
#define TOPK 4
#define DFF 1024
#define NT 512
#define NW 8

#define LAS __attribute__((address_space(3)))
typedef float f32x4 __attribute__((ext_vector_type(4)));
typedef float f32x2 __attribute__((ext_vector_type(2)));
extern __shared__ __attribute__((aligned(16))) unsigned char lds_raw[];
#define LDSP ((LAS unsigned char*)lds_raw)
#define LTID() int z_ = 0; asm volatile("" : "+v"(z_)); const int lane_ = (int)__builtin_amdgcn_mbcnt_hi(~0u, __builtin_amdgcn_mbcnt_lo(~0u, (unsigned)z_)); \
    const int tidx = wv * 64 + lane_; int bidx = blockIdx.x; asm volatile("" : "+s"(bidx))
#define ROTB(rot) ((bidx + (int)gridDim.x - (rot) % (int)gridDim.x) % (int)gridDim.x)
__device__ __forceinline__ float shx(float v, int mask, int lane) { return __builtin_bit_cast(float, __builtin_amdgcn_ds_bpermute((lane ^ mask) << 2, __builtin_bit_cast(int, v))); }
__device__ __forceinline__ int shxi(int v, int mask, int lane) { return __builtin_amdgcn_ds_bpermute((lane ^ mask) << 2, v); }
constexpr int LDS_BYTES = 147456;
constexpr int MISC_OFF = 131072 + 320;

#define XB_TMO      128
#define XB_XCNT(j)  (256  + 64 * (j))
#define XB_XSUB(j)  (1280 + 64 * (j))
#define XB_XGEN(j)  (2304 + 64 * (j))
#define XB_TOP      3328
#define XB_TOPGEN   3392
#define XCD_BAR_WORDS 3456
#define XB_SPIN_CAP (1u << 18)

__device__ __forceinline__ unsigned xb_ld(unsigned* p)              { return __hip_atomic_load(p, __ATOMIC_RELAXED, __HIP_MEMORY_SCOPE_AGENT); }
__device__ __forceinline__ unsigned xb_add(unsigned* p, unsigned v) { return __hip_atomic_fetch_add(p, v, __ATOMIC_RELAXED, __HIP_MEMORY_SCOPE_AGENT); }
__device__ __forceinline__ unsigned xb_xcc_id() { return (unsigned)__builtin_amdgcn_s_getreg((3 << 11) | 20) & 0xFu; }
#define XB_SPIN(cond, bar) do { unsigned _sp = 0; while (cond) { __builtin_amdgcn_s_sleep(1); \
    if ((++_sp & 255u) == 0u) { if (xb_ld(&(bar)[XB_TMO])) break; if (_sp > XB_SPIN_CAP) { atomicAdd(&(bar)[XB_TMO], 1u); break; } } } } while (0)

struct XcdBarrier {
    unsigned* bar; unsigned x;
    volatile LAS unsigned* st;
};
__device__ __forceinline__ XcdBarrier xcd_barrier_post(unsigned* bar, volatile LAS unsigned* st) {
    XcdBarrier b; b.bar = bar; b.x = xb_xcc_id(); b.st = st;
    if (threadIdx.x == 0) (void)xb_add(&bar[XB_XCNT(b.x)], 1u);
    return b;
}
__device__ __forceinline__ void xcd_barrier_complete(unsigned* bar, unsigned x, unsigned& nloc, unsigned& nx) {
    const unsigned G = gridDim.x * gridDim.y * gridDim.z;
    unsigned sum, cnt, mine, sp = 0u;
    for (;;) {
        sum = 0u; cnt = 0u; mine = 0u;
#pragma unroll
        for (unsigned j = 0; j < 16; ++j) { const unsigned c = xb_ld(&bar[XB_XCNT(j)]); sum += c; cnt += (c > 0u) ? 1u : 0u; mine = (j == x) ? c : mine; }
        if (sum == G) break;
        __builtin_amdgcn_s_sleep(1);
        if ((++sp & 255u) == 0u) { if (xb_ld(&bar[XB_TMO])) break; if (sp > XB_SPIN_CAP) { atomicAdd(&bar[XB_TMO], 1u); break; } }
    }
    nloc = mine > 0u ? mine : 1u; nx = cnt > 0u ? cnt : 1u;
}
__device__ __noinline__ void xcd_barrier(unsigned* bar_, unsigned x_, volatile LAS unsigned* st_, int is_t0) {
    XcdBarrier b; b.bar = bar_; b.x = x_; b.st = st_;
    asm volatile("s_waitcnt vmcnt(0)" ::: "memory");
    __syncthreads();
    if (is_t0) {
        unsigned* bar = b.bar;
        __builtin_amdgcn_s_waitcnt(0);
        unsigned nloc = b.st[0], nx = b.st[1];
        if (nloc == 0u) { xcd_barrier_complete(bar, b.x, nloc, nx); b.st[0] = nloc; b.st[1] = nx; }
        const unsigned old = xb_add(&bar[XB_XSUB(b.x)], 1u);
        const unsigned gen = old / nloc;
        if (old + 1u == (gen + 1u) * nloc) {
            __builtin_amdgcn_fence(__ATOMIC_RELEASE, "agent");
            asm volatile("s_waitcnt vmcnt(0)" ::: "memory");
            const unsigned og = xb_add(&bar[XB_TOP], 1u);
            const unsigned tg = og / nx;
            if (og + 1u == (tg + 1u) * nx) xb_add(&bar[XB_TOPGEN], 1u);
            else XB_SPIN(xb_ld(&bar[XB_TOPGEN]) == tg, bar);
            __builtin_amdgcn_fence(__ATOMIC_ACQUIRE, "agent");
            xb_add(&bar[XB_XGEN(b.x)], 1u);
            asm volatile("s_waitcnt vmcnt(0)" ::: "memory");
        } else {
            XB_SPIN(xb_ld(&bar[XB_XGEN(b.x)]) == gen, bar);
            __builtin_amdgcn_fence(__ATOMIC_ACQUIRE, "agent");
            asm volatile("s_waitcnt vmcnt(0)" ::: "memory");
        }
    }
    __syncthreads();
}

constexpr size_t MiB = 1u << 20;
constexpr size_t WS_CTL = 0, CTL_ZERO_BYTES = 64 * 1024;
constexpr int CW_BAR = 4096;
constexpr int CW_CNT = 8192;
constexpr int CW_MX = 8192 + 192;
constexpr int MOE_ROWS = SEQ * TOPK + NEXP * 256;
constexpr int ECAP = SEQ;
constexpr size_t al256(size_t x) { return (x + 255) & ~(size_t)255; }
constexpr size_t WS_H = 2 * MiB;
constexpr size_t WS_XN16 = WS_H + (size_t)SEQ * DM * 4;
constexpr size_t WS_RS = WS_H;
constexpr size_t WS_HB16 = WS_XN16 + (size_t)SEQ * DM * 2;
constexpr size_t WS_PROJ16 = WS_HB16 + (size_t)SEQ * DM * 2;
constexpr size_t WS_OBR = WS_PROJ16 + (size_t)SEQ * 2048 * 2;
constexpr size_t WS_LSE = WS_OBR + 3 * (size_t)SEQ * 512 * 2;
constexpr size_t WS_YG16 = WS_LSE + 3 * (size_t)SEQ * 8 * 4;
constexpr size_t WS_YB16 = WS_YG16 + (size_t)SEQ * 512 * 2;
constexpr size_t WS_MIX16 = WS_YB16 + (size_t)SEQ * 512 * 2;
constexpr size_t WS_QX16 = WS_MIX16 + (size_t)SEQ * DM * 2;
constexpr size_t WS_OX16 = WS_QX16 + (size_t)SEQ * 512 * 2;
constexpr size_t WS_ACT = WS_OX16 + (size_t)SEQ * 512 * 2;
constexpr size_t WS_MOUT = WS_ACT + (size_t)MOE_ROWS * DFF * 2;
constexpr size_t WS_BT1 = WS_MOUT + (size_t)MOE_ROWS * DM * 2;
constexpr size_t WS_BT2 = WS_BT1 + 2 * (size_t)NEXP * 2048 * DM * 2;
constexpr size_t WS_WT_IN = WS_BT2 + 2 * (size_t)NEXP * DM * DFF * 2;
constexpr size_t WS_WT_GLU = WS_WT_IN + 2 * (size_t)2048 * 1024 * 2;
constexpr size_t WS_WT_OUT = WS_WT_GLU + 2 * (size_t)512 * 512 * 2;
constexpr size_t WS_WT_XQ = WS_WT_OUT + 2 * (size_t)1024 * 1024 * 2;
constexpr size_t WS_WT_XKV = WS_WT_XQ + 2 * (size_t)512 * 1024 * 2;
constexpr size_t WS_WT_XO = WS_WT_XKV + 2 * (size_t)1024 * 1024 * 2;
constexpr size_t WS_MEMN16 = WS_WT_XO + 2 * (size_t)1024 * 512 * 2;
constexpr size_t WS_KV16 = WS_MEMN16 + 2 * (size_t)NMEM * 1024 * 2;
constexpr size_t WS_WR16 = WS_KV16 + 2 * (size_t)NMEM * 1024 * 2;
constexpr size_t WS_BIASG = WS_WR16 + 2 * 2 * (size_t)32 * 1024 * 2;
constexpr size_t WS_ABAR = al256(WS_BIASG + 24 * 132 * 4);
constexpr size_t WS_A256 = WS_ABAR + 2 * 2048 * 8;
constexpr size_t WS_BB16 = WS_A256 + 2 * 2048 * 8;
constexpr size_t WS_CM16 = WS_BB16 + 2 * (size_t)32 * 128 * 16 * 2;
constexpr size_t WS_E2 = WS_CM16 + 2 * (size_t)32 * 16 * 128 * 2;
constexpr size_t WS_ROWTOK = WS_E2 + (size_t)64 * 2048 * 8;
constexpr size_t WS_RSC = WS_ROWTOK + (size_t)NEXP * ECAP * 4;
constexpr size_t WS_ESLOT = WS_RSC + (size_t)NEXP * ECAP * 4;
constexpr size_t WS_TOPG = WS_ESLOT + (size_t)SEQ * 4 * 4;
constexpr size_t WS_SSP = WS_TOPG + (size_t)SEQ * 4 * 4;
constexpr size_t WS_END = WS_SSP + (size_t)SEQ * 16 * 4;

struct Args { const float* in[31]; float* out; unsigned char* ws; int ph_lo, ph_hi; };


typedef unsigned short bf16_t;
typedef short bf16x8 __attribute__((ext_vector_type(8)));
typedef unsigned u32x4 __attribute__((ext_vector_type(4)));
typedef unsigned u32x2 __attribute__((ext_vector_type(2)));
constexpr int BM = 256, BK = 64, HALF = 128, HTB = HALF * BK * 2, STAGE_BYTES = 8 * HTB, NXCD = 8, WGM = 4, WGM_MOE = 1;
__host__ __device__ __forceinline__ int lds_byte(int r, int c) { const int st = (r >> 4) * 2 + (c >> 5), rr = r & 15, cc = c & 31, ob = rr * 64 + cc * 2; return st * 1024 + (ob ^ (((ob >> 9) & 1) << 5)); }
__host__ __device__ __forceinline__ void stage_rc(int b, int& R, int& C) { const int st = b / 1024, sb = b % 1024, swz = sb ^ (((sb >> 9) & 1) << 5); R = (st >> 1) * 16 + swz / 64; C = (st & 1) * 32 + (swz % 64) / 2; }
__host__ __device__ __forceinline__ int perm32(int rho) { const int n = rho >> 4, i = rho & 15; return 8 * (i >> 2) + 4 * n + (i & 3); }
__device__ __forceinline__ unsigned cvt_pk_bf16(float lo, float hi) { unsigned r; asm volatile("v_cvt_pk_bf16_f32 %0, %1, %2" : "=v"(r) : "v"(lo), "v"(hi)); return r; }
__device__ __forceinline__ unsigned f2bf(float f) { unsigned u = __builtin_bit_cast(unsigned, f); return (u + 0x7fffu + ((u >> 16) & 1u)) >> 16; }
__device__ __forceinline__ unsigned pk2(float lo, float hi) { return f2bf(lo) | (f2bf(hi) << 16); }
__device__ __forceinline__ float bf2f(unsigned short b) { return __builtin_bit_cast(float, ((unsigned)b) << 16); }

__device__ __forceinline__ void glds16s(const void* sbase, unsigned voff, unsigned lds_dst) {
    unsigned keep;
    asm volatile("s_mov_b32 %0, m0\n\ts_mov_b32 m0, %3\n\ts_nop 0\n\tglobal_load_lds_dwordx4 %1, %2\n\ts_mov_b32 m0, %0" : "=&s"(keep) : "v"(voff), "s"(sbase), "s"(lds_dst) : "memory");
}
struct GUnit { const char* A; const char* B; int pm, pn, e, row0, cnt; };

struct DenseOrder {
    const char* A; const char* Bt; int nM, nN, nwg, G, c, K;
    __device__ __forceinline__ void init(const bf16_t* A_, const bf16_t* Bt_, int M, int N, int K_, int G_, int c_) { A = (const char*)A_; Bt = (const char*)Bt_; nM = M / BM; nN = N / BM; nwg = nM * nN; G = G_; c = c_; K = K_; }
    __device__ __forceinline__ bool next(int i, GUnit& u) const {
        const long L = (long)i * G + c; if (L >= nwg) return false;
        int wgid = (int)L; { const int q = nwg / NXCD, r = nwg % NXCD, xcd = wgid % NXCD, off = wgid / NXCD; wgid = (xcd < r ? xcd * (q + 1) : r * (q + 1) + (xcd - r) * q) + off; }
        const int nig = WGM * nN, gid = wgid / nig, fm = gid * WGM, gsz = (nM - fm) < WGM ? (nM - fm) : WGM;
        u.pm = fm + ((wgid % nig) % gsz); u.pn = (wgid % nig) / gsz; u.e = 0; u.row0 = 0; u.cnt = 0;
        u.A = A + (size_t)u.pm * BM * K * 2; u.B = Bt + (size_t)u.pn * BM * K * 2; return true;
    }
    __device__ __forceinline__ unsigned aoff(const GUnit&, int row) const { return (unsigned)(row * K * 2); }
    __device__ __forceinline__ unsigned tokoff(const GUnit&, int) const { return 0u; }
    __device__ __forceinline__ const int* tokbase() const { return nullptr; }
};

struct EpiF32 {
    static constexpr bool PERM = false; static constexpr bool STAGED = false;
    float* C; int ldc; int resid;
    __device__ __forceinline__ void operator()(const f32x4 (&acc)[2][2][4][2], const GUnit& u, int wr, int wc, int fr, int fq) const {
        const int row0 = u.pm * BM + wr * 64 + fr, col0 = u.pn * BM + wc * 32 + 4 * fq;
#pragma unroll
        for (int ai = 0; ai < 2; ++ai)
#pragma unroll
            for (int m = 0; m < 4; ++m) { float* rowp = C + (size_t)(row0 + ai * HALF + m * 16) * ldc + col0;
#pragma unroll
                for (int bj = 0; bj < 2; ++bj)
#pragma unroll
                    for (int n = 0; n < 2; ++n) { f32x4 v = acc[ai][bj][m][n]; if (resid) v += *(const f32x4*)(rowp + bj * HALF + n * 16); *(f32x4*)(rowp + bj * HALF + n * 16) = v; } }
    }
};
struct EpiGlu {
    static constexpr bool PERM = false; static constexpr bool STAGED = false;
    float* C; const float* Y; int ldc; const float* bias;
    __device__ __forceinline__ void operator()(const f32x4 (&acc)[2][2][4][2], const GUnit& u, int wr, int wc, int fr, int fq) const {
        const int row0 = u.pm * BM + wr * 64 + fr, col0 = u.pn * BM + wc * 32 + 4 * fq;
#pragma unroll
        for (int ai = 0; ai < 2; ++ai)
#pragma unroll
            for (int m = 0; m < 4; ++m) { const size_t ro = (size_t)(row0 + ai * HALF + m * 16) * ldc + col0;
#pragma unroll
                for (int bj = 0; bj < 2; ++bj)
#pragma unroll
                    for (int n = 0; n < 2; ++n) { const f32x4 b = *(const f32x4*)(bias + col0 + bj * HALF + n * 16); const f32x4 y = *(const f32x4*)(Y + ro + bj * HALF + n * 16);
                        f32x4 v = acc[ai][bj][m][n] + b; f32x4 o;
#pragma unroll
                        for (int j = 0; j < 4; ++j) o[j] = y[j] / (1.f + __expf(-v[j]));
                        *(f32x4*)(C + ro + bj * HALF + n * 16) = o; } }
    }
};

constexpr int EPI_OFF = 131072 + 8192;
template <class Epi, class Sched, bool GATHER, bool ALIGN_EPI>
__device__ __forceinline__ void gemm_phase(LAS unsigned char* lds, const int K, const Sched& S, const Epi& E, const int tid, const int wv) {
    const int wid = wv, lane = tid & 63, wr = wid >> 2, wc = wid & 3, fr = lane & 15, fq = lane >> 4;
    const int nt = K / BK;
    unsigned voffB[2];
#pragma unroll
    for (int i = 0; i < 2; ++i) { int R, C; stage_rc(tid * 16 + i * 8192, R, C); const int Rb = Epi::PERM ? ((R & ~31) + perm32(R & 31)) : R; voffB[i] = (unsigned)(Rb * K + C) * 2u; }
#define PG8_AOFFS(dst, u) do { int t2_ = tid; asm volatile("" : "+v"(t2_)); _Pragma("unroll") for (int i = 0; i < 2; ++i) { int R, C; stage_rc(t2_ * 16 + i * 8192, R, C); \
        _Pragma("unroll") for (int h = 0; h < 2; ++h) dst[h][i] = S.aoff(u, h * HALF + R) + (unsigned)C * 2u; } } while (0)
    const size_t kstep = (size_t)(BK * 2);
    const size_t hstep = (size_t)HALF * K * 2;
    const unsigned ldsw = (unsigned)wid * 1024u;
    const int aoff = lds_byte(wr * 64 + fr, fq * 8), boff = lds_byte(wc * 32 + fr, fq * 8);
#define PG8_SA(b, h) (((b) * 2 + (h)) * HTB)
#define PG8_SB(b, h) ((4 + (b) * 2 + (h)) * HTB)
#define PG8_STAGE(bufoff, gbase, v0, v1) do { const unsigned ld_ = (unsigned)(size_t)(lds + (bufoff) + ldsw); glds16s((gbase), (v0), ld_); glds16s((gbase), (v1), ld_ + 8192u); } while (0)
#define PG8_LDA(dst, b, h) do { _Pragma("unroll") for (int m = 0; m < 4; ++m) _Pragma("unroll") for (int k = 0; k < 2; ++k) dst[m][k] = *(const LAS bf16x8*)(lds + PG8_SA(b, h) + aoff + m * 2048 + k * 1024); } while (0)
#define PG8_LDB(dst, b, h) do { _Pragma("unroll") for (int n = 0; n < 2; ++n) _Pragma("unroll") for (int k = 0; k < 2; ++k) dst[n][k] = *(const LAS bf16x8*)(lds + PG8_SB(b, h) + boff + n * 2048 + k * 1024); } while (0)
#define PG8_MMA(ai, bj, At, Bt) do { __builtin_amdgcn_s_setprio(1); _Pragma("unroll") for (int m = 0; m < 4; ++m) _Pragma("unroll") for (int n = 0; n < 2; ++n) _Pragma("unroll") for (int k = 0; k < 2; ++k) \
        acc[ai][bj][m][n] = __builtin_amdgcn_mfma_f32_16x16x32_bf16(Bt[n][k], At[m][k], acc[ai][bj][m][n], 0, 0, 0); __builtin_amdgcn_s_setprio(0); } while (0)
#define PG8_WAIT_V(n) asm volatile("s_waitcnt vmcnt(" #n ")" ::: "memory")
#define PG8_WAIT_L(n) asm volatile("s_waitcnt lgkmcnt(" #n ")" ::: "memory")
#define PG8_BAR __builtin_amdgcn_s_barrier()
#define PG8_SCHED __builtin_amdgcn_sched_barrier(0)
    GUnit cur, nxt; int ui = 0;
    if (!S.next(0, cur)) return;
    int es3 = 0;
    if constexpr (Epi::STAGED) E.stage(lds + EPI_OFF, cur, wid, lane);
    f32x4 acc[2][2][4][2];
#pragma unroll
    for (int a = 0; a < 2; ++a)
#pragma unroll
        for (int b = 0; b < 2; ++b)
#pragma unroll
            for (int m = 0; m < 4; ++m)
#pragma unroll
                for (int n = 0; n < 2; ++n) acc[a][b][m][n] = (f32x4){0.f, 0.f, 0.f, 0.f};
    bf16x8 At[4][2], B0[2][2], B1[2][2];
    unsigned vA[2][2], vN[2][2];
    PG8_AOFFS(vA, cur);
#pragma unroll
    for (int h = 0; h < 2; ++h)
#pragma unroll
        for (int i = 0; i < 2; ++i) vN[h][i] = vA[h][i];
    const char* cA = cur.A; const char* cB = cur.B;
    PG8_STAGE(PG8_SB(0, 0), cB, voffB[0], voffB[1]); PG8_STAGE(PG8_SB(0, 1), cB + hstep, voffB[0], voffB[1]); PG8_STAGE(PG8_SA(0, 0), cA, vA[0][0], vA[0][1]); PG8_STAGE(PG8_SA(0, 1), cA, vA[1][0], vA[1][1]);
    if (wr == 1) PG8_BAR;
    PG8_WAIT_V(2); PG8_BAR;
    PG8_STAGE(PG8_SB(1, 0), cB + kstep, voffB[0], voffB[1]); PG8_STAGE(PG8_SA(1, 0), cA + kstep, vA[0][0], vA[0][1]); PG8_STAGE(PG8_SB(1, 1), cB + hstep + kstep, voffB[0], voffB[1]);
    PG8_WAIT_V(6); PG8_BAR;
    for (;;) {
        const bool has_next = S.next(ui + 1, nxt);
        const int esn = es3 == 2 ? 0 : es3 + 1;
        if constexpr (Epi::STAGED) { if (has_next) E.stage(lds + EPI_OFF + esn * 2048, nxt, wid, lane); }
        const char* nA = GATHER ? cA : (has_next ? nxt.A : cA); const char* nB = has_next ? nxt.B : cB;
        unsigned tok_[2][2] = {{0u, 0u}, {0u, 0u}};
#define PG8_KBODY(a1, a2, b2, a3, b3, W00, W01, W10, W11) do { \
              \
            PG8_LDB(B0, 0, 0); PG8_LDB(B1, 0, 1); PG8_SCHED; PG8_LDA(At, 0, 0); PG8_STAGE(PG8_SA(1, 1), a1, vA[1][0], vA[1][1]); \
            PG8_WAIT_V(8); PG8_WAIT_L(0); PG8_BAR; PG8_MMA(0, 0, At, B0); PG8_MMA(0, 1, At, B1); PG8_BAR; PG8_SCHED; \
              \
            PG8_LDA(At, 0, 1); PG8_STAGE(PG8_SB(0, 0), b2, voffB[0], voffB[1]); PG8_STAGE(PG8_SB(0, 1), (b2) + hstep, voffB[0], voffB[1]); PG8_STAGE(PG8_SA(0, 0), a2, W00, W01); \
            PG8_WAIT_V(8); PG8_WAIT_L(0); PG8_BAR; PG8_MMA(1, 0, At, B0); PG8_MMA(1, 1, At, B1); PG8_BAR; PG8_SCHED; \
              \
            PG8_LDB(B0, 1, 0); PG8_LDB(B1, 1, 1); PG8_SCHED; PG8_LDA(At, 1, 0); PG8_STAGE(PG8_SA(0, 1), a2, W10, W11); \
            PG8_WAIT_V(8); PG8_WAIT_L(0); PG8_BAR; PG8_MMA(0, 0, At, B0); PG8_MMA(0, 1, At, B1); PG8_BAR; PG8_SCHED; \
              \
            PG8_LDA(At, 1, 1); PG8_STAGE(PG8_SB(1, 0), b3, voffB[0], voffB[1]); PG8_STAGE(PG8_SB(1, 1), (b3) + hstep, voffB[0], voffB[1]); PG8_STAGE(PG8_SA(1, 0), a3, W00, W01); \
            PG8_WAIT_V(8); PG8_WAIT_L(0); PG8_BAR; PG8_MMA(1, 0, At, B0); PG8_MMA(1, 1, At, B1); PG8_BAR; PG8_SCHED; } while (0)
        for (int t = 0; t < nt - 2; t += 2) {
            const char* a1 = cA + (size_t)(t + 1) * kstep;
            const char* a2 = cA + (size_t)(t + 2) * kstep; const char* b2 = cB + (size_t)(t + 2) * kstep;
            const char* a3 = a2 + kstep; const char* b3 = b2 + kstep;
            if (GATHER) { if (t == nt - 4 && has_next) { int t2_ = tid; asm volatile("" : "+v"(t2_));
#pragma unroll
                for (int i = 0; i < 2; ++i) { int R, C; stage_rc(t2_ * 16 + i * 8192, R, C);
#pragma unroll
                    for (int h = 0; h < 2; ++h) { const unsigned vo = S.tokoff(nxt, h * HALF + R); asm volatile("global_load_dword %0, %1, %2" : "=v"(tok_[h][i]) : "v"(vo), "s"(S.tokbase()) : "memory"); } } } }
            PG8_KBODY(a1, a2, b2, a3, b3, vA[0][0], vA[0][1], vA[1][0], vA[1][1]);
        }
        if (GATHER) {
            if (has_next) { int t2_ = tid; asm volatile("" : "+v"(t2_), "+v"(tok_[0][0]), "+v"(tok_[0][1]), "+v"(tok_[1][0]), "+v"(tok_[1][1]));
#pragma unroll
                for (int i = 0; i < 2; ++i) { int R, C; stage_rc(t2_ * 16 + i * 8192, R, C);
#pragma unroll
                    for (int h = 0; h < 2; ++h) vN[h][i] = tok_[h][i] * (unsigned)(K * 2) + (unsigned)C * 2u; } }
            else {
#pragma unroll
                for (int h = 0; h < 2; ++h)
#pragma unroll
                    for (int i = 0; i < 2; ++i) vN[h][i] = vA[h][i];
            }
        }
        {
            const char* a1 = cA + (size_t)(nt - 1) * kstep;
            const char* a3 = nA + kstep; const char* b3 = nB + kstep;
            PG8_KBODY(a1, nA, nB, a3, b3, vN[0][0], vN[0][1], vN[1][0], vN[1][1]);
        }
#undef PG8_KBODY
        if constexpr (ALIGN_EPI) { if (wr == 0) PG8_BAR; }
        { int t3_ = tid; asm volatile("" : "+v"(t3_)); const int l3_ = t3_ & 63;
          if constexpr (Epi::STAGED) E(acc, cur, wr, wc, l3_ & 15, l3_ >> 4, lds + EPI_OFF + es3 * 2048); else E(acc, cur, wr, wc, l3_ & 15, l3_ >> 4); }
        if (!has_next) break;
#pragma unroll
        for (int a = 0; a < 2; ++a)
#pragma unroll
            for (int b = 0; b < 2; ++b)
#pragma unroll
                for (int m = 0; m < 4; ++m)
#pragma unroll
                    for (int n = 0; n < 2; ++n) acc[a][b][m][n] = (f32x4){0.f, 0.f, 0.f, 0.f};
        cur = nxt; cA = nA; cB = nB; ++ui; es3 = esn;
        if (GATHER) {
#pragma unroll
            for (int h = 0; h < 2; ++h)
#pragma unroll
                for (int i = 0; i < 2; ++i) vA[h][i] = vN[h][i];
        }
        if constexpr (ALIGN_EPI) { if (wr == 1) PG8_BAR; }
    }
    PG8_WAIT_V(0);
    if constexpr (!ALIGN_EPI) { if (wr == 0) PG8_BAR; }
    PG8_BAR;
#undef PG8_AOFFS
#undef PG8_SA
#undef PG8_SB
#undef PG8_STAGE
#undef PG8_LDA
#undef PG8_LDB
#undef PG8_MMA
#undef PG8_WAIT_V
#undef PG8_WAIT_L
#undef PG8_BAR
#undef PG8_SCHED
}


constexpr int TS_OFF = 131072 + 1024;
template <bool GATHER> struct MoeOrder {
    const char* A; const char* Bt; const int* rowtok; int nN, nwg, nM, G, c, K, pm0, i0, Loff; size_t strideE;
    __device__ __forceinline__ void init(const bf16_t* A_, const bf16_t* Bt_, const int* rowtok_, int N, int K_, size_t strideE_, int G_, int c_, int pm0_, int nM_, int Loff_) {
        A = (const char*)A_; Bt = (const char*)Bt_; rowtok = rowtok_; nN = N / BM; K = K_; strideE = strideE_; G = G_; c = c_;
        pm0 = pm0_; nM = nM_; nwg = nM * nN; Loff = Loff_; i0 = Loff_ > c_ ? (Loff_ - c_ + G_ - 1) / G_ : 0; }
    __device__ __forceinline__ bool next(int i, GUnit& u) const {
        const long L = (long)(i + i0) * G + c - Loff; if (L >= nwg) return false;
        int wgid = (int)L; { const int q = nwg / NXCD, r = nwg % NXCD, xcd = wgid % NXCD, off = wgid / NXCD; wgid = (xcd < r ? xcd * (q + 1) : r * (q + 1) + (xcd - r) * q) + off; }
        const int nig = WGM_MOE * nN, gid = wgid / nig, fm = gid * WGM_MOE, gsz = (nM - fm) < WGM_MOE ? (nM - fm) : WGM_MOE;
        u.pm = pm0 + fm + ((wgid % nig) % gsz); u.pn = (wgid % nig) / gsz;
        LAS const int* ts = (LAS const int*)(LDSP + TS_OFF);
        const int e = __builtin_amdgcn_readfirstlane(ts[72 + u.pm]);
        u.e = e; u.row0 = (u.pm - __builtin_amdgcn_readfirstlane(ts[e])) * BM; u.cnt = __builtin_amdgcn_readfirstlane(ts[33 + e]);
        u.A = GATHER ? A : A + (size_t)u.pm * BM * K * 2;
        u.B = Bt + (size_t)e * strideE + (size_t)u.pn * BM * K * 2; return true;
    }
    __device__ __forceinline__ unsigned aoff(const GUnit& u, int row) const {
        if (GATHER) { int sl = u.row0 + row; sl = sl < u.cnt ? sl : u.cnt - 1; return (unsigned)rowtok[u.e * ECAP + sl] * (unsigned)(K * 2); }
        return (unsigned)(row * K * 2);
    }
    __device__ __forceinline__ unsigned tokoff(const GUnit& u, int row) const { int sl = u.row0 + row; sl = sl < u.cnt ? sl : u.cnt - 1; return (unsigned)(u.e * ECAP + sl) * 4u; }
    __device__ __forceinline__ const int* tokbase() const { return rowtok; }
};
__device__ __forceinline__ void moe_tiles(const unsigned* cnt, int tid) {
    LAS int* ts = (LAS int*)(LDSP + TS_OFF);
    if (tid < 64) {
        const int e = tid & 31, c = (int)cnt[e], n = (c + BM - 1) / BM;
        int incl = n;
#pragma unroll
        for (int d = 1; d < 32; d <<= 1) { const int o = __builtin_amdgcn_ds_bpermute(((tid - d) & 63) << 2, incl); if (e >= d) incl += o; }
        const int s = incl - n;
        if (tid < 32) { ts[e] = s; ts[33 + e] = c; if (e == 31) ts[NEXP] = incl;
_Pragma("clang loop vectorize(disable) unroll(disable)") for (int t = 0; t < n; ++t) ts[72 + s + t] = e; }
    }
    __syncthreads();
}
struct EpiMoe1 {
    static constexpr bool PERM = true; static constexpr bool STAGED = true;
    bf16_t* O; const float* b1; const float* rsc;
    __device__ __forceinline__ void stage(LAS unsigned char* dst, const GUnit& u, int wv_, int lane_) const {
        if (wv_ == 0) glds16s(b1, (unsigned)((u.e * 2048 + (lane_ < 32 ? 0 : 1024) + u.pn * 128 + 4 * (lane_ & 31)) * 4), (unsigned)(size_t)dst);
        else if (wv_ == 1) glds16s(rsc, (unsigned)((u.e * ECAP + u.row0 + 4 * lane_) * 4), (unsigned)(size_t)(dst + 1024));
    }
    __device__ __forceinline__ void operator()(const f32x4 (&acc)[2][2][4][2], const GUnit& u, int wr, int wc, int fr, int fq, const LAS unsigned char* ep) const {
        const int rt0 = wr * 64 + fr, col0 = u.pn * 128 + wc * 32 + 8 * fq;
        f32x4 bgv[2], blv[2];
#pragma unroll
        for (int n = 0; n < 2; ++n) { bgv[n] = *(const LAS f32x4*)(ep + (wc * 32 + 8 * fq + 4 * n) * 4); blv[n] = *(const LAS f32x4*)(ep + 512 + (wc * 32 + 8 * fq + 4 * n) * 4); }
#pragma unroll
        for (int ai = 0; ai < 2; ++ai)
#pragma unroll
            for (int m = 0; m < 4; ++m) {
                const int rt = rt0 + ai * HALF + m * 16;
                const float r = *(const LAS float*)(ep + 1024 + rt * 4);
                float o[8];
                const f32x2 r2 = (f32x2){r, r};
#pragma unroll
                for (int n = 0; n < 2; ++n)
#pragma unroll
                    for (int jp = 0; jp < 2; ++jp) {
                        const f32x2 ag = (f32x2){acc[ai][0][m][n][2 * jp], acc[ai][0][m][n][2 * jp + 1]}, al = (f32x2){acc[ai][1][m][n][2 * jp], acc[ai][1][m][n][2 * jp + 1]};
                        f32x2 g = ag * r2 + (f32x2){bgv[n][2 * jp], bgv[n][2 * jp + 1]}, l = al * r2 + (f32x2){blv[n][2 * jp], blv[n][2 * jp + 1]};
                        g.x = fminf(g.x, 7.f); g.y = fminf(g.y, 7.f);
                        l.x = __builtin_amdgcn_fmed3f(l.x, -7.f, 7.f); l.y = __builtin_amdgcn_fmed3f(l.y, -7.f, 7.f);
                        const f32x2 z = g * (-2.4554669595930157f);
                        f32x2 e; e.x = __builtin_amdgcn_exp2f(z.x); e.y = __builtin_amdgcn_exp2f(z.y);
                        e = e + 1.0f;
                        f32x2 q; q.x = __builtin_amdgcn_rcpf(e.x); q.y = __builtin_amdgcn_rcpf(e.y);
                        const f32x2 v = (g * q) * (l + 1.0f);
                        o[n * 4 + 2 * jp] = v.x; o[n * 4 + 2 * jp + 1] = v.y;
                    }
                u32x4 w; w.x = cvt_pk_bf16(o[0], o[1]); w.y = cvt_pk_bf16(o[2], o[3]); w.z = cvt_pk_bf16(o[4], o[5]); w.w = cvt_pk_bf16(o[6], o[7]);
                *(u32x4*)(O + (size_t)(u.pm * BM + rt) * DFF + col0) = w;
            }
    }
};
struct EpiMoe2 {
    static constexpr bool PERM = true; static constexpr bool STAGED = true;
    bf16_t* O; const float* b2;
    __device__ __forceinline__ void stage(LAS unsigned char* dst, const GUnit& u, int wv_, int lane_) const {
        if (wv_ == 0) glds16s(b2, (unsigned)((u.e * DM + u.pn * BM + 4 * lane_) * 4), (unsigned)(size_t)dst);
    }
    __device__ __forceinline__ void operator()(const f32x4 (&acc)[2][2][4][2], const GUnit& u, int wr, int wc, int fr, int fq, const LAS unsigned char* ep) const {
        const int row0 = u.pm * BM + wr * 64 + fr, col0 = u.pn * BM + wc * 32 + 8 * fq;
        f32x4 bv[2][2];
#pragma unroll
        for (int bj = 0; bj < 2; ++bj)
#pragma unroll
            for (int n = 0; n < 2; ++n) bv[bj][n] = *(const LAS f32x4*)(ep + (wc * 32 + 8 * fq + bj * HALF + 4 * n) * 4);
#pragma unroll
        for (int ai = 0; ai < 2; ++ai)
#pragma unroll
            for (int m = 0; m < 4; ++m) { bf16_t* rowp = O + (size_t)(row0 + ai * HALF + m * 16) * DM + col0;
#pragma unroll
                for (int bj = 0; bj < 2; ++bj) { const f32x4 v0 = acc[ai][bj][m][0] + bv[bj][0], v1 = acc[ai][bj][m][1] + bv[bj][1];
                    u32x4 w; w.x = cvt_pk_bf16(v0[0], v0[1]); w.y = cvt_pk_bf16(v0[2], v0[3]); w.z = cvt_pk_bf16(v1[0], v1[1]); w.w = cvt_pk_bf16(v1[2], v1[3]);
                    *(u32x4*)(rowp + bj * HALF) = w; } }
    }
};

__device__ __forceinline__ void p_transpose_r(const int wv, const float* W, int nmat, int K, int N, bf16_t* WT, const float* kgain, int gdiv, int mode, LAS unsigned char* lds, int it_begin, int it_end, int wrank, int wstride, int scr_pitch = 16384) {
    LTID();
    const int wave = wv, lane = tidx & 63;
    LAS float* scr = (LAS float*)(lds + wave * scr_pitch);
    const int nblk = N / 32, per_mat = (K / 64) * nblk, total = it_end, stride = wstride;
    const int lk = lane >> 3, lc4 = lane & 7;
#define TR_DECODE(item, mat_, kb_, nb_) const int mat_ = (item) / per_mat, r_ = (item) - mat_ * per_mat, g8_ = r_ >> 3, l8_ = r_ & 7, kb_ = 2 * (g8_ / (nblk >> 2)) + (l8_ & 1), nb_ = 4 * (g8_ % (nblk >> 2)) + (l8_ >> 1)
#define TR_ISSUE(item, dst, G0, G1) do { TR_DECODE(item, mat_, kb_, nb_); \
        const float* src_ = W + (size_t)mat_ * K * N + (size_t)(64 * kb_ + lk) * N + 32 * nb_ + 4 * lc4; \
        _Pragma("unroll") for (int i = 0; i < 8; ++i) dst[i] = __builtin_nontemporal_load((const f32x4*)(src_ + (size_t)(8 * i) * N));      \
        if (kgain) { const float* gp_ = kgain + (size_t)(mat_ / gdiv) * DM + 64 * kb_ + 8 * lc4; G0 = *(const f32x4*)gp_; G1 = *(const f32x4*)(gp_ + 4); } } while (0)
#define TR_PROCESS(v, G0, G1, item) do { TR_DECODE(item, mat, kb, nb); const int k0 = 64 * kb, n0 = 32 * nb; \
        _Pragma("unroll") for (int i = 0; i < 8; ++i) \
            _Pragma("unroll") for (int e = 0; e < 4; ++e) scr[(lk + 8 * i) * 33 + 4 * lc4 + e] = v[i][e]; \
        asm volatile("s_waitcnt lgkmcnt(0)" ::: "memory"); \
        int d0 = n0; \
        if (mode == 1) { const int bj = n0 >> 10, rest = n0 & 1023, pn = rest >> 7, j = rest & 127; d0 = pn * 256 + bj * 128 + j; } \
        bf16_t* dst = WT + (size_t)mat * K * N; \
        _Pragma("unroll") for (int j = 0; j < 4; ++j) { const int n = lk + 8 * j; const LAS float* sp = scr + (8 * lc4) * 33 + n; \
            u32x4 o; o.x = cvt_pk_bf16(sp[0 * 33] * G0[0], sp[1 * 33] * G0[1]); o.y = cvt_pk_bf16(sp[2 * 33] * G0[2], sp[3 * 33] * G0[3]); o.z = cvt_pk_bf16(sp[4 * 33] * G1[0], sp[5 * 33] * G1[1]); o.w = cvt_pk_bf16(sp[6 * 33] * G1[2], sp[7 * 33] * G1[3]); \
            __builtin_nontemporal_store(o, (u32x4*)(dst + (size_t)(d0 + n) * K + k0 + 8 * lc4)); } \
        asm volatile("s_waitcnt lgkmcnt(0)" ::: "memory"); } while (0)
    f32x4 va[8], vb[8], vc[8];
    f32x4 ga0 = (f32x4){1.f, 1.f, 1.f, 1.f}, ga1 = ga0, gb0 = ga0, gb1 = ga0, gc0 = ga0, gc1 = ga0;
    int it = it_begin + wrank;
    if (it + 4 * stride < total) {
        TR_ISSUE(it, va, ga0, ga1);
        TR_ISSUE(it + stride, vb, gb0, gb1);
        do {
            TR_ISSUE(it + 2 * stride, vc, gc0, gc1);
            TR_PROCESS(va, ga0, ga1, it);
            TR_ISSUE(it + 3 * stride, va, ga0, ga1);
            TR_PROCESS(vb, gb0, gb1, it + stride);
            TR_ISSUE(it + 4 * stride, vb, gb0, gb1);
            TR_PROCESS(vc, gc0, gc1, it + 2 * stride);
            it += 3 * stride;
        } while (it + 4 * stride < total);
    } else {
        if (it < total) TR_ISSUE(it, va, ga0, ga1);
        if (it + stride < total) TR_ISSUE(it + stride, vb, gb0, gb1);
    }
    if (it + 2 * stride < total) TR_ISSUE(it + 2 * stride, vc, gc0, gc1);
    if (it < total) TR_PROCESS(va, ga0, ga1, it);
    if (it + 3 * stride < total) TR_ISSUE(it + 3 * stride, va, ga0, ga1);
    if (it + stride < total) TR_PROCESS(vb, gb0, gb1, it + stride);
    if (it + 2 * stride < total) TR_PROCESS(vc, gc0, gc1, it + 2 * stride);
    if (it + 3 * stride < total) TR_PROCESS(va, ga0, ga1, it + 3 * stride);
#undef TR_PROCESS
#undef TR_ISSUE
#undef TR_DECODE
}
__device__ __forceinline__ void p_transpose(const int wv, const float* W, int nmat, int K, int N, bf16_t* WT, const float* kgain, int gdiv, int mode, LAS unsigned char* lds, int rot) {
    const int G_ = (int)gridDim.x, b_ = ((int)blockIdx.x + G_ - rot % G_) % G_;
    p_transpose_r(wv, W, nmat, K, N, WT, kgain, gdiv, mode, lds, 0, nmat * (K / 64) * (N / 32), b_ * NW + wv, G_ * NW);
}
typedef short v4i16_t __attribute__((ext_vector_type(4)));
constexpr int ATT_TAB_OFF = 131072 + 2048;
constexpr int ATT_UNITS = 3 * 8 * 128;
__device__ __forceinline__ int t5_bucket_dev(int n) {
    if (n < 16) return n;
    const float v = logf((float)n / 16.f) / 4.852030263919617f * 16.f;
    const int large = 16 + (int)v;
    return large < 31 ? large : 31;
}
__device__ __forceinline__ void p_bias_table(const int wv, const float* rel_bias, float* biasG, int rot) {
    LTID();
    for (int i = ROTB(rot) * NT + tidx; i < 3 * 8 * 132; i += gridDim.x * NT) {
        const int d = i % 132, bh = i / 132, h = bh & 7, b = bh >> 3;
        biasG[i] = (d <= 128) ? rel_bias[t5_bucket_dev(d << (2 * b)) * 8 + h] * 1.4426950408889634f : 0.f;
    }
}
__device__ __forceinline__ void p_dil_attn(const int wv, const bf16_t* proj16, const float* biasG, bf16_t* obr, float* lse, LAS unsigned char* lds) {
    LTID();
    const int lane = tidx & 63, fr = lane & 15, fq = lane >> 4, w = wv;
    const int per = (ATT_UNITS + (int)gridDim.x - 1) / (int)gridDim.x;
    const int u0 = bidx * per, u1 = (u0 + per < ATT_UNITS) ? u0 + per : ATT_UNITS;
    if (u0 >= u1) return;
    const int rowl = tidx >> 3, cs = tidx & 7;
    const unsigned cK = (unsigned)(cs ^ ((rowl >> 1) & 7)) * 16u, cV = (unsigned)(cs ^ (rowl & 7)) * 16u;
    const unsigned fK = (unsigned)((fr >> 1) & 7);
    const unsigned kro0 = (unsigned)fr * 128u + (((unsigned)fq ^ fK) * 16u), kro1 = (unsigned)fr * 128u + ((((unsigned)fq ^ fK) ^ 4u) * 16u);
    const int tq = (lane & 15) >> 2, tp = lane & 3, fv = 4 * (fq & 1) + tq;
    unsigned vro[4];
#pragma unroll
    for (int db = 0; db < 4; ++db) vro[db] = (unsigned)(4 * fq + tq) * 128u + (unsigned)(((2 * db + (tp >> 1)) ^ fv) * 16) + 8u * (unsigned)(tp & 1);
    const int ts_ = (1 + fr) & 3;
    const unsigned tab8 = (unsigned)ATT_TAB_OFF + (unsigned)ts_ * 640u + (unsigned)(((141 + fr - ts_) >> 2) - fq - 32) * 16u;
    const char* gbase = (const char*)proj16;
#define ATT_DECODE(u, b_, h_, r_, n_, dil_) const int cmb_ = (u) >> 7, b_ = cmb_ >> 3, h_ = cmb_ & 7, dil_ = 1 << (2 * b_), idx_ = (u) & 127, nbl_ = 7 - 2 * b_, n_ = idx_ & ((1 << nbl_) - 1), r_ = idx_ >> nbl_
#define ATT_ISSUE_BLK(u, PREV, slot) do { ATT_DECODE(u, b__, h__, r__, n__, dil__); const int nb_ = (PREV) ? (n__ > 0 ? n__ - 1 : n__) : n__; \
        _Pragma("unroll") for (int p = 0; p < 2; ++p) { const int row = 64 * p + rowl; \
            const unsigned pos = (unsigned)(r__ + dil__ * (128 * nb_ + row)); \
            const unsigned so = pos * 4096u + (unsigned)h__ * 128u; const unsigned ld_ = (unsigned)(size_t)(lds + (slot) * 32768 + p * 8192 + w * 1024); \
            glds16s(gbase, so + 1024u + cK, ld_); glds16s(gbase, so + 2048u + cV, ld_ + 16384u); } } while (0)
#define ATT_ISSUE_Q(u, q0, q1) do { ATT_DECODE(u, b__, h__, r__, n__, dil__); \
        const unsigned qpos = (unsigned)(r__ + dil__ * (128 * n__ + 16 * w + fr)); \
        const char* qsrc = gbase + (size_t)qpos * 4096u + (unsigned)h__ * 128u + (unsigned)fq * 16u; \
        asm volatile("global_load_dwordx4 %0, %2, off\n\tglobal_load_dwordx4 %1, %2, off offset:64" : "=&v"(q0), "=&v"(q1) : "v"(qsrc) : "memory"); } while (0)
    bf16x8 qf0, qf1, qn0, qn1;
    const int ucnt = u1 - u0;
    ATT_ISSUE_BLK(u0, true, 3); ATT_ISSUE_BLK(u0, false, 0); ATT_ISSUE_Q(u0, qn0, qn1);
    if (ucnt > 1) ATT_ISSUE_BLK(u0 + 1, false, 1);
    int prev_cmb = -1;
    for (int uk = 0; uk < ucnt; ++uk) {
        const int u = u0 + uk;
        if (uk == 0) { if (ucnt > 1) asm volatile("s_waitcnt vmcnt(4)" ::: "memory"); else asm volatile("s_waitcnt vmcnt(0)" ::: "memory"); }
        else if (uk + 1 < ucnt) asm volatile("s_waitcnt vmcnt(9)" ::: "memory"); else asm volatile("s_waitcnt vmcnt(5)" ::: "memory");
        __builtin_amdgcn_s_barrier();
#define ATT_QCOPY(dst, src) do { const u32x4 s_ = __builtin_bit_cast(u32x4, src); u32x4 d_; \
            asm volatile("v_mov_b32 %0, %4\n\tv_mov_b32 %1, %5\n\tv_mov_b32 %2, %6\n\tv_mov_b32 %3, %7" : "=&v"(d_.x), "=&v"(d_.y), "=&v"(d_.z), "=&v"(d_.w) : "v"(s_.x), "v"(s_.y), "v"(s_.z), "v"(s_.w)); \
            dst = __builtin_bit_cast(bf16x8, d_); } while (0)
        ATT_QCOPY(qf0, qn0); ATT_QCOPY(qf1, qn1);
#undef ATT_QCOPY
        if (uk + 1 < ucnt) ATT_ISSUE_Q(u + 1, qn0, qn1);
        if (uk + 2 < ucnt) ATT_ISSUE_BLK(u + 2, false, (uk + 2) & 3);
        ATT_DECODE(u, b, h, r, n, dil);
        if (cmb_ != prev_cmb) {
            prev_cmb = cmb_;
            for (int e = tidx; e < 4 * 160; e += NT) { const int sft = e / 160, k = e - sft * 160, idx = k + sft, dist = idx - 16;
                const float v = (dist >= 0 && dist <= 128) ? biasG[cmb_ * 132 + dist] : -1e30f;
                ((LAS float*)(lds + ATT_TAB_OFF))[sft * 160 + k] = v; }
            __syncthreads();
        }
        const unsigned oP = (unsigned)((uk + 3) & 3) * 32768u, oC = (unsigned)(uk & 3) * 32768u;
        const int kb0 = w;
#define ATT_KOFF(j) (((j) < 8) ? oP + (unsigned)(j) * 2048u : oC + (unsigned)((j) - 8) * 2048u)
        f32x4 sc[9];
        bf16x8 kf[9][2]; f32x4 tb[9];
#define ATT_LDK(i) do { const unsigned ko_ = ATT_KOFF(kb0 + (i)); kf[i][0] = *(const LAS bf16x8*)(lds + ko_ + kro0); kf[i][1] = *(const LAS bf16x8*)(lds + ko_ + kro1); \
            tb[i] = *(const LAS f32x4*)(lds + tab8 + 64 * (8 - (i))); } while (0)
        ATT_LDK(0); ATT_LDK(1); ATT_LDK(2);
        __builtin_amdgcn_sched_barrier(0);
#pragma unroll
        for (int i = 0; i < 9; ++i) {
            if (i + 3 < 9) { ATT_LDK(i + 3); __builtin_amdgcn_sched_barrier(0); }
            f32x4 a = (f32x4){0.f, 0.f, 0.f, 0.f};
            a = __builtin_amdgcn_mfma_f32_16x16x32_bf16(kf[i][0], qf0, a, 0, 0, 0);
            a = __builtin_amdgcn_mfma_f32_16x16x32_bf16(kf[i][1], qf1, a, 0, 0, 0);
            const f32x4 t = tb[i];
            a = a + (f32x4){t[3], t[2], t[1], t[0]};
            if (n == 0 && kb0 + i < 8) a = (f32x4){-1e30f, -1e30f, -1e30f, -1e30f};
            sc[i] = a;
        }
#undef ATT_LDK
        v4i16_t xv[2][4][2];
#define ATT_LDV(c, bfr) do { const int ia_ = 2 * (c), ib_ = ((c) < 4) ? 2 * (c) + 1 : 8; const unsigned va_ = ATT_KOFF(kb0 + ia_) + 16384u, vb_ = ATT_KOFF(kb0 + ib_) + 16384u; \
            _Pragma("unroll") for (int db = 0; db < 4; ++db) { xv[bfr][db][0] = __builtin_amdgcn_ds_read_tr16_b64_v4i16((LAS v4i16_t*)(lds + va_ + vro[db])); \
                xv[bfr][db][1] = __builtin_amdgcn_ds_read_tr16_b64_v4i16((LAS v4i16_t*)(lds + vb_ + vro[db])); } } while (0)
        ATT_LDV(0, 0);
        __builtin_amdgcn_sched_barrier(0);
#pragma unroll
        for (int i = 0; i < 9; ++i)
#pragma unroll
            for (int j = 0; j < 4; ++j) sc[i][j] = __builtin_amdgcn_exp2f(fminf(sc[i][j], 100.f));
        f32x4 oacc[4]; f32x4 sacc = (f32x4){0.f, 0.f, 0.f, 0.f};
        const bf16x8 ones = (bf16x8){0x3F80, 0x3F80, 0x3F80, 0x3F80, 0x3F80, 0x3F80, 0x3F80, 0x3F80};
#pragma unroll
        for (int db = 0; db < 4; ++db) oacc[db] = (f32x4){0.f, 0.f, 0.f, 0.f};
#pragma unroll
        for (int c = 0; c < 5; ++c) {
            const int ia = 2 * c, ib = (c < 4) ? 2 * c + 1 : 8;
            if (c < 4) { ATT_LDV(c + 1, (c + 1) & 1); __builtin_amdgcn_sched_barrier(0); }
            u32x4 pw; pw.x = cvt_pk_bf16(sc[ia][0], sc[ia][1]); pw.y = cvt_pk_bf16(sc[ia][2], sc[ia][3]);
            if (c < 4) { pw.z = cvt_pk_bf16(sc[ib][0], sc[ib][1]); pw.w = cvt_pk_bf16(sc[ib][2], sc[ib][3]); } else { pw.z = 0u; pw.w = 0u; }
            const bf16x8 pf = __builtin_bit_cast(bf16x8, pw);
            sacc = __builtin_amdgcn_mfma_f32_16x16x32_bf16(ones, pf, sacc, 0, 0, 0);
#pragma unroll
            for (int db = 0; db < 4; ++db) {
                const v4i16_t x0 = xv[c & 1][db][0], x1 = xv[c & 1][db][1];
                const bf16x8 vf = (bf16x8){x0[0], x0[1], x0[2], x0[3], x1[0], x1[1], x1[2], x1[3]};
                oacc[db] = __builtin_amdgcn_mfma_f32_16x16x32_bf16(vf, pf, oacc[db], 0, 0, 0);
            }
        }
#undef ATT_LDV
        const float sum = sacc[0];
        const float inv = 1.f / sum;
        const unsigned qpos = (unsigned)(r + dil * (128 * n + 16 * w + fr));
        bf16_t* orow = obr + ((size_t)b * SEQ + qpos) * 512 + h * 64 + 4 * fq;
#pragma unroll
        for (int db = 0; db < 4; ++db) { u32x2 o2; o2.x = cvt_pk_bf16(oacc[db][0] * inv, oacc[db][1] * inv); o2.y = cvt_pk_bf16(oacc[db][2] * inv, oacc[db][3] * inv); *(u32x2*)(orow + 16 * db) = o2; }
        if (fq == 0) lse[((size_t)b * SEQ + qpos) * 8 + h] = sum;
    }
    asm volatile("s_waitcnt vmcnt(0)" ::: "memory");
    __syncthreads();
#undef ATT_DECODE
#undef ATT_ISSUE_BLK
#undef ATT_ISSUE_Q
#undef ATT_KOFF
}
__device__ __forceinline__ void p_attn_combine(const int wv, const bf16_t* obr, const float* lse, const float* g, bf16_t* mix16) {
    LTID();
    const int lane = tidx & 63, h = lane >> 3;
    const f32x4 g0 = *(const f32x4*)(g + lane * 8), g1 = *(const f32x4*)(g + lane * 8 + 4);
    const int rstride = (int)gridDim.x * NW;
    for (int row0 = bidx * NW + wv; row0 < SEQ; row0 += 4 * rstride) {
        float lv[4][3]; u32x4 av[4][3];
#pragma unroll
        for (int r = 0; r < 4; ++r) { const int row = (row0 + r * rstride < SEQ) ? row0 + r * rstride : row0;
#pragma unroll
            for (int b = 0; b < 3; ++b) { lv[r][b] = lse[((size_t)b * SEQ + row) * 8 + h]; av[r][b] = *(const u32x4*)(obr + ((size_t)b * SEQ + row) * 512 + lane * 8); } }
#pragma unroll
        for (int r = 0; r < 4; ++r) {
            const int row = row0 + r * rstride;
            float w0 = lv[r][0], w1 = lv[r][1], w2 = lv[r][2];
            const float iw = 1.f / (w0 + w1 + w2); w0 *= iw; w1 *= iw; w2 *= iw;
            float y[8]; float ss = 0.f;
#pragma unroll
            for (int k = 0; k < 4; ++k) {
                const float lo = w0 * __builtin_bit_cast(float, av[r][0][k] << 16) + w1 * __builtin_bit_cast(float, av[r][1][k] << 16) + w2 * __builtin_bit_cast(float, av[r][2][k] << 16);
                const float hi = w0 * __builtin_bit_cast(float, av[r][0][k] & 0xffff0000u) + w1 * __builtin_bit_cast(float, av[r][1][k] & 0xffff0000u) + w2 * __builtin_bit_cast(float, av[r][2][k] & 0xffff0000u);
                y[2 * k] = lo; y[2 * k + 1] = hi; ss += lo * lo + hi * hi;
            }
#pragma unroll
            for (int o = 32; o; o >>= 1) ss += shx(ss, o, lane);
            const float sc = rsqrtf(ss * (1.f / 512.f) + 1e-5f);
            u32x4 o4; o4.x = cvt_pk_bf16(y[0] * sc * g0[0], y[1] * sc * g0[1]); o4.y = cvt_pk_bf16(y[2] * sc * g0[2], y[3] * sc * g0[3]);
            o4.z = cvt_pk_bf16(y[4] * sc * g1[0], y[5] * sc * g1[1]); o4.w = cvt_pk_bf16(y[6] * sc * g1[2], y[7] * sc * g1[3]);
            if (row < SEQ) *(u32x4*)(mix16 + (size_t)row * DM + lane * 8) = o4;
        }
    }
}
struct EpiIn {
    static constexpr bool PERM = true; static constexpr bool STAGED = false;
    bf16_t* O; const float* rs;
    __device__ __forceinline__ void operator()(const f32x4 (&acc)[2][2][4][2], const GUnit& u, int wr, int wc, int fr, int fq) const {
        const int row0 = u.pm * BM + wr * 64 + fr, col0 = u.pn * BM + wc * 32 + 8 * fq;
        const float sc0 = u.pn < 2 ? 0.18033688011112042f : 1.f;
#pragma unroll
        for (int ai = 0; ai < 2; ++ai)
#pragma unroll
            for (int m = 0; m < 4; ++m) { const int row = row0 + ai * HALF + m * 16; const size_t ro = (size_t)row * DIN + col0; const float sc = sc0 * rs[row];
#pragma unroll
                for (int bj = 0; bj < 2; ++bj) { const f32x4 v0 = acc[ai][bj][m][0] * sc, v1 = acc[ai][bj][m][1] * sc;
                    u32x4 w; w.x = cvt_pk_bf16(v0[0], v0[1]); w.y = cvt_pk_bf16(v0[2], v0[3]); w.z = cvt_pk_bf16(v1[0], v1[1]); w.w = cvt_pk_bf16(v1[2], v1[3]);
                    *(u32x4*)(O + ro + bj * HALF) = w;
                    } }
    }
};


__device__ __forceinline__ unsigned xoff_b(unsigned row, unsigned ch) { return 256u * row + 16u * (ch ^ (((row & 3u) << 2) | ((row >> 2) & 3u))); }
__device__ __forceinline__ void p_xattn_mfma(const int wv, const bf16_t* qx16, const bf16_t* kv16, bf16_t* ox16, LAS unsigned char* lds) {
    LTID();
    const int lane = tidx & 63, fr = lane & 15, fq = lane >> 4, w = wv;
    const int NU = 4 * 128;
    const int per = (NU + (int)gridDim.x - 1) / (int)gridDim.x;
    const int u0 = bidx * per, u1 = (u0 + per < NU) ? u0 + per : NU;
    if (u0 >= u1) return;
    const int rowl = tidx >> 4, cs = tidx & 15;
    const unsigned csw = (unsigned)(cs ^ (((rowl & 3) << 2) | ((rowl >> 2) & 3))) * 16u;
    const unsigned kswz = (unsigned)(((fr & 3) << 2) | ((fr >> 2) & 3));
    unsigned kro[4];
#pragma unroll
    for (int s4 = 0; s4 < 4; ++s4) kro[s4] = 256u * (unsigned)fr + 16u * ((unsigned)(4 * s4 + fq) ^ kswz);
    const int tq = (lane & 15) >> 2, tp = lane & 3;
    const unsigned vswz = (unsigned)((tq << 2) | fq);
    unsigned vro[8];
#pragma unroll
    for (int c = 0; c < 8; ++c) vro[c] = 65536u + 256u * (unsigned)(4 * fq + tq) + 16u * ((unsigned)(2 * c + (tp >> 1)) ^ vswz) + 8u * (unsigned)(tp & 1);
    int prev_h = -1;
    for (int u = u0; u < u1; ++u) {
        const int h = u >> 7, qt = u & 127;
        if (h != prev_h) {
            __syncthreads();
            prev_h = h;
#pragma unroll
            for (int p = 0; p < 8; ++p) {
                const unsigned row = (unsigned)(32 * p + rowl);
                const unsigned so = row * 2048u + (unsigned)h * 256u + csw;
                const unsigned ld_ = (unsigned)(size_t)(lds + p * 8192 + w * 1024);
                glds16s(kv16, so, ld_); glds16s(kv16, so + 1024u, ld_ + 65536u);
            }
            asm volatile("s_waitcnt vmcnt(0)" ::: "memory");
            __syncthreads();
        }
        const char* qsrc = (const char*)qx16 + ((size_t)(qt * 128 + 16 * w + fr) * 512 + h * 128 + 8 * fq) * 2;
        bf16x8 qf[4];
#pragma unroll
        for (int s4 = 0; s4 < 4; ++s4) qf[s4] = *(const bf16x8*)(qsrc + 64 * s4);
        f32x4 sc[16];
#pragma unroll
        for (int i = 0; i < 16; ++i) {
            f32x4 a = (f32x4){0.f, 0.f, 0.f, 0.f};
#pragma unroll
            for (int s4 = 0; s4 < 4; ++s4) { const bf16x8 kf = *(const LAS bf16x8*)(lds + i * 4096 + kro[s4]); a = __builtin_amdgcn_mfma_f32_16x16x32_bf16(kf, qf[s4], a, 0, 0, 0); }
            sc[i] = a;
        }
        float mx = -1e30f;
#pragma unroll
        for (int i = 0; i < 16; ++i) mx = fmaxf(mx, fmaxf(fmaxf(sc[i][0], sc[i][1]), fmaxf(sc[i][2], sc[i][3])));
        mx = fmaxf(mx, shx(mx, 16, lane)); mx = fmaxf(mx, shx(mx, 32, lane));
        float sum = 0.f;
#pragma unroll
        for (int i = 0; i < 16; ++i)
#pragma unroll
            for (int j = 0; j < 4; ++j) { const float p = __expf(sc[i][j] - mx); sc[i][j] = p; sum += p; }
        sum += shx(sum, 16, lane); sum += shx(sum, 32, lane);
        f32x4 oacc[8];
#pragma unroll
        for (int c = 0; c < 8; ++c) oacc[c] = (f32x4){0.f, 0.f, 0.f, 0.f};
#pragma unroll
        for (int ch = 0; ch < 8; ++ch) {
            const int ia = 2 * ch, ib = 2 * ch + 1;
            u32x4 pw; pw.x = cvt_pk_bf16(sc[ia][0], sc[ia][1]); pw.y = cvt_pk_bf16(sc[ia][2], sc[ia][3]); pw.z = cvt_pk_bf16(sc[ib][0], sc[ib][1]); pw.w = cvt_pk_bf16(sc[ib][2], sc[ib][3]);
            const bf16x8 pf = __builtin_bit_cast(bf16x8, pw);
#pragma unroll
            for (int c = 0; c < 8; ++c) {
                const v4i16_t x0 = __builtin_amdgcn_ds_read_tr16_b64_v4i16((LAS v4i16_t*)(lds + ia * 4096 + vro[c]));
                const v4i16_t x1 = __builtin_amdgcn_ds_read_tr16_b64_v4i16((LAS v4i16_t*)(lds + ib * 4096 + vro[c]));
                const bf16x8 vf = (bf16x8){x0[0], x0[1], x0[2], x0[3], x1[0], x1[1], x1[2], x1[3]};
                oacc[c] = __builtin_amdgcn_mfma_f32_16x16x32_bf16(vf, pf, oacc[c], 0, 0, 0);
            }
        }
        const float inv = 1.f / sum;
        bf16_t* orow = ox16 + (size_t)(qt * 128 + 16 * w + fr) * 512 + h * 128 + 4 * fq;
#pragma unroll
        for (int c = 0; c < 8; ++c) { u32x2 o2; o2.x = cvt_pk_bf16(oacc[c][0] * inv, oacc[c][1] * inv); o2.y = cvt_pk_bf16(oacc[c][2] * inv, oacc[c][3] * inv); *(u32x2*)(orow + 16 * c) = o2; }
    }
    __syncthreads();
}
struct EpiBf16 {
    static constexpr bool PERM = true; static constexpr bool STAGED = false;
    bf16_t* O; int ldc; float scale; const float* ss;
    __device__ __forceinline__ void operator()(const f32x4 (&acc)[2][2][4][2], const GUnit& u, int wr, int wc, int fr, int fq) const {
        const int row0 = u.pm * BM + wr * 64 + fr, col0 = u.pn * BM + wc * 32 + 8 * fq;
#pragma unroll
        for (int ai = 0; ai < 2; ++ai)
#pragma unroll
            for (int m = 0; m < 4; ++m) { const int row = row0 + ai * HALF + m * 16; bf16_t* rowp = O + (size_t)row * ldc + col0;
                float sc = scale;
                if (ss) { const f32x4 p0 = *(const f32x4*)(ss + (size_t)row * 16), p1 = *(const f32x4*)(ss + (size_t)row * 16 + 4), p2 = *(const f32x4*)(ss + (size_t)row * 16 + 8), p3 = *(const f32x4*)(ss + (size_t)row * 16 + 12);
                    const float t = ((p0[0] + p0[1]) + (p0[2] + p0[3])) + ((p1[0] + p1[1]) + (p1[2] + p1[3])) + ((p2[0] + p2[1]) + (p2[2] + p2[3])) + ((p3[0] + p3[1]) + (p3[2] + p3[3]));
                    sc = scale * rsqrtf(t * (1.f / 1024.f) + 1e-5f); }
#pragma unroll
                for (int bj = 0; bj < 2; ++bj) { const f32x4 v0 = acc[ai][bj][m][0] * sc, v1 = acc[ai][bj][m][1] * sc;
                    u32x4 w; w.x = cvt_pk_bf16(v0[0], v0[1]); w.y = cvt_pk_bf16(v0[2], v0[3]); w.z = cvt_pk_bf16(v1[0], v1[1]); w.w = cvt_pk_bf16(v1[2], v1[3]);
                    *(u32x4*)(rowp + bj * HALF) = w; } }
    }
};
__device__ __forceinline__ float bflo(unsigned u) { return __builtin_bit_cast(float, u << 16); }
__device__ __forceinline__ float bfhi(unsigned u) { return __builtin_bit_cast(float, u & 0xffff0000u); }
template <bool R32, bool SS> struct EpiRes16 {
    static constexpr bool PERM = true; static constexpr bool STAGED = false;
    const void* R; bf16_t* H; float* ss;
    __device__ __forceinline__ void operator()(const f32x4 (&acc)[2][2][4][2], const GUnit& u, int wr, int wc, int fr, int fq) const {
        const int row0 = u.pm * BM + wr * 64 + fr, col0 = u.pn * BM + wc * 32 + 8 * fq, lane = fq * 16 + fr;
#pragma unroll
        for (int ai = 0; ai < 2; ++ai)
#pragma unroll
            for (int m = 0; m < 4; ++m) { const int row = row0 + ai * HALF + m * 16; const size_t ro = (size_t)row * DM + col0; float sq = 0.f;
#pragma unroll
                for (int bj = 0; bj < 2; ++bj) {
                    f32x4 r0, r1;
                    if (R32) { r0 = *(const f32x4*)((const float*)R + ro + bj * HALF); r1 = *(const f32x4*)((const float*)R + ro + bj * HALF + 4); }
                    else { const u32x4 rw = *(const u32x4*)((const bf16_t*)R + ro + bj * HALF); r0 = (f32x4){bflo(rw.x), bfhi(rw.x), bflo(rw.y), bfhi(rw.y)}; r1 = (f32x4){bflo(rw.z), bfhi(rw.z), bflo(rw.w), bfhi(rw.w)}; }
                    const f32x4 v0 = acc[ai][bj][m][0] + r0, v1 = acc[ai][bj][m][1] + r1;
                    u32x4 w; w.x = cvt_pk_bf16(v0[0], v0[1]); w.y = cvt_pk_bf16(v0[2], v0[3]); w.z = cvt_pk_bf16(v1[0], v1[1]); w.w = cvt_pk_bf16(v1[2], v1[3]);
                    *(u32x4*)(H + ro + bj * HALF) = w;
                    if (SS) sq += (v0[0] * v0[0] + v0[1] * v0[1]) + (v0[2] * v0[2] + v0[3] * v0[3]) + (v1[0] * v1[0] + v1[1] * v1[1]) + (v1[2] * v1[2] + v1[3] * v1[3]);
                }
                if (SS) { sq += shx(sq, 16, lane); sq += shx(sq, 32, lane);
                    if (fq == 0) ss[(size_t)row * 16 + u.pn * 4 + wc] = sq; }
            }
    }
};

typedef short bf16x4 __attribute__((ext_vector_type(4)));
constexpr int S5_CHUNK = 256, S5_NCH = SEQ / S5_CHUNK, S5_ROWB = 528;
__device__ __forceinline__ f32x2 gelu_pk(f32x2 v) {
    const f32x2 av = __builtin_elementwise_abs(v), d = av * 0.2316418882f + 1.0f;
    f32x2 t; t.x = __builtin_amdgcn_rcpf(d.x); t.y = __builtin_amdgcn_rcpf(d.y);
    f32x2 q = t * 0.5307027145f + (-0.7265760135f); q = q * t + 0.7107068705f; q = q * t + (-0.142248368f); q = q * t + 0.127414796f; q = q * t;
    const f32x2 s2 = (v * v) * (-0.72134752044f);
    f32x2 e; e.x = __builtin_amdgcn_exp2f(s2.x); e.y = __builtin_amdgcn_exp2f(s2.y);
    const f32x2 m = v * (q * e), r = v - m;
    f32x2 o; o.x = v.x < 0.f ? m.x : r.x; o.y = v.y < 0.f ? m.y : r.y; return o;
}
__device__ __forceinline__ void p_s5_tables2(const int wv, const float* a_re, const float* a_im, const float* b_re, const float* b_im, const float* c_re, const float* c_im, const float* log_dt,
                                             float2* abar, float2* a256, bf16_t* BB16, bf16_t* CM16, int rot) {
    LTID();
    for (int i = ROTB(rot) * NT + tidx; i < 2048 * 16; i += gridDim.x * NT) {
        const int gp = i >> 4, c = i & 15, g = gp >> 6, p = gp & 63;
        const float lr = a_re[gp], li = a_im[gp], dt = expf(log_dt[g]);
        const float mag = expf(lr * dt); float sn, cs; sincosf(li * dt, &sn, &cs);
        const float ar = mag * cs, ai = mag * sn;
        if (c == 0) {
            abar[gp] = make_float2(ar, ai);
            float pr = ar, pi = ai;
            for (int k = 0; k < 8; ++k) { const float nr = pr * pr - pi * pi, ni = 2.f * pr * pi; pr = nr; pi = ni; }
            a256[gp] = make_float2(pr, pi);
        }
        const float nr = ar - 1.f, ni = ai, den = lr * lr + li * li;
        const float cr = (nr * lr + ni * li) / den, ci = (ni * lr - nr * li) / den;
        const float br = b_re[gp * 16 + c], bi = b_im[gp * 16 + c];
        BB16[((size_t)g * 128 + p) * 16 + c] = (bf16_t)f2bf(cr * br - ci * bi);
        BB16[((size_t)g * 128 + 64 + p) * 16 + c] = (bf16_t)f2bf(cr * bi + ci * br);
        CM16[((size_t)g * 16 + c) * 128 + p] = (bf16_t)f2bf(c_re[(g * 16 + c) * 64 + p]);
        CM16[((size_t)g * 16 + c) * 128 + 64 + p] = (bf16_t)f2bf(-c_im[(g * 16 + c) * 64 + p]);
    }
}
struct ConvCtx { const float* W1; const float* W2; bf16_t* T1; bf16_t* T2; const float* kg; bf16_t* dump; int begin, end, wr, stride; };
constexpr int CV_NIT1 = 32768;
#define CV_DECODE(item) const bool w1_ = (item) < CV_NIT1; const int it_ = w1_ ? (item) : (item) - CV_NIT1; const int N_ = w1_ ? 2048 : 1024, nq_ = N_ >> 7, per_mat_ = N_ >> 1; \
        const int mat_ = it_ / per_mat_, r_ = it_ - mat_ * per_mat_, g8_ = r_ >> 3, l8_ = r_ & 7, kb_ = 2 * (g8_ / nq_) + (l8_ & 1), nb_ = 4 * (g8_ % nq_) + (l8_ >> 1)
#define CV_ISSUE(cx, item, ok, dst) do { CV_DECODE((ok) ? (item) : 0); int ln_ = lane; asm volatile("" : "+v"(ln_)); const int lk = ln_ >> 3, lc4 = ln_ & 7;     \
        const float* src_ = (ok) ? (w1_ ? cx.W1 : cx.W2) + (size_t)mat_ * 1024 * N_ + (size_t)(64 * kb_ + lk) * N_ + 32 * nb_ + 4 * lc4 : cx.W1; \
        const size_t rs_ = (ok) ? (size_t)(8 * N_) : 0; \
        _Pragma("unroll") for (int i = 0; i < 8; ++i) dst[i] = __builtin_nontemporal_load((const f32x4*)(src_ + (size_t)i * rs_)); \
        } while (0)
#define CV_PROCESS(cx, item, ok, v, scr) do { CV_DECODE((ok) ? (item) : 0); const int k0 = 64 * kb_, n0 = 32 * nb_; int ln_ = lane; asm volatile("" : "+v"(ln_)); const int lk = ln_ >> 3, lc4 = ln_ & 7; \
        const float* gp_ = cx.kg + 64 * kb_ + 8 * lc4; const f32x4 gl0_ = *(const f32x4*)gp_, gl1_ = *(const f32x4*)(gp_ + 4); \
        const f32x4 G0 = w1_ ? gl0_ : (f32x4){1.f, 1.f, 1.f, 1.f}, G1 = w1_ ? gl1_ : (f32x4){1.f, 1.f, 1.f, 1.f}; \
        _Pragma("unroll") for (int i = 0; i < 8; ++i) \
            _Pragma("unroll") for (int e = 0; e < 4; ++e) scr[(lk + 8 * i) * 33 + 4 * lc4 + e] = v[i][e]; \
        asm volatile("s_waitcnt lgkmcnt(0)" ::: "memory"); \
        const int bj_ = n0 >> 10, rest_ = n0 & 1023; const int d0 = w1_ ? (rest_ >> 7) * 256 + bj_ * 128 + (rest_ & 127) : n0; \
        bf16_t* dst = (ok) ? (w1_ ? cx.T1 : cx.T2) + (size_t)mat_ * 1024 * N_ : cx.dump; \
        _Pragma("unroll") for (int j = 0; j < 4; ++j) { const int n = lk + 8 * j; const LAS float* sp = scr + (8 * lc4) * 33 + n; \
            u32x4 o; o.x = cvt_pk_bf16(sp[0 * 33] * G0[0], sp[1 * 33] * G0[1]); o.y = cvt_pk_bf16(sp[2 * 33] * G0[2], sp[3 * 33] * G0[3]); o.z = cvt_pk_bf16(sp[4 * 33] * G1[0], sp[5 * 33] * G1[1]); o.w = cvt_pk_bf16(sp[6 * 33] * G1[2], sp[7 * 33] * G1[3]); \
            __builtin_nontemporal_store(o, (u32x4*)(dst + (size_t)(d0 + n) * 1024 + k0 + 8 * lc4)); } \
        asm volatile("s_waitcnt lgkmcnt(0)" ::: "memory"); } while (0)
template <int MODE> __device__ __forceinline__ int p_s5_pass(const int wv, const bf16_t* proj16, const float2* abar, const float2* a256, const bf16_t* BB16, const bf16_t* CM16, const float* dskip,
                                                              float2* E, bf16_t* yg16, LAS unsigned char* lds, const ConvCtx cx) {
    LTID();
    const int lane = tidx & 63, fr = lane & 15, fq = lane >> 4;
    LAS unsigned char* L = lds + wv * (16 * S5_ROWB);
    LAS float* scr = (LAS float*)L;
    f32x4 cva[8], cvb[8];
    int mdone = 0;
    for (int unit = bidx * NW + wv; unit < S5_NCH * 32; unit += gridDim.x * NW) {
        const int g = unit & 31, chunk = unit >> 5;
        const float2 a = abar[g * 64 + lane];
        bf16x4 bbf[8];
#pragma unroll
        for (int cb = 0; cb < 8; ++cb) bbf[cb] = *(const bf16x4*)(BB16 + ((size_t)g * 128 + 16 * cb + fr) * 16 + 4 * fq);
        bf16x8 cmf[4]; f32x4 dsk = (f32x4){0.f, 0.f, 0.f, 0.f};
        if (MODE == 1) {
#pragma unroll
            for (int s4 = 0; s4 < 4; ++s4) cmf[s4] = *(const bf16x8*)(CM16 + ((size_t)g * 16 + fr) * 128 + 32 * s4 + 8 * fq);
            dsk = *(const f32x4*)(dskip + g * 16 + 4 * fq);
        }
        float sr = 0.f, si = 0.f;
        if (MODE == 1) {
            const float2 A = a256[g * 64 + lane];
            for (int j0 = 0; j0 < chunk; j0 += 16) {
                float2 e[16];
#pragma unroll
                for (int k = 0; k < 16; ++k) { const int j = (j0 + k < chunk) ? j0 + k : chunk - 1; e[k] = E[((size_t)j * 32 + g) * 64 + lane]; }
#pragma unroll
                for (int k = 0; k < 16; ++k) if (j0 + k < chunk) { const float nr = A.x * sr - A.y * si + e[k].x, ni = A.x * si + A.y * sr + e[k].y; sr = nr; si = ni; }
            }
        }
        const bf16_t* ubase = proj16 + (size_t)(chunk * S5_CHUNK + fr) * DIN + 1536 + g * 16 + 4 * fq;
        bf16x4 uf = *(const bf16x4*)ubase;
#define S5_BLOCK(blk, HOOK) do { \
            const bf16x4 ufn = *(const bf16x4*)(ubase + (size_t)(((blk) < S5_CHUNK / 16 - 1) ? ((blk) + 1) * 16 : (blk) * 16) * DIN); \
            HOOK; \
            asm volatile("" ::: "memory"); \
_Pragma("unroll") \
            for (int cb = 0; cb < 8; ++cb) { \
                const f32x4 d = __builtin_amdgcn_mfma_f32_16x16x16bf16_1k(bbf[cb], uf, (f32x4){0.f, 0.f, 0.f, 0.f}, 0, 0, 0); \
                *(LAS f32x4*)(L + fr * S5_ROWB + (16 * cb + 4 * fq) * 4) = d; \
            } \
            asm volatile("" ::: "memory"); \
_Pragma("unroll") \
            for (int t = 0; t < 16; ++t) { \
                const float re = *(const LAS float*)(L + t * S5_ROWB + lane * 4), im = *(const LAS float*)(L + t * S5_ROWB + 256 + lane * 4); \
                const float nr = a.x * sr - a.y * si + re, ni = a.x * si + a.y * sr + im; sr = nr; si = ni; \
                if (MODE == 1) { *(LAS bf16_t*)(L + t * S5_ROWB + lane * 2) = (bf16_t)f2bf(sr); *(LAS bf16_t*)(L + t * S5_ROWB + 128 + lane * 2) = (bf16_t)f2bf(si); } \
            } \
            asm volatile("" ::: "memory"); \
            if (MODE == 1) { \
                f32x4 y = (f32x4){0.f, 0.f, 0.f, 0.f}; \
_Pragma("unroll") \
                for (int s4 = 0; s4 < 4; ++s4) { const bf16x8 sf = *(const LAS bf16x8*)(L + fr * S5_ROWB + 64 * s4 + 16 * fq); y = __builtin_amdgcn_mfma_f32_16x16x32_bf16(cmf[s4], sf, y, 0, 0, 0); } \
                f32x4 v; \
_Pragma("unroll") \
                for (int j = 0; j < 4; ++j) v[j] = y[j] + dsk[j] * bf2f((unsigned short)uf[j]); \
                const f32x2 g0 = gelu_pk((f32x2){v[0], v[1]}), g1 = gelu_pk((f32x2){v[2], v[3]}); \
                u32x2 o2; o2.x = cvt_pk_bf16(g0.x, g0.y); o2.y = cvt_pk_bf16(g1.x, g1.y); \
                *(u32x2*)(yg16 + (size_t)(chunk * S5_CHUNK + (blk) * 16 + fr) * 512 + g * 16 + 4 * fq) = o2; \
            } \
            asm volatile("" ::: "memory"); \
            uf = ufn; } while (0)
        if constexpr (MODE == 1) {
            const int cvi0 = cx.begin + cx.wr + mdone * cx.stride;
#pragma unroll 1
            for (int q4 = 0; q4 < S5_CHUNK / 64; ++q4) {
                const int ia = cvi0 + (2 * q4) * cx.stride, ibp = cvi0 + (2 * q4 - 1) * cx.stride, ib = cvi0 + (2 * q4 + 1) * cx.stride;
                S5_BLOCK(4 * q4, CV_ISSUE(cx, ia, ia < cx.end, cva));
                S5_BLOCK(4 * q4 + 1, (void)0);
                CV_PROCESS(cx, ibp, q4 > 0 && ibp < cx.end, cvb, scr);
                S5_BLOCK(4 * q4 + 2, CV_ISSUE(cx, ib, ib < cx.end, cvb));
                S5_BLOCK(4 * q4 + 3, (void)0);
                CV_PROCESS(cx, ia, ia < cx.end, cva, scr);
            }
            { const int ib = cvi0 + 7 * cx.stride; CV_PROCESS(cx, ib, ib < cx.end, cvb, scr); }
            mdone += 8;
        } else {
#pragma unroll 1
            for (int blk = 0; blk < S5_CHUNK / 16; ++blk) S5_BLOCK(blk, (void)0);
        }
#undef S5_BLOCK
        if (MODE == 0) E[((size_t)chunk * 32 + g) * 64 + lane] = make_float2(sr, si);
    }
    return mdone;
}
struct EpiGlu16 {
    static constexpr bool PERM = true; static constexpr bool STAGED = false;
    bf16_t* O; const bf16_t* Y; const float* bias;
    __device__ __forceinline__ void operator()(const f32x4 (&acc)[2][2][4][2], const GUnit& u, int wr, int wc, int fr, int fq) const {
        const int row0 = u.pm * BM + wr * 64 + fr, col0 = u.pn * BM + wc * 32 + 8 * fq;
        f32x4 bv[2][2];
#pragma unroll
        for (int bj = 0; bj < 2; ++bj)
#pragma unroll
            for (int n = 0; n < 2; ++n) bv[bj][n] = *(const f32x4*)(bias + col0 + bj * HALF + 4 * n);
#pragma unroll
        for (int ai = 0; ai < 2; ++ai)
#pragma unroll
            for (int m = 0; m < 4; ++m) { const size_t ro = (size_t)(row0 + ai * HALF + m * 16) * 512 + col0;
#pragma unroll
                for (int bj = 0; bj < 2; ++bj) {
                    const u32x4 yv = *(const u32x4*)(Y + ro + bj * HALF);
                    float o[8];
#pragma unroll
                    for (int n = 0; n < 2; ++n)
#pragma unroll
                        for (int j = 0; j < 4; ++j) { const unsigned wd = yv[n * 2 + (j >> 1)]; const float y = __builtin_bit_cast(float, (j & 1) ? (wd & 0xffff0000u) : (wd << 16));
                            o[n * 4 + j] = y / (1.f + __expf(-(acc[ai][bj][m][n][j] + bv[bj][n][j]))); }
                    u32x4 w; w.x = cvt_pk_bf16(o[0], o[1]); w.y = cvt_pk_bf16(o[2], o[3]); w.z = cvt_pk_bf16(o[4], o[5]); w.w = cvt_pk_bf16(o[6], o[7]);
                    *(u32x4*)(O + ro + bj * HALF) = w; } }
    }
};
__device__ __forceinline__ void p_ssm_norm(const int wv, const bf16_t* yb16, const float* g, bf16_t* mix16) {
    LTID();
    const int lane = tidx & 63;
    const f32x4 g0 = *(const f32x4*)(g + lane * 8), g1 = *(const f32x4*)(g + lane * 8 + 4);
    const int rstride = (int)gridDim.x * NW;
    for (int row0 = bidx * NW + wv; row0 < SEQ; row0 += 4 * rstride) {
        u32x4 av[4];
#pragma unroll
        for (int r = 0; r < 4; ++r) { const int row = (row0 + r * rstride < SEQ) ? row0 + r * rstride : row0; av[r] = *(const u32x4*)(yb16 + (size_t)row * 512 + lane * 8); }
#pragma unroll
        for (int r = 0; r < 4; ++r) {
            const int row = row0 + r * rstride;
            float y[8]; float ss = 0.f;
#pragma unroll
            for (int k = 0; k < 4; ++k) { y[2 * k] = __builtin_bit_cast(float, av[r][k] << 16); y[2 * k + 1] = __builtin_bit_cast(float, av[r][k] & 0xffff0000u); ss += y[2 * k] * y[2 * k] + y[2 * k + 1] * y[2 * k + 1]; }
#pragma unroll
            for (int o = 32; o; o >>= 1) ss += shx(ss, o, lane);
            const float sc = rsqrtf(ss * (1.f / 512.f) + 1e-5f);
            u32x4 o4; o4.x = cvt_pk_bf16(y[0] * sc * g0[0], y[1] * sc * g0[1]); o4.y = cvt_pk_bf16(y[2] * sc * g0[2], y[3] * sc * g0[3]);
            o4.z = cvt_pk_bf16(y[4] * sc * g1[0], y[5] * sc * g1[1]); o4.w = cvt_pk_bf16(y[6] * sc * g1[2], y[7] * sc * g1[3]);
            if (row < SEQ) *(u32x4*)(mix16 + (size_t)row * DM + 512 + lane * 8) = o4;
        }
    }
}

__device__ __forceinline__ void p_rmsnorm16(const int wv, const float* in, const float* g, bf16_t* out16, int rows, int rot) {
    LTID();
    const int lane = tidx & 63;
    for (int r = ROTB(rot) * NW + wv; r < rows; r += gridDim.x * NW) {
        f32x4 v[4]; float ss = 0.f;
#pragma unroll
        for (int j = 0; j < 4; ++j) { v[j] = *(const f32x4*)(in + (size_t)r * DM + 4 * lane + 256 * j); ss += (v[j][0] * v[j][0] + v[j][1] * v[j][1]) + (v[j][2] * v[j][2] + v[j][3] * v[j][3]); }
#pragma unroll
        for (int o = 32; o; o >>= 1) ss += shx(ss, o, lane);
        const float sc = rsqrtf(ss * (1.f / 1024.f) + 1e-5f);
#pragma unroll
        for (int j = 0; j < 4; ++j) { const f32x4 gg = *(const f32x4*)(g + 4 * lane + 256 * j); u32x2 o2; o2.x = cvt_pk_bf16(v[j][0] * sc * gg[0], v[j][1] * sc * gg[1]); o2.y = cvt_pk_bf16(v[j][2] * sc * gg[2], v[j][3] * sc * gg[3]);
            *(u32x2*)(out16 + (size_t)r * DM + 4 * lane + 256 * j) = o2; }
    }
}
__device__ __forceinline__ void p_x16(const int wv, const float* x, bf16_t* h16, float* rs) {
    LTID();
    const int lane = tidx & 63;
    const int rstride = (int)gridDim.x * NW;
    for (int r0 = bidx * NW + wv; r0 < SEQ; r0 += 2 * rstride) {
        int rr[2]; rr[0] = r0; rr[1] = (r0 + rstride < SEQ) ? r0 + rstride : r0;
        f32x4 v[2][2][2];
#pragma unroll
        for (int q = 0; q < 2; ++q)
#pragma unroll
            for (int j = 0; j < 2; ++j) { v[q][j][0] = *(const f32x4*)(x + (size_t)rr[q] * DM + 8 * lane + 512 * j); v[q][j][1] = *(const f32x4*)(x + (size_t)rr[q] * DM + 8 * lane + 512 * j + 4); }
#pragma unroll
        for (int q = 0; q < 2; ++q) {
            if (q == 1 && r0 + rstride >= SEQ) break;
            const int r = rr[q];
            float ss = 0.f;
#pragma unroll
            for (int j = 0; j < 2; ++j)
#pragma unroll
                for (int t = 0; t < 2; ++t) ss += (v[q][j][t][0] * v[q][j][t][0] + v[q][j][t][1] * v[q][j][t][1]) + (v[q][j][t][2] * v[q][j][t][2] + v[q][j][t][3] * v[q][j][t][3]);
#pragma unroll
            for (int o = 32; o; o >>= 1) ss += shx(ss, o, lane);
            if (lane == 0) rs[r] = rsqrtf(ss * (1.f / 1024.f) + 1e-5f);
#pragma unroll
            for (int j = 0; j < 2; ++j) { u32x4 w; w.x = cvt_pk_bf16(v[q][j][0][0], v[q][j][0][1]); w.y = cvt_pk_bf16(v[q][j][0][2], v[q][j][0][3]); w.z = cvt_pk_bf16(v[q][j][1][0], v[q][j][1][1]); w.w = cvt_pk_bf16(v[q][j][1][2], v[q][j][1][3]);
                *(u32x4*)(h16 + (size_t)r * DM + 8 * lane + 512 * j) = w; }
        }
    }
}
template <bool LAST> __device__ __forceinline__ void p_combine16(const int wv, bf16_t* h16, const bf16_t* mout, const int* eslot, const float* topg, const float* g, float* rs, float* out) {
    LTID();
    const int lane = tidx & 63;
    LAS const int* ts = (LAS const int*)(LDSP + TS_OFF);
    const int rstride = (int)gridDim.x * NW;
    for (int r0 = bidx * NW + wv; r0 < SEQ; r0 += 2 * rstride) {
        int rr[2]; rr[0] = r0; rr[1] = (r0 + rstride < SEQ) ? r0 + rstride : r0;
        u32x4 hw[2][2]; int4 es[2]; f32x4 gt[2]; u32x4 mo[2][4][2];
#pragma unroll
        for (int q = 0; q < 2; ++q) { es[q] = *(const int4*)(eslot + rr[q] * 4); gt[q] = *(const f32x4*)(topg + rr[q] * 4);
#pragma unroll
            for (int j = 0; j < 2; ++j) hw[q][j] = *(const u32x4*)(h16 + (size_t)rr[q] * DM + 8 * lane + 512 * j); }
#pragma unroll
        for (int q = 0; q < 2; ++q) { const int esv[4] = {es[q].x, es[q].y, es[q].z, es[q].w};
#pragma unroll
            for (int k = 0; k < 4; ++k) { const int e = esv[k] >> 16, sl = esv[k] & 0xffff; const size_t row = (size_t)ts[e] * BM + sl;
#pragma unroll
                for (int j = 0; j < 2; ++j) mo[q][k][j] = *(const u32x4*)(mout + row * DM + 8 * lane + 512 * j); } }
        float v[2][2][8];
#pragma unroll
        for (int q = 0; q < 2; ++q)
#pragma unroll
            for (int j = 0; j < 2; ++j) { const u32x4 o = hw[q][j];
                v[q][j][0] = bflo(o.x); v[q][j][1] = bfhi(o.x); v[q][j][2] = bflo(o.y); v[q][j][3] = bfhi(o.y); v[q][j][4] = bflo(o.z); v[q][j][5] = bfhi(o.z); v[q][j][6] = bflo(o.w); v[q][j][7] = bfhi(o.w); }
#pragma unroll
        for (int q = 0; q < 2; ++q)
#pragma unroll
            for (int k = 0; k < 4; ++k) { const float gk = gt[q][k];
#pragma unroll
                for (int j = 0; j < 2; ++j) { const u32x4 o = mo[q][k][j];
                    v[q][j][0] += gk * bflo(o.x); v[q][j][1] += gk * bfhi(o.x); v[q][j][2] += gk * bflo(o.y); v[q][j][3] += gk * bfhi(o.y);
                    v[q][j][4] += gk * bflo(o.z); v[q][j][5] += gk * bfhi(o.z); v[q][j][6] += gk * bflo(o.w); v[q][j][7] += gk * bfhi(o.w); } }
#pragma unroll
        for (int q = 0; q < 2; ++q) {
            if (q == 1 && r0 + rstride >= SEQ) break;
            const int r = rr[q];
            float ss = 0.f;
#pragma unroll
            for (int j = 0; j < 2; ++j) ss += ((v[q][j][0] * v[q][j][0] + v[q][j][1] * v[q][j][1]) + (v[q][j][2] * v[q][j][2] + v[q][j][3] * v[q][j][3])) + ((v[q][j][4] * v[q][j][4] + v[q][j][5] * v[q][j][5]) + (v[q][j][6] * v[q][j][6] + v[q][j][7] * v[q][j][7]));
#pragma unroll
            for (int o = 32; o; o >>= 1) ss += shx(ss, o, lane);
            const float sc = rsqrtf(ss * (1.f / 1024.f) + 1e-5f);
#pragma unroll
            for (int j = 0; j < 2; ++j) {
                if (!LAST) { u32x4 w; w.x = cvt_pk_bf16(v[q][j][0], v[q][j][1]); w.y = cvt_pk_bf16(v[q][j][2], v[q][j][3]); w.z = cvt_pk_bf16(v[q][j][4], v[q][j][5]); w.w = cvt_pk_bf16(v[q][j][6], v[q][j][7]);
                    *(u32x4*)(h16 + (size_t)r * DM + 8 * lane + 512 * j) = w; }
                else { const f32x4 g0 = *(const f32x4*)(g + 8 * lane + 512 * j), g1 = *(const f32x4*)(g + 8 * lane + 512 * j + 4);
                    *(f32x4*)(out + (size_t)r * DM + 8 * lane + 512 * j) = (f32x4){v[q][j][0] * sc * g0[0], v[q][j][1] * sc * g0[1], v[q][j][2] * sc * g0[2], v[q][j][3] * sc * g0[3]};
                    *(f32x4*)(out + (size_t)r * DM + 8 * lane + 512 * j + 4) = (f32x4){v[q][j][4] * sc * g1[0], v[q][j][5] * sc * g1[1], v[q][j][6] * sc * g1[2], v[q][j][7] * sc * g1[3]}; }
            }
            if (!LAST) { if (lane == 0) rs[r] = sc; }
        }
    }
}
__device__ __forceinline__ void p_router_tables(const int wv, const float* w_r, const float* g, bf16_t* WR16, int rot) {
    LTID();
    for (int i = ROTB(rot) * NT + tidx; i < 32 * 1024; i += gridDim.x * NT) {
        const int e = i >> 10, k = i & 1023;
        const float w = g[k] * w_r[k * 32 + e];
        const unsigned hi = f2bf(w); const float lo = w - __builtin_bit_cast(float, hi << 16);
        WR16[i] = (bf16_t)hi; WR16[32 * 1024 + i] = (bf16_t)f2bf(lo);
    }
}
constexpr int RT_CNT_OFF = 131072 + 4608;
constexpr int RT_XCH_OFF = 131072 + 5120;
__device__ __forceinline__ void p_router2(const int wv, const bf16_t* h16, const bf16_t* WR16, const float* b_r, unsigned* gcnt, int* rowtok_e, float* rsc_e, int* eslot, float* topg, LAS unsigned char* lds) {
    LTID();
    const int lane = tidx & 63, fr = lane & 15, fq = lane >> 4, w = wv, tg = w & 3, kh = w >> 2;
#pragma unroll
    for (int part = 0; part < 2; ++part)
#pragma unroll
        for (int p = 0; p < 8; ++p) { const int row = 4 * p + (tidx >> 7), cs = tidx & 127;
            glds16s(WR16, (unsigned)(part * 65536 + row * 2048 + ((cs ^ (row & 15)) * 16)), (unsigned)(size_t)(lds + part * 65536 + p * 8192 + w * 1024)); }
    LAS int* lcnt = (LAS int*)(lds + RT_CNT_OFF);
    if (tidx < 64) lcnt[tidx] = 0;
    asm volatile("s_waitcnt vmcnt(0)" ::: "memory");
    __syncthreads();
    for (int it = bidx; it < SEQ / 64; it += gridDim.x) {
        const int token = it * 64 + 16 * tg + fr;
        const bf16_t* xr = h16 + (size_t)token * DM + 512 * kh + 8 * fq;
        f32x4 acc[2]; acc[0] = (f32x4){0.f, 0.f, 0.f, 0.f}; acc[1] = acc[0];
        float ss = 0.f;
#pragma unroll 4
        for (int s4 = 0; s4 < 16; ++s4) {
            const u32x4 hw = *(const u32x4*)(xr + 32 * s4);
            { const float x0 = bflo(hw.x), x1 = bfhi(hw.x), x2 = bflo(hw.y), x3 = bfhi(hw.y), x4 = bflo(hw.z), x5 = bfhi(hw.z), x6 = bflo(hw.w), x7 = bfhi(hw.w);
              ss += ((x0 * x0 + x1 * x1) + (x2 * x2 + x3 * x3)) + ((x4 * x4 + x5 * x5) + (x6 * x6 + x7 * x7)); }
            const bf16x8 xhi = __builtin_bit_cast(bf16x8, hw);
            const int c = 64 * kh + 4 * s4 + fq, slot = c ^ fr;
#pragma unroll
            for (int nb = 0; nb < 2; ++nb) {
                const bf16x8 whi = *(const LAS bf16x8*)(lds + (16 * nb + fr) * 2048 + slot * 16), wlo = *(const LAS bf16x8*)(lds + 65536 + (16 * nb + fr) * 2048 + slot * 16);
                acc[nb] = __builtin_amdgcn_mfma_f32_16x16x32_bf16(whi, xhi, acc[nb], 0, 0, 0);
                acc[nb] = __builtin_amdgcn_mfma_f32_16x16x32_bf16(wlo, xhi, acc[nb], 0, 0, 0);
            }
        }
        ss += shx(ss, 16, lane); ss += shx(ss, 32, lane);
        LAS float* X = (LAS float*)(lds + RT_XCH_OFF) + (tg * 64 + lane) * 9;
        if (kh == 1) {
#pragma unroll
            for (int nb = 0; nb < 2; ++nb)
#pragma unroll
                for (int j = 0; j < 4; ++j) X[nb * 4 + j] = acc[nb][j];
            X[8] = ss;
        }
        __syncthreads();
        int ti[4] = {0, 0, 0, 0}, ls[4] = {0, 0, 0, 0}; float gv[4] = {0.f, 0.f, 0.f, 0.f}; float rs = 0.f;
        if (kh == 0) {
            float lv[8];
            ss += X[8];
            rs = rsqrtf(ss * (1.f / 1024.f) + 1e-5f);
#pragma unroll
            for (int nb = 0; nb < 2; ++nb)
#pragma unroll
                for (int j = 0; j < 4; ++j) lv[nb * 4 + j] = rs * (acc[nb][j] + X[nb * 4 + j]) + b_r[16 * nb + 4 * fq + j];
            float tv[4];
#pragma unroll
            for (int r = 0; r < 4; ++r) {
                float bv = -3.0e38f; int bi = 0;
#pragma unroll
                for (int q = 0; q < 8; ++q) { const int idx = 16 * (q >> 2) + 4 * fq + (q & 3); if (lv[q] > bv) { bv = lv[q]; bi = idx; } }
#pragma unroll
                for (int mk = 16; mk <= 32; mk <<= 1) { const float ov = shx(bv, mk, lane); const int oi = shxi(bi, mk, lane); if (ov > bv || (ov == bv && oi < bi)) { bv = ov; bi = oi; } }
                tv[r] = bv; ti[r] = bi;
#pragma unroll
                for (int q = 0; q < 8; ++q) { const int idx = 16 * (q >> 2) + 4 * fq + (q & 3); if (idx == bi) lv[q] = -3.0e38f; }
            }
            float sum = 0.f;
#pragma unroll
            for (int r = 0; r < 4; ++r) { gv[r] = __expf(tv[r] - tv[0]); sum += gv[r]; }
            const float inv = 1.f / sum;
#pragma unroll
            for (int r = 0; r < 4; ++r) gv[r] *= inv;
            if (fq == 0) {
#pragma unroll
                for (int r = 0; r < 4; ++r) ls[r] = __hip_atomic_fetch_add(&lcnt[ti[r]], 1, __ATOMIC_RELAXED, __HIP_MEMORY_SCOPE_WORKGROUP);
            }
        }
        __syncthreads();
        if (tidx < 32) { const int c = lcnt[tidx]; lcnt[32 + tidx] = c ? (int)__hip_atomic_fetch_add(gcnt + tidx, (unsigned)c, __ATOMIC_RELAXED, __HIP_MEMORY_SCOPE_AGENT) : 0; }
        __syncthreads();
        if (kh == 0 && fq == 0) {
            int es[4];
#pragma unroll
            for (int r = 0; r < 4; ++r) { const int e = ti[r], sl = lcnt[32 + e] + ls[r]; rowtok_e[e * ECAP + sl] = token; rsc_e[e * ECAP + sl] = rs; es[r] = (e << 16) | sl; }
            *(int4*)(eslot + token * 4) = make_int4(es[0], es[1], es[2], es[3]);
            *(f32x4*)(topg + token * 4) = (f32x4){gv[0], gv[1], gv[2], gv[3]};
        }
        __syncthreads();
        if (tidx < 32) lcnt[tidx] = 0;
    }
    __syncthreads();
}

constexpr int NPL = 13;
constexpr int NPHASES = 1 + 2 * NPL;
typedef const __attribute__((address_space(4))) Args* KA;
#define PHASE __device__ __forceinline__
#define KAP() ({ KA _t = a; asm volatile("" : "+s"(_t)); _t; })
#define WSP(T, off) ((T*)(a->ws + (off)))

constexpr int NIT = 49152, NIT1 = 32768;
constexpr int QS0 = 5, QS1 = 8, QG = 9, QX = 13;
struct ConvBounds { int S1, S2, S3, S4; };
__device__ __forceinline__ int cmin(int a, int b) { return a < b ? a : b; }
__device__ __forceinline__ ConvBounds conv_bounds(int G, int l) {
    ConvBounds b;
    const int Px = G > 128 ? G - 128 : G, Px0 = G > 136 ? G - 136 : G;
    b.S1 = cmin(NIT, G * 8 * QS0); b.S2 = cmin(NIT, b.S1 + G * 8 * QS1);
    b.S3 = cmin(NIT, b.S2 + Px * 8 * QG); b.S4 = cmin(NIT, b.S3 + (l == 0 ? Px0 : Px) * 8 * QX);
    return b;
}
__device__ __forceinline__ ConvCtx conv_ctx(KA a, int l, int begin, int end, int wr, int stride) {
    ConvCtx c; c.W1 = a->in[26] + (size_t)l * NEXP * DM * 2048; c.W2 = a->in[28] + (size_t)l * NEXP * DFF * DM; c.T1 = WSP(bf16_t, WS_BT1) + (size_t)l * NEXP * 2048 * DM; c.T2 = WSP(bf16_t, WS_BT2) + (size_t)l * NEXP * DM * DFF;
    c.kg = a->in[23] + l * DM; c.dump = WSP(bf16_t, WS_H + 4 * MiB);       c.begin = begin; c.end = end; c.wr = wr; c.stride = stride; return c;
}
__device__ __forceinline__ void conv_moe(KA a, const int wv, int l, int begin, int end, int rank, int nranks, int scr_pitch = 16384) {
    if (begin >= end) return;
    const int wr = rank * NW + wv, ws_ = nranks * NW;
    if (begin < NIT1) p_transpose_r(wv, a->in[26] + (size_t)l * NEXP * DM * 2048, NEXP, DM, 2048, WSP(bf16_t, WS_BT1) + (size_t)l * NEXP * 2048 * DM, a->in[23] + l * DM, NEXP, 1, LDSP, begin, cmin(end, NIT1), wr, ws_, scr_pitch);
    if (end > NIT1) { const int b2 = begin > NIT1 ? begin - NIT1 : 0;
        p_transpose_r(wv, a->in[28] + (size_t)l * NEXP * DFF * DM, NEXP, DFF, DM, WSP(bf16_t, WS_BT2) + (size_t)l * NEXP * DM * DFF, nullptr, 1, 0, LDSP, b2, end - NIT1, wr, ws_, scr_pitch); }
}
__device__ __forceinline__ int moe_T_lds() { return __builtin_amdgcn_readfirstlane(((LAS const int*)(LDSP + TS_OFF))[32]); }
PHASE void ph_init(KA a, const int wv) {
    p_x16(wv, a->in[0], WSP(bf16_t, WS_HB16), WSP(float, WS_RS));
    p_bias_table(wv, a->in[2], WSP(float, WS_BIASG), 152);
    for (int l = 0; l < 2; ++l) {
        p_s5_tables2(wv, a->in[5] + l * 2048, a->in[6] + l * 2048, a->in[7] + l * 32768, a->in[8] + l * 32768, a->in[9] + l * 32768, a->in[10] + l * 32768, a->in[11] + l * 32,
                     WSP(float2, WS_ABAR) + l * 2048, WSP(float2, WS_A256) + l * 2048, WSP(bf16_t, WS_BB16) + (size_t)l * 32 * 128 * 16, WSP(bf16_t, WS_CM16) + (size_t)l * 32 * 16 * 128, 160 + 32 * l);
        p_rmsnorm16(wv, a->in[1], a->in[19] + l * DM, WSP(bf16_t, WS_MEMN16) + (size_t)l * NMEM * DM, NMEM, 224 + 16 * l);
        p_router_tables(wv, a->in[24] + (size_t)l * DM * 32, a->in[23] + l * DM, WSP(bf16_t, WS_WR16) + (size_t)l * 2 * 32 * 1024, 160 + 64 * l);
    }
    p_transpose(wv, a->in[4], 2, DM, DIN, WSP(bf16_t, WS_WT_IN), a->in[3], 1, 0, LDSP, 0);
    p_transpose(wv, a->in[13], 2, 512, 512, WSP(bf16_t, WS_WT_GLU), nullptr, 1, 0, LDSP, 0);
    p_transpose(wv, a->in[17], 2, DM, DM, WSP(bf16_t, WS_WT_OUT), nullptr, 1, 0, LDSP, 32);
    p_transpose(wv, a->in[20], 2, DM, 512, WSP(bf16_t, WS_WT_XQ), a->in[18], 1, 0, LDSP, 160);
    p_transpose(wv, a->in[21], 2, DM, 1024, WSP(bf16_t, WS_WT_XKV), nullptr, 1, 0, LDSP, 224);
    p_transpose(wv, a->in[22], 2, 512, DM, WSP(bf16_t, WS_WT_XO), nullptr, 1, 0, LDSP, 96);
    __syncthreads();
}
PHASE void ph_gemm_in(KA a, const int wv, int l) { LTID();
    DenseOrder S; S.init(WSP(bf16_t, WS_HB16), WSP(bf16_t, WS_WT_IN) + (size_t)l * DIN * DM, SEQ, DIN, DM, gridDim.x, bidx);
    EpiIn E{WSP(bf16_t, WS_PROJ16), WSP(float, WS_RS)};
    gemm_phase<EpiIn, DenseOrder, false, true>(LDSP, DM, S, E, tidx, wv);
}
PHASE void ph_attn_s5a(KA a, const int wv, int l) {
    p_dil_attn(wv, WSP(bf16_t, WS_PROJ16), WSP(float, WS_BIASG), WSP(bf16_t, WS_OBR), WSP(float, WS_LSE), LDSP);
    const ConvBounds cb = conv_bounds((int)gridDim.x, l);
    if (wv & 1) conv_moe(a, wv, l, 0, cb.S1, (int)blockIdx.x, (int)gridDim.x, 16 * S5_ROWB);
    p_s5_pass<0>(wv, WSP(bf16_t, WS_PROJ16), WSP(float2, WS_ABAR) + l * 2048, WSP(float2, WS_A256) + l * 2048, WSP(bf16_t, WS_BB16) + (size_t)l * 32 * 128 * 16, WSP(bf16_t, WS_CM16) + (size_t)l * 32 * 16 * 128,
                 a->in[12] + l * 512, WSP(float2, WS_E2), WSP(bf16_t, WS_YG16), LDSP, conv_ctx(a, l, 0, 0, 0, 8));
    if (!(wv & 1)) conv_moe(a, wv, l, 0, cb.S1, (int)blockIdx.x, (int)gridDim.x, 16 * S5_ROWB);
}
PHASE void ph_s5b(KA a, const int wv, int l) {
    const ConvBounds cb = conv_bounds((int)gridDim.x, l);
    const int cstride = (int)gridDim.x * NW;
    const int md = p_s5_pass<1>(wv, WSP(bf16_t, WS_PROJ16), WSP(float2, WS_ABAR) + l * 2048, WSP(float2, WS_A256) + l * 2048, WSP(bf16_t, WS_BB16) + (size_t)l * 32 * 128 * 16, WSP(bf16_t, WS_CM16) + (size_t)l * 32 * 16 * 128,
                 a->in[12] + l * 512, WSP(float2, WS_E2), WSP(bf16_t, WS_YG16), LDSP, conv_ctx(a, l, cb.S1, cb.S2, (int)blockIdx.x * NW + wv, cstride));
    conv_moe(a, wv, l, cmin(cb.S1 + md * cstride, cb.S2), cb.S2, (int)blockIdx.x, (int)gridDim.x, 16 * S5_ROWB);
}
PHASE void ph_gemm_glu(KA a, const int wv, int l) {
    {   LTID();
        DenseOrder S; S.init(WSP(bf16_t, WS_YG16), WSP(bf16_t, WS_WT_GLU) + (size_t)l * 512 * 512, SEQ, 512, 512, gridDim.x, bidx);
        EpiGlu16 E{WSP(bf16_t, WS_YB16), WSP(bf16_t, WS_YG16), a->in[14] + l * 512};
        gemm_phase<EpiGlu16, DenseOrder, false, false>(LDSP, 512, S, E, tidx, wv); }
    {   LTID();
        const int G = (int)gridDim.x; const ConvBounds cb = conv_bounds(G, l);
        if (G > 128) { if (bidx >= 128) conv_moe(a, wv, l, cb.S2, cb.S3, bidx - 128, G - 128); }
        else conv_moe(a, wv, l, cb.S2, cb.S3, bidx, G);
    }
}
PHASE void ph_mixnorm(KA a, const int wv, int l) {
    p_attn_combine(wv, WSP(bf16_t, WS_OBR), WSP(float, WS_LSE), a->in[15] + l * 512, WSP(bf16_t, WS_MIX16));
    p_ssm_norm(wv, WSP(bf16_t, WS_YB16), a->in[16] + l * 512, WSP(bf16_t, WS_MIX16));
}
PHASE void ph_gemm_out(KA a, const int wv, int l) { LTID();
    DenseOrder S; S.init(WSP(bf16_t, WS_MIX16), WSP(bf16_t, WS_WT_OUT) + (size_t)l * DM * DM, SEQ, DM, DM, gridDim.x, bidx);
    {   EpiRes16<false, true> E{WSP(bf16_t, WS_HB16), WSP(bf16_t, WS_HB16), WSP(float, WS_SSP)};
        gemm_phase<EpiRes16<false, true>, DenseOrder, false, false>(LDSP, DM, S, E, tidx, wv); }
}
PHASE void ph_gemm_xq(KA a, const int wv, int l) {
    {   LTID();
        DenseOrder S; S.init(WSP(bf16_t, WS_HB16), WSP(bf16_t, WS_WT_XQ) + (size_t)l * 512 * DM, SEQ, 512, DM, gridDim.x, bidx);
        EpiBf16 E{WSP(bf16_t, WS_QX16), 512, 0.08838834764831845f, WSP(float, WS_SSP)};
        gemm_phase<EpiBf16, DenseOrder, false, false>(LDSP, DM, S, E, tidx, wv); }
    {   LTID();
    const int cc = (int)gridDim.x - 1 - bidx;
    if (l == 0 && cc < 8) {
        const int kl = cc >> 2;
        DenseOrder S; S.init(WSP(bf16_t, WS_MEMN16) + (size_t)kl * NMEM * DM, WSP(bf16_t, WS_WT_XKV) + (size_t)kl * 1024 * DM, NMEM, 1024, DM, 4, cc & 3);
        EpiBf16 E{WSP(bf16_t, WS_KV16) + (size_t)kl * NMEM * 1024, 1024, 1.f, nullptr};
        gemm_phase<EpiBf16, DenseOrder, false, false>(LDSP, DM, S, E, tidx, wv);
    } }
    {   LTID();
        const int G = (int)gridDim.x; const ConvBounds cb = conv_bounds(G, l);
        const int skip = (l == 0) ? 8 : 0;
        if (G > 128 + skip) { if (bidx >= 128 && bidx < G - skip) conv_moe(a, wv, l, cb.S3, cb.S4, bidx - 128, G - 128 - skip); }
        else conv_moe(a, wv, l, cb.S3, cb.S4, bidx, G);
    }
}
PHASE void ph_xattn(KA a, const int wv, int l) { p_xattn_mfma(wv, WSP(bf16_t, WS_QX16), WSP(bf16_t, WS_KV16) + (size_t)l * NMEM * 1024, WSP(bf16_t, WS_OX16), LDSP); }
PHASE void ph_gemm_xo(KA a, const int wv, int l) { LTID();
    DenseOrder S; S.init(WSP(bf16_t, WS_OX16), WSP(bf16_t, WS_WT_XO) + (size_t)l * DM * 512, SEQ, DM, 512, gridDim.x, bidx);
    EpiRes16<false, false> E{WSP(bf16_t, WS_HB16), WSP(bf16_t, WS_HB16), nullptr};
    gemm_phase<EpiRes16<false, false>, DenseOrder, false, false>(LDSP, 512, S, E, tidx, wv);
}
PHASE void ph_router(KA a, const int wv, int l) {
    {   LTID();
        const int G = (int)gridDim.x; const ConvBounds cb = conv_bounds(G, l);
        conv_moe(a, wv, l, cb.S4, NIT, bidx, G);
        __syncthreads();
    }
    p_router2(wv, WSP(bf16_t, WS_HB16), WSP(bf16_t, WS_WR16) + (size_t)l * 2 * 32 * 1024, a->in[25] + l * 32, WSP(unsigned, WS_CTL) + CW_CNT + l * 32,
              WSP(int, WS_ROWTOK), WSP(float, WS_RSC), WSP(int, WS_ESLOT), WSP(float, WS_TOPG), LDSP);
}
__device__ __forceinline__ int moe_split(int T, int G) {
    const int tpr = G / 8, Ta = (T / tpr) * tpr;
    const int base = (8 * T + G - 1) / G + (4 * T + G - 1) / G, alt = (8 * Ta) / G + (8 * (T - Ta) + 4 * T + G - 1) / G;
    return (Ta > 0 && Ta < T && alt < base) ? Ta : T;
}
PHASE void ph_moe1(KA a, const int wv, int l) {
    {   LTID();
        moe_tiles(WSP(unsigned, WS_CTL) + CW_CNT + l * 32, tidx);
        const int G = (int)gridDim.x, T = moe_T_lds(), Ta = moe_split(T, G);
        MoeOrder<true> S; S.init(WSP(bf16_t, WS_HB16), WSP(bf16_t, WS_BT1) + (size_t)l * NEXP * 2048 * DM, WSP(int, WS_ROWTOK), 2048, DM, (size_t)2048 * DM * 2, G, bidx, 0, Ta, 0);
        EpiMoe1 E{WSP(bf16_t, WS_ACT), a->in[27] + (size_t)l * NEXP * 2048, WSP(float, WS_RSC)};
        gemm_phase<EpiMoe1, MoeOrder<true>, true, true>(LDSP, DM, S, E, tidx, wv); }
}
PHASE void ph_moe2(KA a, const int wv, int l) {
    {   LTID();
        moe_tiles(WSP(unsigned, WS_CTL) + CW_CNT + l * 32, tidx);
        const int G = (int)gridDim.x, T = moe_T_lds(), Ta = moe_split(T, G), n1 = 8 * (T - Ta);
        if (n1 > 0) {
            MoeOrder<true> S; S.init(WSP(bf16_t, WS_HB16), WSP(bf16_t, WS_BT1) + (size_t)l * NEXP * 2048 * DM, WSP(int, WS_ROWTOK), 2048, DM, (size_t)2048 * DM * 2, G, bidx, Ta, T - Ta, 0);
            EpiMoe1 E{WSP(bf16_t, WS_ACT), a->in[27] + (size_t)l * NEXP * 2048, WSP(float, WS_RSC)};
            gemm_phase<EpiMoe1, MoeOrder<true>, true, true>(LDSP, DM, S, E, tidx, wv);
            const int mine = n1 > bidx ? (n1 - 1 - bidx) / G + 1 : 0;
            if (mine > 0) {
                asm volatile("s_waitcnt vmcnt(0)" ::: "memory");
                __syncthreads();
                if (tidx == 0) { __builtin_amdgcn_fence(__ATOMIC_RELEASE, "agent"); asm volatile("s_waitcnt vmcnt(0)" ::: "memory");
                    __hip_atomic_fetch_add(WSP(unsigned, WS_CTL) + CW_MX + l, (unsigned)mine, __ATOMIC_RELAXED, __HIP_MEMORY_SCOPE_AGENT); }
            }
        } }
    {   LTID();
        const int G = (int)gridDim.x, T = moe_T_lds(), Ta = moe_split(T, G), n1 = 8 * (T - Ta);
        MoeOrder<false> S; S.init(WSP(bf16_t, WS_ACT), WSP(bf16_t, WS_BT2) + (size_t)l * NEXP * DM * DFF, nullptr, DM, DFF, (size_t)DM * DFF * 2, G, bidx, 0, Ta, n1);
        EpiMoe2 E{WSP(bf16_t, WS_MOUT), a->in[29] + (size_t)l * NEXP * DM};
        gemm_phase<EpiMoe2, MoeOrder<false>, false, true>(LDSP, DFF, S, E, tidx, wv); }
    {   LTID();
        const int G = (int)gridDim.x, T = moe_T_lds(), Ta = moe_split(T, G), n1 = 8 * (T - Ta);
        if (n1 > 0) {
            MoeOrder<false> S; S.init(WSP(bf16_t, WS_ACT), WSP(bf16_t, WS_BT2) + (size_t)l * NEXP * DM * DFF, nullptr, DM, DFF, (size_t)DM * DFF * 2, G, bidx, Ta, T - Ta, n1 + 4 * Ta);
            GUnit u0;
            if (S.next(0, u0)) {
                if (tidx == 0) { unsigned sp = 0;
                    while (__hip_atomic_load(WSP(unsigned, WS_CTL) + CW_MX + l, __ATOMIC_RELAXED, __HIP_MEMORY_SCOPE_AGENT) < (unsigned)n1) { __builtin_amdgcn_s_sleep(2); if (++sp > (1u << 24)) break; }
                    __builtin_amdgcn_fence(__ATOMIC_ACQUIRE, "agent"); }
                __syncthreads();
                EpiMoe2 E{WSP(bf16_t, WS_MOUT), a->in[29] + (size_t)l * NEXP * DM};
                gemm_phase<EpiMoe2, MoeOrder<false>, false, true>(LDSP, DFF, S, E, tidx, wv);
            }
        } }
}
PHASE void ph_combine(KA a, const int wv, int l) { LTID();
    moe_tiles(WSP(unsigned, WS_CTL) + CW_CNT + l * 32, tidx);
    if (l == 0) p_combine16<false>(wv, WSP(bf16_t, WS_HB16), WSP(bf16_t, WS_MOUT), WSP(int, WS_ESLOT), WSP(float, WS_TOPG), nullptr, WSP(float, WS_RS), nullptr);
    else p_combine16<true>(wv, WSP(bf16_t, WS_HB16), WSP(bf16_t, WS_MOUT), WSP(int, WS_ESLOT), WSP(float, WS_TOPG), a->in[30], nullptr, a->out);
}

__global__ void __launch_bounds__(NT, 2) mega(Args args) {
    KA a = (KA)__builtin_amdgcn_kernarg_segment_ptr();
    int wv = __builtin_amdgcn_readfirstlane((int)threadIdx.x >> 6); asm volatile("" : "+s"(wv));
    LAS unsigned char* lds = LDSP;
    volatile LAS unsigned* MISC = (volatile LAS unsigned*)(lds + MISC_OFF);
    unsigned* ctl = (unsigned*)(a->ws + WS_CTL);
    if (threadIdx.x < 32) MISC[threadIdx.x] = 0u;
    __syncthreads();
    XcdBarrier bar; bar.bar = ctl + CW_BAR; bar.x = 0; bar.st = nullptr;
    if (!MK_PER_PHASE) bar = xcd_barrier_post(ctl + CW_BAR, MISC + 8);
    const int lo = a->ph_lo, hi = a->ph_hi;
#define IN(k) (lo <= (k) && (k) < hi)
#define SEAM(k) do { if (IN(k) && IN((k) + 1)) { LTID(); xcd_barrier(bar.bar, bar.x, bar.st, tidx == 0); if (PROBE_DUP == 200) xcd_barrier(bar.bar, bar.x, bar.st, tidx == 0); \
        if (PROBE_AMP_LO >= 0 && ((k) == PROBE_AMP_LO - 1 || (k) == PROBE_AMP_HI)) { if (bidx == 0) { volatile LAS unsigned* M_ = MISC + 20; \
            if (tidx == 0) { const unsigned t_ = (unsigned)__builtin_amdgcn_s_memrealtime(); if ((k) != PROBE_AMP_HI) M_[0] = t_; \
                else { const unsigned d_ = (t_ - M_[0]) * PROBE_AMP_K; while ((unsigned)__builtin_amdgcn_s_memrealtime() - t_ < d_) __builtin_amdgcn_s_sleep(8); } } \
            __syncthreads(); } } } } while (0)
    if (IN(0)) { ph_init(KAP(), wv); if (PROBE_DUP == 100) ph_init(KAP(), wv); }
    SEAM(0);
#define LAYER_PROGRAM(l) { const int pb = 1 + (l) * NPL; \
        if (IN(pb + 0)) { ph_gemm_in(KAP(), wv, (l)); if (PROBE_DUP == 0) { ph_gemm_in(KAP(), wv, (l)); } } \
        SEAM(pb + 0); \
        if (IN(pb + 1)) { ph_attn_s5a(KAP(), wv, (l)); if (PROBE_DUP == 1) { ph_attn_s5a(KAP(), wv, (l)); } } \
        SEAM(pb + 1); \
        if (IN(pb + 2)) { ph_s5b(KAP(), wv, (l)); if (PROBE_DUP == 2) { ph_s5b(KAP(), wv, (l)); } } \
        SEAM(pb + 2); \
        if (IN(pb + 3)) { ph_gemm_glu(KAP(), wv, (l)); if (PROBE_DUP == 3) { ph_gemm_glu(KAP(), wv, (l)); } } \
        SEAM(pb + 3); \
        if (IN(pb + 4)) { ph_mixnorm(KAP(), wv, (l)); if (PROBE_DUP == 4) { ph_mixnorm(KAP(), wv, (l)); } } \
        SEAM(pb + 4); \
        if (IN(pb + 5)) { ph_gemm_out(KAP(), wv, (l)); if (PROBE_DUP == 5) { ph_gemm_out(KAP(), wv, (l)); } } \
        SEAM(pb + 5); \
        if (IN(pb + 6)) { ph_gemm_xq(KAP(), wv, (l)); if (PROBE_DUP == 6) { ph_gemm_xq(KAP(), wv, (l)); } } \
        SEAM(pb + 6); \
        if (IN(pb + 7)) { ph_xattn(KAP(), wv, (l)); if (PROBE_DUP == 7) { ph_xattn(KAP(), wv, (l)); } } \
        SEAM(pb + 7); \
        if (IN(pb + 8)) { ph_gemm_xo(KAP(), wv, (l)); if (PROBE_DUP == 8) { ph_gemm_xo(KAP(), wv, (l)); } } \
        SEAM(pb + 8); \
        if (IN(pb + 9)) { ph_router(KAP(), wv, (l)); if (PROBE_DUP == 9) { ph_router(KAP(), wv, (l)); } } \
        SEAM(pb + 9); \
        if (IN(pb + 10)) { ph_moe1(KAP(), wv, (l)); if (PROBE_DUP == 10) { ph_moe1(KAP(), wv, (l)); } } \
        SEAM(pb + 10); \
        if (IN(pb + 11)) { ph_moe2(KAP(), wv, (l)); if (PROBE_DUP == 11) { ph_moe2(KAP(), wv, (l)); } } \
        SEAM(pb + 11); \
        if (IN(pb + 12)) { ph_combine(KAP(), wv, (l)); if (PROBE_DUP == 12) { ph_combine(KAP(), wv, (l)); } } \
        SEAM(pb + 12); }
    LAYER_PROGRAM(0)
    LAYER_PROGRAM(1)
#undef LAYER_PROGRAM
#undef IN
#undef SEAM
}

extern "C" void kernel_launch(void* const* d_in, const int* in_sizes, int n_in, void* d_out, int out_size, void* d_ws, size_t ws_size, hipStream_t stream) {
    static int grid = 0;
    if (grid == 0) {
        if (n_in != 31 || ws_size < WS_END) { fprintf(stderr, "kernel_launch: unexpected n_in %d or ws_size %zu (need %zu)\n", n_in, ws_size, (size_t)WS_END); grid = -1; return; }
        int dev = 0, cus = 0, per_cu = 0;
        if (hipGetDevice(&dev) != hipSuccess || hipDeviceGetAttribute(&cus, hipDeviceAttributeMultiprocessorCount, dev) != hipSuccess) { grid = -1; return; }
        if (hipFuncSetAttribute((const void*)mega, hipFuncAttributeMaxDynamicSharedMemorySize, LDS_BYTES) != hipSuccess) { fprintf(stderr, "kernel_launch: hipFuncSetAttribute failed\n"); grid = -1; return; }
        if (hipOccupancyMaxActiveBlocksPerMultiprocessor(&per_cu, (const void*)mega, NT, LDS_BYTES) != hipSuccess || per_cu < 1)
            fprintf(stderr, "kernel_launch: occupancy query reports %d workgroups per CU\n", per_cu);
        (void)hipGetLastError();
        grid = cus;
    }
    if (grid < 0) return;
    if (hipMemsetAsync((char*)d_ws + WS_CTL, 0, CTL_ZERO_BYTES, stream) != hipSuccess) return;
    Args a{};
    for (int i = 0; i < 31; ++i) a.in[i] = (const float*)d_in[i];
    a.out = (float*)d_out; a.ws = (unsigned char*)d_ws;
#if MK_PER_PHASE
    for (int p = 0; p < NPHASES; ++p) { a.ph_lo = p; a.ph_hi = p + 1; hipLaunchKernelGGL(mega, dim3(grid), dim3(NT), LDS_BYTES, stream, a); }
#else
    a.ph_lo = 0; a.ph_hi = NPHASES;
    hipLaunchKernelGGL(mega, dim3(grid), dim3(NT), LDS_BYTES, stream, a);
#endif
}
```
